# Optimizing an MI355X kernel written in HIP

```python
import jax, jax.numpy as jnp
from jax import lax
import numpy as np


D_MODEL = 2048
BATCH = 4
SEQ = 4096
DEPTH = 2

GRID_W = 64
CTX_LEN = 256
EPS = 1e-6
F32 = jnp.float32

MLSTM_HEADS = 4
MLSTM_DK = 256
MLSTM_DV = 256
MLSTM_CHUNK = 64
MLSTM_QK = MLSTM_HEADS * MLSTM_DK
MLSTM_V = MLSTM_HEADS * MLSTM_DV
MLSTM_GATES = 2 * 2 * MLSTM_HEADS
NA_HEADS = 8
NA_DIM = 128
NA_WIDTH = NA_HEADS * NA_DIM
NA_KH = 8
NA_KW = 16
GQA_HEADS = 16
GQA_KV_HEADS = 4
GQA_DIM = 64
GQA_Q = GQA_HEADS * GQA_DIM
GQA_KV = GQA_KV_HEADS * GQA_DIM
GQA_WINDOW = 128
GQA_BLOCK = 128
ROPE_THETA = 10000.0
LRU_WIDTH = 1024
LRU_BLOCKS = 8
LRU_BS = LRU_WIDTH // LRU_BLOCKS
LRU_CONV = 4
LRU_C = 8.0
N_EXPERTS = 16
EC_FACTOR = 2
EXPERT_FF = 2048

AB_SIZES = (MLSTM_QK, MLSTM_QK, MLSTM_V, MLSTM_V, MLSTM_GATES, NA_WIDTH, NA_WIDTH, NA_WIDTH)
AB_IN = 2 * MLSTM_QK + 2 * MLSTM_V + MLSTM_GATES + 3 * NA_WIDTH
AB_OUT = MLSTM_V + NA_WIDTH
CD_SIZES = (GQA_Q, GQA_KV, GQA_KV, LRU_WIDTH, LRU_WIDTH)
CD_IN = GQA_Q + 2 * GQA_KV + 2 * LRU_WIDTH
CD_OUT = GQA_Q + LRU_WIDTH

kernel_name = 'hybrid_mlstm_na_swa_rglru_ecmoe_dit'


def _split(t, sizes):
    offs = []
    acc = 0
    for s in sizes[:-1]:
        acc += s
        offs.append(acc)
    return jnp.split(t, offs, axis=-1)


def _rmsnorm(x, w):
    x32 = x.astype(F32)
    y = x32 * lax.rsqrt(jnp.mean(x32 * x32, axis=-1, keepdims=True) + EPS)
    return (y * w.astype(F32)).astype(x.dtype)


def _modulate(h, shift, scale):
    return h * (1.0 + scale) + shift


def _rope_1d(x, pos):
    half = x.shape[-1] // 2
    inv = ROPE_THETA ** (-(jnp.arange(half, dtype=F32) / half))
    ang = pos.astype(F32)[:, None] * inv[None, :]
    cos = jnp.cos(ang)[None, :, None, :]
    sin = jnp.sin(ang)[None, :, None, :]
    x32 = x.astype(F32)
    x1, x2 = x32[..., :half], x32[..., half:]
    return jnp.concatenate([x1 * cos - x2 * sin, x2 * cos + x1 * sin], axis=-1).astype(x.dtype)


def _rope_2d(x, row, col):
    half = x.shape[-1] // 2
    return jnp.concatenate([_rope_1d(x[..., :half], row), _rope_1d(x[..., half:], col)], axis=-1)


def _dense_attn(q, k, v, sink):
    B, L, Hq, d = q.shape
    Hkv = k.shape[2]
    G = Hq // Hkv
    qg = q.reshape(B, L, Hkv, G, d)
    s = jnp.einsum('bqkgd,bskd->bkgqs', qg, k).astype(F32) * (d ** -0.5)
    if sink is not None:
        sk = jnp.broadcast_to(sink.reshape(Hkv, G).astype(F32)[None, :, :, None, None], (B, Hkv, G, L, 1))
        s = jnp.concatenate([s, sk], axis=-1)
    p = jax.nn.softmax(s, axis=-1)[..., :L].astype(v.dtype)
    return jnp.einsum('bkgqs,bskd->bqkgd', p, v).reshape(B, L, Hq * d)


def _mlstm_prep(q, k, v, o, g, gate_b):
    B, N, _ = q.shape
    H = MLSTM_HEADS

    def heads(t, d):
        return jnp.transpose(t.reshape(B, N, H, d), (0, 2, 1, 3)).astype(F32)

    q = heads(q, MLSTM_DK)
    k = heads(k, MLSTM_DK) * (MLSTM_DK ** -0.5)
    v = heads(v, MLSTM_DV)
    g = g.reshape(B, N, 2, 2, H).astype(F32) + gate_b.astype(F32)
    g = jnp.transpose(g, (2, 3, 0, 4, 1))
    ig = g[:, 0]
    lf = jax.nn.log_sigmoid(g[:, 1])
    return q, k, v, o, ig, lf


def _mlstm_scan(q, k, v, ig, lf, state, emit):
    B, H, N, _ = q.shape
    L = MLSTM_CHUNK
    nc = N // L

    def chunks(t):
        return jnp.moveaxis(t.reshape((B, H, nc, L) + t.shape[3:]), 2, 0)

    causal = jnp.tril(jnp.ones((L, L), dtype=bool))

    def step(carry, xs):
        C, n, m = carry
        qc, kc, vc, ic, fc = xs
        b = jnp.cumsum(fc, axis=-1)
        dmat = jnp.where(causal, b[..., :, None] - b[..., None, :] + ic[..., None, :], -jnp.inf)
        inter = b + m[..., None]
        mj = jnp.maximum(inter, jnp.max(dmat, axis=-1))
        s = jnp.einsum('bhjd,bhsd->bhjs', qc, kc) * jnp.exp(dmat - mj[..., None])
        w_inter = jnp.exp(inter - mj)
        num = w_inter[..., None] * jnp.einsum('bhjd,bhde->bhje', qc, C) + jnp.einsum('bhjs,bhse->bhje', s, vc)
        den = w_inter * jnp.einsum('bhjd,bhd->bhj', qc, n) + jnp.sum(s, axis=-1)
        h = num / jnp.maximum(jnp.abs(den), jnp.exp(-mj))[..., None]
        g = b[..., -1:] - b + ic
        m_new = jnp.maximum(b[..., -1] + m, jnp.max(g, axis=-1))
        decay = jnp.exp(b[..., -1] + m - m_new)
        wg = jnp.exp(g - m_new[..., None])
        C = decay[..., None, None] * C + jnp.einsum('bhs,bhsd,bhse->bhde', wg, kc, vc)
        n = decay[..., None] * n + jnp.einsum('bhs,bhsd->bhd', wg, kc)
        return (C, n, m_new), (h if emit else None)

    state, h = lax.scan(step, state, (chunks(q), chunks(k), chunks(v), chunks(ig), chunks(lf)))
    if emit:
        h = jnp.moveaxis(h, 0, 2).reshape(B, H, N, v.shape[-1])
    return h, state


def _mlstm_out(h, o, gain):
    B, H, N, dv = h.shape
    hn = _rmsnorm(jnp.transpose(h, (0, 2, 1, 3)), gain.reshape(H, dv)).reshape(B, N, H * dv)
    return (hn * jax.nn.sigmoid(o.astype(F32))).astype(o.dtype)


def _mlstm_bidir(pl, pc, gate_b, head_norm, need_ctx):
    ql, kl, vl, ol, igl, lfl = _mlstm_prep(*pl, gate_b)
    qc, kc, vc, oc, igc, lfc = _mlstm_prep(*pc, gate_b)
    B = ql.shape[0]
    zero = (jnp.zeros((B, MLSTM_HEADS, MLSTM_DK, MLSTM_DV), F32),
            jnp.zeros((B, MLSTM_HEADS, MLSTM_DK), F32),
            jnp.zeros((B, MLSTM_HEADS), F32))
    hs_l, hs_c = [], []
    for d, rev in ((0, False), (1, True)):
        fl = (lambda t: jnp.flip(t, axis=2)) if rev else (lambda t: t)
        h_c, st = _mlstm_scan(fl(qc), fl(kc), fl(vc), fl(igc[d]), fl(lfc[d]), zero, need_ctx)
        h_l, _ = _mlstm_scan(fl(ql), fl(kl), fl(vl), fl(igl[d]), fl(lfl[d]), st, True)
        hs_l.append(fl(h_l))
        if need_ctx:
            hs_c.append(fl(h_c))
    out_l = _mlstm_out(hs_l[0] + hs_l[1], ol, head_norm)
    out_c = _mlstm_out(hs_c[0] + hs_c[1], oc, head_norm) if need_ctx else None
    return out_l, out_c


def _neighbourhood_attn(pl, pc, rpb, rows_n, need_ctx):
    B, N, _ = pl[0].shape
    H, d = NA_HEADS, NA_DIM
    ql, kl, vl = [t.reshape(B, N, H, d) for t in pl]
    qc, kc, vc = [t.reshape(B, t.shape[1], H, d) for t in pc]
    kh = min(NA_KH, rows_n)
    kw = NA_KW
    nk = kh * kw
    scale = d ** -0.5
    kg = kl.reshape(B, rows_n, GRID_W, H, d)
    vg = vl.reshape(B, rows_n, GRID_W, H, d)
    qg = jnp.moveaxis(ql.reshape(B, rows_n, GRID_W, H, d), 1, 0)
    col_start = np.clip(np.arange(GRID_W) - kw // 2, 0, GRID_W - kw)
    col_idx = col_start[:, None] + np.arange(kw)[None, :]
    dcol = col_idx - np.arange(GRID_W)[:, None] + (NA_KW - 1)

    def row_step(args):
        r, qr = args
        r0 = jnp.clip(r - kh // 2, 0, rows_n - kh)
        kr = lax.dynamic_slice_in_dim(kg, r0, kh, axis=1)[:, :, col_idx]
        vr = lax.dynamic_slice_in_dim(vg, r0, kh, axis=1)[:, :, col_idx]
        kr = jnp.transpose(kr, (0, 2, 1, 3, 4, 5)).reshape(B, GRID_W, nk, H, d)
        vr = jnp.transpose(vr, (0, 2, 1, 3, 4, 5)).reshape(B, GRID_W, nk, H, d)
        drow = r0 + jnp.arange(kh) - r + (NA_KH - 1)
        bias = rpb[:, drow][:, :, dcol]
        bias = jnp.transpose(bias, (2, 0, 1, 3)).reshape(GRID_W, H, nk).astype(F32)
        s_win = jnp.einsum('bwhd,bwkhd->bwhk', qr, kr).astype(F32) * scale + bias
        s_ctx = jnp.einsum('bwhd,bchd->bwhc', qr, kc).astype(F32) * scale
        p = jax.nn.softmax(jnp.concatenate([s_win, s_ctx], axis=-1), axis=-1).astype(vr.dtype)
        return (jnp.einsum('bwhk,bwkhd->bwhd', p[..., :nk], vr)
                + jnp.einsum('bwhc,bchd->bwhd', p[..., nk:], vc))

    o = lax.map(row_step, (jnp.arange(rows_n), qg))
    out_l = jnp.moveaxis(o, 0, 1).reshape(B, N, H * d)
    out_c = _dense_attn(qc, kc, vc, None) if need_ctx else None
    return out_l, out_c


def _mixer_ab(hl, hc, w_in, w_out, gate_b, head_norm, rpb, rows_n, need_ctx):
    pl = _split(hl @ w_in, AB_SIZES)
    pc = _split(hc @ w_in, AB_SIZES)
    ml, mc = _mlstm_bidir(pl[:5], pc[:5], gate_b, head_norm, need_ctx)
    nl, nc = _neighbourhood_attn(pl[5:], pc[5:], rpb, rows_n, need_ctx)
    yl = jnp.concatenate([ml, nl], axis=-1) @ w_out
    yc = (jnp.concatenate([mc, nc], axis=-1) @ w_out) if need_ctx else None
    return yl, yc


def _window_gqa(q, k, v, kc, vc, sink):
    B, N, Hq, d = q.shape
    Hkv = k.shape[2]
    G = Hq // Hkv
    Lc = kc.shape[1]
    nb = N // GQA_BLOCK
    span = GQA_BLOCK + 2 * GQA_WINDOW
    pad = ((0, 0), (GQA_WINDOW, GQA_WINDOW), (0, 0), (0, 0))
    kp = jnp.pad(k, pad)
    vp = jnp.pad(v, pad)
    qb = jnp.moveaxis(q.reshape(B, nb, GQA_BLOCK, Hkv, G, d), 1, 0)
    s_sink = jnp.broadcast_to(sink.reshape(Hkv, G).astype(F32)[None, :, :, None, None], (B, Hkv, G, GQA_BLOCK, 1))
    scale = d ** -0.5

    def block(args):
        i, qi = args
        start = i * GQA_BLOCK
        ki = lax.dynamic_slice_in_dim(kp, start, span, axis=1)
        vi = lax.dynamic_slice_in_dim(vp, start, span, axis=1)
        kpos = start - GQA_WINDOW + jnp.arange(span)
        qpos = start + jnp.arange(GQA_BLOCK)
        valid = ((kpos >= 0) & (kpos < N))[None, :] & (jnp.abs(qpos[:, None] - kpos[None, :]) <= GQA_WINDOW)
        s_win = jnp.einsum('bqkgd,bskd->bkgqs', qi, ki).astype(F32) * scale
        s_win = jnp.where(valid, s_win, -jnp.inf)
        s_ctx = jnp.einsum('bqkgd,bckd->bkgqc', qi, kc).astype(F32) * scale
        p = jax.nn.softmax(jnp.concatenate([s_win, s_ctx, s_sink], axis=-1), axis=-1).astype(v.dtype)
        return (jnp.einsum('bkgqs,bskd->bqkgd', p[..., :span], vi)
                + jnp.einsum('bkgqc,bckd->bqkgd', p[..., span:span + Lc], vc))

    o = lax.map(block, (jnp.arange(nb), qb))
    return jnp.moveaxis(o, 0, 1).reshape(B, N, Hq * d)


def _conv_centred(x, w, b):
    N = x.shape[1]
    lo = (LRU_CONV - 1) // 2
    hi = LRU_CONV - 1 - lo
    xp = jnp.pad(x, ((0, 0), (lo, hi), (0, 0)))
    out = xp[:, 0:N] * w[0] + b
    for j in range(1, LRU_CONV):
        out = out + xp[:, j:j + N] * w[j]
    return out


def _lin_combine(e1, e2):
    a1, b1 = e1
    a2, b2 = e2
    return a1 * a2, a2 * b1 + b2


def _rglru_dir(u, gw, gb, lam, h0, reverse):
    B, N, W = u.shape
    u32 = u.astype(F32)
    ub = u32.reshape(B, N, LRU_BLOCKS, LRU_BS)
    r = jax.nn.sigmoid(jnp.einsum('bnhi,hij->bnhj', ub, gw[0].astype(F32)).reshape(B, N, W) + gb[0].astype(F32))
    i = jax.nn.sigmoid(jnp.einsum('bnhi,hij->bnhj', ub, gw[1].astype(F32)).reshape(B, N, W) + gb[1].astype(F32))
    log_a = -LRU_C * r * jax.nn.softplus(-lam.astype(F32))
    a = jnp.exp(log_a)
    bterm = jnp.sqrt(-jnp.expm1(2.0 * log_a)) * (i * u32)
    if reverse:
        a = jnp.flip(a, axis=1)
        bterm = jnp.flip(bterm, axis=1)
    A, Hs = lax.associative_scan(_lin_combine, (a, bterm), axis=1)
    h = A * h0[:, None, :] + Hs
    final = h[:, -1]
    if reverse:
        h = jnp.flip(h, axis=1)
    return h, final


def _mixer_cd(hl, hc, w_in, w_out, sink, conv_w, conv_b, gate_w, gate_b, lam, row, col, need_ctx):
    B, N, _ = hl.shape
    Lc = hc.shape[1]
    ql, kl, vl, xl_r, gl_r = _split(hl @ w_in, CD_SIZES)
    qc, kc, vc, xc_r, gc_r = _split(hc @ w_in, CD_SIZES)
    ql = _rope_2d(ql.reshape(B, N, GQA_HEADS, GQA_DIM), row, col)
    kl = _rope_2d(kl.reshape(B, N, GQA_KV_HEADS, GQA_DIM), row, col)
    vl = vl.reshape(B, N, GQA_KV_HEADS, GQA_DIM)
    qc = qc.reshape(B, Lc, GQA_HEADS, GQA_DIM)
    kc = kc.reshape(B, Lc, GQA_KV_HEADS, GQA_DIM)
    vc = vc.reshape(B, Lc, GQA_KV_HEADS, GQA_DIM)
    al = _window_gqa(ql, kl, vl, kc, vc, sink)
    ul = _conv_centred(xl_r, conv_w, conv_b)
    uc = _conv_centred(xc_r, conv_w, conv_b)
    zero = jnp.zeros((B, LRU_WIDTH), F32)
    hs_l, hs_c = [], []
    for d, rev in ((0, False), (1, True)):
        h_c, st = _rglru_dir(uc, gate_w[d], gate_b[d], lam[d], zero, rev)
        h_l, _ = _rglru_dir(ul, gate_w[d], gate_b[d], lam[d], st, rev)
        hs_l.append(h_l)
        hs_c.append(h_c)
    rl = ((hs_l[0] + hs_l[1]) * jax.nn.gelu(gl_r.astype(F32))).astype(hl.dtype)
    yl = jnp.concatenate([al, rl], axis=-1) @ w_out
    yc = None
    if need_ctx:
        ac = _dense_attn(qc, kc, vc, sink)
        rc = ((hs_c[0] + hs_c[1]) * jax.nn.gelu(gc_r.astype(F32))).astype(hc.dtype)
        yc = jnp.concatenate([ac, rc], axis=-1) @ w_out
    return yl, yc


def _ec_moe(h, router, w1, w3, w2):
    B, T, D = h.shape
    cap = EC_FACTOR * T // N_EXPERTS
    aff = jax.nn.softmax((h @ router).astype(F32), axis=-1)
    g, idx = lax.top_k(jnp.swapaxes(aff, 1, 2), cap)
    xs = jax.vmap(lambda hb, ib: hb[ib])(h, idx)
    u = jnp.einsum('becd,edf->becf', xs, w1)
    v = jnp.einsum('becd,edf->becf', xs, w3)
    y = jnp.einsum('becf,efd->becd', jax.nn.silu(u) * v, w2) * g[..., None].astype(h.dtype)
    return jax.vmap(lambda ib, yb: jnp.zeros((T, D), yb.dtype).at[ib.reshape(-1)].add(yb.reshape(-1, D)))(idx, y)


def setup_inputs(seed: int = 0) -> dict:
    key = jax.random.key(seed)
    ks = iter(jax.random.split(key, 40))

    def nrm(shape, std):
        return jax.random.normal(next(ks), shape, F32) * std

    D = D_MODEL
    n_even = (DEPTH + 1) // 2
    n_odd = DEPTH // 2
    gate_base = jnp.stack([jnp.zeros((MLSTM_HEADS,), F32), jnp.linspace(3.0, 6.0, MLSTM_HEADS)])
    u = jax.random.uniform(next(ks), (n_odd, 2, LRU_WIDTH), F32, 0.9, 0.999)
    a = u ** (1.0 / LRU_C)
    return {
        'x': nrm((BATCH, SEQ, D), 1.0),
        'c': nrm((BATCH, D), 1.0),
        'ctx': nrm((BATCH, CTX_LEN, D), 1.0),
        'c_ctx': nrm((D,), 1.0),
        'ada_w': nrm((DEPTH, D, 6 * D), 0.5 * D ** -0.5),
        'ada_b': nrm((DEPTH, 6 * D), 0.02),
        'norm_mix_pre': 1.0 + nrm((DEPTH, D), 0.1),
        'norm_mix_post': 1.0 + nrm((DEPTH, D), 0.1),
        'norm_ffn_pre': 1.0 + nrm((DEPTH, D), 0.1),
        'norm_ffn_post': 1.0 + nrm((DEPTH, D), 0.1),
        'ab_w_in': nrm((n_even, D, AB_IN), D ** -0.5),
        'ab_w_out': nrm((n_even, AB_OUT, D), AB_OUT ** -0.5),
        'mlstm_gate_b': gate_base[None, None] + nrm((n_even, 2, 2, MLSTM_HEADS), 0.1),
        'mlstm_norm': 1.0 + nrm((n_even, MLSTM_V), 0.1),
        'na_rpb': nrm((n_even, NA_HEADS, 2 * NA_KH - 1, 2 * NA_KW - 1), 0.1),
        'cd_w_in': nrm((n_odd, D, CD_IN), D ** -0.5),
        'cd_w_out': nrm((n_odd, CD_OUT, D), CD_OUT ** -0.5),
        'gqa_sink': nrm((n_odd, GQA_HEADS), 0.5),
        'lru_conv_w': nrm((n_odd, LRU_CONV, LRU_WIDTH), LRU_CONV ** -0.5),
        'lru_conv_b': nrm((n_odd, LRU_WIDTH), 0.02),
        'lru_gate_w': nrm((n_odd, 2, 2, LRU_BLOCKS, LRU_BS, LRU_BS), LRU_BS ** -0.5),
        'lru_gate_b': nrm((n_odd, 2, 2, LRU_WIDTH), 0.1),
        'lru_lambda': jnp.log(a) - jnp.log1p(-a),
        'moe_router': nrm((DEPTH, D, N_EXPERTS), D ** -0.5),
        'moe_w1': nrm((DEPTH, N_EXPERTS, D, EXPERT_FF), D ** -0.5),
        'moe_w3': nrm((DEPTH, N_EXPERTS, D, EXPERT_FF), D ** -0.5),
        'moe_w2': nrm((DEPTH, N_EXPERTS, EXPERT_FF, D), EXPERT_FF ** -0.5),
    }


def reference(x, c, ctx, c_ctx, ada_w, ada_b, norm_mix_pre, norm_mix_post, norm_ffn_pre, norm_ffn_post,
              ab_w_in, ab_w_out, mlstm_gate_b, mlstm_norm, na_rpb,
              cd_w_in, cd_w_out, gqa_sink, lru_conv_w, lru_conv_b, lru_gate_w, lru_gate_b, lru_lambda,
              moe_router, moe_w1, moe_w3, moe_w2):
    B, N, D = x.shape
    rows_n = N // GRID_W
    t = jnp.arange(N)
    row = t // GRID_W
    col = t % GRID_W
    cond_l = jax.nn.silu(c.astype(F32))
    cond_c = jax.nn.silu(c_ctx.astype(F32))[None]
    xl, xc = x, ctx
    for l in range(DEPTH):
        last = l == DEPTH - 1
        j = l // 2
        mod_l = (cond_l @ ada_w[l].astype(F32) + ada_b[l].astype(F32)).astype(x.dtype)[:, None]
        mod_c = (cond_c @ ada_w[l].astype(F32) + ada_b[l].astype(F32)).astype(x.dtype)[:, None]
        sh1, sc1, g1, sh2, sc2, g2 = jnp.split(mod_l, 6, axis=-1)
        sh1c, sc1c, g1c, sh2c, sc2c, g2c = jnp.split(mod_c, 6, axis=-1)
        hl = _modulate(_rmsnorm(xl, norm_mix_pre[l]), sh1, sc1)
        hc = _modulate(_rmsnorm(xc, norm_mix_pre[l]), sh1c, sc1c)
        if l % 2 == 0:
            yl, yc = _mixer_ab(hl, hc, ab_w_in[j], ab_w_out[j], mlstm_gate_b[j], mlstm_norm[j], na_rpb[j],
                               rows_n, not last)
        else:
            yl, yc = _mixer_cd(hl, hc, cd_w_in[j], cd_w_out[j], gqa_sink[j], lru_conv_w[j], lru_conv_b[j],
                               lru_gate_w[j], lru_gate_b[j], lru_lambda[j], row, col, not last)
        xl = xl + g1 * _rmsnorm(yl, norm_mix_post[l])
        hl = _modulate(_rmsnorm(xl, norm_ffn_pre[l]), sh2, sc2)
        xl = xl + g2 * _rmsnorm(_ec_moe(hl, moe_router[l], moe_w1[l], moe_w3[l], moe_w2[l]), norm_ffn_post[l])
        if not last:
            xc = xc + g1c * _rmsnorm(yc, norm_mix_post[l])
            hc = _modulate(_rmsnorm(xc, norm_ffn_pre[l]), sh2c, sc2c)
            xc = xc + g2c * _rmsnorm(_ec_moe(hc, moe_router[l], moe_w1[l], moe_w3[l], moe_w2[l]), norm_ffn_post[l])
    return xl
```

```cpp
#include <hip/hip_runtime.h>
#include <stdint.h>
#include <stdio.h>
#include <string.h>

#ifndef N_LAUNCH_MODE
#define N_LAUNCH_MODE 1
#endif

typedef unsigned short u16;
typedef short bf16x8 __attribute__((ext_vector_type(8)));
typedef float f32x4 __attribute__((ext_vector_type(4)));
typedef unsigned u32x4 __attribute__((ext_vector_type(4)));
typedef unsigned u32x2 __attribute__((ext_vector_type(2)));

#define NT 512
constexpr int D = 2048, BATCH = 4, SEQ = 4096, LC = 256;
constexpr int NLAT = BATCH * SEQ, NCTX = BATCH * LC, NTOK = NLAT + NCTX;
constexpr int AB_IN = 7184, CD_IN = 3584;
constexpr int NEXP = 16, FF = 2048, EPAD = 2304;
constexpr int NPH = 20;
constexpr int LDS_BYTES = 150 * 1024;

constexpr size_t al256(size_t x) { return (x + 255) & ~(size_t)255; }
constexpr size_t WS_BAR = 0;
constexpr size_t WS_MOD = 16384;
constexpr size_t WS_XL1 = al256(WS_MOD + 2 * 5 * 12288 * 4);
constexpr size_t WS_XL2 = al256(WS_XL1 + (size_t)NTOK * D * 4);
constexpr size_t WS_H = al256(WS_XL2 + (size_t)NTOK * D * 4);
constexpr size_t WS_P = al256(WS_H + (size_t)NTOK * D * 2);
constexpr size_t WS_G = al256(WS_P + (size_t)NTOK * AB_IN * 2);
constexpr size_t WS_HM = al256(WS_G + (size_t)NTOK * 16 * 4);
constexpr size_t WS_YIN = al256(WS_HM + (size_t)2 * NTOK * 1024 * 2);
constexpr size_t WS_Y = al256(WS_YIN + (size_t)NTOK * D * 2);
constexpr size_t WS_AFF = al256(WS_Y + (size_t)NTOK * D * 4);
constexpr size_t WS_SLOT = al256(WS_AFF + (size_t)NTOK * 16 * 4);
constexpr size_t WS_EROW = al256(WS_SLOT + (size_t)NTOK * 16 * 4);
constexpr size_t WS_EGATE = al256(WS_EROW + (size_t)NEXP * EPAD * 4);
constexpr size_t WS_ACT = al256(WS_EGATE + (size_t)NEXP * EPAD * 4);
constexpr size_t WS_YEXP = al256(WS_ACT + (size_t)NEXP * EPAD * FF * 2);
constexpr size_t WS_LRUS = al256(WS_YEXP + (size_t)NEXP * EPAD * D * 2);
constexpr size_t WS_END = al256(WS_LRUS + (size_t)2 * 2 * 4 * 68 * 1024 * 4);

struct Params {
    const float *x, *c, *ctx, *c_ctx, *ada_w, *ada_b, *norm_mix_pre, *norm_mix_post, *norm_ffn_pre, *norm_ffn_post;
    const float *ab_w_in, *ab_w_out, *mlstm_gate_b, *mlstm_norm, *na_rpb;
    const float *cd_w_in, *cd_w_out, *gqa_sink, *lru_conv_w, *lru_conv_b, *lru_gate_w, *lru_gate_b, *lru_lambda;
    const float *moe_router, *moe_w1, *moe_w3, *moe_w2;
    float* out;
    unsigned char* ws;
    int ph_lo, ph_hi;
};

#define XB_TMO      128
#define XB_XCNT(j)  (256  + 64 * (j))
#define XB_XSUB(j)  (1280 + 64 * (j))
#define XB_XGEN(j)  (2304 + 64 * (j))
#define XB_TOP      3328
#define XB_TOPGEN   3392
#define XCD_BAR_WORDS 3456
#define XB_SPIN_CAP (1u << 22)
#define LAS __attribute__((address_space(3)))

__device__ __forceinline__ unsigned xb_ld(unsigned* p)              { return __hip_atomic_load(p, __ATOMIC_RELAXED, __HIP_MEMORY_SCOPE_AGENT); }
__device__ __forceinline__ unsigned xb_add(unsigned* p, unsigned v) { return __hip_atomic_fetch_add(p, v, __ATOMIC_RELAXED, __HIP_MEMORY_SCOPE_AGENT); }
__device__ __forceinline__ unsigned xb_xcc_id() { return (unsigned)__builtin_amdgcn_s_getreg((3 << 11) | 20) & 0xFu; }
#define XB_SPIN(cond, bar) do { unsigned _sp = 0; while (cond) { __builtin_amdgcn_s_sleep(1); \
    if ((++_sp & 255u) == 0u) { if (xb_ld(&(bar)[XB_TMO])) break; if (_sp > XB_SPIN_CAP) { atomicAdd(&(bar)[XB_TMO], 1u); break; } } } } while (0)

struct XcdBarrier {
    unsigned* bar; unsigned x;
    volatile LAS unsigned* st;
};
__device__ __forceinline__ XcdBarrier xcd_barrier_post(unsigned* bar, volatile LAS unsigned* st) {
    XcdBarrier b; b.bar = bar; b.x = xb_xcc_id(); b.st = st;
    if (threadIdx.x == 0) (void)xb_add(&bar[XB_XCNT(b.x)], 1u);
    return b;
}
__device__ __forceinline__ void xcd_barrier_complete(unsigned* bar, unsigned x, unsigned& nloc, unsigned& nx) {
    const unsigned G = gridDim.x * gridDim.y * gridDim.z;
    unsigned sum, cnt, mine, sp = 0u;
    for (;;) {
        sum = 0u; cnt = 0u; mine = 0u;
#pragma unroll
        for (unsigned j = 0; j < 16; ++j) { const unsigned c = xb_ld(&bar[XB_XCNT(j)]); sum += c; cnt += (c > 0u) ? 1u : 0u; mine = (j == x) ? c : mine; }
        if (sum == G) break;
        __builtin_amdgcn_s_sleep(1);
        if ((++sp & 255u) == 0u) { if (xb_ld(&bar[XB_TMO])) break; if (sp > XB_SPIN_CAP) { atomicAdd(&bar[XB_TMO], 1u); break; } }
    }
    nloc = mine > 0u ? mine : 1u; nx = cnt > 0u ? cnt : 1u;
}
__device__ __forceinline__ void xcd_barrier(const XcdBarrier& b) {
    asm volatile("s_waitcnt vmcnt(0)" ::: "memory");
    __syncthreads();
    if (threadIdx.x == 0) {
        unsigned* bar = b.bar;
        __builtin_amdgcn_s_waitcnt(0);
        unsigned nloc = b.st[0], nx = b.st[1];
        if (nloc == 0u) { xcd_barrier_complete(bar, b.x, nloc, nx); b.st[0] = nloc; b.st[1] = nx; }
        const unsigned old = xb_add(&bar[XB_XSUB(b.x)], 1u);
        const unsigned gen = old / nloc;
        if (old + 1u == (gen + 1u) * nloc) {
            __builtin_amdgcn_fence(__ATOMIC_RELEASE, "agent");
            asm volatile("s_waitcnt vmcnt(0)" ::: "memory");
            const unsigned og = xb_add(&bar[XB_TOP], 1u);
            const unsigned tg = og / nx;
            if (og + 1u == (tg + 1u) * nx) xb_add(&bar[XB_TOPGEN], 1u);
            else XB_SPIN(xb_ld(&bar[XB_TOPGEN]) == tg, bar);
            __builtin_amdgcn_fence(__ATOMIC_ACQUIRE, "agent");
            xb_add(&bar[XB_XGEN(b.x)], 1u);
            asm volatile("s_waitcnt vmcnt(0)" ::: "memory");
        } else {
            XB_SPIN(xb_ld(&bar[XB_XGEN(b.x)]) == gen, bar);
            __builtin_amdgcn_fence(__ATOMIC_ACQUIRE, "agent");
            asm volatile("s_waitcnt vmcnt(0)" ::: "memory");
        }
    }
    __syncthreads();
}

typedef float f32x2_t __attribute__((ext_vector_type(2)));
typedef __bf16 bf16x2_t __attribute__((ext_vector_type(2)));
__device__ __forceinline__ unsigned pk_bf16(float lo, float hi) { f32x2_t v = {lo, hi}; return __builtin_bit_cast(unsigned, __builtin_convertvector(v, bf16x2_t)); }
__device__ __forceinline__ float bf_lo(unsigned u) { return __uint_as_float(u << 16); }
__device__ __forceinline__ float bf_hi(unsigned u) { return __uint_as_float(u & 0xffff0000u); }
__device__ __forceinline__ float bf2f(u16 v) { return __uint_as_float(((unsigned)v) << 16); }
__device__ __forceinline__ u16 f2bf(float f) { return (u16)(pk_bf16(f, 0.f) & 0xffffu); }
__device__ __forceinline__ float wave_sum(float v) {
#pragma unroll
    for (int o = 32; o > 0; o >>= 1) v += __shfl_xor(v, o, 64);
    return v;
}
__device__ __forceinline__ int tid_() { int t = threadIdx.x; asm volatile("" : "+v"(t)); return t; }
__device__ __forceinline__ int bid_() { int b = blockIdx.x; asm volatile("" : "+s"(b)); return b; }
__device__ __forceinline__ int gdim_() { int b = gridDim.x; asm volatile("" : "+s"(b)); return b; }
__device__ __forceinline__ float sigmoidf_(float x) { return 1.f / (1.f + __expf(-x)); }
__device__ __forceinline__ f32x4 mfma16(bf16x8 a, bf16x8 b, f32x4 c) { return __builtin_amdgcn_mfma_f32_16x16x32_bf16(a, b, c, 0, 0, 0); }
__device__ __forceinline__ bf16x8 ld_frag_g(const u16* p) { return *reinterpret_cast<const bf16x8*>(p); }
__device__ __forceinline__ bf16x8 ld_frag_s(const u16* p) { return *reinterpret_cast<const bf16x8*>(p); }
__device__ __forceinline__ bf16x8 mk_frag(unsigned a, unsigned b, unsigned c, unsigned d) { u32x4 v = {a, b, c, d}; return __builtin_bit_cast(bf16x8, v); }

__device__ __forceinline__ const float* xin_row(const Params& p, int l, int row) {
    if (l == 0) return row < NLAT ? p.x + (size_t)row * D : p.ctx + (size_t)(row - NLAT) * D;
    return (const float*)(p.ws + WS_XL2) + (size_t)row * D;
}
__device__ __forceinline__ const float* mod_ptr(const Params& p, int l, int row, int chunk) {
    const int bb = row < NLAT ? (row >> 12) : 4;
    return (const float*)(p.ws + WS_MOD) + ((size_t)(l * 5 + bb) * 6 + chunk) * D;
}

__device__ void phase_mod(const Params& p, unsigned char* lds_raw) {
    float* scond = (float*)lds_raw;
    float* red = scond + 5 * D;
    const int t = tid_();
    for (int i = t; i < 5 * D; i += NT) { const int r = i >> 11, k = i & 2047; const float v = r < 4 ? p.c[r * D + k] : p.c_ctx[k]; scond[i] = v / (1.f + __expf(-v)); }
    __syncthreads();
    float* mod = (float*)(p.ws + WS_MOD);
    for (int item = bid_(); item < 192; item += gdim_()) {
        const int l = item / 96, col0 = (item % 96) * 128;
        const int kg = t >> 5, cl = (t & 31) * 4;
        f32x4 acc[5];
#pragma unroll
        for (int r = 0; r < 5; ++r) acc[r] = (f32x4){0.f, 0.f, 0.f, 0.f};
        const float* wp = p.ada_w + ((size_t)l * D + kg * 128) * (6 * D) + col0 + cl;
#pragma unroll 8
        for (int kk = 0; kk < 128; ++kk) {
            const f32x4 w = *reinterpret_cast<const f32x4*>(wp + (size_t)kk * (6 * D));
#pragma unroll
            for (int r = 0; r < 5; ++r) { const float s = scond[r * D + kg * 128 + kk]; acc[r] += w * s; }
        }
#pragma unroll
        for (int r = 0; r < 5; ++r) *reinterpret_cast<f32x4*>(red + (kg * 5 + r) * 128 + cl) = acc[r];
        __syncthreads();
        for (int o = t; o < 640; o += NT) {
            const int r = o >> 7, cc = o & 127;
            float s = p.ada_b[l * 6 * D + col0 + cc];
#pragma unroll
            for (int g = 0; g < 16; ++g) s += red[(g * 5 + r) * 128 + cc];
            mod[(size_t)(l * 5 + r) * 6 * D + col0 + cc] = s;
        }
        __syncthreads();
    }
}

__device__ void phase_norm_mod(const Params& p, int l) {
    const int lane = tid_() & 63, w = tid_() >> 6;
    u16* H = (u16*)(p.ws + WS_H);
    for (int row = bid_() * 8 + w; row < NTOK; row += gdim_() * 8) {
        const float* xr = xin_row(p, l, row);
        f32x4 v[8]; float ss = 0.f;
#pragma unroll
        for (int i = 0; i < 8; ++i) { v[i] = *reinterpret_cast<const f32x4*>(xr + (i * 64 + lane) * 4); ss += v[i][0] * v[i][0] + v[i][1] * v[i][1] + v[i][2] * v[i][2] + v[i][3] * v[i][3]; }
        ss = wave_sum(ss);
        const float rstd = rsqrtf(ss * (1.f / D) + 1e-6f);
        const float* sh = mod_ptr(p, l, row, 0); const float* sc = mod_ptr(p, l, row, 1);
        const float* nw = p.norm_mix_pre + (size_t)l * D;
#pragma unroll
        for (int i = 0; i < 8; ++i) {
            const int col = (i * 64 + lane) * 4;
            const f32x4 w4 = *reinterpret_cast<const f32x4*>(nw + col), s4 = *reinterpret_cast<const f32x4*>(sc + col), h4 = *reinterpret_cast<const f32x4*>(sh + col);
            f32x4 o = v[i] * rstd * w4 * (s4 + 1.f) + h4;
            u32x2 pk = {pk_bf16(o[0], o[1]), pk_bf16(o[2], o[3])};
            *reinterpret_cast<u32x2*>(H + (size_t)row * D + col) = pk;
        }
    }
}

struct GemmDesc {
    const u16* A; int lda; const int* arow; int mvalid; int m0;
    const float* B0; const float* B1; int ldb; int n0; int ncols;
    int K;
};
enum { EPI_BF16 = 0, EPI_F32 = 1, EPI_SWIGLU = 2, EPI_SCALE = 3 };
struct EpiDesc { u16* ob; float* of; int ldo; float* gates; const float* rscale; };
constexpr int GEMM_BUF = 49152, GEMM_BOFF = 32768;

template <int EPI>
__device__ __forceinline__ void gemm_tile(const GemmDesc& g, const EpiDesc& e, unsigned char* lds) {
    const int t = tid_(), lane = t & 63, w = t >> 6;
    const int wr = w >> 1, wc = w & 1, fr = lane & 15, fq = lane >> 4;
    const int ac = t & 7, ar = t >> 3;
    unsigned ap[4];
#pragma unroll
    for (int i = 0; i < 4; ++i) {
        int r = g.m0 + ar + 64 * i; if (r >= g.mvalid) r = g.mvalid - 1;
        const int src = g.arow ? g.arow[r] : r;
        ap[i] = (unsigned)src * (unsigned)g.lda + ((ac ^ ((ar >> 1) & 7)) << 3);
    }
    const int a_off = t * 16;
    const int n2 = lane * 2;
    const float* bp;
    if (EPI == EPI_SWIGLU) {
        const int which = (n2 >> 5) & 1, ffl = (n2 >> 6) * 32 + (n2 & 31);
        bp = (which ? g.B1 : g.B0) + g.n0 + ffl;
    } else {
        int col = g.n0 + n2; if (col > g.ncols - 2) col = g.ncols - 2;
        bp = g.B0 + col;
    }
    bp += (size_t)(w * 8) * g.ldb;
    const int b_off = GEMM_BOFF + n2 * 128 + ((w ^ (lane & 7)) << 4);
    const int s0 = (fr >> 1) & 7;
    const int a_rd0 = wr * 8192 + fr * 128 + ((fq ^ s0) << 4), a_rd1 = a_rd0 ^ 64;
    const int b_rd0 = GEMM_BOFF + wc * 8192 + fr * 128 + ((fq ^ s0) << 4), b_rd1 = b_rd0 ^ 64;

    f32x4 acc[4][4];
#pragma unroll
    for (int i = 0; i < 4; ++i)
#pragma unroll
        for (int j = 0; j < 4; ++j) acc[i][j] = (f32x4){0.f, 0.f, 0.f, 0.f};

    typedef float f32x2 __attribute__((ext_vector_type(2)));
    f32x2 breg[8];
    const int nk = g.K >> 6;
#pragma unroll
    for (int i = 0; i < 4; ++i) __builtin_amdgcn_global_load_lds((const unsigned*)(g.A + ap[i]), (unsigned*)(lds + a_off + i * 8192), 16, 0, 0);
#pragma unroll
    for (int j = 0; j < 8; ++j) breg[j] = *reinterpret_cast<const f32x2*>(bp + (size_t)j * g.ldb);

    for (int kt = 0; kt < nk; ++kt) {
        unsigned char* buf = lds + (kt & 1) * GEMM_BUF;
#pragma unroll
        for (int j = 0; j < 2; ++j) {
            u32x4 v = {pk_bf16(breg[0][j], breg[1][j]), pk_bf16(breg[2][j], breg[3][j]), pk_bf16(breg[4][j], breg[5][j]), pk_bf16(breg[6][j], breg[7][j])};
            *reinterpret_cast<u32x4*>(buf + b_off + j * 128) = v;
        }
        asm volatile("s_waitcnt vmcnt(0)" ::: "memory");
        __syncthreads();
        if (kt + 1 < nk) {
            const int k1 = (kt + 1) << 6;
            unsigned char* nbuf = lds + ((kt + 1) & 1) * GEMM_BUF;
#pragma unroll
            for (int i = 0; i < 4; ++i) __builtin_amdgcn_global_load_lds((const unsigned*)(g.A + (ap[i] + k1)), (unsigned*)(nbuf + a_off + i * 8192), 16, 0, 0);
#pragma unroll
            for (int j = 0; j < 8; ++j) breg[j] = *reinterpret_cast<const f32x2*>(bp + (size_t)(k1 + j) * g.ldb);
        }
#pragma unroll
        for (int kk = 0; kk < 2; ++kk) {
            bf16x8 bfr[4];
#pragma unroll
            for (int ni = 0; ni < 4; ++ni) bfr[ni] = *reinterpret_cast<const bf16x8*>(buf + ((kk ? b_rd1 : b_rd0) + ni * 2048));
#pragma unroll
            for (int mi = 0; mi < 4; ++mi) {
                const bf16x8 afr = *reinterpret_cast<const bf16x8*>(buf + ((kk ? a_rd1 : a_rd0) + mi * 2048));
#pragma unroll
                for (int ni = 0; ni < 4; ++ni) acc[mi][ni] = mfma16(bfr[ni], afr, acc[mi][ni]);
            }
        }
    }
#pragma unroll
    for (int mi = 0; mi < 4; ++mi) {
        const int row = g.m0 + wr * 64 + mi * 16 + fr;
        if (row < g.mvalid) {
            if (EPI == EPI_BF16) {
#pragma unroll
                for (int ni = 0; ni < 4; ++ni) {
                    const int col = g.n0 + wc * 64 + ni * 16 + 4 * fq;
                    if (col < g.ncols) {
                        const f32x4 v = acc[mi][ni];
                        u32x2 pk = {pk_bf16(v[0], v[1]), pk_bf16(v[2], v[3])};
                        *reinterpret_cast<u32x2*>(e.ob + (size_t)row * e.ldo + col) = pk;
                        if (e.gates && col >= 4096 && col < 4112) *reinterpret_cast<f32x4*>(e.gates + (size_t)row * 16 + (col - 4096)) = v;
                    }
                }
            } else if (EPI == EPI_F32) {
#pragma unroll
                for (int ni = 0; ni < 4; ++ni) {
                    const int col = g.n0 + wc * 64 + ni * 16 + 4 * fq;
                    *reinterpret_cast<f32x4*>(e.of + (size_t)row * e.ldo + col) = acc[mi][ni];
                }
            } else if (EPI == EPI_SWIGLU) {
#pragma unroll
                for (int ni = 0; ni < 2; ++ni) {
                    const int col = g.n0 + wc * 32 + ni * 16 + 4 * fq;
                    const f32x4 u = acc[mi][ni], v = acc[mi][ni + 2];
                    f32x4 a;
#pragma unroll
                    for (int q = 0; q < 4; ++q) a[q] = u[q] / (1.f + __expf(-u[q])) * v[q];
                    u32x2 pk = {pk_bf16(a[0], a[1]), pk_bf16(a[2], a[3])};
                    *reinterpret_cast<u32x2*>(e.ob + (size_t)row * e.ldo + col) = pk;
                }
            } else {
                const float sc = e.rscale[row];
#pragma unroll
                for (int ni = 0; ni < 4; ++ni) {
                    const int col = g.n0 + wc * 64 + ni * 16 + 4 * fq;
                    const f32x4 v = acc[mi][ni] * sc;
                    u32x2 pk = {pk_bf16(v[0], v[1]), pk_bf16(v[2], v[3])};
                    *reinterpret_cast<u32x2*>(e.ob + (size_t)row * e.ldo + col) = pk;
                }
            }
        }
    }
    __syncthreads();
}

template <int EPI>
__device__ void phase_gemm_dense(const Params& p, const u16* A, int M, const float* W, int N, EpiDesc e, unsigned char* lds) {
    const int nM = M / 256, nN = (N + 127) / 128;
    for (int tile = bid_(); tile < nM * nN; tile += gdim_()) {
        const int pn = tile / nM, pm = tile % nM;
        GemmDesc g; g.A = A; g.lda = D; g.arow = nullptr; g.mvalid = M; g.m0 = pm * 256;
        g.B0 = W; g.B1 = nullptr; g.ldb = N; g.n0 = pn * 128; g.ncols = N; g.K = D;
        gemm_tile<EPI>(g, e, lds);
    }
}

__device__ void phase_moe_a(const Params& p, int l, unsigned char* lds) {
    const int mvalid = l == 0 ? 2176 : 2048, nM = l == 0 ? 9 : 8;
    const int per_e = nM * 32;
    for (int tile = bid_(); tile < NEXP * per_e; tile += gdim_()) {
        const int ex = tile / per_e, r = tile % per_e, pn = r / nM, pm = r % nM;
        GemmDesc g; g.A = (const u16*)(p.ws + WS_H); g.lda = D; g.arow = (const int*)(p.ws + WS_EROW) + ex * EPAD; g.mvalid = mvalid; g.m0 = pm * 256;
        g.B0 = p.moe_w1 + ((size_t)(l * NEXP + ex) * D) * FF; g.B1 = p.moe_w3 + ((size_t)(l * NEXP + ex) * D) * FF; g.ldb = FF; g.n0 = pn * 64; g.ncols = FF; g.K = D;
        EpiDesc e; e.ob = (u16*)(p.ws + WS_ACT) + (size_t)ex * EPAD * FF; e.of = nullptr; e.ldo = FF; e.gates = nullptr; e.rscale = nullptr;
        gemm_tile<EPI_SWIGLU>(g, e, lds);
    }
}
__device__ void phase_moe_b(const Params& p, int l, unsigned char* lds) {
    const int mvalid = l == 0 ? 2176 : 2048, nM = l == 0 ? 9 : 8;
    const int per_e = nM * 16;
    for (int tile = bid_(); tile < NEXP * per_e; tile += gdim_()) {
        const int ex = tile / per_e, r = tile % per_e, pn = r / nM, pm = r % nM;
        GemmDesc g; g.A = (const u16*)(p.ws + WS_ACT) + (size_t)ex * EPAD * FF; g.lda = FF; g.arow = nullptr; g.mvalid = mvalid; g.m0 = pm * 256;
        g.B0 = p.moe_w2 + ((size_t)(l * NEXP + ex) * FF) * D; g.B1 = nullptr; g.ldb = D; g.n0 = pn * 128; g.ncols = D; g.K = FF;
        EpiDesc e; e.ob = (u16*)(p.ws + WS_YEXP) + (size_t)ex * EPAD * D; e.of = nullptr; e.ldo = D; e.gates = nullptr; e.rscale = (const float*)(p.ws + WS_EGATE) + ex * EPAD;
        gemm_tile<EPI_SCALE>(g, e, lds);
    }
}

__device__ __forceinline__ int mlstm_row(int b, int dir, int pos) {
    if (pos < LC) return NLAT + b * LC + (dir ? (LC - 1 - pos) : pos);
    const int q = pos - LC; return b * SEQ + (dir ? (SEQ - 1 - q) : q);
}
__device__ void phase_mlstm(const Params& p, unsigned char* lds) {
    u16* KT = (u16*)lds;
    u16* VT = KT + 256 * 72;
    u16* VWT = VT + 48 * 72;
    u16* CT = VWT + 48 * 72;
    u16* Ss = CT + 48 * 264;
    float* sb = (float*)(Ss + 64 * 72);
    float* sig = sb + 64;
    float* spm = sig + 64;
    float* ssc = spm + 64;
    const int t = tid_(), lane = t & 63, w = t >> 6, fr = lane & 15, fq = lane >> 4;
    const u16* P = (const u16*)(p.ws + WS_P);
    const float* G = (const float*)(p.ws + WS_G);
    u16* HM = (u16*)(p.ws + WS_HM);
    for (int item = bid_(); item < 256; item += gdim_()) {
        const int vs = item & 7, dir = (item >> 3) & 1, hh = (item >> 4) & 3, b = item >> 6;
        __syncthreads();
        for (int i = t; i < 48 * 264; i += NT) CT[i] = 0;
        for (int i = t; i < 16 * 72; i += NT) { const int er = i / 72; VT[32 * 72 + i] = (er == 0) ? (u16)0x3f80 : (u16)0; VWT[32 * 72 + i] = 0; }
        f32x4 Cacc[2][3];
#pragma unroll
        for (int i = 0; i < 2; ++i)
#pragma unroll
            for (int j = 0; j < 3; ++j) Cacc[i][j] = (f32x4){0.f, 0.f, 0.f, 0.f};
        float m_old = 0.f;
        const float gb_i = p.mlstm_gate_b[(dir * 2 + 0) * 4 + hh], gb_f = p.mlstm_gate_b[(dir * 2 + 1) * 4 + hh];
        const int jt = w & 3, sth = w >> 2;
        for (int ch = 0; ch < 68; ++ch) {
            const int pos0 = ch * 64;
            if (w == 0) {
                const int row = mlstm_row(b, dir, pos0 + lane);
                const float gi = G[(size_t)row * 16 + dir * 8 + hh] + gb_i;
                const float gf = G[(size_t)row * 16 + dir * 8 + 4 + hh] + gb_f;
                const float lf = fminf(gf, 0.f) - log1pf(__expf(-fabsf(gf)));
                float bc = lf;
#pragma unroll
                for (int o = 1; o < 64; o <<= 1) { const float n = __shfl_up(bc, o, 64); if (lane >= o) bc += n; }
                float pm = gi - bc;
#pragma unroll
                for (int o = 1; o < 64; o <<= 1) { const float n = __shfl_up(pm, o, 64); if (lane >= o) pm = fmaxf(pm, n); }
                const float b63 = __shfl(bc, 63, 64);
                float gmax = b63 - bc + gi;
#pragma unroll
                for (int o = 32; o > 0; o >>= 1) gmax = fmaxf(gmax, __shfl_xor(gmax, o, 64));
                const float m_new = fmaxf(b63 + m_old, gmax);
                sb[lane] = bc; sig[lane] = gi; spm[lane] = pm;
                if (lane == 0) { ssc[0] = m_new; ssc[1] = __expf(b63 + m_old - m_new); }
            }
            const int rowq = mlstm_row(b, dir, pos0 + jt * 16 + fr);
            bf16x8 qf[8];
#pragma unroll
            for (int kk = 0; kk < 8; ++kk) qf[kk] = ld_frag_g(P + (size_t)rowq * AB_IN + hh * 256 + kk * 32 + fq * 8);
            bf16x8 kf[8];
            {
                const int rowk = mlstm_row(b, dir, pos0 + (sth * 2) * 16 + fr);
#pragma unroll
                for (int kk = 0; kk < 8; ++kk) kf[kk] = ld_frag_g(P + (size_t)rowk * AB_IN + 1024 + hh * 256 + kk * 32 + fq * 8);
            }
            unsigned ktr[2][8];
#pragma unroll
            for (int i = 0; i < 2; ++i) {
                const int mt = t + NT * i, d2 = (mt & 127) * 2, s8 = (mt >> 7) * 8;
#pragma unroll
                for (int q = 0; q < 8; ++q) ktr[i][q] = *reinterpret_cast<const unsigned*>(P + (size_t)mlstm_row(b, dir, pos0 + s8 + q) * AB_IN + 1024 + hh * 256 + d2);
            }
            const int vs_s = t & 63, vs_eg = t >> 6;
            const u32x2 vraw = *reinterpret_cast<const u32x2*>(P + (size_t)mlstm_row(b, dir, pos0 + vs_s) * AB_IN + 2048 + hh * 256 + vs * 32 + vs_eg * 4);
            __syncthreads();
            const float m_new = ssc[0], decay = ssc[1], b63 = sb[63];
            const int jg = jt * 16 + fr;
            const float bj = sb[jg], mj = bj + fmaxf(m_old, spm[jg]);
            auto s_tile = [&](int st) {
                f32x4 sv = (f32x4){0.f, 0.f, 0.f, 0.f};
                if (st <= jt) {
#pragma unroll
                    for (int kk = 0; kk < 8; ++kk) sv = mfma16(kf[kk], qf[kk], sv);
                }
                float pv[4];
#pragma unroll
                for (int q = 0; q < 4; ++q) {
                    const int sg = st * 16 + 4 * fq + q;
                    pv[q] = (sg <= jg) ? sv[q] * 0.0625f * __expf(bj - sb[sg] + sig[sg] - mj) : 0.f;
                }
                u32x2 pk = {pk_bf16(pv[0], pv[1]), pk_bf16(pv[2], pv[3])};
                *reinterpret_cast<u32x2*>(Ss + jg * 72 + st * 16 + 4 * fq) = pk;
            };
            s_tile(sth * 2);
            {
                const int rowk = mlstm_row(b, dir, pos0 + (sth * 2 + 1) * 16 + fr);
#pragma unroll
                for (int kk = 0; kk < 8; ++kk) kf[kk] = ld_frag_g(P + (size_t)rowk * AB_IN + 1024 + hh * 256 + kk * 32 + fq * 8);
            }
#pragma unroll
            for (int i = 0; i < 2; ++i) {
                const int mt = t + NT * i, d2 = (mt & 127) * 2, s8 = (mt >> 7) * 8;
                u32x4 lo = {(ktr[i][0] & 0xffffu) | (ktr[i][1] << 16), (ktr[i][2] & 0xffffu) | (ktr[i][3] << 16), (ktr[i][4] & 0xffffu) | (ktr[i][5] << 16), (ktr[i][6] & 0xffffu) | (ktr[i][7] << 16)};
                u32x4 hi = {(ktr[i][0] >> 16) | (ktr[i][1] & 0xffff0000u), (ktr[i][2] >> 16) | (ktr[i][3] & 0xffff0000u), (ktr[i][4] >> 16) | (ktr[i][5] & 0xffff0000u), (ktr[i][6] >> 16) | (ktr[i][7] & 0xffff0000u)};
                *reinterpret_cast<u32x4*>(KT + d2 * 72 + s8) = lo;
                *reinterpret_cast<u32x4*>(KT + (d2 + 1) * 72 + s8) = hi;
            }
            {
                const float wg = __expf(b63 - sb[vs_s] + sig[vs_s] - m_new) * 0.0625f;
                const float v0 = bf_lo(vraw[0]), v1 = bf_hi(vraw[0]), v2 = bf_lo(vraw[1]), v3 = bf_hi(vraw[1]);
                const int e0 = vs_eg * 4;
                VT[(e0 + 0) * 72 + vs_s] = (u16)(vraw[0] & 0xffffu); VT[(e0 + 1) * 72 + vs_s] = (u16)(vraw[0] >> 16);
                VT[(e0 + 2) * 72 + vs_s] = (u16)(vraw[1] & 0xffffu); VT[(e0 + 3) * 72 + vs_s] = (u16)(vraw[1] >> 16);
                VWT[(e0 + 0) * 72 + vs_s] = f2bf(v0 * wg); VWT[(e0 + 1) * 72 + vs_s] = f2bf(v1 * wg);
                VWT[(e0 + 2) * 72 + vs_s] = f2bf(v2 * wg); VWT[(e0 + 3) * 72 + vs_s] = f2bf(v3 * wg);
                if (t < 64) VWT[32 * 72 + t] = f2bf(wg);
            }
            s_tile(sth * 2 + 1);
            __syncthreads();
            {
                const float w_inter = __expf(bj + m_old - mj);
                f32x4 nacc[2];
#pragma unroll
                for (int z = 0; z < 2; ++z) {
                    const int et = z == 0 ? sth : 2;
                    f32x4 a = (f32x4){0.f, 0.f, 0.f, 0.f};
#pragma unroll
                    for (int kk = 0; kk < 8; ++kk) a = mfma16(ld_frag_s(CT + (et * 16 + fr) * 264 + kk * 32 + fq * 8), qf[kk], a);
                    a *= w_inter;
#pragma unroll
                    for (int k2 = 0; k2 < 2; ++k2) a = mfma16(ld_frag_s(VT + (et * 16 + fr) * 72 + k2 * 32 + fq * 8), ld_frag_s(Ss + jg * 72 + k2 * 32 + fq * 8), a);
                    nacc[z] = a;
                }
                const float den = __shfl(nacc[1][0], fr, 64);
                const float dd = fmaxf(fabsf(den), __expf(-mj));
                const float inv = 1.f / dd;
                u32x2 pk = {pk_bf16(nacc[0][0] * inv, nacc[0][1] * inv), pk_bf16(nacc[0][2] * inv, nacc[0][3] * inv)};
                *reinterpret_cast<u32x2*>(HM + ((size_t)dir * NTOK + rowq) * 1024 + hh * 256 + vs * 32 + sth * 16 + 4 * fq) = pk;
            }
#pragma unroll
            for (int i = 0; i < 2; ++i)
#pragma unroll
                for (int et = 0; et < 3; ++et) {
                    f32x4 a = Cacc[i][et] * decay;
#pragma unroll
                    for (int k2 = 0; k2 < 2; ++k2) a = mfma16(ld_frag_s(KT + ((w * 2 + i) * 16 + fr) * 72 + k2 * 32 + fq * 8), ld_frag_s(VWT + (et * 16 + fr) * 72 + k2 * 32 + fq * 8), a);
                    Cacc[i][et] = a;
                }
            __syncthreads();
#pragma unroll
            for (int i = 0; i < 2; ++i)
#pragma unroll
                for (int et = 0; et < 3; ++et) {
                    const f32x4 a = Cacc[i][et];
                    u32x2 pk = {pk_bf16(a[0], a[1]), pk_bf16(a[2], a[3])};
                    *reinterpret_cast<u32x2*>(CT + (et * 16 + fr) * 264 + (w * 2 + i) * 16 + 4 * fq) = pk;
                }
            m_old = m_new;
        }
    }
}

__device__ void mlstm_out_rows(const Params& p, int row0, int nrows) {
    const int lane = tid_() & 63, w = tid_() >> 6;
    const u16* P = (const u16*)(p.ws + WS_P);
    const u16* HM = (const u16*)(p.ws + WS_HM);
    u16* YIN = (u16*)(p.ws + WS_YIN);
    for (int r = w; r < nrows; r += 8) {
        const int row = row0 + r;
        const int c0 = lane * 16;
        float v[16]; float ss = 0.f;
#pragma unroll
        for (int h2 = 0; h2 < 2; ++h2) {
            const u32x4 a = *reinterpret_cast<const u32x4*>(HM + (size_t)row * 1024 + c0 + h2 * 8);
            const u32x4 bq = *reinterpret_cast<const u32x4*>(HM + ((size_t)NTOK + row) * 1024 + c0 + h2 * 8);
#pragma unroll
            for (int q = 0; q < 4; ++q) { v[h2 * 8 + 2 * q] = bf_lo(a[q]) + bf_lo(bq[q]); v[h2 * 8 + 2 * q + 1] = bf_hi(a[q]) + bf_hi(bq[q]); }
        }
#pragma unroll
        for (int q = 0; q < 16; ++q) ss += v[q] * v[q];
        ss += __shfl_xor(ss, 1, 64); ss += __shfl_xor(ss, 2, 64); ss += __shfl_xor(ss, 4, 64); ss += __shfl_xor(ss, 8, 64);
        const float rstd = rsqrtf(ss * (1.f / 256.f) + 1e-6f);
        unsigned o[8];
#pragma unroll
        for (int h2 = 0; h2 < 2; ++h2) {
            const u32x4 og = *reinterpret_cast<const u32x4*>(P + (size_t)row * AB_IN + 3072 + c0 + h2 * 8);
#pragma unroll
            for (int q = 0; q < 4; ++q) {
                const int c = c0 + h2 * 8 + 2 * q;
                const float y0 = v[h2 * 8 + 2 * q] * rstd * p.mlstm_norm[c] * sigmoidf_(bf_lo(og[q]));
                const float y1 = v[h2 * 8 + 2 * q + 1] * rstd * p.mlstm_norm[c + 1] * sigmoidf_(bf_hi(og[q]));
                o[h2 * 4 + q] = pk_bf16(y0, y1);
            }
        }
        *reinterpret_cast<u32x4*>(YIN + (size_t)row * D + c0) = (u32x4){o[0], o[1], o[2], o[3]};
        *reinterpret_cast<u32x4*>(YIN + (size_t)row * D + c0 + 8) = (u32x4){o[4], o[5], o[6], o[7]};
    }
}

template <int DH, class KeyFn, class BiasFn>
__device__ __forceinline__ void attn_wave(const u16* qptr, size_t qstride, int nblk, KeyFn keyfn, BiasFn biasfn, float scale,
                                           float m_init, float l_init, u16* vlds, u16* optr, size_t ostride) {
    constexpr int NK = DH / 32, NDT = DH / 16, VS = DH + 8;
    const int lane = tid_() & 63, fr = lane & 15, fq = lane >> 4;
    bf16x8 qf[NK];
#pragma unroll
    for (int kk = 0; kk < NK; ++kk) qf[kk] = ld_frag_g(qptr + (size_t)fr * qstride + kk * 32 + fq * 8);
    f32x4 oacc[NDT];
#pragma unroll
    for (int i = 0; i < NDT; ++i) oacc[i] = (f32x4){0.f, 0.f, 0.f, 0.f};
    float m = m_init, l = l_init;
    for (int ib = 0; ib < nblk; ++ib) {
        const u16* kptr; const u16* vptr; size_t kvs;
        if (!keyfn(ib, kptr, vptr, kvs)) continue;
        asm volatile("" ::: "memory");
#pragma unroll
        for (int i = 0; i < DH / 16; ++i) {
            const int cidx = lane + 64 * i, r = cidx / (DH / 8), cc = cidx % (DH / 8);
            const u32x4 v = *reinterpret_cast<const u32x4*>(vptr + (size_t)r * kvs + cc * 8);
            *reinterpret_cast<u32x4*>(vlds + r * VS + cc * 8) = v;
        }
        f32x4 s[2];
#pragma unroll
        for (int st = 0; st < 2; ++st) {
            f32x4 a = (f32x4){0.f, 0.f, 0.f, 0.f};
#pragma unroll
            for (int kk = 0; kk < NK; ++kk) a = mfma16(ld_frag_g(kptr + (size_t)(st * 16 + fr) * kvs + kk * 32 + fq * 8), qf[kk], a);
            s[st] = a;
        }
        float x[8]; float mx = -INFINITY;
#pragma unroll
        for (int st = 0; st < 2; ++st)
#pragma unroll
            for (int q = 0; q < 4; ++q) { const float v = s[st][q] * scale + biasfn(ib, fr, st * 16 + 4 * fq + q); x[st * 4 + q] = v; mx = fmaxf(mx, v); }
        mx = fmaxf(mx, __shfl_xor(mx, 16, 64)); mx = fmaxf(mx, __shfl_xor(mx, 32, 64));
        const float m_new = fmaxf(m, mx);
        const float m_safe = (m_new == -INFINITY) ? 0.f : m_new;
        const float alpha = __expf(m - m_safe);
        float ps = 0.f; float pe[8];
#pragma unroll
        for (int q = 0; q < 8; ++q) { pe[q] = __expf(x[q] - m_safe); ps += pe[q]; }
        l = l * alpha + ps; m = m_new;
#pragma unroll
        for (int i = 0; i < NDT; ++i) oacc[i] *= alpha;
        const bf16x8 pf = mk_frag(pk_bf16(pe[0], pe[1]), pk_bf16(pe[2], pe[3]), pk_bf16(pe[4], pe[5]), pk_bf16(pe[6], pe[7]));
        asm volatile("s_waitcnt lgkmcnt(0)" ::: "memory");
#pragma unroll
        for (int dt = 0; dt < NDT; ++dt) {
            const u16* vb = vlds + dt * 16 + fr;
            unsigned e[4];
#pragma unroll
            for (int j2 = 0; j2 < 2; ++j2) {
                const int k0 = (j2 == 0 ? 0 : 16) + 4 * fq;
                e[j2 * 2 + 0] = (unsigned)vb[(k0 + 0) * VS] | ((unsigned)vb[(k0 + 1) * VS] << 16);
                e[j2 * 2 + 1] = (unsigned)vb[(k0 + 2) * VS] | ((unsigned)vb[(k0 + 3) * VS] << 16);
            }
            oacc[dt] = mfma16(mk_frag(e[0], e[1], e[2], e[3]), pf, oacc[dt]);
        }
        asm volatile("" ::: "memory");
    }
    l += __shfl_xor(l, 16, 64); l += __shfl_xor(l, 32, 64);
    const float inv = 1.f / l;
#pragma unroll
    for (int dt = 0; dt < NDT; ++dt) {
        const f32x4 o = oacc[dt] * inv;
        u32x2 pk = {pk_bf16(o[0], o[1]), pk_bf16(o[2], o[3])};
        *reinterpret_cast<u32x2*>(optr + (size_t)fr * ostride + dt * 16 + 4 * fq) = pk;
    }
}

__device__ void phase_l0_stage2(const Params& p, unsigned char* lds) {
    const int w = tid_() >> 6;
    const u16* P = (const u16*)(p.ws + WS_P);
    u16* YIN = (u16*)(p.ws + WS_YIN);
    u16* vlds = (u16*)lds + w * (32 * 136);
    for (int item = bid_(); item < 1088 + 2176; item += gdim_()) {
        if (item < 1024) {
            const int qt = item & 3, r = (item >> 2) & 63, b = item >> 8, h = w;
            const int r0 = min(max(r - 4, 0), 56);
            const int cb = qt == 0 ? 0 : (qt == 1 ? 8 : (qt == 2 ? 24 : 32));
            const int qrow = b * SEQ + r * 64 + qt * 16;
            const float* rpb = p.na_rpb + h * 15 * 31;
            auto keyfn = [&](int ib, const u16*& kp, const u16*& vp, size_t& kvs) -> bool {
                int row;
                if (ib < 8) row = b * SEQ + (r0 + ib) * 64 + cb; else row = NLAT + b * LC + (ib - 8) * 32;
                kp = P + (size_t)row * AB_IN + 5136 + h * 128; vp = P + (size_t)row * AB_IN + 6160 + h * 128; kvs = AB_IN; return true; };
            auto biasfn = [&](int ib, int qi, int ki) -> float {
                if (ib >= 8) return 0.f;
                const int c = qt * 16 + qi, kc = cb + ki, c0 = min(max(c - 8, 0), 48);
                if (kc < c0 || kc >= c0 + 16) return -INFINITY;
                return rpb[(r0 + ib - r + 7) * 31 + (kc - c + 15)]; };
            attn_wave<128>(P + (size_t)qrow * AB_IN + 4112 + h * 128, AB_IN, 16, keyfn, biasfn, 0.08838834764831845f, -INFINITY, 0.f, vlds,
                           YIN + (size_t)qrow * D + 1024 + h * 128, D);
        } else if (item < 1088) {
            const int it = item - 1024, qt = it & 15, b = it >> 4, h = w;
            const int qrow = NLAT + b * LC + qt * 16;
            auto keyfn = [&](int ib, const u16*& kp, const u16*& vp, size_t& kvs) -> bool {
                const int row = NLAT + b * LC + ib * 32;
                kp = P + (size_t)row * AB_IN + 5136 + h * 128; vp = P + (size_t)row * AB_IN + 6160 + h * 128; kvs = AB_IN; return true; };
            auto biasfn = [&](int, int, int) -> float { return 0.f; };
            attn_wave<128>(P + (size_t)qrow * AB_IN + 4112 + h * 128, AB_IN, 8, keyfn, biasfn, 0.08838834764831845f, -INFINITY, 0.f, vlds,
                           YIN + (size_t)qrow * D + 1024 + h * 128, D);
        } else {
            mlstm_out_rows(p, (item - 1088) * 8, 8);
        }
    }
}

__device__ void rope_rows(const Params& p, int row0, int nrows) {
    const int lane = tid_() & 63, w = tid_() >> 6;
    u16* P = (u16*)(p.ws + WS_P);
    for (int r = w; r < nrows; r += 8) {
        const int row = row0 + r, tt = row & (SEQ - 1);
        const float prow = (float)(tt >> 6), pcol = (float)(tt & 63);
        for (int pi = lane; pi < 640; pi += 64) {
            const int head = pi >> 5, half = (pi >> 4) & 1, j = pi & 15;
            const int base = (head < 16 ? head * 64 : 1024 + (head - 16) * 64) + half * 32 + j;
            const float inv = exp2f(-(float)j * (13.287712379549449f / 16.f));
            const float ang = (half ? pcol : prow) * inv;
            float sn, cs; sincosf(ang, &sn, &cs);
            u16* q1 = P + (size_t)row * CD_IN + base;
            const float x1 = bf2f(q1[0]), x2 = bf2f(q1[16]);
            q1[0] = f2bf(x1 * cs - x2 * sn); q1[16] = f2bf(x2 * cs + x1 * sn);
        }
    }
}

__device__ __forceinline__ int lru_row(int b, int ci, int j) { return ci < 4 ? NLAT + b * LC + ci * 64 + j : b * SEQ + (ci - 4) * 64 + j; }
__device__ void lru_chunk(const Params& p, int b, int blk, int ci, int mode, unsigned char* lds) {
    u16* ub = (u16*)lds;
    u16* Wb = ub + 64 * 136;
    float* sa = (float*)(Wb + 128 * 136);
    float* sbt = sa + 64 * 128;
    u16* hf = (u16*)(sbt + 64 * 128);
    const int t = tid_(), lane = t & 63, w = t >> 6, fr = lane & 15, fq = lane >> 4;
    const u16* P = (const u16*)(p.ws + WS_P);
    float* SA = (float*)(p.ws + WS_LRUS);
    float* SH = SA + 2 * 4 * 68 * 1024;
    const int seglen = ci < 4 ? LC : SEQ, tt0 = ci < 4 ? ci * 64 : (ci - 4) * 64;
    const int rbase = ci < 4 ? NLAT + b * LC : b * SEQ;
    __syncthreads();
    {
        const int c4 = (t & 31) * 4, j0 = (t >> 5) * 4, ch = blk * 128 + c4;
        float xv[7][4];
#pragma unroll
        for (int q = 0; q < 7; ++q) {
            const int tt = tt0 + j0 - 1 + q;
            if (tt >= 0 && tt < seglen) {
                const u32x2 v = *reinterpret_cast<const u32x2*>(P + (size_t)(rbase + tt) * CD_IN + 1536 + ch);
                xv[q][0] = bf_lo(v[0]); xv[q][1] = bf_hi(v[0]); xv[q][2] = bf_lo(v[1]); xv[q][3] = bf_hi(v[1]);
            } else { xv[q][0] = xv[q][1] = xv[q][2] = xv[q][3] = 0.f; }
        }
        f32x4 cw[4];
#pragma unroll
        for (int tp = 0; tp < 4; ++tp) cw[tp] = *reinterpret_cast<const f32x4*>(p.lru_conv_w + tp * 1024 + ch);
        const f32x4 cb = *reinterpret_cast<const f32x4*>(p.lru_conv_b + ch);
#pragma unroll
        for (int q = 0; q < 4; ++q) {
            float u[4];
#pragma unroll
            for (int cc = 0; cc < 4; ++cc) u[cc] = cb[cc] + xv[q][cc] * cw[0][cc] + xv[q + 1][cc] * cw[1][cc] + xv[q + 2][cc] * cw[2][cc] + xv[q + 3][cc] * cw[3][cc];
            u32x2 pk = {pk_bf16(u[0], u[1]), pk_bf16(u[2], u[3])};
            *reinterpret_cast<u32x2*>(ub + (j0 + q) * 136 + c4) = pk;
        }
    }
    for (int dir = 0; dir < 2; ++dir) {
        float areg[4][4];
        for (int gate = 0; gate < 2; ++gate) {
            __syncthreads();
            {
                const float* Wg = p.lru_gate_w + ((size_t)((dir * 2 + gate) * 8 + blk) * 128) * 128;
                const int j4 = (t & 31) * 4, i8 = (t >> 5) * 8;
                f32x4 r8[8];
#pragma unroll
                for (int q = 0; q < 8; ++q) r8[q] = *reinterpret_cast<const f32x4*>(Wg + (size_t)(i8 + q) * 128 + j4);
#pragma unroll
                for (int jj = 0; jj < 4; ++jj) {
                    u32x4 v = {pk_bf16(r8[0][jj], r8[1][jj]), pk_bf16(r8[2][jj], r8[3][jj]), pk_bf16(r8[4][jj], r8[5][jj]), pk_bf16(r8[6][jj], r8[7][jj])};
                    *reinterpret_cast<u32x4*>(Wb + (j4 + jj) * 136 + i8) = v;
                }
            }
            __syncthreads();
            const int cg = blk * 128 + w * 16 + 4 * fq;
            const f32x4 gbv = *reinterpret_cast<const f32x4*>(p.lru_gate_b + (dir * 2 + gate) * 1024 + cg);
            f32x4 lamv = *reinterpret_cast<const f32x4*>(p.lru_lambda + dir * 1024 + cg);
#pragma unroll
            for (int tt = 0; tt < 4; ++tt) {
                f32x4 z = (f32x4){0.f, 0.f, 0.f, 0.f};
#pragma unroll
                for (int kk = 0; kk < 4; ++kk) z = mfma16(ld_frag_s(Wb + (w * 16 + fr) * 136 + kk * 32 + fq * 8), ld_frag_s(ub + (tt * 16 + fr) * 136 + kk * 32 + fq * 8), z);
                const int tj = tt * 16 + fr;
                if (gate == 0) {
                    f32x4 av;
#pragma unroll
                    for (int q = 0; q < 4; ++q) {
                        const float r = sigmoidf_(z[q] + gbv[q]);
                        const float nl = -lamv[q];
                        const float sp = fmaxf(nl, 0.f) + log1pf(__expf(-fabsf(nl)));
                        const float a = __expf(-8.f * r * sp);
                        areg[tt][q] = a; av[q] = a;
                    }
                    *reinterpret_cast<f32x4*>(sa + tj * 128 + w * 16 + 4 * fq) = av;
                } else {
                    const u32x2 uv = *reinterpret_cast<const u32x2*>(ub + tj * 136 + w * 16 + 4 * fq);
                    const float u4[4] = {bf_lo(uv[0]), bf_hi(uv[0]), bf_lo(uv[1]), bf_hi(uv[1])};
                    f32x4 bv;
#pragma unroll
                    for (int q = 0; q < 4; ++q) {
                        const float ig = sigmoidf_(z[q] + gbv[q]);
                        const float a = areg[tt][q];
                        bv[q] = sqrtf(fmaxf(1.f - a * a, 0.f)) * ig * u4[q];
                    }
                    *reinterpret_cast<f32x4*>(sbt + tj * 128 + w * 16 + 4 * fq) = bv;
                }
            }
        }
        __syncthreads();
        if (t < 128) {
            const int c = t, chg = blk * 128 + c;
            const size_t sidx = ((size_t)(dir * 4 + b) * 68) * 1024 + chg;
            if (mode == 0) {
                float h = 0.f, A = 1.f;
                for (int s = 0; s < 64; ++s) { const int j = dir ? 63 - s : s; const float a = sa[j * 128 + c]; h = a * h + sbt[j * 128 + c]; A *= a; }
                SA[sidx + (size_t)ci * 1024] = A; SH[sidx + (size_t)ci * 1024] = h;
            } else {
                float h = 0.f;
                if (dir == 0) { for (int cj = 0; cj < ci; ++cj) h = SA[sidx + (size_t)cj * 1024] * h + SH[sidx + (size_t)cj * 1024]; }
                else {
                    for (int cj = 3; cj >= 0; --cj) h = SA[sidx + (size_t)cj * 1024] * h + SH[sidx + (size_t)cj * 1024];
                    for (int cj = 67; cj > ci; --cj) h = SA[sidx + (size_t)cj * 1024] * h + SH[sidx + (size_t)cj * 1024];
                }
                u16* YIN = (u16*)(p.ws + WS_YIN);
                for (int s = 0; s < 64; ++s) {
                    const int j = dir ? 63 - s : s;
                    h = sa[j * 128 + c] * h + sbt[j * 128 + c];
                    if (dir == 0) hf[j * 128 + c] = f2bf(h);
                    else {
                        const int row = lru_row(b, ci, j);
                        const float gr = bf2f(P[(size_t)row * CD_IN + 2560 + chg]);
                        const float ge = 0.5f * gr * (1.f + tanhf(0.7978845608028654f * (gr + 0.044715f * gr * gr * gr)));
                        YIN[(size_t)row * D + 1024 + chg] = f2bf((bf2f(hf[j * 128 + c]) + h) * ge);
                    }
                }
            }
        }
    }
}

__device__ void phase_l1_stage1(const Params& p, unsigned char* lds) {
    for (int item = bid_(); item < 2176 + 2048; item += gdim_()) {
        if (item < 2176) { const int ci = item % 68, blk = (item / 68) & 7, b = item / (68 * 8); lru_chunk(p, b, blk, ci, 0, lds); }
        else rope_rows(p, (item - 2176) * 8, 8);
    }
}
__device__ void phase_l1_stage2(const Params& p, unsigned char* lds) {
    const int w = tid_() >> 6;
    const u16* P = (const u16*)(p.ws + WS_P);
    u16* YIN = (u16*)(p.ws + WS_YIN);
    for (int item = bid_(); item < 4096; item += gdim_()) {
        if (item < 2048) { const int cl = item & 63, blk = (item >> 6) & 7, b = item >> 9; lru_chunk(p, b, blk, cl + 4, 1, lds); }
        else {
            __syncthreads();
            const int it = item - 2048, hq = (it & 1) * 8 + w, t16 = (it >> 1) & 255, b = it >> 9;
            const int kvh = hq >> 2, t0 = t16 * 16;
            const int ks = (t0 - 128) & ~31;
            const int qrow = b * SEQ + t0;
            u16* vlds = (u16*)lds + w * (32 * 72);
            auto keyfn = [&](int ib, const u16*& kp, const u16*& vp, size_t& kvs) -> bool {
                int row;
                if (ib < 9) { const int k0 = ks + ib * 32; if (k0 < 0 || k0 >= SEQ) return false; row = b * SEQ + k0; }
                else row = NLAT + b * LC + (ib - 9) * 32;
                kp = P + (size_t)row * CD_IN + 1024 + kvh * 64; vp = P + (size_t)row * CD_IN + 1280 + kvh * 64; kvs = CD_IN; return true; };
            auto biasfn = [&](int ib, int qi, int ki) -> float {
                if (ib >= 9) return 0.f;
                const int dq = (t0 + qi) - (ks + ib * 32 + ki);
                return (dq > 128 || dq < -128) ? -INFINITY : 0.f; };
            const float sink = p.gqa_sink[hq];
            attn_wave<64>(P + (size_t)qrow * CD_IN + hq * 64, CD_IN, 17, keyfn, biasfn, 0.125f, sink, ((tid_() & 63) >> 4) == 0 ? 1.f : 0.f, vlds,
                          YIN + (size_t)qrow * D + hq * 64, D);
        }
    }
}

__device__ void phase_rowpass_mid(const Params& p, int l, unsigned char* lds) {
    float* R = (float*)lds;
    const int t = tid_(), lane = t & 63, w = t >> 6;
    const int nrows = l == 0 ? NTOK : NLAT;
    __syncthreads();
    for (int i = t; i < D * NEXP; i += NT) { const int k = i >> 4, e = i & 15; R[e * D + k] = p.moe_router[(size_t)l * D * NEXP + i]; }
    __syncthreads();
    const float* Y = (const float*)(p.ws + WS_Y);
    float* XL1 = (float*)(p.ws + WS_XL1);
    u16* H = (u16*)(p.ws + WS_H);
    float* AFF = (float*)(p.ws + WS_AFF);
    for (int row = bid_() * 8 + w; row < nrows; row += gdim_() * 8) {
        f32x4 v[8]; float ss = 0.f;
#pragma unroll
        for (int i = 0; i < 8; ++i) { v[i] = *reinterpret_cast<const f32x4*>(Y + (size_t)row * D + (i * 64 + lane) * 4); ss += v[i][0] * v[i][0] + v[i][1] * v[i][1] + v[i][2] * v[i][2] + v[i][3] * v[i][3]; }
        ss = wave_sum(ss);
        const float rstd = rsqrtf(ss * (1.f / D) + 1e-6f);
        const float* xr = xin_row(p, l, row);
        const float* g1 = mod_ptr(p, l, row, 2);
        const float* nw = p.norm_mix_post + (size_t)l * D;
        float ss1 = 0.f;
#pragma unroll
        for (int i = 0; i < 8; ++i) {
            const int col = (i * 64 + lane) * 4;
            const f32x4 x4 = *reinterpret_cast<const f32x4*>(xr + col), w4 = *reinterpret_cast<const f32x4*>(nw + col), g4 = *reinterpret_cast<const f32x4*>(g1 + col);
            const f32x4 x1 = x4 + g4 * (v[i] * rstd * w4);
            *reinterpret_cast<f32x4*>(XL1 + (size_t)row * D + col) = x1;
            v[i] = x1; ss1 += x1[0] * x1[0] + x1[1] * x1[1] + x1[2] * x1[2] + x1[3] * x1[3];
        }
        ss1 = wave_sum(ss1);
        const float rstd1 = rsqrtf(ss1 * (1.f / D) + 1e-6f);
        const float* sh = mod_ptr(p, l, row, 3); const float* sc = mod_ptr(p, l, row, 4);
        const float* nw2 = p.norm_ffn_pre + (size_t)l * D;
#pragma unroll
        for (int i = 0; i < 8; ++i) {
            const int col = (i * 64 + lane) * 4;
            const f32x4 w4 = *reinterpret_cast<const f32x4*>(nw2 + col), s4 = *reinterpret_cast<const f32x4*>(sc + col), h4 = *reinterpret_cast<const f32x4*>(sh + col);
            const f32x4 o = v[i] * rstd1 * w4 * (s4 + 1.f) + h4;
            u32x2 pk = {pk_bf16(o[0], o[1]), pk_bf16(o[2], o[3])};
            *reinterpret_cast<u32x2*>(H + (size_t)row * D + col) = pk;
            v[i] = o;
        }
        float mine = 0.f;
#pragma unroll 2
        for (int e = 0; e < 16; ++e) {
            float sdot = 0.f;
#pragma unroll
            for (int i = 0; i < 8; ++i) { const f32x4 r4 = *reinterpret_cast<const f32x4*>(R + e * D + (i * 64 + lane) * 4); sdot += v[i][0] * r4[0] + v[i][1] * r4[1] + v[i][2] * r4[2] + v[i][3] * r4[3]; }
            sdot = wave_sum(sdot);
            if (lane == e) mine = sdot;
        }
        float mx = mine;
#pragma unroll
        for (int o = 8; o > 0; o >>= 1) mx = fmaxf(mx, __shfl_xor(mx, o, 64));
        const float pe = __expf(mine - mx);
        float den = pe;
#pragma unroll
        for (int o = 8; o > 0; o >>= 1) den += __shfl_xor(den, o, 64);
        if (lane < 16) AFF[(size_t)row * 16 + lane] = pe / den;
    }
}

__device__ void phase_topk(const Params& p, int l, unsigned char* lds) {
    unsigned* keys = (unsigned*)lds;
    unsigned* hist = keys + 4096;
    unsigned* misc = hist + 256;
    const int t = tid_(), lane = t & 63, w = t >> 6;
    const float* AFF = (const float*)(p.ws + WS_AFF);
    int* SLOT = (int*)(p.ws + WS_SLOT);
    int* EROW = (int*)(p.ws + WS_EROW);
    float* EGATE = (float*)(p.ws + WS_EGATE);
    const int nitems = l == 0 ? 128 : 64;
    for (int item = bid_(); item < nitems; item += gdim_()) {
        const int kind = item >> 6, b = (item >> 4) & 3, ex = item & 15;
        const int n = kind ? LC : SEQ, cap = n / 8, rowbase = kind ? NLAT + b * LC : b * SEQ;
        __syncthreads();
        for (int i = t; i < n; i += NT) keys[i] = __float_as_uint(AFF[(size_t)(rowbase + i) * 16 + ex]);
        unsigned prefix = 0u, mask = 0u; int kth = cap;
        for (int shift = 24; shift >= 0; shift -= 8) {
            __syncthreads();
            if (t < 256) hist[t] = 0u;
            __syncthreads();
            for (int i = t; i < n; i += NT) { const unsigned k = keys[i]; if ((k & mask) == prefix) atomicAdd(&hist[(k >> shift) & 255u], 1u); }
            __syncthreads();
            if (t < 256) {
                unsigned above = 0u;
                for (int d2 = t + 1; d2 < 256; ++d2) above += hist[d2];
                const unsigned here = hist[t];
                if ((int)above < kth && (int)(above + here) >= kth) { misc[0] = (unsigned)t; misc[1] = (unsigned)(kth - (int)above); }
            }
            __syncthreads();
            prefix |= misc[0] << shift; mask |= 255u << shift; kth = (int)misc[1];
        }
        const unsigned T = prefix; const int need_eq = kth;
        int cgt = 0, ceq = 0;
        const int base = t * 8;
        if (base < n) {
#pragma unroll
            for (int q = 0; q < 8; ++q) { const unsigned k = keys[base + q]; cgt += (k > T); ceq += (k == T); }
        }
        int packed = cgt | (ceq << 16);
        int incl = packed;
#pragma unroll
        for (int o = 1; o < 64; o <<= 1) { const int nb = __shfl_up(incl, o, 64); if (lane >= o) incl += nb; }
        __syncthreads();
        if (lane == 63) misc[8 + w] = (unsigned)incl;
        __syncthreads();
        int woff = 0, total = 0;
#pragma unroll
        for (int q = 0; q < 8; ++q) { const int v = (int)misc[8 + q]; if (q < w) woff += v; total += v; }
        const int excl = woff + incl - packed;
        int pgt = excl & 0xffff, peq = excl >> 16;
        const int tot_gt = total & 0xffff;
        const int sbase = kind ? 2048 + b * 32 : b * 512;
        if (base < n) {
#pragma unroll
            for (int q = 0; q < 8; ++q) {
                const unsigned k = keys[base + q];
                const int row = rowbase + base + q;
                int pos = -1;
                if (k > T) { pos = pgt; ++pgt; }
                else if (k == T) { if (peq < need_eq) pos = tot_gt + peq; ++peq; }
                if (pos >= 0) { const int sl = sbase + pos; EROW[ex * EPAD + sl] = row; EGATE[ex * EPAD + sl] = __uint_as_float(k); SLOT[(size_t)row * 16 + ex] = sl; }
                else SLOT[(size_t)row * 16 + ex] = -1;
            }
        }
    }
}

__device__ void phase_final(const Params& p, int l) {
    const int lane = tid_() & 63, w = tid_() >> 6;
    const int nrows = l == 0 ? NTOK : NLAT;
    const u16* YEXP = (const u16*)(p.ws + WS_YEXP);
    const int* SLOT = (const int*)(p.ws + WS_SLOT);
    const float* XL1 = (const float*)(p.ws + WS_XL1);
    float* XL2 = (float*)(p.ws + WS_XL2);
    u16* H = (u16*)(p.ws + WS_H);
    for (int row = bid_() * 8 + w; row < nrows; row += gdim_() * 8) {
        f32x4 v[8];
#pragma unroll
        for (int i = 0; i < 8; ++i) v[i] = (f32x4){0.f, 0.f, 0.f, 0.f};
        for (int e = 0; e < NEXP; ++e) {
            const int sl = SLOT[(size_t)row * 16 + e];
            if (sl >= 0) {
                const u16* yp = YEXP + ((size_t)e * EPAD + sl) * D;
#pragma unroll
                for (int i = 0; i < 8; ++i) { const u32x2 q = *reinterpret_cast<const u32x2*>(yp + (i * 64 + lane) * 4); v[i][0] += bf_lo(q[0]); v[i][1] += bf_hi(q[0]); v[i][2] += bf_lo(q[1]); v[i][3] += bf_hi(q[1]); }
            }
        }
        float ss = 0.f;
#pragma unroll
        for (int i = 0; i < 8; ++i) ss += v[i][0] * v[i][0] + v[i][1] * v[i][1] + v[i][2] * v[i][2] + v[i][3] * v[i][3];
        ss = wave_sum(ss);
        const float rstd = rsqrtf(ss * (1.f / D) + 1e-6f);
        const float* g2 = mod_ptr(p, l, row, 5);
        const float* nw = p.norm_ffn_post + (size_t)l * D;
        float* dst = l == 0 ? XL2 + (size_t)row * D : p.out + (size_t)row * D;
        float ss2 = 0.f;
#pragma unroll
        for (int i = 0; i < 8; ++i) {
            const int col = (i * 64 + lane) * 4;
            const f32x4 x4 = *reinterpret_cast<const f32x4*>(XL1 + (size_t)row * D + col), w4 = *reinterpret_cast<const f32x4*>(nw + col), g4 = *reinterpret_cast<const f32x4*>(g2 + col);
            const f32x4 x2 = x4 + g4 * (v[i] * rstd * w4);
            *reinterpret_cast<f32x4*>(dst + col) = x2;
            v[i] = x2; ss2 += x2[0] * x2[0] + x2[1] * x2[1] + x2[2] * x2[2] + x2[3] * x2[3];
        }
        if (l == 0) {
            ss2 = wave_sum(ss2);
            const float rstd2 = rsqrtf(ss2 * (1.f / D) + 1e-6f);
            const float* sh = mod_ptr(p, 1, row, 0); const float* sc = mod_ptr(p, 1, row, 1);
            const float* nw1 = p.norm_mix_pre + D;
#pragma unroll
            for (int i = 0; i < 8; ++i) {
                const int col = (i * 64 + lane) * 4;
                const f32x4 w4 = *reinterpret_cast<const f32x4*>(nw1 + col), s4 = *reinterpret_cast<const f32x4*>(sc + col), h4 = *reinterpret_cast<const f32x4*>(sh + col);
                const f32x4 o = v[i] * rstd2 * w4 * (s4 + 1.f) + h4;
                u32x2 pk = {pk_bf16(o[0], o[1]), pk_bf16(o[2], o[3])};
                *reinterpret_cast<u32x2*>(H + (size_t)row * D + col) = pk;
            }
        }
    }
}

__global__ void __launch_bounds__(NT, 2) fwd_kernel(Params p) {
    extern __shared__ __attribute__((aligned(16))) unsigned char lds[];
    unsigned char* wlds = lds + 16;
    if (threadIdx.x == 0) *reinterpret_cast<uint4*>(lds) = make_uint4(0u, 0u, 0u, 0u);
    __syncthreads();
    XcdBarrier bar = xcd_barrier_post((unsigned*)(p.ws + WS_BAR), (volatile LAS unsigned*)lds);
#ifndef PH_MASK
#define PH_MASK 0xFFFFFFFFu
#endif
#define PHASE(id, body) do { if (((PH_MASK >> ((id) % 32)) & 1u) && p.ph_lo <= (id) && (id) < p.ph_hi) { body; if ((id) + 1 < p.ph_hi) xcd_barrier(bar); } } while (0)
    PHASE(0, phase_mod(p, wlds));
    PHASE(1, phase_norm_mod(p, 0));
#pragma unroll
    for (int l = 0; l < 2; ++l) {
        const int pb = 2 + 9 * l;
        {
            EpiDesc e; e.ob = (u16*)(p.ws + WS_P); e.of = nullptr; e.ldo = l == 0 ? AB_IN : CD_IN; e.gates = l == 0 ? (float*)(p.ws + WS_G) : nullptr; e.rscale = nullptr;
            PHASE(pb + 0, phase_gemm_dense<EPI_BF16>(p, (const u16*)(p.ws + WS_H), NTOK, l == 0 ? p.ab_w_in : p.cd_w_in, l == 0 ? AB_IN : CD_IN, e, wlds));
        }
        if (l == 0) {
            PHASE(pb + 1, phase_mlstm(p, wlds));
            PHASE(pb + 2, phase_l0_stage2(p, wlds));
        } else {
            PHASE(pb + 1, phase_l1_stage1(p, wlds));
            PHASE(pb + 2, phase_l1_stage2(p, wlds));
        }
        {
            EpiDesc e; e.ob = nullptr; e.of = (float*)(p.ws + WS_Y); e.ldo = D; e.gates = nullptr; e.rscale = nullptr;
            PHASE(pb + 3, phase_gemm_dense<EPI_F32>(p, (const u16*)(p.ws + WS_YIN), l == 0 ? NTOK : NLAT, l == 0 ? p.ab_w_out : p.cd_w_out, D, e, wlds));
        }
        PHASE(pb + 4, phase_rowpass_mid(p, l, wlds));
        PHASE(pb + 5, phase_topk(p, l, wlds));
        PHASE(pb + 6, phase_moe_a(p, l, wlds));
        PHASE(pb + 7, phase_moe_b(p, l, wlds));
        PHASE(pb + 8, phase_final(p, l));
    }
}


#ifdef DBG_STOP
__global__ void dbg_digest(const unsigned char* ws, size_t off, int kind, size_t nelem, float* out, size_t nout) {
    for (size_t i = (size_t)blockIdx.x * blockDim.x + threadIdx.x; i < nout; i += (size_t)gridDim.x * blockDim.x) {
        float v = 0.f;
        for (size_t j = i; j < nelem; j += nout) {
            if (kind == 0) v += bf2f(((const u16*)(ws + off))[j]);
            else if (kind == 1) v += ((const float*)(ws + off))[j];
            else v += (float)((const int*)(ws + off))[j];
        }
        out[i] = v;
    }
}
#endif
extern "C" void kernel_launch(void* const* d_in, const int* in_sizes, int n_in, void* d_out, int out_size, void* d_ws, size_t ws_size, hipStream_t stream) {
    static int grid = 0;
    if (grid == 0) {
        if (n_in != 27 || ws_size < WS_END) { fprintf(stderr, "kernel_launch: unexpected n_in %d / ws %zu (need %zu)\n", n_in, ws_size, (size_t)WS_END); grid = -1; return; }
        int dev = 0, cus = 0, per_cu = 0;
        hipGetDevice(&dev);
        hipDeviceGetAttribute(&cus, hipDeviceAttributeMultiprocessorCount, dev);
        if (hipFuncSetAttribute((const void*)fwd_kernel, hipFuncAttributeMaxDynamicSharedMemorySize, LDS_BYTES) != hipSuccess) { fprintf(stderr, "kernel_launch: hipFuncSetAttribute failed\n"); grid = -1; return; }
        hipOccupancyMaxActiveBlocksPerMultiprocessor(&per_cu, (const void*)fwd_kernel, NT, LDS_BYTES);
        (void)hipGetLastError();
        if (per_cu < 1) fprintf(stderr, "kernel_launch: occupancy query reports %d blocks per CU\n", per_cu);
        grid = cus > 0 ? cus : 256;
    }
    if (grid < 0) return;
    hipMemsetAsync((char*)d_ws + WS_BAR, 0, XCD_BAR_WORDS * sizeof(unsigned), stream);
    Params p; memset(&p, 0, sizeof(p));
    const float** f = (const float**)&p;
    for (int i = 0; i < 27; ++i) f[i] = (const float*)d_in[i];
    p.out = (float*)d_out; p.ws = (unsigned char*)d_ws;
#if N_LAUNCH_MODE == 1
    p.ph_lo = 0; p.ph_hi = NPH;
    hipLaunchKernelGGL(fwd_kernel, dim3(grid), dim3(NT), LDS_BYTES, stream, p);
#else
#ifdef DBG_STOP
    for (int ph = 0; ph <= DBG_STOP; ++ph) { p.ph_lo = ph; p.ph_hi = ph + 1; hipLaunchKernelGGL(fwd_kernel, dim3(grid), dim3(NT), LDS_BYTES, stream, p); }
    hipLaunchKernelGGL(dbg_digest, dim3(2048), dim3(256), 0, stream, (const unsigned char*)d_ws, (size_t)DBG_OFF, (int)DBG_KIND, (size_t)DBG_NELEM, (float*)d_out, (size_t)out_size);
#else
    for (int ph = 0; ph < NPH; ++ph) { p.ph_lo = ph; p.ph_hi = ph + 1; hipLaunchKernelGGL(fwd_kernel, dim3(grid), dim3(NT), LDS_BYTES, stream, p); }
#endif
#endif
}
```

```cpp
#include <hip/hip_runtime.h>
#include <stdint.h>
#include <stdio.h>
#include <string.h>

#ifndef N_LAUNCH_MODE
#define N_LAUNCH_MODE 1
#endif

typedef unsigned short u16;
typedef short bf16x8 __attribute__((ext_vector_type(8)));
typedef float f32x4 __attribute__((ext_vector_type(4)));
typedef unsigned u32x4 __attribute__((ext_vector_type(4)));
typedef unsigned u32x2 __attribute__((ext_vector_type(2)));

#define NT 512
constexpr int D = 2048, BATCH = 4, SEQ = 4096, LC = 256;
constexpr int NLAT = BATCH * SEQ, NCTX = BATCH * LC, NTOK = NLAT + NCTX;
constexpr int AB_IN = 7184, CD_IN = 3584;
constexpr int NEXP = 16, FF = 2048, EPAD = 2304;
constexpr int NPH = 22;
constexpr int LDS_BYTES = 150 * 1024;

constexpr size_t al256(size_t x) { return (x + 255) & ~(size_t)255; }
constexpr size_t WS_BAR = 0;
constexpr size_t WS_MOD = 16384;
constexpr size_t WS_XL1 = al256(WS_MOD + 2 * 5 * 12288 * 4);
constexpr size_t WS_XL2 = al256(WS_XL1 + (size_t)NTOK * D * 4);
constexpr size_t WS_H = al256(WS_XL2 + (size_t)NTOK * D * 4);
constexpr size_t WS_P = al256(WS_H + (size_t)NTOK * D * 2);
constexpr size_t WS_G = al256(WS_P + (size_t)NTOK * AB_IN * 2);
constexpr size_t WS_HM = al256(WS_G + (size_t)NTOK * 16 * 4);
constexpr size_t WS_YIN = al256(WS_HM + (size_t)2 * NTOK * 1024 * 2);
constexpr size_t WS_Y = al256(WS_YIN + (size_t)NTOK * D * 2);
constexpr size_t WS_AFF = al256(WS_Y + (size_t)NTOK * D * 4);
constexpr size_t WS_SLOT = al256(WS_AFF + (size_t)NTOK * 16 * 4);
constexpr size_t WS_EROW = al256(WS_SLOT + (size_t)NTOK * 16 * 4);
constexpr size_t WS_EGATE = al256(WS_EROW + (size_t)NEXP * EPAD * 4);
constexpr size_t WS_ACT = al256(WS_EGATE + (size_t)NEXP * EPAD * 4);
constexpr size_t WS_YEXP = al256(WS_ACT + (size_t)NEXP * EPAD * FF * 2);
constexpr size_t WS_LRUS = al256(WS_YEXP + (size_t)NEXP * EPAD * D * 2);
constexpr size_t WS_LRUW = al256(WS_LRUS + (size_t)2 * 2 * 4 * 68 * 1024 * 4);
constexpr size_t WS_END = al256(WS_LRUW + (size_t)32 * 128 * 128 * 2);

struct Params {
    const float *x, *c, *ctx, *c_ctx, *ada_w, *ada_b, *norm_mix_pre, *norm_mix_post, *norm_ffn_pre, *norm_ffn_post;
    const float *ab_w_in, *ab_w_out, *mlstm_gate_b, *mlstm_norm, *na_rpb;
    const float *cd_w_in, *cd_w_out, *gqa_sink, *lru_conv_w, *lru_conv_b, *lru_gate_w, *lru_gate_b, *lru_lambda;
    const float *moe_router, *moe_w1, *moe_w3, *moe_w2;
    float* out;
    unsigned char* ws;
    int ph_lo, ph_hi;
};

#define XB_TMO      128
#define XB_XCNT(j)  (256  + 64 * (j))
#define XB_XSUB(j)  (1280 + 64 * (j))
#define XB_XGEN(j)  (2304 + 64 * (j))
#define XB_TOP      3328
#define XB_TOPGEN   3392
#define XCD_BAR_WORDS 3456
#define XB_SPIN_CAP (1u << 22)
#define LAS __attribute__((address_space(3)))

__device__ __forceinline__ unsigned xb_ld(unsigned* p)              { return __hip_atomic_load(p, __ATOMIC_RELAXED, __HIP_MEMORY_SCOPE_AGENT); }
__device__ __forceinline__ unsigned xb_add(unsigned* p, unsigned v) { return __hip_atomic_fetch_add(p, v, __ATOMIC_RELAXED, __HIP_MEMORY_SCOPE_AGENT); }
__device__ __forceinline__ unsigned xb_xcc_id() { return (unsigned)__builtin_amdgcn_s_getreg((3 << 11) | 20) & 0xFu; }
#define XB_SPIN(cond, bar) do { unsigned _sp = 0; while (cond) { __builtin_amdgcn_s_sleep(1); \
    if ((++_sp & 255u) == 0u) { if (xb_ld(&(bar)[XB_TMO])) break; if (_sp > XB_SPIN_CAP) { atomicAdd(&(bar)[XB_TMO], 1u); break; } } } } while (0)

struct XcdBarrier {
    unsigned* bar; unsigned x;
    volatile LAS unsigned* st;
};
__device__ __forceinline__ XcdBarrier xcd_barrier_post(unsigned* bar, volatile LAS unsigned* st) {
    XcdBarrier b; b.bar = bar; b.x = xb_xcc_id(); b.st = st;
    if (threadIdx.x == 0) (void)xb_add(&bar[XB_XCNT(b.x)], 1u);
    return b;
}
__device__ __forceinline__ void xcd_barrier_complete(unsigned* bar, unsigned x, unsigned& nloc, unsigned& nx) {
    const unsigned G = gridDim.x * gridDim.y * gridDim.z;
    unsigned sum, cnt, mine, sp = 0u;
    for (;;) {
        sum = 0u; cnt = 0u; mine = 0u;
#pragma unroll
        for (unsigned j = 0; j < 16; ++j) { const unsigned c = xb_ld(&bar[XB_XCNT(j)]); sum += c; cnt += (c > 0u) ? 1u : 0u; mine = (j == x) ? c : mine; }
        if (sum == G) break;
        __builtin_amdgcn_s_sleep(1);
        if ((++sp & 255u) == 0u) { if (xb_ld(&bar[XB_TMO])) break; if (sp > XB_SPIN_CAP) { atomicAdd(&bar[XB_TMO], 1u); break; } }
    }
    nloc = mine > 0u ? mine : 1u; nx = cnt > 0u ? cnt : 1u;
}
__device__ __forceinline__ void xcd_barrier(const XcdBarrier& b) {
    asm volatile("s_waitcnt vmcnt(0)" ::: "memory");
    __syncthreads();
    if (threadIdx.x == 0) {
        unsigned* bar = b.bar;
        __builtin_amdgcn_s_waitcnt(0);
        unsigned nloc = b.st[0], nx = b.st[1];
        if (nloc == 0u) { xcd_barrier_complete(bar, b.x, nloc, nx); b.st[0] = nloc; b.st[1] = nx; }
        const unsigned old = xb_add(&bar[XB_XSUB(b.x)], 1u);
        const unsigned gen = old / nloc;
        if (old + 1u == (gen + 1u) * nloc) {
            __builtin_amdgcn_fence(__ATOMIC_RELEASE, "agent");
            asm volatile("s_waitcnt vmcnt(0)" ::: "memory");
            const unsigned og = xb_add(&bar[XB_TOP], 1u);
            const unsigned tg = og / nx;
            if (og + 1u == (tg + 1u) * nx) xb_add(&bar[XB_TOPGEN], 1u);
            else XB_SPIN(xb_ld(&bar[XB_TOPGEN]) == tg, bar);
            __builtin_amdgcn_fence(__ATOMIC_ACQUIRE, "agent");
            xb_add(&bar[XB_XGEN(b.x)], 1u);
            asm volatile("s_waitcnt vmcnt(0)" ::: "memory");
        } else {
            XB_SPIN(xb_ld(&bar[XB_XGEN(b.x)]) == gen, bar);
            __builtin_amdgcn_fence(__ATOMIC_ACQUIRE, "agent");
            asm volatile("s_waitcnt vmcnt(0)" ::: "memory");
        }
    }
    __syncthreads();
}

typedef float f32x2_t __attribute__((ext_vector_type(2)));
typedef __bf16 bf16x2_t __attribute__((ext_vector_type(2)));
__device__ __forceinline__ unsigned pk_bf16(float lo, float hi) { f32x2_t v = {lo, hi}; return __builtin_bit_cast(unsigned, __builtin_convertvector(v, bf16x2_t)); }
__device__ __forceinline__ float bf_lo(unsigned u) { return __uint_as_float(u << 16); }
__device__ __forceinline__ float bf_hi(unsigned u) { return __uint_as_float(u & 0xffff0000u); }
__device__ __forceinline__ float bf2f(u16 v) { return __uint_as_float(((unsigned)v) << 16); }
__device__ __forceinline__ u16 f2bf(float f) { return (u16)(pk_bf16(f, 0.f) & 0xffffu); }
__device__ __forceinline__ float wave_sum(float v) {
#pragma unroll
    for (int o = 32; o > 0; o >>= 1) v += __shfl_xor(v, o, 64);
    return v;
}
__device__ __forceinline__ int tid_() { int t = threadIdx.x; asm volatile("" : "+v"(t)); return t; }
__device__ __forceinline__ int bid_() { int b = blockIdx.x; asm volatile("" : "+s"(b)); return b; }
__device__ __forceinline__ int gdim_() { int b = gridDim.x; asm volatile("" : "+s"(b)); return b; }
__device__ __forceinline__ float sigmoidf_(float x) { return 1.f / (1.f + __expf(-x)); }
__device__ __forceinline__ f32x4 mfma16(bf16x8 a, bf16x8 b, f32x4 c) { return __builtin_amdgcn_mfma_f32_16x16x32_bf16(a, b, c, 0, 0, 0); }
__device__ __forceinline__ bf16x8 ld_frag_g(const u16* p) { return *reinterpret_cast<const bf16x8*>(p); }
__device__ __forceinline__ bf16x8 ld_frag_s(const u16* p) { return *reinterpret_cast<const bf16x8*>(p); }
__device__ __forceinline__ bf16x8 mk_frag(unsigned a, unsigned b, unsigned c, unsigned d) { u32x4 v = {a, b, c, d}; return __builtin_bit_cast(bf16x8, v); }

__device__ __forceinline__ const float* xin_row(const Params& p, int l, int row) {
    if (l == 0) return row < NLAT ? p.x + (size_t)row * D : p.ctx + (size_t)(row - NLAT) * D;
    return (const float*)(p.ws + WS_XL2) + (size_t)row * D;
}
__device__ __forceinline__ const float* mod_ptr(const Params& p, int l, int row, int chunk) {
    const int bb = row < NLAT ? (row >> 12) : 4;
    return (const float*)(p.ws + WS_MOD) + ((size_t)(l * 5 + bb) * 6 + chunk) * D;
}

__device__ void phase_mod(const Params& p, unsigned char* lds_raw) {
    float* scond = (float*)lds_raw;
    float* red = scond + 5 * D;
    const int t = tid_();
    for (int i = t; i < 5 * D; i += NT) { const int r = i >> 11, k = i & 2047; const float v = r < 4 ? p.c[r * D + k] : p.c_ctx[k]; scond[i] = v / (1.f + __expf(-v)); }
    __syncthreads();
    float* mod = (float*)(p.ws + WS_MOD);
    for (int item = bid_(); item < 192; item += gdim_()) {
        const int l = item / 96, col0 = (item % 96) * 128;
        const int kg = t >> 5, cl = (t & 31) * 4;
        f32x4 acc[5];
#pragma unroll
        for (int r = 0; r < 5; ++r) acc[r] = (f32x4){0.f, 0.f, 0.f, 0.f};
        const float* wp = p.ada_w + ((size_t)l * D + kg * 128) * (6 * D) + col0 + cl;
#pragma unroll 8
        for (int kk = 0; kk < 128; ++kk) {
            const f32x4 w = *reinterpret_cast<const f32x4*>(wp + (size_t)kk * (6 * D));
#pragma unroll
            for (int r = 0; r < 5; ++r) { const float s = scond[r * D + kg * 128 + kk]; acc[r] += w * s; }
        }
#pragma unroll
        for (int r = 0; r < 5; ++r) *reinterpret_cast<f32x4*>(red + (kg * 5 + r) * 128 + cl) = acc[r];
        __syncthreads();
        for (int o = t; o < 640; o += NT) {
            const int r = o >> 7, cc = o & 127;
            float s = p.ada_b[l * 6 * D + col0 + cc];
#pragma unroll
            for (int g = 0; g < 16; ++g) s += red[(g * 5 + r) * 128 + cc];
            mod[(size_t)(l * 5 + r) * 6 * D + col0 + cc] = s;
        }
        __syncthreads();
    }
}

__device__ void phase_norm_mod(const Params& p, int l) {
    const int lane = tid_() & 63, w = tid_() >> 6;
    u16* H = (u16*)(p.ws + WS_H);
    for (int row = bid_() * 8 + w; row < NTOK; row += gdim_() * 8) {
        const float* xr = xin_row(p, l, row);
        f32x4 v[8]; float ss = 0.f;
#pragma unroll
        for (int i = 0; i < 8; ++i) { v[i] = *reinterpret_cast<const f32x4*>(xr + (i * 64 + lane) * 4); ss += v[i][0] * v[i][0] + v[i][1] * v[i][1] + v[i][2] * v[i][2] + v[i][3] * v[i][3]; }
        ss = wave_sum(ss);
        const float rstd = rsqrtf(ss * (1.f / D) + 1e-6f);
        const float* sh = mod_ptr(p, l, row, 0); const float* sc = mod_ptr(p, l, row, 1);
        const float* nw = p.norm_mix_pre + (size_t)l * D;
#pragma unroll
        for (int i = 0; i < 8; ++i) {
            const int col = (i * 64 + lane) * 4;
            const f32x4 w4 = *reinterpret_cast<const f32x4*>(nw + col), s4 = *reinterpret_cast<const f32x4*>(sc + col), h4 = *reinterpret_cast<const f32x4*>(sh + col);
            f32x4 o = v[i] * rstd * w4 * (s4 + 1.f) + h4;
            u32x2 pk = {pk_bf16(o[0], o[1]), pk_bf16(o[2], o[3])};
            *reinterpret_cast<u32x2*>(H + (size_t)row * D + col) = pk;
        }
    }
}

struct GemmDesc {
    const u16* A; int lda; const int* arow; int mvalid; int m0;
    const float* B0; const float* B1; int ldb; int n0; int ncols;
    int K;
};
enum { EPI_BF16 = 0, EPI_F32 = 1, EPI_SWIGLU = 2, EPI_SCALE = 3 };
struct EpiDesc { u16* ob; float* of; int ldo; float* gates; const float* rscale; };
constexpr int GEMM_BUF = 49152, GEMM_BOFF = 32768;

template <int EPI>
__device__ __forceinline__ void gemm_tile(const GemmDesc& g, const EpiDesc& e, unsigned char* lds) {
    const int t = tid_(), lane = t & 63, w = t >> 6;
    const int wr = w >> 1, wc = w & 1, fr = lane & 15, fq = lane >> 4;
    const int ac = t & 7, ar = t >> 3;
    unsigned ap[4];
#pragma unroll
    for (int i = 0; i < 4; ++i) {
        int r = g.m0 + ar + 64 * i; if (r >= g.mvalid) r = g.mvalid - 1;
        const int src = g.arow ? g.arow[r] : r;
        ap[i] = (unsigned)src * (unsigned)g.lda + ((ac ^ ((ar >> 1) & 7)) << 3);
    }
    const int a_off = t * 16;
    const int n2 = lane * 2;
    const float* bp;
    if (EPI == EPI_SWIGLU) {
        const int which = (n2 >> 5) & 1, ffl = (n2 >> 6) * 32 + (n2 & 31);
        bp = (which ? g.B1 : g.B0) + g.n0 + ffl;
    } else {
        int col = g.n0 + n2; if (col > g.ncols - 2) col = g.ncols - 2;
        bp = g.B0 + col;
    }
    bp += (size_t)(w * 8) * g.ldb;
    const int b_off = GEMM_BOFF + n2 * 128 + ((w ^ (lane & 7)) << 4);
    const int s0 = (fr >> 1) & 7;
    const int a_rd0 = wr * 8192 + fr * 128 + ((fq ^ s0) << 4), a_rd1 = a_rd0 ^ 64;
    const int b_rd0 = GEMM_BOFF + wc * 8192 + fr * 128 + ((fq ^ s0) << 4), b_rd1 = b_rd0 ^ 64;

    f32x4 acc[4][4];
#pragma unroll
    for (int i = 0; i < 4; ++i)
#pragma unroll
        for (int j = 0; j < 4; ++j) acc[i][j] = (f32x4){0.f, 0.f, 0.f, 0.f};

    typedef float f32x2 __attribute__((ext_vector_type(2)));
    f32x2 breg[8];
    const int nk = g.K >> 6;
#pragma unroll
    for (int i = 0; i < 4; ++i) __builtin_amdgcn_global_load_lds((const unsigned*)(g.A + ap[i]), (unsigned*)(lds + a_off + i * 8192), 16, 0, 0);
#pragma unroll
    for (int j = 0; j < 8; ++j) breg[j] = *reinterpret_cast<const f32x2*>(bp + (size_t)j * g.ldb);

    for (int kt = 0; kt < nk; ++kt) {
        unsigned char* buf = lds + (kt & 1) * GEMM_BUF;
#pragma unroll
        for (int j = 0; j < 2; ++j) {
            u32x4 v = {pk_bf16(breg[0][j], breg[1][j]), pk_bf16(breg[2][j], breg[3][j]), pk_bf16(breg[4][j], breg[5][j]), pk_bf16(breg[6][j], breg[7][j])};
            *reinterpret_cast<u32x4*>(buf + b_off + j * 128) = v;
        }
        asm volatile("s_waitcnt vmcnt(0)" ::: "memory");
        __syncthreads();
        if (kt + 1 < nk) {
            const int k1 = (kt + 1) << 6;
            unsigned char* nbuf = lds + ((kt + 1) & 1) * GEMM_BUF;
#pragma unroll
            for (int i = 0; i < 4; ++i) __builtin_amdgcn_global_load_lds((const unsigned*)(g.A + (ap[i] + k1)), (unsigned*)(nbuf + a_off + i * 8192), 16, 0, 0);
#pragma unroll
            for (int j = 0; j < 8; ++j) breg[j] = *reinterpret_cast<const f32x2*>(bp + (size_t)(k1 + j) * g.ldb);
        }
#pragma unroll
        for (int kk = 0; kk < 2; ++kk) {
            bf16x8 bfr[4];
#pragma unroll
            for (int ni = 0; ni < 4; ++ni) bfr[ni] = *reinterpret_cast<const bf16x8*>(buf + ((kk ? b_rd1 : b_rd0) + ni * 2048));
#pragma unroll
            for (int mi = 0; mi < 4; ++mi) {
                const bf16x8 afr = *reinterpret_cast<const bf16x8*>(buf + ((kk ? a_rd1 : a_rd0) + mi * 2048));
#pragma unroll
                for (int ni = 0; ni < 4; ++ni) acc[mi][ni] = mfma16(bfr[ni], afr, acc[mi][ni]);
            }
        }
    }
#pragma unroll
    for (int mi = 0; mi < 4; ++mi) {
        const int row = g.m0 + wr * 64 + mi * 16 + fr;
        if (row < g.mvalid) {
            if (EPI == EPI_BF16) {
#pragma unroll
                for (int ni = 0; ni < 4; ++ni) {
                    const int col = g.n0 + wc * 64 + ni * 16 + 4 * fq;
                    if (col < g.ncols) {
                        const f32x4 v = acc[mi][ni];
                        u32x2 pk = {pk_bf16(v[0], v[1]), pk_bf16(v[2], v[3])};
                        *reinterpret_cast<u32x2*>(e.ob + (size_t)row * e.ldo + col) = pk;
                        if (e.gates && col >= 4096 && col < 4112) *reinterpret_cast<f32x4*>(e.gates + (size_t)row * 16 + (col - 4096)) = v;
                    }
                }
            } else if (EPI == EPI_F32) {
#pragma unroll
                for (int ni = 0; ni < 4; ++ni) {
                    const int col = g.n0 + wc * 64 + ni * 16 + 4 * fq;
                    *reinterpret_cast<f32x4*>(e.of + (size_t)row * e.ldo + col) = acc[mi][ni];
                }
            } else if (EPI == EPI_SWIGLU) {
#pragma unroll
                for (int ni = 0; ni < 2; ++ni) {
                    const int col = g.n0 + wc * 32 + ni * 16 + 4 * fq;
                    const f32x4 u = acc[mi][ni], v = acc[mi][ni + 2];
                    f32x4 a;
#pragma unroll
                    for (int q = 0; q < 4; ++q) a[q] = u[q] / (1.f + __expf(-u[q])) * v[q];
                    u32x2 pk = {pk_bf16(a[0], a[1]), pk_bf16(a[2], a[3])};
                    *reinterpret_cast<u32x2*>(e.ob + (size_t)row * e.ldo + col) = pk;
                }
            } else {
                const float sc = e.rscale[row];
#pragma unroll
                for (int ni = 0; ni < 4; ++ni) {
                    const int col = g.n0 + wc * 64 + ni * 16 + 4 * fq;
                    const f32x4 v = acc[mi][ni] * sc;
                    u32x2 pk = {pk_bf16(v[0], v[1]), pk_bf16(v[2], v[3])};
                    *reinterpret_cast<u32x2*>(e.ob + (size_t)row * e.ldo + col) = pk;
                }
            }
        }
    }
    __syncthreads();
}

template <int EPI>
__device__ void phase_gemm_dense(const Params& p, const u16* A, int M, const float* W, int N, EpiDesc e, unsigned char* lds) {
    const int nM = M / 256, nN = (N + 127) / 128, L = nM * nN;
    const int xcd = bid_() & 7, slot = bid_() >> 3, nslot = gdim_() >> 3;
    const int base = (int)(((long)L * xcd) >> 3), cnt = (int)(((long)L * (xcd + 1)) >> 3) - base;
    const int G8 = nM >> 3, rem = nM & 7;
    for (int k = slot; k < cnt; k += nslot) {
        const int idx = base + k;
        int pn, pm;
        if (idx < G8 * 8 * nN) { const int gq = idx / (8 * nN), r = idx % (8 * nN); pn = r >> 3; pm = gq * 8 + (r & 7); }
        else { const int r = idx - G8 * 8 * nN; pn = r / rem; pm = G8 * 8 + r % rem; }
        GemmDesc g; g.A = A; g.lda = D; g.arow = nullptr; g.mvalid = M; g.m0 = pm * 256;
        g.B0 = W; g.B1 = nullptr; g.ldb = N; g.n0 = pn * 128; g.ncols = N; g.K = D;
        gemm_tile<EPI>(g, e, lds);
    }
}

__device__ void phase_moe_a(const Params& p, int l, unsigned char* lds) {
    const int mvalid = l == 0 ? 2176 : 2048, nM = l == 0 ? 9 : 8;
    const int per_e = nM * 32;
    const int xcd = bid_() & 7, slot = bid_() >> 3, nslot = gdim_() >> 3;
    for (int k = slot; k < 2 * per_e; k += nslot) {
        const int tile = xcd * 2 * per_e + k;
        const int ex = tile / per_e, r = tile % per_e, pn = r / nM, pm = r % nM;
        GemmDesc g; g.A = (const u16*)(p.ws + WS_H); g.lda = D; g.arow = (const int*)(p.ws + WS_EROW) + ex * EPAD; g.mvalid = mvalid; g.m0 = pm * 256;
        g.B0 = p.moe_w1 + ((size_t)(l * NEXP + ex) * D) * FF; g.B1 = p.moe_w3 + ((size_t)(l * NEXP + ex) * D) * FF; g.ldb = FF; g.n0 = pn * 64; g.ncols = FF; g.K = D;
        EpiDesc e; e.ob = (u16*)(p.ws + WS_ACT) + (size_t)ex * EPAD * FF; e.of = nullptr; e.ldo = FF; e.gates = nullptr; e.rscale = nullptr;
        gemm_tile<EPI_SWIGLU>(g, e, lds);
    }
}
__device__ void phase_moe_b(const Params& p, int l, unsigned char* lds) {
    const int mvalid = l == 0 ? 2176 : 2048, nM = l == 0 ? 9 : 8;
    const int per_e = nM * 16;
    const int xcd = bid_() & 7, slot = bid_() >> 3, nslot = gdim_() >> 3;
    for (int k = slot; k < 2 * per_e; k += nslot) {
        const int tile = xcd * 2 * per_e + k;
        const int ex = tile / per_e, r = tile % per_e, pn = r / nM, pm = r % nM;
        GemmDesc g; g.A = (const u16*)(p.ws + WS_ACT) + (size_t)ex * EPAD * FF; g.lda = FF; g.arow = nullptr; g.mvalid = mvalid; g.m0 = pm * 256;
        g.B0 = p.moe_w2 + ((size_t)(l * NEXP + ex) * FF) * D; g.B1 = nullptr; g.ldb = D; g.n0 = pn * 128; g.ncols = D; g.K = FF;
        EpiDesc e; e.ob = (u16*)(p.ws + WS_YEXP) + (size_t)ex * EPAD * D; e.of = nullptr; e.ldo = D; e.gates = nullptr; e.rscale = (const float*)(p.ws + WS_EGATE) + ex * EPAD;
        gemm_tile<EPI_SCALE>(g, e, lds);
    }
}

__device__ __forceinline__ int mlstm_row(int b, int dir, int pos) {
    if (pos < LC) return NLAT + b * LC + (dir ? (LC - 1 - pos) : pos);
    const int q = pos - LC; return b * SEQ + (dir ? (SEQ - 1 - q) : q);
}
__device__ void phase_mlstm(const Params& p, unsigned char* lds) {
    u16* KT = (u16*)lds;
    u16* VT = KT + 256 * 72;
    u16* VWT = VT + 48 * 72;
    u16* CT = VWT + 48 * 72;
    u16* Ss = CT + 48 * 264;
    float* sb = (float*)(Ss + 64 * 72);
    float* sig = sb + 64;
    float* spm = sig + 64;
    float* ssc = spm + 64;
    const int t = tid_(), lane = t & 63, w = t >> 6, fr = lane & 15, fq = lane >> 4;
    const u16* P = (const u16*)(p.ws + WS_P);
    const float* G = (const float*)(p.ws + WS_G);
    u16* HM = (u16*)(p.ws + WS_HM);
    for (int item = bid_(); item < 256; item += gdim_()) {
        const int vs = item & 7, dir = (item >> 3) & 1, hh = (item >> 4) & 3, b = item >> 6;
        __syncthreads();
        for (int i = t; i < 48 * 264; i += NT) CT[i] = 0;
        for (int i = t; i < 16 * 72; i += NT) { const int er = i / 72; VT[32 * 72 + i] = (er == 0) ? (u16)0x3f80 : (u16)0; VWT[32 * 72 + i] = 0; }
        f32x4 Cacc[2][3];
#pragma unroll
        for (int i = 0; i < 2; ++i)
#pragma unroll
            for (int j = 0; j < 3; ++j) Cacc[i][j] = (f32x4){0.f, 0.f, 0.f, 0.f};
        float m_old = 0.f;
        const float gb_i = p.mlstm_gate_b[(dir * 2 + 0) * 4 + hh], gb_f = p.mlstm_gate_b[(dir * 2 + 1) * 4 + hh];
        const int jt = w & 3, sth = w >> 2;
        for (int ch = 0; ch < 68; ++ch) {
            const int pos0 = ch * 64;
            if (w == 0) {
                const int row = mlstm_row(b, dir, pos0 + lane);
                const float gi = G[(size_t)row * 16 + dir * 8 + hh] + gb_i;
                const float gf = G[(size_t)row * 16 + dir * 8 + 4 + hh] + gb_f;
                const float lf = fminf(gf, 0.f) - log1pf(__expf(-fabsf(gf)));
                float bc = lf;
#pragma unroll
                for (int o = 1; o < 64; o <<= 1) { const float n = __shfl_up(bc, o, 64); if (lane >= o) bc += n; }
                float pm = gi - bc;
#pragma unroll
                for (int o = 1; o < 64; o <<= 1) { const float n = __shfl_up(pm, o, 64); if (lane >= o) pm = fmaxf(pm, n); }
                const float b63 = __shfl(bc, 63, 64);
                float gmax = b63 - bc + gi;
#pragma unroll
                for (int o = 32; o > 0; o >>= 1) gmax = fmaxf(gmax, __shfl_xor(gmax, o, 64));
                const float m_new = fmaxf(b63 + m_old, gmax);
                sb[lane] = bc; sig[lane] = gi; spm[lane] = pm;
                if (lane == 0) { ssc[0] = m_new; ssc[1] = __expf(b63 + m_old - m_new); }
            }
            const int rowq = mlstm_row(b, dir, pos0 + jt * 16 + fr);
            bf16x8 qf[8];
#pragma unroll
            for (int kk = 0; kk < 8; ++kk) qf[kk] = ld_frag_g(P + (size_t)rowq * AB_IN + hh * 256 + kk * 32 + fq * 8);
            bf16x8 kf[8];
            {
                const int rowk = mlstm_row(b, dir, pos0 + (sth * 2) * 16 + fr);
#pragma unroll
                for (int kk = 0; kk < 8; ++kk) kf[kk] = ld_frag_g(P + (size_t)rowk * AB_IN + 1024 + hh * 256 + kk * 32 + fq * 8);
            }
            unsigned ktr[2][8];
#pragma unroll
            for (int i = 0; i < 2; ++i) {
                const int mt = t + NT * i, d2 = (mt & 127) * 2, s8 = (mt >> 7) * 8;
#pragma unroll
                for (int q = 0; q < 8; ++q) ktr[i][q] = *reinterpret_cast<const unsigned*>(P + (size_t)mlstm_row(b, dir, pos0 + s8 + q) * AB_IN + 1024 + hh * 256 + d2);
            }
            const int vs_s = t & 63, vs_eg = t >> 6;
            const u32x2 vraw = *reinterpret_cast<const u32x2*>(P + (size_t)mlstm_row(b, dir, pos0 + vs_s) * AB_IN + 2048 + hh * 256 + vs * 32 + vs_eg * 4);
            __syncthreads();
            const float m_new = ssc[0], decay = ssc[1], b63 = sb[63];
            const int jg = jt * 16 + fr;
            const float bj = sb[jg], mj = bj + fmaxf(m_old, spm[jg]);
            auto s_tile = [&](int st) {
                f32x4 sv = (f32x4){0.f, 0.f, 0.f, 0.f};
                if (st <= jt) {
#pragma unroll
                    for (int kk = 0; kk < 8; ++kk) sv = mfma16(kf[kk], qf[kk], sv);
                }
                float pv[4];
#pragma unroll
                for (int q = 0; q < 4; ++q) {
                    const int sg = st * 16 + 4 * fq + q;
                    pv[q] = (sg <= jg) ? sv[q] * 0.0625f * __expf(bj - sb[sg] + sig[sg] - mj) : 0.f;
                }
                u32x2 pk = {pk_bf16(pv[0], pv[1]), pk_bf16(pv[2], pv[3])};
                *reinterpret_cast<u32x2*>(Ss + jg * 72 + st * 16 + 4 * fq) = pk;
            };
            s_tile(sth * 2);
            {
                const int rowk = mlstm_row(b, dir, pos0 + (sth * 2 + 1) * 16 + fr);
#pragma unroll
                for (int kk = 0; kk < 8; ++kk) kf[kk] = ld_frag_g(P + (size_t)rowk * AB_IN + 1024 + hh * 256 + kk * 32 + fq * 8);
            }
#pragma unroll
            for (int i = 0; i < 2; ++i) {
                const int mt = t + NT * i, d2 = (mt & 127) * 2, s8 = (mt >> 7) * 8;
                u32x4 lo = {(ktr[i][0] & 0xffffu) | (ktr[i][1] << 16), (ktr[i][2] & 0xffffu) | (ktr[i][3] << 16), (ktr[i][4] & 0xffffu) | (ktr[i][5] << 16), (ktr[i][6] & 0xffffu) | (ktr[i][7] << 16)};
                u32x4 hi = {(ktr[i][0] >> 16) | (ktr[i][1] & 0xffff0000u), (ktr[i][2] >> 16) | (ktr[i][3] & 0xffff0000u), (ktr[i][4] >> 16) | (ktr[i][5] & 0xffff0000u), (ktr[i][6] >> 16) | (ktr[i][7] & 0xffff0000u)};
                *reinterpret_cast<u32x4*>(KT + d2 * 72 + s8) = lo;
                *reinterpret_cast<u32x4*>(KT + (d2 + 1) * 72 + s8) = hi;
            }
            {
                const float wg = __expf(b63 - sb[vs_s] + sig[vs_s] - m_new) * 0.0625f;
                const float v0 = bf_lo(vraw[0]), v1 = bf_hi(vraw[0]), v2 = bf_lo(vraw[1]), v3 = bf_hi(vraw[1]);
                const int e0 = vs_eg * 4;
                VT[(e0 + 0) * 72 + vs_s] = (u16)(vraw[0] & 0xffffu); VT[(e0 + 1) * 72 + vs_s] = (u16)(vraw[0] >> 16);
                VT[(e0 + 2) * 72 + vs_s] = (u16)(vraw[1] & 0xffffu); VT[(e0 + 3) * 72 + vs_s] = (u16)(vraw[1] >> 16);
                VWT[(e0 + 0) * 72 + vs_s] = f2bf(v0 * wg); VWT[(e0 + 1) * 72 + vs_s] = f2bf(v1 * wg);
                VWT[(e0 + 2) * 72 + vs_s] = f2bf(v2 * wg); VWT[(e0 + 3) * 72 + vs_s] = f2bf(v3 * wg);
                if (t < 64) VWT[32 * 72 + t] = f2bf(wg);
            }
            s_tile(sth * 2 + 1);
            __syncthreads();
            {
                const float w_inter = __expf(bj + m_old - mj);
                f32x4 nacc[2];
#pragma unroll
                for (int z = 0; z < 2; ++z) {
                    const int et = z == 0 ? sth : 2;
                    f32x4 a = (f32x4){0.f, 0.f, 0.f, 0.f};
#pragma unroll
                    for (int kk = 0; kk < 8; ++kk) a = mfma16(ld_frag_s(CT + (et * 16 + fr) * 264 + kk * 32 + fq * 8), qf[kk], a);
                    a *= w_inter;
#pragma unroll
                    for (int k2 = 0; k2 < 2; ++k2) a = mfma16(ld_frag_s(VT + (et * 16 + fr) * 72 + k2 * 32 + fq * 8), ld_frag_s(Ss + jg * 72 + k2 * 32 + fq * 8), a);
                    nacc[z] = a;
                }
                const float den = __shfl(nacc[1][0], fr, 64);
                const float dd = fmaxf(fabsf(den), __expf(-mj));
                const float inv = 1.f / dd;
                u32x2 pk = {pk_bf16(nacc[0][0] * inv, nacc[0][1] * inv), pk_bf16(nacc[0][2] * inv, nacc[0][3] * inv)};
                *reinterpret_cast<u32x2*>(HM + ((size_t)dir * NTOK + rowq) * 1024 + hh * 256 + vs * 32 + sth * 16 + 4 * fq) = pk;
            }
#pragma unroll
            for (int i = 0; i < 2; ++i)
#pragma unroll
                for (int et = 0; et < 3; ++et) {
                    f32x4 a = Cacc[i][et] * decay;
#pragma unroll
                    for (int k2 = 0; k2 < 2; ++k2) a = mfma16(ld_frag_s(KT + ((w * 2 + i) * 16 + fr) * 72 + k2 * 32 + fq * 8), ld_frag_s(VWT + (et * 16 + fr) * 72 + k2 * 32 + fq * 8), a);
                    Cacc[i][et] = a;
                }
            __syncthreads();
#pragma unroll
            for (int i = 0; i < 2; ++i)
#pragma unroll
                for (int et = 0; et < 3; ++et) {
                    const f32x4 a = Cacc[i][et];
                    u32x2 pk = {pk_bf16(a[0], a[1]), pk_bf16(a[2], a[3])};
                    *reinterpret_cast<u32x2*>(CT + (et * 16 + fr) * 264 + (w * 2 + i) * 16 + 4 * fq) = pk;
                }
            m_old = m_new;
        }
    }
}

__device__ void mlstm_out_rows(const Params& p, int row0, int nrows) {
    const int lane = tid_() & 63, w = tid_() >> 6;
    const u16* P = (const u16*)(p.ws + WS_P);
    const u16* HM = (const u16*)(p.ws + WS_HM);
    u16* YIN = (u16*)(p.ws + WS_YIN);
    for (int r = w; r < nrows; r += 8) {
        const int row = row0 + r;
        const int c0 = lane * 16;
        float v[16]; float ss = 0.f;
#pragma unroll
        for (int h2 = 0; h2 < 2; ++h2) {
            const u32x4 a = *reinterpret_cast<const u32x4*>(HM + (size_t)row * 1024 + c0 + h2 * 8);
            const u32x4 bq = *reinterpret_cast<const u32x4*>(HM + ((size_t)NTOK + row) * 1024 + c0 + h2 * 8);
#pragma unroll
            for (int q = 0; q < 4; ++q) { v[h2 * 8 + 2 * q] = bf_lo(a[q]) + bf_lo(bq[q]); v[h2 * 8 + 2 * q + 1] = bf_hi(a[q]) + bf_hi(bq[q]); }
        }
#pragma unroll
        for (int q = 0; q < 16; ++q) ss += v[q] * v[q];
        ss += __shfl_xor(ss, 1, 64); ss += __shfl_xor(ss, 2, 64); ss += __shfl_xor(ss, 4, 64); ss += __shfl_xor(ss, 8, 64);
        const float rstd = rsqrtf(ss * (1.f / 256.f) + 1e-6f);
        unsigned o[8];
#pragma unroll
        for (int h2 = 0; h2 < 2; ++h2) {
            const u32x4 og = *reinterpret_cast<const u32x4*>(P + (size_t)row * AB_IN + 3072 + c0 + h2 * 8);
#pragma unroll
            for (int q = 0; q < 4; ++q) {
                const int c = c0 + h2 * 8 + 2 * q;
                const float y0 = v[h2 * 8 + 2 * q] * rstd * p.mlstm_norm[c] * sigmoidf_(bf_lo(og[q]));
                const float y1 = v[h2 * 8 + 2 * q + 1] * rstd * p.mlstm_norm[c + 1] * sigmoidf_(bf_hi(og[q]));
                o[h2 * 4 + q] = pk_bf16(y0, y1);
            }
        }
        *reinterpret_cast<u32x4*>(YIN + (size_t)row * D + c0) = (u32x4){o[0], o[1], o[2], o[3]};
        *reinterpret_cast<u32x4*>(YIN + (size_t)row * D + c0 + 8) = (u32x4){o[4], o[5], o[6], o[7]};
    }
}

template <int DH, class KeyFn, class BiasFn>
__device__ __forceinline__ void attn_wave(const u16* qptr, size_t qstride, int nblk, KeyFn keyfn, BiasFn biasfn, float scale,
                                           float m_init, float l_init, u16* vlds, u16* optr, size_t ostride) {
    constexpr int NK = DH / 32, NDT = DH / 16, VS = DH + 8, NV = DH / 16;
    const int lane = tid_() & 63, fr = lane & 15, fq = lane >> 4;
    bf16x8 qf[NK];
#pragma unroll
    for (int kk = 0; kk < NK; ++kk) qf[kk] = ld_frag_g(qptr + (size_t)fr * qstride + kk * 32 + fq * 8);
    f32x4 oacc[NDT];
#pragma unroll
    for (int i = 0; i < NDT; ++i) oacc[i] = (f32x4){0.f, 0.f, 0.f, 0.f};
    float m = m_init, l = l_init;
    bf16x8 kn[2][NK]; u32x4 vn[NV];
    auto load_blk = [&](int ib) {
        const u16* kptr; const u16* vptr; size_t kvs;
        (void)keyfn(ib, kptr, vptr, kvs);
#pragma unroll
        for (int st = 0; st < 2; ++st)
#pragma unroll
            for (int kk = 0; kk < NK; ++kk) kn[st][kk] = ld_frag_g(kptr + (size_t)(st * 16 + fr) * kvs + kk * 32 + fq * 8);
#pragma unroll
        for (int i = 0; i < NV; ++i) { const int cidx = lane + 64 * i, r = cidx / (DH / 8), cc = cidx % (DH / 8); vn[i] = *reinterpret_cast<const u32x4*>(vptr + (size_t)r * kvs + cc * 8); }
    };
    auto next_valid = [&](int ib) { const u16* a; const u16* b2; size_t c; while (ib < nblk && !keyfn(ib, a, b2, c)) ++ib; return ib; };
    int ib = next_valid(0);
    if (ib < nblk) load_blk(ib);
    while (ib < nblk) {
        bf16x8 kc[2][NK]; u32x4 vc[NV];
#pragma unroll
        for (int st = 0; st < 2; ++st)
#pragma unroll
            for (int kk = 0; kk < NK; ++kk) kc[st][kk] = kn[st][kk];
#pragma unroll
        for (int i = 0; i < NV; ++i) vc[i] = vn[i];
        const int ibn = next_valid(ib + 1);
        if (ibn < nblk) load_blk(ibn);
        asm volatile("" ::: "memory");
#pragma unroll
        for (int i = 0; i < NV; ++i) { const int cidx = lane + 64 * i, r = cidx / (DH / 8), cc = cidx % (DH / 8); *reinterpret_cast<u32x4*>(vlds + r * VS + cc * 8) = vc[i]; }
        f32x4 s[2];
#pragma unroll
        for (int st = 0; st < 2; ++st) {
            f32x4 a = (f32x4){0.f, 0.f, 0.f, 0.f};
#pragma unroll
            for (int kk = 0; kk < NK; ++kk) a = mfma16(kc[st][kk], qf[kk], a);
            s[st] = a;
        }
        float x[8]; float mx = -INFINITY;
#pragma unroll
        for (int st = 0; st < 2; ++st)
#pragma unroll
            for (int q = 0; q < 4; ++q) { const float v = s[st][q] * scale + biasfn(ib, fr, st * 16 + 4 * fq + q); x[st * 4 + q] = v; mx = fmaxf(mx, v); }
        mx = fmaxf(mx, __shfl_xor(mx, 16, 64)); mx = fmaxf(mx, __shfl_xor(mx, 32, 64));
        const float m_new = fmaxf(m, mx);
        const float m_safe = (m_new == -INFINITY) ? 0.f : m_new;
        const float alpha = __expf(m - m_safe);
        float ps = 0.f; float pe[8];
#pragma unroll
        for (int q = 0; q < 8; ++q) { pe[q] = __expf(x[q] - m_safe); ps += pe[q]; }
        l = l * alpha + ps; m = m_new;
#pragma unroll
        for (int i = 0; i < NDT; ++i) oacc[i] *= alpha;
        const bf16x8 pf = mk_frag(pk_bf16(pe[0], pe[1]), pk_bf16(pe[2], pe[3]), pk_bf16(pe[4], pe[5]), pk_bf16(pe[6], pe[7]));
        asm volatile("s_waitcnt lgkmcnt(0)" ::: "memory");
#pragma unroll
        for (int dt = 0; dt < NDT; ++dt) {
            const u16* vb = vlds + dt * 16 + fr;
            unsigned e[4];
#pragma unroll
            for (int j2 = 0; j2 < 2; ++j2) {
                const int k0 = (j2 == 0 ? 0 : 16) + 4 * fq;
                e[j2 * 2 + 0] = (unsigned)vb[(k0 + 0) * VS] | ((unsigned)vb[(k0 + 1) * VS] << 16);
                e[j2 * 2 + 1] = (unsigned)vb[(k0 + 2) * VS] | ((unsigned)vb[(k0 + 3) * VS] << 16);
            }
            oacc[dt] = mfma16(mk_frag(e[0], e[1], e[2], e[3]), pf, oacc[dt]);
        }
        asm volatile("" ::: "memory");
        ib = ibn;
    }
    l += __shfl_xor(l, 16, 64); l += __shfl_xor(l, 32, 64);
    const float inv = 1.f / l;
#pragma unroll
    for (int dt = 0; dt < NDT; ++dt) {
        const f32x4 o = oacc[dt] * inv;
        u32x2 pk = {pk_bf16(o[0], o[1]), pk_bf16(o[2], o[3])};
        *reinterpret_cast<u32x2*>(optr + (size_t)fr * ostride + dt * 16 + 4 * fq) = pk;
    }
}

__device__ void phase_l0_stage2(const Params& p, unsigned char* lds) {
    const int w = tid_() >> 6;
    const u16* P = (const u16*)(p.ws + WS_P);
    u16* YIN = (u16*)(p.ws + WS_YIN);
    u16* vlds = (u16*)lds + w * (32 * 136);
    for (int item = bid_(); item < 1088 + 2176; item += gdim_()) {
        if (item < 1024) {
            const int qt = item & 3, r = (item >> 2) & 63, b = item >> 8, h = w;
            const int r0 = min(max(r - 4, 0), 56);
            const int cb = qt == 0 ? 0 : (qt == 1 ? 8 : (qt == 2 ? 24 : 32));
            const int qrow = b * SEQ + r * 64 + qt * 16;
            const float* rpb = p.na_rpb + h * 15 * 31;
            auto keyfn = [&](int ib, const u16*& kp, const u16*& vp, size_t& kvs) -> bool {
                int row;
                if (ib < 8) row = b * SEQ + (r0 + ib) * 64 + cb; else row = NLAT + b * LC + (ib - 8) * 32;
                kp = P + (size_t)row * AB_IN + 5136 + h * 128; vp = P + (size_t)row * AB_IN + 6160 + h * 128; kvs = AB_IN; return true; };
            auto biasfn = [&](int ib, int qi, int ki) -> float {
                if (ib >= 8) return 0.f;
                const int c = qt * 16 + qi, kc = cb + ki, c0 = min(max(c - 8, 0), 48);
                if (kc < c0 || kc >= c0 + 16) return -INFINITY;
                return rpb[(r0 + ib - r + 7) * 31 + (kc - c + 15)]; };
            attn_wave<128>(P + (size_t)qrow * AB_IN + 4112 + h * 128, AB_IN, 16, keyfn, biasfn, 0.08838834764831845f, -INFINITY, 0.f, vlds,
                           YIN + (size_t)qrow * D + 1024 + h * 128, D);
        } else if (item < 1088) {
            const int it = item - 1024, qt = it & 15, b = it >> 4, h = w;
            const int qrow = NLAT + b * LC + qt * 16;
            auto keyfn = [&](int ib, const u16*& kp, const u16*& vp, size_t& kvs) -> bool {
                const int row = NLAT + b * LC + ib * 32;
                kp = P + (size_t)row * AB_IN + 5136 + h * 128; vp = P + (size_t)row * AB_IN + 6160 + h * 128; kvs = AB_IN; return true; };
            auto biasfn = [&](int, int, int) -> float { return 0.f; };
            attn_wave<128>(P + (size_t)qrow * AB_IN + 4112 + h * 128, AB_IN, 8, keyfn, biasfn, 0.08838834764831845f, -INFINITY, 0.f, vlds,
                           YIN + (size_t)qrow * D + 1024 + h * 128, D);
        } else {
            mlstm_out_rows(p, (item - 1088) * 8, 8);
        }
    }
}

__device__ void rope_rows(const Params& p, int row0, int nrows) {
    const int lane = tid_() & 63, w = tid_() >> 6;
    u16* P = (u16*)(p.ws + WS_P);
    for (int r = w; r < nrows; r += 8) {
        const int row = row0 + r, tt = row & (SEQ - 1);
        const float prow = (float)(tt >> 6), pcol = (float)(tt & 63);
        for (int pi = lane; pi < 640; pi += 64) {
            const int head = pi >> 5, half = (pi >> 4) & 1, j = pi & 15;
            const int base = (head < 16 ? head * 64 : 1024 + (head - 16) * 64) + half * 32 + j;
            const float inv = exp2f(-(float)j * (13.287712379549449f / 16.f));
            const float ang = (half ? pcol : prow) * inv;
            float sn, cs; sincosf(ang, &sn, &cs);
            u16* q1 = P + (size_t)row * CD_IN + base;
            const float x1 = bf2f(q1[0]), x2 = bf2f(q1[16]);
            q1[0] = f2bf(x1 * cs - x2 * sn); q1[16] = f2bf(x2 * cs + x1 * sn);
        }
    }
}

__device__ __forceinline__ int lru_row(int b, int ci, int j) { return ci < 4 ? NLAT + b * LC + ci * 64 + j : b * SEQ + (ci - 4) * 64 + j; }
__device__ void lru_chunk(const Params& p, int b, int blk, int ci, int mode, unsigned char* lds) {
    u16* ub = (u16*)lds;
    float* sa = (float*)(ub + 64 * 136);
    float* sbt = sa + 64 * 128;
    float* sx = sbt + 64 * 128;
    const int t = tid_(), lane = t & 63, w = t >> 6, fr = lane & 15, fq = lane >> 4;
    const u16* P = (const u16*)(p.ws + WS_P);
    const u16* WT = (const u16*)(p.ws + WS_LRUW);
    float* SA = (float*)(p.ws + WS_LRUS);
    float* SH = SA + 2 * 4 * 68 * 1024;
    const int seglen = ci < 4 ? LC : SEQ, tt0 = ci < 4 ? ci * 64 : (ci - 4) * 64;
    const int rbase = ci < 4 ? NLAT + b * LC : b * SEQ;
    __syncthreads();
    {
        const int c4 = (t & 31) * 4, j0 = (t >> 5) * 4, ch = blk * 128 + c4;
        float xv[7][4];
#pragma unroll
        for (int q = 0; q < 7; ++q) {
            const int tt = tt0 + j0 - 1 + q;
            if (tt >= 0 && tt < seglen) {
                const u32x2 v = *reinterpret_cast<const u32x2*>(P + (size_t)(rbase + tt) * CD_IN + 1536 + ch);
                xv[q][0] = bf_lo(v[0]); xv[q][1] = bf_hi(v[0]); xv[q][2] = bf_lo(v[1]); xv[q][3] = bf_hi(v[1]);
            } else { xv[q][0] = xv[q][1] = xv[q][2] = xv[q][3] = 0.f; }
        }
        f32x4 cw[4];
#pragma unroll
        for (int tp = 0; tp < 4; ++tp) cw[tp] = *reinterpret_cast<const f32x4*>(p.lru_conv_w + tp * 1024 + ch);
        const f32x4 cb = *reinterpret_cast<const f32x4*>(p.lru_conv_b + ch);
#pragma unroll
        for (int q = 0; q < 4; ++q) {
            float u[4];
#pragma unroll
            for (int cc = 0; cc < 4; ++cc) u[cc] = cb[cc] + xv[q][cc] * cw[0][cc] + xv[q + 1][cc] * cw[1][cc] + xv[q + 2][cc] * cw[2][cc] + xv[q + 3][cc] * cw[3][cc];
            u32x2 pk = {pk_bf16(u[0], u[1]), pk_bf16(u[2], u[3])};
            *reinterpret_cast<u32x2*>(ub + (j0 + q) * 136 + c4) = pk;
        }
    }
    __syncthreads();
    const int sc = t & 127, seg = t >> 7;
    const int chg_s = blk * 128 + sc;
    float hfw[16];
    bf16x8 wfa[2][2][4];
#pragma unroll
    for (int d2 = 0; d2 < 2; ++d2)
#pragma unroll
        for (int g2 = 0; g2 < 2; ++g2)
#pragma unroll
            for (int kk = 0; kk < 4; ++kk) wfa[d2][g2][kk] = ld_frag_g(WT + ((size_t)((d2 * 2 + g2) * 8 + blk) * 128 + w * 16 + fr) * 128 + fq * 8 + kk * 32);
    float carry[2] = {0.f, 0.f}; u16 grv[16];
    if (mode == 1) {
#pragma unroll
        for (int d2 = 0; d2 < 2; ++d2) carry[d2] = SH[((size_t)(d2 * 4 + b) * 68 + ci) * 1024 + chg_s];
#pragma unroll
        for (int s = 0; s < 16; ++s) grv[s] = P[(size_t)lru_row(b, ci, seg * 16 + s) * CD_IN + 2560 + chg_s];
    }
    for (int dir = 0; dir < 2; ++dir) {
        const int cg = blk * 128 + w * 16 + 4 * fq;
        f32x4 av[4];
        {
            bf16x8 wf[4];
#pragma unroll
            for (int kk = 0; kk < 4; ++kk) wf[kk] = dir ? wfa[1][0][kk] : wfa[0][0][kk];
            const f32x4 gbv = *reinterpret_cast<const f32x4*>(p.lru_gate_b + (dir * 2 + 0) * 1024 + cg);
            const f32x4 lamv = *reinterpret_cast<const f32x4*>(p.lru_lambda + dir * 1024 + cg);
            float sp8[4];
#pragma unroll
            for (int q = 0; q < 4; ++q) { const float nl = -lamv[q]; sp8[q] = -8.f * (fmaxf(nl, 0.f) + log1pf(__expf(-fabsf(nl)))); }
#pragma unroll
            for (int tt = 0; tt < 4; ++tt) {
                f32x4 z = (f32x4){0.f, 0.f, 0.f, 0.f};
#pragma unroll
                for (int kk = 0; kk < 4; ++kk) z = mfma16(wf[kk], ld_frag_s(ub + (tt * 16 + fr) * 136 + kk * 32 + fq * 8), z);
#pragma unroll
                for (int q = 0; q < 4; ++q) av[tt][q] = __expf(sigmoidf_(z[q] + gbv[q]) * sp8[q]);
            }
        }
        __syncthreads();
        {
            bf16x8 wf[4];
#pragma unroll
            for (int kk = 0; kk < 4; ++kk) wf[kk] = dir ? wfa[1][1][kk] : wfa[0][1][kk];
            const f32x4 gbv = *reinterpret_cast<const f32x4*>(p.lru_gate_b + (dir * 2 + 1) * 1024 + cg);
#pragma unroll
            for (int tt = 0; tt < 4; ++tt) {
                f32x4 z = (f32x4){0.f, 0.f, 0.f, 0.f};
#pragma unroll
                for (int kk = 0; kk < 4; ++kk) z = mfma16(wf[kk], ld_frag_s(ub + (tt * 16 + fr) * 136 + kk * 32 + fq * 8), z);
                const int tj = tt * 16 + fr;
                const u32x2 uv = *reinterpret_cast<const u32x2*>(ub + tj * 136 + w * 16 + 4 * fq);
                const float u4[4] = {bf_lo(uv[0]), bf_hi(uv[0]), bf_lo(uv[1]), bf_hi(uv[1])};
                f32x4 bv;
#pragma unroll
                for (int q = 0; q < 4; ++q) { const float a = av[tt][q]; bv[q] = sqrtf(fmaxf(1.f - a * a, 0.f)) * sigmoidf_(z[q] + gbv[q]) * u4[q]; }
                *reinterpret_cast<f32x4*>(sa + tj * 128 + w * 16 + 4 * fq) = av[tt];
                *reinterpret_cast<f32x4*>(sbt + tj * 128 + w * 16 + 4 * fq) = bv;
            }
        }
        __syncthreads();
        float A = 1.f, h = 0.f;
#pragma unroll
        for (int s = 0; s < 16; ++s) { const int j = seg * 16 + (dir ? 15 - s : s); const float a = sa[j * 128 + sc]; h = a * h + sbt[j * 128 + sc]; A *= a; }
        sx[(seg * 2 + 0) * 128 + sc] = A; sx[(seg * 2 + 1) * 128 + sc] = h;
        __syncthreads();
        const size_t sidx = ((size_t)(dir * 4 + b) * 68 + ci) * 1024 + chg_s;
        if (mode == 0) {
            if (seg == 0) {
                float At = 1.f, ht = 0.f;
#pragma unroll
                for (int s = 0; s < 4; ++s) { const int sg = dir ? 3 - s : s; const float a = sx[(sg * 2) * 128 + sc]; ht = a * ht + sx[(sg * 2 + 1) * 128 + sc]; At *= a; }
                SA[sidx] = At; SH[sidx] = ht;
            }
        } else {
            float hs = dir ? carry[1] : carry[0];
            const int nprev = dir ? 3 - seg : seg;
#pragma unroll
            for (int s = 0; s < 3; ++s) if (s < nprev) { const int sg = dir ? 3 - s : s; hs = sx[(sg * 2) * 128 + sc] * hs + sx[(sg * 2 + 1) * 128 + sc]; }
            u16* YIN = (u16*)(p.ws + WS_YIN);
#pragma unroll
            for (int s = 0; s < 16; ++s) {
                const int js = dir ? 15 - s : s, j = seg * 16 + js;
                hs = sa[j * 128 + sc] * hs + sbt[j * 128 + sc];
                if (dir == 0) hfw[js] = hs;
                else {
                    const int row = lru_row(b, ci, j);
                    const float gr = bf2f(grv[js]);
                    const float ge = 0.5f * gr * (1.f + tanhf(0.7978845608028654f * (gr + 0.044715f * gr * gr * gr)));
                    YIN[(size_t)row * D + 1024 + chg_s] = f2bf((hfw[js] + hs) * ge);
                }
            }
        }
    }
}

__device__ void lru_prep_weights(const Params& p) {
    const int t = tid_();
    u16* WT = (u16*)(p.ws + WS_LRUW);
    for (int m = bid_(); m < 32; m += gdim_()) {
        const float* Wg = p.lru_gate_w + (size_t)m * 128 * 128;
        const int j4 = (t & 31) * 4, i8 = (t >> 5) * 8;
        f32x4 r8[8];
#pragma unroll
        for (int q = 0; q < 8; ++q) r8[q] = *reinterpret_cast<const f32x4*>(Wg + (size_t)(i8 + q) * 128 + j4);
#pragma unroll
        for (int jj = 0; jj < 4; ++jj) {
            u32x4 v = {pk_bf16(r8[0][jj], r8[1][jj]), pk_bf16(r8[2][jj], r8[3][jj]), pk_bf16(r8[4][jj], r8[5][jj]), pk_bf16(r8[6][jj], r8[7][jj])};
            *reinterpret_cast<u32x4*>(WT + ((size_t)m * 128 + j4 + jj) * 128 + i8) = v;
        }
    }
}
__device__ void lru_carry(const Params& p, int item) {
    const int idx = item * NT + tid_();
    const int c = idx & 1023, b = (idx >> 10) & 3, dir = idx >> 12;
    float* SA = (float*)(p.ws + WS_LRUS);
    float* SH = SA + 2 * 4 * 68 * 1024;
    const size_t base = ((size_t)(dir * 4 + b) * 68) * 1024 + c;
    float h = 0.f;
#pragma unroll 4
    for (int s = 0; s < 68; ++s) {
        const int cj = dir == 0 ? s : (s < 4 ? 3 - s : 71 - s);
        const float a = SA[base + (size_t)cj * 1024], hl = SH[base + (size_t)cj * 1024];
        SH[base + (size_t)cj * 1024] = h;
        h = a * h + hl;
    }
}

__device__ void gqa_item(const Params& p, int it, unsigned char* lds) {
    const int w = tid_() >> 6;
    const u16* P = (const u16*)(p.ws + WS_P);
    u16* YIN = (u16*)(p.ws + WS_YIN);
    const int hq = (it & 1) * 8 + w, t16 = (it >> 1) & 255, b = it >> 9;
    const int kvh = hq >> 2, t0 = t16 * 16;
    const int ks = (t0 - 128) & ~31;
    const int qrow = b * SEQ + t0;
    u16* vlds = (u16*)lds + w * (32 * 72);
    auto keyfn = [&](int ib, const u16*& kp, const u16*& vp, size_t& kvs) -> bool {
        int row;
        if (ib < 9) { const int k0 = ks + ib * 32; if (k0 < 0 || k0 >= SEQ) return false; row = b * SEQ + k0; }
        else row = NLAT + b * LC + (ib - 9) * 32;
        kp = P + (size_t)row * CD_IN + 1024 + kvh * 64; vp = P + (size_t)row * CD_IN + 1280 + kvh * 64; kvs = CD_IN; return true; };
    auto biasfn = [&](int ib, int qi, int ki) -> float {
        if (ib >= 9) return 0.f;
        const int dq = (t0 + qi) - (ks + ib * 32 + ki);
        return (dq > 128 || dq < -128) ? -INFINITY : 0.f; };
    const float sink = p.gqa_sink[hq];
    attn_wave<64>(P + (size_t)qrow * CD_IN + hq * 64, CD_IN, 17, keyfn, biasfn, 0.125f, sink, ((tid_() & 63) >> 4) == 0 ? 1.f : 0.f, vlds,
                  YIN + (size_t)qrow * D + hq * 64, D);
}

__device__ void phase_l1_stage1(const Params& p, unsigned char* lds) {
    for (int item = bid_(); item < 2176 + 2048; item += gdim_()) {
        if (item < 2176) { const int ci = item % 68, blk = (item / 68) & 7, b = item / (68 * 8); lru_chunk(p, b, blk, ci, 0, lds); }
        else rope_rows(p, (item - 2176) * 8, 8);
    }
}
__device__ void phase_l1_stage2(const Params& p, unsigned char* lds) {
    for (int item = bid_(); item < 16 + 2048; item += gdim_()) {
        if (item < 16) lru_carry(p, item);
        else gqa_item(p, item - 16, lds);
    }
}
__device__ void phase_l1_stage3(const Params& p, unsigned char* lds) {
    for (int item = bid_(); item < 2048; item += gdim_()) { const int cl = item & 63, blk = (item >> 6) & 7, b = item >> 9; lru_chunk(p, b, blk, cl + 4, 1, lds); }
}

__device__ void phase_rowpass_mid(const Params& p, int l, unsigned char* lds) {
    float* R = (float*)lds;
    const int t = tid_(), lane = t & 63, w = t >> 6;
    const int nrows = l == 0 ? NTOK : NLAT;
    __syncthreads();
    for (int i = t; i < D * NEXP; i += NT) { const int k = i >> 4, e = i & 15; R[e * D + k] = p.moe_router[(size_t)l * D * NEXP + i]; }
    __syncthreads();
    const float* Y = (const float*)(p.ws + WS_Y);
    float* XL1 = (float*)(p.ws + WS_XL1);
    u16* H = (u16*)(p.ws + WS_H);
    float* AFF = (float*)(p.ws + WS_AFF);
    for (int row = bid_() * 8 + w; row < nrows; row += gdim_() * 8) {
        f32x4 v[8]; float ss = 0.f;
#pragma unroll
        for (int i = 0; i < 8; ++i) { v[i] = *reinterpret_cast<const f32x4*>(Y + (size_t)row * D + (i * 64 + lane) * 4); ss += v[i][0] * v[i][0] + v[i][1] * v[i][1] + v[i][2] * v[i][2] + v[i][3] * v[i][3]; }
        ss = wave_sum(ss);
        const float rstd = rsqrtf(ss * (1.f / D) + 1e-6f);
        const float* xr = xin_row(p, l, row);
        const float* g1 = mod_ptr(p, l, row, 2);
        const float* nw = p.norm_mix_post + (size_t)l * D;
        float ss1 = 0.f;
#pragma unroll
        for (int i = 0; i < 8; ++i) {
            const int col = (i * 64 + lane) * 4;
            const f32x4 x4 = *reinterpret_cast<const f32x4*>(xr + col), w4 = *reinterpret_cast<const f32x4*>(nw + col), g4 = *reinterpret_cast<const f32x4*>(g1 + col);
            const f32x4 x1 = x4 + g4 * (v[i] * rstd * w4);
            *reinterpret_cast<f32x4*>(XL1 + (size_t)row * D + col) = x1;
            v[i] = x1; ss1 += x1[0] * x1[0] + x1[1] * x1[1] + x1[2] * x1[2] + x1[3] * x1[3];
        }
        ss1 = wave_sum(ss1);
        const float rstd1 = rsqrtf(ss1 * (1.f / D) + 1e-6f);
        const float* sh = mod_ptr(p, l, row, 3); const float* sc = mod_ptr(p, l, row, 4);
        const float* nw2 = p.norm_ffn_pre + (size_t)l * D;
#pragma unroll
        for (int i = 0; i < 8; ++i) {
            const int col = (i * 64 + lane) * 4;
            const f32x4 w4 = *reinterpret_cast<const f32x4*>(nw2 + col), s4 = *reinterpret_cast<const f32x4*>(sc + col), h4 = *reinterpret_cast<const f32x4*>(sh + col);
            const f32x4 o = v[i] * rstd1 * w4 * (s4 + 1.f) + h4;
            u32x2 pk = {pk_bf16(o[0], o[1]), pk_bf16(o[2], o[3])};
            *reinterpret_cast<u32x2*>(H + (size_t)row * D + col) = pk;
            v[i] = o;
        }
        float mine = 0.f;
#pragma unroll 2
        for (int e = 0; e < 16; ++e) {
            float sdot = 0.f;
#pragma unroll
            for (int i = 0; i < 8; ++i) { const f32x4 r4 = *reinterpret_cast<const f32x4*>(R + e * D + (i * 64 + lane) * 4); sdot += v[i][0] * r4[0] + v[i][1] * r4[1] + v[i][2] * r4[2] + v[i][3] * r4[3]; }
            sdot = wave_sum(sdot);
            if (lane == e) mine = sdot;
        }
        float mx = mine;
#pragma unroll
        for (int o = 8; o > 0; o >>= 1) mx = fmaxf(mx, __shfl_xor(mx, o, 64));
        const float pe = __expf(mine - mx);
        float den = pe;
#pragma unroll
        for (int o = 8; o > 0; o >>= 1) den += __shfl_xor(den, o, 64);
        if (lane < 16) AFF[(size_t)row * 16 + lane] = pe / den;
    }
}

__device__ void phase_topk(const Params& p, int l, unsigned char* lds) {
    unsigned* keys = (unsigned*)lds;
    unsigned* hist = keys + 4096;
    unsigned* misc = hist + 256;
    const int t = tid_(), lane = t & 63, w = t >> 6;
    const float* AFF = (const float*)(p.ws + WS_AFF);
    int* SLOT = (int*)(p.ws + WS_SLOT);
    int* EROW = (int*)(p.ws + WS_EROW);
    float* EGATE = (float*)(p.ws + WS_EGATE);
    const int nitems = l == 0 ? 128 : 64;
    for (int item = bid_(); item < nitems; item += gdim_()) {
        const int kind = item >> 6, b = (item >> 4) & 3, ex = item & 15;
        const int n = kind ? LC : SEQ, cap = n / 8, rowbase = kind ? NLAT + b * LC : b * SEQ;
        __syncthreads();
        for (int i = t; i < n; i += NT) keys[i] = __float_as_uint(AFF[(size_t)(rowbase + i) * 16 + ex]);
        unsigned prefix = 0u, mask = 0u; int kth = cap;
        for (int shift = 24; shift >= 0; shift -= 8) {
            __syncthreads();
            if (t < 256) hist[t] = 0u;
            __syncthreads();
            for (int i = t; i < n; i += NT) { const unsigned k = keys[i]; if ((k & mask) == prefix) atomicAdd(&hist[(k >> shift) & 255u], 1u); }
            __syncthreads();
            if (t < 256) {
                unsigned above = 0u;
                for (int d2 = t + 1; d2 < 256; ++d2) above += hist[d2];
                const unsigned here = hist[t];
                if ((int)above < kth && (int)(above + here) >= kth) { misc[0] = (unsigned)t; misc[1] = (unsigned)(kth - (int)above); }
            }
            __syncthreads();
            prefix |= misc[0] << shift; mask |= 255u << shift; kth = (int)misc[1];
        }
        const unsigned T = prefix; const int need_eq = kth;
        int cgt = 0, ceq = 0;
        const int base = t * 8;
        if (base < n) {
#pragma unroll
            for (int q = 0; q < 8; ++q) { const unsigned k = keys[base + q]; cgt += (k > T); ceq += (k == T); }
        }
        int packed = cgt | (ceq << 16);
        int incl = packed;
#pragma unroll
        for (int o = 1; o < 64; o <<= 1) { const int nb = __shfl_up(incl, o, 64); if (lane >= o) incl += nb; }
        __syncthreads();
        if (lane == 63) misc[8 + w] = (unsigned)incl;
        __syncthreads();
        int woff = 0, total = 0;
#pragma unroll
        for (int q = 0; q < 8; ++q) { const int v = (int)misc[8 + q]; if (q < w) woff += v; total += v; }
        const int excl = woff + incl - packed;
        int pgt = excl & 0xffff, peq = excl >> 16;
        const int tot_gt = total & 0xffff;
        const int sbase = kind ? 2048 + b * 32 : b * 512;
        if (base < n) {
#pragma unroll
            for (int q = 0; q < 8; ++q) {
                const unsigned k = keys[base + q];
                const int row = rowbase + base + q;
                int pos = -1;
                if (k > T) { pos = pgt; ++pgt; }
                else if (k == T) { if (peq < need_eq) pos = tot_gt + peq; ++peq; }
                if (pos >= 0) { const int sl = sbase + pos; EROW[ex * EPAD + sl] = row; EGATE[ex * EPAD + sl] = __uint_as_float(k); SLOT[(size_t)row * 16 + ex] = sl; }
                else SLOT[(size_t)row * 16 + ex] = -1;
            }
        }
    }
}

__device__ void phase_final(const Params& p, int l) {
    const int lane = tid_() & 63, w = tid_() >> 6;
    const int nrows = l == 0 ? NTOK : NLAT;
    const u16* YEXP = (const u16*)(p.ws + WS_YEXP);
    const int* SLOT = (const int*)(p.ws + WS_SLOT);
    const float* XL1 = (const float*)(p.ws + WS_XL1);
    float* XL2 = (float*)(p.ws + WS_XL2);
    u16* H = (u16*)(p.ws + WS_H);
    for (int row = bid_() * 8 + w; row < nrows; row += gdim_() * 8) {
        f32x4 v[8];
#pragma unroll
        for (int i = 0; i < 8; ++i) v[i] = (f32x4){0.f, 0.f, 0.f, 0.f};
        for (int e = 0; e < NEXP; ++e) {
            const int sl = SLOT[(size_t)row * 16 + e];
            if (sl >= 0) {
                const u16* yp = YEXP + ((size_t)e * EPAD + sl) * D;
#pragma unroll
                for (int i = 0; i < 8; ++i) { const u32x2 q = *reinterpret_cast<const u32x2*>(yp + (i * 64 + lane) * 4); v[i][0] += bf_lo(q[0]); v[i][1] += bf_hi(q[0]); v[i][2] += bf_lo(q[1]); v[i][3] += bf_hi(q[1]); }
            }
        }
        float ss = 0.f;
#pragma unroll
        for (int i = 0; i < 8; ++i) ss += v[i][0] * v[i][0] + v[i][1] * v[i][1] + v[i][2] * v[i][2] + v[i][3] * v[i][3];
        ss = wave_sum(ss);
        const float rstd = rsqrtf(ss * (1.f / D) + 1e-6f);
        const float* g2 = mod_ptr(p, l, row, 5);
        const float* nw = p.norm_ffn_post + (size_t)l * D;
        float* dst = l == 0 ? XL2 + (size_t)row * D : p.out + (size_t)row * D;
        float ss2 = 0.f;
#pragma unroll
        for (int i = 0; i < 8; ++i) {
            const int col = (i * 64 + lane) * 4;
            const f32x4 x4 = *reinterpret_cast<const f32x4*>(XL1 + (size_t)row * D + col), w4 = *reinterpret_cast<const f32x4*>(nw + col), g4 = *reinterpret_cast<const f32x4*>(g2 + col);
            const f32x4 x2 = x4 + g4 * (v[i] * rstd * w4);
            *reinterpret_cast<f32x4*>(dst + col) = x2;
            v[i] = x2; ss2 += x2[0] * x2[0] + x2[1] * x2[1] + x2[2] * x2[2] + x2[3] * x2[3];
        }
        if (l == 0) {
            ss2 = wave_sum(ss2);
            const float rstd2 = rsqrtf(ss2 * (1.f / D) + 1e-6f);
            const float* sh = mod_ptr(p, 1, row, 0); const float* sc = mod_ptr(p, 1, row, 1);
            const float* nw1 = p.norm_mix_pre + D;
#pragma unroll
            for (int i = 0; i < 8; ++i) {
                const int col = (i * 64 + lane) * 4;
                const f32x4 w4 = *reinterpret_cast<const f32x4*>(nw1 + col), s4 = *reinterpret_cast<const f32x4*>(sc + col), h4 = *reinterpret_cast<const f32x4*>(sh + col);
                const f32x4 o = v[i] * rstd2 * w4 * (s4 + 1.f) + h4;
                u32x2 pk = {pk_bf16(o[0], o[1]), pk_bf16(o[2], o[3])};
                *reinterpret_cast<u32x2*>(H + (size_t)row * D + col) = pk;
            }
        }
    }
}

__global__ void __launch_bounds__(NT, 2) fwd_kernel(Params p) {
    extern __shared__ __attribute__((aligned(16))) unsigned char lds[];
    unsigned char* wlds = lds + 16;
    if (threadIdx.x == 0) *reinterpret_cast<uint4*>(lds) = make_uint4(0u, 0u, 0u, 0u);
    __syncthreads();
    XcdBarrier bar = xcd_barrier_post((unsigned*)(p.ws + WS_BAR), (volatile LAS unsigned*)lds);
#ifndef PH_MASK
#define PH_MASK 0xFFFFFFFFu
#endif
#ifndef PROBE_REP_MASK
#define PROBE_REP_MASK 0u
#endif
#define PHASE(id, body) do { if (((PH_MASK >> ((id) % 32)) & 1u) && p.ph_lo <= (id) && (id) < p.ph_hi) { \
    for (int _r = 0; _r < ((((unsigned)PROBE_REP_MASK >> ((id) % 32)) & 1u) ? 2 : 1); ++_r) { body; if ((id) + 1 < p.ph_hi || _r == 0) { if ((id) + 1 < p.ph_hi) xcd_barrier(bar); } } } } while (0)
    PHASE(0, phase_mod(p, wlds));
    PHASE(1, { phase_norm_mod(p, 0); lru_prep_weights(p); });
#pragma unroll
    for (int l = 0; l < 2; ++l) {
        const int pb = 2 + 10 * l;
        {
            EpiDesc e; e.ob = (u16*)(p.ws + WS_P); e.of = nullptr; e.ldo = l == 0 ? AB_IN : CD_IN; e.gates = l == 0 ? (float*)(p.ws + WS_G) : nullptr; e.rscale = nullptr;
            PHASE(pb + 0, phase_gemm_dense<EPI_BF16>(p, (const u16*)(p.ws + WS_H), NTOK, l == 0 ? p.ab_w_in : p.cd_w_in, l == 0 ? AB_IN : CD_IN, e, wlds));
        }
        if (l == 0) {
            PHASE(pb + 1, phase_mlstm(p, wlds));
            PHASE(pb + 2, phase_l0_stage2(p, wlds));
        } else {
            PHASE(pb + 1, phase_l1_stage1(p, wlds));
            PHASE(pb + 2, phase_l1_stage2(p, wlds));
            PHASE(pb + 3, phase_l1_stage3(p, wlds));
        }
        {
            EpiDesc e; e.ob = nullptr; e.of = (float*)(p.ws + WS_Y); e.ldo = D; e.gates = nullptr; e.rscale = nullptr;
            PHASE(pb + 4, phase_gemm_dense<EPI_F32>(p, (const u16*)(p.ws + WS_YIN), l == 0 ? NTOK : NLAT, l == 0 ? p.ab_w_out : p.cd_w_out, D, e, wlds));
        }
        PHASE(pb + 5, phase_rowpass_mid(p, l, wlds));
        PHASE(pb + 6, phase_topk(p, l, wlds));
        PHASE(pb + 7, phase_moe_a(p, l, wlds));
        PHASE(pb + 8, phase_moe_b(p, l, wlds));
        PHASE(pb + 9, phase_final(p, l));
    }
}


#ifdef DBG_STOP
__global__ void dbg_digest(const unsigned char* ws, size_t off, int kind, size_t nelem, float* out, size_t nout) {
    for (size_t i = (size_t)blockIdx.x * blockDim.x + threadIdx.x; i < nout; i += (size_t)gridDim.x * blockDim.x) {
        float v = 0.f;
        for (size_t j = i; j < nelem; j += nout) {
            if (kind == 0) v += bf2f(((const u16*)(ws + off))[j]);
            else if (kind == 1) v += ((const float*)(ws + off))[j];
            else v += (float)((const int*)(ws + off))[j];
        }
        out[i] = v;
    }
}
#endif
extern "C" void kernel_launch(void* const* d_in, const int* in_sizes, int n_in, void* d_out, int out_size, void* d_ws, size_t ws_size, hipStream_t stream) {
    static int grid = 0;
    if (grid == 0) {
        if (n_in != 27 || ws_size < WS_END) { fprintf(stderr, "kernel_launch: unexpected n_in %d / ws %zu (need %zu)\n", n_in, ws_size, (size_t)WS_END); grid = -1; return; }
        int dev = 0, cus = 0, per_cu = 0;
        hipGetDevice(&dev);
        hipDeviceGetAttribute(&cus, hipDeviceAttributeMultiprocessorCount, dev);
        if (hipFuncSetAttribute((const void*)fwd_kernel, hipFuncAttributeMaxDynamicSharedMemorySize, LDS_BYTES) != hipSuccess) { fprintf(stderr, "kernel_launch: hipFuncSetAttribute failed\n"); grid = -1; return; }
        hipOccupancyMaxActiveBlocksPerMultiprocessor(&per_cu, (const void*)fwd_kernel, NT, LDS_BYTES);
        (void)hipGetLastError();
        if (per_cu < 1) fprintf(stderr, "kernel_launch: occupancy query reports %d blocks per CU\n", per_cu);
        grid = cus > 0 ? cus : 256;
    }
    if (grid < 0) return;
    hipMemsetAsync((char*)d_ws + WS_BAR, 0, XCD_BAR_WORDS * sizeof(unsigned), stream);
    Params p; memset(&p, 0, sizeof(p));
    const float** f = (const float**)&p;
    for (int i = 0; i < 27; ++i) f[i] = (const float*)d_in[i];
    p.out = (float*)d_out; p.ws = (unsigned char*)d_ws;
#if N_LAUNCH_MODE == 1
    p.ph_lo = 0; p.ph_hi = NPH;
    hipLaunchKernelGGL(fwd_kernel, dim3(grid), dim3(NT), LDS_BYTES, stream, p);
#else
#ifdef DBG_STOP
    for (int ph = 0; ph <= DBG_STOP; ++ph) { p.ph_lo = ph; p.ph_hi = ph + 1; hipLaunchKernelGGL(fwd_kernel, dim3(grid), dim3(NT), LDS_BYTES, stream, p); }
    hipLaunchKernelGGL(dbg_digest, dim3(2048), dim3(256), 0, stream, (const unsigned char*)d_ws, (size_t)DBG_OFF, (int)DBG_KIND, (size_t)DBG_NELEM, (float*)d_out, (size_t)out_size);
#else
    for (int ph = 0; ph < NPH; ++ph) { p.ph_lo = ph; p.ph_hi = ph + 1; hipLaunchKernelGGL(fwd_kernel, dim3(grid), dim3(NT), LDS_BYTES, stream, p); }
#endif
#endif
}
```

```cpp
#include <hip/hip_runtime.h>
#include <stdint.h>
#include <stdio.h>
#include <string.h>

#ifndef N_LAUNCH_MODE
#define N_LAUNCH_MODE 1
#endif

typedef unsigned short u16;
typedef short bf16x8 __attribute__((ext_vector_type(8)));
typedef float f32x4 __attribute__((ext_vector_type(4)));
typedef unsigned u32x4 __attribute__((ext_vector_type(4)));
typedef unsigned u32x2 __attribute__((ext_vector_type(2)));

#define NT 512
constexpr int D = 2048, BATCH = 4, SEQ = 4096, LC = 256;
constexpr int NLAT = BATCH * SEQ, NCTX = BATCH * LC, NTOK = NLAT + NCTX;
constexpr int AB_IN = 7184, CD_IN = 3584;
constexpr int NEXP = 16, FF = 2048, EPAD = 2304;
constexpr int NPH = 22;
constexpr int LDS_BYTES = 150 * 1024;

constexpr size_t al256(size_t x) { return (x + 255) & ~(size_t)255; }
constexpr size_t WS_BAR = 0;
constexpr size_t WS_MOD = 16384;
constexpr size_t WS_XL1 = al256(WS_MOD + 2 * 5 * 12288 * 4);
constexpr size_t WS_XL2 = al256(WS_XL1 + (size_t)NTOK * D * 4);
constexpr size_t WS_H = al256(WS_XL2 + (size_t)NTOK * D * 4);
constexpr size_t WS_P = al256(WS_H + (size_t)NTOK * D * 2);
constexpr size_t WS_G = al256(WS_P + (size_t)NTOK * AB_IN * 2);
constexpr size_t WS_HM = al256(WS_G + (size_t)NTOK * 16 * 4);
constexpr size_t WS_YIN = al256(WS_HM + (size_t)2 * NTOK * 1024 * 2);
constexpr size_t WS_Y = al256(WS_YIN + (size_t)NTOK * D * 2);
constexpr size_t WS_AFF = al256(WS_Y + (size_t)NTOK * D * 4);
constexpr size_t WS_SLOT = al256(WS_AFF + (size_t)NTOK * 16 * 4);
constexpr size_t WS_EROW = al256(WS_SLOT + (size_t)NTOK * 16 * 4);
constexpr size_t WS_EGATE = al256(WS_EROW + (size_t)NEXP * EPAD * 4);
constexpr size_t WS_ACT = al256(WS_EGATE + (size_t)NEXP * EPAD * 4);
constexpr size_t WS_YEXP = al256(WS_ACT + (size_t)NEXP * EPAD * FF * 2);
constexpr size_t WS_LRUS = al256(WS_YEXP + (size_t)NEXP * EPAD * D * 2);
constexpr size_t WS_LRUW = al256(WS_LRUS + (size_t)2 * 2 * 4 * 68 * 1024 * 4);
constexpr size_t WS_WT_ABIN = al256(WS_LRUW + (size_t)32 * 128 * 128 * 2);
constexpr size_t WS_WT_ABOUT = al256(WS_WT_ABIN + (size_t)AB_IN * D * 2);
constexpr size_t WS_WT_CDIN = al256(WS_WT_ABOUT + (size_t)D * D * 2);
constexpr size_t WS_WT_CDOUT = al256(WS_WT_CDIN + (size_t)CD_IN * D * 2);
constexpr size_t WS_WT_W1 = al256(WS_WT_CDOUT + (size_t)D * D * 2);
constexpr size_t WS_WT_W3 = al256(WS_WT_W1 + (size_t)NEXP * D * FF * 2);
constexpr size_t WS_WT_W2 = al256(WS_WT_W3 + (size_t)NEXP * D * FF * 2);
constexpr size_t WS_END = al256(WS_WT_W2 + (size_t)NEXP * D * FF * 2);

struct Params {
    const float *x, *c, *ctx, *c_ctx, *ada_w, *ada_b, *norm_mix_pre, *norm_mix_post, *norm_ffn_pre, *norm_ffn_post;
    const float *ab_w_in, *ab_w_out, *mlstm_gate_b, *mlstm_norm, *na_rpb;
    const float *cd_w_in, *cd_w_out, *gqa_sink, *lru_conv_w, *lru_conv_b, *lru_gate_w, *lru_gate_b, *lru_lambda;
    const float *moe_router, *moe_w1, *moe_w3, *moe_w2;
    float* out;
    unsigned char* ws;
    int ph_lo, ph_hi;
};

#define XB_TMO      128
#define XB_XCNT(j)  (256  + 64 * (j))
#define XB_XSUB(j)  (1280 + 64 * (j))
#define XB_XGEN(j)  (2304 + 64 * (j))
#define XB_TOP      3328
#define XB_TOPGEN   3392
#define XCD_BAR_WORDS 3456
#define XB_SPIN_CAP (1u << 22)
#define LAS __attribute__((address_space(3)))

__device__ __forceinline__ unsigned xb_ld(unsigned* p)              { return __hip_atomic_load(p, __ATOMIC_RELAXED, __HIP_MEMORY_SCOPE_AGENT); }
__device__ __forceinline__ unsigned xb_add(unsigned* p, unsigned v) { return __hip_atomic_fetch_add(p, v, __ATOMIC_RELAXED, __HIP_MEMORY_SCOPE_AGENT); }
__device__ __forceinline__ unsigned xb_xcc_id() { return (unsigned)__builtin_amdgcn_s_getreg((3 << 11) | 20) & 0xFu; }
#define XB_SPIN(cond, bar) do { unsigned _sp = 0; while (cond) { __builtin_amdgcn_s_sleep(1); \
    if ((++_sp & 255u) == 0u) { if (xb_ld(&(bar)[XB_TMO])) break; if (_sp > XB_SPIN_CAP) { atomicAdd(&(bar)[XB_TMO], 1u); break; } } } } while (0)

struct XcdBarrier {
    unsigned* bar; unsigned x;
    volatile LAS unsigned* st;
};
__device__ __forceinline__ XcdBarrier xcd_barrier_post(unsigned* bar, volatile LAS unsigned* st) {
    XcdBarrier b; b.bar = bar; b.x = xb_xcc_id(); b.st = st;
    if (threadIdx.x == 0) (void)xb_add(&bar[XB_XCNT(b.x)], 1u);
    return b;
}
__device__ __forceinline__ void xcd_barrier_complete(unsigned* bar, unsigned x, unsigned& nloc, unsigned& nx) {
    const unsigned G = gridDim.x * gridDim.y * gridDim.z;
    unsigned sum, cnt, mine, sp = 0u;
    for (;;) {
        sum = 0u; cnt = 0u; mine = 0u;
#pragma unroll
        for (unsigned j = 0; j < 16; ++j) { const unsigned c = xb_ld(&bar[XB_XCNT(j)]); sum += c; cnt += (c > 0u) ? 1u : 0u; mine = (j == x) ? c : mine; }
        if (sum == G) break;
        __builtin_amdgcn_s_sleep(1);
        if ((++sp & 255u) == 0u) { if (xb_ld(&bar[XB_TMO])) break; if (sp > XB_SPIN_CAP) { atomicAdd(&bar[XB_TMO], 1u); break; } }
    }
    nloc = mine > 0u ? mine : 1u; nx = cnt > 0u ? cnt : 1u;
}
__device__ __forceinline__ void xcd_barrier(const XcdBarrier& b) {
    asm volatile("s_waitcnt vmcnt(0)" ::: "memory");
    __syncthreads();
    if (threadIdx.x == 0) {
        unsigned* bar = b.bar;
        __builtin_amdgcn_s_waitcnt(0);
        unsigned nloc = b.st[0], nx = b.st[1];
        if (nloc == 0u) { xcd_barrier_complete(bar, b.x, nloc, nx); b.st[0] = nloc; b.st[1] = nx; }
        const unsigned old = xb_add(&bar[XB_XSUB(b.x)], 1u);
        const unsigned gen = old / nloc;
        if (old + 1u == (gen + 1u) * nloc) {
            __builtin_amdgcn_fence(__ATOMIC_RELEASE, "agent");
            asm volatile("s_waitcnt vmcnt(0)" ::: "memory");
            const unsigned og = xb_add(&bar[XB_TOP], 1u);
            const unsigned tg = og / nx;
            if (og + 1u == (tg + 1u) * nx) xb_add(&bar[XB_TOPGEN], 1u);
            else XB_SPIN(xb_ld(&bar[XB_TOPGEN]) == tg, bar);
            __builtin_amdgcn_fence(__ATOMIC_ACQUIRE, "agent");
            xb_add(&bar[XB_XGEN(b.x)], 1u);
            asm volatile("s_waitcnt vmcnt(0)" ::: "memory");
        } else {
            XB_SPIN(xb_ld(&bar[XB_XGEN(b.x)]) == gen, bar);
            __builtin_amdgcn_fence(__ATOMIC_ACQUIRE, "agent");
            asm volatile("s_waitcnt vmcnt(0)" ::: "memory");
        }
    }
    __syncthreads();
}

typedef float f32x2_t __attribute__((ext_vector_type(2)));
typedef __bf16 bf16x2_t __attribute__((ext_vector_type(2)));
__device__ __forceinline__ unsigned pk_bf16(float lo, float hi) { f32x2_t v = {lo, hi}; return __builtin_bit_cast(unsigned, __builtin_convertvector(v, bf16x2_t)); }
__device__ __forceinline__ float bf_lo(unsigned u) { return __uint_as_float(u << 16); }
__device__ __forceinline__ float bf_hi(unsigned u) { return __uint_as_float(u & 0xffff0000u); }
__device__ __forceinline__ float bf2f(u16 v) { return __uint_as_float(((unsigned)v) << 16); }
__device__ __forceinline__ u16 f2bf(float f) { return (u16)(pk_bf16(f, 0.f) & 0xffffu); }
__device__ __forceinline__ float wave_sum(float v) {
#pragma unroll
    for (int o = 32; o > 0; o >>= 1) v += __shfl_xor(v, o, 64);
    return v;
}
__device__ __forceinline__ int tid_() { int t = threadIdx.x; asm volatile("" : "+v"(t)); return t; }
__device__ __forceinline__ int bid_() { int b = blockIdx.x; asm volatile("" : "+s"(b)); return b; }
__device__ __forceinline__ int gdim_() { int b = gridDim.x; asm volatile("" : "+s"(b)); return b; }
__device__ __forceinline__ float sigmoidf_(float x) { return 1.f / (1.f + __expf(-x)); }
__device__ __forceinline__ f32x4 mfma16(bf16x8 a, bf16x8 b, f32x4 c) { return __builtin_amdgcn_mfma_f32_16x16x32_bf16(a, b, c, 0, 0, 0); }
__device__ __forceinline__ bf16x8 ld_frag_g(const u16* p) { return *reinterpret_cast<const bf16x8*>(p); }
__device__ __forceinline__ bf16x8 ld_frag_s(const u16* p) { return *reinterpret_cast<const bf16x8*>(p); }
__device__ __forceinline__ bf16x8 mk_frag(unsigned a, unsigned b, unsigned c, unsigned d) { u32x4 v = {a, b, c, d}; return __builtin_bit_cast(bf16x8, v); }

__device__ __forceinline__ const float* xin_row(const Params& p, int l, int row) {
    if (l == 0) return row < NLAT ? p.x + (size_t)row * D : p.ctx + (size_t)(row - NLAT) * D;
    return (const float*)(p.ws + WS_XL2) + (size_t)row * D;
}
__device__ __forceinline__ const float* mod_ptr(const Params& p, int l, int row, int chunk) {
    const int bb = row < NLAT ? (row >> 12) : 4;
    return (const float*)(p.ws + WS_MOD) + ((size_t)(l * 5 + bb) * 6 + chunk) * D;
}

__device__ void phase_mod(const Params& p, unsigned char* lds_raw) {
    float* scond = (float*)lds_raw;
    float* red = scond + 5 * D;
    const int t = tid_();
    for (int i = t; i < 5 * D; i += NT) { const int r = i >> 11, k = i & 2047; const float v = r < 4 ? p.c[r * D + k] : p.c_ctx[k]; scond[i] = v / (1.f + __expf(-v)); }
    __syncthreads();
    float* mod = (float*)(p.ws + WS_MOD);
    for (int item = bid_(); item < 192; item += gdim_()) {
        const int l = item / 96, col0 = (item % 96) * 128;
        const int kg = t >> 5, cl = (t & 31) * 4;
        f32x4 acc[5];
#pragma unroll
        for (int r = 0; r < 5; ++r) acc[r] = (f32x4){0.f, 0.f, 0.f, 0.f};
        const float* wp = p.ada_w + ((size_t)l * D + kg * 128) * (6 * D) + col0 + cl;
#pragma unroll 8
        for (int kk = 0; kk < 128; ++kk) {
            const f32x4 w = *reinterpret_cast<const f32x4*>(wp + (size_t)kk * (6 * D));
#pragma unroll
            for (int r = 0; r < 5; ++r) { const float s = scond[r * D + kg * 128 + kk]; acc[r] += w * s; }
        }
#pragma unroll
        for (int r = 0; r < 5; ++r) *reinterpret_cast<f32x4*>(red + (kg * 5 + r) * 128 + cl) = acc[r];
        __syncthreads();
        for (int o = t; o < 640; o += NT) {
            const int r = o >> 7, cc = o & 127;
            float s = p.ada_b[l * 6 * D + col0 + cc];
#pragma unroll
            for (int g = 0; g < 16; ++g) s += red[(g * 5 + r) * 128 + cc];
            mod[(size_t)(l * 5 + r) * 6 * D + col0 + cc] = s;
        }
        __syncthreads();
    }
}

__device__ void phase_norm_mod(const Params& p, int l) {
    const int lane = tid_() & 63, w = tid_() >> 6;
    u16* H = (u16*)(p.ws + WS_H);
    for (int row = bid_() * 8 + w; row < NTOK; row += gdim_() * 8) {
        const float* xr = xin_row(p, l, row);
        f32x4 v[8]; float ss = 0.f;
#pragma unroll
        for (int i = 0; i < 8; ++i) { v[i] = *reinterpret_cast<const f32x4*>(xr + (i * 64 + lane) * 4); ss += v[i][0] * v[i][0] + v[i][1] * v[i][1] + v[i][2] * v[i][2] + v[i][3] * v[i][3]; }
        ss = wave_sum(ss);
        const float rstd = rsqrtf(ss * (1.f / D) + 1e-6f);
        const float* sh = mod_ptr(p, l, row, 0); const float* sc = mod_ptr(p, l, row, 1);
        const float* nw = p.norm_mix_pre + (size_t)l * D;
#pragma unroll
        for (int i = 0; i < 8; ++i) {
            const int col = (i * 64 + lane) * 4;
            const f32x4 w4 = *reinterpret_cast<const f32x4*>(nw + col), s4 = *reinterpret_cast<const f32x4*>(sc + col), h4 = *reinterpret_cast<const f32x4*>(sh + col);
            f32x4 o = v[i] * rstd * w4 * (s4 + 1.f) + h4;
            u32x2 pk = {pk_bf16(o[0], o[1]), pk_bf16(o[2], o[3])};
            *reinterpret_cast<u32x2*>(H + (size_t)row * D + col) = pk;
        }
    }
}

__device__ __forceinline__ void convert_item(const float* W, int N, u16* Wt, int kb, int nb, unsigned char* lds) {
    const int t = tid_(), lane = t & 63, w = t >> 6;
    const int n4 = lane * 4, k0 = kb * 64 + w * 8, n0 = nb * 256;
    int col = n0 + n4; if (col > N - 4) col = N - 4;
    f32x4 r8[8];
#pragma unroll
    for (int j = 0; j < 8; ++j) r8[j] = *reinterpret_cast<const f32x4*>(W + (size_t)(k0 + j) * N + col);
    __syncthreads();
#pragma unroll
    for (int jj = 0; jj < 4; ++jj) {
        u32x4 v = {pk_bf16(r8[0][jj], r8[1][jj]), pk_bf16(r8[2][jj], r8[3][jj]), pk_bf16(r8[4][jj], r8[5][jj]), pk_bf16(r8[6][jj], r8[7][jj])};
        const int r = n4 + jj;
        *reinterpret_cast<u32x4*>(lds + r * 128 + ((w ^ ((r >> 2) & 7)) << 4)) = v;
    }
    __syncthreads();
    const int c = t & 7;
#pragma unroll
    for (int i = 0; i < 4; ++i) {
        const int r = (t >> 3) + 64 * i;
        if (n0 + r < N) {
            const u32x4 v = *reinterpret_cast<const u32x4*>(lds + r * 128 + ((c ^ ((r >> 2) & 7)) << 4));
            *reinterpret_cast<u32x4*>(Wt + (size_t)(n0 + r) * 2048 + kb * 64 + c * 8) = v;
        }
    }
}
__device__ void convert_matrix_items(const float* W, int N, u16* Wt, int first, int count, unsigned char* lds) {
    const int nnb = (N + 255) / 256;
    for (int it = first; it < first + count; ++it) convert_item(W, N, Wt, it / nnb, it % nnb, lds);
}
__device__ void phase_convert_dense(const Params& p, unsigned char* lds) {
    for (int item = bid_(); item < 1888; item += gdim_()) {
        if (item < 928) convert_item(p.ab_w_in, AB_IN, (u16*)(p.ws + WS_WT_ABIN), item / 29, item % 29, lds);
        else if (item < 1184) { const int it = item - 928; convert_item(p.ab_w_out, D, (u16*)(p.ws + WS_WT_ABOUT), it / 8, it % 8, lds); }
        else if (item < 1632) { const int it = item - 1184; convert_item(p.cd_w_in, CD_IN, (u16*)(p.ws + WS_WT_CDIN), it / 14, it % 14, lds); }
        else { const int it = item - 1632; convert_item(p.cd_w_out, D, (u16*)(p.ws + WS_WT_CDOUT), it / 8, it % 8, lds); }
    }
}
__device__ void phase_convert_moe(const Params& p, int l, unsigned char* lds) {
    for (int item = bid_(); item < 3 * NEXP * 256; item += gdim_()) {
        const int which = item / (NEXP * 256), r = item % (NEXP * 256), ex = r >> 8, it = r & 255;
        const float* src = (which == 0 ? p.moe_w1 : (which == 1 ? p.moe_w3 : p.moe_w2)) + (size_t)(l * NEXP + ex) * D * FF;
        u16* dst = (u16*)(p.ws + (which == 0 ? WS_WT_W1 : (which == 1 ? WS_WT_W3 : WS_WT_W2))) + (size_t)ex * D * FF;
        convert_item(src, 2048, dst, it >> 3, it & 7, lds);
    }
}

struct GemmDesc {
    const u16* A; int lda; const int* arow; int mvalid; int m0;
    const u16* B0; const u16* B1; int n0; int ncols;
    int K;
};
enum { EPI_BF16 = 0, EPI_F32 = 1, EPI_SWIGLU = 2, EPI_SCALE = 3 };
struct EpiDesc { u16* ob; float* of; int ldo; float* gates; const float* rscale; };
constexpr int GEMM_BUF = 65536, GEMM_BOFF = 32768;

template <int EPI>
__device__ __forceinline__ void gemm_tile(const GemmDesc& g, const EpiDesc& e, unsigned char* lds) {
    const int t = tid_(), lane = t & 63, w = t >> 6;
    const int wr = w >> 2, wc = w & 3, fr = lane & 15, fq = lane >> 4;
    const int ac = t & 7, ar = t >> 3;
    const int kofs = (ac ^ ((ar >> 1) & 7)) << 3;
    unsigned ap[4], bpo[4];
#pragma unroll
    for (int i = 0; i < 4; ++i) {
        int r = g.m0 + ar + 64 * i; if (r >= g.mvalid) r = g.mvalid - 1;
        const int src = g.arow ? g.arow[r] : r;
        ap[i] = (unsigned)src * (unsigned)g.lda + kofs;
        const int np = ar + 64 * i;
        if (EPI == EPI_SWIGLU) {
            const int which = (np >> 5) & 1, ffl = (np >> 6) * 32 + (np & 31);
            bpo[i] = (unsigned)(g.n0 + ffl) * (unsigned)g.K + kofs + (which ? 0x80000000u : 0u);
        } else {
            int n = g.n0 + np; if (n >= g.ncols) n = g.ncols - 1;
            bpo[i] = (unsigned)n * (unsigned)g.K + kofs;
        }
    }
    const int d_off = t * 16;
    const int s0 = (fr >> 1) & 7;
    const int a_rd0 = wr * 16384 + fr * 128 + ((fq ^ s0) << 4), a_rd1 = a_rd0 ^ 64;
    const int b_rd0 = GEMM_BOFF + wc * 8192 + fr * 128 + ((fq ^ s0) << 4), b_rd1 = b_rd0 ^ 64;

    f32x4 acc[8][4];
#pragma unroll
    for (int i = 0; i < 8; ++i)
#pragma unroll
        for (int j = 0; j < 4; ++j) acc[i][j] = (f32x4){0.f, 0.f, 0.f, 0.f};

    const int nk = g.K >> 6;
#define G_DMA(BUF, KT) do { const unsigned _k = (unsigned)(KT) << 6; \
    _Pragma("unroll") for (int i = 0; i < 4; ++i) __builtin_amdgcn_global_load_lds((const unsigned*)(g.A + (ap[i] + _k)), (unsigned*)((BUF) + d_off + i * 8192), 16, 0, 0); \
    _Pragma("unroll") for (int i = 0; i < 4; ++i) { \
        const u16* _b = (EPI == EPI_SWIGLU && (bpo[i] & 0x80000000u)) ? g.B1 : g.B0; \
        __builtin_amdgcn_global_load_lds((const unsigned*)(_b + ((bpo[i] & 0x7fffffffu) + _k)), (unsigned*)((BUF) + GEMM_BOFF + d_off + i * 8192), 16, 0, 0); } } while (0)
    G_DMA(lds, 0);
    for (int kt = 0; kt < nk; ++kt) {
        unsigned char* buf = lds + (kt & 1) * GEMM_BUF;
        asm volatile("s_waitcnt vmcnt(0)" ::: "memory");
        __syncthreads();
        if (kt + 1 < nk) G_DMA(lds + ((kt + 1) & 1) * GEMM_BUF, kt + 1);
#pragma unroll
        for (int kk = 0; kk < 2; ++kk) {
            bf16x8 bfr[4];
#pragma unroll
            for (int ni = 0; ni < 4; ++ni) bfr[ni] = *reinterpret_cast<const bf16x8*>(buf + ((kk ? b_rd1 : b_rd0) + ni * 2048));
#pragma unroll
            for (int mi = 0; mi < 8; ++mi) {
                const bf16x8 afr = *reinterpret_cast<const bf16x8*>(buf + ((kk ? a_rd1 : a_rd0) + mi * 2048));
#pragma unroll
                for (int ni = 0; ni < 4; ++ni) acc[mi][ni] = mfma16(bfr[ni], afr, acc[mi][ni]);
            }
        }
    }
#undef G_DMA
#pragma unroll
    for (int mi = 0; mi < 8; ++mi) {
        const int row = g.m0 + wr * 128 + mi * 16 + fr;
        if (row < g.mvalid) {
            if (EPI == EPI_BF16) {
#pragma unroll
                for (int ni = 0; ni < 4; ++ni) {
                    const int col = g.n0 + wc * 64 + ni * 16 + 4 * fq;
                    if (col < g.ncols) {
                        const f32x4 v = acc[mi][ni];
                        u32x2 pk = {pk_bf16(v[0], v[1]), pk_bf16(v[2], v[3])};
                        *reinterpret_cast<u32x2*>(e.ob + (size_t)row * e.ldo + col) = pk;
                        if (e.gates && col >= 4096 && col < 4112) *reinterpret_cast<f32x4*>(e.gates + (size_t)row * 16 + (col - 4096)) = v;
                    }
                }
            } else if (EPI == EPI_F32) {
#pragma unroll
                for (int ni = 0; ni < 4; ++ni) {
                    const int col = g.n0 + wc * 64 + ni * 16 + 4 * fq;
                    *reinterpret_cast<f32x4*>(e.of + (size_t)row * e.ldo + col) = acc[mi][ni];
                }
            } else if (EPI == EPI_SWIGLU) {
#pragma unroll
                for (int ni = 0; ni < 2; ++ni) {
                    const int col = g.n0 + wc * 32 + ni * 16 + 4 * fq;
                    const f32x4 u = acc[mi][ni], v = acc[mi][ni + 2];
                    f32x4 a;
#pragma unroll
                    for (int q = 0; q < 4; ++q) a[q] = u[q] / (1.f + __expf(-u[q])) * v[q];
                    u32x2 pk = {pk_bf16(a[0], a[1]), pk_bf16(a[2], a[3])};
                    *reinterpret_cast<u32x2*>(e.ob + (size_t)row * e.ldo + col) = pk;
                }
            } else {
                const float sc = e.rscale[row];
#pragma unroll
                for (int ni = 0; ni < 4; ++ni) {
                    const int col = g.n0 + wc * 64 + ni * 16 + 4 * fq;
                    const f32x4 v = acc[mi][ni] * sc;
                    u32x2 pk = {pk_bf16(v[0], v[1]), pk_bf16(v[2], v[3])};
                    *reinterpret_cast<u32x2*>(e.ob + (size_t)row * e.ldo + col) = pk;
                }
            }
        }
    }
    __syncthreads();
}

template <int EPI>
__device__ void phase_gemm_dense(const Params& p, const u16* A, int M, const u16* Wt, int N, EpiDesc e, unsigned char* lds) {
    const int nM = M / 256, nN = (N + 255) / 256, L = nM * nN;
    const int xcd = bid_() & 7, slot = bid_() >> 3, nslot = gdim_() >> 3;
    const int base = (int)(((long)L * xcd) >> 3), cnt = (int)(((long)L * (xcd + 1)) >> 3) - base;
    const int G8 = nM >> 3, rem = nM & 7;
    for (int k = slot; k < cnt; k += nslot) {
        const int idx = base + k;
        int pn, pm;
        if (idx < G8 * 8 * nN) { const int gq = idx / (8 * nN), r = idx % (8 * nN); pn = r >> 3; pm = gq * 8 + (r & 7); }
        else { const int r = idx - G8 * 8 * nN; pn = r / rem; pm = G8 * 8 + r % rem; }
        GemmDesc g; g.A = A; g.lda = D; g.arow = nullptr; g.mvalid = M; g.m0 = pm * 256;
        g.B0 = Wt; g.B1 = nullptr; g.n0 = pn * 256; g.ncols = N; g.K = D;
        gemm_tile<EPI>(g, e, lds);
    }
}

__device__ void phase_moe_a(const Params& p, int l, unsigned char* lds) {
    const int mvalid = l == 0 ? 2176 : 2048, nM = l == 0 ? 9 : 8;
    const int per_e = nM * 16;
    const int xcd = bid_() & 7, slot = bid_() >> 3, nslot = gdim_() >> 3;
    for (int k = slot; k < 2 * per_e; k += nslot) {
        const int tile = xcd * 2 * per_e + k;
        const int ex = tile / per_e, r = tile % per_e, pn = r / nM, pm = r % nM;
        GemmDesc g; g.A = (const u16*)(p.ws + WS_H); g.lda = D; g.arow = (const int*)(p.ws + WS_EROW) + ex * EPAD; g.mvalid = mvalid; g.m0 = pm * 256;
        g.B0 = (const u16*)(p.ws + WS_WT_W1) + (size_t)ex * D * FF; g.B1 = (const u16*)(p.ws + WS_WT_W3) + (size_t)ex * D * FF; g.n0 = pn * 128; g.ncols = FF; g.K = D;
        EpiDesc e; e.ob = (u16*)(p.ws + WS_ACT) + (size_t)ex * EPAD * FF; e.of = nullptr; e.ldo = FF; e.gates = nullptr; e.rscale = nullptr;
        gemm_tile<EPI_SWIGLU>(g, e, lds);
    }
}
__device__ void phase_moe_b(const Params& p, int l, unsigned char* lds) {
    const int mvalid = l == 0 ? 2176 : 2048, nM = l == 0 ? 9 : 8;
    const int per_e = nM * 8;
    const int xcd = bid_() & 7, slot = bid_() >> 3, nslot = gdim_() >> 3;
    for (int k = slot; k < 2 * per_e; k += nslot) {
        const int tile = xcd * 2 * per_e + k;
        const int ex = tile / per_e, r = tile % per_e, pn = r / nM, pm = r % nM;
        GemmDesc g; g.A = (const u16*)(p.ws + WS_ACT) + (size_t)ex * EPAD * FF; g.lda = FF; g.arow = nullptr; g.mvalid = mvalid; g.m0 = pm * 256;
        g.B0 = (const u16*)(p.ws + WS_WT_W2) + (size_t)ex * D * FF; g.B1 = nullptr; g.n0 = pn * 256; g.ncols = D; g.K = FF;
        EpiDesc e; e.ob = (u16*)(p.ws + WS_YEXP) + (size_t)ex * EPAD * D; e.of = nullptr; e.ldo = D; e.gates = nullptr; e.rscale = (const float*)(p.ws + WS_EGATE) + ex * EPAD;
        gemm_tile<EPI_SCALE>(g, e, lds);
    }
}

__device__ __forceinline__ int mlstm_row(int b, int dir, int pos) {
    if (pos < LC) return NLAT + b * LC + (dir ? (LC - 1 - pos) : pos);
    const int q = pos - LC; return b * SEQ + (dir ? (SEQ - 1 - q) : q);
}
__device__ void phase_mlstm(const Params& p, unsigned char* lds) {
    u16* KT = (u16*)lds;
    u16* VT = KT + 256 * 72;
    u16* VWT = VT + 48 * 72;
    u16* CT = VWT + 48 * 72;
    u16* Ss = CT + 48 * 264;
    float* sb = (float*)(Ss + 64 * 72);
    float* sig = sb + 64;
    float* spm = sig + 64;
    float* ssc = spm + 64;
    const int t = tid_(), lane = t & 63, w = t >> 6, fr = lane & 15, fq = lane >> 4;
    const u16* P = (const u16*)(p.ws + WS_P);
    const float* G = (const float*)(p.ws + WS_G);
    u16* HM = (u16*)(p.ws + WS_HM);
    for (int item = bid_(); item < 256; item += gdim_()) {
        const int vs = item & 7, dir = (item >> 3) & 1, hh = (item >> 4) & 3, b = item >> 6;
        __syncthreads();
        for (int i = t; i < 48 * 264; i += NT) CT[i] = 0;
        for (int i = t; i < 16 * 72; i += NT) { const int er = i / 72; VT[32 * 72 + i] = (er == 0) ? (u16)0x3f80 : (u16)0; VWT[32 * 72 + i] = 0; }
        f32x4 Cacc[2][3];
#pragma unroll
        for (int i = 0; i < 2; ++i)
#pragma unroll
            for (int j = 0; j < 3; ++j) Cacc[i][j] = (f32x4){0.f, 0.f, 0.f, 0.f};
        float m_old = 0.f;
        const float gb_i = p.mlstm_gate_b[(dir * 2 + 0) * 4 + hh], gb_f = p.mlstm_gate_b[(dir * 2 + 1) * 4 + hh];
        const int jt = w & 3, sth = w >> 2;
        for (int ch = 0; ch < 68; ++ch) {
            const int pos0 = ch * 64;
            if (w == 0) {
                const int row = mlstm_row(b, dir, pos0 + lane);
                const float gi = G[(size_t)row * 16 + dir * 8 + hh] + gb_i;
                const float gf = G[(size_t)row * 16 + dir * 8 + 4 + hh] + gb_f;
                const float lf = fminf(gf, 0.f) - log1pf(__expf(-fabsf(gf)));
                float bc = lf;
#pragma unroll
                for (int o = 1; o < 64; o <<= 1) { const float n = __shfl_up(bc, o, 64); if (lane >= o) bc += n; }
                float pm = gi - bc;
#pragma unroll
                for (int o = 1; o < 64; o <<= 1) { const float n = __shfl_up(pm, o, 64); if (lane >= o) pm = fmaxf(pm, n); }
                const float b63 = __shfl(bc, 63, 64);
                float gmax = b63 - bc + gi;
#pragma unroll
                for (int o = 32; o > 0; o >>= 1) gmax = fmaxf(gmax, __shfl_xor(gmax, o, 64));
                const float m_new = fmaxf(b63 + m_old, gmax);
                sb[lane] = bc; sig[lane] = gi; spm[lane] = pm;
                if (lane == 0) { ssc[0] = m_new; ssc[1] = __expf(b63 + m_old - m_new); }
            }
            const int rowq = mlstm_row(b, dir, pos0 + jt * 16 + fr);
            bf16x8 qf[8];
#pragma unroll
            for (int kk = 0; kk < 8; ++kk) qf[kk] = ld_frag_g(P + (size_t)rowq * AB_IN + hh * 256 + kk * 32 + fq * 8);
            bf16x8 kf[8];
            {
                const int rowk = mlstm_row(b, dir, pos0 + (sth * 2) * 16 + fr);
#pragma unroll
                for (int kk = 0; kk < 8; ++kk) kf[kk] = ld_frag_g(P + (size_t)rowk * AB_IN + 1024 + hh * 256 + kk * 32 + fq * 8);
            }
            unsigned ktr[2][8];
#pragma unroll
            for (int i = 0; i < 2; ++i) {
                const int mt = t + NT * i, d2 = (mt & 127) * 2, s8 = (mt >> 7) * 8;
#pragma unroll
                for (int q = 0; q < 8; ++q) ktr[i][q] = *reinterpret_cast<const unsigned*>(P + (size_t)mlstm_row(b, dir, pos0 + s8 + q) * AB_IN + 1024 + hh * 256 + d2);
            }
            const int vs_s = t & 63, vs_eg = t >> 6;
            const u32x2 vraw = *reinterpret_cast<const u32x2*>(P + (size_t)mlstm_row(b, dir, pos0 + vs_s) * AB_IN + 2048 + hh * 256 + vs * 32 + vs_eg * 4);
            __syncthreads();
            const float m_new = ssc[0], decay = ssc[1], b63 = sb[63];
            const int jg = jt * 16 + fr;
            const float bj = sb[jg], mj = bj + fmaxf(m_old, spm[jg]);
            auto s_tile = [&](int st) {
                f32x4 sv = (f32x4){0.f, 0.f, 0.f, 0.f};
                if (st <= jt) {
#pragma unroll
                    for (int kk = 0; kk < 8; ++kk) sv = mfma16(kf[kk], qf[kk], sv);
                }
                float pv[4];
#pragma unroll
                for (int q = 0; q < 4; ++q) {
                    const int sg = st * 16 + 4 * fq + q;
                    pv[q] = (sg <= jg) ? sv[q] * 0.0625f * __expf(bj - sb[sg] + sig[sg] - mj) : 0.f;
                }
                u32x2 pk = {pk_bf16(pv[0], pv[1]), pk_bf16(pv[2], pv[3])};
                *reinterpret_cast<u32x2*>(Ss + jg * 72 + st * 16 + 4 * fq) = pk;
            };
            s_tile(sth * 2);
            {
                const int rowk = mlstm_row(b, dir, pos0 + (sth * 2 + 1) * 16 + fr);
#pragma unroll
                for (int kk = 0; kk < 8; ++kk) kf[kk] = ld_frag_g(P + (size_t)rowk * AB_IN + 1024 + hh * 256 + kk * 32 + fq * 8);
            }
#pragma unroll
            for (int i = 0; i < 2; ++i) {
                const int mt = t + NT * i, d2 = (mt & 127) * 2, s8 = (mt >> 7) * 8;
                u32x4 lo = {(ktr[i][0] & 0xffffu) | (ktr[i][1] << 16), (ktr[i][2] & 0xffffu) | (ktr[i][3] << 16), (ktr[i][4] & 0xffffu) | (ktr[i][5] << 16), (ktr[i][6] & 0xffffu) | (ktr[i][7] << 16)};
                u32x4 hi = {(ktr[i][0] >> 16) | (ktr[i][1] & 0xffff0000u), (ktr[i][2] >> 16) | (ktr[i][3] & 0xffff0000u), (ktr[i][4] >> 16) | (ktr[i][5] & 0xffff0000u), (ktr[i][6] >> 16) | (ktr[i][7] & 0xffff0000u)};
                *reinterpret_cast<u32x4*>(KT + d2 * 72 + s8) = lo;
                *reinterpret_cast<u32x4*>(KT + (d2 + 1) * 72 + s8) = hi;
            }
            {
                const float wg = __expf(b63 - sb[vs_s] + sig[vs_s] - m_new) * 0.0625f;
                const float v0 = bf_lo(vraw[0]), v1 = bf_hi(vraw[0]), v2 = bf_lo(vraw[1]), v3 = bf_hi(vraw[1]);
                const int e0 = vs_eg * 4;
                VT[(e0 + 0) * 72 + vs_s] = (u16)(vraw[0] & 0xffffu); VT[(e0 + 1) * 72 + vs_s] = (u16)(vraw[0] >> 16);
                VT[(e0 + 2) * 72 + vs_s] = (u16)(vraw[1] & 0xffffu); VT[(e0 + 3) * 72 + vs_s] = (u16)(vraw[1] >> 16);
                VWT[(e0 + 0) * 72 + vs_s] = f2bf(v0 * wg); VWT[(e0 + 1) * 72 + vs_s] = f2bf(v1 * wg);
                VWT[(e0 + 2) * 72 + vs_s] = f2bf(v2 * wg); VWT[(e0 + 3) * 72 + vs_s] = f2bf(v3 * wg);
                if (t < 64) VWT[32 * 72 + t] = f2bf(wg);
            }
            s_tile(sth * 2 + 1);
            __syncthreads();
            {
                const float w_inter = __expf(bj + m_old - mj);
                f32x4 nacc[2];
#pragma unroll
                for (int z = 0; z < 2; ++z) {
                    const int et = z == 0 ? sth : 2;
                    f32x4 a = (f32x4){0.f, 0.f, 0.f, 0.f};
#pragma unroll
                    for (int kk = 0; kk < 8; ++kk) a = mfma16(ld_frag_s(CT + (et * 16 + fr) * 264 + kk * 32 + fq * 8), qf[kk], a);
                    a *= w_inter;
#pragma unroll
                    for (int k2 = 0; k2 < 2; ++k2) a = mfma16(ld_frag_s(VT + (et * 16 + fr) * 72 + k2 * 32 + fq * 8), ld_frag_s(Ss + jg * 72 + k2 * 32 + fq * 8), a);
                    nacc[z] = a;
                }
                const float den = __shfl(nacc[1][0], fr, 64);
                const float dd = fmaxf(fabsf(den), __expf(-mj));
                const float inv = 1.f / dd;
                u32x2 pk = {pk_bf16(nacc[0][0] * inv, nacc[0][1] * inv), pk_bf16(nacc[0][2] * inv, nacc[0][3] * inv)};
                *reinterpret_cast<u32x2*>(HM + ((size_t)dir * NTOK + rowq) * 1024 + hh * 256 + vs * 32 + sth * 16 + 4 * fq) = pk;
            }
#pragma unroll
            for (int i = 0; i < 2; ++i)
#pragma unroll
                for (int et = 0; et < 3; ++et) {
                    f32x4 a = Cacc[i][et] * decay;
#pragma unroll
                    for (int k2 = 0; k2 < 2; ++k2) a = mfma16(ld_frag_s(KT + ((w * 2 + i) * 16 + fr) * 72 + k2 * 32 + fq * 8), ld_frag_s(VWT + (et * 16 + fr) * 72 + k2 * 32 + fq * 8), a);
                    Cacc[i][et] = a;
                }
            __syncthreads();
#pragma unroll
            for (int i = 0; i < 2; ++i)
#pragma unroll
                for (int et = 0; et < 3; ++et) {
                    const f32x4 a = Cacc[i][et];
                    u32x2 pk = {pk_bf16(a[0], a[1]), pk_bf16(a[2], a[3])};
                    *reinterpret_cast<u32x2*>(CT + (et * 16 + fr) * 264 + (w * 2 + i) * 16 + 4 * fq) = pk;
                }
            m_old = m_new;
        }
    }
}

__device__ void mlstm_out_rows(const Params& p, int row0, int nrows) {
    const int lane = tid_() & 63, w = tid_() >> 6;
    const u16* P = (const u16*)(p.ws + WS_P);
    const u16* HM = (const u16*)(p.ws + WS_HM);
    u16* YIN = (u16*)(p.ws + WS_YIN);
    for (int r = w; r < nrows; r += 8) {
        const int row = row0 + r;
        const int c0 = lane * 16;
        float v[16]; float ss = 0.f;
#pragma unroll
        for (int h2 = 0; h2 < 2; ++h2) {
            const u32x4 a = *reinterpret_cast<const u32x4*>(HM + (size_t)row * 1024 + c0 + h2 * 8);
            const u32x4 bq = *reinterpret_cast<const u32x4*>(HM + ((size_t)NTOK + row) * 1024 + c0 + h2 * 8);
#pragma unroll
            for (int q = 0; q < 4; ++q) { v[h2 * 8 + 2 * q] = bf_lo(a[q]) + bf_lo(bq[q]); v[h2 * 8 + 2 * q + 1] = bf_hi(a[q]) + bf_hi(bq[q]); }
        }
#pragma unroll
        for (int q = 0; q < 16; ++q) ss += v[q] * v[q];
        ss += __shfl_xor(ss, 1, 64); ss += __shfl_xor(ss, 2, 64); ss += __shfl_xor(ss, 4, 64); ss += __shfl_xor(ss, 8, 64);
        const float rstd = rsqrtf(ss * (1.f / 256.f) + 1e-6f);
        unsigned o[8];
#pragma unroll
        for (int h2 = 0; h2 < 2; ++h2) {
            const u32x4 og = *reinterpret_cast<const u32x4*>(P + (size_t)row * AB_IN + 3072 + c0 + h2 * 8);
#pragma unroll
            for (int q = 0; q < 4; ++q) {
                const int c = c0 + h2 * 8 + 2 * q;
                const float y0 = v[h2 * 8 + 2 * q] * rstd * p.mlstm_norm[c] * sigmoidf_(bf_lo(og[q]));
                const float y1 = v[h2 * 8 + 2 * q + 1] * rstd * p.mlstm_norm[c + 1] * sigmoidf_(bf_hi(og[q]));
                o[h2 * 4 + q] = pk_bf16(y0, y1);
            }
        }
        *reinterpret_cast<u32x4*>(YIN + (size_t)row * D + c0) = (u32x4){o[0], o[1], o[2], o[3]};
        *reinterpret_cast<u32x4*>(YIN + (size_t)row * D + c0 + 8) = (u32x4){o[4], o[5], o[6], o[7]};
    }
}

template <int DH, class KeyFn, class BiasFn>
__device__ __forceinline__ void attn_wave(const u16* qptr, size_t qstride, int nblk, KeyFn keyfn, BiasFn biasfn, float scale,
                                           float m_init, float l_init, u16* vlds, u16* optr, size_t ostride) {
    constexpr int NK = DH / 32, NDT = DH / 16, VS = DH + 8, NV = DH / 16;
    const int lane = tid_() & 63, fr = lane & 15, fq = lane >> 4;
    bf16x8 qf[NK];
#pragma unroll
    for (int kk = 0; kk < NK; ++kk) qf[kk] = ld_frag_g(qptr + (size_t)fr * qstride + kk * 32 + fq * 8);
    f32x4 oacc[NDT];
#pragma unroll
    for (int i = 0; i < NDT; ++i) oacc[i] = (f32x4){0.f, 0.f, 0.f, 0.f};
    float m = m_init, l = l_init;
    bf16x8 kn[2][NK]; u32x4 vn[NV];
    auto load_blk = [&](int ib) {
        const u16* kptr; const u16* vptr; size_t kvs;
        (void)keyfn(ib, kptr, vptr, kvs);
#pragma unroll
        for (int st = 0; st < 2; ++st)
#pragma unroll
            for (int kk = 0; kk < NK; ++kk) kn[st][kk] = ld_frag_g(kptr + (size_t)(st * 16 + fr) * kvs + kk * 32 + fq * 8);
#pragma unroll
        for (int i = 0; i < NV; ++i) { const int cidx = lane + 64 * i, r = cidx / (DH / 8), cc = cidx % (DH / 8); vn[i] = *reinterpret_cast<const u32x4*>(vptr + (size_t)r * kvs + cc * 8); }
    };
    auto next_valid = [&](int ib) { const u16* a; const u16* b2; size_t c; while (ib < nblk && !keyfn(ib, a, b2, c)) ++ib; return ib; };
    int ib = next_valid(0);
    if (ib < nblk) load_blk(ib);
    while (ib < nblk) {
        bf16x8 kc[2][NK]; u32x4 vc[NV];
#pragma unroll
        for (int st = 0; st < 2; ++st)
#pragma unroll
            for (int kk = 0; kk < NK; ++kk) kc[st][kk] = kn[st][kk];
#pragma unroll
        for (int i = 0; i < NV; ++i) vc[i] = vn[i];
        const int ibn = next_valid(ib + 1);
        if (ibn < nblk) load_blk(ibn);
        asm volatile("" ::: "memory");
#pragma unroll
        for (int i = 0; i < NV; ++i) { const int cidx = lane + 64 * i, r = cidx / (DH / 8), cc = cidx % (DH / 8); *reinterpret_cast<u32x4*>(vlds + r * VS + cc * 8) = vc[i]; }
        f32x4 s[2];
#pragma unroll
        for (int st = 0; st < 2; ++st) {
            f32x4 a = (f32x4){0.f, 0.f, 0.f, 0.f};
#pragma unroll
            for (int kk = 0; kk < NK; ++kk) a = mfma16(kc[st][kk], qf[kk], a);
            s[st] = a;
        }
        float x[8]; float mx = -INFINITY;
#pragma unroll
        for (int st = 0; st < 2; ++st)
#pragma unroll
            for (int q = 0; q < 4; ++q) { const float v = s[st][q] * scale + biasfn(ib, fr, st * 16 + 4 * fq + q); x[st * 4 + q] = v; mx = fmaxf(mx, v); }
        mx = fmaxf(mx, __shfl_xor(mx, 16, 64)); mx = fmaxf(mx, __shfl_xor(mx, 32, 64));
        const float m_new = fmaxf(m, mx);
        const float m_safe = (m_new == -INFINITY) ? 0.f : m_new;
        const float alpha = __expf(m - m_safe);
        float ps = 0.f; float pe[8];
#pragma unroll
        for (int q = 0; q < 8; ++q) { pe[q] = __expf(x[q] - m_safe); ps += pe[q]; }
        l = l * alpha + ps; m = m_new;
#pragma unroll
        for (int i = 0; i < NDT; ++i) oacc[i] *= alpha;
        const bf16x8 pf = mk_frag(pk_bf16(pe[0], pe[1]), pk_bf16(pe[2], pe[3]), pk_bf16(pe[4], pe[5]), pk_bf16(pe[6], pe[7]));
        asm volatile("s_waitcnt lgkmcnt(0)" ::: "memory");
#pragma unroll
        for (int dt = 0; dt < NDT; ++dt) {
            const u16* vb = vlds + dt * 16 + fr;
            unsigned e[4];
#pragma unroll
            for (int j2 = 0; j2 < 2; ++j2) {
                const int k0 = (j2 == 0 ? 0 : 16) + 4 * fq;
                e[j2 * 2 + 0] = (unsigned)vb[(k0 + 0) * VS] | ((unsigned)vb[(k0 + 1) * VS] << 16);
                e[j2 * 2 + 1] = (unsigned)vb[(k0 + 2) * VS] | ((unsigned)vb[(k0 + 3) * VS] << 16);
            }
            oacc[dt] = mfma16(mk_frag(e[0], e[1], e[2], e[3]), pf, oacc[dt]);
        }
        asm volatile("" ::: "memory");
        ib = ibn;
    }
    l += __shfl_xor(l, 16, 64); l += __shfl_xor(l, 32, 64);
    const float inv = 1.f / l;
#pragma unroll
    for (int dt = 0; dt < NDT; ++dt) {
        const f32x4 o = oacc[dt] * inv;
        u32x2 pk = {pk_bf16(o[0], o[1]), pk_bf16(o[2], o[3])};
        *reinterpret_cast<u32x2*>(optr + (size_t)fr * ostride + dt * 16 + 4 * fq) = pk;
    }
}

__device__ void phase_l0_stage2(const Params& p, unsigned char* lds) {
    const int w = tid_() >> 6;
    const u16* P = (const u16*)(p.ws + WS_P);
    u16* YIN = (u16*)(p.ws + WS_YIN);
    u16* vlds = (u16*)lds + w * (32 * 136);
    for (int item = bid_(); item < 1088 + 2176; item += gdim_()) {
        if (item < 1024) {
            const int qt = item & 3, r = (item >> 2) & 63, b = item >> 8, h = w;
            const int r0 = min(max(r - 4, 0), 56);
            const int cb = qt == 0 ? 0 : (qt == 1 ? 8 : (qt == 2 ? 24 : 32));
            const int qrow = b * SEQ + r * 64 + qt * 16;
            const float* rpb = p.na_rpb + h * 15 * 31;
            auto keyfn = [&](int ib, const u16*& kp, const u16*& vp, size_t& kvs) -> bool {
                int row;
                if (ib < 8) row = b * SEQ + (r0 + ib) * 64 + cb; else row = NLAT + b * LC + (ib - 8) * 32;
                kp = P + (size_t)row * AB_IN + 5136 + h * 128; vp = P + (size_t)row * AB_IN + 6160 + h * 128; kvs = AB_IN; return true; };
            auto biasfn = [&](int ib, int qi, int ki) -> float {
                if (ib >= 8) return 0.f;
                const int c = qt * 16 + qi, kc = cb + ki, c0 = min(max(c - 8, 0), 48);
                if (kc < c0 || kc >= c0 + 16) return -INFINITY;
                return rpb[(r0 + ib - r + 7) * 31 + (kc - c + 15)]; };
            attn_wave<128>(P + (size_t)qrow * AB_IN + 4112 + h * 128, AB_IN, 16, keyfn, biasfn, 0.08838834764831845f, -INFINITY, 0.f, vlds,
                           YIN + (size_t)qrow * D + 1024 + h * 128, D);
        } else if (item < 1088) {
            const int it = item - 1024, qt = it & 15, b = it >> 4, h = w;
            const int qrow = NLAT + b * LC + qt * 16;
            auto keyfn = [&](int ib, const u16*& kp, const u16*& vp, size_t& kvs) -> bool {
                const int row = NLAT + b * LC + ib * 32;
                kp = P + (size_t)row * AB_IN + 5136 + h * 128; vp = P + (size_t)row * AB_IN + 6160 + h * 128; kvs = AB_IN; return true; };
            auto biasfn = [&](int, int, int) -> float { return 0.f; };
            attn_wave<128>(P + (size_t)qrow * AB_IN + 4112 + h * 128, AB_IN, 8, keyfn, biasfn, 0.08838834764831845f, -INFINITY, 0.f, vlds,
                           YIN + (size_t)qrow * D + 1024 + h * 128, D);
        } else {
            mlstm_out_rows(p, (item - 1088) * 8, 8);
        }
    }
}

__device__ void rope_rows(const Params& p, int row0, int nrows) {
    const int lane = tid_() & 63, w = tid_() >> 6;
    u16* P = (u16*)(p.ws + WS_P);
    for (int r = w; r < nrows; r += 8) {
        const int row = row0 + r, tt = row & (SEQ - 1);
        const float prow = (float)(tt >> 6), pcol = (float)(tt & 63);
        for (int pi = lane; pi < 640; pi += 64) {
            const int head = pi >> 5, half = (pi >> 4) & 1, j = pi & 15;
            const int base = (head < 16 ? head * 64 : 1024 + (head - 16) * 64) + half * 32 + j;
            const float inv = exp2f(-(float)j * (13.287712379549449f / 16.f));
            const float ang = (half ? pcol : prow) * inv;
            float sn, cs; sincosf(ang, &sn, &cs);
            u16* q1 = P + (size_t)row * CD_IN + base;
            const float x1 = bf2f(q1[0]), x2 = bf2f(q1[16]);
            q1[0] = f2bf(x1 * cs - x2 * sn); q1[16] = f2bf(x2 * cs + x1 * sn);
        }
    }
}

__device__ __forceinline__ int lru_row(int b, int ci, int j) { return ci < 4 ? NLAT + b * LC + ci * 64 + j : b * SEQ + (ci - 4) * 64 + j; }
__device__ void lru_chunk(const Params& p, int b, int blk, int ci, int mode, unsigned char* lds) {
    u16* ub = (u16*)lds;
    float* sa = (float*)(ub + 64 * 136);
    float* sbt = sa + 64 * 128;
    float* sx = sbt + 64 * 128;
    const int t = tid_(), lane = t & 63, w = t >> 6, fr = lane & 15, fq = lane >> 4;
    const u16* P = (const u16*)(p.ws + WS_P);
    const u16* WT = (const u16*)(p.ws + WS_LRUW);
    float* SA = (float*)(p.ws + WS_LRUS);
    float* SH = SA + 2 * 4 * 68 * 1024;
    const int seglen = ci < 4 ? LC : SEQ, tt0 = ci < 4 ? ci * 64 : (ci - 4) * 64;
    const int rbase = ci < 4 ? NLAT + b * LC : b * SEQ;
    __syncthreads();
    {
        const int c4 = (t & 31) * 4, j0 = (t >> 5) * 4, ch = blk * 128 + c4;
        float xv[7][4];
#pragma unroll
        for (int q = 0; q < 7; ++q) {
            const int tt = tt0 + j0 - 1 + q;
            if (tt >= 0 && tt < seglen) {
                const u32x2 v = *reinterpret_cast<const u32x2*>(P + (size_t)(rbase + tt) * CD_IN + 1536 + ch);
                xv[q][0] = bf_lo(v[0]); xv[q][1] = bf_hi(v[0]); xv[q][2] = bf_lo(v[1]); xv[q][3] = bf_hi(v[1]);
            } else { xv[q][0] = xv[q][1] = xv[q][2] = xv[q][3] = 0.f; }
        }
        f32x4 cw[4];
#pragma unroll
        for (int tp = 0; tp < 4; ++tp) cw[tp] = *reinterpret_cast<const f32x4*>(p.lru_conv_w + tp * 1024 + ch);
        const f32x4 cb = *reinterpret_cast<const f32x4*>(p.lru_conv_b + ch);
#pragma unroll
        for (int q = 0; q < 4; ++q) {
            float u[4];
#pragma unroll
            for (int cc = 0; cc < 4; ++cc) u[cc] = cb[cc] + xv[q][cc] * cw[0][cc] + xv[q + 1][cc] * cw[1][cc] + xv[q + 2][cc] * cw[2][cc] + xv[q + 3][cc] * cw[3][cc];
            u32x2 pk = {pk_bf16(u[0], u[1]), pk_bf16(u[2], u[3])};
            *reinterpret_cast<u32x2*>(ub + (j0 + q) * 136 + c4) = pk;
        }
    }
    __syncthreads();
    const int sc = t & 127, seg = t >> 7;
    const int chg_s = blk * 128 + sc;
    float hfw[16];
    bf16x8 wfa[2][2][4];
#pragma unroll
    for (int d2 = 0; d2 < 2; ++d2)
#pragma unroll
        for (int g2 = 0; g2 < 2; ++g2)
#pragma unroll
            for (int kk = 0; kk < 4; ++kk) wfa[d2][g2][kk] = ld_frag_g(WT + ((size_t)((d2 * 2 + g2) * 8 + blk) * 128 + w * 16 + fr) * 128 + fq * 8 + kk * 32);
    float carry[2] = {0.f, 0.f}; u16 grv[16];
    if (mode == 1) {
#pragma unroll
        for (int d2 = 0; d2 < 2; ++d2) carry[d2] = SH[((size_t)(d2 * 4 + b) * 68 + ci) * 1024 + chg_s];
#pragma unroll
        for (int s = 0; s < 16; ++s) grv[s] = P[(size_t)lru_row(b, ci, seg * 16 + s) * CD_IN + 2560 + chg_s];
    }
    for (int dir = 0; dir < 2; ++dir) {
        const int cg = blk * 128 + w * 16 + 4 * fq;
        f32x4 av[4];
        {
            bf16x8 wf[4];
#pragma unroll
            for (int kk = 0; kk < 4; ++kk) wf[kk] = dir ? wfa[1][0][kk] : wfa[0][0][kk];
            const f32x4 gbv = *reinterpret_cast<const f32x4*>(p.lru_gate_b + (dir * 2 + 0) * 1024 + cg);
            const f32x4 lamv = *reinterpret_cast<const f32x4*>(p.lru_lambda + dir * 1024 + cg);
            float sp8[4];
#pragma unroll
            for (int q = 0; q < 4; ++q) { const float nl = -lamv[q]; sp8[q] = -8.f * (fmaxf(nl, 0.f) + log1pf(__expf(-fabsf(nl)))); }
#pragma unroll
            for (int tt = 0; tt < 4; ++tt) {
                f32x4 z = (f32x4){0.f, 0.f, 0.f, 0.f};
#pragma unroll
                for (int kk = 0; kk < 4; ++kk) z = mfma16(wf[kk], ld_frag_s(ub + (tt * 16 + fr) * 136 + kk * 32 + fq * 8), z);
#pragma unroll
                for (int q = 0; q < 4; ++q) av[tt][q] = __expf(sigmoidf_(z[q] + gbv[q]) * sp8[q]);
            }
        }
        __syncthreads();
        {
            bf16x8 wf[4];
#pragma unroll
            for (int kk = 0; kk < 4; ++kk) wf[kk] = dir ? wfa[1][1][kk] : wfa[0][1][kk];
            const f32x4 gbv = *reinterpret_cast<const f32x4*>(p.lru_gate_b + (dir * 2 + 1) * 1024 + cg);
#pragma unroll
            for (int tt = 0; tt < 4; ++tt) {
                f32x4 z = (f32x4){0.f, 0.f, 0.f, 0.f};
#pragma unroll
                for (int kk = 0; kk < 4; ++kk) z = mfma16(wf[kk], ld_frag_s(ub + (tt * 16 + fr) * 136 + kk * 32 + fq * 8), z);
                const int tj = tt * 16 + fr;
                const u32x2 uv = *reinterpret_cast<const u32x2*>(ub + tj * 136 + w * 16 + 4 * fq);
                const float u4[4] = {bf_lo(uv[0]), bf_hi(uv[0]), bf_lo(uv[1]), bf_hi(uv[1])};
                f32x4 bv;
#pragma unroll
                for (int q = 0; q < 4; ++q) { const float a = av[tt][q]; bv[q] = sqrtf(fmaxf(1.f - a * a, 0.f)) * sigmoidf_(z[q] + gbv[q]) * u4[q]; }
                *reinterpret_cast<f32x4*>(sa + tj * 128 + w * 16 + 4 * fq) = av[tt];
                *reinterpret_cast<f32x4*>(sbt + tj * 128 + w * 16 + 4 * fq) = bv;
            }
        }
        __syncthreads();
        float A = 1.f, h = 0.f;
#pragma unroll
        for (int s = 0; s < 16; ++s) { const int j = seg * 16 + (dir ? 15 - s : s); const float a = sa[j * 128 + sc]; h = a * h + sbt[j * 128 + sc]; A *= a; }
        sx[(seg * 2 + 0) * 128 + sc] = A; sx[(seg * 2 + 1) * 128 + sc] = h;
        __syncthreads();
        const size_t sidx = ((size_t)(dir * 4 + b) * 68 + ci) * 1024 + chg_s;
        if (mode == 0) {
            if (seg == 0) {
                float At = 1.f, ht = 0.f;
#pragma unroll
                for (int s = 0; s < 4; ++s) { const int sg = dir ? 3 - s : s; const float a = sx[(sg * 2) * 128 + sc]; ht = a * ht + sx[(sg * 2 + 1) * 128 + sc]; At *= a; }
                SA[sidx] = At; SH[sidx] = ht;
            }
        } else {
            float hs = dir ? carry[1] : carry[0];
            const int nprev = dir ? 3 - seg : seg;
#pragma unroll
            for (int s = 0; s < 3; ++s) if (s < nprev) { const int sg = dir ? 3 - s : s; hs = sx[(sg * 2) * 128 + sc] * hs + sx[(sg * 2 + 1) * 128 + sc]; }
            u16* YIN = (u16*)(p.ws + WS_YIN);
#pragma unroll
            for (int s = 0; s < 16; ++s) {
                const int js = dir ? 15 - s : s, j = seg * 16 + js;
                hs = sa[j * 128 + sc] * hs + sbt[j * 128 + sc];
                if (dir == 0) hfw[js] = hs;
                else {
                    const int row = lru_row(b, ci, j);
                    const float gr = bf2f(grv[js]);
                    const float ge = 0.5f * gr * (1.f + tanhf(0.7978845608028654f * (gr + 0.044715f * gr * gr * gr)));
                    YIN[(size_t)row * D + 1024 + chg_s] = f2bf((hfw[js] + hs) * ge);
                }
            }
        }
    }
}

__device__ void lru_prep_weights(const Params& p) {
    const int t = tid_();
    u16* WT = (u16*)(p.ws + WS_LRUW);
    for (int m = bid_(); m < 32; m += gdim_()) {
        const float* Wg = p.lru_gate_w + (size_t)m * 128 * 128;
        const int j4 = (t & 31) * 4, i8 = (t >> 5) * 8;
        f32x4 r8[8];
#pragma unroll
        for (int q = 0; q < 8; ++q) r8[q] = *reinterpret_cast<const f32x4*>(Wg + (size_t)(i8 + q) * 128 + j4);
#pragma unroll
        for (int jj = 0; jj < 4; ++jj) {
            u32x4 v = {pk_bf16(r8[0][jj], r8[1][jj]), pk_bf16(r8[2][jj], r8[3][jj]), pk_bf16(r8[4][jj], r8[5][jj]), pk_bf16(r8[6][jj], r8[7][jj])};
            *reinterpret_cast<u32x4*>(WT + ((size_t)m * 128 + j4 + jj) * 128 + i8) = v;
        }
    }
}
__device__ void lru_carry(const Params& p, int item) {
    const int idx = item * NT + tid_();
    const int c = idx & 1023, b = (idx >> 10) & 3, dir = idx >> 12;
    float* SA = (float*)(p.ws + WS_LRUS);
    float* SH = SA + 2 * 4 * 68 * 1024;
    const size_t base = ((size_t)(dir * 4 + b) * 68) * 1024 + c;
    float h = 0.f;
#pragma unroll 4
    for (int s = 0; s < 68; ++s) {
        const int cj = dir == 0 ? s : (s < 4 ? 3 - s : 71 - s);
        const float a = SA[base + (size_t)cj * 1024], hl = SH[base + (size_t)cj * 1024];
        SH[base + (size_t)cj * 1024] = h;
        h = a * h + hl;
    }
}

__device__ void gqa_item(const Params& p, int it, unsigned char* lds) {
    const int w = tid_() >> 6;
    const u16* P = (const u16*)(p.ws + WS_P);
    u16* YIN = (u16*)(p.ws + WS_YIN);
    const int hq = (it & 1) * 8 + w, t16 = (it >> 1) & 255, b = it >> 9;
    const int kvh = hq >> 2, t0 = t16 * 16;
    const int ks = (t0 - 128) & ~31;
    const int qrow = b * SEQ + t0;
    u16* vlds = (u16*)lds + w * (32 * 72);
    auto keyfn = [&](int ib, const u16*& kp, const u16*& vp, size_t& kvs) -> bool {
        int row;
        if (ib < 9) { const int k0 = ks + ib * 32; if (k0 < 0 || k0 >= SEQ) return false; row = b * SEQ + k0; }
        else row = NLAT + b * LC + (ib - 9) * 32;
        kp = P + (size_t)row * CD_IN + 1024 + kvh * 64; vp = P + (size_t)row * CD_IN + 1280 + kvh * 64; kvs = CD_IN; return true; };
    auto biasfn = [&](int ib, int qi, int ki) -> float {
        if (ib >= 9) return 0.f;
        const int dq = (t0 + qi) - (ks + ib * 32 + ki);
        return (dq > 128 || dq < -128) ? -INFINITY : 0.f; };
    const float sink = p.gqa_sink[hq];
    attn_wave<64>(P + (size_t)qrow * CD_IN + hq * 64, CD_IN, 17, keyfn, biasfn, 0.125f, sink, ((tid_() & 63) >> 4) == 0 ? 1.f : 0.f, vlds,
                  YIN + (size_t)qrow * D + hq * 64, D);
}

__device__ void phase_l1_stage1(const Params& p, unsigned char* lds) {
    for (int item = bid_(); item < 2176 + 2048; item += gdim_()) {
        if (item < 2176) { const int ci = item % 68, blk = (item / 68) & 7, b = item / (68 * 8); lru_chunk(p, b, blk, ci, 0, lds); }
        else rope_rows(p, (item - 2176) * 8, 8);
    }
}
__device__ void phase_l1_stage2(const Params& p, unsigned char* lds) {
    for (int item = bid_(); item < 16 + 2048; item += gdim_()) {
        if (item < 16) lru_carry(p, item);
        else gqa_item(p, item - 16, lds);
    }
}
__device__ void phase_l1_stage3(const Params& p, unsigned char* lds) {
    for (int item = bid_(); item < 2048; item += gdim_()) { const int cl = item & 63, blk = (item >> 6) & 7, b = item >> 9; lru_chunk(p, b, blk, cl + 4, 1, lds); }
}

__device__ void phase_rowpass_mid(const Params& p, int l, unsigned char* lds) {
    float* R = (float*)lds;
    const int t = tid_(), lane = t & 63, w = t >> 6;
    const int nrows = l == 0 ? NTOK : NLAT;
    __syncthreads();
    for (int i = t; i < D * NEXP; i += NT) { const int k = i >> 4, e = i & 15; R[e * D + k] = p.moe_router[(size_t)l * D * NEXP + i]; }
    __syncthreads();
    const float* Y = (const float*)(p.ws + WS_Y);
    float* XL1 = (float*)(p.ws + WS_XL1);
    u16* H = (u16*)(p.ws + WS_H);
    float* AFF = (float*)(p.ws + WS_AFF);
    for (int row = bid_() * 8 + w; row < nrows; row += gdim_() * 8) {
        f32x4 v[8]; float ss = 0.f;
#pragma unroll
        for (int i = 0; i < 8; ++i) { v[i] = *reinterpret_cast<const f32x4*>(Y + (size_t)row * D + (i * 64 + lane) * 4); ss += v[i][0] * v[i][0] + v[i][1] * v[i][1] + v[i][2] * v[i][2] + v[i][3] * v[i][3]; }
        ss = wave_sum(ss);
        const float rstd = rsqrtf(ss * (1.f / D) + 1e-6f);
        const float* xr = xin_row(p, l, row);
        const float* g1 = mod_ptr(p, l, row, 2);
        const float* nw = p.norm_mix_post + (size_t)l * D;
        float ss1 = 0.f;
#pragma unroll
        for (int i = 0; i < 8; ++i) {
            const int col = (i * 64 + lane) * 4;
            const f32x4 x4 = *reinterpret_cast<const f32x4*>(xr + col), w4 = *reinterpret_cast<const f32x4*>(nw + col), g4 = *reinterpret_cast<const f32x4*>(g1 + col);
            const f32x4 x1 = x4 + g4 * (v[i] * rstd * w4);
            *reinterpret_cast<f32x4*>(XL1 + (size_t)row * D + col) = x1;
            v[i] = x1; ss1 += x1[0] * x1[0] + x1[1] * x1[1] + x1[2] * x1[2] + x1[3] * x1[3];
        }
        ss1 = wave_sum(ss1);
        const float rstd1 = rsqrtf(ss1 * (1.f / D) + 1e-6f);
        const float* sh = mod_ptr(p, l, row, 3); const float* sc = mod_ptr(p, l, row, 4);
        const float* nw2 = p.norm_ffn_pre + (size_t)l * D;
#pragma unroll
        for (int i = 0; i < 8; ++i) {
            const int col = (i * 64 + lane) * 4;
            const f32x4 w4 = *reinterpret_cast<const f32x4*>(nw2 + col), s4 = *reinterpret_cast<const f32x4*>(sc + col), h4 = *reinterpret_cast<const f32x4*>(sh + col);
            const f32x4 o = v[i] * rstd1 * w4 * (s4 + 1.f) + h4;
            u32x2 pk = {pk_bf16(o[0], o[1]), pk_bf16(o[2], o[3])};
            *reinterpret_cast<u32x2*>(H + (size_t)row * D + col) = pk;
            v[i] = o;
        }
        float mine = 0.f;
#pragma unroll 2
        for (int e = 0; e < 16; ++e) {
            float sdot = 0.f;
#pragma unroll
            for (int i = 0; i < 8; ++i) { const f32x4 r4 = *reinterpret_cast<const f32x4*>(R + e * D + (i * 64 + lane) * 4); sdot += v[i][0] * r4[0] + v[i][1] * r4[1] + v[i][2] * r4[2] + v[i][3] * r4[3]; }
            sdot = wave_sum(sdot);
            if (lane == e) mine = sdot;
        }
        float mx = mine;
#pragma unroll
        for (int o = 8; o > 0; o >>= 1) mx = fmaxf(mx, __shfl_xor(mx, o, 64));
        const float pe = __expf(mine - mx);
        float den = pe;
#pragma unroll
        for (int o = 8; o > 0; o >>= 1) den += __shfl_xor(den, o, 64);
        if (lane < 16) AFF[(size_t)row * 16 + lane] = pe / den;
    }
}

__device__ void phase_topk(const Params& p, int l, unsigned char* lds) {
    unsigned* keys = (unsigned*)lds;
    unsigned* hist = keys + 4096;
    unsigned* misc = hist + 256;
    const int t = tid_(), lane = t & 63, w = t >> 6;
    const float* AFF = (const float*)(p.ws + WS_AFF);
    int* SLOT = (int*)(p.ws + WS_SLOT);
    int* EROW = (int*)(p.ws + WS_EROW);
    float* EGATE = (float*)(p.ws + WS_EGATE);
    const int nitems = l == 0 ? 128 : 64;
    for (int item = bid_(); item < nitems; item += gdim_()) {
        const int kind = item >> 6, b = (item >> 4) & 3, ex = item & 15;
        const int n = kind ? LC : SEQ, cap = n / 8, rowbase = kind ? NLAT + b * LC : b * SEQ;
        __syncthreads();
        for (int i = t; i < n; i += NT) keys[i] = __float_as_uint(AFF[(size_t)(rowbase + i) * 16 + ex]);
        unsigned prefix = 0u, mask = 0u; int kth = cap;
        for (int shift = 24; shift >= 0; shift -= 8) {
            __syncthreads();
            if (t < 256) hist[t] = 0u;
            __syncthreads();
            for (int i = t; i < n; i += NT) { const unsigned k = keys[i]; if ((k & mask) == prefix) atomicAdd(&hist[(k >> shift) & 255u], 1u); }
            __syncthreads();
            if (t < 256) {
                unsigned above = 0u;
                for (int d2 = t + 1; d2 < 256; ++d2) above += hist[d2];
                const unsigned here = hist[t];
                if ((int)above < kth && (int)(above + here) >= kth) { misc[0] = (unsigned)t; misc[1] = (unsigned)(kth - (int)above); }
            }
            __syncthreads();
            prefix |= misc[0] << shift; mask |= 255u << shift; kth = (int)misc[1];
        }
        const unsigned T = prefix; const int need_eq = kth;
        int cgt = 0, ceq = 0;
        const int base = t * 8;
        if (base < n) {
#pragma unroll
            for (int q = 0; q < 8; ++q) { const unsigned k = keys[base + q]; cgt += (k > T); ceq += (k == T); }
        }
        int packed = cgt | (ceq << 16);
        int incl = packed;
#pragma unroll
        for (int o = 1; o < 64; o <<= 1) { const int nb = __shfl_up(incl, o, 64); if (lane >= o) incl += nb; }
        __syncthreads();
        if (lane == 63) misc[8 + w] = (unsigned)incl;
        __syncthreads();
        int woff = 0, total = 0;
#pragma unroll
        for (int q = 0; q < 8; ++q) { const int v = (int)misc[8 + q]; if (q < w) woff += v; total += v; }
        const int excl = woff + incl - packed;
        int pgt = excl & 0xffff, peq = excl >> 16;
        const int tot_gt = total & 0xffff;
        const int sbase = kind ? 2048 + b * 32 : b * 512;
        if (base < n) {
#pragma unroll
            for (int q = 0; q < 8; ++q) {
                const unsigned k = keys[base + q];
                const int row = rowbase + base + q;
                int pos = -1;
                if (k > T) { pos = pgt; ++pgt; }
                else if (k == T) { if (peq < need_eq) pos = tot_gt + peq; ++peq; }
                if (pos >= 0) { const int sl = sbase + pos; EROW[ex * EPAD + sl] = row; EGATE[ex * EPAD + sl] = __uint_as_float(k); SLOT[(size_t)row * 16 + ex] = sl; }
                else SLOT[(size_t)row * 16 + ex] = -1;
            }
        }
    }
}

__device__ void phase_final(const Params& p, int l) {
    const int lane = tid_() & 63, w = tid_() >> 6;
    const int nrows = l == 0 ? NTOK : NLAT;
    const u16* YEXP = (const u16*)(p.ws + WS_YEXP);
    const int* SLOT = (const int*)(p.ws + WS_SLOT);
    const float* XL1 = (const float*)(p.ws + WS_XL1);
    float* XL2 = (float*)(p.ws + WS_XL2);
    u16* H = (u16*)(p.ws + WS_H);
    for (int row = bid_() * 8 + w; row < nrows; row += gdim_() * 8) {
        f32x4 v[8];
#pragma unroll
        for (int i = 0; i < 8; ++i) v[i] = (f32x4){0.f, 0.f, 0.f, 0.f};
        for (int e = 0; e < NEXP; ++e) {
            const int sl = SLOT[(size_t)row * 16 + e];
            if (sl >= 0) {
                const u16* yp = YEXP + ((size_t)e * EPAD + sl) * D;
#pragma unroll
                for (int i = 0; i < 8; ++i) { const u32x2 q = *reinterpret_cast<const u32x2*>(yp + (i * 64 + lane) * 4); v[i][0] += bf_lo(q[0]); v[i][1] += bf_hi(q[0]); v[i][2] += bf_lo(q[1]); v[i][3] += bf_hi(q[1]); }
            }
        }
        float ss = 0.f;
#pragma unroll
        for (int i = 0; i < 8; ++i) ss += v[i][0] * v[i][0] + v[i][1] * v[i][1] + v[i][2] * v[i][2] + v[i][3] * v[i][3];
        ss = wave_sum(ss);
        const float rstd = rsqrtf(ss * (1.f / D) + 1e-6f);
        const float* g2 = mod_ptr(p, l, row, 5);
        const float* nw = p.norm_ffn_post + (size_t)l * D;
        float* dst = l == 0 ? XL2 + (size_t)row * D : p.out + (size_t)row * D;
        float ss2 = 0.f;
#pragma unroll
        for (int i = 0; i < 8; ++i) {
            const int col = (i * 64 + lane) * 4;
            const f32x4 x4 = *reinterpret_cast<const f32x4*>(XL1 + (size_t)row * D + col), w4 = *reinterpret_cast<const f32x4*>(nw + col), g4 = *reinterpret_cast<const f32x4*>(g2 + col);
            const f32x4 x2 = x4 + g4 * (v[i] * rstd * w4);
            *reinterpret_cast<f32x4*>(dst + col) = x2;
            v[i] = x2; ss2 += x2[0] * x2[0] + x2[1] * x2[1] + x2[2] * x2[2] + x2[3] * x2[3];
        }
        if (l == 0) {
            ss2 = wave_sum(ss2);
            const float rstd2 = rsqrtf(ss2 * (1.f / D) + 1e-6f);
            const float* sh = mod_ptr(p, 1, row, 0); const float* sc = mod_ptr(p, 1, row, 1);
            const float* nw1 = p.norm_mix_pre + D;
#pragma unroll
            for (int i = 0; i < 8; ++i) {
                const int col = (i * 64 + lane) * 4;
                const f32x4 w4 = *reinterpret_cast<const f32x4*>(nw1 + col), s4 = *reinterpret_cast<const f32x4*>(sc + col), h4 = *reinterpret_cast<const f32x4*>(sh + col);
                const f32x4 o = v[i] * rstd2 * w4 * (s4 + 1.f) + h4;
                u32x2 pk = {pk_bf16(o[0], o[1]), pk_bf16(o[2], o[3])};
                *reinterpret_cast<u32x2*>(H + (size_t)row * D + col) = pk;
            }
        }
    }
}

__global__ void __launch_bounds__(NT, 2) fwd_kernel(Params p) {
    extern __shared__ __attribute__((aligned(16))) unsigned char lds[];
    unsigned char* wlds = lds + 16;
    if (threadIdx.x == 0) *reinterpret_cast<uint4*>(lds) = make_uint4(0u, 0u, 0u, 0u);
    __syncthreads();
    XcdBarrier bar = xcd_barrier_post((unsigned*)(p.ws + WS_BAR), (volatile LAS unsigned*)lds);
#ifndef PH_MASK
#define PH_MASK 0xFFFFFFFFu
#endif
#ifndef PROBE_REP_MASK
#define PROBE_REP_MASK 0u
#endif
#define PHASE(id, body) do { if (((PH_MASK >> ((id) % 32)) & 1u) && p.ph_lo <= (id) && (id) < p.ph_hi) { \
    for (int _r = 0; _r < ((((unsigned)PROBE_REP_MASK >> ((id) % 32)) & 1u) ? 2 : 1); ++_r) { body; if ((id) + 1 < p.ph_hi || _r == 0) { if ((id) + 1 < p.ph_hi) xcd_barrier(bar); } } } } while (0)
    PHASE(0, { phase_mod(p, wlds); phase_convert_dense(p, wlds); });
    PHASE(1, { phase_norm_mod(p, 0); lru_prep_weights(p); });
#pragma unroll
    for (int l = 0; l < 2; ++l) {
        const int pb = 2 + 10 * l;
        {
            EpiDesc e; e.ob = (u16*)(p.ws + WS_P); e.of = nullptr; e.ldo = l == 0 ? AB_IN : CD_IN; e.gates = l == 0 ? (float*)(p.ws + WS_G) : nullptr; e.rscale = nullptr;
            PHASE(pb + 0, phase_gemm_dense<EPI_BF16>(p, (const u16*)(p.ws + WS_H), NTOK, (const u16*)(p.ws + (l == 0 ? WS_WT_ABIN : WS_WT_CDIN)), l == 0 ? AB_IN : CD_IN, e, wlds));
        }
        if (l == 0) {
            PHASE(pb + 1, phase_mlstm(p, wlds));
            PHASE(pb + 2, phase_l0_stage2(p, wlds));
        } else {
            PHASE(pb + 1, phase_l1_stage1(p, wlds));
            PHASE(pb + 2, phase_l1_stage2(p, wlds));
            PHASE(pb + 3, phase_l1_stage3(p, wlds));
        }
        {
            EpiDesc e; e.ob = nullptr; e.of = (float*)(p.ws + WS_Y); e.ldo = D; e.gates = nullptr; e.rscale = nullptr;
            PHASE(pb + 4, phase_gemm_dense<EPI_F32>(p, (const u16*)(p.ws + WS_YIN), l == 0 ? NTOK : NLAT, (const u16*)(p.ws + (l == 0 ? WS_WT_ABOUT : WS_WT_CDOUT)), D, e, wlds));
        }
        PHASE(pb + 5, phase_rowpass_mid(p, l, wlds));
        PHASE(pb + 6, { phase_topk(p, l, wlds); phase_convert_moe(p, l, wlds); });
        PHASE(pb + 7, phase_moe_a(p, l, wlds));
        PHASE(pb + 8, phase_moe_b(p, l, wlds));
        PHASE(pb + 9, phase_final(p, l));
    }
}


#ifdef DBG_STOP
__global__ void dbg_digest(const unsigned char* ws, size_t off, int kind, size_t nelem, float* out, size_t nout) {
    for (size_t i = (size_t)blockIdx.x * blockDim.x + threadIdx.x; i < nout; i += (size_t)gridDim.x * blockDim.x) {
        float v = 0.f;
        for (size_t j = i; j < nelem; j += nout) {
            if (kind == 0) v += bf2f(((const u16*)(ws + off))[j]);
            else if (kind == 1) v += ((const float*)(ws + off))[j];
            else v += (float)((const int*)(ws + off))[j];
        }
        out[i] = v;
    }
}
#endif
extern "C" void kernel_launch(void* const* d_in, const int* in_sizes, int n_in, void* d_out, int out_size, void* d_ws, size_t ws_size, hipStream_t stream) {
    static int grid = 0;
    if (grid == 0) {
        if (n_in != 27 || ws_size < WS_END) { fprintf(stderr, "kernel_launch: unexpected n_in %d / ws %zu (need %zu)\n", n_in, ws_size, (size_t)WS_END); grid = -1; return; }
        int dev = 0, cus = 0, per_cu = 0;
        hipGetDevice(&dev);
        hipDeviceGetAttribute(&cus, hipDeviceAttributeMultiprocessorCount, dev);
        if (hipFuncSetAttribute((const void*)fwd_kernel, hipFuncAttributeMaxDynamicSharedMemorySize, LDS_BYTES) != hipSuccess) { fprintf(stderr, "kernel_launch: hipFuncSetAttribute failed\n"); grid = -1; return; }
        hipOccupancyMaxActiveBlocksPerMultiprocessor(&per_cu, (const void*)fwd_kernel, NT, LDS_BYTES);
        (void)hipGetLastError();
        if (per_cu < 1) fprintf(stderr, "kernel_launch: occupancy query reports %d blocks per CU\n", per_cu);
        grid = cus > 0 ? cus : 256;
    }
    if (grid < 0) return;
    hipMemsetAsync((char*)d_ws + WS_BAR, 0, XCD_BAR_WORDS * sizeof(unsigned), stream);
    Params p; memset(&p, 0, sizeof(p));
    const float** f = (const float**)&p;
    for (int i = 0; i < 27; ++i) f[i] = (const float*)d_in[i];
    p.out = (float*)d_out; p.ws = (unsigned char*)d_ws;
#if N_LAUNCH_MODE == 1
    p.ph_lo = 0; p.ph_hi = NPH;
    hipLaunchKernelGGL(fwd_kernel, dim3(grid), dim3(NT), LDS_BYTES, stream, p);
#else
#ifdef DBG_STOP
    for (int ph = 0; ph <= DBG_STOP; ++ph) { p.ph_lo = ph; p.ph_hi = ph + 1; hipLaunchKernelGGL(fwd_kernel, dim3(grid), dim3(NT), LDS_BYTES, stream, p); }
    hipLaunchKernelGGL(dbg_digest, dim3(2048), dim3(256), 0, stream, (const unsigned char*)d_ws, (size_t)DBG_OFF, (int)DBG_KIND, (size_t)DBG_NELEM, (float*)d_out, (size_t)out_size);
#else
    for (int ph = 0; ph < NPH; ++ph) { p.ph_lo = ph; p.ph_hi = ph + 1; hipLaunchKernelGGL(fwd_kernel, dim3(grid), dim3(NT), LDS_BYTES, stream, p); }
#endif
#endif
}
```

```cpp
#include <hip/hip_runtime.h>
#include <stdint.h>
#include <stdio.h>
#include <string.h>

#ifndef N_LAUNCH_MODE
#define N_LAUNCH_MODE 1
#endif

typedef unsigned short u16;
typedef short bf16x8 __attribute__((ext_vector_type(8)));
typedef float f32x4 __attribute__((ext_vector_type(4)));
typedef unsigned u32x4 __attribute__((ext_vector_type(4)));
typedef unsigned u32x2 __attribute__((ext_vector_type(2)));

#define NT 512
constexpr int D = 2048, BATCH = 4, SEQ = 4096, LC = 256;
constexpr int NLAT = BATCH * SEQ, NCTX = BATCH * LC, NTOK = NLAT + NCTX;
constexpr int AB_IN = 7184, CD_IN = 3584;
constexpr int NEXP = 16, FF = 2048, EPAD = 2304;
constexpr int NPH = 22;
constexpr int LDS_BYTES = 150 * 1024;

constexpr size_t al256(size_t x) { return (x + 255) & ~(size_t)255; }
constexpr size_t WS_BAR = 0;
constexpr size_t WS_MOD = 16384;
constexpr size_t WS_XL1 = al256(WS_MOD + 2 * 5 * 12288 * 4);
constexpr size_t WS_XL2 = al256(WS_XL1 + (size_t)NTOK * D * 4);
constexpr size_t WS_H = al256(WS_XL2 + (size_t)NTOK * D * 4);
constexpr size_t WS_P = al256(WS_H + (size_t)NTOK * D * 2);
constexpr size_t WS_G = al256(WS_P + (size_t)NTOK * AB_IN * 2);
constexpr size_t WS_HM = al256(WS_G + (size_t)NTOK * 16 * 4);
constexpr size_t WS_YIN = al256(WS_HM + (size_t)2 * NTOK * 1024 * 2);
constexpr size_t WS_Y = al256(WS_YIN + (size_t)NTOK * D * 2);
constexpr size_t WS_AFF = al256(WS_Y + (size_t)NTOK * D * 4);
constexpr size_t WS_SLOT = al256(WS_AFF + (size_t)NTOK * 16 * 4);
constexpr size_t WS_EROW = al256(WS_SLOT + (size_t)NTOK * 16 * 4);
constexpr size_t WS_EGATE = al256(WS_EROW + (size_t)NEXP * EPAD * 4);
constexpr size_t WS_ACT = al256(WS_EGATE + (size_t)NEXP * EPAD * 4);
constexpr size_t WS_YEXP = al256(WS_ACT + (size_t)NEXP * EPAD * FF * 2);
constexpr size_t WS_LRUS = al256(WS_YEXP + (size_t)NEXP * EPAD * D * 2);
constexpr size_t WS_LRUW = al256(WS_LRUS + (size_t)2 * 2 * 4 * 68 * 1024 * 4);
constexpr size_t WS_WT_ABIN = al256(WS_LRUW + (size_t)32 * 128 * 128 * 2);
constexpr size_t WS_WT_ABOUT = al256(WS_WT_ABIN + (size_t)AB_IN * D * 2);
constexpr size_t WS_WT_CDIN = al256(WS_WT_ABOUT + (size_t)D * D * 2);
constexpr size_t WS_WT_CDOUT = al256(WS_WT_CDIN + (size_t)CD_IN * D * 2);
constexpr size_t WS_WT_W1 = al256(WS_WT_CDOUT + (size_t)D * D * 2);
constexpr size_t WS_WT_W3 = al256(WS_WT_W1 + (size_t)NEXP * D * FF * 2);
constexpr size_t WS_WT_W2 = al256(WS_WT_W3 + (size_t)NEXP * D * FF * 2);
constexpr size_t WS_END = al256(WS_WT_W2 + (size_t)NEXP * D * FF * 2);

struct Params {
    const float *x, *c, *ctx, *c_ctx, *ada_w, *ada_b, *norm_mix_pre, *norm_mix_post, *norm_ffn_pre, *norm_ffn_post;
    const float *ab_w_in, *ab_w_out, *mlstm_gate_b, *mlstm_norm, *na_rpb;
    const float *cd_w_in, *cd_w_out, *gqa_sink, *lru_conv_w, *lru_conv_b, *lru_gate_w, *lru_gate_b, *lru_lambda;
    const float *moe_router, *moe_w1, *moe_w3, *moe_w2;
    float* out;
    unsigned char* ws;
    int ph_lo, ph_hi;
};

#define XB_TMO      128
#define XB_XCNT(j)  (256  + 64 * (j))
#define XB_XSUB(j)  (1280 + 64 * (j))
#define XB_XGEN(j)  (2304 + 64 * (j))
#define XB_TOP      3328
#define XB_TOPGEN   3392
#define XCD_BAR_WORDS 3456
#define XB_SPIN_CAP (1u << 22)
#define LAS __attribute__((address_space(3)))

__device__ __forceinline__ unsigned xb_ld(unsigned* p)              { return __hip_atomic_load(p, __ATOMIC_RELAXED, __HIP_MEMORY_SCOPE_AGENT); }
__device__ __forceinline__ unsigned xb_add(unsigned* p, unsigned v) { return __hip_atomic_fetch_add(p, v, __ATOMIC_RELAXED, __HIP_MEMORY_SCOPE_AGENT); }
__device__ __forceinline__ unsigned xb_xcc_id() { return (unsigned)__builtin_amdgcn_s_getreg((3 << 11) | 20) & 0xFu; }
#define XB_SPIN(cond, bar) do { unsigned _sp = 0; while (cond) { __builtin_amdgcn_s_sleep(1); \
    if ((++_sp & 255u) == 0u) { if (xb_ld(&(bar)[XB_TMO])) break; if (_sp > XB_SPIN_CAP) { atomicAdd(&(bar)[XB_TMO], 1u); break; } } } } while (0)

struct XcdBarrier {
    unsigned* bar; unsigned x;
    volatile LAS unsigned* st;
};
__device__ __forceinline__ XcdBarrier xcd_barrier_post(unsigned* bar, volatile LAS unsigned* st) {
    XcdBarrier b; b.bar = bar; b.x = xb_xcc_id(); b.st = st;
    if (threadIdx.x == 0) (void)xb_add(&bar[XB_XCNT(b.x)], 1u);
    return b;
}
__device__ __forceinline__ void xcd_barrier_complete(unsigned* bar, unsigned x, unsigned& nloc, unsigned& nx) {
    const unsigned G = gridDim.x * gridDim.y * gridDim.z;
    unsigned sum, cnt, mine, sp = 0u;
    for (;;) {
        sum = 0u; cnt = 0u; mine = 0u;
#pragma unroll
        for (unsigned j = 0; j < 16; ++j) { const unsigned c = xb_ld(&bar[XB_XCNT(j)]); sum += c; cnt += (c > 0u) ? 1u : 0u; mine = (j == x) ? c : mine; }
        if (sum == G) break;
        __builtin_amdgcn_s_sleep(1);
        if ((++sp & 255u) == 0u) { if (xb_ld(&bar[XB_TMO])) break; if (sp > XB_SPIN_CAP) { atomicAdd(&bar[XB_TMO], 1u); break; } }
    }
    nloc = mine > 0u ? mine : 1u; nx = cnt > 0u ? cnt : 1u;
}
__device__ __forceinline__ void xcd_barrier(const XcdBarrier& b) {
    asm volatile("s_waitcnt vmcnt(0)" ::: "memory");
    __syncthreads();
    if (threadIdx.x == 0) {
        unsigned* bar = b.bar;
        __builtin_amdgcn_s_waitcnt(0);
        unsigned nloc = b.st[0], nx = b.st[1];
        if (nloc == 0u) { xcd_barrier_complete(bar, b.x, nloc, nx); b.st[0] = nloc; b.st[1] = nx; }
        const unsigned old = xb_add(&bar[XB_XSUB(b.x)], 1u);
        const unsigned gen = old / nloc;
        if (old + 1u == (gen + 1u) * nloc) {
            __builtin_amdgcn_fence(__ATOMIC_RELEASE, "agent");
            asm volatile("s_waitcnt vmcnt(0)" ::: "memory");
            const unsigned og = xb_add(&bar[XB_TOP], 1u);
            const unsigned tg = og / nx;
            if (og + 1u == (tg + 1u) * nx) xb_add(&bar[XB_TOPGEN], 1u);
            else XB_SPIN(xb_ld(&bar[XB_TOPGEN]) == tg, bar);
            __builtin_amdgcn_fence(__ATOMIC_ACQUIRE, "agent");
            xb_add(&bar[XB_XGEN(b.x)], 1u);
            asm volatile("s_waitcnt vmcnt(0)" ::: "memory");
        } else {
            XB_SPIN(xb_ld(&bar[XB_XGEN(b.x)]) == gen, bar);
            __builtin_amdgcn_fence(__ATOMIC_ACQUIRE, "agent");
            asm volatile("s_waitcnt vmcnt(0)" ::: "memory");
        }
    }
    __syncthreads();
}

typedef float f32x2_t __attribute__((ext_vector_type(2)));
typedef __bf16 bf16x2_t __attribute__((ext_vector_type(2)));
__device__ __forceinline__ unsigned pk_bf16(float lo, float hi) { f32x2_t v = {lo, hi}; return __builtin_bit_cast(unsigned, __builtin_convertvector(v, bf16x2_t)); }
__device__ __forceinline__ float bf_lo(unsigned u) { return __uint_as_float(u << 16); }
__device__ __forceinline__ float bf_hi(unsigned u) { return __uint_as_float(u & 0xffff0000u); }
__device__ __forceinline__ float bf2f(u16 v) { return __uint_as_float(((unsigned)v) << 16); }
__device__ __forceinline__ u16 f2bf(float f) { return (u16)(pk_bf16(f, 0.f) & 0xffffu); }
__device__ __forceinline__ float wave_sum(float v) {
#pragma unroll
    for (int o = 32; o > 0; o >>= 1) v += __shfl_xor(v, o, 64);
    return v;
}
__device__ __forceinline__ int tid_() { int t = threadIdx.x; asm volatile("" : "+v"(t)); return t; }
__device__ __forceinline__ int bid_() { int b = blockIdx.x; asm volatile("" : "+s"(b)); return b; }
__device__ __forceinline__ int gdim_() { int b = gridDim.x; asm volatile("" : "+s"(b)); return b; }
__device__ __forceinline__ float sigmoidf_(float x) { return 1.f / (1.f + __expf(-x)); }
__device__ __forceinline__ f32x4 mfma16(bf16x8 a, bf16x8 b, f32x4 c) { return __builtin_amdgcn_mfma_f32_16x16x32_bf16(a, b, c, 0, 0, 0); }
__device__ __forceinline__ bf16x8 ld_frag_g(const u16* p) { return *reinterpret_cast<const bf16x8*>(p); }
__device__ __forceinline__ bf16x8 ld_frag_s(const u16* p) { return *reinterpret_cast<const bf16x8*>(p); }
__device__ __forceinline__ bf16x8 mk_frag(unsigned a, unsigned b, unsigned c, unsigned d) { u32x4 v = {a, b, c, d}; return __builtin_bit_cast(bf16x8, v); }

__device__ __forceinline__ const float* xin_row(const Params& p, int l, int row) {
    if (l == 0) return row < NLAT ? p.x + (size_t)row * D : p.ctx + (size_t)(row - NLAT) * D;
    return (const float*)(p.ws + WS_XL2) + (size_t)row * D;
}
__device__ __forceinline__ const float* mod_ptr(const Params& p, int l, int row, int chunk) {
    const int bb = row < NLAT ? (row >> 12) : 4;
    return (const float*)(p.ws + WS_MOD) + ((size_t)(l * 5 + bb) * 6 + chunk) * D;
}

__device__ void phase_mod(const Params& p, unsigned char* lds_raw) {
    float* scond = (float*)lds_raw;
    float* red = scond + 5 * D;
    const int t = tid_();
    for (int i = t; i < 5 * D; i += NT) { const int r = i >> 11, k = i & 2047; const float v = r < 4 ? p.c[r * D + k] : p.c_ctx[k]; scond[i] = v / (1.f + __expf(-v)); }
    __syncthreads();
    float* mod = (float*)(p.ws + WS_MOD);
    for (int item = bid_(); item < 192; item += gdim_()) {
        const int l = item / 96, col0 = (item % 96) * 128;
        const int kg = t >> 5, cl = (t & 31) * 4;
        f32x4 acc[5];
#pragma unroll
        for (int r = 0; r < 5; ++r) acc[r] = (f32x4){0.f, 0.f, 0.f, 0.f};
        const float* wp = p.ada_w + ((size_t)l * D + kg * 128) * (6 * D) + col0 + cl;
#pragma unroll 8
        for (int kk = 0; kk < 128; ++kk) {
            const f32x4 w = *reinterpret_cast<const f32x4*>(wp + (size_t)kk * (6 * D));
#pragma unroll
            for (int r = 0; r < 5; ++r) { const float s = scond[r * D + kg * 128 + kk]; acc[r] += w * s; }
        }
#pragma unroll
        for (int r = 0; r < 5; ++r) *reinterpret_cast<f32x4*>(red + (kg * 5 + r) * 128 + cl) = acc[r];
        __syncthreads();
        for (int o = t; o < 640; o += NT) {
            const int r = o >> 7, cc = o & 127;
            float s = p.ada_b[l * 6 * D + col0 + cc];
#pragma unroll
            for (int g = 0; g < 16; ++g) s += red[(g * 5 + r) * 128 + cc];
            mod[(size_t)(l * 5 + r) * 6 * D + col0 + cc] = s;
        }
        __syncthreads();
    }
}

__device__ void phase_norm_mod(const Params& p, int l) {
    const int lane = tid_() & 63, w = tid_() >> 6;
    u16* H = (u16*)(p.ws + WS_H);
    for (int row = bid_() * 8 + w; row < NTOK; row += gdim_() * 8) {
        const float* xr = xin_row(p, l, row);
        f32x4 v[8]; float ss = 0.f;
#pragma unroll
        for (int i = 0; i < 8; ++i) { v[i] = *reinterpret_cast<const f32x4*>(xr + (i * 64 + lane) * 4); ss += v[i][0] * v[i][0] + v[i][1] * v[i][1] + v[i][2] * v[i][2] + v[i][3] * v[i][3]; }
        ss = wave_sum(ss);
        const float rstd = rsqrtf(ss * (1.f / D) + 1e-6f);
        const float* sh = mod_ptr(p, l, row, 0); const float* sc = mod_ptr(p, l, row, 1);
        const float* nw = p.norm_mix_pre + (size_t)l * D;
#pragma unroll
        for (int i = 0; i < 8; ++i) {
            const int col = (i * 64 + lane) * 4;
            const f32x4 w4 = *reinterpret_cast<const f32x4*>(nw + col), s4 = *reinterpret_cast<const f32x4*>(sc + col), h4 = *reinterpret_cast<const f32x4*>(sh + col);
            f32x4 o = v[i] * rstd * w4 * (s4 + 1.f) + h4;
            u32x2 pk = {pk_bf16(o[0], o[1]), pk_bf16(o[2], o[3])};
            *reinterpret_cast<u32x2*>(H + (size_t)row * D + col) = pk;
        }
    }
}

__device__ __forceinline__ void convert_item(const float* W, int N, u16* Wt, int kb, int nb, unsigned char* lds) {
    const int t = tid_(), lane = t & 63, w = t >> 6;
    const int n4 = lane * 4, k0 = kb * 64 + w * 8, n0 = nb * 256;
    int col = n0 + n4; if (col > N - 4) col = N - 4;
    f32x4 r8[8];
#pragma unroll
    for (int j = 0; j < 8; ++j) r8[j] = *reinterpret_cast<const f32x4*>(W + (size_t)(k0 + j) * N + col);
    __syncthreads();
#pragma unroll
    for (int jj = 0; jj < 4; ++jj) {
        u32x4 v = {pk_bf16(r8[0][jj], r8[1][jj]), pk_bf16(r8[2][jj], r8[3][jj]), pk_bf16(r8[4][jj], r8[5][jj]), pk_bf16(r8[6][jj], r8[7][jj])};
        const int r = n4 + jj;
        *reinterpret_cast<u32x4*>(lds + r * 128 + ((w ^ ((r >> 2) & 7)) << 4)) = v;
    }
    __syncthreads();
    const int c = t & 7;
#pragma unroll
    for (int i = 0; i < 4; ++i) {
        const int r = (t >> 3) + 64 * i;
        if (n0 + r < N) {
            const u32x4 v = *reinterpret_cast<const u32x4*>(lds + r * 128 + ((c ^ ((r >> 2) & 7)) << 4));
            *reinterpret_cast<u32x4*>(Wt + (size_t)(n0 + r) * 2048 + kb * 64 + c * 8) = v;
        }
    }
}
__device__ void convert_matrix_items(const float* W, int N, u16* Wt, int first, int count, unsigned char* lds) {
    const int nnb = (N + 255) / 256;
    for (int it = first; it < first + count; ++it) convert_item(W, N, Wt, it / nnb, it % nnb, lds);
}
__device__ void phase_convert_dense(const Params& p, unsigned char* lds) {
    for (int item = bid_(); item < 1888; item += gdim_()) {
        if (item < 928) convert_item(p.ab_w_in, AB_IN, (u16*)(p.ws + WS_WT_ABIN), item / 29, item % 29, lds);
        else if (item < 1184) { const int it = item - 928; convert_item(p.ab_w_out, D, (u16*)(p.ws + WS_WT_ABOUT), it / 8, it % 8, lds); }
        else if (item < 1632) { const int it = item - 1184; convert_item(p.cd_w_in, CD_IN, (u16*)(p.ws + WS_WT_CDIN), it / 14, it % 14, lds); }
        else { const int it = item - 1632; convert_item(p.cd_w_out, D, (u16*)(p.ws + WS_WT_CDOUT), it / 8, it % 8, lds); }
    }
}
__device__ void phase_convert_moe(const Params& p, int l, unsigned char* lds) {
    for (int item = bid_(); item < 3 * NEXP * 256; item += gdim_()) {
        const int which = item / (NEXP * 256), r = item % (NEXP * 256), ex = r >> 8, it = r & 255;
        const float* src = (which == 0 ? p.moe_w1 : (which == 1 ? p.moe_w3 : p.moe_w2)) + (size_t)(l * NEXP + ex) * D * FF;
        u16* dst = (u16*)(p.ws + (which == 0 ? WS_WT_W1 : (which == 1 ? WS_WT_W3 : WS_WT_W2))) + (size_t)ex * D * FF;
        convert_item(src, 2048, dst, it >> 3, it & 7, lds);
    }
}

struct GemmDesc {
    const u16* A; int lda; const int* arow; int mvalid; int m0;
    const u16* B0; const u16* B1; int n0; int ncols;
    int K;
};
enum { EPI_BF16 = 0, EPI_F32 = 1, EPI_SWIGLU = 2, EPI_SCALE = 3 };
struct EpiDesc { u16* ob; float* of; int ldo; float* gates; const float* rscale; };
constexpr int GEMM_BUF = 65536, GEMM_BOFF = 32768;

template <int EPI>
__device__ __forceinline__ void gemm_tile(const GemmDesc& g, const EpiDesc& e, unsigned char* lds) {
    const int t = tid_(), lane = t & 63, w = t >> 6;
    const int wr = w >> 2, wc = w & 3, fr = lane & 15, fq = lane >> 4;
    const int ac = t & 7, ar = t >> 3;
    const int kofs = (ac ^ ((ar >> 1) & 7)) << 3;
    unsigned ap[4], bpo[4];
#pragma unroll
    for (int i = 0; i < 4; ++i) {
        int r = g.m0 + ar + 64 * i; if (r >= g.mvalid) r = g.mvalid - 1;
        const int src = g.arow ? g.arow[r] : r;
        ap[i] = (unsigned)src * (unsigned)g.lda + kofs;
        const int np = ar + 64 * i;
        if (EPI == EPI_SWIGLU) {
            const int which = (np >> 5) & 1, ffl = (np >> 6) * 32 + (np & 31);
            bpo[i] = (unsigned)(g.n0 + ffl) * (unsigned)g.K + kofs + (which ? 0x80000000u : 0u);
        } else {
            int n = g.n0 + np; if (n >= g.ncols) n = g.ncols - 1;
            bpo[i] = (unsigned)n * (unsigned)g.K + kofs;
        }
    }
    const int d_off = t * 16;
    const int s0 = (fr >> 1) & 7;
    const int a_rd0 = wr * 16384 + fr * 128 + ((fq ^ s0) << 4), a_rd1 = a_rd0 ^ 64;
    const int b_rd0 = GEMM_BOFF + wc * 8192 + fr * 128 + ((fq ^ s0) << 4), b_rd1 = b_rd0 ^ 64;

    f32x4 acc[8][4];
#pragma unroll
    for (int i = 0; i < 8; ++i)
#pragma unroll
        for (int j = 0; j < 4; ++j) acc[i][j] = (f32x4){0.f, 0.f, 0.f, 0.f};

    const int nk = g.K >> 6;
#define G_DMA(BUF, KT) do { const unsigned _k = (unsigned)(KT) << 6; \
    _Pragma("unroll") for (int i = 0; i < 4; ++i) __builtin_amdgcn_global_load_lds((const unsigned*)(g.A + (ap[i] + _k)), (unsigned*)((BUF) + d_off + i * 8192), 16, 0, 0); \
    _Pragma("unroll") for (int i = 0; i < 4; ++i) { \
        const u16* _b = (EPI == EPI_SWIGLU && (bpo[i] & 0x80000000u)) ? g.B1 : g.B0; \
        __builtin_amdgcn_global_load_lds((const unsigned*)(_b + ((bpo[i] & 0x7fffffffu) + _k)), (unsigned*)((BUF) + GEMM_BOFF + d_off + i * 8192), 16, 0, 0); } } while (0)
    G_DMA(lds, 0);
    for (int kt = 0; kt < nk; ++kt) {
        unsigned char* buf = lds + (kt & 1) * GEMM_BUF;
        asm volatile("s_waitcnt vmcnt(0)" ::: "memory");
        __syncthreads();
        if (kt + 1 < nk) G_DMA(lds + ((kt + 1) & 1) * GEMM_BUF, kt + 1);
#define RD_A(KK, MI) (*reinterpret_cast<const bf16x8*>(buf + (((KK) ? a_rd1 : a_rd0) + (MI) * 2048)))
#define RD_B(KK, NI) (*reinterpret_cast<const bf16x8*>(buf + (((KK) ? b_rd1 : b_rd0) + (NI) * 2048)))
        bf16x8 bq[2][4], aq[2][2];
#pragma unroll
        for (int ni = 0; ni < 4; ++ni) bq[0][ni] = RD_B(0, ni);
        aq[0][0] = RD_A(0, 0); aq[0][1] = RD_A(0, 1);
#define G_STEP(ST) do { \
        constexpr int kk = (ST) >> 2, pr = (ST) & 3, cur = (ST) & 1, nxt = cur ^ 1, nkk = ((ST) + 1) >> 2, npr = ((ST) + 1) & 3; \
        if ((ST) < 7) { \
            if (npr == 0) { _Pragma("unroll") for (int ni = 0; ni < 4; ++ni) bq[nkk & 1][ni] = RD_B(nkk & 1, ni); } \
            aq[nxt][0] = RD_A(nkk & 1, npr * 2); aq[nxt][1] = RD_A(nkk & 1, npr * 2 + 1); } \
        _Pragma("unroll") for (int h2 = 0; h2 < 2; ++h2) \
            _Pragma("unroll") for (int ni = 0; ni < 4; ++ni) acc[pr * 2 + h2][ni] = mfma16(bq[kk][ni], aq[cur][h2], acc[pr * 2 + h2][ni]); \
        __builtin_amdgcn_sched_group_barrier(0x100, ((ST) < 7) ? (npr == 0 ? 6 : 2) : 0, 0); \
        __builtin_amdgcn_sched_group_barrier(0x008, 8, 0); } while (0)
        G_STEP(0); G_STEP(1); G_STEP(2); G_STEP(3); G_STEP(4); G_STEP(5); G_STEP(6); G_STEP(7);
#undef G_STEP
#undef RD_A
#undef RD_B
    }
#undef G_DMA
#pragma unroll
    for (int mi = 0; mi < 8; ++mi) {
        const int row = g.m0 + wr * 128 + mi * 16 + fr;
        if (row < g.mvalid) {
            if (EPI == EPI_BF16) {
#pragma unroll
                for (int ni = 0; ni < 4; ++ni) {
                    const int col = g.n0 + wc * 64 + ni * 16 + 4 * fq;
                    if (col < g.ncols) {
                        const f32x4 v = acc[mi][ni];
                        u32x2 pk = {pk_bf16(v[0], v[1]), pk_bf16(v[2], v[3])};
                        *reinterpret_cast<u32x2*>(e.ob + (size_t)row * e.ldo + col) = pk;
                        if (e.gates && col >= 4096 && col < 4112) *reinterpret_cast<f32x4*>(e.gates + (size_t)row * 16 + (col - 4096)) = v;
                    }
                }
            } else if (EPI == EPI_F32) {
#pragma unroll
                for (int ni = 0; ni < 4; ++ni) {
                    const int col = g.n0 + wc * 64 + ni * 16 + 4 * fq;
                    *reinterpret_cast<f32x4*>(e.of + (size_t)row * e.ldo + col) = acc[mi][ni];
                }
            } else if (EPI == EPI_SWIGLU) {
#pragma unroll
                for (int ni = 0; ni < 2; ++ni) {
                    const int col = g.n0 + wc * 32 + ni * 16 + 4 * fq;
                    const f32x4 u = acc[mi][ni], v = acc[mi][ni + 2];
                    f32x4 a;
#pragma unroll
                    for (int q = 0; q < 4; ++q) a[q] = u[q] / (1.f + __expf(-u[q])) * v[q];
                    u32x2 pk = {pk_bf16(a[0], a[1]), pk_bf16(a[2], a[3])};
                    *reinterpret_cast<u32x2*>(e.ob + (size_t)row * e.ldo + col) = pk;
                }
            } else {
                const float sc = e.rscale[row];
#pragma unroll
                for (int ni = 0; ni < 4; ++ni) {
                    const int col = g.n0 + wc * 64 + ni * 16 + 4 * fq;
                    const f32x4 v = acc[mi][ni] * sc;
                    u32x2 pk = {pk_bf16(v[0], v[1]), pk_bf16(v[2], v[3])};
                    *reinterpret_cast<u32x2*>(e.ob + (size_t)row * e.ldo + col) = pk;
                }
            }
        }
    }
    __syncthreads();
}

template <int EPI>
__device__ void phase_gemm_dense(const Params& p, const u16* A, int M, const u16* Wt, int N, EpiDesc e, unsigned char* lds) {
    const int nM = M / 256, nN = (N + 255) / 256, L = nM * nN;
    const int xcd = bid_() & 7, slot = bid_() >> 3, nslot = gdim_() >> 3;
    const int base = (int)(((long)L * xcd) >> 3), cnt = (int)(((long)L * (xcd + 1)) >> 3) - base;
    const int G8 = nM >> 3, rem = nM & 7;
    for (int k = slot; k < cnt; k += nslot) {
        const int idx = base + k;
        int pn, pm;
        if (idx < G8 * 8 * nN) { const int gq = idx / (8 * nN), r = idx % (8 * nN); pn = r >> 3; pm = gq * 8 + (r & 7); }
        else { const int r = idx - G8 * 8 * nN; pn = r / rem; pm = G8 * 8 + r % rem; }
        GemmDesc g; g.A = A; g.lda = D; g.arow = nullptr; g.mvalid = M; g.m0 = pm * 256;
        g.B0 = Wt; g.B1 = nullptr; g.n0 = pn * 256; g.ncols = N; g.K = D;
        gemm_tile<EPI>(g, e, lds);
    }
}

__device__ void phase_moe_a(const Params& p, int l, unsigned char* lds) {
    const int mvalid = l == 0 ? 2176 : 2048, nM = l == 0 ? 9 : 8;
    const int per_e = nM * 16;
    const int xcd = bid_() & 7, slot = bid_() >> 3, nslot = gdim_() >> 3;
    for (int k = slot; k < 2 * per_e; k += nslot) {
        const int tile = xcd * 2 * per_e + k;
        const int ex = tile / per_e, r = tile % per_e, pn = r / nM, pm = r % nM;
        GemmDesc g; g.A = (const u16*)(p.ws + WS_H); g.lda = D; g.arow = (const int*)(p.ws + WS_EROW) + ex * EPAD; g.mvalid = mvalid; g.m0 = pm * 256;
        g.B0 = (const u16*)(p.ws + WS_WT_W1) + (size_t)ex * D * FF; g.B1 = (const u16*)(p.ws + WS_WT_W3) + (size_t)ex * D * FF; g.n0 = pn * 128; g.ncols = FF; g.K = D;
        EpiDesc e; e.ob = (u16*)(p.ws + WS_ACT) + (size_t)ex * EPAD * FF; e.of = nullptr; e.ldo = FF; e.gates = nullptr; e.rscale = nullptr;
        gemm_tile<EPI_SWIGLU>(g, e, lds);
    }
}
__device__ void phase_moe_b(const Params& p, int l, unsigned char* lds) {
    const int mvalid = l == 0 ? 2176 : 2048, nM = l == 0 ? 9 : 8;
    const int per_e = nM * 8;
    const int xcd = bid_() & 7, slot = bid_() >> 3, nslot = gdim_() >> 3;
    for (int k = slot; k < 2 * per_e; k += nslot) {
        const int tile = xcd * 2 * per_e + k;
        const int ex = tile / per_e, r = tile % per_e, pn = r / nM, pm = r % nM;
        GemmDesc g; g.A = (const u16*)(p.ws + WS_ACT) + (size_t)ex * EPAD * FF; g.lda = FF; g.arow = nullptr; g.mvalid = mvalid; g.m0 = pm * 256;
        g.B0 = (const u16*)(p.ws + WS_WT_W2) + (size_t)ex * D * FF; g.B1 = nullptr; g.n0 = pn * 256; g.ncols = D; g.K = FF;
        EpiDesc e; e.ob = (u16*)(p.ws + WS_YEXP) + (size_t)ex * EPAD * D; e.of = nullptr; e.ldo = D; e.gates = nullptr; e.rscale = (const float*)(p.ws + WS_EGATE) + ex * EPAD;
        gemm_tile<EPI_SCALE>(g, e, lds);
    }
}

__device__ __forceinline__ int mlstm_row(int b, int dir, int pos) {
    if (pos < LC) return NLAT + b * LC + (dir ? (LC - 1 - pos) : pos);
    const int q = pos - LC; return b * SEQ + (dir ? (SEQ - 1 - q) : q);
}
__device__ void phase_mlstm(const Params& p, unsigned char* lds) {
    u16* KT = (u16*)lds;
    u16* VT = KT + 256 * 72;
    u16* VWT = VT + 48 * 72;
    u16* CT = VWT + 48 * 72;
    u16* Ss = CT + 48 * 264;
    float* sb = (float*)(Ss + 64 * 72);
    float* sig = sb + 64;
    float* spm = sig + 64;
    float* ssc = spm + 64;
    const int t = tid_(), lane = t & 63, w = t >> 6, fr = lane & 15, fq = lane >> 4;
    const u16* P = (const u16*)(p.ws + WS_P);
    const float* G = (const float*)(p.ws + WS_G);
    u16* HM = (u16*)(p.ws + WS_HM);
    for (int item = bid_(); item < 256; item += gdim_()) {
        const int vs = item & 7, dir = (item >> 3) & 1, hh = (item >> 4) & 3, b = item >> 6;
        __syncthreads();
        for (int i = t; i < 48 * 264; i += NT) CT[i] = 0;
        for (int i = t; i < 16 * 72; i += NT) { const int er = i / 72; VT[32 * 72 + i] = (er == 0) ? (u16)0x3f80 : (u16)0; VWT[32 * 72 + i] = 0; }
        f32x4 Cacc[2][3];
#pragma unroll
        for (int i = 0; i < 2; ++i)
#pragma unroll
            for (int j = 0; j < 3; ++j) Cacc[i][j] = (f32x4){0.f, 0.f, 0.f, 0.f};
        float m_old = 0.f;
        const float gb_i = p.mlstm_gate_b[(dir * 2 + 0) * 4 + hh], gb_f = p.mlstm_gate_b[(dir * 2 + 1) * 4 + hh];
        const int jt = w & 3, sth = w >> 2;
        for (int ch = 0; ch < 68; ++ch) {
            const int pos0 = ch * 64;
            if (w == 0) {
                const int row = mlstm_row(b, dir, pos0 + lane);
                const float gi = G[(size_t)row * 16 + dir * 8 + hh] + gb_i;
                const float gf = G[(size_t)row * 16 + dir * 8 + 4 + hh] + gb_f;
                const float lf = fminf(gf, 0.f) - log1pf(__expf(-fabsf(gf)));
                float bc = lf;
#pragma unroll
                for (int o = 1; o < 64; o <<= 1) { const float n = __shfl_up(bc, o, 64); if (lane >= o) bc += n; }
                float pm = gi - bc;
#pragma unroll
                for (int o = 1; o < 64; o <<= 1) { const float n = __shfl_up(pm, o, 64); if (lane >= o) pm = fmaxf(pm, n); }
                const float b63 = __shfl(bc, 63, 64);
                float gmax = b63 - bc + gi;
#pragma unroll
                for (int o = 32; o > 0; o >>= 1) gmax = fmaxf(gmax, __shfl_xor(gmax, o, 64));
                const float m_new = fmaxf(b63 + m_old, gmax);
                sb[lane] = bc; sig[lane] = gi; spm[lane] = pm;
                if (lane == 0) { ssc[0] = m_new; ssc[1] = __expf(b63 + m_old - m_new); }
            }
            const int rowq = mlstm_row(b, dir, pos0 + jt * 16 + fr);
            bf16x8 qf[8];
#pragma unroll
            for (int kk = 0; kk < 8; ++kk) qf[kk] = ld_frag_g(P + (size_t)rowq * AB_IN + hh * 256 + kk * 32 + fq * 8);
            bf16x8 kf[8];
            {
                const int rowk = mlstm_row(b, dir, pos0 + (sth * 2) * 16 + fr);
#pragma unroll
                for (int kk = 0; kk < 8; ++kk) kf[kk] = ld_frag_g(P + (size_t)rowk * AB_IN + 1024 + hh * 256 + kk * 32 + fq * 8);
            }
            unsigned ktr[2][8];
#pragma unroll
            for (int i = 0; i < 2; ++i) {
                const int mt = t + NT * i, d2 = (mt & 127) * 2, s8 = (mt >> 7) * 8;
#pragma unroll
                for (int q = 0; q < 8; ++q) ktr[i][q] = *reinterpret_cast<const unsigned*>(P + (size_t)mlstm_row(b, dir, pos0 + s8 + q) * AB_IN + 1024 + hh * 256 + d2);
            }
            const int vs_s = t & 63, vs_eg = t >> 6;
            const u32x2 vraw = *reinterpret_cast<const u32x2*>(P + (size_t)mlstm_row(b, dir, pos0 + vs_s) * AB_IN + 2048 + hh * 256 + vs * 32 + vs_eg * 4);
            __syncthreads();
            const float m_new = ssc[0], decay = ssc[1], b63 = sb[63];
            const int jg = jt * 16 + fr;
            const float bj = sb[jg], mj = bj + fmaxf(m_old, spm[jg]);
            auto s_tile = [&](int st) {
                f32x4 sv = (f32x4){0.f, 0.f, 0.f, 0.f};
                if (st <= jt) {
#pragma unroll
                    for (int kk = 0; kk < 8; ++kk) sv = mfma16(kf[kk], qf[kk], sv);
                }
                float pv[4];
#pragma unroll
                for (int q = 0; q < 4; ++q) {
                    const int sg = st * 16 + 4 * fq + q;
                    pv[q] = (sg <= jg) ? sv[q] * 0.0625f * __expf(bj - sb[sg] + sig[sg] - mj) : 0.f;
                }
                u32x2 pk = {pk_bf16(pv[0], pv[1]), pk_bf16(pv[2], pv[3])};
                *reinterpret_cast<u32x2*>(Ss + jg * 72 + st * 16 + 4 * fq) = pk;
            };
            s_tile(sth * 2);
            {
                const int rowk = mlstm_row(b, dir, pos0 + (sth * 2 + 1) * 16 + fr);
#pragma unroll
                for (int kk = 0; kk < 8; ++kk) kf[kk] = ld_frag_g(P + (size_t)rowk * AB_IN + 1024 + hh * 256 + kk * 32 + fq * 8);
            }
#pragma unroll
            for (int i = 0; i < 2; ++i) {
                const int mt = t + NT * i, d2 = (mt & 127) * 2, s8 = (mt >> 7) * 8;
                u32x4 lo = {(ktr[i][0] & 0xffffu) | (ktr[i][1] << 16), (ktr[i][2] & 0xffffu) | (ktr[i][3] << 16), (ktr[i][4] & 0xffffu) | (ktr[i][5] << 16), (ktr[i][6] & 0xffffu) | (ktr[i][7] << 16)};
                u32x4 hi = {(ktr[i][0] >> 16) | (ktr[i][1] & 0xffff0000u), (ktr[i][2] >> 16) | (ktr[i][3] & 0xffff0000u), (ktr[i][4] >> 16) | (ktr[i][5] & 0xffff0000u), (ktr[i][6] >> 16) | (ktr[i][7] & 0xffff0000u)};
                *reinterpret_cast<u32x4*>(KT + d2 * 72 + s8) = lo;
                *reinterpret_cast<u32x4*>(KT + (d2 + 1) * 72 + s8) = hi;
            }
            {
                const float wg = __expf(b63 - sb[vs_s] + sig[vs_s] - m_new) * 0.0625f;
                const float v0 = bf_lo(vraw[0]), v1 = bf_hi(vraw[0]), v2 = bf_lo(vraw[1]), v3 = bf_hi(vraw[1]);
                const int e0 = vs_eg * 4;
                VT[(e0 + 0) * 72 + vs_s] = (u16)(vraw[0] & 0xffffu); VT[(e0 + 1) * 72 + vs_s] = (u16)(vraw[0] >> 16);
                VT[(e0 + 2) * 72 + vs_s] = (u16)(vraw[1] & 0xffffu); VT[(e0 + 3) * 72 + vs_s] = (u16)(vraw[1] >> 16);
                VWT[(e0 + 0) * 72 + vs_s] = f2bf(v0 * wg); VWT[(e0 + 1) * 72 + vs_s] = f2bf(v1 * wg);
                VWT[(e0 + 2) * 72 + vs_s] = f2bf(v2 * wg); VWT[(e0 + 3) * 72 + vs_s] = f2bf(v3 * wg);
                if (t < 64) VWT[32 * 72 + t] = f2bf(wg);
            }
            s_tile(sth * 2 + 1);
            __syncthreads();
            {
                const float w_inter = __expf(bj + m_old - mj);
                f32x4 nacc[2];
#pragma unroll
                for (int z = 0; z < 2; ++z) {
                    const int et = z == 0 ? sth : 2;
                    f32x4 a = (f32x4){0.f, 0.f, 0.f, 0.f};
#pragma unroll
                    for (int kk = 0; kk < 8; ++kk) a = mfma16(ld_frag_s(CT + (et * 16 + fr) * 264 + kk * 32 + fq * 8), qf[kk], a);
                    a *= w_inter;
#pragma unroll
                    for (int k2 = 0; k2 < 2; ++k2) a = mfma16(ld_frag_s(VT + (et * 16 + fr) * 72 + k2 * 32 + fq * 8), ld_frag_s(Ss + jg * 72 + k2 * 32 + fq * 8), a);
                    nacc[z] = a;
                }
                const float den = __shfl(nacc[1][0], fr, 64);
                const float dd = fmaxf(fabsf(den), __expf(-mj));
                const float inv = 1.f / dd;
                u32x2 pk = {pk_bf16(nacc[0][0] * inv, nacc[0][1] * inv), pk_bf16(nacc[0][2] * inv, nacc[0][3] * inv)};
                *reinterpret_cast<u32x2*>(HM + ((size_t)dir * NTOK + rowq) * 1024 + hh * 256 + vs * 32 + sth * 16 + 4 * fq) = pk;
            }
#pragma unroll
            for (int i = 0; i < 2; ++i)
#pragma unroll
                for (int et = 0; et < 3; ++et) {
                    f32x4 a = Cacc[i][et] * decay;
#pragma unroll
                    for (int k2 = 0; k2 < 2; ++k2) a = mfma16(ld_frag_s(KT + ((w * 2 + i) * 16 + fr) * 72 + k2 * 32 + fq * 8), ld_frag_s(VWT + (et * 16 + fr) * 72 + k2 * 32 + fq * 8), a);
                    Cacc[i][et] = a;
                }
            __syncthreads();
#pragma unroll
            for (int i = 0; i < 2; ++i)
#pragma unroll
                for (int et = 0; et < 3; ++et) {
                    const f32x4 a = Cacc[i][et];
                    u32x2 pk = {pk_bf16(a[0], a[1]), pk_bf16(a[2], a[3])};
                    *reinterpret_cast<u32x2*>(CT + (et * 16 + fr) * 264 + (w * 2 + i) * 16 + 4 * fq) = pk;
                }
            m_old = m_new;
        }
    }
}

__device__ void mlstm_out_rows(const Params& p, int row0, int nrows) {
    const int lane = tid_() & 63, w = tid_() >> 6;
    const u16* P = (const u16*)(p.ws + WS_P);
    const u16* HM = (const u16*)(p.ws + WS_HM);
    u16* YIN = (u16*)(p.ws + WS_YIN);
    for (int r = w; r < nrows; r += 8) {
        const int row = row0 + r;
        const int c0 = lane * 16;
        float v[16]; float ss = 0.f;
#pragma unroll
        for (int h2 = 0; h2 < 2; ++h2) {
            const u32x4 a = *reinterpret_cast<const u32x4*>(HM + (size_t)row * 1024 + c0 + h2 * 8);
            const u32x4 bq = *reinterpret_cast<const u32x4*>(HM + ((size_t)NTOK + row) * 1024 + c0 + h2 * 8);
#pragma unroll
            for (int q = 0; q < 4; ++q) { v[h2 * 8 + 2 * q] = bf_lo(a[q]) + bf_lo(bq[q]); v[h2 * 8 + 2 * q + 1] = bf_hi(a[q]) + bf_hi(bq[q]); }
        }
#pragma unroll
        for (int q = 0; q < 16; ++q) ss += v[q] * v[q];
        ss += __shfl_xor(ss, 1, 64); ss += __shfl_xor(ss, 2, 64); ss += __shfl_xor(ss, 4, 64); ss += __shfl_xor(ss, 8, 64);
        const float rstd = rsqrtf(ss * (1.f / 256.f) + 1e-6f);
        unsigned o[8];
#pragma unroll
        for (int h2 = 0; h2 < 2; ++h2) {
            const u32x4 og = *reinterpret_cast<const u32x4*>(P + (size_t)row * AB_IN + 3072 + c0 + h2 * 8);
#pragma unroll
            for (int q = 0; q < 4; ++q) {
                const int c = c0 + h2 * 8 + 2 * q;
                const float y0 = v[h2 * 8 + 2 * q] * rstd * p.mlstm_norm[c] * sigmoidf_(bf_lo(og[q]));
                const float y1 = v[h2 * 8 + 2 * q + 1] * rstd * p.mlstm_norm[c + 1] * sigmoidf_(bf_hi(og[q]));
                o[h2 * 4 + q] = pk_bf16(y0, y1);
            }
        }
        *reinterpret_cast<u32x4*>(YIN + (size_t)row * D + c0) = (u32x4){o[0], o[1], o[2], o[3]};
        *reinterpret_cast<u32x4*>(YIN + (size_t)row * D + c0 + 8) = (u32x4){o[4], o[5], o[6], o[7]};
    }
}

template <int DH, class KeyFn, class BiasFn>
__device__ __forceinline__ void attn_wave(const u16* qptr, size_t qstride, int nblk, KeyFn keyfn, BiasFn biasfn, float scale,
                                           float m_init, float l_init, u16* vlds, u16* optr, size_t ostride) {
    constexpr int NK = DH / 32, NDT = DH / 16, VS = DH + 8, NV = DH / 16;
    const int lane = tid_() & 63, fr = lane & 15, fq = lane >> 4;
    bf16x8 qf[NK];
#pragma unroll
    for (int kk = 0; kk < NK; ++kk) qf[kk] = ld_frag_g(qptr + (size_t)fr * qstride + kk * 32 + fq * 8);
    f32x4 oacc[NDT];
#pragma unroll
    for (int i = 0; i < NDT; ++i) oacc[i] = (f32x4){0.f, 0.f, 0.f, 0.f};
    float m = m_init, l = l_init;
    bf16x8 kn[2][NK]; u32x4 vn[NV];
    auto load_blk = [&](int ib) {
        const u16* kptr; const u16* vptr; size_t kvs;
        (void)keyfn(ib, kptr, vptr, kvs);
#pragma unroll
        for (int st = 0; st < 2; ++st)
#pragma unroll
            for (int kk = 0; kk < NK; ++kk) kn[st][kk] = ld_frag_g(kptr + (size_t)(st * 16 + fr) * kvs + kk * 32 + fq * 8);
#pragma unroll
        for (int i = 0; i < NV; ++i) { const int cidx = lane + 64 * i, r = cidx / (DH / 8), cc = cidx % (DH / 8); vn[i] = *reinterpret_cast<const u32x4*>(vptr + (size_t)r * kvs + cc * 8); }
    };
    auto next_valid = [&](int ib) { const u16* a; const u16* b2; size_t c; while (ib < nblk && !keyfn(ib, a, b2, c)) ++ib; return ib; };
    int ib = next_valid(0);
    if (ib < nblk) load_blk(ib);
    while (ib < nblk) {
        bf16x8 kc[2][NK]; u32x4 vc[NV];
#pragma unroll
        for (int st = 0; st < 2; ++st)
#pragma unroll
            for (int kk = 0; kk < NK; ++kk) kc[st][kk] = kn[st][kk];
#pragma unroll
        for (int i = 0; i < NV; ++i) vc[i] = vn[i];
        const int ibn = next_valid(ib + 1);
        if (ibn < nblk) load_blk(ibn);
        asm volatile("" ::: "memory");
#pragma unroll
        for (int i = 0; i < NV; ++i) { const int cidx = lane + 64 * i, r = cidx / (DH / 8), cc = cidx % (DH / 8); *reinterpret_cast<u32x4*>(vlds + r * VS + cc * 8) = vc[i]; }
        f32x4 s[2];
#pragma unroll
        for (int st = 0; st < 2; ++st) {
            f32x4 a = (f32x4){0.f, 0.f, 0.f, 0.f};
#pragma unroll
            for (int kk = 0; kk < NK; ++kk) a = mfma16(kc[st][kk], qf[kk], a);
            s[st] = a;
        }
        float x[8]; float mx = -INFINITY;
#pragma unroll
        for (int st = 0; st < 2; ++st)
#pragma unroll
            for (int q = 0; q < 4; ++q) { const float v = s[st][q] * scale + biasfn(ib, fr, st * 16 + 4 * fq + q); x[st * 4 + q] = v; mx = fmaxf(mx, v); }
        mx = fmaxf(mx, __shfl_xor(mx, 16, 64)); mx = fmaxf(mx, __shfl_xor(mx, 32, 64));
        const float m_new = fmaxf(m, mx);
        const float m_safe = (m_new == -INFINITY) ? 0.f : m_new;
        const float alpha = __expf(m - m_safe);
        float ps = 0.f; float pe[8];
#pragma unroll
        for (int q = 0; q < 8; ++q) { pe[q] = __expf(x[q] - m_safe); ps += pe[q]; }
        l = l * alpha + ps; m = m_new;
#pragma unroll
        for (int i = 0; i < NDT; ++i) oacc[i] *= alpha;
        const bf16x8 pf = mk_frag(pk_bf16(pe[0], pe[1]), pk_bf16(pe[2], pe[3]), pk_bf16(pe[4], pe[5]), pk_bf16(pe[6], pe[7]));
        asm volatile("s_waitcnt lgkmcnt(0)" ::: "memory");
#pragma unroll
        for (int dt = 0; dt < NDT; ++dt) {
            const u16* vb = vlds + dt * 16 + fr;
            unsigned e[4];
#pragma unroll
            for (int j2 = 0; j2 < 2; ++j2) {
                const int k0 = (j2 == 0 ? 0 : 16) + 4 * fq;
                e[j2 * 2 + 0] = (unsigned)vb[(k0 + 0) * VS] | ((unsigned)vb[(k0 + 1) * VS] << 16);
                e[j2 * 2 + 1] = (unsigned)vb[(k0 + 2) * VS] | ((unsigned)vb[(k0 + 3) * VS] << 16);
            }
            oacc[dt] = mfma16(mk_frag(e[0], e[1], e[2], e[3]), pf, oacc[dt]);
        }
        asm volatile("" ::: "memory");
        ib = ibn;
    }
    l += __shfl_xor(l, 16, 64); l += __shfl_xor(l, 32, 64);
    const float inv = 1.f / l;
#pragma unroll
    for (int dt = 0; dt < NDT; ++dt) {
        const f32x4 o = oacc[dt] * inv;
        u32x2 pk = {pk_bf16(o[0], o[1]), pk_bf16(o[2], o[3])};
        *reinterpret_cast<u32x2*>(optr + (size_t)fr * ostride + dt * 16 + 4 * fq) = pk;
    }
}

__device__ void phase_l0_stage2(const Params& p, unsigned char* lds) {
    const int w = tid_() >> 6;
    const u16* P = (const u16*)(p.ws + WS_P);
    u16* YIN = (u16*)(p.ws + WS_YIN);
    u16* vlds = (u16*)lds + w * (32 * 136);
    for (int item = bid_(); item < 1088 + 2176; item += gdim_()) {
        if (item < 1024) {
            const int qt = item & 3, r = (item >> 2) & 63, b = item >> 8, h = w;
            const int r0 = min(max(r - 4, 0), 56);
            const int cb = qt == 0 ? 0 : (qt == 1 ? 8 : (qt == 2 ? 24 : 32));
            const int qrow = b * SEQ + r * 64 + qt * 16;
            const float* rpb = p.na_rpb + h * 15 * 31;
            auto keyfn = [&](int ib, const u16*& kp, const u16*& vp, size_t& kvs) -> bool {
                int row;
                if (ib < 8) row = b * SEQ + (r0 + ib) * 64 + cb; else row = NLAT + b * LC + (ib - 8) * 32;
                kp = P + (size_t)row * AB_IN + 5136 + h * 128; vp = P + (size_t)row * AB_IN + 6160 + h * 128; kvs = AB_IN; return true; };
            auto biasfn = [&](int ib, int qi, int ki) -> float {
                if (ib >= 8) return 0.f;
                const int c = qt * 16 + qi, kc = cb + ki, c0 = min(max(c - 8, 0), 48);
                if (kc < c0 || kc >= c0 + 16) return -INFINITY;
                return rpb[(r0 + ib - r + 7) * 31 + (kc - c + 15)]; };
            attn_wave<128>(P + (size_t)qrow * AB_IN + 4112 + h * 128, AB_IN, 16, keyfn, biasfn, 0.08838834764831845f, -INFINITY, 0.f, vlds,
                           YIN + (size_t)qrow * D + 1024 + h * 128, D);
        } else if (item < 1088) {
            const int it = item - 1024, qt = it & 15, b = it >> 4, h = w;
            const int qrow = NLAT + b * LC + qt * 16;
            auto keyfn = [&](int ib, const u16*& kp, const u16*& vp, size_t& kvs) -> bool {
                const int row = NLAT + b * LC + ib * 32;
                kp = P + (size_t)row * AB_IN + 5136 + h * 128; vp = P + (size_t)row * AB_IN + 6160 + h * 128; kvs = AB_IN; return true; };
            auto biasfn = [&](int, int, int) -> float { return 0.f; };
            attn_wave<128>(P + (size_t)qrow * AB_IN + 4112 + h * 128, AB_IN, 8, keyfn, biasfn, 0.08838834764831845f, -INFINITY, 0.f, vlds,
                           YIN + (size_t)qrow * D + 1024 + h * 128, D);
        } else {
            mlstm_out_rows(p, (item - 1088) * 8, 8);
        }
    }
}

__device__ void rope_rows(const Params& p, int row0, int nrows) {
    const int lane = tid_() & 63, w = tid_() >> 6;
    u16* P = (u16*)(p.ws + WS_P);
    for (int r = w; r < nrows; r += 8) {
        const int row = row0 + r, tt = row & (SEQ - 1);
        const float prow = (float)(tt >> 6), pcol = (float)(tt & 63);
        for (int pi = lane; pi < 640; pi += 64) {
            const int head = pi >> 5, half = (pi >> 4) & 1, j = pi & 15;
            const int base = (head < 16 ? head * 64 : 1024 + (head - 16) * 64) + half * 32 + j;
            const float inv = exp2f(-(float)j * (13.287712379549449f / 16.f));
            const float ang = (half ? pcol : prow) * inv;
            float sn, cs; sincosf(ang, &sn, &cs);
            u16* q1 = P + (size_t)row * CD_IN + base;
            const float x1 = bf2f(q1[0]), x2 = bf2f(q1[16]);
            q1[0] = f2bf(x1 * cs - x2 * sn); q1[16] = f2bf(x2 * cs + x1 * sn);
        }
    }
}

__device__ __forceinline__ int lru_row(int b, int ci, int j) { return ci < 4 ? NLAT + b * LC + ci * 64 + j : b * SEQ + (ci - 4) * 64 + j; }
__device__ void lru_chunk(const Params& p, int b, int blk, int ci, int mode, unsigned char* lds) {
    u16* ub = (u16*)lds;
    float* sa = (float*)(ub + 64 * 136);
    float* sbt = sa + 64 * 128;
    float* sx = sbt + 64 * 128;
    const int t = tid_(), lane = t & 63, w = t >> 6, fr = lane & 15, fq = lane >> 4;
    const u16* P = (const u16*)(p.ws + WS_P);
    const u16* WT = (const u16*)(p.ws + WS_LRUW);
    float* SA = (float*)(p.ws + WS_LRUS);
    float* SH = SA + 2 * 4 * 68 * 1024;
    const int seglen = ci < 4 ? LC : SEQ, tt0 = ci < 4 ? ci * 64 : (ci - 4) * 64;
    const int rbase = ci < 4 ? NLAT + b * LC : b * SEQ;
    __syncthreads();
    {
        const int c4 = (t & 31) * 4, j0 = (t >> 5) * 4, ch = blk * 128 + c4;
        float xv[7][4];
#pragma unroll
        for (int q = 0; q < 7; ++q) {
            const int tt = tt0 + j0 - 1 + q;
            if (tt >= 0 && tt < seglen) {
                const u32x2 v = *reinterpret_cast<const u32x2*>(P + (size_t)(rbase + tt) * CD_IN + 1536 + ch);
                xv[q][0] = bf_lo(v[0]); xv[q][1] = bf_hi(v[0]); xv[q][2] = bf_lo(v[1]); xv[q][3] = bf_hi(v[1]);
            } else { xv[q][0] = xv[q][1] = xv[q][2] = xv[q][3] = 0.f; }
        }
        f32x4 cw[4];
#pragma unroll
        for (int tp = 0; tp < 4; ++tp) cw[tp] = *reinterpret_cast<const f32x4*>(p.lru_conv_w + tp * 1024 + ch);
        const f32x4 cb = *reinterpret_cast<const f32x4*>(p.lru_conv_b + ch);
#pragma unroll
        for (int q = 0; q < 4; ++q) {
            float u[4];
#pragma unroll
            for (int cc = 0; cc < 4; ++cc) u[cc] = cb[cc] + xv[q][cc] * cw[0][cc] + xv[q + 1][cc] * cw[1][cc] + xv[q + 2][cc] * cw[2][cc] + xv[q + 3][cc] * cw[3][cc];
            u32x2 pk = {pk_bf16(u[0], u[1]), pk_bf16(u[2], u[3])};
            *reinterpret_cast<u32x2*>(ub + (j0 + q) * 136 + c4) = pk;
        }
    }
    __syncthreads();
    const int sc = t & 127, seg = t >> 7;
    const int chg_s = blk * 128 + sc;
    float hfw[16];
    bf16x8 wfa[2][2][4];
#pragma unroll
    for (int d2 = 0; d2 < 2; ++d2)
#pragma unroll
        for (int g2 = 0; g2 < 2; ++g2)
#pragma unroll
            for (int kk = 0; kk < 4; ++kk) wfa[d2][g2][kk] = ld_frag_g(WT + ((size_t)((d2 * 2 + g2) * 8 + blk) * 128 + w * 16 + fr) * 128 + fq * 8 + kk * 32);
    float carry[2] = {0.f, 0.f}; u16 grv[16];
    if (mode == 1) {
#pragma unroll
        for (int d2 = 0; d2 < 2; ++d2) carry[d2] = SH[((size_t)(d2 * 4 + b) * 68 + ci) * 1024 + chg_s];
#pragma unroll
        for (int s = 0; s < 16; ++s) grv[s] = P[(size_t)lru_row(b, ci, seg * 16 + s) * CD_IN + 2560 + chg_s];
    }
    for (int dir = 0; dir < 2; ++dir) {
        const int cg = blk * 128 + w * 16 + 4 * fq;
        f32x4 av[4];
        {
            bf16x8 wf[4];
#pragma unroll
            for (int kk = 0; kk < 4; ++kk) wf[kk] = dir ? wfa[1][0][kk] : wfa[0][0][kk];
            const f32x4 gbv = *reinterpret_cast<const f32x4*>(p.lru_gate_b + (dir * 2 + 0) * 1024 + cg);
            const f32x4 lamv = *reinterpret_cast<const f32x4*>(p.lru_lambda + dir * 1024 + cg);
            float sp8[4];
#pragma unroll
            for (int q = 0; q < 4; ++q) { const float nl = -lamv[q]; sp8[q] = -8.f * (fmaxf(nl, 0.f) + log1pf(__expf(-fabsf(nl)))); }
#pragma unroll
            for (int tt = 0; tt < 4; ++tt) {
                f32x4 z = (f32x4){0.f, 0.f, 0.f, 0.f};
#pragma unroll
                for (int kk = 0; kk < 4; ++kk) z = mfma16(wf[kk], ld_frag_s(ub + (tt * 16 + fr) * 136 + kk * 32 + fq * 8), z);
#pragma unroll
                for (int q = 0; q < 4; ++q) av[tt][q] = __expf(sigmoidf_(z[q] + gbv[q]) * sp8[q]);
            }
        }
        __syncthreads();
        {
            bf16x8 wf[4];
#pragma unroll
            for (int kk = 0; kk < 4; ++kk) wf[kk] = dir ? wfa[1][1][kk] : wfa[0][1][kk];
            const f32x4 gbv = *reinterpret_cast<const f32x4*>(p.lru_gate_b + (dir * 2 + 1) * 1024 + cg);
#pragma unroll
            for (int tt = 0; tt < 4; ++tt) {
                f32x4 z = (f32x4){0.f, 0.f, 0.f, 0.f};
#pragma unroll
                for (int kk = 0; kk < 4; ++kk) z = mfma16(wf[kk], ld_frag_s(ub + (tt * 16 + fr) * 136 + kk * 32 + fq * 8), z);
                const int tj = tt * 16 + fr;
                const u32x2 uv = *reinterpret_cast<const u32x2*>(ub + tj * 136 + w * 16 + 4 * fq);
                const float u4[4] = {bf_lo(uv[0]), bf_hi(uv[0]), bf_lo(uv[1]), bf_hi(uv[1])};
                f32x4 bv;
#pragma unroll
                for (int q = 0; q < 4; ++q) { const float a = av[tt][q]; bv[q] = sqrtf(fmaxf(1.f - a * a, 0.f)) * sigmoidf_(z[q] + gbv[q]) * u4[q]; }
                *reinterpret_cast<f32x4*>(sa + tj * 128 + w * 16 + 4 * fq) = av[tt];
                *reinterpret_cast<f32x4*>(sbt + tj * 128 + w * 16 + 4 * fq) = bv;
            }
        }
        __syncthreads();
        float A = 1.f, h = 0.f;
#pragma unroll
        for (int s = 0; s < 16; ++s) { const int j = seg * 16 + (dir ? 15 - s : s); const float a = sa[j * 128 + sc]; h = a * h + sbt[j * 128 + sc]; A *= a; }
        sx[(seg * 2 + 0) * 128 + sc] = A; sx[(seg * 2 + 1) * 128 + sc] = h;
        __syncthreads();
        const size_t sidx = ((size_t)(dir * 4 + b) * 68 + ci) * 1024 + chg_s;
        if (mode == 0) {
            if (seg == 0) {
                float At = 1.f, ht = 0.f;
#pragma unroll
                for (int s = 0; s < 4; ++s) { const int sg = dir ? 3 - s : s; const float a = sx[(sg * 2) * 128 + sc]; ht = a * ht + sx[(sg * 2 + 1) * 128 + sc]; At *= a; }
                SA[sidx] = At; SH[sidx] = ht;
            }
        } else {
            float hs = dir ? carry[1] : carry[0];
            const int nprev = dir ? 3 - seg : seg;
#pragma unroll
            for (int s = 0; s < 3; ++s) if (s < nprev) { const int sg = dir ? 3 - s : s; hs = sx[(sg * 2) * 128 + sc] * hs + sx[(sg * 2 + 1) * 128 + sc]; }
            u16* YIN = (u16*)(p.ws + WS_YIN);
#pragma unroll
            for (int s = 0; s < 16; ++s) {
                const int js = dir ? 15 - s : s, j = seg * 16 + js;
                hs = sa[j * 128 + sc] * hs + sbt[j * 128 + sc];
                if (dir == 0) hfw[js] = hs;
                else {
                    const int row = lru_row(b, ci, j);
                    const float gr = bf2f(grv[js]);
                    const float ge = 0.5f * gr * (1.f + tanhf(0.7978845608028654f * (gr + 0.044715f * gr * gr * gr)));
                    YIN[(size_t)row * D + 1024 + chg_s] = f2bf((hfw[js] + hs) * ge);
                }
            }
        }
    }
}

__device__ void lru_prep_weights(const Params& p) {
    const int t = tid_();
    u16* WT = (u16*)(p.ws + WS_LRUW);
    for (int m = bid_(); m < 32; m += gdim_()) {
        const float* Wg = p.lru_gate_w + (size_t)m * 128 * 128;
        const int j4 = (t & 31) * 4, i8 = (t >> 5) * 8;
        f32x4 r8[8];
#pragma unroll
        for (int q = 0; q < 8; ++q) r8[q] = *reinterpret_cast<const f32x4*>(Wg + (size_t)(i8 + q) * 128 + j4);
#pragma unroll
        for (int jj = 0; jj < 4; ++jj) {
            u32x4 v = {pk_bf16(r8[0][jj], r8[1][jj]), pk_bf16(r8[2][jj], r8[3][jj]), pk_bf16(r8[4][jj], r8[5][jj]), pk_bf16(r8[6][jj], r8[7][jj])};
            *reinterpret_cast<u32x4*>(WT + ((size_t)m * 128 + j4 + jj) * 128 + i8) = v;
        }
    }
}
__device__ void lru_carry(const Params& p, int item) {
    const int idx = item * NT + tid_();
    const int c = idx & 1023, b = (idx >> 10) & 3, dir = idx >> 12;
    float* SA = (float*)(p.ws + WS_LRUS);
    float* SH = SA + 2 * 4 * 68 * 1024;
    const size_t base = ((size_t)(dir * 4 + b) * 68) * 1024 + c;
    float h = 0.f;
#pragma unroll 4
    for (int s = 0; s < 68; ++s) {
        const int cj = dir == 0 ? s : (s < 4 ? 3 - s : 71 - s);
        const float a = SA[base + (size_t)cj * 1024], hl = SH[base + (size_t)cj * 1024];
        SH[base + (size_t)cj * 1024] = h;
        h = a * h + hl;
    }
}

__device__ void gqa_item(const Params& p, int it, unsigned char* lds) {
    const int w = tid_() >> 6;
    const u16* P = (const u16*)(p.ws + WS_P);
    u16* YIN = (u16*)(p.ws + WS_YIN);
    const int hq = (it & 1) * 8 + w, t16 = (it >> 1) & 255, b = it >> 9;
    const int kvh = hq >> 2, t0 = t16 * 16;
    const int ks = (t0 - 128) & ~31;
    const int qrow = b * SEQ + t0;
    u16* vlds = (u16*)lds + w * (32 * 72);
    auto keyfn = [&](int ib, const u16*& kp, const u16*& vp, size_t& kvs) -> bool {
        int row;
        if (ib < 9) { const int k0 = ks + ib * 32; if (k0 < 0 || k0 >= SEQ) return false; row = b * SEQ + k0; }
        else row = NLAT + b * LC + (ib - 9) * 32;
        kp = P + (size_t)row * CD_IN + 1024 + kvh * 64; vp = P + (size_t)row * CD_IN + 1280 + kvh * 64; kvs = CD_IN; return true; };
    auto biasfn = [&](int ib, int qi, int ki) -> float {
        if (ib >= 9) return 0.f;
        const int dq = (t0 + qi) - (ks + ib * 32 + ki);
        return (dq > 128 || dq < -128) ? -INFINITY : 0.f; };
    const float sink = p.gqa_sink[hq];
    attn_wave<64>(P + (size_t)qrow * CD_IN + hq * 64, CD_IN, 17, keyfn, biasfn, 0.125f, sink, ((tid_() & 63) >> 4) == 0 ? 1.f : 0.f, vlds,
                  YIN + (size_t)qrow * D + hq * 64, D);
}

__device__ void phase_l1_stage1(const Params& p, unsigned char* lds) {
    for (int item = bid_(); item < 2176 + 2048; item += gdim_()) {
        if (item < 2176) { const int ci = item % 68, blk = (item / 68) & 7, b = item / (68 * 8); lru_chunk(p, b, blk, ci, 0, lds); }
        else rope_rows(p, (item - 2176) * 8, 8);
    }
}
__device__ void phase_l1_stage2(const Params& p, unsigned char* lds) {
    for (int item = bid_(); item < 16 + 2048; item += gdim_()) {
        if (item < 16) lru_carry(p, item);
        else gqa_item(p, item - 16, lds);
    }
}
__device__ void phase_l1_stage3(const Params& p, unsigned char* lds) {
    for (int item = bid_(); item < 2048; item += gdim_()) { const int cl = item & 63, blk = (item >> 6) & 7, b = item >> 9; lru_chunk(p, b, blk, cl + 4, 1, lds); }
}

__device__ void phase_rowpass_mid(const Params& p, int l, unsigned char* lds) {
    float* R = (float*)lds;
    const int t = tid_(), lane = t & 63, w = t >> 6;
    const int nrows = l == 0 ? NTOK : NLAT;
    __syncthreads();
    for (int i = t; i < D * NEXP; i += NT) { const int k = i >> 4, e = i & 15; R[e * D + k] = p.moe_router[(size_t)l * D * NEXP + i]; }
    __syncthreads();
    const float* Y = (const float*)(p.ws + WS_Y);
    float* XL1 = (float*)(p.ws + WS_XL1);
    u16* H = (u16*)(p.ws + WS_H);
    float* AFF = (float*)(p.ws + WS_AFF);
    for (int row = bid_() * 8 + w; row < nrows; row += gdim_() * 8) {
        f32x4 v[8]; float ss = 0.f;
#pragma unroll
        for (int i = 0; i < 8; ++i) { v[i] = *reinterpret_cast<const f32x4*>(Y + (size_t)row * D + (i * 64 + lane) * 4); ss += v[i][0] * v[i][0] + v[i][1] * v[i][1] + v[i][2] * v[i][2] + v[i][3] * v[i][3]; }
        ss = wave_sum(ss);
        const float rstd = rsqrtf(ss * (1.f / D) + 1e-6f);
        const float* xr = xin_row(p, l, row);
        const float* g1 = mod_ptr(p, l, row, 2);
        const float* nw = p.norm_mix_post + (size_t)l * D;
        float ss1 = 0.f;
#pragma unroll
        for (int i = 0; i < 8; ++i) {
            const int col = (i * 64 + lane) * 4;
            const f32x4 x4 = *reinterpret_cast<const f32x4*>(xr + col), w4 = *reinterpret_cast<const f32x4*>(nw + col), g4 = *reinterpret_cast<const f32x4*>(g1 + col);
            const f32x4 x1 = x4 + g4 * (v[i] * rstd * w4);
            *reinterpret_cast<f32x4*>(XL1 + (size_t)row * D + col) = x1;
            v[i] = x1; ss1 += x1[0] * x1[0] + x1[1] * x1[1] + x1[2] * x1[2] + x1[3] * x1[3];
        }
        ss1 = wave_sum(ss1);
        const float rstd1 = rsqrtf(ss1 * (1.f / D) + 1e-6f);
        const float* sh = mod_ptr(p, l, row, 3); const float* sc = mod_ptr(p, l, row, 4);
        const float* nw2 = p.norm_ffn_pre + (size_t)l * D;
#pragma unroll
        for (int i = 0; i < 8; ++i) {
            const int col = (i * 64 + lane) * 4;
            const f32x4 w4 = *reinterpret_cast<const f32x4*>(nw2 + col), s4 = *reinterpret_cast<const f32x4*>(sc + col), h4 = *reinterpret_cast<const f32x4*>(sh + col);
            const f32x4 o = v[i] * rstd1 * w4 * (s4 + 1.f) + h4;
            u32x2 pk = {pk_bf16(o[0], o[1]), pk_bf16(o[2], o[3])};
            *reinterpret_cast<u32x2*>(H + (size_t)row * D + col) = pk;
            v[i] = o;
        }
        float mine = 0.f;
#pragma unroll 2
        for (int e = 0; e < 16; ++e) {
            float sdot = 0.f;
#pragma unroll
            for (int i = 0; i < 8; ++i) { const f32x4 r4 = *reinterpret_cast<const f32x4*>(R + e * D + (i * 64 + lane) * 4); sdot += v[i][0] * r4[0] + v[i][1] * r4[1] + v[i][2] * r4[2] + v[i][3] * r4[3]; }
            sdot = wave_sum(sdot);
            if (lane == e) mine = sdot;
        }
        float mx = mine;
#pragma unroll
        for (int o = 8; o > 0; o >>= 1) mx = fmaxf(mx, __shfl_xor(mx, o, 64));
        const float pe = __expf(mine - mx);
        float den = pe;
#pragma unroll
        for (int o = 8; o > 0; o >>= 1) den += __shfl_xor(den, o, 64);
        if (lane < 16) AFF[(size_t)row * 16 + lane] = pe / den;
    }
}

__device__ void phase_topk(const Params& p, int l, unsigned char* lds) {
    unsigned* keys = (unsigned*)lds;
    unsigned* hist = keys + 4096;
    unsigned* misc = hist + 256;
    const int t = tid_(), lane = t & 63, w = t >> 6;
    const float* AFF = (const float*)(p.ws + WS_AFF);
    int* SLOT = (int*)(p.ws + WS_SLOT);
    int* EROW = (int*)(p.ws + WS_EROW);
    float* EGATE = (float*)(p.ws + WS_EGATE);
    const int nitems = l == 0 ? 128 : 64;
    for (int item = bid_(); item < nitems; item += gdim_()) {
        const int kind = item >> 6, b = (item >> 4) & 3, ex = item & 15;
        const int n = kind ? LC : SEQ, cap = n / 8, rowbase = kind ? NLAT + b * LC : b * SEQ;
        __syncthreads();
        for (int i = t; i < n; i += NT) keys[i] = __float_as_uint(AFF[(size_t)(rowbase + i) * 16 + ex]);
        unsigned prefix = 0u, mask = 0u; int kth = cap;
        for (int shift = 24; shift >= 0; shift -= 8) {
            __syncthreads();
            if (t < 256) hist[t] = 0u;
            __syncthreads();
            for (int i = t; i < n; i += NT) { const unsigned k = keys[i]; if ((k & mask) == prefix) atomicAdd(&hist[(k >> shift) & 255u], 1u); }
            __syncthreads();
            if (t < 256) {
                unsigned above = 0u;
                for (int d2 = t + 1; d2 < 256; ++d2) above += hist[d2];
                const unsigned here = hist[t];
                if ((int)above < kth && (int)(above + here) >= kth) { misc[0] = (unsigned)t; misc[1] = (unsigned)(kth - (int)above); }
            }
            __syncthreads();
            prefix |= misc[0] << shift; mask |= 255u << shift; kth = (int)misc[1];
        }
        const unsigned T = prefix; const int need_eq = kth;
        int cgt = 0, ceq = 0;
        const int base = t * 8;
        if (base < n) {
#pragma unroll
            for (int q = 0; q < 8; ++q) { const unsigned k = keys[base + q]; cgt += (k > T); ceq += (k == T); }
        }
        int packed = cgt | (ceq << 16);
        int incl = packed;
#pragma unroll
        for (int o = 1; o < 64; o <<= 1) { const int nb = __shfl_up(incl, o, 64); if (lane >= o) incl += nb; }
        __syncthreads();
        if (lane == 63) misc[8 + w] = (unsigned)incl;
        __syncthreads();
        int woff = 0, total = 0;
#pragma unroll
        for (int q = 0; q < 8; ++q) { const int v = (int)misc[8 + q]; if (q < w) woff += v; total += v; }
        const int excl = woff + incl - packed;
        int pgt = excl & 0xffff, peq = excl >> 16;
        const int tot_gt = total & 0xffff;
        const int sbase = kind ? 2048 + b * 32 : b * 512;
        if (base < n) {
#pragma unroll
            for (int q = 0; q < 8; ++q) {
                const unsigned k = keys[base + q];
                const int row = rowbase + base + q;
                int pos = -1;
                if (k > T) { pos = pgt; ++pgt; }
                else if (k == T) { if (peq < need_eq) pos = tot_gt + peq; ++peq; }
                if (pos >= 0) { const int sl = sbase + pos; EROW[ex * EPAD + sl] = row; EGATE[ex * EPAD + sl] = __uint_as_float(k); SLOT[(size_t)row * 16 + ex] = sl; }
                else SLOT[(size_t)row * 16 + ex] = -1;
            }
        }
    }
}

__device__ void phase_final(const Params& p, int l) {
    const int lane = tid_() & 63, w = tid_() >> 6;
    const int nrows = l == 0 ? NTOK : NLAT;
    const u16* YEXP = (const u16*)(p.ws + WS_YEXP);
    const int* SLOT = (const int*)(p.ws + WS_SLOT);
    const float* XL1 = (const float*)(p.ws + WS_XL1);
    float* XL2 = (float*)(p.ws + WS_XL2);
    u16* H = (u16*)(p.ws + WS_H);
    for (int row = bid_() * 8 + w; row < nrows; row += gdim_() * 8) {
        f32x4 v[8];
#pragma unroll
        for (int i = 0; i < 8; ++i) v[i] = (f32x4){0.f, 0.f, 0.f, 0.f};
        for (int e = 0; e < NEXP; ++e) {
            const int sl = SLOT[(size_t)row * 16 + e];
            if (sl >= 0) {
                const u16* yp = YEXP + ((size_t)e * EPAD + sl) * D;
#pragma unroll
                for (int i = 0; i < 8; ++i) { const u32x2 q = *reinterpret_cast<const u32x2*>(yp + (i * 64 + lane) * 4); v[i][0] += bf_lo(q[0]); v[i][1] += bf_hi(q[0]); v[i][2] += bf_lo(q[1]); v[i][3] += bf_hi(q[1]); }
            }
        }
        float ss = 0.f;
#pragma unroll
        for (int i = 0; i < 8; ++i) ss += v[i][0] * v[i][0] + v[i][1] * v[i][1] + v[i][2] * v[i][2] + v[i][3] * v[i][3];
        ss = wave_sum(ss);
        const float rstd = rsqrtf(ss * (1.f / D) + 1e-6f);
        const float* g2 = mod_ptr(p, l, row, 5);
        const float* nw = p.norm_ffn_post + (size_t)l * D;
        float* dst = l == 0 ? XL2 + (size_t)row * D : p.out + (size_t)row * D;
        float ss2 = 0.f;
#pragma unroll
        for (int i = 0; i < 8; ++i) {
            const int col = (i * 64 + lane) * 4;
            const f32x4 x4 = *reinterpret_cast<const f32x4*>(XL1 + (size_t)row * D + col), w4 = *reinterpret_cast<const f32x4*>(nw + col), g4 = *reinterpret_cast<const f32x4*>(g2 + col);
            const f32x4 x2 = x4 + g4 * (v[i] * rstd * w4);
            *reinterpret_cast<f32x4*>(dst + col) = x2;
            v[i] = x2; ss2 += x2[0] * x2[0] + x2[1] * x2[1] + x2[2] * x2[2] + x2[3] * x2[3];
        }
        if (l == 0) {
            ss2 = wave_sum(ss2);
            const float rstd2 = rsqrtf(ss2 * (1.f / D) + 1e-6f);
            const float* sh = mod_ptr(p, 1, row, 0); const float* sc = mod_ptr(p, 1, row, 1);
            const float* nw1 = p.norm_mix_pre + D;
#pragma unroll
            for (int i = 0; i < 8; ++i) {
                const int col = (i * 64 + lane) * 4;
                const f32x4 w4 = *reinterpret_cast<const f32x4*>(nw1 + col), s4 = *reinterpret_cast<const f32x4*>(sc + col), h4 = *reinterpret_cast<const f32x4*>(sh + col);
                const f32x4 o = v[i] * rstd2 * w4 * (s4 + 1.f) + h4;
                u32x2 pk = {pk_bf16(o[0], o[1]), pk_bf16(o[2], o[3])};
                *reinterpret_cast<u32x2*>(H + (size_t)row * D + col) = pk;
            }
        }
    }
}

__global__ void __launch_bounds__(NT, 2) fwd_kernel(Params p) {
    extern __shared__ __attribute__((aligned(16))) unsigned char lds[];
    unsigned char* wlds = lds + 16;
    if (threadIdx.x == 0) *reinterpret_cast<uint4*>(lds) = make_uint4(0u, 0u, 0u, 0u);
    __syncthreads();
    XcdBarrier bar = xcd_barrier_post((unsigned*)(p.ws + WS_BAR), (volatile LAS unsigned*)lds);
#ifndef PH_MASK
#define PH_MASK 0xFFFFFFFFu
#endif
#ifndef PROBE_REP_MASK
#define PROBE_REP_MASK 0u
#endif
#define PHASE(id, body) do { if (((PH_MASK >> ((id) % 32)) & 1u) && p.ph_lo <= (id) && (id) < p.ph_hi) { \
    for (int _r = 0; _r < ((((unsigned)PROBE_REP_MASK >> ((id) % 32)) & 1u) ? 2 : 1); ++_r) { body; if ((id) + 1 < p.ph_hi || _r == 0) { if ((id) + 1 < p.ph_hi) xcd_barrier(bar); } } } } while (0)
    PHASE(0, { phase_mod(p, wlds); phase_convert_dense(p, wlds); });
    PHASE(1, { phase_norm_mod(p, 0); lru_prep_weights(p); });
#pragma unroll
    for (int l = 0; l < 2; ++l) {
        const int pb = 2 + 10 * l;
        {
            EpiDesc e; e.ob = (u16*)(p.ws + WS_P); e.of = nullptr; e.ldo = l == 0 ? AB_IN : CD_IN; e.gates = l == 0 ? (float*)(p.ws + WS_G) : nullptr; e.rscale = nullptr;
            PHASE(pb + 0, phase_gemm_dense<EPI_BF16>(p, (const u16*)(p.ws + WS_H), NTOK, (const u16*)(p.ws + (l == 0 ? WS_WT_ABIN : WS_WT_CDIN)), l == 0 ? AB_IN : CD_IN, e, wlds));
        }
        if (l == 0) {
            PHASE(pb + 1, phase_mlstm(p, wlds));
            PHASE(pb + 2, phase_l0_stage2(p, wlds));
        } else {
            PHASE(pb + 1, phase_l1_stage1(p, wlds));
            PHASE(pb + 2, phase_l1_stage2(p, wlds));
            PHASE(pb + 3, phase_l1_stage3(p, wlds));
        }
        {
            EpiDesc e; e.ob = nullptr; e.of = (float*)(p.ws + WS_Y); e.ldo = D; e.gates = nullptr; e.rscale = nullptr;
            PHASE(pb + 4, phase_gemm_dense<EPI_F32>(p, (const u16*)(p.ws + WS_YIN), l == 0 ? NTOK : NLAT, (const u16*)(p.ws + (l == 0 ? WS_WT_ABOUT : WS_WT_CDOUT)), D, e, wlds));
        }
        PHASE(pb + 5, phase_rowpass_mid(p, l, wlds));
        PHASE(pb + 6, { phase_topk(p, l, wlds); phase_convert_moe(p, l, wlds); });
        PHASE(pb + 7, phase_moe_a(p, l, wlds));
        PHASE(pb + 8, phase_moe_b(p, l, wlds));
        PHASE(pb + 9, phase_final(p, l));
    }
}


#ifdef DBG_STOP
__global__ void dbg_digest(const unsigned char* ws, size_t off, int kind, size_t nelem, float* out, size_t nout) {
    for (size_t i = (size_t)blockIdx.x * blockDim.x + threadIdx.x; i < nout; i += (size_t)gridDim.x * blockDim.x) {
        float v = 0.f;
        for (size_t j = i; j < nelem; j += nout) {
            if (kind == 0) v += bf2f(((const u16*)(ws + off))[j]);
            else if (kind == 1) v += ((const float*)(ws + off))[j];
            else v += (float)((const int*)(ws + off))[j];
        }
        out[i] = v;
    }
}
#endif
extern "C" void kernel_launch(void* const* d_in, const int* in_sizes, int n_in, void* d_out, int out_size, void* d_ws, size_t ws_size, hipStream_t stream) {
    static int grid = 0;
    if (grid == 0) {
        if (n_in != 27 || ws_size < WS_END) { fprintf(stderr, "kernel_launch: unexpected n_in %d / ws %zu (need %zu)\n", n_in, ws_size, (size_t)WS_END); grid = -1; return; }
        int dev = 0, cus = 0, per_cu = 0;
        hipGetDevice(&dev);
        hipDeviceGetAttribute(&cus, hipDeviceAttributeMultiprocessorCount, dev);
        if (hipFuncSetAttribute((const void*)fwd_kernel, hipFuncAttributeMaxDynamicSharedMemorySize, LDS_BYTES) != hipSuccess) { fprintf(stderr, "kernel_launch: hipFuncSetAttribute failed\n"); grid = -1; return; }
        hipOccupancyMaxActiveBlocksPerMultiprocessor(&per_cu, (const void*)fwd_kernel, NT, LDS_BYTES);
        (void)hipGetLastError();
        if (per_cu < 1) fprintf(stderr, "kernel_launch: occupancy query reports %d blocks per CU\n", per_cu);
        grid = cus > 0 ? cus : 256;
    }
    if (grid < 0) return;
    hipMemsetAsync((char*)d_ws + WS_BAR, 0, XCD_BAR_WORDS * sizeof(unsigned), stream);
    Params p; memset(&p, 0, sizeof(p));
    const float** f = (const float**)&p;
    for (int i = 0; i < 27; ++i) f[i] = (const float*)d_in[i];
    p.out = (float*)d_out; p.ws = (unsigned char*)d_ws;
#if N_LAUNCH_MODE == 1
    p.ph_lo = 0; p.ph_hi = NPH;
    hipLaunchKernelGGL(fwd_kernel, dim3(grid), dim3(NT), LDS_BYTES, stream, p);
#else
#ifdef DBG_STOP
    for (int ph = 0; ph <= DBG_STOP; ++ph) { p.ph_lo = ph; p.ph_hi = ph + 1; hipLaunchKernelGGL(fwd_kernel, dim3(grid), dim3(NT), LDS_BYTES, stream, p); }
    hipLaunchKernelGGL(dbg_digest, dim3(2048), dim3(256), 0, stream, (const unsigned char*)d_ws, (size_t)DBG_OFF, (int)DBG_KIND, (size_t)DBG_NELEM, (float*)d_out, (size_t)out_size);
#else
    for (int ph = 0; ph < NPH; ++ph) { p.ph_lo = ph; p.ph_hi = ph + 1; hipLaunchKernelGGL(fwd_kernel, dim3(grid), dim3(NT), LDS_BYTES, stream, p); }
#endif
#endif
}
```

```cpp
#include <hip/hip_runtime.h>
#include <stdint.h>
#include <stdio.h>
#include <string.h>

#ifndef N_LAUNCH_MODE
#define N_LAUNCH_MODE 1
#endif

typedef unsigned short u16;
typedef short bf16x8 __attribute__((ext_vector_type(8)));
typedef float f32x4 __attribute__((ext_vector_type(4)));
typedef unsigned u32x4 __attribute__((ext_vector_type(4)));
typedef unsigned u32x2 __attribute__((ext_vector_type(2)));

#define NT 512
constexpr int D = 2048, BATCH = 4, SEQ = 4096, LC = 256;
constexpr int NLAT = BATCH * SEQ, NCTX = BATCH * LC, NTOK = NLAT + NCTX;
constexpr int AB_IN = 7184, CD_IN = 3584;
constexpr int NEXP = 16, FF = 2048, EPAD = 2304;
constexpr int NPH = 22;
constexpr int LDS_BYTES = 150 * 1024;

constexpr size_t al256(size_t x) { return (x + 255) & ~(size_t)255; }
constexpr size_t WS_BAR = 0;
constexpr size_t WS_MOD = 16384;
constexpr size_t WS_XL1 = al256(WS_MOD + 2 * 5 * 12288 * 4);
constexpr size_t WS_XL2 = al256(WS_XL1 + (size_t)NTOK * D * 4);
constexpr size_t WS_H = al256(WS_XL2 + (size_t)NTOK * D * 4);
constexpr size_t WS_P = al256(WS_H + (size_t)NTOK * D * 2);
constexpr size_t WS_G = al256(WS_P + (size_t)NTOK * AB_IN * 2);
constexpr size_t WS_HM = al256(WS_G + (size_t)NTOK * 16 * 4);
constexpr size_t WS_YIN = al256(WS_HM + (size_t)2 * NTOK * 1024 * 2);
constexpr size_t WS_Y = al256(WS_YIN + (size_t)NTOK * D * 2);
constexpr size_t WS_AFF = al256(WS_Y + (size_t)NTOK * D * 4);
constexpr size_t WS_SLOT = al256(WS_AFF + (size_t)NTOK * 16 * 4);
constexpr size_t WS_EROW = al256(WS_SLOT + (size_t)NTOK * 16 * 4);
constexpr size_t WS_EGATE = al256(WS_EROW + (size_t)NEXP * EPAD * 4);
constexpr size_t WS_ACT = al256(WS_EGATE + (size_t)NEXP * EPAD * 4);
constexpr size_t WS_YEXP = al256(WS_ACT + (size_t)NEXP * EPAD * FF * 2);
constexpr size_t WS_LRUS = al256(WS_YEXP + (size_t)NEXP * EPAD * D * 2);
constexpr size_t WS_LRUW = al256(WS_LRUS + (size_t)2 * 2 * 4 * 68 * 1024 * 4);
constexpr size_t WS_WT_ABIN = al256(WS_LRUW + (size_t)32 * 128 * 128 * 2);
constexpr size_t WS_WT_ABOUT = al256(WS_WT_ABIN + (size_t)AB_IN * D * 2);
constexpr size_t WS_WT_CDIN = al256(WS_WT_ABOUT + (size_t)D * D * 2);
constexpr size_t WS_WT_CDOUT = al256(WS_WT_CDIN + (size_t)CD_IN * D * 2);
constexpr size_t WS_WT_W1 = al256(WS_WT_CDOUT + (size_t)D * D * 2);
constexpr size_t WS_WT_W3 = al256(WS_WT_W1 + (size_t)NEXP * D * FF * 2);
constexpr size_t WS_WT_W2 = al256(WS_WT_W3 + (size_t)NEXP * D * FF * 2);
constexpr size_t WS_END = al256(WS_WT_W2 + (size_t)NEXP * D * FF * 2);

struct Params {
    const float *x, *c, *ctx, *c_ctx, *ada_w, *ada_b, *norm_mix_pre, *norm_mix_post, *norm_ffn_pre, *norm_ffn_post;
    const float *ab_w_in, *ab_w_out, *mlstm_gate_b, *mlstm_norm, *na_rpb;
    const float *cd_w_in, *cd_w_out, *gqa_sink, *lru_conv_w, *lru_conv_b, *lru_gate_w, *lru_gate_b, *lru_lambda;
    const float *moe_router, *moe_w1, *moe_w3, *moe_w2;
    float* out;
    unsigned char* ws;
    int ph_lo, ph_hi;
};

#define XB_TMO      128
#define XB_XCNT(j)  (256  + 64 * (j))
#define XB_XSUB(j)  (1280 + 64 * (j))
#define XB_XGEN(j)  (2304 + 64 * (j))
#define XB_TOP      3328
#define XB_TOPGEN   3392
#define XCD_BAR_WORDS 3456
#define XB_SPIN_CAP (1u << 22)
#define LAS __attribute__((address_space(3)))

__device__ __forceinline__ unsigned xb_ld(unsigned* p)              { return __hip_atomic_load(p, __ATOMIC_RELAXED, __HIP_MEMORY_SCOPE_AGENT); }
__device__ __forceinline__ unsigned xb_add(unsigned* p, unsigned v) { return __hip_atomic_fetch_add(p, v, __ATOMIC_RELAXED, __HIP_MEMORY_SCOPE_AGENT); }
__device__ __forceinline__ unsigned xb_xcc_id() { return (unsigned)__builtin_amdgcn_s_getreg((3 << 11) | 20) & 0xFu; }
#define XB_SPIN(cond, bar) do { unsigned _sp = 0; while (cond) { __builtin_amdgcn_s_sleep(1); \
    if ((++_sp & 255u) == 0u) { if (xb_ld(&(bar)[XB_TMO])) break; if (_sp > XB_SPIN_CAP) { atomicAdd(&(bar)[XB_TMO], 1u); break; } } } } while (0)

struct XcdBarrier {
    unsigned* bar; unsigned x;
    volatile LAS unsigned* st;
};
__device__ __forceinline__ XcdBarrier xcd_barrier_post(unsigned* bar, volatile LAS unsigned* st) {
    XcdBarrier b; b.bar = bar; b.x = xb_xcc_id(); b.st = st;
    if (threadIdx.x == 0) (void)xb_add(&bar[XB_XCNT(b.x)], 1u);
    return b;
}
__device__ __forceinline__ void xcd_barrier_complete(unsigned* bar, unsigned x, unsigned& nloc, unsigned& nx) {
    const unsigned G = gridDim.x * gridDim.y * gridDim.z;
    unsigned sum, cnt, mine, sp = 0u;
    for (;;) {
        sum = 0u; cnt = 0u; mine = 0u;
#pragma unroll
        for (unsigned j = 0; j < 16; ++j) { const unsigned c = xb_ld(&bar[XB_XCNT(j)]); sum += c; cnt += (c > 0u) ? 1u : 0u; mine = (j == x) ? c : mine; }
        if (sum == G) break;
        __builtin_amdgcn_s_sleep(1);
        if ((++sp & 255u) == 0u) { if (xb_ld(&bar[XB_TMO])) break; if (sp > XB_SPIN_CAP) { atomicAdd(&bar[XB_TMO], 1u); break; } }
    }
    nloc = mine > 0u ? mine : 1u; nx = cnt > 0u ? cnt : 1u;
}
__device__ __forceinline__ void xcd_barrier(const XcdBarrier& b) {
    asm volatile("s_waitcnt vmcnt(0)" ::: "memory");
    __syncthreads();
    if (threadIdx.x == 0) {
        unsigned* bar = b.bar;
        __builtin_amdgcn_s_waitcnt(0);
        unsigned nloc = b.st[0], nx = b.st[1];
        if (nloc == 0u) { xcd_barrier_complete(bar, b.x, nloc, nx); b.st[0] = nloc; b.st[1] = nx; }
        const unsigned old = xb_add(&bar[XB_XSUB(b.x)], 1u);
        const unsigned gen = old / nloc;
        if (old + 1u == (gen + 1u) * nloc) {
            __builtin_amdgcn_fence(__ATOMIC_RELEASE, "agent");
            asm volatile("s_waitcnt vmcnt(0)" ::: "memory");
            const unsigned og = xb_add(&bar[XB_TOP], 1u);
            const unsigned tg = og / nx;
            if (og + 1u == (tg + 1u) * nx) xb_add(&bar[XB_TOPGEN], 1u);
            else XB_SPIN(xb_ld(&bar[XB_TOPGEN]) == tg, bar);
            __builtin_amdgcn_fence(__ATOMIC_ACQUIRE, "agent");
            xb_add(&bar[XB_XGEN(b.x)], 1u);
            asm volatile("s_waitcnt vmcnt(0)" ::: "memory");
        } else {
            XB_SPIN(xb_ld(&bar[XB_XGEN(b.x)]) == gen, bar);
            __builtin_amdgcn_fence(__ATOMIC_ACQUIRE, "agent");
            asm volatile("s_waitcnt vmcnt(0)" ::: "memory");
        }
    }
    __syncthreads();
}

typedef float f32x2_t __attribute__((ext_vector_type(2)));
typedef __bf16 bf16x2_t __attribute__((ext_vector_type(2)));
__device__ __forceinline__ unsigned pk_bf16(float lo, float hi) { f32x2_t v = {lo, hi}; return __builtin_bit_cast(unsigned, __builtin_convertvector(v, bf16x2_t)); }
__device__ __forceinline__ float bf_lo(unsigned u) { return __uint_as_float(u << 16); }
__device__ __forceinline__ float bf_hi(unsigned u) { return __uint_as_float(u & 0xffff0000u); }
__device__ __forceinline__ float bf2f(u16 v) { return __uint_as_float(((unsigned)v) << 16); }
__device__ __forceinline__ u16 f2bf(float f) { return (u16)(pk_bf16(f, 0.f) & 0xffffu); }
template <int CTRL> __device__ __forceinline__ float dpp_f(float v) { return __uint_as_float((unsigned)__builtin_amdgcn_update_dpp(0, (int)__float_as_uint(v), CTRL, 0xf, 0xf, true)); }
__device__ __forceinline__ float row_sum16(float v) { v += dpp_f<0xB1>(v); v += dpp_f<0x4E>(v); v += dpp_f<0x141>(v); v += dpp_f<0x140>(v); return v; }
__device__ __forceinline__ float row_max16(float v) { v = fmaxf(v, dpp_f<0xB1>(v)); v = fmaxf(v, dpp_f<0x4E>(v)); v = fmaxf(v, dpp_f<0x141>(v)); v = fmaxf(v, dpp_f<0x140>(v)); return v; }
__device__ __forceinline__ float rdlane_f(float v, int l) { return __uint_as_float((unsigned)__builtin_amdgcn_readlane((int)__float_as_uint(v), l)); }
__device__ __forceinline__ float wave_sum(float v) { v = row_sum16(v); return (rdlane_f(v, 0) + rdlane_f(v, 16)) + (rdlane_f(v, 32) + rdlane_f(v, 48)); }
__device__ __forceinline__ float wave_max(float v) { v = row_max16(v); return fmaxf(fmaxf(rdlane_f(v, 0), rdlane_f(v, 16)), fmaxf(rdlane_f(v, 32), rdlane_f(v, 48))); }
__device__ __forceinline__ int tid_() { int t = threadIdx.x; asm volatile("" : "+v"(t)); return t; }
__device__ __forceinline__ int bid_() { int b = blockIdx.x; asm volatile("" : "+s"(b)); return b; }
__device__ __forceinline__ int gdim_() { int b = gridDim.x; asm volatile("" : "+s"(b)); return b; }
__device__ __forceinline__ float sigmoidf_(float x) { return 1.f / (1.f + __expf(-x)); }
__device__ __forceinline__ f32x4 mfma16(bf16x8 a, bf16x8 b, f32x4 c) { return __builtin_amdgcn_mfma_f32_16x16x32_bf16(a, b, c, 0, 0, 0); }
__device__ __forceinline__ bf16x8 ld_frag_g(const u16* p) { return *reinterpret_cast<const bf16x8*>(p); }
__device__ __forceinline__ bf16x8 ld_frag_s(const u16* p) { return *reinterpret_cast<const bf16x8*>(p); }
__device__ __forceinline__ bf16x8 mk_frag(unsigned a, unsigned b, unsigned c, unsigned d) { u32x4 v = {a, b, c, d}; return __builtin_bit_cast(bf16x8, v); }

__device__ __forceinline__ const float* xin_row(const Params& p, int l, int row) {
    if (l == 0) return row < NLAT ? p.x + (size_t)row * D : p.ctx + (size_t)(row - NLAT) * D;
    return (const float*)(p.ws + WS_XL2) + (size_t)row * D;
}
__device__ __forceinline__ const float* mod_ptr(const Params& p, int l, int row, int chunk) {
    const int bb = row < NLAT ? (row >> 12) : 4;
    return (const float*)(p.ws + WS_MOD) + ((size_t)(l * 5 + bb) * 6 + chunk) * D;
}

__device__ void phase_mod(const Params& p, unsigned char* lds_raw) {
    float* scond = (float*)lds_raw;
    float* red = scond + 5 * D;
    const int t = tid_();
    for (int i = t; i < 5 * D; i += NT) { const int r = i >> 11, k = i & 2047; const float v = r < 4 ? p.c[r * D + k] : p.c_ctx[k]; scond[i] = v / (1.f + __expf(-v)); }
    __syncthreads();
    float* mod = (float*)(p.ws + WS_MOD);
    for (int item = bid_(); item < 192; item += gdim_()) {
        const int l = item / 96, col0 = (item % 96) * 128;
        const int kg = t >> 5, cl = (t & 31) * 4;
        f32x4 acc[5];
#pragma unroll
        for (int r = 0; r < 5; ++r) acc[r] = (f32x4){0.f, 0.f, 0.f, 0.f};
        const float* wp = p.ada_w + ((size_t)l * D + kg * 128) * (6 * D) + col0 + cl;
#pragma unroll 8
        for (int kk = 0; kk < 128; ++kk) {
            const f32x4 w = *reinterpret_cast<const f32x4*>(wp + (size_t)kk * (6 * D));
#pragma unroll
            for (int r = 0; r < 5; ++r) { const float s = scond[r * D + kg * 128 + kk]; acc[r] += w * s; }
        }
#pragma unroll
        for (int r = 0; r < 5; ++r) *reinterpret_cast<f32x4*>(red + (kg * 5 + r) * 128 + cl) = acc[r];
        __syncthreads();
        for (int o = t; o < 640; o += NT) {
            const int r = o >> 7, cc = o & 127;
            float s = p.ada_b[l * 6 * D + col0 + cc];
#pragma unroll
            for (int g = 0; g < 16; ++g) s += red[(g * 5 + r) * 128 + cc];
            mod[(size_t)(l * 5 + r) * 6 * D + col0 + cc] = s;
        }
        __syncthreads();
    }
}

__device__ void phase_norm_mod(const Params& p, int l) {
    const int lane = tid_() & 63, w = tid_() >> 6;
    u16* H = (u16*)(p.ws + WS_H);
    for (int row = bid_() * 8 + w; row < NTOK; row += gdim_() * 8) {
        const float* xr = xin_row(p, l, row);
        f32x4 v[8]; float ss = 0.f;
#pragma unroll
        for (int i = 0; i < 8; ++i) { v[i] = *reinterpret_cast<const f32x4*>(xr + (i * 64 + lane) * 4); ss += v[i][0] * v[i][0] + v[i][1] * v[i][1] + v[i][2] * v[i][2] + v[i][3] * v[i][3]; }
        ss = wave_sum(ss);
        const float rstd = rsqrtf(ss * (1.f / D) + 1e-6f);
        const float* sh = mod_ptr(p, l, row, 0); const float* sc = mod_ptr(p, l, row, 1);
        const float* nw = p.norm_mix_pre + (size_t)l * D;
#pragma unroll
        for (int i = 0; i < 8; ++i) {
            const int col = (i * 64 + lane) * 4;
            const f32x4 w4 = *reinterpret_cast<const f32x4*>(nw + col), s4 = *reinterpret_cast<const f32x4*>(sc + col), h4 = *reinterpret_cast<const f32x4*>(sh + col);
            f32x4 o = v[i] * rstd * w4 * (s4 + 1.f) + h4;
            u32x2 pk = {pk_bf16(o[0], o[1]), pk_bf16(o[2], o[3])};
            *reinterpret_cast<u32x2*>(H + (size_t)row * D + col) = pk;
        }
    }
}

__device__ __forceinline__ void convert_item(const float* W, int N, u16* Wt, int kb, int nb, unsigned char* lds) {
    const int t = tid_(), lane = t & 63, w = t >> 6;
    const int n4 = lane * 4, k0 = kb * 64 + w * 8, n0 = nb * 256;
    int col = n0 + n4; if (col > N - 4) col = N - 4;
    f32x4 r8[8];
#pragma unroll
    for (int j = 0; j < 8; ++j) r8[j] = *reinterpret_cast<const f32x4*>(W + (size_t)(k0 + j) * N + col);
    __syncthreads();
#pragma unroll
    for (int jj = 0; jj < 4; ++jj) {
        u32x4 v = {pk_bf16(r8[0][jj], r8[1][jj]), pk_bf16(r8[2][jj], r8[3][jj]), pk_bf16(r8[4][jj], r8[5][jj]), pk_bf16(r8[6][jj], r8[7][jj])};
        const int r = n4 + jj;
        *reinterpret_cast<u32x4*>(lds + r * 128 + ((w ^ ((r >> 2) & 7)) << 4)) = v;
    }
    __syncthreads();
    const int c = t & 7;
#pragma unroll
    for (int i = 0; i < 4; ++i) {
        const int r = (t >> 3) + 64 * i;
        if (n0 + r < N) {
            const u32x4 v = *reinterpret_cast<const u32x4*>(lds + r * 128 + ((c ^ ((r >> 2) & 7)) << 4));
            *reinterpret_cast<u32x4*>(Wt + (size_t)(n0 + r) * 2048 + ((kb * 64 + c * 8 + 64 * ((n0 + r) & 31)) & 2047)) = v;
        }
    }
}
__device__ void convert_matrix_items(const float* W, int N, u16* Wt, int first, int count, unsigned char* lds) {
    const int nnb = (N + 255) / 256;
    for (int it = first; it < first + count; ++it) convert_item(W, N, Wt, it / nnb, it % nnb, lds);
}
__device__ void phase_convert_dense(const Params& p, unsigned char* lds) {
    for (int item = bid_(); item < 1888; item += gdim_()) {
        if (item < 928) convert_item(p.ab_w_in, AB_IN, (u16*)(p.ws + WS_WT_ABIN), item / 29, item % 29, lds);
        else if (item < 1184) { const int it = item - 928; convert_item(p.ab_w_out, D, (u16*)(p.ws + WS_WT_ABOUT), it / 8, it % 8, lds); }
        else if (item < 1632) { const int it = item - 1184; convert_item(p.cd_w_in, CD_IN, (u16*)(p.ws + WS_WT_CDIN), it / 14, it % 14, lds); }
        else { const int it = item - 1632; convert_item(p.cd_w_out, D, (u16*)(p.ws + WS_WT_CDOUT), it / 8, it % 8, lds); }
    }
}
__device__ void phase_convert_moe(const Params& p, int l, unsigned char* lds) {
    for (int item = bid_(); item < 3 * NEXP * 256; item += gdim_()) {
        const int which = item / (NEXP * 256), r = item % (NEXP * 256), ex = r >> 8, it = r & 255;
        const float* src = (which == 0 ? p.moe_w1 : (which == 1 ? p.moe_w3 : p.moe_w2)) + (size_t)(l * NEXP + ex) * D * FF;
        u16* dst = (u16*)(p.ws + (which == 0 ? WS_WT_W1 : (which == 1 ? WS_WT_W3 : WS_WT_W2))) + (size_t)ex * D * FF;
        convert_item(src, 2048, dst, it >> 3, it & 7, lds);
    }
}

struct GemmDesc {
    const u16* A; int lda; const int* arow; int mvalid; int m0;
    const u16* B0; const u16* B1; int n0; int ncols;
    int K;
};
enum { EPI_BF16 = 0, EPI_F32 = 1, EPI_SWIGLU = 2, EPI_SCALE = 3 };
struct EpiDesc { u16* ob; float* of; int ldo; float* gates; const float* rscale; };
constexpr int GEMM_BUF = 65536, GEMM_BOFF = 32768;

template <int EPI>
__device__ __forceinline__ void gemm_tile(const GemmDesc& g, const EpiDesc& e, unsigned char* lds) {
    const int t = tid_(), lane = t & 63, w = t >> 6;
    const int wr = w >> 2, wc = w & 3, fr = lane & 15, fq = lane >> 4;
    const int ac = t & 7, ar = t >> 3;
    const int kofs = (ac ^ ((ar >> 1) & 7)) << 3;
    unsigned ap[4], bpo[4];
#pragma unroll
    for (int i = 0; i < 4; ++i) {
        int r = g.m0 + ar + 64 * i; if (r >= g.mvalid) r = g.mvalid - 1;
        const int src = g.arow ? g.arow[r] : r;
        ap[i] = ((unsigned)src * 2048u + kofs) * 2u;
        const int np = ar + 64 * i;
        if (EPI == EPI_SWIGLU) {
            const int which = (np >> 5) & 1, ffl = (np >> 6) * 32 + (np & 31);
            bpo[i] = ((unsigned)(g.n0 + ffl) * 2048u) * 2u + (which ? (unsigned)(WS_WT_W3 - WS_WT_W1) : 0u);
        } else {
            int n = g.n0 + np; if (n >= g.ncols) n = g.ncols - 1;
            bpo[i] = ((unsigned)n * 2048u) * 2u;
        }
    }
    const int d_off = t * 16;
    const int s0 = (fr >> 1) & 7;
    const int a_rd0 = wr * 16384 + fr * 128 + ((fq ^ s0) << 4), a_rd1 = a_rd0 ^ 64;
    const int b_rd0 = GEMM_BOFF + wc * 8192 + fr * 128 + ((fq ^ s0) << 4), b_rd1 = b_rd0 ^ 64;

    f32x4 acc[8][4];
#pragma unroll
    for (int i = 0; i < 8; ++i)
#pragma unroll
        for (int j = 0; j < 4; ++j) acc[i][j] = (f32x4){0.f, 0.f, 0.f, 0.f};

    constexpr int nk = 2048 >> 6;
    const unsigned brot = (unsigned)(kofs * 2 + (ar & 31) * 128);
#define G_DMA(BUF, KT) do { const unsigned _k = (unsigned)(KT) << 7; \
    const unsigned char* _ab = (const unsigned char*)g.A + _k; const unsigned char* _bb = (const unsigned char*)g.B0; \
    asm volatile("" : "+s"(_ab), "+s"(_bb));     \
    const unsigned _kb = (_k + brot) & 4095u; \
    _Pragma("unroll") for (int i = 0; i < 4; ++i) __builtin_amdgcn_global_load_lds((const unsigned*)(_ab + ap[i]), (unsigned*)((BUF) + d_off + i * 8192), 16, 0, 0); \
    _Pragma("unroll") for (int i = 0; i < 4; ++i) __builtin_amdgcn_global_load_lds((const unsigned*)(_bb + (bpo[i] + _kb)), (unsigned*)((BUF) + GEMM_BOFF + d_off + i * 8192), 16, 0, 0); } while (0)
    G_DMA(lds, 0);
    for (int kt = 0; kt < nk; ++kt) {
        unsigned char* buf = lds + (kt & 1) * GEMM_BUF;
        asm volatile("s_waitcnt vmcnt(0)" ::: "memory");
        __syncthreads();
        if (kt + 1 < nk) G_DMA(lds + ((kt + 1) & 1) * GEMM_BUF, kt + 1);
#define RD_A(KK, MI) (*reinterpret_cast<const bf16x8*>(buf + (((KK) ? a_rd1 : a_rd0) + (MI) * 2048)))
#define RD_B(KK, NI) (*reinterpret_cast<const bf16x8*>(buf + (((KK) ? b_rd1 : b_rd0) + (NI) * 2048)))
        bf16x8 bq[2][4], aq[2][2];
#pragma unroll
        for (int ni = 0; ni < 4; ++ni) bq[0][ni] = RD_B(0, ni);
        aq[0][0] = RD_A(0, 0); aq[0][1] = RD_A(0, 1);
#define G_STEP(ST) do { \
        constexpr int kk = (ST) >> 2, pr = (ST) & 3, cur = (ST) & 1, nxt = cur ^ 1, nkk = ((ST) + 1) >> 2, npr = ((ST) + 1) & 3; \
        if ((ST) < 7) { \
            if (npr == 0) { _Pragma("unroll") for (int ni = 0; ni < 4; ++ni) bq[nkk & 1][ni] = RD_B(nkk & 1, ni); } \
            aq[nxt][0] = RD_A(nkk & 1, npr * 2); aq[nxt][1] = RD_A(nkk & 1, npr * 2 + 1); } \
        _Pragma("unroll") for (int h2 = 0; h2 < 2; ++h2) \
            _Pragma("unroll") for (int ni = 0; ni < 4; ++ni) acc[pr * 2 + h2][ni] = mfma16(bq[kk][ni], aq[cur][h2], acc[pr * 2 + h2][ni]); \
        __builtin_amdgcn_sched_group_barrier(0x100, ((ST) < 7) ? (npr == 0 ? 6 : 2) : 0, 0); \
        __builtin_amdgcn_sched_group_barrier(0x008, 8, 0); } while (0)
        G_STEP(0); G_STEP(1); G_STEP(2); G_STEP(3); G_STEP(4); G_STEP(5); G_STEP(6); G_STEP(7);
#undef G_STEP
#undef RD_A
#undef RD_B
    }
#undef G_DMA
#pragma unroll
    for (int mi = 0; mi < 8; ++mi) {
        const int row = g.m0 + wr * 128 + mi * 16 + fr;
        if (row < g.mvalid) {
            if (EPI == EPI_BF16) {
#pragma unroll
                for (int ni = 0; ni < 4; ++ni) {
                    const int col = g.n0 + wc * 64 + ni * 16 + 4 * fq;
                    if (col < g.ncols) {
                        const f32x4 v = acc[mi][ni];
                        u32x2 pk = {pk_bf16(v[0], v[1]), pk_bf16(v[2], v[3])};
                        *reinterpret_cast<u32x2*>(e.ob + (size_t)row * e.ldo + col) = pk;
                        if (e.gates && col >= 4096 && col < 4112) *reinterpret_cast<f32x4*>(e.gates + (size_t)row * 16 + (col - 4096)) = v;
                    }
                }
            } else if (EPI == EPI_F32) {
#pragma unroll
                for (int ni = 0; ni < 4; ++ni) {
                    const int col = g.n0 + wc * 64 + ni * 16 + 4 * fq;
                    *reinterpret_cast<f32x4*>(e.of + (size_t)row * e.ldo + col) = acc[mi][ni];
                }
            } else if (EPI == EPI_SWIGLU) {
#pragma unroll
                for (int ni = 0; ni < 2; ++ni) {
                    const int col = g.n0 + wc * 32 + ni * 16 + 4 * fq;
                    const f32x4 u = acc[mi][ni], v = acc[mi][ni + 2];
                    f32x4 a;
#pragma unroll
                    for (int q = 0; q < 4; ++q) a[q] = u[q] / (1.f + __expf(-u[q])) * v[q];
                    u32x2 pk = {pk_bf16(a[0], a[1]), pk_bf16(a[2], a[3])};
                    *reinterpret_cast<u32x2*>(e.ob + (size_t)row * e.ldo + col) = pk;
                }
            } else {
                const float sc = e.rscale[row];
#pragma unroll
                for (int ni = 0; ni < 4; ++ni) {
                    const int col = g.n0 + wc * 64 + ni * 16 + 4 * fq;
                    const f32x4 v = acc[mi][ni] * sc;
                    u32x2 pk = {pk_bf16(v[0], v[1]), pk_bf16(v[2], v[3])};
                    *reinterpret_cast<u32x2*>(e.ob + (size_t)row * e.ldo + col) = pk;
                }
            }
        }
    }
    __syncthreads();
}

template <int EPI>
__device__ void phase_gemm_dense(const Params& p, const u16* A, int M, const u16* Wt, int N, EpiDesc e, unsigned char* lds) {
    const int nM = M / 256, nN = (N + 255) / 256, L = nM * nN;
    const int xcd = bid_() & 7, slot = bid_() >> 3, nslot = gdim_() >> 3;
    const int base = (int)(((long)L * xcd) >> 3), cnt = (int)(((long)L * (xcd + 1)) >> 3) - base;
    const int G8 = nM >> 3, rem = nM & 7;
    for (int k = slot; k < cnt; k += nslot) {
        const int idx = base + k;
        int pn, pm;
        if (idx < G8 * 8 * nN) { const int gq = idx / (8 * nN), r = idx % (8 * nN); pn = r >> 3; pm = gq * 8 + (r & 7); }
        else { const int r = idx - G8 * 8 * nN; pn = r / rem; pm = G8 * 8 + r % rem; }
        GemmDesc g; g.A = A; g.lda = D; g.arow = nullptr; g.mvalid = M; g.m0 = pm * 256;
        g.B0 = Wt; g.B1 = nullptr; g.n0 = pn * 256; g.ncols = N; g.K = D;
        gemm_tile<EPI>(g, e, lds);
    }
}

__device__ void phase_moe_a(const Params& p, int l, unsigned char* lds) {
    const int mvalid = l == 0 ? 2176 : 2048, nM = l == 0 ? 9 : 8;
    const int per_e = nM * 16;
    const int xcd = bid_() & 7, slot = bid_() >> 3, nslot = gdim_() >> 3;
    for (int k = slot; k < 2 * per_e; k += nslot) {
        const int tile = xcd * 2 * per_e + k;
        const int ex = tile / per_e, r = tile % per_e, pn = r / nM, pm = r % nM;
        GemmDesc g; g.A = (const u16*)(p.ws + WS_H); g.lda = D; g.arow = (const int*)(p.ws + WS_EROW) + ex * EPAD; g.mvalid = mvalid; g.m0 = pm * 256;
        g.B0 = (const u16*)(p.ws + WS_WT_W1) + (size_t)ex * D * FF; g.B1 = (const u16*)(p.ws + WS_WT_W3) + (size_t)ex * D * FF; g.n0 = pn * 128; g.ncols = FF; g.K = D;
        EpiDesc e; e.ob = (u16*)(p.ws + WS_ACT) + (size_t)ex * EPAD * FF; e.of = nullptr; e.ldo = FF; e.gates = nullptr; e.rscale = nullptr;
        gemm_tile<EPI_SWIGLU>(g, e, lds);
    }
}
__device__ void phase_moe_b(const Params& p, int l, unsigned char* lds) {
    const int mvalid = l == 0 ? 2176 : 2048, nM = l == 0 ? 9 : 8;
    const int per_e = nM * 8;
    const int xcd = bid_() & 7, slot = bid_() >> 3, nslot = gdim_() >> 3;
    for (int k = slot; k < 2 * per_e; k += nslot) {
        const int tile = xcd * 2 * per_e + k;
        const int ex = tile / per_e, r = tile % per_e, pn = r / nM, pm = r % nM;
        GemmDesc g; g.A = (const u16*)(p.ws + WS_ACT) + (size_t)ex * EPAD * FF; g.lda = FF; g.arow = nullptr; g.mvalid = mvalid; g.m0 = pm * 256;
        g.B0 = (const u16*)(p.ws + WS_WT_W2) + (size_t)ex * D * FF; g.B1 = nullptr; g.n0 = pn * 256; g.ncols = D; g.K = FF;
        EpiDesc e; e.ob = (u16*)(p.ws + WS_YEXP) + (size_t)ex * EPAD * D; e.of = nullptr; e.ldo = D; e.gates = nullptr; e.rscale = (const float*)(p.ws + WS_EGATE) + ex * EPAD;
        gemm_tile<EPI_SCALE>(g, e, lds);
    }
}

__device__ __forceinline__ int mlstm_row(int b, int dir, int pos) {
    if (pos < LC) return NLAT + b * LC + (dir ? (LC - 1 - pos) : pos);
    const int q = pos - LC; return b * SEQ + (dir ? (SEQ - 1 - q) : q);
}
__device__ void phase_mlstm(const Params& p, unsigned char* lds) {
    u16* KT = (u16*)lds;
    u16* VT = KT + 256 * 72;
    u16* VWT = VT + 48 * 72;
    u16* CT = VWT + 48 * 72;
    u16* Ss = CT + 48 * 264;
    float* gB = (float*)(Ss + 64 * 72);
    float* gI = gB + 68 * 64;
    float* gP = gI + 68 * 64;
    float* gE = gP + 68 * 64;
    const int t = tid_(), lane = t & 63, w = t >> 6, fr = lane & 15, fq = lane >> 4;
    const u16* P = (const u16*)(p.ws + WS_P);
    const float* G = (const float*)(p.ws + WS_G);
    u16* HM = (u16*)(p.ws + WS_HM);
    for (int item = bid_(); item < 256; item += gdim_()) {
        const int vs = item & 7, dir = (item >> 3) & 1, hh = (item >> 4) & 3, b = item >> 6;
        __syncthreads();
        for (int i = t; i < 48 * 264; i += NT) CT[i] = 0;
        for (int i = t; i < 16 * 72; i += NT) { const int er = i / 72; VT[32 * 72 + i] = (er == 0) ? (u16)0x3f80 : (u16)0; VWT[32 * 72 + i] = 0; }
        {
            const float gb_i = p.mlstm_gate_b[(dir * 2 + 0) * 4 + hh], gb_f = p.mlstm_gate_b[(dir * 2 + 1) * 4 + hh];
            for (int ch = w; ch < 68; ch += 8) {
                const int row = mlstm_row(b, dir, ch * 64 + lane);
                const float gi = G[(size_t)row * 16 + dir * 8 + hh] + gb_i;
                const float gf = G[(size_t)row * 16 + dir * 8 + 4 + hh] + gb_f;
                const float lf = fminf(gf, 0.f) - log1pf(__expf(-fabsf(gf)));
                float bc = lf;
#pragma unroll
                for (int o = 1; o < 64; o <<= 1) { const float n = __shfl_up(bc, o, 64); if (lane >= o) bc += n; }
                float pm = gi - bc;
#pragma unroll
                for (int o = 1; o < 64; o <<= 1) { const float n = __shfl_up(pm, o, 64); if (lane >= o) pm = fmaxf(pm, n); }
                const float b63 = __shfl(bc, 63, 64);
                float gmax = b63 - bc + gi;
#pragma unroll
                for (int o = 32; o > 0; o >>= 1) gmax = fmaxf(gmax, __shfl_xor(gmax, o, 64));
                gB[ch * 64 + lane] = bc; gI[ch * 64 + lane] = gi; gP[ch * 64 + lane] = pm;
                if (lane == 0) { gE[ch * 2] = b63; gE[ch * 2 + 1] = gmax; }
            }
        }
        f32x4 Cacc[2][3];
#pragma unroll
        for (int i = 0; i < 2; ++i)
#pragma unroll
            for (int j = 0; j < 3; ++j) Cacc[i][j] = (f32x4){0.f, 0.f, 0.f, 0.f};
        float m_old = 0.f;
        const int jt = w & 3, sth = w >> 2;
        const int vs_s = t & 63, vs_eg = t >> 6;
        bf16x8 qf[8], kf[8]; unsigned ktr[2][8]; u32x2 vraw;
        const int jq = jt * 16 + fr, jjq = dir ? 63 - jq : jq;
        const unsigned off_q = (unsigned)jjq * AB_IN + hh * 256 + fq * 8;
        const int jk0 = (sth * 2) * 16 + fr, jk1 = jk0 + 16;
        const unsigned off_k0 = (unsigned)(dir ? 63 - jk0 : jk0) * AB_IN + 1024 + hh * 256 + fq * 8;
        const unsigned off_k1 = (unsigned)(dir ? 63 - jk1 : jk1) * AB_IN + 1024 + hh * 256 + fq * 8;
        unsigned off_kt[2];
#pragma unroll
        for (int i = 0; i < 2; ++i) { const int mt = t + NT * i, d2 = (mt & 127) * 2, s8 = (mt >> 7) * 8; off_kt[i] = (unsigned)(dir ? 63 - s8 - 7 : s8) * AB_IN + 1024 + hh * 256 + d2; }
        const unsigned off_v = (unsigned)(dir ? 63 - vs_s : vs_s) * AB_IN + 2048 + hh * 256 + vs * 32 + vs_eg * 4;
        const unsigned off_h = (unsigned)jjq * 1024 + hh * 256 + vs * 32 + sth * 16 + 4 * fq;
#define ML_BASE(POS0) (P + (size_t)(dir ? mlstm_row(b, dir, (POS0)) - 63 : mlstm_row(b, dir, (POS0))) * AB_IN)
#define ML_LOAD_Q(POS0) do { const u16* _pc = ML_BASE(POS0); \
            _Pragma("unroll") for (int kk = 0; kk < 8; ++kk) qf[kk] = ld_frag_g(_pc + off_q + kk * 32); } while (0)
#define ML_LOAD_K(POS0, S2) do { const u16* _pc = ML_BASE(POS0); \
            _Pragma("unroll") for (int kk = 0; kk < 8; ++kk) kf[kk] = ld_frag_g(_pc + ((S2) ? off_k1 : off_k0) + kk * 32); } while (0)
#define ML_LOAD_KTV(POS0) do { const u16* _pc = ML_BASE(POS0); \
            _Pragma("unroll") for (int i = 0; i < 2; ++i) { \
                _Pragma("unroll") for (int q = 0; q < 8; ++q) ktr[i][q] = *reinterpret_cast<const unsigned*>(_pc + (size_t)((dir ? 7 - q : q) * AB_IN) + off_kt[i]); } \
            vraw = *reinterpret_cast<const u32x2*>(_pc + off_v); } while (0)
        ML_LOAD_Q(0);
        __syncthreads();
        for (int ch = 0; ch < 68; ++ch) {
            const int pos0 = ch * 64;
            const float* sb = gB + ch * 64; const float* sig = gI + ch * 64; const float* spm = gP + ch * 64;
            const float b63 = gE[ch * 2], m_new = fmaxf(b63 + m_old, gE[ch * 2 + 1]), decay = __expf(b63 + m_old - m_new);
            const int jg = jt * 16 + fr;
            const float bj = sb[jg], mj = bj + fmaxf(m_old, spm[jg]);
            auto s_tile = [&](int st) {
                f32x4 sv = (f32x4){0.f, 0.f, 0.f, 0.f};
                if (st <= jt) {
#pragma unroll
                    for (int kk = 0; kk < 8; ++kk) sv = mfma16(kf[kk], qf[kk], sv);
                }
                float pv[4];
#pragma unroll
                for (int q = 0; q < 4; ++q) {
                    const int sg = st * 16 + 4 * fq + q;
                    pv[q] = (sg <= jg) ? sv[q] * 0.0625f * __expf(bj - sb[sg] + sig[sg] - mj) : 0.f;
                }
                u32x2 pk = {pk_bf16(pv[0], pv[1]), pk_bf16(pv[2], pv[3])};
                *reinterpret_cast<u32x2*>(Ss + jg * 72 + st * 16 + 4 * fq) = pk;
            };
            ML_LOAD_KTV(pos0);
            if (sth * 2 <= jt) ML_LOAD_K(pos0, 0);
#pragma unroll
            for (int i = 0; i < 2; ++i) {
                const int mt = t + NT * i, d2 = (mt & 127) * 2, s8 = (mt >> 7) * 8;
                u32x4 lo = {(ktr[i][0] & 0xffffu) | (ktr[i][1] << 16), (ktr[i][2] & 0xffffu) | (ktr[i][3] << 16), (ktr[i][4] & 0xffffu) | (ktr[i][5] << 16), (ktr[i][6] & 0xffffu) | (ktr[i][7] << 16)};
                u32x4 hi = {(ktr[i][0] >> 16) | (ktr[i][1] & 0xffff0000u), (ktr[i][2] >> 16) | (ktr[i][3] & 0xffff0000u), (ktr[i][4] >> 16) | (ktr[i][5] & 0xffff0000u), (ktr[i][6] >> 16) | (ktr[i][7] & 0xffff0000u)};
                *reinterpret_cast<u32x4*>(KT + d2 * 72 + s8) = lo;
                *reinterpret_cast<u32x4*>(KT + (d2 + 1) * 72 + s8) = hi;
            }
            {
                const float wg = __expf(b63 - sb[vs_s] + sig[vs_s] - m_new) * 0.0625f;
                const float v0 = bf_lo(vraw[0]), v1 = bf_hi(vraw[0]), v2 = bf_lo(vraw[1]), v3 = bf_hi(vraw[1]);
                const int e0 = vs_eg * 4;
                VT[(e0 + 0) * 72 + vs_s] = (u16)(vraw[0] & 0xffffu); VT[(e0 + 1) * 72 + vs_s] = (u16)(vraw[0] >> 16);
                VT[(e0 + 2) * 72 + vs_s] = (u16)(vraw[1] & 0xffffu); VT[(e0 + 3) * 72 + vs_s] = (u16)(vraw[1] >> 16);
                VWT[(e0 + 0) * 72 + vs_s] = f2bf(v0 * wg); VWT[(e0 + 1) * 72 + vs_s] = f2bf(v1 * wg);
                VWT[(e0 + 2) * 72 + vs_s] = f2bf(v2 * wg); VWT[(e0 + 3) * 72 + vs_s] = f2bf(v3 * wg);
                if (t < 64) VWT[32 * 72 + t] = f2bf(wg);
            }
            s_tile(sth * 2);
            if (sth * 2 + 1 <= jt) ML_LOAD_K(pos0, 1);
            s_tile(sth * 2 + 1);
            __syncthreads();
            {
                const float w_inter = __expf(bj + m_old - mj);
                f32x4 nacc[2];
#pragma unroll
                for (int z = 0; z < 2; ++z) {
                    const int et = z == 0 ? sth : 2;
                    f32x4 a = (f32x4){0.f, 0.f, 0.f, 0.f};
#pragma unroll
                    for (int kk = 0; kk < 8; ++kk) a = mfma16(ld_frag_s(CT + (et * 16 + fr) * 264 + kk * 32 + fq * 8), qf[kk], a);
                    nacc[z] = a * w_inter;
                }
                if (ch + 1 < 68) ML_LOAD_Q(pos0 + 64);
#pragma unroll
                for (int z = 0; z < 2; ++z) {
                    const int et = z == 0 ? sth : 2;
                    f32x4 a = nacc[z];
#pragma unroll
                    for (int k2 = 0; k2 < 2; ++k2) a = mfma16(ld_frag_s(VT + (et * 16 + fr) * 72 + k2 * 32 + fq * 8), ld_frag_s(Ss + jg * 72 + k2 * 32 + fq * 8), a);
                    nacc[z] = a;
                }
                const float den = __shfl(nacc[1][0], fr, 64);
                const float dd = fmaxf(fabsf(den), __expf(-mj));
                const float inv = 1.f / dd;
                u32x2 pk = {pk_bf16(nacc[0][0] * inv, nacc[0][1] * inv), pk_bf16(nacc[0][2] * inv, nacc[0][3] * inv)};
                *reinterpret_cast<u32x2*>(HM + ((size_t)dir * NTOK + (dir ? mlstm_row(b, dir, pos0) - 63 : mlstm_row(b, dir, pos0))) * 1024 + off_h) = pk;
            }
#pragma unroll
            for (int i = 0; i < 2; ++i)
#pragma unroll
                for (int et = 0; et < 3; ++et) {
                    f32x4 a = Cacc[i][et] * decay;
#pragma unroll
                    for (int k2 = 0; k2 < 2; ++k2) a = mfma16(ld_frag_s(KT + ((w * 2 + i) * 16 + fr) * 72 + k2 * 32 + fq * 8), ld_frag_s(VWT + (et * 16 + fr) * 72 + k2 * 32 + fq * 8), a);
                    Cacc[i][et] = a;
                }
            __syncthreads();
#pragma unroll
            for (int i = 0; i < 2; ++i)
#pragma unroll
                for (int et = 0; et < 3; ++et) {
                    const f32x4 a = Cacc[i][et];
                    u32x2 pk = {pk_bf16(a[0], a[1]), pk_bf16(a[2], a[3])};
                    *reinterpret_cast<u32x2*>(CT + (et * 16 + fr) * 264 + (w * 2 + i) * 16 + 4 * fq) = pk;
                }
            m_old = m_new;
        }
#undef ML_LOAD_Q
#undef ML_LOAD_K
#undef ML_LOAD_KTV
    }
}

__device__ void mlstm_out_rows(const Params& p, int row0, int nrows) {
    const int lane = tid_() & 63, w = tid_() >> 6;
    const u16* P = (const u16*)(p.ws + WS_P);
    const u16* HM = (const u16*)(p.ws + WS_HM);
    u16* YIN = (u16*)(p.ws + WS_YIN);
    for (int r = w; r < nrows; r += 8) {
        const int row = row0 + r;
        const int c0 = lane * 16;
        float v[16]; float ss = 0.f;
#pragma unroll
        for (int h2 = 0; h2 < 2; ++h2) {
            const u32x4 a = *reinterpret_cast<const u32x4*>(HM + (size_t)row * 1024 + c0 + h2 * 8);
            const u32x4 bq = *reinterpret_cast<const u32x4*>(HM + ((size_t)NTOK + row) * 1024 + c0 + h2 * 8);
#pragma unroll
            for (int q = 0; q < 4; ++q) { v[h2 * 8 + 2 * q] = bf_lo(a[q]) + bf_lo(bq[q]); v[h2 * 8 + 2 * q + 1] = bf_hi(a[q]) + bf_hi(bq[q]); }
        }
#pragma unroll
        for (int q = 0; q < 16; ++q) ss += v[q] * v[q];
        ss += __shfl_xor(ss, 1, 64); ss += __shfl_xor(ss, 2, 64); ss += __shfl_xor(ss, 4, 64); ss += __shfl_xor(ss, 8, 64);
        const float rstd = rsqrtf(ss * (1.f / 256.f) + 1e-6f);
        unsigned o[8];
#pragma unroll
        for (int h2 = 0; h2 < 2; ++h2) {
            const u32x4 og = *reinterpret_cast<const u32x4*>(P + (size_t)row * AB_IN + 3072 + c0 + h2 * 8);
#pragma unroll
            for (int q = 0; q < 4; ++q) {
                const int c = c0 + h2 * 8 + 2 * q;
                const float y0 = v[h2 * 8 + 2 * q] * rstd * p.mlstm_norm[c] * sigmoidf_(bf_lo(og[q]));
                const float y1 = v[h2 * 8 + 2 * q + 1] * rstd * p.mlstm_norm[c + 1] * sigmoidf_(bf_hi(og[q]));
                o[h2 * 4 + q] = pk_bf16(y0, y1);
            }
        }
        *reinterpret_cast<u32x4*>(YIN + (size_t)row * D + c0) = (u32x4){o[0], o[1], o[2], o[3]};
        *reinterpret_cast<u32x4*>(YIN + (size_t)row * D + c0 + 8) = (u32x4){o[4], o[5], o[6], o[7]};
    }
}

template <int DH, class KeyFn, class BiasFn>
__device__ __forceinline__ void attn_wave(const u16* qptr, size_t qstride, int nblk, KeyFn keyfn, BiasFn biasfn, float scale,
                                           float m_init, float l_init, u16* vlds, u16* optr, size_t ostride) {
    constexpr int NK = DH / 32, NDT = DH / 16, VS = DH + 8, NV = DH / 16;
    const int lane = tid_() & 63, fr = lane & 15, fq = lane >> 4;
    bf16x8 qf[NK];
#pragma unroll
    for (int kk = 0; kk < NK; ++kk) qf[kk] = ld_frag_g(qptr + (size_t)fr * qstride + kk * 32 + fq * 8);
    f32x4 oacc[NDT];
#pragma unroll
    for (int i = 0; i < NDT; ++i) oacc[i] = (f32x4){0.f, 0.f, 0.f, 0.f};
    float m = m_init, l = l_init;
    bf16x8 kn[2][NK]; u32x4 vn[NV];
    auto load_blk = [&](int ib) {
        const u16* kptr; const u16* vptr; size_t kvs;
        (void)keyfn(ib, kptr, vptr, kvs);
#pragma unroll
        for (int st = 0; st < 2; ++st)
#pragma unroll
            for (int kk = 0; kk < NK; ++kk) kn[st][kk] = ld_frag_g(kptr + (size_t)(st * 16 + fr) * kvs + kk * 32 + fq * 8);
#pragma unroll
        for (int i = 0; i < NV; ++i) { const int cidx = lane + 64 * i, r = cidx / (DH / 8), cc = cidx % (DH / 8); vn[i] = *reinterpret_cast<const u32x4*>(vptr + (size_t)r * kvs + cc * 8); }
    };
    auto next_valid = [&](int ib) { const u16* a; const u16* b2; size_t c; while (ib < nblk && !keyfn(ib, a, b2, c)) ++ib; return ib; };
    int ib = next_valid(0);
    if (ib < nblk) load_blk(ib);
    while (ib < nblk) {
        bf16x8 kc[2][NK]; u32x4 vc[NV];
#pragma unroll
        for (int st = 0; st < 2; ++st)
#pragma unroll
            for (int kk = 0; kk < NK; ++kk) kc[st][kk] = kn[st][kk];
#pragma unroll
        for (int i = 0; i < NV; ++i) vc[i] = vn[i];
        const int ibn = next_valid(ib + 1);
        if (ibn < nblk) load_blk(ibn);
        asm volatile("" ::: "memory");
#pragma unroll
        for (int i = 0; i < NV; ++i) { const int cidx = lane + 64 * i, r = cidx / (DH / 8), cc = cidx % (DH / 8); *reinterpret_cast<u32x4*>(vlds + r * VS + cc * 8) = vc[i]; }
        f32x4 s[2];
#pragma unroll
        for (int st = 0; st < 2; ++st) {
            f32x4 a = (f32x4){0.f, 0.f, 0.f, 0.f};
#pragma unroll
            for (int kk = 0; kk < NK; ++kk) a = mfma16(kc[st][kk], qf[kk], a);
            s[st] = a;
        }
        float x[8]; float mx = -INFINITY;
#pragma unroll
        for (int st = 0; st < 2; ++st)
#pragma unroll
            for (int q = 0; q < 4; ++q) { const float v = s[st][q] * scale + biasfn(ib, fr, st * 16 + 4 * fq + q); x[st * 4 + q] = v; mx = fmaxf(mx, v); }
        mx = fmaxf(mx, __shfl_xor(mx, 16, 64)); mx = fmaxf(mx, __shfl_xor(mx, 32, 64));
        const float m_new = fmaxf(m, mx);
        const float m_safe = (m_new == -INFINITY) ? 0.f : m_new;
        const float alpha = __expf(m - m_safe);
        float ps = 0.f; float pe[8];
#pragma unroll
        for (int q = 0; q < 8; ++q) { pe[q] = __expf(x[q] - m_safe); ps += pe[q]; }
        l = l * alpha + ps; m = m_new;
#pragma unroll
        for (int i = 0; i < NDT; ++i) oacc[i] *= alpha;
        const bf16x8 pf = mk_frag(pk_bf16(pe[0], pe[1]), pk_bf16(pe[2], pe[3]), pk_bf16(pe[4], pe[5]), pk_bf16(pe[6], pe[7]));
        asm volatile("s_waitcnt lgkmcnt(0)" ::: "memory");
#pragma unroll
        for (int dt = 0; dt < NDT; ++dt) {
            const u16* vb = vlds + dt * 16 + fr;
            unsigned e[4];
#pragma unroll
            for (int j2 = 0; j2 < 2; ++j2) {
                const int k0 = (j2 == 0 ? 0 : 16) + 4 * fq;
                e[j2 * 2 + 0] = (unsigned)vb[(k0 + 0) * VS] | ((unsigned)vb[(k0 + 1) * VS] << 16);
                e[j2 * 2 + 1] = (unsigned)vb[(k0 + 2) * VS] | ((unsigned)vb[(k0 + 3) * VS] << 16);
            }
            oacc[dt] = mfma16(mk_frag(e[0], e[1], e[2], e[3]), pf, oacc[dt]);
        }
        asm volatile("" ::: "memory");
        ib = ibn;
    }
    l += __shfl_xor(l, 16, 64); l += __shfl_xor(l, 32, 64);
    const float inv = 1.f / l;
#pragma unroll
    for (int dt = 0; dt < NDT; ++dt) {
        const f32x4 o = oacc[dt] * inv;
        u32x2 pk = {pk_bf16(o[0], o[1]), pk_bf16(o[2], o[3])};
        *reinterpret_cast<u32x2*>(optr + (size_t)fr * ostride + dt * 16 + 4 * fq) = pk;
    }
}

__device__ void phase_l0_stage2(const Params& p, unsigned char* lds) {
    const int w = tid_() >> 6;
    const u16* P = (const u16*)(p.ws + WS_P);
    u16* YIN = (u16*)(p.ws + WS_YIN);
    u16* vlds = (u16*)lds + w * (32 * 136);
    for (int item = bid_(); item < 1088 + 2176; item += gdim_()) {
        if (item < 1024) {
            const int qt = item & 3, r = (item >> 2) & 63, b = item >> 8, h = w;
            const int r0 = min(max(r - 4, 0), 56);
            const int cb = qt == 0 ? 0 : (qt == 1 ? 8 : (qt == 2 ? 24 : 32));
            const int qrow = b * SEQ + r * 64 + qt * 16;
            const float* rpb = p.na_rpb + h * 15 * 31;
            auto keyfn = [&](int ib, const u16*& kp, const u16*& vp, size_t& kvs) -> bool {
                int row;
                if (ib < 8) row = b * SEQ + (r0 + ib) * 64 + cb; else row = NLAT + b * LC + (ib - 8) * 32;
                kp = P + (size_t)row * AB_IN + 5136 + h * 128; vp = P + (size_t)row * AB_IN + 6160 + h * 128; kvs = AB_IN; return true; };
            auto biasfn = [&](int ib, int qi, int ki) -> float {
                if (ib >= 8) return 0.f;
                const int c = qt * 16 + qi, kc = cb + ki, c0 = min(max(c - 8, 0), 48);
                if (kc < c0 || kc >= c0 + 16) return -INFINITY;
                return rpb[(r0 + ib - r + 7) * 31 + (kc - c + 15)]; };
            attn_wave<128>(P + (size_t)qrow * AB_IN + 4112 + h * 128, AB_IN, 16, keyfn, biasfn, 0.08838834764831845f, -INFINITY, 0.f, vlds,
                           YIN + (size_t)qrow * D + 1024 + h * 128, D);
        } else if (item < 1088) {
            const int it = item - 1024, qt = it & 15, b = it >> 4, h = w;
            const int qrow = NLAT + b * LC + qt * 16;
            auto keyfn = [&](int ib, const u16*& kp, const u16*& vp, size_t& kvs) -> bool {
                const int row = NLAT + b * LC + ib * 32;
                kp = P + (size_t)row * AB_IN + 5136 + h * 128; vp = P + (size_t)row * AB_IN + 6160 + h * 128; kvs = AB_IN; return true; };
            auto biasfn = [&](int, int, int) -> float { return 0.f; };
            attn_wave<128>(P + (size_t)qrow * AB_IN + 4112 + h * 128, AB_IN, 8, keyfn, biasfn, 0.08838834764831845f, -INFINITY, 0.f, vlds,
                           YIN + (size_t)qrow * D + 1024 + h * 128, D);
        } else {
            mlstm_out_rows(p, (item - 1088) * 8, 8);
        }
    }
}

__device__ void rope_rows(const Params& p, int row0, int nrows) {
    const int lane = tid_() & 63, w = tid_() >> 6;
    u16* P = (u16*)(p.ws + WS_P);
    for (int r = w; r < nrows; r += 8) {
        const int row = row0 + r, tt = row & (SEQ - 1);
        const float prow = (float)(tt >> 6), pcol = (float)(tt & 63);
        for (int pi = lane; pi < 640; pi += 64) {
            const int head = pi >> 5, half = (pi >> 4) & 1, j = pi & 15;
            const int base = (head < 16 ? head * 64 : 1024 + (head - 16) * 64) + half * 32 + j;
            const float inv = exp2f(-(float)j * (13.287712379549449f / 16.f));
            const float ang = (half ? pcol : prow) * inv;
            float sn, cs; sincosf(ang, &sn, &cs);
            u16* q1 = P + (size_t)row * CD_IN + base;
            const float x1 = bf2f(q1[0]), x2 = bf2f(q1[16]);
            q1[0] = f2bf(x1 * cs - x2 * sn); q1[16] = f2bf(x2 * cs + x1 * sn);
        }
    }
}

__device__ __forceinline__ int lru_row(int b, int ci, int j) { return ci < 4 ? NLAT + b * LC + ci * 64 + j : b * SEQ + (ci - 4) * 64 + j; }
__device__ void lru_chunk(const Params& p, int b, int blk, int ci, int mode, unsigned char* lds) {
    u16* ub = (u16*)lds;
    float* sa = (float*)(ub + 64 * 136);
    float* sbt = sa + 64 * 128;
    float* sx = sbt + 64 * 128;
    const int t = tid_(), lane = t & 63, w = t >> 6, fr = lane & 15, fq = lane >> 4;
    const u16* P = (const u16*)(p.ws + WS_P);
    const u16* WT = (const u16*)(p.ws + WS_LRUW);
    float* SA = (float*)(p.ws + WS_LRUS);
    float* SH = SA + 2 * 4 * 68 * 1024;
    const int seglen = ci < 4 ? LC : SEQ, tt0 = ci < 4 ? ci * 64 : (ci - 4) * 64;
    const int rbase = ci < 4 ? NLAT + b * LC : b * SEQ;
    __syncthreads();
    {
        const int c4 = (t & 31) * 4, j0 = (t >> 5) * 4, ch = blk * 128 + c4;
        float xv[7][4];
#pragma unroll
        for (int q = 0; q < 7; ++q) {
            const int tt = tt0 + j0 - 1 + q;
            if (tt >= 0 && tt < seglen) {
                const u32x2 v = *reinterpret_cast<const u32x2*>(P + (size_t)(rbase + tt) * CD_IN + 1536 + ch);
                xv[q][0] = bf_lo(v[0]); xv[q][1] = bf_hi(v[0]); xv[q][2] = bf_lo(v[1]); xv[q][3] = bf_hi(v[1]);
            } else { xv[q][0] = xv[q][1] = xv[q][2] = xv[q][3] = 0.f; }
        }
        f32x4 cw[4];
#pragma unroll
        for (int tp = 0; tp < 4; ++tp) cw[tp] = *reinterpret_cast<const f32x4*>(p.lru_conv_w + tp * 1024 + ch);
        const f32x4 cb = *reinterpret_cast<const f32x4*>(p.lru_conv_b + ch);
#pragma unroll
        for (int q = 0; q < 4; ++q) {
            float u[4];
#pragma unroll
            for (int cc = 0; cc < 4; ++cc) u[cc] = cb[cc] + xv[q][cc] * cw[0][cc] + xv[q + 1][cc] * cw[1][cc] + xv[q + 2][cc] * cw[2][cc] + xv[q + 3][cc] * cw[3][cc];
            u32x2 pk = {pk_bf16(u[0], u[1]), pk_bf16(u[2], u[3])};
            *reinterpret_cast<u32x2*>(ub + (j0 + q) * 136 + c4) = pk;
        }
    }
    __syncthreads();
    const int sc = t & 127, seg = t >> 7;
    const int chg_s = blk * 128 + sc;
    float hfw[16];
    bf16x8 wfa[2][2][4];
#pragma unroll
    for (int d2 = 0; d2 < 2; ++d2)
#pragma unroll
        for (int g2 = 0; g2 < 2; ++g2)
#pragma unroll
            for (int kk = 0; kk < 4; ++kk) wfa[d2][g2][kk] = ld_frag_g(WT + ((size_t)((d2 * 2 + g2) * 8 + blk) * 128 + w * 16 + fr) * 128 + fq * 8 + kk * 32);
    float carry[2] = {0.f, 0.f}; u16 grv[16];
    if (mode == 1) {
#pragma unroll
        for (int d2 = 0; d2 < 2; ++d2) carry[d2] = SH[((size_t)(d2 * 4 + b) * 68 + ci) * 1024 + chg_s];
#pragma unroll
        for (int s = 0; s < 16; ++s) grv[s] = P[(size_t)lru_row(b, ci, seg * 16 + s) * CD_IN + 2560 + chg_s];
    }
    for (int dir = 0; dir < 2; ++dir) {
        const int cg = blk * 128 + w * 16 + 4 * fq;
        f32x4 av[4];
        {
            bf16x8 wf[4];
#pragma unroll
            for (int kk = 0; kk < 4; ++kk) wf[kk] = dir ? wfa[1][0][kk] : wfa[0][0][kk];
            const f32x4 gbv = *reinterpret_cast<const f32x4*>(p.lru_gate_b + (dir * 2 + 0) * 1024 + cg);
            const f32x4 lamv = *reinterpret_cast<const f32x4*>(p.lru_lambda + dir * 1024 + cg);
            float sp8[4];
#pragma unroll
            for (int q = 0; q < 4; ++q) { const float nl = -lamv[q]; sp8[q] = -8.f * (fmaxf(nl, 0.f) + log1pf(__expf(-fabsf(nl)))); }
#pragma unroll
            for (int tt = 0; tt < 4; ++tt) {
                f32x4 z = (f32x4){0.f, 0.f, 0.f, 0.f};
#pragma unroll
                for (int kk = 0; kk < 4; ++kk) z = mfma16(wf[kk], ld_frag_s(ub + (tt * 16 + fr) * 136 + kk * 32 + fq * 8), z);
#pragma unroll
                for (int q = 0; q < 4; ++q) av[tt][q] = __expf(sigmoidf_(z[q] + gbv[q]) * sp8[q]);
            }
        }
        __syncthreads();
        {
            bf16x8 wf[4];
#pragma unroll
            for (int kk = 0; kk < 4; ++kk) wf[kk] = dir ? wfa[1][1][kk] : wfa[0][1][kk];
            const f32x4 gbv = *reinterpret_cast<const f32x4*>(p.lru_gate_b + (dir * 2 + 1) * 1024 + cg);
#pragma unroll
            for (int tt = 0; tt < 4; ++tt) {
                f32x4 z = (f32x4){0.f, 0.f, 0.f, 0.f};
#pragma unroll
                for (int kk = 0; kk < 4; ++kk) z = mfma16(wf[kk], ld_frag_s(ub + (tt * 16 + fr) * 136 + kk * 32 + fq * 8), z);
                const int tj = tt * 16 + fr;
                const u32x2 uv = *reinterpret_cast<const u32x2*>(ub + tj * 136 + w * 16 + 4 * fq);
                const float u4[4] = {bf_lo(uv[0]), bf_hi(uv[0]), bf_lo(uv[1]), bf_hi(uv[1])};
                f32x4 bv;
#pragma unroll
                for (int q = 0; q < 4; ++q) { const float a = av[tt][q]; bv[q] = sqrtf(fmaxf(1.f - a * a, 0.f)) * sigmoidf_(z[q] + gbv[q]) * u4[q]; }
                *reinterpret_cast<f32x4*>(sa + tj * 128 + w * 16 + 4 * fq) = av[tt];
                *reinterpret_cast<f32x4*>(sbt + tj * 128 + w * 16 + 4 * fq) = bv;
            }
        }
        __syncthreads();
        float A = 1.f, h = 0.f;
#pragma unroll
        for (int s = 0; s < 16; ++s) { const int j = seg * 16 + (dir ? 15 - s : s); const float a = sa[j * 128 + sc]; h = a * h + sbt[j * 128 + sc]; A *= a; }
        sx[(seg * 2 + 0) * 128 + sc] = A; sx[(seg * 2 + 1) * 128 + sc] = h;
        __syncthreads();
        const size_t sidx = ((size_t)(dir * 4 + b) * 68 + ci) * 1024 + chg_s;
        if (mode == 0) {
            if (seg == 0) {
                float At = 1.f, ht = 0.f;
#pragma unroll
                for (int s = 0; s < 4; ++s) { const int sg = dir ? 3 - s : s; const float a = sx[(sg * 2) * 128 + sc]; ht = a * ht + sx[(sg * 2 + 1) * 128 + sc]; At *= a; }
                SA[sidx] = At; SH[sidx] = ht;
            }
        } else {
            float hs = dir ? carry[1] : carry[0];
            const int nprev = dir ? 3 - seg : seg;
#pragma unroll
            for (int s = 0; s < 3; ++s) if (s < nprev) { const int sg = dir ? 3 - s : s; hs = sx[(sg * 2) * 128 + sc] * hs + sx[(sg * 2 + 1) * 128 + sc]; }
            u16* YIN = (u16*)(p.ws + WS_YIN);
#pragma unroll
            for (int s = 0; s < 16; ++s) {
                const int js = dir ? 15 - s : s, j = seg * 16 + js;
                hs = sa[j * 128 + sc] * hs + sbt[j * 128 + sc];
                if (dir == 0) hfw[js] = hs;
                else {
                    const int row = lru_row(b, ci, j);
                    const float gr = bf2f(grv[js]);
                    const float ge = 0.5f * gr * (1.f + tanhf(0.7978845608028654f * (gr + 0.044715f * gr * gr * gr)));
                    YIN[(size_t)row * D + 1024 + chg_s] = f2bf((hfw[js] + hs) * ge);
                }
            }
        }
    }
}

__device__ void lru_prep_weights(const Params& p) {
    const int t = tid_();
    u16* WT = (u16*)(p.ws + WS_LRUW);
    for (int m = bid_(); m < 32; m += gdim_()) {
        const float* Wg = p.lru_gate_w + (size_t)m * 128 * 128;
        const int j4 = (t & 31) * 4, i8 = (t >> 5) * 8;
        f32x4 r8[8];
#pragma unroll
        for (int q = 0; q < 8; ++q) r8[q] = *reinterpret_cast<const f32x4*>(Wg + (size_t)(i8 + q) * 128 + j4);
#pragma unroll
        for (int jj = 0; jj < 4; ++jj) {
            u32x4 v = {pk_bf16(r8[0][jj], r8[1][jj]), pk_bf16(r8[2][jj], r8[3][jj]), pk_bf16(r8[4][jj], r8[5][jj]), pk_bf16(r8[6][jj], r8[7][jj])};
            *reinterpret_cast<u32x4*>(WT + ((size_t)m * 128 + j4 + jj) * 128 + i8) = v;
        }
    }
}
__device__ void lru_carry(const Params& p, int item) {
    const int idx = item * NT + tid_();
    const int c = idx & 1023, b = (idx >> 10) & 3, dir = idx >> 12;
    float* SA = (float*)(p.ws + WS_LRUS);
    float* SH = SA + 2 * 4 * 68 * 1024;
    const size_t base = ((size_t)(dir * 4 + b) * 68) * 1024 + c;
    float h = 0.f;
#pragma unroll 4
    for (int s = 0; s < 68; ++s) {
        const int cj = dir == 0 ? s : (s < 4 ? 3 - s : 71 - s);
        const float a = SA[base + (size_t)cj * 1024], hl = SH[base + (size_t)cj * 1024];
        SH[base + (size_t)cj * 1024] = h;
        h = a * h + hl;
    }
}

__device__ void gqa_item(const Params& p, int it, unsigned char* lds) {
    const int w = tid_() >> 6;
    const u16* P = (const u16*)(p.ws + WS_P);
    u16* YIN = (u16*)(p.ws + WS_YIN);
    const int hq = (it & 1) * 8 + w, t16 = (it >> 1) & 255, b = it >> 9;
    const int kvh = hq >> 2, t0 = t16 * 16;
    const int ks = (t0 - 128) & ~31;
    const int qrow = b * SEQ + t0;
    u16* vlds = (u16*)lds + w * (32 * 72);
    auto keyfn = [&](int ib, const u16*& kp, const u16*& vp, size_t& kvs) -> bool {
        int row;
        if (ib < 9) { const int k0 = ks + ib * 32; if (k0 < 0 || k0 >= SEQ) return false; row = b * SEQ + k0; }
        else row = NLAT + b * LC + (ib - 9) * 32;
        kp = P + (size_t)row * CD_IN + 1024 + kvh * 64; vp = P + (size_t)row * CD_IN + 1280 + kvh * 64; kvs = CD_IN; return true; };
    auto biasfn = [&](int ib, int qi, int ki) -> float {
        if (ib >= 9) return 0.f;
        const int dq = (t0 + qi) - (ks + ib * 32 + ki);
        return (dq > 128 || dq < -128) ? -INFINITY : 0.f; };
    const float sink = p.gqa_sink[hq];
    attn_wave<64>(P + (size_t)qrow * CD_IN + hq * 64, CD_IN, 17, keyfn, biasfn, 0.125f, sink, ((tid_() & 63) >> 4) == 0 ? 1.f : 0.f, vlds,
                  YIN + (size_t)qrow * D + hq * 64, D);
}

__device__ void phase_l1_stage1(const Params& p, unsigned char* lds) {
    for (int item = bid_(); item < 2176 + 2048; item += gdim_()) {
        if (item < 2176) { const int ci = item % 68, blk = (item / 68) & 7, b = item / (68 * 8); lru_chunk(p, b, blk, ci, 0, lds); }
        else rope_rows(p, (item - 2176) * 8, 8);
    }
}
__device__ void phase_l1_stage2(const Params& p, unsigned char* lds) {
    for (int item = bid_(); item < 16 + 2048; item += gdim_()) {
        if (item < 16) lru_carry(p, item);
        else gqa_item(p, item - 16, lds);
    }
}
__device__ void phase_l1_stage3(const Params& p, unsigned char* lds) {
    for (int item = bid_(); item < 2048; item += gdim_()) { const int cl = item & 63, blk = (item >> 6) & 7, b = item >> 9; lru_chunk(p, b, blk, cl + 4, 1, lds); }
}

__device__ void phase_rowpass_mid(const Params& p, int l, unsigned char* lds) {
    float* R = (float*)lds;
    const int t = tid_(), lane = t & 63, w = t >> 6;
    const int nrows = l == 0 ? NTOK : NLAT;
    __syncthreads();
    for (int i = t; i < D * NEXP; i += NT) { const int k = i >> 4, e = i & 15; R[e * D + k] = p.moe_router[(size_t)l * D * NEXP + i]; }
    __syncthreads();
    const float* Y = (const float*)(p.ws + WS_Y);
    float* XL1 = (float*)(p.ws + WS_XL1);
    u16* H = (u16*)(p.ws + WS_H);
    float* AFF = (float*)(p.ws + WS_AFF);
    for (int row = bid_() * 8 + w; row < nrows; row += gdim_() * 8) {
        f32x4 v[8]; float ss = 0.f;
#pragma unroll
        for (int i = 0; i < 8; ++i) { v[i] = *reinterpret_cast<const f32x4*>(Y + (size_t)row * D + (i * 64 + lane) * 4); ss += v[i][0] * v[i][0] + v[i][1] * v[i][1] + v[i][2] * v[i][2] + v[i][3] * v[i][3]; }
        ss = wave_sum(ss);
        const float rstd = rsqrtf(ss * (1.f / D) + 1e-6f);
        const float* xr = xin_row(p, l, row);
        const float* g1 = mod_ptr(p, l, row, 2);
        const float* nw = p.norm_mix_post + (size_t)l * D;
        float ss1 = 0.f;
#pragma unroll
        for (int i = 0; i < 8; ++i) {
            const int col = (i * 64 + lane) * 4;
            const f32x4 x4 = *reinterpret_cast<const f32x4*>(xr + col), w4 = *reinterpret_cast<const f32x4*>(nw + col), g4 = *reinterpret_cast<const f32x4*>(g1 + col);
            const f32x4 x1 = x4 + g4 * (v[i] * rstd * w4);
            *reinterpret_cast<f32x4*>(XL1 + (size_t)row * D + col) = x1;
            v[i] = x1; ss1 += x1[0] * x1[0] + x1[1] * x1[1] + x1[2] * x1[2] + x1[3] * x1[3];
        }
        ss1 = wave_sum(ss1);
        const float rstd1 = rsqrtf(ss1 * (1.f / D) + 1e-6f);
        const float* sh = mod_ptr(p, l, row, 3); const float* sc = mod_ptr(p, l, row, 4);
        const float* nw2 = p.norm_ffn_pre + (size_t)l * D;
#pragma unroll
        for (int i = 0; i < 8; ++i) {
            const int col = (i * 64 + lane) * 4;
            const f32x4 w4 = *reinterpret_cast<const f32x4*>(nw2 + col), s4 = *reinterpret_cast<const f32x4*>(sc + col), h4 = *reinterpret_cast<const f32x4*>(sh + col);
            const f32x4 o = v[i] * rstd1 * w4 * (s4 + 1.f) + h4;
            u32x2 pk = {pk_bf16(o[0], o[1]), pk_bf16(o[2], o[3])};
            *reinterpret_cast<u32x2*>(H + (size_t)row * D + col) = pk;
            v[i] = o;
        }
        float lg[16];
#pragma unroll
        for (int e = 0; e < 16; ++e) lg[e] = 0.f;
#pragma unroll
        for (int i = 0; i < 8; ++i) {
#pragma unroll
            for (int e = 0; e < 16; ++e) { const f32x4 r4 = *reinterpret_cast<const f32x4*>(R + e * D + (i * 64 + lane) * 4); lg[e] += v[i][0] * r4[0] + v[i][1] * r4[1] + v[i][2] * r4[2] + v[i][3] * r4[3]; }
        }
        const bool b5 = lane & 32, b4 = lane & 16, b3 = lane & 8, b2 = lane & 4;
        float t8[8], t4[4], t2[2], lgt;
#pragma unroll
        for (int j = 0; j < 8; ++j) { const float keep = b5 ? lg[8 + j] : lg[j], send = b5 ? lg[j] : lg[8 + j]; t8[j] = keep + __shfl_xor(send, 32, 64); }
#pragma unroll
        for (int j = 0; j < 4; ++j) { const float keep = b4 ? t8[4 + j] : t8[j], send = b4 ? t8[j] : t8[4 + j]; t4[j] = keep + __shfl_xor(send, 16, 64); }
#pragma unroll
        for (int j = 0; j < 2; ++j) { const float keep = b3 ? t4[2 + j] : t4[j], send = b3 ? t4[j] : t4[2 + j]; t2[j] = keep + dpp_f<0x140>(send); }
        { const float keep = b2 ? t2[1] : t2[0], send = b2 ? t2[0] : t2[1]; lgt = keep + dpp_f<0x141>(send); }
        lgt += dpp_f<0x4E>(lgt); lgt += dpp_f<0xB1>(lgt);
        const float mx = wave_max(lgt);
        const float pe = __expf(lgt - mx);
        const float den = wave_sum(pe) * 0.25f;
        if ((lane & 3) == 0) AFF[(size_t)row * 16 + ((b5 ? 8 : 0) + (b4 ? 4 : 0) + (b3 ? 2 : 0) + (b2 ? 1 : 0))] = pe / den;
    }
}

__device__ void phase_topk(const Params& p, int l, unsigned char* lds) {
    unsigned* keys = (unsigned*)lds;
    unsigned* hist = keys + 4096;
    unsigned* misc = hist + 256;
    const int t = tid_(), lane = t & 63, w = t >> 6;
    const float* AFF = (const float*)(p.ws + WS_AFF);
    int* SLOT = (int*)(p.ws + WS_SLOT);
    int* EROW = (int*)(p.ws + WS_EROW);
    float* EGATE = (float*)(p.ws + WS_EGATE);
    const int nitems = l == 0 ? 128 : 64;
    for (int item = bid_(); item < nitems; item += gdim_()) {
        const int kind = item >> 6, b = (item >> 4) & 3, ex = item & 15;
        const int n = kind ? LC : SEQ, cap = n / 8, rowbase = kind ? NLAT + b * LC : b * SEQ;
        __syncthreads();
        for (int i = t; i < n; i += NT) keys[i] = __float_as_uint(AFF[(size_t)(rowbase + i) * 16 + ex]);
        unsigned prefix = 0u, mask = 0u; int kth = cap;
        for (int shift = 24; shift >= 0; shift -= 8) {
            __syncthreads();
            if (t < 256) hist[t] = 0u;
            __syncthreads();
            for (int i = t; i < n; i += NT) { const unsigned k = keys[i]; if ((k & mask) == prefix) atomicAdd(&hist[(k >> shift) & 255u], 1u); }
            __syncthreads();
            if (t < 256) {
                unsigned above = 0u;
                for (int d2 = t + 1; d2 < 256; ++d2) above += hist[d2];
                const unsigned here = hist[t];
                if ((int)above < kth && (int)(above + here) >= kth) { misc[0] = (unsigned)t; misc[1] = (unsigned)(kth - (int)above); }
            }
            __syncthreads();
            prefix |= misc[0] << shift; mask |= 255u << shift; kth = (int)misc[1];
        }
        const unsigned T = prefix; const int need_eq = kth;
        int cgt = 0, ceq = 0;
        const int base = t * 8;
        if (base < n) {
#pragma unroll
            for (int q = 0; q < 8; ++q) { const unsigned k = keys[base + q]; cgt += (k > T); ceq += (k == T); }
        }
        int packed = cgt | (ceq << 16);
        int incl = packed;
#pragma unroll
        for (int o = 1; o < 64; o <<= 1) { const int nb = __shfl_up(incl, o, 64); if (lane >= o) incl += nb; }
        __syncthreads();
        if (lane == 63) misc[8 + w] = (unsigned)incl;
        __syncthreads();
        int woff = 0, total = 0;
#pragma unroll
        for (int q = 0; q < 8; ++q) { const int v = (int)misc[8 + q]; if (q < w) woff += v; total += v; }
        const int excl = woff + incl - packed;
        int pgt = excl & 0xffff, peq = excl >> 16;
        const int tot_gt = total & 0xffff;
        const int sbase = kind ? 2048 + b * 32 : b * 512;
        if (base < n) {
#pragma unroll
            for (int q = 0; q < 8; ++q) {
                const unsigned k = keys[base + q];
                const int row = rowbase + base + q;
                int pos = -1;
                if (k > T) { pos = pgt; ++pgt; }
                else if (k == T) { if (peq < need_eq) pos = tot_gt + peq; ++peq; }
                if (pos >= 0) { const int sl = sbase + pos; EROW[ex * EPAD + sl] = row; EGATE[ex * EPAD + sl] = __uint_as_float(k); SLOT[(size_t)row * 16 + ex] = sl; }
                else SLOT[(size_t)row * 16 + ex] = -1;
            }
        }
    }
}

__device__ void phase_final(const Params& p, int l) {
    const int lane = tid_() & 63, w = tid_() >> 6;
    const int nrows = l == 0 ? NTOK : NLAT;
    const u16* YEXP = (const u16*)(p.ws + WS_YEXP);
    const int* SLOT = (const int*)(p.ws + WS_SLOT);
    const float* XL1 = (const float*)(p.ws + WS_XL1);
    float* XL2 = (float*)(p.ws + WS_XL2);
    u16* H = (u16*)(p.ws + WS_H);
    for (int row = bid_() * 8 + w; row < nrows; row += gdim_() * 8) {
        const int myslot = lane < 16 ? SLOT[(size_t)row * 16 + lane] : -1;
        f32x4 xl[8];
#pragma unroll
        for (int i = 0; i < 8; ++i) xl[i] = *reinterpret_cast<const f32x4*>(XL1 + (size_t)row * D + (i * 64 + lane) * 4);
        f32x4 v[8];
#pragma unroll
        for (int i = 0; i < 8; ++i) v[i] = (f32x4){0.f, 0.f, 0.f, 0.f};
        unsigned long long em = __ballot(myslot >= 0);
        while (em) {
            const int e0 = __builtin_ctzll(em); em &= em - 1;
            const bool two = em != 0;
            const int e1 = two ? __builtin_ctzll(em) : e0; if (two) em &= em - 1;
            const int sl0 = __shfl(myslot, e0, 64), sl1 = __shfl(myslot, e1, 64);
            const u16* y0 = YEXP + ((size_t)e0 * EPAD + sl0) * D; const u16* y1 = YEXP + ((size_t)e1 * EPAD + sl1) * D;
            u32x2 q0[8], q1[8];
#pragma unroll
            for (int i = 0; i < 8; ++i) { q0[i] = *reinterpret_cast<const u32x2*>(y0 + (i * 64 + lane) * 4); q1[i] = *reinterpret_cast<const u32x2*>(y1 + (i * 64 + lane) * 4); }
            const float f1 = two ? 1.f : 0.f;
#pragma unroll
            for (int i = 0; i < 8; ++i) {
                v[i][0] += bf_lo(q0[i][0]) + f1 * bf_lo(q1[i][0]); v[i][1] += bf_hi(q0[i][0]) + f1 * bf_hi(q1[i][0]);
                v[i][2] += bf_lo(q0[i][1]) + f1 * bf_lo(q1[i][1]); v[i][3] += bf_hi(q0[i][1]) + f1 * bf_hi(q1[i][1]);
            }
        }
        float ss = 0.f;
#pragma unroll
        for (int i = 0; i < 8; ++i) ss += v[i][0] * v[i][0] + v[i][1] * v[i][1] + v[i][2] * v[i][2] + v[i][3] * v[i][3];
        ss = wave_sum(ss);
        const float rstd = rsqrtf(ss * (1.f / D) + 1e-6f);
        const float* g2 = mod_ptr(p, l, row, 5);
        const float* nw = p.norm_ffn_post + (size_t)l * D;
        float* dst = l == 0 ? XL2 + (size_t)row * D : p.out + (size_t)row * D;
        float ss2 = 0.f;
#pragma unroll
        for (int i = 0; i < 8; ++i) {
            const int col = (i * 64 + lane) * 4;
            const f32x4 x4 = xl[i], w4 = *reinterpret_cast<const f32x4*>(nw + col), g4 = *reinterpret_cast<const f32x4*>(g2 + col);
            const f32x4 x2 = x4 + g4 * (v[i] * rstd * w4);
            *reinterpret_cast<f32x4*>(dst + col) = x2;
            v[i] = x2; ss2 += x2[0] * x2[0] + x2[1] * x2[1] + x2[2] * x2[2] + x2[3] * x2[3];
        }
        if (l == 0) {
            ss2 = wave_sum(ss2);
            const float rstd2 = rsqrtf(ss2 * (1.f / D) + 1e-6f);
            const float* sh = mod_ptr(p, 1, row, 0); const float* sc = mod_ptr(p, 1, row, 1);
            const float* nw1 = p.norm_mix_pre + D;
#pragma unroll
            for (int i = 0; i < 8; ++i) {
                const int col = (i * 64 + lane) * 4;
                const f32x4 w4 = *reinterpret_cast<const f32x4*>(nw1 + col), s4 = *reinterpret_cast<const f32x4*>(sc + col), h4 = *reinterpret_cast<const f32x4*>(sh + col);
                const f32x4 o = v[i] * rstd2 * w4 * (s4 + 1.f) + h4;
                u32x2 pk = {pk_bf16(o[0], o[1]), pk_bf16(o[2], o[3])};
                *reinterpret_cast<u32x2*>(H + (size_t)row * D + col) = pk;
            }
        }
    }
}

__global__ void __launch_bounds__(NT, 2) fwd_kernel(Params p) {
    extern __shared__ __attribute__((aligned(16))) unsigned char lds[];
    unsigned char* wlds = lds + 16;
    if (threadIdx.x == 0) *reinterpret_cast<uint4*>(lds) = make_uint4(0u, 0u, 0u, 0u);
    __syncthreads();
    XcdBarrier bar = xcd_barrier_post((unsigned*)(p.ws + WS_BAR), (volatile LAS unsigned*)lds);
#ifndef PH_MASK
#define PH_MASK 0xFFFFFFFFu
#endif
#ifndef PROBE_REP_MASK
#define PROBE_REP_MASK 0u
#endif
#define PHASE(id, body) do { if (((PH_MASK >> ((id) % 32)) & 1u) && p.ph_lo <= (id) && (id) < p.ph_hi) { \
    for (int _r = 0; _r < ((((unsigned)PROBE_REP_MASK >> ((id) % 32)) & 1u) ? 2 : 1); ++_r) { body; if ((id) + 1 < p.ph_hi || _r == 0) { if ((id) + 1 < p.ph_hi) xcd_barrier(bar); } } } } while (0)
    PHASE(0, { phase_mod(p, wlds); phase_convert_dense(p, wlds); });
    PHASE(1, { phase_norm_mod(p, 0); lru_prep_weights(p); });
#pragma unroll
    for (int l = 0; l < 2; ++l) {
        const int pb = 2 + 10 * l;
        {
            EpiDesc e; e.ob = (u16*)(p.ws + WS_P); e.of = nullptr; e.ldo = l == 0 ? AB_IN : CD_IN; e.gates = l == 0 ? (float*)(p.ws + WS_G) : nullptr; e.rscale = nullptr;
            PHASE(pb + 0, phase_gemm_dense<EPI_BF16>(p, (const u16*)(p.ws + WS_H), NTOK, (const u16*)(p.ws + (l == 0 ? WS_WT_ABIN : WS_WT_CDIN)), l == 0 ? AB_IN : CD_IN, e, wlds));
        }
        if (l == 0) {
            PHASE(pb + 1, phase_mlstm(p, wlds));
            PHASE(pb + 2, phase_l0_stage2(p, wlds));
        } else {
            PHASE(pb + 1, phase_l1_stage1(p, wlds));
            PHASE(pb + 2, phase_l1_stage2(p, wlds));
            PHASE(pb + 3, phase_l1_stage3(p, wlds));
        }
        {
            EpiDesc e; e.ob = nullptr; e.of = (float*)(p.ws + WS_Y); e.ldo = D; e.gates = nullptr; e.rscale = nullptr;
            PHASE(pb + 4, phase_gemm_dense<EPI_F32>(p, (const u16*)(p.ws + WS_YIN), l == 0 ? NTOK : NLAT, (const u16*)(p.ws + (l == 0 ? WS_WT_ABOUT : WS_WT_CDOUT)), D, e, wlds));
        }
        PHASE(pb + 5, phase_rowpass_mid(p, l, wlds));
        PHASE(pb + 6, { phase_topk(p, l, wlds); phase_convert_moe(p, l, wlds); });
        PHASE(pb + 7, phase_moe_a(p, l, wlds));
        PHASE(pb + 8, phase_moe_b(p, l, wlds));
        PHASE(pb + 9, phase_final(p, l));
    }
}


#ifdef DBG_STOP
__global__ void dbg_digest(const unsigned char* ws, size_t off, int kind, size_t nelem, float* out, size_t nout) {
    for (size_t i = (size_t)blockIdx.x * blockDim.x + threadIdx.x; i < nout; i += (size_t)gridDim.x * blockDim.x) {
        float v = 0.f;
        for (size_t j = i; j < nelem; j += nout) {
            if (kind == 0) v += bf2f(((const u16*)(ws + off))[j]);
            else if (kind == 1) v += ((const float*)(ws + off))[j];
            else v += (float)((const int*)(ws + off))[j];
        }
        out[i] = v;
    }
}
#endif
extern "C" void kernel_launch(void* const* d_in, const int* in_sizes, int n_in, void* d_out, int out_size, void* d_ws, size_t ws_size, hipStream_t stream) {
    static int grid = 0;
    if (grid == 0) {
        if (n_in != 27 || ws_size < WS_END) { fprintf(stderr, "kernel_launch: unexpected n_in %d / ws %zu (need %zu)\n", n_in, ws_size, (size_t)WS_END); grid = -1; return; }
        int dev = 0, cus = 0, per_cu = 0;
        hipGetDevice(&dev);
        hipDeviceGetAttribute(&cus, hipDeviceAttributeMultiprocessorCount, dev);
        if (hipFuncSetAttribute((const void*)fwd_kernel, hipFuncAttributeMaxDynamicSharedMemorySize, LDS_BYTES) != hipSuccess) { fprintf(stderr, "kernel_launch: hipFuncSetAttribute failed\n"); grid = -1; return; }
        hipOccupancyMaxActiveBlocksPerMultiprocessor(&per_cu, (const void*)fwd_kernel, NT, LDS_BYTES);
        (void)hipGetLastError();
        if (per_cu < 1) fprintf(stderr, "kernel_launch: occupancy query reports %d blocks per CU\n", per_cu);
        grid = cus > 0 ? cus : 256;
    }
    if (grid < 0) return;
    hipMemsetAsync((char*)d_ws + WS_BAR, 0, XCD_BAR_WORDS * sizeof(unsigned), stream);
    Params p; memset(&p, 0, sizeof(p));
    const float** f = (const float**)&p;
    for (int i = 0; i < 27; ++i) f[i] = (const float*)d_in[i];
    p.out = (float*)d_out; p.ws = (unsigned char*)d_ws;
#if N_LAUNCH_MODE == 1
    p.ph_lo = 0; p.ph_hi = NPH;
    hipLaunchKernelGGL(fwd_kernel, dim3(grid), dim3(NT), LDS_BYTES, stream, p);
#else
#ifdef DBG_STOP
    for (int ph = 0; ph <= DBG_STOP; ++ph) { p.ph_lo = ph; p.ph_hi = ph + 1; hipLaunchKernelGGL(fwd_kernel, dim3(grid), dim3(NT), LDS_BYTES, stream, p); }
    hipLaunchKernelGGL(dbg_digest, dim3(2048), dim3(256), 0, stream, (const unsigned char*)d_ws, (size_t)DBG_OFF, (int)DBG_KIND, (size_t)DBG_NELEM, (float*)d_out, (size_t)out_size);
#else
    for (int ph = 0; ph < NPH; ++ph) { p.ph_lo = ph; p.ph_hi = ph + 1; hipLaunchKernelGGL(fwd_kernel, dim3(grid), dim3(NT), LDS_BYTES, stream, p); }
#endif
#endif
}
```

```cpp
#include <hip/hip_runtime.h>
#include <stdint.h>
#include <stdio.h>
#include <string.h>

#ifndef N_LAUNCH_MODE
#define N_LAUNCH_MODE 1
#endif

typedef unsigned short u16;
typedef short bf16x8 __attribute__((ext_vector_type(8)));
typedef float f32x4 __attribute__((ext_vector_type(4)));
typedef unsigned u32x4 __attribute__((ext_vector_type(4)));
typedef unsigned u32x2 __attribute__((ext_vector_type(2)));

#define NT 512
constexpr int D = 2048, BATCH = 4, SEQ = 4096, LC = 256;
constexpr int NLAT = BATCH * SEQ, NCTX = BATCH * LC, NTOK = NLAT + NCTX;
constexpr int AB_IN = 7184, CD_IN = 3584;
constexpr int NEXP = 16, FF = 2048, EPAD = 2304;
constexpr int NPH = 22;
constexpr int LDS_BYTES = 150 * 1024;

constexpr size_t al256(size_t x) { return (x + 255) & ~(size_t)255; }
constexpr size_t WS_BAR = 0;
constexpr size_t WS_MOD = 16384;
constexpr size_t WS_XL1 = al256(WS_MOD + 2 * 5 * 12288 * 4);
constexpr size_t WS_XL2 = al256(WS_XL1 + (size_t)NTOK * D * 4);
constexpr size_t WS_H = al256(WS_XL2 + (size_t)NTOK * D * 4);
constexpr size_t WS_P = al256(WS_H + (size_t)NTOK * D * 2);
constexpr size_t WS_G = al256(WS_P + (size_t)NTOK * AB_IN * 2);
constexpr size_t WS_HM = al256(WS_G + (size_t)NTOK * 16 * 4);
constexpr size_t WS_YIN = al256(WS_HM + (size_t)2 * NTOK * 1024 * 2);
constexpr size_t WS_Y = al256(WS_YIN + (size_t)NTOK * D * 2);
constexpr size_t WS_AFF = al256(WS_Y + (size_t)NTOK * D * 4);
constexpr size_t WS_SLOT = al256(WS_AFF + (size_t)NTOK * 16 * 4);
constexpr size_t WS_EROW = al256(WS_SLOT + (size_t)NTOK * 16 * 4);
constexpr size_t WS_EGATE = al256(WS_EROW + (size_t)NEXP * EPAD * 4);
constexpr size_t WS_ACT = al256(WS_EGATE + (size_t)NEXP * EPAD * 4);
constexpr size_t WS_YEXP = al256(WS_ACT + (size_t)NEXP * EPAD * FF * 2);
constexpr size_t WS_LRUS = al256(WS_YEXP + (size_t)NEXP * EPAD * D * 2);
constexpr size_t WS_LRUW = al256(WS_LRUS + (size_t)2 * 2 * 4 * 68 * 1024 * 4);
constexpr size_t WS_WT_ABIN = al256(WS_LRUW + (size_t)32 * 128 * 128 * 2);
constexpr size_t WS_WT_ABOUT = al256(WS_WT_ABIN + (size_t)AB_IN * D * 2);
constexpr size_t WS_WT_CDIN = al256(WS_WT_ABOUT + (size_t)D * D * 2);
constexpr size_t WS_WT_CDOUT = al256(WS_WT_CDIN + (size_t)CD_IN * D * 2);
constexpr size_t WS_WT_W1 = al256(WS_WT_CDOUT + (size_t)D * D * 2);
constexpr size_t WS_WT_W3 = al256(WS_WT_W1 + (size_t)NEXP * D * FF * 2);
constexpr size_t WS_WT_W2 = al256(WS_WT_W3 + (size_t)NEXP * D * FF * 2);
constexpr size_t WS_END = al256(WS_WT_W2 + (size_t)NEXP * D * FF * 2);

struct Params {
    const float *x, *c, *ctx, *c_ctx, *ada_w, *ada_b, *norm_mix_pre, *norm_mix_post, *norm_ffn_pre, *norm_ffn_post;
    const float *ab_w_in, *ab_w_out, *mlstm_gate_b, *mlstm_norm, *na_rpb;
    const float *cd_w_in, *cd_w_out, *gqa_sink, *lru_conv_w, *lru_conv_b, *lru_gate_w, *lru_gate_b, *lru_lambda;
    const float *moe_router, *moe_w1, *moe_w3, *moe_w2;
    float* out;
    unsigned char* ws;
    int ph_lo, ph_hi;
};

#define XB_TMO      128
#define XB_XCNT(j)  (256  + 64 * (j))
#define XB_XSUB(j)  (1280 + 64 * (j))
#define XB_XGEN(j)  (2304 + 64 * (j))
#define XB_TOP      3328
#define XB_TOPGEN   3392
#define XCD_BAR_WORDS 3456
#define XB_SPIN_CAP (1u << 22)
#define LAS __attribute__((address_space(3)))

__device__ __forceinline__ unsigned xb_ld(unsigned* p)              { return __hip_atomic_load(p, __ATOMIC_RELAXED, __HIP_MEMORY_SCOPE_AGENT); }
__device__ __forceinline__ unsigned xb_add(unsigned* p, unsigned v) { return __hip_atomic_fetch_add(p, v, __ATOMIC_RELAXED, __HIP_MEMORY_SCOPE_AGENT); }
__device__ __forceinline__ unsigned xb_xcc_id() { return (unsigned)__builtin_amdgcn_s_getreg((3 << 11) | 20) & 0xFu; }
#define XB_SPIN(cond, bar) do { unsigned _sp = 0; while (cond) { __builtin_amdgcn_s_sleep(1); \
    if ((++_sp & 255u) == 0u) { if (xb_ld(&(bar)[XB_TMO])) break; if (_sp > XB_SPIN_CAP) { atomicAdd(&(bar)[XB_TMO], 1u); break; } } } } while (0)

struct XcdBarrier {
    unsigned* bar; unsigned x;
    volatile LAS unsigned* st;
};
__device__ __forceinline__ XcdBarrier xcd_barrier_post(unsigned* bar, volatile LAS unsigned* st) {
    XcdBarrier b; b.bar = bar; b.x = xb_xcc_id(); b.st = st;
    if (threadIdx.x == 0) (void)xb_add(&bar[XB_XCNT(b.x)], 1u);
    return b;
}
__device__ __forceinline__ void xcd_barrier_complete(unsigned* bar, unsigned x, unsigned& nloc, unsigned& nx) {
    const unsigned G = gridDim.x * gridDim.y * gridDim.z;
    unsigned sum, cnt, mine, sp = 0u;
    for (;;) {
        sum = 0u; cnt = 0u; mine = 0u;
#pragma unroll
        for (unsigned j = 0; j < 16; ++j) { const unsigned c = xb_ld(&bar[XB_XCNT(j)]); sum += c; cnt += (c > 0u) ? 1u : 0u; mine = (j == x) ? c : mine; }
        if (sum == G) break;
        __builtin_amdgcn_s_sleep(1);
        if ((++sp & 255u) == 0u) { if (xb_ld(&bar[XB_TMO])) break; if (sp > XB_SPIN_CAP) { atomicAdd(&bar[XB_TMO], 1u); break; } }
    }
    nloc = mine > 0u ? mine : 1u; nx = cnt > 0u ? cnt : 1u;
}
__device__ __forceinline__ void xcd_barrier(const XcdBarrier& b) {
    asm volatile("s_waitcnt vmcnt(0)" ::: "memory");
    __syncthreads();
    if (threadIdx.x == 0) {
        unsigned* bar = b.bar;
        __builtin_amdgcn_s_waitcnt(0);
        unsigned nloc = b.st[0], nx = b.st[1];
        if (nloc == 0u) { xcd_barrier_complete(bar, b.x, nloc, nx); b.st[0] = nloc; b.st[1] = nx; }
        const unsigned old = xb_add(&bar[XB_XSUB(b.x)], 1u);
        const unsigned gen = old / nloc;
        if (old + 1u == (gen + 1u) * nloc) {
            __builtin_amdgcn_fence(__ATOMIC_RELEASE, "agent");
            asm volatile("s_waitcnt vmcnt(0)" ::: "memory");
            const unsigned og = xb_add(&bar[XB_TOP], 1u);
            const unsigned tg = og / nx;
            if (og + 1u == (tg + 1u) * nx) xb_add(&bar[XB_TOPGEN], 1u);
            else XB_SPIN(xb_ld(&bar[XB_TOPGEN]) == tg, bar);
            __builtin_amdgcn_fence(__ATOMIC_ACQUIRE, "agent");
            xb_add(&bar[XB_XGEN(b.x)], 1u);
            asm volatile("s_waitcnt vmcnt(0)" ::: "memory");
        } else {
            XB_SPIN(xb_ld(&bar[XB_XGEN(b.x)]) == gen, bar);
            __builtin_amdgcn_fence(__ATOMIC_ACQUIRE, "agent");
            asm volatile("s_waitcnt vmcnt(0)" ::: "memory");
        }
    }
    __syncthreads();
}

typedef float f32x2_t __attribute__((ext_vector_type(2)));
typedef __bf16 bf16x2_t __attribute__((ext_vector_type(2)));
__device__ __forceinline__ unsigned pk_bf16(float lo, float hi) { f32x2_t v = {lo, hi}; return __builtin_bit_cast(unsigned, __builtin_convertvector(v, bf16x2_t)); }
__device__ __forceinline__ float bf_lo(unsigned u) { return __uint_as_float(u << 16); }
__device__ __forceinline__ float bf_hi(unsigned u) { return __uint_as_float(u & 0xffff0000u); }
__device__ __forceinline__ float bf2f(u16 v) { return __uint_as_float(((unsigned)v) << 16); }
__device__ __forceinline__ u16 f2bf(float f) { return (u16)(pk_bf16(f, 0.f) & 0xffffu); }
template <int CTRL> __device__ __forceinline__ float dpp_f(float v) { return __uint_as_float((unsigned)__builtin_amdgcn_update_dpp(0, (int)__float_as_uint(v), CTRL, 0xf, 0xf, true)); }
__device__ __forceinline__ float row_sum16(float v) { v += dpp_f<0xB1>(v); v += dpp_f<0x4E>(v); v += dpp_f<0x141>(v); v += dpp_f<0x140>(v); return v; }
__device__ __forceinline__ float row_max16(float v) { v = fmaxf(v, dpp_f<0xB1>(v)); v = fmaxf(v, dpp_f<0x4E>(v)); v = fmaxf(v, dpp_f<0x141>(v)); v = fmaxf(v, dpp_f<0x140>(v)); return v; }
__device__ __forceinline__ float rdlane_f(float v, int l) { return __uint_as_float((unsigned)__builtin_amdgcn_readlane((int)__float_as_uint(v), l)); }
__device__ __forceinline__ float wave_sum(float v) { v = row_sum16(v); return (rdlane_f(v, 0) + rdlane_f(v, 16)) + (rdlane_f(v, 32) + rdlane_f(v, 48)); }
__device__ __forceinline__ float wave_max(float v) { v = row_max16(v); return fmaxf(fmaxf(rdlane_f(v, 0), rdlane_f(v, 16)), fmaxf(rdlane_f(v, 32), rdlane_f(v, 48))); }
__device__ __forceinline__ int tid_() { int t = threadIdx.x; asm volatile("" : "+v"(t)); return t; }
__device__ __forceinline__ int bid_() { int b = blockIdx.x; asm volatile("" : "+s"(b)); return b; }
__device__ __forceinline__ int gdim_() { int b = gridDim.x; asm volatile("" : "+s"(b)); return b; }
__device__ __forceinline__ float frcp_(float x) { return __builtin_amdgcn_rcpf(x); }
__device__ __forceinline__ float sigmoidf_(float x) { return frcp_(1.f + __expf(-x)); }
__device__ __forceinline__ f32x4 mfma16(bf16x8 a, bf16x8 b, f32x4 c) { return __builtin_amdgcn_mfma_f32_16x16x32_bf16(a, b, c, 0, 0, 0); }
__device__ __forceinline__ bf16x8 ld_frag_g(const u16* p) { return *reinterpret_cast<const bf16x8*>(p); }
__device__ __forceinline__ bf16x8 ld_frag_s(const u16* p) { return *reinterpret_cast<const bf16x8*>(p); }
__device__ __forceinline__ bf16x8 mk_frag(unsigned a, unsigned b, unsigned c, unsigned d) { u32x4 v = {a, b, c, d}; return __builtin_bit_cast(bf16x8, v); }

__device__ __forceinline__ const float* xin_row(const Params& p, int l, int row) {
    if (l == 0) return row < NLAT ? p.x + (size_t)row * D : p.ctx + (size_t)(row - NLAT) * D;
    return (const float*)(p.ws + WS_XL2) + (size_t)row * D;
}
__device__ __forceinline__ const float* mod_ptr(const Params& p, int l, int row, int chunk) {
    const int bb = row < NLAT ? (row >> 12) : 4;
    return (const float*)(p.ws + WS_MOD) + ((size_t)(l * 5 + bb) * 6 + chunk) * D;
}

__device__ void phase_mod(const Params& p, unsigned char* lds_raw) {
    float* scond = (float*)lds_raw;
    float* red = scond + 5 * D;
    const int t = tid_();
    for (int i = t; i < 5 * D; i += NT) { const int r = i >> 11, k = i & 2047; const float v = r < 4 ? p.c[r * D + k] : p.c_ctx[k]; scond[i] = v / (1.f + __expf(-v)); }
    __syncthreads();
    float* mod = (float*)(p.ws + WS_MOD);
    for (int item = bid_(); item < 192; item += gdim_()) {
        const int l = item / 96, col0 = (item % 96) * 128;
        const int kg = t >> 5, cl = (t & 31) * 4;
        f32x4 acc[5];
#pragma unroll
        for (int r = 0; r < 5; ++r) acc[r] = (f32x4){0.f, 0.f, 0.f, 0.f};
        const float* wp = p.ada_w + ((size_t)l * D + kg * 128) * (6 * D) + col0 + cl;
#pragma unroll 8
        for (int kk = 0; kk < 128; ++kk) {
            const f32x4 w = *reinterpret_cast<const f32x4*>(wp + (size_t)kk * (6 * D));
#pragma unroll
            for (int r = 0; r < 5; ++r) { const float s = scond[r * D + kg * 128 + kk]; acc[r] += w * s; }
        }
#pragma unroll
        for (int r = 0; r < 5; ++r) *reinterpret_cast<f32x4*>(red + (kg * 5 + r) * 128 + cl) = acc[r];
        __syncthreads();
        for (int o = t; o < 640; o += NT) {
            const int r = o >> 7, cc = o & 127;
            float s = p.ada_b[l * 6 * D + col0 + cc];
#pragma unroll
            for (int g = 0; g < 16; ++g) s += red[(g * 5 + r) * 128 + cc];
            mod[(size_t)(l * 5 + r) * 6 * D + col0 + cc] = s;
        }
        __syncthreads();
    }
}

__device__ void phase_norm_mod(const Params& p, int l) {
    const int lane = tid_() & 63, w = tid_() >> 6;
    u16* H = (u16*)(p.ws + WS_H);
    for (int row = bid_() * 8 + w; row < NTOK; row += gdim_() * 8) {
        const float* xr = xin_row(p, l, row);
        f32x4 v[8]; float ss = 0.f;
#pragma unroll
        for (int i = 0; i < 8; ++i) { v[i] = *reinterpret_cast<const f32x4*>(xr + (i * 64 + lane) * 4); ss += v[i][0] * v[i][0] + v[i][1] * v[i][1] + v[i][2] * v[i][2] + v[i][3] * v[i][3]; }
        ss = wave_sum(ss);
        const float rstd = rsqrtf(ss * (1.f / D) + 1e-6f);
        const float* sh = mod_ptr(p, l, row, 0); const float* sc = mod_ptr(p, l, row, 1);
        const float* nw = p.norm_mix_pre + (size_t)l * D;
#pragma unroll
        for (int i = 0; i < 8; ++i) {
            const int col = (i * 64 + lane) * 4;
            const f32x4 w4 = *reinterpret_cast<const f32x4*>(nw + col), s4 = *reinterpret_cast<const f32x4*>(sc + col), h4 = *reinterpret_cast<const f32x4*>(sh + col);
            f32x4 o = v[i] * rstd * w4 * (s4 + 1.f) + h4;
            u32x2 pk = {pk_bf16(o[0], o[1]), pk_bf16(o[2], o[3])};
            *reinterpret_cast<u32x2*>(H + (size_t)row * D + col) = pk;
        }
    }
}

__device__ __forceinline__ void convert_item(const float* W, int N, u16* Wt, int kb, int nb, unsigned char* lds) {
    const int t = tid_(), lane = t & 63, w = t >> 6;
    const int n4 = lane * 4, k0 = kb * 64 + w * 8, n0 = nb * 256;
    int col = n0 + n4; if (col > N - 4) col = N - 4;
    f32x4 r8[8];
#pragma unroll
    for (int j = 0; j < 8; ++j) r8[j] = *reinterpret_cast<const f32x4*>(W + (size_t)(k0 + j) * N + col);
    __syncthreads();
#pragma unroll
    for (int jj = 0; jj < 4; ++jj) {
        u32x4 v = {pk_bf16(r8[0][jj], r8[1][jj]), pk_bf16(r8[2][jj], r8[3][jj]), pk_bf16(r8[4][jj], r8[5][jj]), pk_bf16(r8[6][jj], r8[7][jj])};
        const int r = n4 + jj;
        *reinterpret_cast<u32x4*>(lds + r * 128 + ((w ^ ((r >> 2) & 7)) << 4)) = v;
    }
    __syncthreads();
    const int c = t & 7;
#pragma unroll
    for (int i = 0; i < 4; ++i) {
        const int r = (t >> 3) + 64 * i;
        if (n0 + r < N) {
            const u32x4 v = *reinterpret_cast<const u32x4*>(lds + r * 128 + ((c ^ ((r >> 2) & 7)) << 4));
            *reinterpret_cast<u32x4*>(Wt + (size_t)(n0 + r) * 2048 + ((kb * 64 + c * 8 + 64 * ((n0 + r) & 31)) & 2047)) = v;
        }
    }
}
__device__ void convert_matrix_items(const float* W, int N, u16* Wt, int first, int count, unsigned char* lds) {
    const int nnb = (N + 255) / 256;
    for (int it = first; it < first + count; ++it) convert_item(W, N, Wt, it / nnb, it % nnb, lds);
}
__device__ void phase_convert_dense(const Params& p, unsigned char* lds) {
    for (int item = bid_(); item < 1888; item += gdim_()) {
        if (item < 928) convert_item(p.ab_w_in, AB_IN, (u16*)(p.ws + WS_WT_ABIN), item / 29, item % 29, lds);
        else if (item < 1184) { const int it = item - 928; convert_item(p.ab_w_out, D, (u16*)(p.ws + WS_WT_ABOUT), it / 8, it % 8, lds); }
        else if (item < 1632) { const int it = item - 1184; convert_item(p.cd_w_in, CD_IN, (u16*)(p.ws + WS_WT_CDIN), it / 14, it % 14, lds); }
        else { const int it = item - 1632; convert_item(p.cd_w_out, D, (u16*)(p.ws + WS_WT_CDOUT), it / 8, it % 8, lds); }
    }
}
__device__ void phase_convert_moe(const Params& p, int l, unsigned char* lds) {
    for (int item = bid_(); item < 3 * NEXP * 256; item += gdim_()) {
        const int which = item / (NEXP * 256), r = item % (NEXP * 256), ex = r >> 8, it = r & 255;
        const float* src = (which == 0 ? p.moe_w1 : (which == 1 ? p.moe_w3 : p.moe_w2)) + (size_t)(l * NEXP + ex) * D * FF;
        u16* dst = (u16*)(p.ws + (which == 0 ? WS_WT_W1 : (which == 1 ? WS_WT_W3 : WS_WT_W2))) + (size_t)ex * D * FF;
        convert_item(src, 2048, dst, it >> 3, it & 7, lds);
    }
}

struct GemmDesc {
    const u16* A; int lda; const int* arow; int mvalid; int m0;
    const u16* B0; const u16* B1; int n0; int ncols;
    int K;
};
enum { EPI_BF16 = 0, EPI_F32 = 1, EPI_SWIGLU = 2, EPI_SCALE = 3 };
struct EpiDesc { u16* ob; float* of; int ldo; float* gates; const float* rscale; };
constexpr int GEMM_BUF = 65536, GEMM_BOFF = 32768;

template <int EPI>
__device__ __forceinline__ void gemm_tile(const GemmDesc& g, const EpiDesc& e, unsigned char* lds) {
    const int t = tid_(), lane = t & 63, w = t >> 6;
    const int wr = w >> 2, wc = w & 3, fr = lane & 15, fq = lane >> 4;
    const int ac = t & 7, ar = t >> 3;
    const int kofs = (ac ^ ((ar >> 1) & 7)) << 3;
    unsigned ap[4], bpo[4];
#pragma unroll
    for (int i = 0; i < 4; ++i) {
        int r = g.m0 + ar + 64 * i; if (r >= g.mvalid) r = g.mvalid - 1;
        const int src = g.arow ? g.arow[r] : r;
        ap[i] = ((unsigned)src * 2048u + kofs) * 2u;
        const int np = ar + 64 * i;
        if (EPI == EPI_SWIGLU) {
            const int which = (np >> 5) & 1, ffl = (np >> 6) * 32 + (np & 31);
            bpo[i] = ((unsigned)(g.n0 + ffl) * 2048u) * 2u + (which ? (unsigned)(WS_WT_W3 - WS_WT_W1) : 0u);
        } else {
            int n = g.n0 + np; if (n >= g.ncols) n = g.ncols - 1;
            bpo[i] = ((unsigned)n * 2048u) * 2u;
        }
    }
    const int d_off = t * 16;
    const int s0 = (fr >> 1) & 7;
    const int a_rd0 = wr * 16384 + fr * 128 + ((fq ^ s0) << 4), a_rd1 = a_rd0 ^ 64;
    const int b_rd0 = GEMM_BOFF + wc * 8192 + fr * 128 + ((fq ^ s0) << 4), b_rd1 = b_rd0 ^ 64;

    f32x4 acc[8][4];
#pragma unroll
    for (int i = 0; i < 8; ++i)
#pragma unroll
        for (int j = 0; j < 4; ++j) acc[i][j] = (f32x4){0.f, 0.f, 0.f, 0.f};

    constexpr int nk = 2048 >> 6;
    const unsigned brot = (unsigned)(kofs * 2 + (ar & 31) * 128);
#define G_DMA(BUF, KT) do { const unsigned _k = (unsigned)(KT) << 7; \
    const unsigned char* _ab = (const unsigned char*)g.A + _k; const unsigned char* _bb = (const unsigned char*)g.B0; \
    asm volatile("" : "+s"(_ab), "+s"(_bb));     \
    const unsigned _kb = (_k + brot) & 4095u; \
    _Pragma("unroll") for (int i = 0; i < 4; ++i) __builtin_amdgcn_global_load_lds((const unsigned*)(_ab + ap[i]), (unsigned*)((BUF) + d_off + i * 8192), 16, 0, 0); \
    _Pragma("unroll") for (int i = 0; i < 4; ++i) __builtin_amdgcn_global_load_lds((const unsigned*)(_bb + (bpo[i] + _kb)), (unsigned*)((BUF) + GEMM_BOFF + d_off + i * 8192), 16, 0, 0); } while (0)
    G_DMA(lds, 0);
    for (int kt = 0; kt < nk; ++kt) {
        unsigned char* buf = lds + (kt & 1) * GEMM_BUF;
        asm volatile("s_waitcnt vmcnt(0)" ::: "memory");
        __syncthreads();
        if (kt + 1 < nk) G_DMA(lds + ((kt + 1) & 1) * GEMM_BUF, kt + 1);
#define RD_A(KK, MI) (*reinterpret_cast<const bf16x8*>(buf + (((KK) ? a_rd1 : a_rd0) + (MI) * 2048)))
#define RD_B(KK, NI) (*reinterpret_cast<const bf16x8*>(buf + (((KK) ? b_rd1 : b_rd0) + (NI) * 2048)))
        bf16x8 bq[2][4], aq[2][2];
#pragma unroll
        for (int ni = 0; ni < 4; ++ni) bq[0][ni] = RD_B(0, ni);
        aq[0][0] = RD_A(0, 0); aq[0][1] = RD_A(0, 1);
#define G_STEP(ST) do { \
        constexpr int kk = (ST) >> 2, pr = (ST) & 3, cur = (ST) & 1, nxt = cur ^ 1, nkk = ((ST) + 1) >> 2, npr = ((ST) + 1) & 3; \
        if ((ST) < 7) { \
            if (npr == 0) { _Pragma("unroll") for (int ni = 0; ni < 4; ++ni) bq[nkk & 1][ni] = RD_B(nkk & 1, ni); } \
            aq[nxt][0] = RD_A(nkk & 1, npr * 2); aq[nxt][1] = RD_A(nkk & 1, npr * 2 + 1); } \
        _Pragma("unroll") for (int h2 = 0; h2 < 2; ++h2) \
            _Pragma("unroll") for (int ni = 0; ni < 4; ++ni) acc[pr * 2 + h2][ni] = mfma16(bq[kk][ni], aq[cur][h2], acc[pr * 2 + h2][ni]); \
        __builtin_amdgcn_sched_group_barrier(0x100, ((ST) < 7) ? (npr == 0 ? 6 : 2) : 0, 0); \
        __builtin_amdgcn_sched_group_barrier(0x008, 8, 0); } while (0)
        G_STEP(0); G_STEP(1); G_STEP(2); G_STEP(3); G_STEP(4); G_STEP(5); G_STEP(6); G_STEP(7);
#undef G_STEP
#undef RD_A
#undef RD_B
    }
#undef G_DMA
#pragma unroll
    for (int mi = 0; mi < 8; ++mi) {
        const int row = g.m0 + wr * 128 + mi * 16 + fr;
        if (row < g.mvalid) {
            if (EPI == EPI_BF16) {
#pragma unroll
                for (int ni = 0; ni < 4; ++ni) {
                    const int col = g.n0 + wc * 64 + ni * 16 + 4 * fq;
                    if (col < g.ncols) {
                        const f32x4 v = acc[mi][ni];
                        u32x2 pk = {pk_bf16(v[0], v[1]), pk_bf16(v[2], v[3])};
                        *reinterpret_cast<u32x2*>(e.ob + (size_t)row * e.ldo + col) = pk;
                        if (e.gates && col >= 4096 && col < 4112) *reinterpret_cast<f32x4*>(e.gates + (size_t)row * 16 + (col - 4096)) = v;
                    }
                }
            } else if (EPI == EPI_F32) {
#pragma unroll
                for (int ni = 0; ni < 4; ++ni) {
                    const int col = g.n0 + wc * 64 + ni * 16 + 4 * fq;
                    *reinterpret_cast<f32x4*>(e.of + (size_t)row * e.ldo + col) = acc[mi][ni];
                }
            } else if (EPI == EPI_SWIGLU) {
#pragma unroll
                for (int ni = 0; ni < 2; ++ni) {
                    const int col = g.n0 + wc * 32 + ni * 16 + 4 * fq;
                    const f32x4 u = acc[mi][ni], v = acc[mi][ni + 2];
                    f32x4 a;
#pragma unroll
                    for (int q = 0; q < 4; ++q) a[q] = u[q] * frcp_(1.f + __expf(-u[q])) * v[q];
                    u32x2 pk = {pk_bf16(a[0], a[1]), pk_bf16(a[2], a[3])};
                    *reinterpret_cast<u32x2*>(e.ob + (size_t)row * e.ldo + col) = pk;
                }
            } else {
                const float sc = e.rscale[row];
#pragma unroll
                for (int ni = 0; ni < 4; ++ni) {
                    const int col = g.n0 + wc * 64 + ni * 16 + 4 * fq;
                    const f32x4 v = acc[mi][ni] * sc;
                    u32x2 pk = {pk_bf16(v[0], v[1]), pk_bf16(v[2], v[3])};
                    *reinterpret_cast<u32x2*>(e.ob + (size_t)row * e.ldo + col) = pk;
                }
            }
        }
    }
    __syncthreads();
}

template <int EPI>
__device__ void phase_gemm_dense(const Params& p, const u16* A, int M, const u16* Wt, int N, EpiDesc e, unsigned char* lds) {
    const int nM = M / 256, nN = (N + 255) / 256, L = nM * nN;
    const int xcd = bid_() & 7, slot = bid_() >> 3, nslot = gdim_() >> 3;
    const int base = (int)(((long)L * xcd) >> 3), cnt = (int)(((long)L * (xcd + 1)) >> 3) - base;
    const int G8 = nM >> 3, rem = nM & 7;
    for (int k = slot; k < cnt; k += nslot) {
        const int idx = base + k;
        int pn, pm;
        if (idx < G8 * 8 * nN) { const int gq = idx / (8 * nN), r = idx % (8 * nN); pn = r >> 3; pm = gq * 8 + (r & 7); }
        else { const int r = idx - G8 * 8 * nN; pn = r / rem; pm = G8 * 8 + r % rem; }
        GemmDesc g; g.A = A; g.lda = D; g.arow = nullptr; g.mvalid = M; g.m0 = pm * 256;
        g.B0 = Wt; g.B1 = nullptr; g.n0 = pn * 256; g.ncols = N; g.K = D;
        gemm_tile<EPI>(g, e, lds);
    }
}

__device__ void phase_moe_a(const Params& p, int l, unsigned char* lds) {
    const int mvalid = l == 0 ? 2176 : 2048, nM = l == 0 ? 9 : 8;
    const int per_e = nM * 16;
    const int xcd = bid_() & 7, slot = bid_() >> 3, nslot = gdim_() >> 3;
    for (int k = slot; k < 2 * per_e; k += nslot) {
        const int tile = xcd * 2 * per_e + k;
        const int ex = tile / per_e, r = tile % per_e, pn = r / nM, pm = r % nM;
        GemmDesc g; g.A = (const u16*)(p.ws + WS_H); g.lda = D; g.arow = (const int*)(p.ws + WS_EROW) + ex * EPAD; g.mvalid = mvalid; g.m0 = pm * 256;
        g.B0 = (const u16*)(p.ws + WS_WT_W1) + (size_t)ex * D * FF; g.B1 = (const u16*)(p.ws + WS_WT_W3) + (size_t)ex * D * FF; g.n0 = pn * 128; g.ncols = FF; g.K = D;
        EpiDesc e; e.ob = (u16*)(p.ws + WS_ACT) + (size_t)ex * EPAD * FF; e.of = nullptr; e.ldo = FF; e.gates = nullptr; e.rscale = nullptr;
        gemm_tile<EPI_SWIGLU>(g, e, lds);
    }
}
__device__ void phase_moe_b(const Params& p, int l, unsigned char* lds) {
    const int mvalid = l == 0 ? 2176 : 2048, nM = l == 0 ? 9 : 8;
    const int per_e = nM * 8;
    const int xcd = bid_() & 7, slot = bid_() >> 3, nslot = gdim_() >> 3;
    for (int k = slot; k < 2 * per_e; k += nslot) {
        const int tile = xcd * 2 * per_e + k;
        const int ex = tile / per_e, r = tile % per_e, pn = r / nM, pm = r % nM;
        GemmDesc g; g.A = (const u16*)(p.ws + WS_ACT) + (size_t)ex * EPAD * FF; g.lda = FF; g.arow = nullptr; g.mvalid = mvalid; g.m0 = pm * 256;
        g.B0 = (const u16*)(p.ws + WS_WT_W2) + (size_t)ex * D * FF; g.B1 = nullptr; g.n0 = pn * 256; g.ncols = D; g.K = FF;
        EpiDesc e; e.ob = (u16*)(p.ws + WS_YEXP) + (size_t)ex * EPAD * D; e.of = nullptr; e.ldo = D; e.gates = nullptr; e.rscale = (const float*)(p.ws + WS_EGATE) + ex * EPAD;
        gemm_tile<EPI_SCALE>(g, e, lds);
    }
}

__device__ __forceinline__ int mlstm_row(int b, int dir, int pos) {
    if (pos < LC) return NLAT + b * LC + (dir ? (LC - 1 - pos) : pos);
    const int q = pos - LC; return b * SEQ + (dir ? (SEQ - 1 - q) : q);
}
__device__ void phase_mlstm(const Params& p, unsigned char* lds) {
    u16* KT = (u16*)lds;
    u16* VT = KT + 256 * 72;
    u16* VWT = VT + 48 * 72;
    u16* CT = VWT + 48 * 72;
    u16* Ss = CT + 48 * 264;
    float* gB = (float*)(Ss + 64 * 72);
    float* gI = gB + 68 * 64;
    float* gP = gI + 68 * 64;
    float* gE = gP + 68 * 64;
    const int t = tid_(), lane = t & 63, w = t >> 6, fr = lane & 15, fq = lane >> 4;
    const u16* P = (const u16*)(p.ws + WS_P);
    const float* G = (const float*)(p.ws + WS_G);
    u16* HM = (u16*)(p.ws + WS_HM);
    for (int item = bid_(); item < 256; item += gdim_()) {
        const int vs = item & 7, dir = (item >> 3) & 1, hh = (item >> 4) & 3, b = item >> 6;
        __syncthreads();
        for (int i = t; i < 48 * 264; i += NT) CT[i] = 0;
        for (int i = t; i < 16 * 72; i += NT) { const int er = i / 72; VT[32 * 72 + i] = (er == 0) ? (u16)0x3f80 : (u16)0; VWT[32 * 72 + i] = 0; }
        {
            const float gb_i = p.mlstm_gate_b[(dir * 2 + 0) * 4 + hh], gb_f = p.mlstm_gate_b[(dir * 2 + 1) * 4 + hh];
            for (int ch = w; ch < 68; ch += 8) {
                const int row = mlstm_row(b, dir, ch * 64 + lane);
                const float gi = G[(size_t)row * 16 + dir * 8 + hh] + gb_i;
                const float gf = G[(size_t)row * 16 + dir * 8 + 4 + hh] + gb_f;
                const float lf = fminf(gf, 0.f) - log1pf(__expf(-fabsf(gf)));
                float bc = lf;
#pragma unroll
                for (int o = 1; o < 64; o <<= 1) { const float n = __shfl_up(bc, o, 64); if (lane >= o) bc += n; }
                float pm = gi - bc;
#pragma unroll
                for (int o = 1; o < 64; o <<= 1) { const float n = __shfl_up(pm, o, 64); if (lane >= o) pm = fmaxf(pm, n); }
                const float b63 = __shfl(bc, 63, 64);
                float gmax = b63 - bc + gi;
#pragma unroll
                for (int o = 32; o > 0; o >>= 1) gmax = fmaxf(gmax, __shfl_xor(gmax, o, 64));
                gB[ch * 64 + lane] = bc; gI[ch * 64 + lane] = gi; gP[ch * 64 + lane] = pm;
                if (lane == 0) { gE[ch * 2] = b63; gE[ch * 2 + 1] = gmax; }
            }
        }
        f32x4 Cacc[2][3];
#pragma unroll
        for (int i = 0; i < 2; ++i)
#pragma unroll
            for (int j = 0; j < 3; ++j) Cacc[i][j] = (f32x4){0.f, 0.f, 0.f, 0.f};
        float m_old = 0.f;
        const int jt = w & 3, sth = w >> 2;
        const int vs_s = t & 63, vs_eg = t >> 6;
        bf16x8 qf[8], kf[8]; unsigned ktr[2][8]; u32x2 vraw;
        const int jq = jt * 16 + fr, jjq = dir ? 63 - jq : jq;
        const unsigned off_q = (unsigned)jjq * AB_IN + hh * 256 + fq * 8;
        const int jk0 = (sth * 2) * 16 + fr, jk1 = jk0 + 16;
        const unsigned off_k0 = (unsigned)(dir ? 63 - jk0 : jk0) * AB_IN + 1024 + hh * 256 + fq * 8;
        const unsigned off_k1 = (unsigned)(dir ? 63 - jk1 : jk1) * AB_IN + 1024 + hh * 256 + fq * 8;
        unsigned off_kt[2];
#pragma unroll
        for (int i = 0; i < 2; ++i) { const int mt = t + NT * i, d2 = (mt & 127) * 2, s8 = (mt >> 7) * 8; off_kt[i] = (unsigned)(dir ? 63 - s8 - 7 : s8) * AB_IN + 1024 + hh * 256 + d2; }
        const unsigned off_v = (unsigned)(dir ? 63 - vs_s : vs_s) * AB_IN + 2048 + hh * 256 + vs * 32 + vs_eg * 4;
        const unsigned off_h = (unsigned)jjq * 1024 + hh * 256 + vs * 32 + sth * 16 + 4 * fq;
#define ML_BASE(POS0) (P + (size_t)(dir ? mlstm_row(b, dir, (POS0)) - 63 : mlstm_row(b, dir, (POS0))) * AB_IN)
#define ML_LOAD_Q(POS0) do { const u16* _pc = ML_BASE(POS0); \
            _Pragma("unroll") for (int kk = 0; kk < 8; ++kk) qf[kk] = ld_frag_g(_pc + off_q + kk * 32); } while (0)
#define ML_LOAD_K(POS0, S2) do { const u16* _pc = ML_BASE(POS0); \
            _Pragma("unroll") for (int kk = 0; kk < 8; ++kk) kf[kk] = ld_frag_g(_pc + ((S2) ? off_k1 : off_k0) + kk * 32); } while (0)
#define ML_LOAD_KTV(POS0) do { const u16* _pc = ML_BASE(POS0); \
            _Pragma("unroll") for (int i = 0; i < 2; ++i) { \
                _Pragma("unroll") for (int q = 0; q < 8; ++q) ktr[i][q] = *reinterpret_cast<const unsigned*>(_pc + (size_t)((dir ? 7 - q : q) * AB_IN) + off_kt[i]); } \
            vraw = *reinterpret_cast<const u32x2*>(_pc + off_v); } while (0)
        ML_LOAD_Q(0);
        __syncthreads();
        for (int ch = 0; ch < 68; ++ch) {
            const int pos0 = ch * 64;
            const float* sb = gB + ch * 64; const float* sig = gI + ch * 64; const float* spm = gP + ch * 64;
            const float b63 = gE[ch * 2], m_new = fmaxf(b63 + m_old, gE[ch * 2 + 1]), decay = __expf(b63 + m_old - m_new);
            const int jg = jt * 16 + fr;
            const float bj = sb[jg], mj = bj + fmaxf(m_old, spm[jg]);
            auto s_tile = [&](int st) {
                f32x4 sv = (f32x4){0.f, 0.f, 0.f, 0.f};
                if (st <= jt) {
#pragma unroll
                    for (int kk = 0; kk < 8; ++kk) sv = mfma16(kf[kk], qf[kk], sv);
                }
                float pv[4];
#pragma unroll
                for (int q = 0; q < 4; ++q) {
                    const int sg = st * 16 + 4 * fq + q;
                    pv[q] = (sg <= jg) ? sv[q] * 0.0625f * __expf(bj - sb[sg] + sig[sg] - mj) : 0.f;
                }
                u32x2 pk = {pk_bf16(pv[0], pv[1]), pk_bf16(pv[2], pv[3])};
                *reinterpret_cast<u32x2*>(Ss + jg * 72 + st * 16 + 4 * fq) = pk;
            };
            ML_LOAD_KTV(pos0);
            if (sth * 2 <= jt) ML_LOAD_K(pos0, 0);
#pragma unroll
            for (int i = 0; i < 2; ++i) {
                const int mt = t + NT * i, d2 = (mt & 127) * 2, s8 = (mt >> 7) * 8;
                u32x4 lo = {(ktr[i][0] & 0xffffu) | (ktr[i][1] << 16), (ktr[i][2] & 0xffffu) | (ktr[i][3] << 16), (ktr[i][4] & 0xffffu) | (ktr[i][5] << 16), (ktr[i][6] & 0xffffu) | (ktr[i][7] << 16)};
                u32x4 hi = {(ktr[i][0] >> 16) | (ktr[i][1] & 0xffff0000u), (ktr[i][2] >> 16) | (ktr[i][3] & 0xffff0000u), (ktr[i][4] >> 16) | (ktr[i][5] & 0xffff0000u), (ktr[i][6] >> 16) | (ktr[i][7] & 0xffff0000u)};
                *reinterpret_cast<u32x4*>(KT + d2 * 72 + s8) = lo;
                *reinterpret_cast<u32x4*>(KT + (d2 + 1) * 72 + s8) = hi;
            }
            {
                const float wg = __expf(b63 - sb[vs_s] + sig[vs_s] - m_new) * 0.0625f;
                const float v0 = bf_lo(vraw[0]), v1 = bf_hi(vraw[0]), v2 = bf_lo(vraw[1]), v3 = bf_hi(vraw[1]);
                const int e0 = vs_eg * 4;
                VT[(e0 + 0) * 72 + vs_s] = (u16)(vraw[0] & 0xffffu); VT[(e0 + 1) * 72 + vs_s] = (u16)(vraw[0] >> 16);
                VT[(e0 + 2) * 72 + vs_s] = (u16)(vraw[1] & 0xffffu); VT[(e0 + 3) * 72 + vs_s] = (u16)(vraw[1] >> 16);
                VWT[(e0 + 0) * 72 + vs_s] = f2bf(v0 * wg); VWT[(e0 + 1) * 72 + vs_s] = f2bf(v1 * wg);
                VWT[(e0 + 2) * 72 + vs_s] = f2bf(v2 * wg); VWT[(e0 + 3) * 72 + vs_s] = f2bf(v3 * wg);
                if (t < 64) VWT[32 * 72 + t] = f2bf(wg);
            }
            s_tile(sth * 2);
            if (sth * 2 + 1 <= jt) ML_LOAD_K(pos0, 1);
            s_tile(sth * 2 + 1);
            __syncthreads();
            {
                const float w_inter = __expf(bj + m_old - mj);
                f32x4 nacc[2];
#pragma unroll
                for (int z = 0; z < 2; ++z) {
                    const int et = z == 0 ? sth : 2;
                    f32x4 a = (f32x4){0.f, 0.f, 0.f, 0.f};
#pragma unroll
                    for (int kk = 0; kk < 8; ++kk) a = mfma16(ld_frag_s(CT + (et * 16 + fr) * 264 + kk * 32 + fq * 8), qf[kk], a);
                    nacc[z] = a * w_inter;
                }
                if (ch + 1 < 68) ML_LOAD_Q(pos0 + 64);
#pragma unroll
                for (int z = 0; z < 2; ++z) {
                    const int et = z == 0 ? sth : 2;
                    f32x4 a = nacc[z];
#pragma unroll
                    for (int k2 = 0; k2 < 2; ++k2) a = mfma16(ld_frag_s(VT + (et * 16 + fr) * 72 + k2 * 32 + fq * 8), ld_frag_s(Ss + jg * 72 + k2 * 32 + fq * 8), a);
                    nacc[z] = a;
                }
                const float den = __shfl(nacc[1][0], fr, 64);
                const float dd = fmaxf(fabsf(den), __expf(-mj));
                const float inv = 1.f / dd;
                u32x2 pk = {pk_bf16(nacc[0][0] * inv, nacc[0][1] * inv), pk_bf16(nacc[0][2] * inv, nacc[0][3] * inv)};
                *reinterpret_cast<u32x2*>(HM + ((size_t)dir * NTOK + (dir ? mlstm_row(b, dir, pos0) - 63 : mlstm_row(b, dir, pos0))) * 1024 + off_h) = pk;
            }
#pragma unroll
            for (int i = 0; i < 2; ++i)
#pragma unroll
                for (int et = 0; et < 3; ++et) {
                    f32x4 a = Cacc[i][et] * decay;
#pragma unroll
                    for (int k2 = 0; k2 < 2; ++k2) a = mfma16(ld_frag_s(KT + ((w * 2 + i) * 16 + fr) * 72 + k2 * 32 + fq * 8), ld_frag_s(VWT + (et * 16 + fr) * 72 + k2 * 32 + fq * 8), a);
                    Cacc[i][et] = a;
                }
            __syncthreads();
#pragma unroll
            for (int i = 0; i < 2; ++i)
#pragma unroll
                for (int et = 0; et < 3; ++et) {
                    const f32x4 a = Cacc[i][et];
                    u32x2 pk = {pk_bf16(a[0], a[1]), pk_bf16(a[2], a[3])};
                    *reinterpret_cast<u32x2*>(CT + (et * 16 + fr) * 264 + (w * 2 + i) * 16 + 4 * fq) = pk;
                }
            m_old = m_new;
        }
#undef ML_LOAD_Q
#undef ML_LOAD_K
#undef ML_LOAD_KTV
    }
}

__device__ void mlstm_out_rows(const Params& p, int row0, int nrows) {
    const int lane = tid_() & 63, w = tid_() >> 6;
    const u16* P = (const u16*)(p.ws + WS_P);
    const u16* HM = (const u16*)(p.ws + WS_HM);
    u16* YIN = (u16*)(p.ws + WS_YIN);
    for (int r = w; r < nrows; r += 8) {
        const int row = row0 + r;
        const int c0 = lane * 16;
        float v[16]; float ss = 0.f;
#pragma unroll
        for (int h2 = 0; h2 < 2; ++h2) {
            const u32x4 a = *reinterpret_cast<const u32x4*>(HM + (size_t)row * 1024 + c0 + h2 * 8);
            const u32x4 bq = *reinterpret_cast<const u32x4*>(HM + ((size_t)NTOK + row) * 1024 + c0 + h2 * 8);
#pragma unroll
            for (int q = 0; q < 4; ++q) { v[h2 * 8 + 2 * q] = bf_lo(a[q]) + bf_lo(bq[q]); v[h2 * 8 + 2 * q + 1] = bf_hi(a[q]) + bf_hi(bq[q]); }
        }
#pragma unroll
        for (int q = 0; q < 16; ++q) ss += v[q] * v[q];
        ss += __shfl_xor(ss, 1, 64); ss += __shfl_xor(ss, 2, 64); ss += __shfl_xor(ss, 4, 64); ss += __shfl_xor(ss, 8, 64);
        const float rstd = rsqrtf(ss * (1.f / 256.f) + 1e-6f);
        unsigned o[8];
#pragma unroll
        for (int h2 = 0; h2 < 2; ++h2) {
            const u32x4 og = *reinterpret_cast<const u32x4*>(P + (size_t)row * AB_IN + 3072 + c0 + h2 * 8);
#pragma unroll
            for (int q = 0; q < 4; ++q) {
                const int c = c0 + h2 * 8 + 2 * q;
                const float y0 = v[h2 * 8 + 2 * q] * rstd * p.mlstm_norm[c] * sigmoidf_(bf_lo(og[q]));
                const float y1 = v[h2 * 8 + 2 * q + 1] * rstd * p.mlstm_norm[c + 1] * sigmoidf_(bf_hi(og[q]));
                o[h2 * 4 + q] = pk_bf16(y0, y1);
            }
        }
        *reinterpret_cast<u32x4*>(YIN + (size_t)row * D + c0) = (u32x4){o[0], o[1], o[2], o[3]};
        *reinterpret_cast<u32x4*>(YIN + (size_t)row * D + c0 + 8) = (u32x4){o[4], o[5], o[6], o[7]};
    }
}

template <int DH, class KeyFn, class BiasFn>
__device__ __forceinline__ void attn_wave(const u16* qptr, size_t qstride, int nblk, KeyFn keyfn, BiasFn biasfn, float scale,
                                           float m_init, float l_init, u16* vlds, u16* optr, size_t ostride) {
    constexpr int NK = DH / 32, NDT = DH / 16, VS = DH + 8, NV = DH / 16;
    const int lane = tid_() & 63, fr = lane & 15, fq = lane >> 4;
    bf16x8 qf[NK];
#pragma unroll
    for (int kk = 0; kk < NK; ++kk) qf[kk] = ld_frag_g(qptr + (size_t)fr * qstride + kk * 32 + fq * 8);
    f32x4 oacc[NDT];
#pragma unroll
    for (int i = 0; i < NDT; ++i) oacc[i] = (f32x4){0.f, 0.f, 0.f, 0.f};
    float m = m_init, l = l_init;
    bf16x8 kn[2][NK]; u32x4 vn[NV];
    auto load_blk = [&](int ib) {
        const u16* kptr; const u16* vptr; size_t kvs;
        (void)keyfn(ib, kptr, vptr, kvs);
#pragma unroll
        for (int st = 0; st < 2; ++st)
#pragma unroll
            for (int kk = 0; kk < NK; ++kk) kn[st][kk] = ld_frag_g(kptr + (size_t)(st * 16 + fr) * kvs + kk * 32 + fq * 8);
#pragma unroll
        for (int i = 0; i < NV; ++i) { const int cidx = lane + 64 * i, r = cidx / (DH / 8), cc = cidx % (DH / 8); vn[i] = *reinterpret_cast<const u32x4*>(vptr + (size_t)r * kvs + cc * 8); }
    };
    auto next_valid = [&](int ib) { const u16* a; const u16* b2; size_t c; while (ib < nblk && !keyfn(ib, a, b2, c)) ++ib; return ib; };
    int ib = next_valid(0);
    if (ib < nblk) load_blk(ib);
    while (ib < nblk) {
        bf16x8 kc[2][NK]; u32x4 vc[NV];
#pragma unroll
        for (int st = 0; st < 2; ++st)
#pragma unroll
            for (int kk = 0; kk < NK; ++kk) kc[st][kk] = kn[st][kk];
#pragma unroll
        for (int i = 0; i < NV; ++i) vc[i] = vn[i];
        const int ibn = next_valid(ib + 1);
        if (ibn < nblk) load_blk(ibn);
        asm volatile("" ::: "memory");
#pragma unroll
        for (int i = 0; i < NV; ++i) { const int cidx = lane + 64 * i, r = cidx / (DH / 8), cc = cidx % (DH / 8); *reinterpret_cast<u32x4*>(vlds + r * VS + cc * 8) = vc[i]; }
        f32x4 s[2];
#pragma unroll
        for (int st = 0; st < 2; ++st) {
            f32x4 a = (f32x4){0.f, 0.f, 0.f, 0.f};
#pragma unroll
            for (int kk = 0; kk < NK; ++kk) a = mfma16(kc[st][kk], qf[kk], a);
            s[st] = a;
        }
        float x[8]; float mx = -INFINITY;
#pragma unroll
        for (int st = 0; st < 2; ++st)
#pragma unroll
            for (int q = 0; q < 4; ++q) { const float v = s[st][q] * scale + biasfn(ib, fr, st * 16 + 4 * fq + q); x[st * 4 + q] = v; mx = fmaxf(mx, v); }
        mx = fmaxf(mx, __shfl_xor(mx, 16, 64)); mx = fmaxf(mx, __shfl_xor(mx, 32, 64));
        const float m_new = fmaxf(m, mx);
        const float m_safe = (m_new == -INFINITY) ? 0.f : m_new;
        const float alpha = __expf(m - m_safe);
        float ps = 0.f; float pe[8];
#pragma unroll
        for (int q = 0; q < 8; ++q) { pe[q] = __expf(x[q] - m_safe); ps += pe[q]; }
        l = l * alpha + ps; m = m_new;
#pragma unroll
        for (int i = 0; i < NDT; ++i) oacc[i] *= alpha;
        const bf16x8 pf = mk_frag(pk_bf16(pe[0], pe[1]), pk_bf16(pe[2], pe[3]), pk_bf16(pe[4], pe[5]), pk_bf16(pe[6], pe[7]));
        asm volatile("s_waitcnt lgkmcnt(0)" ::: "memory");
#pragma unroll
        for (int dt = 0; dt < NDT; ++dt) {
            const u16* vb = vlds + dt * 16 + fr;
            unsigned e[4];
#pragma unroll
            for (int j2 = 0; j2 < 2; ++j2) {
                const int k0 = (j2 == 0 ? 0 : 16) + 4 * fq;
                e[j2 * 2 + 0] = (unsigned)vb[(k0 + 0) * VS] | ((unsigned)vb[(k0 + 1) * VS] << 16);
                e[j2 * 2 + 1] = (unsigned)vb[(k0 + 2) * VS] | ((unsigned)vb[(k0 + 3) * VS] << 16);
            }
            oacc[dt] = mfma16(mk_frag(e[0], e[1], e[2], e[3]), pf, oacc[dt]);
        }
        asm volatile("" ::: "memory");
        ib = ibn;
    }
    l += __shfl_xor(l, 16, 64); l += __shfl_xor(l, 32, 64);
    const float inv = 1.f / l;
#pragma unroll
    for (int dt = 0; dt < NDT; ++dt) {
        const f32x4 o = oacc[dt] * inv;
        u32x2 pk = {pk_bf16(o[0], o[1]), pk_bf16(o[2], o[3])};
        *reinterpret_cast<u32x2*>(optr + (size_t)fr * ostride + dt * 16 + 4 * fq) = pk;
    }
}

__device__ void phase_l0_stage2(const Params& p, unsigned char* lds) {
    const int w = tid_() >> 6;
    const u16* P = (const u16*)(p.ws + WS_P);
    u16* YIN = (u16*)(p.ws + WS_YIN);
    u16* vlds = (u16*)lds + w * (32 * 136);
    for (int item = bid_(); item < 1088 + 2176; item += gdim_()) {
        if (item < 1024) {
            const int qt = item & 3, r = (item >> 2) & 63, b = item >> 8, h = w;
            const int r0 = min(max(r - 4, 0), 56);
            const int cb = qt == 0 ? 0 : (qt == 1 ? 8 : (qt == 2 ? 24 : 32));
            const int qrow = b * SEQ + r * 64 + qt * 16;
            const float* rpb = p.na_rpb + h * 15 * 31;
            auto keyfn = [&](int ib, const u16*& kp, const u16*& vp, size_t& kvs) -> bool {
                int row;
                if (ib < 8) row = b * SEQ + (r0 + ib) * 64 + cb; else row = NLAT + b * LC + (ib - 8) * 32;
                kp = P + (size_t)row * AB_IN + 5136 + h * 128; vp = P + (size_t)row * AB_IN + 6160 + h * 128; kvs = AB_IN; return true; };
            auto biasfn = [&](int ib, int qi, int ki) -> float {
                if (ib >= 8) return 0.f;
                const int c = qt * 16 + qi, kc = cb + ki, c0 = min(max(c - 8, 0), 48);
                if (kc < c0 || kc >= c0 + 16) return -INFINITY;
                return rpb[(r0 + ib - r + 7) * 31 + (kc - c + 15)]; };
            attn_wave<128>(P + (size_t)qrow * AB_IN + 4112 + h * 128, AB_IN, 16, keyfn, biasfn, 0.08838834764831845f, -INFINITY, 0.f, vlds,
                           YIN + (size_t)qrow * D + 1024 + h * 128, D);
        } else if (item < 1088) {
            const int it = item - 1024, qt = it & 15, b = it >> 4, h = w;
            const int qrow = NLAT + b * LC + qt * 16;
            auto keyfn = [&](int ib, const u16*& kp, const u16*& vp, size_t& kvs) -> bool {
                const int row = NLAT + b * LC + ib * 32;
                kp = P + (size_t)row * AB_IN + 5136 + h * 128; vp = P + (size_t)row * AB_IN + 6160 + h * 128; kvs = AB_IN; return true; };
            auto biasfn = [&](int, int, int) -> float { return 0.f; };
            attn_wave<128>(P + (size_t)qrow * AB_IN + 4112 + h * 128, AB_IN, 8, keyfn, biasfn, 0.08838834764831845f, -INFINITY, 0.f, vlds,
                           YIN + (size_t)qrow * D + 1024 + h * 128, D);
        } else {
            mlstm_out_rows(p, (item - 1088) * 8, 8);
        }
    }
}

__device__ void rope_rows(const Params& p, int row0, int nrows) {
    const int lane = tid_() & 63, w = tid_() >> 6;
    u16* P = (u16*)(p.ws + WS_P);
    for (int r = w; r < nrows; r += 8) {
        const int row = row0 + r, tt = row & (SEQ - 1);
        const float prow = (float)(tt >> 6), pcol = (float)(tt & 63);
        for (int pi = lane; pi < 640; pi += 64) {
            const int head = pi >> 5, half = (pi >> 4) & 1, j = pi & 15;
            const int base = (head < 16 ? head * 64 : 1024 + (head - 16) * 64) + half * 32 + j;
            const float inv = exp2f(-(float)j * (13.287712379549449f / 16.f));
            const float ang = (half ? pcol : prow) * inv;
            float sn, cs; sincosf(ang, &sn, &cs);
            u16* q1 = P + (size_t)row * CD_IN + base;
            const float x1 = bf2f(q1[0]), x2 = bf2f(q1[16]);
            q1[0] = f2bf(x1 * cs - x2 * sn); q1[16] = f2bf(x2 * cs + x1 * sn);
        }
    }
}

__device__ __forceinline__ int lru_row(int b, int ci, int j) { return ci < 4 ? NLAT + b * LC + ci * 64 + j : b * SEQ + (ci - 4) * 64 + j; }
__device__ void lru_chunk(const Params& p, int b, int blk, int ci, int mode, unsigned char* lds) {
    u16* ub = (u16*)lds;
    constexpr int SR = 132;
    float* sa = (float*)(ub + 64 * 136);
    float* sbt = sa + 64 * SR;
    float* sx = sbt + 64 * SR;
    const int t = tid_(), lane = t & 63, w = t >> 6, fr = lane & 15, fq = lane >> 4;
    const u16* P = (const u16*)(p.ws + WS_P);
    const u16* WT = (const u16*)(p.ws + WS_LRUW);
    float* SA = (float*)(p.ws + WS_LRUS);
    float* SH = SA + 2 * 4 * 68 * 1024;
    const int seglen = ci < 4 ? LC : SEQ, tt0 = ci < 4 ? ci * 64 : (ci - 4) * 64;
    const int rbase = ci < 4 ? NLAT + b * LC : b * SEQ;
    const int sc = t & 127, seg = t >> 7;
    const int chg_s = blk * 128 + sc;
    const int cg = blk * 128 + w * 16 + 4 * fq;
    bf16x8 wfa[2][2][4];
#pragma unroll
    for (int d2 = 0; d2 < 2; ++d2)
#pragma unroll
        for (int g2 = 0; g2 < 2; ++g2)
#pragma unroll
            for (int kk = 0; kk < 4; ++kk) wfa[d2][g2][kk] = ld_frag_g(WT + ((size_t)((d2 * 2 + g2) * 8 + blk) * 128 + w * 16 + fr) * 128 + fq * 8 + kk * 32);
    f32x4 gba[2][2], lama[2];
#pragma unroll
    for (int d2 = 0; d2 < 2; ++d2) {
        lama[d2] = *reinterpret_cast<const f32x4*>(p.lru_lambda + d2 * 1024 + cg);
#pragma unroll
        for (int g2 = 0; g2 < 2; ++g2) gba[d2][g2] = *reinterpret_cast<const f32x4*>(p.lru_gate_b + (d2 * 2 + g2) * 1024 + cg);
    }
    float carry[2] = {0.f, 0.f}; u16 grv[16];
    if (mode == 1) {
#pragma unroll
        for (int d2 = 0; d2 < 2; ++d2) carry[d2] = SH[((size_t)(d2 * 4 + b) * 68 + ci) * 1024 + chg_s];
#pragma unroll
        for (int s = 0; s < 16; ++s) grv[s] = P[(size_t)lru_row(b, ci, seg * 16 + s) * CD_IN + 2560 + chg_s];
    }
    __syncthreads();
    {
        const int c4 = (t & 31) * 4, j0 = (t >> 5) * 4, ch = blk * 128 + c4;
        float xv[7][4];
#pragma unroll
        for (int q = 0; q < 7; ++q) {
            const int tt = tt0 + j0 - 1 + q;
            if (tt >= 0 && tt < seglen) {
                const u32x2 v = *reinterpret_cast<const u32x2*>(P + (size_t)(rbase + tt) * CD_IN + 1536 + ch);
                xv[q][0] = bf_lo(v[0]); xv[q][1] = bf_hi(v[0]); xv[q][2] = bf_lo(v[1]); xv[q][3] = bf_hi(v[1]);
            } else { xv[q][0] = xv[q][1] = xv[q][2] = xv[q][3] = 0.f; }
        }
        f32x4 cw[4];
#pragma unroll
        for (int tp = 0; tp < 4; ++tp) cw[tp] = *reinterpret_cast<const f32x4*>(p.lru_conv_w + tp * 1024 + ch);
        const f32x4 cb = *reinterpret_cast<const f32x4*>(p.lru_conv_b + ch);
#pragma unroll
        for (int q = 0; q < 4; ++q) {
            float u[4];
#pragma unroll
            for (int cc = 0; cc < 4; ++cc) u[cc] = cb[cc] + xv[q][cc] * cw[0][cc] + xv[q + 1][cc] * cw[1][cc] + xv[q + 2][cc] * cw[2][cc] + xv[q + 3][cc] * cw[3][cc];
            u32x2 pk = {pk_bf16(u[0], u[1]), pk_bf16(u[2], u[3])};
            *reinterpret_cast<u32x2*>(ub + (j0 + q) * 136 + c4) = pk;
        }
    }
    __syncthreads();
    float hfw[16];
    for (int dir = 0; dir < 2; ++dir) {
        f32x4 av[4];
        {
            bf16x8 wf[4];
#pragma unroll
            for (int kk = 0; kk < 4; ++kk) wf[kk] = dir ? wfa[1][0][kk] : wfa[0][0][kk];
            const f32x4 gbv = dir ? gba[1][0] : gba[0][0];
            const f32x4 lamv = dir ? lama[1] : lama[0];
            float sp8[4];
#pragma unroll
            for (int q = 0; q < 4; ++q) { const float nl = -lamv[q]; sp8[q] = -8.f * (fmaxf(nl, 0.f) + __logf(1.f + __expf(-fabsf(nl)))); }
#pragma unroll
            for (int tt = 0; tt < 4; ++tt) {
                f32x4 z = (f32x4){0.f, 0.f, 0.f, 0.f};
#pragma unroll
                for (int kk = 0; kk < 4; ++kk) z = mfma16(wf[kk], ld_frag_s(ub + (tt * 16 + fr) * 136 + kk * 32 + fq * 8), z);
#pragma unroll
                for (int q = 0; q < 4; ++q) av[tt][q] = __expf(sigmoidf_(z[q] + gbv[q]) * sp8[q]);
            }
        }
        __syncthreads();
        {
            bf16x8 wf[4];
#pragma unroll
            for (int kk = 0; kk < 4; ++kk) wf[kk] = dir ? wfa[1][1][kk] : wfa[0][1][kk];
            const f32x4 gbv = dir ? gba[1][1] : gba[0][1];
#pragma unroll
            for (int tt = 0; tt < 4; ++tt) {
                f32x4 z = (f32x4){0.f, 0.f, 0.f, 0.f};
#pragma unroll
                for (int kk = 0; kk < 4; ++kk) z = mfma16(wf[kk], ld_frag_s(ub + (tt * 16 + fr) * 136 + kk * 32 + fq * 8), z);
                const int tj = tt * 16 + fr;
                const u32x2 uv = *reinterpret_cast<const u32x2*>(ub + tj * 136 + w * 16 + 4 * fq);
                const float u4[4] = {bf_lo(uv[0]), bf_hi(uv[0]), bf_lo(uv[1]), bf_hi(uv[1])};
                f32x4 bv;
#pragma unroll
                for (int q = 0; q < 4; ++q) { const float a = av[tt][q]; bv[q] = sqrtf(fmaxf(1.f - a * a, 0.f)) * sigmoidf_(z[q] + gbv[q]) * u4[q]; }
                *reinterpret_cast<f32x4*>(sa + tj * SR + w * 16 + 4 * fq) = av[tt];
                *reinterpret_cast<f32x4*>(sbt + tj * SR + w * 16 + 4 * fq) = bv;
            }
        }
        __syncthreads();
        float A = 1.f, h = 0.f;
#pragma unroll
        for (int s = 0; s < 16; ++s) { const int j = seg * 16 + (dir ? 15 - s : s); const float a = sa[j * SR + sc]; h = a * h + sbt[j * SR + sc]; A *= a; }
        sx[(seg * 2 + 0) * 128 + sc] = A; sx[(seg * 2 + 1) * 128 + sc] = h;
        __syncthreads();
        const size_t sidx = ((size_t)(dir * 4 + b) * 68 + ci) * 1024 + chg_s;
        if (mode == 0) {
            if (seg == 0) {
                float At = 1.f, ht = 0.f;
#pragma unroll
                for (int s = 0; s < 4; ++s) { const int sg = dir ? 3 - s : s; const float a = sx[(sg * 2) * 128 + sc]; ht = a * ht + sx[(sg * 2 + 1) * 128 + sc]; At *= a; }
                SA[sidx] = At; SH[sidx] = ht;
            }
        } else {
            float hs = dir ? carry[1] : carry[0];
            const int nprev = dir ? 3 - seg : seg;
#pragma unroll
            for (int s = 0; s < 3; ++s) if (s < nprev) { const int sg = dir ? 3 - s : s; hs = sx[(sg * 2) * 128 + sc] * hs + sx[(sg * 2 + 1) * 128 + sc]; }
            u16* YIN = (u16*)(p.ws + WS_YIN);
            if (dir == 0) {
#pragma unroll
                for (int s = 0; s < 16; ++s) { const int j = seg * 16 + s; hs = sa[j * SR + sc] * hs + sbt[j * SR + sc]; hfw[s] = hs; }
            } else {
#pragma unroll
                for (int s = 0; s < 16; ++s) {
                    const int js = 15 - s, j = seg * 16 + js;
                    hs = sa[j * SR + sc] * hs + sbt[j * SR + sc];
                    const int row = lru_row(b, ci, j);
                    const float gr = bf2f(grv[js]);
                    const float th = 1.f - 2.f * frcp_(1.f + __expf(1.5957691216057308f * (gr + 0.044715f * gr * gr * gr)));
                    const float ge = 0.5f * gr * (1.f + th);
                    YIN[(size_t)row * D + 1024 + chg_s] = f2bf((hfw[js] + hs) * ge);
                }
            }
        }
    }
}

__device__ void lru_prep_weights(const Params& p) {
    const int t = tid_();
    u16* WT = (u16*)(p.ws + WS_LRUW);
    for (int m = bid_(); m < 32; m += gdim_()) {
        const float* Wg = p.lru_gate_w + (size_t)m * 128 * 128;
        const int j4 = (t & 31) * 4, i8 = (t >> 5) * 8;
        f32x4 r8[8];
#pragma unroll
        for (int q = 0; q < 8; ++q) r8[q] = *reinterpret_cast<const f32x4*>(Wg + (size_t)(i8 + q) * 128 + j4);
#pragma unroll
        for (int jj = 0; jj < 4; ++jj) {
            u32x4 v = {pk_bf16(r8[0][jj], r8[1][jj]), pk_bf16(r8[2][jj], r8[3][jj]), pk_bf16(r8[4][jj], r8[5][jj]), pk_bf16(r8[6][jj], r8[7][jj])};
            *reinterpret_cast<u32x4*>(WT + ((size_t)m * 128 + j4 + jj) * 128 + i8) = v;
        }
    }
}
__device__ void lru_carry(const Params& p, int item) {
    const int idx = item * NT + tid_();
    const int c = idx & 1023, b = (idx >> 10) & 3, dir = idx >> 12;
    float* SA = (float*)(p.ws + WS_LRUS);
    float* SH = SA + 2 * 4 * 68 * 1024;
    const size_t base = ((size_t)(dir * 4 + b) * 68) * 1024 + c;
    float h = 0.f;
#pragma unroll 4
    for (int s = 0; s < 68; ++s) {
        const int cj = dir == 0 ? s : (s < 4 ? 3 - s : 71 - s);
        const float a = SA[base + (size_t)cj * 1024], hl = SH[base + (size_t)cj * 1024];
        SH[base + (size_t)cj * 1024] = h;
        h = a * h + hl;
    }
}

__device__ void gqa_item(const Params& p, int it, unsigned char* lds) {
    const int w = tid_() >> 6;
    const u16* P = (const u16*)(p.ws + WS_P);
    u16* YIN = (u16*)(p.ws + WS_YIN);
    const int hq = (it & 1) * 8 + w, t16 = (it >> 1) & 255, b = it >> 9;
    const int kvh = hq >> 2, t0 = t16 * 16;
    const int ks = (t0 - 128) & ~31;
    const int qrow = b * SEQ + t0;
    u16* vlds = (u16*)lds + w * (32 * 72);
    auto keyfn = [&](int ib, const u16*& kp, const u16*& vp, size_t& kvs) -> bool {
        int row;
        if (ib < 9) { const int k0 = ks + ib * 32; if (k0 < 0 || k0 >= SEQ) return false; row = b * SEQ + k0; }
        else row = NLAT + b * LC + (ib - 9) * 32;
        kp = P + (size_t)row * CD_IN + 1024 + kvh * 64; vp = P + (size_t)row * CD_IN + 1280 + kvh * 64; kvs = CD_IN; return true; };
    auto biasfn = [&](int ib, int qi, int ki) -> float {
        if (ib >= 9) return 0.f;
        const int dq = (t0 + qi) - (ks + ib * 32 + ki);
        return (dq > 128 || dq < -128) ? -INFINITY : 0.f; };
    const float sink = p.gqa_sink[hq];
    attn_wave<64>(P + (size_t)qrow * CD_IN + hq * 64, CD_IN, 17, keyfn, biasfn, 0.125f, sink, ((tid_() & 63) >> 4) == 0 ? 1.f : 0.f, vlds,
                  YIN + (size_t)qrow * D + hq * 64, D);
}

__device__ void phase_l1_stage1(const Params& p, unsigned char* lds) {
    for (int item = bid_(); item < 2176 + 2048; item += gdim_()) {
        if (item < 2176) { const int ci = item % 68, blk = (item / 68) & 7, b = item / (68 * 8); lru_chunk(p, b, blk, ci, 0, lds); }
        else rope_rows(p, (item - 2176) * 8, 8);
    }
}
__device__ void phase_l1_stage2(const Params& p, unsigned char* lds) {
    for (int item = bid_(); item < 16 + 2048; item += gdim_()) {
        if (item < 16) lru_carry(p, item);
        else gqa_item(p, item - 16, lds);
    }
}
__device__ void phase_l1_stage3(const Params& p, unsigned char* lds) {
    for (int item = bid_(); item < 2048; item += gdim_()) { const int cl = item & 63, blk = (item >> 6) & 7, b = item >> 9; lru_chunk(p, b, blk, cl + 4, 1, lds); }
}

__device__ void phase_rowpass_mid(const Params& p, int l, unsigned char* lds) {
    float* R = (float*)lds;
    const int t = tid_(), lane = t & 63, w = t >> 6;
    const int nrows = l == 0 ? NTOK : NLAT;
    __syncthreads();
    for (int i = t; i < D * NEXP; i += NT) { const int k = i >> 4, e = i & 15; R[e * D + k] = p.moe_router[(size_t)l * D * NEXP + i]; }
    __syncthreads();
    const u16* Y = (const u16*)(p.ws + WS_Y);
    float* XL1 = (float*)(p.ws + WS_XL1);
    u16* H = (u16*)(p.ws + WS_H);
    float* AFF = (float*)(p.ws + WS_AFF);
    for (int row = bid_() * 8 + w; row < nrows; row += gdim_() * 8) {
        f32x4 v[8]; float ss = 0.f;
#pragma unroll
        for (int i = 0; i < 8; ++i) { const u32x2 q = *reinterpret_cast<const u32x2*>(Y + (size_t)row * D + (i * 64 + lane) * 4); v[i] = (f32x4){bf_lo(q[0]), bf_hi(q[0]), bf_lo(q[1]), bf_hi(q[1])}; ss += v[i][0] * v[i][0] + v[i][1] * v[i][1] + v[i][2] * v[i][2] + v[i][3] * v[i][3]; }
        ss = wave_sum(ss);
        const float rstd = rsqrtf(ss * (1.f / D) + 1e-6f);
        const float* xr = xin_row(p, l, row);
        const float* g1 = mod_ptr(p, l, row, 2);
        const float* nw = p.norm_mix_post + (size_t)l * D;
        float ss1 = 0.f;
#pragma unroll
        for (int i = 0; i < 8; ++i) {
            const int col = (i * 64 + lane) * 4;
            const f32x4 x4 = *reinterpret_cast<const f32x4*>(xr + col), w4 = *reinterpret_cast<const f32x4*>(nw + col), g4 = *reinterpret_cast<const f32x4*>(g1 + col);
            const f32x4 x1 = x4 + g4 * (v[i] * rstd * w4);
            *reinterpret_cast<f32x4*>(XL1 + (size_t)row * D + col) = x1;
            v[i] = x1; ss1 += x1[0] * x1[0] + x1[1] * x1[1] + x1[2] * x1[2] + x1[3] * x1[3];
        }
        ss1 = wave_sum(ss1);
        const float rstd1 = rsqrtf(ss1 * (1.f / D) + 1e-6f);
        const float* sh = mod_ptr(p, l, row, 3); const float* sc = mod_ptr(p, l, row, 4);
        const float* nw2 = p.norm_ffn_pre + (size_t)l * D;
#pragma unroll
        for (int i = 0; i < 8; ++i) {
            const int col = (i * 64 + lane) * 4;
            const f32x4 w4 = *reinterpret_cast<const f32x4*>(nw2 + col), s4 = *reinterpret_cast<const f32x4*>(sc + col), h4 = *reinterpret_cast<const f32x4*>(sh + col);
            const f32x4 o = v[i] * rstd1 * w4 * (s4 + 1.f) + h4;
            u32x2 pk = {pk_bf16(o[0], o[1]), pk_bf16(o[2], o[3])};
            *reinterpret_cast<u32x2*>(H + (size_t)row * D + col) = pk;
            v[i] = o;
        }
        float lg[16];
#pragma unroll
        for (int e = 0; e < 16; ++e) lg[e] = 0.f;
#pragma unroll
        for (int i = 0; i < 8; ++i) {
#pragma unroll
            for (int e = 0; e < 16; ++e) { const f32x4 r4 = *reinterpret_cast<const f32x4*>(R + e * D + (i * 64 + lane) * 4); lg[e] += v[i][0] * r4[0] + v[i][1] * r4[1] + v[i][2] * r4[2] + v[i][3] * r4[3]; }
        }
        const bool b5 = lane & 32, b4 = lane & 16, b3 = lane & 8, b2 = lane & 4;
        float t8[8], t4[4], t2[2], lgt;
#pragma unroll
        for (int j = 0; j < 8; ++j) { const float keep = b5 ? lg[8 + j] : lg[j], send = b5 ? lg[j] : lg[8 + j]; t8[j] = keep + __shfl_xor(send, 32, 64); }
#pragma unroll
        for (int j = 0; j < 4; ++j) { const float keep = b4 ? t8[4 + j] : t8[j], send = b4 ? t8[j] : t8[4 + j]; t4[j] = keep + __shfl_xor(send, 16, 64); }
#pragma unroll
        for (int j = 0; j < 2; ++j) { const float keep = b3 ? t4[2 + j] : t4[j], send = b3 ? t4[j] : t4[2 + j]; t2[j] = keep + dpp_f<0x140>(send); }
        { const float keep = b2 ? t2[1] : t2[0], send = b2 ? t2[0] : t2[1]; lgt = keep + dpp_f<0x141>(send); }
        lgt += dpp_f<0x4E>(lgt); lgt += dpp_f<0xB1>(lgt);
        const float mx = wave_max(lgt);
        const float pe = __expf(lgt - mx);
        const float den = wave_sum(pe) * 0.25f;
        if ((lane & 3) == 0) AFF[(size_t)row * 16 + ((b5 ? 8 : 0) + (b4 ? 4 : 0) + (b3 ? 2 : 0) + (b2 ? 1 : 0))] = pe / den;
    }
}

__device__ void phase_topk(const Params& p, int l, unsigned char* lds) {
    unsigned* keys = (unsigned*)lds;
    unsigned* hist = keys + 4096;
    unsigned* misc = hist + 256;
    const int t = tid_(), lane = t & 63, w = t >> 6;
    const float* AFF = (const float*)(p.ws + WS_AFF);
    int* SLOT = (int*)(p.ws + WS_SLOT);
    int* EROW = (int*)(p.ws + WS_EROW);
    float* EGATE = (float*)(p.ws + WS_EGATE);
    const int nitems = l == 0 ? 128 : 64;
    for (int item = bid_(); item < nitems; item += gdim_()) {
        const int kind = item >> 6, b = (item >> 4) & 3, ex = item & 15;
        const int n = kind ? LC : SEQ, cap = n / 8, rowbase = kind ? NLAT + b * LC : b * SEQ;
        __syncthreads();
        for (int i = t; i < n; i += NT) keys[i] = __float_as_uint(AFF[(size_t)(rowbase + i) * 16 + ex]);
        unsigned prefix = 0u, mask = 0u; int kth = cap;
        for (int shift = 24; shift >= 0; shift -= 8) {
            __syncthreads();
            if (t < 256) hist[t] = 0u;
            __syncthreads();
            for (int i = t; i < n; i += NT) { const unsigned k = keys[i]; if ((k & mask) == prefix) atomicAdd(&hist[(k >> shift) & 255u], 1u); }
            __syncthreads();
            if (t < 256) {
                unsigned above = 0u;
                for (int d2 = t + 1; d2 < 256; ++d2) above += hist[d2];
                const unsigned here = hist[t];
                if ((int)above < kth && (int)(above + here) >= kth) { misc[0] = (unsigned)t; misc[1] = (unsigned)(kth - (int)above); }
            }
            __syncthreads();
            prefix |= misc[0] << shift; mask |= 255u << shift; kth = (int)misc[1];
        }
        const unsigned T = prefix; const int need_eq = kth;
        int cgt = 0, ceq = 0;
        const int base = t * 8;
        if (base < n) {
#pragma unroll
            for (int q = 0; q < 8; ++q) { const unsigned k = keys[base + q]; cgt += (k > T); ceq += (k == T); }
        }
        int packed = cgt | (ceq << 16);
        int incl = packed;
#pragma unroll
        for (int o = 1; o < 64; o <<= 1) { const int nb = __shfl_up(incl, o, 64); if (lane >= o) incl += nb; }
        __syncthreads();
        if (lane == 63) misc[8 + w] = (unsigned)incl;
        __syncthreads();
        int woff = 0, total = 0;
#pragma unroll
        for (int q = 0; q < 8; ++q) { const int v = (int)misc[8 + q]; if (q < w) woff += v; total += v; }
        const int excl = woff + incl - packed;
        int pgt = excl & 0xffff, peq = excl >> 16;
        const int tot_gt = total & 0xffff;
        const int sbase = kind ? 2048 + b * 32 : b * 512;
        if (base < n) {
#pragma unroll
            for (int q = 0; q < 8; ++q) {
                const unsigned k = keys[base + q];
                const int row = rowbase + base + q;
                int pos = -1;
                if (k > T) { pos = pgt; ++pgt; }
                else if (k == T) { if (peq < need_eq) pos = tot_gt + peq; ++peq; }
                if (pos >= 0) { const int sl = sbase + pos; EROW[ex * EPAD + sl] = row; EGATE[ex * EPAD + sl] = __uint_as_float(k); SLOT[(size_t)row * 16 + ex] = sl; }
                else SLOT[(size_t)row * 16 + ex] = -1;
            }
        }
    }
}

__device__ void phase_final(const Params& p, int l) {
    const int lane = tid_() & 63, w = tid_() >> 6;
    const int nrows = l == 0 ? NTOK : NLAT;
    const u16* YEXP = (const u16*)(p.ws + WS_YEXP);
    const int* SLOT = (const int*)(p.ws + WS_SLOT);
    const float* XL1 = (const float*)(p.ws + WS_XL1);
    float* XL2 = (float*)(p.ws + WS_XL2);
    u16* H = (u16*)(p.ws + WS_H);
    for (int row = bid_() * 8 + w; row < nrows; row += gdim_() * 8) {
        const int myslot = lane < 16 ? SLOT[(size_t)row * 16 + lane] : -1;
        f32x4 xl[8];
#pragma unroll
        for (int i = 0; i < 8; ++i) xl[i] = *reinterpret_cast<const f32x4*>(XL1 + (size_t)row * D + (i * 64 + lane) * 4);
        f32x4 v[8];
#pragma unroll
        for (int i = 0; i < 8; ++i) v[i] = (f32x4){0.f, 0.f, 0.f, 0.f};
        unsigned long long em = __ballot(myslot >= 0);
        while (em) {
            const int e0 = __builtin_ctzll(em); em &= em - 1;
            const bool two = em != 0;
            const int e1 = two ? __builtin_ctzll(em) : e0; if (two) em &= em - 1;
            const int sl0 = __shfl(myslot, e0, 64), sl1 = __shfl(myslot, e1, 64);
            const u16* y0 = YEXP + ((size_t)e0 * EPAD + sl0) * D; const u16* y1 = YEXP + ((size_t)e1 * EPAD + sl1) * D;
            u32x2 q0[8], q1[8];
#pragma unroll
            for (int i = 0; i < 8; ++i) { q0[i] = *reinterpret_cast<const u32x2*>(y0 + (i * 64 + lane) * 4); q1[i] = *reinterpret_cast<const u32x2*>(y1 + (i * 64 + lane) * 4); }
            const float f1 = two ? 1.f : 0.f;
#pragma unroll
            for (int i = 0; i < 8; ++i) {
                v[i][0] += bf_lo(q0[i][0]) + f1 * bf_lo(q1[i][0]); v[i][1] += bf_hi(q0[i][0]) + f1 * bf_hi(q1[i][0]);
                v[i][2] += bf_lo(q0[i][1]) + f1 * bf_lo(q1[i][1]); v[i][3] += bf_hi(q0[i][1]) + f1 * bf_hi(q1[i][1]);
            }
        }
        float ss = 0.f;
#pragma unroll
        for (int i = 0; i < 8; ++i) ss += v[i][0] * v[i][0] + v[i][1] * v[i][1] + v[i][2] * v[i][2] + v[i][3] * v[i][3];
        ss = wave_sum(ss);
        const float rstd = rsqrtf(ss * (1.f / D) + 1e-6f);
        const float* g2 = mod_ptr(p, l, row, 5);
        const float* nw = p.norm_ffn_post + (size_t)l * D;
        float* dst = l == 0 ? XL2 + (size_t)row * D : p.out + (size_t)row * D;
        float ss2 = 0.f;
#pragma unroll
        for (int i = 0; i < 8; ++i) {
            const int col = (i * 64 + lane) * 4;
            const f32x4 x4 = xl[i], w4 = *reinterpret_cast<const f32x4*>(nw + col), g4 = *reinterpret_cast<const f32x4*>(g2 + col);
            const f32x4 x2 = x4 + g4 * (v[i] * rstd * w4);
            *reinterpret_cast<f32x4*>(dst + col) = x2;
            v[i] = x2; ss2 += x2[0] * x2[0] + x2[1] * x2[1] + x2[2] * x2[2] + x2[3] * x2[3];
        }
        if (l == 0) {
            ss2 = wave_sum(ss2);
            const float rstd2 = rsqrtf(ss2 * (1.f / D) + 1e-6f);
            const float* sh = mod_ptr(p, 1, row, 0); const float* sc = mod_ptr(p, 1, row, 1);
            const float* nw1 = p.norm_mix_pre + D;
#pragma unroll
            for (int i = 0; i < 8; ++i) {
                const int col = (i * 64 + lane) * 4;
                const f32x4 w4 = *reinterpret_cast<const f32x4*>(nw1 + col), s4 = *reinterpret_cast<const f32x4*>(sc + col), h4 = *reinterpret_cast<const f32x4*>(sh + col);
                const f32x4 o = v[i] * rstd2 * w4 * (s4 + 1.f) + h4;
                u32x2 pk = {pk_bf16(o[0], o[1]), pk_bf16(o[2], o[3])};
                *reinterpret_cast<u32x2*>(H + (size_t)row * D + col) = pk;
            }
        }
    }
}

__global__ void __launch_bounds__(NT, 2) fwd_kernel(Params p) {
    extern __shared__ __attribute__((aligned(16))) unsigned char lds[];
    unsigned char* wlds = lds + 16;
    if (threadIdx.x == 0) *reinterpret_cast<uint4*>(lds) = make_uint4(0u, 0u, 0u, 0u);
    __syncthreads();
    XcdBarrier bar = xcd_barrier_post((unsigned*)(p.ws + WS_BAR), (volatile LAS unsigned*)lds);
#ifndef PH_MASK
#define PH_MASK 0xFFFFFFFFu
#endif
#ifndef PROBE_REP_MASK
#define PROBE_REP_MASK 0u
#endif
#define PHASE(id, body) do { if (((PH_MASK >> ((id) % 32)) & 1u) && p.ph_lo <= (id) && (id) < p.ph_hi) { \
    for (int _r = 0; _r < ((((unsigned)PROBE_REP_MASK >> ((id) % 32)) & 1u) ? 2 : 1); ++_r) { body; if ((id) + 1 < p.ph_hi || _r == 0) { if ((id) + 1 < p.ph_hi) xcd_barrier(bar); } } } } while (0)
    PHASE(0, { phase_mod(p, wlds); phase_convert_dense(p, wlds); });
    PHASE(1, { phase_norm_mod(p, 0); lru_prep_weights(p); });
#pragma unroll
    for (int l = 0; l < 2; ++l) {
        const int pb = 2 + 10 * l;
        {
            EpiDesc e; e.ob = (u16*)(p.ws + WS_P); e.of = nullptr; e.ldo = l == 0 ? AB_IN : CD_IN; e.gates = l == 0 ? (float*)(p.ws + WS_G) : nullptr; e.rscale = nullptr;
            PHASE(pb + 0, phase_gemm_dense<EPI_BF16>(p, (const u16*)(p.ws + WS_H), NTOK, (const u16*)(p.ws + (l == 0 ? WS_WT_ABIN : WS_WT_CDIN)), l == 0 ? AB_IN : CD_IN, e, wlds));
        }
        if (l == 0) {
            PHASE(pb + 1, phase_mlstm(p, wlds));
            PHASE(pb + 2, phase_l0_stage2(p, wlds));
        } else {
            PHASE(pb + 1, phase_l1_stage1(p, wlds));
            PHASE(pb + 2, phase_l1_stage2(p, wlds));
            PHASE(pb + 3, phase_l1_stage3(p, wlds));
        }
        {
            EpiDesc e; e.ob = (u16*)(p.ws + WS_Y); e.of = nullptr; e.ldo = D; e.gates = nullptr; e.rscale = nullptr;
            PHASE(pb + 4, phase_gemm_dense<EPI_BF16>(p, (const u16*)(p.ws + WS_YIN), l == 0 ? NTOK : NLAT, (const u16*)(p.ws + (l == 0 ? WS_WT_ABOUT : WS_WT_CDOUT)), D, e, wlds));
        }
        PHASE(pb + 5, phase_rowpass_mid(p, l, wlds));
        PHASE(pb + 6, { phase_topk(p, l, wlds); phase_convert_moe(p, l, wlds); });
        PHASE(pb + 7, phase_moe_a(p, l, wlds));
        PHASE(pb + 8, phase_moe_b(p, l, wlds));
        PHASE(pb + 9, phase_final(p, l));
    }
}


#ifdef DBG_STOP
__global__ void dbg_digest(const unsigned char* ws, size_t off, int kind, size_t nelem, float* out, size_t nout) {
    for (size_t i = (size_t)blockIdx.x * blockDim.x + threadIdx.x; i < nout; i += (size_t)gridDim.x * blockDim.x) {
        float v = 0.f;
        for (size_t j = i; j < nelem; j += nout) {
            if (kind == 0) v += bf2f(((const u16*)(ws + off))[j]);
            else if (kind == 1) v += ((const float*)(ws + off))[j];
            else v += (float)((const int*)(ws + off))[j];
        }
        out[i] = v;
    }
}
#endif
extern "C" void kernel_launch(void* const* d_in, const int* in_sizes, int n_in, void* d_out, int out_size, void* d_ws, size_t ws_size, hipStream_t stream) {
    static int grid = 0;
    if (grid == 0) {
        if (n_in != 27 || ws_size < WS_END) { fprintf(stderr, "kernel_launch: unexpected n_in %d / ws %zu (need %zu)\n", n_in, ws_size, (size_t)WS_END); grid = -1; return; }
        int dev = 0, cus = 0, per_cu = 0;
        hipGetDevice(&dev);
        hipDeviceGetAttribute(&cus, hipDeviceAttributeMultiprocessorCount, dev);
        if (hipFuncSetAttribute((const void*)fwd_kernel, hipFuncAttributeMaxDynamicSharedMemorySize, LDS_BYTES) != hipSuccess) { fprintf(stderr, "kernel_launch: hipFuncSetAttribute failed\n"); grid = -1; return; }
        hipOccupancyMaxActiveBlocksPerMultiprocessor(&per_cu, (const void*)fwd_kernel, NT, LDS_BYTES);
        (void)hipGetLastError();
        if (per_cu < 1) fprintf(stderr, "kernel_launch: occupancy query reports %d blocks per CU\n", per_cu);
        grid = cus > 0 ? cus : 256;
    }
    if (grid < 0) return;
    hipMemsetAsync((char*)d_ws + WS_BAR, 0, XCD_BAR_WORDS * sizeof(unsigned), stream);
    Params p; memset(&p, 0, sizeof(p));
    const float** f = (const float**)&p;
    for (int i = 0; i < 27; ++i) f[i] = (const float*)d_in[i];
    p.out = (float*)d_out; p.ws = (unsigned char*)d_ws;
#if N_LAUNCH_MODE == 1
    p.ph_lo = 0; p.ph_hi = NPH;
    hipLaunchKernelGGL(fwd_kernel, dim3(grid), dim3(NT), LDS_BYTES, stream, p);
#else
#ifdef DBG_STOP
    for (int ph = 0; ph <= DBG_STOP; ++ph) { p.ph_lo = ph; p.ph_hi = ph + 1; hipLaunchKernelGGL(fwd_kernel, dim3(grid), dim3(NT), LDS_BYTES, stream, p); }
    hipLaunchKernelGGL(dbg_digest, dim3(2048), dim3(256), 0, stream, (const unsigned char*)d_ws, (size_t)DBG_OFF, (int)DBG_KIND, (size_t)DBG_NELEM, (float*)d_out, (size_t)out_size);
#else
    for (int ph = 0; ph < NPH; ++ph) { p.ph_lo = ph; p.ph_hi = ph + 1; hipLaunchKernelGGL(fwd_kernel, dim3(grid), dim3(NT), LDS_BYTES, stream, p); }
#endif
#endif
}
```

```cpp
#include <hip/hip_runtime.h>
#include <stdint.h>
#include <stdio.h>
#include <string.h>

#ifndef N_LAUNCH_MODE
#define N_LAUNCH_MODE 1
#endif

typedef unsigned short u16;
typedef short bf16x8 __attribute__((ext_vector_type(8)));
typedef float f32x4 __attribute__((ext_vector_type(4)));
typedef unsigned u32x4 __attribute__((ext_vector_type(4)));
typedef unsigned u32x2 __attribute__((ext_vector_type(2)));

#define NT 512
constexpr int D = 2048, BATCH = 4, SEQ = 4096, LC = 256;
constexpr int NLAT = BATCH * SEQ, NCTX = BATCH * LC, NTOK = NLAT + NCTX;
constexpr int AB_IN = 7184, CD_IN = 3584;
constexpr int NEXP = 16, FF = 2048, EPAD = 2304;
constexpr int NPH = 22;
constexpr int LDS_BYTES = 150 * 1024;

constexpr size_t al256(size_t x) { return (x + 255) & ~(size_t)255; }
constexpr size_t WS_BAR = 0;
constexpr size_t WS_MOD = 16384;
constexpr size_t WS_XL1 = al256(WS_MOD + 2 * 5 * 12288 * 4);
constexpr size_t WS_XL2 = al256(WS_XL1 + (size_t)NTOK * D * 4);
constexpr size_t WS_H = al256(WS_XL2 + (size_t)NTOK * D * 4);
constexpr size_t WS_P = al256(WS_H + (size_t)NTOK * D * 2);
constexpr size_t WS_G = al256(WS_P + (size_t)NTOK * AB_IN * 2);
constexpr size_t WS_HM = al256(WS_G + (size_t)NTOK * 16 * 4);
constexpr size_t WS_YIN = al256(WS_HM + (size_t)2 * NTOK * 1024 * 2);
constexpr size_t WS_Y = al256(WS_YIN + (size_t)NTOK * D * 2);
constexpr size_t WS_AFF = al256(WS_Y + (size_t)NTOK * D * 4);
constexpr size_t WS_SLOT = al256(WS_AFF + (size_t)NTOK * 16 * 4);
constexpr size_t WS_EROW = al256(WS_SLOT + (size_t)NTOK * 16 * 4);
constexpr size_t WS_EGATE = al256(WS_EROW + (size_t)NEXP * EPAD * 4);
constexpr size_t WS_ACT = al256(WS_EGATE + (size_t)NEXP * EPAD * 4);
constexpr size_t WS_YEXP = al256(WS_ACT + (size_t)NEXP * EPAD * FF * 2);
constexpr size_t WS_LRUS = al256(WS_YEXP + (size_t)NEXP * EPAD * D * 2);
constexpr size_t WS_LRUW = al256(WS_LRUS + (size_t)2 * 2 * 4 * 68 * 1024 * 4);
constexpr size_t WS_WT_ABIN = al256(WS_LRUW + (size_t)32 * 128 * 128 * 2);
constexpr size_t WS_WT_ABOUT = al256(WS_WT_ABIN + (size_t)AB_IN * D * 2);
constexpr size_t WS_WT_CDIN = al256(WS_WT_ABOUT + (size_t)D * D * 2);
constexpr size_t WS_WT_CDOUT = al256(WS_WT_CDIN + (size_t)CD_IN * D * 2);
constexpr size_t WS_WT_W1 = al256(WS_WT_CDOUT + (size_t)D * D * 2);
constexpr size_t WS_WT_W3 = al256(WS_WT_W1 + (size_t)NEXP * D * FF * 2);
constexpr size_t WS_WT_W2 = al256(WS_WT_W3 + (size_t)NEXP * D * FF * 2);
constexpr size_t WS_END = al256(WS_WT_W2 + (size_t)NEXP * D * FF * 2);

struct Params {
    const float *x, *c, *ctx, *c_ctx, *ada_w, *ada_b, *norm_mix_pre, *norm_mix_post, *norm_ffn_pre, *norm_ffn_post;
    const float *ab_w_in, *ab_w_out, *mlstm_gate_b, *mlstm_norm, *na_rpb;
    const float *cd_w_in, *cd_w_out, *gqa_sink, *lru_conv_w, *lru_conv_b, *lru_gate_w, *lru_gate_b, *lru_lambda;
    const float *moe_router, *moe_w1, *moe_w3, *moe_w2;
    float* out;
    unsigned char* ws;
    int ph_lo, ph_hi;
};

#define XB_TMO      128
#define XB_XCNT(j)  (256  + 64 * (j))
#define XB_XSUB(j)  (1280 + 64 * (j))
#define XB_XGEN(j)  (2304 + 64 * (j))
#define XB_TOP      3328
#define XB_TOPGEN   3392
#define XCD_BAR_WORDS 3456
#define XB_SPIN_CAP (1u << 22)
#define LAS __attribute__((address_space(3)))

__device__ __forceinline__ unsigned xb_ld(unsigned* p)              { return __hip_atomic_load(p, __ATOMIC_RELAXED, __HIP_MEMORY_SCOPE_AGENT); }
__device__ __forceinline__ unsigned xb_add(unsigned* p, unsigned v) { return __hip_atomic_fetch_add(p, v, __ATOMIC_RELAXED, __HIP_MEMORY_SCOPE_AGENT); }
__device__ __forceinline__ unsigned xb_xcc_id() { return (unsigned)__builtin_amdgcn_s_getreg((3 << 11) | 20) & 0xFu; }
#define XB_SPIN(cond, bar) do { unsigned _sp = 0; while (cond) { __builtin_amdgcn_s_sleep(1); \
    if ((++_sp & 255u) == 0u) { if (xb_ld(&(bar)[XB_TMO])) break; if (_sp > XB_SPIN_CAP) { atomicAdd(&(bar)[XB_TMO], 1u); break; } } } } while (0)

struct XcdBarrier {
    unsigned* bar; unsigned x;
    volatile LAS unsigned* st;
};
__device__ __forceinline__ XcdBarrier xcd_barrier_post(unsigned* bar, volatile LAS unsigned* st) {
    XcdBarrier b; b.bar = bar; b.x = xb_xcc_id(); b.st = st;
    if (threadIdx.x == 0) (void)xb_add(&bar[XB_XCNT(b.x)], 1u);
    return b;
}
__device__ __forceinline__ void xcd_barrier_complete(unsigned* bar, unsigned x, unsigned& nloc, unsigned& nx) {
    const unsigned G = gridDim.x * gridDim.y * gridDim.z;
    unsigned sum, cnt, mine, sp = 0u;
    for (;;) {
        sum = 0u; cnt = 0u; mine = 0u;
#pragma unroll
        for (unsigned j = 0; j < 16; ++j) { const unsigned c = xb_ld(&bar[XB_XCNT(j)]); sum += c; cnt += (c > 0u) ? 1u : 0u; mine = (j == x) ? c : mine; }
        if (sum == G) break;
        __builtin_amdgcn_s_sleep(1);
        if ((++sp & 255u) == 0u) { if (xb_ld(&bar[XB_TMO])) break; if (sp > XB_SPIN_CAP) { atomicAdd(&bar[XB_TMO], 1u); break; } }
    }
    nloc = mine > 0u ? mine : 1u; nx = cnt > 0u ? cnt : 1u;
}
__device__ __forceinline__ void xcd_barrier(const XcdBarrier& b) {
    asm volatile("s_waitcnt vmcnt(0)" ::: "memory");
    __syncthreads();
    if (threadIdx.x == 0) {
        unsigned* bar = b.bar;
        __builtin_amdgcn_s_waitcnt(0);
        unsigned nloc = b.st[0], nx = b.st[1];
        if (nloc == 0u) { xcd_barrier_complete(bar, b.x, nloc, nx); b.st[0] = nloc; b.st[1] = nx; }
        const unsigned old = xb_add(&bar[XB_XSUB(b.x)], 1u);
        const unsigned gen = old / nloc;
        if (old + 1u == (gen + 1u) * nloc) {
            __builtin_amdgcn_fence(__ATOMIC_RELEASE, "agent");
            asm volatile("s_waitcnt vmcnt(0)" ::: "memory");
            const unsigned og = xb_add(&bar[XB_TOP], 1u);
            const unsigned tg = og / nx;
            if (og + 1u == (tg + 1u) * nx) xb_add(&bar[XB_TOPGEN], 1u);
            else XB_SPIN(xb_ld(&bar[XB_TOPGEN]) == tg, bar);
            __builtin_amdgcn_fence(__ATOMIC_ACQUIRE, "agent");
            xb_add(&bar[XB_XGEN(b.x)], 1u);
            asm volatile("s_waitcnt vmcnt(0)" ::: "memory");
        } else {
            XB_SPIN(xb_ld(&bar[XB_XGEN(b.x)]) == gen, bar);
            __builtin_amdgcn_fence(__ATOMIC_ACQUIRE, "agent");
            asm volatile("s_waitcnt vmcnt(0)" ::: "memory");
        }
    }
    __syncthreads();
}

typedef float f32x2_t __attribute__((ext_vector_type(2)));
typedef __bf16 bf16x2_t __attribute__((ext_vector_type(2)));
__device__ __forceinline__ unsigned pk_bf16(float lo, float hi) { f32x2_t v = {lo, hi}; return __builtin_bit_cast(unsigned, __builtin_convertvector(v, bf16x2_t)); }
__device__ __forceinline__ float bf_lo(unsigned u) { return __uint_as_float(u << 16); }
__device__ __forceinline__ float bf_hi(unsigned u) { return __uint_as_float(u & 0xffff0000u); }
__device__ __forceinline__ float bf2f(u16 v) { return __uint_as_float(((unsigned)v) << 16); }
__device__ __forceinline__ u16 f2bf(float f) { return (u16)(pk_bf16(f, 0.f) & 0xffffu); }
template <int CTRL> __device__ __forceinline__ float dpp_f(float v) { return __uint_as_float((unsigned)__builtin_amdgcn_update_dpp(0, (int)__float_as_uint(v), CTRL, 0xf, 0xf, true)); }
__device__ __forceinline__ float row_sum16(float v) { v += dpp_f<0xB1>(v); v += dpp_f<0x4E>(v); v += dpp_f<0x141>(v); v += dpp_f<0x140>(v); return v; }
__device__ __forceinline__ float row_max16(float v) { v = fmaxf(v, dpp_f<0xB1>(v)); v = fmaxf(v, dpp_f<0x4E>(v)); v = fmaxf(v, dpp_f<0x141>(v)); v = fmaxf(v, dpp_f<0x140>(v)); return v; }
__device__ __forceinline__ float rdlane_f(float v, int l) { return __uint_as_float((unsigned)__builtin_amdgcn_readlane((int)__float_as_uint(v), l)); }
__device__ __forceinline__ float wave_sum(float v) { v = row_sum16(v); return (rdlane_f(v, 0) + rdlane_f(v, 16)) + (rdlane_f(v, 32) + rdlane_f(v, 48)); }
__device__ __forceinline__ float wave_max(float v) { v = row_max16(v); return fmaxf(fmaxf(rdlane_f(v, 0), rdlane_f(v, 16)), fmaxf(rdlane_f(v, 32), rdlane_f(v, 48))); }
__device__ __forceinline__ int tid_() { int t = threadIdx.x; asm volatile("" : "+v"(t)); return t; }
__device__ __forceinline__ int bid_() { int b = blockIdx.x; asm volatile("" : "+s"(b)); return b; }
__device__ __forceinline__ int gdim_() { int b = gridDim.x; asm volatile("" : "+s"(b)); return b; }
__device__ __forceinline__ float frcp_(float x) { return __builtin_amdgcn_rcpf(x); }
__device__ __forceinline__ float sigmoidf_(float x) { return frcp_(1.f + __expf(-x)); }
__device__ __forceinline__ f32x4 mfma16(bf16x8 a, bf16x8 b, f32x4 c) { return __builtin_amdgcn_mfma_f32_16x16x32_bf16(a, b, c, 0, 0, 0); }
__device__ __forceinline__ bf16x8 ld_frag_g(const u16* p) { return *reinterpret_cast<const bf16x8*>(p); }
__device__ __forceinline__ bf16x8 ld_frag_s(const u16* p) { return *reinterpret_cast<const bf16x8*>(p); }
__device__ __forceinline__ bf16x8 mk_frag(unsigned a, unsigned b, unsigned c, unsigned d) { u32x4 v = {a, b, c, d}; return __builtin_bit_cast(bf16x8, v); }

__device__ __forceinline__ const float* xin_row(const Params& p, int l, int row) {
    if (l == 0) return row < NLAT ? p.x + (size_t)row * D : p.ctx + (size_t)(row - NLAT) * D;
    return (const float*)(p.ws + WS_XL2) + (size_t)row * D;
}
__device__ __forceinline__ const float* mod_ptr(const Params& p, int l, int row, int chunk) {
    const int bb = row < NLAT ? (row >> 12) : 4;
    return (const float*)(p.ws + WS_MOD) + ((size_t)(l * 5 + bb) * 6 + chunk) * D;
}

__device__ void phase_mod(const Params& p, unsigned char* lds_raw) {
    float* scond = (float*)lds_raw;
    float* red = scond + 5 * D;
    const int t = tid_();
    for (int i = t; i < 5 * D; i += NT) { const int r = i >> 11, k = i & 2047; const float v = r < 4 ? p.c[r * D + k] : p.c_ctx[k]; scond[i] = v / (1.f + __expf(-v)); }
    __syncthreads();
    float* mod = (float*)(p.ws + WS_MOD);
    for (int item = bid_(); item < 192; item += gdim_()) {
        const int l = item / 96, col0 = (item % 96) * 128;
        const int kg = t >> 5, cl = (t & 31) * 4;
        f32x4 acc[5];
#pragma unroll
        for (int r = 0; r < 5; ++r) acc[r] = (f32x4){0.f, 0.f, 0.f, 0.f};
        const float* wp = p.ada_w + ((size_t)l * D + kg * 128) * (6 * D) + col0 + cl;
#pragma unroll 8
        for (int kk = 0; kk < 128; ++kk) {
            const f32x4 w = *reinterpret_cast<const f32x4*>(wp + (size_t)kk * (6 * D));
#pragma unroll
            for (int r = 0; r < 5; ++r) { const float s = scond[r * D + kg * 128 + kk]; acc[r] += w * s; }
        }
#pragma unroll
        for (int r = 0; r < 5; ++r) *reinterpret_cast<f32x4*>(red + (kg * 5 + r) * 128 + cl) = acc[r];
        __syncthreads();
        for (int o = t; o < 640; o += NT) {
            const int r = o >> 7, cc = o & 127;
            float s = p.ada_b[l * 6 * D + col0 + cc];
#pragma unroll
            for (int g = 0; g < 16; ++g) s += red[(g * 5 + r) * 128 + cc];
            mod[(size_t)(l * 5 + r) * 6 * D + col0 + cc] = s;
        }
        __syncthreads();
    }
}

__device__ void phase_norm_mod(const Params& p, int l) {
    const int lane = tid_() & 63, w = tid_() >> 6;
    u16* H = (u16*)(p.ws + WS_H);
    for (int row = bid_() * 8 + w; row < NTOK; row += gdim_() * 8) {
        const float* xr = xin_row(p, l, row);
        f32x4 v[8]; float ss = 0.f;
#pragma unroll
        for (int i = 0; i < 8; ++i) { v[i] = *reinterpret_cast<const f32x4*>(xr + (i * 64 + lane) * 4); ss += v[i][0] * v[i][0] + v[i][1] * v[i][1] + v[i][2] * v[i][2] + v[i][3] * v[i][3]; }
        ss = wave_sum(ss);
        const float rstd = rsqrtf(ss * (1.f / D) + 1e-6f);
        const float* sh = mod_ptr(p, l, row, 0); const float* sc = mod_ptr(p, l, row, 1);
        const float* nw = p.norm_mix_pre + (size_t)l * D;
#pragma unroll
        for (int i = 0; i < 8; ++i) {
            const int col = (i * 64 + lane) * 4;
            const f32x4 w4 = *reinterpret_cast<const f32x4*>(nw + col), s4 = *reinterpret_cast<const f32x4*>(sc + col), h4 = *reinterpret_cast<const f32x4*>(sh + col);
            f32x4 o = v[i] * rstd * w4 * (s4 + 1.f) + h4;
            u32x2 pk = {pk_bf16(o[0], o[1]), pk_bf16(o[2], o[3])};
            *reinterpret_cast<u32x2*>(H + (size_t)row * D + col) = pk;
        }
    }
}

__device__ __forceinline__ void convert_item(const float* W, int N, u16* Wt, int kb, int nb, unsigned char* lds) {
    const int t = tid_(), lane = t & 63, w = t >> 6;
    const int n4 = lane * 4, k0 = kb * 64 + w * 8, n0 = nb * 256;
    int col = n0 + n4; if (col > N - 4) col = N - 4;
    f32x4 r8[8];
#pragma unroll
    for (int j = 0; j < 8; ++j) r8[j] = *reinterpret_cast<const f32x4*>(W + (size_t)(k0 + j) * N + col);
    __syncthreads();
#pragma unroll
    for (int jj = 0; jj < 4; ++jj) {
        u32x4 v = {pk_bf16(r8[0][jj], r8[1][jj]), pk_bf16(r8[2][jj], r8[3][jj]), pk_bf16(r8[4][jj], r8[5][jj]), pk_bf16(r8[6][jj], r8[7][jj])};
        const int r = n4 + jj;
        *reinterpret_cast<u32x4*>(lds + r * 128 + ((w ^ ((r >> 2) & 7)) << 4)) = v;
    }
    __syncthreads();
    const int c = t & 7;
#pragma unroll
    for (int i = 0; i < 4; ++i) {
        const int r = (t >> 3) + 64 * i;
        if (n0 + r < N) {
            const u32x4 v = *reinterpret_cast<const u32x4*>(lds + r * 128 + ((c ^ ((r >> 2) & 7)) << 4));
            *reinterpret_cast<u32x4*>(Wt + (size_t)(n0 + r) * 2048 + ((kb * 64 + c * 8 + 64 * ((n0 + r) & 31)) & 2047)) = v;
        }
    }
}
__device__ void convert_matrix_items(const float* W, int N, u16* Wt, int first, int count, unsigned char* lds) {
    const int nnb = (N + 255) / 256;
    for (int it = first; it < first + count; ++it) convert_item(W, N, Wt, it / nnb, it % nnb, lds);
}
__device__ void phase_convert_dense(const Params& p, unsigned char* lds) {
    for (int item = bid_(); item < 1888; item += gdim_()) {
        if (item < 928) convert_item(p.ab_w_in, AB_IN, (u16*)(p.ws + WS_WT_ABIN), item / 29, item % 29, lds);
        else if (item < 1184) { const int it = item - 928; convert_item(p.ab_w_out, D, (u16*)(p.ws + WS_WT_ABOUT), it / 8, it % 8, lds); }
        else if (item < 1632) { const int it = item - 1184; convert_item(p.cd_w_in, CD_IN, (u16*)(p.ws + WS_WT_CDIN), it / 14, it % 14, lds); }
        else { const int it = item - 1632; convert_item(p.cd_w_out, D, (u16*)(p.ws + WS_WT_CDOUT), it / 8, it % 8, lds); }
    }
}
__device__ void phase_convert_moe(const Params& p, int l, unsigned char* lds) {
    for (int item = bid_(); item < 3 * NEXP * 256; item += gdim_()) {
        const int which = item / (NEXP * 256), r = item % (NEXP * 256), ex = r >> 8, it = r & 255;
        const float* src = (which == 0 ? p.moe_w1 : (which == 1 ? p.moe_w3 : p.moe_w2)) + (size_t)(l * NEXP + ex) * D * FF;
        u16* dst = (u16*)(p.ws + (which == 0 ? WS_WT_W1 : (which == 1 ? WS_WT_W3 : WS_WT_W2))) + (size_t)ex * D * FF;
        convert_item(src, 2048, dst, it >> 3, it & 7, lds);
    }
}

struct GemmDesc {
    const u16* A; int lda; const int* arow; int mvalid; int m0;
    const u16* B0; const u16* B1; int n0; int ncols;
    int K;
};
enum { EPI_BF16 = 0, EPI_F32 = 1, EPI_SWIGLU = 2, EPI_SCALE = 3 };
struct EpiDesc { u16* ob; float* of; int ldo; float* gates; const float* rscale; };
constexpr int GEMM_BUF = 65536, GEMM_BOFF = 32768;

template <int EPI>
__device__ __forceinline__ void gemm_tile(const GemmDesc& g, const EpiDesc& e, unsigned char* lds) {
    const int t = tid_(), lane = t & 63, w = t >> 6;
    const int wr = w >> 2, wc = w & 3, fr = lane & 15, fq = lane >> 4;
    const int ac = t & 7, ar = t >> 3;
    const int kofs = (ac ^ ((ar >> 1) & 7)) << 3;
    unsigned ap[4], bpo[4];
#pragma unroll
    for (int i = 0; i < 4; ++i) {
        int r = g.m0 + ar + 64 * i; if (r >= g.mvalid) r = g.mvalid - 1;
        const int src = g.arow ? g.arow[r] : r;
        ap[i] = ((unsigned)src * 2048u + kofs) * 2u;
        const int np = ar + 64 * i;
        const int rho = np & 31, pcol = 8 * ((rho & 15) >> 2) + 4 * (rho >> 4) + (rho & 3);
        if (EPI == EPI_SWIGLU) {
            const int which = (np >> 5) & 1, ffl = (np >> 6) * 32 + pcol;
            bpo[i] = ((unsigned)(g.n0 + ffl) * 2048u) * 2u + (which ? (unsigned)(WS_WT_W3 - WS_WT_W1) : 0u);
        } else {
            int n = g.n0 + (np & ~31) + pcol; if (n >= g.ncols) n = g.ncols - 1;
            bpo[i] = ((unsigned)n * 2048u) * 2u;
        }
    }
    const int d_off = t * 16;
    const int s0 = (fr >> 1) & 7;
    const int a_rd0 = wr * 16384 + fr * 128 + ((fq ^ s0) << 4), a_rd1 = a_rd0 ^ 64;
    const int b_rd0 = GEMM_BOFF + wc * 8192 + fr * 128 + ((fq ^ s0) << 4), b_rd1 = b_rd0 ^ 64;

    f32x4 acc[8][4];
#pragma unroll
    for (int i = 0; i < 8; ++i)
#pragma unroll
        for (int j = 0; j < 4; ++j) acc[i][j] = (f32x4){0.f, 0.f, 0.f, 0.f};

    constexpr int nk = 2048 >> 6;
    const unsigned brot = (unsigned)(kofs * 2 + (8 * (((ar & 31) & 15) >> 2) + 4 * ((ar & 31) >> 4) + (ar & 3)) * 128);
#define G_DMA(BUF, KT) do { const unsigned _k = (unsigned)(KT) << 7; \
    const unsigned char* _ab = (const unsigned char*)g.A + _k; const unsigned char* _bb = (const unsigned char*)g.B0; \
    asm volatile("" : "+s"(_ab), "+s"(_bb));     \
    const unsigned _kb = (_k + brot) & 4095u; \
    _Pragma("unroll") for (int i = 0; i < 4; ++i) __builtin_amdgcn_global_load_lds((const unsigned*)(_ab + ap[i]), (unsigned*)((BUF) + d_off + i * 8192), 16, 0, 0); \
    _Pragma("unroll") for (int i = 0; i < 4; ++i) __builtin_amdgcn_global_load_lds((const unsigned*)(_bb + (bpo[i] + _kb)), (unsigned*)((BUF) + GEMM_BOFF + d_off + i * 8192), 16, 0, 0); } while (0)
    G_DMA(lds, 0);
    for (int kt = 0; kt < nk; ++kt) {
        unsigned char* buf = lds + (kt & 1) * GEMM_BUF;
        asm volatile("s_waitcnt vmcnt(0)" ::: "memory");
        __syncthreads();
        if (kt + 1 < nk) G_DMA(lds + ((kt + 1) & 1) * GEMM_BUF, kt + 1);
#define RD_A(KK, MI) (*reinterpret_cast<const bf16x8*>(buf + (((KK) ? a_rd1 : a_rd0) + (MI) * 2048)))
#define RD_B(KK, NI) (*reinterpret_cast<const bf16x8*>(buf + (((KK) ? b_rd1 : b_rd0) + (NI) * 2048)))
        bf16x8 bq[2][4], aq[2][2];
#pragma unroll
        for (int ni = 0; ni < 4; ++ni) bq[0][ni] = RD_B(0, ni);
        aq[0][0] = RD_A(0, 0); aq[0][1] = RD_A(0, 1);
#define G_STEP(ST) do { \
        constexpr int kk = (ST) >> 2, pr = (ST) & 3, cur = (ST) & 1, nxt = cur ^ 1, nkk = ((ST) + 1) >> 2, npr = ((ST) + 1) & 3; \
        if ((ST) < 7) { \
            if (npr == 0) { _Pragma("unroll") for (int ni = 0; ni < 4; ++ni) bq[nkk & 1][ni] = RD_B(nkk & 1, ni); } \
            aq[nxt][0] = RD_A(nkk & 1, npr * 2); aq[nxt][1] = RD_A(nkk & 1, npr * 2 + 1); } \
        _Pragma("unroll") for (int h2 = 0; h2 < 2; ++h2) \
            _Pragma("unroll") for (int ni = 0; ni < 4; ++ni) acc[pr * 2 + h2][ni] = mfma16(bq[kk][ni], aq[cur][h2], acc[pr * 2 + h2][ni]); \
        __builtin_amdgcn_sched_group_barrier(0x100, ((ST) < 7) ? (npr == 0 ? 6 : 2) : 0, 0); \
        __builtin_amdgcn_sched_group_barrier(0x008, 8, 0); } while (0)
        G_STEP(0); G_STEP(1); G_STEP(2); G_STEP(3); G_STEP(4); G_STEP(5); G_STEP(6); G_STEP(7);
#undef G_STEP
#undef RD_A
#undef RD_B
    }
#undef G_DMA
#pragma unroll
    for (int mi = 0; mi < 8; ++mi) {
        const int row = g.m0 + wr * 128 + mi * 16 + fr;
        if (row < g.mvalid) {
            if (EPI == EPI_BF16 || EPI == EPI_F32) {
#pragma unroll
                for (int gq = 0; gq < 2; ++gq) {
                    const int col = g.n0 + wc * 64 + gq * 32 + 8 * fq;
                    if (col < g.ncols) {
                        const f32x4 v0 = acc[mi][2 * gq], v1 = acc[mi][2 * gq + 1];
                        u32x4 pk = {pk_bf16(v0[0], v0[1]), pk_bf16(v0[2], v0[3]), pk_bf16(v1[0], v1[1]), pk_bf16(v1[2], v1[3])};
                        *reinterpret_cast<u32x4*>(e.ob + (size_t)row * e.ldo + col) = pk;
                        if (e.gates && col >= 4096 && col < 4112) { *reinterpret_cast<f32x4*>(e.gates + (size_t)row * 16 + (col - 4096)) = v0; *reinterpret_cast<f32x4*>(e.gates + (size_t)row * 16 + (col - 4096) + 4) = v1; }
                    }
                }
            } else if (EPI == EPI_SWIGLU) {
                const int col = g.n0 + wc * 32 + 8 * fq;
                float a[8];
#pragma unroll
                for (int ni = 0; ni < 2; ++ni)
#pragma unroll
                    for (int q = 0; q < 4; ++q) { const float u = acc[mi][ni][q]; a[ni * 4 + q] = u * frcp_(1.f + __expf(-u)) * acc[mi][ni + 2][q]; }
                u32x4 pk = {pk_bf16(a[0], a[1]), pk_bf16(a[2], a[3]), pk_bf16(a[4], a[5]), pk_bf16(a[6], a[7])};
                *reinterpret_cast<u32x4*>(e.ob + (size_t)row * e.ldo + col) = pk;
            } else {
                const float sc = e.rscale[row];
#pragma unroll
                for (int gq = 0; gq < 2; ++gq) {
                    const int col = g.n0 + wc * 64 + gq * 32 + 8 * fq;
                    const f32x4 v0 = acc[mi][2 * gq] * sc, v1 = acc[mi][2 * gq + 1] * sc;
                    u32x4 pk = {pk_bf16(v0[0], v0[1]), pk_bf16(v0[2], v0[3]), pk_bf16(v1[0], v1[1]), pk_bf16(v1[2], v1[3])};
                    *reinterpret_cast<u32x4*>(e.ob + (size_t)row * e.ldo + col) = pk;
                }
            }
        }
    }
    __syncthreads();
}

template <int EPI>
__device__ void phase_gemm_dense(const Params& p, const u16* A, int M, const u16* Wt, int N, EpiDesc e, unsigned char* lds) {
    const int nM = M / 256, nN = (N + 255) / 256, L = nM * nN;
    const int xcd = bid_() & 7, slot = bid_() >> 3, nslot = gdim_() >> 3;
    const int base = (int)(((long)L * xcd) >> 3), cnt = (int)(((long)L * (xcd + 1)) >> 3) - base;
    const int G8 = nM >> 3, rem = nM & 7;
    for (int k = slot; k < cnt; k += nslot) {
        const int idx = base + k;
        int pn, pm;
        if (idx < G8 * 8 * nN) { const int gq = idx / (8 * nN), r = idx % (8 * nN); pn = r >> 3; pm = gq * 8 + (r & 7); }
        else { const int r = idx - G8 * 8 * nN; pn = r / rem; pm = G8 * 8 + r % rem; }
        GemmDesc g; g.A = A; g.lda = D; g.arow = nullptr; g.mvalid = M; g.m0 = pm * 256;
        g.B0 = Wt; g.B1 = nullptr; g.n0 = pn * 256; g.ncols = N; g.K = D;
        gemm_tile<EPI>(g, e, lds);
    }
}

__device__ void phase_moe_a(const Params& p, int l, unsigned char* lds) {
    const int mvalid = l == 0 ? 2176 : 2048, nM = l == 0 ? 9 : 8;
    const int per_e = nM * 16;
    const int xcd = bid_() & 7, slot = bid_() >> 3, nslot = gdim_() >> 3;
    for (int k = slot; k < 2 * per_e; k += nslot) {
        const int tile = xcd * 2 * per_e + k;
        const int ex = tile / per_e, r = tile % per_e, pn = r / nM, pm = r % nM;
        GemmDesc g; g.A = (const u16*)(p.ws + WS_H); g.lda = D; g.arow = (const int*)(p.ws + WS_EROW) + ex * EPAD; g.mvalid = mvalid; g.m0 = pm * 256;
        g.B0 = (const u16*)(p.ws + WS_WT_W1) + (size_t)ex * D * FF; g.B1 = (const u16*)(p.ws + WS_WT_W3) + (size_t)ex * D * FF; g.n0 = pn * 128; g.ncols = FF; g.K = D;
        EpiDesc e; e.ob = (u16*)(p.ws + WS_ACT) + (size_t)ex * EPAD * FF; e.of = nullptr; e.ldo = FF; e.gates = nullptr; e.rscale = nullptr;
        gemm_tile<EPI_SWIGLU>(g, e, lds);
    }
}
__device__ void phase_moe_b(const Params& p, int l, unsigned char* lds) {
    const int mvalid = l == 0 ? 2176 : 2048, nM = l == 0 ? 9 : 8;
    const int per_e = nM * 8;
    const int xcd = bid_() & 7, slot = bid_() >> 3, nslot = gdim_() >> 3;
    for (int k = slot; k < 2 * per_e; k += nslot) {
        const int tile = xcd * 2 * per_e + k;
        const int ex = tile / per_e, r = tile % per_e, pn = r / nM, pm = r % nM;
        GemmDesc g; g.A = (const u16*)(p.ws + WS_ACT) + (size_t)ex * EPAD * FF; g.lda = FF; g.arow = nullptr; g.mvalid = mvalid; g.m0 = pm * 256;
        g.B0 = (const u16*)(p.ws + WS_WT_W2) + (size_t)ex * D * FF; g.B1 = nullptr; g.n0 = pn * 256; g.ncols = D; g.K = FF;
        EpiDesc e; e.ob = (u16*)(p.ws + WS_YEXP) + (size_t)ex * EPAD * D; e.of = nullptr; e.ldo = D; e.gates = nullptr; e.rscale = (const float*)(p.ws + WS_EGATE) + ex * EPAD;
        gemm_tile<EPI_SCALE>(g, e, lds);
    }
}

__device__ __forceinline__ int mlstm_row(int b, int dir, int pos) {
    if (pos < LC) return NLAT + b * LC + (dir ? (LC - 1 - pos) : pos);
    const int q = pos - LC; return b * SEQ + (dir ? (SEQ - 1 - q) : q);
}
__device__ void phase_mlstm(const Params& p, unsigned char* lds) {
    u16* KT = (u16*)lds;
    u16* VT = KT + 256 * 72;
    u16* VWT = VT + 48 * 72;
    u16* CT = VWT + 48 * 72;
    u16* Ss = CT + 48 * 264;
    float* gB = (float*)(Ss + 64 * 72);
    float* gI = gB + 68 * 64;
    float* gP = gI + 68 * 64;
    float* gE = gP + 68 * 64;
    const int t = tid_(), lane = t & 63, w = t >> 6, fr = lane & 15, fq = lane >> 4;
    const u16* P = (const u16*)(p.ws + WS_P);
    const float* G = (const float*)(p.ws + WS_G);
    u16* HM = (u16*)(p.ws + WS_HM);
    for (int item = bid_(); item < 256; item += gdim_()) {
        const int vs = item & 7, dir = (item >> 3) & 1, hh = (item >> 4) & 3, b = item >> 6;
        __syncthreads();
        for (int i = t; i < 48 * 264; i += NT) CT[i] = 0;
        for (int i = t; i < 16 * 72; i += NT) { const int er = i / 72; VT[32 * 72 + i] = (er == 0) ? (u16)0x3f80 : (u16)0; VWT[32 * 72 + i] = 0; }
        {
            const float gb_i = p.mlstm_gate_b[(dir * 2 + 0) * 4 + hh], gb_f = p.mlstm_gate_b[(dir * 2 + 1) * 4 + hh];
            for (int ch = w; ch < 68; ch += 8) {
                const int row = mlstm_row(b, dir, ch * 64 + lane);
                const float gi = G[(size_t)row * 16 + dir * 8 + hh] + gb_i;
                const float gf = G[(size_t)row * 16 + dir * 8 + 4 + hh] + gb_f;
                const float lf = fminf(gf, 0.f) - log1pf(__expf(-fabsf(gf)));
                float bc = lf;
#pragma unroll
                for (int o = 1; o < 64; o <<= 1) { const float n = __shfl_up(bc, o, 64); if (lane >= o) bc += n; }
                float pm = gi - bc;
#pragma unroll
                for (int o = 1; o < 64; o <<= 1) { const float n = __shfl_up(pm, o, 64); if (lane >= o) pm = fmaxf(pm, n); }
                const float b63 = __shfl(bc, 63, 64);
                float gmax = b63 - bc + gi;
#pragma unroll
                for (int o = 32; o > 0; o >>= 1) gmax = fmaxf(gmax, __shfl_xor(gmax, o, 64));
                gB[ch * 64 + lane] = bc; gI[ch * 64 + lane] = gi; gP[ch * 64 + lane] = pm;
                if (lane == 0) { gE[ch * 2] = b63; gE[ch * 2 + 1] = gmax; }
            }
        }
        f32x4 Cacc[2][3];
#pragma unroll
        for (int i = 0; i < 2; ++i)
#pragma unroll
            for (int j = 0; j < 3; ++j) Cacc[i][j] = (f32x4){0.f, 0.f, 0.f, 0.f};
        float m_old = 0.f;
        const int jt = w & 3, sth = w >> 2;
        const int vs_s = t & 63, vs_eg = t >> 6;
        bf16x8 qf[8], kf[8]; unsigned ktr[2][8]; u32x2 vraw;
        const int jq = jt * 16 + fr, jjq = dir ? 63 - jq : jq;
        const unsigned off_q = (unsigned)jjq * AB_IN + hh * 256 + fq * 8;
        const int jk0 = (sth * 2) * 16 + fr, jk1 = jk0 + 16;
        const unsigned off_k0 = (unsigned)(dir ? 63 - jk0 : jk0) * AB_IN + 1024 + hh * 256 + fq * 8;
        const unsigned off_k1 = (unsigned)(dir ? 63 - jk1 : jk1) * AB_IN + 1024 + hh * 256 + fq * 8;
        unsigned off_kt[2];
#pragma unroll
        for (int i = 0; i < 2; ++i) { const int mt = t + NT * i, d2 = (mt & 127) * 2, s8 = (mt >> 7) * 8; off_kt[i] = (unsigned)(dir ? 63 - s8 - 7 : s8) * AB_IN + 1024 + hh * 256 + d2; }
        const unsigned off_v = (unsigned)(dir ? 63 - vs_s : vs_s) * AB_IN + 2048 + hh * 256 + vs * 32 + vs_eg * 4;
        const unsigned off_h = (unsigned)jjq * 1024 + hh * 256 + vs * 32 + sth * 16 + 4 * fq;
#define ML_BASE(POS0) (P + (size_t)(dir ? mlstm_row(b, dir, (POS0)) - 63 : mlstm_row(b, dir, (POS0))) * AB_IN)
#define ML_LOAD_Q(POS0) do { const u16* _pc = ML_BASE(POS0); \
            _Pragma("unroll") for (int kk = 0; kk < 8; ++kk) qf[kk] = ld_frag_g(_pc + off_q + kk * 32); } while (0)
#define ML_LOAD_K(POS0, S2) do { const u16* _pc = ML_BASE(POS0); \
            _Pragma("unroll") for (int kk = 0; kk < 8; ++kk) kf[kk] = ld_frag_g(_pc + ((S2) ? off_k1 : off_k0) + kk * 32); } while (0)
#define ML_LOAD_KTV(POS0) do { const u16* _pc = ML_BASE(POS0); \
            _Pragma("unroll") for (int i = 0; i < 2; ++i) { \
                _Pragma("unroll") for (int q = 0; q < 8; ++q) ktr[i][q] = *reinterpret_cast<const unsigned*>(_pc + (size_t)((dir ? 7 - q : q) * AB_IN) + off_kt[i]); } \
            vraw = *reinterpret_cast<const u32x2*>(_pc + off_v); } while (0)
        ML_LOAD_Q(0);
        __syncthreads();
        for (int ch = 0; ch < 68; ++ch) {
            const int pos0 = ch * 64;
            const float* sb = gB + ch * 64; const float* sig = gI + ch * 64; const float* spm = gP + ch * 64;
            const float b63 = gE[ch * 2], m_new = fmaxf(b63 + m_old, gE[ch * 2 + 1]), decay = __expf(b63 + m_old - m_new);
            const int jg = jt * 16 + fr;
            const float bj = sb[jg], mj = bj + fmaxf(m_old, spm[jg]);
            auto s_tile = [&](int st) {
                f32x4 sv = (f32x4){0.f, 0.f, 0.f, 0.f};
                if (st <= jt) {
#pragma unroll
                    for (int kk = 0; kk < 8; ++kk) sv = mfma16(kf[kk], qf[kk], sv);
                }
                float pv[4];
#pragma unroll
                for (int q = 0; q < 4; ++q) {
                    const int sg = st * 16 + 4 * fq + q;
                    pv[q] = (sg <= jg) ? sv[q] * 0.0625f * __expf(bj - sb[sg] + sig[sg] - mj) : 0.f;
                }
                u32x2 pk = {pk_bf16(pv[0], pv[1]), pk_bf16(pv[2], pv[3])};
                *reinterpret_cast<u32x2*>(Ss + jg * 72 + st * 16 + 4 * fq) = pk;
            };
            ML_LOAD_KTV(pos0);
            if (sth * 2 <= jt) ML_LOAD_K(pos0, 0);
#pragma unroll
            for (int i = 0; i < 2; ++i) {
                const int mt = t + NT * i, d2 = (mt & 127) * 2, s8 = (mt >> 7) * 8;
                u32x4 lo = {(ktr[i][0] & 0xffffu) | (ktr[i][1] << 16), (ktr[i][2] & 0xffffu) | (ktr[i][3] << 16), (ktr[i][4] & 0xffffu) | (ktr[i][5] << 16), (ktr[i][6] & 0xffffu) | (ktr[i][7] << 16)};
                u32x4 hi = {(ktr[i][0] >> 16) | (ktr[i][1] & 0xffff0000u), (ktr[i][2] >> 16) | (ktr[i][3] & 0xffff0000u), (ktr[i][4] >> 16) | (ktr[i][5] & 0xffff0000u), (ktr[i][6] >> 16) | (ktr[i][7] & 0xffff0000u)};
                *reinterpret_cast<u32x4*>(KT + d2 * 72 + s8) = lo;
                *reinterpret_cast<u32x4*>(KT + (d2 + 1) * 72 + s8) = hi;
            }
            {
                const float wg = __expf(b63 - sb[vs_s] + sig[vs_s] - m_new) * 0.0625f;
                const float v0 = bf_lo(vraw[0]), v1 = bf_hi(vraw[0]), v2 = bf_lo(vraw[1]), v3 = bf_hi(vraw[1]);
                const int e0 = vs_eg * 4;
                VT[(e0 + 0) * 72 + vs_s] = (u16)(vraw[0] & 0xffffu); VT[(e0 + 1) * 72 + vs_s] = (u16)(vraw[0] >> 16);
                VT[(e0 + 2) * 72 + vs_s] = (u16)(vraw[1] & 0xffffu); VT[(e0 + 3) * 72 + vs_s] = (u16)(vraw[1] >> 16);
                VWT[(e0 + 0) * 72 + vs_s] = f2bf(v0 * wg); VWT[(e0 + 1) * 72 + vs_s] = f2bf(v1 * wg);
                VWT[(e0 + 2) * 72 + vs_s] = f2bf(v2 * wg); VWT[(e0 + 3) * 72 + vs_s] = f2bf(v3 * wg);
                if (t < 64) VWT[32 * 72 + t] = f2bf(wg);
            }
            s_tile(sth * 2);
            if (sth * 2 + 1 <= jt) ML_LOAD_K(pos0, 1);
            s_tile(sth * 2 + 1);
            __syncthreads();
            {
                const float w_inter = __expf(bj + m_old - mj);
                f32x4 nacc[2];
#pragma unroll
                for (int z = 0; z < 2; ++z) {
                    const int et = z == 0 ? sth : 2;
                    f32x4 a = (f32x4){0.f, 0.f, 0.f, 0.f};
#pragma unroll
                    for (int kk = 0; kk < 8; ++kk) a = mfma16(ld_frag_s(CT + (et * 16 + fr) * 264 + kk * 32 + fq * 8), qf[kk], a);
                    nacc[z] = a * w_inter;
                }
                if (ch + 1 < 68) ML_LOAD_Q(pos0 + 64);
#pragma unroll
                for (int z = 0; z < 2; ++z) {
                    const int et = z == 0 ? sth : 2;
                    f32x4 a = nacc[z];
#pragma unroll
                    for (int k2 = 0; k2 < 2; ++k2) a = mfma16(ld_frag_s(VT + (et * 16 + fr) * 72 + k2 * 32 + fq * 8), ld_frag_s(Ss + jg * 72 + k2 * 32 + fq * 8), a);
                    nacc[z] = a;
                }
                const float den = __shfl(nacc[1][0], fr, 64);
                const float dd = fmaxf(fabsf(den), __expf(-mj));
                const float inv = 1.f / dd;
                u32x2 pk = {pk_bf16(nacc[0][0] * inv, nacc[0][1] * inv), pk_bf16(nacc[0][2] * inv, nacc[0][3] * inv)};
                *reinterpret_cast<u32x2*>(HM + ((size_t)dir * NTOK + (dir ? mlstm_row(b, dir, pos0) - 63 : mlstm_row(b, dir, pos0))) * 1024 + off_h) = pk;
            }
#pragma unroll
            for (int i = 0; i < 2; ++i)
#pragma unroll
                for (int et = 0; et < 3; ++et) {
                    f32x4 a = Cacc[i][et] * decay;
#pragma unroll
                    for (int k2 = 0; k2 < 2; ++k2) a = mfma16(ld_frag_s(KT + ((w * 2 + i) * 16 + fr) * 72 + k2 * 32 + fq * 8), ld_frag_s(VWT + (et * 16 + fr) * 72 + k2 * 32 + fq * 8), a);
                    Cacc[i][et] = a;
                }
            __syncthreads();
#pragma unroll
            for (int i = 0; i < 2; ++i)
#pragma unroll
                for (int et = 0; et < 3; ++et) {
                    const f32x4 a = Cacc[i][et];
                    u32x2 pk = {pk_bf16(a[0], a[1]), pk_bf16(a[2], a[3])};
                    *reinterpret_cast<u32x2*>(CT + (et * 16 + fr) * 264 + (w * 2 + i) * 16 + 4 * fq) = pk;
                }
            m_old = m_new;
        }
#undef ML_LOAD_Q
#undef ML_LOAD_K
#undef ML_LOAD_KTV
    }
}

__device__ void mlstm_out_rows(const Params& p, int row0, int nrows) {
    const int lane = tid_() & 63, w = tid_() >> 6;
    const u16* P = (const u16*)(p.ws + WS_P);
    const u16* HM = (const u16*)(p.ws + WS_HM);
    u16* YIN = (u16*)(p.ws + WS_YIN);
    for (int r = w; r < nrows; r += 8) {
        const int row = row0 + r;
        const int c0 = lane * 16;
        float v[16]; float ss = 0.f;
#pragma unroll
        for (int h2 = 0; h2 < 2; ++h2) {
            const u32x4 a = *reinterpret_cast<const u32x4*>(HM + (size_t)row * 1024 + c0 + h2 * 8);
            const u32x4 bq = *reinterpret_cast<const u32x4*>(HM + ((size_t)NTOK + row) * 1024 + c0 + h2 * 8);
#pragma unroll
            for (int q = 0; q < 4; ++q) { v[h2 * 8 + 2 * q] = bf_lo(a[q]) + bf_lo(bq[q]); v[h2 * 8 + 2 * q + 1] = bf_hi(a[q]) + bf_hi(bq[q]); }
        }
#pragma unroll
        for (int q = 0; q < 16; ++q) ss += v[q] * v[q];
        ss += __shfl_xor(ss, 1, 64); ss += __shfl_xor(ss, 2, 64); ss += __shfl_xor(ss, 4, 64); ss += __shfl_xor(ss, 8, 64);
        const float rstd = rsqrtf(ss * (1.f / 256.f) + 1e-6f);
        unsigned o[8];
#pragma unroll
        for (int h2 = 0; h2 < 2; ++h2) {
            const u32x4 og = *reinterpret_cast<const u32x4*>(P + (size_t)row * AB_IN + 3072 + c0 + h2 * 8);
#pragma unroll
            for (int q = 0; q < 4; ++q) {
                const int c = c0 + h2 * 8 + 2 * q;
                const float y0 = v[h2 * 8 + 2 * q] * rstd * p.mlstm_norm[c] * sigmoidf_(bf_lo(og[q]));
                const float y1 = v[h2 * 8 + 2 * q + 1] * rstd * p.mlstm_norm[c + 1] * sigmoidf_(bf_hi(og[q]));
                o[h2 * 4 + q] = pk_bf16(y0, y1);
            }
        }
        *reinterpret_cast<u32x4*>(YIN + (size_t)row * D + c0) = (u32x4){o[0], o[1], o[2], o[3]};
        *reinterpret_cast<u32x4*>(YIN + (size_t)row * D + c0 + 8) = (u32x4){o[4], o[5], o[6], o[7]};
    }
}

template <int DH, class KeyFn, class BiasFn>
__device__ __forceinline__ void attn_wave(const u16* qptr, size_t qstride, int nblk, KeyFn keyfn, BiasFn biasfn, float scale,
                                           float m_init, float l_init, u16* vlds, u16* optr, size_t ostride) {
    constexpr int NK = DH / 32, NDT = DH / 16, VS = DH + 8, NV = DH / 16;
    const int lane = tid_() & 63, fr = lane & 15, fq = lane >> 4;
    bf16x8 qf[NK];
#pragma unroll
    for (int kk = 0; kk < NK; ++kk) qf[kk] = ld_frag_g(qptr + (size_t)fr * qstride + kk * 32 + fq * 8);
    f32x4 oacc[NDT];
#pragma unroll
    for (int i = 0; i < NDT; ++i) oacc[i] = (f32x4){0.f, 0.f, 0.f, 0.f};
    float m = m_init, l = l_init;
    bf16x8 kn[2][NK]; u32x4 vn[NV];
    auto load_blk = [&](int ib) {
        const u16* kptr; const u16* vptr; size_t kvs;
        (void)keyfn(ib, kptr, vptr, kvs);
#pragma unroll
        for (int st = 0; st < 2; ++st)
#pragma unroll
            for (int kk = 0; kk < NK; ++kk) kn[st][kk] = ld_frag_g(kptr + (size_t)(st * 16 + fr) * kvs + kk * 32 + fq * 8);
#pragma unroll
        for (int i = 0; i < NV; ++i) { const int cidx = lane + 64 * i, r = cidx / (DH / 8), cc = cidx % (DH / 8); vn[i] = *reinterpret_cast<const u32x4*>(vptr + (size_t)r * kvs + cc * 8); }
    };
    auto next_valid = [&](int ib) { const u16* a; const u16* b2; size_t c; while (ib < nblk && !keyfn(ib, a, b2, c)) ++ib; return ib; };
    int ib = next_valid(0);
    if (ib < nblk) load_blk(ib);
    while (ib < nblk) {
        bf16x8 kc[2][NK]; u32x4 vc[NV];
#pragma unroll
        for (int st = 0; st < 2; ++st)
#pragma unroll
            for (int kk = 0; kk < NK; ++kk) kc[st][kk] = kn[st][kk];
#pragma unroll
        for (int i = 0; i < NV; ++i) vc[i] = vn[i];
        const int ibn = next_valid(ib + 1);
        if (ibn < nblk) load_blk(ibn);
        asm volatile("" ::: "memory");
#pragma unroll
        for (int i = 0; i < NV; ++i) { const int cidx = lane + 64 * i, r = cidx / (DH / 8), cc = cidx % (DH / 8); *reinterpret_cast<u32x4*>(vlds + r * VS + cc * 8) = vc[i]; }
        f32x4 s[2];
#pragma unroll
        for (int st = 0; st < 2; ++st) {
            f32x4 a = (f32x4){0.f, 0.f, 0.f, 0.f};
#pragma unroll
            for (int kk = 0; kk < NK; ++kk) a = mfma16(kc[st][kk], qf[kk], a);
            s[st] = a;
        }
        float x[8]; float mx = -INFINITY;
#pragma unroll
        for (int st = 0; st < 2; ++st)
#pragma unroll
            for (int q = 0; q < 4; ++q) { const float v = s[st][q] * scale + biasfn(ib, fr, st * 16 + 4 * fq + q); x[st * 4 + q] = v; mx = fmaxf(mx, v); }
        mx = fmaxf(mx, __shfl_xor(mx, 16, 64)); mx = fmaxf(mx, __shfl_xor(mx, 32, 64));
        const float m_new = fmaxf(m, mx);
        const float m_safe = (m_new == -INFINITY) ? 0.f : m_new;
        const float alpha = __expf(m - m_safe);
        float ps = 0.f; float pe[8];
#pragma unroll
        for (int q = 0; q < 8; ++q) { pe[q] = __expf(x[q] - m_safe); ps += pe[q]; }
        l = l * alpha + ps; m = m_new;
#pragma unroll
        for (int i = 0; i < NDT; ++i) oacc[i] *= alpha;
        const bf16x8 pf = mk_frag(pk_bf16(pe[0], pe[1]), pk_bf16(pe[2], pe[3]), pk_bf16(pe[4], pe[5]), pk_bf16(pe[6], pe[7]));
        asm volatile("s_waitcnt lgkmcnt(0)" ::: "memory");
#pragma unroll
        for (int dt = 0; dt < NDT; ++dt) {
            const u16* vb = vlds + dt * 16 + fr;
            unsigned e[4];
#pragma unroll
            for (int j2 = 0; j2 < 2; ++j2) {
                const int k0 = (j2 == 0 ? 0 : 16) + 4 * fq;
                e[j2 * 2 + 0] = (unsigned)vb[(k0 + 0) * VS] | ((unsigned)vb[(k0 + 1) * VS] << 16);
                e[j2 * 2 + 1] = (unsigned)vb[(k0 + 2) * VS] | ((unsigned)vb[(k0 + 3) * VS] << 16);
            }
            oacc[dt] = mfma16(mk_frag(e[0], e[1], e[2], e[3]), pf, oacc[dt]);
        }
        asm volatile("" ::: "memory");
        ib = ibn;
    }
    l += __shfl_xor(l, 16, 64); l += __shfl_xor(l, 32, 64);
    const float inv = 1.f / l;
#pragma unroll
    for (int dt = 0; dt < NDT; ++dt) {
        const f32x4 o = oacc[dt] * inv;
        u32x2 pk = {pk_bf16(o[0], o[1]), pk_bf16(o[2], o[3])};
        *reinterpret_cast<u32x2*>(optr + (size_t)fr * ostride + dt * 16 + 4 * fq) = pk;
    }
}

__device__ void phase_l0_stage2(const Params& p, unsigned char* lds) {
    const int w = tid_() >> 6;
    const u16* P = (const u16*)(p.ws + WS_P);
    u16* YIN = (u16*)(p.ws + WS_YIN);
    u16* vlds = (u16*)lds + w * (32 * 136);
    for (int item = bid_(); item < 1088 + 2176; item += gdim_()) {
        if (item < 1024) {
            const int qt = item & 3, r = (item >> 2) & 63, b = item >> 8, h = w;
            const int r0 = min(max(r - 4, 0), 56);
            const int cb = qt == 0 ? 0 : (qt == 1 ? 8 : (qt == 2 ? 24 : 32));
            const int qrow = b * SEQ + r * 64 + qt * 16;
            const float* rpb = p.na_rpb + h * 15 * 31;
            auto keyfn = [&](int ib, const u16*& kp, const u16*& vp, size_t& kvs) -> bool {
                int row;
                if (ib < 8) row = b * SEQ + (r0 + ib) * 64 + cb; else row = NLAT + b * LC + (ib - 8) * 32;
                kp = P + (size_t)row * AB_IN + 5136 + h * 128; vp = P + (size_t)row * AB_IN + 6160 + h * 128; kvs = AB_IN; return true; };
            auto biasfn = [&](int ib, int qi, int ki) -> float {
                if (ib >= 8) return 0.f;
                const int c = qt * 16 + qi, kc = cb + ki, c0 = min(max(c - 8, 0), 48);
                if (kc < c0 || kc >= c0 + 16) return -INFINITY;
                return rpb[(r0 + ib - r + 7) * 31 + (kc - c + 15)]; };
            attn_wave<128>(P + (size_t)qrow * AB_IN + 4112 + h * 128, AB_IN, 16, keyfn, biasfn, 0.08838834764831845f, -INFINITY, 0.f, vlds,
                           YIN + (size_t)qrow * D + 1024 + h * 128, D);
        } else if (item < 1088) {
            const int it = item - 1024, qt = it & 15, b = it >> 4, h = w;
            const int qrow = NLAT + b * LC + qt * 16;
            auto keyfn = [&](int ib, const u16*& kp, const u16*& vp, size_t& kvs) -> bool {
                const int row = NLAT + b * LC + ib * 32;
                kp = P + (size_t)row * AB_IN + 5136 + h * 128; vp = P + (size_t)row * AB_IN + 6160 + h * 128; kvs = AB_IN; return true; };
            auto biasfn = [&](int, int, int) -> float { return 0.f; };
            attn_wave<128>(P + (size_t)qrow * AB_IN + 4112 + h * 128, AB_IN, 8, keyfn, biasfn, 0.08838834764831845f, -INFINITY, 0.f, vlds,
                           YIN + (size_t)qrow * D + 1024 + h * 128, D);
        } else {
            mlstm_out_rows(p, (item - 1088) * 8, 8);
        }
    }
}

__device__ void rope_rows(const Params& p, int row0, int nrows) {
    const int lane = tid_() & 63, w = tid_() >> 6;
    u16* P = (u16*)(p.ws + WS_P);
    for (int r = w; r < nrows; r += 8) {
        const int row = row0 + r, tt = row & (SEQ - 1);
        const float prow = (float)(tt >> 6), pcol = (float)(tt & 63);
        for (int pi = lane; pi < 640; pi += 64) {
            const int head = pi >> 5, half = (pi >> 4) & 1, j = pi & 15;
            const int base = (head < 16 ? head * 64 : 1024 + (head - 16) * 64) + half * 32 + j;
            const float inv = exp2f(-(float)j * (13.287712379549449f / 16.f));
            const float ang = (half ? pcol : prow) * inv;
            float sn, cs; sincosf(ang, &sn, &cs);
            u16* q1 = P + (size_t)row * CD_IN + base;
            const float x1 = bf2f(q1[0]), x2 = bf2f(q1[16]);
            q1[0] = f2bf(x1 * cs - x2 * sn); q1[16] = f2bf(x2 * cs + x1 * sn);
        }
    }
}

__device__ __forceinline__ int lru_row(int b, int ci, int j) { return ci < 4 ? NLAT + b * LC + ci * 64 + j : b * SEQ + (ci - 4) * 64 + j; }
__device__ void lru_chunk(const Params& p, int b, int blk, int ci, int mode, unsigned char* lds) {
    u16* ub = (u16*)lds;
    constexpr int SR = 132;
    float* sa = (float*)(ub + 64 * 136);
    float* sbt = sa + 64 * SR;
    float* sx = sbt + 64 * SR;
    const int t = tid_(), lane = t & 63, w = t >> 6, fr = lane & 15, fq = lane >> 4;
    const u16* P = (const u16*)(p.ws + WS_P);
    const u16* WT = (const u16*)(p.ws + WS_LRUW);
    float* SA = (float*)(p.ws + WS_LRUS);
    float* SH = SA + 2 * 4 * 68 * 1024;
    const int seglen = ci < 4 ? LC : SEQ, tt0 = ci < 4 ? ci * 64 : (ci - 4) * 64;
    const int rbase = ci < 4 ? NLAT + b * LC : b * SEQ;
    const int sc = t & 127, seg = t >> 7;
    const int chg_s = blk * 128 + sc;
    const int cg = blk * 128 + w * 16 + 4 * fq;
    bf16x8 wfa[2][2][4];
#pragma unroll
    for (int d2 = 0; d2 < 2; ++d2)
#pragma unroll
        for (int g2 = 0; g2 < 2; ++g2)
#pragma unroll
            for (int kk = 0; kk < 4; ++kk) wfa[d2][g2][kk] = ld_frag_g(WT + ((size_t)((d2 * 2 + g2) * 8 + blk) * 128 + w * 16 + fr) * 128 + fq * 8 + kk * 32);
    f32x4 gba[2][2], lama[2];
#pragma unroll
    for (int d2 = 0; d2 < 2; ++d2) {
        lama[d2] = *reinterpret_cast<const f32x4*>(p.lru_lambda + d2 * 1024 + cg);
#pragma unroll
        for (int g2 = 0; g2 < 2; ++g2) gba[d2][g2] = *reinterpret_cast<const f32x4*>(p.lru_gate_b + (d2 * 2 + g2) * 1024 + cg);
    }
    float carry[2] = {0.f, 0.f}; u16 grv[16];
    if (mode == 1) {
#pragma unroll
        for (int d2 = 0; d2 < 2; ++d2) carry[d2] = SH[((size_t)(d2 * 4 + b) * 68 + ci) * 1024 + chg_s];
#pragma unroll
        for (int s = 0; s < 16; ++s) grv[s] = P[(size_t)lru_row(b, ci, seg * 16 + s) * CD_IN + 2560 + chg_s];
    }
    __syncthreads();
    {
        const int c4 = (t & 31) * 4, j0 = (t >> 5) * 4, ch = blk * 128 + c4;
        float xv[7][4];
#pragma unroll
        for (int q = 0; q < 7; ++q) {
            const int tt = tt0 + j0 - 1 + q;
            if (tt >= 0 && tt < seglen) {
                const u32x2 v = *reinterpret_cast<const u32x2*>(P + (size_t)(rbase + tt) * CD_IN + 1536 + ch);
                xv[q][0] = bf_lo(v[0]); xv[q][1] = bf_hi(v[0]); xv[q][2] = bf_lo(v[1]); xv[q][3] = bf_hi(v[1]);
            } else { xv[q][0] = xv[q][1] = xv[q][2] = xv[q][3] = 0.f; }
        }
        f32x4 cw[4];
#pragma unroll
        for (int tp = 0; tp < 4; ++tp) cw[tp] = *reinterpret_cast<const f32x4*>(p.lru_conv_w + tp * 1024 + ch);
        const f32x4 cb = *reinterpret_cast<const f32x4*>(p.lru_conv_b + ch);
#pragma unroll
        for (int q = 0; q < 4; ++q) {
            float u[4];
#pragma unroll
            for (int cc = 0; cc < 4; ++cc) u[cc] = cb[cc] + xv[q][cc] * cw[0][cc] + xv[q + 1][cc] * cw[1][cc] + xv[q + 2][cc] * cw[2][cc] + xv[q + 3][cc] * cw[3][cc];
            u32x2 pk = {pk_bf16(u[0], u[1]), pk_bf16(u[2], u[3])};
            *reinterpret_cast<u32x2*>(ub + (j0 + q) * 136 + c4) = pk;
        }
    }
    __syncthreads();
    float hfw[16];
    for (int dir = 0; dir < 2; ++dir) {
        f32x4 av[4];
        {
            bf16x8 wf[4];
#pragma unroll
            for (int kk = 0; kk < 4; ++kk) wf[kk] = dir ? wfa[1][0][kk] : wfa[0][0][kk];
            const f32x4 gbv = dir ? gba[1][0] : gba[0][0];
            const f32x4 lamv = dir ? lama[1] : lama[0];
            float sp8[4];
#pragma unroll
            for (int q = 0; q < 4; ++q) { const float nl = -lamv[q]; sp8[q] = -8.f * (fmaxf(nl, 0.f) + __logf(1.f + __expf(-fabsf(nl)))); }
#pragma unroll
            for (int tt = 0; tt < 4; ++tt) {
                f32x4 z = (f32x4){0.f, 0.f, 0.f, 0.f};
#pragma unroll
                for (int kk = 0; kk < 4; ++kk) z = mfma16(wf[kk], ld_frag_s(ub + (tt * 16 + fr) * 136 + kk * 32 + fq * 8), z);
#pragma unroll
                for (int q = 0; q < 4; ++q) av[tt][q] = __expf(sigmoidf_(z[q] + gbv[q]) * sp8[q]);
            }
        }
        __syncthreads();
        {
            bf16x8 wf[4];
#pragma unroll
            for (int kk = 0; kk < 4; ++kk) wf[kk] = dir ? wfa[1][1][kk] : wfa[0][1][kk];
            const f32x4 gbv = dir ? gba[1][1] : gba[0][1];
#pragma unroll
            for (int tt = 0; tt < 4; ++tt) {
                f32x4 z = (f32x4){0.f, 0.f, 0.f, 0.f};
#pragma unroll
                for (int kk = 0; kk < 4; ++kk) z = mfma16(wf[kk], ld_frag_s(ub + (tt * 16 + fr) * 136 + kk * 32 + fq * 8), z);
                const int tj = tt * 16 + fr;
                const u32x2 uv = *reinterpret_cast<const u32x2*>(ub + tj * 136 + w * 16 + 4 * fq);
                const float u4[4] = {bf_lo(uv[0]), bf_hi(uv[0]), bf_lo(uv[1]), bf_hi(uv[1])};
                f32x4 bv;
#pragma unroll
                for (int q = 0; q < 4; ++q) { const float a = av[tt][q]; bv[q] = sqrtf(fmaxf(1.f - a * a, 0.f)) * sigmoidf_(z[q] + gbv[q]) * u4[q]; }
                *reinterpret_cast<f32x4*>(sa + tj * SR + w * 16 + 4 * fq) = av[tt];
                *reinterpret_cast<f32x4*>(sbt + tj * SR + w * 16 + 4 * fq) = bv;
            }
        }
        __syncthreads();
        float A = 1.f, h = 0.f;
#pragma unroll
        for (int s = 0; s < 16; ++s) { const int j = seg * 16 + (dir ? 15 - s : s); const float a = sa[j * SR + sc]; h = a * h + sbt[j * SR + sc]; A *= a; }
        sx[(seg * 2 + 0) * 128 + sc] = A; sx[(seg * 2 + 1) * 128 + sc] = h;
        __syncthreads();
        const size_t sidx = ((size_t)(dir * 4 + b) * 68 + ci) * 1024 + chg_s;
        if (mode == 0) {
            if (seg == 0) {
                float At = 1.f, ht = 0.f;
#pragma unroll
                for (int s = 0; s < 4; ++s) { const int sg = dir ? 3 - s : s; const float a = sx[(sg * 2) * 128 + sc]; ht = a * ht + sx[(sg * 2 + 1) * 128 + sc]; At *= a; }
                SA[sidx] = At; SH[sidx] = ht;
            }
        } else {
            float hs = dir ? carry[1] : carry[0];
            const int nprev = dir ? 3 - seg : seg;
#pragma unroll
            for (int s = 0; s < 3; ++s) if (s < nprev) { const int sg = dir ? 3 - s : s; hs = sx[(sg * 2) * 128 + sc] * hs + sx[(sg * 2 + 1) * 128 + sc]; }
            u16* YIN = (u16*)(p.ws + WS_YIN);
            if (dir == 0) {
#pragma unroll
                for (int s = 0; s < 16; ++s) { const int j = seg * 16 + s; hs = sa[j * SR + sc] * hs + sbt[j * SR + sc]; hfw[s] = hs; }
            } else {
#pragma unroll
                for (int s = 0; s < 16; ++s) {
                    const int js = 15 - s, j = seg * 16 + js;
                    hs = sa[j * SR + sc] * hs + sbt[j * SR + sc];
                    const int row = lru_row(b, ci, j);
                    const float gr = bf2f(grv[js]);
                    const float th = 1.f - 2.f * frcp_(1.f + __expf(1.5957691216057308f * (gr + 0.044715f * gr * gr * gr)));
                    const float ge = 0.5f * gr * (1.f + th);
                    YIN[(size_t)row * D + 1024 + chg_s] = f2bf((hfw[js] + hs) * ge);
                }
            }
        }
    }
}

__device__ void lru_prep_weights(const Params& p) {
    const int t = tid_();
    u16* WT = (u16*)(p.ws + WS_LRUW);
    for (int m = bid_(); m < 32; m += gdim_()) {
        const float* Wg = p.lru_gate_w + (size_t)m * 128 * 128;
        const int j4 = (t & 31) * 4, i8 = (t >> 5) * 8;
        f32x4 r8[8];
#pragma unroll
        for (int q = 0; q < 8; ++q) r8[q] = *reinterpret_cast<const f32x4*>(Wg + (size_t)(i8 + q) * 128 + j4);
#pragma unroll
        for (int jj = 0; jj < 4; ++jj) {
            u32x4 v = {pk_bf16(r8[0][jj], r8[1][jj]), pk_bf16(r8[2][jj], r8[3][jj]), pk_bf16(r8[4][jj], r8[5][jj]), pk_bf16(r8[6][jj], r8[7][jj])};
            *reinterpret_cast<u32x4*>(WT + ((size_t)m * 128 + j4 + jj) * 128 + i8) = v;
        }
    }
}
__device__ void lru_carry(const Params& p, int item) {
    const int idx = item * NT + tid_();
    const int c = idx & 1023, b = (idx >> 10) & 3, dir = idx >> 12;
    float* SA = (float*)(p.ws + WS_LRUS);
    float* SH = SA + 2 * 4 * 68 * 1024;
    const size_t base = ((size_t)(dir * 4 + b) * 68) * 1024 + c;
    float h = 0.f;
#pragma unroll 4
    for (int s = 0; s < 68; ++s) {
        const int cj = dir == 0 ? s : (s < 4 ? 3 - s : 71 - s);
        const float a = SA[base + (size_t)cj * 1024], hl = SH[base + (size_t)cj * 1024];
        SH[base + (size_t)cj * 1024] = h;
        h = a * h + hl;
    }
}

__device__ void gqa_item(const Params& p, int it, unsigned char* lds) {
    const int w = tid_() >> 6;
    const u16* P = (const u16*)(p.ws + WS_P);
    u16* YIN = (u16*)(p.ws + WS_YIN);
    const int hq = (it & 1) * 8 + w, t16 = (it >> 1) & 255, b = it >> 9;
    const int kvh = hq >> 2, t0 = t16 * 16;
    const int ks = (t0 - 128) & ~31;
    const int qrow = b * SEQ + t0;
    u16* vlds = (u16*)lds + w * (32 * 72);
    auto keyfn = [&](int ib, const u16*& kp, const u16*& vp, size_t& kvs) -> bool {
        int row;
        if (ib < 9) { const int k0 = ks + ib * 32; if (k0 < 0 || k0 >= SEQ) return false; row = b * SEQ + k0; }
        else row = NLAT + b * LC + (ib - 9) * 32;
        kp = P + (size_t)row * CD_IN + 1024 + kvh * 64; vp = P + (size_t)row * CD_IN + 1280 + kvh * 64; kvs = CD_IN; return true; };
    auto biasfn = [&](int ib, int qi, int ki) -> float {
        if (ib >= 9) return 0.f;
        const int dq = (t0 + qi) - (ks + ib * 32 + ki);
        return (dq > 128 || dq < -128) ? -INFINITY : 0.f; };
    const float sink = p.gqa_sink[hq];
    attn_wave<64>(P + (size_t)qrow * CD_IN + hq * 64, CD_IN, 17, keyfn, biasfn, 0.125f, sink, ((tid_() & 63) >> 4) == 0 ? 1.f : 0.f, vlds,
                  YIN + (size_t)qrow * D + hq * 64, D);
}

__device__ void phase_l1_stage1(const Params& p, unsigned char* lds) {
    for (int item = bid_(); item < 2176 + 2048; item += gdim_()) {
        if (item < 2176) { const int ci = item % 68, blk = (item / 68) & 7, b = item / (68 * 8); lru_chunk(p, b, blk, ci, 0, lds); }
        else rope_rows(p, (item - 2176) * 8, 8);
    }
}
__device__ void phase_l1_stage2(const Params& p, unsigned char* lds) {
    for (int item = bid_(); item < 16 + 2048; item += gdim_()) {
        if (item < 16) lru_carry(p, item);
        else gqa_item(p, item - 16, lds);
    }
}
__device__ void phase_l1_stage3(const Params& p, unsigned char* lds) {
    for (int item = bid_(); item < 2048; item += gdim_()) { const int cl = item & 63, blk = (item >> 6) & 7, b = item >> 9; lru_chunk(p, b, blk, cl + 4, 1, lds); }
}

__device__ void phase_rowpass_mid(const Params& p, int l, unsigned char* lds) {
    float* R = (float*)lds;
    const int t = tid_(), lane = t & 63, w = t >> 6;
    const int nrows = l == 0 ? NTOK : NLAT;
    __syncthreads();
    for (int i = t; i < D * NEXP; i += NT) { const int k = i >> 4, e = i & 15; R[e * D + k] = p.moe_router[(size_t)l * D * NEXP + i]; }
    __syncthreads();
    const u16* Y = (const u16*)(p.ws + WS_Y);
    float* XL1 = (float*)(p.ws + WS_XL1);
    u16* H = (u16*)(p.ws + WS_H);
    float* AFF = (float*)(p.ws + WS_AFF);
    for (int row = bid_() * 8 + w; row < nrows; row += gdim_() * 8) {
        f32x4 v[8]; float ss = 0.f;
#pragma unroll
        for (int i = 0; i < 8; ++i) { const u32x2 q = *reinterpret_cast<const u32x2*>(Y + (size_t)row * D + (i * 64 + lane) * 4); v[i] = (f32x4){bf_lo(q[0]), bf_hi(q[0]), bf_lo(q[1]), bf_hi(q[1])}; ss += v[i][0] * v[i][0] + v[i][1] * v[i][1] + v[i][2] * v[i][2] + v[i][3] * v[i][3]; }
        ss = wave_sum(ss);
        const float rstd = rsqrtf(ss * (1.f / D) + 1e-6f);
        const float* xr = xin_row(p, l, row);
        const float* g1 = mod_ptr(p, l, row, 2);
        const float* nw = p.norm_mix_post + (size_t)l * D;
        float ss1 = 0.f;
#pragma unroll
        for (int i = 0; i < 8; ++i) {
            const int col = (i * 64 + lane) * 4;
            const f32x4 x4 = *reinterpret_cast<const f32x4*>(xr + col), w4 = *reinterpret_cast<const f32x4*>(nw + col), g4 = *reinterpret_cast<const f32x4*>(g1 + col);
            const f32x4 x1 = x4 + g4 * (v[i] * rstd * w4);
            *reinterpret_cast<f32x4*>(XL1 + (size_t)row * D + col) = x1;
            v[i] = x1; ss1 += x1[0] * x1[0] + x1[1] * x1[1] + x1[2] * x1[2] + x1[3] * x1[3];
        }
        ss1 = wave_sum(ss1);
        const float rstd1 = rsqrtf(ss1 * (1.f / D) + 1e-6f);
        const float* sh = mod_ptr(p, l, row, 3); const float* sc = mod_ptr(p, l, row, 4);
        const float* nw2 = p.norm_ffn_pre + (size_t)l * D;
#pragma unroll
        for (int i = 0; i < 8; ++i) {
            const int col = (i * 64 + lane) * 4;
            const f32x4 w4 = *reinterpret_cast<const f32x4*>(nw2 + col), s4 = *reinterpret_cast<const f32x4*>(sc + col), h4 = *reinterpret_cast<const f32x4*>(sh + col);
            const f32x4 o = v[i] * rstd1 * w4 * (s4 + 1.f) + h4;
            u32x2 pk = {pk_bf16(o[0], o[1]), pk_bf16(o[2], o[3])};
            *reinterpret_cast<u32x2*>(H + (size_t)row * D + col) = pk;
            v[i] = o;
        }
        float lg[16];
#pragma unroll
        for (int e = 0; e < 16; ++e) lg[e] = 0.f;
#pragma unroll
        for (int i = 0; i < 8; ++i) {
#pragma unroll
            for (int e = 0; e < 16; ++e) { const f32x4 r4 = *reinterpret_cast<const f32x4*>(R + e * D + (i * 64 + lane) * 4); lg[e] += v[i][0] * r4[0] + v[i][1] * r4[1] + v[i][2] * r4[2] + v[i][3] * r4[3]; }
        }
        const bool b5 = lane & 32, b4 = lane & 16, b3 = lane & 8, b2 = lane & 4;
        float t8[8], t4[4], t2[2], lgt;
#pragma unroll
        for (int j = 0; j < 8; ++j) { const float keep = b5 ? lg[8 + j] : lg[j], send = b5 ? lg[j] : lg[8 + j]; t8[j] = keep + __shfl_xor(send, 32, 64); }
#pragma unroll
        for (int j = 0; j < 4; ++j) { const float keep = b4 ? t8[4 + j] : t8[j], send = b4 ? t8[j] : t8[4 + j]; t4[j] = keep + __shfl_xor(send, 16, 64); }
#pragma unroll
        for (int j = 0; j < 2; ++j) { const float keep = b3 ? t4[2 + j] : t4[j], send = b3 ? t4[j] : t4[2 + j]; t2[j] = keep + dpp_f<0x140>(send); }
        { const float keep = b2 ? t2[1] : t2[0], send = b2 ? t2[0] : t2[1]; lgt = keep + dpp_f<0x141>(send); }
        lgt += dpp_f<0x4E>(lgt); lgt += dpp_f<0xB1>(lgt);
        const float mx = wave_max(lgt);
        const float pe = __expf(lgt - mx);
        const float den = wave_sum(pe) * 0.25f;
        if ((lane & 3) == 0) AFF[(size_t)row * 16 + ((b5 ? 8 : 0) + (b4 ? 4 : 0) + (b3 ? 2 : 0) + (b2 ? 1 : 0))] = pe / den;
    }
}

__device__ void phase_topk(const Params& p, int l, unsigned char* lds) {
    unsigned* keys = (unsigned*)lds;
    unsigned* hist = keys + 4096;
    unsigned* misc = hist + 256;
    const int t = tid_(), lane = t & 63, w = t >> 6;
    const float* AFF = (const float*)(p.ws + WS_AFF);
    int* SLOT = (int*)(p.ws + WS_SLOT);
    int* EROW = (int*)(p.ws + WS_EROW);
    float* EGATE = (float*)(p.ws + WS_EGATE);
    const int nitems = l == 0 ? 128 : 64;
    for (int item = bid_(); item < nitems; item += gdim_()) {
        const int kind = item >> 6, b = (item >> 4) & 3, ex = item & 15;
        const int n = kind ? LC : SEQ, cap = n / 8, rowbase = kind ? NLAT + b * LC : b * SEQ;
        __syncthreads();
        for (int i = t; i < n; i += NT) keys[i] = __float_as_uint(AFF[(size_t)(rowbase + i) * 16 + ex]);
        unsigned prefix = 0u, mask = 0u; int kth = cap;
        for (int shift = 24; shift >= 0; shift -= 8) {
            __syncthreads();
            if (t < 256) hist[t] = 0u;
            __syncthreads();
            for (int i = t; i < n; i += NT) { const unsigned k = keys[i]; if ((k & mask) == prefix) atomicAdd(&hist[(k >> shift) & 255u], 1u); }
            __syncthreads();
            if (t < 256) {
                unsigned above = 0u;
                for (int d2 = t + 1; d2 < 256; ++d2) above += hist[d2];
                const unsigned here = hist[t];
                if ((int)above < kth && (int)(above + here) >= kth) { misc[0] = (unsigned)t; misc[1] = (unsigned)(kth - (int)above); }
            }
            __syncthreads();
            prefix |= misc[0] << shift; mask |= 255u << shift; kth = (int)misc[1];
        }
        const unsigned T = prefix; const int need_eq = kth;
        int cgt = 0, ceq = 0;
        const int base = t * 8;
        if (base < n) {
#pragma unroll
            for (int q = 0; q < 8; ++q) { const unsigned k = keys[base + q]; cgt += (k > T); ceq += (k == T); }
        }
        int packed = cgt | (ceq << 16);
        int incl = packed;
#pragma unroll
        for (int o = 1; o < 64; o <<= 1) { const int nb = __shfl_up(incl, o, 64); if (lane >= o) incl += nb; }
        __syncthreads();
        if (lane == 63) misc[8 + w] = (unsigned)incl;
        __syncthreads();
        int woff = 0, total = 0;
#pragma unroll
        for (int q = 0; q < 8; ++q) { const int v = (int)misc[8 + q]; if (q < w) woff += v; total += v; }
        const int excl = woff + incl - packed;
        int pgt = excl & 0xffff, peq = excl >> 16;
        const int tot_gt = total & 0xffff;
        const int sbase = kind ? 2048 + b * 32 : b * 512;
        if (base < n) {
#pragma unroll
            for (int q = 0; q < 8; ++q) {
                const unsigned k = keys[base + q];
                const int row = rowbase + base + q;
                int pos = -1;
                if (k > T) { pos = pgt; ++pgt; }
                else if (k == T) { if (peq < need_eq) pos = tot_gt + peq; ++peq; }
                if (pos >= 0) { const int sl = sbase + pos; EROW[ex * EPAD + sl] = row; EGATE[ex * EPAD + sl] = __uint_as_float(k); SLOT[(size_t)row * 16 + ex] = sl; }
                else SLOT[(size_t)row * 16 + ex] = -1;
            }
        }
    }
}

__device__ void phase_final(const Params& p, int l) {
    const int lane = tid_() & 63, w = tid_() >> 6;
    const int nrows = l == 0 ? NTOK : NLAT;
    const u16* YEXP = (const u16*)(p.ws + WS_YEXP);
    const int* SLOT = (const int*)(p.ws + WS_SLOT);
    const float* XL1 = (const float*)(p.ws + WS_XL1);
    float* XL2 = (float*)(p.ws + WS_XL2);
    u16* H = (u16*)(p.ws + WS_H);
    for (int row = bid_() * 8 + w; row < nrows; row += gdim_() * 8) {
        const int myslot = lane < 16 ? SLOT[(size_t)row * 16 + lane] : -1;
        f32x4 xl[8];
#pragma unroll
        for (int i = 0; i < 8; ++i) xl[i] = *reinterpret_cast<const f32x4*>(XL1 + (size_t)row * D + (i * 64 + lane) * 4);
        f32x4 v[8];
#pragma unroll
        for (int i = 0; i < 8; ++i) v[i] = (f32x4){0.f, 0.f, 0.f, 0.f};
        unsigned long long em = __ballot(myslot >= 0);
        while (em) {
            const int e0 = __builtin_ctzll(em); em &= em - 1;
            const bool two = em != 0;
            const int e1 = two ? __builtin_ctzll(em) : e0; if (two) em &= em - 1;
            const int sl0 = __shfl(myslot, e0, 64), sl1 = __shfl(myslot, e1, 64);
            const u16* y0 = YEXP + ((size_t)e0 * EPAD + sl0) * D; const u16* y1 = YEXP + ((size_t)e1 * EPAD + sl1) * D;
            u32x2 q0[8], q1[8];
#pragma unroll
            for (int i = 0; i < 8; ++i) { q0[i] = *reinterpret_cast<const u32x2*>(y0 + (i * 64 + lane) * 4); q1[i] = *reinterpret_cast<const u32x2*>(y1 + (i * 64 + lane) * 4); }
            const float f1 = two ? 1.f : 0.f;
#pragma unroll
            for (int i = 0; i < 8; ++i) {
                v[i][0] += bf_lo(q0[i][0]) + f1 * bf_lo(q1[i][0]); v[i][1] += bf_hi(q0[i][0]) + f1 * bf_hi(q1[i][0]);
                v[i][2] += bf_lo(q0[i][1]) + f1 * bf_lo(q1[i][1]); v[i][3] += bf_hi(q0[i][1]) + f1 * bf_hi(q1[i][1]);
            }
        }
        float ss = 0.f;
#pragma unroll
        for (int i = 0; i < 8; ++i) ss += v[i][0] * v[i][0] + v[i][1] * v[i][1] + v[i][2] * v[i][2] + v[i][3] * v[i][3];
        ss = wave_sum(ss);
        const float rstd = rsqrtf(ss * (1.f / D) + 1e-6f);
        const float* g2 = mod_ptr(p, l, row, 5);
        const float* nw = p.norm_ffn_post + (size_t)l * D;
        float* dst = l == 0 ? XL2 + (size_t)row * D : p.out + (size_t)row * D;
        float ss2 = 0.f;
#pragma unroll
        for (int i = 0; i < 8; ++i) {
            const int col = (i * 64 + lane) * 4;
            const f32x4 x4 = xl[i], w4 = *reinterpret_cast<const f32x4*>(nw + col), g4 = *reinterpret_cast<const f32x4*>(g2 + col);
            const f32x4 x2 = x4 + g4 * (v[i] * rstd * w4);
            *reinterpret_cast<f32x4*>(dst + col) = x2;
            v[i] = x2; ss2 += x2[0] * x2[0] + x2[1] * x2[1] + x2[2] * x2[2] + x2[3] * x2[3];
        }
        if (l == 0) {
            ss2 = wave_sum(ss2);
            const float rstd2 = rsqrtf(ss2 * (1.f / D) + 1e-6f);
            const float* sh = mod_ptr(p, 1, row, 0); const float* sc = mod_ptr(p, 1, row, 1);
            const float* nw1 = p.norm_mix_pre + D;
#pragma unroll
            for (int i = 0; i < 8; ++i) {
                const int col = (i * 64 + lane) * 4;
                const f32x4 w4 = *reinterpret_cast<const f32x4*>(nw1 + col), s4 = *reinterpret_cast<const f32x4*>(sc + col), h4 = *reinterpret_cast<const f32x4*>(sh + col);
                const f32x4 o = v[i] * rstd2 * w4 * (s4 + 1.f) + h4;
                u32x2 pk = {pk_bf16(o[0], o[1]), pk_bf16(o[2], o[3])};
                *reinterpret_cast<u32x2*>(H + (size_t)row * D + col) = pk;
            }
        }
    }
}

__global__ void __launch_bounds__(NT, 2) fwd_kernel(Params p) {
    extern __shared__ __attribute__((aligned(16))) unsigned char lds[];
    unsigned char* wlds = lds + 16;
    if (threadIdx.x == 0) *reinterpret_cast<uint4*>(lds) = make_uint4(0u, 0u, 0u, 0u);
    __syncthreads();
    XcdBarrier bar = xcd_barrier_post((unsigned*)(p.ws + WS_BAR), (volatile LAS unsigned*)lds);
#ifndef PH_MASK
#define PH_MASK 0xFFFFFFFFu
#endif
#ifndef PROBE_REP_MASK
#define PROBE_REP_MASK 0u
#endif
#define PHASE(id, body) do { if (((PH_MASK >> ((id) % 32)) & 1u) && p.ph_lo <= (id) && (id) < p.ph_hi) { \
    for (int _r = 0; _r < ((((unsigned)PROBE_REP_MASK >> ((id) % 32)) & 1u) ? 2 : 1); ++_r) { body; if ((id) + 1 < p.ph_hi || _r == 0) { if ((id) + 1 < p.ph_hi) xcd_barrier(bar); } } } } while (0)
    PHASE(0, { phase_mod(p, wlds); phase_convert_dense(p, wlds); });
    PHASE(1, { phase_norm_mod(p, 0); lru_prep_weights(p); });
#pragma unroll
    for (int l = 0; l < 2; ++l) {
        const int pb = 2 + 10 * l;
        {
            EpiDesc e; e.ob = (u16*)(p.ws + WS_P); e.of = nullptr; e.ldo = l == 0 ? AB_IN : CD_IN; e.gates = l == 0 ? (float*)(p.ws + WS_G) : nullptr; e.rscale = nullptr;
            PHASE(pb + 0, phase_gemm_dense<EPI_BF16>(p, (const u16*)(p.ws + WS_H), NTOK, (const u16*)(p.ws + (l == 0 ? WS_WT_ABIN : WS_WT_CDIN)), l == 0 ? AB_IN : CD_IN, e, wlds));
        }
        if (l == 0) {
            PHASE(pb + 1, phase_mlstm(p, wlds));
            PHASE(pb + 2, phase_l0_stage2(p, wlds));
        } else {
            PHASE(pb + 1, phase_l1_stage1(p, wlds));
            PHASE(pb + 2, phase_l1_stage2(p, wlds));
            PHASE(pb + 3, phase_l1_stage3(p, wlds));
        }
        {
            EpiDesc e; e.ob = (u16*)(p.ws + WS_Y); e.of = nullptr; e.ldo = D; e.gates = nullptr; e.rscale = nullptr;
            PHASE(pb + 4, phase_gemm_dense<EPI_BF16>(p, (const u16*)(p.ws + WS_YIN), l == 0 ? NTOK : NLAT, (const u16*)(p.ws + (l == 0 ? WS_WT_ABOUT : WS_WT_CDOUT)), D, e, wlds));
        }
        PHASE(pb + 5, phase_rowpass_mid(p, l, wlds));
        PHASE(pb + 6, { phase_topk(p, l, wlds); phase_convert_moe(p, l, wlds); });
        PHASE(pb + 7, phase_moe_a(p, l, wlds));
        PHASE(pb + 8, phase_moe_b(p, l, wlds));
        PHASE(pb + 9, phase_final(p, l));
    }
}


#ifdef DBG_STOP
__global__ void dbg_digest(const unsigned char* ws, size_t off, int kind, size_t nelem, float* out, size_t nout) {
    for (size_t i = (size_t)blockIdx.x * blockDim.x + threadIdx.x; i < nout; i += (size_t)gridDim.x * blockDim.x) {
        float v = 0.f;
        for (size_t j = i; j < nelem; j += nout) {
            if (kind == 0) v += bf2f(((const u16*)(ws + off))[j]);
            else if (kind == 1) v += ((const float*)(ws + off))[j];
            else v += (float)((const int*)(ws + off))[j];
        }
        out[i] = v;
    }
}
#endif
extern "C" void kernel_launch(void* const* d_in, const int* in_sizes, int n_in, void* d_out, int out_size, void* d_ws, size_t ws_size, hipStream_t stream) {
    static int grid = 0;
    if (grid == 0) {
        if (n_in != 27 || ws_size < WS_END) { fprintf(stderr, "kernel_launch: unexpected n_in %d / ws %zu (need %zu)\n", n_in, ws_size, (size_t)WS_END); grid = -1; return; }
        int dev = 0, cus = 0, per_cu = 0;
        hipGetDevice(&dev);
        hipDeviceGetAttribute(&cus, hipDeviceAttributeMultiprocessorCount, dev);
        if (hipFuncSetAttribute((const void*)fwd_kernel, hipFuncAttributeMaxDynamicSharedMemorySize, LDS_BYTES) != hipSuccess) { fprintf(stderr, "kernel_launch: hipFuncSetAttribute failed\n"); grid = -1; return; }
        hipOccupancyMaxActiveBlocksPerMultiprocessor(&per_cu, (const void*)fwd_kernel, NT, LDS_BYTES);
        (void)hipGetLastError();
        if (per_cu < 1) fprintf(stderr, "kernel_launch: occupancy query reports %d blocks per CU\n", per_cu);
        grid = cus > 0 ? cus : 256;
    }
    if (grid < 0) return;
    hipMemsetAsync((char*)d_ws + WS_BAR, 0, XCD_BAR_WORDS * sizeof(unsigned), stream);
    Params p; memset(&p, 0, sizeof(p));
    const float** f = (const float**)&p;
    for (int i = 0; i < 27; ++i) f[i] = (const float*)d_in[i];
    p.out = (float*)d_out; p.ws = (unsigned char*)d_ws;
#if N_LAUNCH_MODE == 1
    p.ph_lo = 0; p.ph_hi = NPH;
    hipLaunchKernelGGL(fwd_kernel, dim3(grid), dim3(NT), LDS_BYTES, stream, p);
#else
#ifdef DBG_STOP
    for (int ph = 0; ph <= DBG_STOP; ++ph) { p.ph_lo = ph; p.ph_hi = ph + 1; hipLaunchKernelGGL(fwd_kernel, dim3(grid), dim3(NT), LDS_BYTES, stream, p); }
    hipLaunchKernelGGL(dbg_digest, dim3(2048), dim3(256), 0, stream, (const unsigned char*)d_ws, (size_t)DBG_OFF, (int)DBG_KIND, (size_t)DBG_NELEM, (float*)d_out, (size_t)out_size);
#else
    for (int ph = 0; ph < NPH; ++ph) { p.ph_lo = ph; p.ph_hi = ph + 1; hipLaunchKernelGGL(fwd_kernel, dim3(grid), dim3(NT), LDS_BYTES, stream, p); }
#endif
#endif
}
```

```cpp
#include <hip/hip_runtime.h>
#include <stdint.h>
#include <stdio.h>
#include <string.h>

#ifndef N_LAUNCH_MODE
#define N_LAUNCH_MODE 1
#endif

typedef unsigned short u16;
typedef short bf16x8 __attribute__((ext_vector_type(8)));
typedef float f32x4 __attribute__((ext_vector_type(4)));
typedef unsigned u32x4 __attribute__((ext_vector_type(4)));
typedef unsigned u32x2 __attribute__((ext_vector_type(2)));

#define NT 512
constexpr int D = 2048, BATCH = 4, SEQ = 4096, LC = 256;
constexpr int NLAT = BATCH * SEQ, NCTX = BATCH * LC, NTOK = NLAT + NCTX;
constexpr int AB_IN = 7184, CD_IN = 3584;
constexpr int NEXP = 16, FF = 2048, EPAD = 2304;
constexpr int NPH = 22;
constexpr int LDS_BYTES = 150 * 1024;

constexpr size_t al256(size_t x) { return (x + 255) & ~(size_t)255; }
constexpr size_t WS_BAR = 0;
constexpr size_t WS_MOD = 16384;
constexpr size_t WS_XL1 = al256(WS_MOD + 2 * 5 * 12288 * 4);
constexpr size_t WS_XL2 = al256(WS_XL1 + (size_t)NTOK * D * 4);
constexpr size_t WS_H = al256(WS_XL2 + (size_t)NTOK * D * 4);
constexpr size_t WS_P = al256(WS_H + (size_t)NTOK * D * 2);
constexpr size_t WS_G = al256(WS_P + (size_t)NTOK * AB_IN * 2);
constexpr size_t WS_HM = al256(WS_G + (size_t)NTOK * 16 * 4);
constexpr size_t WS_YIN = al256(WS_HM + (size_t)2 * NTOK * 1024 * 2);
constexpr size_t WS_Y = al256(WS_YIN + (size_t)NTOK * D * 2);
constexpr size_t WS_AFF = al256(WS_Y + (size_t)NTOK * D * 4);
constexpr size_t WS_SLOT = al256(WS_AFF + (size_t)NTOK * 16 * 4);
constexpr size_t WS_EROW = al256(WS_SLOT + (size_t)NTOK * 16 * 4);
constexpr size_t WS_EGATE = al256(WS_EROW + (size_t)NEXP * EPAD * 4);
constexpr size_t WS_ACT = al256(WS_EGATE + (size_t)NEXP * EPAD * 4);
constexpr size_t WS_YEXP = al256(WS_ACT + (size_t)NEXP * EPAD * FF * 2);
constexpr size_t WS_LRUS = al256(WS_YEXP + (size_t)NEXP * EPAD * D * 2);
constexpr size_t WS_LRUW = al256(WS_LRUS + (size_t)2 * 2 * 4 * 68 * 1024 * 4);
constexpr size_t WS_WT_ABIN = al256(WS_LRUW + (size_t)32 * 128 * 128 * 2);
constexpr size_t WS_WT_ABOUT = al256(WS_WT_ABIN + (size_t)AB_IN * D * 2);
constexpr size_t WS_WT_CDIN = al256(WS_WT_ABOUT + (size_t)D * D * 2);
constexpr size_t WS_WT_CDOUT = al256(WS_WT_CDIN + (size_t)CD_IN * D * 2);
constexpr size_t WS_WT_W1 = al256(WS_WT_CDOUT + (size_t)D * D * 2);
constexpr size_t WS_WT_W3 = al256(WS_WT_W1 + (size_t)NEXP * D * FF * 2);
constexpr size_t WS_WT_W2 = al256(WS_WT_W3 + (size_t)NEXP * D * FF * 2);
constexpr size_t WS_END = al256(WS_WT_W2 + (size_t)NEXP * D * FF * 2);

struct Params {
    const float *x, *c, *ctx, *c_ctx, *ada_w, *ada_b, *norm_mix_pre, *norm_mix_post, *norm_ffn_pre, *norm_ffn_post;
    const float *ab_w_in, *ab_w_out, *mlstm_gate_b, *mlstm_norm, *na_rpb;
    const float *cd_w_in, *cd_w_out, *gqa_sink, *lru_conv_w, *lru_conv_b, *lru_gate_w, *lru_gate_b, *lru_lambda;
    const float *moe_router, *moe_w1, *moe_w3, *moe_w2;
    float* out;
    unsigned char* ws;
    int ph_lo, ph_hi;
};

#define XB_TMO      128
#define XB_XCNT(j)  (256  + 64 * (j))
#define XB_XSUB(j)  (1280 + 64 * (j))
#define XB_XGEN(j)  (2304 + 64 * (j))
#define XB_TOP      3328
#define XB_TOPGEN   3392
#define XCD_BAR_WORDS 3456
#define XB_SPIN_CAP (1u << 22)
#define LAS __attribute__((address_space(3)))

__device__ __forceinline__ unsigned xb_ld(unsigned* p)              { return __hip_atomic_load(p, __ATOMIC_RELAXED, __HIP_MEMORY_SCOPE_AGENT); }
__device__ __forceinline__ unsigned xb_add(unsigned* p, unsigned v) { return __hip_atomic_fetch_add(p, v, __ATOMIC_RELAXED, __HIP_MEMORY_SCOPE_AGENT); }
__device__ __forceinline__ unsigned xb_xcc_id() { return (unsigned)__builtin_amdgcn_s_getreg((3 << 11) | 20) & 0xFu; }
#define XB_SPIN(cond, bar) do { unsigned _sp = 0; while (cond) { __builtin_amdgcn_s_sleep(1); \
    if ((++_sp & 255u) == 0u) { if (xb_ld(&(bar)[XB_TMO])) break; if (_sp > XB_SPIN_CAP) { atomicAdd(&(bar)[XB_TMO], 1u); break; } } } } while (0)

struct XcdBarrier {
    unsigned* bar; unsigned x;
    volatile LAS unsigned* st;
};
__device__ __forceinline__ XcdBarrier xcd_barrier_post(unsigned* bar, volatile LAS unsigned* st) {
    XcdBarrier b; b.bar = bar; b.x = xb_xcc_id(); b.st = st;
    if (threadIdx.x == 0) (void)xb_add(&bar[XB_XCNT(b.x)], 1u);
    return b;
}
__device__ __forceinline__ void xcd_barrier_complete(unsigned* bar, unsigned x, unsigned& nloc, unsigned& nx) {
    const unsigned G = gridDim.x * gridDim.y * gridDim.z;
    unsigned sum, cnt, mine, sp = 0u;
    for (;;) {
        sum = 0u; cnt = 0u; mine = 0u;
#pragma unroll
        for (unsigned j = 0; j < 16; ++j) { const unsigned c = xb_ld(&bar[XB_XCNT(j)]); sum += c; cnt += (c > 0u) ? 1u : 0u; mine = (j == x) ? c : mine; }
        if (sum == G) break;
        __builtin_amdgcn_s_sleep(1);
        if ((++sp & 255u) == 0u) { if (xb_ld(&bar[XB_TMO])) break; if (sp > XB_SPIN_CAP) { atomicAdd(&bar[XB_TMO], 1u); break; } }
    }
    nloc = mine > 0u ? mine : 1u; nx = cnt > 0u ? cnt : 1u;
}
__device__ __forceinline__ void xcd_barrier(const XcdBarrier& b) {
    asm volatile("s_waitcnt vmcnt(0)" ::: "memory");
    __syncthreads();
    if (threadIdx.x == 0) {
        unsigned* bar = b.bar;
        __builtin_amdgcn_s_waitcnt(0);
        unsigned nloc = b.st[0], nx = b.st[1];
        if (nloc == 0u) { xcd_barrier_complete(bar, b.x, nloc, nx); b.st[0] = nloc; b.st[1] = nx; }
        const unsigned old = xb_add(&bar[XB_XSUB(b.x)], 1u);
        const unsigned gen = old / nloc;
        if (old + 1u == (gen + 1u) * nloc) {
            __builtin_amdgcn_fence(__ATOMIC_RELEASE, "agent");
            asm volatile("s_waitcnt vmcnt(0)" ::: "memory");
            const unsigned og = xb_add(&bar[XB_TOP], 1u);
            const unsigned tg = og / nx;
            if (og + 1u == (tg + 1u) * nx) xb_add(&bar[XB_TOPGEN], 1u);
            else XB_SPIN(xb_ld(&bar[XB_TOPGEN]) == tg, bar);
            __builtin_amdgcn_fence(__ATOMIC_ACQUIRE, "agent");
            xb_add(&bar[XB_XGEN(b.x)], 1u);
            asm volatile("s_waitcnt vmcnt(0)" ::: "memory");
        } else {
            XB_SPIN(xb_ld(&bar[XB_XGEN(b.x)]) == gen, bar);
            __builtin_amdgcn_fence(__ATOMIC_ACQUIRE, "agent");
            asm volatile("s_waitcnt vmcnt(0)" ::: "memory");
        }
    }
    __syncthreads();
}

typedef float f32x2_t __attribute__((ext_vector_type(2)));
typedef __bf16 bf16x2_t __attribute__((ext_vector_type(2)));
__device__ __forceinline__ unsigned pk_bf16(float lo, float hi) { f32x2_t v = {lo, hi}; return __builtin_bit_cast(unsigned, __builtin_convertvector(v, bf16x2_t)); }
__device__ __forceinline__ float bf_lo(unsigned u) { return __uint_as_float(u << 16); }
__device__ __forceinline__ float bf_hi(unsigned u) { return __uint_as_float(u & 0xffff0000u); }
__device__ __forceinline__ float bf2f(u16 v) { return __uint_as_float(((unsigned)v) << 16); }
__device__ __forceinline__ u16 f2bf(float f) { return (u16)(pk_bf16(f, 0.f) & 0xffffu); }
template <int CTRL> __device__ __forceinline__ float dpp_f(float v) { return __uint_as_float((unsigned)__builtin_amdgcn_update_dpp(0, (int)__float_as_uint(v), CTRL, 0xf, 0xf, true)); }
__device__ __forceinline__ float row_sum16(float v) { v += dpp_f<0xB1>(v); v += dpp_f<0x4E>(v); v += dpp_f<0x141>(v); v += dpp_f<0x140>(v); return v; }
__device__ __forceinline__ float row_max16(float v) { v = fmaxf(v, dpp_f<0xB1>(v)); v = fmaxf(v, dpp_f<0x4E>(v)); v = fmaxf(v, dpp_f<0x141>(v)); v = fmaxf(v, dpp_f<0x140>(v)); return v; }
__device__ __forceinline__ float rdlane_f(float v, int l) { return __uint_as_float((unsigned)__builtin_amdgcn_readlane((int)__float_as_uint(v), l)); }
__device__ __forceinline__ float sum_x16(float v) { const auto r = __builtin_amdgcn_permlane16_swap(__float_as_uint(v), __float_as_uint(v), false, false); return __uint_as_float(r[0]) + __uint_as_float(r[1]); }
__device__ __forceinline__ float sum_x32(float v) { const auto r = __builtin_amdgcn_permlane32_swap(__float_as_uint(v), __float_as_uint(v), false, false); return __uint_as_float(r[0]) + __uint_as_float(r[1]); }
__device__ __forceinline__ float max_x16(float v) { const auto r = __builtin_amdgcn_permlane16_swap(__float_as_uint(v), __float_as_uint(v), false, false); return fmaxf(__uint_as_float(r[0]), __uint_as_float(r[1])); }
__device__ __forceinline__ float max_x32(float v) { const auto r = __builtin_amdgcn_permlane32_swap(__float_as_uint(v), __float_as_uint(v), false, false); return fmaxf(__uint_as_float(r[0]), __uint_as_float(r[1])); }
__device__ __forceinline__ float partner_x16(float v) { const auto r = __builtin_amdgcn_permlane16_swap(__float_as_uint(v), __float_as_uint(v), false, false); return __uint_as_float(r[0] ^ r[1] ^ __float_as_uint(v)); }
__device__ __forceinline__ float partner_x32(float v) { const auto r = __builtin_amdgcn_permlane32_swap(__float_as_uint(v), __float_as_uint(v), false, false); return __uint_as_float(r[0] ^ r[1] ^ __float_as_uint(v)); }
__device__ __forceinline__ float wave_sum(float v) { return sum_x32(sum_x16(row_sum16(v))); }
__device__ __forceinline__ float wave_max(float v) { return max_x32(max_x16(row_max16(v))); }
__device__ __forceinline__ int tid_() { int t = threadIdx.x; asm volatile("" : "+v"(t)); return t; }
__device__ __forceinline__ int bid_() { int b = blockIdx.x; asm volatile("" : "+s"(b)); return b; }
__device__ __forceinline__ int gdim_() { int b = gridDim.x; asm volatile("" : "+s"(b)); return b; }
__device__ __forceinline__ float frcp_(float x) { return __builtin_amdgcn_rcpf(x); }
__device__ __forceinline__ float sigmoidf_(float x) { return frcp_(1.f + __expf(-x)); }
__device__ __forceinline__ f32x4 mfma16(bf16x8 a, bf16x8 b, f32x4 c) { return __builtin_amdgcn_mfma_f32_16x16x32_bf16(a, b, c, 0, 0, 0); }
__device__ __forceinline__ bf16x8 ld_frag_g(const u16* p) { return *reinterpret_cast<const bf16x8*>(p); }
__device__ __forceinline__ bf16x8 ld_frag_s(const u16* p) { return *reinterpret_cast<const bf16x8*>(p); }
__device__ __forceinline__ bf16x8 mk_frag(unsigned a, unsigned b, unsigned c, unsigned d) { u32x4 v = {a, b, c, d}; return __builtin_bit_cast(bf16x8, v); }

__device__ __forceinline__ const float* xin_row(const Params& p, int l, int row) {
    if (l == 0) return row < NLAT ? p.x + (size_t)row * D : p.ctx + (size_t)(row - NLAT) * D;
    return (const float*)(p.ws + WS_XL2) + (size_t)row * D;
}
__device__ __forceinline__ const float* mod_ptr(const Params& p, int l, int row, int chunk) {
    const int bb = row < NLAT ? (row >> 12) : 4;
    return (const float*)(p.ws + WS_MOD) + ((size_t)(l * 5 + bb) * 6 + chunk) * D;
}

__device__ void phase_mod(const Params& p, unsigned char* lds_raw) {
    float* scond = (float*)lds_raw;
    float* red = scond + 5 * D;
    const int t = tid_();
    for (int i = t; i < 5 * D; i += NT) { const int r = i >> 11, k = i & 2047; const float v = r < 4 ? p.c[r * D + k] : p.c_ctx[k]; scond[i] = v / (1.f + __expf(-v)); }
    __syncthreads();
    float* mod = (float*)(p.ws + WS_MOD);
    for (int item = bid_(); item < 192; item += gdim_()) {
        const int l = item / 96, col0 = (item % 96) * 128;
        const int kg = t >> 5, cl = (t & 31) * 4;
        f32x4 acc[5];
#pragma unroll
        for (int r = 0; r < 5; ++r) acc[r] = (f32x4){0.f, 0.f, 0.f, 0.f};
        const float* wp = p.ada_w + ((size_t)l * D + kg * 128) * (6 * D) + col0 + cl;
#pragma unroll 8
        for (int kk = 0; kk < 128; ++kk) {
            const f32x4 w = *reinterpret_cast<const f32x4*>(wp + (size_t)kk * (6 * D));
#pragma unroll
            for (int r = 0; r < 5; ++r) { const float s = scond[r * D + kg * 128 + kk]; acc[r] += w * s; }
        }
#pragma unroll
        for (int r = 0; r < 5; ++r) *reinterpret_cast<f32x4*>(red + (kg * 5 + r) * 128 + cl) = acc[r];
        __syncthreads();
        for (int o = t; o < 640; o += NT) {
            const int r = o >> 7, cc = o & 127;
            float s = p.ada_b[l * 6 * D + col0 + cc];
#pragma unroll
            for (int g = 0; g < 16; ++g) s += red[(g * 5 + r) * 128 + cc];
            mod[(size_t)(l * 5 + r) * 6 * D + col0 + cc] = s;
        }
        __syncthreads();
    }
}

__device__ void phase_norm_mod(const Params& p, int l) {
    const int lane = tid_() & 63, w = tid_() >> 6;
    u16* H = (u16*)(p.ws + WS_H);
    for (int row = bid_() * 8 + w; row < NTOK; row += gdim_() * 8) {
        const float* xr = xin_row(p, l, row);
        f32x4 v[8]; float ss = 0.f;
#pragma unroll
        for (int i = 0; i < 8; ++i) { v[i] = *reinterpret_cast<const f32x4*>(xr + (i * 64 + lane) * 4); ss += v[i][0] * v[i][0] + v[i][1] * v[i][1] + v[i][2] * v[i][2] + v[i][3] * v[i][3]; }
        ss = wave_sum(ss);
        const float rstd = rsqrtf(ss * (1.f / D) + 1e-6f);
        const float* sh = mod_ptr(p, l, row, 0); const float* sc = mod_ptr(p, l, row, 1);
        const float* nw = p.norm_mix_pre + (size_t)l * D;
#pragma unroll
        for (int i = 0; i < 8; ++i) {
            const int col = (i * 64 + lane) * 4;
            const f32x4 w4 = *reinterpret_cast<const f32x4*>(nw + col), s4 = *reinterpret_cast<const f32x4*>(sc + col), h4 = *reinterpret_cast<const f32x4*>(sh + col);
            f32x4 o = v[i] * rstd * w4 * (s4 + 1.f) + h4;
            u32x2 pk = {pk_bf16(o[0], o[1]), pk_bf16(o[2], o[3])};
            *reinterpret_cast<u32x2*>(H + (size_t)row * D + col) = pk;
        }
    }
}

__device__ __forceinline__ void convert_item(const float* W, int N, u16* Wt, int kb, int nb, unsigned char* lds) {
    const int t = tid_(), lane = t & 63, w = t >> 6;
    const int n4 = lane * 4, k0 = kb * 64 + w * 8, n0 = nb * 256;
    int col = n0 + n4; if (col > N - 4) col = N - 4;
    f32x4 r8[8];
#pragma unroll
    for (int j = 0; j < 8; ++j) r8[j] = *reinterpret_cast<const f32x4*>(W + (size_t)(k0 + j) * N + col);
    __syncthreads();
#pragma unroll
    for (int jj = 0; jj < 4; ++jj) {
        u32x4 v = {pk_bf16(r8[0][jj], r8[1][jj]), pk_bf16(r8[2][jj], r8[3][jj]), pk_bf16(r8[4][jj], r8[5][jj]), pk_bf16(r8[6][jj], r8[7][jj])};
        const int r = n4 + jj;
        *reinterpret_cast<u32x4*>(lds + r * 128 + ((w ^ ((r >> 2) & 7)) << 4)) = v;
    }
    __syncthreads();
    const int c = t & 7;
#pragma unroll
    for (int i = 0; i < 4; ++i) {
        const int r = (t >> 3) + 64 * i;
        if (n0 + r < N) {
            const u32x4 v = *reinterpret_cast<const u32x4*>(lds + r * 128 + ((c ^ ((r >> 2) & 7)) << 4));
            *reinterpret_cast<u32x4*>(Wt + (size_t)(n0 + r) * 2048 + ((kb * 64 + c * 8 + 64 * ((n0 + r) & 31)) & 2047)) = v;
        }
    }
}
__device__ void convert_matrix_items(const float* W, int N, u16* Wt, int first, int count, unsigned char* lds) {
    const int nnb = (N + 255) / 256;
    for (int it = first; it < first + count; ++it) convert_item(W, N, Wt, it / nnb, it % nnb, lds);
}
__device__ void phase_convert_dense(const Params& p, unsigned char* lds) {
    for (int item = bid_(); item < 1888; item += gdim_()) {
        if (item < 928) convert_item(p.ab_w_in, AB_IN, (u16*)(p.ws + WS_WT_ABIN), item / 29, item % 29, lds);
        else if (item < 1184) { const int it = item - 928; convert_item(p.ab_w_out, D, (u16*)(p.ws + WS_WT_ABOUT), it / 8, it % 8, lds); }
        else if (item < 1632) { const int it = item - 1184; convert_item(p.cd_w_in, CD_IN, (u16*)(p.ws + WS_WT_CDIN), it / 14, it % 14, lds); }
        else { const int it = item - 1632; convert_item(p.cd_w_out, D, (u16*)(p.ws + WS_WT_CDOUT), it / 8, it % 8, lds); }
    }
}
__device__ void phase_convert_moe(const Params& p, int l, unsigned char* lds) {
    for (int item = bid_(); item < 3 * NEXP * 256; item += gdim_()) {
        const int which = item / (NEXP * 256), r = item % (NEXP * 256), ex = r >> 8, it = r & 255;
        const float* src = (which == 0 ? p.moe_w1 : (which == 1 ? p.moe_w3 : p.moe_w2)) + (size_t)(l * NEXP + ex) * D * FF;
        u16* dst = (u16*)(p.ws + (which == 0 ? WS_WT_W1 : (which == 1 ? WS_WT_W3 : WS_WT_W2))) + (size_t)ex * D * FF;
        convert_item(src, 2048, dst, it >> 3, it & 7, lds);
    }
}

struct GemmDesc {
    const u16* A; int lda; const int* arow; int mvalid; int m0;
    const u16* B0; const u16* B1; int n0; int ncols;
    int K;
};
enum { EPI_BF16 = 0, EPI_F32 = 1, EPI_SWIGLU = 2, EPI_SCALE = 3 };
struct EpiDesc { u16* ob; float* of; int ldo; float* gates; const float* rscale; };
constexpr int GEMM_BUF = 65536, GEMM_BOFF = 32768;

template <int EPI>
__device__ __forceinline__ void gemm_tile(const GemmDesc& g, const EpiDesc& e, unsigned char* lds) {
    const int t = tid_(), lane = t & 63, w = t >> 6;
    const int wr = w >> 2, wc = w & 3, fr = lane & 15, fq = lane >> 4;
    const int ac = t & 7, ar = t >> 3;
    const int kofs = (ac ^ ((ar >> 1) & 7)) << 3;
    unsigned ap[4], bpo[4];
#pragma unroll
    for (int i = 0; i < 4; ++i) {
        int r = g.m0 + ar + 64 * i; if (r >= g.mvalid) r = g.mvalid - 1;
        const int src = g.arow ? g.arow[r] : r;
        ap[i] = ((unsigned)src * 2048u + kofs) * 2u;
        const int np = ar + 64 * i;
        const int rho = np & 31, pcol = 8 * ((rho & 15) >> 2) + 4 * (rho >> 4) + (rho & 3);
        if (EPI == EPI_SWIGLU) {
            const int which = (np >> 5) & 1, ffl = (np >> 6) * 32 + pcol;
            bpo[i] = ((unsigned)(g.n0 + ffl) * 2048u) * 2u + (which ? (unsigned)(WS_WT_W3 - WS_WT_W1) : 0u);
        } else {
            int n = g.n0 + (np & ~31) + pcol; if (n >= g.ncols) n = g.ncols - 1;
            bpo[i] = ((unsigned)n * 2048u) * 2u;
        }
    }
    const int d_off = t * 16;
    const int s0 = (fr >> 1) & 7;
    const int a_rd0 = wr * 16384 + fr * 128 + ((fq ^ s0) << 4), a_rd1 = a_rd0 ^ 64;
    const int b_rd0 = GEMM_BOFF + wc * 8192 + fr * 128 + ((fq ^ s0) << 4), b_rd1 = b_rd0 ^ 64;

    f32x4 acc[8][4];
#pragma unroll
    for (int i = 0; i < 8; ++i)
#pragma unroll
        for (int j = 0; j < 4; ++j) acc[i][j] = (f32x4){0.f, 0.f, 0.f, 0.f};

    constexpr int nk = 2048 >> 6;
    const unsigned brot = (unsigned)(kofs * 2 + (8 * (((ar & 31) & 15) >> 2) + 4 * ((ar & 31) >> 4) + (ar & 3)) * 128);
#define G_DMA(BUF, KT) do { const unsigned _k = (unsigned)(KT) << 7; \
    const unsigned char* _ab = (const unsigned char*)g.A + _k; const unsigned char* _bb = (const unsigned char*)g.B0; \
    asm volatile("" : "+s"(_ab), "+s"(_bb));     \
    const unsigned _kb = (_k + brot) & 4095u; \
    _Pragma("unroll") for (int i = 0; i < 4; ++i) __builtin_amdgcn_global_load_lds((const unsigned*)(_ab + ap[i]), (unsigned*)((BUF) + d_off + i * 8192), 16, 0, 0); \
    _Pragma("unroll") for (int i = 0; i < 4; ++i) __builtin_amdgcn_global_load_lds((const unsigned*)(_bb + (bpo[i] + _kb)), (unsigned*)((BUF) + GEMM_BOFF + d_off + i * 8192), 16, 0, 0); } while (0)
    G_DMA(lds, 0);
    for (int kt = 0; kt < nk; ++kt) {
        unsigned char* buf = lds + (kt & 1) * GEMM_BUF;
        asm volatile("s_waitcnt vmcnt(0)" ::: "memory");
        __syncthreads();
        if (kt + 1 < nk) G_DMA(lds + ((kt + 1) & 1) * GEMM_BUF, kt + 1);
#define RD_A(KK, MI) (*reinterpret_cast<const bf16x8*>(buf + (((KK) ? a_rd1 : a_rd0) + (MI) * 2048)))
#define RD_B(KK, NI) (*reinterpret_cast<const bf16x8*>(buf + (((KK) ? b_rd1 : b_rd0) + (NI) * 2048)))
        bf16x8 bq[2][4], aq[2][2];
#pragma unroll
        for (int ni = 0; ni < 4; ++ni) bq[0][ni] = RD_B(0, ni);
        aq[0][0] = RD_A(0, 0); aq[0][1] = RD_A(0, 1);
#define G_STEP(ST) do { \
        constexpr int kk = (ST) >> 2, pr = (ST) & 3, cur = (ST) & 1, nxt = cur ^ 1, nkk = ((ST) + 1) >> 2, npr = ((ST) + 1) & 3; \
        if ((ST) < 7) { \
            if (npr == 0) { _Pragma("unroll") for (int ni = 0; ni < 4; ++ni) bq[nkk & 1][ni] = RD_B(nkk & 1, ni); } \
            aq[nxt][0] = RD_A(nkk & 1, npr * 2); aq[nxt][1] = RD_A(nkk & 1, npr * 2 + 1); } \
        _Pragma("unroll") for (int h2 = 0; h2 < 2; ++h2) \
            _Pragma("unroll") for (int ni = 0; ni < 4; ++ni) acc[pr * 2 + h2][ni] = mfma16(bq[kk][ni], aq[cur][h2], acc[pr * 2 + h2][ni]); \
        __builtin_amdgcn_sched_group_barrier(0x100, ((ST) < 7) ? (npr == 0 ? 6 : 2) : 0, 0); \
        __builtin_amdgcn_sched_group_barrier(0x008, 8, 0); } while (0)
        G_STEP(0); G_STEP(1); G_STEP(2); G_STEP(3); G_STEP(4); G_STEP(5); G_STEP(6); G_STEP(7);
#undef G_STEP
#undef RD_A
#undef RD_B
    }
#undef G_DMA
#pragma unroll
    for (int mi = 0; mi < 8; ++mi) {
        const int row = g.m0 + wr * 128 + mi * 16 + fr;
        if (row < g.mvalid) {
            if (EPI == EPI_BF16 || EPI == EPI_F32) {
#pragma unroll
                for (int gq = 0; gq < 2; ++gq) {
                    const int col = g.n0 + wc * 64 + gq * 32 + 8 * fq;
                    if (col < g.ncols) {
                        const f32x4 v0 = acc[mi][2 * gq], v1 = acc[mi][2 * gq + 1];
                        u32x4 pk = {pk_bf16(v0[0], v0[1]), pk_bf16(v0[2], v0[3]), pk_bf16(v1[0], v1[1]), pk_bf16(v1[2], v1[3])};
                        *reinterpret_cast<u32x4*>(e.ob + (size_t)row * e.ldo + col) = pk;
                        if (e.gates && col >= 4096 && col < 4112) { *reinterpret_cast<f32x4*>(e.gates + (size_t)row * 16 + (col - 4096)) = v0; *reinterpret_cast<f32x4*>(e.gates + (size_t)row * 16 + (col - 4096) + 4) = v1; }
                    }
                }
            } else if (EPI == EPI_SWIGLU) {
                const int col = g.n0 + wc * 32 + 8 * fq;
                float a[8];
#pragma unroll
                for (int ni = 0; ni < 2; ++ni)
#pragma unroll
                    for (int q = 0; q < 4; ++q) { const float u = acc[mi][ni][q]; a[ni * 4 + q] = u * frcp_(1.f + __expf(-u)) * acc[mi][ni + 2][q]; }
                u32x4 pk = {pk_bf16(a[0], a[1]), pk_bf16(a[2], a[3]), pk_bf16(a[4], a[5]), pk_bf16(a[6], a[7])};
                *reinterpret_cast<u32x4*>(e.ob + (size_t)row * e.ldo + col) = pk;
            } else {
                const float sc = e.rscale[row];
#pragma unroll
                for (int gq = 0; gq < 2; ++gq) {
                    const int col = g.n0 + wc * 64 + gq * 32 + 8 * fq;
                    const f32x4 v0 = acc[mi][2 * gq] * sc, v1 = acc[mi][2 * gq + 1] * sc;
                    u32x4 pk = {pk_bf16(v0[0], v0[1]), pk_bf16(v0[2], v0[3]), pk_bf16(v1[0], v1[1]), pk_bf16(v1[2], v1[3])};
                    *reinterpret_cast<u32x4*>(e.ob + (size_t)row * e.ldo + col) = pk;
                }
            }
        }
    }
    __syncthreads();
}

template <int EPI>
__device__ void phase_gemm_dense(const Params& p, const u16* A, int M, const u16* Wt, int N, EpiDesc e, unsigned char* lds) {
    const int nM = M / 256, nN = (N + 255) / 256, L = nM * nN;
    const int xcd = bid_() & 7, slot = bid_() >> 3, nslot = gdim_() >> 3;
    const int base = (int)(((long)L * xcd) >> 3), cnt = (int)(((long)L * (xcd + 1)) >> 3) - base;
    const int G8 = nM >> 3, rem = nM & 7;
    for (int k = slot; k < cnt; k += nslot) {
        const int idx = base + k;
        int pn, pm;
        if (idx < G8 * 8 * nN) { const int gq = idx / (8 * nN), r = idx % (8 * nN); pn = r >> 3; pm = gq * 8 + (r & 7); }
        else { const int r = idx - G8 * 8 * nN; pn = r / rem; pm = G8 * 8 + r % rem; }
        GemmDesc g; g.A = A; g.lda = D; g.arow = nullptr; g.mvalid = M; g.m0 = pm * 256;
        g.B0 = Wt; g.B1 = nullptr; g.n0 = pn * 256; g.ncols = N; g.K = D;
        gemm_tile<EPI>(g, e, lds);
    }
}

__device__ void phase_moe_a(const Params& p, int l, unsigned char* lds) {
    const int mvalid = l == 0 ? 2176 : 2048, nM = l == 0 ? 9 : 8;
    const int per_e = nM * 16;
    const int xcd = bid_() & 7, slot = bid_() >> 3, nslot = gdim_() >> 3;
    for (int k = slot; k < 2 * per_e; k += nslot) {
        const int tile = xcd * 2 * per_e + k;
        const int ex = tile / per_e, r = tile % per_e, pn = r / nM, pm = r % nM;
        GemmDesc g; g.A = (const u16*)(p.ws + WS_H); g.lda = D; g.arow = (const int*)(p.ws + WS_EROW) + ex * EPAD; g.mvalid = mvalid; g.m0 = pm * 256;
        g.B0 = (const u16*)(p.ws + WS_WT_W1) + (size_t)ex * D * FF; g.B1 = (const u16*)(p.ws + WS_WT_W3) + (size_t)ex * D * FF; g.n0 = pn * 128; g.ncols = FF; g.K = D;
        EpiDesc e; e.ob = (u16*)(p.ws + WS_ACT) + (size_t)ex * EPAD * FF; e.of = nullptr; e.ldo = FF; e.gates = nullptr; e.rscale = nullptr;
        gemm_tile<EPI_SWIGLU>(g, e, lds);
    }
}
__device__ void phase_moe_b(const Params& p, int l, unsigned char* lds) {
    const int mvalid = l == 0 ? 2176 : 2048, nM = l == 0 ? 9 : 8;
    const int per_e = nM * 8;
    const int xcd = bid_() & 7, slot = bid_() >> 3, nslot = gdim_() >> 3;
    for (int k = slot; k < 2 * per_e; k += nslot) {
        const int tile = xcd * 2 * per_e + k;
        const int ex = tile / per_e, r = tile % per_e, pn = r / nM, pm = r % nM;
        GemmDesc g; g.A = (const u16*)(p.ws + WS_ACT) + (size_t)ex * EPAD * FF; g.lda = FF; g.arow = nullptr; g.mvalid = mvalid; g.m0 = pm * 256;
        g.B0 = (const u16*)(p.ws + WS_WT_W2) + (size_t)ex * D * FF; g.B1 = nullptr; g.n0 = pn * 256; g.ncols = D; g.K = FF;
        EpiDesc e; e.ob = (u16*)(p.ws + WS_YEXP) + (size_t)ex * EPAD * D; e.of = nullptr; e.ldo = D; e.gates = nullptr; e.rscale = (const float*)(p.ws + WS_EGATE) + ex * EPAD;
        gemm_tile<EPI_SCALE>(g, e, lds);
    }
}

__device__ __forceinline__ int mlstm_row(int b, int dir, int pos) {
    if (pos < LC) return NLAT + b * LC + (dir ? (LC - 1 - pos) : pos);
    const int q = pos - LC; return b * SEQ + (dir ? (SEQ - 1 - q) : q);
}
__device__ void phase_mlstm(const Params& p, unsigned char* lds) {
    u16* KT = (u16*)lds;
    u16* VT = KT + 256 * 72;
    u16* VWT = VT + 48 * 72;
    u16* CT = VWT + 48 * 72;
    u16* Ss = CT + 48 * 264;
    float* gB = (float*)(Ss + 64 * 72);
    float* gI = gB + 68 * 64;
    float* gP = gI + 68 * 64;
    float* gE = gP + 68 * 64;
    const int t = tid_(), lane = t & 63, w = t >> 6, fr = lane & 15, fq = lane >> 4;
    const u16* P = (const u16*)(p.ws + WS_P);
    const float* G = (const float*)(p.ws + WS_G);
    u16* HM = (u16*)(p.ws + WS_HM);
    for (int item = bid_(); item < 256; item += gdim_()) {
        const int vs = item & 7, dir = (item >> 3) & 1, hh = (item >> 4) & 3, b = item >> 6;
        __syncthreads();
        for (int i = t; i < 48 * 264; i += NT) CT[i] = 0;
        for (int i = t; i < 16 * 72; i += NT) { const int er = i / 72; VT[32 * 72 + i] = (er == 0) ? (u16)0x3f80 : (u16)0; VWT[32 * 72 + i] = 0; }
        {
            const float gb_i = p.mlstm_gate_b[(dir * 2 + 0) * 4 + hh], gb_f = p.mlstm_gate_b[(dir * 2 + 1) * 4 + hh];
            for (int ch = w; ch < 68; ch += 8) {
                const int row = mlstm_row(b, dir, ch * 64 + lane);
                const float gi = G[(size_t)row * 16 + dir * 8 + hh] + gb_i;
                const float gf = G[(size_t)row * 16 + dir * 8 + 4 + hh] + gb_f;
                const float lf = fminf(gf, 0.f) - log1pf(__expf(-fabsf(gf)));
                float bc = lf;
#pragma unroll
                for (int o = 1; o < 64; o <<= 1) { const float n = __shfl_up(bc, o, 64); if (lane >= o) bc += n; }
                float pm = gi - bc;
#pragma unroll
                for (int o = 1; o < 64; o <<= 1) { const float n = __shfl_up(pm, o, 64); if (lane >= o) pm = fmaxf(pm, n); }
                const float b63 = __shfl(bc, 63, 64);
                float gmax = b63 - bc + gi;
#pragma unroll
                for (int o = 32; o > 0; o >>= 1) gmax = fmaxf(gmax, __shfl_xor(gmax, o, 64));
                gB[ch * 64 + lane] = bc; gI[ch * 64 + lane] = gi; gP[ch * 64 + lane] = pm;
                if (lane == 0) { gE[ch * 2] = b63; gE[ch * 2 + 1] = gmax; }
            }
        }
        f32x4 Cacc[2][3];
#pragma unroll
        for (int i = 0; i < 2; ++i)
#pragma unroll
            for (int j = 0; j < 3; ++j) Cacc[i][j] = (f32x4){0.f, 0.f, 0.f, 0.f};
        float m_old = 0.f;
        const int jt = w & 3, sth = w >> 2;
        const int vs_s = t & 63, vs_eg = t >> 6;
        bf16x8 qf[8], kf[8]; unsigned ktr[2][8]; u32x2 vraw;
        const int jq = jt * 16 + fr, jjq = dir ? 63 - jq : jq;
        const unsigned off_q = (unsigned)jjq * AB_IN + hh * 256 + fq * 8;
        const int jk0 = (sth * 2) * 16 + fr, jk1 = jk0 + 16;
        const unsigned off_k0 = (unsigned)(dir ? 63 - jk0 : jk0) * AB_IN + 1024 + hh * 256 + fq * 8;
        const unsigned off_k1 = (unsigned)(dir ? 63 - jk1 : jk1) * AB_IN + 1024 + hh * 256 + fq * 8;
        unsigned off_kt[2];
#pragma unroll
        for (int i = 0; i < 2; ++i) { const int mt = t + NT * i, d2 = (mt & 127) * 2, s8 = (mt >> 7) * 8; off_kt[i] = (unsigned)(dir ? 63 - s8 - 7 : s8) * AB_IN + 1024 + hh * 256 + d2; }
        const unsigned off_v = (unsigned)(dir ? 63 - vs_s : vs_s) * AB_IN + 2048 + hh * 256 + vs * 32 + vs_eg * 4;
        const unsigned off_h = (unsigned)jjq * 1024 + hh * 256 + vs * 32 + sth * 16 + 4 * fq;
#define ML_BASE(POS0) (P + (size_t)(dir ? mlstm_row(b, dir, (POS0)) - 63 : mlstm_row(b, dir, (POS0))) * AB_IN)
#define ML_LOAD_Q(POS0) do { const u16* _pc = ML_BASE(POS0); \
            _Pragma("unroll") for (int kk = 0; kk < 8; ++kk) qf[kk] = ld_frag_g(_pc + off_q + kk * 32); } while (0)
#define ML_LOAD_K(POS0, S2) do { const u16* _pc = ML_BASE(POS0); \
            _Pragma("unroll") for (int kk = 0; kk < 8; ++kk) kf[kk] = ld_frag_g(_pc + ((S2) ? off_k1 : off_k0) + kk * 32); } while (0)
#define ML_LOAD_KTV(POS0) do { const u16* _pc = ML_BASE(POS0); \
            _Pragma("unroll") for (int i = 0; i < 2; ++i) { \
                _Pragma("unroll") for (int q = 0; q < 8; ++q) ktr[i][q] = *reinterpret_cast<const unsigned*>(_pc + (size_t)((dir ? 7 - q : q) * AB_IN) + off_kt[i]); } \
            vraw = *reinterpret_cast<const u32x2*>(_pc + off_v); } while (0)
        ML_LOAD_Q(0);
        __syncthreads();
        for (int ch = 0; ch < 68; ++ch) {
            const int pos0 = ch * 64;
            const float* sb = gB + ch * 64; const float* sig = gI + ch * 64; const float* spm = gP + ch * 64;
            const float b63 = gE[ch * 2], m_new = fmaxf(b63 + m_old, gE[ch * 2 + 1]), decay = __expf(b63 + m_old - m_new);
            const int jg = jt * 16 + fr;
            const float bj = sb[jg], mj = bj + fmaxf(m_old, spm[jg]);
            auto s_tile = [&](int st) {
                f32x4 sv = (f32x4){0.f, 0.f, 0.f, 0.f};
                if (st <= jt) {
#pragma unroll
                    for (int kk = 0; kk < 8; ++kk) sv = mfma16(kf[kk], qf[kk], sv);
                }
                float pv[4];
#pragma unroll
                for (int q = 0; q < 4; ++q) {
                    const int sg = st * 16 + 4 * fq + q;
                    pv[q] = (sg <= jg) ? sv[q] * 0.0625f * __expf(bj - sb[sg] + sig[sg] - mj) : 0.f;
                }
                u32x2 pk = {pk_bf16(pv[0], pv[1]), pk_bf16(pv[2], pv[3])};
                *reinterpret_cast<u32x2*>(Ss + jg * 72 + st * 16 + 4 * fq) = pk;
            };
            ML_LOAD_KTV(pos0);
            if (sth * 2 <= jt) ML_LOAD_K(pos0, 0);
#pragma unroll
            for (int i = 0; i < 2; ++i) {
                const int mt = t + NT * i, d2 = (mt & 127) * 2, s8 = (mt >> 7) * 8;
                u32x4 lo = {(ktr[i][0] & 0xffffu) | (ktr[i][1] << 16), (ktr[i][2] & 0xffffu) | (ktr[i][3] << 16), (ktr[i][4] & 0xffffu) | (ktr[i][5] << 16), (ktr[i][6] & 0xffffu) | (ktr[i][7] << 16)};
                u32x4 hi = {(ktr[i][0] >> 16) | (ktr[i][1] & 0xffff0000u), (ktr[i][2] >> 16) | (ktr[i][3] & 0xffff0000u), (ktr[i][4] >> 16) | (ktr[i][5] & 0xffff0000u), (ktr[i][6] >> 16) | (ktr[i][7] & 0xffff0000u)};
                *reinterpret_cast<u32x4*>(KT + d2 * 72 + s8) = lo;
                *reinterpret_cast<u32x4*>(KT + (d2 + 1) * 72 + s8) = hi;
            }
            {
                const float wg = __expf(b63 - sb[vs_s] + sig[vs_s] - m_new) * 0.0625f;
                const float v0 = bf_lo(vraw[0]), v1 = bf_hi(vraw[0]), v2 = bf_lo(vraw[1]), v3 = bf_hi(vraw[1]);
                const int e0 = vs_eg * 4;
                VT[(e0 + 0) * 72 + vs_s] = (u16)(vraw[0] & 0xffffu); VT[(e0 + 1) * 72 + vs_s] = (u16)(vraw[0] >> 16);
                VT[(e0 + 2) * 72 + vs_s] = (u16)(vraw[1] & 0xffffu); VT[(e0 + 3) * 72 + vs_s] = (u16)(vraw[1] >> 16);
                VWT[(e0 + 0) * 72 + vs_s] = f2bf(v0 * wg); VWT[(e0 + 1) * 72 + vs_s] = f2bf(v1 * wg);
                VWT[(e0 + 2) * 72 + vs_s] = f2bf(v2 * wg); VWT[(e0 + 3) * 72 + vs_s] = f2bf(v3 * wg);
                if (t < 64) VWT[32 * 72 + t] = f2bf(wg);
            }
            s_tile(sth * 2);
            if (sth * 2 + 1 <= jt) ML_LOAD_K(pos0, 1);
            s_tile(sth * 2 + 1);
            __syncthreads();
            {
                const float w_inter = __expf(bj + m_old - mj);
                f32x4 nacc[2];
#pragma unroll
                for (int z = 0; z < 2; ++z) {
                    const int et = z == 0 ? sth : 2;
                    f32x4 a = (f32x4){0.f, 0.f, 0.f, 0.f};
#pragma unroll
                    for (int kk = 0; kk < 8; ++kk) a = mfma16(ld_frag_s(CT + (et * 16 + fr) * 264 + kk * 32 + fq * 8), qf[kk], a);
                    nacc[z] = a * w_inter;
                }
                if (ch + 1 < 68) ML_LOAD_Q(pos0 + 64);
#pragma unroll
                for (int z = 0; z < 2; ++z) {
                    const int et = z == 0 ? sth : 2;
                    f32x4 a = nacc[z];
#pragma unroll
                    for (int k2 = 0; k2 < 2; ++k2) a = mfma16(ld_frag_s(VT + (et * 16 + fr) * 72 + k2 * 32 + fq * 8), ld_frag_s(Ss + jg * 72 + k2 * 32 + fq * 8), a);
                    nacc[z] = a;
                }
                const float den = __shfl(nacc[1][0], fr, 64);
                const float dd = fmaxf(fabsf(den), __expf(-mj));
                const float inv = 1.f / dd;
                u32x2 pk = {pk_bf16(nacc[0][0] * inv, nacc[0][1] * inv), pk_bf16(nacc[0][2] * inv, nacc[0][3] * inv)};
                *reinterpret_cast<u32x2*>(HM + ((size_t)dir * NTOK + (dir ? mlstm_row(b, dir, pos0) - 63 : mlstm_row(b, dir, pos0))) * 1024 + off_h) = pk;
            }
#pragma unroll
            for (int i = 0; i < 2; ++i)
#pragma unroll
                for (int et = 0; et < 3; ++et) {
                    f32x4 a = Cacc[i][et] * decay;
#pragma unroll
                    for (int k2 = 0; k2 < 2; ++k2) a = mfma16(ld_frag_s(KT + ((w * 2 + i) * 16 + fr) * 72 + k2 * 32 + fq * 8), ld_frag_s(VWT + (et * 16 + fr) * 72 + k2 * 32 + fq * 8), a);
                    Cacc[i][et] = a;
                }
            __syncthreads();
#pragma unroll
            for (int i = 0; i < 2; ++i)
#pragma unroll
                for (int et = 0; et < 3; ++et) {
                    const f32x4 a = Cacc[i][et];
                    u32x2 pk = {pk_bf16(a[0], a[1]), pk_bf16(a[2], a[3])};
                    *reinterpret_cast<u32x2*>(CT + (et * 16 + fr) * 264 + (w * 2 + i) * 16 + 4 * fq) = pk;
                }
            m_old = m_new;
        }
#undef ML_LOAD_Q
#undef ML_LOAD_K
#undef ML_LOAD_KTV
    }
}

__device__ void mlstm_out_rows(const Params& p, int row0, int nrows) {
    const int lane = tid_() & 63, w = tid_() >> 6;
    const u16* P = (const u16*)(p.ws + WS_P);
    const u16* HM = (const u16*)(p.ws + WS_HM);
    u16* YIN = (u16*)(p.ws + WS_YIN);
    for (int r = w; r < nrows; r += 8) {
        const int row = row0 + r;
        const int c0 = lane * 16;
        float v[16]; float ss = 0.f;
#pragma unroll
        for (int h2 = 0; h2 < 2; ++h2) {
            const u32x4 a = *reinterpret_cast<const u32x4*>(HM + (size_t)row * 1024 + c0 + h2 * 8);
            const u32x4 bq = *reinterpret_cast<const u32x4*>(HM + ((size_t)NTOK + row) * 1024 + c0 + h2 * 8);
#pragma unroll
            for (int q = 0; q < 4; ++q) { v[h2 * 8 + 2 * q] = bf_lo(a[q]) + bf_lo(bq[q]); v[h2 * 8 + 2 * q + 1] = bf_hi(a[q]) + bf_hi(bq[q]); }
        }
#pragma unroll
        for (int q = 0; q < 16; ++q) ss += v[q] * v[q];
        ss += __shfl_xor(ss, 1, 64); ss += __shfl_xor(ss, 2, 64); ss += __shfl_xor(ss, 4, 64); ss += __shfl_xor(ss, 8, 64);
        const float rstd = rsqrtf(ss * (1.f / 256.f) + 1e-6f);
        unsigned o[8];
#pragma unroll
        for (int h2 = 0; h2 < 2; ++h2) {
            const u32x4 og = *reinterpret_cast<const u32x4*>(P + (size_t)row * AB_IN + 3072 + c0 + h2 * 8);
#pragma unroll
            for (int q = 0; q < 4; ++q) {
                const int c = c0 + h2 * 8 + 2 * q;
                const float y0 = v[h2 * 8 + 2 * q] * rstd * p.mlstm_norm[c] * sigmoidf_(bf_lo(og[q]));
                const float y1 = v[h2 * 8 + 2 * q + 1] * rstd * p.mlstm_norm[c + 1] * sigmoidf_(bf_hi(og[q]));
                o[h2 * 4 + q] = pk_bf16(y0, y1);
            }
        }
        *reinterpret_cast<u32x4*>(YIN + (size_t)row * D + c0) = (u32x4){o[0], o[1], o[2], o[3]};
        *reinterpret_cast<u32x4*>(YIN + (size_t)row * D + c0 + 8) = (u32x4){o[4], o[5], o[6], o[7]};
    }
}

template <int DH, class KeyFn, class BiasFn>
__device__ __forceinline__ void attn_wave(const u16* qptr, size_t qstride, int nblk, KeyFn keyfn, BiasFn biasfn, float scale,
                                           float m_init, float l_init, u16* vlds, u16* optr, size_t ostride) {
    constexpr int NK = DH / 32, NDT = DH / 16, VS = DH + 8, NV = DH / 16;
    const int lane = tid_() & 63, fr = lane & 15, fq = lane >> 4;
    bf16x8 qf[NK];
#pragma unroll
    for (int kk = 0; kk < NK; ++kk) qf[kk] = ld_frag_g(qptr + (size_t)fr * qstride + kk * 32 + fq * 8);
    f32x4 oacc[NDT];
#pragma unroll
    for (int i = 0; i < NDT; ++i) oacc[i] = (f32x4){0.f, 0.f, 0.f, 0.f};
    float m = m_init, l = l_init;
    bf16x8 kn[2][NK]; u32x4 vn[NV];
    auto load_blk = [&](int ib) {
        const u16* kptr; const u16* vptr; size_t kvs;
        (void)keyfn(ib, kptr, vptr, kvs);
#pragma unroll
        for (int st = 0; st < 2; ++st)
#pragma unroll
            for (int kk = 0; kk < NK; ++kk) kn[st][kk] = ld_frag_g(kptr + (size_t)(st * 16 + fr) * kvs + kk * 32 + fq * 8);
#pragma unroll
        for (int i = 0; i < NV; ++i) { const int cidx = lane + 64 * i, r = cidx / (DH / 8), cc = cidx % (DH / 8); vn[i] = *reinterpret_cast<const u32x4*>(vptr + (size_t)r * kvs + cc * 8); }
    };
    auto next_valid = [&](int ib) { const u16* a; const u16* b2; size_t c; while (ib < nblk && !keyfn(ib, a, b2, c)) ++ib; return ib; };
    int ib = next_valid(0);
    if (ib < nblk) load_blk(ib);
    while (ib < nblk) {
        bf16x8 kc[2][NK]; u32x4 vc[NV];
#pragma unroll
        for (int st = 0; st < 2; ++st)
#pragma unroll
            for (int kk = 0; kk < NK; ++kk) kc[st][kk] = kn[st][kk];
#pragma unroll
        for (int i = 0; i < NV; ++i) vc[i] = vn[i];
        const int ibn = next_valid(ib + 1);
        if (ibn < nblk) load_blk(ibn);
        asm volatile("" ::: "memory");
#pragma unroll
        for (int i = 0; i < NV; ++i) { const int cidx = lane + 64 * i, r = cidx / (DH / 8), cc = cidx % (DH / 8); *reinterpret_cast<u32x4*>(vlds + r * VS + cc * 8) = vc[i]; }
        f32x4 s[2];
#pragma unroll
        for (int st = 0; st < 2; ++st) {
            f32x4 a = (f32x4){0.f, 0.f, 0.f, 0.f};
#pragma unroll
            for (int kk = 0; kk < NK; ++kk) a = mfma16(kc[st][kk], qf[kk], a);
            s[st] = a;
        }
        float x[8]; float mx = -INFINITY;
#pragma unroll
        for (int st = 0; st < 2; ++st)
#pragma unroll
            for (int q = 0; q < 4; ++q) { const float v = s[st][q] * scale + biasfn(ib, fr, st * 16 + 4 * fq + q); x[st * 4 + q] = v; mx = fmaxf(mx, v); }
        mx = max_x32(max_x16(mx));
        const float m_new = fmaxf(m, mx);
        const float m_safe = (m_new == -INFINITY) ? 0.f : m_new;
        const float alpha = __expf(m - m_safe);
        float ps = 0.f; float pe[8];
#pragma unroll
        for (int q = 0; q < 8; ++q) { pe[q] = __expf(x[q] - m_safe); ps += pe[q]; }
        l = l * alpha + ps; m = m_new;
#pragma unroll
        for (int i = 0; i < NDT; ++i) oacc[i] *= alpha;
        const bf16x8 pf = mk_frag(pk_bf16(pe[0], pe[1]), pk_bf16(pe[2], pe[3]), pk_bf16(pe[4], pe[5]), pk_bf16(pe[6], pe[7]));
        asm volatile("s_waitcnt lgkmcnt(0)" ::: "memory");
        {
            typedef short s16x4 __attribute__((ext_vector_type(4)));
            const int tq = (lane & 15) >> 2, tp = lane & 3;
            const u16* vb0 = vlds + (4 * fq + tq) * VS + 4 * tp;
            const u16* vb1 = vb0 + 16 * VS;
#pragma unroll
            for (int dt = 0; dt < NDT; ++dt) {
                const s16x4 lo = __builtin_amdgcn_ds_read_tr16_b64_v4i16((LAS s16x4*)(vb0 + dt * 16));
                const s16x4 hi = __builtin_amdgcn_ds_read_tr16_b64_v4i16((LAS s16x4*)(vb1 + dt * 16));
                const bf16x8 vf = {lo[0], lo[1], lo[2], lo[3], hi[0], hi[1], hi[2], hi[3]};
                oacc[dt] = mfma16(vf, pf, oacc[dt]);
            }
        }
        asm volatile("" ::: "memory");
        ib = ibn;
    }
    l = sum_x32(sum_x16(l));
    const float inv = 1.f / l;
#pragma unroll
    for (int dt = 0; dt < NDT; ++dt) {
        const f32x4 o = oacc[dt] * inv;
        u32x2 pk = {pk_bf16(o[0], o[1]), pk_bf16(o[2], o[3])};
        *reinterpret_cast<u32x2*>(optr + (size_t)fr * ostride + dt * 16 + 4 * fq) = pk;
    }
}


template <int DH, class SlabFn, class SubFn, class BiasFn>
__device__ __forceinline__ void attn_block(const u16* qptr, size_t qstride, int nslab, SlabFn slabfn, SubFn subfn, BiasFn biasfn, float scale,
                                            float m_init, float l_init, unsigned char* lds, u16* optr, size_t ostride) {
    constexpr int NK = DH / 32, NDT = DH / 16, VS = DH + 8, NLD = DH / 64;
    constexpr int STAGE = 2 * 64 * VS * 2;
    const int t = tid_(), lane = t & 63, fr = lane & 15, fq = lane >> 4;
    bf16x8 qf[NK];
#pragma unroll
    for (int kk = 0; kk < NK; ++kk) qf[kk] = ld_frag_g(qptr + (size_t)fr * qstride + kk * 32 + fq * 8);
    f32x4 oacc[NDT];
#pragma unroll
    for (int i = 0; i < NDT; ++i) oacc[i] = (f32x4){0.f, 0.f, 0.f, 0.f};
    float m = m_init, l = l_init;
    u32x4 kreg[NLD], vreg[NLD];
    auto load_slab = [&](int i) {
        const u16* kp; const u16* vp; size_t kvs; slabfn(i, kp, vp, kvs);
#pragma unroll
        for (int q = 0; q < NLD; ++q) { const int c = t + NT * q, r = c / (DH / 8), cc = c % (DH / 8);
            kreg[q] = *reinterpret_cast<const u32x4*>(kp + (size_t)r * kvs + cc * 8); vreg[q] = *reinterpret_cast<const u32x4*>(vp + (size_t)r * kvs + cc * 8); } };
    auto store_slab = [&](int st) {
        u16* Ks = (u16*)(lds + st * STAGE); u16* Vs = Ks + 64 * VS;
#pragma unroll
        for (int q = 0; q < NLD; ++q) { const int c = t + NT * q, r = c / (DH / 8), cc = c % (DH / 8);
            *reinterpret_cast<u32x4*>(Ks + r * VS + cc * 8) = kreg[q]; *reinterpret_cast<u32x4*>(Vs + r * VS + cc * 8) = vreg[q]; } };
    __syncthreads();
    load_slab(0); store_slab(0);
    if (nslab > 1) load_slab(1);
    __syncthreads();
    for (int i = 0; i < nslab; ++i) {
        const int cur = i & 1;
        if (i + 1 < nslab) store_slab(cur ^ 1);
        if (i + 2 < nslab) load_slab(i + 2);
        const u16* Ks = (const u16*)(lds + cur * STAGE); const u16* Vs = Ks + 64 * VS;
#pragma unroll
        for (int j = 0; j < 2; ++j) {
            int off;
            if (!subfn(i, j, off)) continue;
            f32x4 s[2];
#pragma unroll
            for (int st = 0; st < 2; ++st) {
                f32x4 a = (f32x4){0.f, 0.f, 0.f, 0.f};
#pragma unroll
                for (int kk = 0; kk < NK; ++kk) a = mfma16(ld_frag_s(Ks + (off + st * 16 + fr) * VS + kk * 32 + fq * 8), qf[kk], a);
                s[st] = a;
            }
            float x[8]; float mx = -INFINITY;
#pragma unroll
            for (int st = 0; st < 2; ++st)
#pragma unroll
                for (int q = 0; q < 4; ++q) { const float v = s[st][q] * scale + biasfn(i, off, fr, st * 16 + 4 * fq + q); x[st * 4 + q] = v; mx = fmaxf(mx, v); }
            mx = max_x32(max_x16(mx));
            const float m_new = fmaxf(m, mx);
            const float m_safe = (m_new == -INFINITY) ? 0.f : m_new;
            const float alpha = __expf(m - m_safe);
            float ps = 0.f; float pe[8];
#pragma unroll
            for (int q = 0; q < 8; ++q) { pe[q] = __expf(x[q] - m_safe); ps += pe[q]; }
            l = l * alpha + ps; m = m_new;
#pragma unroll
            for (int dt = 0; dt < NDT; ++dt) oacc[dt] *= alpha;
            const bf16x8 pf = mk_frag(pk_bf16(pe[0], pe[1]), pk_bf16(pe[2], pe[3]), pk_bf16(pe[4], pe[5]), pk_bf16(pe[6], pe[7]));
            typedef short s16x4 __attribute__((ext_vector_type(4)));
            const int tq = (lane & 15) >> 2, tp = lane & 3;
            const u16* vb0 = Vs + (off + 4 * fq + tq) * VS + 4 * tp;
            const u16* vb1 = vb0 + 16 * VS;
#pragma unroll
            for (int dt = 0; dt < NDT; ++dt) {
                const s16x4 lo = __builtin_amdgcn_ds_read_tr16_b64_v4i16((LAS s16x4*)(vb0 + dt * 16));
                const s16x4 hi = __builtin_amdgcn_ds_read_tr16_b64_v4i16((LAS s16x4*)(vb1 + dt * 16));
                const bf16x8 vf = {lo[0], lo[1], lo[2], lo[3], hi[0], hi[1], hi[2], hi[3]};
                oacc[dt] = mfma16(vf, pf, oacc[dt]);
            }
        }
        __syncthreads();
    }
    l = sum_x32(sum_x16(l));
    const float inv = 1.f / l;
#pragma unroll
    for (int dt = 0; dt < NDT; ++dt) {
        const f32x4 o = oacc[dt] * inv;
        u32x2 pk = {pk_bf16(o[0], o[1]), pk_bf16(o[2], o[3])};
        *reinterpret_cast<u32x2*>(optr + (size_t)fr * ostride + dt * 16 + 4 * fq) = pk;
    }
}

__device__ void phase_l0_stage2(const Params& p, unsigned char* lds) {
    const int w = tid_() >> 6;
    const u16* P = (const u16*)(p.ws + WS_P);
    u16* YIN = (u16*)(p.ws + WS_YIN);
    for (int item = bid_(); item < 1088 + 2176; item += gdim_()) {
        if (item < 1024) {
            const int r2 = item & 31, h = (item >> 5) & 7, b = item >> 8;
            const int rr = w >> 2, qt = w & 3, r = 2 * r2 + rr;
            const int r0 = min(max(r - 4, 0), 56);
            const int krow0 = min(max(2 * r2 - 4, 0), 56), nwin = min(max(2 * r2 + 1 - 4, 0), 56) + 8 - krow0;
            const int cb = qt == 0 ? 0 : (qt == 1 ? 8 : (qt == 2 ? 24 : 32));
            const int qrow = b * SEQ + r * 64 + qt * 16;
            const float* rpb = p.na_rpb + h * 15 * 31;
            auto slabfn = [&](int i, const u16*& kp, const u16*& vp, size_t& kvs) {
                const int row = i < nwin ? b * SEQ + (krow0 + i) * 64 : NLAT + b * LC + (i - nwin) * 64;
                kp = P + (size_t)row * AB_IN + 5136 + h * 128; vp = P + (size_t)row * AB_IN + 6160 + h * 128; kvs = AB_IN; };
            auto subfn = [&](int i, int j, int& off) -> bool {
                if (i < nwin) { off = cb; return j == 0 && (krow0 + i) >= r0 && (krow0 + i) < r0 + 8; }
                off = 32 * j; return true; };
            auto biasfn = [&](int i, int off, int qi, int ki) -> float {
                if (i >= nwin) return 0.f;
                const int c = qt * 16 + qi, kc = off + ki, c0 = min(max(c - 8, 0), 48);
                if (kc < c0 || kc >= c0 + 16) return -INFINITY;
                return rpb[(krow0 + i - r + 7) * 31 + (kc - c + 15)]; };
            attn_block<128>(P + (size_t)qrow * AB_IN + 4112 + h * 128, AB_IN, nwin + 4, slabfn, subfn, biasfn, 0.08838834764831845f, -INFINITY, 0.f, lds,
                            YIN + (size_t)qrow * D + 1024 + h * 128, D);
        } else if (item < 1088) {
            const int it = item - 1024, half = it & 1, h = (it >> 1) & 7, b = it >> 4;
            const int qrow = NLAT + b * LC + (half * 8 + w) * 16;
            auto slabfn = [&](int i, const u16*& kp, const u16*& vp, size_t& kvs) {
                const int row = NLAT + b * LC + i * 64;
                kp = P + (size_t)row * AB_IN + 5136 + h * 128; vp = P + (size_t)row * AB_IN + 6160 + h * 128; kvs = AB_IN; };
            auto subfn = [&](int, int j, int& off) -> bool { off = 32 * j; return true; };
            auto biasfn = [&](int, int, int, int) -> float { return 0.f; };
            attn_block<128>(P + (size_t)qrow * AB_IN + 4112 + h * 128, AB_IN, 4, slabfn, subfn, biasfn, 0.08838834764831845f, -INFINITY, 0.f, lds,
                            YIN + (size_t)qrow * D + 1024 + h * 128, D);
        } else {
            mlstm_out_rows(p, (item - 1088) * 8, 8);
        }
    }
}

__device__ void rope_rows(const Params& p, int row0, int nrows) {
    const int lane = tid_() & 63, w = tid_() >> 6;
    u16* P = (u16*)(p.ws + WS_P);
    for (int r = w; r < nrows; r += 8) {
        const int row = row0 + r, tt = row & (SEQ - 1);
        const float prow = (float)(tt >> 6), pcol = (float)(tt & 63);
        for (int pi = lane; pi < 640; pi += 64) {
            const int head = pi >> 5, half = (pi >> 4) & 1, j = pi & 15;
            const int base = (head < 16 ? head * 64 : 1024 + (head - 16) * 64) + half * 32 + j;
            const float inv = exp2f(-(float)j * (13.287712379549449f / 16.f));
            const float ang = (half ? pcol : prow) * inv;
            float sn, cs; sincosf(ang, &sn, &cs);
            u16* q1 = P + (size_t)row * CD_IN + base;
            const float x1 = bf2f(q1[0]), x2 = bf2f(q1[16]);
            q1[0] = f2bf(x1 * cs - x2 * sn); q1[16] = f2bf(x2 * cs + x1 * sn);
        }
    }
}

__device__ __forceinline__ int lru_row(int b, int ci, int j) { return ci < 4 ? NLAT + b * LC + ci * 64 + j : b * SEQ + (ci - 4) * 64 + j; }
__device__ void lru_chunk(const Params& p, int b, int blk, int ci, int mode, unsigned char* lds) {
    u16* ub = (u16*)lds;
    constexpr int SR = 132;
    float* sa = (float*)(ub + 64 * 136);
    float* sbt = sa + 64 * SR;
    float* sx = sbt + 64 * SR;
    const int t = tid_(), lane = t & 63, w = t >> 6, fr = lane & 15, fq = lane >> 4;
    const u16* P = (const u16*)(p.ws + WS_P);
    const u16* WT = (const u16*)(p.ws + WS_LRUW);
    float* SA = (float*)(p.ws + WS_LRUS);
    float* SH = SA + 2 * 4 * 68 * 1024;
    const int seglen = ci < 4 ? LC : SEQ, tt0 = ci < 4 ? ci * 64 : (ci - 4) * 64;
    const int rbase = ci < 4 ? NLAT + b * LC : b * SEQ;
    const int sc = t & 127, seg = t >> 7;
    const int chg_s = blk * 128 + sc;
    const int cg = blk * 128 + w * 16 + 4 * fq;
    bf16x8 wfa[2][2][4];
#pragma unroll
    for (int d2 = 0; d2 < 2; ++d2)
#pragma unroll
        for (int g2 = 0; g2 < 2; ++g2)
#pragma unroll
            for (int kk = 0; kk < 4; ++kk) wfa[d2][g2][kk] = ld_frag_g(WT + ((size_t)((d2 * 2 + g2) * 8 + blk) * 128 + w * 16 + fr) * 128 + fq * 8 + kk * 32);
    f32x4 gba[2][2], lama[2];
#pragma unroll
    for (int d2 = 0; d2 < 2; ++d2) {
        lama[d2] = *reinterpret_cast<const f32x4*>(p.lru_lambda + d2 * 1024 + cg);
#pragma unroll
        for (int g2 = 0; g2 < 2; ++g2) gba[d2][g2] = *reinterpret_cast<const f32x4*>(p.lru_gate_b + (d2 * 2 + g2) * 1024 + cg);
    }
    float carry[2] = {0.f, 0.f}; u16 grv[16];
    if (mode == 1) {
#pragma unroll
        for (int d2 = 0; d2 < 2; ++d2) carry[d2] = SH[((size_t)(d2 * 4 + b) * 68 + ci) * 1024 + chg_s];
#pragma unroll
        for (int s = 0; s < 16; ++s) grv[s] = P[(size_t)lru_row(b, ci, seg * 16 + s) * CD_IN + 2560 + chg_s];
    }
    __syncthreads();
    {
        const int c4 = (t & 31) * 4, j0 = (t >> 5) * 4, ch = blk * 128 + c4;
        float xv[7][4];
#pragma unroll
        for (int q = 0; q < 7; ++q) {
            const int tt = tt0 + j0 - 1 + q;
            if (tt >= 0 && tt < seglen) {
                const u32x2 v = *reinterpret_cast<const u32x2*>(P + (size_t)(rbase + tt) * CD_IN + 1536 + ch);
                xv[q][0] = bf_lo(v[0]); xv[q][1] = bf_hi(v[0]); xv[q][2] = bf_lo(v[1]); xv[q][3] = bf_hi(v[1]);
            } else { xv[q][0] = xv[q][1] = xv[q][2] = xv[q][3] = 0.f; }
        }
        f32x4 cw[4];
#pragma unroll
        for (int tp = 0; tp < 4; ++tp) cw[tp] = *reinterpret_cast<const f32x4*>(p.lru_conv_w + tp * 1024 + ch);
        const f32x4 cb = *reinterpret_cast<const f32x4*>(p.lru_conv_b + ch);
#pragma unroll
        for (int q = 0; q < 4; ++q) {
            float u[4];
#pragma unroll
            for (int cc = 0; cc < 4; ++cc) u[cc] = cb[cc] + xv[q][cc] * cw[0][cc] + xv[q + 1][cc] * cw[1][cc] + xv[q + 2][cc] * cw[2][cc] + xv[q + 3][cc] * cw[3][cc];
            u32x2 pk = {pk_bf16(u[0], u[1]), pk_bf16(u[2], u[3])};
            *reinterpret_cast<u32x2*>(ub + (j0 + q) * 136 + c4) = pk;
        }
    }
    __syncthreads();
    float hfw[16];
    for (int dir = 0; dir < 2; ++dir) {
        f32x4 av[4];
        {
            bf16x8 wf[4];
#pragma unroll
            for (int kk = 0; kk < 4; ++kk) wf[kk] = dir ? wfa[1][0][kk] : wfa[0][0][kk];
            const f32x4 gbv = dir ? gba[1][0] : gba[0][0];
            const f32x4 lamv = dir ? lama[1] : lama[0];
            float sp8[4];
#pragma unroll
            for (int q = 0; q < 4; ++q) { const float nl = -lamv[q]; sp8[q] = -8.f * (fmaxf(nl, 0.f) + __logf(1.f + __expf(-fabsf(nl)))); }
#pragma unroll
            for (int tt = 0; tt < 4; ++tt) {
                f32x4 z = (f32x4){0.f, 0.f, 0.f, 0.f};
#pragma unroll
                for (int kk = 0; kk < 4; ++kk) z = mfma16(wf[kk], ld_frag_s(ub + (tt * 16 + fr) * 136 + kk * 32 + fq * 8), z);
#pragma unroll
                for (int q = 0; q < 4; ++q) av[tt][q] = __expf(sigmoidf_(z[q] + gbv[q]) * sp8[q]);
            }
        }
        __syncthreads();
        {
            bf16x8 wf[4];
#pragma unroll
            for (int kk = 0; kk < 4; ++kk) wf[kk] = dir ? wfa[1][1][kk] : wfa[0][1][kk];
            const f32x4 gbv = dir ? gba[1][1] : gba[0][1];
#pragma unroll
            for (int tt = 0; tt < 4; ++tt) {
                f32x4 z = (f32x4){0.f, 0.f, 0.f, 0.f};
#pragma unroll
                for (int kk = 0; kk < 4; ++kk) z = mfma16(wf[kk], ld_frag_s(ub + (tt * 16 + fr) * 136 + kk * 32 + fq * 8), z);
                const int tj = tt * 16 + fr;
                const u32x2 uv = *reinterpret_cast<const u32x2*>(ub + tj * 136 + w * 16 + 4 * fq);
                const float u4[4] = {bf_lo(uv[0]), bf_hi(uv[0]), bf_lo(uv[1]), bf_hi(uv[1])};
                f32x4 bv;
#pragma unroll
                for (int q = 0; q < 4; ++q) { const float a = av[tt][q]; bv[q] = sqrtf(fmaxf(1.f - a * a, 0.f)) * sigmoidf_(z[q] + gbv[q]) * u4[q]; }
                *reinterpret_cast<f32x4*>(sa + tj * SR + w * 16 + 4 * fq) = av[tt];
                *reinterpret_cast<f32x4*>(sbt + tj * SR + w * 16 + 4 * fq) = bv;
            }
        }
        __syncthreads();
        float A = 1.f, h = 0.f;
#pragma unroll
        for (int s = 0; s < 16; ++s) { const int j = seg * 16 + (dir ? 15 - s : s); const float a = sa[j * SR + sc]; h = a * h + sbt[j * SR + sc]; A *= a; }
        sx[(seg * 2 + 0) * 128 + sc] = A; sx[(seg * 2 + 1) * 128 + sc] = h;
        __syncthreads();
        const size_t sidx = ((size_t)(dir * 4 + b) * 68 + ci) * 1024 + chg_s;
        if (mode == 0) {
            if (seg == 0) {
                float At = 1.f, ht = 0.f;
#pragma unroll
                for (int s = 0; s < 4; ++s) { const int sg = dir ? 3 - s : s; const float a = sx[(sg * 2) * 128 + sc]; ht = a * ht + sx[(sg * 2 + 1) * 128 + sc]; At *= a; }
                SA[sidx] = At; SH[sidx] = ht;
            }
        } else {
            float hs = dir ? carry[1] : carry[0];
            const int nprev = dir ? 3 - seg : seg;
#pragma unroll
            for (int s = 0; s < 3; ++s) if (s < nprev) { const int sg = dir ? 3 - s : s; hs = sx[(sg * 2) * 128 + sc] * hs + sx[(sg * 2 + 1) * 128 + sc]; }
            u16* YIN = (u16*)(p.ws + WS_YIN);
            if (dir == 0) {
#pragma unroll
                for (int s = 0; s < 16; ++s) { const int j = seg * 16 + s; hs = sa[j * SR + sc] * hs + sbt[j * SR + sc]; hfw[s] = hs; }
            } else {
#pragma unroll
                for (int s = 0; s < 16; ++s) {
                    const int js = 15 - s, j = seg * 16 + js;
                    hs = sa[j * SR + sc] * hs + sbt[j * SR + sc];
                    const int row = lru_row(b, ci, j);
                    const float gr = bf2f(grv[js]);
                    const float th = 1.f - 2.f * frcp_(1.f + __expf(1.5957691216057308f * (gr + 0.044715f * gr * gr * gr)));
                    const float ge = 0.5f * gr * (1.f + th);
                    YIN[(size_t)row * D + 1024 + chg_s] = f2bf((hfw[js] + hs) * ge);
                }
            }
        }
    }
}

__device__ void lru_prep_weights(const Params& p) {
    const int t = tid_();
    u16* WT = (u16*)(p.ws + WS_LRUW);
    for (int m = bid_(); m < 32; m += gdim_()) {
        const float* Wg = p.lru_gate_w + (size_t)m * 128 * 128;
        const int j4 = (t & 31) * 4, i8 = (t >> 5) * 8;
        f32x4 r8[8];
#pragma unroll
        for (int q = 0; q < 8; ++q) r8[q] = *reinterpret_cast<const f32x4*>(Wg + (size_t)(i8 + q) * 128 + j4);
#pragma unroll
        for (int jj = 0; jj < 4; ++jj) {
            u32x4 v = {pk_bf16(r8[0][jj], r8[1][jj]), pk_bf16(r8[2][jj], r8[3][jj]), pk_bf16(r8[4][jj], r8[5][jj]), pk_bf16(r8[6][jj], r8[7][jj])};
            *reinterpret_cast<u32x4*>(WT + ((size_t)m * 128 + j4 + jj) * 128 + i8) = v;
        }
    }
}
__device__ void lru_carry(const Params& p, int item) {
    const int idx = item * NT + tid_();
    const int c = idx & 1023, b = (idx >> 10) & 3, dir = idx >> 12;
    float* SA = (float*)(p.ws + WS_LRUS);
    float* SH = SA + 2 * 4 * 68 * 1024;
    const size_t base = ((size_t)(dir * 4 + b) * 68) * 1024 + c;
    float h = 0.f;
#pragma unroll 4
    for (int s = 0; s < 68; ++s) {
        const int cj = dir == 0 ? s : (s < 4 ? 3 - s : 71 - s);
        const float a = SA[base + (size_t)cj * 1024], hl = SH[base + (size_t)cj * 1024];
        SH[base + (size_t)cj * 1024] = h;
        h = a * h + hl;
    }
}

__device__ void gqa_item(const Params& p, int it, unsigned char* lds) {
    const int w = tid_() >> 6;
    const u16* P = (const u16*)(p.ws + WS_P);
    u16* YIN = (u16*)(p.ws + WS_YIN);
    const int t32 = it & 127, kvh = (it >> 7) & 3, b = it >> 9;
    const int hq = kvh * 4 + (w & 3), t0 = t32 * 32 + (w >> 2) * 16;
    const int kfirst = max((t32 * 32 - 128) & ~63, 0), klast = min(((t32 * 32 - 128) & ~63) + 256, SEQ - 64);
    const int nwin = (klast - kfirst) / 64 + 1;
    const int qrow = b * SEQ + t0;
    auto slabfn = [&](int i, const u16*& kp, const u16*& vp, size_t& kvs) {
        const int row = i < nwin ? b * SEQ + kfirst + i * 64 : NLAT + b * LC + (i - nwin) * 64;
        kp = P + (size_t)row * CD_IN + 1024 + kvh * 64; vp = P + (size_t)row * CD_IN + 1280 + kvh * 64; kvs = CD_IN; };
    auto subfn = [&](int i, int j, int& off) -> bool {
        off = 32 * j;
        if (i >= nwin) return true;
        const int k0 = kfirst + i * 64 + off;
        return k0 + 31 >= t0 - 128 && k0 <= t0 + 15 + 128; };
    auto biasfn = [&](int i, int off, int qi, int ki) -> float {
        if (i >= nwin) return 0.f;
        const int dq = (t0 + qi) - (kfirst + i * 64 + off + ki);
        return (dq > 128 || dq < -128) ? -INFINITY : 0.f; };
    const float sink = p.gqa_sink[hq];
    attn_block<64>(P + (size_t)qrow * CD_IN + hq * 64, CD_IN, nwin + 4, slabfn, subfn, biasfn, 0.125f, sink, ((tid_() & 63) >> 4) == 0 ? 1.f : 0.f, lds,
                   YIN + (size_t)qrow * D + hq * 64, D);
}

__device__ void phase_l1_stage1(const Params& p, unsigned char* lds) {
    for (int item = bid_(); item < 2176 + 2048; item += gdim_()) {
        if (item < 2176) { const int ci = item % 68, blk = (item / 68) & 7, b = item / (68 * 8); lru_chunk(p, b, blk, ci, 0, lds); }
        else rope_rows(p, (item - 2176) * 8, 8);
    }
}
__device__ void phase_l1_stage2(const Params& p, unsigned char* lds) {
    for (int item = bid_(); item < 16 + 2048; item += gdim_()) {
        if (item < 16) lru_carry(p, item);
        else gqa_item(p, item - 16, lds);
    }
}
__device__ void phase_l1_stage3(const Params& p, unsigned char* lds) {
    for (int item = bid_(); item < 2048; item += gdim_()) { const int cl = item & 63, blk = (item >> 6) & 7, b = item >> 9; lru_chunk(p, b, blk, cl + 4, 1, lds); }
}

__device__ void phase_rowpass_mid(const Params& p, int l, unsigned char* lds) {
    float* R = (float*)lds;
    const int t = tid_(), lane = t & 63, w = t >> 6;
    const int nrows = l == 0 ? NTOK : NLAT;
    __syncthreads();
    for (int i = t; i < D * NEXP; i += NT) { const int k = i >> 4, e = i & 15; R[e * D + k] = p.moe_router[(size_t)l * D * NEXP + i]; }
    __syncthreads();
    const u16* Y = (const u16*)(p.ws + WS_Y);
    float* XL1 = (float*)(p.ws + WS_XL1);
    u16* H = (u16*)(p.ws + WS_H);
    float* AFF = (float*)(p.ws + WS_AFF);
    for (int row = bid_() * 8 + w; row < nrows; row += gdim_() * 8) {
        f32x4 v[8]; float ss = 0.f;
#pragma unroll
        for (int i = 0; i < 8; ++i) { const u32x2 q = *reinterpret_cast<const u32x2*>(Y + (size_t)row * D + (i * 64 + lane) * 4); v[i] = (f32x4){bf_lo(q[0]), bf_hi(q[0]), bf_lo(q[1]), bf_hi(q[1])}; ss += v[i][0] * v[i][0] + v[i][1] * v[i][1] + v[i][2] * v[i][2] + v[i][3] * v[i][3]; }
        ss = wave_sum(ss);
        const float rstd = rsqrtf(ss * (1.f / D) + 1e-6f);
        const float* xr = xin_row(p, l, row);
        const float* g1 = mod_ptr(p, l, row, 2);
        const float* nw = p.norm_mix_post + (size_t)l * D;
        float ss1 = 0.f;
#pragma unroll
        for (int i = 0; i < 8; ++i) {
            const int col = (i * 64 + lane) * 4;
            const f32x4 x4 = *reinterpret_cast<const f32x4*>(xr + col), w4 = *reinterpret_cast<const f32x4*>(nw + col), g4 = *reinterpret_cast<const f32x4*>(g1 + col);
            const f32x4 x1 = x4 + g4 * (v[i] * rstd * w4);
            *reinterpret_cast<f32x4*>(XL1 + (size_t)row * D + col) = x1;
            v[i] = x1; ss1 += x1[0] * x1[0] + x1[1] * x1[1] + x1[2] * x1[2] + x1[3] * x1[3];
        }
        ss1 = wave_sum(ss1);
        const float rstd1 = rsqrtf(ss1 * (1.f / D) + 1e-6f);
        const float* sh = mod_ptr(p, l, row, 3); const float* sc = mod_ptr(p, l, row, 4);
        const float* nw2 = p.norm_ffn_pre + (size_t)l * D;
#pragma unroll
        for (int i = 0; i < 8; ++i) {
            const int col = (i * 64 + lane) * 4;
            const f32x4 w4 = *reinterpret_cast<const f32x4*>(nw2 + col), s4 = *reinterpret_cast<const f32x4*>(sc + col), h4 = *reinterpret_cast<const f32x4*>(sh + col);
            const f32x4 o = v[i] * rstd1 * w4 * (s4 + 1.f) + h4;
            u32x2 pk = {pk_bf16(o[0], o[1]), pk_bf16(o[2], o[3])};
            *reinterpret_cast<u32x2*>(H + (size_t)row * D + col) = pk;
            v[i] = o;
        }
        float lg[16];
#pragma unroll
        for (int e = 0; e < 16; ++e) lg[e] = 0.f;
#pragma unroll
        for (int i = 0; i < 8; ++i) {
#pragma unroll
            for (int e = 0; e < 16; ++e) { const f32x4 r4 = *reinterpret_cast<const f32x4*>(R + e * D + (i * 64 + lane) * 4); lg[e] += v[i][0] * r4[0] + v[i][1] * r4[1] + v[i][2] * r4[2] + v[i][3] * r4[3]; }
        }
        const bool b5 = lane & 32, b4 = lane & 16, b3 = lane & 8, b2 = lane & 4;
        float t8[8], t4[4], t2[2], lgt;
#pragma unroll
        for (int j = 0; j < 8; ++j) { const float keep = b5 ? lg[8 + j] : lg[j], send = b5 ? lg[j] : lg[8 + j]; t8[j] = keep + partner_x32(send); }
#pragma unroll
        for (int j = 0; j < 4; ++j) { const float keep = b4 ? t8[4 + j] : t8[j], send = b4 ? t8[j] : t8[4 + j]; t4[j] = keep + partner_x16(send); }
#pragma unroll
        for (int j = 0; j < 2; ++j) { const float keep = b3 ? t4[2 + j] : t4[j], send = b3 ? t4[j] : t4[2 + j]; t2[j] = keep + dpp_f<0x140>(send); }
        { const float keep = b2 ? t2[1] : t2[0], send = b2 ? t2[0] : t2[1]; lgt = keep + dpp_f<0x141>(send); }
        lgt += dpp_f<0x4E>(lgt); lgt += dpp_f<0xB1>(lgt);
        const float mx = wave_max(lgt);
        const float pe = __expf(lgt - mx);
        const float den = wave_sum(pe) * 0.25f;
        if ((lane & 3) == 0) AFF[(size_t)row * 16 + ((b5 ? 8 : 0) + (b4 ? 4 : 0) + (b3 ? 2 : 0) + (b2 ? 1 : 0))] = pe / den;
    }
}

__device__ void phase_topk(const Params& p, int l, unsigned char* lds) {
    unsigned* keys = (unsigned*)lds;
    unsigned* hist = keys + 4096;
    unsigned* misc = hist + 256;
    const int t = tid_(), lane = t & 63, w = t >> 6;
    const float* AFF = (const float*)(p.ws + WS_AFF);
    int* SLOT = (int*)(p.ws + WS_SLOT);
    int* EROW = (int*)(p.ws + WS_EROW);
    float* EGATE = (float*)(p.ws + WS_EGATE);
    const int nitems = l == 0 ? 128 : 64;
    for (int item = bid_(); item < nitems; item += gdim_()) {
        const int kind = item >> 6, b = (item >> 4) & 3, ex = item & 15;
        const int n = kind ? LC : SEQ, cap = n / 8, rowbase = kind ? NLAT + b * LC : b * SEQ;
        __syncthreads();
        for (int i = t; i < n; i += NT) keys[i] = __float_as_uint(AFF[(size_t)(rowbase + i) * 16 + ex]);
        unsigned prefix = 0u, mask = 0u; int kth = cap;
        for (int shift = 24; shift >= 0; shift -= 8) {
            __syncthreads();
            if (t < 256) hist[t] = 0u;
            __syncthreads();
            for (int i = t; i < n; i += NT) { const unsigned k = keys[i]; if ((k & mask) == prefix) atomicAdd(&hist[(k >> shift) & 255u], 1u); }
            __syncthreads();
            if (t < 256) {
                unsigned above = 0u;
                for (int d2 = t + 1; d2 < 256; ++d2) above += hist[d2];
                const unsigned here = hist[t];
                if ((int)above < kth && (int)(above + here) >= kth) { misc[0] = (unsigned)t; misc[1] = (unsigned)(kth - (int)above); }
            }
            __syncthreads();
            prefix |= misc[0] << shift; mask |= 255u << shift; kth = (int)misc[1];
        }
        const unsigned T = prefix; const int need_eq = kth;
        int cgt = 0, ceq = 0;
        const int base = t * 8;
        if (base < n) {
#pragma unroll
            for (int q = 0; q < 8; ++q) { const unsigned k = keys[base + q]; cgt += (k > T); ceq += (k == T); }
        }
        int packed = cgt | (ceq << 16);
        int incl = packed;
#pragma unroll
        for (int o = 1; o < 64; o <<= 1) { const int nb = __shfl_up(incl, o, 64); if (lane >= o) incl += nb; }
        __syncthreads();
        if (lane == 63) misc[8 + w] = (unsigned)incl;
        __syncthreads();
        int woff = 0, total = 0;
#pragma unroll
        for (int q = 0; q < 8; ++q) { const int v = (int)misc[8 + q]; if (q < w) woff += v; total += v; }
        const int excl = woff + incl - packed;
        int pgt = excl & 0xffff, peq = excl >> 16;
        const int tot_gt = total & 0xffff;
        const int sbase = kind ? 2048 + b * 32 : b * 512;
        if (base < n) {
#pragma unroll
            for (int q = 0; q < 8; ++q) {
                const unsigned k = keys[base + q];
                const int row = rowbase + base + q;
                int pos = -1;
                if (k > T) { pos = pgt; ++pgt; }
                else if (k == T) { if (peq < need_eq) pos = tot_gt + peq; ++peq; }
                if (pos >= 0) { const int sl = sbase + pos; EROW[ex * EPAD + sl] = row; EGATE[ex * EPAD + sl] = __uint_as_float(k); SLOT[(size_t)row * 16 + ex] = sl; }
                else SLOT[(size_t)row * 16 + ex] = -1;
            }
        }
    }
}

__device__ void phase_final(const Params& p, int l) {
    const int lane = tid_() & 63, w = tid_() >> 6;
    const int nrows = l == 0 ? NTOK : NLAT;
    const u16* YEXP = (const u16*)(p.ws + WS_YEXP);
    const int* SLOT = (const int*)(p.ws + WS_SLOT);
    const float* XL1 = (const float*)(p.ws + WS_XL1);
    float* XL2 = (float*)(p.ws + WS_XL2);
    u16* H = (u16*)(p.ws + WS_H);
    for (int row = bid_() * 8 + w; row < nrows; row += gdim_() * 8) {
        const int myslot = lane < 16 ? SLOT[(size_t)row * 16 + lane] : -1;
        f32x4 xl[8];
#pragma unroll
        for (int i = 0; i < 8; ++i) xl[i] = *reinterpret_cast<const f32x4*>(XL1 + (size_t)row * D + (i * 64 + lane) * 4);
        f32x4 v[8];
#pragma unroll
        for (int i = 0; i < 8; ++i) v[i] = (f32x4){0.f, 0.f, 0.f, 0.f};
        unsigned long long em = __ballot(myslot >= 0);
        while (em) {
            const int e0 = __builtin_ctzll(em); em &= em - 1;
            const bool two = em != 0;
            const int e1 = two ? __builtin_ctzll(em) : e0; if (two) em &= em - 1;
            const int sl0 = __shfl(myslot, e0, 64), sl1 = __shfl(myslot, e1, 64);
            const u16* y0 = YEXP + ((size_t)e0 * EPAD + sl0) * D; const u16* y1 = YEXP + ((size_t)e1 * EPAD + sl1) * D;
            u32x2 q0[8], q1[8];
#pragma unroll
            for (int i = 0; i < 8; ++i) { q0[i] = *reinterpret_cast<const u32x2*>(y0 + (i * 64 + lane) * 4); q1[i] = *reinterpret_cast<const u32x2*>(y1 + (i * 64 + lane) * 4); }
            const float f1 = two ? 1.f : 0.f;
#pragma unroll
            for (int i = 0; i < 8; ++i) {
                v[i][0] += bf_lo(q0[i][0]) + f1 * bf_lo(q1[i][0]); v[i][1] += bf_hi(q0[i][0]) + f1 * bf_hi(q1[i][0]);
                v[i][2] += bf_lo(q0[i][1]) + f1 * bf_lo(q1[i][1]); v[i][3] += bf_hi(q0[i][1]) + f1 * bf_hi(q1[i][1]);
            }
        }
        float ss = 0.f;
#pragma unroll
        for (int i = 0; i < 8; ++i) ss += v[i][0] * v[i][0] + v[i][1] * v[i][1] + v[i][2] * v[i][2] + v[i][3] * v[i][3];
        ss = wave_sum(ss);
        const float rstd = rsqrtf(ss * (1.f / D) + 1e-6f);
        const float* g2 = mod_ptr(p, l, row, 5);
        const float* nw = p.norm_ffn_post + (size_t)l * D;
        float* dst = l == 0 ? XL2 + (size_t)row * D : p.out + (size_t)row * D;
        float ss2 = 0.f;
#pragma unroll
        for (int i = 0; i < 8; ++i) {
            const int col = (i * 64 + lane) * 4;
            const f32x4 x4 = xl[i], w4 = *reinterpret_cast<const f32x4*>(nw + col), g4 = *reinterpret_cast<const f32x4*>(g2 + col);
            const f32x4 x2 = x4 + g4 * (v[i] * rstd * w4);
            *reinterpret_cast<f32x4*>(dst + col) = x2;
            v[i] = x2; ss2 += x2[0] * x2[0] + x2[1] * x2[1] + x2[2] * x2[2] + x2[3] * x2[3];
        }
        if (l == 0) {
            ss2 = wave_sum(ss2);
            const float rstd2 = rsqrtf(ss2 * (1.f / D) + 1e-6f);
            const float* sh = mod_ptr(p, 1, row, 0); const float* sc = mod_ptr(p, 1, row, 1);
            const float* nw1 = p.norm_mix_pre + D;
#pragma unroll
            for (int i = 0; i < 8; ++i) {
                const int col = (i * 64 + lane) * 4;
                const f32x4 w4 = *reinterpret_cast<const f32x4*>(nw1 + col), s4 = *reinterpret_cast<const f32x4*>(sc + col), h4 = *reinterpret_cast<const f32x4*>(sh + col);
                const f32x4 o = v[i] * rstd2 * w4 * (s4 + 1.f) + h4;
                u32x2 pk = {pk_bf16(o[0], o[1]), pk_bf16(o[2], o[3])};
                *reinterpret_cast<u32x2*>(H + (size_t)row * D + col) = pk;
            }
        }
    }
}

__global__ void __launch_bounds__(NT, 2) fwd_kernel(Params p) {
    extern __shared__ __attribute__((aligned(16))) unsigned char lds[];
    unsigned char* wlds = lds + 16;
    if (threadIdx.x == 0) *reinterpret_cast<uint4*>(lds) = make_uint4(0u, 0u, 0u, 0u);
    __syncthreads();
    XcdBarrier bar = xcd_barrier_post((unsigned*)(p.ws + WS_BAR), (volatile LAS unsigned*)lds);
#ifndef PH_MASK
#define PH_MASK 0xFFFFFFFFu
#endif
#ifndef PROBE_REP_MASK
#define PROBE_REP_MASK 0u
#endif
#define PHASE(id, body) do { if (((PH_MASK >> ((id) % 32)) & 1u) && p.ph_lo <= (id) && (id) < p.ph_hi) { \
    for (int _r = 0; _r < ((((unsigned)PROBE_REP_MASK >> ((id) % 32)) & 1u) ? 2 : 1); ++_r) { body; if ((id) + 1 < p.ph_hi || _r == 0) { if ((id) + 1 < p.ph_hi) xcd_barrier(bar); } } } } while (0)
    PHASE(0, { phase_mod(p, wlds); phase_convert_dense(p, wlds); });
    PHASE(1, { phase_norm_mod(p, 0); lru_prep_weights(p); });
#pragma unroll
    for (int l = 0; l < 2; ++l) {
        const int pb = 2 + 10 * l;
        {
            EpiDesc e; e.ob = (u16*)(p.ws + WS_P); e.of = nullptr; e.ldo = l == 0 ? AB_IN : CD_IN; e.gates = l == 0 ? (float*)(p.ws + WS_G) : nullptr; e.rscale = nullptr;
            PHASE(pb + 0, phase_gemm_dense<EPI_BF16>(p, (const u16*)(p.ws + WS_H), NTOK, (const u16*)(p.ws + (l == 0 ? WS_WT_ABIN : WS_WT_CDIN)), l == 0 ? AB_IN : CD_IN, e, wlds));
        }
        if (l == 0) {
            PHASE(pb + 1, phase_mlstm(p, wlds));
            PHASE(pb + 2, phase_l0_stage2(p, wlds));
        } else {
            PHASE(pb + 1, phase_l1_stage1(p, wlds));
            PHASE(pb + 2, phase_l1_stage2(p, wlds));
            PHASE(pb + 3, phase_l1_stage3(p, wlds));
        }
        {
            EpiDesc e; e.ob = (u16*)(p.ws + WS_Y); e.of = nullptr; e.ldo = D; e.gates = nullptr; e.rscale = nullptr;
            PHASE(pb + 4, phase_gemm_dense<EPI_BF16>(p, (const u16*)(p.ws + WS_YIN), l == 0 ? NTOK : NLAT, (const u16*)(p.ws + (l == 0 ? WS_WT_ABOUT : WS_WT_CDOUT)), D, e, wlds));
        }
        PHASE(pb + 5, phase_rowpass_mid(p, l, wlds));
        PHASE(pb + 6, { phase_topk(p, l, wlds); phase_convert_moe(p, l, wlds); });
        PHASE(pb + 7, phase_moe_a(p, l, wlds));
        PHASE(pb + 8, phase_moe_b(p, l, wlds));
        PHASE(pb + 9, phase_final(p, l));
    }
}


#ifdef DBG_STOP
__global__ void dbg_digest(const unsigned char* ws, size_t off, int kind, size_t nelem, float* out, size_t nout) {
    for (size_t i = (size_t)blockIdx.x * blockDim.x + threadIdx.x; i < nout; i += (size_t)gridDim.x * blockDim.x) {
        float v = 0.f;
        for (size_t j = i; j < nelem; j += nout) {
            if (kind == 0) v += bf2f(((const u16*)(ws + off))[j]);
            else if (kind == 1) v += ((const float*)(ws + off))[j];
            else v += (float)((const int*)(ws + off))[j];
        }
        out[i] = v;
    }
}
#endif
extern "C" void kernel_launch(void* const* d_in, const int* in_sizes, int n_in, void* d_out, int out_size, void* d_ws, size_t ws_size, hipStream_t stream) {
    static int grid = 0;
    if (grid == 0) {
        if (n_in != 27 || ws_size < WS_END) { fprintf(stderr, "kernel_launch: unexpected n_in %d / ws %zu (need %zu)\n", n_in, ws_size, (size_t)WS_END); grid = -1; return; }
        int dev = 0, cus = 0, per_cu = 0;
        hipGetDevice(&dev);
        hipDeviceGetAttribute(&cus, hipDeviceAttributeMultiprocessorCount, dev);
        if (hipFuncSetAttribute((const void*)fwd_kernel, hipFuncAttributeMaxDynamicSharedMemorySize, LDS_BYTES) != hipSuccess) { fprintf(stderr, "kernel_launch: hipFuncSetAttribute failed\n"); grid = -1; return; }
        hipOccupancyMaxActiveBlocksPerMultiprocessor(&per_cu, (const void*)fwd_kernel, NT, LDS_BYTES);
        (void)hipGetLastError();
        if (per_cu < 1) fprintf(stderr, "kernel_launch: occupancy query reports %d blocks per CU\n", per_cu);
        grid = cus > 0 ? cus : 256;
    }
    if (grid < 0) return;
    hipMemsetAsync((char*)d_ws + WS_BAR, 0, XCD_BAR_WORDS * sizeof(unsigned), stream);
    Params p; memset(&p, 0, sizeof(p));
    const float** f = (const float**)&p;
    for (int i = 0; i < 27; ++i) f[i] = (const float*)d_in[i];
    p.out = (float*)d_out; p.ws = (unsigned char*)d_ws;
#if N_LAUNCH_MODE == 1
    p.ph_lo = 0; p.ph_hi = NPH;
    hipLaunchKernelGGL(fwd_kernel, dim3(grid), dim3(NT), LDS_BYTES, stream, p);
#else
#ifdef DBG_STOP
    for (int ph = 0; ph <= DBG_STOP; ++ph) { p.ph_lo = ph; p.ph_hi = ph + 1; hipLaunchKernelGGL(fwd_kernel, dim3(grid), dim3(NT), LDS_BYTES, stream, p); }
    hipLaunchKernelGGL(dbg_digest, dim3(2048), dim3(256), 0, stream, (const unsigned char*)d_ws, (size_t)DBG_OFF, (int)DBG_KIND, (size_t)DBG_NELEM, (float*)d_out, (size_t)out_size);
#else
    for (int ph = 0; ph < NPH; ++ph) { p.ph_lo = ph; p.ph_hi = ph + 1; hipLaunchKernelGGL(fwd_kernel, dim3(grid), dim3(NT), LDS_BYTES, stream, p); }
#endif
#endif
}
```

```cpp
#include <hip/hip_runtime.h>
#include <stdint.h>
#include <stdio.h>
#include <string.h>

#ifndef N_LAUNCH_MODE
#define N_LAUNCH_MODE 1
#endif

typedef unsigned short u16;
typedef short bf16x8 __attribute__((ext_vector_type(8)));
typedef float f32x4 __attribute__((ext_vector_type(4)));
typedef unsigned u32x4 __attribute__((ext_vector_type(4)));
typedef unsigned u32x2 __attribute__((ext_vector_type(2)));

#define NT 512
constexpr int D = 2048, BATCH = 4, SEQ = 4096, LC = 256;
constexpr int NLAT = BATCH * SEQ, NCTX = BATCH * LC, NTOK = NLAT + NCTX;
constexpr int AB_IN = 7184, CD_IN = 3584;
constexpr int NEXP = 16, FF = 2048, EPAD = 2304;
constexpr int NPH = 22;
constexpr int LDS_BYTES = 150 * 1024;

constexpr size_t al256(size_t x) { return (x + 255) & ~(size_t)255; }
constexpr size_t WS_BAR = 0;
constexpr size_t WS_MOD = 16384;
constexpr size_t WS_XL1 = al256(WS_MOD + 2 * 5 * 12288 * 4);
constexpr size_t WS_XL2 = al256(WS_XL1 + (size_t)NTOK * D * 4);
constexpr size_t WS_H = al256(WS_XL2 + (size_t)NTOK * D * 4);
constexpr size_t WS_P = al256(WS_H + (size_t)NTOK * D * 2);
constexpr size_t WS_G = al256(WS_P + (size_t)NTOK * AB_IN * 2);
constexpr size_t WS_HM = al256(WS_G + (size_t)NTOK * 16 * 4);
constexpr size_t WS_YIN = al256(WS_HM + (size_t)2 * NTOK * 1024 * 2);
constexpr size_t WS_Y = al256(WS_YIN + (size_t)NTOK * D * 2);
constexpr size_t WS_AFF = al256(WS_Y + (size_t)NTOK * D * 4);
constexpr size_t WS_SLOT = al256(WS_AFF + (size_t)NTOK * 16 * 4);
constexpr size_t WS_EROW = al256(WS_SLOT + (size_t)NTOK * 16 * 4);
constexpr size_t WS_EGATE = al256(WS_EROW + (size_t)NEXP * EPAD * 4);
constexpr size_t WS_ACT = al256(WS_EGATE + (size_t)NEXP * EPAD * 4);
constexpr size_t WS_YEXP = al256(WS_ACT + (size_t)NEXP * EPAD * FF * 2);
constexpr size_t WS_LRUS = al256(WS_YEXP + (size_t)NEXP * EPAD * D * 2);
constexpr size_t WS_LRUW = al256(WS_LRUS + (size_t)2 * 2 * 4 * 68 * 1024 * 4);
constexpr size_t WS_WT_ABIN = al256(WS_LRUW + (size_t)32 * 128 * 128 * 2);
constexpr size_t WS_WT_ABOUT = al256(WS_WT_ABIN + (size_t)AB_IN * D * 2);
constexpr size_t WS_WT_CDIN = al256(WS_WT_ABOUT + (size_t)D * D * 2);
constexpr size_t WS_WT_CDOUT = al256(WS_WT_CDIN + (size_t)CD_IN * D * 2);
constexpr size_t WS_WT_W1 = al256(WS_WT_CDOUT + (size_t)D * D * 2);
constexpr size_t WS_WT_W3 = al256(WS_WT_W1 + (size_t)NEXP * D * FF * 2);
constexpr size_t WS_WT_W2 = al256(WS_WT_W3 + (size_t)NEXP * D * FF * 2);
constexpr size_t WS_END = al256(WS_WT_W2 + (size_t)NEXP * D * FF * 2);

extern __shared__ __attribute__((aligned(16))) unsigned char g_lds[];

struct Params {
    const float *x, *c, *ctx, *c_ctx, *ada_w, *ada_b, *norm_mix_pre, *norm_mix_post, *norm_ffn_pre, *norm_ffn_post;
    const float *ab_w_in, *ab_w_out, *mlstm_gate_b, *mlstm_norm, *na_rpb;
    const float *cd_w_in, *cd_w_out, *gqa_sink, *lru_conv_w, *lru_conv_b, *lru_gate_w, *lru_gate_b, *lru_lambda;
    const float *moe_router, *moe_w1, *moe_w3, *moe_w2;
    float* out;
    unsigned char* ws;
    int ph_lo, ph_hi;
};

#define XB_TMO      128
#define XB_XCNT(j)  (256  + 64 * (j))
#define XB_XSUB(j)  (1280 + 64 * (j))
#define XB_XGEN(j)  (2304 + 64 * (j))
#define XB_TOP      3328
#define XB_TOPGEN   3392
#define XCD_BAR_WORDS 3456
#define XB_SPIN_CAP (1u << 22)
#define LAS __attribute__((address_space(3)))

__device__ __forceinline__ unsigned xb_ld(unsigned* p)              { return __hip_atomic_load(p, __ATOMIC_RELAXED, __HIP_MEMORY_SCOPE_AGENT); }
__device__ __forceinline__ unsigned xb_add(unsigned* p, unsigned v) { return __hip_atomic_fetch_add(p, v, __ATOMIC_RELAXED, __HIP_MEMORY_SCOPE_AGENT); }
__device__ __forceinline__ unsigned xb_xcc_id() { return (unsigned)__builtin_amdgcn_s_getreg((3 << 11) | 20) & 0xFu; }
#define XB_SPIN(cond, bar) do { unsigned _sp = 0; while (cond) { __builtin_amdgcn_s_sleep(1); \
    if ((++_sp & 255u) == 0u) { if (xb_ld(&(bar)[XB_TMO])) break; if (_sp > XB_SPIN_CAP) { atomicAdd(&(bar)[XB_TMO], 1u); break; } } } } while (0)

struct XcdBarrier {
    unsigned* bar; unsigned x;
    volatile LAS unsigned* st;
};
__device__ __forceinline__ XcdBarrier xcd_barrier_post(unsigned* bar, volatile LAS unsigned* st) {
    XcdBarrier b; b.bar = bar; b.x = xb_xcc_id(); b.st = st;
    if (threadIdx.x == 0) (void)xb_add(&bar[XB_XCNT(b.x)], 1u);
    return b;
}
__device__ __forceinline__ void xcd_barrier_complete(unsigned* bar, unsigned x, unsigned& nloc, unsigned& nx) {
    const unsigned G = gridDim.x * gridDim.y * gridDim.z;
    unsigned sum, cnt, mine, sp = 0u;
    for (;;) {
        sum = 0u; cnt = 0u; mine = 0u;
#pragma unroll
        for (unsigned j = 0; j < 16; ++j) { const unsigned c = xb_ld(&bar[XB_XCNT(j)]); sum += c; cnt += (c > 0u) ? 1u : 0u; mine = (j == x) ? c : mine; }
        if (sum == G) break;
        __builtin_amdgcn_s_sleep(1);
        if ((++sp & 255u) == 0u) { if (xb_ld(&bar[XB_TMO])) break; if (sp > XB_SPIN_CAP) { atomicAdd(&bar[XB_TMO], 1u); break; } }
    }
    nloc = mine > 0u ? mine : 1u; nx = cnt > 0u ? cnt : 1u;
}
__device__ __forceinline__ void xcd_barrier(const XcdBarrier& b) {
    asm volatile("s_waitcnt vmcnt(0)" ::: "memory");
    __syncthreads();
    if (threadIdx.x == 0) {
        unsigned* bar = b.bar;
        __builtin_amdgcn_s_waitcnt(0);
        unsigned nloc = b.st[0], nx = b.st[1];
        if (nloc == 0u) { xcd_barrier_complete(bar, b.x, nloc, nx); b.st[0] = nloc; b.st[1] = nx; }
        const unsigned old = xb_add(&bar[XB_XSUB(b.x)], 1u);
        const unsigned gen = old / nloc;
        if (old + 1u == (gen + 1u) * nloc) {
            __builtin_amdgcn_fence(__ATOMIC_RELEASE, "agent");
            asm volatile("s_waitcnt vmcnt(0)" ::: "memory");
            const unsigned og = xb_add(&bar[XB_TOP], 1u);
            const unsigned tg = og / nx;
            if (og + 1u == (tg + 1u) * nx) xb_add(&bar[XB_TOPGEN], 1u);
            else XB_SPIN(xb_ld(&bar[XB_TOPGEN]) == tg, bar);
            __builtin_amdgcn_fence(__ATOMIC_ACQUIRE, "agent");
            xb_add(&bar[XB_XGEN(b.x)], 1u);
            asm volatile("s_waitcnt vmcnt(0)" ::: "memory");
        } else {
            XB_SPIN(xb_ld(&bar[XB_XGEN(b.x)]) == gen, bar);
            __builtin_amdgcn_fence(__ATOMIC_ACQUIRE, "agent");
            asm volatile("s_waitcnt vmcnt(0)" ::: "memory");
        }
    }
    __syncthreads();
}

typedef float f32x2_t __attribute__((ext_vector_type(2)));
typedef __bf16 bf16x2_t __attribute__((ext_vector_type(2)));
__device__ __forceinline__ unsigned pk_bf16(float lo, float hi) { f32x2_t v = {lo, hi}; return __builtin_bit_cast(unsigned, __builtin_convertvector(v, bf16x2_t)); }
__device__ __forceinline__ float bf_lo(unsigned u) { return __uint_as_float(u << 16); }
__device__ __forceinline__ float bf_hi(unsigned u) { return __uint_as_float(u & 0xffff0000u); }
__device__ __forceinline__ float bf2f(u16 v) { return __uint_as_float(((unsigned)v) << 16); }
__device__ __forceinline__ u16 f2bf(float f) { return (u16)(pk_bf16(f, 0.f) & 0xffffu); }
template <int CTRL> __device__ __forceinline__ float dpp_f(float v) { return __uint_as_float((unsigned)__builtin_amdgcn_update_dpp(0, (int)__float_as_uint(v), CTRL, 0xf, 0xf, true)); }
__device__ __forceinline__ float row_sum16(float v) { v += dpp_f<0xB1>(v); v += dpp_f<0x4E>(v); v += dpp_f<0x141>(v); v += dpp_f<0x140>(v); return v; }
__device__ __forceinline__ float row_max16(float v) { v = fmaxf(v, dpp_f<0xB1>(v)); v = fmaxf(v, dpp_f<0x4E>(v)); v = fmaxf(v, dpp_f<0x141>(v)); v = fmaxf(v, dpp_f<0x140>(v)); return v; }
__device__ __forceinline__ float rdlane_f(float v, int l) { return __uint_as_float((unsigned)__builtin_amdgcn_readlane((int)__float_as_uint(v), l)); }
__device__ __forceinline__ float sum_x16(float v) { const auto r = __builtin_amdgcn_permlane16_swap(__float_as_uint(v), __float_as_uint(v), false, false); return __uint_as_float(r[0]) + __uint_as_float(r[1]); }
__device__ __forceinline__ float sum_x32(float v) { const auto r = __builtin_amdgcn_permlane32_swap(__float_as_uint(v), __float_as_uint(v), false, false); return __uint_as_float(r[0]) + __uint_as_float(r[1]); }
__device__ __forceinline__ float max_x16(float v) { const auto r = __builtin_amdgcn_permlane16_swap(__float_as_uint(v), __float_as_uint(v), false, false); return fmaxf(__uint_as_float(r[0]), __uint_as_float(r[1])); }
__device__ __forceinline__ float max_x32(float v) { const auto r = __builtin_amdgcn_permlane32_swap(__float_as_uint(v), __float_as_uint(v), false, false); return fmaxf(__uint_as_float(r[0]), __uint_as_float(r[1])); }
__device__ __forceinline__ float partner_x16(float v) { const auto r = __builtin_amdgcn_permlane16_swap(__float_as_uint(v), __float_as_uint(v), false, false); return __uint_as_float(r[0] ^ r[1] ^ __float_as_uint(v)); }
__device__ __forceinline__ float partner_x32(float v) { const auto r = __builtin_amdgcn_permlane32_swap(__float_as_uint(v), __float_as_uint(v), false, false); return __uint_as_float(r[0] ^ r[1] ^ __float_as_uint(v)); }
__device__ __forceinline__ float wave_sum(float v) { return sum_x32(sum_x16(row_sum16(v))); }
__device__ __forceinline__ float wave_max(float v) { return max_x32(max_x16(row_max16(v))); }
__device__ __forceinline__ int hw_slot_() { return (int)(__builtin_amdgcn_s_getreg((5 << 11) | 4) & 63u); }
__device__ __forceinline__ int tid_() {
    int lane; asm volatile("v_mbcnt_lo_u32_b32 %0, -1, 0\n\tv_mbcnt_hi_u32_b32 %0, -1, %0" : "=v"(lane));
    const int w = ((volatile LAS int*)(g_lds))[8 + hw_slot_()];
    int t = __builtin_amdgcn_readfirstlane(w) * 64 + lane; asm volatile("" : "+v"(t)); return t; }
__device__ __forceinline__ int bid_() { int b = blockIdx.x; asm volatile("" : "+s"(b)); return b; }
__device__ __forceinline__ int gdim_() { int b = gridDim.x; asm volatile("" : "+s"(b)); return b; }
__device__ __forceinline__ float frcp_(float x) { return __builtin_amdgcn_rcpf(x); }
__device__ __forceinline__ float sigmoidf_(float x) { return frcp_(1.f + __expf(-x)); }
__device__ __forceinline__ f32x4 mfma16(bf16x8 a, bf16x8 b, f32x4 c) { return __builtin_amdgcn_mfma_f32_16x16x32_bf16(a, b, c, 0, 0, 0); }
__device__ __forceinline__ bf16x8 ld_frag_g(const u16* p) { return *reinterpret_cast<const bf16x8*>(p); }
__device__ __forceinline__ bf16x8 ld_frag_s(const u16* p) { return *reinterpret_cast<const bf16x8*>(p); }
__device__ __forceinline__ bf16x8 mk_frag(unsigned a, unsigned b, unsigned c, unsigned d) { u32x4 v = {a, b, c, d}; return __builtin_bit_cast(bf16x8, v); }

__device__ __forceinline__ const float* xin_row(const Params& p, int l, int row) {
    if (l == 0) return row < NLAT ? p.x + (size_t)row * D : p.ctx + (size_t)(row - NLAT) * D;
    return (const float*)(p.ws + WS_XL2) + (size_t)row * D;
}
__device__ __forceinline__ const float* mod_ptr(const Params& p, int l, int row, int chunk) {
    const int bb = row < NLAT ? (row >> 12) : 4;
    return (const float*)(p.ws + WS_MOD) + ((size_t)(l * 5 + bb) * 6 + chunk) * D;
}

__device__ void phase_mod(const Params& p, unsigned char* lds_raw) {
    float* scond = (float*)lds_raw;
    float* red = scond + 5 * D;
    const int t = tid_();
    for (int i = t; i < 5 * D; i += NT) { const int r = i >> 11, k = i & 2047; const float v = r < 4 ? p.c[r * D + k] : p.c_ctx[k]; scond[i] = v / (1.f + __expf(-v)); }
    __syncthreads();
    float* mod = (float*)(p.ws + WS_MOD);
    for (int item = bid_(); item < 192; item += gdim_()) {
        const int l = item / 96, col0 = (item % 96) * 128;
        const int kg = t >> 5, cl = (t & 31) * 4;
        f32x4 acc[5];
#pragma unroll
        for (int r = 0; r < 5; ++r) acc[r] = (f32x4){0.f, 0.f, 0.f, 0.f};
        const float* wp = p.ada_w + ((size_t)l * D + kg * 128) * (6 * D) + col0 + cl;
#pragma unroll 8
        for (int kk = 0; kk < 128; ++kk) {
            const f32x4 w = *reinterpret_cast<const f32x4*>(wp + (size_t)kk * (6 * D));
#pragma unroll
            for (int r = 0; r < 5; ++r) { const float s = scond[r * D + kg * 128 + kk]; acc[r] += w * s; }
        }
#pragma unroll
        for (int r = 0; r < 5; ++r) *reinterpret_cast<f32x4*>(red + (kg * 5 + r) * 128 + cl) = acc[r];
        __syncthreads();
        for (int o = t; o < 640; o += NT) {
            const int r = o >> 7, cc = o & 127;
            float s = p.ada_b[l * 6 * D + col0 + cc];
#pragma unroll
            for (int g = 0; g < 16; ++g) s += red[(g * 5 + r) * 128 + cc];
            mod[(size_t)(l * 5 + r) * 6 * D + col0 + cc] = s;
        }
        __syncthreads();
    }
}

__device__ void phase_norm_mod(const Params& p, int l) {
    const int lane = tid_() & 63, w = tid_() >> 6;
    u16* H = (u16*)(p.ws + WS_H);
    for (int row = bid_() * 8 + w; row < NTOK; row += gdim_() * 8) {
        const float* xr = xin_row(p, l, row);
        f32x4 v[8]; float ss = 0.f;
#pragma unroll
        for (int i = 0; i < 8; ++i) { v[i] = *reinterpret_cast<const f32x4*>(xr + (i * 64 + lane) * 4); ss += v[i][0] * v[i][0] + v[i][1] * v[i][1] + v[i][2] * v[i][2] + v[i][3] * v[i][3]; }
        ss = wave_sum(ss);
        const float rstd = rsqrtf(ss * (1.f / D) + 1e-6f);
        const float* sh = mod_ptr(p, l, row, 0); const float* sc = mod_ptr(p, l, row, 1);
        const float* nw = p.norm_mix_pre + (size_t)l * D;
#pragma unroll
        for (int i = 0; i < 8; ++i) {
            const int col = (i * 64 + lane) * 4;
            const f32x4 w4 = *reinterpret_cast<const f32x4*>(nw + col), s4 = *reinterpret_cast<const f32x4*>(sc + col), h4 = *reinterpret_cast<const f32x4*>(sh + col);
            f32x4 o = v[i] * rstd * w4 * (s4 + 1.f) + h4;
            u32x2 pk = {pk_bf16(o[0], o[1]), pk_bf16(o[2], o[3])};
            *reinterpret_cast<u32x2*>(H + (size_t)row * D + col) = pk;
        }
    }
}

__device__ __forceinline__ void convert_item(const float* W, int N, u16* Wt, int kb, int nb, unsigned char* lds) {
    const int t = tid_(), lane = t & 63, w = t >> 6;
    const int n4 = lane * 4, k0 = kb * 64 + w * 8, n0 = nb * 256;
    int col = n0 + n4; if (col > N - 4) col = N - 4;
    f32x4 r8[8];
#pragma unroll
    for (int j = 0; j < 8; ++j) r8[j] = *reinterpret_cast<const f32x4*>(W + (size_t)(k0 + j) * N + col);
    __syncthreads();
#pragma unroll
    for (int jj = 0; jj < 4; ++jj) {
        u32x4 v = {pk_bf16(r8[0][jj], r8[1][jj]), pk_bf16(r8[2][jj], r8[3][jj]), pk_bf16(r8[4][jj], r8[5][jj]), pk_bf16(r8[6][jj], r8[7][jj])};
        const int r = n4 + jj;
        *reinterpret_cast<u32x4*>(lds + r * 128 + ((w ^ ((r >> 2) & 7)) << 4)) = v;
    }
    __syncthreads();
    const int c = t & 7;
#pragma unroll
    for (int i = 0; i < 4; ++i) {
        const int r = (t >> 3) + 64 * i;
        if (n0 + r < N) {
            const u32x4 v = *reinterpret_cast<const u32x4*>(lds + r * 128 + ((c ^ ((r >> 2) & 7)) << 4));
            *reinterpret_cast<u32x4*>(Wt + (size_t)(n0 + r) * 2048 + kb * 64 + c * 8) = v;
        }
    }
}
__device__ void convert_matrix_items(const float* W, int N, u16* Wt, int first, int count, unsigned char* lds) {
    const int nnb = (N + 255) / 256;
    for (int it = first; it < first + count; ++it) convert_item(W, N, Wt, it / nnb, it % nnb, lds);
}
__device__ void phase_convert_dense(const Params& p, unsigned char* lds) {
    for (int item = bid_(); item < 1888; item += gdim_()) {
        if (item < 928) convert_item(p.ab_w_in, AB_IN, (u16*)(p.ws + WS_WT_ABIN), item / 29, item % 29, lds);
        else if (item < 1184) { const int it = item - 928; convert_item(p.ab_w_out, D, (u16*)(p.ws + WS_WT_ABOUT), it / 8, it % 8, lds); }
        else if (item < 1632) { const int it = item - 1184; convert_item(p.cd_w_in, CD_IN, (u16*)(p.ws + WS_WT_CDIN), it / 14, it % 14, lds); }
        else { const int it = item - 1632; convert_item(p.cd_w_out, D, (u16*)(p.ws + WS_WT_CDOUT), it / 8, it % 8, lds); }
    }
}
__device__ void phase_convert_moe(const Params& p, int l, unsigned char* lds) {
    for (int item = bid_(); item < 3 * NEXP * 256; item += gdim_()) {
        const int which = item / (NEXP * 256), r = item % (NEXP * 256), ex = r >> 8, it = r & 255;
        const float* src = (which == 0 ? p.moe_w1 : (which == 1 ? p.moe_w3 : p.moe_w2)) + (size_t)(l * NEXP + ex) * D * FF;
        u16* dst = (u16*)(p.ws + (which == 0 ? WS_WT_W1 : (which == 1 ? WS_WT_W3 : WS_WT_W2))) + (size_t)ex * D * FF;
        convert_item(src, 2048, dst, it >> 3, it & 7, lds);
    }
}

__device__ __forceinline__ int g8_lds_byte(int r, int c) { const int st = (r >> 4) * 2 + (c >> 5), rr = r & 15, cc = c & 31, ob = rr * 64 + cc * 2; return st * 1024 + (ob ^ (((ob >> 9) & 1) << 5)); }
__device__ __forceinline__ void g8_stage_rc(int bb, int& R, int& C) { const int st = bb / 1024, sb = bb % 1024, swz = sb ^ (((sb >> 9) & 1) << 5); R = (st >> 1) * 16 + swz / 64; C = (st & 1) * 32 + (swz % 64) / 2; }
__device__ __forceinline__ int g8_perm32(int rho) { const int n = rho >> 4, i = rho & 15; return 8 * (i >> 2) + 4 * n + (i & 3); }

enum { EPI_BF16 = 0, EPI_SWIGLU = 2, EPI_SCALE = 3 };
struct GUnit { const char* a; const char* b0; const char* b1; const int* arow; int m0, n0, mvalid, ncols; u16* ob; int ldo; float* gates; const float* rscale; };
constexpr int G8_HTB = 128 * 64 * 2;
constexpr size_t G8_KSTEP = 128, G8_HSTEP = (size_t)128 * 2048 * 2;

template <int EPI>
__device__ __forceinline__ void g8_epilogue(const f32x4 (&acc)[2][2][4][2], const GUnit& u, int wr, int wc, int fr, int fq) {
#pragma unroll
    for (int ai = 0; ai < 2; ++ai)
#pragma unroll
        for (int m = 0; m < 4; ++m) {
            const int row = u.m0 + 128 * ai + 64 * wr + 16 * m + fr;
            if (row < u.mvalid) {
                if (EPI == EPI_BF16) {
#pragma unroll
                    for (int bj = 0; bj < 2; ++bj) {
                        const int col = u.n0 + 128 * bj + 32 * wc + 8 * fq;
                        if (col < u.ncols) {
                            const f32x4 v0 = acc[ai][bj][m][0], v1 = acc[ai][bj][m][1];
                            u32x4 pk = {pk_bf16(v0[0], v0[1]), pk_bf16(v0[2], v0[3]), pk_bf16(v1[0], v1[1]), pk_bf16(v1[2], v1[3])};
                            *reinterpret_cast<u32x4*>(u.ob + (size_t)row * u.ldo + col) = pk;
                            if (u.gates && col >= 4096 && col < 4112) { *reinterpret_cast<f32x4*>(u.gates + (size_t)row * 16 + (col - 4096)) = v0; *reinterpret_cast<f32x4*>(u.gates + (size_t)row * 16 + (col - 4096) + 4) = v1; }
                        }
                    }
                } else if (EPI == EPI_SWIGLU) {
                    const int col = u.n0 + 32 * wc + 8 * fq;
                    float a[8];
#pragma unroll
                    for (int n = 0; n < 2; ++n)
#pragma unroll
                        for (int q = 0; q < 4; ++q) { const float x = acc[ai][0][m][n][q]; a[n * 4 + q] = x * frcp_(1.f + __expf(-x)) * acc[ai][1][m][n][q]; }
                    u32x4 pk = {pk_bf16(a[0], a[1]), pk_bf16(a[2], a[3]), pk_bf16(a[4], a[5]), pk_bf16(a[6], a[7])};
                    *reinterpret_cast<u32x4*>(u.ob + (size_t)row * u.ldo + col) = pk;
                } else {
                    const float sc = u.rscale[row];
#pragma unroll
                    for (int bj = 0; bj < 2; ++bj) {
                        const int col = u.n0 + 128 * bj + 32 * wc + 8 * fq;
                        const f32x4 v0 = acc[ai][bj][m][0] * sc, v1 = acc[ai][bj][m][1] * sc;
                        u32x4 pk = {pk_bf16(v0[0], v0[1]), pk_bf16(v0[2], v0[3]), pk_bf16(v1[0], v1[1]), pk_bf16(v1[2], v1[3])};
                        *reinterpret_cast<u32x4*>(u.ob + (size_t)row * u.ldo + col) = pk;
                    }
                }
            }
        }
}

template <int EPI, bool GATHER, class UnitFn>
__device__ __forceinline__ void gemm_phase8(unsigned char* lds, UnitFn next) {
    const int tid = tid_(), wid = __builtin_amdgcn_readfirstlane(tid >> 6), lane = tid & 63, wr = wid >> 2, wc = wid & 3, fr = lane & 15, fq = lane >> 4;
    constexpr int nt = 2048 / 64;
    GUnit cur, nxt; int ui = 0;
    if (!next(0, cur)) return;
    int sR[2], sC[2];
#pragma unroll
    for (int i = 0; i < 2; ++i) g8_stage_rc(tid * 16 + i * 8192, sR[i], sC[i]);
    unsigned voffB[2];
#pragma unroll
    for (int i = 0; i < 2; ++i) voffB[i] = (unsigned)(((sR[i] & ~31) + g8_perm32(sR[i] & 31)) * 2048 + sC[i]) * 2u;
    unsigned voffA[2][2], voffAn[2][2];
    auto set_voffA = [&](const GUnit& u, unsigned (&vo)[2][2]) {
#pragma unroll
        for (int h = 0; h < 2; ++h)
#pragma unroll
            for (int i = 0; i < 2; ++i) {
                if (GATHER) vo[h][i] = (unsigned)(u.arow[u.m0 + h * 128 + sR[i]] * 2048 + sC[i]) * 2u;
                else vo[h][i] = (unsigned)((h * 128 + sR[i]) * 2048 + sC[i]) * 2u;
            } };
    set_voffA(cur, voffA);
    const unsigned ldsw = (unsigned)wid * 1024u;
    const int aoff = g8_lds_byte(wr * 64 + fr, fq * 8), boff = g8_lds_byte(wc * 32 + fr, fq * 8);
#define G8_SA(b, h) (((b) * 2 + (h)) * G8_HTB)
#define G8_SB(b, h) ((4 + (b) * 2 + (h)) * G8_HTB)
#define G8_STAGE(bufoff, gbase, voff) do { _Pragma("unroll") for (int _i = 0; _i < 2; ++_i) \
        __builtin_amdgcn_global_load_lds((const unsigned*)((const char*)(gbase) + (voff)[_i]), (LAS unsigned*)(lds + (bufoff) + ldsw + _i * 8192), 16, 0, 0); } while (0)
#define G8_LDA(dst, b, h) do { _Pragma("unroll") for (int m = 0; m < 4; ++m) _Pragma("unroll") for (int k = 0; k < 2; ++k) dst[m][k] = *(const LAS bf16x8*)(lds + G8_SA(b, h) + aoff + m * 2048 + k * 1024); } while (0)
#define G8_LDB(dst, b, h) do { _Pragma("unroll") for (int n = 0; n < 2; ++n) _Pragma("unroll") for (int k = 0; k < 2; ++k) dst[n][k] = *(const LAS bf16x8*)(lds + G8_SB(b, h) + boff + n * 2048 + k * 1024); } while (0)
#define G8_MMA(ai, bj, At, Bt) do { __builtin_amdgcn_s_setprio(1); _Pragma("unroll") for (int m = 0; m < 4; ++m) _Pragma("unroll") for (int n = 0; n < 2; ++n) _Pragma("unroll") for (int k = 0; k < 2; ++k) \
        acc[ai][bj][m][n] = __builtin_amdgcn_mfma_f32_16x16x32_bf16(Bt[n][k], At[m][k], acc[ai][bj][m][n], 0, 0, 0); __builtin_amdgcn_s_setprio(0); } while (0)
#define G8_WAIT_V(n) asm volatile("s_waitcnt vmcnt(" #n ")" ::: "memory")
#define G8_WAIT_L(n) asm volatile("s_waitcnt lgkmcnt(" #n ")" ::: "memory")
#define G8_BAR __builtin_amdgcn_s_barrier()
#define G8_SCHED __builtin_amdgcn_sched_barrier(0)
    f32x4 acc[2][2][4][2];
#pragma unroll
    for (int a2 = 0; a2 < 2; ++a2)
#pragma unroll
        for (int b2 = 0; b2 < 2; ++b2)
#pragma unroll
            for (int m = 0; m < 4; ++m)
#pragma unroll
                for (int n = 0; n < 2; ++n) acc[a2][b2][m][n] = (f32x4){0.f, 0.f, 0.f, 0.f};
    bf16x8 At[4][2], B0[2][2], B1[2][2];
    const char* cA = cur.a; const char* cB0 = cur.b0; const char* cB1 = cur.b1;
    G8_STAGE(G8_SB(0, 0), cB0, voffB); G8_STAGE(G8_SA(0, 0), cA, voffA[0]); G8_STAGE(G8_SB(0, 1), cB1, voffB); G8_STAGE(G8_SA(0, 1), cA, voffA[1]);
    if (wr == 1) G8_BAR;
    G8_WAIT_V(4); G8_BAR;
    G8_STAGE(G8_SB(1, 0), cB0 + G8_KSTEP, voffB); G8_STAGE(G8_SA(1, 0), cA + G8_KSTEP, voffA[0]); G8_STAGE(G8_SB(1, 1), cB1 + G8_KSTEP, voffB);
    G8_WAIT_V(6); G8_BAR;
    for (;;) {
        const bool has_next = next(ui + 1, nxt);
        const char* nA = has_next ? nxt.a : cA; const char* nB0 = has_next ? nxt.b0 : cB0; const char* nB1 = has_next ? nxt.b1 : cB1;
        if (GATHER) { if (has_next) set_voffA(nxt, voffAn); else { _Pragma("unroll") for (int h = 0; h < 2; ++h) _Pragma("unroll") for (int i = 0; i < 2; ++i) voffAn[h][i] = voffA[h][i]; } }
        for (int t = 0; t < nt; t += 2) {
            const bool last = (t == nt - 2);
            const char* a1 = cA + (size_t)(t + 1) * G8_KSTEP;
            const char* a2 = last ? nA : cA + (size_t)(t + 2) * G8_KSTEP;
            const char* b20 = last ? nB0 : cB0 + (size_t)(t + 2) * G8_KSTEP; const char* b21 = last ? nB1 : cB1 + (size_t)(t + 2) * G8_KSTEP;
            const char* a3 = a2 + G8_KSTEP; const char* b30 = b20 + G8_KSTEP; const char* b31 = b21 + G8_KSTEP;
            unsigned vA2[2][2];
#pragma unroll
            for (int h = 0; h < 2; ++h)
#pragma unroll
                for (int i = 0; i < 2; ++i) vA2[h][i] = (GATHER && last) ? voffAn[h][i] : voffA[h][i];
            G8_LDB(B0, 0, 0); G8_SCHED; G8_LDA(At, 0, 0); G8_STAGE(G8_SA(1, 1), a1, voffA[1]);
            G8_WAIT_L(8); G8_BAR; G8_WAIT_L(0); G8_MMA(0, 0, At, B0); G8_BAR; G8_SCHED;
            G8_LDB(B1, 0, 1); G8_STAGE(G8_SB(0, 0), b20, voffB);
            G8_BAR; G8_WAIT_L(0); G8_MMA(0, 1, At, B1); G8_BAR;
            G8_LDA(At, 0, 1); G8_STAGE(G8_SA(0, 0), a2, vA2[0]);
            G8_BAR; G8_WAIT_L(0); G8_MMA(1, 0, At, B0); G8_BAR; G8_SCHED;
            G8_STAGE(G8_SB(0, 1), b21, voffB);
            G8_WAIT_V(6); G8_BAR; G8_MMA(1, 1, At, B1); G8_BAR;
            G8_LDB(B0, 1, 0); G8_SCHED; G8_LDA(At, 1, 0); G8_STAGE(G8_SA(0, 1), a2, vA2[1]);
            G8_WAIT_L(8); G8_BAR; G8_WAIT_L(0); G8_MMA(0, 0, At, B0); G8_BAR; G8_SCHED;
            G8_LDB(B1, 1, 1); G8_STAGE(G8_SB(1, 0), b30, voffB);
            G8_BAR; G8_WAIT_L(0); G8_MMA(0, 1, At, B1); G8_BAR;
            G8_LDA(At, 1, 1); G8_STAGE(G8_SA(1, 0), a3, vA2[0]);
            G8_BAR; G8_WAIT_L(0); G8_MMA(1, 0, At, B0); G8_BAR; G8_SCHED;
            G8_STAGE(G8_SB(1, 1), b31, voffB);
            G8_WAIT_V(6); G8_BAR; G8_MMA(1, 1, At, B1); G8_BAR;
        }
        g8_epilogue<EPI>(acc, cur, wr, wc, fr, fq);
        if (!has_next) break;
#pragma unroll
        for (int a2 = 0; a2 < 2; ++a2)
#pragma unroll
            for (int b2 = 0; b2 < 2; ++b2)
#pragma unroll
                for (int m = 0; m < 4; ++m)
#pragma unroll
                    for (int n = 0; n < 2; ++n) acc[a2][b2][m][n] = (f32x4){0.f, 0.f, 0.f, 0.f};
        cur = nxt; cA = nA; cB0 = nB0; cB1 = nB1; ++ui;
        if (GATHER) { _Pragma("unroll") for (int h = 0; h < 2; ++h) _Pragma("unroll") for (int i = 0; i < 2; ++i) voffA[h][i] = voffAn[h][i]; }
    }
    G8_WAIT_V(0);
    if (wr == 0) G8_BAR;
    G8_BAR;
#undef G8_SA
#undef G8_SB
#undef G8_STAGE
#undef G8_LDA
#undef G8_LDB
#undef G8_MMA
#undef G8_WAIT_V
#undef G8_WAIT_L
#undef G8_BAR
#undef G8_SCHED
}

__device__ __forceinline__ void phase_gemm_dense(const Params& p, const u16* A, int M, const u16* Wt, int N, u16* ob, int ldo, float* gates, unsigned char* lds) {
    const int nM = M / 256, nN = (N + 255) / 256, L = nM * nN;
    const int xcd = bid_() & 7, slot = bid_() >> 3, nslot = gdim_() >> 3;
    const int base = (int)(((long)L * xcd) >> 3), cnt = (int)(((long)L * (xcd + 1)) >> 3) - base;
    const int G8n = nM >> 3, rem = nM & 7;
    auto next = [&](int i, GUnit& u) -> bool {
        const int k = slot + i * nslot;
        if (k >= cnt) return false;
        const int idx = base + k;
        int pn, pm;
        if (idx < G8n * 8 * nN) { const int gq = idx / (8 * nN), r = idx % (8 * nN); pn = r >> 3; pm = gq * 8 + (r & 7); }
        else { const int r = idx - G8n * 8 * nN; pn = r / rem; pm = G8n * 8 + r % rem; }
        u.a = (const char*)(A + (size_t)pm * 256 * 2048); u.b0 = (const char*)(Wt + (size_t)pn * 256 * 2048); u.b1 = u.b0 + G8_HSTEP; u.arow = nullptr;
        u.m0 = pm * 256; u.n0 = pn * 256; u.mvalid = M; u.ncols = N; u.ob = ob; u.ldo = ldo; u.gates = gates; u.rscale = nullptr;
        return true; };
    gemm_phase8<EPI_BF16, false>(lds, next);
}

__device__ __forceinline__ void phase_moe_a(const Params& p, int l, unsigned char* lds) {
    const int mvalid = l == 0 ? 2176 : 2048, nM = l == 0 ? 9 : 8;
    const int per_e = nM * 16;
    const int xcd = bid_() & 7, slot = bid_() >> 3, nslot = gdim_() >> 3;
    auto next = [&](int i, GUnit& u) -> bool {
        const int k = slot + i * nslot;
        if (k >= 2 * per_e) return false;
        const int tile = xcd * 2 * per_e + k;
        const int ex = tile / per_e, r = tile % per_e, pn = r / nM, pm = r % nM;
        u.a = (const char*)(p.ws + WS_H); u.arow = (const int*)(p.ws + WS_EROW) + ex * EPAD;
        u.b0 = (const char*)((const u16*)(p.ws + WS_WT_W1) + ((size_t)ex * FF + pn * 128) * D); u.b1 = (const char*)((const u16*)(p.ws + WS_WT_W3) + ((size_t)ex * FF + pn * 128) * D);
        u.m0 = pm * 256; u.n0 = pn * 128; u.mvalid = mvalid; u.ncols = FF; u.ob = (u16*)(p.ws + WS_ACT) + (size_t)ex * EPAD * FF; u.ldo = FF; u.gates = nullptr; u.rscale = nullptr;
        return true; };
    gemm_phase8<EPI_SWIGLU, true>(lds, next);
}
__device__ __forceinline__ void phase_moe_b(const Params& p, int l, unsigned char* lds) {
    const int mvalid = l == 0 ? 2176 : 2048, nM = l == 0 ? 9 : 8;
    const int per_e = nM * 8;
    const int xcd = bid_() & 7, slot = bid_() >> 3, nslot = gdim_() >> 3;
    auto next = [&](int i, GUnit& u) -> bool {
        const int k = slot + i * nslot;
        if (k >= 2 * per_e) return false;
        const int tile = xcd * 2 * per_e + k;
        const int ex = tile / per_e, r = tile % per_e, pn = r / nM, pm = r % nM;
        u.a = (const char*)((const u16*)(p.ws + WS_ACT) + ((size_t)ex * EPAD + pm * 256) * FF); u.arow = nullptr;
        u.b0 = (const char*)((const u16*)(p.ws + WS_WT_W2) + ((size_t)ex * D + pn * 256) * FF); u.b1 = u.b0 + G8_HSTEP;
        u.m0 = pm * 256; u.n0 = pn * 256; u.mvalid = mvalid; u.ncols = D; u.ob = (u16*)(p.ws + WS_YEXP) + (size_t)ex * EPAD * D; u.ldo = D; u.gates = nullptr;
        u.rscale = (const float*)(p.ws + WS_EGATE) + ex * EPAD;
        return true; };
    gemm_phase8<EPI_SCALE, false>(lds, next);
}

__device__ __forceinline__ int mlstm_row(int b, int dir, int pos) {
    if (pos < LC) return NLAT + b * LC + (dir ? (LC - 1 - pos) : pos);
    const int q = pos - LC; return b * SEQ + (dir ? (SEQ - 1 - q) : q);
}
__device__ void phase_mlstm(const Params& p, unsigned char* lds) {
    u16* KT = (u16*)lds;
    u16* VT = KT + 256 * 72;
    u16* VWT = VT + 48 * 72;
    u16* CT = VWT + 48 * 72;
    u16* Ss = CT + 48 * 264;
    float* gB = (float*)(Ss + 64 * 72);
    float* gI = gB + 68 * 64;
    float* gP = gI + 68 * 64;
    float* gE = gP + 68 * 64;
    const int t = tid_(), lane = t & 63, w = t >> 6, fr = lane & 15, fq = lane >> 4;
    const u16* P = (const u16*)(p.ws + WS_P);
    const float* G = (const float*)(p.ws + WS_G);
    u16* HM = (u16*)(p.ws + WS_HM);
    for (int item = bid_(); item < 256; item += gdim_()) {
        const int vs = item & 7, dir = (item >> 3) & 1, hh = (item >> 4) & 3, b = item >> 6;
        __syncthreads();
        for (int i = t; i < 48 * 264; i += NT) CT[i] = 0;
        for (int i = t; i < 16 * 72; i += NT) { const int er = i / 72; VT[32 * 72 + i] = (er == 0) ? (u16)0x3f80 : (u16)0; VWT[32 * 72 + i] = 0; }
        {
            const float gb_i = p.mlstm_gate_b[(dir * 2 + 0) * 4 + hh], gb_f = p.mlstm_gate_b[(dir * 2 + 1) * 4 + hh];
            for (int ch = w; ch < 68; ch += 8) {
                const int row = mlstm_row(b, dir, ch * 64 + lane);
                const float gi = G[(size_t)row * 16 + dir * 8 + hh] + gb_i;
                const float gf = G[(size_t)row * 16 + dir * 8 + 4 + hh] + gb_f;
                const float lf = fminf(gf, 0.f) - log1pf(__expf(-fabsf(gf)));
                float bc = lf;
#pragma unroll
                for (int o = 1; o < 64; o <<= 1) { const float n = __shfl_up(bc, o, 64); if (lane >= o) bc += n; }
                float pm = gi - bc;
#pragma unroll
                for (int o = 1; o < 64; o <<= 1) { const float n = __shfl_up(pm, o, 64); if (lane >= o) pm = fmaxf(pm, n); }
                const float b63 = __shfl(bc, 63, 64);
                float gmax = b63 - bc + gi;
#pragma unroll
                for (int o = 32; o > 0; o >>= 1) gmax = fmaxf(gmax, __shfl_xor(gmax, o, 64));
                gB[ch * 64 + lane] = bc; gI[ch * 64 + lane] = gi; gP[ch * 64 + lane] = pm;
                if (lane == 0) { gE[ch * 2] = b63; gE[ch * 2 + 1] = gmax; }
            }
        }
        f32x4 Cacc[2][3];
#pragma unroll
        for (int i = 0; i < 2; ++i)
#pragma unroll
            for (int j = 0; j < 3; ++j) Cacc[i][j] = (f32x4){0.f, 0.f, 0.f, 0.f};
        float m_old = 0.f;
        const int jt = w & 3, sth = w >> 2;
        const int vs_s = t & 63, vs_eg = t >> 6;
        bf16x8 qf[8]; unsigned ktr[2][8]; u32x2 vraw;
        const int jq = jt * 16 + fr, jjq = dir ? 63 - jq : jq;
        const unsigned off_q = (unsigned)jjq * AB_IN + hh * 256 + fq * 8;
        const int jk0 = (sth * 2) * 16 + fr, jk1 = jk0 + 16;
        const unsigned off_k0 = (unsigned)(dir ? 63 - jk0 : jk0) * AB_IN + 1024 + hh * 256 + fq * 8;
        const unsigned off_k1 = (unsigned)(dir ? 63 - jk1 : jk1) * AB_IN + 1024 + hh * 256 + fq * 8;
        unsigned off_kt[2];
#pragma unroll
        for (int i = 0; i < 2; ++i) { const int mt = t + NT * i, d2 = (mt & 127) * 2, s8 = (mt >> 7) * 8; off_kt[i] = (unsigned)(dir ? 63 - s8 - 7 : s8) * AB_IN + 1024 + hh * 256 + d2; }
        const unsigned off_v = (unsigned)(dir ? 63 - vs_s : vs_s) * AB_IN + 2048 + hh * 256 + vs * 32 + vs_eg * 4;
        const unsigned off_h = (unsigned)jjq * 1024 + hh * 256 + vs * 32 + sth * 16 + 4 * fq;
#define ML_BASE(POS0) (P + (size_t)(dir ? mlstm_row(b, dir, (POS0)) - 63 : mlstm_row(b, dir, (POS0))) * AB_IN)
#define ML_LOAD_Q(POS0) do { const u16* _pc = ML_BASE(POS0); \
            _Pragma("unroll") for (int kk = 0; kk < 8; ++kk) qf[kk] = ld_frag_g(_pc + off_q + kk * 32); } while (0)
#define ML_LOAD_K(POS0, S2) do { const u16* _pc = ML_BASE(POS0); \
            _Pragma("unroll") for (int kk = 0; kk < 8; ++kk) kf[kk] = ld_frag_g(_pc + ((S2) ? off_k1 : off_k0) + kk * 32); } while (0)
#define ML_LOAD_KTV(POS0) do { const u16* _pc = ML_BASE(POS0); \
            _Pragma("unroll") for (int i = 0; i < 2; ++i) { \
                _Pragma("unroll") for (int q = 0; q < 8; ++q) ktr[i][q] = *reinterpret_cast<const unsigned*>(_pc + (size_t)((dir ? 7 - q : q) * AB_IN) + off_kt[i]); } \
            vraw = *reinterpret_cast<const u32x2*>(_pc + off_v); } while (0)
        ML_LOAD_Q(0); ML_LOAD_KTV(0);
        __syncthreads();
        for (int ch = 0; ch < 68; ++ch) {
            const int pos0 = ch * 64;
            const float* sb = gB + ch * 64; const float* sig = gI + ch * 64; const float* spm = gP + ch * 64;
            const float b63 = gE[ch * 2], m_new = fmaxf(b63 + m_old, gE[ch * 2 + 1]), decay = __expf(b63 + m_old - m_new);
            const int jg = jt * 16 + fr;
            const float bj = sb[jg], mj = bj + fmaxf(m_old, spm[jg]);
            auto s_tile = [&](int st) {
                f32x4 sv = (f32x4){0.f, 0.f, 0.f, 0.f};
                if (st <= jt) {
                    typedef short s16x4 __attribute__((ext_vector_type(4)));
                    const u16* kb = KT + (8 * fq + ((lane & 15) >> 2)) * 72 + st * 16 + 4 * (lane & 3);
#pragma unroll
                    for (int kk = 0; kk < 8; ++kk) {
                        const s16x4 lo = __builtin_amdgcn_ds_read_tr16_b64_v4i16((LAS s16x4*)(kb + kk * 32 * 72));
                        const s16x4 hi = __builtin_amdgcn_ds_read_tr16_b64_v4i16((LAS s16x4*)(kb + (kk * 32 + 4) * 72));
                        const bf16x8 kfr = {lo[0], lo[1], lo[2], lo[3], hi[0], hi[1], hi[2], hi[3]};
                        sv = mfma16(kfr, qf[kk], sv);
                    }
                }
                float pv[4];
#pragma unroll
                for (int q = 0; q < 4; ++q) {
                    const int sg = st * 16 + 4 * fq + q;
                    pv[q] = (sg <= jg) ? sv[q] * 0.0625f * __expf(bj - sb[sg] + sig[sg] - mj) : 0.f;
                }
                u32x2 pk = {pk_bf16(pv[0], pv[1]), pk_bf16(pv[2], pv[3])};
                *reinterpret_cast<u32x2*>(Ss + jg * 72 + st * 16 + 4 * fq) = pk;
            };
#pragma unroll
            for (int i = 0; i < 2; ++i) {
                const int mt = t + NT * i, d2 = (mt & 127) * 2, s8 = (mt >> 7) * 8;
                u32x4 lo = {(ktr[i][0] & 0xffffu) | (ktr[i][1] << 16), (ktr[i][2] & 0xffffu) | (ktr[i][3] << 16), (ktr[i][4] & 0xffffu) | (ktr[i][5] << 16), (ktr[i][6] & 0xffffu) | (ktr[i][7] << 16)};
                u32x4 hi = {(ktr[i][0] >> 16) | (ktr[i][1] & 0xffff0000u), (ktr[i][2] >> 16) | (ktr[i][3] & 0xffff0000u), (ktr[i][4] >> 16) | (ktr[i][5] & 0xffff0000u), (ktr[i][6] >> 16) | (ktr[i][7] & 0xffff0000u)};
                *reinterpret_cast<u32x4*>(KT + d2 * 72 + s8) = lo;
                *reinterpret_cast<u32x4*>(KT + (d2 + 1) * 72 + s8) = hi;
            }
            {
                const float wg = __expf(b63 - sb[vs_s] + sig[vs_s] - m_new) * 0.0625f;
                const float v0 = bf_lo(vraw[0]), v1 = bf_hi(vraw[0]), v2 = bf_lo(vraw[1]), v3 = bf_hi(vraw[1]);
                const int e0 = vs_eg * 4;
                VT[(e0 + 0) * 72 + vs_s] = (u16)(vraw[0] & 0xffffu); VT[(e0 + 1) * 72 + vs_s] = (u16)(vraw[0] >> 16);
                VT[(e0 + 2) * 72 + vs_s] = (u16)(vraw[1] & 0xffffu); VT[(e0 + 3) * 72 + vs_s] = (u16)(vraw[1] >> 16);
                VWT[(e0 + 0) * 72 + vs_s] = f2bf(v0 * wg); VWT[(e0 + 1) * 72 + vs_s] = f2bf(v1 * wg);
                VWT[(e0 + 2) * 72 + vs_s] = f2bf(v2 * wg); VWT[(e0 + 3) * 72 + vs_s] = f2bf(v3 * wg);
                if (t < 64) VWT[32 * 72 + t] = f2bf(wg);
            }
            if (ch + 1 < 68) ML_LOAD_KTV(pos0 + 64);
            __syncthreads();
            s_tile(sth * 2);
            s_tile(sth * 2 + 1);
            __syncthreads();
            {
                const float w_inter = __expf(bj + m_old - mj);
                f32x4 nacc[2];
#pragma unroll
                for (int z = 0; z < 2; ++z) {
                    const int et = z == 0 ? sth : 2;
                    f32x4 a = (f32x4){0.f, 0.f, 0.f, 0.f};
#pragma unroll
                    for (int kk = 0; kk < 8; ++kk) a = mfma16(ld_frag_s(CT + (et * 16 + fr) * 264 + kk * 32 + fq * 8), qf[kk], a);
                    nacc[z] = a * w_inter;
                }
                if (ch + 1 < 68) ML_LOAD_Q(pos0 + 64);
#pragma unroll
                for (int z = 0; z < 2; ++z) {
                    const int et = z == 0 ? sth : 2;
                    f32x4 a = nacc[z];
#pragma unroll
                    for (int k2 = 0; k2 < 2; ++k2) a = mfma16(ld_frag_s(VT + (et * 16 + fr) * 72 + k2 * 32 + fq * 8), ld_frag_s(Ss + jg * 72 + k2 * 32 + fq * 8), a);
                    nacc[z] = a;
                }
                const float den = __shfl(nacc[1][0], fr, 64);
                const float dd = fmaxf(fabsf(den), __expf(-mj));
                const float inv = 1.f / dd;
                u32x2 pk = {pk_bf16(nacc[0][0] * inv, nacc[0][1] * inv), pk_bf16(nacc[0][2] * inv, nacc[0][3] * inv)};
                *reinterpret_cast<u32x2*>(HM + ((size_t)dir * NTOK + (dir ? mlstm_row(b, dir, pos0) - 63 : mlstm_row(b, dir, pos0))) * 1024 + off_h) = pk;
            }
#pragma unroll
            for (int i = 0; i < 2; ++i)
#pragma unroll
                for (int et = 0; et < 3; ++et) {
                    f32x4 a = Cacc[i][et] * decay;
#pragma unroll
                    for (int k2 = 0; k2 < 2; ++k2) a = mfma16(ld_frag_s(KT + ((w * 2 + i) * 16 + fr) * 72 + k2 * 32 + fq * 8), ld_frag_s(VWT + (et * 16 + fr) * 72 + k2 * 32 + fq * 8), a);
                    Cacc[i][et] = a;
                }
            __syncthreads();
#pragma unroll
            for (int i = 0; i < 2; ++i)
#pragma unroll
                for (int et = 0; et < 3; ++et) {
                    const f32x4 a = Cacc[i][et];
                    u32x2 pk = {pk_bf16(a[0], a[1]), pk_bf16(a[2], a[3])};
                    *reinterpret_cast<u32x2*>(CT + (et * 16 + fr) * 264 + (w * 2 + i) * 16 + 4 * fq) = pk;
                }
            m_old = m_new;
        }
#undef ML_LOAD_Q
#undef ML_LOAD_K
#undef ML_LOAD_KTV
    }
}

__device__ void mlstm_out_rows(const Params& p, int row0, int nrows) {
    const int lane = tid_() & 63, w = tid_() >> 6;
    const u16* P = (const u16*)(p.ws + WS_P);
    const u16* HM = (const u16*)(p.ws + WS_HM);
    u16* YIN = (u16*)(p.ws + WS_YIN);
    for (int r = w; r < nrows; r += 8) {
        const int row = row0 + r;
        const int c0 = lane * 16;
        float v[16]; float ss = 0.f;
#pragma unroll
        for (int h2 = 0; h2 < 2; ++h2) {
            const u32x4 a = *reinterpret_cast<const u32x4*>(HM + (size_t)row * 1024 + c0 + h2 * 8);
            const u32x4 bq = *reinterpret_cast<const u32x4*>(HM + ((size_t)NTOK + row) * 1024 + c0 + h2 * 8);
#pragma unroll
            for (int q = 0; q < 4; ++q) { v[h2 * 8 + 2 * q] = bf_lo(a[q]) + bf_lo(bq[q]); v[h2 * 8 + 2 * q + 1] = bf_hi(a[q]) + bf_hi(bq[q]); }
        }
#pragma unroll
        for (int q = 0; q < 16; ++q) ss += v[q] * v[q];
        ss += __shfl_xor(ss, 1, 64); ss += __shfl_xor(ss, 2, 64); ss += __shfl_xor(ss, 4, 64); ss += __shfl_xor(ss, 8, 64);
        const float rstd = rsqrtf(ss * (1.f / 256.f) + 1e-6f);
        unsigned o[8];
#pragma unroll
        for (int h2 = 0; h2 < 2; ++h2) {
            const u32x4 og = *reinterpret_cast<const u32x4*>(P + (size_t)row * AB_IN + 3072 + c0 + h2 * 8);
#pragma unroll
            for (int q = 0; q < 4; ++q) {
                const int c = c0 + h2 * 8 + 2 * q;
                const float y0 = v[h2 * 8 + 2 * q] * rstd * p.mlstm_norm[c] * sigmoidf_(bf_lo(og[q]));
                const float y1 = v[h2 * 8 + 2 * q + 1] * rstd * p.mlstm_norm[c + 1] * sigmoidf_(bf_hi(og[q]));
                o[h2 * 4 + q] = pk_bf16(y0, y1);
            }
        }
        *reinterpret_cast<u32x4*>(YIN + (size_t)row * D + c0) = (u32x4){o[0], o[1], o[2], o[3]};
        *reinterpret_cast<u32x4*>(YIN + (size_t)row * D + c0 + 8) = (u32x4){o[4], o[5], o[6], o[7]};
    }
}

template <int DH, class KeyFn, class BiasFn>
__device__ __forceinline__ void attn_wave(const u16* qptr, size_t qstride, int nblk, KeyFn keyfn, BiasFn biasfn, float scale,
                                           float m_init, float l_init, u16* vlds, u16* optr, size_t ostride) {
    constexpr int NK = DH / 32, NDT = DH / 16, VS = DH + 8, NV = DH / 16;
    const int lane = tid_() & 63, fr = lane & 15, fq = lane >> 4;
    bf16x8 qf[NK];
#pragma unroll
    for (int kk = 0; kk < NK; ++kk) qf[kk] = ld_frag_g(qptr + (size_t)fr * qstride + kk * 32 + fq * 8);
    f32x4 oacc[NDT];
#pragma unroll
    for (int i = 0; i < NDT; ++i) oacc[i] = (f32x4){0.f, 0.f, 0.f, 0.f};
    float m = m_init, l = l_init;
    bf16x8 kn[2][NK]; u32x4 vn[NV];
    auto load_blk = [&](int ib) {
        const u16* kptr; const u16* vptr; size_t kvs;
        (void)keyfn(ib, kptr, vptr, kvs);
#pragma unroll
        for (int st = 0; st < 2; ++st)
#pragma unroll
            for (int kk = 0; kk < NK; ++kk) kn[st][kk] = ld_frag_g(kptr + (size_t)(st * 16 + fr) * kvs + kk * 32 + fq * 8);
#pragma unroll
        for (int i = 0; i < NV; ++i) { const int cidx = lane + 64 * i, r = cidx / (DH / 8), cc = cidx % (DH / 8); vn[i] = *reinterpret_cast<const u32x4*>(vptr + (size_t)r * kvs + cc * 8); }
    };
    auto next_valid = [&](int ib) { const u16* a; const u16* b2; size_t c; while (ib < nblk && !keyfn(ib, a, b2, c)) ++ib; return ib; };
    int ib = next_valid(0);
    if (ib < nblk) load_blk(ib);
    while (ib < nblk) {
        bf16x8 kc[2][NK]; u32x4 vc[NV];
#pragma unroll
        for (int st = 0; st < 2; ++st)
#pragma unroll
            for (int kk = 0; kk < NK; ++kk) kc[st][kk] = kn[st][kk];
#pragma unroll
        for (int i = 0; i < NV; ++i) vc[i] = vn[i];
        const int ibn = next_valid(ib + 1);
        if (ibn < nblk) load_blk(ibn);
        asm volatile("" ::: "memory");
#pragma unroll
        for (int i = 0; i < NV; ++i) { const int cidx = lane + 64 * i, r = cidx / (DH / 8), cc = cidx % (DH / 8); *reinterpret_cast<u32x4*>(vlds + r * VS + cc * 8) = vc[i]; }
        f32x4 s[2];
#pragma unroll
        for (int st = 0; st < 2; ++st) {
            f32x4 a = (f32x4){0.f, 0.f, 0.f, 0.f};
#pragma unroll
            for (int kk = 0; kk < NK; ++kk) a = mfma16(kc[st][kk], qf[kk], a);
            s[st] = a;
        }
        float x[8]; float mx = -INFINITY;
#pragma unroll
        for (int st = 0; st < 2; ++st)
#pragma unroll
            for (int q = 0; q < 4; ++q) { const float v = s[st][q] * scale + biasfn(ib, fr, st * 16 + 4 * fq + q); x[st * 4 + q] = v; mx = fmaxf(mx, v); }
        mx = max_x32(max_x16(mx));
        const float m_new = fmaxf(m, mx);
        const float m_safe = (m_new == -INFINITY) ? 0.f : m_new;
        const float alpha = __expf(m - m_safe);
        float ps = 0.f; float pe[8];
#pragma unroll
        for (int q = 0; q < 8; ++q) { pe[q] = __expf(x[q] - m_safe); ps += pe[q]; }
        l = l * alpha + ps; m = m_new;
#pragma unroll
        for (int i = 0; i < NDT; ++i) oacc[i] *= alpha;
        const bf16x8 pf = mk_frag(pk_bf16(pe[0], pe[1]), pk_bf16(pe[2], pe[3]), pk_bf16(pe[4], pe[5]), pk_bf16(pe[6], pe[7]));
        asm volatile("s_waitcnt lgkmcnt(0)" ::: "memory");
        {
            typedef short s16x4 __attribute__((ext_vector_type(4)));
            const int tq = (lane & 15) >> 2, tp = lane & 3;
            const u16* vb0 = vlds + (4 * fq + tq) * VS + 4 * tp;
            const u16* vb1 = vb0 + 16 * VS;
#pragma unroll
            for (int dt = 0; dt < NDT; ++dt) {
                const s16x4 lo = __builtin_amdgcn_ds_read_tr16_b64_v4i16((LAS s16x4*)(vb0 + dt * 16));
                const s16x4 hi = __builtin_amdgcn_ds_read_tr16_b64_v4i16((LAS s16x4*)(vb1 + dt * 16));
                const bf16x8 vf = {lo[0], lo[1], lo[2], lo[3], hi[0], hi[1], hi[2], hi[3]};
                oacc[dt] = mfma16(vf, pf, oacc[dt]);
            }
        }
        asm volatile("" ::: "memory");
        ib = ibn;
    }
    l = sum_x32(sum_x16(l));
    const float inv = 1.f / l;
#pragma unroll
    for (int dt = 0; dt < NDT; ++dt) {
        const f32x4 o = oacc[dt] * inv;
        u32x2 pk = {pk_bf16(o[0], o[1]), pk_bf16(o[2], o[3])};
        *reinterpret_cast<u32x2*>(optr + (size_t)fr * ostride + dt * 16 + 4 * fq) = pk;
    }
}


template <int DH, class SlabFn, class SubFn, class BiasFn>
__device__ __forceinline__ void attn_block(const u16* qptr, size_t qstride, int nslab, SlabFn slabfn, SubFn subfn, BiasFn biasfn, float scale,
                                            float m_init, float l_init, unsigned char* lds, u16* optr, size_t ostride) {
    constexpr int NK = DH / 32, NDT = DH / 16, VS = DH + 8, NLD = DH / 64;
    constexpr int STAGE = 2 * 64 * VS * 2;
    const int t = tid_(), lane = t & 63, fr = lane & 15, fq = lane >> 4;
    bf16x8 qf[NK];
#pragma unroll
    for (int kk = 0; kk < NK; ++kk) qf[kk] = ld_frag_g(qptr + (size_t)fr * qstride + kk * 32 + fq * 8);
    f32x4 oacc[NDT];
#pragma unroll
    for (int i = 0; i < NDT; ++i) oacc[i] = (f32x4){0.f, 0.f, 0.f, 0.f};
    float m = m_init, l = l_init;
    u32x4 kreg[NLD], vreg[NLD];
    auto load_slab = [&](int i) {
        const u16* kp; const u16* vp; size_t kvs; slabfn(i, kp, vp, kvs);
#pragma unroll
        for (int q = 0; q < NLD; ++q) { const int c = t + NT * q, r = c / (DH / 8), cc = c % (DH / 8);
            kreg[q] = *reinterpret_cast<const u32x4*>(kp + (size_t)r * kvs + cc * 8); vreg[q] = *reinterpret_cast<const u32x4*>(vp + (size_t)r * kvs + cc * 8); } };
    auto store_slab = [&](int st) {
        u16* Ks = (u16*)(lds + st * STAGE); u16* Vs = Ks + 64 * VS;
#pragma unroll
        for (int q = 0; q < NLD; ++q) { const int c = t + NT * q, r = c / (DH / 8), cc = c % (DH / 8);
            *reinterpret_cast<u32x4*>(Ks + r * VS + cc * 8) = kreg[q]; *reinterpret_cast<u32x4*>(Vs + r * VS + cc * 8) = vreg[q]; } };
    __syncthreads();
    load_slab(0); store_slab(0);
    if (nslab > 1) load_slab(1);
    __syncthreads();
    for (int i = 0; i < nslab; ++i) {
        const int cur = i & 1;
        if (i + 1 < nslab) store_slab(cur ^ 1);
        if (i + 2 < nslab) load_slab(i + 2);
        const u16* Ks = (const u16*)(lds + cur * STAGE); const u16* Vs = Ks + 64 * VS;
#pragma unroll
        for (int j = 0; j < 2; ++j) {
            int off;
            if (!subfn(i, j, off)) continue;
            f32x4 s[2];
#pragma unroll
            for (int st = 0; st < 2; ++st) {
                f32x4 a = (f32x4){0.f, 0.f, 0.f, 0.f};
#pragma unroll
                for (int kk = 0; kk < NK; ++kk) a = mfma16(ld_frag_s(Ks + (off + st * 16 + fr) * VS + kk * 32 + fq * 8), qf[kk], a);
                s[st] = a;
            }
            float x[8]; float mx = -INFINITY;
#pragma unroll
            for (int st = 0; st < 2; ++st)
#pragma unroll
                for (int q = 0; q < 4; ++q) { const float v = s[st][q] * scale + biasfn(i, off, fr, st * 16 + 4 * fq + q); x[st * 4 + q] = v; mx = fmaxf(mx, v); }
            mx = max_x32(max_x16(mx));
            const float m_new = fmaxf(m, mx);
            const float m_safe = (m_new == -INFINITY) ? 0.f : m_new;
            const float alpha = __expf(m - m_safe);
            float ps = 0.f; float pe[8];
#pragma unroll
            for (int q = 0; q < 8; ++q) { pe[q] = __expf(x[q] - m_safe); ps += pe[q]; }
            l = l * alpha + ps; m = m_new;
#pragma unroll
            for (int dt = 0; dt < NDT; ++dt) oacc[dt] *= alpha;
            const bf16x8 pf = mk_frag(pk_bf16(pe[0], pe[1]), pk_bf16(pe[2], pe[3]), pk_bf16(pe[4], pe[5]), pk_bf16(pe[6], pe[7]));
            typedef short s16x4 __attribute__((ext_vector_type(4)));
            const int tq = (lane & 15) >> 2, tp = lane & 3;
            const u16* vb0 = Vs + (off + 4 * fq + tq) * VS + 4 * tp;
            const u16* vb1 = vb0 + 16 * VS;
#pragma unroll
            for (int dt = 0; dt < NDT; ++dt) {
                const s16x4 lo = __builtin_amdgcn_ds_read_tr16_b64_v4i16((LAS s16x4*)(vb0 + dt * 16));
                const s16x4 hi = __builtin_amdgcn_ds_read_tr16_b64_v4i16((LAS s16x4*)(vb1 + dt * 16));
                const bf16x8 vf = {lo[0], lo[1], lo[2], lo[3], hi[0], hi[1], hi[2], hi[3]};
                oacc[dt] = mfma16(vf, pf, oacc[dt]);
            }
        }
        __syncthreads();
    }
    l = sum_x32(sum_x16(l));
    const float inv = 1.f / l;
#pragma unroll
    for (int dt = 0; dt < NDT; ++dt) {
        const f32x4 o = oacc[dt] * inv;
        u32x2 pk = {pk_bf16(o[0], o[1]), pk_bf16(o[2], o[3])};
        *reinterpret_cast<u32x2*>(optr + (size_t)fr * ostride + dt * 16 + 4 * fq) = pk;
    }
}

__device__ void phase_l0_stage2(const Params& p, unsigned char* lds) {
    const int w = tid_() >> 6;
    const u16* P = (const u16*)(p.ws + WS_P);
    u16* YIN = (u16*)(p.ws + WS_YIN);
    for (int item = bid_(); item < 1088 + 2176; item += gdim_()) {
        if (item < 1024) {
            const int r2 = item & 31, h = (item >> 5) & 7, b = item >> 8;
            const int rr = w >> 2, qt = w & 3, r = 2 * r2 + rr;
            const int r0 = min(max(r - 4, 0), 56);
            const int krow0 = min(max(2 * r2 - 4, 0), 56), nwin = min(max(2 * r2 + 1 - 4, 0), 56) + 8 - krow0;
            const int cb = qt == 0 ? 0 : (qt == 1 ? 8 : (qt == 2 ? 24 : 32));
            const int qrow = b * SEQ + r * 64 + qt * 16;
            const float* rpb = p.na_rpb + h * 15 * 31;
            auto slabfn = [&](int i, const u16*& kp, const u16*& vp, size_t& kvs) {
                const int row = i < nwin ? b * SEQ + (krow0 + i) * 64 : NLAT + b * LC + (i - nwin) * 64;
                kp = P + (size_t)row * AB_IN + 5136 + h * 128; vp = P + (size_t)row * AB_IN + 6160 + h * 128; kvs = AB_IN; };
            auto subfn = [&](int i, int j, int& off) -> bool {
                if (i < nwin) { off = cb; return j == 0 && (krow0 + i) >= r0 && (krow0 + i) < r0 + 8; }
                off = 32 * j; return true; };
            auto biasfn = [&](int i, int off, int qi, int ki) -> float {
                if (i >= nwin) return 0.f;
                const int c = qt * 16 + qi, kc = off + ki, c0 = min(max(c - 8, 0), 48);
                if (kc < c0 || kc >= c0 + 16) return -INFINITY;
                return rpb[(krow0 + i - r + 7) * 31 + (kc - c + 15)]; };
            attn_block<128>(P + (size_t)qrow * AB_IN + 4112 + h * 128, AB_IN, nwin + 4, slabfn, subfn, biasfn, 0.08838834764831845f, -INFINITY, 0.f, lds,
                            YIN + (size_t)qrow * D + 1024 + h * 128, D);
        } else if (item < 1088) {
            const int it = item - 1024, half = it & 1, h = (it >> 1) & 7, b = it >> 4;
            const int qrow = NLAT + b * LC + (half * 8 + w) * 16;
            auto slabfn = [&](int i, const u16*& kp, const u16*& vp, size_t& kvs) {
                const int row = NLAT + b * LC + i * 64;
                kp = P + (size_t)row * AB_IN + 5136 + h * 128; vp = P + (size_t)row * AB_IN + 6160 + h * 128; kvs = AB_IN; };
            auto subfn = [&](int, int j, int& off) -> bool { off = 32 * j; return true; };
            auto biasfn = [&](int, int, int, int) -> float { return 0.f; };
            attn_block<128>(P + (size_t)qrow * AB_IN + 4112 + h * 128, AB_IN, 4, slabfn, subfn, biasfn, 0.08838834764831845f, -INFINITY, 0.f, lds,
                            YIN + (size_t)qrow * D + 1024 + h * 128, D);
        } else {
            mlstm_out_rows(p, (item - 1088) * 8, 8);
        }
    }
}

__device__ void rope_rows(const Params& p, int row0, int nrows) {
    const int lane = tid_() & 63, w = tid_() >> 6;
    u16* P = (u16*)(p.ws + WS_P);
    for (int r = w; r < nrows; r += 8) {
        const int row = row0 + r, tt = row & (SEQ - 1);
        const float prow = (float)(tt >> 6), pcol = (float)(tt & 63);
        for (int pi = lane; pi < 640; pi += 64) {
            const int head = pi >> 5, half = (pi >> 4) & 1, j = pi & 15;
            const int base = (head < 16 ? head * 64 : 1024 + (head - 16) * 64) + half * 32 + j;
            const float inv = exp2f(-(float)j * (13.287712379549449f / 16.f));
            const float ang = (half ? pcol : prow) * inv;
            float sn, cs; sincosf(ang, &sn, &cs);
            u16* q1 = P + (size_t)row * CD_IN + base;
            const float x1 = bf2f(q1[0]), x2 = bf2f(q1[16]);
            q1[0] = f2bf(x1 * cs - x2 * sn); q1[16] = f2bf(x2 * cs + x1 * sn);
        }
    }
}

__device__ __forceinline__ int lru_row(int b, int ci, int j) { return ci < 4 ? NLAT + b * LC + ci * 64 + j : b * SEQ + (ci - 4) * 64 + j; }
__device__ void lru_chunk(const Params& p, int b, int blk, int ci, int mode, unsigned char* lds) {
    u16* ub = (u16*)lds;
    constexpr int SR = 132;
    float* sa = (float*)(ub + 64 * 136);
    float* sbt = sa + 64 * SR;
    float* sx = sbt + 64 * SR;
    const int t = tid_(), lane = t & 63, w = t >> 6, fr = lane & 15, fq = lane >> 4;
    const u16* P = (const u16*)(p.ws + WS_P);
    const u16* WT = (const u16*)(p.ws + WS_LRUW);
    float* SA = (float*)(p.ws + WS_LRUS);
    float* SH = SA + 2 * 4 * 68 * 1024;
    const int seglen = ci < 4 ? LC : SEQ, tt0 = ci < 4 ? ci * 64 : (ci - 4) * 64;
    const int rbase = ci < 4 ? NLAT + b * LC : b * SEQ;
    const int sc = t & 127, seg = t >> 7;
    const int chg_s = blk * 128 + sc;
    const int cg = blk * 128 + w * 16 + 4 * fq;
    bf16x8 wfa[2][2][4];
#pragma unroll
    for (int d2 = 0; d2 < 2; ++d2)
#pragma unroll
        for (int g2 = 0; g2 < 2; ++g2)
#pragma unroll
            for (int kk = 0; kk < 4; ++kk) wfa[d2][g2][kk] = ld_frag_g(WT + ((size_t)((d2 * 2 + g2) * 8 + blk) * 128 + w * 16 + fr) * 128 + fq * 8 + kk * 32);
    f32x4 gba[2][2], lama[2];
#pragma unroll
    for (int d2 = 0; d2 < 2; ++d2) {
        lama[d2] = *reinterpret_cast<const f32x4*>(p.lru_lambda + d2 * 1024 + cg);
#pragma unroll
        for (int g2 = 0; g2 < 2; ++g2) gba[d2][g2] = *reinterpret_cast<const f32x4*>(p.lru_gate_b + (d2 * 2 + g2) * 1024 + cg);
    }
    float carry[2] = {0.f, 0.f}; u16 grv[16];
    if (mode == 1) {
#pragma unroll
        for (int d2 = 0; d2 < 2; ++d2) carry[d2] = SH[((size_t)(d2 * 4 + b) * 68 + ci) * 1024 + chg_s];
#pragma unroll
        for (int s = 0; s < 16; ++s) grv[s] = P[(size_t)lru_row(b, ci, seg * 16 + s) * CD_IN + 2560 + chg_s];
    }
    __syncthreads();
    {
        const int c4 = (t & 31) * 4, j0 = (t >> 5) * 4, ch = blk * 128 + c4;
        float xv[7][4];
#pragma unroll
        for (int q = 0; q < 7; ++q) {
            const int tt = tt0 + j0 - 1 + q;
            if (tt >= 0 && tt < seglen) {
                const u32x2 v = *reinterpret_cast<const u32x2*>(P + (size_t)(rbase + tt) * CD_IN + 1536 + ch);
                xv[q][0] = bf_lo(v[0]); xv[q][1] = bf_hi(v[0]); xv[q][2] = bf_lo(v[1]); xv[q][3] = bf_hi(v[1]);
            } else { xv[q][0] = xv[q][1] = xv[q][2] = xv[q][3] = 0.f; }
        }
        f32x4 cw[4];
#pragma unroll
        for (int tp = 0; tp < 4; ++tp) cw[tp] = *reinterpret_cast<const f32x4*>(p.lru_conv_w + tp * 1024 + ch);
        const f32x4 cb = *reinterpret_cast<const f32x4*>(p.lru_conv_b + ch);
#pragma unroll
        for (int q = 0; q < 4; ++q) {
            float u[4];
#pragma unroll
            for (int cc = 0; cc < 4; ++cc) u[cc] = cb[cc] + xv[q][cc] * cw[0][cc] + xv[q + 1][cc] * cw[1][cc] + xv[q + 2][cc] * cw[2][cc] + xv[q + 3][cc] * cw[3][cc];
            u32x2 pk = {pk_bf16(u[0], u[1]), pk_bf16(u[2], u[3])};
            *reinterpret_cast<u32x2*>(ub + (j0 + q) * 136 + c4) = pk;
        }
    }
    __syncthreads();
    float hfw[16];
    for (int dir = 0; dir < 2; ++dir) {
        f32x4 av[4];
        {
            bf16x8 wf[4];
#pragma unroll
            for (int kk = 0; kk < 4; ++kk) wf[kk] = dir ? wfa[1][0][kk] : wfa[0][0][kk];
            const f32x4 gbv = dir ? gba[1][0] : gba[0][0];
            const f32x4 lamv = dir ? lama[1] : lama[0];
            float sp8[4];
#pragma unroll
            for (int q = 0; q < 4; ++q) { const float nl = -lamv[q]; sp8[q] = -8.f * (fmaxf(nl, 0.f) + __logf(1.f + __expf(-fabsf(nl)))); }
#pragma unroll
            for (int tt = 0; tt < 4; ++tt) {
                f32x4 z = (f32x4){0.f, 0.f, 0.f, 0.f};
#pragma unroll
                for (int kk = 0; kk < 4; ++kk) z = mfma16(wf[kk], ld_frag_s(ub + (tt * 16 + fr) * 136 + kk * 32 + fq * 8), z);
#pragma unroll
                for (int q = 0; q < 4; ++q) av[tt][q] = __expf(sigmoidf_(z[q] + gbv[q]) * sp8[q]);
            }
        }
        __syncthreads();
        {
            bf16x8 wf[4];
#pragma unroll
            for (int kk = 0; kk < 4; ++kk) wf[kk] = dir ? wfa[1][1][kk] : wfa[0][1][kk];
            const f32x4 gbv = dir ? gba[1][1] : gba[0][1];
#pragma unroll
            for (int tt = 0; tt < 4; ++tt) {
                f32x4 z = (f32x4){0.f, 0.f, 0.f, 0.f};
#pragma unroll
                for (int kk = 0; kk < 4; ++kk) z = mfma16(wf[kk], ld_frag_s(ub + (tt * 16 + fr) * 136 + kk * 32 + fq * 8), z);
                const int tj = tt * 16 + fr;
                const u32x2 uv = *reinterpret_cast<const u32x2*>(ub + tj * 136 + w * 16 + 4 * fq);
                const float u4[4] = {bf_lo(uv[0]), bf_hi(uv[0]), bf_lo(uv[1]), bf_hi(uv[1])};
                f32x4 bv;
#pragma unroll
                for (int q = 0; q < 4; ++q) { const float a = av[tt][q]; bv[q] = sqrtf(fmaxf(1.f - a * a, 0.f)) * sigmoidf_(z[q] + gbv[q]) * u4[q]; }
                *reinterpret_cast<f32x4*>(sa + tj * SR + w * 16 + 4 * fq) = av[tt];
                *reinterpret_cast<f32x4*>(sbt + tj * SR + w * 16 + 4 * fq) = bv;
            }
        }
        __syncthreads();
        float A = 1.f, h = 0.f;
#pragma unroll
        for (int s = 0; s < 16; ++s) { const int j = seg * 16 + (dir ? 15 - s : s); const float a = sa[j * SR + sc]; h = a * h + sbt[j * SR + sc]; A *= a; }
        sx[(seg * 2 + 0) * 128 + sc] = A; sx[(seg * 2 + 1) * 128 + sc] = h;
        __syncthreads();
        const size_t sidx = ((size_t)(dir * 4 + b) * 68 + ci) * 1024 + chg_s;
        if (mode == 0) {
            if (seg == 0) {
                float At = 1.f, ht = 0.f;
#pragma unroll
                for (int s = 0; s < 4; ++s) { const int sg = dir ? 3 - s : s; const float a = sx[(sg * 2) * 128 + sc]; ht = a * ht + sx[(sg * 2 + 1) * 128 + sc]; At *= a; }
                SA[sidx] = At; SH[sidx] = ht;
            }
        } else {
            float hs = dir ? carry[1] : carry[0];
            const int nprev = dir ? 3 - seg : seg;
#pragma unroll
            for (int s = 0; s < 3; ++s) if (s < nprev) { const int sg = dir ? 3 - s : s; hs = sx[(sg * 2) * 128 + sc] * hs + sx[(sg * 2 + 1) * 128 + sc]; }
            u16* YIN = (u16*)(p.ws + WS_YIN);
            if (dir == 0) {
#pragma unroll
                for (int s = 0; s < 16; ++s) { const int j = seg * 16 + s; hs = sa[j * SR + sc] * hs + sbt[j * SR + sc]; hfw[s] = hs; }
            } else {
#pragma unroll
                for (int s = 0; s < 16; ++s) {
                    const int js = 15 - s, j = seg * 16 + js;
                    hs = sa[j * SR + sc] * hs + sbt[j * SR + sc];
                    const int row = lru_row(b, ci, j);
                    const float gr = bf2f(grv[js]);
                    const float th = 1.f - 2.f * frcp_(1.f + __expf(1.5957691216057308f * (gr + 0.044715f * gr * gr * gr)));
                    const float ge = 0.5f * gr * (1.f + th);
                    YIN[(size_t)row * D + 1024 + chg_s] = f2bf((hfw[js] + hs) * ge);
                }
            }
        }
    }
}

__device__ void lru_prep_weights(const Params& p) {
    const int t = tid_();
    u16* WT = (u16*)(p.ws + WS_LRUW);
    for (int m = bid_(); m < 32; m += gdim_()) {
        const float* Wg = p.lru_gate_w + (size_t)m * 128 * 128;
        const int j4 = (t & 31) * 4, i8 = (t >> 5) * 8;
        f32x4 r8[8];
#pragma unroll
        for (int q = 0; q < 8; ++q) r8[q] = *reinterpret_cast<const f32x4*>(Wg + (size_t)(i8 + q) * 128 + j4);
#pragma unroll
        for (int jj = 0; jj < 4; ++jj) {
            u32x4 v = {pk_bf16(r8[0][jj], r8[1][jj]), pk_bf16(r8[2][jj], r8[3][jj]), pk_bf16(r8[4][jj], r8[5][jj]), pk_bf16(r8[6][jj], r8[7][jj])};
            *reinterpret_cast<u32x4*>(WT + ((size_t)m * 128 + j4 + jj) * 128 + i8) = v;
        }
    }
}
__device__ void lru_carry(const Params& p, int item) {
    const int idx = item * NT + tid_();
    const int c = idx & 1023, b = (idx >> 10) & 3, dir = idx >> 12;
    float* SA = (float*)(p.ws + WS_LRUS);
    float* SH = SA + 2 * 4 * 68 * 1024;
    const size_t base = ((size_t)(dir * 4 + b) * 68) * 1024 + c;
    float h = 0.f;
#pragma unroll 4
    for (int s = 0; s < 68; ++s) {
        const int cj = dir == 0 ? s : (s < 4 ? 3 - s : 71 - s);
        const float a = SA[base + (size_t)cj * 1024], hl = SH[base + (size_t)cj * 1024];
        SH[base + (size_t)cj * 1024] = h;
        h = a * h + hl;
    }
}

__device__ void gqa_item(const Params& p, int it, unsigned char* lds) {
    const int w = tid_() >> 6;
    const u16* P = (const u16*)(p.ws + WS_P);
    u16* YIN = (u16*)(p.ws + WS_YIN);
    const int t32 = it & 127, kvh = (it >> 7) & 3, b = it >> 9;
    const int hq = kvh * 4 + (w & 3), t0 = t32 * 32 + (w >> 2) * 16;
    const int kfirst = max((t32 * 32 - 128) & ~63, 0), klast = min(((t32 * 32 - 128) & ~63) + 256, SEQ - 64);
    const int nwin = (klast - kfirst) / 64 + 1;
    const int qrow = b * SEQ + t0;
    auto slabfn = [&](int i, const u16*& kp, const u16*& vp, size_t& kvs) {
        const int row = i < nwin ? b * SEQ + kfirst + i * 64 : NLAT + b * LC + (i - nwin) * 64;
        kp = P + (size_t)row * CD_IN + 1024 + kvh * 64; vp = P + (size_t)row * CD_IN + 1280 + kvh * 64; kvs = CD_IN; };
    auto subfn = [&](int i, int j, int& off) -> bool {
        off = 32 * j;
        if (i >= nwin) return true;
        const int k0 = kfirst + i * 64 + off;
        return k0 + 31 >= t0 - 128 && k0 <= t0 + 15 + 128; };
    auto biasfn = [&](int i, int off, int qi, int ki) -> float {
        if (i >= nwin) return 0.f;
        const int dq = (t0 + qi) - (kfirst + i * 64 + off + ki);
        return (dq > 128 || dq < -128) ? -INFINITY : 0.f; };
    const float sink = p.gqa_sink[hq];
    attn_block<64>(P + (size_t)qrow * CD_IN + hq * 64, CD_IN, nwin + 4, slabfn, subfn, biasfn, 0.125f, sink, ((tid_() & 63) >> 4) == 0 ? 1.f : 0.f, lds,
                   YIN + (size_t)qrow * D + hq * 64, D);
}

__device__ void phase_l1_stage1(const Params& p, unsigned char* lds) {
    for (int item = bid_(); item < 2176 + 2048; item += gdim_()) {
        if (item < 2176) { const int ci = item % 68, blk = (item / 68) & 7, b = item / (68 * 8); lru_chunk(p, b, blk, ci, 0, lds); }
        else rope_rows(p, (item - 2176) * 8, 8);
    }
}
__device__ void phase_l1_stage2(const Params& p, unsigned char* lds) {
    for (int item = bid_(); item < 16 + 2048; item += gdim_()) {
        if (item < 16) lru_carry(p, item);
        else gqa_item(p, item - 16, lds);
    }
}
__device__ void phase_l1_stage3(const Params& p, unsigned char* lds) {
    for (int item = bid_(); item < 2048; item += gdim_()) { const int cl = item & 63, blk = (item >> 6) & 7, b = item >> 9; lru_chunk(p, b, blk, cl + 4, 1, lds); }
}

__device__ void phase_rowpass_mid(const Params& p, int l, unsigned char* lds) {
    float* R = (float*)lds;
    const int t = tid_(), lane = t & 63, w = t >> 6;
    const int nrows = l == 0 ? NTOK : NLAT;
    __syncthreads();
    for (int i = t; i < D * NEXP; i += NT) { const int k = i >> 4, e = i & 15; R[e * D + k] = p.moe_router[(size_t)l * D * NEXP + i]; }
    __syncthreads();
    const u16* Y = (const u16*)(p.ws + WS_Y);
    float* XL1 = (float*)(p.ws + WS_XL1);
    u16* H = (u16*)(p.ws + WS_H);
    float* AFF = (float*)(p.ws + WS_AFF);
    for (int row = bid_() * 8 + w; row < nrows; row += gdim_() * 8) {
        f32x4 v[8]; float ss = 0.f;
#pragma unroll
        for (int i = 0; i < 8; ++i) { const u32x2 q = *reinterpret_cast<const u32x2*>(Y + (size_t)row * D + (i * 64 + lane) * 4); v[i] = (f32x4){bf_lo(q[0]), bf_hi(q[0]), bf_lo(q[1]), bf_hi(q[1])}; ss += v[i][0] * v[i][0] + v[i][1] * v[i][1] + v[i][2] * v[i][2] + v[i][3] * v[i][3]; }
        ss = wave_sum(ss);
        const float rstd = rsqrtf(ss * (1.f / D) + 1e-6f);
        const float* xr = xin_row(p, l, row);
        const float* g1 = mod_ptr(p, l, row, 2);
        const float* nw = p.norm_mix_post + (size_t)l * D;
        float ss1 = 0.f;
#pragma unroll
        for (int i = 0; i < 8; ++i) {
            const int col = (i * 64 + lane) * 4;
            const f32x4 x4 = *reinterpret_cast<const f32x4*>(xr + col), w4 = *reinterpret_cast<const f32x4*>(nw + col), g4 = *reinterpret_cast<const f32x4*>(g1 + col);
            const f32x4 x1 = x4 + g4 * (v[i] * rstd * w4);
            *reinterpret_cast<f32x4*>(XL1 + (size_t)row * D + col) = x1;
            v[i] = x1; ss1 += x1[0] * x1[0] + x1[1] * x1[1] + x1[2] * x1[2] + x1[3] * x1[3];
        }
        ss1 = wave_sum(ss1);
        const float rstd1 = rsqrtf(ss1 * (1.f / D) + 1e-6f);
        const float* sh = mod_ptr(p, l, row, 3); const float* sc = mod_ptr(p, l, row, 4);
        const float* nw2 = p.norm_ffn_pre + (size_t)l * D;
#pragma unroll
        for (int i = 0; i < 8; ++i) {
            const int col = (i * 64 + lane) * 4;
            const f32x4 w4 = *reinterpret_cast<const f32x4*>(nw2 + col), s4 = *reinterpret_cast<const f32x4*>(sc + col), h4 = *reinterpret_cast<const f32x4*>(sh + col);
            const f32x4 o = v[i] * rstd1 * w4 * (s4 + 1.f) + h4;
            u32x2 pk = {pk_bf16(o[0], o[1]), pk_bf16(o[2], o[3])};
            *reinterpret_cast<u32x2*>(H + (size_t)row * D + col) = pk;
            v[i] = o;
        }
        float lg[16];
#pragma unroll
        for (int e = 0; e < 16; ++e) lg[e] = 0.f;
#pragma unroll
        for (int i = 0; i < 8; ++i) {
#pragma unroll
            for (int e = 0; e < 16; ++e) { const f32x4 r4 = *reinterpret_cast<const f32x4*>(R + e * D + (i * 64 + lane) * 4); lg[e] += v[i][0] * r4[0] + v[i][1] * r4[1] + v[i][2] * r4[2] + v[i][3] * r4[3]; }
        }
        const bool b5 = lane & 32, b4 = lane & 16, b3 = lane & 8, b2 = lane & 4;
        float t8[8], t4[4], t2[2], lgt;
#pragma unroll
        for (int j = 0; j < 8; ++j) { const float keep = b5 ? lg[8 + j] : lg[j], send = b5 ? lg[j] : lg[8 + j]; t8[j] = keep + partner_x32(send); }
#pragma unroll
        for (int j = 0; j < 4; ++j) { const float keep = b4 ? t8[4 + j] : t8[j], send = b4 ? t8[j] : t8[4 + j]; t4[j] = keep + partner_x16(send); }
#pragma unroll
        for (int j = 0; j < 2; ++j) { const float keep = b3 ? t4[2 + j] : t4[j], send = b3 ? t4[j] : t4[2 + j]; t2[j] = keep + dpp_f<0x140>(send); }
        { const float keep = b2 ? t2[1] : t2[0], send = b2 ? t2[0] : t2[1]; lgt = keep + dpp_f<0x141>(send); }
        lgt += dpp_f<0x4E>(lgt); lgt += dpp_f<0xB1>(lgt);
        const float mx = wave_max(lgt);
        const float pe = __expf(lgt - mx);
        const float den = wave_sum(pe) * 0.25f;
        if ((lane & 3) == 0) AFF[(size_t)row * 16 + ((b5 ? 8 : 0) + (b4 ? 4 : 0) + (b3 ? 2 : 0) + (b2 ? 1 : 0))] = pe / den;
    }
}

__device__ void phase_topk(const Params& p, int l, unsigned char* lds) {
    unsigned* keys = (unsigned*)lds;
    unsigned* hist = keys + 4096;
    unsigned* misc = hist + 256;
    const int t = tid_(), lane = t & 63, w = t >> 6;
    const float* AFF = (const float*)(p.ws + WS_AFF);
    int* SLOT = (int*)(p.ws + WS_SLOT);
    int* EROW = (int*)(p.ws + WS_EROW);
    float* EGATE = (float*)(p.ws + WS_EGATE);
    const int nitems = l == 0 ? 128 : 64;
    for (int item = bid_(); item < nitems; item += gdim_()) {
        const int kind = item >> 6, b = (item >> 4) & 3, ex = item & 15;
        const int n = kind ? LC : SEQ, cap = n / 8, rowbase = kind ? NLAT + b * LC : b * SEQ;
        __syncthreads();
        for (int i = t; i < n; i += NT) keys[i] = __float_as_uint(AFF[(size_t)(rowbase + i) * 16 + ex]);
        unsigned prefix = 0u, mask = 0u; int kth = cap;
        for (int shift = 24; shift >= 0; shift -= 8) {
            __syncthreads();
            if (t < 256) hist[t] = 0u;
            __syncthreads();
            for (int i = t; i < n; i += NT) { const unsigned k = keys[i]; if ((k & mask) == prefix) atomicAdd(&hist[(k >> shift) & 255u], 1u); }
            __syncthreads();
            if (t < 256) {
                unsigned above = 0u;
                for (int d2 = t + 1; d2 < 256; ++d2) above += hist[d2];
                const unsigned here = hist[t];
                if ((int)above < kth && (int)(above + here) >= kth) { misc[0] = (unsigned)t; misc[1] = (unsigned)(kth - (int)above); }
            }
            __syncthreads();
            prefix |= misc[0] << shift; mask |= 255u << shift; kth = (int)misc[1];
        }
        const unsigned T = prefix; const int need_eq = kth;
        int cgt = 0, ceq = 0;
        const int base = t * 8;
        if (base < n) {
#pragma unroll
            for (int q = 0; q < 8; ++q) { const unsigned k = keys[base + q]; cgt += (k > T); ceq += (k == T); }
        }
        int packed = cgt | (ceq << 16);
        int incl = packed;
#pragma unroll
        for (int o = 1; o < 64; o <<= 1) { const int nb = __shfl_up(incl, o, 64); if (lane >= o) incl += nb; }
        __syncthreads();
        if (lane == 63) misc[8 + w] = (unsigned)incl;
        __syncthreads();
        int woff = 0, total = 0;
#pragma unroll
        for (int q = 0; q < 8; ++q) { const int v = (int)misc[8 + q]; if (q < w) woff += v; total += v; }
        const int excl = woff + incl - packed;
        int pgt = excl & 0xffff, peq = excl >> 16;
        const int tot_gt = total & 0xffff;
        const int sbase = kind ? 2048 + b * 32 : b * 512;
        if (base < n) {
#pragma unroll
            for (int q = 0; q < 8; ++q) {
                const unsigned k = keys[base + q];
                const int row = rowbase + base + q;
                int pos = -1;
                if (k > T) { pos = pgt; ++pgt; }
                else if (k == T) { if (peq < need_eq) pos = tot_gt + peq; ++peq; }
                if (pos >= 0) { const int sl = sbase + pos; EROW[ex * EPAD + sl] = row; EGATE[ex * EPAD + sl] = __uint_as_float(k); SLOT[(size_t)row * 16 + ex] = sl; }
                else SLOT[(size_t)row * 16 + ex] = -1;
            }
        }
        if (kind == 1 && b == 3) for (int i = t; i < EPAD - 2176; i += NT) EROW[ex * EPAD + 2176 + i] = rowbase;
    }
}

__device__ void phase_final(const Params& p, int l) {
    const int lane = tid_() & 63, w = tid_() >> 6;
    const int nrows = l == 0 ? NTOK : NLAT;
    const u16* YEXP = (const u16*)(p.ws + WS_YEXP);
    const int* SLOT = (const int*)(p.ws + WS_SLOT);
    const float* XL1 = (const float*)(p.ws + WS_XL1);
    float* XL2 = (float*)(p.ws + WS_XL2);
    u16* H = (u16*)(p.ws + WS_H);
    for (int row = bid_() * 8 + w; row < nrows; row += gdim_() * 8) {
        const int myslot = lane < 16 ? SLOT[(size_t)row * 16 + lane] : -1;
        f32x4 xl[8];
#pragma unroll
        for (int i = 0; i < 8; ++i) xl[i] = *reinterpret_cast<const f32x4*>(XL1 + (size_t)row * D + (i * 64 + lane) * 4);
        f32x4 v[8];
#pragma unroll
        for (int i = 0; i < 8; ++i) v[i] = (f32x4){0.f, 0.f, 0.f, 0.f};
        unsigned long long em = __ballot(myslot >= 0);
        while (em) {
            const int e0 = __builtin_ctzll(em); em &= em - 1;
            const bool two = em != 0;
            const int e1 = two ? __builtin_ctzll(em) : e0; if (two) em &= em - 1;
            const int sl0 = __shfl(myslot, e0, 64), sl1 = __shfl(myslot, e1, 64);
            const u16* y0 = YEXP + ((size_t)e0 * EPAD + sl0) * D; const u16* y1 = YEXP + ((size_t)e1 * EPAD + sl1) * D;
            u32x2 q0[8], q1[8];
#pragma unroll
            for (int i = 0; i < 8; ++i) { q0[i] = *reinterpret_cast<const u32x2*>(y0 + (i * 64 + lane) * 4); q1[i] = *reinterpret_cast<const u32x2*>(y1 + (i * 64 + lane) * 4); }
            const float f1 = two ? 1.f : 0.f;
#pragma unroll
            for (int i = 0; i < 8; ++i) {
                v[i][0] += bf_lo(q0[i][0]) + f1 * bf_lo(q1[i][0]); v[i][1] += bf_hi(q0[i][0]) + f1 * bf_hi(q1[i][0]);
                v[i][2] += bf_lo(q0[i][1]) + f1 * bf_lo(q1[i][1]); v[i][3] += bf_hi(q0[i][1]) + f1 * bf_hi(q1[i][1]);
            }
        }
        float ss = 0.f;
#pragma unroll
        for (int i = 0; i < 8; ++i) ss += v[i][0] * v[i][0] + v[i][1] * v[i][1] + v[i][2] * v[i][2] + v[i][3] * v[i][3];
        ss = wave_sum(ss);
        const float rstd = rsqrtf(ss * (1.f / D) + 1e-6f);
        const float* g2 = mod_ptr(p, l, row, 5);
        const float* nw = p.norm_ffn_post + (size_t)l * D;
        float* dst = l == 0 ? XL2 + (size_t)row * D : p.out + (size_t)row * D;
        float ss2 = 0.f;
#pragma unroll
        for (int i = 0; i < 8; ++i) {
            const int col = (i * 64 + lane) * 4;
            const f32x4 x4 = xl[i], w4 = *reinterpret_cast<const f32x4*>(nw + col), g4 = *reinterpret_cast<const f32x4*>(g2 + col);
            const f32x4 x2 = x4 + g4 * (v[i] * rstd * w4);
            *reinterpret_cast<f32x4*>(dst + col) = x2;
            v[i] = x2; ss2 += x2[0] * x2[0] + x2[1] * x2[1] + x2[2] * x2[2] + x2[3] * x2[3];
        }
        if (l == 0) {
            ss2 = wave_sum(ss2);
            const float rstd2 = rsqrtf(ss2 * (1.f / D) + 1e-6f);
            const float* sh = mod_ptr(p, 1, row, 0); const float* sc = mod_ptr(p, 1, row, 1);
            const float* nw1 = p.norm_mix_pre + D;
#pragma unroll
            for (int i = 0; i < 8; ++i) {
                const int col = (i * 64 + lane) * 4;
                const f32x4 w4 = *reinterpret_cast<const f32x4*>(nw1 + col), s4 = *reinterpret_cast<const f32x4*>(sc + col), h4 = *reinterpret_cast<const f32x4*>(sh + col);
                const f32x4 o = v[i] * rstd2 * w4 * (s4 + 1.f) + h4;
                u32x2 pk = {pk_bf16(o[0], o[1]), pk_bf16(o[2], o[3])};
                *reinterpret_cast<u32x2*>(H + (size_t)row * D + col) = pk;
            }
        }
    }
}

__global__ void __launch_bounds__(NT, 2) fwd_kernel(Params p) {
    unsigned char* lds = g_lds;
    unsigned char* wlds = lds + 512;
    if (threadIdx.x == 0) *reinterpret_cast<uint4*>(lds) = make_uint4(0u, 0u, 0u, 0u);
    if ((threadIdx.x & 63) == 0) ((volatile LAS int*)(g_lds))[8 + hw_slot_()] = threadIdx.x >> 6;
    __syncthreads();
    (void)xcd_barrier_post((unsigned*)(p.ws + WS_BAR), (volatile LAS unsigned*)lds);
#define GRID_BARRIER() do { XcdBarrier _b; _b.bar = (unsigned*)(p.ws + WS_BAR); _b.x = xb_xcc_id(); _b.st = (volatile LAS unsigned*)lds; xcd_barrier(_b); } while (0)
#ifndef PH_MASK
#define PH_MASK 0xFFFFFFFFu
#endif
#ifndef PROBE_REP_MASK
#define PROBE_REP_MASK 0u
#endif
#define PHASE(id, body) do { if (((PH_MASK >> ((id) % 32)) & 1u) && p.ph_lo <= (id) && (id) < p.ph_hi) { \
    for (int _r = 0; _r < ((((unsigned)PROBE_REP_MASK >> ((id) % 32)) & 1u) ? 2 : 1); ++_r) { body; if ((id) + 1 < p.ph_hi || _r == 0) { if ((id) + 1 < p.ph_hi) GRID_BARRIER(); } } } } while (0)
    PHASE(0, { phase_mod(p, wlds); phase_convert_dense(p, wlds); });
    PHASE(1, { phase_norm_mod(p, 0); lru_prep_weights(p); });
#pragma unroll
    for (int l = 0; l < 2; ++l) {
        const int pb = 2 + 10 * l;
        PHASE(pb + 0, phase_gemm_dense(p, (const u16*)(p.ws + WS_H), NTOK, (const u16*)(p.ws + (l == 0 ? WS_WT_ABIN : WS_WT_CDIN)), l == 0 ? AB_IN : CD_IN,
                                       (u16*)(p.ws + WS_P), l == 0 ? AB_IN : CD_IN, l == 0 ? (float*)(p.ws + WS_G) : nullptr, wlds));
        if (l == 0) {
            PHASE(pb + 1, phase_mlstm(p, wlds));
            PHASE(pb + 2, phase_l0_stage2(p, wlds));
        } else {
            PHASE(pb + 1, phase_l1_stage1(p, wlds));
            PHASE(pb + 2, phase_l1_stage2(p, wlds));
            PHASE(pb + 3, phase_l1_stage3(p, wlds));
        }
        PHASE(pb + 4, phase_gemm_dense(p, (const u16*)(p.ws + WS_YIN), l == 0 ? NTOK : NLAT, (const u16*)(p.ws + (l == 0 ? WS_WT_ABOUT : WS_WT_CDOUT)), D,
                                       (u16*)(p.ws + WS_Y), D, nullptr, wlds));
        PHASE(pb + 5, phase_rowpass_mid(p, l, wlds));
        PHASE(pb + 6, { phase_topk(p, l, wlds); phase_convert_moe(p, l, wlds); });
        PHASE(pb + 7, phase_moe_a(p, l, wlds));
        PHASE(pb + 8, phase_moe_b(p, l, wlds));
        PHASE(pb + 9, phase_final(p, l));
    }
}


#ifdef DBG_STOP
__global__ void dbg_digest(const unsigned char* ws, size_t off, int kind, size_t nelem, float* out, size_t nout) {
    for (size_t i = (size_t)blockIdx.x * blockDim.x + threadIdx.x; i < nout; i += (size_t)gridDim.x * blockDim.x) {
        float v = 0.f;
        for (size_t j = i; j < nelem; j += nout) {
            if (kind == 0) v += bf2f(((const u16*)(ws + off))[j]);
            else if (kind == 1) v += ((const float*)(ws + off))[j];
            else v += (float)((const int*)(ws + off))[j];
        }
        out[i] = v;
    }
}
#endif
extern "C" void kernel_launch(void* const* d_in, const int* in_sizes, int n_in, void* d_out, int out_size, void* d_ws, size_t ws_size, hipStream_t stream) {
    static int grid = 0;
    if (grid == 0) {
        if (n_in != 27 || ws_size < WS_END) { fprintf(stderr, "kernel_launch: unexpected n_in %d / ws %zu (need %zu)\n", n_in, ws_size, (size_t)WS_END); grid = -1; return; }
        int dev = 0, cus = 0, per_cu = 0;
        hipGetDevice(&dev);
        hipDeviceGetAttribute(&cus, hipDeviceAttributeMultiprocessorCount, dev);
        if (hipFuncSetAttribute((const void*)fwd_kernel, hipFuncAttributeMaxDynamicSharedMemorySize, LDS_BYTES) != hipSuccess) { fprintf(stderr, "kernel_launch: hipFuncSetAttribute failed\n"); grid = -1; return; }
        hipOccupancyMaxActiveBlocksPerMultiprocessor(&per_cu, (const void*)fwd_kernel, NT, LDS_BYTES);
        (void)hipGetLastError();
        if (per_cu < 1) fprintf(stderr, "kernel_launch: occupancy query reports %d blocks per CU\n", per_cu);
        grid = cus > 0 ? cus : 256;
    }
    if (grid < 0) return;
    hipMemsetAsync((char*)d_ws + WS_BAR, 0, XCD_BAR_WORDS * sizeof(unsigned), stream);
    Params p; memset(&p, 0, sizeof(p));
    const float** f = (const float**)&p;
    for (int i = 0; i < 27; ++i) f[i] = (const float*)d_in[i];
    p.out = (float*)d_out; p.ws = (unsigned char*)d_ws;
#if N_LAUNCH_MODE == 1
    p.ph_lo = 0; p.ph_hi = NPH;
    hipLaunchKernelGGL(fwd_kernel, dim3(grid), dim3(NT), LDS_BYTES, stream, p);
#else
#ifdef DBG_STOP
    for (int ph = 0; ph <= DBG_STOP; ++ph) { p.ph_lo = ph; p.ph_hi = ph + 1; hipLaunchKernelGGL(fwd_kernel, dim3(grid), dim3(NT), LDS_BYTES, stream, p); }
    hipLaunchKernelGGL(dbg_digest, dim3(2048), dim3(256), 0, stream, (const unsigned char*)d_ws, (size_t)DBG_OFF, (int)DBG_KIND, (size_t)DBG_NELEM, (float*)d_out, (size_t)out_size);
#else
    for (int ph = 0; ph < NPH; ++ph) { p.ph_lo = ph; p.ph_hi = ph + 1; hipLaunchKernelGGL(fwd_kernel, dim3(grid), dim3(NT), LDS_BYTES, stream, p); }
#endif
#endif
}
```

```cpp
#include <hip/hip_runtime.h>
#include <stdint.h>
#include <stdio.h>
#include <string.h>

#ifndef N_LAUNCH_MODE
#define N_LAUNCH_MODE 1
#endif

typedef unsigned short u16;
typedef short bf16x8 __attribute__((ext_vector_type(8)));
typedef float f32x4 __attribute__((ext_vector_type(4)));
typedef unsigned u32x4 __attribute__((ext_vector_type(4)));
typedef unsigned u32x2 __attribute__((ext_vector_type(2)));

#define NT 512
constexpr int D = 2048, BATCH = 4, SEQ = 4096, LC = 256;
constexpr int NLAT = BATCH * SEQ, NCTX = BATCH * LC, NTOK = NLAT + NCTX;
constexpr int AB_IN = 7184, CD_IN = 3584;
constexpr int NEXP = 16, FF = 2048, EPAD = 2304;
constexpr int NPH = 22;
constexpr int LDS_BYTES = 150 * 1024;

constexpr size_t al256(size_t x) { return (x + 255) & ~(size_t)255; }
constexpr size_t WS_BAR = 0;
constexpr size_t WS_MOD = 16384;
constexpr size_t WS_XL1 = al256(WS_MOD + 2 * 5 * 12288 * 4);
constexpr size_t WS_XL2 = al256(WS_XL1 + (size_t)NTOK * D * 4);
constexpr size_t WS_H = al256(WS_XL2 + (size_t)NTOK * D * 4);
constexpr size_t WS_P = al256(WS_H + (size_t)NTOK * D * 2);
constexpr size_t WS_G = al256(WS_P + (size_t)NTOK * AB_IN * 2);
constexpr size_t WS_HM = al256(WS_G + (size_t)NTOK * 16 * 4);
constexpr size_t WS_YIN = al256(WS_HM + (size_t)2 * NTOK * 1024 * 2);
constexpr size_t WS_Y = al256(WS_YIN + (size_t)NTOK * D * 2);
constexpr size_t WS_AFF = al256(WS_Y + (size_t)NTOK * D * 4);
constexpr size_t WS_SLOT = al256(WS_AFF + (size_t)NTOK * 16 * 4);
constexpr size_t WS_EROW = al256(WS_SLOT + (size_t)NTOK * 16 * 4);
constexpr size_t WS_EGATE = al256(WS_EROW + (size_t)NEXP * EPAD * 4);
constexpr size_t WS_ACT = al256(WS_EGATE + (size_t)NEXP * EPAD * 4);
constexpr size_t WS_YEXP = al256(WS_ACT + (size_t)NEXP * EPAD * FF * 2);
constexpr size_t WS_LRUS = al256(WS_YEXP + (size_t)NEXP * EPAD * D * 2);
constexpr size_t WS_LRUW = al256(WS_LRUS + (size_t)2 * 2 * 4 * 68 * 1024 * 4);
constexpr size_t WS_WT_ABIN = al256(WS_LRUW + (size_t)32 * 128 * 128 * 2);
constexpr size_t WS_WT_ABOUT = al256(WS_WT_ABIN + (size_t)AB_IN * D * 2);
constexpr size_t WS_WT_CDIN = al256(WS_WT_ABOUT + (size_t)D * D * 2);
constexpr size_t WS_WT_CDOUT = al256(WS_WT_CDIN + (size_t)CD_IN * D * 2);
constexpr size_t WS_WT_W1 = al256(WS_WT_CDOUT + (size_t)D * D * 2);
constexpr size_t WS_WT_W3 = al256(WS_WT_W1 + (size_t)NEXP * D * FF * 2);
constexpr size_t WS_WT_W2 = al256(WS_WT_W3 + (size_t)NEXP * D * FF * 2);
constexpr size_t WS_END = al256(WS_WT_W2 + (size_t)NEXP * D * FF * 2);

extern __shared__ __attribute__((aligned(16))) unsigned char g_lds[];

struct Params {
    const float *x, *c, *ctx, *c_ctx, *ada_w, *ada_b, *norm_mix_pre, *norm_mix_post, *norm_ffn_pre, *norm_ffn_post;
    const float *ab_w_in, *ab_w_out, *mlstm_gate_b, *mlstm_norm, *na_rpb;
    const float *cd_w_in, *cd_w_out, *gqa_sink, *lru_conv_w, *lru_conv_b, *lru_gate_w, *lru_gate_b, *lru_lambda;
    const float *moe_router, *moe_w1, *moe_w3, *moe_w2;
    float* out;
    unsigned char* ws;
    int ph_lo, ph_hi;
};

#define XB_TMO      128
#define XB_XCNT(j)  (256  + 64 * (j))
#define XB_XSUB(j)  (1280 + 64 * (j))
#define XB_XGEN(j)  (2304 + 64 * (j))
#define XB_TOP      3328
#define XB_TOPGEN   3392
#define XCD_BAR_WORDS 3456
#define XB_SPIN_CAP (1u << 22)
#define LAS __attribute__((address_space(3)))

__device__ __forceinline__ unsigned xb_ld(unsigned* p)              { return __hip_atomic_load(p, __ATOMIC_RELAXED, __HIP_MEMORY_SCOPE_AGENT); }
__device__ __forceinline__ unsigned xb_add(unsigned* p, unsigned v) { return __hip_atomic_fetch_add(p, v, __ATOMIC_RELAXED, __HIP_MEMORY_SCOPE_AGENT); }
__device__ __forceinline__ unsigned xb_xcc_id() { return (unsigned)__builtin_amdgcn_s_getreg((3 << 11) | 20) & 0xFu; }
#define XB_SPIN(cond, bar) do { unsigned _sp = 0; while (cond) { __builtin_amdgcn_s_sleep(1); \
    if ((++_sp & 255u) == 0u) { if (xb_ld(&(bar)[XB_TMO])) break; if (_sp > XB_SPIN_CAP) { atomicAdd(&(bar)[XB_TMO], 1u); break; } } } } while (0)

struct XcdBarrier {
    unsigned* bar; unsigned x;
    volatile LAS unsigned* st;
};
__device__ __forceinline__ XcdBarrier xcd_barrier_post(unsigned* bar, volatile LAS unsigned* st) {
    XcdBarrier b; b.bar = bar; b.x = xb_xcc_id(); b.st = st;
    if (threadIdx.x == 0) (void)xb_add(&bar[XB_XCNT(b.x)], 1u);
    return b;
}
__device__ __forceinline__ void xcd_barrier_complete(unsigned* bar, unsigned x, unsigned& nloc, unsigned& nx) {
    const unsigned G = gridDim.x * gridDim.y * gridDim.z;
    unsigned sum, cnt, mine, sp = 0u;
    for (;;) {
        sum = 0u; cnt = 0u; mine = 0u;
#pragma unroll
        for (unsigned j = 0; j < 16; ++j) { const unsigned c = xb_ld(&bar[XB_XCNT(j)]); sum += c; cnt += (c > 0u) ? 1u : 0u; mine = (j == x) ? c : mine; }
        if (sum == G) break;
        __builtin_amdgcn_s_sleep(1);
        if ((++sp & 255u) == 0u) { if (xb_ld(&bar[XB_TMO])) break; if (sp > XB_SPIN_CAP) { atomicAdd(&bar[XB_TMO], 1u); break; } }
    }
    nloc = mine > 0u ? mine : 1u; nx = cnt > 0u ? cnt : 1u;
}
__device__ __forceinline__ void xcd_barrier(const XcdBarrier& b) {
    asm volatile("s_waitcnt vmcnt(0)" ::: "memory");
    __syncthreads();
    if (threadIdx.x == 0) {
        unsigned* bar = b.bar;
        __builtin_amdgcn_s_waitcnt(0);
        unsigned nloc = b.st[0], nx = b.st[1];
        if (nloc == 0u) { xcd_barrier_complete(bar, b.x, nloc, nx); b.st[0] = nloc; b.st[1] = nx; }
        const unsigned old = xb_add(&bar[XB_XSUB(b.x)], 1u);
        const unsigned gen = old / nloc;
        if (old + 1u == (gen + 1u) * nloc) {
            __builtin_amdgcn_fence(__ATOMIC_RELEASE, "agent");
            asm volatile("s_waitcnt vmcnt(0)" ::: "memory");
            const unsigned og = xb_add(&bar[XB_TOP], 1u);
            const unsigned tg = og / nx;
            if (og + 1u == (tg + 1u) * nx) xb_add(&bar[XB_TOPGEN], 1u);
            else XB_SPIN(xb_ld(&bar[XB_TOPGEN]) == tg, bar);
            __builtin_amdgcn_fence(__ATOMIC_ACQUIRE, "agent");
            xb_add(&bar[XB_XGEN(b.x)], 1u);
            asm volatile("s_waitcnt vmcnt(0)" ::: "memory");
        } else {
            XB_SPIN(xb_ld(&bar[XB_XGEN(b.x)]) == gen, bar);
            __builtin_amdgcn_fence(__ATOMIC_ACQUIRE, "agent");
            asm volatile("s_waitcnt vmcnt(0)" ::: "memory");
        }
    }
    __syncthreads();
}

typedef float f32x2_t __attribute__((ext_vector_type(2)));
typedef __bf16 bf16x2_t __attribute__((ext_vector_type(2)));
__device__ __forceinline__ unsigned pk_bf16(float lo, float hi) { f32x2_t v = {lo, hi}; return __builtin_bit_cast(unsigned, __builtin_convertvector(v, bf16x2_t)); }
__device__ __forceinline__ float bf_lo(unsigned u) { return __uint_as_float(u << 16); }
__device__ __forceinline__ float bf_hi(unsigned u) { return __uint_as_float(u & 0xffff0000u); }
__device__ __forceinline__ float bf2f(u16 v) { return __uint_as_float(((unsigned)v) << 16); }
typedef int i32x4 __attribute__((ext_vector_type(4)));
typedef int i32x8 __attribute__((ext_vector_type(8)));
constexpr float F8_SW = 256.f, F8_SH = 8.f, F8_SA = 4.f;
__device__ __forceinline__ float f8_clamp(float x) { return __builtin_amdgcn_fmed3f(x, -448.f, 448.f); }
__device__ __forceinline__ unsigned pk_fp8x4(float a, float b, float c, float d) {
    unsigned r = 0u;
    r = (unsigned)__builtin_amdgcn_cvt_pk_fp8_f32(f8_clamp(a), f8_clamp(b), (int)r, false);
    r = (unsigned)__builtin_amdgcn_cvt_pk_fp8_f32(f8_clamp(c), f8_clamp(d), (int)r, true);
    return r; }
__device__ __forceinline__ i32x8 cat8(bf16x8 lo, bf16x8 hi) { return __builtin_shufflevector(__builtin_bit_cast(i32x4, lo), __builtin_bit_cast(i32x4, hi), 0, 1, 2, 3, 4, 5, 6, 7); }
__device__ __forceinline__ u16 f2bf(float f) { return (u16)(pk_bf16(f, 0.f) & 0xffffu); }
template <int CTRL> __device__ __forceinline__ float dpp_f(float v) { return __uint_as_float((unsigned)__builtin_amdgcn_update_dpp(0, (int)__float_as_uint(v), CTRL, 0xf, 0xf, true)); }
__device__ __forceinline__ float row_sum16(float v) { v += dpp_f<0xB1>(v); v += dpp_f<0x4E>(v); v += dpp_f<0x141>(v); v += dpp_f<0x140>(v); return v; }
__device__ __forceinline__ float row_max16(float v) { v = fmaxf(v, dpp_f<0xB1>(v)); v = fmaxf(v, dpp_f<0x4E>(v)); v = fmaxf(v, dpp_f<0x141>(v)); v = fmaxf(v, dpp_f<0x140>(v)); return v; }
__device__ __forceinline__ float rdlane_f(float v, int l) { return __uint_as_float((unsigned)__builtin_amdgcn_readlane((int)__float_as_uint(v), l)); }
__device__ __forceinline__ float sum_x16(float v) { const auto r = __builtin_amdgcn_permlane16_swap(__float_as_uint(v), __float_as_uint(v), false, false); return __uint_as_float(r[0]) + __uint_as_float(r[1]); }
__device__ __forceinline__ float sum_x32(float v) { const auto r = __builtin_amdgcn_permlane32_swap(__float_as_uint(v), __float_as_uint(v), false, false); return __uint_as_float(r[0]) + __uint_as_float(r[1]); }
__device__ __forceinline__ float max_x16(float v) { const auto r = __builtin_amdgcn_permlane16_swap(__float_as_uint(v), __float_as_uint(v), false, false); return fmaxf(__uint_as_float(r[0]), __uint_as_float(r[1])); }
__device__ __forceinline__ float max_x32(float v) { const auto r = __builtin_amdgcn_permlane32_swap(__float_as_uint(v), __float_as_uint(v), false, false); return fmaxf(__uint_as_float(r[0]), __uint_as_float(r[1])); }
__device__ __forceinline__ float partner_x16(float v) { const auto r = __builtin_amdgcn_permlane16_swap(__float_as_uint(v), __float_as_uint(v), false, false); return __uint_as_float(r[0] ^ r[1] ^ __float_as_uint(v)); }
__device__ __forceinline__ float partner_x32(float v) { const auto r = __builtin_amdgcn_permlane32_swap(__float_as_uint(v), __float_as_uint(v), false, false); return __uint_as_float(r[0] ^ r[1] ^ __float_as_uint(v)); }
__device__ __forceinline__ float wave_sum(float v) { return sum_x32(sum_x16(row_sum16(v))); }
__device__ __forceinline__ float wave_max(float v) { return max_x32(max_x16(row_max16(v))); }
__device__ __forceinline__ int hw_slot_() { return (int)(__builtin_amdgcn_s_getreg((5 << 11) | 4) & 63u); }
__device__ __forceinline__ int tid_() {
    int lane; asm volatile("v_mbcnt_lo_u32_b32 %0, -1, 0\n\tv_mbcnt_hi_u32_b32 %0, -1, %0" : "=v"(lane));
    const int w = ((volatile LAS int*)(g_lds))[8 + hw_slot_()];
    int t = __builtin_amdgcn_readfirstlane(w) * 64 + lane; asm volatile("" : "+v"(t)); return t; }
__device__ __forceinline__ int bid_() { unsigned o = 16; asm volatile("" : "+v"(o)); return __builtin_amdgcn_readfirstlane(*(const LAS int*)((LAS unsigned char*)(g_lds) + o)); }
__device__ __forceinline__ int gdim_() { unsigned o = 20; asm volatile("" : "+v"(o)); return __builtin_amdgcn_readfirstlane(*(const LAS int*)((LAS unsigned char*)(g_lds) + o)); }
__device__ __forceinline__ unsigned char* ws_() {
    unsigned o = 24; asm volatile("" : "+v"(o));
    const u32x2 v = *(const LAS u32x2*)((LAS unsigned char*)(g_lds) + o);
    const unsigned long long a = ((unsigned long long)(unsigned)__builtin_amdgcn_readfirstlane((int)v[1]) << 32) | (unsigned)__builtin_amdgcn_readfirstlane((int)v[0]);
    return (unsigned char*)a; }
__device__ __forceinline__ float frcp_(float x) { return __builtin_amdgcn_rcpf(x); }
__device__ __forceinline__ float sigmoidf_(float x) { return frcp_(1.f + __expf(-x)); }
__device__ __forceinline__ f32x4 mfma16(bf16x8 a, bf16x8 b, f32x4 c) { return __builtin_amdgcn_mfma_f32_16x16x32_bf16(a, b, c, 0, 0, 0); }
__device__ __forceinline__ bf16x8 ld_frag_g(const u16* p) { return *reinterpret_cast<const bf16x8*>(p); }
__device__ __forceinline__ bf16x8 ld_frag_s(const u16* p) { return *reinterpret_cast<const bf16x8*>(p); }
__device__ __forceinline__ bf16x8 mk_frag(unsigned a, unsigned b, unsigned c, unsigned d) { u32x4 v = {a, b, c, d}; return __builtin_bit_cast(bf16x8, v); }

__device__ __forceinline__ const float* xin_row(const Params& p, const unsigned char* ws, int l, int row) {
    if (l == 0) return row < NLAT ? p.x + (size_t)row * D : p.ctx + (size_t)(row - NLAT) * D;
    return (const float*)(ws + WS_XL2) + (size_t)row * D;
}
__device__ __forceinline__ const float* mod_ptr(const unsigned char* ws, int l, int row, int chunk) {
    const int bb = row < NLAT ? (row >> 12) : 4;
    return (const float*)(ws + WS_MOD) + ((size_t)(l * 5 + bb) * 6 + chunk) * D;
}

__device__ void phase_mod(const Params& p, unsigned char* lds_raw) {
    unsigned char* const ws = ws_();
    float* scond = (float*)lds_raw;
    float* red = scond + 5 * D;
    const int t = tid_();
    for (int i = t; i < 5 * D; i += NT) { const int r = i >> 11, k = i & 2047; const float v = r < 4 ? p.c[r * D + k] : p.c_ctx[k]; scond[i] = v / (1.f + __expf(-v)); }
    __syncthreads();
    float* mod = (float*)(ws + WS_MOD);
    for (int item = bid_(); item < 192; item += gdim_()) {
        const int l = item / 96, col0 = (item % 96) * 128;
        const int kg = t >> 5, cl = (t & 31) * 4;
        f32x4 acc[5];
#pragma unroll
        for (int r = 0; r < 5; ++r) acc[r] = (f32x4){0.f, 0.f, 0.f, 0.f};
        const float* wp = p.ada_w + ((size_t)l * D + kg * 128) * (6 * D) + col0 + cl;
#pragma unroll 8
        for (int kk = 0; kk < 128; ++kk) {
            const f32x4 w = *reinterpret_cast<const f32x4*>(wp + (size_t)kk * (6 * D));
#pragma unroll
            for (int r = 0; r < 5; ++r) { const float s = scond[r * D + kg * 128 + kk]; acc[r] += w * s; }
        }
#pragma unroll
        for (int r = 0; r < 5; ++r) *reinterpret_cast<f32x4*>(red + (kg * 5 + r) * 128 + cl) = acc[r];
        __syncthreads();
        for (int o = t; o < 640; o += NT) {
            const int r = o >> 7, cc = o & 127;
            float s = p.ada_b[l * 6 * D + col0 + cc];
#pragma unroll
            for (int g = 0; g < 16; ++g) s += red[(g * 5 + r) * 128 + cc];
            mod[(size_t)(l * 5 + r) * 6 * D + col0 + cc] = s;
        }
        __syncthreads();
    }
}

__device__ void phase_norm_mod(const Params& p, int l) {
    unsigned char* const ws = ws_();
    const int lane = tid_() & 63, w = tid_() >> 6;
    u16* H = (u16*)(ws + WS_H);
    for (int row = bid_() * 8 + w; row < NTOK; row += gdim_() * 8) {
        const float* xr = xin_row(p, ws, l, row);
        f32x4 v[8]; float ss = 0.f;
#pragma unroll
        for (int i = 0; i < 8; ++i) { v[i] = *reinterpret_cast<const f32x4*>(xr + (i * 64 + lane) * 4); ss += v[i][0] * v[i][0] + v[i][1] * v[i][1] + v[i][2] * v[i][2] + v[i][3] * v[i][3]; }
        ss = wave_sum(ss);
        const float rstd = rsqrtf(ss * (1.f / D) + 1e-6f);
        const float* sh = mod_ptr(ws, l, row, 0); const float* sc = mod_ptr(ws, l, row, 1);
        const float* nw = p.norm_mix_pre + (size_t)l * D;
#pragma unroll
        for (int i = 0; i < 8; ++i) {
            const int col = (i * 64 + lane) * 4;
            const f32x4 w4 = *reinterpret_cast<const f32x4*>(nw + col), s4 = *reinterpret_cast<const f32x4*>(sc + col), h4 = *reinterpret_cast<const f32x4*>(sh + col);
            f32x4 o = v[i] * rstd * w4 * (s4 + 1.f) + h4;
            u32x2 pk = {pk_bf16(o[0], o[1]), pk_bf16(o[2], o[3])};
            *reinterpret_cast<u32x2*>(H + (size_t)row * D + col) = pk;
        }
    }
}

__device__ __forceinline__ void convert_item(const float* W, int N, u16* Wt, int kb, int nb, unsigned char* lds) {
    const int t = tid_(), lane = t & 63, w = t >> 6;
    const int n4 = lane * 4, k0 = kb * 64 + w * 8, n0 = nb * 256;
    int col = n0 + n4; if (col > N - 4) col = N - 4;
    f32x4 r8[8];
#pragma unroll
    for (int j = 0; j < 8; ++j) r8[j] = *reinterpret_cast<const f32x4*>(W + (size_t)(k0 + j) * N + col);
    __syncthreads();
#pragma unroll
    for (int jj = 0; jj < 4; ++jj) {
        u32x4 v = {pk_bf16(r8[0][jj], r8[1][jj]), pk_bf16(r8[2][jj], r8[3][jj]), pk_bf16(r8[4][jj], r8[5][jj]), pk_bf16(r8[6][jj], r8[7][jj])};
        const int r = n4 + jj;
        *reinterpret_cast<u32x4*>(lds + r * 128 + ((w ^ ((r >> 2) & 7)) << 4)) = v;
    }
    __syncthreads();
    const int c = t & 7;
#pragma unroll
    for (int i = 0; i < 4; ++i) {
        const int r = (t >> 3) + 64 * i;
        if (n0 + r < N) {
            const u32x4 v = *reinterpret_cast<const u32x4*>(lds + r * 128 + ((c ^ ((r >> 2) & 7)) << 4));
            *reinterpret_cast<u32x4*>(Wt + (size_t)(n0 + r) * 2048 + kb * 64 + c * 8) = v;
        }
    }
}
__device__ __forceinline__ void convert_item8(const float* W, unsigned char* Wt, int kb, int nb, unsigned char* lds) {
    const int t = tid_(), lane = t & 63, w = t >> 6;
    const int n4 = lane * 4, k0 = kb * 128 + w * 16, n0 = nb * 256;
    f32x4 r[16];
#pragma unroll
    for (int j = 0; j < 16; ++j) r[j] = *reinterpret_cast<const f32x4*>(W + (size_t)(k0 + j) * 2048 + n0 + n4);
    __syncthreads();
#pragma unroll
    for (int jj = 0; jj < 4; ++jj) {
        u32x4 v;
#pragma unroll
        for (int q = 0; q < 4; ++q) v[q] = pk_fp8x4(r[4 * q][jj] * F8_SW, r[4 * q + 1][jj] * F8_SW, r[4 * q + 2][jj] * F8_SW, r[4 * q + 3][jj] * F8_SW);
        const int rr = n4 + jj;
        *reinterpret_cast<u32x4*>(lds + rr * 128 + ((w ^ ((rr >> 2) & 7)) << 4)) = v;
    }
    __syncthreads();
    const int c = t & 7;
#pragma unroll
    for (int i = 0; i < 4; ++i) {
        const int rr = (t >> 3) + 64 * i;
        const u32x4 v = *reinterpret_cast<const u32x4*>(lds + rr * 128 + ((c ^ ((rr >> 2) & 7)) << 4));
        *reinterpret_cast<u32x4*>(Wt + (size_t)(n0 + rr) * 2048 + kb * 128 + c * 16) = v;
    }
}
__device__ void convert_matrix_items(const float* W, int N, u16* Wt, int first, int count, unsigned char* lds) {
    const int nnb = (N + 255) / 256;
    for (int it = first; it < first + count; ++it) convert_item(W, N, Wt, it / nnb, it % nnb, lds);
}
__device__ void phase_convert_dense(const Params& p, unsigned char* lds) {
    unsigned char* const ws = ws_();
    for (int item = bid_(); item < 1888; item += gdim_()) {
        if (item < 928) convert_item(p.ab_w_in, AB_IN, (u16*)(ws + WS_WT_ABIN), item / 29, item % 29, lds);
        else if (item < 1184) { const int it = item - 928; convert_item(p.ab_w_out, D, (u16*)(ws + WS_WT_ABOUT), it / 8, it % 8, lds); }
        else if (item < 1632) { const int it = item - 1184; convert_item(p.cd_w_in, CD_IN, (u16*)(ws + WS_WT_CDIN), it / 14, it % 14, lds); }
        else { const int it = item - 1632; convert_item(p.cd_w_out, D, (u16*)(ws + WS_WT_CDOUT), it / 8, it % 8, lds); }
    }
}
__device__ void phase_convert_moe(const Params& p, int l, unsigned char* lds) {
    unsigned char* const ws = ws_();
    for (int item = bid_(); item < 3 * NEXP * 128; item += gdim_()) {
        const int which = item / (NEXP * 128), r = item % (NEXP * 128), ex = r >> 7, it = r & 127;
        const float* src = (which == 0 ? p.moe_w1 : (which == 1 ? p.moe_w3 : p.moe_w2)) + (size_t)(l * NEXP + ex) * D * FF;
        unsigned char* dst = ws + (which == 0 ? WS_WT_W1 : (which == 1 ? WS_WT_W3 : WS_WT_W2)) + (size_t)ex * D * FF;
        convert_item8(src, dst, it >> 3, it & 7, lds);
    }
}

__device__ __forceinline__ int g8_lds_byte(int r, int c) { const int st = (r >> 4) * 2 + (c >> 5), rr = r & 15, cc = c & 31, ob = rr * 64 + cc * 2; return st * 1024 + (ob ^ (((ob >> 9) & 1) << 5)); }
__device__ __forceinline__ void g8_stage_rc(int bb, int& R, int& C) { const int st = bb / 1024, sb = bb % 1024, swz = sb ^ (((sb >> 9) & 1) << 5); R = (st >> 1) * 16 + swz / 64; C = (st & 1) * 32 + (swz % 64) / 2; }
__device__ __forceinline__ int g8_perm32(int rho) { const int n = rho >> 4, i = rho & 15; return 8 * (i >> 2) + 4 * n + (i & 3); }

enum { EPI_BF16 = 0, EPI_SWIGLU = 2, EPI_SCALE = 3 };
struct GUnit { const char* a; const char* b0; const char* b1; const int* arow; int m0, n0, mvalid, ncols; u16* ob; int ldo; float* gates; const float* rscale; };
constexpr int G8_HTB = 128 * 64 * 2;
constexpr size_t G8_KSTEP = 128, G8_HSTEP = (size_t)128 * 2048 * 2;

template <int EPI>
__device__ __forceinline__ void g8_epilogue(const f32x4 (&acc)[2][2][4][2], const GUnit& u, int wr, int wc, int fr, int fq) {
#pragma unroll
    for (int ai = 0; ai < 2; ++ai)
#pragma unroll
        for (int m = 0; m < 4; ++m) {
            const int row = u.m0 + 128 * ai + 64 * wr + 16 * m + fr;
            if (row < u.mvalid) {
                if (EPI == EPI_BF16) {
#pragma unroll
                    for (int bj = 0; bj < 2; ++bj) {
                        const int col = u.n0 + 128 * bj + 32 * wc + 8 * fq;
                        if (col < u.ncols) {
                            const f32x4 v0 = acc[ai][bj][m][0], v1 = acc[ai][bj][m][1];
                            u32x4 pk = {pk_bf16(v0[0], v0[1]), pk_bf16(v0[2], v0[3]), pk_bf16(v1[0], v1[1]), pk_bf16(v1[2], v1[3])};
                            *reinterpret_cast<u32x4*>(u.ob + (size_t)row * u.ldo + col) = pk;
                            if (u.gates && col >= 4096 && col < 4112) { *reinterpret_cast<f32x4*>(u.gates + (size_t)row * 16 + (col - 4096)) = v0; *reinterpret_cast<f32x4*>(u.gates + (size_t)row * 16 + (col - 4096) + 4) = v1; }
                        }
                    }
                } else if (EPI == EPI_SWIGLU) {
                    const int col = u.n0 + 32 * wc + 8 * fq;
                    float a[8];
                    constexpr float si = 1.f / (F8_SH * F8_SW);
#pragma unroll
                    for (int n = 0; n < 2; ++n)
#pragma unroll
                        for (int q = 0; q < 4; ++q) { const float x = acc[ai][0][m][n][q] * si; a[n * 4 + q] = x * frcp_(1.f + __expf(-x)) * (acc[ai][1][m][n][q] * (si * F8_SA)); }
                    u32x2 pk = {pk_fp8x4(a[0], a[1], a[2], a[3]), pk_fp8x4(a[4], a[5], a[6], a[7])};
                    *reinterpret_cast<u32x2*>((unsigned char*)u.ob + (size_t)row * u.ldo + col) = pk;
                } else {
                    const float sc = u.rscale[row] * (1.f / (F8_SA * F8_SW));
#pragma unroll
                    for (int bj = 0; bj < 2; ++bj) {
                        const int col = u.n0 + 128 * bj + 32 * wc + 8 * fq;
                        const f32x4 v0 = acc[ai][bj][m][0] * sc, v1 = acc[ai][bj][m][1] * sc;
                        u32x4 pk = {pk_bf16(v0[0], v0[1]), pk_bf16(v0[2], v0[3]), pk_bf16(v1[0], v1[1]), pk_bf16(v1[2], v1[3])};
                        *reinterpret_cast<u32x4*>(u.ob + (size_t)row * u.ldo + col) = pk;
                    }
                }
            }
        }
}

template <int EPI, bool GATHER, class UnitFn>
__device__ __forceinline__ void gemm_phase8(unsigned char* lds, UnitFn next) {
    const int tid = tid_(), wid = __builtin_amdgcn_readfirstlane(tid >> 6), lane = tid & 63, wr = wid >> 2, wc = wid & 3, fr = lane & 15, fq = lane >> 4;
    constexpr bool F8 = (EPI != EPI_BF16);
    constexpr int nt = F8 ? 2048 / 128 : 2048 / 64;
    constexpr unsigned ROWB = F8 ? 2048u : 4096u;
    GUnit cur, nxt; int ui = 0;
    if (!next(0, cur)) return;
    int sR[2], sC[2];
#pragma unroll
    for (int i = 0; i < 2; ++i) g8_stage_rc(tid * 16 + i * 8192, sR[i], sC[i]);
    unsigned voffB[2];
#pragma unroll
    for (int i = 0; i < 2; ++i) voffB[i] = (unsigned)((sR[i] & ~31) + g8_perm32(sR[i] & 31)) * ROWB + (unsigned)sC[i] * 2u;
    unsigned voffA[2][2], voffAn[2][2];
    auto set_voffA = [&](const GUnit& u, unsigned (&vo)[2][2]) {
#pragma unroll
        for (int h = 0; h < 2; ++h)
#pragma unroll
            for (int i = 0; i < 2; ++i) {
                if (GATHER) vo[h][i] = (unsigned)u.arow[u.m0 + h * 128 + sR[i]] * ROWB + (unsigned)sC[i] * 2u;
                else vo[h][i] = (unsigned)(h * 128 + sR[i]) * ROWB + (unsigned)sC[i] * 2u;
            } };
    set_voffA(cur, voffA);
    const unsigned ldsw = (unsigned)wid * 1024u;
    const int aoff = g8_lds_byte(wr * 64 + fr, fq * 8), boff = g8_lds_byte(wc * 32 + fr, fq * 8);
#define G8_SA(b, h) (((b) * 2 + (h)) * G8_HTB)
#define G8_SB(b, h) ((4 + (b) * 2 + (h)) * G8_HTB)
#define G8_STAGE(bufoff, gbase, voff) do { _Pragma("unroll") for (int _i = 0; _i < 2; ++_i) \
        __builtin_amdgcn_global_load_lds((const unsigned*)((const char*)(gbase) + (voff)[_i]), (LAS unsigned*)(lds + (bufoff) + ldsw + _i * 8192), 16, 0, 0); } while (0)
#define G8_LDA(dst, b, h) do { _Pragma("unroll") for (int m = 0; m < 4; ++m) _Pragma("unroll") for (int k = 0; k < 2; ++k) dst[m][k] = *(const LAS bf16x8*)(lds + G8_SA(b, h) + aoff + m * 2048 + k * 1024); } while (0)
#define G8_LDB(dst, b, h) do { _Pragma("unroll") for (int n = 0; n < 2; ++n) _Pragma("unroll") for (int k = 0; k < 2; ++k) dst[n][k] = *(const LAS bf16x8*)(lds + G8_SB(b, h) + boff + n * 2048 + k * 1024); } while (0)
#define G8_MMA(ai, bj, At, Bt) do { __builtin_amdgcn_s_setprio(1); _Pragma("unroll") for (int m = 0; m < 4; ++m) _Pragma("unroll") for (int n = 0; n < 2; ++n) { \
        if (F8) { const i32x8 _b = cat8(Bt[n][0], Bt[n][1]), _a = cat8(At[m][0], At[m][1]); asm volatile("v_mfma_f32_16x16x128_f8f6f4 %0, %1, %2, %0" : "+v"(acc[ai][bj][m][n]) : "v"(_b), "v"(_a)); } \
        else { _Pragma("unroll") for (int k = 0; k < 2; ++k) acc[ai][bj][m][n] = __builtin_amdgcn_mfma_f32_16x16x32_bf16(Bt[n][k], At[m][k], acc[ai][bj][m][n], 0, 0, 0); } } \
        __builtin_amdgcn_s_setprio(0); } while (0)
#define G8_WAIT_V(n) asm volatile("s_waitcnt vmcnt(" #n ")" ::: "memory")
#define G8_WAIT_L(n) asm volatile("s_waitcnt lgkmcnt(" #n ")" ::: "memory")
#define G8_BAR __builtin_amdgcn_s_barrier()
#define G8_SCHED __builtin_amdgcn_sched_barrier(0)
    f32x4 acc[2][2][4][2];
#pragma unroll
    for (int a2 = 0; a2 < 2; ++a2)
#pragma unroll
        for (int b2 = 0; b2 < 2; ++b2)
#pragma unroll
            for (int m = 0; m < 4; ++m)
#pragma unroll
                for (int n = 0; n < 2; ++n) acc[a2][b2][m][n] = (f32x4){0.f, 0.f, 0.f, 0.f};
    bf16x8 At[4][2], B0[2][2], B1[2][2];
    const char* cA = cur.a; const char* cB0 = cur.b0; const char* cB1 = cur.b1;
    G8_STAGE(G8_SB(0, 0), cB0, voffB); G8_STAGE(G8_SA(0, 0), cA, voffA[0]); G8_STAGE(G8_SB(0, 1), cB1, voffB); G8_STAGE(G8_SA(0, 1), cA, voffA[1]);
    if (wr == 1) G8_BAR;
    G8_WAIT_V(4); G8_BAR;
    G8_STAGE(G8_SB(1, 0), cB0 + G8_KSTEP, voffB); G8_STAGE(G8_SA(1, 0), cA + G8_KSTEP, voffA[0]); G8_STAGE(G8_SB(1, 1), cB1 + G8_KSTEP, voffB);
    G8_WAIT_V(6); G8_BAR;
    for (;;) {
        const bool has_next = next(ui + 1, nxt);
        const char* nA = has_next ? nxt.a : cA; const char* nB0 = has_next ? nxt.b0 : cB0; const char* nB1 = has_next ? nxt.b1 : cB1;
        if (GATHER) { if (has_next) set_voffA(nxt, voffAn); else { _Pragma("unroll") for (int h = 0; h < 2; ++h) _Pragma("unroll") for (int i = 0; i < 2; ++i) voffAn[h][i] = voffA[h][i]; } }
        for (int t = 0; t < nt; t += 2) {
            const bool last = (t == nt - 2);
            const char* a1 = cA + (size_t)(t + 1) * G8_KSTEP;
            const char* a2 = last ? nA : cA + (size_t)(t + 2) * G8_KSTEP;
            const char* b20 = last ? nB0 : cB0 + (size_t)(t + 2) * G8_KSTEP; const char* b21 = last ? nB1 : cB1 + (size_t)(t + 2) * G8_KSTEP;
            const char* a3 = a2 + G8_KSTEP; const char* b30 = b20 + G8_KSTEP; const char* b31 = b21 + G8_KSTEP;
            unsigned vA2[2][2];
#pragma unroll
            for (int h = 0; h < 2; ++h)
#pragma unroll
                for (int i = 0; i < 2; ++i) vA2[h][i] = (GATHER && last) ? voffAn[h][i] : voffA[h][i];
            G8_LDB(B0, 0, 0); G8_SCHED; G8_LDA(At, 0, 0); G8_STAGE(G8_SA(1, 1), a1, voffA[1]);
            G8_WAIT_L(8); G8_BAR; G8_WAIT_L(0); G8_MMA(0, 0, At, B0); G8_BAR; G8_SCHED;
            G8_LDB(B1, 0, 1); G8_STAGE(G8_SB(0, 0), b20, voffB);
            G8_BAR; G8_WAIT_L(0); G8_MMA(0, 1, At, B1); G8_BAR;
            G8_LDA(At, 0, 1); G8_STAGE(G8_SA(0, 0), a2, vA2[0]);
            G8_BAR; G8_WAIT_L(0); G8_MMA(1, 0, At, B0); G8_BAR; G8_SCHED;
            G8_STAGE(G8_SB(0, 1), b21, voffB);
            G8_WAIT_V(6); G8_BAR; G8_MMA(1, 1, At, B1); G8_BAR;
            G8_LDB(B0, 1, 0); G8_SCHED; G8_LDA(At, 1, 0); G8_STAGE(G8_SA(0, 1), a2, vA2[1]);
            G8_WAIT_L(8); G8_BAR; G8_WAIT_L(0); G8_MMA(0, 0, At, B0); G8_BAR; G8_SCHED;
            G8_LDB(B1, 1, 1); G8_STAGE(G8_SB(1, 0), b30, voffB);
            G8_BAR; G8_WAIT_L(0); G8_MMA(0, 1, At, B1); G8_BAR;
            G8_LDA(At, 1, 1); G8_STAGE(G8_SA(1, 0), a3, vA2[0]);
            G8_BAR; G8_WAIT_L(0); G8_MMA(1, 0, At, B0); G8_BAR; G8_SCHED;
            G8_STAGE(G8_SB(1, 1), b31, voffB);
            G8_WAIT_V(6); G8_BAR; G8_MMA(1, 1, At, B1); G8_BAR;
        }
        if (F8) asm volatile("s_nop 15\n\ts_nop 15" ::: "memory");
        g8_epilogue<EPI>(acc, cur, wr, wc, fr, fq);
        if (!has_next) break;
#pragma unroll
        for (int a2 = 0; a2 < 2; ++a2)
#pragma unroll
            for (int b2 = 0; b2 < 2; ++b2)
#pragma unroll
                for (int m = 0; m < 4; ++m)
#pragma unroll
                    for (int n = 0; n < 2; ++n) acc[a2][b2][m][n] = (f32x4){0.f, 0.f, 0.f, 0.f};
        cur = nxt; cA = nA; cB0 = nB0; cB1 = nB1; ++ui;
        if (GATHER) { _Pragma("unroll") for (int h = 0; h < 2; ++h) _Pragma("unroll") for (int i = 0; i < 2; ++i) voffA[h][i] = voffAn[h][i]; }
    }
    G8_WAIT_V(0);
    if (wr == 0) G8_BAR;
    G8_BAR;
#undef G8_SA
#undef G8_SB
#undef G8_STAGE
#undef G8_LDA
#undef G8_LDB
#undef G8_MMA
#undef G8_WAIT_V
#undef G8_WAIT_L
#undef G8_BAR
#undef G8_SCHED
}

__device__ __forceinline__ void phase_gemm_dense(const Params& p, const u16* A, int M, const u16* Wt, int N, u16* ob, int ldo, float* gates, unsigned char* lds) {
    const int nM = M / 256, nN = (N + 255) / 256, L = nM * nN;
    const int xcd = bid_() & 7, slot = bid_() >> 3, nslot = gdim_() >> 3;
    const int base = (int)(((long)L * xcd) >> 3), cnt = (int)(((long)L * (xcd + 1)) >> 3) - base;
    const int G8n = nM >> 3, rem = nM & 7;
    auto next = [&](int i, GUnit& u) -> bool {
        const int k = slot + i * nslot;
        if (k >= cnt) return false;
        const int idx = base + k;
        int pn, pm;
        if (idx < G8n * 8 * nN) { const int gq = idx / (8 * nN), r = idx % (8 * nN); pn = r >> 3; pm = gq * 8 + (r & 7); }
        else { const int r = idx - G8n * 8 * nN; pn = r / rem; pm = G8n * 8 + r % rem; }
        u.a = (const char*)(A + (size_t)pm * 256 * 2048); u.b0 = (const char*)(Wt + (size_t)pn * 256 * 2048); u.b1 = u.b0 + G8_HSTEP; u.arow = nullptr;
        u.m0 = pm * 256; u.n0 = pn * 256; u.mvalid = M; u.ncols = N; u.ob = ob; u.ldo = ldo; u.gates = gates; u.rscale = nullptr;
        return true; };
    gemm_phase8<EPI_BF16, false>(lds, next);
}

__device__ __forceinline__ void phase_moe_a(const Params& p, int l, unsigned char* lds) {
    unsigned char* const ws = ws_();
    const int mvalid = l == 0 ? 2176 : 2048, nM = l == 0 ? 9 : 8;
    const int per_e = nM * 16;
    const int xcd = bid_() & 7, slot = bid_() >> 3, nslot = gdim_() >> 3;
    auto next = [&](int i, GUnit& u) -> bool {
        const int k = slot + i * nslot;
        if (k >= 2 * per_e) return false;
        const int tile = xcd * 2 * per_e + k;
        const int ex = tile / per_e, r = tile % per_e, pn = r / nM, pm = r % nM;
        u.a = (const char*)(ws + WS_H); u.arow = (const int*)(ws + WS_EROW) + ex * EPAD;
        u.b0 = (const char*)(ws + WS_WT_W1) + ((size_t)ex * FF + pn * 128) * D; u.b1 = (const char*)(ws + WS_WT_W3) + ((size_t)ex * FF + pn * 128) * D;
        u.m0 = pm * 256; u.n0 = pn * 128; u.mvalid = mvalid; u.ncols = FF; u.ob = (u16*)(ws + WS_ACT + (size_t)ex * EPAD * FF); u.ldo = FF; u.gates = nullptr; u.rscale = nullptr;
        return true; };
    gemm_phase8<EPI_SWIGLU, true>(lds, next);
}
__device__ __forceinline__ void phase_moe_b(const Params& p, int l, unsigned char* lds) {
    unsigned char* const ws = ws_();
    const int mvalid = l == 0 ? 2176 : 2048, nM = l == 0 ? 9 : 8;
    const int per_e = nM * 8;
    const int xcd = bid_() & 7, slot = bid_() >> 3, nslot = gdim_() >> 3;
    auto next = [&](int i, GUnit& u) -> bool {
        const int k = slot + i * nslot;
        if (k >= 2 * per_e) return false;
        const int tile = xcd * 2 * per_e + k;
        const int ex = tile / per_e, r = tile % per_e, pn = r / nM, pm = r % nM;
        u.a = (const char*)(ws + WS_ACT) + ((size_t)ex * EPAD + pm * 256) * FF; u.arow = nullptr;
        u.b0 = (const char*)(ws + WS_WT_W2) + ((size_t)ex * D + pn * 256) * FF; u.b1 = u.b0 + (size_t)128 * 2048;
        u.m0 = pm * 256; u.n0 = pn * 256; u.mvalid = mvalid; u.ncols = D; u.ob = (u16*)(ws + WS_YEXP) + (size_t)ex * EPAD * D; u.ldo = D; u.gates = nullptr;
        u.rscale = (const float*)(ws + WS_EGATE) + ex * EPAD;
        return true; };
    gemm_phase8<EPI_SCALE, false>(lds, next);
}

__device__ __forceinline__ int mlstm_row(int b, int dir, int pos) {
    if (pos < LC) return NLAT + b * LC + (dir ? (LC - 1 - pos) : pos);
    const int q = pos - LC; return b * SEQ + (dir ? (SEQ - 1 - q) : q);
}
__device__ void phase_mlstm(const Params& p, unsigned char* lds) {
    unsigned char* const ws = ws_();
    u16* KT = (u16*)lds;
    u16* VT = KT + 256 * 72;
    u16* VWT = VT + 48 * 72;
    u16* CT = VWT + 48 * 72;
    u16* Ss = CT + 48 * 264;
    float* gB = (float*)(Ss + 64 * 72);
    float* gI = gB + 68 * 64;
    float* gP = gI + 68 * 64;
    float* gE = gP + 68 * 64;
    const int t = tid_(), lane = t & 63, w = t >> 6, fr = lane & 15, fq = lane >> 4;
    const u16* P = (const u16*)(ws + WS_P);
    const float* G = (const float*)(ws + WS_G);
    u16* HM = (u16*)(ws + WS_HM);
    for (int item = bid_(); item < 256; item += gdim_()) {
        const int vs = item & 7, dir = (item >> 3) & 1, hh = (item >> 4) & 3, b = item >> 6;
        __syncthreads();
        for (int i = t; i < 48 * 264; i += NT) CT[i] = 0;
        for (int i = t; i < 16 * 72; i += NT) { const int er = i / 72; VT[32 * 72 + i] = (er == 0) ? (u16)0x3f80 : (u16)0; VWT[32 * 72 + i] = 0; }
        {
            const float gb_i = p.mlstm_gate_b[(dir * 2 + 0) * 4 + hh], gb_f = p.mlstm_gate_b[(dir * 2 + 1) * 4 + hh];
            for (int ch = w; ch < 68; ch += 8) {
                const int row = mlstm_row(b, dir, ch * 64 + lane);
                const float gi = G[(size_t)row * 16 + dir * 8 + hh] + gb_i;
                const float gf = G[(size_t)row * 16 + dir * 8 + 4 + hh] + gb_f;
                const float lf = fminf(gf, 0.f) - log1pf(__expf(-fabsf(gf)));
                float bc = lf;
#pragma unroll
                for (int o = 1; o < 64; o <<= 1) { const float n = __shfl_up(bc, o, 64); if (lane >= o) bc += n; }
                float pm = gi - bc;
#pragma unroll
                for (int o = 1; o < 64; o <<= 1) { const float n = __shfl_up(pm, o, 64); if (lane >= o) pm = fmaxf(pm, n); }
                const float b63 = __shfl(bc, 63, 64);
                float gmax = b63 - bc + gi;
#pragma unroll
                for (int o = 32; o > 0; o >>= 1) gmax = fmaxf(gmax, __shfl_xor(gmax, o, 64));
                gB[ch * 64 + lane] = bc; gI[ch * 64 + lane] = gi; gP[ch * 64 + lane] = pm;
                if (lane == 0) { gE[ch * 2] = b63; gE[ch * 2 + 1] = gmax; }
            }
        }
        f32x4 Cacc[2][3];
#pragma unroll
        for (int i = 0; i < 2; ++i)
#pragma unroll
            for (int j = 0; j < 3; ++j) Cacc[i][j] = (f32x4){0.f, 0.f, 0.f, 0.f};
        float m_old = 0.f;
        const int jt = w & 3, sth = w >> 2;
        const int vs_s = t & 63, vs_eg = t >> 6;
        bf16x8 qf[8]; unsigned ktr[2][8]; u32x2 vraw;
        const int jq = jt * 16 + fr, jjq = dir ? 63 - jq : jq;
        const unsigned off_q = (unsigned)jjq * AB_IN + hh * 256 + fq * 8;
        const int jk0 = (sth * 2) * 16 + fr, jk1 = jk0 + 16;
        const unsigned off_k0 = (unsigned)(dir ? 63 - jk0 : jk0) * AB_IN + 1024 + hh * 256 + fq * 8;
        const unsigned off_k1 = (unsigned)(dir ? 63 - jk1 : jk1) * AB_IN + 1024 + hh * 256 + fq * 8;
        unsigned off_kt[2];
#pragma unroll
        for (int i = 0; i < 2; ++i) { const int mt = t + NT * i, d2 = (mt & 127) * 2, s8 = (mt >> 7) * 8; off_kt[i] = (unsigned)(dir ? 63 - s8 - 7 : s8) * AB_IN + 1024 + hh * 256 + d2; }
        const unsigned off_v = (unsigned)(dir ? 63 - vs_s : vs_s) * AB_IN + 2048 + hh * 256 + vs * 32 + vs_eg * 4;
        const unsigned off_h = (unsigned)jjq * 1024 + hh * 256 + vs * 32 + sth * 16 + 4 * fq;
#define ML_BASE(POS0) (P + (size_t)(dir ? mlstm_row(b, dir, (POS0)) - 63 : mlstm_row(b, dir, (POS0))) * AB_IN)
#define ML_LOAD_Q(POS0) do { const u16* _pc = ML_BASE(POS0); \
            _Pragma("unroll") for (int kk = 0; kk < 8; ++kk) qf[kk] = ld_frag_g(_pc + off_q + kk * 32); } while (0)
#define ML_LOAD_K(POS0, S2) do { const u16* _pc = ML_BASE(POS0); \
            _Pragma("unroll") for (int kk = 0; kk < 8; ++kk) kf[kk] = ld_frag_g(_pc + ((S2) ? off_k1 : off_k0) + kk * 32); } while (0)
#define ML_LOAD_KTV(POS0) do { const u16* _pc = ML_BASE(POS0); \
            _Pragma("unroll") for (int i = 0; i < 2; ++i) { \
                _Pragma("unroll") for (int q = 0; q < 8; ++q) ktr[i][q] = *reinterpret_cast<const unsigned*>(_pc + (size_t)((dir ? 7 - q : q) * AB_IN) + off_kt[i]); } \
            vraw = *reinterpret_cast<const u32x2*>(_pc + off_v); } while (0)
        ML_LOAD_Q(0); ML_LOAD_KTV(0);
        __syncthreads();
        for (int ch = 0; ch < 68; ++ch) {
            const int pos0 = ch * 64;
            const float* sb = gB + ch * 64; const float* sig = gI + ch * 64; const float* spm = gP + ch * 64;
            const float b63 = gE[ch * 2], m_new = fmaxf(b63 + m_old, gE[ch * 2 + 1]), decay = __expf(b63 + m_old - m_new);
            const int jg = jt * 16 + fr;
            const float bj = sb[jg], mj = bj + fmaxf(m_old, spm[jg]);
            auto s_tile = [&](int st) {
                f32x4 sv = (f32x4){0.f, 0.f, 0.f, 0.f};
                if (st <= jt) {
                    typedef short s16x4 __attribute__((ext_vector_type(4)));
                    const u16* kb = KT + (8 * fq + ((lane & 15) >> 2)) * 72 + st * 16 + 4 * (lane & 3);
#pragma unroll
                    for (int kk = 0; kk < 8; ++kk) {
                        const s16x4 lo = __builtin_amdgcn_ds_read_tr16_b64_v4i16((LAS s16x4*)(kb + kk * 32 * 72));
                        const s16x4 hi = __builtin_amdgcn_ds_read_tr16_b64_v4i16((LAS s16x4*)(kb + (kk * 32 + 4) * 72));
                        const bf16x8 kfr = {lo[0], lo[1], lo[2], lo[3], hi[0], hi[1], hi[2], hi[3]};
                        sv = mfma16(kfr, qf[kk], sv);
                    }
                }
                float pv[4];
#pragma unroll
                for (int q = 0; q < 4; ++q) {
                    const int sg = st * 16 + 4 * fq + q;
                    pv[q] = (sg <= jg) ? sv[q] * 0.0625f * __expf(bj - sb[sg] + sig[sg] - mj) : 0.f;
                }
                u32x2 pk = {pk_bf16(pv[0], pv[1]), pk_bf16(pv[2], pv[3])};
                *reinterpret_cast<u32x2*>(Ss + jg * 72 + st * 16 + 4 * fq) = pk;
            };
#pragma unroll
            for (int i = 0; i < 2; ++i) {
                const int mt = t + NT * i, d2 = (mt & 127) * 2, s8 = (mt >> 7) * 8;
                u32x4 lo = {(ktr[i][0] & 0xffffu) | (ktr[i][1] << 16), (ktr[i][2] & 0xffffu) | (ktr[i][3] << 16), (ktr[i][4] & 0xffffu) | (ktr[i][5] << 16), (ktr[i][6] & 0xffffu) | (ktr[i][7] << 16)};
                u32x4 hi = {(ktr[i][0] >> 16) | (ktr[i][1] & 0xffff0000u), (ktr[i][2] >> 16) | (ktr[i][3] & 0xffff0000u), (ktr[i][4] >> 16) | (ktr[i][5] & 0xffff0000u), (ktr[i][6] >> 16) | (ktr[i][7] & 0xffff0000u)};
                *reinterpret_cast<u32x4*>(KT + d2 * 72 + s8) = lo;
                *reinterpret_cast<u32x4*>(KT + (d2 + 1) * 72 + s8) = hi;
            }
            {
                const float wg = __expf(b63 - sb[vs_s] + sig[vs_s] - m_new) * 0.0625f;
                const float v0 = bf_lo(vraw[0]), v1 = bf_hi(vraw[0]), v2 = bf_lo(vraw[1]), v3 = bf_hi(vraw[1]);
                const int e0 = vs_eg * 4;
                VT[(e0 + 0) * 72 + vs_s] = (u16)(vraw[0] & 0xffffu); VT[(e0 + 1) * 72 + vs_s] = (u16)(vraw[0] >> 16);
                VT[(e0 + 2) * 72 + vs_s] = (u16)(vraw[1] & 0xffffu); VT[(e0 + 3) * 72 + vs_s] = (u16)(vraw[1] >> 16);
                VWT[(e0 + 0) * 72 + vs_s] = f2bf(v0 * wg); VWT[(e0 + 1) * 72 + vs_s] = f2bf(v1 * wg);
                VWT[(e0 + 2) * 72 + vs_s] = f2bf(v2 * wg); VWT[(e0 + 3) * 72 + vs_s] = f2bf(v3 * wg);
                if (t < 64) VWT[32 * 72 + t] = f2bf(wg);
            }
            if (ch + 1 < 68) ML_LOAD_KTV(pos0 + 64);
            __syncthreads();
            s_tile(sth * 2);
            s_tile(sth * 2 + 1);
            __syncthreads();
            {
                const float w_inter = __expf(bj + m_old - mj);
                f32x4 nacc[2];
#pragma unroll
                for (int z = 0; z < 2; ++z) {
                    const int et = z == 0 ? sth : 2;
                    f32x4 a = (f32x4){0.f, 0.f, 0.f, 0.f};
#pragma unroll
                    for (int kk = 0; kk < 8; ++kk) a = mfma16(ld_frag_s(CT + (et * 16 + fr) * 264 + kk * 32 + fq * 8), qf[kk], a);
                    nacc[z] = a * w_inter;
                }
                if (ch + 1 < 68) ML_LOAD_Q(pos0 + 64);
#pragma unroll
                for (int z = 0; z < 2; ++z) {
                    const int et = z == 0 ? sth : 2;
                    f32x4 a = nacc[z];
#pragma unroll
                    for (int k2 = 0; k2 < 2; ++k2) a = mfma16(ld_frag_s(VT + (et * 16 + fr) * 72 + k2 * 32 + fq * 8), ld_frag_s(Ss + jg * 72 + k2 * 32 + fq * 8), a);
                    nacc[z] = a;
                }
                const float den = __shfl(nacc[1][0], fr, 64);
                const float dd = fmaxf(fabsf(den), __expf(-mj));
                const float inv = 1.f / dd;
                u32x2 pk = {pk_bf16(nacc[0][0] * inv, nacc[0][1] * inv), pk_bf16(nacc[0][2] * inv, nacc[0][3] * inv)};
                *reinterpret_cast<u32x2*>(HM + ((size_t)dir * NTOK + (dir ? mlstm_row(b, dir, pos0) - 63 : mlstm_row(b, dir, pos0))) * 1024 + off_h) = pk;
            }
#pragma unroll
            for (int i = 0; i < 2; ++i)
#pragma unroll
                for (int et = 0; et < 3; ++et) {
                    f32x4 a = Cacc[i][et] * decay;
#pragma unroll
                    for (int k2 = 0; k2 < 2; ++k2) a = mfma16(ld_frag_s(KT + ((w * 2 + i) * 16 + fr) * 72 + k2 * 32 + fq * 8), ld_frag_s(VWT + (et * 16 + fr) * 72 + k2 * 32 + fq * 8), a);
                    Cacc[i][et] = a;
                }
            __syncthreads();
#pragma unroll
            for (int i = 0; i < 2; ++i)
#pragma unroll
                for (int et = 0; et < 3; ++et) {
                    const f32x4 a = Cacc[i][et];
                    u32x2 pk = {pk_bf16(a[0], a[1]), pk_bf16(a[2], a[3])};
                    *reinterpret_cast<u32x2*>(CT + (et * 16 + fr) * 264 + (w * 2 + i) * 16 + 4 * fq) = pk;
                }
            m_old = m_new;
        }
#undef ML_LOAD_Q
#undef ML_LOAD_K
#undef ML_LOAD_KTV
    }
}

__device__ void mlstm_out_rows(const Params& p, int row0, int nrows) {
    unsigned char* const ws = ws_();
    const int lane = tid_() & 63, w = tid_() >> 6;
    const u16* P = (const u16*)(ws + WS_P);
    const u16* HM = (const u16*)(ws + WS_HM);
    u16* YIN = (u16*)(ws + WS_YIN);
    for (int r = w; r < nrows; r += 8) {
        const int row = row0 + r;
        const int c0 = lane * 16;
        float v[16]; float ss = 0.f;
#pragma unroll
        for (int h2 = 0; h2 < 2; ++h2) {
            const u32x4 a = *reinterpret_cast<const u32x4*>(HM + (size_t)row * 1024 + c0 + h2 * 8);
            const u32x4 bq = *reinterpret_cast<const u32x4*>(HM + ((size_t)NTOK + row) * 1024 + c0 + h2 * 8);
#pragma unroll
            for (int q = 0; q < 4; ++q) { v[h2 * 8 + 2 * q] = bf_lo(a[q]) + bf_lo(bq[q]); v[h2 * 8 + 2 * q + 1] = bf_hi(a[q]) + bf_hi(bq[q]); }
        }
#pragma unroll
        for (int q = 0; q < 16; ++q) ss += v[q] * v[q];
        ss += __shfl_xor(ss, 1, 64); ss += __shfl_xor(ss, 2, 64); ss += __shfl_xor(ss, 4, 64); ss += __shfl_xor(ss, 8, 64);
        const float rstd = rsqrtf(ss * (1.f / 256.f) + 1e-6f);
        unsigned o[8];
#pragma unroll
        for (int h2 = 0; h2 < 2; ++h2) {
            const u32x4 og = *reinterpret_cast<const u32x4*>(P + (size_t)row * AB_IN + 3072 + c0 + h2 * 8);
#pragma unroll
            for (int q = 0; q < 4; ++q) {
                const int c = c0 + h2 * 8 + 2 * q;
                const float y0 = v[h2 * 8 + 2 * q] * rstd * p.mlstm_norm[c] * sigmoidf_(bf_lo(og[q]));
                const float y1 = v[h2 * 8 + 2 * q + 1] * rstd * p.mlstm_norm[c + 1] * sigmoidf_(bf_hi(og[q]));
                o[h2 * 4 + q] = pk_bf16(y0, y1);
            }
        }
        *reinterpret_cast<u32x4*>(YIN + (size_t)row * D + c0) = (u32x4){o[0], o[1], o[2], o[3]};
        *reinterpret_cast<u32x4*>(YIN + (size_t)row * D + c0 + 8) = (u32x4){o[4], o[5], o[6], o[7]};
    }
}

template <int DH, class KeyFn, class BiasFn>
__device__ __forceinline__ void attn_wave(const u16* qptr, size_t qstride, int nblk, KeyFn keyfn, BiasFn biasfn, float scale,
                                           float m_init, float l_init, u16* vlds, u16* optr, size_t ostride) {
    constexpr int NK = DH / 32, NDT = DH / 16, VS = DH + 8, NV = DH / 16;
    const int lane = tid_() & 63, fr = lane & 15, fq = lane >> 4;
    bf16x8 qf[NK];
#pragma unroll
    for (int kk = 0; kk < NK; ++kk) qf[kk] = ld_frag_g(qptr + (size_t)fr * qstride + kk * 32 + fq * 8);
    f32x4 oacc[NDT];
#pragma unroll
    for (int i = 0; i < NDT; ++i) oacc[i] = (f32x4){0.f, 0.f, 0.f, 0.f};
    float m = m_init, l = l_init;
    bf16x8 kn[2][NK]; u32x4 vn[NV];
    auto load_blk = [&](int ib) {
        const u16* kptr; const u16* vptr; size_t kvs;
        (void)keyfn(ib, kptr, vptr, kvs);
#pragma unroll
        for (int st = 0; st < 2; ++st)
#pragma unroll
            for (int kk = 0; kk < NK; ++kk) kn[st][kk] = ld_frag_g(kptr + (size_t)(st * 16 + fr) * kvs + kk * 32 + fq * 8);
#pragma unroll
        for (int i = 0; i < NV; ++i) { const int cidx = lane + 64 * i, r = cidx / (DH / 8), cc = cidx % (DH / 8); vn[i] = *reinterpret_cast<const u32x4*>(vptr + (size_t)r * kvs + cc * 8); }
    };
    auto next_valid = [&](int ib) { const u16* a; const u16* b2; size_t c; while (ib < nblk && !keyfn(ib, a, b2, c)) ++ib; return ib; };
    int ib = next_valid(0);
    if (ib < nblk) load_blk(ib);
    while (ib < nblk) {
        bf16x8 kc[2][NK]; u32x4 vc[NV];
#pragma unroll
        for (int st = 0; st < 2; ++st)
#pragma unroll
            for (int kk = 0; kk < NK; ++kk) kc[st][kk] = kn[st][kk];
#pragma unroll
        for (int i = 0; i < NV; ++i) vc[i] = vn[i];
        const int ibn = next_valid(ib + 1);
        if (ibn < nblk) load_blk(ibn);
        asm volatile("" ::: "memory");
#pragma unroll
        for (int i = 0; i < NV; ++i) { const int cidx = lane + 64 * i, r = cidx / (DH / 8), cc = cidx % (DH / 8); *reinterpret_cast<u32x4*>(vlds + r * VS + cc * 8) = vc[i]; }
        f32x4 s[2];
#pragma unroll
        for (int st = 0; st < 2; ++st) {
            f32x4 a = (f32x4){0.f, 0.f, 0.f, 0.f};
#pragma unroll
            for (int kk = 0; kk < NK; ++kk) a = mfma16(kc[st][kk], qf[kk], a);
            s[st] = a;
        }
        float x[8]; float mx = -INFINITY;
#pragma unroll
        for (int st = 0; st < 2; ++st)
#pragma unroll
            for (int q = 0; q < 4; ++q) { const float v = s[st][q] * scale + biasfn(ib, fr, st * 16 + 4 * fq + q); x[st * 4 + q] = v; mx = fmaxf(mx, v); }
        mx = max_x32(max_x16(mx));
        const float m_new = fmaxf(m, mx);
        const float m_safe = (m_new == -INFINITY) ? 0.f : m_new;
        const float alpha = __expf(m - m_safe);
        float ps = 0.f; float pe[8];
#pragma unroll
        for (int q = 0; q < 8; ++q) { pe[q] = __expf(x[q] - m_safe); ps += pe[q]; }
        l = l * alpha + ps; m = m_new;
#pragma unroll
        for (int i = 0; i < NDT; ++i) oacc[i] *= alpha;
        const bf16x8 pf = mk_frag(pk_bf16(pe[0], pe[1]), pk_bf16(pe[2], pe[3]), pk_bf16(pe[4], pe[5]), pk_bf16(pe[6], pe[7]));
        asm volatile("s_waitcnt lgkmcnt(0)" ::: "memory");
        {
            typedef short s16x4 __attribute__((ext_vector_type(4)));
            const int tq = (lane & 15) >> 2, tp = lane & 3;
            const u16* vb0 = vlds + (4 * fq + tq) * VS + 4 * tp;
            const u16* vb1 = vb0 + 16 * VS;
#pragma unroll
            for (int dt = 0; dt < NDT; ++dt) {
                const s16x4 lo = __builtin_amdgcn_ds_read_tr16_b64_v4i16((LAS s16x4*)(vb0 + dt * 16));
                const s16x4 hi = __builtin_amdgcn_ds_read_tr16_b64_v4i16((LAS s16x4*)(vb1 + dt * 16));
                const bf16x8 vf = {lo[0], lo[1], lo[2], lo[3], hi[0], hi[1], hi[2], hi[3]};
                oacc[dt] = mfma16(vf, pf, oacc[dt]);
            }
        }
        asm volatile("" ::: "memory");
        ib = ibn;
    }
    l = sum_x32(sum_x16(l));
    const float inv = 1.f / l;
#pragma unroll
    for (int dt = 0; dt < NDT; ++dt) {
        const f32x4 o = oacc[dt] * inv;
        u32x2 pk = {pk_bf16(o[0], o[1]), pk_bf16(o[2], o[3])};
        *reinterpret_cast<u32x2*>(optr + (size_t)fr * ostride + dt * 16 + 4 * fq) = pk;
    }
}


template <int DH, class SlabFn, class SubFn, class BiasFn>
__device__ __forceinline__ void attn_block(const u16* qptr, size_t qstride, int nslab, SlabFn slabfn, SubFn subfn, BiasFn biasfn, float scale,
                                            float m_init, float l_init, unsigned char* lds, u16* optr, size_t ostride) {
    constexpr int NK = DH / 32, NDT = DH / 16, VS = DH + 8, NLD = DH / 64;
    constexpr int STAGE = 2 * 64 * VS * 2;
    const int t = tid_(), lane = t & 63, fr = lane & 15, fq = lane >> 4;
    bf16x8 qf[NK];
#pragma unroll
    for (int kk = 0; kk < NK; ++kk) qf[kk] = ld_frag_g(qptr + (size_t)fr * qstride + kk * 32 + fq * 8);
    f32x4 oacc[NDT];
#pragma unroll
    for (int i = 0; i < NDT; ++i) oacc[i] = (f32x4){0.f, 0.f, 0.f, 0.f};
    float m = m_init, l = l_init;
    u32x4 kreg[NLD], vreg[NLD];
    auto load_slab = [&](int i) {
        const u16* kp; const u16* vp; size_t kvs; slabfn(i, kp, vp, kvs);
#pragma unroll
        for (int q = 0; q < NLD; ++q) { const int c = t + NT * q, r = c / (DH / 8), cc = c % (DH / 8);
            kreg[q] = *reinterpret_cast<const u32x4*>(kp + (size_t)r * kvs + cc * 8); vreg[q] = *reinterpret_cast<const u32x4*>(vp + (size_t)r * kvs + cc * 8); } };
    auto store_slab = [&](int st) {
        u16* Ks = (u16*)(lds + st * STAGE); u16* Vs = Ks + 64 * VS;
#pragma unroll
        for (int q = 0; q < NLD; ++q) { const int c = t + NT * q, r = c / (DH / 8), cc = c % (DH / 8);
            *reinterpret_cast<u32x4*>(Ks + r * VS + cc * 8) = kreg[q]; *reinterpret_cast<u32x4*>(Vs + r * VS + cc * 8) = vreg[q]; } };
    __syncthreads();
    load_slab(0); store_slab(0);
    if (nslab > 1) load_slab(1);
    __syncthreads();
    for (int i = 0; i < nslab; ++i) {
        const int cur = i & 1;
        if (i + 1 < nslab) store_slab(cur ^ 1);
        if (i + 2 < nslab) load_slab(i + 2);
        const u16* Ks = (const u16*)(lds + cur * STAGE); const u16* Vs = Ks + 64 * VS;
#pragma unroll
        for (int j = 0; j < 2; ++j) {
            int off;
            if (!subfn(i, j, off)) continue;
            f32x4 s[2];
#pragma unroll
            for (int st = 0; st < 2; ++st) {
                f32x4 a = (f32x4){0.f, 0.f, 0.f, 0.f};
#pragma unroll
                for (int kk = 0; kk < NK; ++kk) a = mfma16(ld_frag_s(Ks + (off + st * 16 + fr) * VS + kk * 32 + fq * 8), qf[kk], a);
                s[st] = a;
            }
            float x[8]; float mx = -INFINITY;
#pragma unroll
            for (int st = 0; st < 2; ++st)
#pragma unroll
                for (int q = 0; q < 4; ++q) { const float v = s[st][q] * scale + biasfn(i, off, fr, st * 16 + 4 * fq + q); x[st * 4 + q] = v; mx = fmaxf(mx, v); }
            mx = max_x32(max_x16(mx));
            const float m_new = fmaxf(m, mx);
            const float m_safe = (m_new == -INFINITY) ? 0.f : m_new;
            const float alpha = __expf(m - m_safe);
            float ps = 0.f; float pe[8];
#pragma unroll
            for (int q = 0; q < 8; ++q) { pe[q] = __expf(x[q] - m_safe); ps += pe[q]; }
            l = l * alpha + ps; m = m_new;
#pragma unroll
            for (int dt = 0; dt < NDT; ++dt) oacc[dt] *= alpha;
            const bf16x8 pf = mk_frag(pk_bf16(pe[0], pe[1]), pk_bf16(pe[2], pe[3]), pk_bf16(pe[4], pe[5]), pk_bf16(pe[6], pe[7]));
            typedef short s16x4 __attribute__((ext_vector_type(4)));
            const int tq = (lane & 15) >> 2, tp = lane & 3;
            const u16* vb0 = Vs + (off + 4 * fq + tq) * VS + 4 * tp;
            const u16* vb1 = vb0 + 16 * VS;
#pragma unroll
            for (int dt = 0; dt < NDT; ++dt) {
                const s16x4 lo = __builtin_amdgcn_ds_read_tr16_b64_v4i16((LAS s16x4*)(vb0 + dt * 16));
                const s16x4 hi = __builtin_amdgcn_ds_read_tr16_b64_v4i16((LAS s16x4*)(vb1 + dt * 16));
                const bf16x8 vf = {lo[0], lo[1], lo[2], lo[3], hi[0], hi[1], hi[2], hi[3]};
                oacc[dt] = mfma16(vf, pf, oacc[dt]);
            }
        }
        __syncthreads();
    }
    l = sum_x32(sum_x16(l));
    const float inv = 1.f / l;
#pragma unroll
    for (int dt = 0; dt < NDT; ++dt) {
        const f32x4 o = oacc[dt] * inv;
        u32x2 pk = {pk_bf16(o[0], o[1]), pk_bf16(o[2], o[3])};
        *reinterpret_cast<u32x2*>(optr + (size_t)fr * ostride + dt * 16 + 4 * fq) = pk;
    }
}

__device__ void phase_l0_stage2(const Params& p, unsigned char* lds) {
    unsigned char* const ws = ws_();
    const int w = tid_() >> 6;
    const u16* P = (const u16*)(ws + WS_P);
    u16* YIN = (u16*)(ws + WS_YIN);
    for (int item = bid_(); item < 1088 + 2176; item += gdim_()) {
        if (item < 1024) {
            const int r2 = item & 31, h = (item >> 5) & 7, b = item >> 8;
            const int rr = w >> 2, qt = w & 3, r = 2 * r2 + rr;
            const int r0 = min(max(r - 4, 0), 56);
            const int krow0 = min(max(2 * r2 - 4, 0), 56), nwin = min(max(2 * r2 + 1 - 4, 0), 56) + 8 - krow0;
            const int cb = qt == 0 ? 0 : (qt == 1 ? 8 : (qt == 2 ? 24 : 32));
            const int qrow = b * SEQ + r * 64 + qt * 16;
            const float* rpb = p.na_rpb + h * 15 * 31;
            auto slabfn = [&](int i, const u16*& kp, const u16*& vp, size_t& kvs) {
                const int row = i < nwin ? b * SEQ + (krow0 + i) * 64 : NLAT + b * LC + (i - nwin) * 64;
                kp = P + (size_t)row * AB_IN + 5136 + h * 128; vp = P + (size_t)row * AB_IN + 6160 + h * 128; kvs = AB_IN; };
            auto subfn = [&](int i, int j, int& off) -> bool {
                if (i < nwin) { off = cb; return j == 0 && (krow0 + i) >= r0 && (krow0 + i) < r0 + 8; }
                off = 32 * j; return true; };
            auto biasfn = [&](int i, int off, int qi, int ki) -> float {
                if (i >= nwin) return 0.f;
                const int c = qt * 16 + qi, kc = off + ki, c0 = min(max(c - 8, 0), 48);
                if (kc < c0 || kc >= c0 + 16) return -INFINITY;
                return rpb[(krow0 + i - r + 7) * 31 + (kc - c + 15)]; };
            attn_block<128>(P + (size_t)qrow * AB_IN + 4112 + h * 128, AB_IN, nwin + 4, slabfn, subfn, biasfn, 0.08838834764831845f, -INFINITY, 0.f, lds,
                            YIN + (size_t)qrow * D + 1024 + h * 128, D);
        } else if (item < 1088) {
            const int it = item - 1024, half = it & 1, h = (it >> 1) & 7, b = it >> 4;
            const int qrow = NLAT + b * LC + (half * 8 + w) * 16;
            auto slabfn = [&](int i, const u16*& kp, const u16*& vp, size_t& kvs) {
                const int row = NLAT + b * LC + i * 64;
                kp = P + (size_t)row * AB_IN + 5136 + h * 128; vp = P + (size_t)row * AB_IN + 6160 + h * 128; kvs = AB_IN; };
            auto subfn = [&](int, int j, int& off) -> bool { off = 32 * j; return true; };
            auto biasfn = [&](int, int, int, int) -> float { return 0.f; };
            attn_block<128>(P + (size_t)qrow * AB_IN + 4112 + h * 128, AB_IN, 4, slabfn, subfn, biasfn, 0.08838834764831845f, -INFINITY, 0.f, lds,
                            YIN + (size_t)qrow * D + 1024 + h * 128, D);
        } else {
            mlstm_out_rows(p, (item - 1088) * 8, 8);
        }
    }
}

__device__ void rope_rows(const Params& p, int row0, int nrows) {
    unsigned char* const ws = ws_();
    const int lane = tid_() & 63, w = tid_() >> 6;
    u16* P = (u16*)(ws + WS_P);
    for (int r = w; r < nrows; r += 8) {
        const int row = row0 + r, tt = row & (SEQ - 1);
        const float prow = (float)(tt >> 6), pcol = (float)(tt & 63);
        for (int pi = lane; pi < 640; pi += 64) {
            const int head = pi >> 5, half = (pi >> 4) & 1, j = pi & 15;
            const int base = (head < 16 ? head * 64 : 1024 + (head - 16) * 64) + half * 32 + j;
            const float inv = exp2f(-(float)j * (13.287712379549449f / 16.f));
            const float ang = (half ? pcol : prow) * inv;
            float sn, cs; sincosf(ang, &sn, &cs);
            u16* q1 = P + (size_t)row * CD_IN + base;
            const float x1 = bf2f(q1[0]), x2 = bf2f(q1[16]);
            q1[0] = f2bf(x1 * cs - x2 * sn); q1[16] = f2bf(x2 * cs + x1 * sn);
        }
    }
}

__device__ __forceinline__ int lru_row(int b, int ci, int j) { return ci < 4 ? NLAT + b * LC + ci * 64 + j : b * SEQ + (ci - 4) * 64 + j; }
__device__ __forceinline__ void lru_chunk(const Params& p, int b, int blk, int ci, int mode, unsigned char* lds) {
    unsigned char* const ws = ws_();
    u16* ub = (u16*)lds;
    constexpr int SR = 132;
    float* sa = (float*)(ub + 64 * 136);
    float* sbt = sa + 64 * SR;
    float* sx = sbt + 64 * SR;
    const int t = tid_(), lane = t & 63, w = t >> 6, fr = lane & 15, fq = lane >> 4;
    const u16* P = (const u16*)(ws + WS_P);
    const u16* WT = (const u16*)(ws + WS_LRUW);
    float* SA = (float*)(ws + WS_LRUS);
    float* SH = SA + 2 * 4 * 68 * 1024;
    const int seglen = ci < 4 ? LC : SEQ, tt0 = ci < 4 ? ci * 64 : (ci - 4) * 64;
    const int rbase = ci < 4 ? NLAT + b * LC : b * SEQ;
    const int sc = t & 127, seg = t >> 7;
    const int chg_s = blk * 128 + sc;
    const int cg = blk * 128 + w * 16 + 4 * fq;
    bf16x8 wfa[2][2][4];
#pragma unroll
    for (int d2 = 0; d2 < 2; ++d2)
#pragma unroll
        for (int g2 = 0; g2 < 2; ++g2)
#pragma unroll
            for (int kk = 0; kk < 4; ++kk) wfa[d2][g2][kk] = ld_frag_g(WT + ((size_t)((d2 * 2 + g2) * 8 + blk) * 128 + w * 16 + fr) * 128 + fq * 8 + kk * 32);
    f32x4 gba[2][2], lama[2];
#pragma unroll
    for (int d2 = 0; d2 < 2; ++d2) {
        lama[d2] = *reinterpret_cast<const f32x4*>(p.lru_lambda + d2 * 1024 + cg);
#pragma unroll
        for (int g2 = 0; g2 < 2; ++g2) gba[d2][g2] = *reinterpret_cast<const f32x4*>(p.lru_gate_b + (d2 * 2 + g2) * 1024 + cg);
    }
    float carry[2] = {0.f, 0.f}; u16 grv[16];
    if (mode == 1) {
#pragma unroll
        for (int d2 = 0; d2 < 2; ++d2) carry[d2] = SH[((size_t)(d2 * 4 + b) * 68 + ci) * 1024 + chg_s];
#pragma unroll
        for (int s = 0; s < 16; ++s) grv[s] = P[(size_t)lru_row(b, ci, seg * 16 + s) * CD_IN + 2560 + chg_s];
    }
    __syncthreads();
    {
        const int c4 = (t & 31) * 4, j0 = (t >> 5) * 4, ch = blk * 128 + c4;
        float xv[7][4];
#pragma unroll
        for (int q = 0; q < 7; ++q) {
            const int tt = tt0 + j0 - 1 + q;
            if (tt >= 0 && tt < seglen) {
                const u32x2 v = *reinterpret_cast<const u32x2*>(P + (size_t)(rbase + tt) * CD_IN + 1536 + ch);
                xv[q][0] = bf_lo(v[0]); xv[q][1] = bf_hi(v[0]); xv[q][2] = bf_lo(v[1]); xv[q][3] = bf_hi(v[1]);
            } else { xv[q][0] = xv[q][1] = xv[q][2] = xv[q][3] = 0.f; }
        }
        f32x4 cw[4];
#pragma unroll
        for (int tp = 0; tp < 4; ++tp) cw[tp] = *reinterpret_cast<const f32x4*>(p.lru_conv_w + tp * 1024 + ch);
        const f32x4 cb = *reinterpret_cast<const f32x4*>(p.lru_conv_b + ch);
#pragma unroll
        for (int q = 0; q < 4; ++q) {
            float u[4];
#pragma unroll
            for (int cc = 0; cc < 4; ++cc) u[cc] = cb[cc] + xv[q][cc] * cw[0][cc] + xv[q + 1][cc] * cw[1][cc] + xv[q + 2][cc] * cw[2][cc] + xv[q + 3][cc] * cw[3][cc];
            u32x2 pk = {pk_bf16(u[0], u[1]), pk_bf16(u[2], u[3])};
            *reinterpret_cast<u32x2*>(ub + (j0 + q) * 136 + c4) = pk;
        }
    }
    __syncthreads();
    float hfw[16];
    for (int dir = 0; dir < 2; ++dir) {
        f32x4 av[4];
        {
            bf16x8 wf[4];
#pragma unroll
            for (int kk = 0; kk < 4; ++kk) wf[kk] = dir ? wfa[1][0][kk] : wfa[0][0][kk];
            const f32x4 gbv = dir ? gba[1][0] : gba[0][0];
            const f32x4 lamv = dir ? lama[1] : lama[0];
            float sp8[4];
#pragma unroll
            for (int q = 0; q < 4; ++q) { const float nl = -lamv[q]; sp8[q] = -8.f * (fmaxf(nl, 0.f) + __logf(1.f + __expf(-fabsf(nl)))); }
#pragma unroll
            for (int tt = 0; tt < 4; ++tt) {
                f32x4 z = (f32x4){0.f, 0.f, 0.f, 0.f};
#pragma unroll
                for (int kk = 0; kk < 4; ++kk) z = mfma16(wf[kk], ld_frag_s(ub + (tt * 16 + fr) * 136 + kk * 32 + fq * 8), z);
#pragma unroll
                for (int q = 0; q < 4; ++q) av[tt][q] = __expf(sigmoidf_(z[q] + gbv[q]) * sp8[q]);
            }
        }
        __syncthreads();
        {
            bf16x8 wf[4];
#pragma unroll
            for (int kk = 0; kk < 4; ++kk) wf[kk] = dir ? wfa[1][1][kk] : wfa[0][1][kk];
            const f32x4 gbv = dir ? gba[1][1] : gba[0][1];
#pragma unroll
            for (int tt = 0; tt < 4; ++tt) {
                f32x4 z = (f32x4){0.f, 0.f, 0.f, 0.f};
#pragma unroll
                for (int kk = 0; kk < 4; ++kk) z = mfma16(wf[kk], ld_frag_s(ub + (tt * 16 + fr) * 136 + kk * 32 + fq * 8), z);
                const int tj = tt * 16 + fr;
                const u32x2 uv = *reinterpret_cast<const u32x2*>(ub + tj * 136 + w * 16 + 4 * fq);
                const float u4[4] = {bf_lo(uv[0]), bf_hi(uv[0]), bf_lo(uv[1]), bf_hi(uv[1])};
                f32x4 bv;
#pragma unroll
                for (int q = 0; q < 4; ++q) { const float a = av[tt][q]; bv[q] = __builtin_amdgcn_sqrtf(fmaxf(1.f - a * a, 0.f)) * sigmoidf_(z[q] + gbv[q]) * u4[q]; }
                *reinterpret_cast<f32x4*>(sa + tj * SR + w * 16 + 4 * fq) = av[tt];
                *reinterpret_cast<f32x4*>(sbt + tj * SR + w * 16 + 4 * fq) = bv;
            }
        }
        __syncthreads();
        float A = 1.f, h = 0.f;
#pragma unroll
        for (int s = 0; s < 16; ++s) { const int j = seg * 16 + (dir ? 15 - s : s); const float a = sa[j * SR + sc]; h = a * h + sbt[j * SR + sc]; A *= a; }
        sx[(seg * 2 + 0) * 128 + sc] = A; sx[(seg * 2 + 1) * 128 + sc] = h;
        __syncthreads();
        const size_t sidx = ((size_t)(dir * 4 + b) * 68 + ci) * 1024 + chg_s;
        if (mode == 0) {
            if (seg == 0) {
                float At = 1.f, ht = 0.f;
#pragma unroll
                for (int s = 0; s < 4; ++s) { const int sg = dir ? 3 - s : s; const float a = sx[(sg * 2) * 128 + sc]; ht = a * ht + sx[(sg * 2 + 1) * 128 + sc]; At *= a; }
                SA[sidx] = At; SH[sidx] = ht;
            }
        } else {
            float hs = dir ? carry[1] : carry[0];
            const int nprev = dir ? 3 - seg : seg;
#pragma unroll
            for (int s = 0; s < 3; ++s) if (s < nprev) { const int sg = dir ? 3 - s : s; hs = sx[(sg * 2) * 128 + sc] * hs + sx[(sg * 2 + 1) * 128 + sc]; }
            u16* YIN = (u16*)(ws + WS_YIN);
            if (dir == 0) {
#pragma unroll
                for (int s = 0; s < 16; ++s) { const int j = seg * 16 + s; hs = sa[j * SR + sc] * hs + sbt[j * SR + sc]; hfw[s] = hs; }
            } else {
#pragma unroll
                for (int s = 0; s < 16; ++s) {
                    const int js = 15 - s, j = seg * 16 + js;
                    hs = sa[j * SR + sc] * hs + sbt[j * SR + sc];
                    const int row = lru_row(b, ci, j);
                    const float gr = bf2f(grv[js]);
                    const float th = 1.f - 2.f * frcp_(1.f + __expf(1.5957691216057308f * (gr + 0.044715f * gr * gr * gr)));
                    const float ge = 0.5f * gr * (1.f + th);
                    YIN[(size_t)row * D + 1024 + chg_s] = f2bf((hfw[js] + hs) * ge);
                }
            }
        }
    }
}

__device__ void lru_prep_weights(const Params& p) {
    unsigned char* const ws = ws_();
    const int t = tid_();
    u16* WT = (u16*)(ws + WS_LRUW);
    for (int m = bid_(); m < 32; m += gdim_()) {
        const float* Wg = p.lru_gate_w + (size_t)m * 128 * 128;
        const int j4 = (t & 31) * 4, i8 = (t >> 5) * 8;
        f32x4 r8[8];
#pragma unroll
        for (int q = 0; q < 8; ++q) r8[q] = *reinterpret_cast<const f32x4*>(Wg + (size_t)(i8 + q) * 128 + j4);
#pragma unroll
        for (int jj = 0; jj < 4; ++jj) {
            u32x4 v = {pk_bf16(r8[0][jj], r8[1][jj]), pk_bf16(r8[2][jj], r8[3][jj]), pk_bf16(r8[4][jj], r8[5][jj]), pk_bf16(r8[6][jj], r8[7][jj])};
            *reinterpret_cast<u32x4*>(WT + ((size_t)m * 128 + j4 + jj) * 128 + i8) = v;
        }
    }
}
__device__ void lru_carry(const Params& p, int item) {
    unsigned char* const ws = ws_();
    const int idx = item * NT + tid_();
    const int c = idx & 1023, b = (idx >> 10) & 3, dir = idx >> 12;
    float* SA = (float*)(ws + WS_LRUS);
    float* SH = SA + 2 * 4 * 68 * 1024;
    const size_t base = ((size_t)(dir * 4 + b) * 68) * 1024 + c;
    float h = 0.f;
#pragma unroll 4
    for (int s = 0; s < 68; ++s) {
        const int cj = dir == 0 ? s : (s < 4 ? 3 - s : 71 - s);
        const float a = SA[base + (size_t)cj * 1024], hl = SH[base + (size_t)cj * 1024];
        SH[base + (size_t)cj * 1024] = h;
        h = a * h + hl;
    }
}

__device__ void gqa_item(const Params& p, int it, unsigned char* lds) {
    unsigned char* const ws = ws_();
    const int w = tid_() >> 6;
    const u16* P = (const u16*)(ws + WS_P);
    u16* YIN = (u16*)(ws + WS_YIN);
    const int t32 = it & 127, kvh = (it >> 7) & 3, b = it >> 9;
    const int hq = kvh * 4 + (w & 3), t0 = t32 * 32 + (w >> 2) * 16;
    const int kfirst = max((t32 * 32 - 128) & ~63, 0), klast = min(((t32 * 32 - 128) & ~63) + 256, SEQ - 64);
    const int nwin = (klast - kfirst) / 64 + 1;
    const int qrow = b * SEQ + t0;
    auto slabfn = [&](int i, const u16*& kp, const u16*& vp, size_t& kvs) {
        const int row = i < nwin ? b * SEQ + kfirst + i * 64 : NLAT + b * LC + (i - nwin) * 64;
        kp = P + (size_t)row * CD_IN + 1024 + kvh * 64; vp = P + (size_t)row * CD_IN + 1280 + kvh * 64; kvs = CD_IN; };
    auto subfn = [&](int i, int j, int& off) -> bool {
        off = 32 * j;
        if (i >= nwin) return true;
        const int k0 = kfirst + i * 64 + off;
        return k0 + 31 >= t0 - 128 && k0 <= t0 + 15 + 128; };
    auto biasfn = [&](int i, int off, int qi, int ki) -> float {
        if (i >= nwin) return 0.f;
        const int dq = (t0 + qi) - (kfirst + i * 64 + off + ki);
        return (dq > 128 || dq < -128) ? -INFINITY : 0.f; };
    const float sink = p.gqa_sink[hq];
    attn_block<64>(P + (size_t)qrow * CD_IN + hq * 64, CD_IN, nwin + 4, slabfn, subfn, biasfn, 0.125f, sink, ((tid_() & 63) >> 4) == 0 ? 1.f : 0.f, lds,
                   YIN + (size_t)qrow * D + hq * 64, D);
}

__device__ void phase_l1_stage1(const Params& p, unsigned char* lds) {
    for (int item = bid_(); item < 2176 + 2048; item += gdim_()) {
        if (item < 2176) { const int ci = item % 68, blk = (item / 68) & 7, b = item / (68 * 8); lru_chunk(p, b, blk, ci, 0, lds); }
        else rope_rows(p, (item - 2176) * 8, 8);
    }
}
__device__ void phase_l1_stage2(const Params& p, unsigned char* lds) {
    for (int item = bid_(); item < 16 + 2048; item += gdim_()) {
        if (item < 16) lru_carry(p, item);
        else gqa_item(p, item - 16, lds);
    }
}
__device__ void phase_l1_stage3(const Params& p, unsigned char* lds) {
    for (int item = bid_(); item < 2048; item += gdim_()) { const int cl = item & 63, blk = (item >> 6) & 7, b = item >> 9; lru_chunk(p, b, blk, cl + 4, 1, lds); }
}

__device__ void phase_rowpass_mid(const Params& p, int l, unsigned char* lds) {
    unsigned char* const ws = ws_();
    float* R = (float*)lds;
    const int t = tid_(), lane = t & 63, w = t >> 6;
    const int nrows = l == 0 ? NTOK : NLAT;
    __syncthreads();
    constexpr int RS = D + 4;
    for (int i = t; i < D * NEXP; i += NT) { const int k = i >> 4, e = i & 15; R[e * RS + k] = p.moe_router[(size_t)l * D * NEXP + i]; }
    __syncthreads();
    const u16* Y = (const u16*)(ws + WS_Y);
    float* XL1 = (float*)(ws + WS_XL1);
    u16* H = (u16*)(ws + WS_H);
    float* AFF = (float*)(ws + WS_AFF);
    for (int row = bid_() * 8 + w; row < nrows; row += gdim_() * 8) {
        f32x4 v[8]; float ss = 0.f;
#pragma unroll
        for (int i = 0; i < 8; ++i) { const u32x2 q = *reinterpret_cast<const u32x2*>(Y + (size_t)row * D + (i * 64 + lane) * 4); v[i] = (f32x4){bf_lo(q[0]), bf_hi(q[0]), bf_lo(q[1]), bf_hi(q[1])}; ss += v[i][0] * v[i][0] + v[i][1] * v[i][1] + v[i][2] * v[i][2] + v[i][3] * v[i][3]; }
        ss = wave_sum(ss);
        const float rstd = rsqrtf(ss * (1.f / D) + 1e-6f);
        const float* xr = xin_row(p, ws, l, row);
        const float* g1 = mod_ptr(ws, l, row, 2);
        const float* nw = p.norm_mix_post + (size_t)l * D;
        float ss1 = 0.f;
#pragma unroll
        for (int i = 0; i < 8; ++i) {
            const int col = (i * 64 + lane) * 4;
            const f32x4 x4 = *reinterpret_cast<const f32x4*>(xr + col), w4 = *reinterpret_cast<const f32x4*>(nw + col), g4 = *reinterpret_cast<const f32x4*>(g1 + col);
            const f32x4 x1 = x4 + g4 * (v[i] * rstd * w4);
            *reinterpret_cast<f32x4*>(XL1 + (size_t)row * D + col) = x1;
            v[i] = x1; ss1 += x1[0] * x1[0] + x1[1] * x1[1] + x1[2] * x1[2] + x1[3] * x1[3];
        }
        ss1 = wave_sum(ss1);
        const float rstd1 = rsqrtf(ss1 * (1.f / D) + 1e-6f);
        const float* sh = mod_ptr(ws, l, row, 3); const float* sc = mod_ptr(ws, l, row, 4);
        const float* nw2 = p.norm_ffn_pre + (size_t)l * D;
#pragma unroll
        for (int i = 0; i < 8; ++i) {
            const int col = (i * 64 + lane) * 4;
            const f32x4 w4 = *reinterpret_cast<const f32x4*>(nw2 + col), s4 = *reinterpret_cast<const f32x4*>(sc + col), h4 = *reinterpret_cast<const f32x4*>(sh + col);
            const f32x4 o = v[i] * rstd1 * w4 * (s4 + 1.f) + h4;
            *reinterpret_cast<unsigned*>((unsigned char*)H + (size_t)row * D + col) = pk_fp8x4(o[0] * F8_SH, o[1] * F8_SH, o[2] * F8_SH, o[3] * F8_SH);
            v[i] = o;
        }
        float lg[16];
#pragma unroll
        for (int e = 0; e < 16; ++e) lg[e] = 0.f;
#pragma unroll
        for (int i = 0; i < 8; ++i) {
#pragma unroll
            for (int e = 0; e < 16; ++e) { const f32x4 r4 = *reinterpret_cast<const f32x4*>(R + e * RS + (i * 64 + lane) * 4); lg[e] += v[i][0] * r4[0] + v[i][1] * r4[1] + v[i][2] * r4[2] + v[i][3] * r4[3]; }
        }
        const bool b5 = lane & 32, b4 = lane & 16, b3 = lane & 8, b2 = lane & 4;
        float t8[8], t4[4], t2[2], lgt;
#pragma unroll
        for (int j = 0; j < 8; ++j) { const float keep = b5 ? lg[8 + j] : lg[j], send = b5 ? lg[j] : lg[8 + j]; t8[j] = keep + partner_x32(send); }
#pragma unroll
        for (int j = 0; j < 4; ++j) { const float keep = b4 ? t8[4 + j] : t8[j], send = b4 ? t8[j] : t8[4 + j]; t4[j] = keep + partner_x16(send); }
#pragma unroll
        for (int j = 0; j < 2; ++j) { const float keep = b3 ? t4[2 + j] : t4[j], send = b3 ? t4[j] : t4[2 + j]; t2[j] = keep + dpp_f<0x140>(send); }
        { const float keep = b2 ? t2[1] : t2[0], send = b2 ? t2[0] : t2[1]; lgt = keep + dpp_f<0x141>(send); }
        lgt += dpp_f<0x4E>(lgt); lgt += dpp_f<0xB1>(lgt);
        const float mx = wave_max(lgt);
        const float pe = __expf(lgt - mx);
        const float den = wave_sum(pe) * 0.25f;
        if ((lane & 3) == 0) AFF[(size_t)row * 16 + ((b5 ? 8 : 0) + (b4 ? 4 : 0) + (b3 ? 2 : 0) + (b2 ? 1 : 0))] = pe / den;
    }
}

__device__ void phase_topk(const Params& p, int l, unsigned char* lds) {
    unsigned char* const ws = ws_();
    unsigned* keys = (unsigned*)lds;
    unsigned* hist = keys + 4096;
    unsigned* misc = hist + 256;
    const int t = tid_(), lane = t & 63, w = t >> 6;
    const float* AFF = (const float*)(ws + WS_AFF);
    int* SLOT = (int*)(ws + WS_SLOT);
    int* EROW = (int*)(ws + WS_EROW);
    float* EGATE = (float*)(ws + WS_EGATE);
    const int nitems = l == 0 ? 128 : 64;
    for (int item = bid_(); item < nitems; item += gdim_()) {
        const int kind = item >> 6, b = (item >> 4) & 3, ex = item & 15;
        const int n = kind ? LC : SEQ, cap = n / 8, rowbase = kind ? NLAT + b * LC : b * SEQ;
        __syncthreads();
        for (int i = t; i < n; i += NT) keys[i] = __float_as_uint(AFF[(size_t)(rowbase + i) * 16 + ex]);
        unsigned prefix = 0u, mask = 0u; int kth = cap;
        for (int shift = 24; shift >= 0; shift -= 8) {
            __syncthreads();
            if (t < 256) hist[t] = 0u;
            __syncthreads();
            for (int i = t; i < n; i += NT) { const unsigned k = keys[i]; if ((k & mask) == prefix) atomicAdd(&hist[(k >> shift) & 255u], 1u); }
            __syncthreads();
            if (t < 256) {
                unsigned above = 0u;
                for (int d2 = t + 1; d2 < 256; ++d2) above += hist[d2];
                const unsigned here = hist[t];
                if ((int)above < kth && (int)(above + here) >= kth) { misc[0] = (unsigned)t; misc[1] = (unsigned)(kth - (int)above); }
            }
            __syncthreads();
            prefix |= misc[0] << shift; mask |= 255u << shift; kth = (int)misc[1];
        }
        const unsigned T = prefix; const int need_eq = kth;
        int cgt = 0, ceq = 0;
        const int base = t * 8;
        if (base < n) {
#pragma unroll
            for (int q = 0; q < 8; ++q) { const unsigned k = keys[base + q]; cgt += (k > T); ceq += (k == T); }
        }
        int packed = cgt | (ceq << 16);
        int incl = packed;
#pragma unroll
        for (int o = 1; o < 64; o <<= 1) { const int nb = __shfl_up(incl, o, 64); if (lane >= o) incl += nb; }
        __syncthreads();
        if (lane == 63) misc[8 + w] = (unsigned)incl;
        __syncthreads();
        int woff = 0, total = 0;
#pragma unroll
        for (int q = 0; q < 8; ++q) { const int v = (int)misc[8 + q]; if (q < w) woff += v; total += v; }
        const int excl = woff + incl - packed;
        int pgt = excl & 0xffff, peq = excl >> 16;
        const int tot_gt = total & 0xffff;
        const int sbase = kind ? 2048 + b * 32 : b * 512;
        if (base < n) {
#pragma unroll
            for (int q = 0; q < 8; ++q) {
                const unsigned k = keys[base + q];
                const int row = rowbase + base + q;
                int pos = -1;
                if (k > T) { pos = pgt; ++pgt; }
                else if (k == T) { if (peq < need_eq) pos = tot_gt + peq; ++peq; }
                if (pos >= 0) { const int sl = sbase + pos; EROW[ex * EPAD + sl] = row; EGATE[ex * EPAD + sl] = __uint_as_float(k); SLOT[(size_t)row * 16 + ex] = sl; }
                else SLOT[(size_t)row * 16 + ex] = -1;
            }
        }
        if (kind == 1 && b == 3) for (int i = t; i < EPAD - 2176; i += NT) EROW[ex * EPAD + 2176 + i] = rowbase;
    }
}

__device__ void phase_final(const Params& p, int l) {
    unsigned char* const ws = ws_();
    const int lane = tid_() & 63, w = __builtin_amdgcn_readfirstlane(tid_() >> 6);
    const int nrows = l == 0 ? NTOK : NLAT;
    const u16* YEXP = (const u16*)(ws + WS_YEXP);
    const int* SLOT = (const int*)(ws + WS_SLOT);
    const float* XL1 = (const float*)(ws + WS_XL1);
    float* XL2 = (float*)(ws + WS_XL2);
    u16* H = (u16*)(ws + WS_H);
    const int stride = gdim_() * 8;
    struct Pre { f32x4 xl[8]; u32x2 q0[8], q1[8]; };
    auto slots_of = [&](int row) -> int { const int s = SLOT[(size_t)min(row, nrows - 1) * 16 + (lane & 15)]; return (row < nrows && lane < 16) ? s : -1; };
    auto prefetch = [&](int row, int myslot, Pre& pr) {
        const int rc = min(row, nrows - 1);
        unsigned long long em = __ballot(myslot >= 0);
        const int e0 = em ? __builtin_ctzll(em) : 0; em &= em - 1;
        const int e1 = em ? __builtin_ctzll(em) : e0;
        const int sl0 = max(__shfl(myslot, e0, 64), 0), sl1 = max(__shfl(myslot, e1, 64), 0);
        const u16* y0 = YEXP + ((size_t)e0 * EPAD + sl0) * D; const u16* y1 = YEXP + ((size_t)e1 * EPAD + sl1) * D;
#pragma unroll
        for (int i = 0; i < 8; ++i) pr.xl[i] = *reinterpret_cast<const f32x4*>(XL1 + (size_t)rc * D + (i * 64 + lane) * 4);
#pragma unroll
        for (int i = 0; i < 8; ++i) { pr.q0[i] = *reinterpret_cast<const u32x2*>(y0 + (i * 64 + lane) * 4); pr.q1[i] = *reinterpret_cast<const u32x2*>(y1 + (i * 64 + lane) * 4); }
    };
    int row = bid_() * 8 + w;
    int slot_c = slots_of(row), slot_n = slots_of(row + stride);
    Pre cur; prefetch(row, slot_c, cur);
    for (; row < nrows; row += stride) {
        const int slot_nn = slots_of(row + 2 * stride);
        Pre nxt; prefetch(row + stride, slot_n, nxt);
        f32x4 v[8];
#pragma unroll
        for (int i = 0; i < 8; ++i) v[i] = (f32x4){0.f, 0.f, 0.f, 0.f};
        unsigned long long em = __ballot(slot_c >= 0);
        if (em) {
            em &= em - 1;
            const float f1 = em ? 1.f : 0.f;
            if (em) em &= em - 1;
#pragma unroll
            for (int i = 0; i < 8; ++i) {
                v[i][0] = bf_lo(cur.q0[i][0]) + f1 * bf_lo(cur.q1[i][0]); v[i][1] = bf_hi(cur.q0[i][0]) + f1 * bf_hi(cur.q1[i][0]);
                v[i][2] = bf_lo(cur.q0[i][1]) + f1 * bf_lo(cur.q1[i][1]); v[i][3] = bf_hi(cur.q0[i][1]) + f1 * bf_hi(cur.q1[i][1]);
            }
        }
        while (em) {
            const int e0 = __builtin_ctzll(em); em &= em - 1;
            const int sl0 = __shfl(slot_c, e0, 64);
            const u16* y0 = YEXP + ((size_t)e0 * EPAD + sl0) * D;
#pragma unroll
            for (int i = 0; i < 8; ++i) { const u32x2 q = *reinterpret_cast<const u32x2*>(y0 + (i * 64 + lane) * 4); v[i][0] += bf_lo(q[0]); v[i][1] += bf_hi(q[0]); v[i][2] += bf_lo(q[1]); v[i][3] += bf_hi(q[1]); }
        }
        float ss = 0.f;
#pragma unroll
        for (int i = 0; i < 8; ++i) ss += v[i][0] * v[i][0] + v[i][1] * v[i][1] + v[i][2] * v[i][2] + v[i][3] * v[i][3];
        ss = wave_sum(ss);
        const float rstd = rsqrtf(ss * (1.f / D) + 1e-6f);
        const float* g2 = mod_ptr(ws, l, row, 5);
        const float* nw = p.norm_ffn_post + (size_t)l * D;
        float* dst = l == 0 ? XL2 + (size_t)row * D : p.out + (size_t)row * D;
        float ss2 = 0.f;
#pragma unroll
        for (int i = 0; i < 8; ++i) {
            const int col = (i * 64 + lane) * 4;
            const f32x4 x4 = cur.xl[i], w4 = *reinterpret_cast<const f32x4*>(nw + col), g4 = *reinterpret_cast<const f32x4*>(g2 + col);
            const f32x4 x2 = x4 + g4 * (v[i] * rstd * w4);
            *reinterpret_cast<f32x4*>(dst + col) = x2;
            v[i] = x2; ss2 += x2[0] * x2[0] + x2[1] * x2[1] + x2[2] * x2[2] + x2[3] * x2[3];
        }
        if (l == 0) {
            ss2 = wave_sum(ss2);
            const float rstd2 = rsqrtf(ss2 * (1.f / D) + 1e-6f);
            const float* sh = mod_ptr(ws, 1, row, 0); const float* sc = mod_ptr(ws, 1, row, 1);
            const float* nw1 = p.norm_mix_pre + D;
#pragma unroll
            for (int i = 0; i < 8; ++i) {
                const int col = (i * 64 + lane) * 4;
                const f32x4 w4 = *reinterpret_cast<const f32x4*>(nw1 + col), s4 = *reinterpret_cast<const f32x4*>(sc + col), h4 = *reinterpret_cast<const f32x4*>(sh + col);
                const f32x4 o = v[i] * rstd2 * w4 * (s4 + 1.f) + h4;
                u32x2 pk = {pk_bf16(o[0], o[1]), pk_bf16(o[2], o[3])};
                *reinterpret_cast<u32x2*>(H + (size_t)row * D + col) = pk;
            }
        }
        cur = nxt; slot_c = slot_n; slot_n = slot_nn;
    }
}

__global__ void __launch_bounds__(NT, 2) fwd_kernel(Params p) {
    unsigned char* lds = g_lds;
    unsigned char* wlds = lds + 512;
    if (threadIdx.x == 0) { *reinterpret_cast<uint4*>(lds) = make_uint4(0u, 0u, 0u, 0u); ((volatile LAS int*)(g_lds))[4] = (int)blockIdx.x; ((volatile LAS int*)(g_lds))[5] = (int)gridDim.x; *(volatile LAS unsigned long long*)((LAS unsigned char*)(g_lds) + 24) = (unsigned long long)p.ws; }
    if ((threadIdx.x & 63) == 0) ((volatile LAS int*)(g_lds))[8 + hw_slot_()] = threadIdx.x >> 6;
    __syncthreads();
    (void)xcd_barrier_post((unsigned*)(ws_() + WS_BAR), (volatile LAS unsigned*)lds);
#define GRID_BARRIER() do { XcdBarrier _b; _b.bar = (unsigned*)(ws_() + WS_BAR); _b.x = xb_xcc_id(); _b.st = (volatile LAS unsigned*)lds; xcd_barrier(_b); } while (0)
#ifndef PH_MASK
#define PH_MASK 0xFFFFFFFFu
#endif
#ifndef PROBE_REP_MASK
#define PROBE_REP_MASK 0u
#endif
#define PHASE(id, body) do { if (((PH_MASK >> ((id) % 32)) & 1u) && p.ph_lo <= (id) && (id) < p.ph_hi) { \
    for (int _r = 0; _r < ((((unsigned)PROBE_REP_MASK >> ((id) % 32)) & 1u) ? 2 : 1); ++_r) { body; if ((id) + 1 < p.ph_hi || _r == 0) { if ((id) + 1 < p.ph_hi) GRID_BARRIER(); } } } } while (0)
    PHASE(0, { phase_mod(p, wlds); phase_convert_dense(p, wlds); });
    PHASE(1, { phase_norm_mod(p, 0); lru_prep_weights(p); });
#pragma unroll
    for (int l = 0; l < 2; ++l) {
        const int pb = 2 + 10 * l;
        PHASE(pb + 0, phase_gemm_dense(p, (const u16*)(ws_() + WS_H), NTOK, (const u16*)(ws_() + (l == 0 ? WS_WT_ABIN : WS_WT_CDIN)), l == 0 ? AB_IN : CD_IN,
                                       (u16*)(ws_() + WS_P), l == 0 ? AB_IN : CD_IN, l == 0 ? (float*)(ws_() + WS_G) : nullptr, wlds));
        if (l == 0) {
            PHASE(pb + 1, phase_mlstm(p, wlds));
            PHASE(pb + 2, phase_l0_stage2(p, wlds));
        } else {
            PHASE(pb + 1, phase_l1_stage1(p, wlds));
            PHASE(pb + 2, phase_l1_stage2(p, wlds));
            PHASE(pb + 3, phase_l1_stage3(p, wlds));
        }
        PHASE(pb + 4, phase_gemm_dense(p, (const u16*)(ws_() + WS_YIN), l == 0 ? NTOK : NLAT, (const u16*)(ws_() + (l == 0 ? WS_WT_ABOUT : WS_WT_CDOUT)), D,
                                       (u16*)(ws_() + WS_Y), D, nullptr, wlds));
        PHASE(pb + 5, phase_rowpass_mid(p, l, wlds));
        PHASE(pb + 6, { phase_topk(p, l, wlds); phase_convert_moe(p, l, wlds); });
        PHASE(pb + 7, phase_moe_a(p, l, wlds));
        PHASE(pb + 8, phase_moe_b(p, l, wlds));
        PHASE(pb + 9, phase_final(p, l));
    }
}


#ifdef DBG_STOP
__global__ void dbg_digest(const unsigned char* ws, size_t off, int kind, size_t nelem, float* out, size_t nout) {
    for (size_t i = (size_t)blockIdx.x * blockDim.x + threadIdx.x; i < nout; i += (size_t)gridDim.x * blockDim.x) {
        float v = 0.f;
        for (size_t j = i; j < nelem; j += nout) {
            if (kind == 0) v += bf2f(((const u16*)(ws + off))[j]);
            else if (kind == 1) v += ((const float*)(ws + off))[j];
            else v += (float)((const int*)(ws + off))[j];
        }
        out[i] = v;
    }
}
#endif
extern "C" void kernel_launch(void* const* d_in, const int* in_sizes, int n_in, void* d_out, int out_size, void* d_ws, size_t ws_size, hipStream_t stream) {
    static int grid = 0;
    if (grid == 0) {
        if (n_in != 27 || ws_size < WS_END) { fprintf(stderr, "kernel_launch: unexpected n_in %d / ws %zu (need %zu)\n", n_in, ws_size, (size_t)WS_END); grid = -1; return; }
        int dev = 0, cus = 0, per_cu = 0;
        hipGetDevice(&dev);
        hipDeviceGetAttribute(&cus, hipDeviceAttributeMultiprocessorCount, dev);
        if (hipFuncSetAttribute((const void*)fwd_kernel, hipFuncAttributeMaxDynamicSharedMemorySize, LDS_BYTES) != hipSuccess) { fprintf(stderr, "kernel_launch: hipFuncSetAttribute failed\n"); grid = -1; return; }
        hipOccupancyMaxActiveBlocksPerMultiprocessor(&per_cu, (const void*)fwd_kernel, NT, LDS_BYTES);
        (void)hipGetLastError();
        if (per_cu < 1) fprintf(stderr, "kernel_launch: occupancy query reports %d blocks per CU\n", per_cu);
        grid = cus > 0 ? cus : 256;
    }
    if (grid < 0) return;
    hipMemsetAsync((char*)d_ws + WS_BAR, 0, XCD_BAR_WORDS * sizeof(unsigned), stream);
    Params p; memset(&p, 0, sizeof(p));
    const float** f = (const float**)&p;
    for (int i = 0; i < 27; ++i) f[i] = (const float*)d_in[i];
    p.out = (float*)d_out; p.ws = (unsigned char*)d_ws;
#if N_LAUNCH_MODE == 1
    p.ph_lo = 0; p.ph_hi = NPH;
    hipLaunchKernelGGL(fwd_kernel, dim3(grid), dim3(NT), LDS_BYTES, stream, p);
#else
#ifdef DBG_STOP
    for (int ph = 0; ph <= DBG_STOP; ++ph) { p.ph_lo = ph; p.ph_hi = ph + 1; hipLaunchKernelGGL(fwd_kernel, dim3(grid), dim3(NT), LDS_BYTES, stream, p); }
    hipLaunchKernelGGL(dbg_digest, dim3(2048), dim3(256), 0, stream, (const unsigned char*)d_ws, (size_t)DBG_OFF, (int)DBG_KIND, (size_t)DBG_NELEM, (float*)d_out, (size_t)out_size);
#else
    for (int ph = 0; ph < NPH; ++ph) { p.ph_lo = ph; p.ph_hi = ph + 1; hipLaunchKernelGGL(fwd_kernel, dim3(grid), dim3(NT), LDS_BYTES, stream, p); }
#endif
#endif
}
```

```cpp
#include <hip/hip_runtime.h>
#include <stdint.h>
#include <stdio.h>
#include <string.h>

#ifndef N_LAUNCH_MODE
#define N_LAUNCH_MODE 1
#endif

typedef unsigned short u16;
typedef short bf16x8 __attribute__((ext_vector_type(8)));
typedef float f32x4 __attribute__((ext_vector_type(4)));
typedef unsigned u32x4 __attribute__((ext_vector_type(4)));
typedef unsigned u32x2 __attribute__((ext_vector_type(2)));

#define NT 512
constexpr int D = 2048, BATCH = 4, SEQ = 4096, LC = 256;
constexpr int NLAT = BATCH * SEQ, NCTX = BATCH * LC, NTOK = NLAT + NCTX;
constexpr int AB_IN = 7184, CD_IN = 3584;
constexpr int NEXP = 16, FF = 2048, EPAD = 2304;
constexpr int NPH = 22;
constexpr int LDS_BYTES = 150 * 1024;

constexpr size_t al256(size_t x) { return (x + 255) & ~(size_t)255; }
constexpr size_t WS_BAR = 0;
constexpr size_t WS_MOD = 16384;
constexpr size_t WS_XL1 = al256(WS_MOD + 2 * 5 * 12288 * 4);
constexpr size_t WS_XL2 = al256(WS_XL1 + (size_t)NTOK * D * 4);
constexpr size_t WS_H = al256(WS_XL2 + (size_t)NTOK * D * 4);
constexpr size_t WS_P = al256(WS_H + (size_t)NTOK * D * 2);
constexpr size_t WS_G = al256(WS_P + (size_t)NTOK * AB_IN * 2);
constexpr size_t WS_HM = al256(WS_G + (size_t)NTOK * 16 * 4);
constexpr size_t WS_YIN = al256(WS_HM + (size_t)2 * NTOK * 1024 * 2);
constexpr size_t WS_Y = al256(WS_YIN + (size_t)NTOK * D * 2);
constexpr size_t WS_AFF = al256(WS_Y + (size_t)NTOK * D * 4);
constexpr size_t WS_SLOT = al256(WS_AFF + (size_t)NTOK * 16 * 4);
constexpr size_t WS_EROW = al256(WS_SLOT + (size_t)NTOK * 16 * 4);
constexpr size_t WS_EGATE = al256(WS_EROW + (size_t)NEXP * EPAD * 4);
constexpr size_t WS_ACT = al256(WS_EGATE + (size_t)NEXP * EPAD * 4);
constexpr size_t WS_YEXP = al256(WS_ACT + (size_t)NEXP * EPAD * FF * 2);
constexpr size_t WS_LRUS = al256(WS_YEXP + (size_t)NEXP * EPAD * D * 2);
constexpr size_t WS_LRUW = al256(WS_LRUS + (size_t)2 * 2 * 4 * 68 * 1024 * 4);
constexpr size_t WS_WT_ABIN = al256(WS_LRUW + (size_t)32 * 128 * 128 * 2);
constexpr size_t WS_WT_ABOUT = al256(WS_WT_ABIN + (size_t)AB_IN * D * 2);
constexpr size_t WS_WT_CDIN = al256(WS_WT_ABOUT + (size_t)D * D * 2);
constexpr size_t WS_WT_CDOUT = al256(WS_WT_CDIN + (size_t)CD_IN * D * 2);
constexpr size_t WS_WT_W1 = al256(WS_WT_CDOUT + (size_t)D * D * 2);
constexpr size_t WS_WT_W3 = al256(WS_WT_W1 + (size_t)NEXP * D * FF * 2);
constexpr size_t WS_WT_W2 = al256(WS_WT_W3 + (size_t)NEXP * D * FF * 2);
constexpr size_t WS_END = al256(WS_WT_W2 + (size_t)NEXP * D * FF * 2);

extern __shared__ __attribute__((aligned(16))) unsigned char g_lds[];

struct Params {
    const float *x, *c, *ctx, *c_ctx, *ada_w, *ada_b, *norm_mix_pre, *norm_mix_post, *norm_ffn_pre, *norm_ffn_post;
    const float *ab_w_in, *ab_w_out, *mlstm_gate_b, *mlstm_norm, *na_rpb;
    const float *cd_w_in, *cd_w_out, *gqa_sink, *lru_conv_w, *lru_conv_b, *lru_gate_w, *lru_gate_b, *lru_lambda;
    const float *moe_router, *moe_w1, *moe_w3, *moe_w2;
    float* out;
    unsigned char* ws;
    int ph_lo, ph_hi;
};

#define XB_TMO      128
#define XB_XCNT(j)  (256  + 64 * (j))
#define XB_XSUB(j)  (1280 + 64 * (j))
#define XB_XGEN(j)  (2304 + 64 * (j))
#define XB_TOP      3328
#define XB_TOPGEN   3392
#define XCD_BAR_WORDS 3456
#define XB_SPIN_CAP (1u << 22)
#define LAS __attribute__((address_space(3)))

__device__ __forceinline__ unsigned xb_ld(unsigned* p)              { return __hip_atomic_load(p, __ATOMIC_RELAXED, __HIP_MEMORY_SCOPE_AGENT); }
__device__ __forceinline__ unsigned xb_add(unsigned* p, unsigned v) { return __hip_atomic_fetch_add(p, v, __ATOMIC_RELAXED, __HIP_MEMORY_SCOPE_AGENT); }
__device__ __forceinline__ unsigned xb_xcc_id() { return (unsigned)__builtin_amdgcn_s_getreg((3 << 11) | 20) & 0xFu; }
#define XB_SPIN(cond, bar) do { unsigned _sp = 0; while (cond) { __builtin_amdgcn_s_sleep(1); \
    if ((++_sp & 255u) == 0u) { if (xb_ld(&(bar)[XB_TMO])) break; if (_sp > XB_SPIN_CAP) { atomicAdd(&(bar)[XB_TMO], 1u); break; } } } } while (0)

struct XcdBarrier {
    unsigned* bar; unsigned x;
    volatile LAS unsigned* st;
};
__device__ __forceinline__ XcdBarrier xcd_barrier_post(unsigned* bar, volatile LAS unsigned* st) {
    XcdBarrier b; b.bar = bar; b.x = xb_xcc_id(); b.st = st;
    if (threadIdx.x == 0) (void)xb_add(&bar[XB_XCNT(b.x)], 1u);
    return b;
}
__device__ __forceinline__ void xcd_barrier_complete(unsigned* bar, unsigned x, unsigned& nloc, unsigned& nx) {
    const unsigned G = gridDim.x * gridDim.y * gridDim.z;
    unsigned sum, cnt, mine, sp = 0u;
    for (;;) {
        sum = 0u; cnt = 0u; mine = 0u;
#pragma unroll
        for (unsigned j = 0; j < 16; ++j) { const unsigned c = xb_ld(&bar[XB_XCNT(j)]); sum += c; cnt += (c > 0u) ? 1u : 0u; mine = (j == x) ? c : mine; }
        if (sum == G) break;
        __builtin_amdgcn_s_sleep(1);
        if ((++sp & 255u) == 0u) { if (xb_ld(&bar[XB_TMO])) break; if (sp > XB_SPIN_CAP) { atomicAdd(&bar[XB_TMO], 1u); break; } }
    }
    nloc = mine > 0u ? mine : 1u; nx = cnt > 0u ? cnt : 1u;
}
__device__ __forceinline__ void xcd_barrier(const XcdBarrier& b) {
    asm volatile("s_waitcnt vmcnt(0)" ::: "memory");
    __syncthreads();
    if (threadIdx.x == 0) {
        unsigned* bar = b.bar;
        __builtin_amdgcn_s_waitcnt(0);
        unsigned nloc = b.st[0], nx = b.st[1];
        if (nloc == 0u) { xcd_barrier_complete(bar, b.x, nloc, nx); b.st[0] = nloc; b.st[1] = nx; }
        const unsigned old = xb_add(&bar[XB_XSUB(b.x)], 1u);
        const unsigned gen = old / nloc;
        if (old + 1u == (gen + 1u) * nloc) {
            __builtin_amdgcn_fence(__ATOMIC_RELEASE, "agent");
            asm volatile("s_waitcnt vmcnt(0)" ::: "memory");
            const unsigned og = xb_add(&bar[XB_TOP], 1u);
            const unsigned tg = og / nx;
            if (og + 1u == (tg + 1u) * nx) xb_add(&bar[XB_TOPGEN], 1u);
            else XB_SPIN(xb_ld(&bar[XB_TOPGEN]) == tg, bar);
            __builtin_amdgcn_fence(__ATOMIC_ACQUIRE, "agent");
            xb_add(&bar[XB_XGEN(b.x)], 1u);
            asm volatile("s_waitcnt vmcnt(0)" ::: "memory");
        } else {
            XB_SPIN(xb_ld(&bar[XB_XGEN(b.x)]) == gen, bar);
            __builtin_amdgcn_fence(__ATOMIC_ACQUIRE, "agent");
            asm volatile("s_waitcnt vmcnt(0)" ::: "memory");
        }
    }
    __syncthreads();
}

typedef float f32x2_t __attribute__((ext_vector_type(2)));
typedef __bf16 bf16x2_t __attribute__((ext_vector_type(2)));
__device__ __forceinline__ unsigned pk_bf16(float lo, float hi) { f32x2_t v = {lo, hi}; return __builtin_bit_cast(unsigned, __builtin_convertvector(v, bf16x2_t)); }
__device__ __forceinline__ float bf_lo(unsigned u) { return __uint_as_float(u << 16); }
__device__ __forceinline__ float bf_hi(unsigned u) { return __uint_as_float(u & 0xffff0000u); }
__device__ __forceinline__ float bf2f(u16 v) { return __uint_as_float(((unsigned)v) << 16); }
typedef int i32x4 __attribute__((ext_vector_type(4)));
typedef int i32x8 __attribute__((ext_vector_type(8)));
constexpr float F8_SW = 256.f, F8_SH = 8.f, F8_SA = 4.f;
__device__ __forceinline__ float f8_clamp(float x) { return __builtin_amdgcn_fmed3f(x, -448.f, 448.f); }
__device__ __forceinline__ unsigned pk_fp8x4(float a, float b, float c, float d) {
    unsigned r = 0u;
    r = (unsigned)__builtin_amdgcn_cvt_pk_fp8_f32(f8_clamp(a), f8_clamp(b), (int)r, false);
    r = (unsigned)__builtin_amdgcn_cvt_pk_fp8_f32(f8_clamp(c), f8_clamp(d), (int)r, true);
    return r; }
__device__ __forceinline__ i32x8 cat8(bf16x8 lo, bf16x8 hi) { return __builtin_shufflevector(__builtin_bit_cast(i32x4, lo), __builtin_bit_cast(i32x4, hi), 0, 1, 2, 3, 4, 5, 6, 7); }
__device__ __forceinline__ u16 f2bf(float f) { return (u16)(pk_bf16(f, 0.f) & 0xffffu); }
template <int CTRL> __device__ __forceinline__ float dpp_f(float v) { return __uint_as_float((unsigned)__builtin_amdgcn_update_dpp(0, (int)__float_as_uint(v), CTRL, 0xf, 0xf, true)); }
__device__ __forceinline__ float row_sum16(float v) { v += dpp_f<0xB1>(v); v += dpp_f<0x4E>(v); v += dpp_f<0x141>(v); v += dpp_f<0x140>(v); return v; }
__device__ __forceinline__ float row_max16(float v) { v = fmaxf(v, dpp_f<0xB1>(v)); v = fmaxf(v, dpp_f<0x4E>(v)); v = fmaxf(v, dpp_f<0x141>(v)); v = fmaxf(v, dpp_f<0x140>(v)); return v; }
__device__ __forceinline__ float rdlane_f(float v, int l) { return __uint_as_float((unsigned)__builtin_amdgcn_readlane((int)__float_as_uint(v), l)); }
__device__ __forceinline__ float sum_x16(float v) { const auto r = __builtin_amdgcn_permlane16_swap(__float_as_uint(v), __float_as_uint(v), false, false); return __uint_as_float(r[0]) + __uint_as_float(r[1]); }
__device__ __forceinline__ float sum_x32(float v) { const auto r = __builtin_amdgcn_permlane32_swap(__float_as_uint(v), __float_as_uint(v), false, false); return __uint_as_float(r[0]) + __uint_as_float(r[1]); }
__device__ __forceinline__ float max_x16(float v) { const auto r = __builtin_amdgcn_permlane16_swap(__float_as_uint(v), __float_as_uint(v), false, false); return fmaxf(__uint_as_float(r[0]), __uint_as_float(r[1])); }
__device__ __forceinline__ float max_x32(float v) { const auto r = __builtin_amdgcn_permlane32_swap(__float_as_uint(v), __float_as_uint(v), false, false); return fmaxf(__uint_as_float(r[0]), __uint_as_float(r[1])); }
__device__ __forceinline__ float partner_x16(float v) { const auto r = __builtin_amdgcn_permlane16_swap(__float_as_uint(v), __float_as_uint(v), false, false); return __uint_as_float(r[0] ^ r[1] ^ __float_as_uint(v)); }
__device__ __forceinline__ float partner_x32(float v) { const auto r = __builtin_amdgcn_permlane32_swap(__float_as_uint(v), __float_as_uint(v), false, false); return __uint_as_float(r[0] ^ r[1] ^ __float_as_uint(v)); }
__device__ __forceinline__ float wave_sum(float v) { return sum_x32(sum_x16(row_sum16(v))); }
__device__ __forceinline__ float wave_max(float v) { return max_x32(max_x16(row_max16(v))); }
__device__ __forceinline__ int hw_slot_() { return (int)(__builtin_amdgcn_s_getreg((5 << 11) | 4) & 63u); }
__device__ __forceinline__ int tid_() {
    int lane; asm volatile("v_mbcnt_lo_u32_b32 %0, -1, 0\n\tv_mbcnt_hi_u32_b32 %0, -1, %0" : "=v"(lane));
    const int w = ((volatile LAS int*)(g_lds))[8 + hw_slot_()];
    int t = __builtin_amdgcn_readfirstlane(w) * 64 + lane; asm volatile("" : "+v"(t)); return t; }
__device__ __forceinline__ int bid_() { unsigned o = 16; asm volatile("" : "+v"(o)); return __builtin_amdgcn_readfirstlane(*(const LAS int*)((LAS unsigned char*)(g_lds) + o)); }
__device__ __forceinline__ int gdim_() { unsigned o = 20; asm volatile("" : "+v"(o)); return __builtin_amdgcn_readfirstlane(*(const LAS int*)((LAS unsigned char*)(g_lds) + o)); }
__device__ __forceinline__ unsigned char* ws_() {
    unsigned o = 24; asm volatile("" : "+v"(o));
    const u32x2 v = *(const LAS u32x2*)((LAS unsigned char*)(g_lds) + o);
    const unsigned long long a = ((unsigned long long)(unsigned)__builtin_amdgcn_readfirstlane((int)v[1]) << 32) | (unsigned)__builtin_amdgcn_readfirstlane((int)v[0]);
    return (unsigned char*)(__attribute__((address_space(1))) unsigned char*)a; }
__device__ __forceinline__ float frcp_(float x) { return __builtin_amdgcn_rcpf(x); }
__device__ __forceinline__ float sigmoidf_(float x) { return frcp_(1.f + __expf(-x)); }
__device__ __forceinline__ f32x4 mfma16(bf16x8 a, bf16x8 b, f32x4 c) { return __builtin_amdgcn_mfma_f32_16x16x32_bf16(a, b, c, 0, 0, 0); }
__device__ __forceinline__ bf16x8 ld_frag_g(const u16* p) { return *reinterpret_cast<const bf16x8*>(p); }
__device__ __forceinline__ bf16x8 ld_frag_s(const u16* p) { return *reinterpret_cast<const bf16x8*>(p); }
__device__ __forceinline__ bf16x8 mk_frag(unsigned a, unsigned b, unsigned c, unsigned d) { u32x4 v = {a, b, c, d}; return __builtin_bit_cast(bf16x8, v); }

__device__ __forceinline__ const float* xin_row(const Params& p, int row) {
    return row < NLAT ? p.x + (size_t)row * D : p.ctx + (size_t)(row - NLAT) * D;
}
__device__ __forceinline__ const float* mod_ptr(const unsigned char* ws, int l, int row, int chunk) {
    const int bb = row < NLAT ? (row >> 12) : 4;
    return (const float*)(ws + WS_MOD) + ((size_t)(l * 5 + bb) * 6 + chunk) * D;
}

__device__ __forceinline__ void phase_mod(const Params& p, unsigned char* lds_raw) {
    unsigned char* const ws = ws_();
    float* scond = (float*)lds_raw;
    float* red = scond + 5 * D;
    const int t = tid_();
    for (int i = t; i < 5 * D; i += NT) { const int r = i >> 11, k = i & 2047; const float v = r < 4 ? p.c[r * D + k] : p.c_ctx[k]; scond[i] = v / (1.f + __expf(-v)); }
    __syncthreads();
    float* mod = (float*)(ws + WS_MOD);
    for (int item = bid_(); item < 192; item += gdim_()) {
        const int l = item / 96, col0 = (item % 96) * 128;
        const int kg = t >> 5, cl = (t & 31) * 4;
        f32x4 acc[5];
#pragma unroll
        for (int r = 0; r < 5; ++r) acc[r] = (f32x4){0.f, 0.f, 0.f, 0.f};
        const float* wp = p.ada_w + ((size_t)l * D + kg * 128) * (6 * D) + col0 + cl;
#pragma unroll 8
        for (int kk = 0; kk < 128; ++kk) {
            const f32x4 w = *reinterpret_cast<const f32x4*>(wp + (size_t)kk * (6 * D));
#pragma unroll
            for (int r = 0; r < 5; ++r) { const float s = scond[r * D + kg * 128 + kk]; acc[r] += w * s; }
        }
#pragma unroll
        for (int r = 0; r < 5; ++r) *reinterpret_cast<f32x4*>(red + (kg * 5 + r) * 128 + cl) = acc[r];
        __syncthreads();
        for (int o = t; o < 640; o += NT) {
            const int r = o >> 7, cc = o & 127;
            float s = p.ada_b[l * 6 * D + col0 + cc];
#pragma unroll
            for (int g = 0; g < 16; ++g) s += red[(g * 5 + r) * 128 + cc];
            mod[(size_t)(l * 5 + r) * 6 * D + col0 + cc] = s;
        }
        __syncthreads();
    }
}

__device__ __forceinline__ void phase_norm_mod(const Params& p, int l) {
    unsigned char* const ws = ws_();
    const int lane = tid_() & 63, w = tid_() >> 6;
    u16* H = (u16*)(ws + WS_H);
    for (int row = bid_() * 8 + w; row < NTOK; row += gdim_() * 8) {
        const float* xr = xin_row(p, row);
        f32x4 v[8]; float ss = 0.f;
#pragma unroll
        for (int i = 0; i < 8; ++i) { v[i] = *reinterpret_cast<const f32x4*>(xr + (i * 64 + lane) * 4); ss += v[i][0] * v[i][0] + v[i][1] * v[i][1] + v[i][2] * v[i][2] + v[i][3] * v[i][3]; }
        ss = wave_sum(ss);
        const float rstd = rsqrtf(ss * (1.f / D) + 1e-6f);
        const float* sh = mod_ptr(ws, l, row, 0); const float* sc = mod_ptr(ws, l, row, 1);
        const float* nw = p.norm_mix_pre + (size_t)l * D;
#pragma unroll
        for (int i = 0; i < 8; ++i) {
            const int col = (i * 64 + lane) * 4;
            const f32x4 w4 = *reinterpret_cast<const f32x4*>(nw + col), s4 = *reinterpret_cast<const f32x4*>(sc + col), h4 = *reinterpret_cast<const f32x4*>(sh + col);
            f32x4 o = v[i] * rstd * w4 * (s4 + 1.f) + h4;
            u32x2 pk = {pk_bf16(o[0], o[1]), pk_bf16(o[2], o[3])};
            *reinterpret_cast<u32x2*>(H + (size_t)row * D + col) = pk;
        }
    }
}

__device__ __forceinline__ void convert_item(const float* W, int N, u16* Wt, int kb, int nb, unsigned char* lds) {
    const int t = tid_(), lane = t & 63, w = t >> 6;
    const int n4 = lane * 4, k0 = kb * 64 + w * 8, n0 = nb * 256;
    int col = n0 + n4; if (col > N - 4) col = N - 4;
    f32x4 r8[8];
#pragma unroll
    for (int j = 0; j < 8; ++j) r8[j] = *reinterpret_cast<const f32x4*>(W + (size_t)(k0 + j) * N + col);
    __syncthreads();
#pragma unroll
    for (int jj = 0; jj < 4; ++jj) {
        u32x4 v = {pk_bf16(r8[0][jj], r8[1][jj]), pk_bf16(r8[2][jj], r8[3][jj]), pk_bf16(r8[4][jj], r8[5][jj]), pk_bf16(r8[6][jj], r8[7][jj])};
        const int r = n4 + jj;
        *reinterpret_cast<u32x4*>(lds + r * 128 + ((w ^ ((r >> 2) & 7)) << 4)) = v;
    }
    __syncthreads();
    const int c = t & 7;
#pragma unroll
    for (int i = 0; i < 4; ++i) {
        const int r = (t >> 3) + 64 * i;
        if (n0 + r < N) {
            const u32x4 v = *reinterpret_cast<const u32x4*>(lds + r * 128 + ((c ^ ((r >> 2) & 7)) << 4));
            *reinterpret_cast<u32x4*>(Wt + (size_t)(n0 + r) * 2048 + kb * 64 + c * 8) = v;
        }
    }
}
__device__ __forceinline__ void convert_item8(const float* W, unsigned char* Wt, int kb, int nb, unsigned char* lds) {
    const int t = tid_(), lane = t & 63, w = t >> 6;
    const int n4 = lane * 4, k0 = kb * 128 + w * 16, n0 = nb * 256;
    f32x4 r[16];
#pragma unroll
    for (int j = 0; j < 16; ++j) r[j] = *reinterpret_cast<const f32x4*>(W + (size_t)(k0 + j) * 2048 + n0 + n4);
    __syncthreads();
#pragma unroll
    for (int jj = 0; jj < 4; ++jj) {
        u32x4 v;
#pragma unroll
        for (int q = 0; q < 4; ++q) v[q] = pk_fp8x4(r[4 * q][jj] * F8_SW, r[4 * q + 1][jj] * F8_SW, r[4 * q + 2][jj] * F8_SW, r[4 * q + 3][jj] * F8_SW);
        const int rr = n4 + jj;
        *reinterpret_cast<u32x4*>(lds + rr * 128 + ((w ^ ((rr >> 2) & 7)) << 4)) = v;
    }
    __syncthreads();
    const int c = t & 7;
#pragma unroll
    for (int i = 0; i < 4; ++i) {
        const int rr = (t >> 3) + 64 * i;
        const u32x4 v = *reinterpret_cast<const u32x4*>(lds + rr * 128 + ((c ^ ((rr >> 2) & 7)) << 4));
        *reinterpret_cast<u32x4*>(Wt + (size_t)(n0 + rr) * 2048 + kb * 128 + c * 16) = v;
    }
}
__device__ __forceinline__ void convert_matrix_items(const float* W, int N, u16* Wt, int first, int count, unsigned char* lds) {
    const int nnb = (N + 255) / 256;
    for (int it = first; it < first + count; ++it) convert_item(W, N, Wt, it / nnb, it % nnb, lds);
}
__device__ __forceinline__ void phase_convert_dense(const Params& p, unsigned char* lds) {
    unsigned char* const ws = ws_();
    for (int item = bid_(); item < 1888; item += gdim_()) {
        if (item < 928) convert_item(p.ab_w_in, AB_IN, (u16*)(ws + WS_WT_ABIN), item / 29, item % 29, lds);
        else if (item < 1184) { const int it = item - 928; convert_item(p.ab_w_out, D, (u16*)(ws + WS_WT_ABOUT), it / 8, it % 8, lds); }
        else if (item < 1632) { const int it = item - 1184; convert_item(p.cd_w_in, CD_IN, (u16*)(ws + WS_WT_CDIN), it / 14, it % 14, lds); }
        else { const int it = item - 1632; convert_item(p.cd_w_out, D, (u16*)(ws + WS_WT_CDOUT), it / 8, it % 8, lds); }
    }
}
__device__ __forceinline__ void phase_convert_moe(const Params& p, int l, unsigned char* lds) {
    unsigned char* const ws = ws_();
    for (int item = bid_(); item < 3 * NEXP * 128; item += gdim_()) {
        const int which = item / (NEXP * 128), r = item % (NEXP * 128), ex = r >> 7, it = r & 127;
        const float* src = (which == 0 ? p.moe_w1 : (which == 1 ? p.moe_w3 : p.moe_w2)) + (size_t)(l * NEXP + ex) * D * FF;
        unsigned char* dst = ws + (which == 0 ? WS_WT_W1 : (which == 1 ? WS_WT_W3 : WS_WT_W2)) + (size_t)ex * D * FF;
        convert_item8(src, dst, it >> 3, it & 7, lds);
    }
}

__device__ __forceinline__ int g8_lds_byte(int r, int c) { const int st = (r >> 4) * 2 + (c >> 5), rr = r & 15, cc = c & 31, ob = rr * 64 + cc * 2; return st * 1024 + (ob ^ (((ob >> 9) & 1) << 5)); }
__device__ __forceinline__ void g8_stage_rc(int bb, int& R, int& C) { const int st = bb / 1024, sb = bb % 1024, swz = sb ^ (((sb >> 9) & 1) << 5); R = (st >> 1) * 16 + swz / 64; C = (st & 1) * 32 + (swz % 64) / 2; }
__device__ __forceinline__ int g8_perm32(int rho) { const int n = rho >> 4, i = rho & 15; return 8 * (i >> 2) + 4 * n + (i & 3); }

enum { EPI_BF16 = 0, EPI_SWIGLU = 2, EPI_SCALE = 3 };
struct GUnit { const char* a; const char* b0; const char* b1; const int* arow; int m0, n0, mvalid, ncols; u16* ob; int ldo; float* gates; const float* rscale; };
constexpr int G8_HTB = 128 * 64 * 2;
constexpr size_t G8_KSTEP = 128, G8_HSTEP = (size_t)128 * 2048 * 2;

template <int EPI>
__device__ __forceinline__ void g8_epilogue(const f32x4 (&acc)[2][2][4][2], const GUnit& u, int wr, int wc, int fr, int fq) {
#pragma unroll
    for (int ai = 0; ai < 2; ++ai)
#pragma unroll
        for (int m = 0; m < 4; ++m) {
            const int row = u.m0 + 128 * ai + 64 * wr + 16 * m + fr;
            if (row < u.mvalid) {
                if (EPI == EPI_BF16) {
#pragma unroll
                    for (int bj = 0; bj < 2; ++bj) {
                        const int col = u.n0 + 128 * bj + 32 * wc + 8 * fq;
                        if (col < u.ncols) {
                            const f32x4 v0 = acc[ai][bj][m][0], v1 = acc[ai][bj][m][1];
                            u32x4 pk = {pk_bf16(v0[0], v0[1]), pk_bf16(v0[2], v0[3]), pk_bf16(v1[0], v1[1]), pk_bf16(v1[2], v1[3])};
                            *reinterpret_cast<u32x4*>(u.ob + (size_t)row * u.ldo + col) = pk;
                            if (u.gates && col >= 4096 && col < 4112) { *reinterpret_cast<f32x4*>(u.gates + (size_t)row * 16 + (col - 4096)) = v0; *reinterpret_cast<f32x4*>(u.gates + (size_t)row * 16 + (col - 4096) + 4) = v1; }
                        }
                    }
                } else if (EPI == EPI_SWIGLU) {
                    const int col = u.n0 + 32 * wc + 8 * fq;
                    float a[8];
                    constexpr float si = 1.f / (F8_SH * F8_SW);
#pragma unroll
                    for (int n = 0; n < 2; ++n)
#pragma unroll
                        for (int q = 0; q < 4; ++q) { const float x = acc[ai][0][m][n][q] * si; a[n * 4 + q] = x * frcp_(1.f + __expf(-x)) * (acc[ai][1][m][n][q] * (si * F8_SA)); }
                    u32x2 pk = {pk_fp8x4(a[0], a[1], a[2], a[3]), pk_fp8x4(a[4], a[5], a[6], a[7])};
                    *reinterpret_cast<u32x2*>((unsigned char*)u.ob + (size_t)row * u.ldo + col) = pk;
                } else {
                    const float sc = u.rscale[row] * (1.f / (F8_SA * F8_SW));
#pragma unroll
                    for (int bj = 0; bj < 2; ++bj) {
                        const int col = u.n0 + 128 * bj + 32 * wc + 8 * fq;
                        const f32x4 v0 = acc[ai][bj][m][0] * sc, v1 = acc[ai][bj][m][1] * sc;
                        u32x4 pk = {pk_bf16(v0[0], v0[1]), pk_bf16(v0[2], v0[3]), pk_bf16(v1[0], v1[1]), pk_bf16(v1[2], v1[3])};
                        *reinterpret_cast<u32x4*>(u.ob + (size_t)row * u.ldo + col) = pk;
                    }
                }
            }
        }
}

template <int EPI, bool GATHER, class UnitFn>
__device__ __forceinline__ void gemm_phase8(unsigned char* lds, UnitFn next) {
    const int tid = tid_(), wid = __builtin_amdgcn_readfirstlane(tid >> 6), lane = tid & 63, wr = wid >> 2, wc = wid & 3, fr = lane & 15, fq = lane >> 4;
    constexpr bool F8 = (EPI != EPI_BF16);
    constexpr int nt = F8 ? 2048 / 128 : 2048 / 64;
    constexpr unsigned ROWB = F8 ? 2048u : 4096u;
    GUnit cur, nxt; int ui = 0;
    if (!next(0, cur)) return;
    int sR[2], sC[2];
#pragma unroll
    for (int i = 0; i < 2; ++i) g8_stage_rc(tid * 16 + i * 8192, sR[i], sC[i]);
    unsigned voffB[2];
#pragma unroll
    for (int i = 0; i < 2; ++i) voffB[i] = (unsigned)((sR[i] & ~31) + g8_perm32(sR[i] & 31)) * ROWB + (unsigned)sC[i] * 2u;
    unsigned voffA[2][2], voffAn[2][2];
    auto set_voffA = [&](const GUnit& u, unsigned (&vo)[2][2]) {
#pragma unroll
        for (int h = 0; h < 2; ++h)
#pragma unroll
            for (int i = 0; i < 2; ++i) {
                if (GATHER) vo[h][i] = (unsigned)u.arow[u.m0 + h * 128 + sR[i]] * ROWB + (unsigned)sC[i] * 2u;
                else vo[h][i] = (unsigned)(h * 128 + sR[i]) * ROWB + (unsigned)sC[i] * 2u;
            } };
    set_voffA(cur, voffA);
    const unsigned ldsw = (unsigned)wid * 1024u;
    const int aoff = g8_lds_byte(wr * 64 + fr, fq * 8), boff = g8_lds_byte(wc * 32 + fr, fq * 8);
#define G8_SA(b, h) (((b) * 2 + (h)) * G8_HTB)
#define G8_SB(b, h) ((4 + (b) * 2 + (h)) * G8_HTB)
#define G8_STAGE(bufoff, gbase, voff) do { _Pragma("unroll") for (int _i = 0; _i < 2; ++_i) \
        __builtin_amdgcn_global_load_lds((const unsigned*)((const char*)(gbase) + (voff)[_i]), (LAS unsigned*)(lds + (bufoff) + ldsw + _i * 8192), 16, 0, 0); } while (0)
#define G8_LDA(dst, b, h) do { _Pragma("unroll") for (int m = 0; m < 4; ++m) _Pragma("unroll") for (int k = 0; k < 2; ++k) dst[m][k] = *(const LAS bf16x8*)(lds + G8_SA(b, h) + aoff + m * 2048 + k * 1024); } while (0)
#define G8_LDB(dst, b, h) do { _Pragma("unroll") for (int n = 0; n < 2; ++n) _Pragma("unroll") for (int k = 0; k < 2; ++k) dst[n][k] = *(const LAS bf16x8*)(lds + G8_SB(b, h) + boff + n * 2048 + k * 1024); } while (0)
#define G8_MMA(ai, bj, At, Bt) do { __builtin_amdgcn_s_setprio(1); _Pragma("unroll") for (int m = 0; m < 4; ++m) _Pragma("unroll") for (int n = 0; n < 2; ++n) { \
        if (F8) { const i32x8 _b = cat8(Bt[n][0], Bt[n][1]), _a = cat8(At[m][0], At[m][1]); asm volatile("v_mfma_f32_16x16x128_f8f6f4 %0, %1, %2, %0" : "+v"(acc[ai][bj][m][n]) : "v"(_b), "v"(_a)); } \
        else { _Pragma("unroll") for (int k = 0; k < 2; ++k) acc[ai][bj][m][n] = __builtin_amdgcn_mfma_f32_16x16x32_bf16(Bt[n][k], At[m][k], acc[ai][bj][m][n], 0, 0, 0); } } \
        __builtin_amdgcn_s_setprio(0); } while (0)
#define G8_WAIT_V(n) asm volatile("s_waitcnt vmcnt(" #n ")" ::: "memory")
#define G8_WAIT_L(n) asm volatile("s_waitcnt lgkmcnt(" #n ")" ::: "memory")
#define G8_BAR __builtin_amdgcn_s_barrier()
#define G8_SCHED __builtin_amdgcn_sched_barrier(0)
    f32x4 acc[2][2][4][2];
#pragma unroll
    for (int a2 = 0; a2 < 2; ++a2)
#pragma unroll
        for (int b2 = 0; b2 < 2; ++b2)
#pragma unroll
            for (int m = 0; m < 4; ++m)
#pragma unroll
                for (int n = 0; n < 2; ++n) acc[a2][b2][m][n] = (f32x4){0.f, 0.f, 0.f, 0.f};
    bf16x8 At[4][2], B0[2][2], B1[2][2];
    const char* cA = cur.a; const char* cB0 = cur.b0; const char* cB1 = cur.b1;
    G8_STAGE(G8_SB(0, 0), cB0, voffB); G8_STAGE(G8_SA(0, 0), cA, voffA[0]); G8_STAGE(G8_SB(0, 1), cB1, voffB); G8_STAGE(G8_SA(0, 1), cA, voffA[1]);
    if (wr == 1) G8_BAR;
    G8_WAIT_V(4); G8_BAR;
    G8_STAGE(G8_SB(1, 0), cB0 + G8_KSTEP, voffB); G8_STAGE(G8_SA(1, 0), cA + G8_KSTEP, voffA[0]); G8_STAGE(G8_SB(1, 1), cB1 + G8_KSTEP, voffB);
    G8_WAIT_V(6); G8_BAR;
    for (;;) {
        const bool has_next = next(ui + 1, nxt);
        const char* nA = has_next ? nxt.a : cA; const char* nB0 = has_next ? nxt.b0 : cB0; const char* nB1 = has_next ? nxt.b1 : cB1;
        if (GATHER) { if (has_next) set_voffA(nxt, voffAn); else { _Pragma("unroll") for (int h = 0; h < 2; ++h) _Pragma("unroll") for (int i = 0; i < 2; ++i) voffAn[h][i] = voffA[h][i]; } }
        for (int t = 0; t < nt; t += 2) {
            const bool last = (t == nt - 2);
            const char* a1 = cA + (size_t)(t + 1) * G8_KSTEP;
            const char* a2 = last ? nA : cA + (size_t)(t + 2) * G8_KSTEP;
            const char* b20 = last ? nB0 : cB0 + (size_t)(t + 2) * G8_KSTEP; const char* b21 = last ? nB1 : cB1 + (size_t)(t + 2) * G8_KSTEP;
            const char* a3 = a2 + G8_KSTEP; const char* b30 = b20 + G8_KSTEP; const char* b31 = b21 + G8_KSTEP;
            unsigned vA2[2][2];
#pragma unroll
            for (int h = 0; h < 2; ++h)
#pragma unroll
                for (int i = 0; i < 2; ++i) vA2[h][i] = (GATHER && last) ? voffAn[h][i] : voffA[h][i];
            G8_LDB(B0, 0, 0); G8_SCHED; G8_LDA(At, 0, 0); G8_STAGE(G8_SA(1, 1), a1, voffA[1]);
            G8_WAIT_L(8); G8_BAR; G8_WAIT_L(0); G8_MMA(0, 0, At, B0); G8_BAR; G8_SCHED;
            G8_LDB(B1, 0, 1); G8_STAGE(G8_SB(0, 0), b20, voffB);
            G8_BAR; G8_WAIT_L(0); G8_MMA(0, 1, At, B1); G8_BAR;
            G8_LDA(At, 0, 1); G8_STAGE(G8_SA(0, 0), a2, vA2[0]);
            G8_BAR; G8_WAIT_L(0); G8_MMA(1, 0, At, B0); G8_BAR; G8_SCHED;
            G8_STAGE(G8_SB(0, 1), b21, voffB);
            G8_WAIT_V(6); G8_BAR; G8_MMA(1, 1, At, B1); G8_BAR;
            G8_LDB(B0, 1, 0); G8_SCHED; G8_LDA(At, 1, 0); G8_STAGE(G8_SA(0, 1), a2, vA2[1]);
            G8_WAIT_L(8); G8_BAR; G8_WAIT_L(0); G8_MMA(0, 0, At, B0); G8_BAR; G8_SCHED;
            G8_LDB(B1, 1, 1); G8_STAGE(G8_SB(1, 0), b30, voffB);
            G8_BAR; G8_WAIT_L(0); G8_MMA(0, 1, At, B1); G8_BAR;
            G8_LDA(At, 1, 1); G8_STAGE(G8_SA(1, 0), a3, vA2[0]);
            G8_BAR; G8_WAIT_L(0); G8_MMA(1, 0, At, B0); G8_BAR; G8_SCHED;
            G8_STAGE(G8_SB(1, 1), b31, voffB);
            G8_WAIT_V(6); G8_BAR; G8_MMA(1, 1, At, B1); G8_BAR;
        }
        if (F8) asm volatile("s_nop 15\n\ts_nop 15" ::: "memory");
        g8_epilogue<EPI>(acc, cur, wr, wc, fr, fq);
        if (!has_next) break;
#pragma unroll
        for (int a2 = 0; a2 < 2; ++a2)
#pragma unroll
            for (int b2 = 0; b2 < 2; ++b2)
#pragma unroll
                for (int m = 0; m < 4; ++m)
#pragma unroll
                    for (int n = 0; n < 2; ++n) acc[a2][b2][m][n] = (f32x4){0.f, 0.f, 0.f, 0.f};
        cur = nxt; cA = nA; cB0 = nB0; cB1 = nB1; ++ui;
        if (GATHER) { _Pragma("unroll") for (int h = 0; h < 2; ++h) _Pragma("unroll") for (int i = 0; i < 2; ++i) voffA[h][i] = voffAn[h][i]; }
    }
    G8_WAIT_V(0);
    if (wr == 0) G8_BAR;
    G8_BAR;
#undef G8_SA
#undef G8_SB
#undef G8_STAGE
#undef G8_LDA
#undef G8_LDB
#undef G8_MMA
#undef G8_WAIT_V
#undef G8_WAIT_L
#undef G8_BAR
#undef G8_SCHED
}

__device__ __forceinline__ void phase_gemm_dense(const Params& p, const u16* A, int M, const u16* Wt, int N, u16* ob, int ldo, float* gates, unsigned char* lds) {
    const int nM = M / 256, nN = (N + 255) / 256, L = nM * nN;
    const int xcd = bid_() & 7, slot = bid_() >> 3, nslot = gdim_() >> 3;
    const int base = (int)(((long)L * xcd) >> 3), cnt = (int)(((long)L * (xcd + 1)) >> 3) - base;
    const int G8n = nM >> 3, rem = nM & 7;
    auto next = [&](int i, GUnit& u) -> bool {
        const int k = slot + i * nslot;
        if (k >= cnt) return false;
        const int idx = base + k;
        int pn, pm;
        if (idx < G8n * 8 * nN) { const int gq = idx / (8 * nN), r = idx % (8 * nN); pn = r >> 3; pm = gq * 8 + (r & 7); }
        else { const int r = idx - G8n * 8 * nN; pn = r / rem; pm = G8n * 8 + r % rem; }
        u.a = (const char*)(A + (size_t)pm * 256 * 2048); u.b0 = (const char*)(Wt + (size_t)pn * 256 * 2048); u.b1 = u.b0 + G8_HSTEP; u.arow = nullptr;
        u.m0 = pm * 256; u.n0 = pn * 256; u.mvalid = M; u.ncols = N; u.ob = ob; u.ldo = ldo; u.gates = gates; u.rscale = nullptr;
        return true; };
    gemm_phase8<EPI_BF16, false>(lds, next);
}

__device__ __forceinline__ void phase_moe_a(const Params& p, int l, unsigned char* lds) {
    unsigned char* const ws = ws_();
    const int mvalid = l == 0 ? 2176 : 2048, nM = l == 0 ? 9 : 8;
    const int per_e = nM * 16;
    const int xcd = bid_() & 7, slot = bid_() >> 3, nslot = gdim_() >> 3;
    auto next = [&](int i, GUnit& u) -> bool {
        const int k = slot + i * nslot;
        if (k >= 2 * per_e) return false;
        const int tile = xcd * 2 * per_e + k;
        const int ex = tile / per_e, r = tile % per_e, pn = r / nM, pm = r % nM;
        u.a = (const char*)(ws + WS_H); u.arow = (const int*)(ws + WS_EROW) + ex * EPAD;
        u.b0 = (const char*)(ws + WS_WT_W1) + ((size_t)ex * FF + pn * 128) * D; u.b1 = (const char*)(ws + WS_WT_W3) + ((size_t)ex * FF + pn * 128) * D;
        u.m0 = pm * 256; u.n0 = pn * 128; u.mvalid = mvalid; u.ncols = FF; u.ob = (u16*)(ws + WS_ACT + (size_t)ex * EPAD * FF); u.ldo = FF; u.gates = nullptr; u.rscale = nullptr;
        return true; };
    gemm_phase8<EPI_SWIGLU, true>(lds, next);
}
__device__ __forceinline__ void phase_moe_b(const Params& p, int l, unsigned char* lds) {
    unsigned char* const ws = ws_();
    const int mvalid = l == 0 ? 2176 : 2048, nM = l == 0 ? 9 : 8;
    const int per_e = nM * 8;
    const int xcd = bid_() & 7, slot = bid_() >> 3, nslot = gdim_() >> 3;
    auto next = [&](int i, GUnit& u) -> bool {
        const int k = slot + i * nslot;
        if (k >= 2 * per_e) return false;
        const int tile = xcd * 2 * per_e + k;
        const int ex = tile / per_e, r = tile % per_e, pn = r / nM, pm = r % nM;
        u.a = (const char*)(ws + WS_ACT) + ((size_t)ex * EPAD + pm * 256) * FF; u.arow = nullptr;
        u.b0 = (const char*)(ws + WS_WT_W2) + ((size_t)ex * D + pn * 256) * FF; u.b1 = u.b0 + (size_t)128 * 2048;
        u.m0 = pm * 256; u.n0 = pn * 256; u.mvalid = mvalid; u.ncols = D; u.ob = (u16*)(ws + WS_YEXP) + (size_t)ex * EPAD * D; u.ldo = D; u.gates = nullptr;
        u.rscale = (const float*)(ws + WS_EGATE) + ex * EPAD;
        return true; };
    gemm_phase8<EPI_SCALE, false>(lds, next);
}

__device__ __forceinline__ int mlstm_row(int b, int dir, int pos) {
    if (pos < LC) return NLAT + b * LC + (dir ? (LC - 1 - pos) : pos);
    const int q = pos - LC; return b * SEQ + (dir ? (SEQ - 1 - q) : q);
}
__device__ __forceinline__ void phase_mlstm(const Params& p, unsigned char* lds) {
    unsigned char* const ws = ws_();
    u16* KT = (u16*)lds;
    u16* VT = KT + 256 * 72;
    u16* VWT = VT + 48 * 72;
    u16* CT = VWT + 48 * 72;
    u16* Ss = CT + 48 * 264;
    float* gB = (float*)(Ss + 64 * 72);
    float* gI = gB + 68 * 64;
    float* gP = gI + 68 * 64;
    float* gE = gP + 68 * 64;
    const int t = tid_(), lane = t & 63, w = t >> 6, fr = lane & 15, fq = lane >> 4;
    const u16* P = (const u16*)(ws + WS_P);
    const float* G = (const float*)(ws + WS_G);
    u16* HM = (u16*)(ws + WS_HM);
    for (int item = bid_(); item < 256; item += gdim_()) {
        const int vs = item & 7, dir = (item >> 3) & 1, hh = (item >> 4) & 3, b = item >> 6;
        __syncthreads();
        for (int i = t; i < 48 * 264; i += NT) CT[i] = 0;
        for (int i = t; i < 16 * 72; i += NT) { const int er = i / 72; VT[32 * 72 + i] = (er == 0) ? (u16)0x3f80 : (u16)0; VWT[32 * 72 + i] = 0; }
        {
            const float gb_i = p.mlstm_gate_b[(dir * 2 + 0) * 4 + hh], gb_f = p.mlstm_gate_b[(dir * 2 + 1) * 4 + hh];
            for (int ch = w; ch < 68; ch += 8) {
                const int row = mlstm_row(b, dir, ch * 64 + lane);
                const float gi = G[(size_t)row * 16 + dir * 8 + hh] + gb_i;
                const float gf = G[(size_t)row * 16 + dir * 8 + 4 + hh] + gb_f;
                const float lf = fminf(gf, 0.f) - log1pf(__expf(-fabsf(gf)));
                float bc = lf;
#pragma unroll
                for (int o = 1; o < 64; o <<= 1) { const float n = __shfl_up(bc, o, 64); if (lane >= o) bc += n; }
                float pm = gi - bc;
#pragma unroll
                for (int o = 1; o < 64; o <<= 1) { const float n = __shfl_up(pm, o, 64); if (lane >= o) pm = fmaxf(pm, n); }
                const float b63 = __shfl(bc, 63, 64);
                float gmax = b63 - bc + gi;
#pragma unroll
                for (int o = 32; o > 0; o >>= 1) gmax = fmaxf(gmax, __shfl_xor(gmax, o, 64));
                gB[ch * 64 + lane] = bc; gI[ch * 64 + lane] = gi; gP[ch * 64 + lane] = pm;
                if (lane == 0) { gE[ch * 2] = b63; gE[ch * 2 + 1] = gmax; }
            }
        }
        f32x4 Cacc[2][3];
#pragma unroll
        for (int i = 0; i < 2; ++i)
#pragma unroll
            for (int j = 0; j < 3; ++j) Cacc[i][j] = (f32x4){0.f, 0.f, 0.f, 0.f};
        float m_old = 0.f;
        const int jt = w & 3, sth = w >> 2;
        const int vs_s = t & 63, vs_eg = t >> 6;
        bf16x8 qf[8]; unsigned ktr[2][8]; u32x2 vraw;
        const int jq = jt * 16 + fr, jjq = dir ? 63 - jq : jq;
        const unsigned off_q = (unsigned)jjq * AB_IN + hh * 256 + fq * 8;
        const int jk0 = (sth * 2) * 16 + fr, jk1 = jk0 + 16;
        const unsigned off_k0 = (unsigned)(dir ? 63 - jk0 : jk0) * AB_IN + 1024 + hh * 256 + fq * 8;
        const unsigned off_k1 = (unsigned)(dir ? 63 - jk1 : jk1) * AB_IN + 1024 + hh * 256 + fq * 8;
        unsigned off_kt[2];
#pragma unroll
        for (int i = 0; i < 2; ++i) { const int mt = t + NT * i, d2 = (mt & 127) * 2, s8 = (mt >> 7) * 8; off_kt[i] = (unsigned)(dir ? 63 - s8 - 7 : s8) * AB_IN + 1024 + hh * 256 + d2; }
        const unsigned off_v = (unsigned)(dir ? 63 - vs_s : vs_s) * AB_IN + 2048 + hh * 256 + vs * 32 + vs_eg * 4;
        const unsigned off_h = (unsigned)jjq * 1024 + hh * 256 + vs * 32 + sth * 16 + 4 * fq;
#define ML_BASE(POS0) (P + (size_t)(dir ? mlstm_row(b, dir, (POS0)) - 63 : mlstm_row(b, dir, (POS0))) * AB_IN)
#define ML_LOAD_Q(POS0) do { const u16* _pc = ML_BASE(POS0); \
            _Pragma("unroll") for (int kk = 0; kk < 8; ++kk) qf[kk] = ld_frag_g(_pc + off_q + kk * 32); } while (0)
#define ML_LOAD_K(POS0, S2) do { const u16* _pc = ML_BASE(POS0); \
            _Pragma("unroll") for (int kk = 0; kk < 8; ++kk) kf[kk] = ld_frag_g(_pc + ((S2) ? off_k1 : off_k0) + kk * 32); } while (0)
#define ML_LOAD_KTV(POS0) do { const u16* _pc = ML_BASE(POS0); \
            _Pragma("unroll") for (int i = 0; i < 2; ++i) { \
                _Pragma("unroll") for (int q = 0; q < 8; ++q) ktr[i][q] = *reinterpret_cast<const unsigned*>(_pc + (size_t)((dir ? 7 - q : q) * AB_IN) + off_kt[i]); } \
            vraw = *reinterpret_cast<const u32x2*>(_pc + off_v); } while (0)
        ML_LOAD_Q(0); ML_LOAD_KTV(0);
        __syncthreads();
        for (int ch = 0; ch < 68; ++ch) {
            const int pos0 = ch * 64;
            const float* sb = gB + ch * 64; const float* sig = gI + ch * 64; const float* spm = gP + ch * 64;
            const float b63 = gE[ch * 2], m_new = fmaxf(b63 + m_old, gE[ch * 2 + 1]), decay = __expf(b63 + m_old - m_new);
            const int jg = jt * 16 + fr;
            const float bj = sb[jg], mj = bj + fmaxf(m_old, spm[jg]);
            auto s_tile = [&](int st) {
                f32x4 sv = (f32x4){0.f, 0.f, 0.f, 0.f};
                if (st <= jt) {
                    typedef short s16x4 __attribute__((ext_vector_type(4)));
                    const u16* kb = KT + (8 * fq + ((lane & 15) >> 2)) * 72 + st * 16 + 4 * (lane & 3);
#pragma unroll
                    for (int kk = 0; kk < 8; ++kk) {
                        const s16x4 lo = __builtin_amdgcn_ds_read_tr16_b64_v4i16((LAS s16x4*)(kb + kk * 32 * 72));
                        const s16x4 hi = __builtin_amdgcn_ds_read_tr16_b64_v4i16((LAS s16x4*)(kb + (kk * 32 + 4) * 72));
                        const bf16x8 kfr = {lo[0], lo[1], lo[2], lo[3], hi[0], hi[1], hi[2], hi[3]};
                        sv = mfma16(kfr, qf[kk], sv);
                    }
                }
                float pv[4];
#pragma unroll
                for (int q = 0; q < 4; ++q) {
                    const int sg = st * 16 + 4 * fq + q;
                    pv[q] = (sg <= jg) ? sv[q] * 0.0625f * __expf(bj - sb[sg] + sig[sg] - mj) : 0.f;
                }
                u32x2 pk = {pk_bf16(pv[0], pv[1]), pk_bf16(pv[2], pv[3])};
                *reinterpret_cast<u32x2*>(Ss + jg * 72 + st * 16 + 4 * fq) = pk;
            };
#pragma unroll
            for (int i = 0; i < 2; ++i) {
                const int mt = t + NT * i, d2 = (mt & 127) * 2, s8 = (mt >> 7) * 8;
                u32x4 lo = {(ktr[i][0] & 0xffffu) | (ktr[i][1] << 16), (ktr[i][2] & 0xffffu) | (ktr[i][3] << 16), (ktr[i][4] & 0xffffu) | (ktr[i][5] << 16), (ktr[i][6] & 0xffffu) | (ktr[i][7] << 16)};
                u32x4 hi = {(ktr[i][0] >> 16) | (ktr[i][1] & 0xffff0000u), (ktr[i][2] >> 16) | (ktr[i][3] & 0xffff0000u), (ktr[i][4] >> 16) | (ktr[i][5] & 0xffff0000u), (ktr[i][6] >> 16) | (ktr[i][7] & 0xffff0000u)};
                *reinterpret_cast<u32x4*>(KT + d2 * 72 + s8) = lo;
                *reinterpret_cast<u32x4*>(KT + (d2 + 1) * 72 + s8) = hi;
            }
            {
                const float wg = __expf(b63 - sb[vs_s] + sig[vs_s] - m_new) * 0.0625f;
                const float v0 = bf_lo(vraw[0]), v1 = bf_hi(vraw[0]), v2 = bf_lo(vraw[1]), v3 = bf_hi(vraw[1]);
                const int e0 = vs_eg * 4;
                VT[(e0 + 0) * 72 + vs_s] = (u16)(vraw[0] & 0xffffu); VT[(e0 + 1) * 72 + vs_s] = (u16)(vraw[0] >> 16);
                VT[(e0 + 2) * 72 + vs_s] = (u16)(vraw[1] & 0xffffu); VT[(e0 + 3) * 72 + vs_s] = (u16)(vraw[1] >> 16);
                VWT[(e0 + 0) * 72 + vs_s] = f2bf(v0 * wg); VWT[(e0 + 1) * 72 + vs_s] = f2bf(v1 * wg);
                VWT[(e0 + 2) * 72 + vs_s] = f2bf(v2 * wg); VWT[(e0 + 3) * 72 + vs_s] = f2bf(v3 * wg);
                if (t < 64) VWT[32 * 72 + t] = f2bf(wg);
            }
            if (ch + 1 < 68) ML_LOAD_KTV(pos0 + 64);
            __syncthreads();
            s_tile(sth * 2);
            s_tile(sth * 2 + 1);
            __syncthreads();
            {
                const float w_inter = __expf(bj + m_old - mj);
                f32x4 nacc[2];
#pragma unroll
                for (int z = 0; z < 2; ++z) {
                    const int et = z == 0 ? sth : 2;
                    f32x4 a = (f32x4){0.f, 0.f, 0.f, 0.f};
#pragma unroll
                    for (int kk = 0; kk < 8; ++kk) a = mfma16(ld_frag_s(CT + (et * 16 + fr) * 264 + kk * 32 + fq * 8), qf[kk], a);
                    nacc[z] = a * w_inter;
                }
                if (ch + 1 < 68) ML_LOAD_Q(pos0 + 64);
#pragma unroll
                for (int z = 0; z < 2; ++z) {
                    const int et = z == 0 ? sth : 2;
                    f32x4 a = nacc[z];
#pragma unroll
                    for (int k2 = 0; k2 < 2; ++k2) a = mfma16(ld_frag_s(VT + (et * 16 + fr) * 72 + k2 * 32 + fq * 8), ld_frag_s(Ss + jg * 72 + k2 * 32 + fq * 8), a);
                    nacc[z] = a;
                }
                const float den = __shfl(nacc[1][0], fr, 64);
                const float dd = fmaxf(fabsf(den), __expf(-mj));
                const float inv = 1.f / dd;
                u32x2 pk = {pk_bf16(nacc[0][0] * inv, nacc[0][1] * inv), pk_bf16(nacc[0][2] * inv, nacc[0][3] * inv)};
                *reinterpret_cast<u32x2*>(HM + ((size_t)dir * NTOK + (dir ? mlstm_row(b, dir, pos0) - 63 : mlstm_row(b, dir, pos0))) * 1024 + off_h) = pk;
            }
#pragma unroll
            for (int i = 0; i < 2; ++i)
#pragma unroll
                for (int et = 0; et < 3; ++et) {
                    f32x4 a = Cacc[i][et] * decay;
#pragma unroll
                    for (int k2 = 0; k2 < 2; ++k2) a = mfma16(ld_frag_s(KT + ((w * 2 + i) * 16 + fr) * 72 + k2 * 32 + fq * 8), ld_frag_s(VWT + (et * 16 + fr) * 72 + k2 * 32 + fq * 8), a);
                    Cacc[i][et] = a;
                }
            __syncthreads();
#pragma unroll
            for (int i = 0; i < 2; ++i)
#pragma unroll
                for (int et = 0; et < 3; ++et) {
                    const f32x4 a = Cacc[i][et];
                    u32x2 pk = {pk_bf16(a[0], a[1]), pk_bf16(a[2], a[3])};
                    *reinterpret_cast<u32x2*>(CT + (et * 16 + fr) * 264 + (w * 2 + i) * 16 + 4 * fq) = pk;
                }
            m_old = m_new;
        }
#undef ML_LOAD_Q
#undef ML_LOAD_K
#undef ML_LOAD_KTV
    }
}

__device__ __forceinline__ void mlstm_out_rows(const Params& p, int row0, int nrows) {
    unsigned char* const ws = ws_();
    const int lane = tid_() & 63, w = tid_() >> 6;
    const u16* P = (const u16*)(ws + WS_P);
    const u16* HM = (const u16*)(ws + WS_HM);
    u16* YIN = (u16*)(ws + WS_YIN);
    for (int r = w; r < nrows; r += 8) {
        const int row = row0 + r;
        const int c0 = lane * 16;
        float v[16]; float ss = 0.f;
#pragma unroll
        for (int h2 = 0; h2 < 2; ++h2) {
            const u32x4 a = *reinterpret_cast<const u32x4*>(HM + (size_t)row * 1024 + c0 + h2 * 8);
            const u32x4 bq = *reinterpret_cast<const u32x4*>(HM + ((size_t)NTOK + row) * 1024 + c0 + h2 * 8);
#pragma unroll
            for (int q = 0; q < 4; ++q) { v[h2 * 8 + 2 * q] = bf_lo(a[q]) + bf_lo(bq[q]); v[h2 * 8 + 2 * q + 1] = bf_hi(a[q]) + bf_hi(bq[q]); }
        }
#pragma unroll
        for (int q = 0; q < 16; ++q) ss += v[q] * v[q];
        ss += __shfl_xor(ss, 1, 64); ss += __shfl_xor(ss, 2, 64); ss += __shfl_xor(ss, 4, 64); ss += __shfl_xor(ss, 8, 64);
        const float rstd = rsqrtf(ss * (1.f / 256.f) + 1e-6f);
        unsigned o[8];
#pragma unroll
        for (int h2 = 0; h2 < 2; ++h2) {
            const u32x4 og = *reinterpret_cast<const u32x4*>(P + (size_t)row * AB_IN + 3072 + c0 + h2 * 8);
#pragma unroll
            for (int q = 0; q < 4; ++q) {
                const int c = c0 + h2 * 8 + 2 * q;
                const float y0 = v[h2 * 8 + 2 * q] * rstd * p.mlstm_norm[c] * sigmoidf_(bf_lo(og[q]));
                const float y1 = v[h2 * 8 + 2 * q + 1] * rstd * p.mlstm_norm[c + 1] * sigmoidf_(bf_hi(og[q]));
                o[h2 * 4 + q] = pk_bf16(y0, y1);
            }
        }
        *reinterpret_cast<u32x4*>(YIN + (size_t)row * D + c0) = (u32x4){o[0], o[1], o[2], o[3]};
        *reinterpret_cast<u32x4*>(YIN + (size_t)row * D + c0 + 8) = (u32x4){o[4], o[5], o[6], o[7]};
    }
}

template <int DH, class KeyFn, class BiasFn>
__device__ __forceinline__ void attn_wave(const u16* qptr, size_t qstride, int nblk, KeyFn keyfn, BiasFn biasfn, float scale,
                                           float m_init, float l_init, u16* vlds, u16* optr, size_t ostride) {
    constexpr int NK = DH / 32, NDT = DH / 16, VS = DH + 8, NV = DH / 16;
    const int lane = tid_() & 63, fr = lane & 15, fq = lane >> 4;
    bf16x8 qf[NK];
#pragma unroll
    for (int kk = 0; kk < NK; ++kk) qf[kk] = ld_frag_g(qptr + (size_t)fr * qstride + kk * 32 + fq * 8);
    f32x4 oacc[NDT];
#pragma unroll
    for (int i = 0; i < NDT; ++i) oacc[i] = (f32x4){0.f, 0.f, 0.f, 0.f};
    float m = m_init, l = l_init;
    bf16x8 kn[2][NK]; u32x4 vn[NV];
    auto load_blk = [&](int ib) {
        const u16* kptr; const u16* vptr; size_t kvs;
        (void)keyfn(ib, kptr, vptr, kvs);
#pragma unroll
        for (int st = 0; st < 2; ++st)
#pragma unroll
            for (int kk = 0; kk < NK; ++kk) kn[st][kk] = ld_frag_g(kptr + (size_t)(st * 16 + fr) * kvs + kk * 32 + fq * 8);
#pragma unroll
        for (int i = 0; i < NV; ++i) { const int cidx = lane + 64 * i, r = cidx / (DH / 8), cc = cidx % (DH / 8); vn[i] = *reinterpret_cast<const u32x4*>(vptr + (size_t)r * kvs + cc * 8); }
    };
    auto next_valid = [&](int ib) { const u16* a; const u16* b2; size_t c; while (ib < nblk && !keyfn(ib, a, b2, c)) ++ib; return ib; };
    int ib = next_valid(0);
    if (ib < nblk) load_blk(ib);
    while (ib < nblk) {
        bf16x8 kc[2][NK]; u32x4 vc[NV];
#pragma unroll
        for (int st = 0; st < 2; ++st)
#pragma unroll
            for (int kk = 0; kk < NK; ++kk) kc[st][kk] = kn[st][kk];
#pragma unroll
        for (int i = 0; i < NV; ++i) vc[i] = vn[i];
        const int ibn = next_valid(ib + 1);
        if (ibn < nblk) load_blk(ibn);
        asm volatile("" ::: "memory");
#pragma unroll
        for (int i = 0; i < NV; ++i) { const int cidx = lane + 64 * i, r = cidx / (DH / 8), cc = cidx % (DH / 8); *reinterpret_cast<u32x4*>(vlds + r * VS + cc * 8) = vc[i]; }
        f32x4 s[2];
#pragma unroll
        for (int st = 0; st < 2; ++st) {
            f32x4 a = (f32x4){0.f, 0.f, 0.f, 0.f};
#pragma unroll
            for (int kk = 0; kk < NK; ++kk) a = mfma16(kc[st][kk], qf[kk], a);
            s[st] = a;
        }
        float x[8]; float mx = -INFINITY;
#pragma unroll
        for (int st = 0; st < 2; ++st)
#pragma unroll
            for (int q = 0; q < 4; ++q) { const float v = s[st][q] * scale + biasfn(ib, fr, st * 16 + 4 * fq + q); x[st * 4 + q] = v; mx = fmaxf(mx, v); }
        mx = max_x32(max_x16(mx));
        const float m_new = fmaxf(m, mx);
        const float m_safe = (m_new == -INFINITY) ? 0.f : m_new;
        const float alpha = __expf(m - m_safe);
        float ps = 0.f; float pe[8];
#pragma unroll
        for (int q = 0; q < 8; ++q) { pe[q] = __expf(x[q] - m_safe); ps += pe[q]; }
        l = l * alpha + ps; m = m_new;
#pragma unroll
        for (int i = 0; i < NDT; ++i) oacc[i] *= alpha;
        const bf16x8 pf = mk_frag(pk_bf16(pe[0], pe[1]), pk_bf16(pe[2], pe[3]), pk_bf16(pe[4], pe[5]), pk_bf16(pe[6], pe[7]));
        asm volatile("s_waitcnt lgkmcnt(0)" ::: "memory");
        {
            typedef short s16x4 __attribute__((ext_vector_type(4)));
            const int tq = (lane & 15) >> 2, tp = lane & 3;
            const u16* vb0 = vlds + (4 * fq + tq) * VS + 4 * tp;
            const u16* vb1 = vb0 + 16 * VS;
#pragma unroll
            for (int dt = 0; dt < NDT; ++dt) {
                const s16x4 lo = __builtin_amdgcn_ds_read_tr16_b64_v4i16((LAS s16x4*)(vb0 + dt * 16));
                const s16x4 hi = __builtin_amdgcn_ds_read_tr16_b64_v4i16((LAS s16x4*)(vb1 + dt * 16));
                const bf16x8 vf = {lo[0], lo[1], lo[2], lo[3], hi[0], hi[1], hi[2], hi[3]};
                oacc[dt] = mfma16(vf, pf, oacc[dt]);
            }
        }
        asm volatile("" ::: "memory");
        ib = ibn;
    }
    l = sum_x32(sum_x16(l));
    const float inv = 1.f / l;
#pragma unroll
    for (int dt = 0; dt < NDT; ++dt) {
        const f32x4 o = oacc[dt] * inv;
        u32x2 pk = {pk_bf16(o[0], o[1]), pk_bf16(o[2], o[3])};
        *reinterpret_cast<u32x2*>(optr + (size_t)fr * ostride + dt * 16 + 4 * fq) = pk;
    }
}


template <int DH, class SlabFn, class SubFn, class BiasFn>
__device__ __forceinline__ void attn_block(const u16* qptr, size_t qstride, int nslab, SlabFn slabfn, SubFn subfn, BiasFn biasfn, float scale,
                                            float m_init, float l_init, unsigned char* lds, u16* optr, size_t ostride) {
    constexpr int NK = DH / 32, NDT = DH / 16, VS = DH + 8, NLD = DH / 64;
    constexpr int STAGE = 2 * 64 * VS * 2;
    const int t = tid_(), lane = t & 63, fr = lane & 15, fq = lane >> 4;
    bf16x8 qf[NK];
#pragma unroll
    for (int kk = 0; kk < NK; ++kk) qf[kk] = ld_frag_g(qptr + (size_t)fr * qstride + kk * 32 + fq * 8);
    f32x4 oacc[NDT];
#pragma unroll
    for (int i = 0; i < NDT; ++i) oacc[i] = (f32x4){0.f, 0.f, 0.f, 0.f};
    float m = m_init, l = l_init;
    u32x4 kreg[NLD], vreg[NLD];
    auto load_slab = [&](int i) {
        const u16* kp; const u16* vp; size_t kvs; slabfn(i, kp, vp, kvs);
#pragma unroll
        for (int q = 0; q < NLD; ++q) { const int c = t + NT * q, r = c / (DH / 8), cc = c % (DH / 8);
            kreg[q] = *reinterpret_cast<const u32x4*>(kp + (size_t)r * kvs + cc * 8); vreg[q] = *reinterpret_cast<const u32x4*>(vp + (size_t)r * kvs + cc * 8); } };
    auto store_slab = [&](int st) {
        u16* Ks = (u16*)(lds + st * STAGE); u16* Vs = Ks + 64 * VS;
#pragma unroll
        for (int q = 0; q < NLD; ++q) { const int c = t + NT * q, r = c / (DH / 8), cc = c % (DH / 8);
            *reinterpret_cast<u32x4*>(Ks + r * VS + cc * 8) = kreg[q]; *reinterpret_cast<u32x4*>(Vs + r * VS + cc * 8) = vreg[q]; } };
    __syncthreads();
    load_slab(0); store_slab(0);
    if (nslab > 1) load_slab(1);
    __syncthreads();
    for (int i = 0; i < nslab; ++i) {
        const int cur = i & 1;
        if (i + 1 < nslab) store_slab(cur ^ 1);
        if (i + 2 < nslab) load_slab(i + 2);
        const u16* Ks = (const u16*)(lds + cur * STAGE); const u16* Vs = Ks + 64 * VS;
#pragma unroll
        for (int j = 0; j < 2; ++j) {
            int off;
            if (!subfn(i, j, off)) continue;
            f32x4 s[2];
#pragma unroll
            for (int st = 0; st < 2; ++st) {
                f32x4 a = (f32x4){0.f, 0.f, 0.f, 0.f};
#pragma unroll
                for (int kk = 0; kk < NK; ++kk) a = mfma16(ld_frag_s(Ks + (off + st * 16 + fr) * VS + kk * 32 + fq * 8), qf[kk], a);
                s[st] = a;
            }
            float x[8]; float mx = -INFINITY;
#pragma unroll
            for (int st = 0; st < 2; ++st)
#pragma unroll
                for (int q = 0; q < 4; ++q) { const float v = s[st][q] * scale + biasfn(i, off, fr, st * 16 + 4 * fq + q); x[st * 4 + q] = v; mx = fmaxf(mx, v); }
            mx = max_x32(max_x16(mx));
            const float m_new = fmaxf(m, mx);
            const float m_safe = (m_new == -INFINITY) ? 0.f : m_new;
            const float alpha = __expf(m - m_safe);
            float ps = 0.f; float pe[8];
#pragma unroll
            for (int q = 0; q < 8; ++q) { pe[q] = __expf(x[q] - m_safe); ps += pe[q]; }
            l = l * alpha + ps; m = m_new;
#pragma unroll
            for (int dt = 0; dt < NDT; ++dt) oacc[dt] *= alpha;
            const bf16x8 pf = mk_frag(pk_bf16(pe[0], pe[1]), pk_bf16(pe[2], pe[3]), pk_bf16(pe[4], pe[5]), pk_bf16(pe[6], pe[7]));
            typedef short s16x4 __attribute__((ext_vector_type(4)));
            const int tq = (lane & 15) >> 2, tp = lane & 3;
            const u16* vb0 = Vs + (off + 4 * fq + tq) * VS + 4 * tp;
            const u16* vb1 = vb0 + 16 * VS;
#pragma unroll
            for (int dt = 0; dt < NDT; ++dt) {
                const s16x4 lo = __builtin_amdgcn_ds_read_tr16_b64_v4i16((LAS s16x4*)(vb0 + dt * 16));
                const s16x4 hi = __builtin_amdgcn_ds_read_tr16_b64_v4i16((LAS s16x4*)(vb1 + dt * 16));
                const bf16x8 vf = {lo[0], lo[1], lo[2], lo[3], hi[0], hi[1], hi[2], hi[3]};
                oacc[dt] = mfma16(vf, pf, oacc[dt]);
            }
        }
        __syncthreads();
    }
    l = sum_x32(sum_x16(l));
    const float inv = 1.f / l;
#pragma unroll
    for (int dt = 0; dt < NDT; ++dt) {
        const f32x4 o = oacc[dt] * inv;
        u32x2 pk = {pk_bf16(o[0], o[1]), pk_bf16(o[2], o[3])};
        *reinterpret_cast<u32x2*>(optr + (size_t)fr * ostride + dt * 16 + 4 * fq) = pk;
    }
}

__device__ __forceinline__ void phase_l0_stage2(const Params& p, unsigned char* lds) {
    unsigned char* const ws = ws_();
    const int w = tid_() >> 6;
    const u16* P = (const u16*)(ws + WS_P);
    u16* YIN = (u16*)(ws + WS_YIN);
    for (int item = bid_(); item < 1088 + 2176; item += gdim_()) {
        if (item < 1024) {
            const int r2 = item & 31, h = (item >> 5) & 7, b = item >> 8;
            const int rr = w >> 2, qt = w & 3, r = 2 * r2 + rr;
            const int r0 = min(max(r - 4, 0), 56);
            const int krow0 = min(max(2 * r2 - 4, 0), 56), nwin = min(max(2 * r2 + 1 - 4, 0), 56) + 8 - krow0;
            const int cb = qt == 0 ? 0 : (qt == 1 ? 8 : (qt == 2 ? 24 : 32));
            const int qrow = b * SEQ + r * 64 + qt * 16;
            const float* rpb = p.na_rpb + h * 15 * 31;
            auto slabfn = [&](int i, const u16*& kp, const u16*& vp, size_t& kvs) {
                const int row = i < nwin ? b * SEQ + (krow0 + i) * 64 : NLAT + b * LC + (i - nwin) * 64;
                kp = P + (size_t)row * AB_IN + 5136 + h * 128; vp = P + (size_t)row * AB_IN + 6160 + h * 128; kvs = AB_IN; };
            auto subfn = [&](int i, int j, int& off) -> bool {
                if (i < nwin) { off = cb; return j == 0 && (krow0 + i) >= r0 && (krow0 + i) < r0 + 8; }
                off = 32 * j; return true; };
            auto biasfn = [&](int i, int off, int qi, int ki) -> float {
                if (i >= nwin) return 0.f;
                const int c = qt * 16 + qi, kc = off + ki, c0 = min(max(c - 8, 0), 48);
                if (kc < c0 || kc >= c0 + 16) return -INFINITY;
                return rpb[(krow0 + i - r + 7) * 31 + (kc - c + 15)]; };
            attn_block<128>(P + (size_t)qrow * AB_IN + 4112 + h * 128, AB_IN, nwin + 4, slabfn, subfn, biasfn, 0.08838834764831845f, -INFINITY, 0.f, lds,
                            YIN + (size_t)qrow * D + 1024 + h * 128, D);
        } else if (item < 1088) {
            const int it = item - 1024, half = it & 1, h = (it >> 1) & 7, b = it >> 4;
            const int qrow = NLAT + b * LC + (half * 8 + w) * 16;
            auto slabfn = [&](int i, const u16*& kp, const u16*& vp, size_t& kvs) {
                const int row = NLAT + b * LC + i * 64;
                kp = P + (size_t)row * AB_IN + 5136 + h * 128; vp = P + (size_t)row * AB_IN + 6160 + h * 128; kvs = AB_IN; };
            auto subfn = [&](int, int j, int& off) -> bool { off = 32 * j; return true; };
            auto biasfn = [&](int, int, int, int) -> float { return 0.f; };
            attn_block<128>(P + (size_t)qrow * AB_IN + 4112 + h * 128, AB_IN, 4, slabfn, subfn, biasfn, 0.08838834764831845f, -INFINITY, 0.f, lds,
                            YIN + (size_t)qrow * D + 1024 + h * 128, D);
        } else {
            mlstm_out_rows(p, (item - 1088) * 8, 8);
        }
    }
}

__device__ __forceinline__ void rope_rows(const Params& p, int row0, int nrows) {
    unsigned char* const ws = ws_();
    const int lane = tid_() & 63, w = tid_() >> 6;
    u16* P = (u16*)(ws + WS_P);
    for (int r = w; r < nrows; r += 8) {
        const int row = row0 + r, tt = row & (SEQ - 1);
        const float prow = (float)(tt >> 6), pcol = (float)(tt & 63);
        for (int pi = lane; pi < 640; pi += 64) {
            const int head = pi >> 5, half = (pi >> 4) & 1, j = pi & 15;
            const int base = (head < 16 ? head * 64 : 1024 + (head - 16) * 64) + half * 32 + j;
            const float inv = exp2f(-(float)j * (13.287712379549449f / 16.f));
            const float ang = (half ? pcol : prow) * inv;
            float sn, cs; sincosf(ang, &sn, &cs);
            u16* q1 = P + (size_t)row * CD_IN + base;
            const float x1 = bf2f(q1[0]), x2 = bf2f(q1[16]);
            q1[0] = f2bf(x1 * cs - x2 * sn); q1[16] = f2bf(x2 * cs + x1 * sn);
        }
    }
}

__device__ __forceinline__ int lru_row(int b, int ci, int j) { return ci < 4 ? NLAT + b * LC + ci * 64 + j : b * SEQ + (ci - 4) * 64 + j; }
__device__ __forceinline__ void lru_chunk(const Params& p, int b, int blk, int ci, int mode, unsigned char* lds) {
    unsigned char* const ws = ws_();
    u16* ub = (u16*)lds;
    constexpr int SR = 132;
    float* sa = (float*)(ub + 64 * 136);
    float* sbt = sa + 64 * SR;
    float* sx = sbt + 64 * SR;
    const int t = tid_(), lane = t & 63, w = t >> 6, fr = lane & 15, fq = lane >> 4;
    const u16* P = (const u16*)(ws + WS_P);
    const u16* WT = (const u16*)(ws + WS_LRUW);
    float* SA = (float*)(ws + WS_LRUS);
    float* SH = SA + 2 * 4 * 68 * 1024;
    const int seglen = ci < 4 ? LC : SEQ, tt0 = ci < 4 ? ci * 64 : (ci - 4) * 64;
    const int rbase = ci < 4 ? NLAT + b * LC : b * SEQ;
    const int sc = t & 127, seg = t >> 7;
    const int chg_s = blk * 128 + sc;
    const int cg = blk * 128 + w * 16 + 4 * fq;
    bf16x8 wfa[2][2][4];
#pragma unroll
    for (int d2 = 0; d2 < 2; ++d2)
#pragma unroll
        for (int g2 = 0; g2 < 2; ++g2)
#pragma unroll
            for (int kk = 0; kk < 4; ++kk) wfa[d2][g2][kk] = ld_frag_g(WT + ((size_t)((d2 * 2 + g2) * 8 + blk) * 128 + w * 16 + fr) * 128 + fq * 8 + kk * 32);
    f32x4 gba[2][2], lama[2];
#pragma unroll
    for (int d2 = 0; d2 < 2; ++d2) {
        lama[d2] = *reinterpret_cast<const f32x4*>(p.lru_lambda + d2 * 1024 + cg);
#pragma unroll
        for (int g2 = 0; g2 < 2; ++g2) gba[d2][g2] = *reinterpret_cast<const f32x4*>(p.lru_gate_b + (d2 * 2 + g2) * 1024 + cg);
    }
    float carry[2] = {0.f, 0.f}; u16 grv[16];
    if (mode == 1) {
#pragma unroll
        for (int d2 = 0; d2 < 2; ++d2) carry[d2] = SH[((size_t)(d2 * 4 + b) * 68 + ci) * 1024 + chg_s];
#pragma unroll
        for (int s = 0; s < 16; ++s) grv[s] = P[(size_t)lru_row(b, ci, seg * 16 + s) * CD_IN + 2560 + chg_s];
    }
    __syncthreads();
    {
        const int c4 = (t & 31) * 4, j0 = (t >> 5) * 4, ch = blk * 128 + c4;
        float xv[7][4];
#pragma unroll
        for (int q = 0; q < 7; ++q) {
            const int tt = tt0 + j0 - 1 + q;
            if (tt >= 0 && tt < seglen) {
                const u32x2 v = *reinterpret_cast<const u32x2*>(P + (size_t)(rbase + tt) * CD_IN + 1536 + ch);
                xv[q][0] = bf_lo(v[0]); xv[q][1] = bf_hi(v[0]); xv[q][2] = bf_lo(v[1]); xv[q][3] = bf_hi(v[1]);
            } else { xv[q][0] = xv[q][1] = xv[q][2] = xv[q][3] = 0.f; }
        }
        f32x4 cw[4];
#pragma unroll
        for (int tp = 0; tp < 4; ++tp) cw[tp] = *reinterpret_cast<const f32x4*>(p.lru_conv_w + tp * 1024 + ch);
        const f32x4 cb = *reinterpret_cast<const f32x4*>(p.lru_conv_b + ch);
#pragma unroll
        for (int q = 0; q < 4; ++q) {
            float u[4];
#pragma unroll
            for (int cc = 0; cc < 4; ++cc) u[cc] = cb[cc] + xv[q][cc] * cw[0][cc] + xv[q + 1][cc] * cw[1][cc] + xv[q + 2][cc] * cw[2][cc] + xv[q + 3][cc] * cw[3][cc];
            u32x2 pk = {pk_bf16(u[0], u[1]), pk_bf16(u[2], u[3])};
            *reinterpret_cast<u32x2*>(ub + (j0 + q) * 136 + c4) = pk;
        }
    }
    __syncthreads();
    float hfw[16];
    for (int dir = 0; dir < 2; ++dir) {
        f32x4 av[4];
        {
            bf16x8 wf[4];
#pragma unroll
            for (int kk = 0; kk < 4; ++kk) wf[kk] = dir ? wfa[1][0][kk] : wfa[0][0][kk];
            const f32x4 gbv = dir ? gba[1][0] : gba[0][0];
            const f32x4 lamv = dir ? lama[1] : lama[0];
            float sp8[4];
#pragma unroll
            for (int q = 0; q < 4; ++q) { const float nl = -lamv[q]; sp8[q] = -8.f * (fmaxf(nl, 0.f) + __logf(1.f + __expf(-fabsf(nl)))); }
#pragma unroll
            for (int tt = 0; tt < 4; ++tt) {
                f32x4 z = (f32x4){0.f, 0.f, 0.f, 0.f};
#pragma unroll
                for (int kk = 0; kk < 4; ++kk) z = mfma16(wf[kk], ld_frag_s(ub + (tt * 16 + fr) * 136 + kk * 32 + fq * 8), z);
#pragma unroll
                for (int q = 0; q < 4; ++q) av[tt][q] = __expf(sigmoidf_(z[q] + gbv[q]) * sp8[q]);
            }
        }
        __syncthreads();
        {
            bf16x8 wf[4];
#pragma unroll
            for (int kk = 0; kk < 4; ++kk) wf[kk] = dir ? wfa[1][1][kk] : wfa[0][1][kk];
            const f32x4 gbv = dir ? gba[1][1] : gba[0][1];
#pragma unroll
            for (int tt = 0; tt < 4; ++tt) {
                f32x4 z = (f32x4){0.f, 0.f, 0.f, 0.f};
#pragma unroll
                for (int kk = 0; kk < 4; ++kk) z = mfma16(wf[kk], ld_frag_s(ub + (tt * 16 + fr) * 136 + kk * 32 + fq * 8), z);
                const int tj = tt * 16 + fr;
                const u32x2 uv = *reinterpret_cast<const u32x2*>(ub + tj * 136 + w * 16 + 4 * fq);
                const float u4[4] = {bf_lo(uv[0]), bf_hi(uv[0]), bf_lo(uv[1]), bf_hi(uv[1])};
                f32x4 bv;
#pragma unroll
                for (int q = 0; q < 4; ++q) { const float a = av[tt][q]; bv[q] = __builtin_amdgcn_sqrtf(fmaxf(1.f - a * a, 0.f)) * sigmoidf_(z[q] + gbv[q]) * u4[q]; }
                *reinterpret_cast<f32x4*>(sa + tj * SR + w * 16 + 4 * fq) = av[tt];
                *reinterpret_cast<f32x4*>(sbt + tj * SR + w * 16 + 4 * fq) = bv;
            }
        }
        __syncthreads();
        float A = 1.f, h = 0.f;
#pragma unroll
        for (int s = 0; s < 16; ++s) { const int j = seg * 16 + (dir ? 15 - s : s); const float a = sa[j * SR + sc]; h = a * h + sbt[j * SR + sc]; A *= a; }
        sx[(seg * 2 + 0) * 128 + sc] = A; sx[(seg * 2 + 1) * 128 + sc] = h;
        __syncthreads();
        const size_t sidx = ((size_t)(dir * 4 + b) * 68 + ci) * 1024 + chg_s;
        if (mode == 0) {
            if (seg == 0) {
                float At = 1.f, ht = 0.f;
#pragma unroll
                for (int s = 0; s < 4; ++s) { const int sg = dir ? 3 - s : s; const float a = sx[(sg * 2) * 128 + sc]; ht = a * ht + sx[(sg * 2 + 1) * 128 + sc]; At *= a; }
                SA[sidx] = At; SH[sidx] = ht;
            }
        } else {
            float hs = dir ? carry[1] : carry[0];
            const int nprev = dir ? 3 - seg : seg;
#pragma unroll
            for (int s = 0; s < 3; ++s) if (s < nprev) { const int sg = dir ? 3 - s : s; hs = sx[(sg * 2) * 128 + sc] * hs + sx[(sg * 2 + 1) * 128 + sc]; }
            u16* YIN = (u16*)(ws + WS_YIN);
            if (dir == 0) {
#pragma unroll
                for (int s = 0; s < 16; ++s) { const int j = seg * 16 + s; hs = sa[j * SR + sc] * hs + sbt[j * SR + sc]; hfw[s] = hs; }
            } else {
#pragma unroll
                for (int s = 0; s < 16; ++s) {
                    const int js = 15 - s, j = seg * 16 + js;
                    hs = sa[j * SR + sc] * hs + sbt[j * SR + sc];
                    const int row = lru_row(b, ci, j);
                    const float gr = bf2f(grv[js]);
                    const float th = 1.f - 2.f * frcp_(1.f + __expf(1.5957691216057308f * (gr + 0.044715f * gr * gr * gr)));
                    const float ge = 0.5f * gr * (1.f + th);
                    YIN[(size_t)row * D + 1024 + chg_s] = f2bf((hfw[js] + hs) * ge);
                }
            }
        }
    }
}

__device__ __forceinline__ void lru_prep_weights(const Params& p) {
    unsigned char* const ws = ws_();
    const int t = tid_();
    u16* WT = (u16*)(ws + WS_LRUW);
    for (int m = bid_(); m < 32; m += gdim_()) {
        const float* Wg = p.lru_gate_w + (size_t)m * 128 * 128;
        const int j4 = (t & 31) * 4, i8 = (t >> 5) * 8;
        f32x4 r8[8];
#pragma unroll
        for (int q = 0; q < 8; ++q) r8[q] = *reinterpret_cast<const f32x4*>(Wg + (size_t)(i8 + q) * 128 + j4);
#pragma unroll
        for (int jj = 0; jj < 4; ++jj) {
            u32x4 v = {pk_bf16(r8[0][jj], r8[1][jj]), pk_bf16(r8[2][jj], r8[3][jj]), pk_bf16(r8[4][jj], r8[5][jj]), pk_bf16(r8[6][jj], r8[7][jj])};
            *reinterpret_cast<u32x4*>(WT + ((size_t)m * 128 + j4 + jj) * 128 + i8) = v;
        }
    }
}
__device__ __forceinline__ void lru_carry(const Params& p, int item) {
    unsigned char* const ws = ws_();
    const int idx = item * NT + tid_();
    const int c = idx & 1023, b = (idx >> 10) & 3, dir = idx >> 12;
    float* SA = (float*)(ws + WS_LRUS);
    float* SH = SA + 2 * 4 * 68 * 1024;
    const size_t base = ((size_t)(dir * 4 + b) * 68) * 1024 + c;
    float h = 0.f;
#pragma unroll 4
    for (int s = 0; s < 68; ++s) {
        const int cj = dir == 0 ? s : (s < 4 ? 3 - s : 71 - s);
        const float a = SA[base + (size_t)cj * 1024], hl = SH[base + (size_t)cj * 1024];
        SH[base + (size_t)cj * 1024] = h;
        h = a * h + hl;
    }
}

__device__ __forceinline__ void gqa_item(const Params& p, int it, unsigned char* lds) {
    unsigned char* const ws = ws_();
    const int w = tid_() >> 6;
    const u16* P = (const u16*)(ws + WS_P);
    u16* YIN = (u16*)(ws + WS_YIN);
    const int t32 = it & 127, kvh = (it >> 7) & 3, b = it >> 9;
    const int hq = kvh * 4 + (w & 3), t0 = t32 * 32 + (w >> 2) * 16;
    const int kfirst = max((t32 * 32 - 128) & ~63, 0), klast = min(((t32 * 32 - 128) & ~63) + 256, SEQ - 64);
    const int nwin = (klast - kfirst) / 64 + 1;
    const int qrow = b * SEQ + t0;
    auto slabfn = [&](int i, const u16*& kp, const u16*& vp, size_t& kvs) {
        const int row = i < nwin ? b * SEQ + kfirst + i * 64 : NLAT + b * LC + (i - nwin) * 64;
        kp = P + (size_t)row * CD_IN + 1024 + kvh * 64; vp = P + (size_t)row * CD_IN + 1280 + kvh * 64; kvs = CD_IN; };
    auto subfn = [&](int i, int j, int& off) -> bool {
        off = 32 * j;
        if (i >= nwin) return true;
        const int k0 = kfirst + i * 64 + off;
        return k0 + 31 >= t0 - 128 && k0 <= t0 + 15 + 128; };
    auto biasfn = [&](int i, int off, int qi, int ki) -> float {
        if (i >= nwin) return 0.f;
        const int dq = (t0 + qi) - (kfirst + i * 64 + off + ki);
        return (dq > 128 || dq < -128) ? -INFINITY : 0.f; };
    const float sink = p.gqa_sink[hq];
    attn_block<64>(P + (size_t)qrow * CD_IN + hq * 64, CD_IN, nwin + 4, slabfn, subfn, biasfn, 0.125f, sink, ((tid_() & 63) >> 4) == 0 ? 1.f : 0.f, lds,
                   YIN + (size_t)qrow * D + hq * 64, D);
}

__device__ __forceinline__ void phase_l1_stage1(const Params& p, unsigned char* lds) {
    for (int item = bid_(); item < 2176 + 2048; item += gdim_()) {
        if (item < 2176) { const int ci = item % 68, blk = (item / 68) & 7, b = item / (68 * 8); lru_chunk(p, b, blk, ci, 0, lds); }
        else rope_rows(p, (item - 2176) * 8, 8);
    }
}
__device__ __forceinline__ void phase_l1_stage2(const Params& p, unsigned char* lds) {
    for (int item = bid_(); item < 16 + 2048; item += gdim_()) {
        if (item < 16) lru_carry(p, item);
        else gqa_item(p, item - 16, lds);
    }
}
__device__ __forceinline__ void phase_l1_stage3(const Params& p, unsigned char* lds) {
    for (int item = bid_(); item < 2048; item += gdim_()) { const int cl = item & 63, blk = (item >> 6) & 7, b = item >> 9; lru_chunk(p, b, blk, cl + 4, 1, lds); }
}

__device__ __forceinline__ void phase_rowpass_mid(const Params& p, int l, unsigned char* lds) {
    unsigned char* const ws = ws_();
    float* R = (float*)lds;
    const int t = tid_(), lane = t & 63, w = t >> 6;
    const int nrows = l == 0 ? NTOK : NLAT;
    __syncthreads();
    constexpr int RS = D + 4;
    for (int i = t; i < D * NEXP; i += NT) { const int k = i >> 4, e = i & 15; R[e * RS + k] = p.moe_router[(size_t)l * D * NEXP + i]; }
    __syncthreads();
    const u16* Y = (const u16*)(ws + WS_Y);
    u16* XL1 = (u16*)(ws + WS_XL1);
    u16* H = (u16*)(ws + WS_H);
    float* AFF = (float*)(ws + WS_AFF);
    for (int row = bid_() * 8 + w; row < nrows; row += gdim_() * 8) {
        f32x4 v[8]; float ss = 0.f;
#pragma unroll
        for (int i = 0; i < 8; ++i) { const u32x2 q = *reinterpret_cast<const u32x2*>(Y + (size_t)row * D + (i * 64 + lane) * 4); v[i] = (f32x4){bf_lo(q[0]), bf_hi(q[0]), bf_lo(q[1]), bf_hi(q[1])}; ss += v[i][0] * v[i][0] + v[i][1] * v[i][1] + v[i][2] * v[i][2] + v[i][3] * v[i][3]; }
        ss = wave_sum(ss);
        const float rstd = rsqrtf(ss * (1.f / D) + 1e-6f);
        const float* xr = xin_row(p, row);
        const u16* xb = (const u16*)(ws + WS_XL2) + (size_t)row * D;
        const float* g1 = mod_ptr(ws, l, row, 2);
        const float* nw = p.norm_mix_post + (size_t)l * D;
        float ss1 = 0.f;
#pragma unroll
        for (int i = 0; i < 8; ++i) {
            const int col = (i * 64 + lane) * 4;
            f32x4 x4;
            if (l == 0) x4 = *reinterpret_cast<const f32x4*>(xr + col);
            else { const u32x2 q = *reinterpret_cast<const u32x2*>(xb + col); x4 = (f32x4){bf_lo(q[0]), bf_hi(q[0]), bf_lo(q[1]), bf_hi(q[1])}; }
            const f32x4 w4 = *reinterpret_cast<const f32x4*>(nw + col), g4 = *reinterpret_cast<const f32x4*>(g1 + col);
            const f32x4 x1 = x4 + g4 * (v[i] * rstd * w4);
            { const u32x2 pk1 = {pk_bf16(x1[0], x1[1]), pk_bf16(x1[2], x1[3])}; *reinterpret_cast<u32x2*>(XL1 + (size_t)row * D + col) = pk1; }
            v[i] = x1; ss1 += x1[0] * x1[0] + x1[1] * x1[1] + x1[2] * x1[2] + x1[3] * x1[3];
        }
        ss1 = wave_sum(ss1);
        const float rstd1 = rsqrtf(ss1 * (1.f / D) + 1e-6f);
        const float* sh = mod_ptr(ws, l, row, 3); const float* sc = mod_ptr(ws, l, row, 4);
        const float* nw2 = p.norm_ffn_pre + (size_t)l * D;
#pragma unroll
        for (int i = 0; i < 8; ++i) {
            const int col = (i * 64 + lane) * 4;
            const f32x4 w4 = *reinterpret_cast<const f32x4*>(nw2 + col), s4 = *reinterpret_cast<const f32x4*>(sc + col), h4 = *reinterpret_cast<const f32x4*>(sh + col);
            const f32x4 o = v[i] * rstd1 * w4 * (s4 + 1.f) + h4;
            *reinterpret_cast<unsigned*>((unsigned char*)H + (size_t)row * D + col) = pk_fp8x4(o[0] * F8_SH, o[1] * F8_SH, o[2] * F8_SH, o[3] * F8_SH);
            v[i] = o;
        }
        float lg[16];
        f32x2_t lg2[16];
#pragma unroll
        for (int e = 0; e < 16; ++e) lg2[e] = (f32x2_t){0.f, 0.f};
#pragma unroll
        for (int i = 0; i < 8; ++i) {
            const f32x2_t va = {v[i][0], v[i][1]}, vb = {v[i][2], v[i][3]};
#pragma unroll
            for (int e = 0; e < 16; ++e) {
                const f32x4 r4 = *reinterpret_cast<const f32x4*>(R + e * RS + (i * 64 + lane) * 4);
                lg2[e] = __builtin_elementwise_fma(va, (f32x2_t){r4[0], r4[1]}, lg2[e]);
                lg2[e] = __builtin_elementwise_fma(vb, (f32x2_t){r4[2], r4[3]}, lg2[e]);
            }
        }
#pragma unroll
        for (int e = 0; e < 16; ++e) lg[e] = lg2[e][0] + lg2[e][1];
        const bool b5 = lane & 32, b4 = lane & 16, b3 = lane & 8, b2 = lane & 4;
        float t8[8], t4[4], t2[2], lgt;
#pragma unroll
        for (int j = 0; j < 8; ++j) { const float keep = b5 ? lg[8 + j] : lg[j], send = b5 ? lg[j] : lg[8 + j]; t8[j] = keep + partner_x32(send); }
#pragma unroll
        for (int j = 0; j < 4; ++j) { const float keep = b4 ? t8[4 + j] : t8[j], send = b4 ? t8[j] : t8[4 + j]; t4[j] = keep + partner_x16(send); }
#pragma unroll
        for (int j = 0; j < 2; ++j) { const float keep = b3 ? t4[2 + j] : t4[j], send = b3 ? t4[j] : t4[2 + j]; t2[j] = keep + dpp_f<0x140>(send); }
        { const float keep = b2 ? t2[1] : t2[0], send = b2 ? t2[0] : t2[1]; lgt = keep + dpp_f<0x141>(send); }
        lgt += dpp_f<0x4E>(lgt); lgt += dpp_f<0xB1>(lgt);
        const float mx = wave_max(lgt);
        const float pe = __expf(lgt - mx);
        const float den = wave_sum(pe) * 0.25f;
        if ((lane & 3) == 0) AFF[(size_t)row * 16 + ((b5 ? 8 : 0) + (b4 ? 4 : 0) + (b3 ? 2 : 0) + (b2 ? 1 : 0))] = pe / den;
    }
}

__device__ __forceinline__ void phase_topk(const Params& p, int l, unsigned char* lds) {
    unsigned char* const ws = ws_();
    unsigned* keys = (unsigned*)lds;
    unsigned* hist = keys + 4096;
    unsigned* misc = hist + 256;
    const int t = tid_(), lane = t & 63, w = t >> 6;
    const float* AFF = (const float*)(ws + WS_AFF);
    int* SLOT = (int*)(ws + WS_SLOT);
    int* EROW = (int*)(ws + WS_EROW);
    float* EGATE = (float*)(ws + WS_EGATE);
    const int nitems = l == 0 ? 128 : 64;
    for (int item = bid_(); item < nitems; item += gdim_()) {
        const int kind = item >> 6, b = (item >> 4) & 3, ex = item & 15;
        const int n = kind ? LC : SEQ, cap = n / 8, rowbase = kind ? NLAT + b * LC : b * SEQ;
        __syncthreads();
        for (int i = t; i < n; i += NT) keys[i] = __float_as_uint(AFF[(size_t)(rowbase + i) * 16 + ex]);
        unsigned prefix = 0u, mask = 0u; int kth = cap;
        for (int shift = 24; shift >= 0; shift -= 8) {
            __syncthreads();
            if (t < 256) hist[t] = 0u;
            __syncthreads();
            for (int i = t; i < n; i += NT) { const unsigned k = keys[i]; if ((k & mask) == prefix) atomicAdd(&hist[(k >> shift) & 255u], 1u); }
            __syncthreads();
            if (t < 256) {
                unsigned above = 0u;
                for (int d2 = t + 1; d2 < 256; ++d2) above += hist[d2];
                const unsigned here = hist[t];
                if ((int)above < kth && (int)(above + here) >= kth) { misc[0] = (unsigned)t; misc[1] = (unsigned)(kth - (int)above); }
            }
            __syncthreads();
            prefix |= misc[0] << shift; mask |= 255u << shift; kth = (int)misc[1];
        }
        const unsigned T = prefix; const int need_eq = kth;
        int cgt = 0, ceq = 0;
        const int base = t * 8;
        if (base < n) {
#pragma unroll
            for (int q = 0; q < 8; ++q) { const unsigned k = keys[base + q]; cgt += (k > T); ceq += (k == T); }
        }
        int packed = cgt | (ceq << 16);
        int incl = packed;
#pragma unroll
        for (int o = 1; o < 64; o <<= 1) { const int nb = __shfl_up(incl, o, 64); if (lane >= o) incl += nb; }
        __syncthreads();
        if (lane == 63) misc[8 + w] = (unsigned)incl;
        __syncthreads();
        int woff = 0, total = 0;
#pragma unroll
        for (int q = 0; q < 8; ++q) { const int v = (int)misc[8 + q]; if (q < w) woff += v; total += v; }
        const int excl = woff + incl - packed;
        int pgt = excl & 0xffff, peq = excl >> 16;
        const int tot_gt = total & 0xffff;
        const int sbase = kind ? 2048 + b * 32 : b * 512;
        if (base < n) {
#pragma unroll
            for (int q = 0; q < 8; ++q) {
                const unsigned k = keys[base + q];
                const int row = rowbase + base + q;
                int pos = -1;
                if (k > T) { pos = pgt; ++pgt; }
                else if (k == T) { if (peq < need_eq) pos = tot_gt + peq; ++peq; }
                if (pos >= 0) { const int sl = sbase + pos; EROW[ex * EPAD + sl] = row; EGATE[ex * EPAD + sl] = __uint_as_float(k); SLOT[(size_t)row * 16 + ex] = sl; }
                else SLOT[(size_t)row * 16 + ex] = -1;
            }
        }
        if (kind == 1 && b == 3) for (int i = t; i < EPAD - 2176; i += NT) EROW[ex * EPAD + 2176 + i] = rowbase;
    }
}

__device__ __forceinline__ void phase_final(const Params& p, int l) {
    unsigned char* const ws = ws_();
    const int lane = tid_() & 63, w = __builtin_amdgcn_readfirstlane(tid_() >> 6);
    const int nrows = l == 0 ? NTOK : NLAT;
    const u16* YEXP = (const u16*)(ws + WS_YEXP);
    const int* SLOT = (const int*)(ws + WS_SLOT);
    const u16* XL1 = (const u16*)(ws + WS_XL1);
    u16* XL2 = (u16*)(ws + WS_XL2);
    u16* H = (u16*)(ws + WS_H);
    const int stride = gdim_() * 8;
    struct Pre { u32x2 xl[8], q0[8], q1[8]; };
    auto slots_of = [&](int row) -> int { const int s = SLOT[(size_t)min(row, nrows - 1) * 16 + (lane & 15)]; return (row < nrows && lane < 16) ? s : -1; };
    auto prefetch = [&](int row, int myslot, Pre& pr) {
        const int rc = min(row, nrows - 1);
        unsigned long long em = __ballot(myslot >= 0);
        const int e0 = em ? __builtin_ctzll(em) : 0; em &= em - 1;
        const int e1 = em ? __builtin_ctzll(em) : e0;
        const int sl0 = max(__shfl(myslot, e0, 64), 0), sl1 = max(__shfl(myslot, e1, 64), 0);
        const u16* y0 = YEXP + ((size_t)e0 * EPAD + sl0) * D; const u16* y1 = YEXP + ((size_t)e1 * EPAD + sl1) * D;
#pragma unroll
        for (int i = 0; i < 8; ++i) pr.xl[i] = *reinterpret_cast<const u32x2*>(XL1 + (size_t)rc * D + (i * 64 + lane) * 4);
#pragma unroll
        for (int i = 0; i < 8; ++i) { pr.q0[i] = *reinterpret_cast<const u32x2*>(y0 + (i * 64 + lane) * 4); pr.q1[i] = *reinterpret_cast<const u32x2*>(y1 + (i * 64 + lane) * 4); }
    };
    int row = bid_() * 8 + w;
    int slot_c = slots_of(row), slot_n = slots_of(row + stride);
    Pre cur; prefetch(row, slot_c, cur);
    for (; row < nrows; row += stride) {
        const int slot_nn = slots_of(row + 2 * stride);
        Pre nxt; prefetch(row + stride, slot_n, nxt);
        f32x4 v[8];
#pragma unroll
        for (int i = 0; i < 8; ++i) v[i] = (f32x4){0.f, 0.f, 0.f, 0.f};
        unsigned long long em = __ballot(slot_c >= 0);
        if (em) {
            em &= em - 1;
            const float f1 = em ? 1.f : 0.f;
            if (em) em &= em - 1;
#pragma unroll
            for (int i = 0; i < 8; ++i) {
                v[i][0] = bf_lo(cur.q0[i][0]) + f1 * bf_lo(cur.q1[i][0]); v[i][1] = bf_hi(cur.q0[i][0]) + f1 * bf_hi(cur.q1[i][0]);
                v[i][2] = bf_lo(cur.q0[i][1]) + f1 * bf_lo(cur.q1[i][1]); v[i][3] = bf_hi(cur.q0[i][1]) + f1 * bf_hi(cur.q1[i][1]);
            }
        }
        while (em) {
            const int e0 = __builtin_ctzll(em); em &= em - 1;
            const int sl0 = __shfl(slot_c, e0, 64);
            const u16* y0 = YEXP + ((size_t)e0 * EPAD + sl0) * D;
#pragma unroll
            for (int i = 0; i < 8; ++i) { const u32x2 q = *reinterpret_cast<const u32x2*>(y0 + (i * 64 + lane) * 4); v[i][0] += bf_lo(q[0]); v[i][1] += bf_hi(q[0]); v[i][2] += bf_lo(q[1]); v[i][3] += bf_hi(q[1]); }
        }
        float ss = 0.f;
#pragma unroll
        for (int i = 0; i < 8; ++i) ss += v[i][0] * v[i][0] + v[i][1] * v[i][1] + v[i][2] * v[i][2] + v[i][3] * v[i][3];
        ss = wave_sum(ss);
        const float rstd = rsqrtf(ss * (1.f / D) + 1e-6f);
        const float* g2 = mod_ptr(ws, l, row, 5);
        const float* nw = p.norm_ffn_post + (size_t)l * D;
        float ss2 = 0.f;
#pragma unroll
        for (int i = 0; i < 8; ++i) {
            const int col = (i * 64 + lane) * 4;
            const f32x4 x4 = {bf_lo(cur.xl[i][0]), bf_hi(cur.xl[i][0]), bf_lo(cur.xl[i][1]), bf_hi(cur.xl[i][1])};
            const f32x4 w4 = *reinterpret_cast<const f32x4*>(nw + col), g4 = *reinterpret_cast<const f32x4*>(g2 + col);
            const f32x4 x2 = x4 + g4 * (v[i] * rstd * w4);
            if (l == 0) { const u32x2 pk2 = {pk_bf16(x2[0], x2[1]), pk_bf16(x2[2], x2[3])}; *reinterpret_cast<u32x2*>(XL2 + (size_t)row * D + col) = pk2; }
            else *reinterpret_cast<f32x4*>(p.out + (size_t)row * D + col) = x2;
            v[i] = x2; ss2 += x2[0] * x2[0] + x2[1] * x2[1] + x2[2] * x2[2] + x2[3] * x2[3];
        }
        if (l == 0) {
            ss2 = wave_sum(ss2);
            const float rstd2 = rsqrtf(ss2 * (1.f / D) + 1e-6f);
            const float* sh = mod_ptr(ws, 1, row, 0); const float* sc = mod_ptr(ws, 1, row, 1);
            const float* nw1 = p.norm_mix_pre + D;
#pragma unroll
            for (int i = 0; i < 8; ++i) {
                const int col = (i * 64 + lane) * 4;
                const f32x4 w4 = *reinterpret_cast<const f32x4*>(nw1 + col), s4 = *reinterpret_cast<const f32x4*>(sc + col), h4 = *reinterpret_cast<const f32x4*>(sh + col);
                const f32x4 o = v[i] * rstd2 * w4 * (s4 + 1.f) + h4;
                u32x2 pk = {pk_bf16(o[0], o[1]), pk_bf16(o[2], o[3])};
                *reinterpret_cast<u32x2*>(H + (size_t)row * D + col) = pk;
            }
        }
        cur = nxt; slot_c = slot_n; slot_n = slot_nn;
    }
}

__global__ void __launch_bounds__(NT, 2) fwd_kernel(Params p) {
    unsigned char* lds = g_lds;
    unsigned char* wlds = lds + 512;
    if (threadIdx.x == 0) { *reinterpret_cast<uint4*>(lds) = make_uint4(0u, 0u, 0u, 0u); ((volatile LAS int*)(g_lds))[4] = (int)blockIdx.x; ((volatile LAS int*)(g_lds))[5] = (int)gridDim.x; *(volatile LAS unsigned long long*)((LAS unsigned char*)(g_lds) + 24) = (unsigned long long)p.ws; }
    if ((threadIdx.x & 63) == 0) ((volatile LAS int*)(g_lds))[8 + hw_slot_()] = threadIdx.x >> 6;
    __syncthreads();
    (void)xcd_barrier_post((unsigned*)(ws_() + WS_BAR), (volatile LAS unsigned*)lds);
#define GRID_BARRIER() do { XcdBarrier _b; _b.bar = (unsigned*)(ws_() + WS_BAR); _b.x = xb_xcc_id(); _b.st = (volatile LAS unsigned*)lds; xcd_barrier(_b); } while (0)
#ifndef PH_MASK
#define PH_MASK 0xFFFFFFFFu
#endif
#ifndef PROBE_REP_MASK
#define PROBE_REP_MASK 0u
#endif
#define PHASE(id, body) do { if (((PH_MASK >> ((id) % 32)) & 1u) && p.ph_lo <= (id) && (id) < p.ph_hi) { \
    for (int _r = 0; _r < ((((unsigned)PROBE_REP_MASK >> ((id) % 32)) & 1u) ? 2 : 1); ++_r) { body; if ((id) + 1 < p.ph_hi || _r == 0) { if ((id) + 1 < p.ph_hi) GRID_BARRIER(); } } } } while (0)
    PHASE(0, { phase_mod(p, wlds); phase_convert_dense(p, wlds); });
    PHASE(1, { phase_norm_mod(p, 0); lru_prep_weights(p); });
#pragma unroll
    for (int l = 0; l < 2; ++l) {
        const int pb = 2 + 10 * l;
        PHASE(pb + 0, phase_gemm_dense(p, (const u16*)(ws_() + WS_H), NTOK, (const u16*)(ws_() + (l == 0 ? WS_WT_ABIN : WS_WT_CDIN)), l == 0 ? AB_IN : CD_IN,
                                       (u16*)(ws_() + WS_P), l == 0 ? AB_IN : CD_IN, l == 0 ? (float*)(ws_() + WS_G) : nullptr, wlds));
        if (l == 0) {
            PHASE(pb + 1, phase_mlstm(p, wlds));
            PHASE(pb + 2, phase_l0_stage2(p, wlds));
        } else {
            PHASE(pb + 1, phase_l1_stage1(p, wlds));
            PHASE(pb + 2, phase_l1_stage2(p, wlds));
            PHASE(pb + 3, phase_l1_stage3(p, wlds));
        }
        PHASE(pb + 4, phase_gemm_dense(p, (const u16*)(ws_() + WS_YIN), l == 0 ? NTOK : NLAT, (const u16*)(ws_() + (l == 0 ? WS_WT_ABOUT : WS_WT_CDOUT)), D,
                                       (u16*)(ws_() + WS_Y), D, nullptr, wlds));
        PHASE(pb + 5, phase_rowpass_mid(p, l, wlds));
        PHASE(pb + 6, { phase_topk(p, l, wlds); phase_convert_moe(p, l, wlds); });
        PHASE(pb + 7, phase_moe_a(p, l, wlds));
        PHASE(pb + 8, phase_moe_b(p, l, wlds));
        PHASE(pb + 9, phase_final(p, l));
    }
}


#ifdef DBG_STOP
__global__ void dbg_digest(const unsigned char* ws, size_t off, int kind, size_t nelem, float* out, size_t nout) {
    for (size_t i = (size_t)blockIdx.x * blockDim.x + threadIdx.x; i < nout; i += (size_t)gridDim.x * blockDim.x) {
        float v = 0.f;
        for (size_t j = i; j < nelem; j += nout) {
            if (kind == 0) v += bf2f(((const u16*)(ws + off))[j]);
            else if (kind == 1) v += ((const float*)(ws + off))[j];
            else v += (float)((const int*)(ws + off))[j];
        }
        out[i] = v;
    }
}
#endif
extern "C" void kernel_launch(void* const* d_in, const int* in_sizes, int n_in, void* d_out, int out_size, void* d_ws, size_t ws_size, hipStream_t stream) {
    static int grid = 0;
    if (grid == 0) {
        if (n_in != 27 || ws_size < WS_END) { fprintf(stderr, "kernel_launch: unexpected n_in %d / ws %zu (need %zu)\n", n_in, ws_size, (size_t)WS_END); grid = -1; return; }
        int dev = 0, cus = 0, per_cu = 0;
        hipGetDevice(&dev);
        hipDeviceGetAttribute(&cus, hipDeviceAttributeMultiprocessorCount, dev);
        if (hipFuncSetAttribute((const void*)fwd_kernel, hipFuncAttributeMaxDynamicSharedMemorySize, LDS_BYTES) != hipSuccess) { fprintf(stderr, "kernel_launch: hipFuncSetAttribute failed\n"); grid = -1; return; }
        hipOccupancyMaxActiveBlocksPerMultiprocessor(&per_cu, (const void*)fwd_kernel, NT, LDS_BYTES);
        (void)hipGetLastError();
        if (per_cu < 1) fprintf(stderr, "kernel_launch: occupancy query reports %d blocks per CU\n", per_cu);
        grid = cus > 0 ? cus : 256;
    }
    if (grid < 0) return;
    hipMemsetAsync((char*)d_ws + WS_BAR, 0, XCD_BAR_WORDS * sizeof(unsigned), stream);
    Params p; memset(&p, 0, sizeof(p));
    const float** f = (const float**)&p;
    for (int i = 0; i < 27; ++i) f[i] = (const float*)d_in[i];
    p.out = (float*)d_out; p.ws = (unsigned char*)d_ws;
#if N_LAUNCH_MODE == 1
    p.ph_lo = 0; p.ph_hi = NPH;
    hipLaunchKernelGGL(fwd_kernel, dim3(grid), dim3(NT), LDS_BYTES, stream, p);
#else
#ifdef DBG_STOP
    for (int ph = 0; ph <= DBG_STOP; ++ph) { p.ph_lo = ph; p.ph_hi = ph + 1; hipLaunchKernelGGL(fwd_kernel, dim3(grid), dim3(NT), LDS_BYTES, stream, p); }
    hipLaunchKernelGGL(dbg_digest, dim3(2048), dim3(256), 0, stream, (const unsigned char*)d_ws, (size_t)DBG_OFF, (int)DBG_KIND, (size_t)DBG_NELEM, (float*)d_out, (size_t)out_size);
#else
    for (int ph = 0; ph < NPH; ++ph) { p.ph_lo = ph; p.ph_hi = ph + 1; hipLaunchKernelGGL(fwd_kernel, dim3(grid), dim3(NT), LDS_BYTES, stream, p); }
#endif
#endif
}
```

```cpp
#include <hip/hip_runtime.h>
#include <stdint.h>
#include <stdio.h>
#include <string.h>

#ifndef N_LAUNCH_MODE
#define N_LAUNCH_MODE 1
#endif

typedef unsigned short u16;
typedef short bf16x8 __attribute__((ext_vector_type(8)));
typedef float f32x4 __attribute__((ext_vector_type(4)));
typedef unsigned u32x4 __attribute__((ext_vector_type(4)));
typedef unsigned u32x2 __attribute__((ext_vector_type(2)));

#define NT 512
constexpr int D = 2048, BATCH = 4, SEQ = 4096, LC = 256;
constexpr int NLAT = BATCH * SEQ, NCTX = BATCH * LC, NTOK = NLAT + NCTX;
constexpr int AB_IN = 7184, CD_IN = 3584;
constexpr int NEXP = 16, FF = 2048, EPAD = 2304;
constexpr int NPH = 22;
constexpr int LDS_BYTES = 150 * 1024;

constexpr size_t al256(size_t x) { return (x + 255) & ~(size_t)255; }
constexpr size_t WS_BAR = 0;
constexpr size_t WS_MOD = 16384;
constexpr size_t WS_XL1 = al256(WS_MOD + 2 * 5 * 12288 * 4);
constexpr size_t WS_XL2 = al256(WS_XL1 + (size_t)NTOK * D * 4);
constexpr size_t WS_H = al256(WS_XL2 + (size_t)NTOK * D * 4);
constexpr size_t WS_P = al256(WS_H + (size_t)NTOK * D * 2);
constexpr size_t WS_G = al256(WS_P + (size_t)NTOK * AB_IN * 2);
constexpr size_t WS_HM = al256(WS_G + (size_t)NTOK * 16 * 4);
constexpr size_t WS_YIN = al256(WS_HM + (size_t)2 * NTOK * 1024 * 2);
constexpr size_t WS_Y = al256(WS_YIN + (size_t)NTOK * D * 2);
constexpr size_t WS_AFF = al256(WS_Y + (size_t)NTOK * D * 4);
constexpr size_t WS_SLOT = al256(WS_AFF + (size_t)NTOK * 16 * 4);
constexpr size_t WS_EROW = al256(WS_SLOT + (size_t)NTOK * 16 * 4);
constexpr size_t WS_EGATE = al256(WS_EROW + (size_t)NEXP * EPAD * 4);
constexpr size_t WS_ACT = al256(WS_EGATE + (size_t)NEXP * EPAD * 4);
constexpr size_t WS_YEXP = al256(WS_ACT + (size_t)NEXP * EPAD * FF * 2);
constexpr size_t WS_LRUS = al256(WS_YEXP + (size_t)NEXP * EPAD * D * 2);
constexpr size_t WS_LRUW = al256(WS_LRUS + (size_t)2 * 2 * 4 * 68 * 1024 * 4);
constexpr size_t WS_WT_ABIN = al256(WS_LRUW + (size_t)32 * 128 * 128 * 2);
constexpr size_t WS_WT_ABOUT = al256(WS_WT_ABIN + (size_t)AB_IN * D * 2);
constexpr size_t WS_WT_CDIN = al256(WS_WT_ABOUT + (size_t)D * D * 2);
constexpr size_t WS_WT_CDOUT = al256(WS_WT_CDIN + (size_t)CD_IN * D * 2);
constexpr size_t WS_WT_W1 = al256(WS_WT_CDOUT + (size_t)D * D * 2);
constexpr size_t WS_WT_W3 = al256(WS_WT_W1 + (size_t)NEXP * D * FF * 2);
constexpr size_t WS_WT_W2 = al256(WS_WT_W3 + (size_t)NEXP * D * FF * 2);
constexpr size_t WS_END = al256(WS_WT_W2 + (size_t)NEXP * D * FF * 2);

extern __shared__ __attribute__((aligned(16))) unsigned char g_lds[];

struct Params {
    const float *x, *c, *ctx, *c_ctx, *ada_w, *ada_b, *norm_mix_pre, *norm_mix_post, *norm_ffn_pre, *norm_ffn_post;
    const float *ab_w_in, *ab_w_out, *mlstm_gate_b, *mlstm_norm, *na_rpb;
    const float *cd_w_in, *cd_w_out, *gqa_sink, *lru_conv_w, *lru_conv_b, *lru_gate_w, *lru_gate_b, *lru_lambda;
    const float *moe_router, *moe_w1, *moe_w3, *moe_w2;
    float* out;
    unsigned char* ws;
    int ph_lo, ph_hi;
};

#define XB_TMO      128
#define XB_XCNT(j)  (256  + 64 * (j))
#define XB_XSUB(j)  (1280 + 64 * (j))
#define XB_XGEN(j)  (2304 + 64 * (j))
#define XB_TOP      3328
#define XB_TOPGEN   3392
#define XCD_BAR_WORDS 3456
#define XB_SPIN_CAP (1u << 22)
#define LAS __attribute__((address_space(3)))

__device__ __forceinline__ unsigned xb_ld(unsigned* p)              { return __hip_atomic_load(p, __ATOMIC_RELAXED, __HIP_MEMORY_SCOPE_AGENT); }
__device__ __forceinline__ unsigned xb_add(unsigned* p, unsigned v) { return __hip_atomic_fetch_add(p, v, __ATOMIC_RELAXED, __HIP_MEMORY_SCOPE_AGENT); }
__device__ __forceinline__ unsigned xb_xcc_id() { return (unsigned)__builtin_amdgcn_s_getreg((3 << 11) | 20) & 0xFu; }
#define XB_SPIN(cond, bar) do { unsigned _sp = 0; while (cond) { __builtin_amdgcn_s_sleep(1); \
    if ((++_sp & 255u) == 0u) { if (xb_ld(&(bar)[XB_TMO])) break; if (_sp > XB_SPIN_CAP) { atomicAdd(&(bar)[XB_TMO], 1u); break; } } } } while (0)

struct XcdBarrier {
    unsigned* bar; unsigned x;
    volatile LAS unsigned* st;
};
__device__ __forceinline__ XcdBarrier xcd_barrier_post(unsigned* bar, volatile LAS unsigned* st) {
    XcdBarrier b; b.bar = bar; b.x = xb_xcc_id(); b.st = st;
    if (threadIdx.x == 0) (void)xb_add(&bar[XB_XCNT(b.x)], 1u);
    return b;
}
__device__ __forceinline__ void xcd_barrier_complete(unsigned* bar, unsigned x, unsigned& nloc, unsigned& nx) {
    const unsigned G = gridDim.x * gridDim.y * gridDim.z;
    unsigned sum, cnt, mine, sp = 0u;
    for (;;) {
        sum = 0u; cnt = 0u; mine = 0u;
#pragma unroll
        for (unsigned j = 0; j < 16; ++j) { const unsigned c = xb_ld(&bar[XB_XCNT(j)]); sum += c; cnt += (c > 0u) ? 1u : 0u; mine = (j == x) ? c : mine; }
        if (sum == G) break;
        __builtin_amdgcn_s_sleep(1);
        if ((++sp & 255u) == 0u) { if (xb_ld(&bar[XB_TMO])) break; if (sp > XB_SPIN_CAP) { atomicAdd(&bar[XB_TMO], 1u); break; } }
    }
    nloc = mine > 0u ? mine : 1u; nx = cnt > 0u ? cnt : 1u;
}
__device__ __forceinline__ void xcd_barrier(const XcdBarrier& b) {
    asm volatile("s_waitcnt vmcnt(0)" ::: "memory");
    __syncthreads();
    if (threadIdx.x == 0) {
        unsigned* bar = b.bar;
        __builtin_amdgcn_s_waitcnt(0);
        unsigned nloc = b.st[0], nx = b.st[1];
        if (nloc == 0u) { xcd_barrier_complete(bar, b.x, nloc, nx); b.st[0] = nloc; b.st[1] = nx; }
        const unsigned old = xb_add(&bar[XB_XSUB(b.x)], 1u);
        const unsigned gen = old / nloc;
        if (old + 1u == (gen + 1u) * nloc) {
            __builtin_amdgcn_fence(__ATOMIC_RELEASE, "agent");
            asm volatile("s_waitcnt vmcnt(0)" ::: "memory");
            const unsigned og = xb_add(&bar[XB_TOP], 1u);
            const unsigned tg = og / nx;
            if (og + 1u == (tg + 1u) * nx) xb_add(&bar[XB_TOPGEN], 1u);
            else XB_SPIN(xb_ld(&bar[XB_TOPGEN]) == tg, bar);
            __builtin_amdgcn_fence(__ATOMIC_ACQUIRE, "agent");
            xb_add(&bar[XB_XGEN(b.x)], 1u);
            asm volatile("s_waitcnt vmcnt(0)" ::: "memory");
        } else {
            XB_SPIN(xb_ld(&bar[XB_XGEN(b.x)]) == gen, bar);
            __builtin_amdgcn_fence(__ATOMIC_ACQUIRE, "agent");
            asm volatile("s_waitcnt vmcnt(0)" ::: "memory");
        }
    }
    __syncthreads();
}

typedef float f32x2_t __attribute__((ext_vector_type(2)));
typedef __bf16 bf16x2_t __attribute__((ext_vector_type(2)));
__device__ __forceinline__ unsigned pk_bf16(float lo, float hi) { f32x2_t v = {lo, hi}; return __builtin_bit_cast(unsigned, __builtin_convertvector(v, bf16x2_t)); }
__device__ __forceinline__ float bf_lo(unsigned u) { return __uint_as_float(u << 16); }
__device__ __forceinline__ float bf_hi(unsigned u) { return __uint_as_float(u & 0xffff0000u); }
__device__ __forceinline__ float bf2f(u16 v) { return __uint_as_float(((unsigned)v) << 16); }
typedef int i32x4 __attribute__((ext_vector_type(4)));
typedef int i32x8 __attribute__((ext_vector_type(8)));
constexpr float F8_SW = 256.f, F8_SH = 8.f, F8_SA = 4.f;
__device__ __forceinline__ float f8_clamp(float x) { return __builtin_amdgcn_fmed3f(x, -448.f, 448.f); }
__device__ __forceinline__ unsigned pk_fp8x4(float a, float b, float c, float d) {
    unsigned r = 0u;
    r = (unsigned)__builtin_amdgcn_cvt_pk_fp8_f32(f8_clamp(a), f8_clamp(b), (int)r, false);
    r = (unsigned)__builtin_amdgcn_cvt_pk_fp8_f32(f8_clamp(c), f8_clamp(d), (int)r, true);
    return r; }
__device__ __forceinline__ i32x8 cat8(bf16x8 lo, bf16x8 hi) { return __builtin_shufflevector(__builtin_bit_cast(i32x4, lo), __builtin_bit_cast(i32x4, hi), 0, 1, 2, 3, 4, 5, 6, 7); }
__device__ __forceinline__ u16 f2bf(float f) { return (u16)(pk_bf16(f, 0.f) & 0xffffu); }
template <int CTRL> __device__ __forceinline__ float dpp_f(float v) { return __uint_as_float((unsigned)__builtin_amdgcn_update_dpp(0, (int)__float_as_uint(v), CTRL, 0xf, 0xf, true)); }
__device__ __forceinline__ float row_sum16(float v) { v += dpp_f<0xB1>(v); v += dpp_f<0x4E>(v); v += dpp_f<0x141>(v); v += dpp_f<0x140>(v); return v; }
__device__ __forceinline__ float row_max16(float v) { v = fmaxf(v, dpp_f<0xB1>(v)); v = fmaxf(v, dpp_f<0x4E>(v)); v = fmaxf(v, dpp_f<0x141>(v)); v = fmaxf(v, dpp_f<0x140>(v)); return v; }
__device__ __forceinline__ float rdlane_f(float v, int l) { return __uint_as_float((unsigned)__builtin_amdgcn_readlane((int)__float_as_uint(v), l)); }
__device__ __forceinline__ float sum_x16(float v) { const auto r = __builtin_amdgcn_permlane16_swap(__float_as_uint(v), __float_as_uint(v), false, false); return __uint_as_float(r[0]) + __uint_as_float(r[1]); }
__device__ __forceinline__ float sum_x32(float v) { const auto r = __builtin_amdgcn_permlane32_swap(__float_as_uint(v), __float_as_uint(v), false, false); return __uint_as_float(r[0]) + __uint_as_float(r[1]); }
__device__ __forceinline__ float max_x16(float v) { const auto r = __builtin_amdgcn_permlane16_swap(__float_as_uint(v), __float_as_uint(v), false, false); return fmaxf(__uint_as_float(r[0]), __uint_as_float(r[1])); }
__device__ __forceinline__ float max_x32(float v) { const auto r = __builtin_amdgcn_permlane32_swap(__float_as_uint(v), __float_as_uint(v), false, false); return fmaxf(__uint_as_float(r[0]), __uint_as_float(r[1])); }
__device__ __forceinline__ float partner_x16(float v) { const auto r = __builtin_amdgcn_permlane16_swap(__float_as_uint(v), __float_as_uint(v), false, false); return __uint_as_float(r[0] ^ r[1] ^ __float_as_uint(v)); }
__device__ __forceinline__ float partner_x32(float v) { const auto r = __builtin_amdgcn_permlane32_swap(__float_as_uint(v), __float_as_uint(v), false, false); return __uint_as_float(r[0] ^ r[1] ^ __float_as_uint(v)); }
__device__ __forceinline__ float wave_sum(float v) { return sum_x32(sum_x16(row_sum16(v))); }
__device__ __forceinline__ float wave_max(float v) { return max_x32(max_x16(row_max16(v))); }
__device__ __forceinline__ int hw_slot_() { return (int)(__builtin_amdgcn_s_getreg((5 << 11) | 4) & 63u); }
__device__ __forceinline__ int tid_() {
    int lane; asm volatile("v_mbcnt_lo_u32_b32 %0, -1, 0\n\tv_mbcnt_hi_u32_b32 %0, -1, %0" : "=v"(lane));
    const int w = ((volatile LAS int*)(g_lds))[8 + hw_slot_()];
    int t = __builtin_amdgcn_readfirstlane(w) * 64 + lane; asm volatile("" : "+v"(t)); return t; }
__device__ __forceinline__ int bid_() { unsigned o = 16; asm volatile("" : "+v"(o)); return __builtin_amdgcn_readfirstlane(*(const LAS int*)((LAS unsigned char*)(g_lds) + o)); }
__device__ __forceinline__ int gdim_() { unsigned o = 20; asm volatile("" : "+v"(o)); return __builtin_amdgcn_readfirstlane(*(const LAS int*)((LAS unsigned char*)(g_lds) + o)); }
__device__ __forceinline__ unsigned char* ws_() {
    unsigned o = 24; asm volatile("" : "+v"(o));
    const u32x2 v = *(const LAS u32x2*)((LAS unsigned char*)(g_lds) + o);
    const unsigned long long a = ((unsigned long long)(unsigned)__builtin_amdgcn_readfirstlane((int)v[1]) << 32) | (unsigned)__builtin_amdgcn_readfirstlane((int)v[0]);
    return (unsigned char*)(__attribute__((address_space(1))) unsigned char*)a; }
__device__ __forceinline__ float frcp_(float x) { return __builtin_amdgcn_rcpf(x); }
__device__ __forceinline__ float sigmoidf_(float x) { return frcp_(1.f + __expf(-x)); }
__device__ __forceinline__ f32x4 mfma16(bf16x8 a, bf16x8 b, f32x4 c) { return __builtin_amdgcn_mfma_f32_16x16x32_bf16(a, b, c, 0, 0, 0); }
__device__ __forceinline__ bf16x8 ld_frag_g(const u16* p) { return *reinterpret_cast<const bf16x8*>(p); }
__device__ __forceinline__ bf16x8 ld_frag_s(const u16* p) { return *reinterpret_cast<const bf16x8*>(p); }
__device__ __forceinline__ bf16x8 mk_frag(unsigned a, unsigned b, unsigned c, unsigned d) { u32x4 v = {a, b, c, d}; return __builtin_bit_cast(bf16x8, v); }

__device__ __forceinline__ const float* xin_row(const Params& p, int row) {
    return row < NLAT ? p.x + (size_t)row * D : p.ctx + (size_t)(row - NLAT) * D;
}
__device__ __forceinline__ const float* mod_ptr(const unsigned char* ws, int l, int row, int chunk) {
    const int bb = row < NLAT ? (row >> 12) : 4;
    return (const float*)(ws + WS_MOD) + ((size_t)(l * 5 + bb) * 6 + chunk) * D;
}

__device__ __forceinline__ void phase_mod(const Params& p, unsigned char* lds_raw) {
    unsigned char* const ws = ws_();
    float* scond = (float*)lds_raw;
    float* red = scond + 5 * D;
    const int t = tid_();
    for (int i = t; i < 5 * D; i += NT) { const int r = i >> 11, k = i & 2047; const float v = r < 4 ? p.c[r * D + k] : p.c_ctx[k]; scond[i] = v / (1.f + __expf(-v)); }
    __syncthreads();
    float* mod = (float*)(ws + WS_MOD);
    for (int item = bid_(); item < 192; item += gdim_()) {
        const int l = item / 96, col0 = (item % 96) * 128;
        const int kg = t >> 5, cl = (t & 31) * 4;
        f32x4 acc[5];
#pragma unroll
        for (int r = 0; r < 5; ++r) acc[r] = (f32x4){0.f, 0.f, 0.f, 0.f};
        const float* wp = p.ada_w + ((size_t)l * D + kg * 128) * (6 * D) + col0 + cl;
#pragma unroll 8
        for (int kk = 0; kk < 128; ++kk) {
            const f32x4 w = *reinterpret_cast<const f32x4*>(wp + (size_t)kk * (6 * D));
#pragma unroll
            for (int r = 0; r < 5; ++r) { const float s = scond[r * D + kg * 128 + kk]; acc[r] += w * s; }
        }
#pragma unroll
        for (int r = 0; r < 5; ++r) *reinterpret_cast<f32x4*>(red + (kg * 5 + r) * 128 + cl) = acc[r];
        __syncthreads();
        for (int o = t; o < 640; o += NT) {
            const int r = o >> 7, cc = o & 127;
            float s = p.ada_b[l * 6 * D + col0 + cc];
#pragma unroll
            for (int g = 0; g < 16; ++g) s += red[(g * 5 + r) * 128 + cc];
            mod[(size_t)(l * 5 + r) * 6 * D + col0 + cc] = s;
        }
        __syncthreads();
    }
}

__device__ __forceinline__ void phase_norm_mod(const Params& p, int l) {
    unsigned char* const ws = ws_();
    const int lane = tid_() & 63, w = tid_() >> 6;
    u16* H = (u16*)(ws + WS_H);
    for (int row = bid_() * 8 + w; row < NTOK; row += gdim_() * 8) {
        const float* xr = xin_row(p, row);
        f32x4 v[8]; float ss = 0.f;
#pragma unroll
        for (int i = 0; i < 8; ++i) { v[i] = *reinterpret_cast<const f32x4*>(xr + (i * 64 + lane) * 4); ss += v[i][0] * v[i][0] + v[i][1] * v[i][1] + v[i][2] * v[i][2] + v[i][3] * v[i][3]; }
        ss = wave_sum(ss);
        const float rstd = rsqrtf(ss * (1.f / D) + 1e-6f);
        const float* sh = mod_ptr(ws, l, row, 0); const float* sc = mod_ptr(ws, l, row, 1);
        const float* nw = p.norm_mix_pre + (size_t)l * D;
#pragma unroll
        for (int i = 0; i < 8; ++i) {
            const int col = (i * 64 + lane) * 4;
            const f32x4 w4 = *reinterpret_cast<const f32x4*>(nw + col), s4 = *reinterpret_cast<const f32x4*>(sc + col), h4 = *reinterpret_cast<const f32x4*>(sh + col);
            f32x4 o = v[i] * rstd * w4 * (s4 + 1.f) + h4;
            u32x2 pk = {pk_bf16(o[0], o[1]), pk_bf16(o[2], o[3])};
            *reinterpret_cast<u32x2*>(H + (size_t)row * D + col) = pk;
        }
    }
}

__device__ __forceinline__ void convert_item(const float* W, int N, u16* Wt, int kb, int nb, unsigned char* lds) {
    const int t = tid_(), lane = t & 63, w = t >> 6;
    const int n4 = lane * 4, k0 = kb * 64 + w * 8, n0 = nb * 256;
    int col = n0 + n4; if (col > N - 4) col = N - 4;
    f32x4 r8[8];
#pragma unroll
    for (int j = 0; j < 8; ++j) r8[j] = *reinterpret_cast<const f32x4*>(W + (size_t)(k0 + j) * N + col);
    __syncthreads();
#pragma unroll
    for (int jj = 0; jj < 4; ++jj) {
        u32x4 v = {pk_bf16(r8[0][jj], r8[1][jj]), pk_bf16(r8[2][jj], r8[3][jj]), pk_bf16(r8[4][jj], r8[5][jj]), pk_bf16(r8[6][jj], r8[7][jj])};
        const int r = n4 + jj;
        *reinterpret_cast<u32x4*>(lds + r * 128 + ((w ^ ((r >> 2) & 7)) << 4)) = v;
    }
    __syncthreads();
    const int c = t & 7;
#pragma unroll
    for (int i = 0; i < 4; ++i) {
        const int r = (t >> 3) + 64 * i;
        if (n0 + r < N) {
            const u32x4 v = *reinterpret_cast<const u32x4*>(lds + r * 128 + ((c ^ ((r >> 2) & 7)) << 4));
            *reinterpret_cast<u32x4*>(Wt + (size_t)(n0 + r) * 2048 + kb * 64 + c * 8) = v;
        }
    }
}
__device__ __forceinline__ void convert_item8(const float* W, unsigned char* Wt, int kb, int nb, unsigned char* lds) {
    const int t = tid_(), lane = t & 63, w = t >> 6;
    const int n4 = lane * 4, k0 = kb * 128 + w * 16, n0 = nb * 256;
    f32x4 r[16];
#pragma unroll
    for (int j = 0; j < 16; ++j) r[j] = *reinterpret_cast<const f32x4*>(W + (size_t)(k0 + j) * 2048 + n0 + n4);
    __syncthreads();
#pragma unroll
    for (int jj = 0; jj < 4; ++jj) {
        u32x4 v;
#pragma unroll
        for (int q = 0; q < 4; ++q) v[q] = pk_fp8x4(r[4 * q][jj] * F8_SW, r[4 * q + 1][jj] * F8_SW, r[4 * q + 2][jj] * F8_SW, r[4 * q + 3][jj] * F8_SW);
        const int rr = n4 + jj;
        *reinterpret_cast<u32x4*>(lds + rr * 128 + ((w ^ ((rr >> 2) & 7)) << 4)) = v;
    }
    __syncthreads();
    const int c = t & 7;
#pragma unroll
    for (int i = 0; i < 4; ++i) {
        const int rr = (t >> 3) + 64 * i;
        const u32x4 v = *reinterpret_cast<const u32x4*>(lds + rr * 128 + ((c ^ ((rr >> 2) & 7)) << 4));
        *reinterpret_cast<u32x4*>(Wt + (size_t)(n0 + rr) * 2048 + kb * 128 + c * 16) = v;
    }
}
__device__ __forceinline__ void convert_matrix_items(const float* W, int N, u16* Wt, int first, int count, unsigned char* lds) {
    const int nnb = (N + 255) / 256;
    for (int it = first; it < first + count; ++it) convert_item(W, N, Wt, it / nnb, it % nnb, lds);
}
__device__ __forceinline__ void phase_convert_dense(const Params& p, unsigned char* lds) {
    unsigned char* const ws = ws_();
    for (int item = bid_(); item < 1888; item += gdim_()) {
        if (item < 928) convert_item(p.ab_w_in, AB_IN, (u16*)(ws + WS_WT_ABIN), item / 29, item % 29, lds);
        else if (item < 1184) { const int it = item - 928; convert_item(p.ab_w_out, D, (u16*)(ws + WS_WT_ABOUT), it / 8, it % 8, lds); }
        else if (item < 1632) { const int it = item - 1184; convert_item(p.cd_w_in, CD_IN, (u16*)(ws + WS_WT_CDIN), it / 14, it % 14, lds); }
        else { const int it = item - 1632; convert_item(p.cd_w_out, D, (u16*)(ws + WS_WT_CDOUT), it / 8, it % 8, lds); }
    }
}
__device__ __forceinline__ void phase_convert_moe(const Params& p, int l, unsigned char* lds) {
    unsigned char* const ws = ws_();
    for (int item = bid_(); item < 3 * NEXP * 128; item += gdim_()) {
        const int which = item / (NEXP * 128), r = item % (NEXP * 128), ex = r >> 7, it = r & 127;
        const float* src = (which == 0 ? p.moe_w1 : (which == 1 ? p.moe_w3 : p.moe_w2)) + (size_t)(l * NEXP + ex) * D * FF;
        unsigned char* dst = ws + (which == 0 ? WS_WT_W1 : (which == 1 ? WS_WT_W3 : WS_WT_W2)) + (size_t)ex * D * FF;
        convert_item8(src, dst, it >> 3, it & 7, lds);
    }
}

__device__ __forceinline__ int g8_lds_byte(int r, int c) { const int st = (r >> 4) * 2 + (c >> 5), rr = r & 15, cc = c & 31, ob = rr * 64 + cc * 2; return st * 1024 + (ob ^ (((ob >> 9) & 1) << 5)); }
__device__ __forceinline__ void g8_stage_rc(int bb, int& R, int& C) { const int st = bb / 1024, sb = bb % 1024, swz = sb ^ (((sb >> 9) & 1) << 5); R = (st >> 1) * 16 + swz / 64; C = (st & 1) * 32 + (swz % 64) / 2; }
__device__ __forceinline__ int g8_perm32(int rho) { const int n = rho >> 4, i = rho & 15; return 8 * (i >> 2) + 4 * n + (i & 3); }

enum { EPI_BF16 = 0, EPI_SWIGLU = 2, EPI_SCALE = 3 };
struct GUnit { const char* a; const char* b0; const char* b1; const int* arow; int m0, n0, mvalid, ncols; u16* ob; int ldo; float* gates; const float* rscale; };
constexpr int G8_HTB = 128 * 64 * 2;
constexpr size_t G8_KSTEP = 128, G8_HSTEP = (size_t)128 * 2048 * 2;

template <int EPI>
__device__ __forceinline__ void g8_epilogue(const f32x4 (&acc)[2][2][4][2], const GUnit& u, int wr, int wc, int fr, int fq) {
#pragma unroll
    for (int ai = 0; ai < 2; ++ai)
#pragma unroll
        for (int m = 0; m < 4; ++m) {
            const int row = u.m0 + 128 * ai + 64 * wr + 16 * m + fr;
            if (row < u.mvalid) {
                if (EPI == EPI_BF16) {
#pragma unroll
                    for (int bj = 0; bj < 2; ++bj) {
                        const int col = u.n0 + 128 * bj + 32 * wc + 8 * fq;
                        if (col < u.ncols) {
                            const f32x4 v0 = acc[ai][bj][m][0], v1 = acc[ai][bj][m][1];
                            u32x4 pk = {pk_bf16(v0[0], v0[1]), pk_bf16(v0[2], v0[3]), pk_bf16(v1[0], v1[1]), pk_bf16(v1[2], v1[3])};
                            *reinterpret_cast<u32x4*>(u.ob + (size_t)row * u.ldo + col) = pk;
                            if (u.gates && col >= 4096 && col < 4112) { *reinterpret_cast<f32x4*>(u.gates + (size_t)row * 16 + (col - 4096)) = v0; *reinterpret_cast<f32x4*>(u.gates + (size_t)row * 16 + (col - 4096) + 4) = v1; }
                        }
                    }
                } else if (EPI == EPI_SWIGLU) {
                    const int col = u.n0 + 32 * wc + 8 * fq;
                    float a[8];
                    constexpr float si = 1.f / (F8_SH * F8_SW);
#pragma unroll
                    for (int n = 0; n < 2; ++n)
#pragma unroll
                        for (int q = 0; q < 4; ++q) { const float x = acc[ai][0][m][n][q] * si; a[n * 4 + q] = x * frcp_(1.f + __expf(-x)) * (acc[ai][1][m][n][q] * (si * F8_SA)); }
                    u32x2 pk = {pk_fp8x4(a[0], a[1], a[2], a[3]), pk_fp8x4(a[4], a[5], a[6], a[7])};
                    *reinterpret_cast<u32x2*>((unsigned char*)u.ob + (size_t)row * u.ldo + col) = pk;
                } else {
                    const float sc = u.rscale[row] * (1.f / (F8_SA * F8_SW));
#pragma unroll
                    for (int bj = 0; bj < 2; ++bj) {
                        const int col = u.n0 + 128 * bj + 32 * wc + 8 * fq;
                        const f32x4 v0 = acc[ai][bj][m][0] * sc, v1 = acc[ai][bj][m][1] * sc;
                        u32x4 pk = {pk_bf16(v0[0], v0[1]), pk_bf16(v0[2], v0[3]), pk_bf16(v1[0], v1[1]), pk_bf16(v1[2], v1[3])};
                        *reinterpret_cast<u32x4*>(u.ob + (size_t)row * u.ldo + col) = pk;
                    }
                }
            }
        }
}

template <int EPI, bool GATHER, class UnitFn>
__device__ __forceinline__ void gemm_phase8(unsigned char* lds, UnitFn next) {
    const int tid = tid_(), wid = __builtin_amdgcn_readfirstlane(tid >> 6), lane = tid & 63, wr = wid >> 2, wc = wid & 3, fr = lane & 15, fq = lane >> 4;
    constexpr bool F8 = (EPI != EPI_BF16);
    constexpr int nt = F8 ? 2048 / 128 : 2048 / 64;
    constexpr unsigned ROWB = F8 ? 2048u : 4096u;
    GUnit cur, nxt; int ui = 0;
    if (!next(0, cur)) return;
    int sR[2], sC[2];
#pragma unroll
    for (int i = 0; i < 2; ++i) g8_stage_rc(tid * 16 + i * 8192, sR[i], sC[i]);
    unsigned voffB[2];
#pragma unroll
    for (int i = 0; i < 2; ++i) voffB[i] = (unsigned)((sR[i] & ~31) + g8_perm32(sR[i] & 31)) * ROWB + (unsigned)sC[i] * 2u;
    unsigned voffA[2][2], voffAn[2][2];
    auto set_voffA = [&](const GUnit& u, unsigned (&vo)[2][2]) {
#pragma unroll
        for (int h = 0; h < 2; ++h)
#pragma unroll
            for (int i = 0; i < 2; ++i) {
                if (GATHER) vo[h][i] = (unsigned)u.arow[u.m0 + h * 128 + sR[i]] * ROWB + (unsigned)sC[i] * 2u;
                else vo[h][i] = (unsigned)(h * 128 + sR[i]) * ROWB + (unsigned)sC[i] * 2u;
            } };
    set_voffA(cur, voffA);
    const unsigned ldsw = (unsigned)wid * 1024u;
    const int aoff = g8_lds_byte(wr * 64 + fr, fq * 8), boff = g8_lds_byte(wc * 32 + fr, fq * 8);
#define G8_SA(b, h) (((b) * 2 + (h)) * G8_HTB)
#define G8_SB(b, h) ((4 + (b) * 2 + (h)) * G8_HTB)
#define G8_STAGE(bufoff, gbase, voff) do { _Pragma("unroll") for (int _i = 0; _i < 2; ++_i) \
        __builtin_amdgcn_global_load_lds((const unsigned*)((const char*)(gbase) + (voff)[_i]), (LAS unsigned*)(lds + (bufoff) + ldsw + _i * 8192), 16, 0, 0); } while (0)
#define G8_LDA(dst, b, h) do { _Pragma("unroll") for (int m = 0; m < 4; ++m) _Pragma("unroll") for (int k = 0; k < 2; ++k) dst[m][k] = *(const LAS bf16x8*)(lds + G8_SA(b, h) + aoff + m * 2048 + k * 1024); } while (0)
#define G8_LDB(dst, b, h) do { _Pragma("unroll") for (int n = 0; n < 2; ++n) _Pragma("unroll") for (int k = 0; k < 2; ++k) dst[n][k] = *(const LAS bf16x8*)(lds + G8_SB(b, h) + boff + n * 2048 + k * 1024); } while (0)
#define G8_MMA(ai, bj, At, Bt) do { __builtin_amdgcn_s_setprio(1); _Pragma("unroll") for (int m = 0; m < 4; ++m) _Pragma("unroll") for (int n = 0; n < 2; ++n) { \
        if (F8) { const i32x8 _b = cat8(Bt[n][0], Bt[n][1]), _a = cat8(At[m][0], At[m][1]); asm volatile("v_mfma_f32_16x16x128_f8f6f4 %0, %1, %2, %0" : "+v"(acc[ai][bj][m][n]) : "v"(_b), "v"(_a)); } \
        else { _Pragma("unroll") for (int k = 0; k < 2; ++k) acc[ai][bj][m][n] = __builtin_amdgcn_mfma_f32_16x16x32_bf16(Bt[n][k], At[m][k], acc[ai][bj][m][n], 0, 0, 0); } } \
        __builtin_amdgcn_s_setprio(0); } while (0)
#define G8_WAIT_V(n) asm volatile("s_waitcnt vmcnt(" #n ")" ::: "memory")
#define G8_WAIT_L(n) asm volatile("s_waitcnt lgkmcnt(" #n ")" ::: "memory")
#define G8_BAR __builtin_amdgcn_s_barrier()
#define G8_SCHED __builtin_amdgcn_sched_barrier(0)
    f32x4 acc[2][2][4][2];
#pragma unroll
    for (int a2 = 0; a2 < 2; ++a2)
#pragma unroll
        for (int b2 = 0; b2 < 2; ++b2)
#pragma unroll
            for (int m = 0; m < 4; ++m)
#pragma unroll
                for (int n = 0; n < 2; ++n) acc[a2][b2][m][n] = (f32x4){0.f, 0.f, 0.f, 0.f};
    bf16x8 At[4][2], B0[2][2], B1[2][2];
    const char* cA = cur.a; const char* cB0 = cur.b0; const char* cB1 = cur.b1;
    G8_STAGE(G8_SB(0, 0), cB0, voffB); G8_STAGE(G8_SA(0, 0), cA, voffA[0]); G8_STAGE(G8_SB(0, 1), cB1, voffB); G8_STAGE(G8_SA(0, 1), cA, voffA[1]);
    if (wr == 1) G8_BAR;
    G8_WAIT_V(4); G8_BAR;
    G8_STAGE(G8_SB(1, 0), cB0 + G8_KSTEP, voffB); G8_STAGE(G8_SA(1, 0), cA + G8_KSTEP, voffA[0]); G8_STAGE(G8_SB(1, 1), cB1 + G8_KSTEP, voffB);
    G8_WAIT_V(6); G8_BAR;
    for (;;) {
        const bool has_next = next(ui + 1, nxt);
        const char* nA = has_next ? nxt.a : cA; const char* nB0 = has_next ? nxt.b0 : cB0; const char* nB1 = has_next ? nxt.b1 : cB1;
        if (GATHER) { if (has_next) set_voffA(nxt, voffAn); else { _Pragma("unroll") for (int h = 0; h < 2; ++h) _Pragma("unroll") for (int i = 0; i < 2; ++i) voffAn[h][i] = voffA[h][i]; } }
        for (int t = 0; t < nt; t += 2) {
            const bool last = (t == nt - 2);
            const char* a1 = cA + (size_t)(t + 1) * G8_KSTEP;
            const char* a2 = last ? nA : cA + (size_t)(t + 2) * G8_KSTEP;
            const char* b20 = last ? nB0 : cB0 + (size_t)(t + 2) * G8_KSTEP; const char* b21 = last ? nB1 : cB1 + (size_t)(t + 2) * G8_KSTEP;
            const char* a3 = a2 + G8_KSTEP; const char* b30 = b20 + G8_KSTEP; const char* b31 = b21 + G8_KSTEP;
            unsigned vA2[2][2];
#pragma unroll
            for (int h = 0; h < 2; ++h)
#pragma unroll
                for (int i = 0; i < 2; ++i) vA2[h][i] = (GATHER && last) ? voffAn[h][i] : voffA[h][i];
            G8_LDB(B0, 0, 0); G8_SCHED; G8_LDA(At, 0, 0); G8_STAGE(G8_SA(1, 1), a1, voffA[1]);
            G8_WAIT_L(8); G8_BAR; G8_WAIT_L(0); G8_MMA(0, 0, At, B0); G8_BAR; G8_SCHED;
            G8_LDB(B1, 0, 1); G8_STAGE(G8_SB(0, 0), b20, voffB);
            G8_BAR; G8_WAIT_L(0); G8_MMA(0, 1, At, B1); G8_BAR;
            G8_LDA(At, 0, 1); G8_STAGE(G8_SA(0, 0), a2, vA2[0]);
            G8_BAR; G8_WAIT_L(0); G8_MMA(1, 0, At, B0); G8_BAR; G8_SCHED;
            G8_STAGE(G8_SB(0, 1), b21, voffB);
            G8_WAIT_V(6); G8_BAR; G8_MMA(1, 1, At, B1); G8_BAR;
            G8_LDB(B0, 1, 0); G8_SCHED; G8_LDA(At, 1, 0); G8_STAGE(G8_SA(0, 1), a2, vA2[1]);
            G8_WAIT_L(8); G8_BAR; G8_WAIT_L(0); G8_MMA(0, 0, At, B0); G8_BAR; G8_SCHED;
            G8_LDB(B1, 1, 1); G8_STAGE(G8_SB(1, 0), b30, voffB);
            G8_BAR; G8_WAIT_L(0); G8_MMA(0, 1, At, B1); G8_BAR;
            G8_LDA(At, 1, 1); G8_STAGE(G8_SA(1, 0), a3, vA2[0]);
            G8_BAR; G8_WAIT_L(0); G8_MMA(1, 0, At, B0); G8_BAR; G8_SCHED;
            G8_STAGE(G8_SB(1, 1), b31, voffB);
            G8_WAIT_V(6); G8_BAR; G8_MMA(1, 1, At, B1); G8_BAR;
        }
        if (F8) asm volatile("s_nop 15\n\ts_nop 15" ::: "memory");
        g8_epilogue<EPI>(acc, cur, wr, wc, fr, fq);
        if (!has_next) break;
#pragma unroll
        for (int a2 = 0; a2 < 2; ++a2)
#pragma unroll
            for (int b2 = 0; b2 < 2; ++b2)
#pragma unroll
                for (int m = 0; m < 4; ++m)
#pragma unroll
                    for (int n = 0; n < 2; ++n) acc[a2][b2][m][n] = (f32x4){0.f, 0.f, 0.f, 0.f};
        cur = nxt; cA = nA; cB0 = nB0; cB1 = nB1; ++ui;
        if (GATHER) { _Pragma("unroll") for (int h = 0; h < 2; ++h) _Pragma("unroll") for (int i = 0; i < 2; ++i) voffA[h][i] = voffAn[h][i]; }
    }
    G8_WAIT_V(0);
    if (wr == 0) G8_BAR;
    G8_BAR;
#undef G8_SA
#undef G8_SB
#undef G8_STAGE
#undef G8_LDA
#undef G8_LDB
#undef G8_MMA
#undef G8_WAIT_V
#undef G8_WAIT_L
#undef G8_BAR
#undef G8_SCHED
}

__device__ __forceinline__ void phase_gemm_dense(const Params& p, const u16* A, int M, const u16* Wt, int N, u16* ob, int ldo, float* gates, unsigned char* lds) {
    const int nM = M / 256, nN = (N + 255) / 256, L = nM * nN;
    const int xcd = bid_() & 7, slot = bid_() >> 3, nslot = gdim_() >> 3;
    const int base = (int)(((long)L * xcd) >> 3), cnt = (int)(((long)L * (xcd + 1)) >> 3) - base;
    const int G8n = nM >> 3, rem = nM & 7;
    auto next = [&](int i, GUnit& u) -> bool {
        const int k = slot + i * nslot;
        if (k >= cnt) return false;
        const int idx = base + k;
        int pn, pm;
        if (idx < G8n * 8 * nN) { const int gq = idx / (8 * nN), r = idx % (8 * nN); pn = r >> 3; pm = gq * 8 + (r & 7); }
        else { const int r = idx - G8n * 8 * nN; pn = r / rem; pm = G8n * 8 + r % rem; }
        u.a = (const char*)(A + (size_t)pm * 256 * 2048); u.b0 = (const char*)(Wt + (size_t)pn * 256 * 2048); u.b1 = u.b0 + G8_HSTEP; u.arow = nullptr;
        u.m0 = pm * 256; u.n0 = pn * 256; u.mvalid = M; u.ncols = N; u.ob = ob; u.ldo = ldo; u.gates = gates; u.rscale = nullptr;
        return true; };
    gemm_phase8<EPI_BF16, false>(lds, next);
}

__device__ __forceinline__ void phase_moe_a(const Params& p, int l, unsigned char* lds) {
    unsigned char* const ws = ws_();
    const int mvalid = l == 0 ? 2176 : 2048, nM = l == 0 ? 9 : 8;
    const int per_e = nM * 16;
    const int xcd = bid_() & 7, slot = bid_() >> 3, nslot = gdim_() >> 3;
    auto next = [&](int i, GUnit& u) -> bool {
        const int k = slot + i * nslot;
        if (k >= 2 * per_e) return false;
        const int tile = xcd * 2 * per_e + k;
        const int ex = tile / per_e, r = tile % per_e, pn = r / nM, pm = r % nM;
        u.a = (const char*)(ws + WS_H); u.arow = (const int*)(ws + WS_EROW) + ex * EPAD;
        u.b0 = (const char*)(ws + WS_WT_W1) + ((size_t)ex * FF + pn * 128) * D; u.b1 = (const char*)(ws + WS_WT_W3) + ((size_t)ex * FF + pn * 128) * D;
        u.m0 = pm * 256; u.n0 = pn * 128; u.mvalid = mvalid; u.ncols = FF; u.ob = (u16*)(ws + WS_ACT + (size_t)ex * EPAD * FF); u.ldo = FF; u.gates = nullptr; u.rscale = nullptr;
        return true; };
    gemm_phase8<EPI_SWIGLU, true>(lds, next);
}
__device__ __forceinline__ void phase_moe_b(const Params& p, int l, unsigned char* lds) {
    unsigned char* const ws = ws_();
    const int mvalid = l == 0 ? 2176 : 2048, nM = l == 0 ? 9 : 8;
    const int per_e = nM * 8;
    const int xcd = bid_() & 7, slot = bid_() >> 3, nslot = gdim_() >> 3;
    auto next = [&](int i, GUnit& u) -> bool {
        const int k = slot + i * nslot;
        if (k >= 2 * per_e) return false;
        const int tile = xcd * 2 * per_e + k;
        const int ex = tile / per_e, r = tile % per_e, pn = r / nM, pm = r % nM;
        u.a = (const char*)(ws + WS_ACT) + ((size_t)ex * EPAD + pm * 256) * FF; u.arow = nullptr;
        u.b0 = (const char*)(ws + WS_WT_W2) + ((size_t)ex * D + pn * 256) * FF; u.b1 = u.b0 + (size_t)128 * 2048;
        u.m0 = pm * 256; u.n0 = pn * 256; u.mvalid = mvalid; u.ncols = D; u.ob = (u16*)(ws + WS_YEXP) + (size_t)ex * EPAD * D; u.ldo = D; u.gates = nullptr;
        u.rscale = (const float*)(ws + WS_EGATE) + ex * EPAD;
        return true; };
    gemm_phase8<EPI_SCALE, false>(lds, next);
}

__device__ __forceinline__ int mlstm_row(int b, int dir, int pos) {
    if (pos < LC) return NLAT + b * LC + (dir ? (LC - 1 - pos) : pos);
    const int q = pos - LC; return b * SEQ + (dir ? (SEQ - 1 - q) : q);
}
__device__ __forceinline__ void phase_mlstm(const Params& p, unsigned char* lds) {
    unsigned char* const ws = ws_();
    u16* KT = (u16*)lds;
    u16* VT = KT + 256 * 72;
    u16* VWT = VT + 48 * 72;
    u16* CT = VWT + 48 * 72;
    u16* Ss = CT + 48 * 264;
    float* gB = (float*)(Ss + 64 * 72);
    float* gI = gB + 68 * 64;
    float* gP = gI + 68 * 64;
    float* gE = gP + 68 * 64;
    const int t = tid_(), lane = t & 63, w = t >> 6, fr = lane & 15, fq = lane >> 4;
    const u16* P = (const u16*)(ws + WS_P);
    const float* G = (const float*)(ws + WS_G);
    u16* HM = (u16*)(ws + WS_HM);
    for (int item = bid_(); item < 256; item += gdim_()) {
        const int combo = (item & 7) * 4 + (item >> 6), vs = (item >> 3) & 7, dir = combo & 1, hh = (combo >> 1) & 3, b = combo >> 3;
        __syncthreads();
        for (int i = t; i < 48 * 264; i += NT) CT[i] = 0;
        for (int i = t; i < 16 * 72; i += NT) { const int er = i / 72; VT[32 * 72 + i] = (er == 0) ? (u16)0x3f80 : (u16)0; VWT[32 * 72 + i] = 0; }
        {
            const float gb_i = p.mlstm_gate_b[(dir * 2 + 0) * 4 + hh], gb_f = p.mlstm_gate_b[(dir * 2 + 1) * 4 + hh];
            for (int ch = w; ch < 68; ch += 8) {
                const int row = mlstm_row(b, dir, ch * 64 + lane);
                const float gi = G[(size_t)row * 16 + dir * 8 + hh] + gb_i;
                const float gf = G[(size_t)row * 16 + dir * 8 + 4 + hh] + gb_f;
                const float lf = fminf(gf, 0.f) - log1pf(__expf(-fabsf(gf)));
                float bc = lf;
#pragma unroll
                for (int o = 1; o < 64; o <<= 1) { const float n = __shfl_up(bc, o, 64); if (lane >= o) bc += n; }
                float pm = gi - bc;
#pragma unroll
                for (int o = 1; o < 64; o <<= 1) { const float n = __shfl_up(pm, o, 64); if (lane >= o) pm = fmaxf(pm, n); }
                const float b63 = __shfl(bc, 63, 64);
                float gmax = b63 - bc + gi;
#pragma unroll
                for (int o = 32; o > 0; o >>= 1) gmax = fmaxf(gmax, __shfl_xor(gmax, o, 64));
                gB[ch * 64 + lane] = bc; gI[ch * 64 + lane] = gi; gP[ch * 64 + lane] = pm;
                if (lane == 0) { gE[ch * 2] = b63; gE[ch * 2 + 1] = gmax; }
            }
        }
        f32x4 Cacc[2][3];
#pragma unroll
        for (int i = 0; i < 2; ++i)
#pragma unroll
            for (int j = 0; j < 3; ++j) Cacc[i][j] = (f32x4){0.f, 0.f, 0.f, 0.f};
        float m_old = 0.f;
        const int jt = w & 3, sth = w >> 2;
        const int vs_s = t & 63, vs_eg = t >> 6;
        bf16x8 qf[8]; unsigned ktr[2][8]; u32x2 vraw;
        const int jq = jt * 16 + fr, jjq = dir ? 63 - jq : jq;
        const unsigned off_q = (unsigned)jjq * AB_IN + hh * 256 + fq * 8;
        const int jk0 = (sth * 2) * 16 + fr, jk1 = jk0 + 16;
        const unsigned off_k0 = (unsigned)(dir ? 63 - jk0 : jk0) * AB_IN + 1024 + hh * 256 + fq * 8;
        const unsigned off_k1 = (unsigned)(dir ? 63 - jk1 : jk1) * AB_IN + 1024 + hh * 256 + fq * 8;
        unsigned off_kt[2];
#pragma unroll
        for (int i = 0; i < 2; ++i) { const int mt = t + NT * i, d2 = (mt & 127) * 2, s8 = (mt >> 7) * 8; off_kt[i] = (unsigned)(dir ? 63 - s8 - 7 : s8) * AB_IN + 1024 + hh * 256 + d2; }
        const unsigned off_v = (unsigned)(dir ? 63 - vs_s : vs_s) * AB_IN + 2048 + hh * 256 + vs * 32 + vs_eg * 4;
        const unsigned off_h = (unsigned)jjq * 1024 + hh * 256 + vs * 32 + sth * 16 + 4 * fq;
#define ML_BASE(POS0) (P + (size_t)(dir ? mlstm_row(b, dir, (POS0)) - 63 : mlstm_row(b, dir, (POS0))) * AB_IN)
#define ML_LOAD_Q(POS0) do { const u16* _pc = ML_BASE(POS0); \
            _Pragma("unroll") for (int kk = 0; kk < 8; ++kk) qf[kk] = ld_frag_g(_pc + off_q + kk * 32); } while (0)
#define ML_LOAD_K(POS0, S2) do { const u16* _pc = ML_BASE(POS0); \
            _Pragma("unroll") for (int kk = 0; kk < 8; ++kk) kf[kk] = ld_frag_g(_pc + ((S2) ? off_k1 : off_k0) + kk * 32); } while (0)
#define ML_LOAD_KTV(POS0) do { const u16* _pc = ML_BASE(POS0); \
            _Pragma("unroll") for (int i = 0; i < 2; ++i) { \
                _Pragma("unroll") for (int q = 0; q < 8; ++q) ktr[i][q] = *reinterpret_cast<const unsigned*>(_pc + (size_t)((dir ? 7 - q : q) * AB_IN) + off_kt[i]); } \
            vraw = *reinterpret_cast<const u32x2*>(_pc + off_v); } while (0)
        ML_LOAD_Q(0); ML_LOAD_KTV(0);
        __syncthreads();
        for (int ch = 0; ch < 68; ++ch) {
            const int pos0 = ch * 64;
            const float* sb = gB + ch * 64; const float* sig = gI + ch * 64; const float* spm = gP + ch * 64;
            const float b63 = gE[ch * 2], m_new = fmaxf(b63 + m_old, gE[ch * 2 + 1]), decay = __expf(b63 + m_old - m_new);
            const int jg = jt * 16 + fr;
            const float bj = sb[jg], mj = bj + fmaxf(m_old, spm[jg]);
            auto s_tile = [&](int st) {
                f32x4 sv = (f32x4){0.f, 0.f, 0.f, 0.f};
                if (st <= jt) {
                    typedef short s16x4 __attribute__((ext_vector_type(4)));
                    const u16* kb = KT + (8 * fq + ((lane & 15) >> 2)) * 72 + st * 16 + 4 * (lane & 3);
#pragma unroll
                    for (int kk = 0; kk < 8; ++kk) {
                        const s16x4 lo = __builtin_amdgcn_ds_read_tr16_b64_v4i16((LAS s16x4*)(kb + kk * 32 * 72));
                        const s16x4 hi = __builtin_amdgcn_ds_read_tr16_b64_v4i16((LAS s16x4*)(kb + (kk * 32 + 4) * 72));
                        const bf16x8 kfr = {lo[0], lo[1], lo[2], lo[3], hi[0], hi[1], hi[2], hi[3]};
                        sv = mfma16(kfr, qf[kk], sv);
                    }
                }
                float pv[4];
#pragma unroll
                for (int q = 0; q < 4; ++q) {
                    const int sg = st * 16 + 4 * fq + q;
                    pv[q] = (sg <= jg) ? sv[q] * 0.0625f * __expf(bj - sb[sg] + sig[sg] - mj) : 0.f;
                }
                u32x2 pk = {pk_bf16(pv[0], pv[1]), pk_bf16(pv[2], pv[3])};
                *reinterpret_cast<u32x2*>(Ss + jg * 72 + st * 16 + 4 * fq) = pk;
            };
#pragma unroll
            for (int i = 0; i < 2; ++i) {
                const int mt = t + NT * i, d2 = (mt & 127) * 2, s8 = (mt >> 7) * 8;
                u32x4 lo = {(ktr[i][0] & 0xffffu) | (ktr[i][1] << 16), (ktr[i][2] & 0xffffu) | (ktr[i][3] << 16), (ktr[i][4] & 0xffffu) | (ktr[i][5] << 16), (ktr[i][6] & 0xffffu) | (ktr[i][7] << 16)};
                u32x4 hi = {(ktr[i][0] >> 16) | (ktr[i][1] & 0xffff0000u), (ktr[i][2] >> 16) | (ktr[i][3] & 0xffff0000u), (ktr[i][4] >> 16) | (ktr[i][5] & 0xffff0000u), (ktr[i][6] >> 16) | (ktr[i][7] & 0xffff0000u)};
                *reinterpret_cast<u32x4*>(KT + d2 * 72 + s8) = lo;
                *reinterpret_cast<u32x4*>(KT + (d2 + 1) * 72 + s8) = hi;
            }
            {
                const float wg = __expf(b63 - sb[vs_s] + sig[vs_s] - m_new) * 0.0625f;
                const float v0 = bf_lo(vraw[0]), v1 = bf_hi(vraw[0]), v2 = bf_lo(vraw[1]), v3 = bf_hi(vraw[1]);
                const int e0 = vs_eg * 4;
                VT[(e0 + 0) * 72 + vs_s] = (u16)(vraw[0] & 0xffffu); VT[(e0 + 1) * 72 + vs_s] = (u16)(vraw[0] >> 16);
                VT[(e0 + 2) * 72 + vs_s] = (u16)(vraw[1] & 0xffffu); VT[(e0 + 3) * 72 + vs_s] = (u16)(vraw[1] >> 16);
                VWT[(e0 + 0) * 72 + vs_s] = f2bf(v0 * wg); VWT[(e0 + 1) * 72 + vs_s] = f2bf(v1 * wg);
                VWT[(e0 + 2) * 72 + vs_s] = f2bf(v2 * wg); VWT[(e0 + 3) * 72 + vs_s] = f2bf(v3 * wg);
                if (t < 64) VWT[32 * 72 + t] = f2bf(wg);
            }
            if (ch + 1 < 68) ML_LOAD_KTV(pos0 + 64);
            __syncthreads();
            s_tile(sth * 2);
            s_tile(sth * 2 + 1);
            __syncthreads();
            {
                const float w_inter = __expf(bj + m_old - mj);
                f32x4 nacc[2];
#pragma unroll
                for (int z = 0; z < 2; ++z) {
                    const int et = z == 0 ? sth : 2;
                    f32x4 a = (f32x4){0.f, 0.f, 0.f, 0.f};
#pragma unroll
                    for (int kk = 0; kk < 8; ++kk) a = mfma16(ld_frag_s(CT + (et * 16 + fr) * 264 + kk * 32 + fq * 8), qf[kk], a);
                    nacc[z] = a * w_inter;
                }
                if (ch + 1 < 68) ML_LOAD_Q(pos0 + 64);
#pragma unroll
                for (int z = 0; z < 2; ++z) {
                    const int et = z == 0 ? sth : 2;
                    f32x4 a = nacc[z];
#pragma unroll
                    for (int k2 = 0; k2 < 2; ++k2) a = mfma16(ld_frag_s(VT + (et * 16 + fr) * 72 + k2 * 32 + fq * 8), ld_frag_s(Ss + jg * 72 + k2 * 32 + fq * 8), a);
                    nacc[z] = a;
                }
                const float den = __shfl(nacc[1][0], fr, 64);
                const float dd = fmaxf(fabsf(den), __expf(-mj));
                const float inv = 1.f / dd;
                u32x2 pk = {pk_bf16(nacc[0][0] * inv, nacc[0][1] * inv), pk_bf16(nacc[0][2] * inv, nacc[0][3] * inv)};
                *reinterpret_cast<u32x2*>(HM + ((size_t)dir * NTOK + (dir ? mlstm_row(b, dir, pos0) - 63 : mlstm_row(b, dir, pos0))) * 1024 + off_h) = pk;
            }
#pragma unroll
            for (int i = 0; i < 2; ++i)
#pragma unroll
                for (int et = 0; et < 3; ++et) {
                    f32x4 a = Cacc[i][et] * decay;
#pragma unroll
                    for (int k2 = 0; k2 < 2; ++k2) a = mfma16(ld_frag_s(KT + ((w * 2 + i) * 16 + fr) * 72 + k2 * 32 + fq * 8), ld_frag_s(VWT + (et * 16 + fr) * 72 + k2 * 32 + fq * 8), a);
                    Cacc[i][et] = a;
                }
            __syncthreads();
#pragma unroll
            for (int i = 0; i < 2; ++i)
#pragma unroll
                for (int et = 0; et < 3; ++et) {
                    const f32x4 a = Cacc[i][et];
                    u32x2 pk = {pk_bf16(a[0], a[1]), pk_bf16(a[2], a[3])};
                    *reinterpret_cast<u32x2*>(CT + (et * 16 + fr) * 264 + (w * 2 + i) * 16 + 4 * fq) = pk;
                }
            m_old = m_new;
        }
#undef ML_LOAD_Q
#undef ML_LOAD_K
#undef ML_LOAD_KTV
    }
}

__device__ __forceinline__ void mlstm_out_rows(const Params& p, int row0, int nrows) {
    unsigned char* const ws = ws_();
    const int lane = tid_() & 63, w = tid_() >> 6;
    const u16* P = (const u16*)(ws + WS_P);
    const u16* HM = (const u16*)(ws + WS_HM);
    u16* YIN = (u16*)(ws + WS_YIN);
    for (int r = w; r < nrows; r += 8) {
        const int row = row0 + r;
        const int c0 = lane * 16;
        float v[16]; float ss = 0.f;
#pragma unroll
        for (int h2 = 0; h2 < 2; ++h2) {
            const u32x4 a = *reinterpret_cast<const u32x4*>(HM + (size_t)row * 1024 + c0 + h2 * 8);
            const u32x4 bq = *reinterpret_cast<const u32x4*>(HM + ((size_t)NTOK + row) * 1024 + c0 + h2 * 8);
#pragma unroll
            for (int q = 0; q < 4; ++q) { v[h2 * 8 + 2 * q] = bf_lo(a[q]) + bf_lo(bq[q]); v[h2 * 8 + 2 * q + 1] = bf_hi(a[q]) + bf_hi(bq[q]); }
        }
#pragma unroll
        for (int q = 0; q < 16; ++q) ss += v[q] * v[q];
        ss += __shfl_xor(ss, 1, 64); ss += __shfl_xor(ss, 2, 64); ss += __shfl_xor(ss, 4, 64); ss += __shfl_xor(ss, 8, 64);
        const float rstd = rsqrtf(ss * (1.f / 256.f) + 1e-6f);
        unsigned o[8];
#pragma unroll
        for (int h2 = 0; h2 < 2; ++h2) {
            const u32x4 og = *reinterpret_cast<const u32x4*>(P + (size_t)row * AB_IN + 3072 + c0 + h2 * 8);
#pragma unroll
            for (int q = 0; q < 4; ++q) {
                const int c = c0 + h2 * 8 + 2 * q;
                const float y0 = v[h2 * 8 + 2 * q] * rstd * p.mlstm_norm[c] * sigmoidf_(bf_lo(og[q]));
                const float y1 = v[h2 * 8 + 2 * q + 1] * rstd * p.mlstm_norm[c + 1] * sigmoidf_(bf_hi(og[q]));
                o[h2 * 4 + q] = pk_bf16(y0, y1);
            }
        }
        *reinterpret_cast<u32x4*>(YIN + (size_t)row * D + c0) = (u32x4){o[0], o[1], o[2], o[3]};
        *reinterpret_cast<u32x4*>(YIN + (size_t)row * D + c0 + 8) = (u32x4){o[4], o[5], o[6], o[7]};
    }
}

template <int DH, class KeyFn, class BiasFn>
__device__ __forceinline__ void attn_wave(const u16* qptr, size_t qstride, int nblk, KeyFn keyfn, BiasFn biasfn, float scale,
                                           float m_init, float l_init, u16* vlds, u16* optr, size_t ostride) {
    constexpr int NK = DH / 32, NDT = DH / 16, VS = DH + 8, NV = DH / 16;
    const int lane = tid_() & 63, fr = lane & 15, fq = lane >> 4;
    bf16x8 qf[NK];
#pragma unroll
    for (int kk = 0; kk < NK; ++kk) qf[kk] = ld_frag_g(qptr + (size_t)fr * qstride + kk * 32 + fq * 8);
    f32x4 oacc[NDT];
#pragma unroll
    for (int i = 0; i < NDT; ++i) oacc[i] = (f32x4){0.f, 0.f, 0.f, 0.f};
    float m = m_init, l = l_init;
    bf16x8 kn[2][NK]; u32x4 vn[NV];
    auto load_blk = [&](int ib) {
        const u16* kptr; const u16* vptr; size_t kvs;
        (void)keyfn(ib, kptr, vptr, kvs);
#pragma unroll
        for (int st = 0; st < 2; ++st)
#pragma unroll
            for (int kk = 0; kk < NK; ++kk) kn[st][kk] = ld_frag_g(kptr + (size_t)(st * 16 + fr) * kvs + kk * 32 + fq * 8);
#pragma unroll
        for (int i = 0; i < NV; ++i) { const int cidx = lane + 64 * i, r = cidx / (DH / 8), cc = cidx % (DH / 8); vn[i] = *reinterpret_cast<const u32x4*>(vptr + (size_t)r * kvs + cc * 8); }
    };
    auto next_valid = [&](int ib) { const u16* a; const u16* b2; size_t c; while (ib < nblk && !keyfn(ib, a, b2, c)) ++ib; return ib; };
    int ib = next_valid(0);
    if (ib < nblk) load_blk(ib);
    while (ib < nblk) {
        bf16x8 kc[2][NK]; u32x4 vc[NV];
#pragma unroll
        for (int st = 0; st < 2; ++st)
#pragma unroll
            for (int kk = 0; kk < NK; ++kk) kc[st][kk] = kn[st][kk];
#pragma unroll
        for (int i = 0; i < NV; ++i) vc[i] = vn[i];
        const int ibn = next_valid(ib + 1);
        if (ibn < nblk) load_blk(ibn);
        asm volatile("" ::: "memory");
#pragma unroll
        for (int i = 0; i < NV; ++i) { const int cidx = lane + 64 * i, r = cidx / (DH / 8), cc = cidx % (DH / 8); *reinterpret_cast<u32x4*>(vlds + r * VS + cc * 8) = vc[i]; }
        f32x4 s[2];
#pragma unroll
        for (int st = 0; st < 2; ++st) {
            f32x4 a = (f32x4){0.f, 0.f, 0.f, 0.f};
#pragma unroll
            for (int kk = 0; kk < NK; ++kk) a = mfma16(kc[st][kk], qf[kk], a);
            s[st] = a;
        }
        float x[8]; float mx = -INFINITY;
#pragma unroll
        for (int st = 0; st < 2; ++st)
#pragma unroll
            for (int q = 0; q < 4; ++q) { const float v = s[st][q] * scale + biasfn(ib, fr, st * 16 + 4 * fq + q); x[st * 4 + q] = v; mx = fmaxf(mx, v); }
        mx = max_x32(max_x16(mx));
        const float m_new = fmaxf(m, mx);
        const float m_safe = (m_new == -INFINITY) ? 0.f : m_new;
        const float alpha = __expf(m - m_safe);
        float ps = 0.f; float pe[8];
#pragma unroll
        for (int q = 0; q < 8; ++q) { pe[q] = __expf(x[q] - m_safe); ps += pe[q]; }
        l = l * alpha + ps; m = m_new;
#pragma unroll
        for (int i = 0; i < NDT; ++i) oacc[i] *= alpha;
        const bf16x8 pf = mk_frag(pk_bf16(pe[0], pe[1]), pk_bf16(pe[2], pe[3]), pk_bf16(pe[4], pe[5]), pk_bf16(pe[6], pe[7]));
        asm volatile("s_waitcnt lgkmcnt(0)" ::: "memory");
        {
            typedef short s16x4 __attribute__((ext_vector_type(4)));
            const int tq = (lane & 15) >> 2, tp = lane & 3;
            const u16* vb0 = vlds + (4 * fq + tq) * VS + 4 * tp;
            const u16* vb1 = vb0 + 16 * VS;
#pragma unroll
            for (int dt = 0; dt < NDT; ++dt) {
                const s16x4 lo = __builtin_amdgcn_ds_read_tr16_b64_v4i16((LAS s16x4*)(vb0 + dt * 16));
                const s16x4 hi = __builtin_amdgcn_ds_read_tr16_b64_v4i16((LAS s16x4*)(vb1 + dt * 16));
                const bf16x8 vf = {lo[0], lo[1], lo[2], lo[3], hi[0], hi[1], hi[2], hi[3]};
                oacc[dt] = mfma16(vf, pf, oacc[dt]);
            }
        }
        asm volatile("" ::: "memory");
        ib = ibn;
    }
    l = sum_x32(sum_x16(l));
    const float inv = 1.f / l;
#pragma unroll
    for (int dt = 0; dt < NDT; ++dt) {
        const f32x4 o = oacc[dt] * inv;
        u32x2 pk = {pk_bf16(o[0], o[1]), pk_bf16(o[2], o[3])};
        *reinterpret_cast<u32x2*>(optr + (size_t)fr * ostride + dt * 16 + 4 * fq) = pk;
    }
}


template <int DH, class SlabFn, class SubFn, class BiasFn>
__device__ __forceinline__ void attn_block(const u16* qptr, size_t qstride, int nslab, SlabFn slabfn, SubFn subfn, BiasFn biasfn, float scale,
                                            float m_init, float l_init, unsigned char* lds, u16* optr, size_t ostride) {
    constexpr int NK = DH / 32, NDT = DH / 16, VS = DH + 8, NLD = DH / 64;
    constexpr int STAGE = 2 * 64 * VS * 2;
    const int t = tid_(), lane = t & 63, fr = lane & 15, fq = lane >> 4;
    bf16x8 qf[NK];
#pragma unroll
    for (int kk = 0; kk < NK; ++kk) qf[kk] = ld_frag_g(qptr + (size_t)fr * qstride + kk * 32 + fq * 8);
    f32x4 oacc[NDT];
#pragma unroll
    for (int i = 0; i < NDT; ++i) oacc[i] = (f32x4){0.f, 0.f, 0.f, 0.f};
    float m = m_init, l = l_init;
    u32x4 kreg[NLD], vreg[NLD];
    auto load_slab = [&](int i) {
        const u16* kp; const u16* vp; size_t kvs; slabfn(i, kp, vp, kvs);
#pragma unroll
        for (int q = 0; q < NLD; ++q) { const int c = t + NT * q, r = c / (DH / 8), cc = c % (DH / 8);
            kreg[q] = *reinterpret_cast<const u32x4*>(kp + (size_t)r * kvs + cc * 8); vreg[q] = *reinterpret_cast<const u32x4*>(vp + (size_t)r * kvs + cc * 8); } };
    auto store_slab = [&](int st) {
        u16* Ks = (u16*)(lds + st * STAGE); u16* Vs = Ks + 64 * VS;
#pragma unroll
        for (int q = 0; q < NLD; ++q) { const int c = t + NT * q, r = c / (DH / 8), cc = c % (DH / 8);
            *reinterpret_cast<u32x4*>(Ks + r * VS + cc * 8) = kreg[q]; *reinterpret_cast<u32x4*>(Vs + r * VS + cc * 8) = vreg[q]; } };
    __syncthreads();
    load_slab(0); store_slab(0);
    if (nslab > 1) load_slab(1);
    __syncthreads();
    for (int i = 0; i < nslab; ++i) {
        const int cur = i & 1;
        if (i + 1 < nslab) store_slab(cur ^ 1);
        if (i + 2 < nslab) load_slab(i + 2);
        const u16* Ks = (const u16*)(lds + cur * STAGE); const u16* Vs = Ks + 64 * VS;
#pragma unroll
        for (int j = 0; j < 2; ++j) {
            int off;
            if (!subfn(i, j, off)) continue;
            f32x4 s[2];
#pragma unroll
            for (int st = 0; st < 2; ++st) {
                f32x4 a = (f32x4){0.f, 0.f, 0.f, 0.f};
#pragma unroll
                for (int kk = 0; kk < NK; ++kk) a = mfma16(ld_frag_s(Ks + (off + st * 16 + fr) * VS + kk * 32 + fq * 8), qf[kk], a);
                s[st] = a;
            }
            float x[8]; float mx = -INFINITY;
#pragma unroll
            for (int st = 0; st < 2; ++st)
#pragma unroll
                for (int q = 0; q < 4; ++q) { const float v = s[st][q] * scale + biasfn(i, off, fr, st * 16 + 4 * fq + q); x[st * 4 + q] = v; mx = fmaxf(mx, v); }
            mx = max_x32(max_x16(mx));
            const float m_new = fmaxf(m, mx);
            const float m_safe = (m_new == -INFINITY) ? 0.f : m_new;
            const float alpha = __expf(m - m_safe);
            float ps = 0.f; float pe[8];
#pragma unroll
            for (int q = 0; q < 8; ++q) { pe[q] = __expf(x[q] - m_safe); ps += pe[q]; }
            l = l * alpha + ps; m = m_new;
#pragma unroll
            for (int dt = 0; dt < NDT; ++dt) oacc[dt] *= alpha;
            const bf16x8 pf = mk_frag(pk_bf16(pe[0], pe[1]), pk_bf16(pe[2], pe[3]), pk_bf16(pe[4], pe[5]), pk_bf16(pe[6], pe[7]));
            typedef short s16x4 __attribute__((ext_vector_type(4)));
            const int tq = (lane & 15) >> 2, tp = lane & 3;
            const u16* vb0 = Vs + (off + 4 * fq + tq) * VS + 4 * tp;
            const u16* vb1 = vb0 + 16 * VS;
#pragma unroll
            for (int dt = 0; dt < NDT; ++dt) {
                const s16x4 lo = __builtin_amdgcn_ds_read_tr16_b64_v4i16((LAS s16x4*)(vb0 + dt * 16));
                const s16x4 hi = __builtin_amdgcn_ds_read_tr16_b64_v4i16((LAS s16x4*)(vb1 + dt * 16));
                const bf16x8 vf = {lo[0], lo[1], lo[2], lo[3], hi[0], hi[1], hi[2], hi[3]};
                oacc[dt] = mfma16(vf, pf, oacc[dt]);
            }
        }
        __syncthreads();
    }
    l = sum_x32(sum_x16(l));
    const float inv = 1.f / l;
#pragma unroll
    for (int dt = 0; dt < NDT; ++dt) {
        const f32x4 o = oacc[dt] * inv;
        u32x2 pk = {pk_bf16(o[0], o[1]), pk_bf16(o[2], o[3])};
        *reinterpret_cast<u32x2*>(optr + (size_t)fr * ostride + dt * 16 + 4 * fq) = pk;
    }
}

__device__ __forceinline__ void phase_l0_stage2(const Params& p, unsigned char* lds) {
    unsigned char* const ws = ws_();
    const int w = tid_() >> 6;
    const u16* P = (const u16*)(ws + WS_P);
    u16* YIN = (u16*)(ws + WS_YIN);
    for (int item = bid_(); item < 1088 + 2176; item += gdim_()) {
        if (item < 1024) {
            const int r2 = item & 31, h = (item >> 5) & 7, b = item >> 8;
            const int rr = w >> 2, qt = w & 3, r = 2 * r2 + rr;
            const int r0 = min(max(r - 4, 0), 56);
            const int krow0 = min(max(2 * r2 - 4, 0), 56), nwin = min(max(2 * r2 + 1 - 4, 0), 56) + 8 - krow0;
            const int cb = qt == 0 ? 0 : (qt == 1 ? 8 : (qt == 2 ? 24 : 32));
            const int qrow = b * SEQ + r * 64 + qt * 16;
            const float* rpb = p.na_rpb + h * 15 * 31;
            auto slabfn = [&](int i, const u16*& kp, const u16*& vp, size_t& kvs) {
                const int row = i < nwin ? b * SEQ + (krow0 + i) * 64 : NLAT + b * LC + (i - nwin) * 64;
                kp = P + (size_t)row * AB_IN + 5136 + h * 128; vp = P + (size_t)row * AB_IN + 6160 + h * 128; kvs = AB_IN; };
            auto subfn = [&](int i, int j, int& off) -> bool {
                if (i < nwin) { off = cb; return j == 0 && (krow0 + i) >= r0 && (krow0 + i) < r0 + 8; }
                off = 32 * j; return true; };
            auto biasfn = [&](int i, int off, int qi, int ki) -> float {
                if (i >= nwin) return 0.f;
                const int c = qt * 16 + qi, kc = off + ki, c0 = min(max(c - 8, 0), 48);
                if (kc < c0 || kc >= c0 + 16) return -INFINITY;
                return rpb[(krow0 + i - r + 7) * 31 + (kc - c + 15)]; };
            attn_block<128>(P + (size_t)qrow * AB_IN + 4112 + h * 128, AB_IN, nwin + 4, slabfn, subfn, biasfn, 0.08838834764831845f, -INFINITY, 0.f, lds,
                            YIN + (size_t)qrow * D + 1024 + h * 128, D);
        } else if (item < 1088) {
            const int it = item - 1024, half = it & 1, h = (it >> 1) & 7, b = it >> 4;
            const int qrow = NLAT + b * LC + (half * 8 + w) * 16;
            auto slabfn = [&](int i, const u16*& kp, const u16*& vp, size_t& kvs) {
                const int row = NLAT + b * LC + i * 64;
                kp = P + (size_t)row * AB_IN + 5136 + h * 128; vp = P + (size_t)row * AB_IN + 6160 + h * 128; kvs = AB_IN; };
            auto subfn = [&](int, int j, int& off) -> bool { off = 32 * j; return true; };
            auto biasfn = [&](int, int, int, int) -> float { return 0.f; };
            attn_block<128>(P + (size_t)qrow * AB_IN + 4112 + h * 128, AB_IN, 4, slabfn, subfn, biasfn, 0.08838834764831845f, -INFINITY, 0.f, lds,
                            YIN + (size_t)qrow * D + 1024 + h * 128, D);
        } else {
            mlstm_out_rows(p, (item - 1088) * 8, 8);
        }
    }
}

__device__ __forceinline__ void rope_rows(const Params& p, int row0, int nrows) {
    unsigned char* const ws = ws_();
    const int lane = tid_() & 63, w = tid_() >> 6;
    u16* P = (u16*)(ws + WS_P);
    for (int r = w; r < nrows; r += 8) {
        const int row = row0 + r, tt = row & (SEQ - 1);
        const float prow = (float)(tt >> 6), pcol = (float)(tt & 63);
        for (int pi = lane; pi < 640; pi += 64) {
            const int head = pi >> 5, half = (pi >> 4) & 1, j = pi & 15;
            const int base = (head < 16 ? head * 64 : 1024 + (head - 16) * 64) + half * 32 + j;
            const float inv = exp2f(-(float)j * (13.287712379549449f / 16.f));
            const float ang = (half ? pcol : prow) * inv;
            float sn, cs; sincosf(ang, &sn, &cs);
            u16* q1 = P + (size_t)row * CD_IN + base;
            const float x1 = bf2f(q1[0]), x2 = bf2f(q1[16]);
            q1[0] = f2bf(x1 * cs - x2 * sn); q1[16] = f2bf(x2 * cs + x1 * sn);
        }
    }
}

__device__ __forceinline__ int lru_row(int b, int ci, int j) { return ci < 4 ? NLAT + b * LC + ci * 64 + j : b * SEQ + (ci - 4) * 64 + j; }
__device__ __forceinline__ void lru_chunk(const Params& p, int b, int blk, int ci, int mode, unsigned char* lds) {
    unsigned char* const ws = ws_();
    u16* ub = (u16*)lds;
    constexpr int SR = 132;
    float* sa = (float*)(ub + 64 * 136);
    float* sbt = sa + 64 * SR;
    float* sx = sbt + 64 * SR;
    const int t = tid_(), lane = t & 63, w = t >> 6, fr = lane & 15, fq = lane >> 4;
    const u16* P = (const u16*)(ws + WS_P);
    const u16* WT = (const u16*)(ws + WS_LRUW);
    float* SA = (float*)(ws + WS_LRUS);
    float* SH = SA + 2 * 4 * 68 * 1024;
    const int seglen = ci < 4 ? LC : SEQ, tt0 = ci < 4 ? ci * 64 : (ci - 4) * 64;
    const int rbase = ci < 4 ? NLAT + b * LC : b * SEQ;
    const int sc = t & 127, seg = t >> 7;
    const int chg_s = blk * 128 + sc;
    const int cg = blk * 128 + w * 16 + 4 * fq;
    bf16x8 wfa[2][2][4];
#pragma unroll
    for (int d2 = 0; d2 < 2; ++d2)
#pragma unroll
        for (int g2 = 0; g2 < 2; ++g2)
#pragma unroll
            for (int kk = 0; kk < 4; ++kk) wfa[d2][g2][kk] = ld_frag_g(WT + ((size_t)((d2 * 2 + g2) * 8 + blk) * 128 + w * 16 + fr) * 128 + fq * 8 + kk * 32);
    f32x4 gba[2][2], lama[2];
#pragma unroll
    for (int d2 = 0; d2 < 2; ++d2) {
        lama[d2] = *reinterpret_cast<const f32x4*>(p.lru_lambda + d2 * 1024 + cg);
#pragma unroll
        for (int g2 = 0; g2 < 2; ++g2) gba[d2][g2] = *reinterpret_cast<const f32x4*>(p.lru_gate_b + (d2 * 2 + g2) * 1024 + cg);
    }
    float carry[2] = {0.f, 0.f}; u16 grv[16];
    if (mode == 1) {
#pragma unroll
        for (int d2 = 0; d2 < 2; ++d2) carry[d2] = SH[((size_t)(d2 * 4 + b) * 68 + ci) * 1024 + chg_s];
#pragma unroll
        for (int s = 0; s < 16; ++s) grv[s] = P[(size_t)lru_row(b, ci, seg * 16 + s) * CD_IN + 2560 + chg_s];
    }
    __syncthreads();
    {
        const int c4 = (t & 31) * 4, j0 = (t >> 5) * 4, ch = blk * 128 + c4;
        float xv[7][4];
#pragma unroll
        for (int q = 0; q < 7; ++q) {
            const int tt = tt0 + j0 - 1 + q;
            if (tt >= 0 && tt < seglen) {
                const u32x2 v = *reinterpret_cast<const u32x2*>(P + (size_t)(rbase + tt) * CD_IN + 1536 + ch);
                xv[q][0] = bf_lo(v[0]); xv[q][1] = bf_hi(v[0]); xv[q][2] = bf_lo(v[1]); xv[q][3] = bf_hi(v[1]);
            } else { xv[q][0] = xv[q][1] = xv[q][2] = xv[q][3] = 0.f; }
        }
        f32x4 cw[4];
#pragma unroll
        for (int tp = 0; tp < 4; ++tp) cw[tp] = *reinterpret_cast<const f32x4*>(p.lru_conv_w + tp * 1024 + ch);
        const f32x4 cb = *reinterpret_cast<const f32x4*>(p.lru_conv_b + ch);
#pragma unroll
        for (int q = 0; q < 4; ++q) {
            float u[4];
#pragma unroll
            for (int cc = 0; cc < 4; ++cc) u[cc] = cb[cc] + xv[q][cc] * cw[0][cc] + xv[q + 1][cc] * cw[1][cc] + xv[q + 2][cc] * cw[2][cc] + xv[q + 3][cc] * cw[3][cc];
            u32x2 pk = {pk_bf16(u[0], u[1]), pk_bf16(u[2], u[3])};
            *reinterpret_cast<u32x2*>(ub + (j0 + q) * 136 + c4) = pk;
        }
    }
    __syncthreads();
    float hfw[16];
    for (int dir = 0; dir < 2; ++dir) {
        f32x4 av[4];
        {
            bf16x8 wf[4];
#pragma unroll
            for (int kk = 0; kk < 4; ++kk) wf[kk] = dir ? wfa[1][0][kk] : wfa[0][0][kk];
            const f32x4 gbv = dir ? gba[1][0] : gba[0][0];
            const f32x4 lamv = dir ? lama[1] : lama[0];
            float sp8[4];
#pragma unroll
            for (int q = 0; q < 4; ++q) { const float nl = -lamv[q]; sp8[q] = -8.f * (fmaxf(nl, 0.f) + __logf(1.f + __expf(-fabsf(nl)))); }
#pragma unroll
            for (int tt = 0; tt < 4; ++tt) {
                f32x4 z = (f32x4){0.f, 0.f, 0.f, 0.f};
#pragma unroll
                for (int kk = 0; kk < 4; ++kk) z = mfma16(wf[kk], ld_frag_s(ub + (tt * 16 + fr) * 136 + kk * 32 + fq * 8), z);
#pragma unroll
                for (int q = 0; q < 4; ++q) av[tt][q] = __expf(sigmoidf_(z[q] + gbv[q]) * sp8[q]);
            }
        }
        __syncthreads();
        {
            bf16x8 wf[4];
#pragma unroll
            for (int kk = 0; kk < 4; ++kk) wf[kk] = dir ? wfa[1][1][kk] : wfa[0][1][kk];
            const f32x4 gbv = dir ? gba[1][1] : gba[0][1];
#pragma unroll
            for (int tt = 0; tt < 4; ++tt) {
                f32x4 z = (f32x4){0.f, 0.f, 0.f, 0.f};
#pragma unroll
                for (int kk = 0; kk < 4; ++kk) z = mfma16(wf[kk], ld_frag_s(ub + (tt * 16 + fr) * 136 + kk * 32 + fq * 8), z);
                const int tj = tt * 16 + fr;
                const u32x2 uv = *reinterpret_cast<const u32x2*>(ub + tj * 136 + w * 16 + 4 * fq);
                const float u4[4] = {bf_lo(uv[0]), bf_hi(uv[0]), bf_lo(uv[1]), bf_hi(uv[1])};
                f32x4 bv;
#pragma unroll
                for (int q = 0; q < 4; ++q) { const float a = av[tt][q]; bv[q] = __builtin_amdgcn_sqrtf(fmaxf(1.f - a * a, 0.f)) * sigmoidf_(z[q] + gbv[q]) * u4[q]; }
                *reinterpret_cast<f32x4*>(sa + tj * SR + w * 16 + 4 * fq) = av[tt];
                *reinterpret_cast<f32x4*>(sbt + tj * SR + w * 16 + 4 * fq) = bv;
            }
        }
        __syncthreads();
        float A = 1.f, h = 0.f;
#pragma unroll
        for (int s = 0; s < 16; ++s) { const int j = seg * 16 + (dir ? 15 - s : s); const float a = sa[j * SR + sc]; h = a * h + sbt[j * SR + sc]; A *= a; }
        sx[(seg * 2 + 0) * 128 + sc] = A; sx[(seg * 2 + 1) * 128 + sc] = h;
        __syncthreads();
        const size_t sidx = ((size_t)(dir * 4 + b) * 68 + ci) * 1024 + chg_s;
        if (mode == 0) {
            if (seg == 0) {
                float At = 1.f, ht = 0.f;
#pragma unroll
                for (int s = 0; s < 4; ++s) { const int sg = dir ? 3 - s : s; const float a = sx[(sg * 2) * 128 + sc]; ht = a * ht + sx[(sg * 2 + 1) * 128 + sc]; At *= a; }
                SA[sidx] = At; SH[sidx] = ht;
            }
        } else {
            float hs = dir ? carry[1] : carry[0];
            const int nprev = dir ? 3 - seg : seg;
#pragma unroll
            for (int s = 0; s < 3; ++s) if (s < nprev) { const int sg = dir ? 3 - s : s; hs = sx[(sg * 2) * 128 + sc] * hs + sx[(sg * 2 + 1) * 128 + sc]; }
            u16* YIN = (u16*)(ws + WS_YIN);
            if (dir == 0) {
#pragma unroll
                for (int s = 0; s < 16; ++s) { const int j = seg * 16 + s; hs = sa[j * SR + sc] * hs + sbt[j * SR + sc]; hfw[s] = hs; }
            } else {
#pragma unroll
                for (int s = 0; s < 16; ++s) {
                    const int js = 15 - s, j = seg * 16 + js;
                    hs = sa[j * SR + sc] * hs + sbt[j * SR + sc];
                    const int row = lru_row(b, ci, j);
                    const float gr = bf2f(grv[js]);
                    const float th = 1.f - 2.f * frcp_(1.f + __expf(1.5957691216057308f * (gr + 0.044715f * gr * gr * gr)));
                    const float ge = 0.5f * gr * (1.f + th);
                    YIN[(size_t)row * D + 1024 + chg_s] = f2bf((hfw[js] + hs) * ge);
                }
            }
        }
    }
}

__device__ __forceinline__ void lru_prep_weights(const Params& p) {
    unsigned char* const ws = ws_();
    const int t = tid_();
    u16* WT = (u16*)(ws + WS_LRUW);
    for (int m = bid_(); m < 32; m += gdim_()) {
        const float* Wg = p.lru_gate_w + (size_t)m * 128 * 128;
        const int j4 = (t & 31) * 4, i8 = (t >> 5) * 8;
        f32x4 r8[8];
#pragma unroll
        for (int q = 0; q < 8; ++q) r8[q] = *reinterpret_cast<const f32x4*>(Wg + (size_t)(i8 + q) * 128 + j4);
#pragma unroll
        for (int jj = 0; jj < 4; ++jj) {
            u32x4 v = {pk_bf16(r8[0][jj], r8[1][jj]), pk_bf16(r8[2][jj], r8[3][jj]), pk_bf16(r8[4][jj], r8[5][jj]), pk_bf16(r8[6][jj], r8[7][jj])};
            *reinterpret_cast<u32x4*>(WT + ((size_t)m * 128 + j4 + jj) * 128 + i8) = v;
        }
    }
}
__device__ __forceinline__ void lru_carry(const Params& p, int item) {
    unsigned char* const ws = ws_();
    const int idx = item * NT + tid_();
    const int c = idx & 1023, b = (idx >> 10) & 3, dir = idx >> 12;
    float* SA = (float*)(ws + WS_LRUS);
    float* SH = SA + 2 * 4 * 68 * 1024;
    const size_t base = ((size_t)(dir * 4 + b) * 68) * 1024 + c;
    float h = 0.f;
#pragma unroll 4
    for (int s = 0; s < 68; ++s) {
        const int cj = dir == 0 ? s : (s < 4 ? 3 - s : 71 - s);
        const float a = SA[base + (size_t)cj * 1024], hl = SH[base + (size_t)cj * 1024];
        SH[base + (size_t)cj * 1024] = h;
        h = a * h + hl;
    }
}

__device__ __forceinline__ void gqa_item(const Params& p, int it, unsigned char* lds) {
    unsigned char* const ws = ws_();
    const int w = tid_() >> 6;
    const u16* P = (const u16*)(ws + WS_P);
    u16* YIN = (u16*)(ws + WS_YIN);
    const int t32 = it & 127, kvh = (it >> 7) & 3, b = it >> 9;
    const int hq = kvh * 4 + (w & 3), t0 = t32 * 32 + (w >> 2) * 16;
    const int kfirst = max((t32 * 32 - 128) & ~63, 0), klast = min(((t32 * 32 - 128) & ~63) + 256, SEQ - 64);
    const int nwin = (klast - kfirst) / 64 + 1;
    const int qrow = b * SEQ + t0;
    auto slabfn = [&](int i, const u16*& kp, const u16*& vp, size_t& kvs) {
        const int row = i < nwin ? b * SEQ + kfirst + i * 64 : NLAT + b * LC + (i - nwin) * 64;
        kp = P + (size_t)row * CD_IN + 1024 + kvh * 64; vp = P + (size_t)row * CD_IN + 1280 + kvh * 64; kvs = CD_IN; };
    auto subfn = [&](int i, int j, int& off) -> bool {
        off = 32 * j;
        if (i >= nwin) return true;
        const int k0 = kfirst + i * 64 + off;
        return k0 + 31 >= t0 - 128 && k0 <= t0 + 15 + 128; };
    auto biasfn = [&](int i, int off, int qi, int ki) -> float {
        if (i >= nwin) return 0.f;
        const int dq = (t0 + qi) - (kfirst + i * 64 + off + ki);
        return (dq > 128 || dq < -128) ? -INFINITY : 0.f; };
    const float sink = p.gqa_sink[hq];
    attn_block<64>(P + (size_t)qrow * CD_IN + hq * 64, CD_IN, nwin + 4, slabfn, subfn, biasfn, 0.125f, sink, ((tid_() & 63) >> 4) == 0 ? 1.f : 0.f, lds,
                   YIN + (size_t)qrow * D + hq * 64, D);
}

__device__ __forceinline__ void phase_l1_stage1(const Params& p, unsigned char* lds) {
    for (int item = bid_(); item < 2176 + 2048; item += gdim_()) {
        if (item < 2176) { const int ci = item % 68, blk = (item / 68) & 7, b = item / (68 * 8); lru_chunk(p, b, blk, ci, 0, lds); }
        else rope_rows(p, (item - 2176) * 8, 8);
    }
}
__device__ __forceinline__ void phase_l1_stage2(const Params& p, unsigned char* lds) {
    for (int item = bid_(); item < 16 + 2048; item += gdim_()) {
        if (item < 16) lru_carry(p, item);
        else gqa_item(p, item - 16, lds);
    }
}
__device__ __forceinline__ void phase_l1_stage3(const Params& p, unsigned char* lds) {
    for (int item = bid_(); item < 2048; item += gdim_()) { const int cl = item & 63, blk = (item >> 6) & 7, b = item >> 9; lru_chunk(p, b, blk, cl + 4, 1, lds); }
}

__device__ __forceinline__ void phase_rowpass_mid(const Params& p, int l, unsigned char* lds) {
    unsigned char* const ws = ws_();
    float* R = (float*)lds;
    const int t = tid_(), lane = t & 63, w = t >> 6;
    const int nrows = l == 0 ? NTOK : NLAT;
    __syncthreads();
    constexpr int RS = D + 4;
    for (int i = t; i < D * NEXP; i += NT) { const int k = i >> 4, e = i & 15; R[e * RS + k] = p.moe_router[(size_t)l * D * NEXP + i]; }
    __syncthreads();
    const u16* Y = (const u16*)(ws + WS_Y);
    u16* XL1 = (u16*)(ws + WS_XL1);
    u16* H = (u16*)(ws + WS_H);
    float* AFF = (float*)(ws + WS_AFF);
    for (int row = bid_() * 8 + w; row < nrows; row += gdim_() * 8) {
        f32x4 v[8]; float ss = 0.f;
#pragma unroll
        for (int i = 0; i < 8; ++i) { const u32x2 q = *reinterpret_cast<const u32x2*>(Y + (size_t)row * D + (i * 64 + lane) * 4); v[i] = (f32x4){bf_lo(q[0]), bf_hi(q[0]), bf_lo(q[1]), bf_hi(q[1])}; ss += v[i][0] * v[i][0] + v[i][1] * v[i][1] + v[i][2] * v[i][2] + v[i][3] * v[i][3]; }
        ss = wave_sum(ss);
        const float rstd = rsqrtf(ss * (1.f / D) + 1e-6f);
        const float* xr = xin_row(p, row);
        const u16* xb = (const u16*)(ws + WS_XL2) + (size_t)row * D;
        const float* g1 = mod_ptr(ws, l, row, 2);
        const float* nw = p.norm_mix_post + (size_t)l * D;
        float ss1 = 0.f;
#pragma unroll
        for (int i = 0; i < 8; ++i) {
            const int col = (i * 64 + lane) * 4;
            f32x4 x4;
            if (l == 0) x4 = *reinterpret_cast<const f32x4*>(xr + col);
            else { const u32x2 q = *reinterpret_cast<const u32x2*>(xb + col); x4 = (f32x4){bf_lo(q[0]), bf_hi(q[0]), bf_lo(q[1]), bf_hi(q[1])}; }
            const f32x4 w4 = *reinterpret_cast<const f32x4*>(nw + col), g4 = *reinterpret_cast<const f32x4*>(g1 + col);
            const f32x4 x1 = x4 + g4 * (v[i] * rstd * w4);
            { const u32x2 pk1 = {pk_bf16(x1[0], x1[1]), pk_bf16(x1[2], x1[3])}; *reinterpret_cast<u32x2*>(XL1 + (size_t)row * D + col) = pk1; }
            v[i] = x1; ss1 += x1[0] * x1[0] + x1[1] * x1[1] + x1[2] * x1[2] + x1[3] * x1[3];
        }
        ss1 = wave_sum(ss1);
        const float rstd1 = rsqrtf(ss1 * (1.f / D) + 1e-6f);
        const float* sh = mod_ptr(ws, l, row, 3); const float* sc = mod_ptr(ws, l, row, 4);
        const float* nw2 = p.norm_ffn_pre + (size_t)l * D;
#pragma unroll
        for (int i = 0; i < 8; ++i) {
            const int col = (i * 64 + lane) * 4;
            const f32x4 w4 = *reinterpret_cast<const f32x4*>(nw2 + col), s4 = *reinterpret_cast<const f32x4*>(sc + col), h4 = *reinterpret_cast<const f32x4*>(sh + col);
            const f32x4 o = v[i] * rstd1 * w4 * (s4 + 1.f) + h4;
            *reinterpret_cast<unsigned*>((unsigned char*)H + (size_t)row * D + col) = pk_fp8x4(o[0] * F8_SH, o[1] * F8_SH, o[2] * F8_SH, o[3] * F8_SH);
            v[i] = o;
        }
        float lg[16];
        f32x2_t lg2[16];
#pragma unroll
        for (int e = 0; e < 16; ++e) lg2[e] = (f32x2_t){0.f, 0.f};
#pragma unroll
        for (int i = 0; i < 8; ++i) {
            const f32x2_t va = {v[i][0], v[i][1]}, vb = {v[i][2], v[i][3]};
#pragma unroll
            for (int e = 0; e < 16; ++e) {
                const f32x4 r4 = *reinterpret_cast<const f32x4*>(R + e * RS + (i * 64 + lane) * 4);
                lg2[e] = __builtin_elementwise_fma(va, (f32x2_t){r4[0], r4[1]}, lg2[e]);
                lg2[e] = __builtin_elementwise_fma(vb, (f32x2_t){r4[2], r4[3]}, lg2[e]);
            }
        }
#pragma unroll
        for (int e = 0; e < 16; ++e) lg[e] = lg2[e][0] + lg2[e][1];
        const bool b5 = lane & 32, b4 = lane & 16, b3 = lane & 8, b2 = lane & 4;
        float t8[8], t4[4], t2[2], lgt;
#pragma unroll
        for (int j = 0; j < 8; ++j) { const float keep = b5 ? lg[8 + j] : lg[j], send = b5 ? lg[j] : lg[8 + j]; t8[j] = keep + partner_x32(send); }
#pragma unroll
        for (int j = 0; j < 4; ++j) { const float keep = b4 ? t8[4 + j] : t8[j], send = b4 ? t8[j] : t8[4 + j]; t4[j] = keep + partner_x16(send); }
#pragma unroll
        for (int j = 0; j < 2; ++j) { const float keep = b3 ? t4[2 + j] : t4[j], send = b3 ? t4[j] : t4[2 + j]; t2[j] = keep + dpp_f<0x140>(send); }
        { const float keep = b2 ? t2[1] : t2[0], send = b2 ? t2[0] : t2[1]; lgt = keep + dpp_f<0x141>(send); }
        lgt += dpp_f<0x4E>(lgt); lgt += dpp_f<0xB1>(lgt);
        const float mx = wave_max(lgt);
        const float pe = __expf(lgt - mx);
        const float den = wave_sum(pe) * 0.25f;
        if ((lane & 3) == 0) AFF[(size_t)row * 16 + ((b5 ? 8 : 0) + (b4 ? 4 : 0) + (b3 ? 2 : 0) + (b2 ? 1 : 0))] = pe / den;
    }
}

__device__ __forceinline__ void phase_topk(const Params& p, int l, unsigned char* lds) {
    unsigned char* const ws = ws_();
    unsigned* keys = (unsigned*)lds;
    unsigned* hist = keys + 4096;
    unsigned* misc = hist + 256;
    const int t = tid_(), lane = t & 63, w = t >> 6;
    const float* AFF = (const float*)(ws + WS_AFF);
    int* SLOT = (int*)(ws + WS_SLOT);
    int* EROW = (int*)(ws + WS_EROW);
    float* EGATE = (float*)(ws + WS_EGATE);
    const int nitems = l == 0 ? 128 : 64;
    for (int item = bid_(); item < nitems; item += gdim_()) {
        const int kind = item >> 6, b = (item >> 4) & 3, ex = item & 15;
        const int n = kind ? LC : SEQ, cap = n / 8, rowbase = kind ? NLAT + b * LC : b * SEQ;
        __syncthreads();
        for (int i = t; i < n; i += NT) keys[i] = __float_as_uint(AFF[(size_t)(rowbase + i) * 16 + ex]);
        unsigned prefix = 0u, mask = 0u; int kth = cap;
        for (int shift = 24; shift >= 0; shift -= 8) {
            __syncthreads();
            if (t < 256) hist[t] = 0u;
            __syncthreads();
            for (int i = t; i < n; i += NT) { const unsigned k = keys[i]; if ((k & mask) == prefix) atomicAdd(&hist[(k >> shift) & 255u], 1u); }
            __syncthreads();
            if (t < 256) {
                unsigned above = 0u;
                for (int d2 = t + 1; d2 < 256; ++d2) above += hist[d2];
                const unsigned here = hist[t];
                if ((int)above < kth && (int)(above + here) >= kth) { misc[0] = (unsigned)t; misc[1] = (unsigned)(kth - (int)above); }
            }
            __syncthreads();
            prefix |= misc[0] << shift; mask |= 255u << shift; kth = (int)misc[1];
        }
        const unsigned T = prefix; const int need_eq = kth;
        int cgt = 0, ceq = 0;
        const int base = t * 8;
        if (base < n) {
#pragma unroll
            for (int q = 0; q < 8; ++q) { const unsigned k = keys[base + q]; cgt += (k > T); ceq += (k == T); }
        }
        int packed = cgt | (ceq << 16);
        int incl = packed;
#pragma unroll
        for (int o = 1; o < 64; o <<= 1) { const int nb = __shfl_up(incl, o, 64); if (lane >= o) incl += nb; }
        __syncthreads();
        if (lane == 63) misc[8 + w] = (unsigned)incl;
        __syncthreads();
        int woff = 0, total = 0;
#pragma unroll
        for (int q = 0; q < 8; ++q) { const int v = (int)misc[8 + q]; if (q < w) woff += v; total += v; }
        const int excl = woff + incl - packed;
        int pgt = excl & 0xffff, peq = excl >> 16;
        const int tot_gt = total & 0xffff;
        const int sbase = kind ? 2048 + b * 32 : b * 512;
        if (base < n) {
#pragma unroll
            for (int q = 0; q < 8; ++q) {
                const unsigned k = keys[base + q];
                const int row = rowbase + base + q;
                int pos = -1;
                if (k > T) { pos = pgt; ++pgt; }
                else if (k == T) { if (peq < need_eq) pos = tot_gt + peq; ++peq; }
                if (pos >= 0) { const int sl = sbase + pos; EROW[ex * EPAD + sl] = row; EGATE[ex * EPAD + sl] = __uint_as_float(k); SLOT[(size_t)row * 16 + ex] = sl; }
                else SLOT[(size_t)row * 16 + ex] = -1;
            }
        }
        if (kind == 1 && b == 3) for (int i = t; i < EPAD - 2176; i += NT) EROW[ex * EPAD + 2176 + i] = rowbase;
    }
}

__device__ __forceinline__ void phase_final(const Params& p, int l) {
    unsigned char* const ws = ws_();
    const int lane = tid_() & 63, w = __builtin_amdgcn_readfirstlane(tid_() >> 6);
    const int nrows = l == 0 ? NTOK : NLAT;
    const u16* YEXP = (const u16*)(ws + WS_YEXP);
    const int* SLOT = (const int*)(ws + WS_SLOT);
    const u16* XL1 = (const u16*)(ws + WS_XL1);
    u16* XL2 = (u16*)(ws + WS_XL2);
    u16* H = (u16*)(ws + WS_H);
    const int stride = gdim_() * 8;
    struct Pre { u32x2 xl[8], q0[8], q1[8]; };
    auto slots_of = [&](int row) -> int { const int s = SLOT[(size_t)min(row, nrows - 1) * 16 + (lane & 15)]; return (row < nrows && lane < 16) ? s : -1; };
    auto prefetch = [&](int row, int myslot, Pre& pr) {
        const int rc = min(row, nrows - 1);
        unsigned long long em = __ballot(myslot >= 0);
        const int e0 = em ? __builtin_ctzll(em) : 0; em &= em - 1;
        const int e1 = em ? __builtin_ctzll(em) : e0;
        const int sl0 = max(__shfl(myslot, e0, 64), 0), sl1 = max(__shfl(myslot, e1, 64), 0);
        const u16* y0 = YEXP + ((size_t)e0 * EPAD + sl0) * D; const u16* y1 = YEXP + ((size_t)e1 * EPAD + sl1) * D;
#pragma unroll
        for (int i = 0; i < 8; ++i) pr.xl[i] = *reinterpret_cast<const u32x2*>(XL1 + (size_t)rc * D + (i * 64 + lane) * 4);
#pragma unroll
        for (int i = 0; i < 8; ++i) { pr.q0[i] = *reinterpret_cast<const u32x2*>(y0 + (i * 64 + lane) * 4); pr.q1[i] = *reinterpret_cast<const u32x2*>(y1 + (i * 64 + lane) * 4); }
    };
    int row = bid_() * 8 + w;
    int slot_c = slots_of(row), slot_n = slots_of(row + stride);
    Pre cur; prefetch(row, slot_c, cur);
    for (; row < nrows; row += stride) {
        const int slot_nn = slots_of(row + 2 * stride);
        Pre nxt; prefetch(row + stride, slot_n, nxt);
        f32x4 v[8];
#pragma unroll
        for (int i = 0; i < 8; ++i) v[i] = (f32x4){0.f, 0.f, 0.f, 0.f};
        unsigned long long em = __ballot(slot_c >= 0);
        if (em) {
            em &= em - 1;
            const float f1 = em ? 1.f : 0.f;
            if (em) em &= em - 1;
#pragma unroll
            for (int i = 0; i < 8; ++i) {
                v[i][0] = bf_lo(cur.q0[i][0]) + f1 * bf_lo(cur.q1[i][0]); v[i][1] = bf_hi(cur.q0[i][0]) + f1 * bf_hi(cur.q1[i][0]);
                v[i][2] = bf_lo(cur.q0[i][1]) + f1 * bf_lo(cur.q1[i][1]); v[i][3] = bf_hi(cur.q0[i][1]) + f1 * bf_hi(cur.q1[i][1]);
            }
        }
        while (em) {
            const int e0 = __builtin_ctzll(em); em &= em - 1;
            const int sl0 = __shfl(slot_c, e0, 64);
            const u16* y0 = YEXP + ((size_t)e0 * EPAD + sl0) * D;
#pragma unroll
            for (int i = 0; i < 8; ++i) { const u32x2 q = *reinterpret_cast<const u32x2*>(y0 + (i * 64 + lane) * 4); v[i][0] += bf_lo(q[0]); v[i][1] += bf_hi(q[0]); v[i][2] += bf_lo(q[1]); v[i][3] += bf_hi(q[1]); }
        }
        float ss = 0.f;
#pragma unroll
        for (int i = 0; i < 8; ++i) ss += v[i][0] * v[i][0] + v[i][1] * v[i][1] + v[i][2] * v[i][2] + v[i][3] * v[i][3];
        ss = wave_sum(ss);
        const float rstd = rsqrtf(ss * (1.f / D) + 1e-6f);
        const float* g2 = mod_ptr(ws, l, row, 5);
        const float* nw = p.norm_ffn_post + (size_t)l * D;
        float ss2 = 0.f;
#pragma unroll
        for (int i = 0; i < 8; ++i) {
            const int col = (i * 64 + lane) * 4;
            const f32x4 x4 = {bf_lo(cur.xl[i][0]), bf_hi(cur.xl[i][0]), bf_lo(cur.xl[i][1]), bf_hi(cur.xl[i][1])};
            const f32x4 w4 = *reinterpret_cast<const f32x4*>(nw + col), g4 = *reinterpret_cast<const f32x4*>(g2 + col);
            const f32x4 x2 = x4 + g4 * (v[i] * rstd * w4);
            if (l == 0) { const u32x2 pk2 = {pk_bf16(x2[0], x2[1]), pk_bf16(x2[2], x2[3])}; *reinterpret_cast<u32x2*>(XL2 + (size_t)row * D + col) = pk2; }
            else *reinterpret_cast<f32x4*>(p.out + (size_t)row * D + col) = x2;
            v[i] = x2; ss2 += x2[0] * x2[0] + x2[1] * x2[1] + x2[2] * x2[2] + x2[3] * x2[3];
        }
        if (l == 0) {
            ss2 = wave_sum(ss2);
            const float rstd2 = rsqrtf(ss2 * (1.f / D) + 1e-6f);
            const float* sh = mod_ptr(ws, 1, row, 0); const float* sc = mod_ptr(ws, 1, row, 1);
            const float* nw1 = p.norm_mix_pre + D;
#pragma unroll
            for (int i = 0; i < 8; ++i) {
                const int col = (i * 64 + lane) * 4;
                const f32x4 w4 = *reinterpret_cast<const f32x4*>(nw1 + col), s4 = *reinterpret_cast<const f32x4*>(sc + col), h4 = *reinterpret_cast<const f32x4*>(sh + col);
                const f32x4 o = v[i] * rstd2 * w4 * (s4 + 1.f) + h4;
                u32x2 pk = {pk_bf16(o[0], o[1]), pk_bf16(o[2], o[3])};
                *reinterpret_cast<u32x2*>(H + (size_t)row * D + col) = pk;
            }
        }
        cur = nxt; slot_c = slot_n; slot_n = slot_nn;
    }
}

__global__ void __launch_bounds__(NT, 2) fwd_kernel(Params p) {
    unsigned char* lds = g_lds;
    unsigned char* wlds = lds + 512;
    if (threadIdx.x == 0) { *reinterpret_cast<uint4*>(lds) = make_uint4(0u, 0u, 0u, 0u); ((volatile LAS int*)(g_lds))[4] = (int)blockIdx.x; ((volatile LAS int*)(g_lds))[5] = (int)gridDim.x; *(volatile LAS unsigned long long*)((LAS unsigned char*)(g_lds) + 24) = (unsigned long long)p.ws; }
    if ((threadIdx.x & 63) == 0) ((volatile LAS int*)(g_lds))[8 + hw_slot_()] = threadIdx.x >> 6;
    __syncthreads();
    (void)xcd_barrier_post((unsigned*)(ws_() + WS_BAR), (volatile LAS unsigned*)lds);
#define GRID_BARRIER() do { XcdBarrier _b; _b.bar = (unsigned*)(ws_() + WS_BAR); _b.x = xb_xcc_id(); _b.st = (volatile LAS unsigned*)lds; xcd_barrier(_b); } while (0)
#ifndef PH_MASK
#define PH_MASK 0xFFFFFFFFu
#endif
#ifndef PROBE_REP_MASK
#define PROBE_REP_MASK 0u
#endif
#define PHASE(id, body) do { if (((PH_MASK >> ((id) % 32)) & 1u) && p.ph_lo <= (id) && (id) < p.ph_hi) { \
    for (int _r = 0; _r < ((((unsigned)PROBE_REP_MASK >> ((id) % 32)) & 1u) ? 2 : 1); ++_r) { body; if ((id) + 1 < p.ph_hi || _r == 0) { if ((id) + 1 < p.ph_hi) GRID_BARRIER(); } } } } while (0)
    PHASE(0, { phase_mod(p, wlds); phase_convert_dense(p, wlds); });
    PHASE(1, { phase_norm_mod(p, 0); lru_prep_weights(p); });
#pragma unroll
    for (int l = 0; l < 2; ++l) {
        const int pb = 2 + 10 * l;
        PHASE(pb + 0, phase_gemm_dense(p, (const u16*)(ws_() + WS_H), NTOK, (const u16*)(ws_() + (l == 0 ? WS_WT_ABIN : WS_WT_CDIN)), l == 0 ? AB_IN : CD_IN,
                                       (u16*)(ws_() + WS_P), l == 0 ? AB_IN : CD_IN, l == 0 ? (float*)(ws_() + WS_G) : nullptr, wlds));
        if (l == 0) {
            PHASE(pb + 1, phase_mlstm(p, wlds));
            PHASE(pb + 2, phase_l0_stage2(p, wlds));
        } else {
            PHASE(pb + 1, phase_l1_stage1(p, wlds));
            PHASE(pb + 2, phase_l1_stage2(p, wlds));
            PHASE(pb + 3, phase_l1_stage3(p, wlds));
        }
        PHASE(pb + 4, phase_gemm_dense(p, (const u16*)(ws_() + WS_YIN), l == 0 ? NTOK : NLAT, (const u16*)(ws_() + (l == 0 ? WS_WT_ABOUT : WS_WT_CDOUT)), D,
                                       (u16*)(ws_() + WS_Y), D, nullptr, wlds));
        PHASE(pb + 5, phase_rowpass_mid(p, l, wlds));
        PHASE(pb + 6, { phase_topk(p, l, wlds); phase_convert_moe(p, l, wlds); });
        PHASE(pb + 7, phase_moe_a(p, l, wlds));
        PHASE(pb + 8, phase_moe_b(p, l, wlds));
        PHASE(pb + 9, phase_final(p, l));
    }
}


#ifdef DBG_STOP
__global__ void dbg_digest(const unsigned char* ws, size_t off, int kind, size_t nelem, float* out, size_t nout) {
    for (size_t i = (size_t)blockIdx.x * blockDim.x + threadIdx.x; i < nout; i += (size_t)gridDim.x * blockDim.x) {
        float v = 0.f;
        for (size_t j = i; j < nelem; j += nout) {
            if (kind == 0) v += bf2f(((const u16*)(ws + off))[j]);
            else if (kind == 1) v += ((const float*)(ws + off))[j];
            else v += (float)((const int*)(ws + off))[j];
        }
        out[i] = v;
    }
}
#endif
extern "C" void kernel_launch(void* const* d_in, const int* in_sizes, int n_in, void* d_out, int out_size, void* d_ws, size_t ws_size, hipStream_t stream) {
    static int grid = 0;
    if (grid == 0) {
        if (n_in != 27 || ws_size < WS_END) { fprintf(stderr, "kernel_launch: unexpected n_in %d / ws %zu (need %zu)\n", n_in, ws_size, (size_t)WS_END); grid = -1; return; }
        int dev = 0, cus = 0, per_cu = 0;
        hipGetDevice(&dev);
        hipDeviceGetAttribute(&cus, hipDeviceAttributeMultiprocessorCount, dev);
        if (hipFuncSetAttribute((const void*)fwd_kernel, hipFuncAttributeMaxDynamicSharedMemorySize, LDS_BYTES) != hipSuccess) { fprintf(stderr, "kernel_launch: hipFuncSetAttribute failed\n"); grid = -1; return; }
        hipOccupancyMaxActiveBlocksPerMultiprocessor(&per_cu, (const void*)fwd_kernel, NT, LDS_BYTES);
        (void)hipGetLastError();
        if (per_cu < 1) fprintf(stderr, "kernel_launch: occupancy query reports %d blocks per CU\n", per_cu);
        grid = cus > 0 ? cus : 256;
    }
    if (grid < 0) return;
    hipMemsetAsync((char*)d_ws + WS_BAR, 0, XCD_BAR_WORDS * sizeof(unsigned), stream);
    Params p; memset(&p, 0, sizeof(p));
    const float** f = (const float**)&p;
    for (int i = 0; i < 27; ++i) f[i] = (const float*)d_in[i];
    p.out = (float*)d_out; p.ws = (unsigned char*)d_ws;
#if N_LAUNCH_MODE == 1
    p.ph_lo = 0; p.ph_hi = NPH;
    hipLaunchKernelGGL(fwd_kernel, dim3(grid), dim3(NT), LDS_BYTES, stream, p);
#else
#ifdef DBG_STOP
    for (int ph = 0; ph <= DBG_STOP; ++ph) { p.ph_lo = ph; p.ph_hi = ph + 1; hipLaunchKernelGGL(fwd_kernel, dim3(grid), dim3(NT), LDS_BYTES, stream, p); }
    hipLaunchKernelGGL(dbg_digest, dim3(2048), dim3(256), 0, stream, (const unsigned char*)d_ws, (size_t)DBG_OFF, (int)DBG_KIND, (size_t)DBG_NELEM, (float*)d_out, (size_t)out_size);
#else
    for (int ph = 0; ph < NPH; ++ph) { p.ph_lo = ph; p.ph_hi = ph + 1; hipLaunchKernelGGL(fwd_kernel, dim3(grid), dim3(NT), LDS_BYTES, stream, p); }
#endif
#endif
}
```

```cpp
#include <hip/hip_runtime.h>
#include <stdint.h>
#include <stdio.h>
#include <string.h>

#ifndef N_LAUNCH_MODE
#define N_LAUNCH_MODE 1
#endif

typedef unsigned short u16;
typedef short bf16x8 __attribute__((ext_vector_type(8)));
typedef float f32x4 __attribute__((ext_vector_type(4)));
typedef unsigned u32x4 __attribute__((ext_vector_type(4)));
typedef unsigned u32x2 __attribute__((ext_vector_type(2)));

#define NT 512
constexpr int D = 2048, BATCH = 4, SEQ = 4096, LC = 256;
constexpr int NLAT = BATCH * SEQ, NCTX = BATCH * LC, NTOK = NLAT + NCTX;
constexpr int AB_IN = 7184, CD_IN = 3584;
constexpr int NEXP = 16, FF = 2048, EPAD = 2304;
constexpr int NPH = 22;
constexpr int LDS_BYTES = 150 * 1024;

constexpr size_t al256(size_t x) { return (x + 255) & ~(size_t)255; }
constexpr size_t WS_BAR = 0;
constexpr size_t WS_MOD = 16384;
constexpr size_t WS_XL1 = al256(WS_MOD + 2 * 5 * 12288 * 4);
constexpr size_t WS_XL2 = al256(WS_XL1 + (size_t)NTOK * D * 4);
constexpr size_t WS_H = al256(WS_XL2 + (size_t)NTOK * D * 4);
constexpr size_t WS_P = al256(WS_H + (size_t)NTOK * D * 2);
constexpr size_t WS_G = al256(WS_P + (size_t)NTOK * AB_IN * 2);
constexpr size_t WS_HM = al256(WS_G + (size_t)NTOK * 16 * 4);
constexpr size_t WS_YIN = al256(WS_HM + (size_t)2 * NTOK * 1024 * 2);
constexpr size_t WS_Y = al256(WS_YIN + (size_t)NTOK * D * 2);
constexpr size_t WS_AFF = al256(WS_Y + (size_t)NTOK * D * 4);
constexpr size_t WS_SLOT = al256(WS_AFF + (size_t)NTOK * 16 * 4);
constexpr size_t WS_EROW = al256(WS_SLOT + (size_t)NTOK * 16 * 4);
constexpr size_t WS_EGATE = al256(WS_EROW + (size_t)NEXP * EPAD * 4);
constexpr size_t WS_ACT = al256(WS_EGATE + (size_t)NEXP * EPAD * 4);
constexpr size_t WS_YEXP = al256(WS_ACT + (size_t)NEXP * EPAD * FF * 2);
constexpr size_t WS_LRUS = al256(WS_YEXP + (size_t)NEXP * EPAD * D * 2);
constexpr size_t WS_LRUW = al256(WS_LRUS + (size_t)2 * 2 * 4 * 68 * 1024 * 4);
constexpr size_t WS_WT_ABIN = al256(WS_LRUW + (size_t)32 * 128 * 128 * 2);
constexpr size_t WS_WT_ABOUT = al256(WS_WT_ABIN + (size_t)AB_IN * D * 2);
constexpr size_t WS_WT_CDIN = al256(WS_WT_ABOUT + (size_t)D * D * 2);
constexpr size_t WS_WT_CDOUT = al256(WS_WT_CDIN + (size_t)CD_IN * D * 2);
constexpr size_t WS_WT_W1 = al256(WS_WT_CDOUT + (size_t)D * D * 2);
constexpr size_t WS_WT_W3 = al256(WS_WT_W1 + (size_t)NEXP * D * FF * 2);
constexpr size_t WS_WT_W2 = al256(WS_WT_W3 + (size_t)NEXP * D * FF * 2);
constexpr size_t WS_END = al256(WS_WT_W2 + (size_t)NEXP * D * FF * 2);

extern __shared__ __attribute__((aligned(16))) unsigned char g_lds[];

struct Params {
    const float *x, *c, *ctx, *c_ctx, *ada_w, *ada_b, *norm_mix_pre, *norm_mix_post, *norm_ffn_pre, *norm_ffn_post;
    const float *ab_w_in, *ab_w_out, *mlstm_gate_b, *mlstm_norm, *na_rpb;
    const float *cd_w_in, *cd_w_out, *gqa_sink, *lru_conv_w, *lru_conv_b, *lru_gate_w, *lru_gate_b, *lru_lambda;
    const float *moe_router, *moe_w1, *moe_w3, *moe_w2;
    float* out;
    unsigned char* ws;
    int ph_lo, ph_hi;
};

#define XB_TMO      128
#define XB_XCNT(j)  (256  + 64 * (j))
#define XB_XSUB(j)  (1280 + 64 * (j))
#define XB_XGEN(j)  (2304 + 64 * (j))
#define XB_TOP      3328
#define XB_TOPGEN   3392
#define XCD_BAR_WORDS 3456
#define XB_SPIN_CAP (1u << 22)
#define LAS __attribute__((address_space(3)))

__device__ __forceinline__ unsigned xb_ld(unsigned* p)              { return __hip_atomic_load(p, __ATOMIC_RELAXED, __HIP_MEMORY_SCOPE_AGENT); }
__device__ __forceinline__ unsigned xb_add(unsigned* p, unsigned v) { return __hip_atomic_fetch_add(p, v, __ATOMIC_RELAXED, __HIP_MEMORY_SCOPE_AGENT); }
__device__ __forceinline__ unsigned xb_xcc_id() { return (unsigned)__builtin_amdgcn_s_getreg((3 << 11) | 20) & 0xFu; }
#define XB_SPIN(cond, bar) do { unsigned _sp = 0; while (cond) { __builtin_amdgcn_s_sleep(1); \
    if ((++_sp & 255u) == 0u) { if (xb_ld(&(bar)[XB_TMO])) break; if (_sp > XB_SPIN_CAP) { atomicAdd(&(bar)[XB_TMO], 1u); break; } } } } while (0)

struct XcdBarrier {
    unsigned* bar; unsigned x;
    volatile LAS unsigned* st;
};
__device__ __forceinline__ XcdBarrier xcd_barrier_post(unsigned* bar, volatile LAS unsigned* st) {
    XcdBarrier b; b.bar = bar; b.x = xb_xcc_id(); b.st = st;
    if (threadIdx.x == 0) (void)xb_add(&bar[XB_XCNT(b.x)], 1u);
    return b;
}
__device__ __forceinline__ void xcd_barrier_complete(unsigned* bar, unsigned x, unsigned& nloc, unsigned& nx) {
    const unsigned G = gridDim.x * gridDim.y * gridDim.z;
    unsigned sum, cnt, mine, sp = 0u;
    for (;;) {
        sum = 0u; cnt = 0u; mine = 0u;
#pragma unroll
        for (unsigned j = 0; j < 16; ++j) { const unsigned c = xb_ld(&bar[XB_XCNT(j)]); sum += c; cnt += (c > 0u) ? 1u : 0u; mine = (j == x) ? c : mine; }
        if (sum == G) break;
        __builtin_amdgcn_s_sleep(1);
        if ((++sp & 255u) == 0u) { if (xb_ld(&bar[XB_TMO])) break; if (sp > XB_SPIN_CAP) { atomicAdd(&bar[XB_TMO], 1u); break; } }
    }
    nloc = mine > 0u ? mine : 1u; nx = cnt > 0u ? cnt : 1u;
}
__device__ __forceinline__ void xcd_barrier(const XcdBarrier& b) {
    asm volatile("s_waitcnt vmcnt(0)" ::: "memory");
    __syncthreads();
    if (threadIdx.x == 0) {
        unsigned* bar = b.bar;
        __builtin_amdgcn_s_waitcnt(0);
        unsigned nloc = b.st[0], nx = b.st[1];
        if (nloc == 0u) { xcd_barrier_complete(bar, b.x, nloc, nx); b.st[0] = nloc; b.st[1] = nx; }
        const unsigned old = xb_add(&bar[XB_XSUB(b.x)], 1u);
        const unsigned gen = old / nloc;
        if (old + 1u == (gen + 1u) * nloc) {
            __builtin_amdgcn_fence(__ATOMIC_RELEASE, "agent");
            asm volatile("s_waitcnt vmcnt(0)" ::: "memory");
            const unsigned og = xb_add(&bar[XB_TOP], 1u);
            const unsigned tg = og / nx;
            if (og + 1u == (tg + 1u) * nx) xb_add(&bar[XB_TOPGEN], 1u);
            else XB_SPIN(xb_ld(&bar[XB_TOPGEN]) == tg, bar);
            __builtin_amdgcn_fence(__ATOMIC_ACQUIRE, "agent");
            xb_add(&bar[XB_XGEN(b.x)], 1u);
            asm volatile("s_waitcnt vmcnt(0)" ::: "memory");
        } else {
            XB_SPIN(xb_ld(&bar[XB_XGEN(b.x)]) == gen, bar);
            __builtin_amdgcn_fence(__ATOMIC_ACQUIRE, "agent");
            asm volatile("s_waitcnt vmcnt(0)" ::: "memory");
        }
    }
    __syncthreads();
}

typedef float f32x2_t __attribute__((ext_vector_type(2)));
typedef __bf16 bf16x2_t __attribute__((ext_vector_type(2)));
__device__ __forceinline__ unsigned pk_bf16(float lo, float hi) { f32x2_t v = {lo, hi}; return __builtin_bit_cast(unsigned, __builtin_convertvector(v, bf16x2_t)); }
__device__ __forceinline__ float bf_lo(unsigned u) { return __uint_as_float(u << 16); }
__device__ __forceinline__ float bf_hi(unsigned u) { return __uint_as_float(u & 0xffff0000u); }
__device__ __forceinline__ float bf2f(u16 v) { return __uint_as_float(((unsigned)v) << 16); }
typedef int i32x4 __attribute__((ext_vector_type(4)));
typedef int i32x8 __attribute__((ext_vector_type(8)));
constexpr bool WIN_F8_L0 = true, WIN_F8_L1 = true;
constexpr float F8_SW = 256.f, F8_SH = 8.f, F8_SA = 4.f;
__device__ __forceinline__ float f8_clamp(float x) { return __builtin_amdgcn_fmed3f(x, -448.f, 448.f); }
__device__ __forceinline__ unsigned pk_fp8x4(float a, float b, float c, float d) {
    unsigned r = 0u;
    r = (unsigned)__builtin_amdgcn_cvt_pk_fp8_f32(f8_clamp(a), f8_clamp(b), (int)r, false);
    r = (unsigned)__builtin_amdgcn_cvt_pk_fp8_f32(f8_clamp(c), f8_clamp(d), (int)r, true);
    return r; }
__device__ __forceinline__ i32x8 cat8(bf16x8 lo, bf16x8 hi) { return __builtin_shufflevector(__builtin_bit_cast(i32x4, lo), __builtin_bit_cast(i32x4, hi), 0, 1, 2, 3, 4, 5, 6, 7); }
__device__ __forceinline__ u16 f2bf(float f) { return (u16)(pk_bf16(f, 0.f) & 0xffffu); }
template <int CTRL> __device__ __forceinline__ float dpp_f(float v) { return __uint_as_float((unsigned)__builtin_amdgcn_update_dpp(0, (int)__float_as_uint(v), CTRL, 0xf, 0xf, true)); }
__device__ __forceinline__ float row_sum16(float v) { v += dpp_f<0xB1>(v); v += dpp_f<0x4E>(v); v += dpp_f<0x141>(v); v += dpp_f<0x140>(v); return v; }
__device__ __forceinline__ float row_max16(float v) { v = fmaxf(v, dpp_f<0xB1>(v)); v = fmaxf(v, dpp_f<0x4E>(v)); v = fmaxf(v, dpp_f<0x141>(v)); v = fmaxf(v, dpp_f<0x140>(v)); return v; }
__device__ __forceinline__ float rdlane_f(float v, int l) { return __uint_as_float((unsigned)__builtin_amdgcn_readlane((int)__float_as_uint(v), l)); }
__device__ __forceinline__ float sum_x16(float v) { const auto r = __builtin_amdgcn_permlane16_swap(__float_as_uint(v), __float_as_uint(v), false, false); return __uint_as_float(r[0]) + __uint_as_float(r[1]); }
__device__ __forceinline__ float sum_x32(float v) { const auto r = __builtin_amdgcn_permlane32_swap(__float_as_uint(v), __float_as_uint(v), false, false); return __uint_as_float(r[0]) + __uint_as_float(r[1]); }
__device__ __forceinline__ float max_x16(float v) { const auto r = __builtin_amdgcn_permlane16_swap(__float_as_uint(v), __float_as_uint(v), false, false); return fmaxf(__uint_as_float(r[0]), __uint_as_float(r[1])); }
__device__ __forceinline__ float max_x32(float v) { const auto r = __builtin_amdgcn_permlane32_swap(__float_as_uint(v), __float_as_uint(v), false, false); return fmaxf(__uint_as_float(r[0]), __uint_as_float(r[1])); }
__device__ __forceinline__ float partner_x16(float v) { const auto r = __builtin_amdgcn_permlane16_swap(__float_as_uint(v), __float_as_uint(v), false, false); return __uint_as_float(r[0] ^ r[1] ^ __float_as_uint(v)); }
__device__ __forceinline__ float partner_x32(float v) { const auto r = __builtin_amdgcn_permlane32_swap(__float_as_uint(v), __float_as_uint(v), false, false); return __uint_as_float(r[0] ^ r[1] ^ __float_as_uint(v)); }
__device__ __forceinline__ float wave_sum(float v) { return sum_x32(sum_x16(row_sum16(v))); }
__device__ __forceinline__ float wave_max(float v) { return max_x32(max_x16(row_max16(v))); }
__device__ __forceinline__ int hw_slot_() { return (int)(__builtin_amdgcn_s_getreg((5 << 11) | 4) & 63u); }
__device__ __forceinline__ int tid_() {
    int lane; asm volatile("v_mbcnt_lo_u32_b32 %0, -1, 0\n\tv_mbcnt_hi_u32_b32 %0, -1, %0" : "=v"(lane));
    const int w = ((volatile LAS int*)(g_lds))[8 + hw_slot_()];
    int t = __builtin_amdgcn_readfirstlane(w) * 64 + lane; asm volatile("" : "+v"(t)); return t; }
__device__ __forceinline__ int bid_() { unsigned o = 16; asm volatile("" : "+v"(o)); return __builtin_amdgcn_readfirstlane(*(const LAS int*)((LAS unsigned char*)(g_lds) + o)); }
__device__ __forceinline__ int gdim_() { unsigned o = 20; asm volatile("" : "+v"(o)); return __builtin_amdgcn_readfirstlane(*(const LAS int*)((LAS unsigned char*)(g_lds) + o)); }
__device__ __forceinline__ unsigned char* ws_() {
    unsigned o = 24; asm volatile("" : "+v"(o));
    const u32x2 v = *(const LAS u32x2*)((LAS unsigned char*)(g_lds) + o);
    const unsigned long long a = ((unsigned long long)(unsigned)__builtin_amdgcn_readfirstlane((int)v[1]) << 32) | (unsigned)__builtin_amdgcn_readfirstlane((int)v[0]);
    return (unsigned char*)(__attribute__((address_space(1))) unsigned char*)a; }
__device__ __forceinline__ float frcp_(float x) { return __builtin_amdgcn_rcpf(x); }
__device__ __forceinline__ float sigmoidf_(float x) { return frcp_(1.f + __expf(-x)); }
__device__ __forceinline__ f32x4 mfma16(bf16x8 a, bf16x8 b, f32x4 c) { return __builtin_amdgcn_mfma_f32_16x16x32_bf16(a, b, c, 0, 0, 0); }
__device__ __forceinline__ bf16x8 ld_frag_g(const u16* p) { return *reinterpret_cast<const bf16x8*>(p); }
__device__ __forceinline__ bf16x8 ld_frag_s(const u16* p) { return *reinterpret_cast<const bf16x8*>(p); }
__device__ __forceinline__ bf16x8 mk_frag(unsigned a, unsigned b, unsigned c, unsigned d) { u32x4 v = {a, b, c, d}; return __builtin_bit_cast(bf16x8, v); }

__device__ __forceinline__ const float* xin_row(const Params& p, int row) {
    return row < NLAT ? p.x + (size_t)row * D : p.ctx + (size_t)(row - NLAT) * D;
}
__device__ __forceinline__ const float* mod_ptr(const unsigned char* ws, int l, int row, int chunk) {
    const int bb = row < NLAT ? (row >> 12) : 4;
    return (const float*)(ws + WS_MOD) + ((size_t)(l * 5 + bb) * 6 + chunk) * D;
}

__device__ __forceinline__ void phase_mod(const Params& p, unsigned char* lds_raw) {
    unsigned char* const ws = ws_();
    float* scond = (float*)lds_raw;
    float* red = scond + 5 * D;
    const int t = tid_();
    for (int i = t; i < 5 * D; i += NT) { const int r = i >> 11, k = i & 2047; const float v = r < 4 ? p.c[r * D + k] : p.c_ctx[k]; scond[i] = v / (1.f + __expf(-v)); }
    __syncthreads();
    float* mod = (float*)(ws + WS_MOD);
    for (int item = bid_(); item < 192; item += gdim_()) {
        const int l = item / 96, col0 = (item % 96) * 128;
        const int kg = t >> 5, cl = (t & 31) * 4;
        f32x4 acc[5];
#pragma unroll
        for (int r = 0; r < 5; ++r) acc[r] = (f32x4){0.f, 0.f, 0.f, 0.f};
        const float* wp = p.ada_w + ((size_t)l * D + kg * 128) * (6 * D) + col0 + cl;
#pragma unroll 8
        for (int kk = 0; kk < 128; ++kk) {
            const f32x4 w = *reinterpret_cast<const f32x4*>(wp + (size_t)kk * (6 * D));
#pragma unroll
            for (int r = 0; r < 5; ++r) { const float s = scond[r * D + kg * 128 + kk]; acc[r] += w * s; }
        }
#pragma unroll
        for (int r = 0; r < 5; ++r) *reinterpret_cast<f32x4*>(red + (kg * 5 + r) * 128 + cl) = acc[r];
        __syncthreads();
        for (int o = t; o < 640; o += NT) {
            const int r = o >> 7, cc = o & 127;
            float s = p.ada_b[l * 6 * D + col0 + cc];
#pragma unroll
            for (int g = 0; g < 16; ++g) s += red[(g * 5 + r) * 128 + cc];
            mod[(size_t)(l * 5 + r) * 6 * D + col0 + cc] = s;
        }
        __syncthreads();
    }
}

__device__ __forceinline__ void phase_norm_mod(const Params& p, int l, unsigned char* lds) {
    unsigned char* const ws = ws_();
    const int t = tid_(), lane = t & 63, w = t >> 6;
    u16* H = (u16*)(ws + WS_H);
    float* R = (float*)lds;
    constexpr int RS = D + 4;
    float* G = (float*)(ws + WS_G);
    __syncthreads();
    for (int i = t; i < D * 16; i += NT) { const int k = i >> 4, e = i & 15; R[e * RS + k] = p.ab_w_in[(size_t)k * AB_IN + 4096 + e]; }
    __syncthreads();
    for (int row = bid_() * 8 + w; row < NTOK; row += gdim_() * 8) {
        const float* xr = xin_row(p, row);
        f32x4 v[8]; float ss = 0.f;
#pragma unroll
        for (int i = 0; i < 8; ++i) { v[i] = *reinterpret_cast<const f32x4*>(xr + (i * 64 + lane) * 4); ss += v[i][0] * v[i][0] + v[i][1] * v[i][1] + v[i][2] * v[i][2] + v[i][3] * v[i][3]; }
        ss = wave_sum(ss);
        const float rstd = rsqrtf(ss * (1.f / D) + 1e-6f);
        const float* sh = mod_ptr(ws, l, row, 0); const float* sc = mod_ptr(ws, l, row, 1);
        const float* nw = p.norm_mix_pre + (size_t)l * D;
#pragma unroll
        for (int i = 0; i < 8; ++i) {
            const int col = (i * 64 + lane) * 4;
            const f32x4 w4 = *reinterpret_cast<const f32x4*>(nw + col), s4 = *reinterpret_cast<const f32x4*>(sc + col), h4 = *reinterpret_cast<const f32x4*>(sh + col);
            f32x4 o = v[i] * rstd * w4 * (s4 + 1.f) + h4;
            if (WIN_F8_L0) *reinterpret_cast<unsigned*>((unsigned char*)H + (size_t)row * D + col) = pk_fp8x4(o[0] * F8_SH, o[1] * F8_SH, o[2] * F8_SH, o[3] * F8_SH);
            else { const u32x2 pk = {pk_bf16(o[0], o[1]), pk_bf16(o[2], o[3])}; *reinterpret_cast<u32x2*>(H + (size_t)row * D + col) = pk; }
            v[i] = o;
        }
        f32x2_t lg2[16];
#pragma unroll
        for (int e = 0; e < 16; ++e) lg2[e] = (f32x2_t){0.f, 0.f};
#pragma unroll
        for (int i = 0; i < 8; ++i) {
            const f32x2_t va = {v[i][0], v[i][1]}, vb = {v[i][2], v[i][3]};
#pragma unroll
            for (int e = 0; e < 16; ++e) {
                const f32x4 r4 = *reinterpret_cast<const f32x4*>(R + e * RS + (i * 64 + lane) * 4);
                lg2[e] = __builtin_elementwise_fma(va, (f32x2_t){r4[0], r4[1]}, lg2[e]);
                lg2[e] = __builtin_elementwise_fma(vb, (f32x2_t){r4[2], r4[3]}, lg2[e]);
            }
        }
        float lg[16];
#pragma unroll
        for (int e = 0; e < 16; ++e) lg[e] = lg2[e][0] + lg2[e][1];
        const bool b5 = lane & 32, b4 = lane & 16, b3 = lane & 8, b2 = lane & 4;
        float t8[8], t4[4], t2[2], lgt;
#pragma unroll
        for (int j = 0; j < 8; ++j) { const float keep = b5 ? lg[8 + j] : lg[j], send = b5 ? lg[j] : lg[8 + j]; t8[j] = keep + partner_x32(send); }
#pragma unroll
        for (int j = 0; j < 4; ++j) { const float keep = b4 ? t8[4 + j] : t8[j], send = b4 ? t8[j] : t8[4 + j]; t4[j] = keep + partner_x16(send); }
#pragma unroll
        for (int j = 0; j < 2; ++j) { const float keep = b3 ? t4[2 + j] : t4[j], send = b3 ? t4[j] : t4[2 + j]; t2[j] = keep + dpp_f<0x140>(send); }
        { const float keep = b2 ? t2[1] : t2[0], send = b2 ? t2[0] : t2[1]; lgt = keep + dpp_f<0x141>(send); }
        lgt += dpp_f<0x4E>(lgt); lgt += dpp_f<0xB1>(lgt);
        if ((lane & 3) == 0) G[(size_t)row * 16 + ((b5 ? 8 : 0) + (b4 ? 4 : 0) + (b3 ? 2 : 0) + (b2 ? 1 : 0))] = lgt;
    }
}

__device__ __forceinline__ void convert_item(const float* W, int N, u16* Wt, int kb, int nb, unsigned char* lds) {
    const int t = tid_(), lane = t & 63, w = t >> 6;
    const int n4 = lane * 4, k0 = kb * 64 + w * 8, n0 = nb * 256;
    int col = n0 + n4; if (col > N - 4) col = N - 4;
    f32x4 r8[8];
#pragma unroll
    for (int j = 0; j < 8; ++j) r8[j] = *reinterpret_cast<const f32x4*>(W + (size_t)(k0 + j) * N + col);
    __syncthreads();
#pragma unroll
    for (int jj = 0; jj < 4; ++jj) {
        u32x4 v = {pk_bf16(r8[0][jj], r8[1][jj]), pk_bf16(r8[2][jj], r8[3][jj]), pk_bf16(r8[4][jj], r8[5][jj]), pk_bf16(r8[6][jj], r8[7][jj])};
        const int r = n4 + jj;
        *reinterpret_cast<u32x4*>(lds + r * 128 + ((w ^ ((r >> 2) & 7)) << 4)) = v;
    }
    __syncthreads();
    const int c = t & 7;
#pragma unroll
    for (int i = 0; i < 4; ++i) {
        const int r = (t >> 3) + 64 * i;
        if (n0 + r < N) {
            const u32x4 v = *reinterpret_cast<const u32x4*>(lds + r * 128 + ((c ^ ((r >> 2) & 7)) << 4));
            *reinterpret_cast<u32x4*>(Wt + (size_t)(n0 + r) * 2048 + kb * 64 + c * 8) = v;
        }
    }
}
template <int N>
__device__ __forceinline__ void convert_item8(const float* W, unsigned char* Wt, int kb, int nb, unsigned char* lds) {
    const int t = tid_(), lane = t & 63, w = t >> 6;
    const int n4 = lane * 4, k0 = kb * 128 + w * 16, n0 = nb * 256;
    int col = n0 + n4; if (N % 256 != 0 && col > N - 4) col = N - 4;
    f32x4 r[16];
#pragma unroll
    for (int j = 0; j < 16; ++j) r[j] = *reinterpret_cast<const f32x4*>(W + (size_t)(k0 + j) * N + col);
    __syncthreads();
#pragma unroll
    for (int jj = 0; jj < 4; ++jj) {
        u32x4 v;
#pragma unroll
        for (int q = 0; q < 4; ++q) v[q] = pk_fp8x4(r[4 * q][jj] * F8_SW, r[4 * q + 1][jj] * F8_SW, r[4 * q + 2][jj] * F8_SW, r[4 * q + 3][jj] * F8_SW);
        const int rr = n4 + jj;
        *reinterpret_cast<u32x4*>(lds + rr * 128 + ((w ^ ((rr >> 2) & 7)) << 4)) = v;
    }
    __syncthreads();
    const int c = t & 7;
#pragma unroll
    for (int i = 0; i < 4; ++i) {
        const int rr = (t >> 3) + 64 * i;
        if (N % 256 == 0 || n0 + rr < N) {
            const u32x4 v = *reinterpret_cast<const u32x4*>(lds + rr * 128 + ((c ^ ((rr >> 2) & 7)) << 4));
            *reinterpret_cast<u32x4*>(Wt + (size_t)(n0 + rr) * 2048 + kb * 128 + c * 16) = v;
        }
    }
}
__device__ __forceinline__ void convert_matrix_items(const float* W, int N, u16* Wt, int first, int count, unsigned char* lds) {
    const int nnb = (N + 255) / 256;
    for (int it = first; it < first + count; ++it) convert_item(W, N, Wt, it / nnb, it % nnb, lds);
}
__device__ __forceinline__ void phase_convert_dense(const Params& p, unsigned char* lds) {
    unsigned char* const ws = ws_();
    constexpr int n_ab = (WIN_F8_L0 ? 16 : 32) * 29, n_cd = (WIN_F8_L1 ? 16 : 32) * 14;
    for (int item = bid_(); item < n_ab + 128 + n_cd + 128; item += gdim_()) {
        if (item < n_ab) { if (WIN_F8_L0) convert_item8<AB_IN>(p.ab_w_in, ws + WS_WT_ABIN, item / 29, item % 29, lds); else convert_item(p.ab_w_in, AB_IN, (u16*)(ws + WS_WT_ABIN), item / 29, item % 29, lds); }
        else if (item < n_ab + 128) { const int it = item - n_ab; convert_item8<2048>(p.ab_w_out, ws + WS_WT_ABOUT, it / 8, it % 8, lds); }
        else if (item < n_ab + 128 + n_cd) { const int it = item - n_ab - 128; if (WIN_F8_L1) convert_item8<CD_IN>(p.cd_w_in, ws + WS_WT_CDIN, it / 14, it % 14, lds); else convert_item(p.cd_w_in, CD_IN, (u16*)(ws + WS_WT_CDIN), it / 14, it % 14, lds); }
        else { const int it = item - n_ab - 128 - n_cd; convert_item8<2048>(p.cd_w_out, ws + WS_WT_CDOUT, it / 8, it % 8, lds); }
    }
}
__device__ __forceinline__ void phase_convert_moe(const Params& p, int l, unsigned char* lds) {
    unsigned char* const ws = ws_();
    for (int item = bid_(); item < 3 * NEXP * 128; item += gdim_()) {
        const int which = item / (NEXP * 128), r = item % (NEXP * 128), ex = r >> 7, it = r & 127;
        const float* src = (which == 0 ? p.moe_w1 : (which == 1 ? p.moe_w3 : p.moe_w2)) + (size_t)(l * NEXP + ex) * D * FF;
        unsigned char* dst = ws + (which == 0 ? WS_WT_W1 : (which == 1 ? WS_WT_W3 : WS_WT_W2)) + (size_t)ex * D * FF;
        convert_item8<2048>(src, dst, it >> 3, it & 7, lds);
    }
}

__device__ __forceinline__ int g8_lds_byte(int r, int c) { const int st = (r >> 4) * 2 + (c >> 5), rr = r & 15, cc = c & 31, ob = rr * 64 + cc * 2; return st * 1024 + (ob ^ (((ob >> 9) & 1) << 5)); }
__device__ __forceinline__ void g8_stage_rc(int bb, int& R, int& C) { const int st = bb / 1024, sb = bb % 1024, swz = sb ^ (((sb >> 9) & 1) << 5); R = (st >> 1) * 16 + swz / 64; C = (st & 1) * 32 + (swz % 64) / 2; }
__device__ __forceinline__ int g8_perm32(int rho) { const int n = rho >> 4, i = rho & 15; return 8 * (i >> 2) + 4 * n + (i & 3); }

enum { EPI_BF16 = 0, EPI_SWIGLU = 2, EPI_SCALE = 3, EPI_F8BF16 = 4 };
struct GUnit { const char* a; const char* b0; const char* b1; const int* arow; int m0, n0, mvalid, ncols; u16* ob; int ldo; float* gates; const float* rscale; };
constexpr int G8_HTB = 128 * 64 * 2;
constexpr size_t G8_KSTEP = 128, G8_HSTEP = (size_t)128 * 2048 * 2;

template <int EPI>
__device__ __forceinline__ void g8_epilogue(const f32x4 (&acc)[2][2][4][2], const GUnit& u, int wr, int wc, int fr, int fq) {
#pragma unroll
    for (int ai = 0; ai < 2; ++ai)
#pragma unroll
        for (int m = 0; m < 4; ++m) {
            const int row = u.m0 + 128 * ai + 64 * wr + 16 * m + fr;
            if (row < u.mvalid) {
                if (EPI == EPI_BF16 || EPI == EPI_F8BF16) {
                    constexpr float si = EPI == EPI_F8BF16 ? 1.f / (F8_SH * F8_SW) : 1.f;
#pragma unroll
                    for (int bj = 0; bj < 2; ++bj) {
                        const int col = u.n0 + 128 * bj + 32 * wc + 8 * fq;
                        if (col < u.ncols) {
                            const f32x4 v0 = acc[ai][bj][m][0] * si, v1 = acc[ai][bj][m][1] * si;
                            u32x4 pk = {pk_bf16(v0[0], v0[1]), pk_bf16(v0[2], v0[3]), pk_bf16(v1[0], v1[1]), pk_bf16(v1[2], v1[3])};
                            *reinterpret_cast<u32x4*>(u.ob + (size_t)row * u.ldo + col) = pk;
                            if (u.gates && col >= 4096 && col < 4112) { *reinterpret_cast<f32x4*>(u.gates + (size_t)row * 16 + (col - 4096)) = v0; *reinterpret_cast<f32x4*>(u.gates + (size_t)row * 16 + (col - 4096) + 4) = v1; }
                        }
                    }
                } else if (EPI == EPI_SWIGLU) {
                    const int col = u.n0 + 32 * wc + 8 * fq;
                    float a[8];
                    constexpr float si = 1.f / (F8_SH * F8_SW);
#pragma unroll
                    for (int n = 0; n < 2; ++n)
#pragma unroll
                        for (int q = 0; q < 4; ++q) { const float x = acc[ai][0][m][n][q] * si; a[n * 4 + q] = x * frcp_(1.f + __expf(-x)) * (acc[ai][1][m][n][q] * (si * F8_SA)); }
                    u32x2 pk = {pk_fp8x4(a[0], a[1], a[2], a[3]), pk_fp8x4(a[4], a[5], a[6], a[7])};
                    *reinterpret_cast<u32x2*>((unsigned char*)u.ob + (size_t)row * u.ldo + col) = pk;
                } else {
                    const float sc = u.rscale[row] * (1.f / (F8_SA * F8_SW));
#pragma unroll
                    for (int bj = 0; bj < 2; ++bj) {
                        const int col = u.n0 + 128 * bj + 32 * wc + 8 * fq;
                        const f32x4 v0 = acc[ai][bj][m][0] * sc, v1 = acc[ai][bj][m][1] * sc;
                        u32x4 pk = {pk_bf16(v0[0], v0[1]), pk_bf16(v0[2], v0[3]), pk_bf16(v1[0], v1[1]), pk_bf16(v1[2], v1[3])};
                        *reinterpret_cast<u32x4*>(u.ob + (size_t)row * u.ldo + col) = pk;
                    }
                }
            }
        }
}

template <int EPI, bool GATHER, class UnitFn>
__device__ __forceinline__ void gemm_phase8(unsigned char* lds, UnitFn next) {
    const int tid = tid_(), wid = __builtin_amdgcn_readfirstlane(tid >> 6), lane = tid & 63, wr = wid >> 2, wc = wid & 3, fr = lane & 15, fq = lane >> 4;
    constexpr bool F8 = (EPI != EPI_BF16);
    constexpr int nt = F8 ? 2048 / 128 : 2048 / 64;
    constexpr unsigned ROWB = F8 ? 2048u : 4096u;
    GUnit cur, nxt; int ui = 0;
    if (!next(0, cur)) return;
    int sR[2], sC[2];
#pragma unroll
    for (int i = 0; i < 2; ++i) g8_stage_rc(tid * 16 + i * 8192, sR[i], sC[i]);
    unsigned voffB[2];
#pragma unroll
    for (int i = 0; i < 2; ++i) voffB[i] = (unsigned)((sR[i] & ~31) + g8_perm32(sR[i] & 31)) * ROWB + (unsigned)sC[i] * 2u;
    unsigned voffA[2][2], voffAn[2][2];
    auto set_voffA = [&](const GUnit& u, unsigned (&vo)[2][2]) {
#pragma unroll
        for (int h = 0; h < 2; ++h)
#pragma unroll
            for (int i = 0; i < 2; ++i) {
                if (GATHER) vo[h][i] = (unsigned)u.arow[u.m0 + h * 128 + sR[i]] * ROWB + (unsigned)sC[i] * 2u;
                else vo[h][i] = (unsigned)(h * 128 + sR[i]) * ROWB + (unsigned)sC[i] * 2u;
            } };
    set_voffA(cur, voffA);
    const unsigned ldsw = (unsigned)wid * 1024u;
    const int aoff = g8_lds_byte(wr * 64 + fr, fq * 8), boff = g8_lds_byte(wc * 32 + fr, fq * 8);
#define G8_SA(b, h) (((b) * 2 + (h)) * G8_HTB)
#define G8_SB(b, h) ((4 + (b) * 2 + (h)) * G8_HTB)
#define G8_STAGE(bufoff, gbase, voff) do { _Pragma("unroll") for (int _i = 0; _i < 2; ++_i) \
        __builtin_amdgcn_global_load_lds((const unsigned*)((const char*)(gbase) + (voff)[_i]), (LAS unsigned*)(lds + (bufoff) + ldsw + _i * 8192), 16, 0, 0); } while (0)
#define G8_LDA(dst, b, h) do { _Pragma("unroll") for (int m = 0; m < 4; ++m) _Pragma("unroll") for (int k = 0; k < 2; ++k) dst[m][k] = *(const LAS bf16x8*)(lds + G8_SA(b, h) + aoff + m * 2048 + k * 1024); } while (0)
#define G8_LDB(dst, b, h) do { _Pragma("unroll") for (int n = 0; n < 2; ++n) _Pragma("unroll") for (int k = 0; k < 2; ++k) dst[n][k] = *(const LAS bf16x8*)(lds + G8_SB(b, h) + boff + n * 2048 + k * 1024); } while (0)
#define G8_MMA(ai, bj, At, Bt) do { __builtin_amdgcn_s_setprio(1); _Pragma("unroll") for (int m = 0; m < 4; ++m) _Pragma("unroll") for (int n = 0; n < 2; ++n) { \
        if (F8) { const i32x8 _b = cat8(Bt[n][0], Bt[n][1]), _a = cat8(At[m][0], At[m][1]); asm volatile("v_mfma_f32_16x16x128_f8f6f4 %0, %1, %2, %0" : "+v"(acc[ai][bj][m][n]) : "v"(_b), "v"(_a)); } \
        else { _Pragma("unroll") for (int k = 0; k < 2; ++k) acc[ai][bj][m][n] = __builtin_amdgcn_mfma_f32_16x16x32_bf16(Bt[n][k], At[m][k], acc[ai][bj][m][n], 0, 0, 0); } } \
        __builtin_amdgcn_s_setprio(0); } while (0)
#define G8_WAIT_V(n) asm volatile("s_waitcnt vmcnt(" #n ")" ::: "memory")
#define G8_WAIT_L(n) asm volatile("s_waitcnt lgkmcnt(" #n ")" ::: "memory")
#define G8_BAR __builtin_amdgcn_s_barrier()
#define G8_SCHED __builtin_amdgcn_sched_barrier(0)
    f32x4 acc[2][2][4][2];
#pragma unroll
    for (int a2 = 0; a2 < 2; ++a2)
#pragma unroll
        for (int b2 = 0; b2 < 2; ++b2)
#pragma unroll
            for (int m = 0; m < 4; ++m)
#pragma unroll
                for (int n = 0; n < 2; ++n) acc[a2][b2][m][n] = (f32x4){0.f, 0.f, 0.f, 0.f};
    bf16x8 At[4][2], B0[2][2], B1[2][2];
    const char* cA = cur.a; const char* cB0 = cur.b0; const char* cB1 = cur.b1;
    G8_STAGE(G8_SB(0, 0), cB0, voffB); G8_STAGE(G8_SA(0, 0), cA, voffA[0]); G8_STAGE(G8_SB(0, 1), cB1, voffB); G8_STAGE(G8_SA(0, 1), cA, voffA[1]);
    if (wr == 1) G8_BAR;
    G8_WAIT_V(4); G8_BAR;
    G8_STAGE(G8_SB(1, 0), cB0 + G8_KSTEP, voffB); G8_STAGE(G8_SA(1, 0), cA + G8_KSTEP, voffA[0]); G8_STAGE(G8_SB(1, 1), cB1 + G8_KSTEP, voffB);
    G8_WAIT_V(6); G8_BAR;
    for (;;) {
        const bool has_next = next(ui + 1, nxt);
        const char* nA = has_next ? nxt.a : cA; const char* nB0 = has_next ? nxt.b0 : cB0; const char* nB1 = has_next ? nxt.b1 : cB1;
        if (GATHER) { if (has_next) set_voffA(nxt, voffAn); else { _Pragma("unroll") for (int h = 0; h < 2; ++h) _Pragma("unroll") for (int i = 0; i < 2; ++i) voffAn[h][i] = voffA[h][i]; } }
        for (int t = 0; t < nt; t += 2) {
            const bool last = (t == nt - 2);
            const char* a1 = cA + (size_t)(t + 1) * G8_KSTEP;
            const char* a2 = last ? nA : cA + (size_t)(t + 2) * G8_KSTEP;
            const char* b20 = last ? nB0 : cB0 + (size_t)(t + 2) * G8_KSTEP; const char* b21 = last ? nB1 : cB1 + (size_t)(t + 2) * G8_KSTEP;
            const char* a3 = a2 + G8_KSTEP; const char* b30 = b20 + G8_KSTEP; const char* b31 = b21 + G8_KSTEP;
            unsigned vA2[2][2];
#pragma unroll
            for (int h = 0; h < 2; ++h)
#pragma unroll
                for (int i = 0; i < 2; ++i) vA2[h][i] = (GATHER && last) ? voffAn[h][i] : voffA[h][i];
            G8_LDB(B0, 0, 0); G8_SCHED; G8_LDA(At, 0, 0); G8_STAGE(G8_SA(1, 1), a1, voffA[1]);
            G8_WAIT_L(8); G8_BAR; G8_WAIT_L(0); G8_MMA(0, 0, At, B0); G8_BAR; G8_SCHED;
            G8_LDB(B1, 0, 1); G8_STAGE(G8_SB(0, 0), b20, voffB);
            G8_BAR; G8_WAIT_L(0); G8_MMA(0, 1, At, B1); G8_BAR;
            G8_LDA(At, 0, 1); G8_STAGE(G8_SA(0, 0), a2, vA2[0]);
            G8_BAR; G8_WAIT_L(0); G8_MMA(1, 0, At, B0); G8_BAR; G8_SCHED;
            G8_STAGE(G8_SB(0, 1), b21, voffB);
            G8_WAIT_V(6); G8_BAR; G8_MMA(1, 1, At, B1); G8_BAR;
            G8_LDB(B0, 1, 0); G8_SCHED; G8_LDA(At, 1, 0); G8_STAGE(G8_SA(0, 1), a2, vA2[1]);
            G8_WAIT_L(8); G8_BAR; G8_WAIT_L(0); G8_MMA(0, 0, At, B0); G8_BAR; G8_SCHED;
            G8_LDB(B1, 1, 1); G8_STAGE(G8_SB(1, 0), b30, voffB);
            G8_BAR; G8_WAIT_L(0); G8_MMA(0, 1, At, B1); G8_BAR;
            G8_LDA(At, 1, 1); G8_STAGE(G8_SA(1, 0), a3, vA2[0]);
            G8_BAR; G8_WAIT_L(0); G8_MMA(1, 0, At, B0); G8_BAR; G8_SCHED;
            G8_STAGE(G8_SB(1, 1), b31, voffB);
            G8_WAIT_V(6); G8_BAR; G8_MMA(1, 1, At, B1); G8_BAR;
        }
        if (F8) asm volatile("s_nop 15\n\ts_nop 15" ::: "memory");
        g8_epilogue<EPI>(acc, cur, wr, wc, fr, fq);
        if (!has_next) break;
#pragma unroll
        for (int a2 = 0; a2 < 2; ++a2)
#pragma unroll
            for (int b2 = 0; b2 < 2; ++b2)
#pragma unroll
                for (int m = 0; m < 4; ++m)
#pragma unroll
                    for (int n = 0; n < 2; ++n) acc[a2][b2][m][n] = (f32x4){0.f, 0.f, 0.f, 0.f};
        cur = nxt; cA = nA; cB0 = nB0; cB1 = nB1; ++ui;
        if (GATHER) { _Pragma("unroll") for (int h = 0; h < 2; ++h) _Pragma("unroll") for (int i = 0; i < 2; ++i) voffA[h][i] = voffAn[h][i]; }
    }
    G8_WAIT_V(0);
    if (wr == 0) G8_BAR;
    G8_BAR;
#undef G8_SA
#undef G8_SB
#undef G8_STAGE
#undef G8_LDA
#undef G8_LDB
#undef G8_MMA
#undef G8_WAIT_V
#undef G8_WAIT_L
#undef G8_BAR
#undef G8_SCHED
}

template <bool F8>
__device__ __forceinline__ void phase_gemm_dense(const Params& p, const u16* A, int M, const u16* Wt, int N, u16* ob, int ldo, float* gates, unsigned char* lds) {
    const int nM = M / 256, nN = (N + 255) / 256, L = nM * nN;
    const int xcd = bid_() & 7, slot = bid_() >> 3, nslot = gdim_() >> 3;
    const int base = (int)(((long)L * xcd) >> 3), cnt = (int)(((long)L * (xcd + 1)) >> 3) - base;
    const int G8n = nM >> 3, rem = nM & 7;
    auto next = [&](int i, GUnit& u) -> bool {
        const int k = slot + i * nslot;
        if (k >= cnt) return false;
        const int idx = base + k;
        int pn, pm;
        if (idx < G8n * 8 * nN) { const int gq = idx / (8 * nN), r = idx % (8 * nN); pn = r >> 3; pm = gq * 8 + (r & 7); }
        else { const int r = idx - G8n * 8 * nN; pn = r / rem; pm = G8n * 8 + r % rem; }
        constexpr size_t rowb = F8 ? 2048 : 4096;
        u.a = (const char*)A + (size_t)pm * 256 * rowb; u.b0 = (const char*)Wt + (size_t)pn * 256 * rowb; u.b1 = u.b0 + 128 * rowb; u.arow = nullptr;
        u.m0 = pm * 256; u.n0 = pn * 256; u.mvalid = M; u.ncols = N; u.ob = ob; u.ldo = ldo; u.gates = gates; u.rscale = nullptr;
        return true; };
    gemm_phase8<F8 ? EPI_F8BF16 : EPI_BF16, false>(lds, next);
}

__device__ __forceinline__ void phase_moe_a(const Params& p, int l, unsigned char* lds) {
    unsigned char* const ws = ws_();
    const int mvalid = l == 0 ? 2176 : 2048, nM = l == 0 ? 9 : 8;
    const int per_e = nM * 16;
    const int xcd = bid_() & 7, slot = bid_() >> 3, nslot = gdim_() >> 3;
    auto next = [&](int i, GUnit& u) -> bool {
        const int k = slot + i * nslot;
        if (k >= 2 * per_e) return false;
        const int tile = xcd * 2 * per_e + k;
        const int ex = tile / per_e, r = tile % per_e, pn = r / nM, pm = r % nM;
        u.a = (const char*)(ws + WS_H); u.arow = (const int*)(ws + WS_EROW) + ex * EPAD;
        u.b0 = (const char*)(ws + WS_WT_W1) + ((size_t)ex * FF + pn * 128) * D; u.b1 = (const char*)(ws + WS_WT_W3) + ((size_t)ex * FF + pn * 128) * D;
        u.m0 = pm * 256; u.n0 = pn * 128; u.mvalid = mvalid; u.ncols = FF; u.ob = (u16*)(ws + WS_ACT + (size_t)ex * EPAD * FF); u.ldo = FF; u.gates = nullptr; u.rscale = nullptr;
        return true; };
    gemm_phase8<EPI_SWIGLU, true>(lds, next);
}
__device__ __forceinline__ void phase_moe_b(const Params& p, int l, unsigned char* lds) {
    unsigned char* const ws = ws_();
    const int mvalid = l == 0 ? 2176 : 2048, nM = l == 0 ? 9 : 8;
    const int per_e = nM * 8;
    const int xcd = bid_() & 7, slot = bid_() >> 3, nslot = gdim_() >> 3;
    auto next = [&](int i, GUnit& u) -> bool {
        const int k = slot + i * nslot;
        if (k >= 2 * per_e) return false;
        const int tile = xcd * 2 * per_e + k;
        const int ex = tile / per_e, r = tile % per_e, pn = r / nM, pm = r % nM;
        u.a = (const char*)(ws + WS_ACT) + ((size_t)ex * EPAD + pm * 256) * FF; u.arow = nullptr;
        u.b0 = (const char*)(ws + WS_WT_W2) + ((size_t)ex * D + pn * 256) * FF; u.b1 = u.b0 + (size_t)128 * 2048;
        u.m0 = pm * 256; u.n0 = pn * 256; u.mvalid = mvalid; u.ncols = D; u.ob = (u16*)(ws + WS_YEXP) + (size_t)ex * EPAD * D; u.ldo = D; u.gates = nullptr;
        u.rscale = (const float*)(ws + WS_EGATE) + ex * EPAD;
        return true; };
    gemm_phase8<EPI_SCALE, false>(lds, next);
}

__device__ __forceinline__ int mlstm_row(int b, int dir, int pos) {
    if (pos < LC) return NLAT + b * LC + (dir ? (LC - 1 - pos) : pos);
    const int q = pos - LC; return b * SEQ + (dir ? (SEQ - 1 - q) : q);
}
__device__ __forceinline__ void phase_mlstm(const Params& p, unsigned char* lds) {
    unsigned char* const ws = ws_();
    u16* KT = (u16*)lds;
    u16* VT = KT + 256 * 72;
    u16* VWT = VT + 48 * 72;
    u16* CT = VWT + 48 * 72;
    u16* Ss = CT + 48 * 264;
    float* gB = (float*)(Ss + 64 * 72);
    float* gI = gB + 68 * 64;
    float* gP = gI + 68 * 64;
    float* gE = gP + 68 * 64;
    const int t = tid_(), lane = t & 63, w = t >> 6, fr = lane & 15, fq = lane >> 4;
    const u16* P = (const u16*)(ws + WS_P);
    const float* G = (const float*)(ws + WS_G);
    u16* HM = (u16*)(ws + WS_HM);
    for (int item = bid_(); item < 256; item += gdim_()) {
        const int combo = (item & 7) * 4 + (item >> 6), vs = (item >> 3) & 7, dir = combo & 1, hh = (combo >> 1) & 3, b = combo >> 3;
        __syncthreads();
        for (int i = t; i < 48 * 264; i += NT) CT[i] = 0;
        for (int i = t; i < 16 * 72; i += NT) { const int er = i / 72; VT[32 * 72 + i] = (er == 0) ? (u16)0x3f80 : (u16)0; VWT[32 * 72 + i] = 0; }
        {
            const float gb_i = p.mlstm_gate_b[(dir * 2 + 0) * 4 + hh], gb_f = p.mlstm_gate_b[(dir * 2 + 1) * 4 + hh];
            for (int ch = w; ch < 68; ch += 8) {
                const int row = mlstm_row(b, dir, ch * 64 + lane);
                const float gi = G[(size_t)row * 16 + dir * 8 + hh] + gb_i;
                const float gf = G[(size_t)row * 16 + dir * 8 + 4 + hh] + gb_f;
                const float lf = fminf(gf, 0.f) - log1pf(__expf(-fabsf(gf)));
                float bc = lf;
#pragma unroll
                for (int o = 1; o < 64; o <<= 1) { const float n = __shfl_up(bc, o, 64); if (lane >= o) bc += n; }
                float pm = gi - bc;
#pragma unroll
                for (int o = 1; o < 64; o <<= 1) { const float n = __shfl_up(pm, o, 64); if (lane >= o) pm = fmaxf(pm, n); }
                const float b63 = __shfl(bc, 63, 64);
                float gmax = b63 - bc + gi;
#pragma unroll
                for (int o = 32; o > 0; o >>= 1) gmax = fmaxf(gmax, __shfl_xor(gmax, o, 64));
                gB[ch * 64 + lane] = bc; gI[ch * 64 + lane] = gi; gP[ch * 64 + lane] = pm;
                if (lane == 0) { gE[ch * 2] = b63; gE[ch * 2 + 1] = gmax; }
            }
        }
        f32x4 Cacc[2][3];
#pragma unroll
        for (int i = 0; i < 2; ++i)
#pragma unroll
            for (int j = 0; j < 3; ++j) Cacc[i][j] = (f32x4){0.f, 0.f, 0.f, 0.f};
        float m_old = 0.f;
        const int jt = w & 3, sth = w >> 2;
        const int vs_s = t & 63, vs_eg = t >> 6;
        bf16x8 qf[8]; unsigned ktr[2][8]; u32x2 vraw;
        const int jq = jt * 16 + fr, jjq = dir ? 63 - jq : jq;
        const unsigned off_q = (unsigned)jjq * AB_IN + hh * 256 + fq * 8;
        const int jk0 = (sth * 2) * 16 + fr, jk1 = jk0 + 16;
        const unsigned off_k0 = (unsigned)(dir ? 63 - jk0 : jk0) * AB_IN + 1024 + hh * 256 + fq * 8;
        const unsigned off_k1 = (unsigned)(dir ? 63 - jk1 : jk1) * AB_IN + 1024 + hh * 256 + fq * 8;
        unsigned off_kt[2];
#pragma unroll
        for (int i = 0; i < 2; ++i) { const int mt = t + NT * i, d2 = (mt & 127) * 2, s8 = (mt >> 7) * 8; off_kt[i] = (unsigned)(dir ? 63 - s8 - 7 : s8) * AB_IN + 1024 + hh * 256 + d2; }
        const unsigned off_v = (unsigned)(dir ? 63 - vs_s : vs_s) * AB_IN + 2048 + hh * 256 + vs * 32 + vs_eg * 4;
        const unsigned off_h = (unsigned)jjq * 1024 + hh * 256 + vs * 32 + sth * 16 + 4 * fq;
#define ML_BASE(POS0) (P + (size_t)(dir ? mlstm_row(b, dir, (POS0)) - 63 : mlstm_row(b, dir, (POS0))) * AB_IN)
#define ML_LOAD_Q(POS0) do { const u16* _pc = ML_BASE(POS0); \
            _Pragma("unroll") for (int kk = 0; kk < 8; ++kk) qf[kk] = ld_frag_g(_pc + off_q + kk * 32); } while (0)
#define ML_LOAD_K(POS0, S2) do { const u16* _pc = ML_BASE(POS0); \
            _Pragma("unroll") for (int kk = 0; kk < 8; ++kk) kf[kk] = ld_frag_g(_pc + ((S2) ? off_k1 : off_k0) + kk * 32); } while (0)
#define ML_LOAD_KTV(POS0) do { const u16* _pc = ML_BASE(POS0); \
            _Pragma("unroll") for (int i = 0; i < 2; ++i) { \
                _Pragma("unroll") for (int q = 0; q < 8; ++q) ktr[i][q] = *reinterpret_cast<const unsigned*>(_pc + (size_t)((dir ? 7 - q : q) * AB_IN) + off_kt[i]); } \
            vraw = *reinterpret_cast<const u32x2*>(_pc + off_v); } while (0)
        ML_LOAD_Q(0); ML_LOAD_KTV(0);
        __syncthreads();
        for (int ch = 0; ch < 68; ++ch) {
            const int pos0 = ch * 64;
            const float* sb = gB + ch * 64; const float* sig = gI + ch * 64; const float* spm = gP + ch * 64;
            const float b63 = gE[ch * 2], m_new = fmaxf(b63 + m_old, gE[ch * 2 + 1]), decay = __expf(b63 + m_old - m_new);
            const int jg = jt * 16 + fr;
            const float bj = sb[jg], mj = bj + fmaxf(m_old, spm[jg]);
            auto s_tile = [&](int st) {
                f32x4 sv = (f32x4){0.f, 0.f, 0.f, 0.f};
                if (st <= jt) {
                    typedef short s16x4 __attribute__((ext_vector_type(4)));
                    const u16* kb = KT + (8 * fq + ((lane & 15) >> 2)) * 72 + st * 16 + 4 * (lane & 3);
#pragma unroll
                    for (int kk = 0; kk < 8; ++kk) {
                        const s16x4 lo = __builtin_amdgcn_ds_read_tr16_b64_v4i16((LAS s16x4*)(kb + kk * 32 * 72));
                        const s16x4 hi = __builtin_amdgcn_ds_read_tr16_b64_v4i16((LAS s16x4*)(kb + (kk * 32 + 4) * 72));
                        const bf16x8 kfr = {lo[0], lo[1], lo[2], lo[3], hi[0], hi[1], hi[2], hi[3]};
                        sv = mfma16(kfr, qf[kk], sv);
                    }
                }
                float pv[4];
#pragma unroll
                for (int q = 0; q < 4; ++q) {
                    const int sg = st * 16 + 4 * fq + q;
                    pv[q] = (sg <= jg) ? sv[q] * 0.0625f * __expf(bj - sb[sg] + sig[sg] - mj) : 0.f;
                }
                u32x2 pk = {pk_bf16(pv[0], pv[1]), pk_bf16(pv[2], pv[3])};
                *reinterpret_cast<u32x2*>(Ss + jg * 72 + st * 16 + 4 * fq) = pk;
            };
#pragma unroll
            for (int i = 0; i < 2; ++i) {
                const int mt = t + NT * i, d2 = (mt & 127) * 2, s8 = (mt >> 7) * 8;
                u32x4 lo = {(ktr[i][0] & 0xffffu) | (ktr[i][1] << 16), (ktr[i][2] & 0xffffu) | (ktr[i][3] << 16), (ktr[i][4] & 0xffffu) | (ktr[i][5] << 16), (ktr[i][6] & 0xffffu) | (ktr[i][7] << 16)};
                u32x4 hi = {(ktr[i][0] >> 16) | (ktr[i][1] & 0xffff0000u), (ktr[i][2] >> 16) | (ktr[i][3] & 0xffff0000u), (ktr[i][4] >> 16) | (ktr[i][5] & 0xffff0000u), (ktr[i][6] >> 16) | (ktr[i][7] & 0xffff0000u)};
                *reinterpret_cast<u32x4*>(KT + d2 * 72 + s8) = lo;
                *reinterpret_cast<u32x4*>(KT + (d2 + 1) * 72 + s8) = hi;
            }
            {
                const float wg = __expf(b63 - sb[vs_s] + sig[vs_s] - m_new) * 0.0625f;
                const float v0 = bf_lo(vraw[0]), v1 = bf_hi(vraw[0]), v2 = bf_lo(vraw[1]), v3 = bf_hi(vraw[1]);
                const int e0 = vs_eg * 4;
                VT[(e0 + 0) * 72 + vs_s] = (u16)(vraw[0] & 0xffffu); VT[(e0 + 1) * 72 + vs_s] = (u16)(vraw[0] >> 16);
                VT[(e0 + 2) * 72 + vs_s] = (u16)(vraw[1] & 0xffffu); VT[(e0 + 3) * 72 + vs_s] = (u16)(vraw[1] >> 16);
                VWT[(e0 + 0) * 72 + vs_s] = f2bf(v0 * wg); VWT[(e0 + 1) * 72 + vs_s] = f2bf(v1 * wg);
                VWT[(e0 + 2) * 72 + vs_s] = f2bf(v2 * wg); VWT[(e0 + 3) * 72 + vs_s] = f2bf(v3 * wg);
                if (t < 64) VWT[32 * 72 + t] = f2bf(wg);
            }
            if (ch + 1 < 68) ML_LOAD_KTV(pos0 + 64);
            __syncthreads();
            s_tile(sth * 2);
            s_tile(sth * 2 + 1);
            __syncthreads();
            {
                const float w_inter = __expf(bj + m_old - mj);
                f32x4 nacc[2];
#pragma unroll
                for (int z = 0; z < 2; ++z) {
                    const int et = z == 0 ? sth : 2;
                    f32x4 a = (f32x4){0.f, 0.f, 0.f, 0.f};
#pragma unroll
                    for (int kk = 0; kk < 8; ++kk) a = mfma16(ld_frag_s(CT + (et * 16 + fr) * 264 + kk * 32 + fq * 8), qf[kk], a);
                    nacc[z] = a * w_inter;
                }
                if (ch + 1 < 68) ML_LOAD_Q(pos0 + 64);
#pragma unroll
                for (int z = 0; z < 2; ++z) {
                    const int et = z == 0 ? sth : 2;
                    f32x4 a = nacc[z];
#pragma unroll
                    for (int k2 = 0; k2 < 2; ++k2) a = mfma16(ld_frag_s(VT + (et * 16 + fr) * 72 + k2 * 32 + fq * 8), ld_frag_s(Ss + jg * 72 + k2 * 32 + fq * 8), a);
                    nacc[z] = a;
                }
                const float den = __shfl(nacc[1][0], fr, 64);
                const float dd = fmaxf(fabsf(den), __expf(-mj));
                const float inv = 1.f / dd;
                u32x2 pk = {pk_bf16(nacc[0][0] * inv, nacc[0][1] * inv), pk_bf16(nacc[0][2] * inv, nacc[0][3] * inv)};
                *reinterpret_cast<u32x2*>(HM + ((size_t)dir * NTOK + (dir ? mlstm_row(b, dir, pos0) - 63 : mlstm_row(b, dir, pos0))) * 1024 + off_h) = pk;
            }
#pragma unroll
            for (int i = 0; i < 2; ++i)
#pragma unroll
                for (int et = 0; et < 3; ++et) {
                    f32x4 a = Cacc[i][et] * decay;
#pragma unroll
                    for (int k2 = 0; k2 < 2; ++k2) a = mfma16(ld_frag_s(KT + ((w * 2 + i) * 16 + fr) * 72 + k2 * 32 + fq * 8), ld_frag_s(VWT + (et * 16 + fr) * 72 + k2 * 32 + fq * 8), a);
                    Cacc[i][et] = a;
                }
            __syncthreads();
#pragma unroll
            for (int i = 0; i < 2; ++i)
#pragma unroll
                for (int et = 0; et < 3; ++et) {
                    const f32x4 a = Cacc[i][et];
                    u32x2 pk = {pk_bf16(a[0], a[1]), pk_bf16(a[2], a[3])};
                    *reinterpret_cast<u32x2*>(CT + (et * 16 + fr) * 264 + (w * 2 + i) * 16 + 4 * fq) = pk;
                }
            m_old = m_new;
        }
#undef ML_LOAD_Q
#undef ML_LOAD_K
#undef ML_LOAD_KTV
    }
}

__device__ __forceinline__ void mlstm_out_rows(const Params& p, int row0, int nrows) {
    unsigned char* const ws = ws_();
    const int lane = tid_() & 63, w = tid_() >> 6;
    const u16* P = (const u16*)(ws + WS_P);
    const u16* HM = (const u16*)(ws + WS_HM);
    u16* YIN = (u16*)(ws + WS_YIN);
    for (int r = w; r < nrows; r += 8) {
        const int row = row0 + r;
        const int c0 = lane * 16;
        float v[16]; float ss = 0.f;
#pragma unroll
        for (int h2 = 0; h2 < 2; ++h2) {
            const u32x4 a = *reinterpret_cast<const u32x4*>(HM + (size_t)row * 1024 + c0 + h2 * 8);
            const u32x4 bq = *reinterpret_cast<const u32x4*>(HM + ((size_t)NTOK + row) * 1024 + c0 + h2 * 8);
#pragma unroll
            for (int q = 0; q < 4; ++q) { v[h2 * 8 + 2 * q] = bf_lo(a[q]) + bf_lo(bq[q]); v[h2 * 8 + 2 * q + 1] = bf_hi(a[q]) + bf_hi(bq[q]); }
        }
#pragma unroll
        for (int q = 0; q < 16; ++q) ss += v[q] * v[q];
        ss += __shfl_xor(ss, 1, 64); ss += __shfl_xor(ss, 2, 64); ss += __shfl_xor(ss, 4, 64); ss += __shfl_xor(ss, 8, 64);
        const float rstd = rsqrtf(ss * (1.f / 256.f) + 1e-6f);
        float y[16];
#pragma unroll
        for (int h2 = 0; h2 < 2; ++h2) {
            const u32x4 og = *reinterpret_cast<const u32x4*>(P + (size_t)row * AB_IN + 3072 + c0 + h2 * 8);
#pragma unroll
            for (int q = 0; q < 4; ++q) {
                const int c = c0 + h2 * 8 + 2 * q;
                y[h2 * 8 + 2 * q] = v[h2 * 8 + 2 * q] * rstd * p.mlstm_norm[c] * sigmoidf_(bf_lo(og[q])) * F8_SH;
                y[h2 * 8 + 2 * q + 1] = v[h2 * 8 + 2 * q + 1] * rstd * p.mlstm_norm[c + 1] * sigmoidf_(bf_hi(og[q])) * F8_SH;
            }
        }
        *reinterpret_cast<u32x4*>((unsigned char*)YIN + (size_t)row * D + c0) = (u32x4){pk_fp8x4(y[0], y[1], y[2], y[3]), pk_fp8x4(y[4], y[5], y[6], y[7]), pk_fp8x4(y[8], y[9], y[10], y[11]), pk_fp8x4(y[12], y[13], y[14], y[15])};
    }
}

template <int DH, class KeyFn, class BiasFn>
__device__ __forceinline__ void attn_wave(const u16* qptr, size_t qstride, int nblk, KeyFn keyfn, BiasFn biasfn, float scale,
                                           float m_init, float l_init, u16* vlds, u16* optr, size_t ostride) {
    constexpr int NK = DH / 32, NDT = DH / 16, VS = DH + 8, NV = DH / 16;
    const int lane = tid_() & 63, fr = lane & 15, fq = lane >> 4;
    bf16x8 qf[NK];
#pragma unroll
    for (int kk = 0; kk < NK; ++kk) qf[kk] = ld_frag_g(qptr + (size_t)fr * qstride + kk * 32 + fq * 8);
    f32x4 oacc[NDT];
#pragma unroll
    for (int i = 0; i < NDT; ++i) oacc[i] = (f32x4){0.f, 0.f, 0.f, 0.f};
    float m = m_init, l = l_init;
    bf16x8 kn[2][NK]; u32x4 vn[NV];
    auto load_blk = [&](int ib) {
        const u16* kptr; const u16* vptr; size_t kvs;
        (void)keyfn(ib, kptr, vptr, kvs);
#pragma unroll
        for (int st = 0; st < 2; ++st)
#pragma unroll
            for (int kk = 0; kk < NK; ++kk) kn[st][kk] = ld_frag_g(kptr + (size_t)(st * 16 + fr) * kvs + kk * 32 + fq * 8);
#pragma unroll
        for (int i = 0; i < NV; ++i) { const int cidx = lane + 64 * i, r = cidx / (DH / 8), cc = cidx % (DH / 8); vn[i] = *reinterpret_cast<const u32x4*>(vptr + (size_t)r * kvs + cc * 8); }
    };
    auto next_valid = [&](int ib) { const u16* a; const u16* b2; size_t c; while (ib < nblk && !keyfn(ib, a, b2, c)) ++ib; return ib; };
    int ib = next_valid(0);
    if (ib < nblk) load_blk(ib);
    while (ib < nblk) {
        bf16x8 kc[2][NK]; u32x4 vc[NV];
#pragma unroll
        for (int st = 0; st < 2; ++st)
#pragma unroll
            for (int kk = 0; kk < NK; ++kk) kc[st][kk] = kn[st][kk];
#pragma unroll
        for (int i = 0; i < NV; ++i) vc[i] = vn[i];
        const int ibn = next_valid(ib + 1);
        if (ibn < nblk) load_blk(ibn);
        asm volatile("" ::: "memory");
#pragma unroll
        for (int i = 0; i < NV; ++i) { const int cidx = lane + 64 * i, r = cidx / (DH / 8), cc = cidx % (DH / 8); *reinterpret_cast<u32x4*>(vlds + r * VS + cc * 8) = vc[i]; }
        f32x4 s[2];
#pragma unroll
        for (int st = 0; st < 2; ++st) {
            f32x4 a = (f32x4){0.f, 0.f, 0.f, 0.f};
#pragma unroll
            for (int kk = 0; kk < NK; ++kk) a = mfma16(kc[st][kk], qf[kk], a);
            s[st] = a;
        }
        float x[8]; float mx = -INFINITY;
#pragma unroll
        for (int st = 0; st < 2; ++st)
#pragma unroll
            for (int q = 0; q < 4; ++q) { const float v = s[st][q] * scale + biasfn(ib, fr, st * 16 + 4 * fq + q); x[st * 4 + q] = v; mx = fmaxf(mx, v); }
        mx = max_x32(max_x16(mx));
        const float m_new = fmaxf(m, mx);
        const float m_safe = (m_new == -INFINITY) ? 0.f : m_new;
        const float alpha = __expf(m - m_safe);
        float ps = 0.f; float pe[8];
#pragma unroll
        for (int q = 0; q < 8; ++q) { pe[q] = __expf(x[q] - m_safe); ps += pe[q]; }
        l = l * alpha + ps; m = m_new;
#pragma unroll
        for (int i = 0; i < NDT; ++i) oacc[i] *= alpha;
        const bf16x8 pf = mk_frag(pk_bf16(pe[0], pe[1]), pk_bf16(pe[2], pe[3]), pk_bf16(pe[4], pe[5]), pk_bf16(pe[6], pe[7]));
        asm volatile("s_waitcnt lgkmcnt(0)" ::: "memory");
        {
            typedef short s16x4 __attribute__((ext_vector_type(4)));
            const int tq = (lane & 15) >> 2, tp = lane & 3;
            const u16* vb0 = vlds + (4 * fq + tq) * VS + 4 * tp;
            const u16* vb1 = vb0 + 16 * VS;
#pragma unroll
            for (int dt = 0; dt < NDT; ++dt) {
                const s16x4 lo = __builtin_amdgcn_ds_read_tr16_b64_v4i16((LAS s16x4*)(vb0 + dt * 16));
                const s16x4 hi = __builtin_amdgcn_ds_read_tr16_b64_v4i16((LAS s16x4*)(vb1 + dt * 16));
                const bf16x8 vf = {lo[0], lo[1], lo[2], lo[3], hi[0], hi[1], hi[2], hi[3]};
                oacc[dt] = mfma16(vf, pf, oacc[dt]);
            }
        }
        asm volatile("" ::: "memory");
        ib = ibn;
    }
    l = sum_x32(sum_x16(l));
    const float inv = 1.f / l;
#pragma unroll
    for (int dt = 0; dt < NDT; ++dt) {
        const f32x4 o = oacc[dt] * (inv * F8_SH);
        *reinterpret_cast<unsigned*>((unsigned char*)optr + (size_t)fr * ostride + dt * 16 + 4 * fq) = pk_fp8x4(o[0], o[1], o[2], o[3]);
    }
}


template <int DH, class SlabFn, class SubFn, class BiasFn>
__device__ __forceinline__ void attn_block(const u16* qptr, size_t qstride, int nslab, SlabFn slabfn, SubFn subfn, BiasFn biasfn, float scale,
                                            float m_init, float l_init, unsigned char* lds, u16* optr, size_t ostride) {
    constexpr int NK = DH / 32, NDT = DH / 16, VS = DH + 8, NLD = DH / 64;
    constexpr int STAGE = 2 * 64 * VS * 2;
    const int t = tid_(), lane = t & 63, fr = lane & 15, fq = lane >> 4;
    bf16x8 qf[NK];
#pragma unroll
    for (int kk = 0; kk < NK; ++kk) qf[kk] = ld_frag_g(qptr + (size_t)fr * qstride + kk * 32 + fq * 8);
    f32x4 oacc[NDT];
#pragma unroll
    for (int i = 0; i < NDT; ++i) oacc[i] = (f32x4){0.f, 0.f, 0.f, 0.f};
    float m = m_init, l = l_init;
    u32x4 kreg[NLD], vreg[NLD];
    auto load_slab = [&](int i) {
        const u16* kp; const u16* vp; size_t kvs; slabfn(i, kp, vp, kvs);
#pragma unroll
        for (int q = 0; q < NLD; ++q) { const int c = t + NT * q, r = c / (DH / 8), cc = c % (DH / 8);
            kreg[q] = *reinterpret_cast<const u32x4*>(kp + (size_t)r * kvs + cc * 8); vreg[q] = *reinterpret_cast<const u32x4*>(vp + (size_t)r * kvs + cc * 8); } };
    auto store_slab = [&](int st) {
        u16* Ks = (u16*)(lds + st * STAGE); u16* Vs = Ks + 64 * VS;
#pragma unroll
        for (int q = 0; q < NLD; ++q) { const int c = t + NT * q, r = c / (DH / 8), cc = c % (DH / 8);
            *reinterpret_cast<u32x4*>(Ks + r * VS + cc * 8) = kreg[q]; *reinterpret_cast<u32x4*>(Vs + r * VS + cc * 8) = vreg[q]; } };
    __syncthreads();
    load_slab(0); store_slab(0);
    if (nslab > 1) load_slab(1);
    __syncthreads();
    for (int i = 0; i < nslab; ++i) {
        const int cur = i & 1;
        if (i + 1 < nslab) store_slab(cur ^ 1);
        if (i + 2 < nslab) load_slab(i + 2);
        const u16* Ks = (const u16*)(lds + cur * STAGE); const u16* Vs = Ks + 64 * VS;
#pragma unroll
        for (int j = 0; j < 2; ++j) {
            int off;
            if (!subfn(i, j, off)) continue;
            f32x4 s[2];
#pragma unroll
            for (int st = 0; st < 2; ++st) {
                f32x4 a = (f32x4){0.f, 0.f, 0.f, 0.f};
#pragma unroll
                for (int kk = 0; kk < NK; ++kk) a = mfma16(ld_frag_s(Ks + (off + st * 16 + fr) * VS + kk * 32 + fq * 8), qf[kk], a);
                s[st] = a;
            }
            float x[8]; float mx = -INFINITY;
#pragma unroll
            for (int st = 0; st < 2; ++st)
#pragma unroll
                for (int q = 0; q < 4; ++q) { const float v = s[st][q] * scale + biasfn(i, off, fr, st * 16 + 4 * fq + q); x[st * 4 + q] = v; mx = fmaxf(mx, v); }
            mx = max_x32(max_x16(mx));
            const float m_new = fmaxf(m, mx);
            const float m_safe = (m_new == -INFINITY) ? 0.f : m_new;
            const float alpha = __expf(m - m_safe);
            float ps = 0.f; float pe[8];
#pragma unroll
            for (int q = 0; q < 8; ++q) { pe[q] = __expf(x[q] - m_safe); ps += pe[q]; }
            l = l * alpha + ps; m = m_new;
#pragma unroll
            for (int dt = 0; dt < NDT; ++dt) oacc[dt] *= alpha;
            const bf16x8 pf = mk_frag(pk_bf16(pe[0], pe[1]), pk_bf16(pe[2], pe[3]), pk_bf16(pe[4], pe[5]), pk_bf16(pe[6], pe[7]));
            typedef short s16x4 __attribute__((ext_vector_type(4)));
            const int tq = (lane & 15) >> 2, tp = lane & 3;
            const u16* vb0 = Vs + (off + 4 * fq + tq) * VS + 4 * tp;
            const u16* vb1 = vb0 + 16 * VS;
#pragma unroll
            for (int dt = 0; dt < NDT; ++dt) {
                const s16x4 lo = __builtin_amdgcn_ds_read_tr16_b64_v4i16((LAS s16x4*)(vb0 + dt * 16));
                const s16x4 hi = __builtin_amdgcn_ds_read_tr16_b64_v4i16((LAS s16x4*)(vb1 + dt * 16));
                const bf16x8 vf = {lo[0], lo[1], lo[2], lo[3], hi[0], hi[1], hi[2], hi[3]};
                oacc[dt] = mfma16(vf, pf, oacc[dt]);
            }
        }
        __syncthreads();
    }
    l = sum_x32(sum_x16(l));
    const float inv = 1.f / l;
#pragma unroll
    for (int dt = 0; dt < NDT; ++dt) {
        const f32x4 o = oacc[dt] * (inv * F8_SH);
        *reinterpret_cast<unsigned*>((unsigned char*)optr + (size_t)fr * ostride + dt * 16 + 4 * fq) = pk_fp8x4(o[0], o[1], o[2], o[3]);
    }
}

__device__ __forceinline__ void phase_l0_stage2(const Params& p, unsigned char* lds) {
    unsigned char* const ws = ws_();
    const int w = tid_() >> 6;
    const u16* P = (const u16*)(ws + WS_P);
    u16* YIN = (u16*)(ws + WS_YIN);
    for (int item = bid_(); item < 1088 + 2176; item += gdim_()) {
        if (item < 1024) {
            const int r2 = item & 31, h = (item >> 5) & 7, b = item >> 8;
            const int rr = w >> 2, qt = w & 3, r = 2 * r2 + rr;
            const int r0 = min(max(r - 4, 0), 56);
            const int krow0 = min(max(2 * r2 - 4, 0), 56), nwin = min(max(2 * r2 + 1 - 4, 0), 56) + 8 - krow0;
            const int cb = qt == 0 ? 0 : (qt == 1 ? 8 : (qt == 2 ? 24 : 32));
            const int qrow = b * SEQ + r * 64 + qt * 16;
            const float* rpb = p.na_rpb + h * 15 * 31;
            auto slabfn = [&](int i, const u16*& kp, const u16*& vp, size_t& kvs) {
                const int row = i < nwin ? b * SEQ + (krow0 + i) * 64 : NLAT + b * LC + (i - nwin) * 64;
                kp = P + (size_t)row * AB_IN + 5136 + h * 128; vp = P + (size_t)row * AB_IN + 6160 + h * 128; kvs = AB_IN; };
            auto subfn = [&](int i, int j, int& off) -> bool {
                if (i < nwin) { off = cb; return j == 0 && (krow0 + i) >= r0 && (krow0 + i) < r0 + 8; }
                off = 32 * j; return true; };
            auto biasfn = [&](int i, int off, int qi, int ki) -> float {
                if (i >= nwin) return 0.f;
                const int c = qt * 16 + qi, kc = off + ki, c0 = min(max(c - 8, 0), 48);
                if (kc < c0 || kc >= c0 + 16) return -INFINITY;
                return rpb[(krow0 + i - r + 7) * 31 + (kc - c + 15)]; };
            attn_block<128>(P + (size_t)qrow * AB_IN + 4112 + h * 128, AB_IN, nwin + 4, slabfn, subfn, biasfn, 0.08838834764831845f, -INFINITY, 0.f, lds,
                            (u16*)((unsigned char*)YIN + (size_t)qrow * D + 1024 + h * 128), D);
        } else if (item < 1088) {
            const int it = item - 1024, half = it & 1, h = (it >> 1) & 7, b = it >> 4;
            const int qrow = NLAT + b * LC + (half * 8 + w) * 16;
            auto slabfn = [&](int i, const u16*& kp, const u16*& vp, size_t& kvs) {
                const int row = NLAT + b * LC + i * 64;
                kp = P + (size_t)row * AB_IN + 5136 + h * 128; vp = P + (size_t)row * AB_IN + 6160 + h * 128; kvs = AB_IN; };
            auto subfn = [&](int, int j, int& off) -> bool { off = 32 * j; return true; };
            auto biasfn = [&](int, int, int, int) -> float { return 0.f; };
            attn_block<128>(P + (size_t)qrow * AB_IN + 4112 + h * 128, AB_IN, 4, slabfn, subfn, biasfn, 0.08838834764831845f, -INFINITY, 0.f, lds,
                            (u16*)((unsigned char*)YIN + (size_t)qrow * D + 1024 + h * 128), D);
        } else {
            mlstm_out_rows(p, (item - 1088) * 8, 8);
        }
    }
}

__device__ __forceinline__ void rope_rows(const Params& p, int row0, int nrows) {
    unsigned char* const ws = ws_();
    const int lane = tid_() & 63, w = tid_() >> 6;
    u16* P = (u16*)(ws + WS_P);
    for (int r = w; r < nrows; r += 8) {
        const int row = row0 + r, tt = row & (SEQ - 1);
        const float prow = (float)(tt >> 6), pcol = (float)(tt & 63);
        for (int pi = lane; pi < 640; pi += 64) {
            const int head = pi >> 5, half = (pi >> 4) & 1, j = pi & 15;
            const int base = (head < 16 ? head * 64 : 1024 + (head - 16) * 64) + half * 32 + j;
            const float inv = exp2f(-(float)j * (13.287712379549449f / 16.f));
            const float ang = (half ? pcol : prow) * inv;
            float sn, cs; sincosf(ang, &sn, &cs);
            u16* q1 = P + (size_t)row * CD_IN + base;
            const float x1 = bf2f(q1[0]), x2 = bf2f(q1[16]);
            q1[0] = f2bf(x1 * cs - x2 * sn); q1[16] = f2bf(x2 * cs + x1 * sn);
        }
    }
}

__device__ __forceinline__ int lru_row(int b, int ci, int j) { return ci < 4 ? NLAT + b * LC + ci * 64 + j : b * SEQ + (ci - 4) * 64 + j; }
__device__ __forceinline__ void lru_chunk(const Params& p, int b, int blk, int ci, int mode, unsigned char* lds) {
    unsigned char* const ws = ws_();
    u16* ub = (u16*)lds;
    constexpr int SR = 132;
    float* sa = (float*)(ub + 64 * 136);
    float* sbt = sa + 64 * SR;
    float* sx = sbt + 64 * SR;
    const int t = tid_(), lane = t & 63, w = t >> 6, fr = lane & 15, fq = lane >> 4;
    const u16* P = (const u16*)(ws + WS_P);
    const u16* WT = (const u16*)(ws + WS_LRUW);
    float* SA = (float*)(ws + WS_LRUS);
    float* SH = SA + 2 * 4 * 68 * 1024;
    const int seglen = ci < 4 ? LC : SEQ, tt0 = ci < 4 ? ci * 64 : (ci - 4) * 64;
    const int rbase = ci < 4 ? NLAT + b * LC : b * SEQ;
    const int sc = t & 127, seg = t >> 7;
    const int chg_s = blk * 128 + sc;
    const int cg = blk * 128 + w * 16 + 4 * fq;
    bf16x8 wfa[2][2][4];
#pragma unroll
    for (int d2 = 0; d2 < 2; ++d2)
#pragma unroll
        for (int g2 = 0; g2 < 2; ++g2)
#pragma unroll
            for (int kk = 0; kk < 4; ++kk) wfa[d2][g2][kk] = ld_frag_g(WT + ((size_t)((d2 * 2 + g2) * 8 + blk) * 128 + w * 16 + fr) * 128 + fq * 8 + kk * 32);
    f32x4 gba[2][2], lama[2];
#pragma unroll
    for (int d2 = 0; d2 < 2; ++d2) {
        lama[d2] = *reinterpret_cast<const f32x4*>(p.lru_lambda + d2 * 1024 + cg);
#pragma unroll
        for (int g2 = 0; g2 < 2; ++g2) gba[d2][g2] = *reinterpret_cast<const f32x4*>(p.lru_gate_b + (d2 * 2 + g2) * 1024 + cg);
    }
    float carry[2] = {0.f, 0.f}; u16 grv[16];
    if (mode == 1) {
#pragma unroll
        for (int d2 = 0; d2 < 2; ++d2) carry[d2] = SH[((size_t)(d2 * 4 + b) * 68 + ci) * 1024 + chg_s];
#pragma unroll
        for (int s = 0; s < 16; ++s) grv[s] = P[(size_t)lru_row(b, ci, seg * 16 + s) * CD_IN + 2560 + chg_s];
    }
    __syncthreads();
    {
        const int c4 = (t & 31) * 4, j0 = (t >> 5) * 4, ch = blk * 128 + c4;
        float xv[7][4];
#pragma unroll
        for (int q = 0; q < 7; ++q) {
            const int tt = tt0 + j0 - 1 + q;
            if (tt >= 0 && tt < seglen) {
                const u32x2 v = *reinterpret_cast<const u32x2*>(P + (size_t)(rbase + tt) * CD_IN + 1536 + ch);
                xv[q][0] = bf_lo(v[0]); xv[q][1] = bf_hi(v[0]); xv[q][2] = bf_lo(v[1]); xv[q][3] = bf_hi(v[1]);
            } else { xv[q][0] = xv[q][1] = xv[q][2] = xv[q][3] = 0.f; }
        }
        f32x4 cw[4];
#pragma unroll
        for (int tp = 0; tp < 4; ++tp) cw[tp] = *reinterpret_cast<const f32x4*>(p.lru_conv_w + tp * 1024 + ch);
        const f32x4 cb = *reinterpret_cast<const f32x4*>(p.lru_conv_b + ch);
#pragma unroll
        for (int q = 0; q < 4; ++q) {
            float u[4];
#pragma unroll
            for (int cc = 0; cc < 4; ++cc) u[cc] = cb[cc] + xv[q][cc] * cw[0][cc] + xv[q + 1][cc] * cw[1][cc] + xv[q + 2][cc] * cw[2][cc] + xv[q + 3][cc] * cw[3][cc];
            u32x2 pk = {pk_bf16(u[0], u[1]), pk_bf16(u[2], u[3])};
            *reinterpret_cast<u32x2*>(ub + (j0 + q) * 136 + c4) = pk;
        }
    }
    __syncthreads();
    float hfw[16];
    for (int dir = 0; dir < 2; ++dir) {
        f32x4 av[4];
        {
            bf16x8 wf[4];
#pragma unroll
            for (int kk = 0; kk < 4; ++kk) wf[kk] = dir ? wfa[1][0][kk] : wfa[0][0][kk];
            const f32x4 gbv = dir ? gba[1][0] : gba[0][0];
            const f32x4 lamv = dir ? lama[1] : lama[0];
            float sp8[4];
#pragma unroll
            for (int q = 0; q < 4; ++q) { const float nl = -lamv[q]; sp8[q] = -8.f * (fmaxf(nl, 0.f) + __logf(1.f + __expf(-fabsf(nl)))); }
#pragma unroll
            for (int tt = 0; tt < 4; ++tt) {
                f32x4 z = (f32x4){0.f, 0.f, 0.f, 0.f};
#pragma unroll
                for (int kk = 0; kk < 4; ++kk) z = mfma16(wf[kk], ld_frag_s(ub + (tt * 16 + fr) * 136 + kk * 32 + fq * 8), z);
#pragma unroll
                for (int q = 0; q < 4; ++q) av[tt][q] = __expf(sigmoidf_(z[q] + gbv[q]) * sp8[q]);
            }
        }
        __syncthreads();
        {
            bf16x8 wf[4];
#pragma unroll
            for (int kk = 0; kk < 4; ++kk) wf[kk] = dir ? wfa[1][1][kk] : wfa[0][1][kk];
            const f32x4 gbv = dir ? gba[1][1] : gba[0][1];
#pragma unroll
            for (int tt = 0; tt < 4; ++tt) {
                f32x4 z = (f32x4){0.f, 0.f, 0.f, 0.f};
#pragma unroll
                for (int kk = 0; kk < 4; ++kk) z = mfma16(wf[kk], ld_frag_s(ub + (tt * 16 + fr) * 136 + kk * 32 + fq * 8), z);
                const int tj = tt * 16 + fr;
                const u32x2 uv = *reinterpret_cast<const u32x2*>(ub + tj * 136 + w * 16 + 4 * fq);
                const float u4[4] = {bf_lo(uv[0]), bf_hi(uv[0]), bf_lo(uv[1]), bf_hi(uv[1])};
                f32x4 bv;
#pragma unroll
                for (int q = 0; q < 4; ++q) { const float a = av[tt][q]; bv[q] = __builtin_amdgcn_sqrtf(fmaxf(1.f - a * a, 0.f)) * sigmoidf_(z[q] + gbv[q]) * u4[q]; }
                *reinterpret_cast<f32x4*>(sa + tj * SR + w * 16 + 4 * fq) = av[tt];
                *reinterpret_cast<f32x4*>(sbt + tj * SR + w * 16 + 4 * fq) = bv;
            }
        }
        __syncthreads();
        float A = 1.f, h = 0.f;
#pragma unroll
        for (int s = 0; s < 16; ++s) { const int j = seg * 16 + (dir ? 15 - s : s); const float a = sa[j * SR + sc]; h = a * h + sbt[j * SR + sc]; A *= a; }
        sx[(seg * 2 + 0) * 128 + sc] = A; sx[(seg * 2 + 1) * 128 + sc] = h;
        __syncthreads();
        const size_t sidx = ((size_t)(dir * 4 + b) * 68 + ci) * 1024 + chg_s;
        if (mode == 0) {
            if (seg == 0) {
                float At = 1.f, ht = 0.f;
#pragma unroll
                for (int s = 0; s < 4; ++s) { const int sg = dir ? 3 - s : s; const float a = sx[(sg * 2) * 128 + sc]; ht = a * ht + sx[(sg * 2 + 1) * 128 + sc]; At *= a; }
                SA[sidx] = At; SH[sidx] = ht;
            }
        } else {
            float hs = dir ? carry[1] : carry[0];
            const int nprev = dir ? 3 - seg : seg;
#pragma unroll
            for (int s = 0; s < 3; ++s) if (s < nprev) { const int sg = dir ? 3 - s : s; hs = sx[(sg * 2) * 128 + sc] * hs + sx[(sg * 2 + 1) * 128 + sc]; }
            u16* YIN = (u16*)(ws + WS_YIN);
            if (dir == 0) {
#pragma unroll
                for (int s = 0; s < 16; ++s) { const int j = seg * 16 + s; hs = sa[j * SR + sc] * hs + sbt[j * SR + sc]; hfw[s] = hs; }
            } else {
#pragma unroll
                for (int s = 0; s < 16; ++s) {
                    const int js = 15 - s, j = seg * 16 + js;
                    hs = sa[j * SR + sc] * hs + sbt[j * SR + sc];
                    const int row = lru_row(b, ci, j);
                    const float gr = bf2f(grv[js]);
                    const float th = 1.f - 2.f * frcp_(1.f + __expf(1.5957691216057308f * (gr + 0.044715f * gr * gr * gr)));
                    const float ge = 0.5f * gr * (1.f + th);
                    ((unsigned char*)YIN)[(size_t)row * D + 1024 + chg_s] = (unsigned char)(pk_fp8x4((hfw[js] + hs) * ge * F8_SH, 0.f, 0.f, 0.f) & 0xffu);
                }
            }
        }
    }
}

__device__ __forceinline__ void lru_prep_weights(const Params& p) {
    unsigned char* const ws = ws_();
    const int t = tid_();
    u16* WT = (u16*)(ws + WS_LRUW);
    for (int m = bid_(); m < 32; m += gdim_()) {
        const float* Wg = p.lru_gate_w + (size_t)m * 128 * 128;
        const int j4 = (t & 31) * 4, i8 = (t >> 5) * 8;
        f32x4 r8[8];
#pragma unroll
        for (int q = 0; q < 8; ++q) r8[q] = *reinterpret_cast<const f32x4*>(Wg + (size_t)(i8 + q) * 128 + j4);
#pragma unroll
        for (int jj = 0; jj < 4; ++jj) {
            u32x4 v = {pk_bf16(r8[0][jj], r8[1][jj]), pk_bf16(r8[2][jj], r8[3][jj]), pk_bf16(r8[4][jj], r8[5][jj]), pk_bf16(r8[6][jj], r8[7][jj])};
            *reinterpret_cast<u32x4*>(WT + ((size_t)m * 128 + j4 + jj) * 128 + i8) = v;
        }
    }
}
__device__ __forceinline__ void lru_carry(const Params& p, int item) {
    unsigned char* const ws = ws_();
    const int idx = item * NT + tid_();
    const int c = idx & 1023, b = (idx >> 10) & 3, dir = idx >> 12;
    float* SA = (float*)(ws + WS_LRUS);
    float* SH = SA + 2 * 4 * 68 * 1024;
    const size_t base = ((size_t)(dir * 4 + b) * 68) * 1024 + c;
    float h = 0.f;
#pragma unroll 4
    for (int s = 0; s < 68; ++s) {
        const int cj = dir == 0 ? s : (s < 4 ? 3 - s : 71 - s);
        const float a = SA[base + (size_t)cj * 1024], hl = SH[base + (size_t)cj * 1024];
        SH[base + (size_t)cj * 1024] = h;
        h = a * h + hl;
    }
}

__device__ __forceinline__ void gqa_item(const Params& p, int it, unsigned char* lds) {
    unsigned char* const ws = ws_();
    const int w = tid_() >> 6;
    const u16* P = (const u16*)(ws + WS_P);
    u16* YIN = (u16*)(ws + WS_YIN);
    const int t32 = it & 127, kvh = (it >> 7) & 3, b = it >> 9;
    const int hq = kvh * 4 + (w & 3), t0 = t32 * 32 + (w >> 2) * 16;
    const int kfirst = max((t32 * 32 - 128) & ~63, 0), klast = min(((t32 * 32 - 128) & ~63) + 256, SEQ - 64);
    const int nwin = (klast - kfirst) / 64 + 1;
    const int qrow = b * SEQ + t0;
    auto slabfn = [&](int i, const u16*& kp, const u16*& vp, size_t& kvs) {
        const int row = i < nwin ? b * SEQ + kfirst + i * 64 : NLAT + b * LC + (i - nwin) * 64;
        kp = P + (size_t)row * CD_IN + 1024 + kvh * 64; vp = P + (size_t)row * CD_IN + 1280 + kvh * 64; kvs = CD_IN; };
    auto subfn = [&](int i, int j, int& off) -> bool {
        off = 32 * j;
        if (i >= nwin) return true;
        const int k0 = kfirst + i * 64 + off;
        return k0 + 31 >= t0 - 128 && k0 <= t0 + 15 + 128; };
    auto biasfn = [&](int i, int off, int qi, int ki) -> float {
        if (i >= nwin) return 0.f;
        const int dq = (t0 + qi) - (kfirst + i * 64 + off + ki);
        return (dq > 128 || dq < -128) ? -INFINITY : 0.f; };
    const float sink = p.gqa_sink[hq];
    attn_block<64>(P + (size_t)qrow * CD_IN + hq * 64, CD_IN, nwin + 4, slabfn, subfn, biasfn, 0.125f, sink, ((tid_() & 63) >> 4) == 0 ? 1.f : 0.f, lds,
                   (u16*)((unsigned char*)YIN + (size_t)qrow * D + hq * 64), D);
}

__device__ __forceinline__ void phase_l1_stage1(const Params& p, unsigned char* lds) {
    for (int item = bid_(); item < 2176 + 2048; item += gdim_()) {
        if (item < 2176) { const int ci = item % 68, blk = (item / 68) & 7, b = item / (68 * 8); lru_chunk(p, b, blk, ci, 0, lds); }
        else rope_rows(p, (item - 2176) * 8, 8);
    }
}
__device__ __forceinline__ void phase_l1_stage2(const Params& p, unsigned char* lds) {
    for (int item = bid_(); item < 16 + 2048; item += gdim_()) {
        if (item < 16) lru_carry(p, item);
        else gqa_item(p, item - 16, lds);
    }
}
__device__ __forceinline__ void phase_l1_stage3(const Params& p, unsigned char* lds) {
    for (int item = bid_(); item < 2048; item += gdim_()) { const int cl = item & 63, blk = (item >> 6) & 7, b = item >> 9; lru_chunk(p, b, blk, cl + 4, 1, lds); }
}

__device__ __forceinline__ void phase_rowpass_mid(const Params& p, int l, unsigned char* lds) {
    unsigned char* const ws = ws_();
    float* R = (float*)lds;
    const int t = tid_(), lane = t & 63, w = t >> 6;
    const int nrows = l == 0 ? NTOK : NLAT;
    __syncthreads();
    constexpr int RS = D + 4;
    for (int i = t; i < D * NEXP; i += NT) { const int k = i >> 4, e = i & 15; R[e * RS + k] = p.moe_router[(size_t)l * D * NEXP + i]; }
    __syncthreads();
    const u16* Y = (const u16*)(ws + WS_Y);
    u16* XL1 = (u16*)(ws + WS_XL1);
    u16* H = (u16*)(ws + WS_H);
    float* AFF = (float*)(ws + WS_AFF);
    for (int row = bid_() * 8 + w; row < nrows; row += gdim_() * 8) {
        f32x4 v[8]; float ss = 0.f;
#pragma unroll
        for (int i = 0; i < 8; ++i) { const u32x2 q = *reinterpret_cast<const u32x2*>(Y + (size_t)row * D + (i * 64 + lane) * 4); v[i] = (f32x4){bf_lo(q[0]), bf_hi(q[0]), bf_lo(q[1]), bf_hi(q[1])}; ss += v[i][0] * v[i][0] + v[i][1] * v[i][1] + v[i][2] * v[i][2] + v[i][3] * v[i][3]; }
        ss = wave_sum(ss);
        const float rstd = rsqrtf(ss * (1.f / D) + 1e-6f);
        const float* xr = xin_row(p, row);
        const u16* xb = (const u16*)(ws + WS_XL2) + (size_t)row * D;
        const float* g1 = mod_ptr(ws, l, row, 2);
        const float* nw = p.norm_mix_post + (size_t)l * D;
        float ss1 = 0.f;
#pragma unroll
        for (int i = 0; i < 8; ++i) {
            const int col = (i * 64 + lane) * 4;
            f32x4 x4;
            if (l == 0) x4 = *reinterpret_cast<const f32x4*>(xr + col);
            else { const u32x2 q = *reinterpret_cast<const u32x2*>(xb + col); x4 = (f32x4){bf_lo(q[0]), bf_hi(q[0]), bf_lo(q[1]), bf_hi(q[1])}; }
            const f32x4 w4 = *reinterpret_cast<const f32x4*>(nw + col), g4 = *reinterpret_cast<const f32x4*>(g1 + col);
            const f32x4 x1 = x4 + g4 * (v[i] * rstd * w4);
            { const u32x2 pk1 = {pk_bf16(x1[0], x1[1]), pk_bf16(x1[2], x1[3])}; *reinterpret_cast<u32x2*>(XL1 + (size_t)row * D + col) = pk1; }
            v[i] = x1; ss1 += x1[0] * x1[0] + x1[1] * x1[1] + x1[2] * x1[2] + x1[3] * x1[3];
        }
        ss1 = wave_sum(ss1);
        const float rstd1 = rsqrtf(ss1 * (1.f / D) + 1e-6f);
        const float* sh = mod_ptr(ws, l, row, 3); const float* sc = mod_ptr(ws, l, row, 4);
        const float* nw2 = p.norm_ffn_pre + (size_t)l * D;
#pragma unroll
        for (int i = 0; i < 8; ++i) {
            const int col = (i * 64 + lane) * 4;
            const f32x4 w4 = *reinterpret_cast<const f32x4*>(nw2 + col), s4 = *reinterpret_cast<const f32x4*>(sc + col), h4 = *reinterpret_cast<const f32x4*>(sh + col);
            const f32x4 o = v[i] * rstd1 * w4 * (s4 + 1.f) + h4;
            *reinterpret_cast<unsigned*>((unsigned char*)H + (size_t)row * D + col) = pk_fp8x4(o[0] * F8_SH, o[1] * F8_SH, o[2] * F8_SH, o[3] * F8_SH);
            v[i] = o;
        }
        float lg[16];
        f32x2_t lg2[16];
#pragma unroll
        for (int e = 0; e < 16; ++e) lg2[e] = (f32x2_t){0.f, 0.f};
#pragma unroll
        for (int i = 0; i < 8; ++i) {
            const f32x2_t va = {v[i][0], v[i][1]}, vb = {v[i][2], v[i][3]};
#pragma unroll
            for (int e = 0; e < 16; ++e) {
                const f32x4 r4 = *reinterpret_cast<const f32x4*>(R + e * RS + (i * 64 + lane) * 4);
                lg2[e] = __builtin_elementwise_fma(va, (f32x2_t){r4[0], r4[1]}, lg2[e]);
                lg2[e] = __builtin_elementwise_fma(vb, (f32x2_t){r4[2], r4[3]}, lg2[e]);
            }
        }
#pragma unroll
        for (int e = 0; e < 16; ++e) lg[e] = lg2[e][0] + lg2[e][1];
        const bool b5 = lane & 32, b4 = lane & 16, b3 = lane & 8, b2 = lane & 4;
        float t8[8], t4[4], t2[2], lgt;
#pragma unroll
        for (int j = 0; j < 8; ++j) { const float keep = b5 ? lg[8 + j] : lg[j], send = b5 ? lg[j] : lg[8 + j]; t8[j] = keep + partner_x32(send); }
#pragma unroll
        for (int j = 0; j < 4; ++j) { const float keep = b4 ? t8[4 + j] : t8[j], send = b4 ? t8[j] : t8[4 + j]; t4[j] = keep + partner_x16(send); }
#pragma unroll
        for (int j = 0; j < 2; ++j) { const float keep = b3 ? t4[2 + j] : t4[j], send = b3 ? t4[j] : t4[2 + j]; t2[j] = keep + dpp_f<0x140>(send); }
        { const float keep = b2 ? t2[1] : t2[0], send = b2 ? t2[0] : t2[1]; lgt = keep + dpp_f<0x141>(send); }
        lgt += dpp_f<0x4E>(lgt); lgt += dpp_f<0xB1>(lgt);
        const float mx = wave_max(lgt);
        const float pe = __expf(lgt - mx);
        const float den = wave_sum(pe) * 0.25f;
        if ((lane & 3) == 0) AFF[(size_t)row * 16 + ((b5 ? 8 : 0) + (b4 ? 4 : 0) + (b3 ? 2 : 0) + (b2 ? 1 : 0))] = pe / den;
    }
}

__device__ __forceinline__ void phase_topk(const Params& p, int l, unsigned char* lds) {
    unsigned char* const ws = ws_();
    unsigned* keys = (unsigned*)lds;
    unsigned* hist = keys + 4096;
    unsigned* misc = hist + 256;
    const int t = tid_(), lane = t & 63, w = t >> 6;
    const float* AFF = (const float*)(ws + WS_AFF);
    int* SLOT = (int*)(ws + WS_SLOT);
    int* EROW = (int*)(ws + WS_EROW);
    float* EGATE = (float*)(ws + WS_EGATE);
    const int nitems = l == 0 ? 128 : 64;
    for (int item = bid_(); item < nitems; item += gdim_()) {
        const int kind = item >> 6, b = (item >> 4) & 3, ex = item & 15;
        const int n = kind ? LC : SEQ, cap = n / 8, rowbase = kind ? NLAT + b * LC : b * SEQ;
        __syncthreads();
        for (int i = t; i < n; i += NT) keys[i] = __float_as_uint(AFF[(size_t)(rowbase + i) * 16 + ex]);
        unsigned prefix = 0u, mask = 0u; int kth = cap;
        for (int shift = 24; shift >= 0; shift -= 8) {
            __syncthreads();
            if (t < 256) hist[t] = 0u;
            __syncthreads();
            for (int i = t; i < n; i += NT) { const unsigned k = keys[i]; if ((k & mask) == prefix) atomicAdd(&hist[(k >> shift) & 255u], 1u); }
            __syncthreads();
            if (t < 256) {
                unsigned above = 0u;
                for (int d2 = t + 1; d2 < 256; ++d2) above += hist[d2];
                const unsigned here = hist[t];
                if ((int)above < kth && (int)(above + here) >= kth) { misc[0] = (unsigned)t; misc[1] = (unsigned)(kth - (int)above); }
            }
            __syncthreads();
            prefix |= misc[0] << shift; mask |= 255u << shift; kth = (int)misc[1];
        }
        const unsigned T = prefix; const int need_eq = kth;
        int cgt = 0, ceq = 0;
        const int base = t * 8;
        if (base < n) {
#pragma unroll
            for (int q = 0; q < 8; ++q) { const unsigned k = keys[base + q]; cgt += (k > T); ceq += (k == T); }
        }
        int packed = cgt | (ceq << 16);
        int incl = packed;
#pragma unroll
        for (int o = 1; o < 64; o <<= 1) { const int nb = __shfl_up(incl, o, 64); if (lane >= o) incl += nb; }
        __syncthreads();
        if (lane == 63) misc[8 + w] = (unsigned)incl;
        __syncthreads();
        int woff = 0, total = 0;
#pragma unroll
        for (int q = 0; q < 8; ++q) { const int v = (int)misc[8 + q]; if (q < w) woff += v; total += v; }
        const int excl = woff + incl - packed;
        int pgt = excl & 0xffff, peq = excl >> 16;
        const int tot_gt = total & 0xffff;
        const int sbase = kind ? 2048 + b * 32 : b * 512;
        if (base < n) {
#pragma unroll
            for (int q = 0; q < 8; ++q) {
                const unsigned k = keys[base + q];
                const int row = rowbase + base + q;
                int pos = -1;
                if (k > T) { pos = pgt; ++pgt; }
                else if (k == T) { if (peq < need_eq) pos = tot_gt + peq; ++peq; }
                if (pos >= 0) { const int sl = sbase + pos; EROW[ex * EPAD + sl] = row; EGATE[ex * EPAD + sl] = __uint_as_float(k); SLOT[(size_t)row * 16 + ex] = sl; }
                else SLOT[(size_t)row * 16 + ex] = -1;
            }
        }
        if (kind == 1 && b == 3) for (int i = t; i < EPAD - 2176; i += NT) EROW[ex * EPAD + 2176 + i] = rowbase;
    }
}

__device__ __forceinline__ void phase_final(const Params& p, int l) {
    unsigned char* const ws = ws_();
    const int lane = tid_() & 63, w = __builtin_amdgcn_readfirstlane(tid_() >> 6);
    const int nrows = l == 0 ? NTOK : NLAT;
    const u16* YEXP = (const u16*)(ws + WS_YEXP);
    const int* SLOT = (const int*)(ws + WS_SLOT);
    const u16* XL1 = (const u16*)(ws + WS_XL1);
    u16* XL2 = (u16*)(ws + WS_XL2);
    u16* H = (u16*)(ws + WS_H);
    const int stride = gdim_() * 8;
    struct Pre { u32x2 xl[8], q0[8], q1[8]; };
    auto slots_of = [&](int row) -> int { const int s = SLOT[(size_t)min(row, nrows - 1) * 16 + (lane & 15)]; return (row < nrows && lane < 16) ? s : -1; };
    auto prefetch = [&](int row, int myslot, Pre& pr) {
        const int rc = min(row, nrows - 1);
        unsigned long long em = __ballot(myslot >= 0);
        const int e0 = em ? __builtin_ctzll(em) : 0; em &= em - 1;
        const int e1 = em ? __builtin_ctzll(em) : e0;
        const int sl0 = max(__shfl(myslot, e0, 64), 0), sl1 = max(__shfl(myslot, e1, 64), 0);
        const u16* y0 = YEXP + ((size_t)e0 * EPAD + sl0) * D; const u16* y1 = YEXP + ((size_t)e1 * EPAD + sl1) * D;
#pragma unroll
        for (int i = 0; i < 8; ++i) pr.xl[i] = *reinterpret_cast<const u32x2*>(XL1 + (size_t)rc * D + (i * 64 + lane) * 4);
#pragma unroll
        for (int i = 0; i < 8; ++i) { pr.q0[i] = *reinterpret_cast<const u32x2*>(y0 + (i * 64 + lane) * 4); pr.q1[i] = *reinterpret_cast<const u32x2*>(y1 + (i * 64 + lane) * 4); }
    };
    int row = bid_() * 8 + w;
    int slot_c = slots_of(row), slot_n = slots_of(row + stride);
    Pre cur; prefetch(row, slot_c, cur);
    for (; row < nrows; row += stride) {
        const int slot_nn = slots_of(row + 2 * stride);
        Pre nxt; prefetch(row + stride, slot_n, nxt);
        f32x4 v[8];
#pragma unroll
        for (int i = 0; i < 8; ++i) v[i] = (f32x4){0.f, 0.f, 0.f, 0.f};
        unsigned long long em = __ballot(slot_c >= 0);
        if (em) {
            em &= em - 1;
            const float f1 = em ? 1.f : 0.f;
            if (em) em &= em - 1;
#pragma unroll
            for (int i = 0; i < 8; ++i) {
                v[i][0] = bf_lo(cur.q0[i][0]) + f1 * bf_lo(cur.q1[i][0]); v[i][1] = bf_hi(cur.q0[i][0]) + f1 * bf_hi(cur.q1[i][0]);
                v[i][2] = bf_lo(cur.q0[i][1]) + f1 * bf_lo(cur.q1[i][1]); v[i][3] = bf_hi(cur.q0[i][1]) + f1 * bf_hi(cur.q1[i][1]);
            }
        }
        while (em) {
            const int e0 = __builtin_ctzll(em); em &= em - 1;
            const int sl0 = __shfl(slot_c, e0, 64);
            const u16* y0 = YEXP + ((size_t)e0 * EPAD + sl0) * D;
#pragma unroll
            for (int i = 0; i < 8; ++i) { const u32x2 q = *reinterpret_cast<const u32x2*>(y0 + (i * 64 + lane) * 4); v[i][0] += bf_lo(q[0]); v[i][1] += bf_hi(q[0]); v[i][2] += bf_lo(q[1]); v[i][3] += bf_hi(q[1]); }
        }
        float ss = 0.f;
#pragma unroll
        for (int i = 0; i < 8; ++i) ss += v[i][0] * v[i][0] + v[i][1] * v[i][1] + v[i][2] * v[i][2] + v[i][3] * v[i][3];
        ss = wave_sum(ss);
        const float rstd = rsqrtf(ss * (1.f / D) + 1e-6f);
        const float* g2 = mod_ptr(ws, l, row, 5);
        const float* nw = p.norm_ffn_post + (size_t)l * D;
        float ss2 = 0.f;
#pragma unroll
        for (int i = 0; i < 8; ++i) {
            const int col = (i * 64 + lane) * 4;
            const f32x4 x4 = {bf_lo(cur.xl[i][0]), bf_hi(cur.xl[i][0]), bf_lo(cur.xl[i][1]), bf_hi(cur.xl[i][1])};
            const f32x4 w4 = *reinterpret_cast<const f32x4*>(nw + col), g4 = *reinterpret_cast<const f32x4*>(g2 + col);
            const f32x4 x2 = x4 + g4 * (v[i] * rstd * w4);
            if (l == 0) { const u32x2 pk2 = {pk_bf16(x2[0], x2[1]), pk_bf16(x2[2], x2[3])}; *reinterpret_cast<u32x2*>(XL2 + (size_t)row * D + col) = pk2; }
            else *reinterpret_cast<f32x4*>(p.out + (size_t)row * D + col) = x2;
            v[i] = x2; ss2 += x2[0] * x2[0] + x2[1] * x2[1] + x2[2] * x2[2] + x2[3] * x2[3];
        }
        if (l == 0) {
            ss2 = wave_sum(ss2);
            const float rstd2 = rsqrtf(ss2 * (1.f / D) + 1e-6f);
            const float* sh = mod_ptr(ws, 1, row, 0); const float* sc = mod_ptr(ws, 1, row, 1);
            const float* nw1 = p.norm_mix_pre + D;
#pragma unroll
            for (int i = 0; i < 8; ++i) {
                const int col = (i * 64 + lane) * 4;
                const f32x4 w4 = *reinterpret_cast<const f32x4*>(nw1 + col), s4 = *reinterpret_cast<const f32x4*>(sc + col), h4 = *reinterpret_cast<const f32x4*>(sh + col);
                const f32x4 o = v[i] * rstd2 * w4 * (s4 + 1.f) + h4;
                if (WIN_F8_L1) *reinterpret_cast<unsigned*>((unsigned char*)H + (size_t)row * D + col) = pk_fp8x4(o[0] * F8_SH, o[1] * F8_SH, o[2] * F8_SH, o[3] * F8_SH);
                else { const u32x2 pk = {pk_bf16(o[0], o[1]), pk_bf16(o[2], o[3])}; *reinterpret_cast<u32x2*>(H + (size_t)row * D + col) = pk; }
            }
        }
        cur = nxt; slot_c = slot_n; slot_n = slot_nn;
    }
}

__global__ void __launch_bounds__(NT, 2) fwd_kernel(Params p) {
    unsigned char* lds = g_lds;
    unsigned char* wlds = lds + 512;
    if (threadIdx.x == 0) { *reinterpret_cast<uint4*>(lds) = make_uint4(0u, 0u, 0u, 0u); ((volatile LAS int*)(g_lds))[4] = (int)blockIdx.x; ((volatile LAS int*)(g_lds))[5] = (int)gridDim.x; *(volatile LAS unsigned long long*)((LAS unsigned char*)(g_lds) + 24) = (unsigned long long)p.ws; }
    if ((threadIdx.x & 63) == 0) ((volatile LAS int*)(g_lds))[8 + hw_slot_()] = threadIdx.x >> 6;
    __syncthreads();
    (void)xcd_barrier_post((unsigned*)(ws_() + WS_BAR), (volatile LAS unsigned*)lds);
#define GRID_BARRIER() do { XcdBarrier _b; _b.bar = (unsigned*)(ws_() + WS_BAR); _b.x = xb_xcc_id(); _b.st = (volatile LAS unsigned*)lds; xcd_barrier(_b); } while (0)
#ifndef PH_MASK
#define PH_MASK 0xFFFFFFFFu
#endif
#ifndef PROBE_REP_MASK
#define PROBE_REP_MASK 0u
#endif
#define PHASE(id, body) do { if (((PH_MASK >> ((id) % 32)) & 1u) && p.ph_lo <= (id) && (id) < p.ph_hi) { \
    for (int _r = 0; _r < ((((unsigned)PROBE_REP_MASK >> ((id) % 32)) & 1u) ? 2 : 1); ++_r) { body; if ((id) + 1 < p.ph_hi || _r == 0) { if ((id) + 1 < p.ph_hi) GRID_BARRIER(); } } } } while (0)
    PHASE(0, { phase_mod(p, wlds); phase_convert_dense(p, wlds); });
    PHASE(1, { phase_norm_mod(p, 0, wlds); lru_prep_weights(p); });
#pragma unroll
    for (int l = 0; l < 2; ++l) {
        const int pb = 2 + 10 * l;
        if (l == 0) PHASE(pb + 0, phase_gemm_dense<WIN_F8_L0>(p, (const u16*)(ws_() + WS_H), NTOK, (const u16*)(ws_() + WS_WT_ABIN), AB_IN, (u16*)(ws_() + WS_P), AB_IN, nullptr, wlds));
        else PHASE(pb + 0, phase_gemm_dense<WIN_F8_L1>(p, (const u16*)(ws_() + WS_H), NTOK, (const u16*)(ws_() + WS_WT_CDIN), CD_IN, (u16*)(ws_() + WS_P), CD_IN, nullptr, wlds));
        if (l == 0) {
            PHASE(pb + 1, phase_mlstm(p, wlds));
            PHASE(pb + 2, phase_l0_stage2(p, wlds));
        } else {
            PHASE(pb + 1, phase_l1_stage1(p, wlds));
            PHASE(pb + 2, phase_l1_stage2(p, wlds));
            PHASE(pb + 3, phase_l1_stage3(p, wlds));
        }
        PHASE(pb + 4, phase_gemm_dense<true>(p, (const u16*)(ws_() + WS_YIN), l == 0 ? NTOK : NLAT, (const u16*)(ws_() + (l == 0 ? WS_WT_ABOUT : WS_WT_CDOUT)), D,
                                       (u16*)(ws_() + WS_Y), D, nullptr, wlds));
        PHASE(pb + 5, phase_rowpass_mid(p, l, wlds));
        PHASE(pb + 6, { phase_topk(p, l, wlds); phase_convert_moe(p, l, wlds); });
        PHASE(pb + 7, phase_moe_a(p, l, wlds));
        PHASE(pb + 8, phase_moe_b(p, l, wlds));
        PHASE(pb + 9, phase_final(p, l));
    }
}


#ifdef DBG_STOP
__global__ void dbg_digest(const unsigned char* ws, size_t off, int kind, size_t nelem, float* out, size_t nout) {
    for (size_t i = (size_t)blockIdx.x * blockDim.x + threadIdx.x; i < nout; i += (size_t)gridDim.x * blockDim.x) {
        float v = 0.f;
        for (size_t j = i; j < nelem; j += nout) {
            if (kind == 0) v += bf2f(((const u16*)(ws + off))[j]);
            else if (kind == 1) v += ((const float*)(ws + off))[j];
            else v += (float)((const int*)(ws + off))[j];
        }
        out[i] = v;
    }
}
#endif
extern "C" void kernel_launch(void* const* d_in, const int* in_sizes, int n_in, void* d_out, int out_size, void* d_ws, size_t ws_size, hipStream_t stream) {
    static int grid = 0;
    if (grid == 0) {
        if (n_in != 27 || ws_size < WS_END) { fprintf(stderr, "kernel_launch: unexpected n_in %d / ws %zu (need %zu)\n", n_in, ws_size, (size_t)WS_END); grid = -1; return; }
        int dev = 0, cus = 0, per_cu = 0;
        hipGetDevice(&dev);
        hipDeviceGetAttribute(&cus, hipDeviceAttributeMultiprocessorCount, dev);
        if (hipFuncSetAttribute((const void*)fwd_kernel, hipFuncAttributeMaxDynamicSharedMemorySize, LDS_BYTES) != hipSuccess) { fprintf(stderr, "kernel_launch: hipFuncSetAttribute failed\n"); grid = -1; return; }
        hipOccupancyMaxActiveBlocksPerMultiprocessor(&per_cu, (const void*)fwd_kernel, NT, LDS_BYTES);
        (void)hipGetLastError();
        if (per_cu < 1) fprintf(stderr, "kernel_launch: occupancy query reports %d blocks per CU\n", per_cu);
        grid = cus > 0 ? cus : 256;
    }
    if (grid < 0) return;
    hipMemsetAsync((char*)d_ws + WS_BAR, 0, XCD_BAR_WORDS * sizeof(unsigned), stream);
    Params p; memset(&p, 0, sizeof(p));
    const float** f = (const float**)&p;
    for (int i = 0; i < 27; ++i) f[i] = (const float*)d_in[i];
    p.out = (float*)d_out; p.ws = (unsigned char*)d_ws;
#if N_LAUNCH_MODE == 1
    p.ph_lo = 0; p.ph_hi = NPH;
    hipLaunchKernelGGL(fwd_kernel, dim3(grid), dim3(NT), LDS_BYTES, stream, p);
#else
#ifdef DBG_STOP
    for (int ph = 0; ph <= DBG_STOP; ++ph) { p.ph_lo = ph; p.ph_hi = ph + 1; hipLaunchKernelGGL(fwd_kernel, dim3(grid), dim3(NT), LDS_BYTES, stream, p); }
    hipLaunchKernelGGL(dbg_digest, dim3(2048), dim3(256), 0, stream, (const unsigned char*)d_ws, (size_t)DBG_OFF, (int)DBG_KIND, (size_t)DBG_NELEM, (float*)d_out, (size_t)out_size);
#else
    for (int ph = 0; ph < NPH; ++ph) { p.ph_lo = ph; p.ph_hi = ph + 1; hipLaunchKernelGGL(fwd_kernel, dim3(grid), dim3(NT), LDS_BYTES, stream, p); }
#endif
#endif
}
```

```cpp
#include <hip/hip_runtime.h>
#include <stdint.h>
#include <stdio.h>
#include <string.h>

#ifndef N_LAUNCH_MODE
#define N_LAUNCH_MODE 1
#endif

typedef unsigned short u16;
typedef short bf16x8 __attribute__((ext_vector_type(8)));
typedef float f32x4 __attribute__((ext_vector_type(4)));
typedef unsigned u32x4 __attribute__((ext_vector_type(4)));
typedef unsigned u32x2 __attribute__((ext_vector_type(2)));

#define NT 512
constexpr int D = 2048, BATCH = 4, SEQ = 4096, LC = 256;
constexpr int NLAT = BATCH * SEQ, NCTX = BATCH * LC, NTOK = NLAT + NCTX;
constexpr int AB_IN = 7184, CD_IN = 3584;
constexpr int NEXP = 16, FF = 2048, EPAD = 2304;
constexpr int NPH = 22;
constexpr int LDS_BYTES = 150 * 1024;

constexpr size_t al256(size_t x) { return (x + 255) & ~(size_t)255; }
constexpr size_t WS_BAR = 0;
constexpr size_t WS_MOD = 16384;
constexpr size_t WS_XL1 = al256(WS_MOD + 2 * 5 * 12288 * 4);
constexpr size_t WS_XL2 = al256(WS_XL1 + (size_t)NTOK * D * 4);
constexpr size_t WS_H = al256(WS_XL2 + (size_t)NTOK * D * 4);
constexpr size_t WS_P = al256(WS_H + (size_t)NTOK * D * 2);
constexpr size_t WS_G = al256(WS_P + (size_t)NTOK * AB_IN * 2);
constexpr size_t WS_HM = al256(WS_G + (size_t)NTOK * 16 * 4);
constexpr size_t WS_YIN = al256(WS_HM + (size_t)2 * NTOK * 1024 * 2);
constexpr size_t WS_Y = al256(WS_YIN + (size_t)NTOK * D * 2);
constexpr size_t WS_AFF = al256(WS_Y + (size_t)NTOK * D * 4);
constexpr size_t WS_SLOT = al256(WS_AFF + (size_t)NTOK * 16 * 4);
constexpr size_t WS_EROW = al256(WS_SLOT + (size_t)NTOK * 16 * 4);
constexpr size_t WS_EGATE = al256(WS_EROW + (size_t)NEXP * EPAD * 4);
constexpr size_t WS_ACT = al256(WS_EGATE + (size_t)NEXP * EPAD * 4);
constexpr size_t WS_YEXP = al256(WS_ACT + (size_t)NEXP * EPAD * FF * 2);
constexpr size_t WS_LRUS = al256(WS_YEXP + (size_t)NEXP * EPAD * D * 2);
constexpr size_t WS_LRUW = al256(WS_LRUS + (size_t)2 * 2 * 4 * 68 * 1024 * 4);
constexpr size_t WS_WT_ABIN = al256(WS_LRUW + (size_t)32 * 128 * 128 * 2);
constexpr size_t WS_WT_ABOUT = al256(WS_WT_ABIN + (size_t)AB_IN * D * 2);
constexpr size_t WS_WT_CDIN = al256(WS_WT_ABOUT + (size_t)D * D * 2);
constexpr size_t WS_WT_CDOUT = al256(WS_WT_CDIN + (size_t)CD_IN * D * 2);
constexpr size_t WS_WT_W1 = al256(WS_WT_CDOUT + (size_t)D * D * 2);
constexpr size_t WS_WT_W3 = al256(WS_WT_W1 + (size_t)NEXP * D * FF * 2);
constexpr size_t WS_WT_W2 = al256(WS_WT_W3 + (size_t)NEXP * D * FF * 2);
constexpr size_t WS_ROPE = al256(WS_WT_W2 + (size_t)NEXP * D * FF * 2);
constexpr size_t WS_END = al256(WS_ROPE + 2 * 64 * 16 * 4);

extern __shared__ __attribute__((aligned(16))) unsigned char g_lds[];

struct Params {
    const float *x, *c, *ctx, *c_ctx, *ada_w, *ada_b, *norm_mix_pre, *norm_mix_post, *norm_ffn_pre, *norm_ffn_post;
    const float *ab_w_in, *ab_w_out, *mlstm_gate_b, *mlstm_norm, *na_rpb;
    const float *cd_w_in, *cd_w_out, *gqa_sink, *lru_conv_w, *lru_conv_b, *lru_gate_w, *lru_gate_b, *lru_lambda;
    const float *moe_router, *moe_w1, *moe_w3, *moe_w2;
    float* out;
    unsigned char* ws;
    int ph_lo, ph_hi;
};

#define XB_TMO      128
#define XB_XCNT(j)  (256  + 64 * (j))
#define XB_XSUB(j)  (1280 + 64 * (j))
#define XB_XGEN(j)  (2304 + 64 * (j))
#define XB_TOP      3328
#define XB_TOPGEN   3392
#define XCD_BAR_WORDS 3456
#define XB_SPIN_CAP (1u << 22)
#define LAS __attribute__((address_space(3)))

__device__ __forceinline__ unsigned xb_ld(unsigned* p)              { return __hip_atomic_load(p, __ATOMIC_RELAXED, __HIP_MEMORY_SCOPE_AGENT); }
__device__ __forceinline__ unsigned xb_add(unsigned* p, unsigned v) { return __hip_atomic_fetch_add(p, v, __ATOMIC_RELAXED, __HIP_MEMORY_SCOPE_AGENT); }
__device__ __forceinline__ unsigned xb_xcc_id() { return (unsigned)__builtin_amdgcn_s_getreg((3 << 11) | 20) & 0xFu; }
#define XB_SPIN(cond, bar) do { unsigned _sp = 0; while (cond) { __builtin_amdgcn_s_sleep(1); \
    if ((++_sp & 255u) == 0u) { if (xb_ld(&(bar)[XB_TMO])) break; if (_sp > XB_SPIN_CAP) { atomicAdd(&(bar)[XB_TMO], 1u); break; } } } } while (0)

struct XcdBarrier {
    unsigned* bar; unsigned x;
    volatile LAS unsigned* st;
};
__device__ __forceinline__ XcdBarrier xcd_barrier_post(unsigned* bar, volatile LAS unsigned* st) {
    XcdBarrier b; b.bar = bar; b.x = xb_xcc_id(); b.st = st;
    if (threadIdx.x == 0) (void)xb_add(&bar[XB_XCNT(b.x)], 1u);
    return b;
}
__device__ __forceinline__ void xcd_barrier_complete(unsigned* bar, unsigned x, unsigned& nloc, unsigned& nx) {
    const unsigned G = gridDim.x * gridDim.y * gridDim.z;
    unsigned sum, cnt, mine, sp = 0u;
    for (;;) {
        sum = 0u; cnt = 0u; mine = 0u;
#pragma unroll
        for (unsigned j = 0; j < 16; ++j) { const unsigned c = xb_ld(&bar[XB_XCNT(j)]); sum += c; cnt += (c > 0u) ? 1u : 0u; mine = (j == x) ? c : mine; }
        if (sum == G) break;
        __builtin_amdgcn_s_sleep(1);
        if ((++sp & 255u) == 0u) { if (xb_ld(&bar[XB_TMO])) break; if (sp > XB_SPIN_CAP) { atomicAdd(&bar[XB_TMO], 1u); break; } }
    }
    nloc = mine > 0u ? mine : 1u; nx = cnt > 0u ? cnt : 1u;
}
__device__ __forceinline__ void xcd_barrier(const XcdBarrier& b) {
    asm volatile("s_waitcnt vmcnt(0)" ::: "memory");
    __syncthreads();
    if (threadIdx.x == 0) {
        unsigned* bar = b.bar;
        __builtin_amdgcn_s_waitcnt(0);
        unsigned nloc = b.st[0], nx = b.st[1];
        if (nloc == 0u) { xcd_barrier_complete(bar, b.x, nloc, nx); b.st[0] = nloc; b.st[1] = nx; }
        const unsigned old = xb_add(&bar[XB_XSUB(b.x)], 1u);
        const unsigned gen = old / nloc;
        if (old + 1u == (gen + 1u) * nloc) {
            __builtin_amdgcn_fence(__ATOMIC_RELEASE, "agent");
            asm volatile("s_waitcnt vmcnt(0)" ::: "memory");
            const unsigned og = xb_add(&bar[XB_TOP], 1u);
            const unsigned tg = og / nx;
            if (og + 1u == (tg + 1u) * nx) xb_add(&bar[XB_TOPGEN], 1u);
            else XB_SPIN(xb_ld(&bar[XB_TOPGEN]) == tg, bar);
            __builtin_amdgcn_fence(__ATOMIC_ACQUIRE, "agent");
            xb_add(&bar[XB_XGEN(b.x)], 1u);
            asm volatile("s_waitcnt vmcnt(0)" ::: "memory");
        } else {
            XB_SPIN(xb_ld(&bar[XB_XGEN(b.x)]) == gen, bar);
            __builtin_amdgcn_fence(__ATOMIC_ACQUIRE, "agent");
            asm volatile("s_waitcnt vmcnt(0)" ::: "memory");
        }
    }
    __syncthreads();
}

typedef float f32x2_t __attribute__((ext_vector_type(2)));
typedef __bf16 bf16x2_t __attribute__((ext_vector_type(2)));
__device__ __forceinline__ unsigned pk_bf16(float lo, float hi) { f32x2_t v = {lo, hi}; return __builtin_bit_cast(unsigned, __builtin_convertvector(v, bf16x2_t)); }
__device__ __forceinline__ float bf_lo(unsigned u) { return __uint_as_float(u << 16); }
__device__ __forceinline__ float bf_hi(unsigned u) { return __uint_as_float(u & 0xffff0000u); }
__device__ __forceinline__ float bf2f(u16 v) { return __uint_as_float(((unsigned)v) << 16); }
typedef int i32x4 __attribute__((ext_vector_type(4)));
typedef int i32x8 __attribute__((ext_vector_type(8)));
constexpr bool WIN_F8_L0 = false, WIN_F8_L1 = true;
constexpr float F8_SW = 256.f, F8_SH = 8.f, F8_SA = 4.f;
__device__ __forceinline__ float f8_clamp(float x) { return __builtin_amdgcn_fmed3f(x, -448.f, 448.f); }
__device__ __forceinline__ unsigned pk_fp8x4(float a, float b, float c, float d) {
    unsigned r = 0u;
    r = (unsigned)__builtin_amdgcn_cvt_pk_fp8_f32(f8_clamp(a), f8_clamp(b), (int)r, false);
    r = (unsigned)__builtin_amdgcn_cvt_pk_fp8_f32(f8_clamp(c), f8_clamp(d), (int)r, true);
    return r; }
__device__ __forceinline__ i32x8 cat8(bf16x8 lo, bf16x8 hi) { return __builtin_shufflevector(__builtin_bit_cast(i32x4, lo), __builtin_bit_cast(i32x4, hi), 0, 1, 2, 3, 4, 5, 6, 7); }
__device__ __forceinline__ u16 f2bf(float f) { return (u16)(pk_bf16(f, 0.f) & 0xffffu); }
template <int CTRL> __device__ __forceinline__ float dpp_f(float v) { return __uint_as_float((unsigned)__builtin_amdgcn_update_dpp(0, (int)__float_as_uint(v), CTRL, 0xf, 0xf, true)); }
__device__ __forceinline__ float row_sum16(float v) { v += dpp_f<0xB1>(v); v += dpp_f<0x4E>(v); v += dpp_f<0x141>(v); v += dpp_f<0x140>(v); return v; }
__device__ __forceinline__ float row_max16(float v) { v = fmaxf(v, dpp_f<0xB1>(v)); v = fmaxf(v, dpp_f<0x4E>(v)); v = fmaxf(v, dpp_f<0x141>(v)); v = fmaxf(v, dpp_f<0x140>(v)); return v; }
__device__ __forceinline__ float rdlane_f(float v, int l) { return __uint_as_float((unsigned)__builtin_amdgcn_readlane((int)__float_as_uint(v), l)); }
__device__ __forceinline__ float sum_x16(float v) { const auto r = __builtin_amdgcn_permlane16_swap(__float_as_uint(v), __float_as_uint(v), false, false); return __uint_as_float(r[0]) + __uint_as_float(r[1]); }
__device__ __forceinline__ float sum_x32(float v) { const auto r = __builtin_amdgcn_permlane32_swap(__float_as_uint(v), __float_as_uint(v), false, false); return __uint_as_float(r[0]) + __uint_as_float(r[1]); }
__device__ __forceinline__ float max_x16(float v) { const auto r = __builtin_amdgcn_permlane16_swap(__float_as_uint(v), __float_as_uint(v), false, false); return fmaxf(__uint_as_float(r[0]), __uint_as_float(r[1])); }
__device__ __forceinline__ float max_x32(float v) { const auto r = __builtin_amdgcn_permlane32_swap(__float_as_uint(v), __float_as_uint(v), false, false); return fmaxf(__uint_as_float(r[0]), __uint_as_float(r[1])); }
__device__ __forceinline__ float partner_x16(float v) { const auto r = __builtin_amdgcn_permlane16_swap(__float_as_uint(v), __float_as_uint(v), false, false); return __uint_as_float(r[0] ^ r[1] ^ __float_as_uint(v)); }
__device__ __forceinline__ float partner_x32(float v) { const auto r = __builtin_amdgcn_permlane32_swap(__float_as_uint(v), __float_as_uint(v), false, false); return __uint_as_float(r[0] ^ r[1] ^ __float_as_uint(v)); }
__device__ __forceinline__ float wave_sum(float v) { return sum_x32(sum_x16(row_sum16(v))); }
__device__ __forceinline__ float wave_max(float v) { return max_x32(max_x16(row_max16(v))); }
__device__ __forceinline__ int hw_slot_() { return (int)(__builtin_amdgcn_s_getreg((5 << 11) | 4) & 63u); }
__device__ __forceinline__ int tid_() {
    int lane; asm volatile("v_mbcnt_lo_u32_b32 %0, -1, 0\n\tv_mbcnt_hi_u32_b32 %0, -1, %0" : "=v"(lane));
    const int w = ((volatile LAS int*)(g_lds))[8 + hw_slot_()];
    int t = __builtin_amdgcn_readfirstlane(w) * 64 + lane; asm volatile("" : "+v"(t)); return t; }
__device__ __forceinline__ int bid_() { unsigned o = 16; asm volatile("" : "+v"(o)); return __builtin_amdgcn_readfirstlane(*(const LAS int*)((LAS unsigned char*)(g_lds) + o)); }
__device__ __forceinline__ int gdim_() { unsigned o = 20; asm volatile("" : "+v"(o)); return __builtin_amdgcn_readfirstlane(*(const LAS int*)((LAS unsigned char*)(g_lds) + o)); }
__device__ __forceinline__ unsigned char* ws_() {
    unsigned o = 24; asm volatile("" : "+v"(o));
    const u32x2 v = *(const LAS u32x2*)((LAS unsigned char*)(g_lds) + o);
    const unsigned long long a = ((unsigned long long)(unsigned)__builtin_amdgcn_readfirstlane((int)v[1]) << 32) | (unsigned)__builtin_amdgcn_readfirstlane((int)v[0]);
    return (unsigned char*)(__attribute__((address_space(1))) unsigned char*)a; }
__device__ __forceinline__ float frcp_(float x) { return __builtin_amdgcn_rcpf(x); }
__device__ __forceinline__ float sigmoidf_(float x) { return frcp_(1.f + __expf(-x)); }
__device__ __forceinline__ f32x4 mfma16(bf16x8 a, bf16x8 b, f32x4 c) { return __builtin_amdgcn_mfma_f32_16x16x32_bf16(a, b, c, 0, 0, 0); }
__device__ __forceinline__ bf16x8 ld_frag_g(const u16* p) { return *reinterpret_cast<const bf16x8*>(p); }
__device__ __forceinline__ bf16x8 ld_frag_s(const u16* p) { return *reinterpret_cast<const bf16x8*>(p); }
__device__ __forceinline__ bf16x8 mk_frag(unsigned a, unsigned b, unsigned c, unsigned d) { u32x4 v = {a, b, c, d}; return __builtin_bit_cast(bf16x8, v); }

__device__ __forceinline__ void rowdot16(const f32x4 (&v)[8], const float* R, int lane, float (&lg)[16]) {
    constexpr int RS = D + 4;
    const float* Rl = R + lane * 4;
    f32x4 ra[8], rb[8];
#pragma unroll
    for (int i = 0; i < 8; ++i) ra[i] = *reinterpret_cast<const f32x4*>(Rl + i * 256);
#pragma unroll
    for (int e = 0; e < 16; e += 2) {
#pragma unroll
        for (int i = 0; i < 8; ++i) rb[i] = *reinterpret_cast<const f32x4*>(Rl + (e + 1) * RS + i * 256);
        { f32x2_t a0 = {0.f, 0.f}, a1 = {0.f, 0.f};
#pragma unroll
          for (int i = 0; i < 8; ++i) { a0 = __builtin_elementwise_fma((f32x2_t){v[i][0], v[i][1]}, (f32x2_t){ra[i][0], ra[i][1]}, a0); a1 = __builtin_elementwise_fma((f32x2_t){v[i][2], v[i][3]}, (f32x2_t){ra[i][2], ra[i][3]}, a1); }
          lg[e] = (a0[0] + a0[1]) + (a1[0] + a1[1]); }
        __builtin_amdgcn_sched_barrier(0);
        if (e + 2 < 16) {
#pragma unroll
            for (int i = 0; i < 8; ++i) ra[i] = *reinterpret_cast<const f32x4*>(Rl + (e + 2) * RS + i * 256);
        }
        { f32x2_t a0 = {0.f, 0.f}, a1 = {0.f, 0.f};
#pragma unroll
          for (int i = 0; i < 8; ++i) { a0 = __builtin_elementwise_fma((f32x2_t){v[i][0], v[i][1]}, (f32x2_t){rb[i][0], rb[i][1]}, a0); a1 = __builtin_elementwise_fma((f32x2_t){v[i][2], v[i][3]}, (f32x2_t){rb[i][2], rb[i][3]}, a1); }
          lg[e + 1] = (a0[0] + a0[1]) + (a1[0] + a1[1]); }
        __builtin_amdgcn_sched_barrier(0);
    }
}

__device__ __forceinline__ const float* xin_row(const Params& p, int row) {
    return row < NLAT ? p.x + (size_t)row * D : p.ctx + (size_t)(row - NLAT) * D;
}
__device__ __forceinline__ const float* mod_ptr(const unsigned char* ws, int l, int row, int chunk) {
    const int bb = row < NLAT ? (row >> 12) : 4;
    return (const float*)(ws + WS_MOD) + ((size_t)(l * 5 + bb) * 6 + chunk) * D;
}

__device__ __forceinline__ void phase_mod(const Params& p, unsigned char* lds_raw) {
    unsigned char* const ws = ws_();
    float* scond = (float*)lds_raw;
    float* red = scond + 5 * D;
    const int t = tid_();
    for (int i = t; i < 5 * D; i += NT) { const int r = i >> 11, k = i & 2047; const float v = r < 4 ? p.c[r * D + k] : p.c_ctx[k]; scond[i] = v / (1.f + __expf(-v)); }
    __syncthreads();
    float* mod = (float*)(ws + WS_MOD);
    for (int item = bid_(); item < 192; item += gdim_()) {
        const int l = item / 96, col0 = (item % 96) * 128;
        const int kg = t >> 5, cl = (t & 31) * 4;
        f32x4 acc[5];
#pragma unroll
        for (int r = 0; r < 5; ++r) acc[r] = (f32x4){0.f, 0.f, 0.f, 0.f};
        const float* wp = p.ada_w + ((size_t)l * D + kg * 128) * (6 * D) + col0 + cl;
#pragma unroll 8
        for (int kk = 0; kk < 128; ++kk) {
            const f32x4 w = *reinterpret_cast<const f32x4*>(wp + (size_t)kk * (6 * D));
#pragma unroll
            for (int r = 0; r < 5; ++r) { const float s = scond[r * D + kg * 128 + kk]; acc[r] += w * s; }
        }
#pragma unroll
        for (int r = 0; r < 5; ++r) *reinterpret_cast<f32x4*>(red + (kg * 5 + r) * 128 + cl) = acc[r];
        __syncthreads();
        for (int o = t; o < 640; o += NT) {
            const int r = o >> 7, cc = o & 127;
            float s = p.ada_b[l * 6 * D + col0 + cc];
#pragma unroll
            for (int g = 0; g < 16; ++g) s += red[(g * 5 + r) * 128 + cc];
            mod[(size_t)(l * 5 + r) * 6 * D + col0 + cc] = s;
        }
        __syncthreads();
    }
}

__device__ __forceinline__ void phase_norm_mod(const Params& p, int l, unsigned char* lds) {
    unsigned char* const ws = ws_();
    const int t = tid_(), lane = t & 63, w = t >> 6;
    u16* H = (u16*)(ws + WS_H);
    float* R = (float*)lds;
    constexpr int RS = D + 4;
    float* G = (float*)(ws + WS_G);
    __syncthreads();
    for (int i = t; i < D * 16; i += NT) { const int k = i >> 4, e = i & 15; R[e * RS + k] = p.ab_w_in[(size_t)k * AB_IN + 4096 + e]; }
    __syncthreads();
    f32x4 xq[8];
    const int rstride = gdim_() * 8;
    int row = bid_() * 8 + w;
    if (row < NTOK) { const float* xr = xin_row(p, row); _Pragma("unroll") for (int i = 0; i < 8; ++i) xq[i] = *reinterpret_cast<const f32x4*>(xr + (i * 64 + lane) * 4); }
    for (; row < NTOK; row += rstride) {
        f32x4 v[8]; float ss = 0.f;
#pragma unroll
        for (int i = 0; i < 8; ++i) { v[i] = xq[i]; ss += v[i][0] * v[i][0] + v[i][1] * v[i][1] + v[i][2] * v[i][2] + v[i][3] * v[i][3]; }
        __builtin_amdgcn_sched_barrier(0);
        if (row + rstride < NTOK) { const float* xr = xin_row(p, row + rstride); _Pragma("unroll") for (int i = 0; i < 8; ++i) xq[i] = *reinterpret_cast<const f32x4*>(xr + (i * 64 + lane) * 4); }
        __builtin_amdgcn_sched_barrier(0);
        ss = wave_sum(ss);
        const float rstd = rsqrtf(ss * (1.f / D) + 1e-6f);
        const float* sh = mod_ptr(ws, l, row, 0); const float* sc = mod_ptr(ws, l, row, 1);
        const float* nw = p.norm_mix_pre + (size_t)l * D;
#pragma unroll
        for (int i = 0; i < 8; ++i) {
            const int col = (i * 64 + lane) * 4;
            const f32x4 w4 = *reinterpret_cast<const f32x4*>(nw + col), s4 = *reinterpret_cast<const f32x4*>(sc + col), h4 = *reinterpret_cast<const f32x4*>(sh + col);
            f32x4 o = v[i] * rstd * w4 * (s4 + 1.f) + h4;
            if (WIN_F8_L0) *reinterpret_cast<unsigned*>((unsigned char*)H + (size_t)row * D + col) = pk_fp8x4(o[0] * F8_SH, o[1] * F8_SH, o[2] * F8_SH, o[3] * F8_SH);
            else { const u32x2 pk = {pk_bf16(o[0], o[1]), pk_bf16(o[2], o[3])}; *reinterpret_cast<u32x2*>(H + (size_t)row * D + col) = pk; }
            v[i] = o;
        }
        float lg[16];
        rowdot16(v, R, lane, lg);
        const bool b5 = lane & 32, b4 = lane & 16, b3 = lane & 8, b2 = lane & 4;
        float t8[8], t4[4], t2[2], lgt;
#pragma unroll
        for (int j = 0; j < 8; ++j) { const float keep = b5 ? lg[8 + j] : lg[j], send = b5 ? lg[j] : lg[8 + j]; t8[j] = keep + partner_x32(send); }
#pragma unroll
        for (int j = 0; j < 4; ++j) { const float keep = b4 ? t8[4 + j] : t8[j], send = b4 ? t8[j] : t8[4 + j]; t4[j] = keep + partner_x16(send); }
#pragma unroll
        for (int j = 0; j < 2; ++j) { const float keep = b3 ? t4[2 + j] : t4[j], send = b3 ? t4[j] : t4[2 + j]; t2[j] = keep + dpp_f<0x140>(send); }
        { const float keep = b2 ? t2[1] : t2[0], send = b2 ? t2[0] : t2[1]; lgt = keep + dpp_f<0x141>(send); }
        lgt += dpp_f<0x4E>(lgt); lgt += dpp_f<0xB1>(lgt);
        if ((lane & 3) == 0) G[(size_t)row * 16 + ((b5 ? 8 : 0) + (b4 ? 4 : 0) + (b3 ? 2 : 0) + (b2 ? 1 : 0))] = lgt;
    }
}

__device__ __forceinline__ void convert_item(const float* W, int N, u16* Wt, int kb, int nb, unsigned char* lds) {
    const int t = tid_(), lane = t & 63, w = t >> 6;
    const int n4 = lane * 4, k0 = kb * 64 + w * 8, n0 = nb * 256;
    int col = n0 + n4; if (col > N - 4) col = N - 4;
    f32x4 r8[8];
#pragma unroll
    for (int j = 0; j < 8; ++j) r8[j] = *reinterpret_cast<const f32x4*>(W + (size_t)(k0 + j) * N + col);
    __syncthreads();
#pragma unroll
    for (int jj = 0; jj < 4; ++jj) {
        u32x4 v = {pk_bf16(r8[0][jj], r8[1][jj]), pk_bf16(r8[2][jj], r8[3][jj]), pk_bf16(r8[4][jj], r8[5][jj]), pk_bf16(r8[6][jj], r8[7][jj])};
        const int r = n4 + jj;
        *reinterpret_cast<u32x4*>(lds + r * 128 + ((w ^ ((r >> 2) & 7)) << 4)) = v;
    }
    __syncthreads();
    const int c = t & 7;
#pragma unroll
    for (int i = 0; i < 4; ++i) {
        const int r = (t >> 3) + 64 * i;
        if (n0 + r < N) {
            const u32x4 v = *reinterpret_cast<const u32x4*>(lds + r * 128 + ((c ^ ((r >> 2) & 7)) << 4));
            *reinterpret_cast<u32x4*>(Wt + (size_t)(n0 + r) * 2048 + kb * 64 + c * 8) = v;
        }
    }
}
template <int N>
__device__ __forceinline__ void convert_item8(const float* W, unsigned char* Wt, int kb, int nb, unsigned char* lds) {
    const int t = tid_(), lane = t & 63, w = t >> 6;
    const int n4 = lane * 4, k0 = kb * 128 + w * 16, n0 = nb * 256;
    int col = n0 + n4; if (N % 256 != 0 && col > N - 4) col = N - 4;
    f32x4 r[16];
#pragma unroll
    for (int j = 0; j < 16; ++j) r[j] = *reinterpret_cast<const f32x4*>(W + (size_t)(k0 + j) * N + col);
    __syncthreads();
#pragma unroll
    for (int jj = 0; jj < 4; ++jj) {
        u32x4 v;
#pragma unroll
        for (int q = 0; q < 4; ++q) v[q] = pk_fp8x4(r[4 * q][jj] * F8_SW, r[4 * q + 1][jj] * F8_SW, r[4 * q + 2][jj] * F8_SW, r[4 * q + 3][jj] * F8_SW);
        const int rr = n4 + jj;
        *reinterpret_cast<u32x4*>(lds + rr * 128 + ((w ^ ((rr >> 2) & 7)) << 4)) = v;
    }
    __syncthreads();
    const int c = t & 7;
#pragma unroll
    for (int i = 0; i < 4; ++i) {
        const int rr = (t >> 3) + 64 * i;
        if (N % 256 == 0 || n0 + rr < N) {
            const u32x4 v = *reinterpret_cast<const u32x4*>(lds + rr * 128 + ((c ^ ((rr >> 2) & 7)) << 4));
            *reinterpret_cast<u32x4*>(Wt + (size_t)(n0 + rr) * 2048 + kb * 128 + c * 16) = v;
        }
    }
}
__device__ __forceinline__ void convert_matrix_items(const float* W, int N, u16* Wt, int first, int count, unsigned char* lds) {
    const int nnb = (N + 255) / 256;
    for (int it = first; it < first + count; ++it) convert_item(W, N, Wt, it / nnb, it % nnb, lds);
}
__device__ __forceinline__ void phase_convert_dense(const Params& p, unsigned char* lds) {
    unsigned char* const ws = ws_();
    constexpr int n_ab = (WIN_F8_L0 ? 16 : 32) * 29, n_cd = (WIN_F8_L1 ? 16 : 32) * 14;
    for (int item = bid_(); item < n_ab + 128 + n_cd + 128; item += gdim_()) {
        if (item < n_ab) { if (WIN_F8_L0) convert_item8<AB_IN>(p.ab_w_in, ws + WS_WT_ABIN, item / 29, item % 29, lds); else convert_item(p.ab_w_in, AB_IN, (u16*)(ws + WS_WT_ABIN), item / 29, item % 29, lds); }
        else if (item < n_ab + 128) { const int it = item - n_ab; convert_item8<2048>(p.ab_w_out, ws + WS_WT_ABOUT, it / 8, it % 8, lds); }
        else if (item < n_ab + 128 + n_cd) { const int it = item - n_ab - 128; if (WIN_F8_L1) convert_item8<CD_IN>(p.cd_w_in, ws + WS_WT_CDIN, it / 14, it % 14, lds); else convert_item(p.cd_w_in, CD_IN, (u16*)(ws + WS_WT_CDIN), it / 14, it % 14, lds); }
        else { const int it = item - n_ab - 128 - n_cd; convert_item8<2048>(p.cd_w_out, ws + WS_WT_CDOUT, it / 8, it % 8, lds); }
    }
}
__device__ __forceinline__ void phase_convert_moe(const Params& p, int l, unsigned char* lds) {
    unsigned char* const ws = ws_();
    for (int item = bid_(); item < 3 * NEXP * 128; item += gdim_()) {
        const int which = item / (NEXP * 128), r = item % (NEXP * 128), ex = r >> 7, it = r & 127;
        const float* src = (which == 0 ? p.moe_w1 : (which == 1 ? p.moe_w3 : p.moe_w2)) + (size_t)(l * NEXP + ex) * D * FF;
        unsigned char* dst = ws + (which == 0 ? WS_WT_W1 : (which == 1 ? WS_WT_W3 : WS_WT_W2)) + (size_t)ex * D * FF;
        convert_item8<2048>(src, dst, it >> 3, it & 7, lds);
    }
}

__device__ __forceinline__ int g8_lds_byte(int r, int c) { const int st = (r >> 4) * 2 + (c >> 5), rr = r & 15, cc = c & 31, ob = rr * 64 + cc * 2; return st * 1024 + (ob ^ (((ob >> 9) & 1) << 5)); }
__device__ __forceinline__ void g8_stage_rc(int bb, int& R, int& C) { const int st = bb / 1024, sb = bb % 1024, swz = sb ^ (((sb >> 9) & 1) << 5); R = (st >> 1) * 16 + swz / 64; C = (st & 1) * 32 + (swz % 64) / 2; }
__device__ __forceinline__ int g8_perm32(int rho) { const int n = rho >> 4, i = rho & 15; return 8 * (i >> 2) + 4 * n + (i & 3); }

enum { EPI_BF16 = 0, EPI_SWIGLU = 2, EPI_SCALE = 3, EPI_F8BF16 = 4 };
struct GUnit { const char* a; const char* b0; const char* b1; const int* arow; int m0, n0, mvalid, ncols; u16* ob; int ldo; float* gates; const float* rscale; };
constexpr int G8_HTB = 128 * 64 * 2;
constexpr size_t G8_KSTEP = 128, G8_HSTEP = (size_t)128 * 2048 * 2;

template <int EPI>
__device__ __forceinline__ void g8_epilogue(const f32x4 (&acc)[2][2][4][2], const GUnit& u, int wr, int wc, int fr, int fq) {
#pragma unroll
    for (int ai = 0; ai < 2; ++ai)
#pragma unroll
        for (int m = 0; m < 4; ++m) {
            const int row = u.m0 + 128 * ai + 64 * wr + 16 * m + fr;
            if (row < u.mvalid) {
                if (EPI == EPI_BF16 || EPI == EPI_F8BF16) {
                    constexpr float si = EPI == EPI_F8BF16 ? 1.f / (F8_SH * F8_SW) : 1.f;
#pragma unroll
                    for (int bj = 0; bj < 2; ++bj) {
                        const int col = u.n0 + 128 * bj + 32 * wc + 8 * fq;
                        if (col < u.ncols) {
                            const f32x4 v0 = acc[ai][bj][m][0] * si, v1 = acc[ai][bj][m][1] * si;
                            u32x4 pk = {pk_bf16(v0[0], v0[1]), pk_bf16(v0[2], v0[3]), pk_bf16(v1[0], v1[1]), pk_bf16(v1[2], v1[3])};
                            *reinterpret_cast<u32x4*>(u.ob + (size_t)row * u.ldo + col) = pk;
                            if (u.gates && col >= 4096 && col < 4112) { *reinterpret_cast<f32x4*>(u.gates + (size_t)row * 16 + (col - 4096)) = v0; *reinterpret_cast<f32x4*>(u.gates + (size_t)row * 16 + (col - 4096) + 4) = v1; }
                        }
                    }
                } else if (EPI == EPI_SWIGLU) {
                    const int col = u.n0 + 32 * wc + 8 * fq;
                    float a[8];
                    constexpr float si = 1.f / (F8_SH * F8_SW);
#pragma unroll
                    for (int n = 0; n < 2; ++n)
#pragma unroll
                        for (int q = 0; q < 4; ++q) { const float x = acc[ai][0][m][n][q] * si; a[n * 4 + q] = x * frcp_(1.f + __expf(-x)) * (acc[ai][1][m][n][q] * (si * F8_SA)); }
                    u32x2 pk = {pk_fp8x4(a[0], a[1], a[2], a[3]), pk_fp8x4(a[4], a[5], a[6], a[7])};
                    *reinterpret_cast<u32x2*>((unsigned char*)u.ob + (size_t)row * u.ldo + col) = pk;
                } else {
                    const float sc = u.rscale[row] * (1.f / (F8_SA * F8_SW));
#pragma unroll
                    for (int bj = 0; bj < 2; ++bj) {
                        const int col = u.n0 + 128 * bj + 32 * wc + 8 * fq;
                        const f32x4 v0 = acc[ai][bj][m][0] * sc, v1 = acc[ai][bj][m][1] * sc;
                        u32x4 pk = {pk_bf16(v0[0], v0[1]), pk_bf16(v0[2], v0[3]), pk_bf16(v1[0], v1[1]), pk_bf16(v1[2], v1[3])};
                        *reinterpret_cast<u32x4*>(u.ob + (size_t)row * u.ldo + col) = pk;
                    }
                }
            }
        }
}

template <int EPI, bool GATHER, class UnitFn>
__device__ __forceinline__ void gemm_phase8(unsigned char* lds, UnitFn next) {
    const int tid = tid_(), wid = __builtin_amdgcn_readfirstlane(tid >> 6), lane = tid & 63, wr = wid >> 2, wc = wid & 3, fr = lane & 15, fq = lane >> 4;
    constexpr bool F8 = (EPI != EPI_BF16);
    constexpr int nt = F8 ? 2048 / 128 : 2048 / 64;
    constexpr unsigned ROWB = F8 ? 2048u : 4096u;
    GUnit cur, nxt; int ui = 0;
    if (!next(0, cur)) return;
    int sR[2], sC[2];
#pragma unroll
    for (int i = 0; i < 2; ++i) g8_stage_rc(tid * 16 + i * 8192, sR[i], sC[i]);
    unsigned voffB[2];
#pragma unroll
    for (int i = 0; i < 2; ++i) voffB[i] = (unsigned)((sR[i] & ~31) + g8_perm32(sR[i] & 31)) * ROWB + (unsigned)sC[i] * 2u;
    unsigned voffA[2][2], voffAn[2][2];
    auto set_voffA = [&](const GUnit& u, unsigned (&vo)[2][2]) {
#pragma unroll
        for (int h = 0; h < 2; ++h)
#pragma unroll
            for (int i = 0; i < 2; ++i) {
                if (GATHER) vo[h][i] = (unsigned)u.arow[u.m0 + h * 128 + sR[i]] * ROWB + (unsigned)sC[i] * 2u;
                else vo[h][i] = (unsigned)(h * 128 + sR[i]) * ROWB + (unsigned)sC[i] * 2u;
            } };
    set_voffA(cur, voffA);
    const unsigned ldsw = (unsigned)wid * 1024u;
    const int aoff = g8_lds_byte(wr * 64 + fr, fq * 8), boff = g8_lds_byte(wc * 32 + fr, fq * 8);
#define G8_SA(b, h) (((b) * 2 + (h)) * G8_HTB)
#define G8_SB(b, h) ((4 + (b) * 2 + (h)) * G8_HTB)
#define G8_STAGE(bufoff, gbase, voff) do { _Pragma("unroll") for (int _i = 0; _i < 2; ++_i) \
        __builtin_amdgcn_global_load_lds((const unsigned*)((const char*)(gbase) + (voff)[_i]), (LAS unsigned*)(lds + (bufoff) + ldsw + _i * 8192), 16, 0, 0); } while (0)
#define G8_LDA(dst, b, h) do { _Pragma("unroll") for (int m = 0; m < 4; ++m) _Pragma("unroll") for (int k = 0; k < 2; ++k) dst[m][k] = *(const LAS bf16x8*)(lds + G8_SA(b, h) + aoff + m * 2048 + k * 1024); } while (0)
#define G8_LDB(dst, b, h) do { _Pragma("unroll") for (int n = 0; n < 2; ++n) _Pragma("unroll") for (int k = 0; k < 2; ++k) dst[n][k] = *(const LAS bf16x8*)(lds + G8_SB(b, h) + boff + n * 2048 + k * 1024); } while (0)
#define G8_MMA(ai, bj, At, Bt) do { __builtin_amdgcn_s_setprio(1); _Pragma("unroll") for (int m = 0; m < 4; ++m) _Pragma("unroll") for (int n = 0; n < 2; ++n) { \
        if (F8) { const i32x8 _b = cat8(Bt[n][0], Bt[n][1]), _a = cat8(At[m][0], At[m][1]); asm volatile("v_mfma_f32_16x16x128_f8f6f4 %0, %1, %2, %0" : "+v"(acc[ai][bj][m][n]) : "v"(_b), "v"(_a)); } \
        else { _Pragma("unroll") for (int k = 0; k < 2; ++k) acc[ai][bj][m][n] = __builtin_amdgcn_mfma_f32_16x16x32_bf16(Bt[n][k], At[m][k], acc[ai][bj][m][n], 0, 0, 0); } } \
        __builtin_amdgcn_s_setprio(0); } while (0)
#define G8_WAIT_V(n) asm volatile("s_waitcnt vmcnt(" #n ")" ::: "memory")
#define G8_WAIT_L(n) asm volatile("s_waitcnt lgkmcnt(" #n ")" ::: "memory")
#define G8_BAR __builtin_amdgcn_s_barrier()
#define G8_SCHED __builtin_amdgcn_sched_barrier(0)
    f32x4 acc[2][2][4][2];
#pragma unroll
    for (int a2 = 0; a2 < 2; ++a2)
#pragma unroll
        for (int b2 = 0; b2 < 2; ++b2)
#pragma unroll
            for (int m = 0; m < 4; ++m)
#pragma unroll
                for (int n = 0; n < 2; ++n) acc[a2][b2][m][n] = (f32x4){0.f, 0.f, 0.f, 0.f};
    bf16x8 At[4][2], B0[2][2], B1[2][2];
    const char* cA = cur.a; const char* cB0 = cur.b0; const char* cB1 = cur.b1;
    G8_STAGE(G8_SB(0, 0), cB0, voffB); G8_STAGE(G8_SA(0, 0), cA, voffA[0]); G8_STAGE(G8_SB(0, 1), cB1, voffB); G8_STAGE(G8_SA(0, 1), cA, voffA[1]);
    if (wr == 1) G8_BAR;
    G8_WAIT_V(4); G8_BAR;
    G8_STAGE(G8_SB(1, 0), cB0 + G8_KSTEP, voffB); G8_STAGE(G8_SA(1, 0), cA + G8_KSTEP, voffA[0]); G8_STAGE(G8_SB(1, 1), cB1 + G8_KSTEP, voffB);
    G8_WAIT_V(6); G8_BAR;
    for (;;) {
        const bool has_next = next(ui + 1, nxt);
        const char* nA = has_next ? nxt.a : cA; const char* nB0 = has_next ? nxt.b0 : cB0; const char* nB1 = has_next ? nxt.b1 : cB1;
        if (GATHER) { if (has_next) set_voffA(nxt, voffAn); else { _Pragma("unroll") for (int h = 0; h < 2; ++h) _Pragma("unroll") for (int i = 0; i < 2; ++i) voffAn[h][i] = voffA[h][i]; } }
        for (int t = 0; t < nt; t += 2) {
            const bool last = (t == nt - 2);
            const char* a1 = cA + (size_t)(t + 1) * G8_KSTEP;
            const char* a2 = last ? nA : cA + (size_t)(t + 2) * G8_KSTEP;
            const char* b20 = last ? nB0 : cB0 + (size_t)(t + 2) * G8_KSTEP; const char* b21 = last ? nB1 : cB1 + (size_t)(t + 2) * G8_KSTEP;
            const char* a3 = a2 + G8_KSTEP; const char* b30 = b20 + G8_KSTEP; const char* b31 = b21 + G8_KSTEP;
            unsigned vA2[2][2];
#pragma unroll
            for (int h = 0; h < 2; ++h)
#pragma unroll
                for (int i = 0; i < 2; ++i) vA2[h][i] = (GATHER && last) ? voffAn[h][i] : voffA[h][i];
            G8_LDB(B0, 0, 0); G8_SCHED; G8_LDA(At, 0, 0); G8_STAGE(G8_SA(1, 1), a1, voffA[1]);
            G8_WAIT_L(8); G8_BAR; G8_WAIT_L(0); G8_MMA(0, 0, At, B0); G8_BAR; G8_SCHED;
            G8_LDB(B1, 0, 1); G8_STAGE(G8_SB(0, 0), b20, voffB);
            G8_BAR; G8_WAIT_L(0); G8_MMA(0, 1, At, B1); G8_BAR;
            G8_LDA(At, 0, 1); G8_STAGE(G8_SA(0, 0), a2, vA2[0]);
            G8_BAR; G8_WAIT_L(0); G8_MMA(1, 0, At, B0); G8_BAR; G8_SCHED;
            G8_STAGE(G8_SB(0, 1), b21, voffB);
            G8_WAIT_V(6); G8_BAR; G8_MMA(1, 1, At, B1); G8_BAR;
            G8_LDB(B0, 1, 0); G8_SCHED; G8_LDA(At, 1, 0); G8_STAGE(G8_SA(0, 1), a2, vA2[1]);
            G8_WAIT_L(8); G8_BAR; G8_WAIT_L(0); G8_MMA(0, 0, At, B0); G8_BAR; G8_SCHED;
            G8_LDB(B1, 1, 1); G8_STAGE(G8_SB(1, 0), b30, voffB);
            G8_BAR; G8_WAIT_L(0); G8_MMA(0, 1, At, B1); G8_BAR;
            G8_LDA(At, 1, 1); G8_STAGE(G8_SA(1, 0), a3, vA2[0]);
            G8_BAR; G8_WAIT_L(0); G8_MMA(1, 0, At, B0); G8_BAR; G8_SCHED;
            G8_STAGE(G8_SB(1, 1), b31, voffB);
            G8_WAIT_V(6); G8_BAR; G8_MMA(1, 1, At, B1); G8_BAR;
        }
        if (F8) asm volatile("s_nop 15\n\ts_nop 15" ::: "memory");
        g8_epilogue<EPI>(acc, cur, wr, wc, fr, fq);
        if (!has_next) break;
#pragma unroll
        for (int a2 = 0; a2 < 2; ++a2)
#pragma unroll
            for (int b2 = 0; b2 < 2; ++b2)
#pragma unroll
                for (int m = 0; m < 4; ++m)
#pragma unroll
                    for (int n = 0; n < 2; ++n) acc[a2][b2][m][n] = (f32x4){0.f, 0.f, 0.f, 0.f};
        cur = nxt; cA = nA; cB0 = nB0; cB1 = nB1; ++ui;
        if (GATHER) { _Pragma("unroll") for (int h = 0; h < 2; ++h) _Pragma("unroll") for (int i = 0; i < 2; ++i) voffA[h][i] = voffAn[h][i]; }
    }
    G8_WAIT_V(0);
    if (wr == 0) G8_BAR;
    G8_BAR;
#undef G8_SA
#undef G8_SB
#undef G8_STAGE
#undef G8_LDA
#undef G8_LDB
#undef G8_MMA
#undef G8_WAIT_V
#undef G8_WAIT_L
#undef G8_BAR
#undef G8_SCHED
}

template <bool F8>
__device__ __forceinline__ void phase_gemm_dense(const Params& p, const u16* A, int M, const u16* Wt, int N, u16* ob, int ldo, float* gates, unsigned char* lds) {
    const int nM = M / 256, nN = (N + 255) / 256, L = nM * nN;
    const int xcd = bid_() & 7, slot = bid_() >> 3, nslot = gdim_() >> 3;
    const int base = (int)(((long)L * xcd) >> 3), cnt = (int)(((long)L * (xcd + 1)) >> 3) - base;
    const int G8n = nM >> 3, rem = nM & 7;
    auto next = [&](int i, GUnit& u) -> bool {
        const int k = slot + i * nslot;
        if (k >= cnt) return false;
        const int idx = base + k;
        int pn, pm;
        if (idx < G8n * 8 * nN) { const int gq = idx / (8 * nN), r = idx % (8 * nN); pn = r >> 3; pm = gq * 8 + (r & 7); }
        else { const int r = idx - G8n * 8 * nN; pn = r / rem; pm = G8n * 8 + r % rem; }
        constexpr size_t rowb = F8 ? 2048 : 4096;
        u.a = (const char*)A + (size_t)pm * 256 * rowb; u.b0 = (const char*)Wt + (size_t)pn * 256 * rowb; u.b1 = u.b0 + 128 * rowb; u.arow = nullptr;
        u.m0 = pm * 256; u.n0 = pn * 256; u.mvalid = M; u.ncols = N; u.ob = ob; u.ldo = ldo; u.gates = gates; u.rscale = nullptr;
        return true; };
    gemm_phase8<F8 ? EPI_F8BF16 : EPI_BF16, false>(lds, next);
}

__device__ __forceinline__ void phase_moe_a(const Params& p, int l, unsigned char* lds) {
    unsigned char* const ws = ws_();
    const int mvalid = l == 0 ? 2176 : 2048, nM = l == 0 ? 9 : 8;
    const int per_e = nM * 16;
    const int xcd = bid_() & 7, slot = bid_() >> 3, nslot = gdim_() >> 3;
    auto next = [&](int i, GUnit& u) -> bool {
        const int k = slot + i * nslot;
        if (k >= 2 * per_e) return false;
        const int tile = xcd * 2 * per_e + k;
        const int ex = tile / per_e, r = tile % per_e, pn = r / nM, pm = r % nM;
        u.a = (const char*)(ws + WS_H); u.arow = (const int*)(ws + WS_EROW) + ex * EPAD;
        u.b0 = (const char*)(ws + WS_WT_W1) + ((size_t)ex * FF + pn * 128) * D; u.b1 = (const char*)(ws + WS_WT_W3) + ((size_t)ex * FF + pn * 128) * D;
        u.m0 = pm * 256; u.n0 = pn * 128; u.mvalid = mvalid; u.ncols = FF; u.ob = (u16*)(ws + WS_ACT + (size_t)ex * EPAD * FF); u.ldo = FF; u.gates = nullptr; u.rscale = nullptr;
        return true; };
    gemm_phase8<EPI_SWIGLU, true>(lds, next);
}
__device__ __forceinline__ void phase_moe_b(const Params& p, int l, unsigned char* lds) {
    unsigned char* const ws = ws_();
    const int mvalid = l == 0 ? 2176 : 2048, nM = l == 0 ? 9 : 8;
    const int per_e = nM * 8;
    const int xcd = bid_() & 7, slot = bid_() >> 3, nslot = gdim_() >> 3;
    auto next = [&](int i, GUnit& u) -> bool {
        const int k = slot + i * nslot;
        if (k >= 2 * per_e) return false;
        const int tile = xcd * 2 * per_e + k;
        const int ex = tile / per_e, r = tile % per_e, pn = r / nM, pm = r % nM;
        u.a = (const char*)(ws + WS_ACT) + ((size_t)ex * EPAD + pm * 256) * FF; u.arow = nullptr;
        u.b0 = (const char*)(ws + WS_WT_W2) + ((size_t)ex * D + pn * 256) * FF; u.b1 = u.b0 + (size_t)128 * 2048;
        u.m0 = pm * 256; u.n0 = pn * 256; u.mvalid = mvalid; u.ncols = D; u.ob = (u16*)(ws + WS_YEXP) + (size_t)ex * EPAD * D; u.ldo = D; u.gates = nullptr;
        u.rscale = (const float*)(ws + WS_EGATE) + ex * EPAD;
        return true; };
    gemm_phase8<EPI_SCALE, false>(lds, next);
}

__device__ __forceinline__ int mlstm_row(int b, int dir, int pos) {
    if (pos < LC) return NLAT + b * LC + (dir ? (LC - 1 - pos) : pos);
    const int q = pos - LC; return b * SEQ + (dir ? (SEQ - 1 - q) : q);
}
__device__ __forceinline__ void phase_mlstm(const Params& p, unsigned char* lds) {
    unsigned char* const ws = ws_();
    u16* KT = (u16*)lds;
    u16* VT = KT + 256 * 72;
    u16* VWT = VT + 48 * 72;
    u16* CT = VWT + 48 * 72;
    u16* Ss = CT + 48 * 264;
    float* gB = (float*)(Ss + 64 * 72);
    float* gI = gB + 68 * 64;
    float* gP = gI + 68 * 64;
    float* gE = gP + 68 * 64;
    const int t = tid_(), lane = t & 63, w = t >> 6, fr = lane & 15, fq = lane >> 4;
    const u16* P = (const u16*)(ws + WS_P);
    const float* G = (const float*)(ws + WS_G);
    u16* HM = (u16*)(ws + WS_HM);
    for (int item = bid_(); item < 256; item += gdim_()) {
        const int combo = (item & 7) * 4 + (item >> 6), vs = (item >> 3) & 7, dir = combo & 1, hh = (combo >> 1) & 3, b = combo >> 3;
        __syncthreads();
        for (int i = t; i < 48 * 264; i += NT) CT[i] = 0;
        for (int i = t; i < 16 * 72; i += NT) { const int er = i / 72; VT[32 * 72 + i] = (er == 0) ? (u16)0x3f80 : (u16)0; VWT[32 * 72 + i] = 0; }
        {
            const float gb_i = p.mlstm_gate_b[(dir * 2 + 0) * 4 + hh], gb_f = p.mlstm_gate_b[(dir * 2 + 1) * 4 + hh];
            for (int ch = w; ch < 68; ch += 8) {
                const int row = mlstm_row(b, dir, ch * 64 + lane);
                const float gi = G[(size_t)row * 16 + dir * 8 + hh] + gb_i;
                const float gf = G[(size_t)row * 16 + dir * 8 + 4 + hh] + gb_f;
                const float lf = fminf(gf, 0.f) - log1pf(__expf(-fabsf(gf)));
                float bc = lf;
#pragma unroll
                for (int o = 1; o < 64; o <<= 1) { const float n = __shfl_up(bc, o, 64); if (lane >= o) bc += n; }
                float pm = gi - bc;
#pragma unroll
                for (int o = 1; o < 64; o <<= 1) { const float n = __shfl_up(pm, o, 64); if (lane >= o) pm = fmaxf(pm, n); }
                const float b63 = __shfl(bc, 63, 64);
                float gmax = b63 - bc + gi;
#pragma unroll
                for (int o = 32; o > 0; o >>= 1) gmax = fmaxf(gmax, __shfl_xor(gmax, o, 64));
                gB[ch * 64 + lane] = bc; gI[ch * 64 + lane] = gi; gP[ch * 64 + lane] = pm;
                if (lane == 0) { gE[ch * 2] = b63; gE[ch * 2 + 1] = gmax; }
            }
        }
        f32x4 Cacc[2][3];
#pragma unroll
        for (int i = 0; i < 2; ++i)
#pragma unroll
            for (int j = 0; j < 3; ++j) Cacc[i][j] = (f32x4){0.f, 0.f, 0.f, 0.f};
        float m_old = 0.f;
        const int jt = w & 3, sth = w >> 2;
        const int vs_s = t & 63, vs_eg = t >> 6;
        bf16x8 qf[8]; unsigned ktr[2][8]; u32x2 vraw;
        const int jq = jt * 16 + fr, jjq = dir ? 63 - jq : jq;
        const unsigned off_q = (unsigned)jjq * AB_IN + hh * 256 + fq * 8;
        const int jk0 = (sth * 2) * 16 + fr, jk1 = jk0 + 16;
        const unsigned off_k0 = (unsigned)(dir ? 63 - jk0 : jk0) * AB_IN + 1024 + hh * 256 + fq * 8;
        const unsigned off_k1 = (unsigned)(dir ? 63 - jk1 : jk1) * AB_IN + 1024 + hh * 256 + fq * 8;
        unsigned off_kt[2];
#pragma unroll
        for (int i = 0; i < 2; ++i) { const int mt = t + NT * i, d2 = (mt & 127) * 2, s8 = (mt >> 7) * 8; off_kt[i] = (unsigned)(dir ? 63 - s8 - 7 : s8) * AB_IN + 1024 + hh * 256 + d2; }
        const unsigned off_v = (unsigned)(dir ? 63 - vs_s : vs_s) * AB_IN + 2048 + hh * 256 + vs * 32 + vs_eg * 4;
        const unsigned off_h = (unsigned)jjq * 1024 + hh * 256 + vs * 32 + sth * 16 + 4 * fq;
#define ML_BASE(POS0) (P + (size_t)(dir ? mlstm_row(b, dir, (POS0)) - 63 : mlstm_row(b, dir, (POS0))) * AB_IN)
#define ML_LOAD_Q(POS0) do { const u16* _pc = ML_BASE(POS0); \
            _Pragma("unroll") for (int kk = 0; kk < 8; ++kk) qf[kk] = ld_frag_g(_pc + off_q + kk * 32); } while (0)
#define ML_LOAD_K(POS0, S2) do { const u16* _pc = ML_BASE(POS0); \
            _Pragma("unroll") for (int kk = 0; kk < 8; ++kk) kf[kk] = ld_frag_g(_pc + ((S2) ? off_k1 : off_k0) + kk * 32); } while (0)
#define ML_LOAD_KTV(POS0) do { const u16* _pc = ML_BASE(POS0); \
            _Pragma("unroll") for (int i = 0; i < 2; ++i) { \
                _Pragma("unroll") for (int q = 0; q < 8; ++q) ktr[i][q] = *reinterpret_cast<const unsigned*>(_pc + (size_t)((dir ? 7 - q : q) * AB_IN) + off_kt[i]); } \
            vraw = *reinterpret_cast<const u32x2*>(_pc + off_v); } while (0)
        ML_LOAD_Q(0); ML_LOAD_KTV(0);
        __syncthreads();
        for (int ch = 0; ch < 68; ++ch) {
            const int pos0 = ch * 64;
            const float* sb = gB + ch * 64; const float* sig = gI + ch * 64; const float* spm = gP + ch * 64;
            const float b63 = gE[ch * 2], m_new = fmaxf(b63 + m_old, gE[ch * 2 + 1]), decay = __expf(b63 + m_old - m_new);
            const int jg = jt * 16 + fr;
            const float bj = sb[jg], mj = bj + fmaxf(m_old, spm[jg]);
            auto s_tile = [&](int st) {
                f32x4 sv = (f32x4){0.f, 0.f, 0.f, 0.f};
                if (st <= jt) {
                    typedef short s16x4 __attribute__((ext_vector_type(4)));
                    const u16* kb = KT + (8 * fq + ((lane & 15) >> 2)) * 72 + st * 16 + 4 * (lane & 3);
#pragma unroll
                    for (int kk = 0; kk < 8; ++kk) {
                        const s16x4 lo = __builtin_amdgcn_ds_read_tr16_b64_v4i16((LAS s16x4*)(kb + kk * 32 * 72));
                        const s16x4 hi = __builtin_amdgcn_ds_read_tr16_b64_v4i16((LAS s16x4*)(kb + (kk * 32 + 4) * 72));
                        const bf16x8 kfr = {lo[0], lo[1], lo[2], lo[3], hi[0], hi[1], hi[2], hi[3]};
                        sv = mfma16(kfr, qf[kk], sv);
                    }
                }
                float pv[4];
#pragma unroll
                for (int q = 0; q < 4; ++q) {
                    const int sg = st * 16 + 4 * fq + q;
                    pv[q] = (sg <= jg) ? sv[q] * 0.0625f * __expf(bj - sb[sg] + sig[sg] - mj) : 0.f;
                }
                u32x2 pk = {pk_bf16(pv[0], pv[1]), pk_bf16(pv[2], pv[3])};
                *reinterpret_cast<u32x2*>(Ss + jg * 72 + st * 16 + 4 * fq) = pk;
            };
#pragma unroll
            for (int i = 0; i < 2; ++i) {
                const int mt = t + NT * i, d2 = (mt & 127) * 2, s8 = (mt >> 7) * 8;
                u32x4 lo = {(ktr[i][0] & 0xffffu) | (ktr[i][1] << 16), (ktr[i][2] & 0xffffu) | (ktr[i][3] << 16), (ktr[i][4] & 0xffffu) | (ktr[i][5] << 16), (ktr[i][6] & 0xffffu) | (ktr[i][7] << 16)};
                u32x4 hi = {(ktr[i][0] >> 16) | (ktr[i][1] & 0xffff0000u), (ktr[i][2] >> 16) | (ktr[i][3] & 0xffff0000u), (ktr[i][4] >> 16) | (ktr[i][5] & 0xffff0000u), (ktr[i][6] >> 16) | (ktr[i][7] & 0xffff0000u)};
                *reinterpret_cast<u32x4*>(KT + d2 * 72 + s8) = lo;
                *reinterpret_cast<u32x4*>(KT + (d2 + 1) * 72 + s8) = hi;
            }
            {
                const float wg = __expf(b63 - sb[vs_s] + sig[vs_s] - m_new) * 0.0625f;
                const float v0 = bf_lo(vraw[0]), v1 = bf_hi(vraw[0]), v2 = bf_lo(vraw[1]), v3 = bf_hi(vraw[1]);
                const int e0 = vs_eg * 4;
                VT[(e0 + 0) * 72 + vs_s] = (u16)(vraw[0] & 0xffffu); VT[(e0 + 1) * 72 + vs_s] = (u16)(vraw[0] >> 16);
                VT[(e0 + 2) * 72 + vs_s] = (u16)(vraw[1] & 0xffffu); VT[(e0 + 3) * 72 + vs_s] = (u16)(vraw[1] >> 16);
                VWT[(e0 + 0) * 72 + vs_s] = f2bf(v0 * wg); VWT[(e0 + 1) * 72 + vs_s] = f2bf(v1 * wg);
                VWT[(e0 + 2) * 72 + vs_s] = f2bf(v2 * wg); VWT[(e0 + 3) * 72 + vs_s] = f2bf(v3 * wg);
                if (t < 64) VWT[32 * 72 + t] = f2bf(wg);
            }
            if (ch + 1 < 68) ML_LOAD_KTV(pos0 + 64);
            __syncthreads();
            s_tile(sth * 2);
            s_tile(sth * 2 + 1);
            __syncthreads();
            {
                const float w_inter = __expf(bj + m_old - mj);
                f32x4 nacc[2];
#pragma unroll
                for (int z = 0; z < 2; ++z) {
                    const int et = z == 0 ? sth : 2;
                    f32x4 a = (f32x4){0.f, 0.f, 0.f, 0.f};
#pragma unroll
                    for (int kk = 0; kk < 8; ++kk) a = mfma16(ld_frag_s(CT + (et * 16 + fr) * 264 + kk * 32 + fq * 8), qf[kk], a);
                    nacc[z] = a * w_inter;
                }
                if (ch + 1 < 68) ML_LOAD_Q(pos0 + 64);
#pragma unroll
                for (int z = 0; z < 2; ++z) {
                    const int et = z == 0 ? sth : 2;
                    f32x4 a = nacc[z];
#pragma unroll
                    for (int k2 = 0; k2 < 2; ++k2) a = mfma16(ld_frag_s(VT + (et * 16 + fr) * 72 + k2 * 32 + fq * 8), ld_frag_s(Ss + jg * 72 + k2 * 32 + fq * 8), a);
                    nacc[z] = a;
                }
                const float den = __shfl(nacc[1][0], fr, 64);
                const float dd = fmaxf(fabsf(den), __expf(-mj));
                const float inv = 1.f / dd;
                u32x2 pk = {pk_bf16(nacc[0][0] * inv, nacc[0][1] * inv), pk_bf16(nacc[0][2] * inv, nacc[0][3] * inv)};
                *reinterpret_cast<u32x2*>(HM + ((size_t)dir * NTOK + (dir ? mlstm_row(b, dir, pos0) - 63 : mlstm_row(b, dir, pos0))) * 1024 + off_h) = pk;
            }
#pragma unroll
            for (int i = 0; i < 2; ++i)
#pragma unroll
                for (int et = 0; et < 3; ++et) {
                    f32x4 a = Cacc[i][et] * decay;
#pragma unroll
                    for (int k2 = 0; k2 < 2; ++k2) a = mfma16(ld_frag_s(KT + ((w * 2 + i) * 16 + fr) * 72 + k2 * 32 + fq * 8), ld_frag_s(VWT + (et * 16 + fr) * 72 + k2 * 32 + fq * 8), a);
                    Cacc[i][et] = a;
                }
            __syncthreads();
#pragma unroll
            for (int i = 0; i < 2; ++i)
#pragma unroll
                for (int et = 0; et < 3; ++et) {
                    const f32x4 a = Cacc[i][et];
                    u32x2 pk = {pk_bf16(a[0], a[1]), pk_bf16(a[2], a[3])};
                    *reinterpret_cast<u32x2*>(CT + (et * 16 + fr) * 264 + (w * 2 + i) * 16 + 4 * fq) = pk;
                }
            m_old = m_new;
        }
#undef ML_LOAD_Q
#undef ML_LOAD_K
#undef ML_LOAD_KTV
    }
}

__device__ __forceinline__ void mlstm_out_rows(const Params& p, int row0, int nrows) {
    unsigned char* const ws = ws_();
    const int lane = tid_() & 63, w = tid_() >> 6;
    const u16* P = (const u16*)(ws + WS_P);
    const u16* HM = (const u16*)(ws + WS_HM);
    u16* YIN = (u16*)(ws + WS_YIN);
    for (int r = w; r < nrows; r += 8) {
        const int row = row0 + r;
        const int c0 = lane * 16;
        float v[16]; float ss = 0.f;
#pragma unroll
        for (int h2 = 0; h2 < 2; ++h2) {
            const u32x4 a = *reinterpret_cast<const u32x4*>(HM + (size_t)row * 1024 + c0 + h2 * 8);
            const u32x4 bq = *reinterpret_cast<const u32x4*>(HM + ((size_t)NTOK + row) * 1024 + c0 + h2 * 8);
#pragma unroll
            for (int q = 0; q < 4; ++q) { v[h2 * 8 + 2 * q] = bf_lo(a[q]) + bf_lo(bq[q]); v[h2 * 8 + 2 * q + 1] = bf_hi(a[q]) + bf_hi(bq[q]); }
        }
#pragma unroll
        for (int q = 0; q < 16; ++q) ss += v[q] * v[q];
        ss += __shfl_xor(ss, 1, 64); ss += __shfl_xor(ss, 2, 64); ss += __shfl_xor(ss, 4, 64); ss += __shfl_xor(ss, 8, 64);
        const float rstd = rsqrtf(ss * (1.f / 256.f) + 1e-6f);
        float y[16];
#pragma unroll
        for (int h2 = 0; h2 < 2; ++h2) {
            const u32x4 og = *reinterpret_cast<const u32x4*>(P + (size_t)row * AB_IN + 3072 + c0 + h2 * 8);
#pragma unroll
            for (int q = 0; q < 4; ++q) {
                const int c = c0 + h2 * 8 + 2 * q;
                y[h2 * 8 + 2 * q] = v[h2 * 8 + 2 * q] * rstd * p.mlstm_norm[c] * sigmoidf_(bf_lo(og[q])) * F8_SH;
                y[h2 * 8 + 2 * q + 1] = v[h2 * 8 + 2 * q + 1] * rstd * p.mlstm_norm[c + 1] * sigmoidf_(bf_hi(og[q])) * F8_SH;
            }
        }
        *reinterpret_cast<u32x4*>((unsigned char*)YIN + (size_t)row * D + c0) = (u32x4){pk_fp8x4(y[0], y[1], y[2], y[3]), pk_fp8x4(y[4], y[5], y[6], y[7]), pk_fp8x4(y[8], y[9], y[10], y[11]), pk_fp8x4(y[12], y[13], y[14], y[15])};
    }
}

template <int DH, class KeyFn, class BiasFn>
__device__ __forceinline__ void attn_wave(const u16* qptr, size_t qstride, int nblk, KeyFn keyfn, BiasFn biasfn, float scale,
                                           float m_init, float l_init, u16* vlds, u16* optr, size_t ostride) {
    constexpr int NK = DH / 32, NDT = DH / 16, VS = DH + 8, NV = DH / 16;
    const int lane = tid_() & 63, fr = lane & 15, fq = lane >> 4;
    bf16x8 qf[NK];
#pragma unroll
    for (int kk = 0; kk < NK; ++kk) qf[kk] = ld_frag_g(qptr + (size_t)fr * qstride + kk * 32 + fq * 8);
    f32x4 oacc[NDT];
#pragma unroll
    for (int i = 0; i < NDT; ++i) oacc[i] = (f32x4){0.f, 0.f, 0.f, 0.f};
    float m = m_init, l = l_init;
    bf16x8 kn[2][NK]; u32x4 vn[NV];
    auto load_blk = [&](int ib) {
        const u16* kptr; const u16* vptr; size_t kvs;
        (void)keyfn(ib, kptr, vptr, kvs);
#pragma unroll
        for (int st = 0; st < 2; ++st)
#pragma unroll
            for (int kk = 0; kk < NK; ++kk) kn[st][kk] = ld_frag_g(kptr + (size_t)(st * 16 + fr) * kvs + kk * 32 + fq * 8);
#pragma unroll
        for (int i = 0; i < NV; ++i) { const int cidx = lane + 64 * i, r = cidx / (DH / 8), cc = cidx % (DH / 8); vn[i] = *reinterpret_cast<const u32x4*>(vptr + (size_t)r * kvs + cc * 8); }
    };
    auto next_valid = [&](int ib) { const u16* a; const u16* b2; size_t c; while (ib < nblk && !keyfn(ib, a, b2, c)) ++ib; return ib; };
    int ib = next_valid(0);
    if (ib < nblk) load_blk(ib);
    while (ib < nblk) {
        bf16x8 kc[2][NK]; u32x4 vc[NV];
#pragma unroll
        for (int st = 0; st < 2; ++st)
#pragma unroll
            for (int kk = 0; kk < NK; ++kk) kc[st][kk] = kn[st][kk];
#pragma unroll
        for (int i = 0; i < NV; ++i) vc[i] = vn[i];
        const int ibn = next_valid(ib + 1);
        if (ibn < nblk) load_blk(ibn);
        asm volatile("" ::: "memory");
#pragma unroll
        for (int i = 0; i < NV; ++i) { const int cidx = lane + 64 * i, r = cidx / (DH / 8), cc = cidx % (DH / 8); *reinterpret_cast<u32x4*>(vlds + r * VS + cc * 8) = vc[i]; }
        f32x4 s[2];
#pragma unroll
        for (int st = 0; st < 2; ++st) {
            f32x4 a = (f32x4){0.f, 0.f, 0.f, 0.f};
#pragma unroll
            for (int kk = 0; kk < NK; ++kk) a = mfma16(kc[st][kk], qf[kk], a);
            s[st] = a;
        }
        float x[8]; float mx = -INFINITY;
#pragma unroll
        for (int st = 0; st < 2; ++st)
#pragma unroll
            for (int q = 0; q < 4; ++q) { const float v = s[st][q] * scale + biasfn(ib, fr, st * 16 + 4 * fq + q); x[st * 4 + q] = v; mx = fmaxf(mx, v); }
        mx = max_x32(max_x16(mx));
        const float m_new = fmaxf(m, mx);
        const float m_safe = (m_new == -INFINITY) ? 0.f : m_new;
        const float alpha = __expf(m - m_safe);
        float ps = 0.f; float pe[8];
#pragma unroll
        for (int q = 0; q < 8; ++q) { pe[q] = __expf(x[q] - m_safe); ps += pe[q]; }
        l = l * alpha + ps; m = m_new;
#pragma unroll
        for (int i = 0; i < NDT; ++i) oacc[i] *= alpha;
        const bf16x8 pf = mk_frag(pk_bf16(pe[0], pe[1]), pk_bf16(pe[2], pe[3]), pk_bf16(pe[4], pe[5]), pk_bf16(pe[6], pe[7]));
        asm volatile("s_waitcnt lgkmcnt(0)" ::: "memory");
        {
            typedef short s16x4 __attribute__((ext_vector_type(4)));
            const int tq = (lane & 15) >> 2, tp = lane & 3;
            const u16* vb0 = vlds + (4 * fq + tq) * VS + 4 * tp;
            const u16* vb1 = vb0 + 16 * VS;
#pragma unroll
            for (int dt = 0; dt < NDT; ++dt) {
                const s16x4 lo = __builtin_amdgcn_ds_read_tr16_b64_v4i16((LAS s16x4*)(vb0 + dt * 16));
                const s16x4 hi = __builtin_amdgcn_ds_read_tr16_b64_v4i16((LAS s16x4*)(vb1 + dt * 16));
                const bf16x8 vf = {lo[0], lo[1], lo[2], lo[3], hi[0], hi[1], hi[2], hi[3]};
                oacc[dt] = mfma16(vf, pf, oacc[dt]);
            }
        }
        asm volatile("" ::: "memory");
        ib = ibn;
    }
    l = sum_x32(sum_x16(l));
    const float inv = 1.f / l;
#pragma unroll
    for (int dt = 0; dt < NDT; ++dt) {
        const f32x4 o = oacc[dt] * (inv * F8_SH);
        *reinterpret_cast<unsigned*>((unsigned char*)optr + (size_t)fr * ostride + dt * 16 + 4 * fq) = pk_fp8x4(o[0], o[1], o[2], o[3]);
    }
}


template <int DH, class SlabFn, class SubFn, class BiasFn>
__device__ __forceinline__ void attn_block(const u16* qptr, size_t qstride, int nslab, SlabFn slabfn, SubFn subfn, BiasFn biasfn, float scale,
                                            float m_init, float l_init, unsigned char* lds, u16* optr, size_t ostride) {
    constexpr int NK = DH / 32, NDT = DH / 16, VS = DH + 8, NLD = DH / 64;
    constexpr int STAGE = 2 * 64 * VS * 2;
    const int t = tid_(), lane = t & 63, fr = lane & 15, fq = lane >> 4;
    bf16x8 qf[NK];
#pragma unroll
    for (int kk = 0; kk < NK; ++kk) qf[kk] = ld_frag_g(qptr + (size_t)fr * qstride + kk * 32 + fq * 8);
    f32x4 oacc[NDT];
#pragma unroll
    for (int i = 0; i < NDT; ++i) oacc[i] = (f32x4){0.f, 0.f, 0.f, 0.f};
    float m = m_init, l = l_init;
    u32x4 kreg[NLD], vreg[NLD];
    auto load_slab = [&](int i) {
        const u16* kp; const u16* vp; size_t kvs; slabfn(i, kp, vp, kvs);
#pragma unroll
        for (int q = 0; q < NLD; ++q) { const int c = t + NT * q, r = c / (DH / 8), cc = c % (DH / 8);
            kreg[q] = *reinterpret_cast<const u32x4*>(kp + (size_t)r * kvs + cc * 8); vreg[q] = *reinterpret_cast<const u32x4*>(vp + (size_t)r * kvs + cc * 8); } };
    auto store_slab = [&](int st) {
        u16* Ks = (u16*)(lds + st * STAGE); u16* Vs = Ks + 64 * VS;
#pragma unroll
        for (int q = 0; q < NLD; ++q) { const int c = t + NT * q, r = c / (DH / 8), cc = c % (DH / 8);
            *reinterpret_cast<u32x4*>(Ks + r * VS + cc * 8) = kreg[q]; *reinterpret_cast<u32x4*>(Vs + r * VS + cc * 8) = vreg[q]; } };
    __syncthreads();
    load_slab(0); store_slab(0);
    if (nslab > 1) load_slab(1);
    __syncthreads();
    for (int i = 0; i < nslab; ++i) {
        const int cur = i & 1;
        if (i + 1 < nslab) store_slab(cur ^ 1);
        if (i + 2 < nslab) load_slab(i + 2);
        const u16* Ks = (const u16*)(lds + cur * STAGE); const u16* Vs = Ks + 64 * VS;
#pragma unroll
        for (int j = 0; j < 2; ++j) {
            int off;
            if (!subfn(i, j, off)) continue;
            f32x4 s[2];
#pragma unroll
            for (int st = 0; st < 2; ++st) {
                f32x4 a = (f32x4){0.f, 0.f, 0.f, 0.f};
#pragma unroll
                for (int kk = 0; kk < NK; ++kk) a = mfma16(ld_frag_s(Ks + (off + st * 16 + fr) * VS + kk * 32 + fq * 8), qf[kk], a);
                s[st] = a;
            }
            float x[8]; float mx = -INFINITY;
#pragma unroll
            for (int st = 0; st < 2; ++st)
#pragma unroll
                for (int q = 0; q < 4; ++q) { const float v = s[st][q] * scale + biasfn(i, off, fr, st * 16 + 4 * fq + q); x[st * 4 + q] = v; mx = fmaxf(mx, v); }
            mx = max_x32(max_x16(mx));
            const float m_new = fmaxf(m, mx);
            const float m_safe = (m_new == -INFINITY) ? 0.f : m_new;
            const float alpha = __expf(m - m_safe);
            float ps = 0.f; float pe[8];
#pragma unroll
            for (int q = 0; q < 8; ++q) { pe[q] = __expf(x[q] - m_safe); ps += pe[q]; }
            l = l * alpha + ps; m = m_new;
#pragma unroll
            for (int dt = 0; dt < NDT; ++dt) oacc[dt] *= alpha;
            const bf16x8 pf = mk_frag(pk_bf16(pe[0], pe[1]), pk_bf16(pe[2], pe[3]), pk_bf16(pe[4], pe[5]), pk_bf16(pe[6], pe[7]));
            typedef short s16x4 __attribute__((ext_vector_type(4)));
            const int tq = (lane & 15) >> 2, tp = lane & 3;
            const u16* vb0 = Vs + (off + 4 * fq + tq) * VS + 4 * tp;
            const u16* vb1 = vb0 + 16 * VS;
#pragma unroll
            for (int dt = 0; dt < NDT; ++dt) {
                const s16x4 lo = __builtin_amdgcn_ds_read_tr16_b64_v4i16((LAS s16x4*)(vb0 + dt * 16));
                const s16x4 hi = __builtin_amdgcn_ds_read_tr16_b64_v4i16((LAS s16x4*)(vb1 + dt * 16));
                const bf16x8 vf = {lo[0], lo[1], lo[2], lo[3], hi[0], hi[1], hi[2], hi[3]};
                oacc[dt] = mfma16(vf, pf, oacc[dt]);
            }
        }
        __syncthreads();
    }
    l = sum_x32(sum_x16(l));
    const float inv = 1.f / l;
#pragma unroll
    for (int dt = 0; dt < NDT; ++dt) {
        const f32x4 o = oacc[dt] * (inv * F8_SH);
        *reinterpret_cast<unsigned*>((unsigned char*)optr + (size_t)fr * ostride + dt * 16 + 4 * fq) = pk_fp8x4(o[0], o[1], o[2], o[3]);
    }
}

__device__ __forceinline__ void phase_l0_stage2(const Params& p, unsigned char* lds) {
    unsigned char* const ws = ws_();
    const int w = tid_() >> 6;
    const u16* P = (const u16*)(ws + WS_P);
    u16* YIN = (u16*)(ws + WS_YIN);
    for (int item = bid_(); item < 1088 + 2176; item += gdim_()) {
        if (item < 1024) {
            const int r2 = item & 31, h = (item >> 5) & 7, b = item >> 8;
            const int rr = w >> 2, qt = w & 3, r = 2 * r2 + rr;
            const int r0 = min(max(r - 4, 0), 56);
            const int krow0 = min(max(2 * r2 - 4, 0), 56), nwin = min(max(2 * r2 + 1 - 4, 0), 56) + 8 - krow0;
            const int cb = qt == 0 ? 0 : (qt == 1 ? 8 : (qt == 2 ? 24 : 32));
            const int qrow = b * SEQ + r * 64 + qt * 16;
            const float* rpb = p.na_rpb + h * 15 * 31;
            auto slabfn = [&](int i, const u16*& kp, const u16*& vp, size_t& kvs) {
                const int row = i < nwin ? b * SEQ + (krow0 + i) * 64 : NLAT + b * LC + (i - nwin) * 64;
                kp = P + (size_t)row * AB_IN + 5136 + h * 128; vp = P + (size_t)row * AB_IN + 6160 + h * 128; kvs = AB_IN; };
            auto subfn = [&](int i, int j, int& off) -> bool {
                if (i < nwin) { off = cb; return j == 0 && (krow0 + i) >= r0 && (krow0 + i) < r0 + 8; }
                off = 32 * j; return true; };
            auto biasfn = [&](int i, int off, int qi, int ki) -> float {
                if (i >= nwin) return 0.f;
                const int c = qt * 16 + qi, kc = off + ki, c0 = min(max(c - 8, 0), 48);
                if (kc < c0 || kc >= c0 + 16) return -INFINITY;
                return rpb[(krow0 + i - r + 7) * 31 + (kc - c + 15)]; };
            attn_block<128>(P + (size_t)qrow * AB_IN + 4112 + h * 128, AB_IN, nwin + 4, slabfn, subfn, biasfn, 0.08838834764831845f, -INFINITY, 0.f, lds,
                            (u16*)((unsigned char*)YIN + (size_t)qrow * D + 1024 + h * 128), D);
        } else if (item < 1088) {
            const int it = item - 1024, half = it & 1, h = (it >> 1) & 7, b = it >> 4;
            const int qrow = NLAT + b * LC + (half * 8 + w) * 16;
            auto slabfn = [&](int i, const u16*& kp, const u16*& vp, size_t& kvs) {
                const int row = NLAT + b * LC + i * 64;
                kp = P + (size_t)row * AB_IN + 5136 + h * 128; vp = P + (size_t)row * AB_IN + 6160 + h * 128; kvs = AB_IN; };
            auto subfn = [&](int, int j, int& off) -> bool { off = 32 * j; return true; };
            auto biasfn = [&](int, int, int, int) -> float { return 0.f; };
            attn_block<128>(P + (size_t)qrow * AB_IN + 4112 + h * 128, AB_IN, 4, slabfn, subfn, biasfn, 0.08838834764831845f, -INFINITY, 0.f, lds,
                            (u16*)((unsigned char*)YIN + (size_t)qrow * D + 1024 + h * 128), D);
        } else {
            mlstm_out_rows(p, (item - 1088) * 8, 8);
        }
    }
}

__device__ __forceinline__ void rope_prep(const Params& p) {
    if (bid_() != 0) return;
    float* T = (float*)(ws_() + WS_ROPE);
    for (int i = tid_(); i < 1024; i += NT) {
        const int pos = i >> 4, j = i & 15;
        const float inv = exp2f(-(float)j * (13.287712379549449f / 16.f));
        float sn, cs; sincosf((float)pos * inv, &sn, &cs);
        T[i] = cs; T[1024 + i] = sn;
    }
}
__device__ __forceinline__ void rope_rows(const Params& p, int row0, int nrows) {
    unsigned char* const ws = ws_();
    const int lane = tid_() & 63, w = tid_() >> 6;
    u16* P = (u16*)(ws + WS_P);
    const float* T = (const float*)(ws + WS_ROPE);
    for (int r = w; r < nrows; r += 8) {
        const int row = row0 + r, tt = row & (SEQ - 1), prow = tt >> 6, pcol = tt & 63;
#pragma unroll
        for (int it = 0; it < 2; ++it) {
            const int c = it * 64 + lane;
            if (c < 80) {
                const int head = c >> 2, half = (c >> 1) & 1, j0 = (c & 1) * 8;
                u16* q1 = P + (size_t)row * CD_IN + head * 64 + half * 32 + j0;
                const float* tc = T + (half ? pcol : prow) * 16 + j0;
                const u32x4 xa = *reinterpret_cast<const u32x4*>(q1), xb = *reinterpret_cast<const u32x4*>(q1 + 16);
                const f32x4 c0 = *reinterpret_cast<const f32x4*>(tc), c1 = *reinterpret_cast<const f32x4*>(tc + 4);
                const f32x4 s0 = *reinterpret_cast<const f32x4*>(tc + 1024), s1 = *reinterpret_cast<const f32x4*>(tc + 1028);
                const float cs[8] = {c0[0], c0[1], c0[2], c0[3], c1[0], c1[1], c1[2], c1[3]}, sn[8] = {s0[0], s0[1], s0[2], s0[3], s1[0], s1[1], s1[2], s1[3]};
                u32x4 oa, ob;
#pragma unroll
                for (int q = 0; q < 4; ++q) {
                    const float a0 = bf_lo(xa[q]), a1 = bf_hi(xa[q]), b0 = bf_lo(xb[q]), b1 = bf_hi(xb[q]);
                    oa[q] = pk_bf16(a0 * cs[2 * q] - b0 * sn[2 * q], a1 * cs[2 * q + 1] - b1 * sn[2 * q + 1]);
                    ob[q] = pk_bf16(b0 * cs[2 * q] + a0 * sn[2 * q], b1 * cs[2 * q + 1] + a1 * sn[2 * q + 1]);
                }
                *reinterpret_cast<u32x4*>(q1) = oa; *reinterpret_cast<u32x4*>(q1 + 16) = ob;
            }
        }
    }
}

__device__ __forceinline__ int lru_row(int b, int ci, int j) { return ci < 4 ? NLAT + b * LC + ci * 64 + j : b * SEQ + (ci - 4) * 64 + j; }
__device__ __forceinline__ void lru_chunk(const Params& p, int b, int blk, int ci, int mode, unsigned char* lds) {
    unsigned char* const ws = ws_();
    u16* ub = (u16*)lds;
    constexpr int SR = 132;
    float* sa = (float*)(ub + 64 * 136);
    float* sbt = sa + 64 * SR;
    float* sx = sbt + 64 * SR;
    const int t = tid_(), lane = t & 63, w = t >> 6, fr = lane & 15, fq = lane >> 4;
    const u16* P = (const u16*)(ws + WS_P);
    const u16* WT = (const u16*)(ws + WS_LRUW);
    float* SA = (float*)(ws + WS_LRUS);
    float* SH = SA + 2 * 4 * 68 * 1024;
    const int seglen = ci < 4 ? LC : SEQ, tt0 = ci < 4 ? ci * 64 : (ci - 4) * 64;
    const int rbase = ci < 4 ? NLAT + b * LC : b * SEQ;
    const int sc = t & 127, seg = t >> 7;
    const int chg_s = blk * 128 + sc;
    const int cg = blk * 128 + w * 16 + 4 * fq;
    bf16x8 wfa[2][2][4];
#pragma unroll
    for (int d2 = 0; d2 < 2; ++d2)
#pragma unroll
        for (int g2 = 0; g2 < 2; ++g2)
#pragma unroll
            for (int kk = 0; kk < 4; ++kk) wfa[d2][g2][kk] = ld_frag_g(WT + ((size_t)((d2 * 2 + g2) * 8 + blk) * 128 + w * 16 + fr) * 128 + fq * 8 + kk * 32);
    f32x4 gba[2][2], lama[2];
#pragma unroll
    for (int d2 = 0; d2 < 2; ++d2) {
        lama[d2] = *reinterpret_cast<const f32x4*>(p.lru_lambda + d2 * 1024 + cg);
#pragma unroll
        for (int g2 = 0; g2 < 2; ++g2) gba[d2][g2] = *reinterpret_cast<const f32x4*>(p.lru_gate_b + (d2 * 2 + g2) * 1024 + cg);
    }
    float carry[2] = {0.f, 0.f}; u16 grv[16];
    if (mode == 1) {
#pragma unroll
        for (int d2 = 0; d2 < 2; ++d2) carry[d2] = SH[((size_t)(d2 * 4 + b) * 68 + ci) * 1024 + chg_s];
#pragma unroll
        for (int s = 0; s < 16; ++s) grv[s] = P[(size_t)lru_row(b, ci, seg * 16 + s) * CD_IN + 2560 + chg_s];
    }
    __syncthreads();
    {
        const int c4 = (t & 31) * 4, j0 = (t >> 5) * 4, ch = blk * 128 + c4;
        float xv[7][4];
#pragma unroll
        for (int q = 0; q < 7; ++q) {
            const int tt = tt0 + j0 - 1 + q;
            if (tt >= 0 && tt < seglen) {
                const u32x2 v = *reinterpret_cast<const u32x2*>(P + (size_t)(rbase + tt) * CD_IN + 1536 + ch);
                xv[q][0] = bf_lo(v[0]); xv[q][1] = bf_hi(v[0]); xv[q][2] = bf_lo(v[1]); xv[q][3] = bf_hi(v[1]);
            } else { xv[q][0] = xv[q][1] = xv[q][2] = xv[q][3] = 0.f; }
        }
        f32x4 cw[4];
#pragma unroll
        for (int tp = 0; tp < 4; ++tp) cw[tp] = *reinterpret_cast<const f32x4*>(p.lru_conv_w + tp * 1024 + ch);
        const f32x4 cb = *reinterpret_cast<const f32x4*>(p.lru_conv_b + ch);
#pragma unroll
        for (int q = 0; q < 4; ++q) {
            float u[4];
#pragma unroll
            for (int cc = 0; cc < 4; ++cc) u[cc] = cb[cc] + xv[q][cc] * cw[0][cc] + xv[q + 1][cc] * cw[1][cc] + xv[q + 2][cc] * cw[2][cc] + xv[q + 3][cc] * cw[3][cc];
            u32x2 pk = {pk_bf16(u[0], u[1]), pk_bf16(u[2], u[3])};
            *reinterpret_cast<u32x2*>(ub + (j0 + q) * 136 + c4) = pk;
        }
    }
    __syncthreads();
    float hfw[16];
    for (int dir = 0; dir < 2; ++dir) {
        f32x4 av[4];
        {
            bf16x8 wf[4];
#pragma unroll
            for (int kk = 0; kk < 4; ++kk) wf[kk] = dir ? wfa[1][0][kk] : wfa[0][0][kk];
            const f32x4 gbv = dir ? gba[1][0] : gba[0][0];
            const f32x4 lamv = dir ? lama[1] : lama[0];
            float sp8[4];
#pragma unroll
            for (int q = 0; q < 4; ++q) { const float nl = -lamv[q]; sp8[q] = -8.f * (fmaxf(nl, 0.f) + __logf(1.f + __expf(-fabsf(nl)))); }
#pragma unroll
            for (int tt = 0; tt < 4; ++tt) {
                f32x4 z = (f32x4){0.f, 0.f, 0.f, 0.f};
#pragma unroll
                for (int kk = 0; kk < 4; ++kk) z = mfma16(wf[kk], ld_frag_s(ub + (tt * 16 + fr) * 136 + kk * 32 + fq * 8), z);
#pragma unroll
                for (int q = 0; q < 4; ++q) av[tt][q] = __expf(sigmoidf_(z[q] + gbv[q]) * sp8[q]);
            }
        }
        __syncthreads();
        {
            bf16x8 wf[4];
#pragma unroll
            for (int kk = 0; kk < 4; ++kk) wf[kk] = dir ? wfa[1][1][kk] : wfa[0][1][kk];
            const f32x4 gbv = dir ? gba[1][1] : gba[0][1];
#pragma unroll
            for (int tt = 0; tt < 4; ++tt) {
                f32x4 z = (f32x4){0.f, 0.f, 0.f, 0.f};
#pragma unroll
                for (int kk = 0; kk < 4; ++kk) z = mfma16(wf[kk], ld_frag_s(ub + (tt * 16 + fr) * 136 + kk * 32 + fq * 8), z);
                const int tj = tt * 16 + fr;
                const u32x2 uv = *reinterpret_cast<const u32x2*>(ub + tj * 136 + w * 16 + 4 * fq);
                const float u4[4] = {bf_lo(uv[0]), bf_hi(uv[0]), bf_lo(uv[1]), bf_hi(uv[1])};
                f32x4 bv;
#pragma unroll
                for (int q = 0; q < 4; ++q) { const float a = av[tt][q]; bv[q] = __builtin_amdgcn_sqrtf(fmaxf(1.f - a * a, 0.f)) * sigmoidf_(z[q] + gbv[q]) * u4[q]; }
                *reinterpret_cast<f32x4*>(sa + tj * SR + w * 16 + 4 * fq) = av[tt];
                *reinterpret_cast<f32x4*>(sbt + tj * SR + w * 16 + 4 * fq) = bv;
            }
        }
        __syncthreads();
        float A = 1.f, h = 0.f;
#pragma unroll
        for (int s = 0; s < 16; ++s) { const int j = seg * 16 + (dir ? 15 - s : s); const float a = sa[j * SR + sc]; h = a * h + sbt[j * SR + sc]; A *= a; }
        sx[(seg * 2 + 0) * 128 + sc] = A; sx[(seg * 2 + 1) * 128 + sc] = h;
        __syncthreads();
        const size_t sidx = ((size_t)(dir * 4 + b) * 68 + ci) * 1024 + chg_s;
        if (mode == 0) {
            if (seg == 0) {
                float At = 1.f, ht = 0.f;
#pragma unroll
                for (int s = 0; s < 4; ++s) { const int sg = dir ? 3 - s : s; const float a = sx[(sg * 2) * 128 + sc]; ht = a * ht + sx[(sg * 2 + 1) * 128 + sc]; At *= a; }
                SA[sidx] = At; SH[sidx] = ht;
            }
        } else {
            float hs = dir ? carry[1] : carry[0];
            const int nprev = dir ? 3 - seg : seg;
#pragma unroll
            for (int s = 0; s < 3; ++s) if (s < nprev) { const int sg = dir ? 3 - s : s; hs = sx[(sg * 2) * 128 + sc] * hs + sx[(sg * 2 + 1) * 128 + sc]; }
            u16* YIN = (u16*)(ws + WS_YIN);
            if (dir == 0) {
#pragma unroll
                for (int s = 0; s < 16; ++s) { const int j = seg * 16 + s; hs = sa[j * SR + sc] * hs + sbt[j * SR + sc]; hfw[s] = hs; }
            } else {
#pragma unroll
                for (int s = 0; s < 16; ++s) {
                    const int js = 15 - s, j = seg * 16 + js;
                    hs = sa[j * SR + sc] * hs + sbt[j * SR + sc];
                    const int row = lru_row(b, ci, j);
                    const float gr = bf2f(grv[js]);
                    const float th = 1.f - 2.f * frcp_(1.f + __expf(1.5957691216057308f * (gr + 0.044715f * gr * gr * gr)));
                    const float ge = 0.5f * gr * (1.f + th);
                    ((unsigned char*)YIN)[(size_t)row * D + 1024 + chg_s] = (unsigned char)(pk_fp8x4((hfw[js] + hs) * ge * F8_SH, 0.f, 0.f, 0.f) & 0xffu);
                }
            }
        }
    }
}

__device__ __forceinline__ void lru_prep_weights(const Params& p) {
    unsigned char* const ws = ws_();
    const int t = tid_();
    u16* WT = (u16*)(ws + WS_LRUW);
    for (int m = bid_(); m < 32; m += gdim_()) {
        const float* Wg = p.lru_gate_w + (size_t)m * 128 * 128;
        const int j4 = (t & 31) * 4, i8 = (t >> 5) * 8;
        f32x4 r8[8];
#pragma unroll
        for (int q = 0; q < 8; ++q) r8[q] = *reinterpret_cast<const f32x4*>(Wg + (size_t)(i8 + q) * 128 + j4);
#pragma unroll
        for (int jj = 0; jj < 4; ++jj) {
            u32x4 v = {pk_bf16(r8[0][jj], r8[1][jj]), pk_bf16(r8[2][jj], r8[3][jj]), pk_bf16(r8[4][jj], r8[5][jj]), pk_bf16(r8[6][jj], r8[7][jj])};
            *reinterpret_cast<u32x4*>(WT + ((size_t)m * 128 + j4 + jj) * 128 + i8) = v;
        }
    }
}
__device__ __forceinline__ void lru_carry(const Params& p, int item) {
    unsigned char* const ws = ws_();
    const int idx = item * NT + tid_();
    const int c = idx & 1023, b = (idx >> 10) & 3, dir = idx >> 12;
    float* SA = (float*)(ws + WS_LRUS);
    float* SH = SA + 2 * 4 * 68 * 1024;
    const size_t base = ((size_t)(dir * 4 + b) * 68) * 1024 + c;
    float h = 0.f;
#pragma unroll 4
    for (int s = 0; s < 68; ++s) {
        const int cj = dir == 0 ? s : (s < 4 ? 3 - s : 71 - s);
        const float a = SA[base + (size_t)cj * 1024], hl = SH[base + (size_t)cj * 1024];
        SH[base + (size_t)cj * 1024] = h;
        h = a * h + hl;
    }
}

__device__ __forceinline__ void gqa_item(const Params& p, int it, unsigned char* lds) {
    unsigned char* const ws = ws_();
    const int w = tid_() >> 6;
    const u16* P = (const u16*)(ws + WS_P);
    u16* YIN = (u16*)(ws + WS_YIN);
    const int t32 = it & 127, kvh = (it >> 7) & 3, b = it >> 9;
    const int hq = kvh * 4 + (w & 3), t0 = t32 * 32 + (w >> 2) * 16;
    const int kfirst = max((t32 * 32 - 128) & ~63, 0), klast = min(((t32 * 32 - 128) & ~63) + 256, SEQ - 64);
    const int nwin = (klast - kfirst) / 64 + 1;
    const int qrow = b * SEQ + t0;
    auto slabfn = [&](int i, const u16*& kp, const u16*& vp, size_t& kvs) {
        const int row = i < nwin ? b * SEQ + kfirst + i * 64 : NLAT + b * LC + (i - nwin) * 64;
        kp = P + (size_t)row * CD_IN + 1024 + kvh * 64; vp = P + (size_t)row * CD_IN + 1280 + kvh * 64; kvs = CD_IN; };
    auto subfn = [&](int i, int j, int& off) -> bool {
        off = 32 * j;
        if (i >= nwin) return true;
        const int k0 = kfirst + i * 64 + off;
        return k0 + 31 >= t0 - 128 && k0 <= t0 + 15 + 128; };
    auto biasfn = [&](int i, int off, int qi, int ki) -> float {
        if (i >= nwin) return 0.f;
        const int dq = (t0 + qi) - (kfirst + i * 64 + off + ki);
        return (dq > 128 || dq < -128) ? -INFINITY : 0.f; };
    const float sink = p.gqa_sink[hq];
    attn_block<64>(P + (size_t)qrow * CD_IN + hq * 64, CD_IN, nwin + 4, slabfn, subfn, biasfn, 0.125f, sink, ((tid_() & 63) >> 4) == 0 ? 1.f : 0.f, lds,
                   (u16*)((unsigned char*)YIN + (size_t)qrow * D + hq * 64), D);
}

__device__ __forceinline__ void phase_l1_stage1(const Params& p, unsigned char* lds) {
    for (int item = bid_(); item < 2176 + 2048; item += gdim_()) {
        if (item < 2176) { const int ci = item % 68, blk = (item / 68) & 7, b = item / (68 * 8); lru_chunk(p, b, blk, ci, 0, lds); }
        else rope_rows(p, (item - 2176) * 8, 8);
    }
}
__device__ __forceinline__ void phase_l1_stage2(const Params& p, unsigned char* lds) {
    for (int item = bid_(); item < 16 + 2048; item += gdim_()) {
        if (item < 16) lru_carry(p, item);
        else gqa_item(p, item - 16, lds);
    }
}
__device__ __forceinline__ void phase_l1_stage3(const Params& p, unsigned char* lds) {
    for (int item = bid_(); item < 2048; item += gdim_()) { const int cl = item & 63, blk = (item >> 6) & 7, b = item >> 9; lru_chunk(p, b, blk, cl + 4, 1, lds); }
}

__device__ __forceinline__ void phase_rowpass_mid(const Params& p, int l, unsigned char* lds) {
    unsigned char* const ws = ws_();
    float* R = (float*)lds;
    const int t = tid_(), lane = t & 63, w = t >> 6;
    const int nrows = l == 0 ? NTOK : NLAT;
    __syncthreads();
    constexpr int RS = D + 4;
    for (int i = t; i < D * NEXP; i += NT) { const int k = i >> 4, e = i & 15; R[e * RS + k] = p.moe_router[(size_t)l * D * NEXP + i]; }
    __syncthreads();
    const u16* Y = (const u16*)(ws + WS_Y);
    u16* XL1 = (u16*)(ws + WS_XL1);
    u16* H = (u16*)(ws + WS_H);
    float* AFF = (float*)(ws + WS_AFF);
    u32x2 yq[8]; f32x4 xq[8]; u32x2 xq2[8];
    const int rstride = gdim_() * 8;
    int row = bid_() * 8 + w;
#define RP_FETCH(ROW) do { const int _rw = (ROW); \
        _Pragma("unroll") for (int i = 0; i < 8; ++i) yq[i] = *reinterpret_cast<const u32x2*>(Y + (size_t)_rw * D + (i * 64 + lane) * 4); \
        if (l == 0) { const float* _xr = xin_row(p, _rw); _Pragma("unroll") for (int i = 0; i < 8; ++i) xq[i] = *reinterpret_cast<const f32x4*>(_xr + (i * 64 + lane) * 4); } \
        else { const u16* _xb = (const u16*)(ws + WS_XL2) + (size_t)_rw * D; _Pragma("unroll") for (int i = 0; i < 8; ++i) xq2[i] = *reinterpret_cast<const u32x2*>(_xb + (i * 64 + lane) * 4); } } while (0)
    if (row < nrows) RP_FETCH(row);
    for (; row < nrows; row += rstride) {
        f32x4 v[8]; float ss = 0.f;
#pragma unroll
        for (int i = 0; i < 8; ++i) { const u32x2 q = yq[i]; v[i] = (f32x4){bf_lo(q[0]), bf_hi(q[0]), bf_lo(q[1]), bf_hi(q[1])}; ss += v[i][0] * v[i][0] + v[i][1] * v[i][1] + v[i][2] * v[i][2] + v[i][3] * v[i][3]; }
        ss = wave_sum(ss);
        const float rstd = rsqrtf(ss * (1.f / D) + 1e-6f);
        const float* g1 = mod_ptr(ws, l, row, 2);
        const float* nw = p.norm_mix_post + (size_t)l * D;
        float ss1 = 0.f;
#pragma unroll
        for (int i = 0; i < 8; ++i) {
            const int col = (i * 64 + lane) * 4;
            f32x4 x4;
            if (l == 0) x4 = xq[i];
            else { const u32x2 q = xq2[i]; x4 = (f32x4){bf_lo(q[0]), bf_hi(q[0]), bf_lo(q[1]), bf_hi(q[1])}; }
            const f32x4 w4 = *reinterpret_cast<const f32x4*>(nw + col), g4 = *reinterpret_cast<const f32x4*>(g1 + col);
            const f32x4 x1 = x4 + g4 * (v[i] * rstd * w4);
            { const u32x2 pk1 = {pk_bf16(x1[0], x1[1]), pk_bf16(x1[2], x1[3])}; *reinterpret_cast<u32x2*>(XL1 + (size_t)row * D + col) = pk1; }
            v[i] = x1; ss1 += x1[0] * x1[0] + x1[1] * x1[1] + x1[2] * x1[2] + x1[3] * x1[3];
        }
        __builtin_amdgcn_sched_barrier(0);
        if (row + rstride < nrows) RP_FETCH(row + rstride);
        __builtin_amdgcn_sched_barrier(0);
        ss1 = wave_sum(ss1);
        const float rstd1 = rsqrtf(ss1 * (1.f / D) + 1e-6f);
        const float* sh = mod_ptr(ws, l, row, 3); const float* sc = mod_ptr(ws, l, row, 4);
        const float* nw2 = p.norm_ffn_pre + (size_t)l * D;
#pragma unroll
        for (int i = 0; i < 8; ++i) {
            const int col = (i * 64 + lane) * 4;
            const f32x4 w4 = *reinterpret_cast<const f32x4*>(nw2 + col), s4 = *reinterpret_cast<const f32x4*>(sc + col), h4 = *reinterpret_cast<const f32x4*>(sh + col);
            const f32x4 o = v[i] * rstd1 * w4 * (s4 + 1.f) + h4;
            *reinterpret_cast<unsigned*>((unsigned char*)H + (size_t)row * D + col) = pk_fp8x4(o[0] * F8_SH, o[1] * F8_SH, o[2] * F8_SH, o[3] * F8_SH);
            v[i] = o;
        }
        float lg[16];
        rowdot16(v, R, lane, lg);
        const bool b5 = lane & 32, b4 = lane & 16, b3 = lane & 8, b2 = lane & 4;
        float t8[8], t4[4], t2[2], lgt;
#pragma unroll
        for (int j = 0; j < 8; ++j) { const float keep = b5 ? lg[8 + j] : lg[j], send = b5 ? lg[j] : lg[8 + j]; t8[j] = keep + partner_x32(send); }
#pragma unroll
        for (int j = 0; j < 4; ++j) { const float keep = b4 ? t8[4 + j] : t8[j], send = b4 ? t8[j] : t8[4 + j]; t4[j] = keep + partner_x16(send); }
#pragma unroll
        for (int j = 0; j < 2; ++j) { const float keep = b3 ? t4[2 + j] : t4[j], send = b3 ? t4[j] : t4[2 + j]; t2[j] = keep + dpp_f<0x140>(send); }
        { const float keep = b2 ? t2[1] : t2[0], send = b2 ? t2[0] : t2[1]; lgt = keep + dpp_f<0x141>(send); }
        lgt += dpp_f<0x4E>(lgt); lgt += dpp_f<0xB1>(lgt);
        const float mx = wave_max(lgt);
        const float pe = __expf(lgt - mx);
        const float den = wave_sum(pe) * 0.25f;
        if ((lane & 3) == 0) AFF[(size_t)row * 16 + ((b5 ? 8 : 0) + (b4 ? 4 : 0) + (b3 ? 2 : 0) + (b2 ? 1 : 0))] = pe / den;
    }
#undef RP_FETCH
}

__device__ __forceinline__ void phase_topk(const Params& p, int l, unsigned char* lds) {
    unsigned char* const ws = ws_();
    unsigned* keys = (unsigned*)lds;
    unsigned* hist = keys + 4096;
    unsigned* misc = hist + 256;
    const int t = tid_(), lane = t & 63, w = t >> 6;
    const float* AFF = (const float*)(ws + WS_AFF);
    int* SLOT = (int*)(ws + WS_SLOT);
    int* EROW = (int*)(ws + WS_EROW);
    float* EGATE = (float*)(ws + WS_EGATE);
    const int nitems = l == 0 ? 128 : 64;
    for (int item = bid_(); item < nitems; item += gdim_()) {
        const int kind = item >> 6, b = (item >> 4) & 3, ex = item & 15;
        const int n = kind ? LC : SEQ, cap = n / 8, rowbase = kind ? NLAT + b * LC : b * SEQ;
        __syncthreads();
        for (int i = t; i < n; i += NT) keys[i] = __float_as_uint(AFF[(size_t)(rowbase + i) * 16 + ex]);
        unsigned prefix = 0u, mask = 0u; int kth = cap;
        for (int shift = 24; shift >= 0; shift -= 8) {
            __syncthreads();
            if (t < 256) hist[t] = 0u;
            __syncthreads();
            for (int i = t; i < n; i += NT) { const unsigned k = keys[i]; if ((k & mask) == prefix) atomicAdd(&hist[(k >> shift) & 255u], 1u); }
            __syncthreads();
            if (t < 256) {
                unsigned above = 0u;
                for (int d2 = t + 1; d2 < 256; ++d2) above += hist[d2];
                const unsigned here = hist[t];
                if ((int)above < kth && (int)(above + here) >= kth) { misc[0] = (unsigned)t; misc[1] = (unsigned)(kth - (int)above); }
            }
            __syncthreads();
            prefix |= misc[0] << shift; mask |= 255u << shift; kth = (int)misc[1];
        }
        const unsigned T = prefix; const int need_eq = kth;
        int cgt = 0, ceq = 0;
        const int base = t * 8;
        if (base < n) {
#pragma unroll
            for (int q = 0; q < 8; ++q) { const unsigned k = keys[base + q]; cgt += (k > T); ceq += (k == T); }
        }
        int packed = cgt | (ceq << 16);
        int incl = packed;
#pragma unroll
        for (int o = 1; o < 64; o <<= 1) { const int nb = __shfl_up(incl, o, 64); if (lane >= o) incl += nb; }
        __syncthreads();
        if (lane == 63) misc[8 + w] = (unsigned)incl;
        __syncthreads();
        int woff = 0, total = 0;
#pragma unroll
        for (int q = 0; q < 8; ++q) { const int v = (int)misc[8 + q]; if (q < w) woff += v; total += v; }
        const int excl = woff + incl - packed;
        int pgt = excl & 0xffff, peq = excl >> 16;
        const int tot_gt = total & 0xffff;
        const int sbase = kind ? 2048 + b * 32 : b * 512;
        if (base < n) {
#pragma unroll
            for (int q = 0; q < 8; ++q) {
                const unsigned k = keys[base + q];
                const int row = rowbase + base + q;
                int pos = -1;
                if (k > T) { pos = pgt; ++pgt; }
                else if (k == T) { if (peq < need_eq) pos = tot_gt + peq; ++peq; }
                if (pos >= 0) { const int sl = sbase + pos; EROW[ex * EPAD + sl] = row; EGATE[ex * EPAD + sl] = __uint_as_float(k); SLOT[(size_t)row * 16 + ex] = sl; }
                else SLOT[(size_t)row * 16 + ex] = -1;
            }
        }
        if (kind == 1 && b == 3) for (int i = t; i < EPAD - 2176; i += NT) EROW[ex * EPAD + 2176 + i] = rowbase;
    }
}

__device__ __forceinline__ void phase_final(const Params& p, int l) {
    unsigned char* const ws = ws_();
    const int lane = tid_() & 63, w = __builtin_amdgcn_readfirstlane(tid_() >> 6);
    const int nrows = l == 0 ? NTOK : NLAT;
    const u16* YEXP = (const u16*)(ws + WS_YEXP);
    const int* SLOT = (const int*)(ws + WS_SLOT);
    const u16* XL1 = (const u16*)(ws + WS_XL1);
    u16* XL2 = (u16*)(ws + WS_XL2);
    u16* H = (u16*)(ws + WS_H);
    const int stride = gdim_() * 8;
    struct Pre { u32x2 xl[8], q0[8], q1[8]; };
    auto slots_of = [&](int row) -> int { const int s = SLOT[(size_t)min(row, nrows - 1) * 16 + (lane & 15)]; return (row < nrows && lane < 16) ? s : -1; };
    auto prefetch = [&](int row, int myslot, Pre& pr) {
        const int rc = min(row, nrows - 1);
        unsigned long long em = __ballot(myslot >= 0);
        const int e0 = em ? __builtin_ctzll(em) : 0; em &= em - 1;
        const int e1 = em ? __builtin_ctzll(em) : e0;
        const int sl0 = max(__shfl(myslot, e0, 64), 0), sl1 = max(__shfl(myslot, e1, 64), 0);
        const u16* y0 = YEXP + ((size_t)e0 * EPAD + sl0) * D; const u16* y1 = YEXP + ((size_t)e1 * EPAD + sl1) * D;
#pragma unroll
        for (int i = 0; i < 8; ++i) pr.xl[i] = *reinterpret_cast<const u32x2*>(XL1 + (size_t)rc * D + (i * 64 + lane) * 4);
#pragma unroll
        for (int i = 0; i < 8; ++i) { pr.q0[i] = *reinterpret_cast<const u32x2*>(y0 + (i * 64 + lane) * 4); pr.q1[i] = *reinterpret_cast<const u32x2*>(y1 + (i * 64 + lane) * 4); }
    };
    int row = bid_() * 8 + w;
    int slot_c = slots_of(row), slot_n = slots_of(row + stride);
    Pre cur; prefetch(row, slot_c, cur);
    for (; row < nrows; row += stride) {
        const int slot_nn = slots_of(row + 2 * stride);
        Pre nxt; prefetch(row + stride, slot_n, nxt);
        f32x4 v[8];
#pragma unroll
        for (int i = 0; i < 8; ++i) v[i] = (f32x4){0.f, 0.f, 0.f, 0.f};
        unsigned long long em = __ballot(slot_c >= 0);
        if (em) {
            em &= em - 1;
            const float f1 = em ? 1.f : 0.f;
            if (em) em &= em - 1;
#pragma unroll
            for (int i = 0; i < 8; ++i) {
                v[i][0] = bf_lo(cur.q0[i][0]) + f1 * bf_lo(cur.q1[i][0]); v[i][1] = bf_hi(cur.q0[i][0]) + f1 * bf_hi(cur.q1[i][0]);
                v[i][2] = bf_lo(cur.q0[i][1]) + f1 * bf_lo(cur.q1[i][1]); v[i][3] = bf_hi(cur.q0[i][1]) + f1 * bf_hi(cur.q1[i][1]);
            }
        }
        while (em) {
            const int e0 = __builtin_ctzll(em); em &= em - 1;
            const int sl0 = __shfl(slot_c, e0, 64);
            const u16* y0 = YEXP + ((size_t)e0 * EPAD + sl0) * D;
#pragma unroll
            for (int i = 0; i < 8; ++i) { const u32x2 q = *reinterpret_cast<const u32x2*>(y0 + (i * 64 + lane) * 4); v[i][0] += bf_lo(q[0]); v[i][1] += bf_hi(q[0]); v[i][2] += bf_lo(q[1]); v[i][3] += bf_hi(q[1]); }
        }
        float ss = 0.f;
#pragma unroll
        for (int i = 0; i < 8; ++i) ss += v[i][0] * v[i][0] + v[i][1] * v[i][1] + v[i][2] * v[i][2] + v[i][3] * v[i][3];
        ss = wave_sum(ss);
        const float rstd = rsqrtf(ss * (1.f / D) + 1e-6f);
        const float* g2 = mod_ptr(ws, l, row, 5);
        const float* nw = p.norm_ffn_post + (size_t)l * D;
        float ss2 = 0.f;
#pragma unroll
        for (int i = 0; i < 8; ++i) {
            const int col = (i * 64 + lane) * 4;
            const f32x4 x4 = {bf_lo(cur.xl[i][0]), bf_hi(cur.xl[i][0]), bf_lo(cur.xl[i][1]), bf_hi(cur.xl[i][1])};
            const f32x4 w4 = *reinterpret_cast<const f32x4*>(nw + col), g4 = *reinterpret_cast<const f32x4*>(g2 + col);
            const f32x4 x2 = x4 + g4 * (v[i] * rstd * w4);
            if (l == 0) { const u32x2 pk2 = {pk_bf16(x2[0], x2[1]), pk_bf16(x2[2], x2[3])}; *reinterpret_cast<u32x2*>(XL2 + (size_t)row * D + col) = pk2; }
            else *reinterpret_cast<f32x4*>(p.out + (size_t)row * D + col) = x2;
            v[i] = x2; ss2 += x2[0] * x2[0] + x2[1] * x2[1] + x2[2] * x2[2] + x2[3] * x2[3];
        }
        if (l == 0) {
            ss2 = wave_sum(ss2);
            const float rstd2 = rsqrtf(ss2 * (1.f / D) + 1e-6f);
            const float* sh = mod_ptr(ws, 1, row, 0); const float* sc = mod_ptr(ws, 1, row, 1);
            const float* nw1 = p.norm_mix_pre + D;
#pragma unroll
            for (int i = 0; i < 8; ++i) {
                const int col = (i * 64 + lane) * 4;
                const f32x4 w4 = *reinterpret_cast<const f32x4*>(nw1 + col), s4 = *reinterpret_cast<const f32x4*>(sc + col), h4 = *reinterpret_cast<const f32x4*>(sh + col);
                const f32x4 o = v[i] * rstd2 * w4 * (s4 + 1.f) + h4;
                if (WIN_F8_L1) *reinterpret_cast<unsigned*>((unsigned char*)H + (size_t)row * D + col) = pk_fp8x4(o[0] * F8_SH, o[1] * F8_SH, o[2] * F8_SH, o[3] * F8_SH);
                else { const u32x2 pk = {pk_bf16(o[0], o[1]), pk_bf16(o[2], o[3])}; *reinterpret_cast<u32x2*>(H + (size_t)row * D + col) = pk; }
            }
        }
        cur = nxt; slot_c = slot_n; slot_n = slot_nn;
    }
}

__global__ void __launch_bounds__(NT, 2) fwd_kernel(Params p) {
    unsigned char* lds = g_lds;
    unsigned char* wlds = lds + 512;
    if (threadIdx.x == 0) { *reinterpret_cast<uint4*>(lds) = make_uint4(0u, 0u, 0u, 0u); ((volatile LAS int*)(g_lds))[4] = (int)blockIdx.x; ((volatile LAS int*)(g_lds))[5] = (int)gridDim.x; *(volatile LAS unsigned long long*)((LAS unsigned char*)(g_lds) + 24) = (unsigned long long)p.ws; }
    if ((threadIdx.x & 63) == 0) ((volatile LAS int*)(g_lds))[8 + hw_slot_()] = threadIdx.x >> 6;
    __syncthreads();
    (void)xcd_barrier_post((unsigned*)(ws_() + WS_BAR), (volatile LAS unsigned*)lds);
#define GRID_BARRIER() do { XcdBarrier _b; _b.bar = (unsigned*)(ws_() + WS_BAR); _b.x = xb_xcc_id(); _b.st = (volatile LAS unsigned*)lds; xcd_barrier(_b); } while (0)
#ifndef PH_MASK
#define PH_MASK 0xFFFFFFFFu
#endif
#ifndef PROBE_REP_MASK
#define PROBE_REP_MASK 0u
#endif
#define PHASE(id, body) do { if (((PH_MASK >> ((id) % 32)) & 1u) && p.ph_lo <= (id) && (id) < p.ph_hi) { \
    for (int _r = 0; _r < ((((unsigned)PROBE_REP_MASK >> ((id) % 32)) & 1u) ? 2 : 1); ++_r) { body; if ((id) + 1 < p.ph_hi || _r == 0) { if ((id) + 1 < p.ph_hi) GRID_BARRIER(); } } } } while (0)
    PHASE(0, { phase_mod(p, wlds); phase_convert_dense(p, wlds); });
    PHASE(1, { phase_norm_mod(p, 0, wlds); lru_prep_weights(p); rope_prep(p); });
    {
        constexpr int l = 0, pb = 2;
        PHASE(pb + 0, phase_gemm_dense<WIN_F8_L0>(p, (const u16*)(ws_() + WS_H), NTOK, (const u16*)(ws_() + WS_WT_ABIN), AB_IN, (u16*)(ws_() + WS_P), AB_IN, nullptr, wlds));
        PHASE(pb + 1, phase_mlstm(p, wlds));
        PHASE(pb + 2, phase_l0_stage2(p, wlds));
        PHASE(pb + 4, phase_gemm_dense<true>(p, (const u16*)(ws_() + WS_YIN), NTOK, (const u16*)(ws_() + WS_WT_ABOUT), D, (u16*)(ws_() + WS_Y), D, nullptr, wlds));
        PHASE(pb + 5, phase_rowpass_mid(p, l, wlds));
        PHASE(pb + 6, { phase_topk(p, l, wlds); phase_convert_moe(p, l, wlds); });
        PHASE(pb + 7, phase_moe_a(p, l, wlds));
        PHASE(pb + 8, phase_moe_b(p, l, wlds));
        PHASE(pb + 9, phase_final(p, l));
    }
    {
        constexpr int l = 1, pb = 12;
        PHASE(pb + 0, phase_gemm_dense<WIN_F8_L1>(p, (const u16*)(ws_() + WS_H), NTOK, (const u16*)(ws_() + WS_WT_CDIN), CD_IN, (u16*)(ws_() + WS_P), CD_IN, nullptr, wlds));
        PHASE(pb + 1, phase_l1_stage1(p, wlds));
        PHASE(pb + 2, phase_l1_stage2(p, wlds));
        PHASE(pb + 3, phase_l1_stage3(p, wlds));
        PHASE(pb + 4, phase_gemm_dense<true>(p, (const u16*)(ws_() + WS_YIN), NLAT, (const u16*)(ws_() + WS_WT_CDOUT), D, (u16*)(ws_() + WS_Y), D, nullptr, wlds));
        PHASE(pb + 5, phase_rowpass_mid(p, l, wlds));
        PHASE(pb + 6, { phase_topk(p, l, wlds); phase_convert_moe(p, l, wlds); });
        PHASE(pb + 7, phase_moe_a(p, l, wlds));
        PHASE(pb + 8, phase_moe_b(p, l, wlds));
        PHASE(pb + 9, phase_final(p, l));
    }
}


#ifdef DBG_STOP
__global__ void dbg_digest(const unsigned char* ws, size_t off, int kind, size_t nelem, float* out, size_t nout) {
    for (size_t i = (size_t)blockIdx.x * blockDim.x + threadIdx.x; i < nout; i += (size_t)gridDim.x * blockDim.x) {
        float v = 0.f;
        for (size_t j = i; j < nelem; j += nout) {
            if (kind == 0) v += bf2f(((const u16*)(ws + off))[j]);
            else if (kind == 1) v += ((const float*)(ws + off))[j];
            else v += (float)((const int*)(ws + off))[j];
        }
        out[i] = v;
    }
}
#endif
extern "C" void kernel_launch(void* const* d_in, const int* in_sizes, int n_in, void* d_out, int out_size, void* d_ws, size_t ws_size, hipStream_t stream) {
    static int grid = 0;
    if (grid == 0) {
        if (n_in != 27 || ws_size < WS_END) { fprintf(stderr, "kernel_launch: unexpected n_in %d / ws %zu (need %zu)\n", n_in, ws_size, (size_t)WS_END); grid = -1; return; }
        int dev = 0, cus = 0, per_cu = 0;
        hipGetDevice(&dev);
        hipDeviceGetAttribute(&cus, hipDeviceAttributeMultiprocessorCount, dev);
        if (hipFuncSetAttribute((const void*)fwd_kernel, hipFuncAttributeMaxDynamicSharedMemorySize, LDS_BYTES) != hipSuccess) { fprintf(stderr, "kernel_launch: hipFuncSetAttribute failed\n"); grid = -1; return; }
        hipOccupancyMaxActiveBlocksPerMultiprocessor(&per_cu, (const void*)fwd_kernel, NT, LDS_BYTES);
        (void)hipGetLastError();
        if (per_cu < 1) fprintf(stderr, "kernel_launch: occupancy query reports %d blocks per CU\n", per_cu);
        grid = cus > 0 ? cus : 256;
    }
    if (grid < 0) return;
    hipMemsetAsync((char*)d_ws + WS_BAR, 0, XCD_BAR_WORDS * sizeof(unsigned), stream);
    Params p; memset(&p, 0, sizeof(p));
    const float** f = (const float**)&p;
    for (int i = 0; i < 27; ++i) f[i] = (const float*)d_in[i];
    p.out = (float*)d_out; p.ws = (unsigned char*)d_ws;
#if N_LAUNCH_MODE == 1
    p.ph_lo = 0; p.ph_hi = NPH;
    hipLaunchKernelGGL(fwd_kernel, dim3(grid), dim3(NT), LDS_BYTES, stream, p);
#else
#ifdef DBG_STOP
    for (int ph = 0; ph <= DBG_STOP; ++ph) { p.ph_lo = ph; p.ph_hi = ph + 1; hipLaunchKernelGGL(fwd_kernel, dim3(grid), dim3(NT), LDS_BYTES, stream, p); }
    hipLaunchKernelGGL(dbg_digest, dim3(2048), dim3(256), 0, stream, (const unsigned char*)d_ws, (size_t)DBG_OFF, (int)DBG_KIND, (size_t)DBG_NELEM, (float*)d_out, (size_t)out_size);
#else
    for (int ph = 0; ph < NPH; ++ph) { p.ph_lo = ph; p.ph_hi = ph + 1; hipLaunchKernelGGL(fwd_kernel, dim3(grid), dim3(NT), LDS_BYTES, stream, p); }
#endif
#endif
}
```

```cpp
#include <hip/hip_runtime.h>
#include <stdint.h>
#include <stdio.h>
#include <string.h>

#ifndef N_LAUNCH_MODE
#define N_LAUNCH_MODE 1
#endif

typedef unsigned short u16;
typedef short bf16x8 __attribute__((ext_vector_type(8)));
typedef float f32x4 __attribute__((ext_vector_type(4)));
typedef unsigned u32x4 __attribute__((ext_vector_type(4)));
typedef unsigned u32x2 __attribute__((ext_vector_type(2)));

#define NT 512
constexpr int D = 2048, BATCH = 4, SEQ = 4096, LC = 256;
constexpr int NLAT = BATCH * SEQ, NCTX = BATCH * LC, NTOK = NLAT + NCTX;
constexpr int AB_IN = 7184, CD_IN = 3584;
constexpr int NEXP = 16, FF = 2048, EPAD = 2304;
constexpr int NPH = 22;
constexpr int LDS_BYTES = 150 * 1024;

constexpr bool WIN_F8_L0 = true, WIN_F8_L1 = true;
constexpr int WIN_L0_BF16_COLS = 2048;
constexpr size_t al256(size_t x) { return (x + 255) & ~(size_t)255; }
constexpr size_t WS_BAR = 0;
constexpr size_t WS_MOD = 16384;
constexpr size_t WS_XL1 = al256(WS_MOD + 2 * 5 * 12288 * 4);
constexpr size_t WS_XL2 = al256(WS_XL1 + (size_t)NTOK * D * 4);
constexpr size_t WS_H = al256(WS_XL2 + (size_t)NTOK * D * 4);
constexpr size_t WS_P = al256(WS_H + (size_t)NTOK * D * 2);
constexpr size_t WS_G = al256(WS_P + (size_t)NTOK * AB_IN * 2);
constexpr size_t WS_HM = al256(WS_G + (size_t)NTOK * 16 * 4);
constexpr size_t WS_YIN = al256(WS_HM + (size_t)2 * NTOK * 1024 * 2);
constexpr size_t WS_Y = al256(WS_YIN + (size_t)NTOK * D * 2);
constexpr size_t WS_AFF = al256(WS_Y + (size_t)NTOK * D * 4);
constexpr size_t WS_SLOT = al256(WS_AFF + (size_t)NTOK * 16 * 4);
constexpr size_t WS_EROW = al256(WS_SLOT + (size_t)NTOK * 16 * 4);
constexpr size_t WS_EGATE = al256(WS_EROW + (size_t)NEXP * EPAD * 4);
constexpr size_t WS_ACT = al256(WS_EGATE + (size_t)NEXP * EPAD * 4);
constexpr size_t WS_YEXP = al256(WS_ACT + (size_t)NEXP * EPAD * FF * 2);
constexpr size_t WS_LRUS = al256(WS_YEXP + (size_t)NEXP * EPAD * D * 2);
constexpr size_t WS_LRUW = al256(WS_LRUS + (size_t)2 * 2 * 4 * 68 * 1024 * 4);
constexpr size_t WS_WT_ABIN = al256(WS_LRUW + (size_t)32 * 128 * 128 * 2);
constexpr size_t WS_WT_ABIN8 = WS_WT_ABIN + (size_t)WIN_L0_BF16_COLS * D;
constexpr size_t WS_WT_ABOUT = al256(WS_WT_ABIN + (size_t)AB_IN * D * 2);
constexpr size_t WS_WT_CDIN = al256(WS_WT_ABOUT + (size_t)D * D * 2);
constexpr size_t WS_WT_CDOUT = al256(WS_WT_CDIN + (size_t)CD_IN * D * 2);
constexpr size_t WS_WT_W1 = al256(WS_WT_CDOUT + (size_t)D * D * 2);
constexpr size_t WS_WT_W3 = al256(WS_WT_W1 + (size_t)NEXP * D * FF * 2);
constexpr size_t WS_WT_W2 = al256(WS_WT_W3 + (size_t)NEXP * D * FF * 2);
constexpr size_t WS_H8 = al256(WS_WT_W2 + (size_t)NEXP * D * FF * 2);
constexpr size_t WS_ROPE = al256(WS_H8 + (size_t)NTOK * D);
constexpr size_t WS_END = al256(WS_ROPE + 2 * 64 * 16 * 4);

extern __shared__ __attribute__((aligned(16))) unsigned char g_lds[];

struct Params {
    const float *x, *c, *ctx, *c_ctx, *ada_w, *ada_b, *norm_mix_pre, *norm_mix_post, *norm_ffn_pre, *norm_ffn_post;
    const float *ab_w_in, *ab_w_out, *mlstm_gate_b, *mlstm_norm, *na_rpb;
    const float *cd_w_in, *cd_w_out, *gqa_sink, *lru_conv_w, *lru_conv_b, *lru_gate_w, *lru_gate_b, *lru_lambda;
    const float *moe_router, *moe_w1, *moe_w3, *moe_w2;
    float* out;
    unsigned char* ws;
    int ph_lo, ph_hi;
};

#define XB_TMO      128
#define XB_XCNT(j)  (256  + 64 * (j))
#define XB_XSUB(j)  (1280 + 64 * (j))
#define XB_XGEN(j)  (2304 + 64 * (j))
#define XB_TOP      3328
#define XB_TOPGEN   3392
#define XCD_BAR_WORDS 3456
#define XB_SPIN_CAP (1u << 22)
#define LAS __attribute__((address_space(3)))

__device__ __forceinline__ unsigned xb_ld(unsigned* p)              { return __hip_atomic_load(p, __ATOMIC_RELAXED, __HIP_MEMORY_SCOPE_AGENT); }
__device__ __forceinline__ unsigned xb_add(unsigned* p, unsigned v) { return __hip_atomic_fetch_add(p, v, __ATOMIC_RELAXED, __HIP_MEMORY_SCOPE_AGENT); }
__device__ __forceinline__ unsigned xb_xcc_id() { return (unsigned)__builtin_amdgcn_s_getreg((3 << 11) | 20) & 0xFu; }
#define XB_SPIN(cond, bar) do { unsigned _sp = 0; while (cond) { __builtin_amdgcn_s_sleep(1); \
    if ((++_sp & 255u) == 0u) { if (xb_ld(&(bar)[XB_TMO])) break; if (_sp > XB_SPIN_CAP) { atomicAdd(&(bar)[XB_TMO], 1u); break; } } } } while (0)

struct XcdBarrier {
    unsigned* bar; unsigned x;
    volatile LAS unsigned* st;
};
__device__ __forceinline__ XcdBarrier xcd_barrier_post(unsigned* bar, volatile LAS unsigned* st) {
    XcdBarrier b; b.bar = bar; b.x = xb_xcc_id(); b.st = st;
    if (threadIdx.x == 0) (void)xb_add(&bar[XB_XCNT(b.x)], 1u);
    return b;
}
__device__ __forceinline__ void xcd_barrier_complete(unsigned* bar, unsigned x, unsigned& nloc, unsigned& nx) {
    const unsigned G = gridDim.x * gridDim.y * gridDim.z;
    unsigned sum, cnt, mine, sp = 0u;
    for (;;) {
        sum = 0u; cnt = 0u; mine = 0u;
#pragma unroll
        for (unsigned j = 0; j < 16; ++j) { const unsigned c = xb_ld(&bar[XB_XCNT(j)]); sum += c; cnt += (c > 0u) ? 1u : 0u; mine = (j == x) ? c : mine; }
        if (sum == G) break;
        __builtin_amdgcn_s_sleep(1);
        if ((++sp & 255u) == 0u) { if (xb_ld(&bar[XB_TMO])) break; if (sp > XB_SPIN_CAP) { atomicAdd(&bar[XB_TMO], 1u); break; } }
    }
    nloc = mine > 0u ? mine : 1u; nx = cnt > 0u ? cnt : 1u;
}
__device__ __forceinline__ void xcd_barrier(const XcdBarrier& b) {
    asm volatile("s_waitcnt vmcnt(0)" ::: "memory");
    __syncthreads();
    if (threadIdx.x == 0) {
        unsigned* bar = b.bar;
        __builtin_amdgcn_s_waitcnt(0);
        unsigned nloc = b.st[0], nx = b.st[1];
        if (nloc == 0u) { xcd_barrier_complete(bar, b.x, nloc, nx); b.st[0] = nloc; b.st[1] = nx; }
        const unsigned old = xb_add(&bar[XB_XSUB(b.x)], 1u);
        const unsigned gen = old / nloc;
        if (old + 1u == (gen + 1u) * nloc) {
            __builtin_amdgcn_fence(__ATOMIC_RELEASE, "agent");
            asm volatile("s_waitcnt vmcnt(0)" ::: "memory");
            const unsigned og = xb_add(&bar[XB_TOP], 1u);
            const unsigned tg = og / nx;
            if (og + 1u == (tg + 1u) * nx) xb_add(&bar[XB_TOPGEN], 1u);
            else XB_SPIN(xb_ld(&bar[XB_TOPGEN]) == tg, bar);
            __builtin_amdgcn_fence(__ATOMIC_ACQUIRE, "agent");
            xb_add(&bar[XB_XGEN(b.x)], 1u);
            asm volatile("s_waitcnt vmcnt(0)" ::: "memory");
        } else {
            XB_SPIN(xb_ld(&bar[XB_XGEN(b.x)]) == gen, bar);
            __builtin_amdgcn_fence(__ATOMIC_ACQUIRE, "agent");
            asm volatile("s_waitcnt vmcnt(0)" ::: "memory");
        }
    }
    __syncthreads();
}

typedef float f32x2_t __attribute__((ext_vector_type(2)));
typedef __bf16 bf16x2_t __attribute__((ext_vector_type(2)));
__device__ __forceinline__ unsigned pk_bf16(float lo, float hi) { f32x2_t v = {lo, hi}; return __builtin_bit_cast(unsigned, __builtin_convertvector(v, bf16x2_t)); }
__device__ __forceinline__ float bf_lo(unsigned u) { return __uint_as_float(u << 16); }
__device__ __forceinline__ float bf_hi(unsigned u) { return __uint_as_float(u & 0xffff0000u); }
__device__ __forceinline__ float bf2f(u16 v) { return __uint_as_float(((unsigned)v) << 16); }
typedef int i32x4 __attribute__((ext_vector_type(4)));
typedef int i32x8 __attribute__((ext_vector_type(8)));
constexpr float F8_SW = 256.f, F8_SH = 8.f, F8_SA = 4.f;
__device__ __forceinline__ float f8_clamp(float x) { return __builtin_amdgcn_fmed3f(x, -448.f, 448.f); }
__device__ __forceinline__ unsigned pk_fp8x4(float a, float b, float c, float d) {
    unsigned r = 0u;
    r = (unsigned)__builtin_amdgcn_cvt_pk_fp8_f32(f8_clamp(a), f8_clamp(b), (int)r, false);
    r = (unsigned)__builtin_amdgcn_cvt_pk_fp8_f32(f8_clamp(c), f8_clamp(d), (int)r, true);
    return r; }
__device__ __forceinline__ i32x8 cat8(bf16x8 lo, bf16x8 hi) { return __builtin_shufflevector(__builtin_bit_cast(i32x4, lo), __builtin_bit_cast(i32x4, hi), 0, 1, 2, 3, 4, 5, 6, 7); }
__device__ __forceinline__ u16 f2bf(float f) { return (u16)(pk_bf16(f, 0.f) & 0xffffu); }
template <int CTRL> __device__ __forceinline__ float dpp_f(float v) { return __uint_as_float((unsigned)__builtin_amdgcn_update_dpp(0, (int)__float_as_uint(v), CTRL, 0xf, 0xf, true)); }
__device__ __forceinline__ float row_sum16(float v) { v += dpp_f<0xB1>(v); v += dpp_f<0x4E>(v); v += dpp_f<0x141>(v); v += dpp_f<0x140>(v); return v; }
__device__ __forceinline__ float row_max16(float v) { v = fmaxf(v, dpp_f<0xB1>(v)); v = fmaxf(v, dpp_f<0x4E>(v)); v = fmaxf(v, dpp_f<0x141>(v)); v = fmaxf(v, dpp_f<0x140>(v)); return v; }
__device__ __forceinline__ float rdlane_f(float v, int l) { return __uint_as_float((unsigned)__builtin_amdgcn_readlane((int)__float_as_uint(v), l)); }
__device__ __forceinline__ float sum_x16(float v) { const auto r = __builtin_amdgcn_permlane16_swap(__float_as_uint(v), __float_as_uint(v), false, false); return __uint_as_float(r[0]) + __uint_as_float(r[1]); }
__device__ __forceinline__ float sum_x32(float v) { const auto r = __builtin_amdgcn_permlane32_swap(__float_as_uint(v), __float_as_uint(v), false, false); return __uint_as_float(r[0]) + __uint_as_float(r[1]); }
__device__ __forceinline__ float max_x16(float v) { const auto r = __builtin_amdgcn_permlane16_swap(__float_as_uint(v), __float_as_uint(v), false, false); return fmaxf(__uint_as_float(r[0]), __uint_as_float(r[1])); }
__device__ __forceinline__ float max_x32(float v) { const auto r = __builtin_amdgcn_permlane32_swap(__float_as_uint(v), __float_as_uint(v), false, false); return fmaxf(__uint_as_float(r[0]), __uint_as_float(r[1])); }
__device__ __forceinline__ float partner_x16(float v) { const auto r = __builtin_amdgcn_permlane16_swap(__float_as_uint(v), __float_as_uint(v), false, false); return __uint_as_float(r[0] ^ r[1] ^ __float_as_uint(v)); }
__device__ __forceinline__ float partner_x32(float v) { const auto r = __builtin_amdgcn_permlane32_swap(__float_as_uint(v), __float_as_uint(v), false, false); return __uint_as_float(r[0] ^ r[1] ^ __float_as_uint(v)); }
__device__ __forceinline__ float wave_sum(float v) { return sum_x32(sum_x16(row_sum16(v))); }
__device__ __forceinline__ float wave_max(float v) { return max_x32(max_x16(row_max16(v))); }
__device__ __forceinline__ int hw_slot_() { return (int)(__builtin_amdgcn_s_getreg((5 << 11) | 4) & 63u); }
__device__ __forceinline__ int tid_() {
    int lane; asm volatile("v_mbcnt_lo_u32_b32 %0, -1, 0\n\tv_mbcnt_hi_u32_b32 %0, -1, %0" : "=v"(lane));
    const int w = ((volatile LAS int*)(g_lds))[8 + hw_slot_()];
    int t = __builtin_amdgcn_readfirstlane(w) * 64 + lane; asm volatile("" : "+v"(t)); return t; }
__device__ __forceinline__ int bid_() { unsigned o = 16; asm volatile("" : "+v"(o)); return __builtin_amdgcn_readfirstlane(*(const LAS int*)((LAS unsigned char*)(g_lds) + o)); }
__device__ __forceinline__ int gdim_() { unsigned o = 20; asm volatile("" : "+v"(o)); return __builtin_amdgcn_readfirstlane(*(const LAS int*)((LAS unsigned char*)(g_lds) + o)); }
__device__ __forceinline__ unsigned char* ws_() {
    unsigned o = 24; asm volatile("" : "+v"(o));
    const u32x2 v = *(const LAS u32x2*)((LAS unsigned char*)(g_lds) + o);
    const unsigned long long a = ((unsigned long long)(unsigned)__builtin_amdgcn_readfirstlane((int)v[1]) << 32) | (unsigned)__builtin_amdgcn_readfirstlane((int)v[0]);
    return (unsigned char*)(__attribute__((address_space(1))) unsigned char*)a; }
__device__ __forceinline__ float frcp_(float x) { return __builtin_amdgcn_rcpf(x); }
__device__ __forceinline__ float sigmoidf_(float x) { return frcp_(1.f + __expf(-x)); }
__device__ __forceinline__ f32x4 mfma16(bf16x8 a, bf16x8 b, f32x4 c) { return __builtin_amdgcn_mfma_f32_16x16x32_bf16(a, b, c, 0, 0, 0); }
__device__ __forceinline__ bf16x8 ld_frag_g(const u16* p) { return *reinterpret_cast<const bf16x8*>(p); }
__device__ __forceinline__ bf16x8 ld_frag_s(const u16* p) { return *reinterpret_cast<const bf16x8*>(p); }
__device__ __forceinline__ bf16x8 mk_frag(unsigned a, unsigned b, unsigned c, unsigned d) { u32x4 v = {a, b, c, d}; return __builtin_bit_cast(bf16x8, v); }

__device__ __forceinline__ void rowdot16(const f32x4 (&v)[8], const float* R, int lane, float (&lg)[16]) {
    constexpr int RS = D + 4;
    const float* Rl = R + lane * 4;
    f32x4 ra[8], rb[8];
#pragma unroll
    for (int i = 0; i < 8; ++i) ra[i] = *reinterpret_cast<const f32x4*>(Rl + i * 256);
#pragma unroll
    for (int e = 0; e < 16; e += 2) {
#pragma unroll
        for (int i = 0; i < 8; ++i) rb[i] = *reinterpret_cast<const f32x4*>(Rl + (e + 1) * RS + i * 256);
        { f32x2_t a0 = {0.f, 0.f}, a1 = {0.f, 0.f};
#pragma unroll
          for (int i = 0; i < 8; ++i) { a0 = __builtin_elementwise_fma((f32x2_t){v[i][0], v[i][1]}, (f32x2_t){ra[i][0], ra[i][1]}, a0); a1 = __builtin_elementwise_fma((f32x2_t){v[i][2], v[i][3]}, (f32x2_t){ra[i][2], ra[i][3]}, a1); }
          lg[e] = (a0[0] + a0[1]) + (a1[0] + a1[1]); }
        __builtin_amdgcn_sched_barrier(0);
        if (e + 2 < 16) {
#pragma unroll
            for (int i = 0; i < 8; ++i) ra[i] = *reinterpret_cast<const f32x4*>(Rl + (e + 2) * RS + i * 256);
        }
        { f32x2_t a0 = {0.f, 0.f}, a1 = {0.f, 0.f};
#pragma unroll
          for (int i = 0; i < 8; ++i) { a0 = __builtin_elementwise_fma((f32x2_t){v[i][0], v[i][1]}, (f32x2_t){rb[i][0], rb[i][1]}, a0); a1 = __builtin_elementwise_fma((f32x2_t){v[i][2], v[i][3]}, (f32x2_t){rb[i][2], rb[i][3]}, a1); }
          lg[e + 1] = (a0[0] + a0[1]) + (a1[0] + a1[1]); }
        __builtin_amdgcn_sched_barrier(0);
    }
}

__device__ __forceinline__ const float* xin_row(const Params& p, int row) {
    return row < NLAT ? p.x + (size_t)row * D : p.ctx + (size_t)(row - NLAT) * D;
}
__device__ __forceinline__ const float* mod_ptr(const unsigned char* ws, int l, int row, int chunk) {
    const int bb = row < NLAT ? (row >> 12) : 4;
    return (const float*)(ws + WS_MOD) + ((size_t)(l * 5 + bb) * 6 + chunk) * D;
}

__device__ __forceinline__ void phase_mod(const Params& p, unsigned char* lds_raw) {
    unsigned char* const ws = ws_();
    float* scond = (float*)lds_raw;
    float* red = scond + 5 * D;
    const int t = tid_();
    for (int i = t; i < 5 * D; i += NT) { const int r = i >> 11, k = i & 2047; const float v = r < 4 ? p.c[r * D + k] : p.c_ctx[k]; scond[i] = v / (1.f + __expf(-v)); }
    __syncthreads();
    float* mod = (float*)(ws + WS_MOD);
    for (int item = bid_(); item < 192; item += gdim_()) {
        const int l = item / 96, col0 = (item % 96) * 128;
        const int kg = t >> 5, cl = (t & 31) * 4;
        f32x4 acc[5];
#pragma unroll
        for (int r = 0; r < 5; ++r) acc[r] = (f32x4){0.f, 0.f, 0.f, 0.f};
        const float* wp = p.ada_w + ((size_t)l * D + kg * 128) * (6 * D) + col0 + cl;
#pragma unroll 8
        for (int kk = 0; kk < 128; ++kk) {
            const f32x4 w = *reinterpret_cast<const f32x4*>(wp + (size_t)kk * (6 * D));
#pragma unroll
            for (int r = 0; r < 5; ++r) { const float s = scond[r * D + kg * 128 + kk]; acc[r] += w * s; }
        }
#pragma unroll
        for (int r = 0; r < 5; ++r) *reinterpret_cast<f32x4*>(red + (kg * 5 + r) * 128 + cl) = acc[r];
        __syncthreads();
        for (int o = t; o < 640; o += NT) {
            const int r = o >> 7, cc = o & 127;
            float s = p.ada_b[l * 6 * D + col0 + cc];
#pragma unroll
            for (int g = 0; g < 16; ++g) s += red[(g * 5 + r) * 128 + cc];
            mod[(size_t)(l * 5 + r) * 6 * D + col0 + cc] = s;
        }
        __syncthreads();
    }
}

__device__ __forceinline__ void phase_norm_mod(const Params& p, int l, unsigned char* lds) {
    unsigned char* const ws = ws_();
    const int t = tid_(), lane = t & 63, w = t >> 6;
    u16* H = (u16*)(ws + WS_H);
    float* R = (float*)lds;
    constexpr int RS = D + 4;
    float* G = (float*)(ws + WS_G);
    __syncthreads();
    for (int i = t; i < D * 16; i += NT) { const int k = i >> 4, e = i & 15; R[e * RS + k] = p.ab_w_in[(size_t)k * AB_IN + 4096 + e]; }
    __syncthreads();
    f32x4 xq[8];
    const int rstride = gdim_() * 8;
    int row = bid_() * 8 + w;
    if (row < NTOK) { const float* xr = xin_row(p, row); _Pragma("unroll") for (int i = 0; i < 8; ++i) xq[i] = *reinterpret_cast<const f32x4*>(xr + (i * 64 + lane) * 4); }
    for (; row < NTOK; row += rstride) {
        f32x4 v[8]; float ss = 0.f;
#pragma unroll
        for (int i = 0; i < 8; ++i) { v[i] = xq[i]; ss += v[i][0] * v[i][0] + v[i][1] * v[i][1] + v[i][2] * v[i][2] + v[i][3] * v[i][3]; }
        __builtin_amdgcn_sched_barrier(0);
        if (row + rstride < NTOK) { const float* xr = xin_row(p, row + rstride); _Pragma("unroll") for (int i = 0; i < 8; ++i) xq[i] = *reinterpret_cast<const f32x4*>(xr + (i * 64 + lane) * 4); }
        __builtin_amdgcn_sched_barrier(0);
        ss = wave_sum(ss);
        const float rstd = rsqrtf(ss * (1.f / D) + 1e-6f);
        const float* sh = mod_ptr(ws, l, row, 0); const float* sc = mod_ptr(ws, l, row, 1);
        const float* nw = p.norm_mix_pre + (size_t)l * D;
#pragma unroll
        for (int i = 0; i < 8; ++i) {
            const int col = (i * 64 + lane) * 4;
            const f32x4 w4 = *reinterpret_cast<const f32x4*>(nw + col), s4 = *reinterpret_cast<const f32x4*>(sc + col), h4 = *reinterpret_cast<const f32x4*>(sh + col);
            f32x4 o = v[i] * rstd * w4 * (s4 + 1.f) + h4;
            if (WIN_F8_L0) *reinterpret_cast<unsigned*>(ws + (WIN_L0_BF16_COLS ? WS_H8 : WS_H) + (size_t)row * D + col) = pk_fp8x4(o[0] * F8_SH, o[1] * F8_SH, o[2] * F8_SH, o[3] * F8_SH);
            if (!WIN_F8_L0 || WIN_L0_BF16_COLS) { const u32x2 pk = {pk_bf16(o[0], o[1]), pk_bf16(o[2], o[3])}; *reinterpret_cast<u32x2*>(H + (size_t)row * D + col) = pk; }
            v[i] = o;
        }
        float lg[16];
        rowdot16(v, R, lane, lg);
        const bool b5 = lane & 32, b4 = lane & 16, b3 = lane & 8, b2 = lane & 4;
        float t8[8], t4[4], t2[2], lgt;
#pragma unroll
        for (int j = 0; j < 8; ++j) { const float keep = b5 ? lg[8 + j] : lg[j], send = b5 ? lg[j] : lg[8 + j]; t8[j] = keep + partner_x32(send); }
#pragma unroll
        for (int j = 0; j < 4; ++j) { const float keep = b4 ? t8[4 + j] : t8[j], send = b4 ? t8[j] : t8[4 + j]; t4[j] = keep + partner_x16(send); }
#pragma unroll
        for (int j = 0; j < 2; ++j) { const float keep = b3 ? t4[2 + j] : t4[j], send = b3 ? t4[j] : t4[2 + j]; t2[j] = keep + dpp_f<0x140>(send); }
        { const float keep = b2 ? t2[1] : t2[0], send = b2 ? t2[0] : t2[1]; lgt = keep + dpp_f<0x141>(send); }
        lgt += dpp_f<0x4E>(lgt); lgt += dpp_f<0xB1>(lgt);
        if ((lane & 3) == 0) G[(size_t)row * 16 + ((b5 ? 8 : 0) + (b4 ? 4 : 0) + (b3 ? 2 : 0) + (b2 ? 1 : 0))] = lgt;
    }
}

__device__ __forceinline__ void convert_item(const float* W, int N, u16* Wt, int kb, int nb, unsigned char* lds) {
    const int t = tid_(), lane = t & 63, w = t >> 6;
    const int n4 = lane * 4, k0 = kb * 64 + w * 8, n0 = nb * 256;
    int col = n0 + n4; if (col > N - 4) col = N - 4;
    f32x4 r8[8];
#pragma unroll
    for (int j = 0; j < 8; ++j) r8[j] = *reinterpret_cast<const f32x4*>(W + (size_t)(k0 + j) * N + col);
    __syncthreads();
#pragma unroll
    for (int jj = 0; jj < 4; ++jj) {
        u32x4 v = {pk_bf16(r8[0][jj], r8[1][jj]), pk_bf16(r8[2][jj], r8[3][jj]), pk_bf16(r8[4][jj], r8[5][jj]), pk_bf16(r8[6][jj], r8[7][jj])};
        const int r = n4 + jj;
        *reinterpret_cast<u32x4*>(lds + r * 128 + ((w ^ ((r >> 2) & 7)) << 4)) = v;
    }
    __syncthreads();
    const int c = t & 7;
#pragma unroll
    for (int i = 0; i < 4; ++i) {
        const int r = (t >> 3) + 64 * i;
        if (n0 + r < N) {
            const u32x4 v = *reinterpret_cast<const u32x4*>(lds + r * 128 + ((c ^ ((r >> 2) & 7)) << 4));
            *reinterpret_cast<u32x4*>(Wt + (size_t)(n0 + r) * 2048 + kb * 64 + c * 8) = v;
        }
    }
}
template <int N>
__device__ __forceinline__ void convert_item8(const float* W, unsigned char* Wt, int kb, int nb, unsigned char* lds) {
    const int t = tid_(), lane = t & 63, w = t >> 6;
    const int n4 = lane * 4, k0 = kb * 128 + w * 16, n0 = nb * 256;
    int col = n0 + n4; if (N % 256 != 0 && col > N - 4) col = N - 4;
    f32x4 r[16];
#pragma unroll
    for (int j = 0; j < 16; ++j) r[j] = *reinterpret_cast<const f32x4*>(W + (size_t)(k0 + j) * N + col);
    __syncthreads();
#pragma unroll
    for (int jj = 0; jj < 4; ++jj) {
        u32x4 v;
#pragma unroll
        for (int q = 0; q < 4; ++q) v[q] = pk_fp8x4(r[4 * q][jj] * F8_SW, r[4 * q + 1][jj] * F8_SW, r[4 * q + 2][jj] * F8_SW, r[4 * q + 3][jj] * F8_SW);
        const int rr = n4 + jj;
        *reinterpret_cast<u32x4*>(lds + rr * 128 + ((w ^ ((rr >> 2) & 7)) << 4)) = v;
    }
    __syncthreads();
    const int c = t & 7;
#pragma unroll
    for (int i = 0; i < 4; ++i) {
        const int rr = (t >> 3) + 64 * i;
        if (N % 256 == 0 || n0 + rr < N) {
            const u32x4 v = *reinterpret_cast<const u32x4*>(lds + rr * 128 + ((c ^ ((rr >> 2) & 7)) << 4));
            *reinterpret_cast<u32x4*>(Wt + (size_t)(n0 + rr) * 2048 + kb * 128 + c * 16) = v;
        }
    }
}
__device__ __forceinline__ void convert_matrix_items(const float* W, int N, u16* Wt, int first, int count, unsigned char* lds) {
    const int nnb = (N + 255) / 256;
    for (int it = first; it < first + count; ++it) convert_item(W, N, Wt, it / nnb, it % nnb, lds);
}
__device__ __forceinline__ void phase_convert_dense(const Params& p, unsigned char* lds) {
    unsigned char* const ws = ws_();
    constexpr int NB16 = WIN_F8_L0 ? WIN_L0_BF16_COLS / 256 : 29;
    constexpr int n_ab16 = 32 * NB16, n_ab = n_ab16 + 16 * (29 - NB16), n_cd = (WIN_F8_L1 ? 16 : 32) * 14;
    for (int item = bid_(); item < n_ab + 128 + n_cd + 128; item += gdim_()) {
        if (item < n_ab16) convert_item(p.ab_w_in, AB_IN, (u16*)(ws + WS_WT_ABIN), item / NB16, item % NB16, lds);
        else if (item < n_ab) { const int it = item - n_ab16; convert_item8<AB_IN>(p.ab_w_in, ws + WS_WT_ABIN8, it / (29 - NB16), NB16 + it % (29 - NB16), lds); }
        else if (item < n_ab + 128) { const int it = item - n_ab; convert_item8<2048>(p.ab_w_out, ws + WS_WT_ABOUT, it / 8, it % 8, lds); }
        else if (item < n_ab + 128 + n_cd) { const int it = item - n_ab - 128; if (WIN_F8_L1) convert_item8<CD_IN>(p.cd_w_in, ws + WS_WT_CDIN, it / 14, it % 14, lds); else convert_item(p.cd_w_in, CD_IN, (u16*)(ws + WS_WT_CDIN), it / 14, it % 14, lds); }
        else { const int it = item - n_ab - 128 - n_cd; convert_item8<2048>(p.cd_w_out, ws + WS_WT_CDOUT, it / 8, it % 8, lds); }
    }
}
__device__ __forceinline__ void phase_convert_moe(const Params& p, int l, unsigned char* lds) {
    unsigned char* const ws = ws_();
    for (int item = bid_(); item < 3 * NEXP * 128; item += gdim_()) {
        const int which = item / (NEXP * 128), r = item % (NEXP * 128), ex = r >> 7, it = r & 127;
        const float* src = (which == 0 ? p.moe_w1 : (which == 1 ? p.moe_w3 : p.moe_w2)) + (size_t)(l * NEXP + ex) * D * FF;
        unsigned char* dst = ws + (which == 0 ? WS_WT_W1 : (which == 1 ? WS_WT_W3 : WS_WT_W2)) + (size_t)ex * D * FF;
        convert_item8<2048>(src, dst, it >> 3, it & 7, lds);
    }
}

__device__ __forceinline__ int g8_lds_byte(int r, int c) { const int st = (r >> 4) * 2 + (c >> 5), rr = r & 15, cc = c & 31, ob = rr * 64 + cc * 2; return st * 1024 + (ob ^ (((ob >> 9) & 1) << 5)); }
__device__ __forceinline__ void g8_stage_rc(int bb, int& R, int& C) { const int st = bb / 1024, sb = bb % 1024, swz = sb ^ (((sb >> 9) & 1) << 5); R = (st >> 1) * 16 + swz / 64; C = (st & 1) * 32 + (swz % 64) / 2; }
__device__ __forceinline__ int g8_perm32(int rho) { const int n = rho >> 4, i = rho & 15; return 8 * (i >> 2) + 4 * n + (i & 3); }

enum { EPI_BF16 = 0, EPI_SWIGLU = 2, EPI_SCALE = 3, EPI_F8BF16 = 4 };
struct GUnit { const char* a; const char* b0; const char* b1; const int* arow; int m0, n0, mvalid, ncols; u16* ob; int ldo; float* gates; const float* rscale; };
constexpr int G8_HTB = 128 * 64 * 2;
constexpr size_t G8_KSTEP = 128, G8_HSTEP = (size_t)128 * 2048 * 2;

template <int EPI>
__device__ __forceinline__ void g8_epilogue(const f32x4 (&acc)[2][2][4][2], const GUnit& u, int wr, int wc, int fr, int fq) {
#pragma unroll
    for (int ai = 0; ai < 2; ++ai)
#pragma unroll
        for (int m = 0; m < 4; ++m) {
            const int row = u.m0 + 128 * ai + 64 * wr + 16 * m + fr;
            if (row < u.mvalid) {
                if (EPI == EPI_BF16 || EPI == EPI_F8BF16) {
                    constexpr float si = EPI == EPI_F8BF16 ? 1.f / (F8_SH * F8_SW) : 1.f;
#pragma unroll
                    for (int bj = 0; bj < 2; ++bj) {
                        const int col = u.n0 + 128 * bj + 32 * wc + 8 * fq;
                        if (col < u.ncols) {
                            const f32x4 v0 = acc[ai][bj][m][0] * si, v1 = acc[ai][bj][m][1] * si;
                            u32x4 pk = {pk_bf16(v0[0], v0[1]), pk_bf16(v0[2], v0[3]), pk_bf16(v1[0], v1[1]), pk_bf16(v1[2], v1[3])};
                            *reinterpret_cast<u32x4*>(u.ob + (size_t)row * u.ldo + col) = pk;
                            if (u.gates && col >= 4096 && col < 4112) { *reinterpret_cast<f32x4*>(u.gates + (size_t)row * 16 + (col - 4096)) = v0; *reinterpret_cast<f32x4*>(u.gates + (size_t)row * 16 + (col - 4096) + 4) = v1; }
                        }
                    }
                } else if (EPI == EPI_SWIGLU) {
                    const int col = u.n0 + 32 * wc + 8 * fq;
                    float a[8];
                    constexpr float si = 1.f / (F8_SH * F8_SW);
#pragma unroll
                    for (int n = 0; n < 2; ++n)
#pragma unroll
                        for (int q = 0; q < 4; ++q) { const float x = acc[ai][0][m][n][q] * si; a[n * 4 + q] = x * frcp_(1.f + __expf(-x)) * (acc[ai][1][m][n][q] * (si * F8_SA)); }
                    u32x2 pk = {pk_fp8x4(a[0], a[1], a[2], a[3]), pk_fp8x4(a[4], a[5], a[6], a[7])};
                    *reinterpret_cast<u32x2*>((unsigned char*)u.ob + (size_t)row * u.ldo + col) = pk;
                } else {
                    const float sc = u.rscale[row] * (1.f / (F8_SA * F8_SW));
#pragma unroll
                    for (int bj = 0; bj < 2; ++bj) {
                        const int col = u.n0 + 128 * bj + 32 * wc + 8 * fq;
                        const f32x4 v0 = acc[ai][bj][m][0] * sc, v1 = acc[ai][bj][m][1] * sc;
                        u32x4 pk = {pk_bf16(v0[0], v0[1]), pk_bf16(v0[2], v0[3]), pk_bf16(v1[0], v1[1]), pk_bf16(v1[2], v1[3])};
                        *reinterpret_cast<u32x4*>(u.ob + (size_t)row * u.ldo + col) = pk;
                    }
                }
            }
        }
}

template <int EPI, bool GATHER, class UnitFn>
__device__ __forceinline__ void gemm_phase8(unsigned char* lds, UnitFn next) {
    const int tid = tid_(), wid = __builtin_amdgcn_readfirstlane(tid >> 6), lane = tid & 63, wr = wid >> 2, wc = wid & 3, fr = lane & 15, fq = lane >> 4;
    constexpr bool F8 = (EPI != EPI_BF16);
    constexpr int nt = F8 ? 2048 / 128 : 2048 / 64;
    constexpr unsigned ROWB = F8 ? 2048u : 4096u;
    GUnit cur, nxt; int ui = 0;
    if (!next(0, cur)) return;
    int sR[2], sC[2];
#pragma unroll
    for (int i = 0; i < 2; ++i) g8_stage_rc(tid * 16 + i * 8192, sR[i], sC[i]);
    unsigned voffB[2];
#pragma unroll
    for (int i = 0; i < 2; ++i) voffB[i] = (unsigned)((sR[i] & ~31) + g8_perm32(sR[i] & 31)) * ROWB + (unsigned)sC[i] * 2u;
    unsigned voffA[2][2], voffAn[2][2];
    auto set_voffA = [&](const GUnit& u, unsigned (&vo)[2][2]) {
#pragma unroll
        for (int h = 0; h < 2; ++h)
#pragma unroll
            for (int i = 0; i < 2; ++i) {
                if (GATHER) vo[h][i] = (unsigned)u.arow[u.m0 + h * 128 + sR[i]] * ROWB + (unsigned)sC[i] * 2u;
                else vo[h][i] = (unsigned)(h * 128 + sR[i]) * ROWB + (unsigned)sC[i] * 2u;
            } };
    set_voffA(cur, voffA);
    const unsigned ldsw = (unsigned)wid * 1024u;
    const int aoff = g8_lds_byte(wr * 64 + fr, fq * 8), boff = g8_lds_byte(wc * 32 + fr, fq * 8);
#define G8_SA(b, h) (((b) * 2 + (h)) * G8_HTB)
#define G8_SB(b, h) ((4 + (b) * 2 + (h)) * G8_HTB)
#define G8_STAGE(bufoff, gbase, voff) do { _Pragma("unroll") for (int _i = 0; _i < 2; ++_i) \
        __builtin_amdgcn_global_load_lds((const unsigned*)((const char*)(gbase) + (voff)[_i]), (LAS unsigned*)(lds + (bufoff) + ldsw + _i * 8192), 16, 0, 0); } while (0)
#define G8_LDA(dst, b, h) do { _Pragma("unroll") for (int m = 0; m < 4; ++m) _Pragma("unroll") for (int k = 0; k < 2; ++k) dst[m][k] = *(const LAS bf16x8*)(lds + G8_SA(b, h) + aoff + m * 2048 + k * 1024); } while (0)
#define G8_LDB(dst, b, h) do { _Pragma("unroll") for (int n = 0; n < 2; ++n) _Pragma("unroll") for (int k = 0; k < 2; ++k) dst[n][k] = *(const LAS bf16x8*)(lds + G8_SB(b, h) + boff + n * 2048 + k * 1024); } while (0)
#define G8_MMA(ai, bj, At, Bt) do { __builtin_amdgcn_s_setprio(1); _Pragma("unroll") for (int m = 0; m < 4; ++m) _Pragma("unroll") for (int n = 0; n < 2; ++n) { \
        if (F8) { const i32x8 _b = cat8(Bt[n][0], Bt[n][1]), _a = cat8(At[m][0], At[m][1]); asm volatile("v_mfma_f32_16x16x128_f8f6f4 %0, %1, %2, %0" : "+v"(acc[ai][bj][m][n]) : "v"(_b), "v"(_a)); } \
        else { _Pragma("unroll") for (int k = 0; k < 2; ++k) acc[ai][bj][m][n] = __builtin_amdgcn_mfma_f32_16x16x32_bf16(Bt[n][k], At[m][k], acc[ai][bj][m][n], 0, 0, 0); } } \
        __builtin_amdgcn_s_setprio(0); } while (0)
#define G8_WAIT_V(n) asm volatile("s_waitcnt vmcnt(" #n ")" ::: "memory")
#define G8_WAIT_L(n) asm volatile("s_waitcnt lgkmcnt(" #n ")" ::: "memory")
#define G8_BAR __builtin_amdgcn_s_barrier()
#define G8_SCHED __builtin_amdgcn_sched_barrier(0)
    f32x4 acc[2][2][4][2];
#pragma unroll
    for (int a2 = 0; a2 < 2; ++a2)
#pragma unroll
        for (int b2 = 0; b2 < 2; ++b2)
#pragma unroll
            for (int m = 0; m < 4; ++m)
#pragma unroll
                for (int n = 0; n < 2; ++n) acc[a2][b2][m][n] = (f32x4){0.f, 0.f, 0.f, 0.f};
    bf16x8 At[4][2], B0[2][2], B1[2][2];
    const char* cA = cur.a; const char* cB0 = cur.b0; const char* cB1 = cur.b1;
    G8_STAGE(G8_SB(0, 0), cB0, voffB); G8_STAGE(G8_SA(0, 0), cA, voffA[0]); G8_STAGE(G8_SB(0, 1), cB1, voffB); G8_STAGE(G8_SA(0, 1), cA, voffA[1]);
    if (wr == 1) G8_BAR;
    G8_WAIT_V(4); G8_BAR;
    G8_STAGE(G8_SB(1, 0), cB0 + G8_KSTEP, voffB); G8_STAGE(G8_SA(1, 0), cA + G8_KSTEP, voffA[0]); G8_STAGE(G8_SB(1, 1), cB1 + G8_KSTEP, voffB);
    G8_WAIT_V(6); G8_BAR;
    for (;;) {
        const bool has_next = next(ui + 1, nxt);
        const char* nA = has_next ? nxt.a : cA; const char* nB0 = has_next ? nxt.b0 : cB0; const char* nB1 = has_next ? nxt.b1 : cB1;
        if (GATHER) { if (has_next) set_voffA(nxt, voffAn); else { _Pragma("unroll") for (int h = 0; h < 2; ++h) _Pragma("unroll") for (int i = 0; i < 2; ++i) voffAn[h][i] = voffA[h][i]; } }
        for (int t = 0; t < nt; t += 2) {
            const bool last = (t == nt - 2);
            const char* a1 = cA + (size_t)(t + 1) * G8_KSTEP;
            const char* a2 = last ? nA : cA + (size_t)(t + 2) * G8_KSTEP;
            const char* b20 = last ? nB0 : cB0 + (size_t)(t + 2) * G8_KSTEP; const char* b21 = last ? nB1 : cB1 + (size_t)(t + 2) * G8_KSTEP;
            const char* a3 = a2 + G8_KSTEP; const char* b30 = b20 + G8_KSTEP; const char* b31 = b21 + G8_KSTEP;
            unsigned vA2[2][2];
#pragma unroll
            for (int h = 0; h < 2; ++h)
#pragma unroll
                for (int i = 0; i < 2; ++i) vA2[h][i] = (GATHER && last) ? voffAn[h][i] : voffA[h][i];
            G8_LDB(B0, 0, 0); G8_SCHED; G8_LDA(At, 0, 0); G8_STAGE(G8_SA(1, 1), a1, voffA[1]);
            G8_WAIT_L(8); G8_BAR; G8_WAIT_L(0); G8_MMA(0, 0, At, B0); G8_BAR; G8_SCHED;
            G8_LDB(B1, 0, 1); G8_STAGE(G8_SB(0, 0), b20, voffB);
            G8_BAR; G8_WAIT_L(0); G8_MMA(0, 1, At, B1); G8_BAR;
            G8_LDA(At, 0, 1); G8_STAGE(G8_SA(0, 0), a2, vA2[0]);
            G8_BAR; G8_WAIT_L(0); G8_MMA(1, 0, At, B0); G8_BAR; G8_SCHED;
            G8_STAGE(G8_SB(0, 1), b21, voffB);
            G8_WAIT_V(6); G8_BAR; G8_MMA(1, 1, At, B1); G8_BAR;
            G8_LDB(B0, 1, 0); G8_SCHED; G8_LDA(At, 1, 0); G8_STAGE(G8_SA(0, 1), a2, vA2[1]);
            G8_WAIT_L(8); G8_BAR; G8_WAIT_L(0); G8_MMA(0, 0, At, B0); G8_BAR; G8_SCHED;
            G8_LDB(B1, 1, 1); G8_STAGE(G8_SB(1, 0), b30, voffB);
            G8_BAR; G8_WAIT_L(0); G8_MMA(0, 1, At, B1); G8_BAR;
            G8_LDA(At, 1, 1); G8_STAGE(G8_SA(1, 0), a3, vA2[0]);
            G8_BAR; G8_WAIT_L(0); G8_MMA(1, 0, At, B0); G8_BAR; G8_SCHED;
            G8_STAGE(G8_SB(1, 1), b31, voffB);
            G8_WAIT_V(6); G8_BAR; G8_MMA(1, 1, At, B1); G8_BAR;
        }
        if (F8) asm volatile("s_nop 15\n\ts_nop 15" ::: "memory");
        g8_epilogue<EPI>(acc, cur, wr, wc, fr, fq);
        if (!has_next) break;
#pragma unroll
        for (int a2 = 0; a2 < 2; ++a2)
#pragma unroll
            for (int b2 = 0; b2 < 2; ++b2)
#pragma unroll
                for (int m = 0; m < 4; ++m)
#pragma unroll
                    for (int n = 0; n < 2; ++n) acc[a2][b2][m][n] = (f32x4){0.f, 0.f, 0.f, 0.f};
        cur = nxt; cA = nA; cB0 = nB0; cB1 = nB1; ++ui;
        if (GATHER) { _Pragma("unroll") for (int h = 0; h < 2; ++h) _Pragma("unroll") for (int i = 0; i < 2; ++i) voffA[h][i] = voffAn[h][i]; }
    }
    G8_WAIT_V(0);
    if (wr == 0) G8_BAR;
    G8_BAR;
#undef G8_SA
#undef G8_SB
#undef G8_STAGE
#undef G8_LDA
#undef G8_LDB
#undef G8_MMA
#undef G8_WAIT_V
#undef G8_WAIT_L
#undef G8_BAR
#undef G8_SCHED
}

template <bool F8, bool REV = false>
__device__ __forceinline__ void phase_gemm_dense(const Params& p, const u16* A, int M, const u16* Wt, int N, u16* ob, int ldo, float* gates, unsigned char* lds) {
    const int nM = M / 256, nN = (N + 255) / 256, L = nM * nN;
    const int xcd = bid_() & 7, nslot = gdim_() >> 3, slot = bid_() >> 3;
    const int base = (int)(((long)L * xcd) >> 3), cnt = (int)(((long)L * (xcd + 1)) >> 3) - base;
    const int G8n = nM >> 3, rem = nM & 7;
    auto next = [&](int i, GUnit& u) -> bool {
        int k = slot + i * nslot;
        if (REV) {
            if (slot < 4) { if (i >= 4) return false; k = slot * 4 + i; }
            else k = 16 + (slot - 4) + i * (nslot - 4);
        }
        if (k >= cnt) return false;
        const int idx = base + k;
        int pn, pm;
        if (idx < G8n * 8 * nN) { const int gq = idx / (8 * nN), r = idx % (8 * nN); pn = r >> 3; pm = gq * 8 + (r & 7); }
        else { const int r = idx - G8n * 8 * nN; pn = r / rem; pm = G8n * 8 + r % rem; }
        constexpr size_t rowb = F8 ? 2048 : 4096;
        u.a = (const char*)A + (size_t)pm * 256 * rowb; u.b0 = (const char*)Wt + (size_t)pn * 256 * rowb; u.b1 = u.b0 + 128 * rowb; u.arow = nullptr;
        u.m0 = pm * 256; u.n0 = pn * 256; u.mvalid = M; u.ncols = N; u.ob = ob; u.ldo = ldo; u.gates = gates; u.rscale = nullptr;
        return true; };
    gemm_phase8<F8 ? EPI_F8BF16 : EPI_BF16, false>(lds, next);
}

__device__ __forceinline__ void phase_gemm_dense_f8rev(const Params& p, const u16* A, int M, const u16* Wt, int N, u16* ob, int ldo, unsigned char* lds) { phase_gemm_dense<true, true>(p, A, M, Wt, N, ob, ldo, nullptr, lds); }
__device__ __forceinline__ void phase_moe_a(const Params& p, int l, unsigned char* lds) {
    unsigned char* const ws = ws_();
    const int mvalid = l == 0 ? 2176 : 2048, nM = l == 0 ? 9 : 8;
    const int per_e = nM * 16;
    const int xcd = bid_() & 7, slot = bid_() >> 3, nslot = gdim_() >> 3;
    auto next = [&](int i, GUnit& u) -> bool {
        const int k = slot + i * nslot;
        if (k >= 2 * per_e) return false;
        const int tile = xcd * 2 * per_e + k;
        const int ex = tile / per_e, r = tile % per_e, pn = r / nM, pm = r % nM;
        u.a = (const char*)(ws + WS_H); u.arow = (const int*)(ws + WS_EROW) + ex * EPAD;
        u.b0 = (const char*)(ws + WS_WT_W1) + ((size_t)ex * FF + pn * 128) * D; u.b1 = (const char*)(ws + WS_WT_W3) + ((size_t)ex * FF + pn * 128) * D;
        u.m0 = pm * 256; u.n0 = pn * 128; u.mvalid = mvalid; u.ncols = FF; u.ob = (u16*)(ws + WS_ACT + (size_t)ex * EPAD * FF); u.ldo = FF; u.gates = nullptr; u.rscale = nullptr;
        return true; };
    gemm_phase8<EPI_SWIGLU, true>(lds, next);
}
__device__ __forceinline__ void phase_moe_b(const Params& p, int l, unsigned char* lds) {
    unsigned char* const ws = ws_();
    const int mvalid = l == 0 ? 2176 : 2048, nM = l == 0 ? 9 : 8;
    const int per_e = nM * 8;
    const int xcd = bid_() & 7, slot = bid_() >> 3, nslot = gdim_() >> 3;
    auto next = [&](int i, GUnit& u) -> bool {
        const int k = slot + i * nslot;
        if (k >= 2 * per_e) return false;
        const int tile = xcd * 2 * per_e + k;
        const int ex = tile / per_e, r = tile % per_e, pn = r / nM, pm = r % nM;
        u.a = (const char*)(ws + WS_ACT) + ((size_t)ex * EPAD + pm * 256) * FF; u.arow = nullptr;
        u.b0 = (const char*)(ws + WS_WT_W2) + ((size_t)ex * D + pn * 256) * FF; u.b1 = u.b0 + (size_t)128 * 2048;
        u.m0 = pm * 256; u.n0 = pn * 256; u.mvalid = mvalid; u.ncols = D; u.ob = (u16*)(ws + WS_YEXP) + (size_t)ex * EPAD * D; u.ldo = D; u.gates = nullptr;
        u.rscale = (const float*)(ws + WS_EGATE) + ex * EPAD;
        return true; };
    gemm_phase8<EPI_SCALE, false>(lds, next);
}

__device__ __forceinline__ int mlstm_row(int b, int dir, int pos) {
    if (pos < LC) return NLAT + b * LC + (dir ? (LC - 1 - pos) : pos);
    const int q = pos - LC; return b * SEQ + (dir ? (SEQ - 1 - q) : q);
}
__device__ __forceinline__ void phase_mlstm(const Params& p, unsigned char* lds) {
    unsigned char* const ws = ws_();
    u16* KT = (u16*)lds;
    u16* VT = KT + 256 * 72;
    u16* VWT = VT + 48 * 72;
    u16* CT = VWT + 48 * 72;
    u16* Ss = CT + 48 * 264;
    float* gB = (float*)(Ss + 64 * 72);
    float* gI = gB + 68 * 64;
    float* gP = gI + 68 * 64;
    float* gE = gP + 68 * 64;
    const int t = tid_(), lane = t & 63, w = t >> 6, fr = lane & 15, fq = lane >> 4;
    const u16* P = (const u16*)(ws + WS_P);
    const float* G = (const float*)(ws + WS_G);
    u16* HM = (u16*)(ws + WS_HM);
    for (int item = bid_(); item < 256; item += gdim_()) {
        const int combo = (item & 7) * 4 + (item >> 6), vs = (item >> 3) & 7, dir = combo & 1, hh = (combo >> 1) & 3, b = combo >> 3;
        __syncthreads();
        for (int i = t; i < 48 * 264; i += NT) CT[i] = 0;
        for (int i = t; i < 16 * 72; i += NT) { const int er = i / 72; VT[32 * 72 + i] = (er == 0) ? (u16)0x3f80 : (u16)0; VWT[32 * 72 + i] = 0; }
        {
            const float gb_i = p.mlstm_gate_b[(dir * 2 + 0) * 4 + hh], gb_f = p.mlstm_gate_b[(dir * 2 + 1) * 4 + hh];
            for (int ch = w; ch < 68; ch += 8) {
                const int row = mlstm_row(b, dir, ch * 64 + lane);
                const float gi = G[(size_t)row * 16 + dir * 8 + hh] + gb_i;
                const float gf = G[(size_t)row * 16 + dir * 8 + 4 + hh] + gb_f;
                const float lf = fminf(gf, 0.f) - log1pf(__expf(-fabsf(gf)));
                float bc = lf;
#pragma unroll
                for (int o = 1; o < 64; o <<= 1) { const float n = __shfl_up(bc, o, 64); if (lane >= o) bc += n; }
                float pm = gi - bc;
#pragma unroll
                for (int o = 1; o < 64; o <<= 1) { const float n = __shfl_up(pm, o, 64); if (lane >= o) pm = fmaxf(pm, n); }
                const float b63 = __shfl(bc, 63, 64);
                float gmax = b63 - bc + gi;
#pragma unroll
                for (int o = 32; o > 0; o >>= 1) gmax = fmaxf(gmax, __shfl_xor(gmax, o, 64));
                gB[ch * 64 + lane] = bc; gI[ch * 64 + lane] = gi; gP[ch * 64 + lane] = pm;
                if (lane == 0) { gE[ch * 2] = b63; gE[ch * 2 + 1] = gmax; }
            }
        }
        f32x4 Cacc[2][3];
#pragma unroll
        for (int i = 0; i < 2; ++i)
#pragma unroll
            for (int j = 0; j < 3; ++j) Cacc[i][j] = (f32x4){0.f, 0.f, 0.f, 0.f};
        float m_old = 0.f;
        const int jt = w & 3, sth = w >> 2;
        const int vs_s = t & 63, vs_eg = t >> 6;
        bf16x8 qf[8]; unsigned ktr[2][8]; u32x2 vraw;
        const int jq = jt * 16 + fr, jjq = dir ? 63 - jq : jq;
        const unsigned off_q = (unsigned)jjq * AB_IN + hh * 256 + fq * 8;
        const int jk0 = (sth * 2) * 16 + fr, jk1 = jk0 + 16;
        const unsigned off_k0 = (unsigned)(dir ? 63 - jk0 : jk0) * AB_IN + 1024 + hh * 256 + fq * 8;
        const unsigned off_k1 = (unsigned)(dir ? 63 - jk1 : jk1) * AB_IN + 1024 + hh * 256 + fq * 8;
        unsigned off_kt[2];
#pragma unroll
        for (int i = 0; i < 2; ++i) { const int mt = t + NT * i, d2 = (mt & 127) * 2, s8 = (mt >> 7) * 8; off_kt[i] = (unsigned)(dir ? 63 - s8 - 7 : s8) * AB_IN + 1024 + hh * 256 + d2; }
        const unsigned off_v = (unsigned)(dir ? 63 - vs_s : vs_s) * AB_IN + 2048 + hh * 256 + vs * 32 + vs_eg * 4;
        const unsigned off_h = (unsigned)jjq * 1024 + hh * 256 + vs * 32 + sth * 16 + 4 * fq;
#define ML_BASE(POS0) (P + (size_t)(dir ? mlstm_row(b, dir, (POS0)) - 63 : mlstm_row(b, dir, (POS0))) * AB_IN)
#define ML_LOAD_Q(POS0) do { const u16* _pc = ML_BASE(POS0); \
            _Pragma("unroll") for (int kk = 0; kk < 8; ++kk) qf[kk] = ld_frag_g(_pc + off_q + kk * 32); } while (0)
#define ML_LOAD_K(POS0, S2) do { const u16* _pc = ML_BASE(POS0); \
            _Pragma("unroll") for (int kk = 0; kk < 8; ++kk) kf[kk] = ld_frag_g(_pc + ((S2) ? off_k1 : off_k0) + kk * 32); } while (0)
#define ML_LOAD_KTV(POS0) do { const u16* _pc = ML_BASE(POS0); \
            _Pragma("unroll") for (int i = 0; i < 2; ++i) { \
                _Pragma("unroll") for (int q = 0; q < 8; ++q) ktr[i][q] = *reinterpret_cast<const unsigned*>(_pc + (size_t)((dir ? 7 - q : q) * AB_IN) + off_kt[i]); } \
            vraw = *reinterpret_cast<const u32x2*>(_pc + off_v); } while (0)
        ML_LOAD_Q(0); ML_LOAD_KTV(0);
        __syncthreads();
        for (int ch = 0; ch < 68; ++ch) {
            const int pos0 = ch * 64;
            const float* sb = gB + ch * 64; const float* sig = gI + ch * 64; const float* spm = gP + ch * 64;
            const float b63 = gE[ch * 2], m_new = fmaxf(b63 + m_old, gE[ch * 2 + 1]), decay = __expf(b63 + m_old - m_new);
            const int jg = jt * 16 + fr;
            const float bj = sb[jg], mj = bj + fmaxf(m_old, spm[jg]);
            auto s_tile = [&](int st) {
                f32x4 sv = (f32x4){0.f, 0.f, 0.f, 0.f};
                if (st <= jt) {
                    typedef short s16x4 __attribute__((ext_vector_type(4)));
                    const u16* kb = KT + (8 * fq + ((lane & 15) >> 2)) * 72 + st * 16 + 4 * (lane & 3);
#pragma unroll
                    for (int kk = 0; kk < 8; ++kk) {
                        const s16x4 lo = __builtin_amdgcn_ds_read_tr16_b64_v4i16((LAS s16x4*)(kb + kk * 32 * 72));
                        const s16x4 hi = __builtin_amdgcn_ds_read_tr16_b64_v4i16((LAS s16x4*)(kb + (kk * 32 + 4) * 72));
                        const bf16x8 kfr = {lo[0], lo[1], lo[2], lo[3], hi[0], hi[1], hi[2], hi[3]};
                        sv = mfma16(kfr, qf[kk], sv);
                    }
                }
                float pv[4];
#pragma unroll
                for (int q = 0; q < 4; ++q) {
                    const int sg = st * 16 + 4 * fq + q;
                    pv[q] = (sg <= jg) ? sv[q] * 0.0625f * __expf(bj - sb[sg] + sig[sg] - mj) : 0.f;
                }
                u32x2 pk = {pk_bf16(pv[0], pv[1]), pk_bf16(pv[2], pv[3])};
                *reinterpret_cast<u32x2*>(Ss + jg * 72 + st * 16 + 4 * fq) = pk;
            };
#pragma unroll
            for (int i = 0; i < 2; ++i) {
                const int mt = t + NT * i, d2 = (mt & 127) * 2, s8 = (mt >> 7) * 8;
                u32x4 lo = {(ktr[i][0] & 0xffffu) | (ktr[i][1] << 16), (ktr[i][2] & 0xffffu) | (ktr[i][3] << 16), (ktr[i][4] & 0xffffu) | (ktr[i][5] << 16), (ktr[i][6] & 0xffffu) | (ktr[i][7] << 16)};
                u32x4 hi = {(ktr[i][0] >> 16) | (ktr[i][1] & 0xffff0000u), (ktr[i][2] >> 16) | (ktr[i][3] & 0xffff0000u), (ktr[i][4] >> 16) | (ktr[i][5] & 0xffff0000u), (ktr[i][6] >> 16) | (ktr[i][7] & 0xffff0000u)};
                *reinterpret_cast<u32x4*>(KT + d2 * 72 + s8) = lo;
                *reinterpret_cast<u32x4*>(KT + (d2 + 1) * 72 + s8) = hi;
            }
            {
                const float wg = __expf(b63 - sb[vs_s] + sig[vs_s] - m_new) * 0.0625f;
                const float v0 = bf_lo(vraw[0]), v1 = bf_hi(vraw[0]), v2 = bf_lo(vraw[1]), v3 = bf_hi(vraw[1]);
                const int e0 = vs_eg * 4;
                VT[(e0 + 0) * 72 + vs_s] = (u16)(vraw[0] & 0xffffu); VT[(e0 + 1) * 72 + vs_s] = (u16)(vraw[0] >> 16);
                VT[(e0 + 2) * 72 + vs_s] = (u16)(vraw[1] & 0xffffu); VT[(e0 + 3) * 72 + vs_s] = (u16)(vraw[1] >> 16);
                VWT[(e0 + 0) * 72 + vs_s] = f2bf(v0 * wg); VWT[(e0 + 1) * 72 + vs_s] = f2bf(v1 * wg);
                VWT[(e0 + 2) * 72 + vs_s] = f2bf(v2 * wg); VWT[(e0 + 3) * 72 + vs_s] = f2bf(v3 * wg);
                if (t < 64) VWT[32 * 72 + t] = f2bf(wg);
            }
            if (ch + 1 < 68) ML_LOAD_KTV(pos0 + 64);
            __syncthreads();
            s_tile(sth * 2);
            s_tile(sth * 2 + 1);
            __syncthreads();
            {
                const float w_inter = __expf(bj + m_old - mj);
                f32x4 nacc[2];
#pragma unroll
                for (int z = 0; z < 2; ++z) {
                    const int et = z == 0 ? sth : 2;
                    f32x4 a = (f32x4){0.f, 0.f, 0.f, 0.f};
#pragma unroll
                    for (int kk = 0; kk < 8; ++kk) a = mfma16(ld_frag_s(CT + (et * 16 + fr) * 264 + kk * 32 + fq * 8), qf[kk], a);
                    nacc[z] = a * w_inter;
                }
                if (ch + 1 < 68) ML_LOAD_Q(pos0 + 64);
#pragma unroll
                for (int z = 0; z < 2; ++z) {
                    const int et = z == 0 ? sth : 2;
                    f32x4 a = nacc[z];
#pragma unroll
                    for (int k2 = 0; k2 < 2; ++k2) a = mfma16(ld_frag_s(VT + (et * 16 + fr) * 72 + k2 * 32 + fq * 8), ld_frag_s(Ss + jg * 72 + k2 * 32 + fq * 8), a);
                    nacc[z] = a;
                }
                const float den = __shfl(nacc[1][0], fr, 64);
                const float dd = fmaxf(fabsf(den), __expf(-mj));
                const float inv = 1.f / dd;
                u32x2 pk = {pk_bf16(nacc[0][0] * inv, nacc[0][1] * inv), pk_bf16(nacc[0][2] * inv, nacc[0][3] * inv)};
                *reinterpret_cast<u32x2*>(HM + ((size_t)dir * NTOK + (dir ? mlstm_row(b, dir, pos0) - 63 : mlstm_row(b, dir, pos0))) * 1024 + off_h) = pk;
            }
#pragma unroll
            for (int i = 0; i < 2; ++i)
#pragma unroll
                for (int et = 0; et < 3; ++et) {
                    f32x4 a = Cacc[i][et] * decay;
#pragma unroll
                    for (int k2 = 0; k2 < 2; ++k2) a = mfma16(ld_frag_s(KT + ((w * 2 + i) * 16 + fr) * 72 + k2 * 32 + fq * 8), ld_frag_s(VWT + (et * 16 + fr) * 72 + k2 * 32 + fq * 8), a);
                    Cacc[i][et] = a;
                }
            __syncthreads();
#pragma unroll
            for (int i = 0; i < 2; ++i)
#pragma unroll
                for (int et = 0; et < 3; ++et) {
                    const f32x4 a = Cacc[i][et];
                    u32x2 pk = {pk_bf16(a[0], a[1]), pk_bf16(a[2], a[3])};
                    *reinterpret_cast<u32x2*>(CT + (et * 16 + fr) * 264 + (w * 2 + i) * 16 + 4 * fq) = pk;
                }
            m_old = m_new;
        }
#undef ML_LOAD_Q
#undef ML_LOAD_K
#undef ML_LOAD_KTV
    }
}

__device__ __forceinline__ void mlstm_out_rows(const Params& p, int row0, int nrows) {
    unsigned char* const ws = ws_();
    const int lane = tid_() & 63, w = tid_() >> 6;
    const u16* P = (const u16*)(ws + WS_P);
    const u16* HM = (const u16*)(ws + WS_HM);
    u16* YIN = (u16*)(ws + WS_YIN);
    for (int r = w; r < nrows; r += 8) {
        const int row = row0 + r;
        const int c0 = lane * 16;
        float v[16]; float ss = 0.f;
#pragma unroll
        for (int h2 = 0; h2 < 2; ++h2) {
            const u32x4 a = *reinterpret_cast<const u32x4*>(HM + (size_t)row * 1024 + c0 + h2 * 8);
            const u32x4 bq = *reinterpret_cast<const u32x4*>(HM + ((size_t)NTOK + row) * 1024 + c0 + h2 * 8);
#pragma unroll
            for (int q = 0; q < 4; ++q) { v[h2 * 8 + 2 * q] = bf_lo(a[q]) + bf_lo(bq[q]); v[h2 * 8 + 2 * q + 1] = bf_hi(a[q]) + bf_hi(bq[q]); }
        }
#pragma unroll
        for (int q = 0; q < 16; ++q) ss += v[q] * v[q];
        ss += __shfl_xor(ss, 1, 64); ss += __shfl_xor(ss, 2, 64); ss += __shfl_xor(ss, 4, 64); ss += __shfl_xor(ss, 8, 64);
        const float rstd = rsqrtf(ss * (1.f / 256.f) + 1e-6f);
        float y[16];
#pragma unroll
        for (int h2 = 0; h2 < 2; ++h2) {
            const u32x4 og = *reinterpret_cast<const u32x4*>(P + (size_t)row * AB_IN + 3072 + c0 + h2 * 8);
#pragma unroll
            for (int q = 0; q < 4; ++q) {
                const int c = c0 + h2 * 8 + 2 * q;
                y[h2 * 8 + 2 * q] = v[h2 * 8 + 2 * q] * rstd * p.mlstm_norm[c] * sigmoidf_(bf_lo(og[q])) * F8_SH;
                y[h2 * 8 + 2 * q + 1] = v[h2 * 8 + 2 * q + 1] * rstd * p.mlstm_norm[c + 1] * sigmoidf_(bf_hi(og[q])) * F8_SH;
            }
        }
        *reinterpret_cast<u32x4*>((unsigned char*)YIN + (size_t)row * D + c0) = (u32x4){pk_fp8x4(y[0], y[1], y[2], y[3]), pk_fp8x4(y[4], y[5], y[6], y[7]), pk_fp8x4(y[8], y[9], y[10], y[11]), pk_fp8x4(y[12], y[13], y[14], y[15])};
    }
}

template <int DH, class KeyFn, class BiasFn>
__device__ __forceinline__ void attn_wave(const u16* qptr, size_t qstride, int nblk, KeyFn keyfn, BiasFn biasfn, float scale,
                                           float m_init, float l_init, u16* vlds, u16* optr, size_t ostride) {
    constexpr int NK = DH / 32, NDT = DH / 16, VS = DH + 8, NV = DH / 16;
    const int lane = tid_() & 63, fr = lane & 15, fq = lane >> 4;
    bf16x8 qf[NK];
#pragma unroll
    for (int kk = 0; kk < NK; ++kk) qf[kk] = ld_frag_g(qptr + (size_t)fr * qstride + kk * 32 + fq * 8);
    f32x4 oacc[NDT];
#pragma unroll
    for (int i = 0; i < NDT; ++i) oacc[i] = (f32x4){0.f, 0.f, 0.f, 0.f};
    float m = m_init, l = l_init;
    bf16x8 kn[2][NK]; u32x4 vn[NV];
    auto load_blk = [&](int ib) {
        const u16* kptr; const u16* vptr; size_t kvs;
        (void)keyfn(ib, kptr, vptr, kvs);
#pragma unroll
        for (int st = 0; st < 2; ++st)
#pragma unroll
            for (int kk = 0; kk < NK; ++kk) kn[st][kk] = ld_frag_g(kptr + (size_t)(st * 16 + fr) * kvs + kk * 32 + fq * 8);
#pragma unroll
        for (int i = 0; i < NV; ++i) { const int cidx = lane + 64 * i, r = cidx / (DH / 8), cc = cidx % (DH / 8); vn[i] = *reinterpret_cast<const u32x4*>(vptr + (size_t)r * kvs + cc * 8); }
    };
    auto next_valid = [&](int ib) { const u16* a; const u16* b2; size_t c; while (ib < nblk && !keyfn(ib, a, b2, c)) ++ib; return ib; };
    int ib = next_valid(0);
    if (ib < nblk) load_blk(ib);
    while (ib < nblk) {
        bf16x8 kc[2][NK]; u32x4 vc[NV];
#pragma unroll
        for (int st = 0; st < 2; ++st)
#pragma unroll
            for (int kk = 0; kk < NK; ++kk) kc[st][kk] = kn[st][kk];
#pragma unroll
        for (int i = 0; i < NV; ++i) vc[i] = vn[i];
        const int ibn = next_valid(ib + 1);
        if (ibn < nblk) load_blk(ibn);
        asm volatile("" ::: "memory");
#pragma unroll
        for (int i = 0; i < NV; ++i) { const int cidx = lane + 64 * i, r = cidx / (DH / 8), cc = cidx % (DH / 8); *reinterpret_cast<u32x4*>(vlds + r * VS + cc * 8) = vc[i]; }
        f32x4 s[2];
#pragma unroll
        for (int st = 0; st < 2; ++st) {
            f32x4 a = (f32x4){0.f, 0.f, 0.f, 0.f};
#pragma unroll
            for (int kk = 0; kk < NK; ++kk) a = mfma16(kc[st][kk], qf[kk], a);
            s[st] = a;
        }
        float x[8]; float mx = -INFINITY;
#pragma unroll
        for (int st = 0; st < 2; ++st)
#pragma unroll
            for (int q = 0; q < 4; ++q) { const float v = s[st][q] * scale + biasfn(ib, fr, st * 16 + 4 * fq + q); x[st * 4 + q] = v; mx = fmaxf(mx, v); }
        mx = max_x32(max_x16(mx));
        const float m_new = fmaxf(m, mx);
        const float m_safe = (m_new == -INFINITY) ? 0.f : m_new;
        const float alpha = __expf(m - m_safe);
        float ps = 0.f; float pe[8];
#pragma unroll
        for (int q = 0; q < 8; ++q) { pe[q] = __expf(x[q] - m_safe); ps += pe[q]; }
        l = l * alpha + ps; m = m_new;
#pragma unroll
        for (int i = 0; i < NDT; ++i) oacc[i] *= alpha;
        const bf16x8 pf = mk_frag(pk_bf16(pe[0], pe[1]), pk_bf16(pe[2], pe[3]), pk_bf16(pe[4], pe[5]), pk_bf16(pe[6], pe[7]));
        asm volatile("s_waitcnt lgkmcnt(0)" ::: "memory");
        {
            typedef short s16x4 __attribute__((ext_vector_type(4)));
            const int tq = (lane & 15) >> 2, tp = lane & 3;
            const u16* vb0 = vlds + (4 * fq + tq) * VS + 4 * tp;
            const u16* vb1 = vb0 + 16 * VS;
#pragma unroll
            for (int dt = 0; dt < NDT; ++dt) {
                const s16x4 lo = __builtin_amdgcn_ds_read_tr16_b64_v4i16((LAS s16x4*)(vb0 + dt * 16));
                const s16x4 hi = __builtin_amdgcn_ds_read_tr16_b64_v4i16((LAS s16x4*)(vb1 + dt * 16));
                const bf16x8 vf = {lo[0], lo[1], lo[2], lo[3], hi[0], hi[1], hi[2], hi[3]};
                oacc[dt] = mfma16(vf, pf, oacc[dt]);
            }
        }
        asm volatile("" ::: "memory");
        ib = ibn;
    }
    l = sum_x32(sum_x16(l));
    const float inv = 1.f / l;
#pragma unroll
    for (int dt = 0; dt < NDT; ++dt) {
        const f32x4 o = oacc[dt] * (inv * F8_SH);
        *reinterpret_cast<unsigned*>((unsigned char*)optr + (size_t)fr * ostride + dt * 16 + 4 * fq) = pk_fp8x4(o[0], o[1], o[2], o[3]);
    }
}


template <int DH, class SlabFn, class SubFn, class BiasFn>
__device__ __forceinline__ void attn_block(const u16* qptr, size_t qstride, int nslab, SlabFn slabfn, SubFn subfn, BiasFn biasfn, float scale,
                                            float m_init, float l_init, unsigned char* lds, u16* optr, size_t ostride) {
    constexpr int NK = DH / 32, NDT = DH / 16, VS = DH + 8, NLD = DH / 64;
    constexpr int STAGE = 2 * 64 * VS * 2;
    const int t = tid_(), lane = t & 63, fr = lane & 15, fq = lane >> 4;
    bf16x8 qf[NK];
#pragma unroll
    for (int kk = 0; kk < NK; ++kk) qf[kk] = ld_frag_g(qptr + (size_t)fr * qstride + kk * 32 + fq * 8);
    f32x4 oacc[NDT];
#pragma unroll
    for (int i = 0; i < NDT; ++i) oacc[i] = (f32x4){0.f, 0.f, 0.f, 0.f};
    float m = m_init, l = l_init;
    u32x4 kreg[NLD], vreg[NLD];
    auto load_slab = [&](int i) {
        const u16* kp; const u16* vp; size_t kvs; slabfn(i, kp, vp, kvs);
#pragma unroll
        for (int q = 0; q < NLD; ++q) { const int c = t + NT * q, r = c / (DH / 8), cc = c % (DH / 8);
            kreg[q] = *reinterpret_cast<const u32x4*>(kp + (size_t)r * kvs + cc * 8); vreg[q] = *reinterpret_cast<const u32x4*>(vp + (size_t)r * kvs + cc * 8); } };
    auto store_slab = [&](int st) {
        u16* Ks = (u16*)(lds + st * STAGE); u16* Vs = Ks + 64 * VS;
#pragma unroll
        for (int q = 0; q < NLD; ++q) { const int c = t + NT * q, r = c / (DH / 8), cc = c % (DH / 8);
            *reinterpret_cast<u32x4*>(Ks + r * VS + cc * 8) = kreg[q]; *reinterpret_cast<u32x4*>(Vs + r * VS + cc * 8) = vreg[q]; } };
    __syncthreads();
    load_slab(0); store_slab(0);
    if (nslab > 1) load_slab(1);
    __syncthreads();
    for (int i = 0; i < nslab; ++i) {
        const int cur = i & 1;
        if (i + 1 < nslab) store_slab(cur ^ 1);
        if (i + 2 < nslab) load_slab(i + 2);
        const u16* Ks = (const u16*)(lds + cur * STAGE); const u16* Vs = Ks + 64 * VS;
#pragma unroll
        for (int j = 0; j < 2; ++j) {
            int off;
            if (!subfn(i, j, off)) continue;
            f32x4 s[2];
#pragma unroll
            for (int st = 0; st < 2; ++st) {
                f32x4 a = (f32x4){0.f, 0.f, 0.f, 0.f};
#pragma unroll
                for (int kk = 0; kk < NK; ++kk) a = mfma16(ld_frag_s(Ks + (off + st * 16 + fr) * VS + kk * 32 + fq * 8), qf[kk], a);
                s[st] = a;
            }
            float x[8]; float mx = -INFINITY;
#pragma unroll
            for (int st = 0; st < 2; ++st)
#pragma unroll
                for (int q = 0; q < 4; ++q) { const float v = s[st][q] * scale + biasfn(i, off, fr, st * 16 + 4 * fq + q); x[st * 4 + q] = v; mx = fmaxf(mx, v); }
            mx = max_x32(max_x16(mx));
            const float m_new = fmaxf(m, mx);
            const float m_safe = (m_new == -INFINITY) ? 0.f : m_new;
            const float alpha = __expf(m - m_safe);
            float ps = 0.f; float pe[8];
#pragma unroll
            for (int q = 0; q < 8; ++q) { pe[q] = __expf(x[q] - m_safe); ps += pe[q]; }
            l = l * alpha + ps; m = m_new;
#pragma unroll
            for (int dt = 0; dt < NDT; ++dt) oacc[dt] *= alpha;
            const bf16x8 pf = mk_frag(pk_bf16(pe[0], pe[1]), pk_bf16(pe[2], pe[3]), pk_bf16(pe[4], pe[5]), pk_bf16(pe[6], pe[7]));
            typedef short s16x4 __attribute__((ext_vector_type(4)));
            const int tq = (lane & 15) >> 2, tp = lane & 3;
            const u16* vb0 = Vs + (off + 4 * fq + tq) * VS + 4 * tp;
            const u16* vb1 = vb0 + 16 * VS;
#pragma unroll
            for (int dt = 0; dt < NDT; ++dt) {
                const s16x4 lo = __builtin_amdgcn_ds_read_tr16_b64_v4i16((LAS s16x4*)(vb0 + dt * 16));
                const s16x4 hi = __builtin_amdgcn_ds_read_tr16_b64_v4i16((LAS s16x4*)(vb1 + dt * 16));
                const bf16x8 vf = {lo[0], lo[1], lo[2], lo[3], hi[0], hi[1], hi[2], hi[3]};
                oacc[dt] = mfma16(vf, pf, oacc[dt]);
            }
        }
        __syncthreads();
    }
    l = sum_x32(sum_x16(l));
    const float inv = 1.f / l;
#pragma unroll
    for (int dt = 0; dt < NDT; ++dt) {
        const f32x4 o = oacc[dt] * (inv * F8_SH);
        *reinterpret_cast<unsigned*>((unsigned char*)optr + (size_t)fr * ostride + dt * 16 + 4 * fq) = pk_fp8x4(o[0], o[1], o[2], o[3]);
    }
}

__device__ __forceinline__ void phase_l0_stage2(const Params& p, unsigned char* lds) {
    unsigned char* const ws = ws_();
    const int w = tid_() >> 6;
    const u16* P = (const u16*)(ws + WS_P);
    u16* YIN = (u16*)(ws + WS_YIN);
    for (int item = bid_(); item < 1088 + 2176; item += gdim_()) {
        if (item < 1024) {
            const int r2 = item & 31, h = (item >> 5) & 7, b = item >> 8;
            const int rr = w >> 2, qt = w & 3, r = 2 * r2 + rr;
            const int r0 = min(max(r - 4, 0), 56);
            const int krow0 = min(max(2 * r2 - 4, 0), 56), nwin = min(max(2 * r2 + 1 - 4, 0), 56) + 8 - krow0;
            const int cb = qt == 0 ? 0 : (qt == 1 ? 8 : (qt == 2 ? 24 : 32));
            const int qrow = b * SEQ + r * 64 + qt * 16;
            const float* rpb = p.na_rpb + h * 15 * 31;
            auto slabfn = [&](int i, const u16*& kp, const u16*& vp, size_t& kvs) {
                const int row = i < nwin ? b * SEQ + (krow0 + i) * 64 : NLAT + b * LC + (i - nwin) * 64;
                kp = P + (size_t)row * AB_IN + 5136 + h * 128; vp = P + (size_t)row * AB_IN + 6160 + h * 128; kvs = AB_IN; };
            auto subfn = [&](int i, int j, int& off) -> bool {
                if (i < nwin) { off = cb; return j == 0 && (krow0 + i) >= r0 && (krow0 + i) < r0 + 8; }
                off = 32 * j; return true; };
            auto biasfn = [&](int i, int off, int qi, int ki) -> float {
                if (i >= nwin) return 0.f;
                const int c = qt * 16 + qi, kc = off + ki, c0 = min(max(c - 8, 0), 48);
                if (kc < c0 || kc >= c0 + 16) return -INFINITY;
                return rpb[(krow0 + i - r + 7) * 31 + (kc - c + 15)]; };
            attn_block<128>(P + (size_t)qrow * AB_IN + 4112 + h * 128, AB_IN, nwin + 4, slabfn, subfn, biasfn, 0.08838834764831845f, -INFINITY, 0.f, lds,
                            (u16*)((unsigned char*)YIN + (size_t)qrow * D + 1024 + h * 128), D);
        } else if (item < 1088) {
            const int it = item - 1024, half = it & 1, h = (it >> 1) & 7, b = it >> 4;
            const int qrow = NLAT + b * LC + (half * 8 + w) * 16;
            auto slabfn = [&](int i, const u16*& kp, const u16*& vp, size_t& kvs) {
                const int row = NLAT + b * LC + i * 64;
                kp = P + (size_t)row * AB_IN + 5136 + h * 128; vp = P + (size_t)row * AB_IN + 6160 + h * 128; kvs = AB_IN; };
            auto subfn = [&](int, int j, int& off) -> bool { off = 32 * j; return true; };
            auto biasfn = [&](int, int, int, int) -> float { return 0.f; };
            attn_block<128>(P + (size_t)qrow * AB_IN + 4112 + h * 128, AB_IN, 4, slabfn, subfn, biasfn, 0.08838834764831845f, -INFINITY, 0.f, lds,
                            (u16*)((unsigned char*)YIN + (size_t)qrow * D + 1024 + h * 128), D);
        } else {
            mlstm_out_rows(p, (item - 1088) * 8, 8);
        }
    }
}

__device__ __forceinline__ void rope_prep(const Params& p) {
    if (bid_() != 0) return;
    float* T = (float*)(ws_() + WS_ROPE);
    for (int i = tid_(); i < 1024; i += NT) {
        const int pos = i >> 4, j = i & 15;
        const float inv = exp2f(-(float)j * (13.287712379549449f / 16.f));
        float sn, cs; sincosf((float)pos * inv, &sn, &cs);
        T[i] = cs; T[1024 + i] = sn;
    }
}
__device__ __forceinline__ void rope_rows(const Params& p, int row0, int nrows) {
    unsigned char* const ws = ws_();
    const int lane = tid_() & 63, w = tid_() >> 6;
    u16* P = (u16*)(ws + WS_P);
    const float* T = (const float*)(ws + WS_ROPE);
    for (int r = w; r < nrows; r += 8) {
        const int row = row0 + r, tt = row & (SEQ - 1), prow = tt >> 6, pcol = tt & 63;
#pragma unroll
        for (int it = 0; it < 2; ++it) {
            const int c = it * 64 + lane;
            if (c < 80) {
                const int head = c >> 2, half = (c >> 1) & 1, j0 = (c & 1) * 8;
                u16* q1 = P + (size_t)row * CD_IN + head * 64 + half * 32 + j0;
                const float* tc = T + (half ? pcol : prow) * 16 + j0;
                const u32x4 xa = *reinterpret_cast<const u32x4*>(q1), xb = *reinterpret_cast<const u32x4*>(q1 + 16);
                const f32x4 c0 = *reinterpret_cast<const f32x4*>(tc), c1 = *reinterpret_cast<const f32x4*>(tc + 4);
                const f32x4 s0 = *reinterpret_cast<const f32x4*>(tc + 1024), s1 = *reinterpret_cast<const f32x4*>(tc + 1028);
                const float cs[8] = {c0[0], c0[1], c0[2], c0[3], c1[0], c1[1], c1[2], c1[3]}, sn[8] = {s0[0], s0[1], s0[2], s0[3], s1[0], s1[1], s1[2], s1[3]};
                u32x4 oa, ob;
#pragma unroll
                for (int q = 0; q < 4; ++q) {
                    const float a0 = bf_lo(xa[q]), a1 = bf_hi(xa[q]), b0 = bf_lo(xb[q]), b1 = bf_hi(xb[q]);
                    oa[q] = pk_bf16(a0 * cs[2 * q] - b0 * sn[2 * q], a1 * cs[2 * q + 1] - b1 * sn[2 * q + 1]);
                    ob[q] = pk_bf16(b0 * cs[2 * q] + a0 * sn[2 * q], b1 * cs[2 * q + 1] + a1 * sn[2 * q + 1]);
                }
                *reinterpret_cast<u32x4*>(q1) = oa; *reinterpret_cast<u32x4*>(q1 + 16) = ob;
            }
        }
    }
}

__device__ __forceinline__ int lru_row(int b, int ci, int j) { return ci < 4 ? NLAT + b * LC + ci * 64 + j : b * SEQ + (ci - 4) * 64 + j; }
__device__ __forceinline__ void lru_chunk(const Params& p, int b, int blk, int ci, int mode, unsigned char* lds) {
    unsigned char* const ws = ws_();
    u16* ub = (u16*)lds;
    constexpr int SR = 132;
    float* sa = (float*)(ub + 64 * 136);
    float* sbt = sa + 64 * SR;
    float* sx = sbt + 64 * SR;
    const int t = tid_(), lane = t & 63, w = t >> 6, fr = lane & 15, fq = lane >> 4;
    const u16* P = (const u16*)(ws + WS_P);
    const u16* WT = (const u16*)(ws + WS_LRUW);
    float* SA = (float*)(ws + WS_LRUS);
    float* SH = SA + 2 * 4 * 68 * 1024;
    const int seglen = ci < 4 ? LC : SEQ, tt0 = ci < 4 ? ci * 64 : (ci - 4) * 64;
    const int rbase = ci < 4 ? NLAT + b * LC : b * SEQ;
    const int sc = t & 127, seg = t >> 7;
    const int chg_s = blk * 128 + sc;
    const int cg = blk * 128 + w * 16 + 4 * fq;
    bf16x8 wfa[2][2][4];
#pragma unroll
    for (int d2 = 0; d2 < 2; ++d2)
#pragma unroll
        for (int g2 = 0; g2 < 2; ++g2)
#pragma unroll
            for (int kk = 0; kk < 4; ++kk) wfa[d2][g2][kk] = ld_frag_g(WT + ((size_t)((d2 * 2 + g2) * 8 + blk) * 128 + w * 16 + fr) * 128 + fq * 8 + kk * 32);
    f32x4 gba[2][2], lama[2];
#pragma unroll
    for (int d2 = 0; d2 < 2; ++d2) {
        lama[d2] = *reinterpret_cast<const f32x4*>(p.lru_lambda + d2 * 1024 + cg);
#pragma unroll
        for (int g2 = 0; g2 < 2; ++g2) gba[d2][g2] = *reinterpret_cast<const f32x4*>(p.lru_gate_b + (d2 * 2 + g2) * 1024 + cg);
    }
    float carry[2] = {0.f, 0.f}; u16 grv[16];
    if (mode == 1) {
#pragma unroll
        for (int d2 = 0; d2 < 2; ++d2) carry[d2] = SH[((size_t)(d2 * 4 + b) * 68 + ci) * 1024 + chg_s];
#pragma unroll
        for (int s = 0; s < 16; ++s) grv[s] = P[(size_t)lru_row(b, ci, seg * 16 + s) * CD_IN + 2560 + chg_s];
    }
    __syncthreads();
    {
        const int c4 = (t & 31) * 4, j0 = (t >> 5) * 4, ch = blk * 128 + c4;
        float xv[7][4];
#pragma unroll
        for (int q = 0; q < 7; ++q) {
            const int tt = tt0 + j0 - 1 + q;
            if (tt >= 0 && tt < seglen) {
                const u32x2 v = *reinterpret_cast<const u32x2*>(P + (size_t)(rbase + tt) * CD_IN + 1536 + ch);
                xv[q][0] = bf_lo(v[0]); xv[q][1] = bf_hi(v[0]); xv[q][2] = bf_lo(v[1]); xv[q][3] = bf_hi(v[1]);
            } else { xv[q][0] = xv[q][1] = xv[q][2] = xv[q][3] = 0.f; }
        }
        f32x4 cw[4];
#pragma unroll
        for (int tp = 0; tp < 4; ++tp) cw[tp] = *reinterpret_cast<const f32x4*>(p.lru_conv_w + tp * 1024 + ch);
        const f32x4 cb = *reinterpret_cast<const f32x4*>(p.lru_conv_b + ch);
#pragma unroll
        for (int q = 0; q < 4; ++q) {
            float u[4];
#pragma unroll
            for (int cc = 0; cc < 4; ++cc) u[cc] = cb[cc] + xv[q][cc] * cw[0][cc] + xv[q + 1][cc] * cw[1][cc] + xv[q + 2][cc] * cw[2][cc] + xv[q + 3][cc] * cw[3][cc];
            u32x2 pk = {pk_bf16(u[0], u[1]), pk_bf16(u[2], u[3])};
            *reinterpret_cast<u32x2*>(ub + (j0 + q) * 136 + c4) = pk;
        }
    }
    __syncthreads();
    float hfw[16];
    for (int dir = 0; dir < 2; ++dir) {
        f32x4 av[4];
        {
            bf16x8 wf[4];
#pragma unroll
            for (int kk = 0; kk < 4; ++kk) wf[kk] = dir ? wfa[1][0][kk] : wfa[0][0][kk];
            const f32x4 gbv = dir ? gba[1][0] : gba[0][0];
            const f32x4 lamv = dir ? lama[1] : lama[0];
            float sp8[4];
#pragma unroll
            for (int q = 0; q < 4; ++q) { const float nl = -lamv[q]; sp8[q] = -8.f * (fmaxf(nl, 0.f) + __logf(1.f + __expf(-fabsf(nl)))); }
#pragma unroll
            for (int tt = 0; tt < 4; ++tt) {
                f32x4 z = (f32x4){0.f, 0.f, 0.f, 0.f};
#pragma unroll
                for (int kk = 0; kk < 4; ++kk) z = mfma16(wf[kk], ld_frag_s(ub + (tt * 16 + fr) * 136 + kk * 32 + fq * 8), z);
#pragma unroll
                for (int q = 0; q < 4; ++q) av[tt][q] = __expf(sigmoidf_(z[q] + gbv[q]) * sp8[q]);
            }
        }
        __syncthreads();
        {
            bf16x8 wf[4];
#pragma unroll
            for (int kk = 0; kk < 4; ++kk) wf[kk] = dir ? wfa[1][1][kk] : wfa[0][1][kk];
            const f32x4 gbv = dir ? gba[1][1] : gba[0][1];
#pragma unroll
            for (int tt = 0; tt < 4; ++tt) {
                f32x4 z = (f32x4){0.f, 0.f, 0.f, 0.f};
#pragma unroll
                for (int kk = 0; kk < 4; ++kk) z = mfma16(wf[kk], ld_frag_s(ub + (tt * 16 + fr) * 136 + kk * 32 + fq * 8), z);
                const int tj = tt * 16 + fr;
                const u32x2 uv = *reinterpret_cast<const u32x2*>(ub + tj * 136 + w * 16 + 4 * fq);
                const float u4[4] = {bf_lo(uv[0]), bf_hi(uv[0]), bf_lo(uv[1]), bf_hi(uv[1])};
                f32x4 bv;
#pragma unroll
                for (int q = 0; q < 4; ++q) { const float a = av[tt][q]; bv[q] = __builtin_amdgcn_sqrtf(fmaxf(1.f - a * a, 0.f)) * sigmoidf_(z[q] + gbv[q]) * u4[q]; }
                *reinterpret_cast<f32x4*>(sa + tj * SR + w * 16 + 4 * fq) = av[tt];
                *reinterpret_cast<f32x4*>(sbt + tj * SR + w * 16 + 4 * fq) = bv;
            }
        }
        __syncthreads();
        float A = 1.f, h = 0.f;
#pragma unroll
        for (int s = 0; s < 16; ++s) { const int j = seg * 16 + (dir ? 15 - s : s); const float a = sa[j * SR + sc]; h = a * h + sbt[j * SR + sc]; A *= a; }
        sx[(seg * 2 + 0) * 128 + sc] = A; sx[(seg * 2 + 1) * 128 + sc] = h;
        __syncthreads();
        const size_t sidx = ((size_t)(dir * 4 + b) * 68 + ci) * 1024 + chg_s;
        if (mode == 0) {
            if (seg == 0) {
                float At = 1.f, ht = 0.f;
#pragma unroll
                for (int s = 0; s < 4; ++s) { const int sg = dir ? 3 - s : s; const float a = sx[(sg * 2) * 128 + sc]; ht = a * ht + sx[(sg * 2 + 1) * 128 + sc]; At *= a; }
                SA[sidx] = At; SH[sidx] = ht;
            }
        } else {
            float hs = dir ? carry[1] : carry[0];
            const int nprev = dir ? 3 - seg : seg;
#pragma unroll
            for (int s = 0; s < 3; ++s) if (s < nprev) { const int sg = dir ? 3 - s : s; hs = sx[(sg * 2) * 128 + sc] * hs + sx[(sg * 2 + 1) * 128 + sc]; }
            u16* YIN = (u16*)(ws + WS_YIN);
            if (dir == 0) {
#pragma unroll
                for (int s = 0; s < 16; ++s) { const int j = seg * 16 + s; hs = sa[j * SR + sc] * hs + sbt[j * SR + sc]; hfw[s] = hs; }
            } else {
#pragma unroll
                for (int s = 0; s < 16; ++s) {
                    const int js = 15 - s, j = seg * 16 + js;
                    hs = sa[j * SR + sc] * hs + sbt[j * SR + sc];
                    const int row = lru_row(b, ci, j);
                    const float gr = bf2f(grv[js]);
                    const float th = 1.f - 2.f * frcp_(1.f + __expf(1.5957691216057308f * (gr + 0.044715f * gr * gr * gr)));
                    const float ge = 0.5f * gr * (1.f + th);
                    ((unsigned char*)YIN)[(size_t)row * D + 1024 + chg_s] = (unsigned char)(pk_fp8x4((hfw[js] + hs) * ge * F8_SH, 0.f, 0.f, 0.f) & 0xffu);
                }
            }
        }
    }
}

__device__ __forceinline__ void lru_prep_weights(const Params& p) {
    unsigned char* const ws = ws_();
    const int t = tid_();
    u16* WT = (u16*)(ws + WS_LRUW);
    for (int m = bid_(); m < 32; m += gdim_()) {
        const float* Wg = p.lru_gate_w + (size_t)m * 128 * 128;
        const int j4 = (t & 31) * 4, i8 = (t >> 5) * 8;
        f32x4 r8[8];
#pragma unroll
        for (int q = 0; q < 8; ++q) r8[q] = *reinterpret_cast<const f32x4*>(Wg + (size_t)(i8 + q) * 128 + j4);
#pragma unroll
        for (int jj = 0; jj < 4; ++jj) {
            u32x4 v = {pk_bf16(r8[0][jj], r8[1][jj]), pk_bf16(r8[2][jj], r8[3][jj]), pk_bf16(r8[4][jj], r8[5][jj]), pk_bf16(r8[6][jj], r8[7][jj])};
            *reinterpret_cast<u32x4*>(WT + ((size_t)m * 128 + j4 + jj) * 128 + i8) = v;
        }
    }
}
__device__ __forceinline__ void lru_carry(const Params& p, int item) {
    unsigned char* const ws = ws_();
    const int idx = item * NT + tid_();
    const int c = idx & 1023, b = (idx >> 10) & 3, dir = idx >> 12;
    float* SA = (float*)(ws + WS_LRUS);
    float* SH = SA + 2 * 4 * 68 * 1024;
    const size_t base = ((size_t)(dir * 4 + b) * 68) * 1024 + c;
    float h = 0.f;
#pragma unroll 4
    for (int s = 0; s < 68; ++s) {
        const int cj = dir == 0 ? s : (s < 4 ? 3 - s : 71 - s);
        const float a = SA[base + (size_t)cj * 1024], hl = SH[base + (size_t)cj * 1024];
        SH[base + (size_t)cj * 1024] = h;
        h = a * h + hl;
    }
}

__device__ __forceinline__ void gqa_item(const Params& p, int it, unsigned char* lds) {
    unsigned char* const ws = ws_();
    const int w = tid_() >> 6;
    const u16* P = (const u16*)(ws + WS_P);
    u16* YIN = (u16*)(ws + WS_YIN);
    const int t32 = it & 127, kvh = (it >> 7) & 3, b = it >> 9;
    const int hq = kvh * 4 + (w & 3), t0 = t32 * 32 + (w >> 2) * 16;
    const int kfirst = max((t32 * 32 - 128) & ~63, 0), klast = min(((t32 * 32 - 128) & ~63) + 256, SEQ - 64);
    const int nwin = (klast - kfirst) / 64 + 1;
    const int qrow = b * SEQ + t0;
    auto slabfn = [&](int i, const u16*& kp, const u16*& vp, size_t& kvs) {
        const int row = i < nwin ? b * SEQ + kfirst + i * 64 : NLAT + b * LC + (i - nwin) * 64;
        kp = P + (size_t)row * CD_IN + 1024 + kvh * 64; vp = P + (size_t)row * CD_IN + 1280 + kvh * 64; kvs = CD_IN; };
    auto subfn = [&](int i, int j, int& off) -> bool {
        off = 32 * j;
        if (i >= nwin) return true;
        const int k0 = kfirst + i * 64 + off;
        return k0 + 31 >= t0 - 128 && k0 <= t0 + 15 + 128; };
    auto biasfn = [&](int i, int off, int qi, int ki) -> float {
        if (i >= nwin) return 0.f;
        const int dq = (t0 + qi) - (kfirst + i * 64 + off + ki);
        return (dq > 128 || dq < -128) ? -INFINITY : 0.f; };
    const float sink = p.gqa_sink[hq];
    attn_block<64>(P + (size_t)qrow * CD_IN + hq * 64, CD_IN, nwin + 4, slabfn, subfn, biasfn, 0.125f, sink, ((tid_() & 63) >> 4) == 0 ? 1.f : 0.f, lds,
                   (u16*)((unsigned char*)YIN + (size_t)qrow * D + hq * 64), D);
}

__device__ __forceinline__ void phase_l1_stage1(const Params& p, unsigned char* lds) {
    for (int item = bid_(); item < 2176 + 2048; item += gdim_()) {
        if (item < 2176) { const int ci = item % 68, blk = (item / 68) & 7, b = item / (68 * 8); lru_chunk(p, b, blk, ci, 0, lds); }
        else rope_rows(p, (item - 2176) * 8, 8);
    }
}
__device__ __forceinline__ void phase_l1_stage2(const Params& p, unsigned char* lds) {
    for (int item = bid_(); item < 16 + 2048; item += gdim_()) {
        if (item < 16) lru_carry(p, item);
        else gqa_item(p, item - 16, lds);
    }
}
__device__ __forceinline__ void phase_l1_stage3(const Params& p, unsigned char* lds) {
    for (int item = bid_(); item < 2048; item += gdim_()) { const int cl = item & 63, blk = (item >> 6) & 7, b = item >> 9; lru_chunk(p, b, blk, cl + 4, 1, lds); }
}

__device__ __forceinline__ void phase_rowpass_mid(const Params& p, int l, unsigned char* lds) {
    unsigned char* const ws = ws_();
    float* R = (float*)lds;
    const int t = tid_(), lane = t & 63, w = t >> 6;
    const int nrows = l == 0 ? NTOK : NLAT;
    __syncthreads();
    constexpr int RS = D + 4;
    for (int i = t; i < D * NEXP; i += NT) { const int k = i >> 4, e = i & 15; R[e * RS + k] = p.moe_router[(size_t)l * D * NEXP + i]; }
    __syncthreads();
    const u16* Y = (const u16*)(ws + WS_Y);
    u16* XL1 = (u16*)(ws + WS_XL1);
    u16* H = (u16*)(ws + WS_H);
    float* AFF = (float*)(ws + WS_AFF);
    u32x2 yq[8]; f32x4 xq[8]; u32x2 xq2[8];
    const int rstride = gdim_() * 8;
    int row = bid_() * 8 + w;
#define RP_FETCH(ROW) do { const int _rw = (ROW); \
        _Pragma("unroll") for (int i = 0; i < 8; ++i) yq[i] = *reinterpret_cast<const u32x2*>(Y + (size_t)_rw * D + (i * 64 + lane) * 4); \
        if (l == 0) { const float* _xr = xin_row(p, _rw); _Pragma("unroll") for (int i = 0; i < 8; ++i) xq[i] = *reinterpret_cast<const f32x4*>(_xr + (i * 64 + lane) * 4); } \
        else { const u16* _xb = (const u16*)(ws + WS_XL2) + (size_t)_rw * D; _Pragma("unroll") for (int i = 0; i < 8; ++i) xq2[i] = *reinterpret_cast<const u32x2*>(_xb + (i * 64 + lane) * 4); } } while (0)
    if (row < nrows) RP_FETCH(row);
    for (; row < nrows; row += rstride) {
        f32x4 v[8]; float ss = 0.f;
#pragma unroll
        for (int i = 0; i < 8; ++i) { const u32x2 q = yq[i]; v[i] = (f32x4){bf_lo(q[0]), bf_hi(q[0]), bf_lo(q[1]), bf_hi(q[1])}; ss += v[i][0] * v[i][0] + v[i][1] * v[i][1] + v[i][2] * v[i][2] + v[i][3] * v[i][3]; }
        ss = wave_sum(ss);
        const float rstd = rsqrtf(ss * (1.f / D) + 1e-6f);
        const float* g1 = mod_ptr(ws, l, row, 2);
        const float* nw = p.norm_mix_post + (size_t)l * D;
        float ss1 = 0.f;
#pragma unroll
        for (int i = 0; i < 8; ++i) {
            const int col = (i * 64 + lane) * 4;
            f32x4 x4;
            if (l == 0) x4 = xq[i];
            else { const u32x2 q = xq2[i]; x4 = (f32x4){bf_lo(q[0]), bf_hi(q[0]), bf_lo(q[1]), bf_hi(q[1])}; }
            const f32x4 w4 = *reinterpret_cast<const f32x4*>(nw + col), g4 = *reinterpret_cast<const f32x4*>(g1 + col);
            const f32x4 x1 = x4 + g4 * (v[i] * rstd * w4);
            { const u32x2 pk1 = {pk_bf16(x1[0], x1[1]), pk_bf16(x1[2], x1[3])}; *reinterpret_cast<u32x2*>(XL1 + (size_t)row * D + col) = pk1; }
            v[i] = x1; ss1 += x1[0] * x1[0] + x1[1] * x1[1] + x1[2] * x1[2] + x1[3] * x1[3];
        }
        __builtin_amdgcn_sched_barrier(0);
        if (row + rstride < nrows) RP_FETCH(row + rstride);
        __builtin_amdgcn_sched_barrier(0);
        ss1 = wave_sum(ss1);
        const float rstd1 = rsqrtf(ss1 * (1.f / D) + 1e-6f);
        const float* sh = mod_ptr(ws, l, row, 3); const float* sc = mod_ptr(ws, l, row, 4);
        const float* nw2 = p.norm_ffn_pre + (size_t)l * D;
#pragma unroll
        for (int i = 0; i < 8; ++i) {
            const int col = (i * 64 + lane) * 4;
            const f32x4 w4 = *reinterpret_cast<const f32x4*>(nw2 + col), s4 = *reinterpret_cast<const f32x4*>(sc + col), h4 = *reinterpret_cast<const f32x4*>(sh + col);
            const f32x4 o = v[i] * rstd1 * w4 * (s4 + 1.f) + h4;
            *reinterpret_cast<unsigned*>((unsigned char*)H + (size_t)row * D + col) = pk_fp8x4(o[0] * F8_SH, o[1] * F8_SH, o[2] * F8_SH, o[3] * F8_SH);
            v[i] = o;
        }
        float lg[16];
        rowdot16(v, R, lane, lg);
        const bool b5 = lane & 32, b4 = lane & 16, b3 = lane & 8, b2 = lane & 4;
        float t8[8], t4[4], t2[2], lgt;
#pragma unroll
        for (int j = 0; j < 8; ++j) { const float keep = b5 ? lg[8 + j] : lg[j], send = b5 ? lg[j] : lg[8 + j]; t8[j] = keep + partner_x32(send); }
#pragma unroll
        for (int j = 0; j < 4; ++j) { const float keep = b4 ? t8[4 + j] : t8[j], send = b4 ? t8[j] : t8[4 + j]; t4[j] = keep + partner_x16(send); }
#pragma unroll
        for (int j = 0; j < 2; ++j) { const float keep = b3 ? t4[2 + j] : t4[j], send = b3 ? t4[j] : t4[2 + j]; t2[j] = keep + dpp_f<0x140>(send); }
        { const float keep = b2 ? t2[1] : t2[0], send = b2 ? t2[0] : t2[1]; lgt = keep + dpp_f<0x141>(send); }
        lgt += dpp_f<0x4E>(lgt); lgt += dpp_f<0xB1>(lgt);
        const float mx = wave_max(lgt);
        const float pe = __expf(lgt - mx);
        const float den = wave_sum(pe) * 0.25f;
        if ((lane & 3) == 0) AFF[(size_t)row * 16 + ((b5 ? 8 : 0) + (b4 ? 4 : 0) + (b3 ? 2 : 0) + (b2 ? 1 : 0))] = pe / den;
    }
#undef RP_FETCH
}

__device__ __forceinline__ void phase_topk(const Params& p, int l, unsigned char* lds) {
    unsigned char* const ws = ws_();
    unsigned* keys = (unsigned*)lds;
    unsigned* hist = keys + 4096;
    unsigned* misc = hist + 256;
    const int t = tid_(), lane = t & 63, w = t >> 6;
    const float* AFF = (const float*)(ws + WS_AFF);
    int* SLOT = (int*)(ws + WS_SLOT);
    int* EROW = (int*)(ws + WS_EROW);
    float* EGATE = (float*)(ws + WS_EGATE);
    const int nitems = l == 0 ? 128 : 64;
    for (int item = bid_(); item < nitems; item += gdim_()) {
        const int kind = item >> 6, b = (item >> 4) & 3, ex = item & 15;
        const int n = kind ? LC : SEQ, cap = n / 8, rowbase = kind ? NLAT + b * LC : b * SEQ;
        __syncthreads();
        for (int i = t; i < n; i += NT) keys[i] = __float_as_uint(AFF[(size_t)(rowbase + i) * 16 + ex]);
        unsigned prefix = 0u, mask = 0u; int kth = cap;
        for (int shift = 24; shift >= 0; shift -= 8) {
            __syncthreads();
            if (t < 256) hist[t] = 0u;
            __syncthreads();
            for (int i = t; i < n; i += NT) { const unsigned k = keys[i]; if ((k & mask) == prefix) atomicAdd(&hist[(k >> shift) & 255u], 1u); }
            __syncthreads();
            if (t < 256) {
                unsigned above = 0u;
                for (int d2 = t + 1; d2 < 256; ++d2) above += hist[d2];
                const unsigned here = hist[t];
                if ((int)above < kth && (int)(above + here) >= kth) { misc[0] = (unsigned)t; misc[1] = (unsigned)(kth - (int)above); }
            }
            __syncthreads();
            prefix |= misc[0] << shift; mask |= 255u << shift; kth = (int)misc[1];
        }
        const unsigned T = prefix; const int need_eq = kth;
        int cgt = 0, ceq = 0;
        const int base = t * 8;
        if (base < n) {
#pragma unroll
            for (int q = 0; q < 8; ++q) { const unsigned k = keys[base + q]; cgt += (k > T); ceq += (k == T); }
        }
        int packed = cgt | (ceq << 16);
        int incl = packed;
#pragma unroll
        for (int o = 1; o < 64; o <<= 1) { const int nb = __shfl_up(incl, o, 64); if (lane >= o) incl += nb; }
        __syncthreads();
        if (lane == 63) misc[8 + w] = (unsigned)incl;
        __syncthreads();
        int woff = 0, total = 0;
#pragma unroll
        for (int q = 0; q < 8; ++q) { const int v = (int)misc[8 + q]; if (q < w) woff += v; total += v; }
        const int excl = woff + incl - packed;
        int pgt = excl & 0xffff, peq = excl >> 16;
        const int tot_gt = total & 0xffff;
        const int sbase = kind ? 2048 + b * 32 : b * 512;
        if (base < n) {
#pragma unroll
            for (int q = 0; q < 8; ++q) {
                const unsigned k = keys[base + q];
                const int row = rowbase + base + q;
                int pos = -1;
                if (k > T) { pos = pgt; ++pgt; }
                else if (k == T) { if (peq < need_eq) pos = tot_gt + peq; ++peq; }
                if (pos >= 0) { const int sl = sbase + pos; EROW[ex * EPAD + sl] = row; EGATE[ex * EPAD + sl] = __uint_as_float(k); SLOT[(size_t)row * 16 + ex] = sl; }
                else SLOT[(size_t)row * 16 + ex] = -1;
            }
        }
        if (kind == 1 && b == 3) for (int i = t; i < EPAD - 2176; i += NT) EROW[ex * EPAD + 2176 + i] = rowbase;
    }
}

__device__ __forceinline__ void phase_final(const Params& p, int l) {
    unsigned char* const ws = ws_();
    const int lane = tid_() & 63, w = __builtin_amdgcn_readfirstlane(tid_() >> 6);
    const int nrows = l == 0 ? NTOK : NLAT;
    const u16* YEXP = (const u16*)(ws + WS_YEXP);
    const int* SLOT = (const int*)(ws + WS_SLOT);
    const u16* XL1 = (const u16*)(ws + WS_XL1);
    u16* XL2 = (u16*)(ws + WS_XL2);
    u16* H = (u16*)(ws + WS_H);
    const int stride = gdim_() * 8;
    struct Pre { u32x2 xl[8], q0[8], q1[8]; };
    auto slots_of = [&](int row) -> int { const int s = SLOT[(size_t)min(row, nrows - 1) * 16 + (lane & 15)]; return (row < nrows && lane < 16) ? s : -1; };
    auto prefetch = [&](int row, int myslot, Pre& pr) {
        const int rc = min(row, nrows - 1);
        unsigned long long em = __ballot(myslot >= 0);
        const int e0 = em ? __builtin_ctzll(em) : 0; em &= em - 1;
        const int e1 = em ? __builtin_ctzll(em) : e0;
        const int sl0 = max(__shfl(myslot, e0, 64), 0), sl1 = max(__shfl(myslot, e1, 64), 0);
        const u16* y0 = YEXP + ((size_t)e0 * EPAD + sl0) * D; const u16* y1 = YEXP + ((size_t)e1 * EPAD + sl1) * D;
#pragma unroll
        for (int i = 0; i < 8; ++i) pr.xl[i] = *reinterpret_cast<const u32x2*>(XL1 + (size_t)rc * D + (i * 64 + lane) * 4);
#pragma unroll
        for (int i = 0; i < 8; ++i) { pr.q0[i] = *reinterpret_cast<const u32x2*>(y0 + (i * 64 + lane) * 4); pr.q1[i] = *reinterpret_cast<const u32x2*>(y1 + (i * 64 + lane) * 4); }
    };
    int row = bid_() * 8 + w;
    int slot_c = slots_of(row), slot_n = slots_of(row + stride);
    Pre cur; prefetch(row, slot_c, cur);
    for (; row < nrows; row += stride) {
        const int slot_nn = slots_of(row + 2 * stride);
        Pre nxt; prefetch(row + stride, slot_n, nxt);
        f32x4 v[8];
#pragma unroll
        for (int i = 0; i < 8; ++i) v[i] = (f32x4){0.f, 0.f, 0.f, 0.f};
        unsigned long long em = __ballot(slot_c >= 0);
        if (em) {
            em &= em - 1;
            const float f1 = em ? 1.f : 0.f;
            if (em) em &= em - 1;
#pragma unroll
            for (int i = 0; i < 8; ++i) {
                v[i][0] = bf_lo(cur.q0[i][0]) + f1 * bf_lo(cur.q1[i][0]); v[i][1] = bf_hi(cur.q0[i][0]) + f1 * bf_hi(cur.q1[i][0]);
                v[i][2] = bf_lo(cur.q0[i][1]) + f1 * bf_lo(cur.q1[i][1]); v[i][3] = bf_hi(cur.q0[i][1]) + f1 * bf_hi(cur.q1[i][1]);
            }
        }
        while (em) {
            const int e0 = __builtin_ctzll(em); em &= em - 1;
            const int sl0 = __shfl(slot_c, e0, 64);
            const u16* y0 = YEXP + ((size_t)e0 * EPAD + sl0) * D;
#pragma unroll
            for (int i = 0; i < 8; ++i) { const u32x2 q = *reinterpret_cast<const u32x2*>(y0 + (i * 64 + lane) * 4); v[i][0] += bf_lo(q[0]); v[i][1] += bf_hi(q[0]); v[i][2] += bf_lo(q[1]); v[i][3] += bf_hi(q[1]); }
        }
        float ss = 0.f;
#pragma unroll
        for (int i = 0; i < 8; ++i) ss += v[i][0] * v[i][0] + v[i][1] * v[i][1] + v[i][2] * v[i][2] + v[i][3] * v[i][3];
        ss = wave_sum(ss);
        const float rstd = rsqrtf(ss * (1.f / D) + 1e-6f);
        const float* g2 = mod_ptr(ws, l, row, 5);
        const float* nw = p.norm_ffn_post + (size_t)l * D;
        float ss2 = 0.f;
#pragma unroll
        for (int i = 0; i < 8; ++i) {
            const int col = (i * 64 + lane) * 4;
            const f32x4 x4 = {bf_lo(cur.xl[i][0]), bf_hi(cur.xl[i][0]), bf_lo(cur.xl[i][1]), bf_hi(cur.xl[i][1])};
            const f32x4 w4 = *reinterpret_cast<const f32x4*>(nw + col), g4 = *reinterpret_cast<const f32x4*>(g2 + col);
            const f32x4 x2 = x4 + g4 * (v[i] * rstd * w4);
            if (l == 0) { const u32x2 pk2 = {pk_bf16(x2[0], x2[1]), pk_bf16(x2[2], x2[3])}; *reinterpret_cast<u32x2*>(XL2 + (size_t)row * D + col) = pk2; }
            else *reinterpret_cast<f32x4*>(p.out + (size_t)row * D + col) = x2;
            v[i] = x2; ss2 += x2[0] * x2[0] + x2[1] * x2[1] + x2[2] * x2[2] + x2[3] * x2[3];
        }
        if (l == 0) {
            ss2 = wave_sum(ss2);
            const float rstd2 = rsqrtf(ss2 * (1.f / D) + 1e-6f);
            const float* sh = mod_ptr(ws, 1, row, 0); const float* sc = mod_ptr(ws, 1, row, 1);
            const float* nw1 = p.norm_mix_pre + D;
#pragma unroll
            for (int i = 0; i < 8; ++i) {
                const int col = (i * 64 + lane) * 4;
                const f32x4 w4 = *reinterpret_cast<const f32x4*>(nw1 + col), s4 = *reinterpret_cast<const f32x4*>(sc + col), h4 = *reinterpret_cast<const f32x4*>(sh + col);
                const f32x4 o = v[i] * rstd2 * w4 * (s4 + 1.f) + h4;
                if (WIN_F8_L1) *reinterpret_cast<unsigned*>((unsigned char*)H + (size_t)row * D + col) = pk_fp8x4(o[0] * F8_SH, o[1] * F8_SH, o[2] * F8_SH, o[3] * F8_SH);
                else { const u32x2 pk = {pk_bf16(o[0], o[1]), pk_bf16(o[2], o[3])}; *reinterpret_cast<u32x2*>(H + (size_t)row * D + col) = pk; }
            }
        }
        cur = nxt; slot_c = slot_n; slot_n = slot_nn;
    }
}

__global__ void __launch_bounds__(NT, 2) fwd_kernel(Params p) {
    unsigned char* lds = g_lds;
    unsigned char* wlds = lds + 512;
    if (threadIdx.x == 0) { *reinterpret_cast<uint4*>(lds) = make_uint4(0u, 0u, 0u, 0u); ((volatile LAS int*)(g_lds))[4] = (int)blockIdx.x; ((volatile LAS int*)(g_lds))[5] = (int)gridDim.x; *(volatile LAS unsigned long long*)((LAS unsigned char*)(g_lds) + 24) = (unsigned long long)p.ws; }
    if ((threadIdx.x & 63) == 0) ((volatile LAS int*)(g_lds))[8 + hw_slot_()] = threadIdx.x >> 6;
    __syncthreads();
    (void)xcd_barrier_post((unsigned*)(ws_() + WS_BAR), (volatile LAS unsigned*)lds);
#define GRID_BARRIER() do { XcdBarrier _b; _b.bar = (unsigned*)(ws_() + WS_BAR); _b.x = xb_xcc_id(); _b.st = (volatile LAS unsigned*)lds; xcd_barrier(_b); } while (0)
#ifndef PH_MASK
#define PH_MASK 0xFFFFFFFFu
#endif
#ifndef PROBE_REP_MASK
#define PROBE_REP_MASK 0u
#endif
#define PHASE(id, body) do { if (((PH_MASK >> ((id) % 32)) & 1u) && p.ph_lo <= (id) && (id) < p.ph_hi) { \
    for (int _r = 0; _r < ((((unsigned)PROBE_REP_MASK >> ((id) % 32)) & 1u) ? 2 : 1); ++_r) { body; if ((id) + 1 < p.ph_hi || _r == 0) { if ((id) + 1 < p.ph_hi) GRID_BARRIER(); } } } } while (0)
    PHASE(0, { phase_mod(p, wlds); phase_convert_dense(p, wlds); });
    PHASE(1, { phase_norm_mod(p, 0, wlds); lru_prep_weights(p); rope_prep(p); });
    {
        constexpr int l = 0, pb = 2;
        if (WIN_F8_L0 && WIN_L0_BF16_COLS) {
            PHASE(pb + 0, { phase_gemm_dense<false>(p, (const u16*)(ws_() + WS_H), NTOK, (const u16*)(ws_() + WS_WT_ABIN), WIN_L0_BF16_COLS, (u16*)(ws_() + WS_P), AB_IN, nullptr, wlds);
                            phase_gemm_dense_f8rev(p, (const u16*)(ws_() + WS_H8), NTOK, (const u16*)(ws_() + WS_WT_ABIN8 + (size_t)WIN_L0_BF16_COLS * D), AB_IN - WIN_L0_BF16_COLS,
                                                   (u16*)(ws_() + WS_P) + WIN_L0_BF16_COLS, AB_IN, wlds); });
        } else
        PHASE(pb + 0, phase_gemm_dense<WIN_F8_L0>(p, (const u16*)(ws_() + WS_H), NTOK, (const u16*)(ws_() + WS_WT_ABIN), AB_IN, (u16*)(ws_() + WS_P), AB_IN, nullptr, wlds));
        PHASE(pb + 1, phase_mlstm(p, wlds));
        PHASE(pb + 2, phase_l0_stage2(p, wlds));
        PHASE(pb + 4, phase_gemm_dense<true>(p, (const u16*)(ws_() + WS_YIN), NTOK, (const u16*)(ws_() + WS_WT_ABOUT), D, (u16*)(ws_() + WS_Y), D, nullptr, wlds));
        PHASE(pb + 5, phase_rowpass_mid(p, l, wlds));
        PHASE(pb + 6, { phase_topk(p, l, wlds); phase_convert_moe(p, l, wlds); });
        PHASE(pb + 7, phase_moe_a(p, l, wlds));
        PHASE(pb + 8, phase_moe_b(p, l, wlds));
        PHASE(pb + 9, phase_final(p, l));
    }
    {
        constexpr int l = 1, pb = 12;
        PHASE(pb + 0, phase_gemm_dense<WIN_F8_L1>(p, (const u16*)(ws_() + WS_H), NTOK, (const u16*)(ws_() + WS_WT_CDIN), CD_IN, (u16*)(ws_() + WS_P), CD_IN, nullptr, wlds));
        PHASE(pb + 1, phase_l1_stage1(p, wlds));
        PHASE(pb + 2, phase_l1_stage2(p, wlds));
        PHASE(pb + 3, phase_l1_stage3(p, wlds));
        PHASE(pb + 4, phase_gemm_dense<true>(p, (const u16*)(ws_() + WS_YIN), NLAT, (const u16*)(ws_() + WS_WT_CDOUT), D, (u16*)(ws_() + WS_Y), D, nullptr, wlds));
        PHASE(pb + 5, phase_rowpass_mid(p, l, wlds));
        PHASE(pb + 6, { phase_topk(p, l, wlds); phase_convert_moe(p, l, wlds); });
        PHASE(pb + 7, phase_moe_a(p, l, wlds));
        PHASE(pb + 8, phase_moe_b(p, l, wlds));
        PHASE(pb + 9, phase_final(p, l));
    }
}


#ifdef DBG_STOP
__global__ void dbg_digest(const unsigned char* ws, size_t off, int kind, size_t nelem, float* out, size_t nout) {
    for (size_t i = (size_t)blockIdx.x * blockDim.x + threadIdx.x; i < nout; i += (size_t)gridDim.x * blockDim.x) {
        float v = 0.f;
        for (size_t j = i; j < nelem; j += nout) {
            if (kind == 0) v += bf2f(((const u16*)(ws + off))[j]);
            else if (kind == 1) v += ((const float*)(ws + off))[j];
            else v += (float)((const int*)(ws + off))[j];
        }
        out[i] = v;
    }
}
#endif
extern "C" void kernel_launch(void* const* d_in, const int* in_sizes, int n_in, void* d_out, int out_size, void* d_ws, size_t ws_size, hipStream_t stream) {
    static int grid = 0;
    if (grid == 0) {
        if (n_in != 27 || ws_size < WS_END) { fprintf(stderr, "kernel_launch: unexpected n_in %d / ws %zu (need %zu)\n", n_in, ws_size, (size_t)WS_END); grid = -1; return; }
        int dev = 0, cus = 0, per_cu = 0;
        hipGetDevice(&dev);
        hipDeviceGetAttribute(&cus, hipDeviceAttributeMultiprocessorCount, dev);
        if (hipFuncSetAttribute((const void*)fwd_kernel, hipFuncAttributeMaxDynamicSharedMemorySize, LDS_BYTES) != hipSuccess) { fprintf(stderr, "kernel_launch: hipFuncSetAttribute failed\n"); grid = -1; return; }
        hipOccupancyMaxActiveBlocksPerMultiprocessor(&per_cu, (const void*)fwd_kernel, NT, LDS_BYTES);
        (void)hipGetLastError();
        if (per_cu < 1) fprintf(stderr, "kernel_launch: occupancy query reports %d blocks per CU\n", per_cu);
        grid = cus > 0 ? cus : 256;
    }
    if (grid < 0) return;
    hipMemsetAsync((char*)d_ws + WS_BAR, 0, XCD_BAR_WORDS * sizeof(unsigned), stream);
    Params p; memset(&p, 0, sizeof(p));
    const float** f = (const float**)&p;
    for (int i = 0; i < 27; ++i) f[i] = (const float*)d_in[i];
    p.out = (float*)d_out; p.ws = (unsigned char*)d_ws;
#if N_LAUNCH_MODE == 1
    p.ph_lo = 0; p.ph_hi = NPH;
    hipLaunchKernelGGL(fwd_kernel, dim3(grid), dim3(NT), LDS_BYTES, stream, p);
#else
#ifdef DBG_STOP
    for (int ph = 0; ph <= DBG_STOP; ++ph) { p.ph_lo = ph; p.ph_hi = ph + 1; hipLaunchKernelGGL(fwd_kernel, dim3(grid), dim3(NT), LDS_BYTES, stream, p); }
    hipLaunchKernelGGL(dbg_digest, dim3(2048), dim3(256), 0, stream, (const unsigned char*)d_ws, (size_t)DBG_OFF, (int)DBG_KIND, (size_t)DBG_NELEM, (float*)d_out, (size_t)out_size);
#else
    for (int ph = 0; ph < NPH; ++ph) { p.ph_lo = ph; p.ph_hi = ph + 1; hipLaunchKernelGGL(fwd_kernel, dim3(grid), dim3(NT), LDS_BYTES, stream, p); }
#endif
#endif
}
```

```cpp
#include <hip/hip_runtime.h>
#include <stdint.h>
#include <stdio.h>
#include <string.h>

#ifndef N_LAUNCH_MODE
#define N_LAUNCH_MODE 1
#endif

typedef unsigned short u16;
typedef short bf16x8 __attribute__((ext_vector_type(8)));
typedef float f32x4 __attribute__((ext_vector_type(4)));
typedef unsigned u32x4 __attribute__((ext_vector_type(4)));
typedef unsigned u32x2 __attribute__((ext_vector_type(2)));

#define NT 512
constexpr int D = 2048, BATCH = 4, SEQ = 4096, LC = 256;
constexpr int NLAT = BATCH * SEQ, NCTX = BATCH * LC, NTOK = NLAT + NCTX;
constexpr int AB_IN = 7184, CD_IN = 3584;
constexpr int NEXP = 16, FF = 2048, EPAD = 2304;
constexpr int NPH = 22;
constexpr int LDS_BYTES = 150 * 1024;

constexpr bool WIN_F8_L0 = true, WIN_F8_L1 = true;
constexpr int WIN_L0_BF16_COLS = 2048;
constexpr size_t al256(size_t x) { return (x + 255) & ~(size_t)255; }
constexpr size_t WS_BAR = 0;
constexpr size_t WS_MOD = 16384;
constexpr size_t WS_XL1 = al256(WS_MOD + 2 * 5 * 12288 * 4);
constexpr size_t WS_XL2 = al256(WS_XL1 + (size_t)NTOK * D * 4);
constexpr size_t WS_H = al256(WS_XL2 + (size_t)NTOK * D * 4);
constexpr size_t WS_P = al256(WS_H + (size_t)NTOK * D * 2);
constexpr size_t WS_G = al256(WS_P + (size_t)NTOK * AB_IN * 2);
constexpr size_t WS_HM = al256(WS_G + (size_t)NTOK * 16 * 4);
constexpr size_t WS_YIN = al256(WS_HM + (size_t)2 * NTOK * 1024 * 2);
constexpr size_t WS_Y = al256(WS_YIN + (size_t)NTOK * D * 2);
constexpr size_t WS_AFF = al256(WS_Y + (size_t)NTOK * D * 4);
constexpr size_t WS_SLOT = al256(WS_AFF + (size_t)NTOK * 16 * 4);
constexpr size_t WS_EROW = al256(WS_SLOT + (size_t)NTOK * 16 * 4);
constexpr size_t WS_EGATE = al256(WS_EROW + (size_t)NEXP * EPAD * 4);
constexpr size_t WS_ACT = al256(WS_EGATE + (size_t)NEXP * EPAD * 4);
constexpr size_t WS_YEXP = al256(WS_ACT + (size_t)NEXP * EPAD * FF * 2);
constexpr size_t WS_LRUS = al256(WS_YEXP + (size_t)NEXP * EPAD * D * 2);
constexpr size_t WS_LRUW = al256(WS_LRUS + (size_t)2 * 2 * 4 * 68 * 1024 * 4);
constexpr size_t WS_WT_ABIN = al256(WS_LRUW + (size_t)32 * 128 * 128 * 2);
constexpr size_t WS_WT_ABIN8 = WS_WT_ABIN + (size_t)WIN_L0_BF16_COLS * D;
constexpr size_t WS_WT_ABOUT = al256(WS_WT_ABIN + (size_t)AB_IN * D * 2);
constexpr size_t WS_WT_CDIN = al256(WS_WT_ABOUT + (size_t)D * D * 2);
constexpr size_t WS_WT_CDOUT = al256(WS_WT_CDIN + (size_t)CD_IN * D * 2);
constexpr size_t WS_WT_W1 = al256(WS_WT_CDOUT + (size_t)D * D * 2);
constexpr size_t WS_WT_W3 = al256(WS_WT_W1 + (size_t)NEXP * D * FF * 2);
constexpr size_t WS_WT_W2 = al256(WS_WT_W3 + (size_t)NEXP * D * FF * 2);
constexpr size_t WS_H8 = al256(WS_WT_W2 + (size_t)NEXP * D * FF * 2);
constexpr size_t WS_ROPE = al256(WS_H8 + (size_t)NTOK * D);
constexpr size_t WS_END = al256(WS_ROPE + 2 * 64 * 16 * 4);

extern __shared__ __attribute__((aligned(16))) unsigned char g_lds[];

struct Params {
    const float *x, *c, *ctx, *c_ctx, *ada_w, *ada_b, *norm_mix_pre, *norm_mix_post, *norm_ffn_pre, *norm_ffn_post;
    const float *ab_w_in, *ab_w_out, *mlstm_gate_b, *mlstm_norm, *na_rpb;
    const float *cd_w_in, *cd_w_out, *gqa_sink, *lru_conv_w, *lru_conv_b, *lru_gate_w, *lru_gate_b, *lru_lambda;
    const float *moe_router, *moe_w1, *moe_w3, *moe_w2;
    float* out;
    unsigned char* ws;
    int ph_lo, ph_hi;
};

#define XB_TMO      128
#define XB_XCNT(j)  (256  + 64 * (j))
#define XB_XSUB(j)  (1280 + 64 * (j))
#define XB_XGEN(j)  (2304 + 64 * (j))
#define XB_TOP      3328
#define XB_TOPGEN   3392
#define XCD_BAR_WORDS 3456
#define XB_SPIN_CAP (1u << 22)
#define LAS __attribute__((address_space(3)))

__device__ __forceinline__ unsigned xb_ld(unsigned* p)              { return __hip_atomic_load(p, __ATOMIC_RELAXED, __HIP_MEMORY_SCOPE_AGENT); }
__device__ __forceinline__ unsigned xb_add(unsigned* p, unsigned v) { return __hip_atomic_fetch_add(p, v, __ATOMIC_RELAXED, __HIP_MEMORY_SCOPE_AGENT); }
__device__ __forceinline__ unsigned xb_xcc_id() { return (unsigned)__builtin_amdgcn_s_getreg((3 << 11) | 20) & 0xFu; }
#define XB_SPIN(cond, bar) do { unsigned _sp = 0; while (cond) { __builtin_amdgcn_s_sleep(1); \
    if ((++_sp & 255u) == 0u) { if (xb_ld(&(bar)[XB_TMO])) break; if (_sp > XB_SPIN_CAP) { atomicAdd(&(bar)[XB_TMO], 1u); break; } } } } while (0)

struct XcdBarrier {
    unsigned* bar; unsigned x;
    volatile LAS unsigned* st;
};
__device__ __forceinline__ XcdBarrier xcd_barrier_post(unsigned* bar, volatile LAS unsigned* st) {
    XcdBarrier b; b.bar = bar; b.x = xb_xcc_id(); b.st = st;
    if (threadIdx.x == 0) (void)xb_add(&bar[XB_XCNT(b.x)], 1u);
    return b;
}
__device__ __forceinline__ void xcd_barrier_complete(unsigned* bar, unsigned x, unsigned& nloc, unsigned& nx) {
    const unsigned G = gridDim.x * gridDim.y * gridDim.z;
    unsigned sum, cnt, mine, sp = 0u;
    for (;;) {
        sum = 0u; cnt = 0u; mine = 0u;
#pragma unroll
        for (unsigned j = 0; j < 16; ++j) { const unsigned c = xb_ld(&bar[XB_XCNT(j)]); sum += c; cnt += (c > 0u) ? 1u : 0u; mine = (j == x) ? c : mine; }
        if (sum == G) break;
        __builtin_amdgcn_s_sleep(1);
        if ((++sp & 255u) == 0u) { if (xb_ld(&bar[XB_TMO])) break; if (sp > XB_SPIN_CAP) { atomicAdd(&bar[XB_TMO], 1u); break; } }
    }
    nloc = mine > 0u ? mine : 1u; nx = cnt > 0u ? cnt : 1u;
}
__device__ __forceinline__ void xcd_barrier(const XcdBarrier& b) {
    asm volatile("s_waitcnt vmcnt(0)" ::: "memory");
    __syncthreads();
    if (threadIdx.x == 0) {
        unsigned* bar = b.bar;
        __builtin_amdgcn_s_waitcnt(0);
        unsigned nloc = b.st[0], nx = b.st[1];
        if (nloc == 0u) { xcd_barrier_complete(bar, b.x, nloc, nx); b.st[0] = nloc; b.st[1] = nx; }
        const unsigned old = xb_add(&bar[XB_XSUB(b.x)], 1u);
        const unsigned gen = old / nloc;
        if (old + 1u == (gen + 1u) * nloc) {
            __builtin_amdgcn_fence(__ATOMIC_RELEASE, "agent");
            asm volatile("s_waitcnt vmcnt(0)" ::: "memory");
            const unsigned og = xb_add(&bar[XB_TOP], 1u);
            const unsigned tg = og / nx;
            if (og + 1u == (tg + 1u) * nx) xb_add(&bar[XB_TOPGEN], 1u);
            else XB_SPIN(xb_ld(&bar[XB_TOPGEN]) == tg, bar);
            __builtin_amdgcn_fence(__ATOMIC_ACQUIRE, "agent");
            xb_add(&bar[XB_XGEN(b.x)], 1u);
            asm volatile("s_waitcnt vmcnt(0)" ::: "memory");
        } else {
            XB_SPIN(xb_ld(&bar[XB_XGEN(b.x)]) == gen, bar);
            __builtin_amdgcn_fence(__ATOMIC_ACQUIRE, "agent");
            asm volatile("s_waitcnt vmcnt(0)" ::: "memory");
        }
    }
    __syncthreads();
}

typedef float f32x2_t __attribute__((ext_vector_type(2)));
typedef __bf16 bf16x2_t __attribute__((ext_vector_type(2)));
__device__ __forceinline__ unsigned pk_bf16(float lo, float hi) { f32x2_t v = {lo, hi}; return __builtin_bit_cast(unsigned, __builtin_convertvector(v, bf16x2_t)); }
__device__ __forceinline__ float bf_lo(unsigned u) { return __uint_as_float(u << 16); }
__device__ __forceinline__ float bf_hi(unsigned u) { return __uint_as_float(u & 0xffff0000u); }
__device__ __forceinline__ float bf2f(u16 v) { return __uint_as_float(((unsigned)v) << 16); }
typedef int i32x4 __attribute__((ext_vector_type(4)));
typedef int i32x8 __attribute__((ext_vector_type(8)));
constexpr float F8_SW = 256.f, F8_SH = 8.f, F8_SA = 4.f;
__device__ __forceinline__ float f8_clamp(float x) { return __builtin_amdgcn_fmed3f(x, -448.f, 448.f); }
__device__ __forceinline__ unsigned pk_fp8x4(float a, float b, float c, float d) {
    unsigned r = 0u;
    r = (unsigned)__builtin_amdgcn_cvt_pk_fp8_f32(f8_clamp(a), f8_clamp(b), (int)r, false);
    r = (unsigned)__builtin_amdgcn_cvt_pk_fp8_f32(f8_clamp(c), f8_clamp(d), (int)r, true);
    return r; }
__device__ __forceinline__ i32x8 cat8(bf16x8 lo, bf16x8 hi) { return __builtin_shufflevector(__builtin_bit_cast(i32x4, lo), __builtin_bit_cast(i32x4, hi), 0, 1, 2, 3, 4, 5, 6, 7); }
__device__ __forceinline__ u16 f2bf(float f) { return (u16)(pk_bf16(f, 0.f) & 0xffffu); }
template <int CTRL> __device__ __forceinline__ float dpp_f(float v) { return __uint_as_float((unsigned)__builtin_amdgcn_update_dpp(0, (int)__float_as_uint(v), CTRL, 0xf, 0xf, true)); }
__device__ __forceinline__ float row_sum16(float v) { v += dpp_f<0xB1>(v); v += dpp_f<0x4E>(v); v += dpp_f<0x141>(v); v += dpp_f<0x140>(v); return v; }
__device__ __forceinline__ float row_max16(float v) { v = fmaxf(v, dpp_f<0xB1>(v)); v = fmaxf(v, dpp_f<0x4E>(v)); v = fmaxf(v, dpp_f<0x141>(v)); v = fmaxf(v, dpp_f<0x140>(v)); return v; }
__device__ __forceinline__ float rdlane_f(float v, int l) { return __uint_as_float((unsigned)__builtin_amdgcn_readlane((int)__float_as_uint(v), l)); }
__device__ __forceinline__ float sum_x16(float v) { const auto r = __builtin_amdgcn_permlane16_swap(__float_as_uint(v), __float_as_uint(v), false, false); return __uint_as_float(r[0]) + __uint_as_float(r[1]); }
__device__ __forceinline__ float sum_x32(float v) { const auto r = __builtin_amdgcn_permlane32_swap(__float_as_uint(v), __float_as_uint(v), false, false); return __uint_as_float(r[0]) + __uint_as_float(r[1]); }
__device__ __forceinline__ float max_x16(float v) { const auto r = __builtin_amdgcn_permlane16_swap(__float_as_uint(v), __float_as_uint(v), false, false); return fmaxf(__uint_as_float(r[0]), __uint_as_float(r[1])); }
__device__ __forceinline__ float max_x32(float v) { const auto r = __builtin_amdgcn_permlane32_swap(__float_as_uint(v), __float_as_uint(v), false, false); return fmaxf(__uint_as_float(r[0]), __uint_as_float(r[1])); }
__device__ __forceinline__ float partner_x16(float v) { const auto r = __builtin_amdgcn_permlane16_swap(__float_as_uint(v), __float_as_uint(v), false, false); return __uint_as_float(r[0] ^ r[1] ^ __float_as_uint(v)); }
__device__ __forceinline__ float partner_x32(float v) { const auto r = __builtin_amdgcn_permlane32_swap(__float_as_uint(v), __float_as_uint(v), false, false); return __uint_as_float(r[0] ^ r[1] ^ __float_as_uint(v)); }
__device__ __forceinline__ float wave_sum(float v) { return sum_x32(sum_x16(row_sum16(v))); }
__device__ __forceinline__ float wave_max(float v) { return max_x32(max_x16(row_max16(v))); }
__device__ __forceinline__ int hw_slot_() { return (int)(__builtin_amdgcn_s_getreg((5 << 11) | 4) & 63u); }
__device__ __forceinline__ int tid_() {
    int lane; asm volatile("v_mbcnt_lo_u32_b32 %0, -1, 0\n\tv_mbcnt_hi_u32_b32 %0, -1, %0" : "=v"(lane));
    const int w = ((volatile LAS int*)(g_lds))[8 + hw_slot_()];
    int t = __builtin_amdgcn_readfirstlane(w) * 64 + lane; asm volatile("" : "+v"(t)); return t; }
__device__ __forceinline__ int bid_() { unsigned o = 16; asm volatile("" : "+v"(o)); return __builtin_amdgcn_readfirstlane(*(const LAS int*)((LAS unsigned char*)(g_lds) + o)); }
__device__ __forceinline__ int gdim_() { unsigned o = 20; asm volatile("" : "+v"(o)); return __builtin_amdgcn_readfirstlane(*(const LAS int*)((LAS unsigned char*)(g_lds) + o)); }
__device__ __forceinline__ unsigned char* ws_() {
    unsigned o = 24; asm volatile("" : "+v"(o));
    const u32x2 v = *(const LAS u32x2*)((LAS unsigned char*)(g_lds) + o);
    const unsigned long long a = ((unsigned long long)(unsigned)__builtin_amdgcn_readfirstlane((int)v[1]) << 32) | (unsigned)__builtin_amdgcn_readfirstlane((int)v[0]);
    return (unsigned char*)(__attribute__((address_space(1))) unsigned char*)a; }
__device__ __forceinline__ float frcp_(float x) { return __builtin_amdgcn_rcpf(x); }
__device__ __forceinline__ float sigmoidf_(float x) { return frcp_(1.f + __expf(-x)); }
__device__ __forceinline__ f32x4 mfma16(bf16x8 a, bf16x8 b, f32x4 c) { return __builtin_amdgcn_mfma_f32_16x16x32_bf16(a, b, c, 0, 0, 0); }
__device__ __forceinline__ bf16x8 ld_frag_g(const u16* p) { return *reinterpret_cast<const bf16x8*>(p); }
__device__ __forceinline__ bf16x8 ld_frag_s(const u16* p) { return *reinterpret_cast<const bf16x8*>(p); }
__device__ __forceinline__ bf16x8 mk_frag(unsigned a, unsigned b, unsigned c, unsigned d) { u32x4 v = {a, b, c, d}; return __builtin_bit_cast(bf16x8, v); }

__device__ __forceinline__ void rowdot16(const f32x4 (&v)[8], const float* R, int lane, float (&lg)[16]) {
    constexpr int RS = D + 4;
    const float* Rl = R + lane * 4;
    f32x4 ra[8], rb[8];
#pragma unroll
    for (int i = 0; i < 8; ++i) ra[i] = *reinterpret_cast<const f32x4*>(Rl + i * 256);
#pragma unroll
    for (int e = 0; e < 16; e += 2) {
#pragma unroll
        for (int i = 0; i < 8; ++i) rb[i] = *reinterpret_cast<const f32x4*>(Rl + (e + 1) * RS + i * 256);
        { f32x2_t a0 = {0.f, 0.f}, a1 = {0.f, 0.f};
#pragma unroll
          for (int i = 0; i < 8; ++i) { a0 = __builtin_elementwise_fma((f32x2_t){v[i][0], v[i][1]}, (f32x2_t){ra[i][0], ra[i][1]}, a0); a1 = __builtin_elementwise_fma((f32x2_t){v[i][2], v[i][3]}, (f32x2_t){ra[i][2], ra[i][3]}, a1); }
          lg[e] = (a0[0] + a0[1]) + (a1[0] + a1[1]); }
        __builtin_amdgcn_sched_barrier(0);
        if (e + 2 < 16) {
#pragma unroll
            for (int i = 0; i < 8; ++i) ra[i] = *reinterpret_cast<const f32x4*>(Rl + (e + 2) * RS + i * 256);
        }
        { f32x2_t a0 = {0.f, 0.f}, a1 = {0.f, 0.f};
#pragma unroll
          for (int i = 0; i < 8; ++i) { a0 = __builtin_elementwise_fma((f32x2_t){v[i][0], v[i][1]}, (f32x2_t){rb[i][0], rb[i][1]}, a0); a1 = __builtin_elementwise_fma((f32x2_t){v[i][2], v[i][3]}, (f32x2_t){rb[i][2], rb[i][3]}, a1); }
          lg[e + 1] = (a0[0] + a0[1]) + (a1[0] + a1[1]); }
        __builtin_amdgcn_sched_barrier(0);
    }
}

__device__ __forceinline__ const float* xin_row(const Params& p, int row) {
    return row < NLAT ? p.x + (size_t)row * D : p.ctx + (size_t)(row - NLAT) * D;
}
__device__ __forceinline__ const float* mod_ptr(const unsigned char* ws, int l, int row, int chunk) {
    const int bb = row < NLAT ? (row >> 12) : 4;
    return (const float*)(ws + WS_MOD) + ((size_t)(l * 5 + bb) * 6 + chunk) * D;
}

__device__ __forceinline__ void phase_mod(const Params& p, unsigned char* lds_raw) {
    unsigned char* const ws = ws_();
    float* scond = (float*)lds_raw;
    float* red = scond + 5 * D;
    const int t = tid_();
    for (int i = t; i < 5 * D; i += NT) { const int r = i >> 11, k = i & 2047; const float v = r < 4 ? p.c[r * D + k] : p.c_ctx[k]; scond[i] = v / (1.f + __expf(-v)); }
    __syncthreads();
    float* mod = (float*)(ws + WS_MOD);
    for (int item = bid_(); item < 192; item += gdim_()) {
        const int l = item / 96, col0 = (item % 96) * 128;
        const int kg = t >> 5, cl = (t & 31) * 4;
        f32x4 acc[5];
#pragma unroll
        for (int r = 0; r < 5; ++r) acc[r] = (f32x4){0.f, 0.f, 0.f, 0.f};
        const float* wp = p.ada_w + ((size_t)l * D + kg * 128) * (6 * D) + col0 + cl;
#pragma unroll 8
        for (int kk = 0; kk < 128; ++kk) {
            const f32x4 w = __builtin_nontemporal_load(reinterpret_cast<const f32x4*>(wp + (size_t)kk * (6 * D)));
#pragma unroll
            for (int r = 0; r < 5; ++r) { const float s = scond[r * D + kg * 128 + kk]; acc[r] += w * s; }
        }
#pragma unroll
        for (int r = 0; r < 5; ++r) *reinterpret_cast<f32x4*>(red + (kg * 5 + r) * 128 + cl) = acc[r];
        __syncthreads();
        for (int o = t; o < 640; o += NT) {
            const int r = o >> 7, cc = o & 127;
            float s = p.ada_b[l * 6 * D + col0 + cc];
#pragma unroll
            for (int g = 0; g < 16; ++g) s += red[(g * 5 + r) * 128 + cc];
            mod[(size_t)(l * 5 + r) * 6 * D + col0 + cc] = s;
        }
        __syncthreads();
    }
}

__device__ __forceinline__ void phase_norm_mod(const Params& p, int l, unsigned char* lds) {
    unsigned char* const ws = ws_();
    const int t = tid_(), lane = t & 63, w = t >> 6;
    u16* H = (u16*)(ws + WS_H);
    float* R = (float*)lds;
    constexpr int RS = D + 4;
    float* G = (float*)(ws + WS_G);
    __syncthreads();
    for (int i = t; i < D * 16; i += NT) { const int k = i >> 4, e = i & 15; R[e * RS + k] = p.ab_w_in[(size_t)k * AB_IN + 4096 + e]; }
    __syncthreads();
    f32x4 xq[8];
    const int rstride = gdim_() * 8;
    int row = bid_() * 8 + w;
    if (row < NTOK) { const float* xr = xin_row(p, row); _Pragma("unroll") for (int i = 0; i < 8; ++i) xq[i] = __builtin_nontemporal_load(reinterpret_cast<const f32x4*>(xr + (i * 64 + lane) * 4)); }
    for (; row < NTOK; row += rstride) {
        f32x4 v[8]; float ss = 0.f;
#pragma unroll
        for (int i = 0; i < 8; ++i) { v[i] = xq[i]; ss += v[i][0] * v[i][0] + v[i][1] * v[i][1] + v[i][2] * v[i][2] + v[i][3] * v[i][3]; }
        __builtin_amdgcn_sched_barrier(0);
        if (row + rstride < NTOK) { const float* xr = xin_row(p, row + rstride); _Pragma("unroll") for (int i = 0; i < 8; ++i) xq[i] = __builtin_nontemporal_load(reinterpret_cast<const f32x4*>(xr + (i * 64 + lane) * 4)); }
        __builtin_amdgcn_sched_barrier(0);
        ss = wave_sum(ss);
        const float rstd = rsqrtf(ss * (1.f / D) + 1e-6f);
        const float* sh = mod_ptr(ws, l, row, 0); const float* sc = mod_ptr(ws, l, row, 1);
        const float* nw = p.norm_mix_pre + (size_t)l * D;
#pragma unroll
        for (int i = 0; i < 8; ++i) {
            const int col = (i * 64 + lane) * 4;
            const f32x4 w4 = *reinterpret_cast<const f32x4*>(nw + col), s4 = *reinterpret_cast<const f32x4*>(sc + col), h4 = *reinterpret_cast<const f32x4*>(sh + col);
            f32x4 o = v[i] * rstd * w4 * (s4 + 1.f) + h4;
            if (WIN_F8_L0) *reinterpret_cast<unsigned*>(ws + (WIN_L0_BF16_COLS ? WS_H8 : WS_H) + (size_t)row * D + col) = pk_fp8x4(o[0] * F8_SH, o[1] * F8_SH, o[2] * F8_SH, o[3] * F8_SH);
            if (!WIN_F8_L0 || WIN_L0_BF16_COLS) { const u32x2 pk = {pk_bf16(o[0], o[1]), pk_bf16(o[2], o[3])}; *reinterpret_cast<u32x2*>(H + (size_t)row * D + col) = pk; }
            v[i] = o;
        }
        float lg[16];
        rowdot16(v, R, lane, lg);
        const bool b5 = lane & 32, b4 = lane & 16, b3 = lane & 8, b2 = lane & 4;
        float t8[8], t4[4], t2[2], lgt;
#pragma unroll
        for (int j = 0; j < 8; ++j) { const float keep = b5 ? lg[8 + j] : lg[j], send = b5 ? lg[j] : lg[8 + j]; t8[j] = keep + partner_x32(send); }
#pragma unroll
        for (int j = 0; j < 4; ++j) { const float keep = b4 ? t8[4 + j] : t8[j], send = b4 ? t8[j] : t8[4 + j]; t4[j] = keep + partner_x16(send); }
#pragma unroll
        for (int j = 0; j < 2; ++j) { const float keep = b3 ? t4[2 + j] : t4[j], send = b3 ? t4[j] : t4[2 + j]; t2[j] = keep + dpp_f<0x140>(send); }
        { const float keep = b2 ? t2[1] : t2[0], send = b2 ? t2[0] : t2[1]; lgt = keep + dpp_f<0x141>(send); }
        lgt += dpp_f<0x4E>(lgt); lgt += dpp_f<0xB1>(lgt);
        if ((lane & 3) == 0) G[(size_t)row * 16 + ((b5 ? 8 : 0) + (b4 ? 4 : 0) + (b3 ? 2 : 0) + (b2 ? 1 : 0))] = lgt;
    }
}

__device__ __forceinline__ void convert_item(const float* W, int N, u16* Wt, int kb, int nb, unsigned char* lds) {
    const int t = tid_(), lane = t & 63, w = t >> 6;
    const int n4 = lane * 4, k0 = kb * 64 + w * 8, n0 = nb * 256;
    int col = n0 + n4; if (col > N - 4) col = N - 4;
    f32x4 r8[8];
#pragma unroll
    for (int j = 0; j < 8; ++j) r8[j] = __builtin_nontemporal_load(reinterpret_cast<const f32x4*>(W + (size_t)(k0 + j) * N + col));
    __syncthreads();
#pragma unroll
    for (int jj = 0; jj < 4; ++jj) {
        u32x4 v = {pk_bf16(r8[0][jj], r8[1][jj]), pk_bf16(r8[2][jj], r8[3][jj]), pk_bf16(r8[4][jj], r8[5][jj]), pk_bf16(r8[6][jj], r8[7][jj])};
        const int r = n4 + jj;
        *reinterpret_cast<u32x4*>(lds + r * 128 + ((w ^ ((r >> 2) & 7)) << 4)) = v;
    }
    __syncthreads();
    const int c = t & 7;
#pragma unroll
    for (int i = 0; i < 4; ++i) {
        const int r = (t >> 3) + 64 * i;
        if (n0 + r < N) {
            const u32x4 v = *reinterpret_cast<const u32x4*>(lds + r * 128 + ((c ^ ((r >> 2) & 7)) << 4));
            *reinterpret_cast<u32x4*>(Wt + (size_t)(n0 + r) * 2048 + kb * 64 + c * 8) = v;
        }
    }
}
template <int N>
__device__ __forceinline__ void convert_item8(const float* W, unsigned char* Wt, int kb, int nb, unsigned char* lds) {
    const int t = tid_(), lane = t & 63, w = t >> 6;
    const int n4 = lane * 4, k0 = kb * 128 + w * 16, n0 = nb * 256;
    int col = n0 + n4; if (N % 256 != 0 && col > N - 4) col = N - 4;
    f32x4 r[16];
#pragma unroll
    for (int j = 0; j < 16; ++j) r[j] = __builtin_nontemporal_load(reinterpret_cast<const f32x4*>(W + (size_t)(k0 + j) * N + col));
    __syncthreads();
#pragma unroll
    for (int jj = 0; jj < 4; ++jj) {
        u32x4 v;
#pragma unroll
        for (int q = 0; q < 4; ++q) v[q] = pk_fp8x4(r[4 * q][jj] * F8_SW, r[4 * q + 1][jj] * F8_SW, r[4 * q + 2][jj] * F8_SW, r[4 * q + 3][jj] * F8_SW);
        const int rr = n4 + jj;
        *reinterpret_cast<u32x4*>(lds + rr * 128 + ((w ^ ((rr >> 2) & 7)) << 4)) = v;
    }
    __syncthreads();
    const int c = t & 7;
#pragma unroll
    for (int i = 0; i < 4; ++i) {
        const int rr = (t >> 3) + 64 * i;
        if (N % 256 == 0 || n0 + rr < N) {
            const u32x4 v = *reinterpret_cast<const u32x4*>(lds + rr * 128 + ((c ^ ((rr >> 2) & 7)) << 4));
            *reinterpret_cast<u32x4*>(Wt + (size_t)(n0 + rr) * 2048 + kb * 128 + c * 16) = v;
        }
    }
}
__device__ __forceinline__ void convert_matrix_items(const float* W, int N, u16* Wt, int first, int count, unsigned char* lds) {
    const int nnb = (N + 255) / 256;
    for (int it = first; it < first + count; ++it) convert_item(W, N, Wt, it / nnb, it % nnb, lds);
}
__device__ __forceinline__ void phase_convert_dense(const Params& p, unsigned char* lds) {
    unsigned char* const ws = ws_();
    constexpr int NB16 = WIN_F8_L0 ? WIN_L0_BF16_COLS / 256 : 29;
    constexpr int n_ab16 = 32 * NB16, n_ab = n_ab16 + 16 * (29 - NB16), n_cd = (WIN_F8_L1 ? 16 : 32) * 14;
    for (int item = bid_(); item < n_ab + 128 + n_cd + 128; item += gdim_()) {
        if (item < n_ab16) convert_item(p.ab_w_in, AB_IN, (u16*)(ws + WS_WT_ABIN), item / NB16, item % NB16, lds);
        else if (item < n_ab) { const int it = item - n_ab16; convert_item8<AB_IN>(p.ab_w_in, ws + WS_WT_ABIN8, it / (29 - NB16), NB16 + it % (29 - NB16), lds); }
        else if (item < n_ab + 128) { const int it = item - n_ab; convert_item8<2048>(p.ab_w_out, ws + WS_WT_ABOUT, it / 8, it % 8, lds); }
        else if (item < n_ab + 128 + n_cd) { const int it = item - n_ab - 128; if (WIN_F8_L1) convert_item8<CD_IN>(p.cd_w_in, ws + WS_WT_CDIN, it / 14, it % 14, lds); else convert_item(p.cd_w_in, CD_IN, (u16*)(ws + WS_WT_CDIN), it / 14, it % 14, lds); }
        else { const int it = item - n_ab - 128 - n_cd; convert_item8<2048>(p.cd_w_out, ws + WS_WT_CDOUT, it / 8, it % 8, lds); }
    }
}
__device__ __forceinline__ void phase_convert_moe(const Params& p, int l, unsigned char* lds) {
    unsigned char* const ws = ws_();
    for (int item = bid_(); item < 3 * NEXP * 128; item += gdim_()) {
        const int which = item / (NEXP * 128), r = item % (NEXP * 128), ex = r >> 7, it = r & 127;
        const float* src = (which == 0 ? p.moe_w1 : (which == 1 ? p.moe_w3 : p.moe_w2)) + (size_t)(l * NEXP + ex) * D * FF;
        unsigned char* dst = ws + (which == 0 ? WS_WT_W1 : (which == 1 ? WS_WT_W3 : WS_WT_W2)) + (size_t)ex * D * FF;
        convert_item8<2048>(src, dst, it >> 3, it & 7, lds);
    }
}

__device__ __forceinline__ int g8_lds_byte(int r, int c) { const int st = (r >> 4) * 2 + (c >> 5), rr = r & 15, cc = c & 31, ob = rr * 64 + cc * 2; return st * 1024 + (ob ^ (((ob >> 9) & 1) << 5)); }
__device__ __forceinline__ void g8_stage_rc(int bb, int& R, int& C) { const int st = bb / 1024, sb = bb % 1024, swz = sb ^ (((sb >> 9) & 1) << 5); R = (st >> 1) * 16 + swz / 64; C = (st & 1) * 32 + (swz % 64) / 2; }
__device__ __forceinline__ int g8_perm32(int rho) { const int n = rho >> 4, i = rho & 15; return 8 * (i >> 2) + 4 * n + (i & 3); }

enum { EPI_BF16 = 0, EPI_SWIGLU = 2, EPI_SCALE = 3, EPI_F8BF16 = 4 };
struct GUnit { const char* a; const char* b0; const char* b1; const int* arow; int m0, n0, mvalid, ncols; u16* ob; int ldo; float* gates; const float* rscale; };
constexpr int G8_HTB = 128 * 64 * 2;
constexpr size_t G8_KSTEP = 128, G8_HSTEP = (size_t)128 * 2048 * 2;

template <int EPI>
__device__ __forceinline__ void g8_epilogue(const f32x4 (&acc)[2][2][4][2], const GUnit& u, int wr, int wc, int fr, int fq) {
#pragma unroll
    for (int ai = 0; ai < 2; ++ai)
#pragma unroll
        for (int m = 0; m < 4; ++m) {
            const int row = u.m0 + 128 * ai + 64 * wr + 16 * m + fr;
            if (row < u.mvalid) {
                if (EPI == EPI_BF16 || EPI == EPI_F8BF16) {
                    constexpr float si = EPI == EPI_F8BF16 ? 1.f / (F8_SH * F8_SW) : 1.f;
#pragma unroll
                    for (int bj = 0; bj < 2; ++bj) {
                        const int col = u.n0 + 128 * bj + 32 * wc + 8 * fq;
                        if (col < u.ncols) {
                            const f32x4 v0 = acc[ai][bj][m][0] * si, v1 = acc[ai][bj][m][1] * si;
                            u32x4 pk = {pk_bf16(v0[0], v0[1]), pk_bf16(v0[2], v0[3]), pk_bf16(v1[0], v1[1]), pk_bf16(v1[2], v1[3])};
                            *reinterpret_cast<u32x4*>(u.ob + (size_t)row * u.ldo + col) = pk;
                            if (u.gates && col >= 4096 && col < 4112) { *reinterpret_cast<f32x4*>(u.gates + (size_t)row * 16 + (col - 4096)) = v0; *reinterpret_cast<f32x4*>(u.gates + (size_t)row * 16 + (col - 4096) + 4) = v1; }
                        }
                    }
                } else if (EPI == EPI_SWIGLU) {
                    const int col = u.n0 + 32 * wc + 8 * fq;
                    float a[8];
                    constexpr float si = 1.f / (F8_SH * F8_SW);
#pragma unroll
                    for (int n = 0; n < 2; ++n)
#pragma unroll
                        for (int q = 0; q < 4; ++q) { const float x = acc[ai][0][m][n][q] * si; a[n * 4 + q] = x * frcp_(1.f + __expf(-x)) * (acc[ai][1][m][n][q] * (si * F8_SA)); }
                    u32x2 pk = {pk_fp8x4(a[0], a[1], a[2], a[3]), pk_fp8x4(a[4], a[5], a[6], a[7])};
                    *reinterpret_cast<u32x2*>((unsigned char*)u.ob + (size_t)row * u.ldo + col) = pk;
                } else {
                    const float sc = u.rscale[row] * (1.f / (F8_SA * F8_SW));
#pragma unroll
                    for (int bj = 0; bj < 2; ++bj) {
                        const int col = u.n0 + 128 * bj + 32 * wc + 8 * fq;
                        const f32x4 v0 = acc[ai][bj][m][0] * sc, v1 = acc[ai][bj][m][1] * sc;
                        u32x4 pk = {pk_bf16(v0[0], v0[1]), pk_bf16(v0[2], v0[3]), pk_bf16(v1[0], v1[1]), pk_bf16(v1[2], v1[3])};
                        *reinterpret_cast<u32x4*>(u.ob + (size_t)row * u.ldo + col) = pk;
                    }
                }
            }
        }
}

template <int EPI, bool GATHER, class UnitFn>
__device__ __forceinline__ void gemm_phase8(unsigned char* lds, UnitFn next) {
    const int tid = tid_(), wid = __builtin_amdgcn_readfirstlane(tid >> 6), lane = tid & 63, wr = wid >> 2, wc = wid & 3, fr = lane & 15, fq = lane >> 4;
    constexpr bool F8 = (EPI != EPI_BF16);
    constexpr int nt = F8 ? 2048 / 128 : 2048 / 64;
    constexpr unsigned ROWB = F8 ? 2048u : 4096u;
    GUnit cur, nxt; int ui = 0;
    if (!next(0, cur)) return;
    int sR[2], sC[2];
#pragma unroll
    for (int i = 0; i < 2; ++i) g8_stage_rc(tid * 16 + i * 8192, sR[i], sC[i]);
    unsigned voffB[2];
#pragma unroll
    for (int i = 0; i < 2; ++i) voffB[i] = (unsigned)((sR[i] & ~31) + g8_perm32(sR[i] & 31)) * ROWB + (unsigned)sC[i] * 2u;
    unsigned voffA[2][2], voffAn[2][2];
    auto set_voffA = [&](const GUnit& u, unsigned (&vo)[2][2]) {
#pragma unroll
        for (int h = 0; h < 2; ++h)
#pragma unroll
            for (int i = 0; i < 2; ++i) {
                if (GATHER) vo[h][i] = (unsigned)u.arow[u.m0 + h * 128 + sR[i]] * ROWB + (unsigned)sC[i] * 2u;
                else vo[h][i] = (unsigned)(h * 128 + sR[i]) * ROWB + (unsigned)sC[i] * 2u;
            } };
    set_voffA(cur, voffA);
    const unsigned ldsw = (unsigned)wid * 1024u;
    const int aoff = g8_lds_byte(wr * 64 + fr, fq * 8), boff = g8_lds_byte(wc * 32 + fr, fq * 8);
#define G8_SA(b, h) (((b) * 2 + (h)) * G8_HTB)
#define G8_SB(b, h) ((4 + (b) * 2 + (h)) * G8_HTB)
#define G8_STAGE(bufoff, gbase, voff) do { _Pragma("unroll") for (int _i = 0; _i < 2; ++_i) \
        __builtin_amdgcn_global_load_lds((const unsigned*)((const char*)(gbase) + (voff)[_i]), (LAS unsigned*)(lds + (bufoff) + ldsw + _i * 8192), 16, 0, 0); } while (0)
#define G8_LDA(dst, b, h) do { _Pragma("unroll") for (int m = 0; m < 4; ++m) _Pragma("unroll") for (int k = 0; k < 2; ++k) dst[m][k] = *(const LAS bf16x8*)(lds + G8_SA(b, h) + aoff + m * 2048 + k * 1024); } while (0)
#define G8_LDB(dst, b, h) do { _Pragma("unroll") for (int n = 0; n < 2; ++n) _Pragma("unroll") for (int k = 0; k < 2; ++k) dst[n][k] = *(const LAS bf16x8*)(lds + G8_SB(b, h) + boff + n * 2048 + k * 1024); } while (0)
#define G8_MMA(ai, bj, At, Bt) do { __builtin_amdgcn_s_setprio(1); _Pragma("unroll") for (int m = 0; m < 4; ++m) _Pragma("unroll") for (int n = 0; n < 2; ++n) { \
        if (F8) { const i32x8 _b = cat8(Bt[n][0], Bt[n][1]), _a = cat8(At[m][0], At[m][1]); asm volatile("v_mfma_f32_16x16x128_f8f6f4 %0, %1, %2, %0" : "+v"(acc[ai][bj][m][n]) : "v"(_b), "v"(_a)); } \
        else { _Pragma("unroll") for (int k = 0; k < 2; ++k) acc[ai][bj][m][n] = __builtin_amdgcn_mfma_f32_16x16x32_bf16(Bt[n][k], At[m][k], acc[ai][bj][m][n], 0, 0, 0); } } \
        __builtin_amdgcn_s_setprio(0); } while (0)
#define G8_WAIT_V(n) asm volatile("s_waitcnt vmcnt(" #n ")" ::: "memory")
#define G8_WAIT_L(n) asm volatile("s_waitcnt lgkmcnt(" #n ")" ::: "memory")
#define G8_BAR __builtin_amdgcn_s_barrier()
#define G8_SCHED __builtin_amdgcn_sched_barrier(0)
    f32x4 acc[2][2][4][2];
#pragma unroll
    for (int a2 = 0; a2 < 2; ++a2)
#pragma unroll
        for (int b2 = 0; b2 < 2; ++b2)
#pragma unroll
            for (int m = 0; m < 4; ++m)
#pragma unroll
                for (int n = 0; n < 2; ++n) acc[a2][b2][m][n] = (f32x4){0.f, 0.f, 0.f, 0.f};
    bf16x8 At[4][2], B0[2][2], B1[2][2];
    const char* cA = cur.a; const char* cB0 = cur.b0; const char* cB1 = cur.b1;
    G8_STAGE(G8_SB(0, 0), cB0, voffB); G8_STAGE(G8_SA(0, 0), cA, voffA[0]); G8_STAGE(G8_SB(0, 1), cB1, voffB); G8_STAGE(G8_SA(0, 1), cA, voffA[1]);
    if (wr == 1) G8_BAR;
    G8_WAIT_V(4); G8_BAR;
    G8_STAGE(G8_SB(1, 0), cB0 + G8_KSTEP, voffB); G8_STAGE(G8_SA(1, 0), cA + G8_KSTEP, voffA[0]); G8_STAGE(G8_SB(1, 1), cB1 + G8_KSTEP, voffB);
    G8_WAIT_V(6); G8_BAR;
    for (;;) {
        const bool has_next = next(ui + 1, nxt);
        const char* nA = has_next ? nxt.a : cA; const char* nB0 = has_next ? nxt.b0 : cB0; const char* nB1 = has_next ? nxt.b1 : cB1;
        if (GATHER) { if (has_next) set_voffA(nxt, voffAn); else { _Pragma("unroll") for (int h = 0; h < 2; ++h) _Pragma("unroll") for (int i = 0; i < 2; ++i) voffAn[h][i] = voffA[h][i]; } }
        for (int t = 0; t < nt; t += 2) {
            const bool last = (t == nt - 2);
            const char* a1 = cA + (size_t)(t + 1) * G8_KSTEP;
            const char* a2 = last ? nA : cA + (size_t)(t + 2) * G8_KSTEP;
            const char* b20 = last ? nB0 : cB0 + (size_t)(t + 2) * G8_KSTEP; const char* b21 = last ? nB1 : cB1 + (size_t)(t + 2) * G8_KSTEP;
            const char* a3 = a2 + G8_KSTEP; const char* b30 = b20 + G8_KSTEP; const char* b31 = b21 + G8_KSTEP;
            unsigned vA2[2][2];
#pragma unroll
            for (int h = 0; h < 2; ++h)
#pragma unroll
                for (int i = 0; i < 2; ++i) vA2[h][i] = (GATHER && last) ? voffAn[h][i] : voffA[h][i];
            G8_LDB(B0, 0, 0); G8_SCHED; G8_LDA(At, 0, 0); G8_STAGE(G8_SA(1, 1), a1, voffA[1]);
            G8_WAIT_L(8); G8_BAR; G8_WAIT_L(0); G8_MMA(0, 0, At, B0); G8_BAR; G8_SCHED;
            G8_LDB(B1, 0, 1); G8_STAGE(G8_SB(0, 0), b20, voffB);
            G8_BAR; G8_WAIT_L(0); G8_MMA(0, 1, At, B1); G8_BAR;
            G8_LDA(At, 0, 1); G8_STAGE(G8_SA(0, 0), a2, vA2[0]);
            G8_BAR; G8_WAIT_L(0); G8_MMA(1, 0, At, B0); G8_BAR; G8_SCHED;
            G8_STAGE(G8_SB(0, 1), b21, voffB);
            G8_WAIT_V(6); G8_BAR; G8_MMA(1, 1, At, B1); G8_BAR;
            G8_LDB(B0, 1, 0); G8_SCHED; G8_LDA(At, 1, 0); G8_STAGE(G8_SA(0, 1), a2, vA2[1]);
            G8_WAIT_L(8); G8_BAR; G8_WAIT_L(0); G8_MMA(0, 0, At, B0); G8_BAR; G8_SCHED;
            G8_LDB(B1, 1, 1); G8_STAGE(G8_SB(1, 0), b30, voffB);
            G8_BAR; G8_WAIT_L(0); G8_MMA(0, 1, At, B1); G8_BAR;
            G8_LDA(At, 1, 1); G8_STAGE(G8_SA(1, 0), a3, vA2[0]);
            G8_BAR; G8_WAIT_L(0); G8_MMA(1, 0, At, B0); G8_BAR; G8_SCHED;
            G8_STAGE(G8_SB(1, 1), b31, voffB);
            G8_WAIT_V(6); G8_BAR; G8_MMA(1, 1, At, B1); G8_BAR;
        }
        if (F8) asm volatile("s_nop 15\n\ts_nop 15" ::: "memory");
        g8_epilogue<EPI>(acc, cur, wr, wc, fr, fq);
        if (!has_next) break;
#pragma unroll
        for (int a2 = 0; a2 < 2; ++a2)
#pragma unroll
            for (int b2 = 0; b2 < 2; ++b2)
#pragma unroll
                for (int m = 0; m < 4; ++m)
#pragma unroll
                    for (int n = 0; n < 2; ++n) acc[a2][b2][m][n] = (f32x4){0.f, 0.f, 0.f, 0.f};
        cur = nxt; cA = nA; cB0 = nB0; cB1 = nB1; ++ui;
        if (GATHER) { _Pragma("unroll") for (int h = 0; h < 2; ++h) _Pragma("unroll") for (int i = 0; i < 2; ++i) voffA[h][i] = voffAn[h][i]; }
    }
    G8_WAIT_V(0);
    if (wr == 0) G8_BAR;
    G8_BAR;
#undef G8_SA
#undef G8_SB
#undef G8_STAGE
#undef G8_LDA
#undef G8_LDB
#undef G8_MMA
#undef G8_WAIT_V
#undef G8_WAIT_L
#undef G8_BAR
#undef G8_SCHED
}

template <bool F8, bool REV = false>
__device__ __forceinline__ void phase_gemm_dense(const Params& p, const u16* A, int M, const u16* Wt, int N, u16* ob, int ldo, float* gates, unsigned char* lds) {
    const int nM = M / 256, nN = (N + 255) / 256, L = nM * nN;
    const int xcd = bid_() & 7, nslot = gdim_() >> 3, slot = bid_() >> 3;
    const int base = (int)(((long)L * xcd) >> 3), cnt = (int)(((long)L * (xcd + 1)) >> 3) - base;
    const int G8n = nM >> 3, rem = nM & 7;
    auto next = [&](int i, GUnit& u) -> bool {
        int k = slot + i * nslot;
        if (REV) {
            if (slot < 4) { if (i >= 4) return false; k = slot * 4 + i; }
            else k = 16 + (slot - 4) + i * (nslot - 4);
        }
        if (k >= cnt) return false;
        const int idx = base + k;
        int pn, pm;
        if (idx < G8n * 8 * nN) { const int gq = idx / (8 * nN), r = idx % (8 * nN); pn = r >> 3; pm = gq * 8 + (r & 7); }
        else { const int r = idx - G8n * 8 * nN; pn = r / rem; pm = G8n * 8 + r % rem; }
        constexpr size_t rowb = F8 ? 2048 : 4096;
        u.a = (const char*)A + (size_t)pm * 256 * rowb; u.b0 = (const char*)Wt + (size_t)pn * 256 * rowb; u.b1 = u.b0 + 128 * rowb; u.arow = nullptr;
        u.m0 = pm * 256; u.n0 = pn * 256; u.mvalid = M; u.ncols = N; u.ob = ob; u.ldo = ldo; u.gates = gates; u.rscale = nullptr;
        return true; };
    gemm_phase8<F8 ? EPI_F8BF16 : EPI_BF16, false>(lds, next);
}

__device__ __forceinline__ void phase_gemm_dense_f8rev(const Params& p, const u16* A, int M, const u16* Wt, int N, u16* ob, int ldo, unsigned char* lds) { phase_gemm_dense<true, true>(p, A, M, Wt, N, ob, ldo, nullptr, lds); }
__device__ __forceinline__ void phase_moe_a(const Params& p, int l, unsigned char* lds) {
    unsigned char* const ws = ws_();
    const int mvalid = l == 0 ? 2176 : 2048, nM = l == 0 ? 9 : 8;
    const int per_e = nM * 16;
    const int xcd = bid_() & 7, slot = bid_() >> 3, nslot = gdim_() >> 3;
    auto next = [&](int i, GUnit& u) -> bool {
        const int k = slot + i * nslot;
        if (k >= 2 * per_e) return false;
        const int tile = xcd * 2 * per_e + k;
        const int ex = tile / per_e, r = tile % per_e, pn = r / nM, pm = r % nM;
        u.a = (const char*)(ws + WS_H); u.arow = (const int*)(ws + WS_EROW) + ex * EPAD;
        u.b0 = (const char*)(ws + WS_WT_W1) + ((size_t)ex * FF + pn * 128) * D; u.b1 = (const char*)(ws + WS_WT_W3) + ((size_t)ex * FF + pn * 128) * D;
        u.m0 = pm * 256; u.n0 = pn * 128; u.mvalid = mvalid; u.ncols = FF; u.ob = (u16*)(ws + WS_ACT + (size_t)ex * EPAD * FF); u.ldo = FF; u.gates = nullptr; u.rscale = nullptr;
        return true; };
    gemm_phase8<EPI_SWIGLU, true>(lds, next);
}
__device__ __forceinline__ void phase_moe_b(const Params& p, int l, unsigned char* lds) {
    unsigned char* const ws = ws_();
    const int mvalid = l == 0 ? 2176 : 2048, nM = l == 0 ? 9 : 8;
    const int per_e = nM * 8;
    const int xcd = bid_() & 7, slot = bid_() >> 3, nslot = gdim_() >> 3;
    auto next = [&](int i, GUnit& u) -> bool {
        const int k = slot + i * nslot;
        if (k >= 2 * per_e) return false;
        const int tile = xcd * 2 * per_e + k;
        const int ex = tile / per_e, r = tile % per_e, pn = r / nM, pm = r % nM;
        u.a = (const char*)(ws + WS_ACT) + ((size_t)ex * EPAD + pm * 256) * FF; u.arow = nullptr;
        u.b0 = (const char*)(ws + WS_WT_W2) + ((size_t)ex * D + pn * 256) * FF; u.b1 = u.b0 + (size_t)128 * 2048;
        u.m0 = pm * 256; u.n0 = pn * 256; u.mvalid = mvalid; u.ncols = D; u.ob = (u16*)(ws + WS_YEXP) + (size_t)ex * EPAD * D; u.ldo = D; u.gates = nullptr;
        u.rscale = (const float*)(ws + WS_EGATE) + ex * EPAD;
        return true; };
    gemm_phase8<EPI_SCALE, false>(lds, next);
}

__device__ __forceinline__ int mlstm_row(int b, int dir, int pos) {
    if (pos < LC) return NLAT + b * LC + (dir ? (LC - 1 - pos) : pos);
    const int q = pos - LC; return b * SEQ + (dir ? (SEQ - 1 - q) : q);
}
__device__ __forceinline__ void phase_mlstm(const Params& p, unsigned char* lds) {
    unsigned char* const ws = ws_();
    u16* KT = (u16*)lds;
    u16* VT = KT + 256 * 72;
    u16* VWT = VT + 48 * 72;
    u16* CT = VWT + 48 * 72;
    u16* Ss = CT + 48 * 264;
    float* gB = (float*)(Ss + 64 * 72);
    float* gI = gB + 68 * 64;
    float* gP = gI + 68 * 64;
    float* gE = gP + 68 * 64;
    const int t = tid_(), lane = t & 63, w = t >> 6, fr = lane & 15, fq = lane >> 4;
    const u16* P = (const u16*)(ws + WS_P);
    const float* G = (const float*)(ws + WS_G);
    u16* HM = (u16*)(ws + WS_HM);
    for (int item = bid_(); item < 256; item += gdim_()) {
        const int combo = (item & 7) * 4 + (item >> 6), vs = (item >> 3) & 7, dir = combo & 1, hh = (combo >> 1) & 3, b = combo >> 3;
        __syncthreads();
        for (int i = t; i < 48 * 264; i += NT) CT[i] = 0;
        for (int i = t; i < 16 * 72; i += NT) { const int er = i / 72; VT[32 * 72 + i] = (er == 0) ? (u16)0x3f80 : (u16)0; VWT[32 * 72 + i] = 0; }
        {
            const float gb_i = p.mlstm_gate_b[(dir * 2 + 0) * 4 + hh], gb_f = p.mlstm_gate_b[(dir * 2 + 1) * 4 + hh];
            for (int ch = w; ch < 68; ch += 8) {
                const int row = mlstm_row(b, dir, ch * 64 + lane);
                const float gi = G[(size_t)row * 16 + dir * 8 + hh] + gb_i;
                const float gf = G[(size_t)row * 16 + dir * 8 + 4 + hh] + gb_f;
                const float lf = fminf(gf, 0.f) - log1pf(__expf(-fabsf(gf)));
                float bc = lf;
#pragma unroll
                for (int o = 1; o < 64; o <<= 1) { const float n = __shfl_up(bc, o, 64); if (lane >= o) bc += n; }
                float pm = gi - bc;
#pragma unroll
                for (int o = 1; o < 64; o <<= 1) { const float n = __shfl_up(pm, o, 64); if (lane >= o) pm = fmaxf(pm, n); }
                const float b63 = __shfl(bc, 63, 64);
                float gmax = b63 - bc + gi;
#pragma unroll
                for (int o = 32; o > 0; o >>= 1) gmax = fmaxf(gmax, __shfl_xor(gmax, o, 64));
                gB[ch * 64 + lane] = bc; gI[ch * 64 + lane] = gi; gP[ch * 64 + lane] = pm;
                if (lane == 0) { gE[ch * 2] = b63; gE[ch * 2 + 1] = gmax; }
            }
        }
        f32x4 Cacc[2][3];
#pragma unroll
        for (int i = 0; i < 2; ++i)
#pragma unroll
            for (int j = 0; j < 3; ++j) Cacc[i][j] = (f32x4){0.f, 0.f, 0.f, 0.f};
        float m_old = 0.f;
        const int jt = w & 3, sth = w >> 2;
        const int vs_s = t & 63, vs_eg = t >> 6;
        bf16x8 qf[8]; unsigned ktr[2][8]; u32x2 vraw;
        const int jq = jt * 16 + fr, jjq = dir ? 63 - jq : jq;
        const unsigned off_q = (unsigned)jjq * AB_IN + hh * 256 + fq * 8;
        const int jk0 = (sth * 2) * 16 + fr, jk1 = jk0 + 16;
        const unsigned off_k0 = (unsigned)(dir ? 63 - jk0 : jk0) * AB_IN + 1024 + hh * 256 + fq * 8;
        const unsigned off_k1 = (unsigned)(dir ? 63 - jk1 : jk1) * AB_IN + 1024 + hh * 256 + fq * 8;
        unsigned off_kt[2];
#pragma unroll
        for (int i = 0; i < 2; ++i) { const int mt = t + NT * i, d2 = (mt & 127) * 2, s8 = (mt >> 7) * 8; off_kt[i] = (unsigned)(dir ? 63 - s8 - 7 : s8) * AB_IN + 1024 + hh * 256 + d2; }
        const unsigned off_v = (unsigned)(dir ? 63 - vs_s : vs_s) * AB_IN + 2048 + hh * 256 + vs * 32 + vs_eg * 4;
        const unsigned off_h = (unsigned)jjq * 1024 + hh * 256 + vs * 32 + sth * 16 + 4 * fq;
#define ML_BASE(POS0) (P + (size_t)(dir ? mlstm_row(b, dir, (POS0)) - 63 : mlstm_row(b, dir, (POS0))) * AB_IN)
#define ML_LOAD_Q(POS0) do { const u16* _pc = ML_BASE(POS0); \
            _Pragma("unroll") for (int kk = 0; kk < 8; ++kk) qf[kk] = ld_frag_g(_pc + off_q + kk * 32); } while (0)
#define ML_LOAD_K(POS0, S2) do { const u16* _pc = ML_BASE(POS0); \
            _Pragma("unroll") for (int kk = 0; kk < 8; ++kk) kf[kk] = ld_frag_g(_pc + ((S2) ? off_k1 : off_k0) + kk * 32); } while (0)
#define ML_LOAD_KTV(POS0) do { const u16* _pc = ML_BASE(POS0); \
            _Pragma("unroll") for (int i = 0; i < 2; ++i) { \
                _Pragma("unroll") for (int q = 0; q < 8; ++q) ktr[i][q] = *reinterpret_cast<const unsigned*>(_pc + (size_t)((dir ? 7 - q : q) * AB_IN) + off_kt[i]); } \
            vraw = *reinterpret_cast<const u32x2*>(_pc + off_v); } while (0)
        ML_LOAD_Q(0); ML_LOAD_KTV(0);
        __syncthreads();
        for (int ch = 0; ch < 68; ++ch) {
            const int pos0 = ch * 64;
            const float* sb = gB + ch * 64; const float* sig = gI + ch * 64; const float* spm = gP + ch * 64;
            const float b63 = gE[ch * 2], m_new = fmaxf(b63 + m_old, gE[ch * 2 + 1]), decay = __expf(b63 + m_old - m_new);
            const int jg = jt * 16 + fr;
            const float bj = sb[jg], mj = bj + fmaxf(m_old, spm[jg]);
            auto s_tile = [&](int st) {
                f32x4 sv = (f32x4){0.f, 0.f, 0.f, 0.f};
                if (st <= jt) {
                    typedef short s16x4 __attribute__((ext_vector_type(4)));
                    const u16* kb = KT + (8 * fq + ((lane & 15) >> 2)) * 72 + st * 16 + 4 * (lane & 3);
#pragma unroll
                    for (int kk = 0; kk < 8; ++kk) {
                        const s16x4 lo = __builtin_amdgcn_ds_read_tr16_b64_v4i16((LAS s16x4*)(kb + kk * 32 * 72));
                        const s16x4 hi = __builtin_amdgcn_ds_read_tr16_b64_v4i16((LAS s16x4*)(kb + (kk * 32 + 4) * 72));
                        const bf16x8 kfr = {lo[0], lo[1], lo[2], lo[3], hi[0], hi[1], hi[2], hi[3]};
                        sv = mfma16(kfr, qf[kk], sv);
                    }
                }
                float pv[4];
#pragma unroll
                for (int q = 0; q < 4; ++q) {
                    const int sg = st * 16 + 4 * fq + q;
                    pv[q] = (sg <= jg) ? sv[q] * 0.0625f * __expf(bj - sb[sg] + sig[sg] - mj) : 0.f;
                }
                u32x2 pk = {pk_bf16(pv[0], pv[1]), pk_bf16(pv[2], pv[3])};
                *reinterpret_cast<u32x2*>(Ss + jg * 72 + st * 16 + 4 * fq) = pk;
            };
#pragma unroll
            for (int i = 0; i < 2; ++i) {
                const int mt = t + NT * i, d2 = (mt & 127) * 2, s8 = (mt >> 7) * 8;
                u32x4 lo = {(ktr[i][0] & 0xffffu) | (ktr[i][1] << 16), (ktr[i][2] & 0xffffu) | (ktr[i][3] << 16), (ktr[i][4] & 0xffffu) | (ktr[i][5] << 16), (ktr[i][6] & 0xffffu) | (ktr[i][7] << 16)};
                u32x4 hi = {(ktr[i][0] >> 16) | (ktr[i][1] & 0xffff0000u), (ktr[i][2] >> 16) | (ktr[i][3] & 0xffff0000u), (ktr[i][4] >> 16) | (ktr[i][5] & 0xffff0000u), (ktr[i][6] >> 16) | (ktr[i][7] & 0xffff0000u)};
                *reinterpret_cast<u32x4*>(KT + d2 * 72 + s8) = lo;
                *reinterpret_cast<u32x4*>(KT + (d2 + 1) * 72 + s8) = hi;
            }
            {
                const float wg = __expf(b63 - sb[vs_s] + sig[vs_s] - m_new) * 0.0625f;
                const float v0 = bf_lo(vraw[0]), v1 = bf_hi(vraw[0]), v2 = bf_lo(vraw[1]), v3 = bf_hi(vraw[1]);
                const int e0 = vs_eg * 4;
                VT[(e0 + 0) * 72 + vs_s] = (u16)(vraw[0] & 0xffffu); VT[(e0 + 1) * 72 + vs_s] = (u16)(vraw[0] >> 16);
                VT[(e0 + 2) * 72 + vs_s] = (u16)(vraw[1] & 0xffffu); VT[(e0 + 3) * 72 + vs_s] = (u16)(vraw[1] >> 16);
                VWT[(e0 + 0) * 72 + vs_s] = f2bf(v0 * wg); VWT[(e0 + 1) * 72 + vs_s] = f2bf(v1 * wg);
                VWT[(e0 + 2) * 72 + vs_s] = f2bf(v2 * wg); VWT[(e0 + 3) * 72 + vs_s] = f2bf(v3 * wg);
                if (t < 64) VWT[32 * 72 + t] = f2bf(wg);
            }
            if (ch + 1 < 68) ML_LOAD_KTV(pos0 + 64);
            __syncthreads();
            s_tile(sth * 2);
            s_tile(sth * 2 + 1);
            __syncthreads();
            {
                const float w_inter = __expf(bj + m_old - mj);
                f32x4 nacc[2];
#pragma unroll
                for (int z = 0; z < 2; ++z) {
                    const int et = z == 0 ? sth : 2;
                    f32x4 a = (f32x4){0.f, 0.f, 0.f, 0.f};
#pragma unroll
                    for (int kk = 0; kk < 8; ++kk) a = mfma16(ld_frag_s(CT + (et * 16 + fr) * 264 + kk * 32 + fq * 8), qf[kk], a);
                    nacc[z] = a * w_inter;
                }
                if (ch + 1 < 68) ML_LOAD_Q(pos0 + 64);
#pragma unroll
                for (int z = 0; z < 2; ++z) {
                    const int et = z == 0 ? sth : 2;
                    f32x4 a = nacc[z];
#pragma unroll
                    for (int k2 = 0; k2 < 2; ++k2) a = mfma16(ld_frag_s(VT + (et * 16 + fr) * 72 + k2 * 32 + fq * 8), ld_frag_s(Ss + jg * 72 + k2 * 32 + fq * 8), a);
                    nacc[z] = a;
                }
                const float den = __shfl(nacc[1][0], fr, 64);
                const float dd = fmaxf(fabsf(den), __expf(-mj));
                const float inv = 1.f / dd;
                u32x2 pk = {pk_bf16(nacc[0][0] * inv, nacc[0][1] * inv), pk_bf16(nacc[0][2] * inv, nacc[0][3] * inv)};
                *reinterpret_cast<u32x2*>(HM + ((size_t)dir * NTOK + (dir ? mlstm_row(b, dir, pos0) - 63 : mlstm_row(b, dir, pos0))) * 1024 + off_h) = pk;
            }
#pragma unroll
            for (int i = 0; i < 2; ++i)
#pragma unroll
                for (int et = 0; et < 3; ++et) {
                    f32x4 a = Cacc[i][et] * decay;
#pragma unroll
                    for (int k2 = 0; k2 < 2; ++k2) a = mfma16(ld_frag_s(KT + ((w * 2 + i) * 16 + fr) * 72 + k2 * 32 + fq * 8), ld_frag_s(VWT + (et * 16 + fr) * 72 + k2 * 32 + fq * 8), a);
                    Cacc[i][et] = a;
                }
            __syncthreads();
#pragma unroll
            for (int i = 0; i < 2; ++i)
#pragma unroll
                for (int et = 0; et < 3; ++et) {
                    const f32x4 a = Cacc[i][et];
                    u32x2 pk = {pk_bf16(a[0], a[1]), pk_bf16(a[2], a[3])};
                    *reinterpret_cast<u32x2*>(CT + (et * 16 + fr) * 264 + (w * 2 + i) * 16 + 4 * fq) = pk;
                }
            m_old = m_new;
        }
#undef ML_LOAD_Q
#undef ML_LOAD_K
#undef ML_LOAD_KTV
    }
}

__device__ __forceinline__ void mlstm_out_rows(const Params& p, int row0, int nrows) {
    unsigned char* const ws = ws_();
    const int lane = tid_() & 63, w = tid_() >> 6;
    const u16* P = (const u16*)(ws + WS_P);
    const u16* HM = (const u16*)(ws + WS_HM);
    u16* YIN = (u16*)(ws + WS_YIN);
    for (int r = w; r < nrows; r += 8) {
        const int row = row0 + r;
        const int c0 = lane * 16;
        float v[16]; float ss = 0.f;
#pragma unroll
        for (int h2 = 0; h2 < 2; ++h2) {
            const u32x4 a = *reinterpret_cast<const u32x4*>(HM + (size_t)row * 1024 + c0 + h2 * 8);
            const u32x4 bq = *reinterpret_cast<const u32x4*>(HM + ((size_t)NTOK + row) * 1024 + c0 + h2 * 8);
#pragma unroll
            for (int q = 0; q < 4; ++q) { v[h2 * 8 + 2 * q] = bf_lo(a[q]) + bf_lo(bq[q]); v[h2 * 8 + 2 * q + 1] = bf_hi(a[q]) + bf_hi(bq[q]); }
        }
#pragma unroll
        for (int q = 0; q < 16; ++q) ss += v[q] * v[q];
        ss += __shfl_xor(ss, 1, 64); ss += __shfl_xor(ss, 2, 64); ss += __shfl_xor(ss, 4, 64); ss += __shfl_xor(ss, 8, 64);
        const float rstd = rsqrtf(ss * (1.f / 256.f) + 1e-6f);
        float y[16];
#pragma unroll
        for (int h2 = 0; h2 < 2; ++h2) {
            const u32x4 og = *reinterpret_cast<const u32x4*>(P + (size_t)row * AB_IN + 3072 + c0 + h2 * 8);
#pragma unroll
            for (int q = 0; q < 4; ++q) {
                const int c = c0 + h2 * 8 + 2 * q;
                y[h2 * 8 + 2 * q] = v[h2 * 8 + 2 * q] * rstd * p.mlstm_norm[c] * sigmoidf_(bf_lo(og[q])) * F8_SH;
                y[h2 * 8 + 2 * q + 1] = v[h2 * 8 + 2 * q + 1] * rstd * p.mlstm_norm[c + 1] * sigmoidf_(bf_hi(og[q])) * F8_SH;
            }
        }
        *reinterpret_cast<u32x4*>((unsigned char*)YIN + (size_t)row * D + c0) = (u32x4){pk_fp8x4(y[0], y[1], y[2], y[3]), pk_fp8x4(y[4], y[5], y[6], y[7]), pk_fp8x4(y[8], y[9], y[10], y[11]), pk_fp8x4(y[12], y[13], y[14], y[15])};
    }
}

template <int DH, class KeyFn, class BiasFn>
__device__ __forceinline__ void attn_wave(const u16* qptr, size_t qstride, int nblk, KeyFn keyfn, BiasFn biasfn, float scale,
                                           float m_init, float l_init, u16* vlds, u16* optr, size_t ostride) {
    constexpr int NK = DH / 32, NDT = DH / 16, VS = DH + 8, NV = DH / 16;
    const int lane = tid_() & 63, fr = lane & 15, fq = lane >> 4;
    bf16x8 qf[NK];
#pragma unroll
    for (int kk = 0; kk < NK; ++kk) qf[kk] = ld_frag_g(qptr + (size_t)fr * qstride + kk * 32 + fq * 8);
    f32x4 oacc[NDT];
#pragma unroll
    for (int i = 0; i < NDT; ++i) oacc[i] = (f32x4){0.f, 0.f, 0.f, 0.f};
    float m = m_init, l = l_init;
    bf16x8 kn[2][NK]; u32x4 vn[NV];
    auto load_blk = [&](int ib) {
        const u16* kptr; const u16* vptr; size_t kvs;
        (void)keyfn(ib, kptr, vptr, kvs);
#pragma unroll
        for (int st = 0; st < 2; ++st)
#pragma unroll
            for (int kk = 0; kk < NK; ++kk) kn[st][kk] = ld_frag_g(kptr + (size_t)(st * 16 + fr) * kvs + kk * 32 + fq * 8);
#pragma unroll
        for (int i = 0; i < NV; ++i) { const int cidx = lane + 64 * i, r = cidx / (DH / 8), cc = cidx % (DH / 8); vn[i] = *reinterpret_cast<const u32x4*>(vptr + (size_t)r * kvs + cc * 8); }
    };
    auto next_valid = [&](int ib) { const u16* a; const u16* b2; size_t c; while (ib < nblk && !keyfn(ib, a, b2, c)) ++ib; return ib; };
    int ib = next_valid(0);
    if (ib < nblk) load_blk(ib);
    while (ib < nblk) {
        bf16x8 kc[2][NK]; u32x4 vc[NV];
#pragma unroll
        for (int st = 0; st < 2; ++st)
#pragma unroll
            for (int kk = 0; kk < NK; ++kk) kc[st][kk] = kn[st][kk];
#pragma unroll
        for (int i = 0; i < NV; ++i) vc[i] = vn[i];
        const int ibn = next_valid(ib + 1);
        if (ibn < nblk) load_blk(ibn);
        asm volatile("" ::: "memory");
#pragma unroll
        for (int i = 0; i < NV; ++i) { const int cidx = lane + 64 * i, r = cidx / (DH / 8), cc = cidx % (DH / 8); *reinterpret_cast<u32x4*>(vlds + r * VS + cc * 8) = vc[i]; }
        f32x4 s[2];
#pragma unroll
        for (int st = 0; st < 2; ++st) {
            f32x4 a = (f32x4){0.f, 0.f, 0.f, 0.f};
#pragma unroll
            for (int kk = 0; kk < NK; ++kk) a = mfma16(kc[st][kk], qf[kk], a);
            s[st] = a;
        }
        float x[8]; float mx = -INFINITY;
#pragma unroll
        for (int st = 0; st < 2; ++st)
#pragma unroll
            for (int q = 0; q < 4; ++q) { const float v = s[st][q] * scale + biasfn(ib, fr, st * 16 + 4 * fq + q); x[st * 4 + q] = v; mx = fmaxf(mx, v); }
        mx = max_x32(max_x16(mx));
        const float m_new = fmaxf(m, mx);
        const float m_safe = (m_new == -INFINITY) ? 0.f : m_new;
        const float alpha = __expf(m - m_safe);
        float ps = 0.f; float pe[8];
#pragma unroll
        for (int q = 0; q < 8; ++q) { pe[q] = __expf(x[q] - m_safe); ps += pe[q]; }
        l = l * alpha + ps; m = m_new;
#pragma unroll
        for (int i = 0; i < NDT; ++i) oacc[i] *= alpha;
        const bf16x8 pf = mk_frag(pk_bf16(pe[0], pe[1]), pk_bf16(pe[2], pe[3]), pk_bf16(pe[4], pe[5]), pk_bf16(pe[6], pe[7]));
        asm volatile("s_waitcnt lgkmcnt(0)" ::: "memory");
        {
            typedef short s16x4 __attribute__((ext_vector_type(4)));
            const int tq = (lane & 15) >> 2, tp = lane & 3;
            const u16* vb0 = vlds + (4 * fq + tq) * VS + 4 * tp;
            const u16* vb1 = vb0 + 16 * VS;
#pragma unroll
            for (int dt = 0; dt < NDT; ++dt) {
                const s16x4 lo = __builtin_amdgcn_ds_read_tr16_b64_v4i16((LAS s16x4*)(vb0 + dt * 16));
                const s16x4 hi = __builtin_amdgcn_ds_read_tr16_b64_v4i16((LAS s16x4*)(vb1 + dt * 16));
                const bf16x8 vf = {lo[0], lo[1], lo[2], lo[3], hi[0], hi[1], hi[2], hi[3]};
                oacc[dt] = mfma16(vf, pf, oacc[dt]);
            }
        }
        asm volatile("" ::: "memory");
        ib = ibn;
    }
    l = sum_x32(sum_x16(l));
    const float inv = 1.f / l;
#pragma unroll
    for (int dt = 0; dt < NDT; ++dt) {
        const f32x4 o = oacc[dt] * (inv * F8_SH);
        *reinterpret_cast<unsigned*>((unsigned char*)optr + (size_t)fr * ostride + dt * 16 + 4 * fq) = pk_fp8x4(o[0], o[1], o[2], o[3]);
    }
}


template <int DH, class SlabFn, class SubFn, class BiasFn>
__device__ __forceinline__ void attn_block(const u16* qptr, size_t qstride, int nslab, SlabFn slabfn, SubFn subfn, BiasFn biasfn, float scale,
                                            float m_init, float l_init, unsigned char* lds, u16* optr, size_t ostride) {
    constexpr int NK = DH / 32, NDT = DH / 16, VS = DH + 8, NLD = DH / 64;
    constexpr int STAGE = 2 * 64 * VS * 2;
    const int t = tid_(), lane = t & 63, fr = lane & 15, fq = lane >> 4;
    bf16x8 qf[NK];
#pragma unroll
    for (int kk = 0; kk < NK; ++kk) qf[kk] = ld_frag_g(qptr + (size_t)fr * qstride + kk * 32 + fq * 8);
    f32x4 oacc[NDT];
#pragma unroll
    for (int i = 0; i < NDT; ++i) oacc[i] = (f32x4){0.f, 0.f, 0.f, 0.f};
    float m = m_init, l = l_init;
    u32x4 kreg[NLD], vreg[NLD];
    auto load_slab = [&](int i) {
        const u16* kp; const u16* vp; size_t kvs; slabfn(i, kp, vp, kvs);
#pragma unroll
        for (int q = 0; q < NLD; ++q) { const int c = t + NT * q, r = c / (DH / 8), cc = c % (DH / 8);
            kreg[q] = *reinterpret_cast<const u32x4*>(kp + (size_t)r * kvs + cc * 8); vreg[q] = *reinterpret_cast<const u32x4*>(vp + (size_t)r * kvs + cc * 8); } };
    auto store_slab = [&](int st) {
        u16* Ks = (u16*)(lds + st * STAGE); u16* Vs = Ks + 64 * VS;
#pragma unroll
        for (int q = 0; q < NLD; ++q) { const int c = t + NT * q, r = c / (DH / 8), cc = c % (DH / 8);
            *reinterpret_cast<u32x4*>(Ks + r * VS + cc * 8) = kreg[q]; *reinterpret_cast<u32x4*>(Vs + r * VS + cc * 8) = vreg[q]; } };
    __syncthreads();
    load_slab(0); store_slab(0);
    if (nslab > 1) load_slab(1);
    __syncthreads();
    for (int i = 0; i < nslab; ++i) {
        const int cur = i & 1;
        if (i + 1 < nslab) store_slab(cur ^ 1);
        if (i + 2 < nslab) load_slab(i + 2);
        const u16* Ks = (const u16*)(lds + cur * STAGE); const u16* Vs = Ks + 64 * VS;
#pragma unroll
        for (int j = 0; j < 2; ++j) {
            int off;
            if (!subfn(i, j, off)) continue;
            f32x4 s[2];
#pragma unroll
            for (int st = 0; st < 2; ++st) {
                f32x4 a = (f32x4){0.f, 0.f, 0.f, 0.f};
#pragma unroll
                for (int kk = 0; kk < NK; ++kk) a = mfma16(ld_frag_s(Ks + (off + st * 16 + fr) * VS + kk * 32 + fq * 8), qf[kk], a);
                s[st] = a;
            }
            float x[8]; float mx = -INFINITY;
#pragma unroll
            for (int st = 0; st < 2; ++st)
#pragma unroll
                for (int q = 0; q < 4; ++q) { const float v = s[st][q] * scale + biasfn(i, off, fr, st * 16 + 4 * fq + q); x[st * 4 + q] = v; mx = fmaxf(mx, v); }
            mx = max_x32(max_x16(mx));
            const float m_new = fmaxf(m, mx);
            const float m_safe = (m_new == -INFINITY) ? 0.f : m_new;
            const float alpha = __expf(m - m_safe);
            float ps = 0.f; float pe[8];
#pragma unroll
            for (int q = 0; q < 8; ++q) { pe[q] = __expf(x[q] - m_safe); ps += pe[q]; }
            l = l * alpha + ps; m = m_new;
#pragma unroll
            for (int dt = 0; dt < NDT; ++dt) oacc[dt] *= alpha;
            const bf16x8 pf = mk_frag(pk_bf16(pe[0], pe[1]), pk_bf16(pe[2], pe[3]), pk_bf16(pe[4], pe[5]), pk_bf16(pe[6], pe[7]));
            typedef short s16x4 __attribute__((ext_vector_type(4)));
            const int tq = (lane & 15) >> 2, tp = lane & 3;
            const u16* vb0 = Vs + (off + 4 * fq + tq) * VS + 4 * tp;
            const u16* vb1 = vb0 + 16 * VS;
#pragma unroll
            for (int dt = 0; dt < NDT; ++dt) {
                const s16x4 lo = __builtin_amdgcn_ds_read_tr16_b64_v4i16((LAS s16x4*)(vb0 + dt * 16));
                const s16x4 hi = __builtin_amdgcn_ds_read_tr16_b64_v4i16((LAS s16x4*)(vb1 + dt * 16));
                const bf16x8 vf = {lo[0], lo[1], lo[2], lo[3], hi[0], hi[1], hi[2], hi[3]};
                oacc[dt] = mfma16(vf, pf, oacc[dt]);
            }
        }
        __syncthreads();
    }
    l = sum_x32(sum_x16(l));
    const float inv = 1.f / l;
#pragma unroll
    for (int dt = 0; dt < NDT; ++dt) {
        const f32x4 o = oacc[dt] * (inv * F8_SH);
        *reinterpret_cast<unsigned*>((unsigned char*)optr + (size_t)fr * ostride + dt * 16 + 4 * fq) = pk_fp8x4(o[0], o[1], o[2], o[3]);
    }
}

__device__ __forceinline__ void phase_l0_stage2(const Params& p, unsigned char* lds) {
    unsigned char* const ws = ws_();
    const int w = tid_() >> 6;
    const u16* P = (const u16*)(ws + WS_P);
    u16* YIN = (u16*)(ws + WS_YIN);
    for (int item = bid_(); item < 1088 + 2176; item += gdim_()) {
        if (item < 1024) {
            const int r2 = item & 31, h = (item >> 5) & 7, b = item >> 8;
            const int rr = w >> 2, qt = w & 3, r = 2 * r2 + rr;
            const int r0 = min(max(r - 4, 0), 56);
            const int krow0 = min(max(2 * r2 - 4, 0), 56), nwin = min(max(2 * r2 + 1 - 4, 0), 56) + 8 - krow0;
            const int cb = qt == 0 ? 0 : (qt == 1 ? 8 : (qt == 2 ? 24 : 32));
            const int qrow = b * SEQ + r * 64 + qt * 16;
            const float* rpb = p.na_rpb + h * 15 * 31;
            auto slabfn = [&](int i, const u16*& kp, const u16*& vp, size_t& kvs) {
                const int row = i < nwin ? b * SEQ + (krow0 + i) * 64 : NLAT + b * LC + (i - nwin) * 64;
                kp = P + (size_t)row * AB_IN + 5136 + h * 128; vp = P + (size_t)row * AB_IN + 6160 + h * 128; kvs = AB_IN; };
            auto subfn = [&](int i, int j, int& off) -> bool {
                if (i < nwin) { off = cb; return j == 0 && (krow0 + i) >= r0 && (krow0 + i) < r0 + 8; }
                off = 32 * j; return true; };
            auto biasfn = [&](int i, int off, int qi, int ki) -> float {
                if (i >= nwin) return 0.f;
                const int c = qt * 16 + qi, kc = off + ki, c0 = min(max(c - 8, 0), 48);
                if (kc < c0 || kc >= c0 + 16) return -INFINITY;
                return rpb[(krow0 + i - r + 7) * 31 + (kc - c + 15)]; };
            attn_block<128>(P + (size_t)qrow * AB_IN + 4112 + h * 128, AB_IN, nwin + 4, slabfn, subfn, biasfn, 0.08838834764831845f, -INFINITY, 0.f, lds,
                            (u16*)((unsigned char*)YIN + (size_t)qrow * D + 1024 + h * 128), D);
        } else if (item < 1088) {
            const int it = item - 1024, half = it & 1, h = (it >> 1) & 7, b = it >> 4;
            const int qrow = NLAT + b * LC + (half * 8 + w) * 16;
            auto slabfn = [&](int i, const u16*& kp, const u16*& vp, size_t& kvs) {
                const int row = NLAT + b * LC + i * 64;
                kp = P + (size_t)row * AB_IN + 5136 + h * 128; vp = P + (size_t)row * AB_IN + 6160 + h * 128; kvs = AB_IN; };
            auto subfn = [&](int, int j, int& off) -> bool { off = 32 * j; return true; };
            auto biasfn = [&](int, int, int, int) -> float { return 0.f; };
            attn_block<128>(P + (size_t)qrow * AB_IN + 4112 + h * 128, AB_IN, 4, slabfn, subfn, biasfn, 0.08838834764831845f, -INFINITY, 0.f, lds,
                            (u16*)((unsigned char*)YIN + (size_t)qrow * D + 1024 + h * 128), D);
        } else {
            mlstm_out_rows(p, (item - 1088) * 8, 8);
        }
    }
}

__device__ __forceinline__ void rope_prep(const Params& p) {
    if (bid_() != 0) return;
    float* T = (float*)(ws_() + WS_ROPE);
    for (int i = tid_(); i < 1024; i += NT) {
        const int pos = i >> 4, j = i & 15;
        const float inv = exp2f(-(float)j * (13.287712379549449f / 16.f));
        float sn, cs; sincosf((float)pos * inv, &sn, &cs);
        T[i] = cs; T[1024 + i] = sn;
    }
}
__device__ __forceinline__ void rope_rows(const Params& p, int row0, int nrows) {
    unsigned char* const ws = ws_();
    const int lane = tid_() & 63, w = tid_() >> 6;
    u16* P = (u16*)(ws + WS_P);
    const float* T = (const float*)(ws + WS_ROPE);
    for (int r = w; r < nrows; r += 8) {
        const int row = row0 + r, tt = row & (SEQ - 1), prow = tt >> 6, pcol = tt & 63;
#pragma unroll
        for (int it = 0; it < 2; ++it) {
            const int c = it * 64 + lane;
            if (c < 80) {
                const int head = c >> 2, half = (c >> 1) & 1, j0 = (c & 1) * 8;
                u16* q1 = P + (size_t)row * CD_IN + head * 64 + half * 32 + j0;
                const float* tc = T + (half ? pcol : prow) * 16 + j0;
                const u32x4 xa = *reinterpret_cast<const u32x4*>(q1), xb = *reinterpret_cast<const u32x4*>(q1 + 16);
                const f32x4 c0 = *reinterpret_cast<const f32x4*>(tc), c1 = *reinterpret_cast<const f32x4*>(tc + 4);
                const f32x4 s0 = *reinterpret_cast<const f32x4*>(tc + 1024), s1 = *reinterpret_cast<const f32x4*>(tc + 1028);
                const float cs[8] = {c0[0], c0[1], c0[2], c0[3], c1[0], c1[1], c1[2], c1[3]}, sn[8] = {s0[0], s0[1], s0[2], s0[3], s1[0], s1[1], s1[2], s1[3]};
                u32x4 oa, ob;
#pragma unroll
                for (int q = 0; q < 4; ++q) {
                    const float a0 = bf_lo(xa[q]), a1 = bf_hi(xa[q]), b0 = bf_lo(xb[q]), b1 = bf_hi(xb[q]);
                    oa[q] = pk_bf16(a0 * cs[2 * q] - b0 * sn[2 * q], a1 * cs[2 * q + 1] - b1 * sn[2 * q + 1]);
                    ob[q] = pk_bf16(b0 * cs[2 * q] + a0 * sn[2 * q], b1 * cs[2 * q + 1] + a1 * sn[2 * q + 1]);
                }
                *reinterpret_cast<u32x4*>(q1) = oa; *reinterpret_cast<u32x4*>(q1 + 16) = ob;
            }
        }
    }
}

__device__ __forceinline__ int lru_row(int b, int ci, int j) { return ci < 4 ? NLAT + b * LC + ci * 64 + j : b * SEQ + (ci - 4) * 64 + j; }
__device__ __forceinline__ void lru_chunk(const Params& p, int b, int blk, int ci, int mode, unsigned char* lds) {
    unsigned char* const ws = ws_();
    u16* ub = (u16*)lds;
    constexpr int SR = 132;
    float* sa = (float*)(ub + 64 * 136);
    float* sbt = sa + 64 * SR;
    float* sx = sbt + 64 * SR;
    const int t = tid_(), lane = t & 63, w = t >> 6, fr = lane & 15, fq = lane >> 4;
    const u16* P = (const u16*)(ws + WS_P);
    const u16* WT = (const u16*)(ws + WS_LRUW);
    float* SA = (float*)(ws + WS_LRUS);
    float* SH = SA + 2 * 4 * 68 * 1024;
    const int seglen = ci < 4 ? LC : SEQ, tt0 = ci < 4 ? ci * 64 : (ci - 4) * 64;
    const int rbase = ci < 4 ? NLAT + b * LC : b * SEQ;
    const int sc = t & 127, seg = t >> 7;
    const int chg_s = blk * 128 + sc;
    const int cg = blk * 128 + w * 16 + 4 * fq;
    bf16x8 wfa[2][2][4];
#pragma unroll
    for (int d2 = 0; d2 < 2; ++d2)
#pragma unroll
        for (int g2 = 0; g2 < 2; ++g2)
#pragma unroll
            for (int kk = 0; kk < 4; ++kk) wfa[d2][g2][kk] = ld_frag_g(WT + ((size_t)((d2 * 2 + g2) * 8 + blk) * 128 + w * 16 + fr) * 128 + fq * 8 + kk * 32);
    f32x4 gba[2][2], lama[2];
#pragma unroll
    for (int d2 = 0; d2 < 2; ++d2) {
        lama[d2] = *reinterpret_cast<const f32x4*>(p.lru_lambda + d2 * 1024 + cg);
#pragma unroll
        for (int g2 = 0; g2 < 2; ++g2) gba[d2][g2] = *reinterpret_cast<const f32x4*>(p.lru_gate_b + (d2 * 2 + g2) * 1024 + cg);
    }
    float carry[2] = {0.f, 0.f}; u16 grv[16];
    if (mode == 1) {
#pragma unroll
        for (int d2 = 0; d2 < 2; ++d2) carry[d2] = SH[((size_t)(d2 * 4 + b) * 68 + ci) * 1024 + chg_s];
#pragma unroll
        for (int s = 0; s < 16; ++s) grv[s] = P[(size_t)lru_row(b, ci, seg * 16 + s) * CD_IN + 2560 + chg_s];
    }
    __syncthreads();
    {
        const int c4 = (t & 31) * 4, j0 = (t >> 5) * 4, ch = blk * 128 + c4;
        float xv[7][4];
#pragma unroll
        for (int q = 0; q < 7; ++q) {
            const int tt = tt0 + j0 - 1 + q;
            if (tt >= 0 && tt < seglen) {
                const u32x2 v = *reinterpret_cast<const u32x2*>(P + (size_t)(rbase + tt) * CD_IN + 1536 + ch);
                xv[q][0] = bf_lo(v[0]); xv[q][1] = bf_hi(v[0]); xv[q][2] = bf_lo(v[1]); xv[q][3] = bf_hi(v[1]);
            } else { xv[q][0] = xv[q][1] = xv[q][2] = xv[q][3] = 0.f; }
        }
        f32x4 cw[4];
#pragma unroll
        for (int tp = 0; tp < 4; ++tp) cw[tp] = *reinterpret_cast<const f32x4*>(p.lru_conv_w + tp * 1024 + ch);
        const f32x4 cb = *reinterpret_cast<const f32x4*>(p.lru_conv_b + ch);
#pragma unroll
        for (int q = 0; q < 4; ++q) {
            float u[4];
#pragma unroll
            for (int cc = 0; cc < 4; ++cc) u[cc] = cb[cc] + xv[q][cc] * cw[0][cc] + xv[q + 1][cc] * cw[1][cc] + xv[q + 2][cc] * cw[2][cc] + xv[q + 3][cc] * cw[3][cc];
            u32x2 pk = {pk_bf16(u[0], u[1]), pk_bf16(u[2], u[3])};
            *reinterpret_cast<u32x2*>(ub + (j0 + q) * 136 + c4) = pk;
        }
    }
    __syncthreads();
    float hfw[16];
    for (int dir = 0; dir < 2; ++dir) {
        f32x4 av[4];
        {
            bf16x8 wf[4];
#pragma unroll
            for (int kk = 0; kk < 4; ++kk) wf[kk] = dir ? wfa[1][0][kk] : wfa[0][0][kk];
            const f32x4 gbv = dir ? gba[1][0] : gba[0][0];
            const f32x4 lamv = dir ? lama[1] : lama[0];
            float sp8[4];
#pragma unroll
            for (int q = 0; q < 4; ++q) { const float nl = -lamv[q]; sp8[q] = -8.f * (fmaxf(nl, 0.f) + __logf(1.f + __expf(-fabsf(nl)))); }
#pragma unroll
            for (int tt = 0; tt < 4; ++tt) {
                f32x4 z = (f32x4){0.f, 0.f, 0.f, 0.f};
#pragma unroll
                for (int kk = 0; kk < 4; ++kk) z = mfma16(wf[kk], ld_frag_s(ub + (tt * 16 + fr) * 136 + kk * 32 + fq * 8), z);
#pragma unroll
                for (int q = 0; q < 4; ++q) av[tt][q] = __expf(sigmoidf_(z[q] + gbv[q]) * sp8[q]);
            }
        }
        __syncthreads();
        {
            bf16x8 wf[4];
#pragma unroll
            for (int kk = 0; kk < 4; ++kk) wf[kk] = dir ? wfa[1][1][kk] : wfa[0][1][kk];
            const f32x4 gbv = dir ? gba[1][1] : gba[0][1];
#pragma unroll
            for (int tt = 0; tt < 4; ++tt) {
                f32x4 z = (f32x4){0.f, 0.f, 0.f, 0.f};
#pragma unroll
                for (int kk = 0; kk < 4; ++kk) z = mfma16(wf[kk], ld_frag_s(ub + (tt * 16 + fr) * 136 + kk * 32 + fq * 8), z);
                const int tj = tt * 16 + fr;
                const u32x2 uv = *reinterpret_cast<const u32x2*>(ub + tj * 136 + w * 16 + 4 * fq);
                const float u4[4] = {bf_lo(uv[0]), bf_hi(uv[0]), bf_lo(uv[1]), bf_hi(uv[1])};
                f32x4 bv;
#pragma unroll
                for (int q = 0; q < 4; ++q) { const float a = av[tt][q]; bv[q] = __builtin_amdgcn_sqrtf(fmaxf(1.f - a * a, 0.f)) * sigmoidf_(z[q] + gbv[q]) * u4[q]; }
                *reinterpret_cast<f32x4*>(sa + tj * SR + w * 16 + 4 * fq) = av[tt];
                *reinterpret_cast<f32x4*>(sbt + tj * SR + w * 16 + 4 * fq) = bv;
            }
        }
        __syncthreads();
        float A = 1.f, h = 0.f;
#pragma unroll
        for (int s = 0; s < 16; ++s) { const int j = seg * 16 + (dir ? 15 - s : s); const float a = sa[j * SR + sc]; h = a * h + sbt[j * SR + sc]; A *= a; }
        sx[(seg * 2 + 0) * 128 + sc] = A; sx[(seg * 2 + 1) * 128 + sc] = h;
        __syncthreads();
        const size_t sidx = ((size_t)(dir * 4 + b) * 68 + ci) * 1024 + chg_s;
        if (mode == 0) {
            if (seg == 0) {
                float At = 1.f, ht = 0.f;
#pragma unroll
                for (int s = 0; s < 4; ++s) { const int sg = dir ? 3 - s : s; const float a = sx[(sg * 2) * 128 + sc]; ht = a * ht + sx[(sg * 2 + 1) * 128 + sc]; At *= a; }
                SA[sidx] = At; SH[sidx] = ht;
            }
        } else {
            float hs = dir ? carry[1] : carry[0];
            const int nprev = dir ? 3 - seg : seg;
#pragma unroll
            for (int s = 0; s < 3; ++s) if (s < nprev) { const int sg = dir ? 3 - s : s; hs = sx[(sg * 2) * 128 + sc] * hs + sx[(sg * 2 + 1) * 128 + sc]; }
            u16* YIN = (u16*)(ws + WS_YIN);
            if (dir == 0) {
#pragma unroll
                for (int s = 0; s < 16; ++s) { const int j = seg * 16 + s; hs = sa[j * SR + sc] * hs + sbt[j * SR + sc]; hfw[s] = hs; }
            } else {
#pragma unroll
                for (int s = 0; s < 16; ++s) {
                    const int js = 15 - s, j = seg * 16 + js;
                    hs = sa[j * SR + sc] * hs + sbt[j * SR + sc];
                    const int row = lru_row(b, ci, j);
                    const float gr = bf2f(grv[js]);
                    const float th = 1.f - 2.f * frcp_(1.f + __expf(1.5957691216057308f * (gr + 0.044715f * gr * gr * gr)));
                    const float ge = 0.5f * gr * (1.f + th);
                    ((unsigned char*)YIN)[(size_t)row * D + 1024 + chg_s] = (unsigned char)(pk_fp8x4((hfw[js] + hs) * ge * F8_SH, 0.f, 0.f, 0.f) & 0xffu);
                }
            }
        }
    }
}

__device__ __forceinline__ void lru_prep_weights(const Params& p) {
    unsigned char* const ws = ws_();
    const int t = tid_();
    u16* WT = (u16*)(ws + WS_LRUW);
    for (int m = bid_(); m < 32; m += gdim_()) {
        const float* Wg = p.lru_gate_w + (size_t)m * 128 * 128;
        const int j4 = (t & 31) * 4, i8 = (t >> 5) * 8;
        f32x4 r8[8];
#pragma unroll
        for (int q = 0; q < 8; ++q) r8[q] = *reinterpret_cast<const f32x4*>(Wg + (size_t)(i8 + q) * 128 + j4);
#pragma unroll
        for (int jj = 0; jj < 4; ++jj) {
            u32x4 v = {pk_bf16(r8[0][jj], r8[1][jj]), pk_bf16(r8[2][jj], r8[3][jj]), pk_bf16(r8[4][jj], r8[5][jj]), pk_bf16(r8[6][jj], r8[7][jj])};
            *reinterpret_cast<u32x4*>(WT + ((size_t)m * 128 + j4 + jj) * 128 + i8) = v;
        }
    }
}
__device__ __forceinline__ void lru_carry(const Params& p, int item) {
    unsigned char* const ws = ws_();
    const int idx = item * NT + tid_();
    const int c = idx & 1023, b = (idx >> 10) & 3, dir = idx >> 12;
    float* SA = (float*)(ws + WS_LRUS);
    float* SH = SA + 2 * 4 * 68 * 1024;
    const size_t base = ((size_t)(dir * 4 + b) * 68) * 1024 + c;
    float h = 0.f;
#pragma unroll 4
    for (int s = 0; s < 68; ++s) {
        const int cj = dir == 0 ? s : (s < 4 ? 3 - s : 71 - s);
        const float a = SA[base + (size_t)cj * 1024], hl = SH[base + (size_t)cj * 1024];
        SH[base + (size_t)cj * 1024] = h;
        h = a * h + hl;
    }
}

__device__ __forceinline__ void gqa_item(const Params& p, int it, unsigned char* lds) {
    unsigned char* const ws = ws_();
    const int w = tid_() >> 6;
    const u16* P = (const u16*)(ws + WS_P);
    u16* YIN = (u16*)(ws + WS_YIN);
    const int t32 = it & 127, kvh = (it >> 7) & 3, b = it >> 9;
    const int hq = kvh * 4 + (w & 3), t0 = t32 * 32 + (w >> 2) * 16;
    const int kfirst = max((t32 * 32 - 128) & ~63, 0), klast = min(((t32 * 32 - 128) & ~63) + 256, SEQ - 64);
    const int nwin = (klast - kfirst) / 64 + 1;
    const int qrow = b * SEQ + t0;
    auto slabfn = [&](int i, const u16*& kp, const u16*& vp, size_t& kvs) {
        const int row = i < nwin ? b * SEQ + kfirst + i * 64 : NLAT + b * LC + (i - nwin) * 64;
        kp = P + (size_t)row * CD_IN + 1024 + kvh * 64; vp = P + (size_t)row * CD_IN + 1280 + kvh * 64; kvs = CD_IN; };
    auto subfn = [&](int i, int j, int& off) -> bool {
        off = 32 * j;
        if (i >= nwin) return true;
        const int k0 = kfirst + i * 64 + off;
        return k0 + 31 >= t0 - 128 && k0 <= t0 + 15 + 128; };
    auto biasfn = [&](int i, int off, int qi, int ki) -> float {
        if (i >= nwin) return 0.f;
        const int dq = (t0 + qi) - (kfirst + i * 64 + off + ki);
        return (dq > 128 || dq < -128) ? -INFINITY : 0.f; };
    const float sink = p.gqa_sink[hq];
    attn_block<64>(P + (size_t)qrow * CD_IN + hq * 64, CD_IN, nwin + 4, slabfn, subfn, biasfn, 0.125f, sink, ((tid_() & 63) >> 4) == 0 ? 1.f : 0.f, lds,
                   (u16*)((unsigned char*)YIN + (size_t)qrow * D + hq * 64), D);
}

__device__ __forceinline__ void phase_l1_stage1(const Params& p, unsigned char* lds) {
    for (int item = bid_(); item < 2176 + 2048; item += gdim_()) {
        if (item < 2176) { const int ci = item % 68, blk = (item / 68) & 7, b = item / (68 * 8); lru_chunk(p, b, blk, ci, 0, lds); }
        else rope_rows(p, (item - 2176) * 8, 8);
    }
}
__device__ __forceinline__ void phase_l1_stage2(const Params& p, unsigned char* lds) {
    for (int item = bid_(); item < 16 + 2048; item += gdim_()) {
        if (item < 16) lru_carry(p, item);
        else gqa_item(p, item - 16, lds);
    }
}
__device__ __forceinline__ void phase_l1_stage3(const Params& p, unsigned char* lds) {
    for (int item = bid_(); item < 2048; item += gdim_()) { const int cl = item & 63, blk = (item >> 6) & 7, b = item >> 9; lru_chunk(p, b, blk, cl + 4, 1, lds); }
}

__device__ __forceinline__ void phase_rowpass_mid(const Params& p, int l, unsigned char* lds) {
    unsigned char* const ws = ws_();
    float* R = (float*)lds;
    const int t = tid_(), lane = t & 63, w = t >> 6;
    const int nrows = l == 0 ? NTOK : NLAT;
    __syncthreads();
    constexpr int RS = D + 4;
    for (int i = t; i < D * NEXP; i += NT) { const int k = i >> 4, e = i & 15; R[e * RS + k] = p.moe_router[(size_t)l * D * NEXP + i]; }
    __syncthreads();
    const u16* Y = (const u16*)(ws + WS_Y);
    u16* XL1 = (u16*)(ws + WS_XL1);
    u16* H = (u16*)(ws + WS_H);
    float* AFF = (float*)(ws + WS_AFF);
    u32x2 yq[8]; f32x4 xq[8]; u32x2 xq2[8];
    const int rstride = gdim_() * 8;
    int row = bid_() * 8 + w;
#define RP_FETCH(ROW) do { const int _rw = (ROW); \
        _Pragma("unroll") for (int i = 0; i < 8; ++i) yq[i] = __builtin_nontemporal_load(reinterpret_cast<const u32x2*>(Y + (size_t)_rw * D + (i * 64 + lane) * 4)); \
        if (l == 0) { const float* _xr = xin_row(p, _rw); _Pragma("unroll") for (int i = 0; i < 8; ++i) xq[i] = __builtin_nontemporal_load(reinterpret_cast<const f32x4*>(_xr + (i * 64 + lane) * 4)); } \
        else { const u16* _xb = (const u16*)(ws + WS_XL2) + (size_t)_rw * D; _Pragma("unroll") for (int i = 0; i < 8; ++i) xq2[i] = __builtin_nontemporal_load(reinterpret_cast<const u32x2*>(_xb + (i * 64 + lane) * 4)); } } while (0)
    if (row < nrows) RP_FETCH(row);
    for (; row < nrows; row += rstride) {
        f32x4 v[8]; float ss = 0.f;
#pragma unroll
        for (int i = 0; i < 8; ++i) { const u32x2 q = yq[i]; v[i] = (f32x4){bf_lo(q[0]), bf_hi(q[0]), bf_lo(q[1]), bf_hi(q[1])}; ss += v[i][0] * v[i][0] + v[i][1] * v[i][1] + v[i][2] * v[i][2] + v[i][3] * v[i][3]; }
        ss = wave_sum(ss);
        const float rstd = rsqrtf(ss * (1.f / D) + 1e-6f);
        const float* g1 = mod_ptr(ws, l, row, 2);
        const float* nw = p.norm_mix_post + (size_t)l * D;
        float ss1 = 0.f;
#pragma unroll
        for (int i = 0; i < 8; ++i) {
            const int col = (i * 64 + lane) * 4;
            f32x4 x4;
            if (l == 0) x4 = xq[i];
            else { const u32x2 q = xq2[i]; x4 = (f32x4){bf_lo(q[0]), bf_hi(q[0]), bf_lo(q[1]), bf_hi(q[1])}; }
            const f32x4 w4 = *reinterpret_cast<const f32x4*>(nw + col), g4 = *reinterpret_cast<const f32x4*>(g1 + col);
            const f32x4 x1 = x4 + g4 * (v[i] * rstd * w4);
            { const u32x2 pk1 = {pk_bf16(x1[0], x1[1]), pk_bf16(x1[2], x1[3])}; *reinterpret_cast<u32x2*>(XL1 + (size_t)row * D + col) = pk1; }
            v[i] = x1; ss1 += x1[0] * x1[0] + x1[1] * x1[1] + x1[2] * x1[2] + x1[3] * x1[3];
        }
        __builtin_amdgcn_sched_barrier(0);
        if (row + rstride < nrows) RP_FETCH(row + rstride);
        __builtin_amdgcn_sched_barrier(0);
        ss1 = wave_sum(ss1);
        const float rstd1 = rsqrtf(ss1 * (1.f / D) + 1e-6f);
        const float* sh = mod_ptr(ws, l, row, 3); const float* sc = mod_ptr(ws, l, row, 4);
        const float* nw2 = p.norm_ffn_pre + (size_t)l * D;
#pragma unroll
        for (int i = 0; i < 8; ++i) {
            const int col = (i * 64 + lane) * 4;
            const f32x4 w4 = *reinterpret_cast<const f32x4*>(nw2 + col), s4 = *reinterpret_cast<const f32x4*>(sc + col), h4 = *reinterpret_cast<const f32x4*>(sh + col);
            const f32x4 o = v[i] * rstd1 * w4 * (s4 + 1.f) + h4;
            *reinterpret_cast<unsigned*>((unsigned char*)H + (size_t)row * D + col) = pk_fp8x4(o[0] * F8_SH, o[1] * F8_SH, o[2] * F8_SH, o[3] * F8_SH);
            v[i] = o;
        }
        float lg[16];
        rowdot16(v, R, lane, lg);
        const bool b5 = lane & 32, b4 = lane & 16, b3 = lane & 8, b2 = lane & 4;
        float t8[8], t4[4], t2[2], lgt;
#pragma unroll
        for (int j = 0; j < 8; ++j) { const float keep = b5 ? lg[8 + j] : lg[j], send = b5 ? lg[j] : lg[8 + j]; t8[j] = keep + partner_x32(send); }
#pragma unroll
        for (int j = 0; j < 4; ++j) { const float keep = b4 ? t8[4 + j] : t8[j], send = b4 ? t8[j] : t8[4 + j]; t4[j] = keep + partner_x16(send); }
#pragma unroll
        for (int j = 0; j < 2; ++j) { const float keep = b3 ? t4[2 + j] : t4[j], send = b3 ? t4[j] : t4[2 + j]; t2[j] = keep + dpp_f<0x140>(send); }
        { const float keep = b2 ? t2[1] : t2[0], send = b2 ? t2[0] : t2[1]; lgt = keep + dpp_f<0x141>(send); }
        lgt += dpp_f<0x4E>(lgt); lgt += dpp_f<0xB1>(lgt);
        const float mx = wave_max(lgt);
        const float pe = __expf(lgt - mx);
        const float den = wave_sum(pe) * 0.25f;
        if ((lane & 3) == 0) AFF[(size_t)row * 16 + ((b5 ? 8 : 0) + (b4 ? 4 : 0) + (b3 ? 2 : 0) + (b2 ? 1 : 0))] = pe / den;
    }
#undef RP_FETCH
}

__device__ __forceinline__ void phase_topk(const Params& p, int l, unsigned char* lds) {
    unsigned char* const ws = ws_();
    unsigned* keys = (unsigned*)lds;
    unsigned* hist = keys + 4096;
    unsigned* misc = hist + 256;
    const int t = tid_(), lane = t & 63, w = t >> 6;
    const float* AFF = (const float*)(ws + WS_AFF);
    int* SLOT = (int*)(ws + WS_SLOT);
    int* EROW = (int*)(ws + WS_EROW);
    float* EGATE = (float*)(ws + WS_EGATE);
    const int nitems = l == 0 ? 128 : 64;
    for (int item = bid_(); item < nitems; item += gdim_()) {
        const int kind = item >> 6, b = (item >> 4) & 3, ex = item & 15;
        const int n = kind ? LC : SEQ, cap = n / 8, rowbase = kind ? NLAT + b * LC : b * SEQ;
        __syncthreads();
        for (int i = t; i < n; i += NT) keys[i] = __float_as_uint(AFF[(size_t)(rowbase + i) * 16 + ex]);
        unsigned prefix = 0u, mask = 0u; int kth = cap;
        for (int shift = 24; shift >= 0; shift -= 8) {
            __syncthreads();
            if (t < 256) hist[t] = 0u;
            __syncthreads();
            for (int i = t; i < n; i += NT) { const unsigned k = keys[i]; if ((k & mask) == prefix) atomicAdd(&hist[(k >> shift) & 255u], 1u); }
            __syncthreads();
            if (t < 256) {
                unsigned above = 0u;
                for (int d2 = t + 1; d2 < 256; ++d2) above += hist[d2];
                const unsigned here = hist[t];
                if ((int)above < kth && (int)(above + here) >= kth) { misc[0] = (unsigned)t; misc[1] = (unsigned)(kth - (int)above); }
            }
            __syncthreads();
            prefix |= misc[0] << shift; mask |= 255u << shift; kth = (int)misc[1];
        }
        const unsigned T = prefix; const int need_eq = kth;
        int cgt = 0, ceq = 0;
        const int base = t * 8;
        if (base < n) {
#pragma unroll
            for (int q = 0; q < 8; ++q) { const unsigned k = keys[base + q]; cgt += (k > T); ceq += (k == T); }
        }
        int packed = cgt | (ceq << 16);
        int incl = packed;
#pragma unroll
        for (int o = 1; o < 64; o <<= 1) { const int nb = __shfl_up(incl, o, 64); if (lane >= o) incl += nb; }
        __syncthreads();
        if (lane == 63) misc[8 + w] = (unsigned)incl;
        __syncthreads();
        int woff = 0, total = 0;
#pragma unroll
        for (int q = 0; q < 8; ++q) { const int v = (int)misc[8 + q]; if (q < w) woff += v; total += v; }
        const int excl = woff + incl - packed;
        int pgt = excl & 0xffff, peq = excl >> 16;
        const int tot_gt = total & 0xffff;
        const int sbase = kind ? 2048 + b * 32 : b * 512;
        if (base < n) {
#pragma unroll
            for (int q = 0; q < 8; ++q) {
                const unsigned k = keys[base + q];
                const int row = rowbase + base + q;
                int pos = -1;
                if (k > T) { pos = pgt; ++pgt; }
                else if (k == T) { if (peq < need_eq) pos = tot_gt + peq; ++peq; }
                if (pos >= 0) { const int sl = sbase + pos; EROW[ex * EPAD + sl] = row; EGATE[ex * EPAD + sl] = __uint_as_float(k); SLOT[(size_t)row * 16 + ex] = sl; }
                else SLOT[(size_t)row * 16 + ex] = -1;
            }
        }
        if (kind == 1 && b == 3) for (int i = t; i < EPAD - 2176; i += NT) EROW[ex * EPAD + 2176 + i] = rowbase;
    }
}

__device__ __forceinline__ void phase_final(const Params& p, int l) {
    unsigned char* const ws = ws_();
    const int lane = tid_() & 63, w = __builtin_amdgcn_readfirstlane(tid_() >> 6);
    const int nrows = l == 0 ? NTOK : NLAT;
    const u16* YEXP = (const u16*)(ws + WS_YEXP);
    const int* SLOT = (const int*)(ws + WS_SLOT);
    const u16* XL1 = (const u16*)(ws + WS_XL1);
    u16* XL2 = (u16*)(ws + WS_XL2);
    u16* H = (u16*)(ws + WS_H);
    const int stride = gdim_() * 8;
    struct Pre { u32x2 xl[8], q0[8], q1[8]; };
    auto slots_of = [&](int row) -> int { const int s = SLOT[(size_t)min(row, nrows - 1) * 16 + (lane & 15)]; return (row < nrows && lane < 16) ? s : -1; };
    auto prefetch = [&](int row, int myslot, Pre& pr) {
        const int rc = min(row, nrows - 1);
        unsigned long long em = __ballot(myslot >= 0);
        const int e0 = em ? __builtin_ctzll(em) : 0; em &= em - 1;
        const int e1 = em ? __builtin_ctzll(em) : e0;
        const int sl0 = max(__shfl(myslot, e0, 64), 0), sl1 = max(__shfl(myslot, e1, 64), 0);
        const u16* y0 = YEXP + ((size_t)e0 * EPAD + sl0) * D; const u16* y1 = YEXP + ((size_t)e1 * EPAD + sl1) * D;
#pragma unroll
        for (int i = 0; i < 8; ++i) pr.xl[i] = __builtin_nontemporal_load(reinterpret_cast<const u32x2*>(XL1 + (size_t)rc * D + (i * 64 + lane) * 4));
#pragma unroll
        for (int i = 0; i < 8; ++i) { pr.q0[i] = __builtin_nontemporal_load(reinterpret_cast<const u32x2*>(y0 + (i * 64 + lane) * 4)); pr.q1[i] = __builtin_nontemporal_load(reinterpret_cast<const u32x2*>(y1 + (i * 64 + lane) * 4)); }
    };
    int row = bid_() * 8 + w;
    int slot_c = slots_of(row), slot_n = slots_of(row + stride);
    Pre cur; prefetch(row, slot_c, cur);
    for (; row < nrows; row += stride) {
        const int slot_nn = slots_of(row + 2 * stride);
        Pre nxt; prefetch(row + stride, slot_n, nxt);
        f32x4 v[8];
#pragma unroll
        for (int i = 0; i < 8; ++i) v[i] = (f32x4){0.f, 0.f, 0.f, 0.f};
        unsigned long long em = __ballot(slot_c >= 0);
        if (em) {
            em &= em - 1;
            const float f1 = em ? 1.f : 0.f;
            if (em) em &= em - 1;
#pragma unroll
            for (int i = 0; i < 8; ++i) {
                v[i][0] = bf_lo(cur.q0[i][0]) + f1 * bf_lo(cur.q1[i][0]); v[i][1] = bf_hi(cur.q0[i][0]) + f1 * bf_hi(cur.q1[i][0]);
                v[i][2] = bf_lo(cur.q0[i][1]) + f1 * bf_lo(cur.q1[i][1]); v[i][3] = bf_hi(cur.q0[i][1]) + f1 * bf_hi(cur.q1[i][1]);
            }
        }
        while (em) {
            const int e0 = __builtin_ctzll(em); em &= em - 1;
            const int sl0 = __shfl(slot_c, e0, 64);
            const u16* y0 = YEXP + ((size_t)e0 * EPAD + sl0) * D;
#pragma unroll
            for (int i = 0; i < 8; ++i) { const u32x2 q = *reinterpret_cast<const u32x2*>(y0 + (i * 64 + lane) * 4); v[i][0] += bf_lo(q[0]); v[i][1] += bf_hi(q[0]); v[i][2] += bf_lo(q[1]); v[i][3] += bf_hi(q[1]); }
        }
        float ss = 0.f;
#pragma unroll
        for (int i = 0; i < 8; ++i) ss += v[i][0] * v[i][0] + v[i][1] * v[i][1] + v[i][2] * v[i][2] + v[i][3] * v[i][3];
        ss = wave_sum(ss);
        const float rstd = rsqrtf(ss * (1.f / D) + 1e-6f);
        const float* g2 = mod_ptr(ws, l, row, 5);
        const float* nw = p.norm_ffn_post + (size_t)l * D;
        float ss2 = 0.f;
#pragma unroll
        for (int i = 0; i < 8; ++i) {
            const int col = (i * 64 + lane) * 4;
            const f32x4 x4 = {bf_lo(cur.xl[i][0]), bf_hi(cur.xl[i][0]), bf_lo(cur.xl[i][1]), bf_hi(cur.xl[i][1])};
            const f32x4 w4 = *reinterpret_cast<const f32x4*>(nw + col), g4 = *reinterpret_cast<const f32x4*>(g2 + col);
            const f32x4 x2 = x4 + g4 * (v[i] * rstd * w4);
            if (l == 0) { const u32x2 pk2 = {pk_bf16(x2[0], x2[1]), pk_bf16(x2[2], x2[3])}; *reinterpret_cast<u32x2*>(XL2 + (size_t)row * D + col) = pk2; }
            else *reinterpret_cast<f32x4*>(p.out + (size_t)row * D + col) = x2;
            v[i] = x2; ss2 += x2[0] * x2[0] + x2[1] * x2[1] + x2[2] * x2[2] + x2[3] * x2[3];
        }
        if (l == 0) {
            ss2 = wave_sum(ss2);
            const float rstd2 = rsqrtf(ss2 * (1.f / D) + 1e-6f);
            const float* sh = mod_ptr(ws, 1, row, 0); const float* sc = mod_ptr(ws, 1, row, 1);
            const float* nw1 = p.norm_mix_pre + D;
#pragma unroll
            for (int i = 0; i < 8; ++i) {
                const int col = (i * 64 + lane) * 4;
                const f32x4 w4 = *reinterpret_cast<const f32x4*>(nw1 + col), s4 = *reinterpret_cast<const f32x4*>(sc + col), h4 = *reinterpret_cast<const f32x4*>(sh + col);
                const f32x4 o = v[i] * rstd2 * w4 * (s4 + 1.f) + h4;
                if (WIN_F8_L1) *reinterpret_cast<unsigned*>((unsigned char*)H + (size_t)row * D + col) = pk_fp8x4(o[0] * F8_SH, o[1] * F8_SH, o[2] * F8_SH, o[3] * F8_SH);
                else { const u32x2 pk = {pk_bf16(o[0], o[1]), pk_bf16(o[2], o[3])}; *reinterpret_cast<u32x2*>(H + (size_t)row * D + col) = pk; }
            }
        }
        cur = nxt; slot_c = slot_n; slot_n = slot_nn;
    }
}

__global__ void __launch_bounds__(NT, 2) fwd_kernel(Params p) {
    unsigned char* lds = g_lds;
    unsigned char* wlds = lds + 512;
    if (threadIdx.x == 0) { *reinterpret_cast<uint4*>(lds) = make_uint4(0u, 0u, 0u, 0u); ((volatile LAS int*)(g_lds))[4] = (int)blockIdx.x; ((volatile LAS int*)(g_lds))[5] = (int)gridDim.x; *(volatile LAS unsigned long long*)((LAS unsigned char*)(g_lds) + 24) = (unsigned long long)p.ws; }
    if ((threadIdx.x & 63) == 0) ((volatile LAS int*)(g_lds))[8 + hw_slot_()] = threadIdx.x >> 6;
    __syncthreads();
    (void)xcd_barrier_post((unsigned*)(ws_() + WS_BAR), (volatile LAS unsigned*)lds);
#define GRID_BARRIER() do { XcdBarrier _b; _b.bar = (unsigned*)(ws_() + WS_BAR); _b.x = xb_xcc_id(); _b.st = (volatile LAS unsigned*)lds; xcd_barrier(_b); } while (0)
#ifndef PH_MASK
#define PH_MASK 0xFFFFFFFFu
#endif
#ifndef PROBE_REP_MASK
#define PROBE_REP_MASK 0u
#endif
#define PHASE(id, body) do { if (((PH_MASK >> ((id) % 32)) & 1u) && p.ph_lo <= (id) && (id) < p.ph_hi) { \
    for (int _r = 0; _r < ((((unsigned)PROBE_REP_MASK >> ((id) % 32)) & 1u) ? 2 : 1); ++_r) { body; if ((id) + 1 < p.ph_hi || _r == 0) { if ((id) + 1 < p.ph_hi) GRID_BARRIER(); } } } } while (0)
    PHASE(0, { phase_mod(p, wlds); phase_convert_dense(p, wlds); });
    PHASE(1, { phase_norm_mod(p, 0, wlds); lru_prep_weights(p); rope_prep(p); });
    {
        constexpr int l = 0, pb = 2;
        if (WIN_F8_L0 && WIN_L0_BF16_COLS) {
            PHASE(pb + 0, { phase_gemm_dense<false>(p, (const u16*)(ws_() + WS_H), NTOK, (const u16*)(ws_() + WS_WT_ABIN), WIN_L0_BF16_COLS, (u16*)(ws_() + WS_P), AB_IN, nullptr, wlds);
                            phase_gemm_dense_f8rev(p, (const u16*)(ws_() + WS_H8), NTOK, (const u16*)(ws_() + WS_WT_ABIN8 + (size_t)WIN_L0_BF16_COLS * D), AB_IN - WIN_L0_BF16_COLS,
                                                   (u16*)(ws_() + WS_P) + WIN_L0_BF16_COLS, AB_IN, wlds); });
        } else
        PHASE(pb + 0, phase_gemm_dense<WIN_F8_L0>(p, (const u16*)(ws_() + WS_H), NTOK, (const u16*)(ws_() + WS_WT_ABIN), AB_IN, (u16*)(ws_() + WS_P), AB_IN, nullptr, wlds));
        PHASE(pb + 1, phase_mlstm(p, wlds));
        PHASE(pb + 2, phase_l0_stage2(p, wlds));
        PHASE(pb + 4, phase_gemm_dense<true>(p, (const u16*)(ws_() + WS_YIN), NTOK, (const u16*)(ws_() + WS_WT_ABOUT), D, (u16*)(ws_() + WS_Y), D, nullptr, wlds));
        PHASE(pb + 5, phase_rowpass_mid(p, l, wlds));
        PHASE(pb + 6, { phase_topk(p, l, wlds); phase_convert_moe(p, l, wlds); });
        PHASE(pb + 7, phase_moe_a(p, l, wlds));
        PHASE(pb + 8, phase_moe_b(p, l, wlds));
        PHASE(pb + 9, phase_final(p, l));
    }
    {
        constexpr int l = 1, pb = 12;
        PHASE(pb + 0, phase_gemm_dense<WIN_F8_L1>(p, (const u16*)(ws_() + WS_H), NTOK, (const u16*)(ws_() + WS_WT_CDIN), CD_IN, (u16*)(ws_() + WS_P), CD_IN, nullptr, wlds));
        PHASE(pb + 1, phase_l1_stage1(p, wlds));
        PHASE(pb + 2, phase_l1_stage2(p, wlds));
        PHASE(pb + 3, phase_l1_stage3(p, wlds));
        PHASE(pb + 4, phase_gemm_dense<true>(p, (const u16*)(ws_() + WS_YIN), NLAT, (const u16*)(ws_() + WS_WT_CDOUT), D, (u16*)(ws_() + WS_Y), D, nullptr, wlds));
        PHASE(pb + 5, phase_rowpass_mid(p, l, wlds));
        PHASE(pb + 6, { phase_topk(p, l, wlds); phase_convert_moe(p, l, wlds); });
        PHASE(pb + 7, phase_moe_a(p, l, wlds));
        PHASE(pb + 8, phase_moe_b(p, l, wlds));
        PHASE(pb + 9, phase_final(p, l));
    }
}


#ifdef DBG_STOP
__global__ void dbg_digest(const unsigned char* ws, size_t off, int kind, size_t nelem, float* out, size_t nout) {
    for (size_t i = (size_t)blockIdx.x * blockDim.x + threadIdx.x; i < nout; i += (size_t)gridDim.x * blockDim.x) {
        float v = 0.f;
        for (size_t j = i; j < nelem; j += nout) {
            if (kind == 0) v += bf2f(((const u16*)(ws + off))[j]);
            else if (kind == 1) v += ((const float*)(ws + off))[j];
            else v += (float)((const int*)(ws + off))[j];
        }
        out[i] = v;
    }
}
#endif
extern "C" void kernel_launch(void* const* d_in, const int* in_sizes, int n_in, void* d_out, int out_size, void* d_ws, size_t ws_size, hipStream_t stream) {
    static int grid = 0;
    if (grid == 0) {
        if (n_in != 27 || ws_size < WS_END) { fprintf(stderr, "kernel_launch: unexpected n_in %d / ws %zu (need %zu)\n", n_in, ws_size, (size_t)WS_END); grid = -1; return; }
        int dev = 0, cus = 0, per_cu = 0;
        hipGetDevice(&dev);
        hipDeviceGetAttribute(&cus, hipDeviceAttributeMultiprocessorCount, dev);
        if (hipFuncSetAttribute((const void*)fwd_kernel, hipFuncAttributeMaxDynamicSharedMemorySize, LDS_BYTES) != hipSuccess) { fprintf(stderr, "kernel_launch: hipFuncSetAttribute failed\n"); grid = -1; return; }
        hipOccupancyMaxActiveBlocksPerMultiprocessor(&per_cu, (const void*)fwd_kernel, NT, LDS_BYTES);
        (void)hipGetLastError();
        if (per_cu < 1) fprintf(stderr, "kernel_launch: occupancy query reports %d blocks per CU\n", per_cu);
        grid = cus > 0 ? cus : 256;
    }
    if (grid < 0) return;
    hipMemsetAsync((char*)d_ws + WS_BAR, 0, XCD_BAR_WORDS * sizeof(unsigned), stream);
    Params p; memset(&p, 0, sizeof(p));
    const float** f = (const float**)&p;
    for (int i = 0; i < 27; ++i) f[i] = (const float*)d_in[i];
    p.out = (float*)d_out; p.ws = (unsigned char*)d_ws;
#if N_LAUNCH_MODE == 1
    p.ph_lo = 0; p.ph_hi = NPH;
    hipLaunchKernelGGL(fwd_kernel, dim3(grid), dim3(NT), LDS_BYTES, stream, p);
#else
#ifdef DBG_STOP
    for (int ph = 0; ph <= DBG_STOP; ++ph) { p.ph_lo = ph; p.ph_hi = ph + 1; hipLaunchKernelGGL(fwd_kernel, dim3(grid), dim3(NT), LDS_BYTES, stream, p); }
    hipLaunchKernelGGL(dbg_digest, dim3(2048), dim3(256), 0, stream, (const unsigned char*)d_ws, (size_t)DBG_OFF, (int)DBG_KIND, (size_t)DBG_NELEM, (float*)d_out, (size_t)out_size);
#else
    for (int ph = 0; ph < NPH; ++ph) { p.ph_lo = ph; p.ph_hi = ph + 1; hipLaunchKernelGGL(fwd_kernel, dim3(grid), dim3(NT), LDS_BYTES, stream, p); }
#endif
#endif
}
```

```cpp
#include <hip/hip_runtime.h>
#include <stdint.h>
#include <stdio.h>
#include <string.h>

#ifndef N_LAUNCH_MODE
#define N_LAUNCH_MODE 1
#endif

typedef unsigned short u16;
typedef short bf16x8 __attribute__((ext_vector_type(8)));
typedef float f32x4 __attribute__((ext_vector_type(4)));
typedef unsigned u32x4 __attribute__((ext_vector_type(4)));
typedef unsigned u32x2 __attribute__((ext_vector_type(2)));

#define NT 512
constexpr int D = 2048, BATCH = 4, SEQ = 4096, LC = 256;
constexpr int NLAT = BATCH * SEQ, NCTX = BATCH * LC, NTOK = NLAT + NCTX;
constexpr int AB_IN = 7184, CD_IN = 3584;
constexpr int NEXP = 16, FF = 2048, EPAD = 2304;
constexpr int NPH = 22;
constexpr int LDS_BYTES = 150 * 1024;

constexpr bool WIN_F8_L0 = true, WIN_F8_L1 = true;
constexpr int WIN_L0_BF16_COLS = 0;
constexpr size_t al256(size_t x) { return (x + 255) & ~(size_t)255; }
constexpr size_t WS_BAR = 0;
constexpr size_t WS_MOD = 16384;
constexpr size_t WS_XL1 = al256(WS_MOD + 2 * 5 * 12288 * 4);
constexpr size_t WS_XL2 = al256(WS_XL1 + (size_t)NTOK * D * 4);
constexpr size_t WS_H = al256(WS_XL2 + (size_t)NTOK * D * 4);
constexpr size_t WS_P = al256(WS_H + (size_t)NTOK * D * 2);
constexpr size_t WS_G = al256(WS_P + (size_t)NTOK * AB_IN * 2);
constexpr size_t WS_HM = al256(WS_G + (size_t)NTOK * 16 * 4);
constexpr size_t WS_YIN = al256(WS_HM + (size_t)2 * NTOK * 1024 * 2);
constexpr size_t WS_Y = al256(WS_YIN + (size_t)NTOK * D * 2);
constexpr size_t WS_AFF = al256(WS_Y + (size_t)NTOK * D * 4);
constexpr size_t WS_SLOT = al256(WS_AFF + (size_t)NTOK * 16 * 4);
constexpr size_t WS_EROW = al256(WS_SLOT + (size_t)NTOK * 16 * 4);
constexpr size_t WS_EGATE = al256(WS_EROW + (size_t)NEXP * EPAD * 4);
constexpr size_t WS_ACT = al256(WS_EGATE + (size_t)NEXP * EPAD * 4);
constexpr size_t WS_YEXP = al256(WS_ACT + (size_t)NEXP * EPAD * FF * 2);
constexpr size_t WS_LRUS = al256(WS_YEXP + (size_t)NEXP * EPAD * D * 2);
constexpr size_t WS_LRUW = al256(WS_LRUS + (size_t)2 * 2 * 4 * 68 * 1024 * 4);
constexpr size_t WS_WT_ABIN = al256(WS_LRUW + (size_t)32 * 128 * 128 * 2);
constexpr size_t WS_WT_ABIN8 = WS_WT_ABIN + (size_t)WIN_L0_BF16_COLS * D;
constexpr size_t WS_WT_ABOUT = al256(WS_WT_ABIN + (size_t)AB_IN * D * 2);
constexpr size_t WS_WT_CDIN = al256(WS_WT_ABOUT + (size_t)D * D * 2);
constexpr size_t WS_WT_CDOUT = al256(WS_WT_CDIN + (size_t)CD_IN * D * 2);
constexpr size_t WS_WT_W1 = al256(WS_WT_CDOUT + (size_t)D * D * 2);
constexpr size_t WS_WT_W3 = al256(WS_WT_W1 + (size_t)NEXP * D * FF * 2);
constexpr size_t WS_WT_W2 = al256(WS_WT_W3 + (size_t)NEXP * D * FF * 2);
constexpr size_t WS_H8 = al256(WS_WT_W2 + (size_t)NEXP * D * FF * 2);
constexpr size_t WS_ROPE = al256(WS_H8 + (size_t)NTOK * D);
constexpr size_t WS_END = al256(WS_ROPE + 2 * 64 * 16 * 4);

extern __shared__ __attribute__((aligned(16))) unsigned char g_lds[];

struct Params {
    const float *x, *c, *ctx, *c_ctx, *ada_w, *ada_b, *norm_mix_pre, *norm_mix_post, *norm_ffn_pre, *norm_ffn_post;
    const float *ab_w_in, *ab_w_out, *mlstm_gate_b, *mlstm_norm, *na_rpb;
    const float *cd_w_in, *cd_w_out, *gqa_sink, *lru_conv_w, *lru_conv_b, *lru_gate_w, *lru_gate_b, *lru_lambda;
    const float *moe_router, *moe_w1, *moe_w3, *moe_w2;
    float* out;
    unsigned char* ws;
    int ph_lo, ph_hi;
};

#define XB_TMO      128
#define XB_XCNT(j)  (256  + 64 * (j))
#define XB_XSUB(j)  (1280 + 64 * (j))
#define XB_XGEN(j)  (2304 + 64 * (j))
#define XB_TOP      3328
#define XB_TOPGEN   3392
#define XCD_BAR_WORDS 3456
#define XB_SPIN_CAP (1u << 22)
#define LAS __attribute__((address_space(3)))

__device__ __forceinline__ unsigned xb_ld(unsigned* p)              { return __hip_atomic_load(p, __ATOMIC_RELAXED, __HIP_MEMORY_SCOPE_AGENT); }
__device__ __forceinline__ unsigned xb_add(unsigned* p, unsigned v) { return __hip_atomic_fetch_add(p, v, __ATOMIC_RELAXED, __HIP_MEMORY_SCOPE_AGENT); }
__device__ __forceinline__ unsigned xb_xcc_id() { return (unsigned)__builtin_amdgcn_s_getreg((3 << 11) | 20) & 0xFu; }
#define XB_SPIN(cond, bar) do { unsigned _sp = 0; while (cond) { __builtin_amdgcn_s_sleep(1); \
    if ((++_sp & 255u) == 0u) { if (xb_ld(&(bar)[XB_TMO])) break; if (_sp > XB_SPIN_CAP) { atomicAdd(&(bar)[XB_TMO], 1u); break; } } } } while (0)

struct XcdBarrier {
    unsigned* bar; unsigned x;
    volatile LAS unsigned* st;
};
__device__ __forceinline__ XcdBarrier xcd_barrier_post(unsigned* bar, volatile LAS unsigned* st) {
    XcdBarrier b; b.bar = bar; b.x = xb_xcc_id(); b.st = st;
    if (threadIdx.x == 0) (void)xb_add(&bar[XB_XCNT(b.x)], 1u);
    return b;
}
__device__ __forceinline__ void xcd_barrier_complete(unsigned* bar, unsigned x, unsigned& nloc, unsigned& nx) {
    const unsigned G = gridDim.x * gridDim.y * gridDim.z;
    unsigned sum, cnt, mine, sp = 0u;
    for (;;) {
        sum = 0u; cnt = 0u; mine = 0u;
#pragma unroll
        for (unsigned j = 0; j < 16; ++j) { const unsigned c = xb_ld(&bar[XB_XCNT(j)]); sum += c; cnt += (c > 0u) ? 1u : 0u; mine = (j == x) ? c : mine; }
        if (sum == G) break;
        __builtin_amdgcn_s_sleep(1);
        if ((++sp & 255u) == 0u) { if (xb_ld(&bar[XB_TMO])) break; if (sp > XB_SPIN_CAP) { atomicAdd(&bar[XB_TMO], 1u); break; } }
    }
    nloc = mine > 0u ? mine : 1u; nx = cnt > 0u ? cnt : 1u;
}
__device__ __forceinline__ void xcd_barrier(const XcdBarrier& b) {
    asm volatile("s_waitcnt vmcnt(0)" ::: "memory");
    __syncthreads();
    if (threadIdx.x == 0) {
        unsigned* bar = b.bar;
        __builtin_amdgcn_s_waitcnt(0);
        unsigned nloc = b.st[0], nx = b.st[1];
        if (nloc == 0u) { xcd_barrier_complete(bar, b.x, nloc, nx); b.st[0] = nloc; b.st[1] = nx; }
        const unsigned old = xb_add(&bar[XB_XSUB(b.x)], 1u);
        const unsigned gen = old / nloc;
        if (old + 1u == (gen + 1u) * nloc) {
            __builtin_amdgcn_fence(__ATOMIC_RELEASE, "agent");
            asm volatile("s_waitcnt vmcnt(0)" ::: "memory");
            const unsigned og = xb_add(&bar[XB_TOP], 1u);
            const unsigned tg = og / nx;
            if (og + 1u == (tg + 1u) * nx) xb_add(&bar[XB_TOPGEN], 1u);
            else XB_SPIN(xb_ld(&bar[XB_TOPGEN]) == tg, bar);
            __builtin_amdgcn_fence(__ATOMIC_ACQUIRE, "agent");
            xb_add(&bar[XB_XGEN(b.x)], 1u);
            asm volatile("s_waitcnt vmcnt(0)" ::: "memory");
        } else {
            XB_SPIN(xb_ld(&bar[XB_XGEN(b.x)]) == gen, bar);
            __builtin_amdgcn_fence(__ATOMIC_ACQUIRE, "agent");
            asm volatile("s_waitcnt vmcnt(0)" ::: "memory");
        }
    }
    __syncthreads();
}

typedef float f32x2_t __attribute__((ext_vector_type(2)));
typedef __bf16 bf16x2_t __attribute__((ext_vector_type(2)));
__device__ __forceinline__ unsigned pk_bf16(float lo, float hi) { f32x2_t v = {lo, hi}; return __builtin_bit_cast(unsigned, __builtin_convertvector(v, bf16x2_t)); }
__device__ __forceinline__ float bf_lo(unsigned u) { return __uint_as_float(u << 16); }
__device__ __forceinline__ float bf_hi(unsigned u) { return __uint_as_float(u & 0xffff0000u); }
__device__ __forceinline__ float bf2f(u16 v) { return __uint_as_float(((unsigned)v) << 16); }
typedef int i32x4 __attribute__((ext_vector_type(4)));
typedef int i32x8 __attribute__((ext_vector_type(8)));
constexpr float F8_SW = 256.f, F8_SH = 8.f, F8_SA = 4.f;
__device__ __forceinline__ float f8_clamp(float x) { return __builtin_amdgcn_fmed3f(x, -448.f, 448.f); }
__device__ __forceinline__ unsigned pk_fp8x4(float a, float b, float c, float d) {
    unsigned r = 0u;
    r = (unsigned)__builtin_amdgcn_cvt_pk_fp8_f32(f8_clamp(a), f8_clamp(b), (int)r, false);
    r = (unsigned)__builtin_amdgcn_cvt_pk_fp8_f32(f8_clamp(c), f8_clamp(d), (int)r, true);
    return r; }
__device__ __forceinline__ i32x8 cat8(bf16x8 lo, bf16x8 hi) { return __builtin_shufflevector(__builtin_bit_cast(i32x4, lo), __builtin_bit_cast(i32x4, hi), 0, 1, 2, 3, 4, 5, 6, 7); }
__device__ __forceinline__ u16 f2bf(float f) { return (u16)(pk_bf16(f, 0.f) & 0xffffu); }
template <int CTRL> __device__ __forceinline__ float dpp_f(float v) { return __uint_as_float((unsigned)__builtin_amdgcn_update_dpp(0, (int)__float_as_uint(v), CTRL, 0xf, 0xf, true)); }
__device__ __forceinline__ float row_sum16(float v) { v += dpp_f<0xB1>(v); v += dpp_f<0x4E>(v); v += dpp_f<0x141>(v); v += dpp_f<0x140>(v); return v; }
__device__ __forceinline__ float row_max16(float v) { v = fmaxf(v, dpp_f<0xB1>(v)); v = fmaxf(v, dpp_f<0x4E>(v)); v = fmaxf(v, dpp_f<0x141>(v)); v = fmaxf(v, dpp_f<0x140>(v)); return v; }
__device__ __forceinline__ float rdlane_f(float v, int l) { return __uint_as_float((unsigned)__builtin_amdgcn_readlane((int)__float_as_uint(v), l)); }
__device__ __forceinline__ float sum_x16(float v) { const auto r = __builtin_amdgcn_permlane16_swap(__float_as_uint(v), __float_as_uint(v), false, false); return __uint_as_float(r[0]) + __uint_as_float(r[1]); }
__device__ __forceinline__ float sum_x32(float v) { const auto r = __builtin_amdgcn_permlane32_swap(__float_as_uint(v), __float_as_uint(v), false, false); return __uint_as_float(r[0]) + __uint_as_float(r[1]); }
__device__ __forceinline__ float max_x16(float v) { const auto r = __builtin_amdgcn_permlane16_swap(__float_as_uint(v), __float_as_uint(v), false, false); return fmaxf(__uint_as_float(r[0]), __uint_as_float(r[1])); }
__device__ __forceinline__ float max_x32(float v) { const auto r = __builtin_amdgcn_permlane32_swap(__float_as_uint(v), __float_as_uint(v), false, false); return fmaxf(__uint_as_float(r[0]), __uint_as_float(r[1])); }
__device__ __forceinline__ float partner_x16(float v) { const auto r = __builtin_amdgcn_permlane16_swap(__float_as_uint(v), __float_as_uint(v), false, false); return __uint_as_float(r[0] ^ r[1] ^ __float_as_uint(v)); }
__device__ __forceinline__ float partner_x32(float v) { const auto r = __builtin_amdgcn_permlane32_swap(__float_as_uint(v), __float_as_uint(v), false, false); return __uint_as_float(r[0] ^ r[1] ^ __float_as_uint(v)); }
__device__ __forceinline__ float wave_sum(float v) { return sum_x32(sum_x16(row_sum16(v))); }
__device__ __forceinline__ float wave_max(float v) { return max_x32(max_x16(row_max16(v))); }
__device__ __forceinline__ int hw_slot_() { return (int)(__builtin_amdgcn_s_getreg((5 << 11) | 4) & 63u); }
__device__ __forceinline__ int tid_() {
    int lane; asm volatile("v_mbcnt_lo_u32_b32 %0, -1, 0\n\tv_mbcnt_hi_u32_b32 %0, -1, %0" : "=v"(lane));
    const int w = ((volatile LAS int*)(g_lds))[8 + hw_slot_()];
    int t = __builtin_amdgcn_readfirstlane(w) * 64 + lane; asm volatile("" : "+v"(t)); return t; }
__device__ __forceinline__ int bid_() { unsigned o = 16; asm volatile("" : "+v"(o)); return __builtin_amdgcn_readfirstlane(*(const LAS int*)((LAS unsigned char*)(g_lds) + o)); }
__device__ __forceinline__ int gdim_() { unsigned o = 20; asm volatile("" : "+v"(o)); return __builtin_amdgcn_readfirstlane(*(const LAS int*)((LAS unsigned char*)(g_lds) + o)); }
__device__ __forceinline__ unsigned char* ws_() {
    unsigned o = 24; asm volatile("" : "+v"(o));
    const u32x2 v = *(const LAS u32x2*)((LAS unsigned char*)(g_lds) + o);
    const unsigned long long a = ((unsigned long long)(unsigned)__builtin_amdgcn_readfirstlane((int)v[1]) << 32) | (unsigned)__builtin_amdgcn_readfirstlane((int)v[0]);
    return (unsigned char*)(__attribute__((address_space(1))) unsigned char*)a; }
__device__ __forceinline__ float frcp_(float x) { return __builtin_amdgcn_rcpf(x); }
__device__ __forceinline__ float sigmoidf_(float x) { return frcp_(1.f + __expf(-x)); }
__device__ __forceinline__ f32x4 mfma16(bf16x8 a, bf16x8 b, f32x4 c) { return __builtin_amdgcn_mfma_f32_16x16x32_bf16(a, b, c, 0, 0, 0); }
__device__ __forceinline__ bf16x8 ld_frag_g(const u16* p) { return *reinterpret_cast<const bf16x8*>(p); }
__device__ __forceinline__ bf16x8 ld_frag_s(const u16* p) { return *reinterpret_cast<const bf16x8*>(p); }
__device__ __forceinline__ bf16x8 mk_frag(unsigned a, unsigned b, unsigned c, unsigned d) { u32x4 v = {a, b, c, d}; return __builtin_bit_cast(bf16x8, v); }

__device__ __forceinline__ void rowdot16(const f32x4 (&v)[8], const float* R, int lane, float (&lg)[16]) {
    constexpr int RS = D + 4;
    const float* Rl = R + lane * 4;
    f32x4 ra[8], rb[8];
#pragma unroll
    for (int i = 0; i < 8; ++i) ra[i] = *reinterpret_cast<const f32x4*>(Rl + i * 256);
#pragma unroll
    for (int e = 0; e < 16; e += 2) {
#pragma unroll
        for (int i = 0; i < 8; ++i) rb[i] = *reinterpret_cast<const f32x4*>(Rl + (e + 1) * RS + i * 256);
        { f32x2_t a0 = {0.f, 0.f}, a1 = {0.f, 0.f};
#pragma unroll
          for (int i = 0; i < 8; ++i) { a0 = __builtin_elementwise_fma((f32x2_t){v[i][0], v[i][1]}, (f32x2_t){ra[i][0], ra[i][1]}, a0); a1 = __builtin_elementwise_fma((f32x2_t){v[i][2], v[i][3]}, (f32x2_t){ra[i][2], ra[i][3]}, a1); }
          lg[e] = (a0[0] + a0[1]) + (a1[0] + a1[1]); }
        __builtin_amdgcn_sched_barrier(0);
        if (e + 2 < 16) {
#pragma unroll
            for (int i = 0; i < 8; ++i) ra[i] = *reinterpret_cast<const f32x4*>(Rl + (e + 2) * RS + i * 256);
        }
        { f32x2_t a0 = {0.f, 0.f}, a1 = {0.f, 0.f};
#pragma unroll
          for (int i = 0; i < 8; ++i) { a0 = __builtin_elementwise_fma((f32x2_t){v[i][0], v[i][1]}, (f32x2_t){rb[i][0], rb[i][1]}, a0); a1 = __builtin_elementwise_fma((f32x2_t){v[i][2], v[i][3]}, (f32x2_t){rb[i][2], rb[i][3]}, a1); }
          lg[e + 1] = (a0[0] + a0[1]) + (a1[0] + a1[1]); }
        __builtin_amdgcn_sched_barrier(0);
    }
}

__device__ __forceinline__ const float* xin_row(const Params& p, int row) {
    return row < NLAT ? p.x + (size_t)row * D : p.ctx + (size_t)(row - NLAT) * D;
}
__device__ __forceinline__ const float* mod_ptr(const unsigned char* ws, int l, int row, int chunk) {
    const int bb = row < NLAT ? (row >> 12) : 4;
    return (const float*)(ws + WS_MOD) + ((size_t)(l * 5 + bb) * 6 + chunk) * D;
}

__device__ __forceinline__ void phase_mod(const Params& p, unsigned char* lds_raw) {
    unsigned char* const ws = ws_();
    float* scond = (float*)lds_raw;
    float* red = scond + 5 * D;
    const int t = tid_();
    for (int i = t; i < 5 * D; i += NT) { const int r = i >> 11, k = i & 2047; const float v = r < 4 ? p.c[r * D + k] : p.c_ctx[k]; scond[i] = v / (1.f + __expf(-v)); }
    __syncthreads();
    float* mod = (float*)(ws + WS_MOD);
    for (int item = bid_(); item < 192; item += gdim_()) {
        const int l = item / 96, col0 = (item % 96) * 128;
        const int kg = t >> 5, cl = (t & 31) * 4;
        f32x4 acc[5];
#pragma unroll
        for (int r = 0; r < 5; ++r) acc[r] = (f32x4){0.f, 0.f, 0.f, 0.f};
        const float* wp = p.ada_w + ((size_t)l * D + kg * 128) * (6 * D) + col0 + cl;
#pragma unroll 8
        for (int kk = 0; kk < 128; ++kk) {
            const f32x4 w = __builtin_nontemporal_load(reinterpret_cast<const f32x4*>(wp + (size_t)kk * (6 * D)));
#pragma unroll
            for (int r = 0; r < 5; ++r) { const float s = scond[r * D + kg * 128 + kk]; acc[r] += w * s; }
        }
#pragma unroll
        for (int r = 0; r < 5; ++r) *reinterpret_cast<f32x4*>(red + (kg * 5 + r) * 128 + cl) = acc[r];
        __syncthreads();
        for (int o = t; o < 640; o += NT) {
            const int r = o >> 7, cc = o & 127;
            float s = p.ada_b[l * 6 * D + col0 + cc];
#pragma unroll
            for (int g = 0; g < 16; ++g) s += red[(g * 5 + r) * 128 + cc];
            mod[(size_t)(l * 5 + r) * 6 * D + col0 + cc] = s;
        }
        __syncthreads();
    }
}

__device__ __forceinline__ void phase_norm_mod(const Params& p, int l, unsigned char* lds) {
    unsigned char* const ws = ws_();
    const int t = tid_(), lane = t & 63, w = t >> 6;
    u16* H = (u16*)(ws + WS_H);
    float* R = (float*)lds;
    constexpr int RS = D + 4;
    float* G = (float*)(ws + WS_G);
    __syncthreads();
    for (int i = t; i < D * 16; i += NT) { const int k = i >> 4, e = i & 15; R[e * RS + k] = p.ab_w_in[(size_t)k * AB_IN + 4096 + e]; }
    __syncthreads();
    f32x4 xq[8];
    const int rstride = gdim_() * 8;
    int row = bid_() * 8 + w;
    if (row < NTOK) { const float* xr = xin_row(p, row); _Pragma("unroll") for (int i = 0; i < 8; ++i) xq[i] = __builtin_nontemporal_load(reinterpret_cast<const f32x4*>(xr + (i * 64 + lane) * 4)); }
    for (; row < NTOK; row += rstride) {
        f32x4 v[8]; float ss = 0.f;
#pragma unroll
        for (int i = 0; i < 8; ++i) { v[i] = xq[i]; ss += v[i][0] * v[i][0] + v[i][1] * v[i][1] + v[i][2] * v[i][2] + v[i][3] * v[i][3]; }
        __builtin_amdgcn_sched_barrier(0);
        if (row + rstride < NTOK) { const float* xr = xin_row(p, row + rstride); _Pragma("unroll") for (int i = 0; i < 8; ++i) xq[i] = __builtin_nontemporal_load(reinterpret_cast<const f32x4*>(xr + (i * 64 + lane) * 4)); }
        __builtin_amdgcn_sched_barrier(0);
        ss = wave_sum(ss);
        const float rstd = rsqrtf(ss * (1.f / D) + 1e-6f);
        const float* sh = mod_ptr(ws, l, row, 0); const float* sc = mod_ptr(ws, l, row, 1);
        const float* nw = p.norm_mix_pre + (size_t)l * D;
#pragma unroll
        for (int i = 0; i < 8; ++i) {
            const int col = (i * 64 + lane) * 4;
            const f32x4 w4 = *reinterpret_cast<const f32x4*>(nw + col), s4 = *reinterpret_cast<const f32x4*>(sc + col), h4 = *reinterpret_cast<const f32x4*>(sh + col);
            f32x4 o = v[i] * rstd * w4 * (s4 + 1.f) + h4;
            if (WIN_F8_L0) *reinterpret_cast<unsigned*>(ws + (WIN_L0_BF16_COLS ? WS_H8 : WS_H) + (size_t)row * D + col) = pk_fp8x4(o[0] * F8_SH, o[1] * F8_SH, o[2] * F8_SH, o[3] * F8_SH);
            if (!WIN_F8_L0 || WIN_L0_BF16_COLS) { const u32x2 pk = {pk_bf16(o[0], o[1]), pk_bf16(o[2], o[3])}; *reinterpret_cast<u32x2*>(H + (size_t)row * D + col) = pk; }
            v[i] = o;
        }
        float lg[16];
        rowdot16(v, R, lane, lg);
        const bool b5 = lane & 32, b4 = lane & 16, b3 = lane & 8, b2 = lane & 4;
        float t8[8], t4[4], t2[2], lgt;
#pragma unroll
        for (int j = 0; j < 8; ++j) { const float keep = b5 ? lg[8 + j] : lg[j], send = b5 ? lg[j] : lg[8 + j]; t8[j] = keep + partner_x32(send); }
#pragma unroll
        for (int j = 0; j < 4; ++j) { const float keep = b4 ? t8[4 + j] : t8[j], send = b4 ? t8[j] : t8[4 + j]; t4[j] = keep + partner_x16(send); }
#pragma unroll
        for (int j = 0; j < 2; ++j) { const float keep = b3 ? t4[2 + j] : t4[j], send = b3 ? t4[j] : t4[2 + j]; t2[j] = keep + dpp_f<0x140>(send); }
        { const float keep = b2 ? t2[1] : t2[0], send = b2 ? t2[0] : t2[1]; lgt = keep + dpp_f<0x141>(send); }
        lgt += dpp_f<0x4E>(lgt); lgt += dpp_f<0xB1>(lgt);
        if ((lane & 3) == 0) G[(size_t)row * 16 + ((b5 ? 8 : 0) + (b4 ? 4 : 0) + (b3 ? 2 : 0) + (b2 ? 1 : 0))] = lgt;
    }
}

__device__ __forceinline__ void convert_item(const float* W, int N, u16* Wt, int kb, int nb, unsigned char* lds) {
    const int t = tid_(), lane = t & 63, w = t >> 6;
    const int n4 = lane * 4, k0 = kb * 64 + w * 8, n0 = nb * 256;
    int col = n0 + n4; if (col > N - 4) col = N - 4;
    f32x4 r8[8];
#pragma unroll
    for (int j = 0; j < 8; ++j) r8[j] = __builtin_nontemporal_load(reinterpret_cast<const f32x4*>(W + (size_t)(k0 + j) * N + col));
    __syncthreads();
#pragma unroll
    for (int jj = 0; jj < 4; ++jj) {
        u32x4 v = {pk_bf16(r8[0][jj], r8[1][jj]), pk_bf16(r8[2][jj], r8[3][jj]), pk_bf16(r8[4][jj], r8[5][jj]), pk_bf16(r8[6][jj], r8[7][jj])};
        const int r = n4 + jj;
        *reinterpret_cast<u32x4*>(lds + r * 128 + ((w ^ ((r >> 2) & 7)) << 4)) = v;
    }
    __syncthreads();
    const int c = t & 7;
#pragma unroll
    for (int i = 0; i < 4; ++i) {
        const int r = (t >> 3) + 64 * i;
        if (n0 + r < N) {
            const u32x4 v = *reinterpret_cast<const u32x4*>(lds + r * 128 + ((c ^ ((r >> 2) & 7)) << 4));
            *reinterpret_cast<u32x4*>(Wt + (size_t)(n0 + r) * 2048 + kb * 64 + c * 8) = v;
        }
    }
}
template <int N>
__device__ __forceinline__ void convert_item8(const float* W, unsigned char* Wt, int kb, int nb, unsigned char* lds) {
    const int t = tid_(), lane = t & 63, w = t >> 6;
    const int n4 = lane * 4, k0 = kb * 128 + w * 16, n0 = nb * 256;
    int col = n0 + n4; if (N % 256 != 0 && col > N - 4) col = N - 4;
    f32x4 r[16];
#pragma unroll
    for (int j = 0; j < 16; ++j) r[j] = __builtin_nontemporal_load(reinterpret_cast<const f32x4*>(W + (size_t)(k0 + j) * N + col));
    __syncthreads();
#pragma unroll
    for (int jj = 0; jj < 4; ++jj) {
        u32x4 v;
#pragma unroll
        for (int q = 0; q < 4; ++q) v[q] = pk_fp8x4(r[4 * q][jj] * F8_SW, r[4 * q + 1][jj] * F8_SW, r[4 * q + 2][jj] * F8_SW, r[4 * q + 3][jj] * F8_SW);
        const int rr = n4 + jj;
        *reinterpret_cast<u32x4*>(lds + rr * 128 + ((w ^ ((rr >> 2) & 7)) << 4)) = v;
    }
    __syncthreads();
    const int c = t & 7;
#pragma unroll
    for (int i = 0; i < 4; ++i) {
        const int rr = (t >> 3) + 64 * i;
        if (N % 256 == 0 || n0 + rr < N) {
            const u32x4 v = *reinterpret_cast<const u32x4*>(lds + rr * 128 + ((c ^ ((rr >> 2) & 7)) << 4));
            *reinterpret_cast<u32x4*>(Wt + (size_t)(n0 + rr) * 2048 + kb * 128 + c * 16) = v;
        }
    }
}
__device__ __forceinline__ void convert_matrix_items(const float* W, int N, u16* Wt, int first, int count, unsigned char* lds) {
    const int nnb = (N + 255) / 256;
    for (int it = first; it < first + count; ++it) convert_item(W, N, Wt, it / nnb, it % nnb, lds);
}
__device__ __forceinline__ void phase_convert_dense(const Params& p, unsigned char* lds) {
    unsigned char* const ws = ws_();
    constexpr int NB16 = WIN_F8_L0 ? WIN_L0_BF16_COLS / 256 : 29;
    constexpr int n_ab16 = 32 * NB16, n_ab = n_ab16 + 16 * (29 - NB16), n_cd = (WIN_F8_L1 ? 16 : 32) * 14;
    for (int item = bid_(); item < n_ab + 128 + n_cd + 128; item += gdim_()) {
        if (item < n_ab16) convert_item(p.ab_w_in, AB_IN, (u16*)(ws + WS_WT_ABIN), item / (NB16 ? NB16 : 1), item % (NB16 ? NB16 : 1), lds);
        else if (item < n_ab) { const int it = item - n_ab16; convert_item8<AB_IN>(p.ab_w_in, ws + WS_WT_ABIN8, it / (29 - NB16), NB16 + it % (29 - NB16), lds); }
        else if (item < n_ab + 128) { const int it = item - n_ab; convert_item8<2048>(p.ab_w_out, ws + WS_WT_ABOUT, it / 8, it % 8, lds); }
        else if (item < n_ab + 128 + n_cd) { const int it = item - n_ab - 128; if (WIN_F8_L1) convert_item8<CD_IN>(p.cd_w_in, ws + WS_WT_CDIN, it / 14, it % 14, lds); else convert_item(p.cd_w_in, CD_IN, (u16*)(ws + WS_WT_CDIN), it / 14, it % 14, lds); }
        else { const int it = item - n_ab - 128 - n_cd; convert_item8<2048>(p.cd_w_out, ws + WS_WT_CDOUT, it / 8, it % 8, lds); }
    }
}
__device__ __forceinline__ void phase_convert_moe(const Params& p, int l, unsigned char* lds) {
    unsigned char* const ws = ws_();
    for (int item = bid_(); item < 3 * NEXP * 128; item += gdim_()) {
        const int which = item / (NEXP * 128), r = item % (NEXP * 128), ex = r >> 7, it = r & 127;
        const float* src = (which == 0 ? p.moe_w1 : (which == 1 ? p.moe_w3 : p.moe_w2)) + (size_t)(l * NEXP + ex) * D * FF;
        unsigned char* dst = ws + (which == 0 ? WS_WT_W1 : (which == 1 ? WS_WT_W3 : WS_WT_W2)) + (size_t)ex * D * FF;
        convert_item8<2048>(src, dst, it >> 3, it & 7, lds);
    }
}

__device__ __forceinline__ int g8_lds_byte(int r, int c) { const int st = (r >> 4) * 2 + (c >> 5), rr = r & 15, cc = c & 31, ob = rr * 64 + cc * 2; return st * 1024 + (ob ^ (((ob >> 9) & 1) << 5)); }
__device__ __forceinline__ void g8_stage_rc(int bb, int& R, int& C) { const int st = bb / 1024, sb = bb % 1024, swz = sb ^ (((sb >> 9) & 1) << 5); R = (st >> 1) * 16 + swz / 64; C = (st & 1) * 32 + (swz % 64) / 2; }
__device__ __forceinline__ int g8_perm32(int rho) { const int n = rho >> 4, i = rho & 15; return 8 * (i >> 2) + 4 * n + (i & 3); }

enum { EPI_BF16 = 0, EPI_SWIGLU = 2, EPI_SCALE = 3, EPI_F8BF16 = 4 };
struct GUnit { const char* a; const char* b0; const char* b1; const int* arow; int m0, n0, mvalid, ncols; u16* ob; int ldo; float* gates; const float* rscale; };
constexpr int G8_HTB = 128 * 64 * 2;
constexpr size_t G8_KSTEP = 128, G8_HSTEP = (size_t)128 * 2048 * 2;

template <int EPI>
__device__ __forceinline__ void g8_epilogue(const f32x4 (&acc)[2][2][4][2], const GUnit& u, int wr, int wc, int fr, int fq) {
#pragma unroll
    for (int ai = 0; ai < 2; ++ai)
#pragma unroll
        for (int m = 0; m < 4; ++m) {
            const int row = u.m0 + 128 * ai + 64 * wr + 16 * m + fr;
            if (row < u.mvalid) {
                if (EPI == EPI_BF16 || EPI == EPI_F8BF16) {
                    constexpr float si = EPI == EPI_F8BF16 ? 1.f / (F8_SH * F8_SW) : 1.f;
#pragma unroll
                    for (int bj = 0; bj < 2; ++bj) {
                        const int col = u.n0 + 128 * bj + 32 * wc + 8 * fq;
                        if (col < u.ncols) {
                            const f32x4 v0 = acc[ai][bj][m][0] * si, v1 = acc[ai][bj][m][1] * si;
                            u32x4 pk = {pk_bf16(v0[0], v0[1]), pk_bf16(v0[2], v0[3]), pk_bf16(v1[0], v1[1]), pk_bf16(v1[2], v1[3])};
                            *reinterpret_cast<u32x4*>(u.ob + (size_t)row * u.ldo + col) = pk;
                            if (u.gates && col >= 4096 && col < 4112) { *reinterpret_cast<f32x4*>(u.gates + (size_t)row * 16 + (col - 4096)) = v0; *reinterpret_cast<f32x4*>(u.gates + (size_t)row * 16 + (col - 4096) + 4) = v1; }
                        }
                    }
                } else if (EPI == EPI_SWIGLU) {
                    const int col = u.n0 + 32 * wc + 8 * fq;
                    float a[8];
                    constexpr float si = 1.f / (F8_SH * F8_SW);
#pragma unroll
                    for (int n = 0; n < 2; ++n)
#pragma unroll
                        for (int q = 0; q < 4; ++q) { const float x = acc[ai][0][m][n][q] * si; a[n * 4 + q] = x * frcp_(1.f + __expf(-x)) * (acc[ai][1][m][n][q] * (si * F8_SA)); }
                    u32x2 pk = {pk_fp8x4(a[0], a[1], a[2], a[3]), pk_fp8x4(a[4], a[5], a[6], a[7])};
                    *reinterpret_cast<u32x2*>((unsigned char*)u.ob + (size_t)row * u.ldo + col) = pk;
                } else {
                    const float sc = u.rscale[row] * (1.f / (F8_SA * F8_SW));
#pragma unroll
                    for (int bj = 0; bj < 2; ++bj) {
                        const int col = u.n0 + 128 * bj + 32 * wc + 8 * fq;
                        const f32x4 v0 = acc[ai][bj][m][0] * sc, v1 = acc[ai][bj][m][1] * sc;
                        u32x4 pk = {pk_bf16(v0[0], v0[1]), pk_bf16(v0[2], v0[3]), pk_bf16(v1[0], v1[1]), pk_bf16(v1[2], v1[3])};
                        *reinterpret_cast<u32x4*>(u.ob + (size_t)row * u.ldo + col) = pk;
                    }
                }
            }
        }
}

template <int EPI, bool GATHER, class UnitFn>
__device__ __forceinline__ void gemm_phase8(unsigned char* lds, UnitFn next) {
    const int tid = tid_(), wid = __builtin_amdgcn_readfirstlane(tid >> 6), lane = tid & 63, wr = wid >> 2, wc = wid & 3, fr = lane & 15, fq = lane >> 4;
    constexpr bool F8 = (EPI != EPI_BF16);
    constexpr int nt = F8 ? 2048 / 128 : 2048 / 64;
    constexpr unsigned ROWB = F8 ? 2048u : 4096u;
    GUnit cur, nxt; int ui = 0;
    if (!next(0, cur)) return;
    int sR[2], sC[2];
#pragma unroll
    for (int i = 0; i < 2; ++i) g8_stage_rc(tid * 16 + i * 8192, sR[i], sC[i]);
    unsigned voffB[2];
#pragma unroll
    for (int i = 0; i < 2; ++i) voffB[i] = (unsigned)((sR[i] & ~31) + g8_perm32(sR[i] & 31)) * ROWB + (unsigned)sC[i] * 2u;
    unsigned voffA[2][2], voffAn[2][2];
    auto set_voffA = [&](const GUnit& u, unsigned (&vo)[2][2]) {
#pragma unroll
        for (int h = 0; h < 2; ++h)
#pragma unroll
            for (int i = 0; i < 2; ++i) {
                if (GATHER) vo[h][i] = (unsigned)u.arow[u.m0 + h * 128 + sR[i]] * ROWB + (unsigned)sC[i] * 2u;
                else vo[h][i] = (unsigned)(h * 128 + sR[i]) * ROWB + (unsigned)sC[i] * 2u;
            } };
    set_voffA(cur, voffA);
    const unsigned ldsw = (unsigned)wid * 1024u;
    const int aoff = g8_lds_byte(wr * 64 + fr, fq * 8), boff = g8_lds_byte(wc * 32 + fr, fq * 8);
#define G8_SA(b, h) (((b) * 2 + (h)) * G8_HTB)
#define G8_SB(b, h) ((4 + (b) * 2 + (h)) * G8_HTB)
#define G8_STAGE(bufoff, gbase, voff) do { _Pragma("unroll") for (int _i = 0; _i < 2; ++_i) \
        __builtin_amdgcn_global_load_lds((const unsigned*)((const char*)(gbase) + (voff)[_i]), (LAS unsigned*)(lds + (bufoff) + ldsw + _i * 8192), 16, 0, 0); } while (0)
#define G8_LDA(dst, b, h) do { _Pragma("unroll") for (int m = 0; m < 4; ++m) _Pragma("unroll") for (int k = 0; k < 2; ++k) dst[m][k] = *(const LAS bf16x8*)(lds + G8_SA(b, h) + aoff + m * 2048 + k * 1024); } while (0)
#define G8_LDB(dst, b, h) do { _Pragma("unroll") for (int n = 0; n < 2; ++n) _Pragma("unroll") for (int k = 0; k < 2; ++k) dst[n][k] = *(const LAS bf16x8*)(lds + G8_SB(b, h) + boff + n * 2048 + k * 1024); } while (0)
#define G8_MMA(ai, bj, At, Bt) do { __builtin_amdgcn_s_setprio(1); _Pragma("unroll") for (int m = 0; m < 4; ++m) _Pragma("unroll") for (int n = 0; n < 2; ++n) { \
        if (F8) { const i32x8 _b = cat8(Bt[n][0], Bt[n][1]), _a = cat8(At[m][0], At[m][1]); asm volatile("v_mfma_f32_16x16x128_f8f6f4 %0, %1, %2, %0" : "+v"(acc[ai][bj][m][n]) : "v"(_b), "v"(_a)); } \
        else { _Pragma("unroll") for (int k = 0; k < 2; ++k) acc[ai][bj][m][n] = __builtin_amdgcn_mfma_f32_16x16x32_bf16(Bt[n][k], At[m][k], acc[ai][bj][m][n], 0, 0, 0); } } \
        __builtin_amdgcn_s_setprio(0); } while (0)
#define G8_WAIT_V(n) asm volatile("s_waitcnt vmcnt(" #n ")" ::: "memory")
#define G8_WAIT_L(n) asm volatile("s_waitcnt lgkmcnt(" #n ")" ::: "memory")
#define G8_BAR __builtin_amdgcn_s_barrier()
#define G8_SCHED __builtin_amdgcn_sched_barrier(0)
    f32x4 acc[2][2][4][2];
#pragma unroll
    for (int a2 = 0; a2 < 2; ++a2)
#pragma unroll
        for (int b2 = 0; b2 < 2; ++b2)
#pragma unroll
            for (int m = 0; m < 4; ++m)
#pragma unroll
                for (int n = 0; n < 2; ++n) acc[a2][b2][m][n] = (f32x4){0.f, 0.f, 0.f, 0.f};
    bf16x8 At[4][2], B0[2][2], B1[2][2];
    const char* cA = cur.a; const char* cB0 = cur.b0; const char* cB1 = cur.b1;
    G8_STAGE(G8_SB(0, 0), cB0, voffB); G8_STAGE(G8_SA(0, 0), cA, voffA[0]); G8_STAGE(G8_SB(0, 1), cB1, voffB); G8_STAGE(G8_SA(0, 1), cA, voffA[1]);
    if (wr == 1) G8_BAR;
    G8_WAIT_V(4); G8_BAR;
    G8_STAGE(G8_SB(1, 0), cB0 + G8_KSTEP, voffB); G8_STAGE(G8_SA(1, 0), cA + G8_KSTEP, voffA[0]); G8_STAGE(G8_SB(1, 1), cB1 + G8_KSTEP, voffB);
    G8_WAIT_V(6); G8_BAR;
    for (;;) {
        const bool has_next = next(ui + 1, nxt);
        const char* nA = has_next ? nxt.a : cA; const char* nB0 = has_next ? nxt.b0 : cB0; const char* nB1 = has_next ? nxt.b1 : cB1;
        if (GATHER) { if (has_next) set_voffA(nxt, voffAn); else { _Pragma("unroll") for (int h = 0; h < 2; ++h) _Pragma("unroll") for (int i = 0; i < 2; ++i) voffAn[h][i] = voffA[h][i]; } }
        for (int t = 0; t < nt; t += 2) {
            const bool last = (t == nt - 2);
            const char* a1 = cA + (size_t)(t + 1) * G8_KSTEP;
            const char* a2 = last ? nA : cA + (size_t)(t + 2) * G8_KSTEP;
            const char* b20 = last ? nB0 : cB0 + (size_t)(t + 2) * G8_KSTEP; const char* b21 = last ? nB1 : cB1 + (size_t)(t + 2) * G8_KSTEP;
            const char* a3 = a2 + G8_KSTEP; const char* b30 = b20 + G8_KSTEP; const char* b31 = b21 + G8_KSTEP;
            unsigned vA2[2][2];
#pragma unroll
            for (int h = 0; h < 2; ++h)
#pragma unroll
                for (int i = 0; i < 2; ++i) vA2[h][i] = (GATHER && last) ? voffAn[h][i] : voffA[h][i];
            G8_LDB(B0, 0, 0); G8_SCHED; G8_LDA(At, 0, 0); G8_STAGE(G8_SA(1, 1), a1, voffA[1]);
            G8_WAIT_L(8); G8_BAR; G8_WAIT_L(0); G8_MMA(0, 0, At, B0); G8_BAR; G8_SCHED;
            G8_LDB(B1, 0, 1); G8_STAGE(G8_SB(0, 0), b20, voffB);
            G8_BAR; G8_WAIT_L(0); G8_MMA(0, 1, At, B1); G8_BAR;
            G8_LDA(At, 0, 1); G8_STAGE(G8_SA(0, 0), a2, vA2[0]);
            G8_BAR; G8_WAIT_L(0); G8_MMA(1, 0, At, B0); G8_BAR; G8_SCHED;
            G8_STAGE(G8_SB(0, 1), b21, voffB);
            G8_WAIT_V(6); G8_BAR; G8_MMA(1, 1, At, B1); G8_BAR;
            G8_LDB(B0, 1, 0); G8_SCHED; G8_LDA(At, 1, 0); G8_STAGE(G8_SA(0, 1), a2, vA2[1]);
            G8_WAIT_L(8); G8_BAR; G8_WAIT_L(0); G8_MMA(0, 0, At, B0); G8_BAR; G8_SCHED;
            G8_LDB(B1, 1, 1); G8_STAGE(G8_SB(1, 0), b30, voffB);
            G8_BAR; G8_WAIT_L(0); G8_MMA(0, 1, At, B1); G8_BAR;
            G8_LDA(At, 1, 1); G8_STAGE(G8_SA(1, 0), a3, vA2[0]);
            G8_BAR; G8_WAIT_L(0); G8_MMA(1, 0, At, B0); G8_BAR; G8_SCHED;
            G8_STAGE(G8_SB(1, 1), b31, voffB);
            G8_WAIT_V(6); G8_BAR; G8_MMA(1, 1, At, B1); G8_BAR;
        }
        if (F8) asm volatile("s_nop 15\n\ts_nop 15" ::: "memory");
        g8_epilogue<EPI>(acc, cur, wr, wc, fr, fq);
        if (!has_next) break;
#pragma unroll
        for (int a2 = 0; a2 < 2; ++a2)
#pragma unroll
            for (int b2 = 0; b2 < 2; ++b2)
#pragma unroll
                for (int m = 0; m < 4; ++m)
#pragma unroll
                    for (int n = 0; n < 2; ++n) acc[a2][b2][m][n] = (f32x4){0.f, 0.f, 0.f, 0.f};
        cur = nxt; cA = nA; cB0 = nB0; cB1 = nB1; ++ui;
        if (GATHER) { _Pragma("unroll") for (int h = 0; h < 2; ++h) _Pragma("unroll") for (int i = 0; i < 2; ++i) voffA[h][i] = voffAn[h][i]; }
    }
    G8_WAIT_V(0);
    if (wr == 0) G8_BAR;
    G8_BAR;
#undef G8_SA
#undef G8_SB
#undef G8_STAGE
#undef G8_LDA
#undef G8_LDB
#undef G8_MMA
#undef G8_WAIT_V
#undef G8_WAIT_L
#undef G8_BAR
#undef G8_SCHED
}

template <bool F8, bool REV = false>
__device__ __forceinline__ void phase_gemm_dense(const Params& p, const u16* A, int M, const u16* Wt, int N, u16* ob, int ldo, float* gates, unsigned char* lds) {
    const int nM = M / 256, nN = (N + 255) / 256, L = nM * nN;
    const int xcd = bid_() & 7, nslot = gdim_() >> 3, slot = bid_() >> 3;
    const int base = (int)(((long)L * xcd) >> 3), cnt = (int)(((long)L * (xcd + 1)) >> 3) - base;
    const int G8n = nM >> 3, rem = nM & 7;
    auto next = [&](int i, GUnit& u) -> bool {
        int k = slot + i * nslot;
        if (REV) {
            if (slot < 4) { if (i >= 4) return false; k = slot * 4 + i; }
            else k = 16 + (slot - 4) + i * (nslot - 4);
        }
        if (k >= cnt) return false;
        const int idx = base + k;
        int pn, pm;
        if (idx < G8n * 8 * nN) { const int gq = idx / (8 * nN), r = idx % (8 * nN); pn = r >> 3; pm = gq * 8 + (r & 7); }
        else { const int r = idx - G8n * 8 * nN; pn = r / rem; pm = G8n * 8 + r % rem; }
        constexpr size_t rowb = F8 ? 2048 : 4096;
        u.a = (const char*)A + (size_t)pm * 256 * rowb; u.b0 = (const char*)Wt + (size_t)pn * 256 * rowb; u.b1 = u.b0 + 128 * rowb; u.arow = nullptr;
        u.m0 = pm * 256; u.n0 = pn * 256; u.mvalid = M; u.ncols = N; u.ob = ob; u.ldo = ldo; u.gates = gates; u.rscale = nullptr;
        return true; };
    gemm_phase8<F8 ? EPI_F8BF16 : EPI_BF16, false>(lds, next);
}

__device__ __forceinline__ void phase_gemm_dense_f8rev(const Params& p, const u16* A, int M, const u16* Wt, int N, u16* ob, int ldo, unsigned char* lds) { phase_gemm_dense<true, true>(p, A, M, Wt, N, ob, ldo, nullptr, lds); }
__device__ __forceinline__ void phase_moe_a(const Params& p, int l, unsigned char* lds) {
    unsigned char* const ws = ws_();
    const int mvalid = l == 0 ? 2176 : 2048, nM = l == 0 ? 9 : 8;
    const int per_e = nM * 16;
    const int xcd = bid_() & 7, slot = bid_() >> 3, nslot = gdim_() >> 3;
    auto next = [&](int i, GUnit& u) -> bool {
        const int k = slot + i * nslot;
        if (k >= 2 * per_e) return false;
        const int tile = xcd * 2 * per_e + k;
        const int ex = tile / per_e, r = tile % per_e, pn = r / nM, pm = r % nM;
        u.a = (const char*)(ws + WS_H); u.arow = (const int*)(ws + WS_EROW) + ex * EPAD;
        u.b0 = (const char*)(ws + WS_WT_W1) + ((size_t)ex * FF + pn * 128) * D; u.b1 = (const char*)(ws + WS_WT_W3) + ((size_t)ex * FF + pn * 128) * D;
        u.m0 = pm * 256; u.n0 = pn * 128; u.mvalid = mvalid; u.ncols = FF; u.ob = (u16*)(ws + WS_ACT + (size_t)ex * EPAD * FF); u.ldo = FF; u.gates = nullptr; u.rscale = nullptr;
        return true; };
    gemm_phase8<EPI_SWIGLU, true>(lds, next);
}
__device__ __forceinline__ void phase_moe_b(const Params& p, int l, unsigned char* lds) {
    unsigned char* const ws = ws_();
    const int mvalid = l == 0 ? 2176 : 2048, nM = l == 0 ? 9 : 8;
    const int per_e = nM * 8;
    const int xcd = bid_() & 7, slot = bid_() >> 3, nslot = gdim_() >> 3;
    auto next = [&](int i, GUnit& u) -> bool {
        const int k = slot + i * nslot;
        if (k >= 2 * per_e) return false;
        const int tile = xcd * 2 * per_e + k;
        const int ex = tile / per_e, r = tile % per_e, pn = r / nM, pm = r % nM;
        u.a = (const char*)(ws + WS_ACT) + ((size_t)ex * EPAD + pm * 256) * FF; u.arow = nullptr;
        u.b0 = (const char*)(ws + WS_WT_W2) + ((size_t)ex * D + pn * 256) * FF; u.b1 = u.b0 + (size_t)128 * 2048;
        u.m0 = pm * 256; u.n0 = pn * 256; u.mvalid = mvalid; u.ncols = D; u.ob = (u16*)(ws + WS_YEXP) + (size_t)ex * EPAD * D; u.ldo = D; u.gates = nullptr;
        u.rscale = (const float*)(ws + WS_EGATE) + ex * EPAD;
        return true; };
    gemm_phase8<EPI_SCALE, false>(lds, next);
}

__device__ __forceinline__ int mlstm_row(int b, int dir, int pos) {
    if (pos < LC) return NLAT + b * LC + (dir ? (LC - 1 - pos) : pos);
    const int q = pos - LC; return b * SEQ + (dir ? (SEQ - 1 - q) : q);
}
__device__ __forceinline__ void phase_mlstm(const Params& p, unsigned char* lds) {
    unsigned char* const ws = ws_();
    u16* KT = (u16*)lds;
    u16* VT = KT + 256 * 72;
    u16* VWT = VT + 48 * 72;
    u16* CT = VWT + 48 * 72;
    u16* Ss = CT + 48 * 264;
    float* gB = (float*)(Ss + 64 * 72);
    float* gI = gB + 68 * 64;
    float* gP = gI + 68 * 64;
    float* gE = gP + 68 * 64;
    const int t = tid_(), lane = t & 63, w = t >> 6, fr = lane & 15, fq = lane >> 4;
    const u16* P = (const u16*)(ws + WS_P);
    const float* G = (const float*)(ws + WS_G);
    u16* HM = (u16*)(ws + WS_HM);
    for (int item = bid_(); item < 256; item += gdim_()) {
        const int combo = (item & 7) * 4 + (item >> 6), vs = (item >> 3) & 7, dir = combo & 1, hh = (combo >> 1) & 3, b = combo >> 3;
        __syncthreads();
        for (int i = t; i < 48 * 264; i += NT) CT[i] = 0;
        for (int i = t; i < 16 * 72; i += NT) { const int er = i / 72; VT[32 * 72 + i] = (er == 0) ? (u16)0x3f80 : (u16)0; VWT[32 * 72 + i] = 0; }
        {
            const float gb_i = p.mlstm_gate_b[(dir * 2 + 0) * 4 + hh], gb_f = p.mlstm_gate_b[(dir * 2 + 1) * 4 + hh];
            for (int ch = w; ch < 68; ch += 8) {
                const int row = mlstm_row(b, dir, ch * 64 + lane);
                const float gi = G[(size_t)row * 16 + dir * 8 + hh] + gb_i;
                const float gf = G[(size_t)row * 16 + dir * 8 + 4 + hh] + gb_f;
                const float lf = fminf(gf, 0.f) - log1pf(__expf(-fabsf(gf)));
                float bc = lf;
#pragma unroll
                for (int o = 1; o < 64; o <<= 1) { const float n = __shfl_up(bc, o, 64); if (lane >= o) bc += n; }
                float pm = gi - bc;
#pragma unroll
                for (int o = 1; o < 64; o <<= 1) { const float n = __shfl_up(pm, o, 64); if (lane >= o) pm = fmaxf(pm, n); }
                const float b63 = __shfl(bc, 63, 64);
                float gmax = b63 - bc + gi;
#pragma unroll
                for (int o = 32; o > 0; o >>= 1) gmax = fmaxf(gmax, __shfl_xor(gmax, o, 64));
                gB[ch * 64 + lane] = bc; gI[ch * 64 + lane] = gi; gP[ch * 64 + lane] = pm;
                if (lane == 0) { gE[ch * 2] = b63; gE[ch * 2 + 1] = gmax; }
            }
        }
        f32x4 Cacc[2][3];
#pragma unroll
        for (int i = 0; i < 2; ++i)
#pragma unroll
            for (int j = 0; j < 3; ++j) Cacc[i][j] = (f32x4){0.f, 0.f, 0.f, 0.f};
        float m_old = 0.f;
        const int jt = w & 3, sth = w >> 2;
        const int vs_s = t & 63, vs_eg = t >> 6;
        bf16x8 qf[8]; unsigned ktr[2][8]; u32x2 vraw;
        const int jq = jt * 16 + fr, jjq = dir ? 63 - jq : jq;
        const unsigned off_q = (unsigned)jjq * AB_IN + hh * 256 + fq * 8;
        const int jk0 = (sth * 2) * 16 + fr, jk1 = jk0 + 16;
        const unsigned off_k0 = (unsigned)(dir ? 63 - jk0 : jk0) * AB_IN + 1024 + hh * 256 + fq * 8;
        const unsigned off_k1 = (unsigned)(dir ? 63 - jk1 : jk1) * AB_IN + 1024 + hh * 256 + fq * 8;
        unsigned off_kt[2];
#pragma unroll
        for (int i = 0; i < 2; ++i) { const int mt = t + NT * i, d2 = (mt & 127) * 2, s8 = (mt >> 7) * 8; off_kt[i] = (unsigned)(dir ? 63 - s8 - 7 : s8) * AB_IN + 1024 + hh * 256 + d2; }
        const unsigned off_v = (unsigned)(dir ? 63 - vs_s : vs_s) * AB_IN + 2048 + hh * 256 + vs * 32 + vs_eg * 4;
        const unsigned off_h = (unsigned)jjq * 1024 + hh * 256 + vs * 32 + sth * 16 + 4 * fq;
#define ML_BASE(POS0) (P + (size_t)(dir ? mlstm_row(b, dir, (POS0)) - 63 : mlstm_row(b, dir, (POS0))) * AB_IN)
#define ML_LOAD_Q(POS0) do { const u16* _pc = ML_BASE(POS0); \
            _Pragma("unroll") for (int kk = 0; kk < 8; ++kk) qf[kk] = ld_frag_g(_pc + off_q + kk * 32); } while (0)
#define ML_LOAD_K(POS0, S2) do { const u16* _pc = ML_BASE(POS0); \
            _Pragma("unroll") for (int kk = 0; kk < 8; ++kk) kf[kk] = ld_frag_g(_pc + ((S2) ? off_k1 : off_k0) + kk * 32); } while (0)
#define ML_LOAD_KTV(POS0) do { const u16* _pc = ML_BASE(POS0); \
            _Pragma("unroll") for (int i = 0; i < 2; ++i) { \
                _Pragma("unroll") for (int q = 0; q < 8; ++q) ktr[i][q] = *reinterpret_cast<const unsigned*>(_pc + (size_t)((dir ? 7 - q : q) * AB_IN) + off_kt[i]); } \
            vraw = *reinterpret_cast<const u32x2*>(_pc + off_v); } while (0)
        ML_LOAD_Q(0); ML_LOAD_KTV(0);
        __syncthreads();
        for (int ch = 0; ch < 68; ++ch) {
            const int pos0 = ch * 64;
            const float* sb = gB + ch * 64; const float* sig = gI + ch * 64; const float* spm = gP + ch * 64;
            const float b63 = gE[ch * 2], m_new = fmaxf(b63 + m_old, gE[ch * 2 + 1]), decay = __expf(b63 + m_old - m_new);
            const int jg = jt * 16 + fr;
            const float bj = sb[jg], mj = bj + fmaxf(m_old, spm[jg]);
            auto s_tile = [&](int st) {
                f32x4 sv = (f32x4){0.f, 0.f, 0.f, 0.f};
                if (st <= jt) {
                    typedef short s16x4 __attribute__((ext_vector_type(4)));
                    const u16* kb = KT + (8 * fq + ((lane & 15) >> 2)) * 72 + st * 16 + 4 * (lane & 3);
#pragma unroll
                    for (int kk = 0; kk < 8; ++kk) {
                        const s16x4 lo = __builtin_amdgcn_ds_read_tr16_b64_v4i16((LAS s16x4*)(kb + kk * 32 * 72));
                        const s16x4 hi = __builtin_amdgcn_ds_read_tr16_b64_v4i16((LAS s16x4*)(kb + (kk * 32 + 4) * 72));
                        const bf16x8 kfr = {lo[0], lo[1], lo[2], lo[3], hi[0], hi[1], hi[2], hi[3]};
                        sv = mfma16(kfr, qf[kk], sv);
                    }
                }
                float pv[4];
#pragma unroll
                for (int q = 0; q < 4; ++q) {
                    const int sg = st * 16 + 4 * fq + q;
                    pv[q] = (sg <= jg) ? sv[q] * 0.0625f * __expf(bj - sb[sg] + sig[sg] - mj) : 0.f;
                }
                u32x2 pk = {pk_bf16(pv[0], pv[1]), pk_bf16(pv[2], pv[3])};
                *reinterpret_cast<u32x2*>(Ss + jg * 72 + st * 16 + 4 * fq) = pk;
            };
#pragma unroll
            for (int i = 0; i < 2; ++i) {
                const int mt = t + NT * i, d2 = (mt & 127) * 2, s8 = (mt >> 7) * 8;
                u32x4 lo = {(ktr[i][0] & 0xffffu) | (ktr[i][1] << 16), (ktr[i][2] & 0xffffu) | (ktr[i][3] << 16), (ktr[i][4] & 0xffffu) | (ktr[i][5] << 16), (ktr[i][6] & 0xffffu) | (ktr[i][7] << 16)};
                u32x4 hi = {(ktr[i][0] >> 16) | (ktr[i][1] & 0xffff0000u), (ktr[i][2] >> 16) | (ktr[i][3] & 0xffff0000u), (ktr[i][4] >> 16) | (ktr[i][5] & 0xffff0000u), (ktr[i][6] >> 16) | (ktr[i][7] & 0xffff0000u)};
                *reinterpret_cast<u32x4*>(KT + d2 * 72 + s8) = lo;
                *reinterpret_cast<u32x4*>(KT + (d2 + 1) * 72 + s8) = hi;
            }
            {
                const float wg = __expf(b63 - sb[vs_s] + sig[vs_s] - m_new) * 0.0625f;
                const float v0 = bf_lo(vraw[0]), v1 = bf_hi(vraw[0]), v2 = bf_lo(vraw[1]), v3 = bf_hi(vraw[1]);
                const int e0 = vs_eg * 4;
                VT[(e0 + 0) * 72 + vs_s] = (u16)(vraw[0] & 0xffffu); VT[(e0 + 1) * 72 + vs_s] = (u16)(vraw[0] >> 16);
                VT[(e0 + 2) * 72 + vs_s] = (u16)(vraw[1] & 0xffffu); VT[(e0 + 3) * 72 + vs_s] = (u16)(vraw[1] >> 16);
                VWT[(e0 + 0) * 72 + vs_s] = f2bf(v0 * wg); VWT[(e0 + 1) * 72 + vs_s] = f2bf(v1 * wg);
                VWT[(e0 + 2) * 72 + vs_s] = f2bf(v2 * wg); VWT[(e0 + 3) * 72 + vs_s] = f2bf(v3 * wg);
                if (t < 64) VWT[32 * 72 + t] = f2bf(wg);
            }
            if (ch + 1 < 68) ML_LOAD_KTV(pos0 + 64);
            __syncthreads();
            s_tile(sth * 2);
            s_tile(sth * 2 + 1);
            __syncthreads();
            {
                const float w_inter = __expf(bj + m_old - mj);
                f32x4 nacc[2];
#pragma unroll
                for (int z = 0; z < 2; ++z) {
                    const int et = z == 0 ? sth : 2;
                    f32x4 a = (f32x4){0.f, 0.f, 0.f, 0.f};
#pragma unroll
                    for (int kk = 0; kk < 8; ++kk) a = mfma16(ld_frag_s(CT + (et * 16 + fr) * 264 + kk * 32 + fq * 8), qf[kk], a);
                    nacc[z] = a * w_inter;
                }
                if (ch + 1 < 68) ML_LOAD_Q(pos0 + 64);
#pragma unroll
                for (int z = 0; z < 2; ++z) {
                    const int et = z == 0 ? sth : 2;
                    f32x4 a = nacc[z];
#pragma unroll
                    for (int k2 = 0; k2 < 2; ++k2) a = mfma16(ld_frag_s(VT + (et * 16 + fr) * 72 + k2 * 32 + fq * 8), ld_frag_s(Ss + jg * 72 + k2 * 32 + fq * 8), a);
                    nacc[z] = a;
                }
                const float den = __shfl(nacc[1][0], fr, 64);
                const float dd = fmaxf(fabsf(den), __expf(-mj));
                const float inv = 1.f / dd;
                u32x2 pk = {pk_bf16(nacc[0][0] * inv, nacc[0][1] * inv), pk_bf16(nacc[0][2] * inv, nacc[0][3] * inv)};
                *reinterpret_cast<u32x2*>(HM + ((size_t)dir * NTOK + (dir ? mlstm_row(b, dir, pos0) - 63 : mlstm_row(b, dir, pos0))) * 1024 + off_h) = pk;
            }
#pragma unroll
            for (int i = 0; i < 2; ++i)
#pragma unroll
                for (int et = 0; et < 3; ++et) {
                    f32x4 a = Cacc[i][et] * decay;
#pragma unroll
                    for (int k2 = 0; k2 < 2; ++k2) a = mfma16(ld_frag_s(KT + ((w * 2 + i) * 16 + fr) * 72 + k2 * 32 + fq * 8), ld_frag_s(VWT + (et * 16 + fr) * 72 + k2 * 32 + fq * 8), a);
                    Cacc[i][et] = a;
                }
            __syncthreads();
#pragma unroll
            for (int i = 0; i < 2; ++i)
#pragma unroll
                for (int et = 0; et < 3; ++et) {
                    const f32x4 a = Cacc[i][et];
                    u32x2 pk = {pk_bf16(a[0], a[1]), pk_bf16(a[2], a[3])};
                    *reinterpret_cast<u32x2*>(CT + (et * 16 + fr) * 264 + (w * 2 + i) * 16 + 4 * fq) = pk;
                }
            m_old = m_new;
        }
#undef ML_LOAD_Q
#undef ML_LOAD_K
#undef ML_LOAD_KTV
    }
}

__device__ __forceinline__ void mlstm_out_rows(const Params& p, int row0, int nrows) {
    unsigned char* const ws = ws_();
    const int lane = tid_() & 63, w = tid_() >> 6;
    const u16* P = (const u16*)(ws + WS_P);
    const u16* HM = (const u16*)(ws + WS_HM);
    u16* YIN = (u16*)(ws + WS_YIN);
    for (int r = w; r < nrows; r += 8) {
        const int row = row0 + r;
        const int c0 = lane * 16;
        float v[16]; float ss = 0.f;
#pragma unroll
        for (int h2 = 0; h2 < 2; ++h2) {
            const u32x4 a = *reinterpret_cast<const u32x4*>(HM + (size_t)row * 1024 + c0 + h2 * 8);
            const u32x4 bq = *reinterpret_cast<const u32x4*>(HM + ((size_t)NTOK + row) * 1024 + c0 + h2 * 8);
#pragma unroll
            for (int q = 0; q < 4; ++q) { v[h2 * 8 + 2 * q] = bf_lo(a[q]) + bf_lo(bq[q]); v[h2 * 8 + 2 * q + 1] = bf_hi(a[q]) + bf_hi(bq[q]); }
        }
#pragma unroll
        for (int q = 0; q < 16; ++q) ss += v[q] * v[q];
        ss += __shfl_xor(ss, 1, 64); ss += __shfl_xor(ss, 2, 64); ss += __shfl_xor(ss, 4, 64); ss += __shfl_xor(ss, 8, 64);
        const float rstd = rsqrtf(ss * (1.f / 256.f) + 1e-6f);
        float y[16];
#pragma unroll
        for (int h2 = 0; h2 < 2; ++h2) {
            const u32x4 og = *reinterpret_cast<const u32x4*>(P + (size_t)row * AB_IN + 3072 + c0 + h2 * 8);
#pragma unroll
            for (int q = 0; q < 4; ++q) {
                const int c = c0 + h2 * 8 + 2 * q;
                y[h2 * 8 + 2 * q] = v[h2 * 8 + 2 * q] * rstd * p.mlstm_norm[c] * sigmoidf_(bf_lo(og[q])) * F8_SH;
                y[h2 * 8 + 2 * q + 1] = v[h2 * 8 + 2 * q + 1] * rstd * p.mlstm_norm[c + 1] * sigmoidf_(bf_hi(og[q])) * F8_SH;
            }
        }
        *reinterpret_cast<u32x4*>((unsigned char*)YIN + (size_t)row * D + c0) = (u32x4){pk_fp8x4(y[0], y[1], y[2], y[3]), pk_fp8x4(y[4], y[5], y[6], y[7]), pk_fp8x4(y[8], y[9], y[10], y[11]), pk_fp8x4(y[12], y[13], y[14], y[15])};
    }
}

template <int DH, class KeyFn, class BiasFn>
__device__ __forceinline__ void attn_wave(const u16* qptr, size_t qstride, int nblk, KeyFn keyfn, BiasFn biasfn, float scale,
                                           float m_init, float l_init, u16* vlds, u16* optr, size_t ostride) {
    constexpr int NK = DH / 32, NDT = DH / 16, VS = DH + 8, NV = DH / 16;
    const int lane = tid_() & 63, fr = lane & 15, fq = lane >> 4;
    bf16x8 qf[NK];
#pragma unroll
    for (int kk = 0; kk < NK; ++kk) qf[kk] = ld_frag_g(qptr + (size_t)fr * qstride + kk * 32 + fq * 8);
    f32x4 oacc[NDT];
#pragma unroll
    for (int i = 0; i < NDT; ++i) oacc[i] = (f32x4){0.f, 0.f, 0.f, 0.f};
    float m = m_init, l = l_init;
    bf16x8 kn[2][NK]; u32x4 vn[NV];
    auto load_blk = [&](int ib) {
        const u16* kptr; const u16* vptr; size_t kvs;
        (void)keyfn(ib, kptr, vptr, kvs);
#pragma unroll
        for (int st = 0; st < 2; ++st)
#pragma unroll
            for (int kk = 0; kk < NK; ++kk) kn[st][kk] = ld_frag_g(kptr + (size_t)(st * 16 + fr) * kvs + kk * 32 + fq * 8);
#pragma unroll
        for (int i = 0; i < NV; ++i) { const int cidx = lane + 64 * i, r = cidx / (DH / 8), cc = cidx % (DH / 8); vn[i] = *reinterpret_cast<const u32x4*>(vptr + (size_t)r * kvs + cc * 8); }
    };
    auto next_valid = [&](int ib) { const u16* a; const u16* b2; size_t c; while (ib < nblk && !keyfn(ib, a, b2, c)) ++ib; return ib; };
    int ib = next_valid(0);
    if (ib < nblk) load_blk(ib);
    while (ib < nblk) {
        bf16x8 kc[2][NK]; u32x4 vc[NV];
#pragma unroll
        for (int st = 0; st < 2; ++st)
#pragma unroll
            for (int kk = 0; kk < NK; ++kk) kc[st][kk] = kn[st][kk];
#pragma unroll
        for (int i = 0; i < NV; ++i) vc[i] = vn[i];
        const int ibn = next_valid(ib + 1);
        if (ibn < nblk) load_blk(ibn);
        asm volatile("" ::: "memory");
#pragma unroll
        for (int i = 0; i < NV; ++i) { const int cidx = lane + 64 * i, r = cidx / (DH / 8), cc = cidx % (DH / 8); *reinterpret_cast<u32x4*>(vlds + r * VS + cc * 8) = vc[i]; }
        f32x4 s[2];
#pragma unroll
        for (int st = 0; st < 2; ++st) {
            f32x4 a = (f32x4){0.f, 0.f, 0.f, 0.f};
#pragma unroll
            for (int kk = 0; kk < NK; ++kk) a = mfma16(kc[st][kk], qf[kk], a);
            s[st] = a;
        }
        float x[8]; float mx = -INFINITY;
#pragma unroll
        for (int st = 0; st < 2; ++st)
#pragma unroll
            for (int q = 0; q < 4; ++q) { const float v = s[st][q] * scale + biasfn(ib, fr, st * 16 + 4 * fq + q); x[st * 4 + q] = v; mx = fmaxf(mx, v); }
        mx = max_x32(max_x16(mx));
        const float m_new = fmaxf(m, mx);
        const float m_safe = (m_new == -INFINITY) ? 0.f : m_new;
        const float alpha = __expf(m - m_safe);
        float ps = 0.f; float pe[8];
#pragma unroll
        for (int q = 0; q < 8; ++q) { pe[q] = __expf(x[q] - m_safe); ps += pe[q]; }
        l = l * alpha + ps; m = m_new;
#pragma unroll
        for (int i = 0; i < NDT; ++i) oacc[i] *= alpha;
        const bf16x8 pf = mk_frag(pk_bf16(pe[0], pe[1]), pk_bf16(pe[2], pe[3]), pk_bf16(pe[4], pe[5]), pk_bf16(pe[6], pe[7]));
        asm volatile("s_waitcnt lgkmcnt(0)" ::: "memory");
        {
            typedef short s16x4 __attribute__((ext_vector_type(4)));
            const int tq = (lane & 15) >> 2, tp = lane & 3;
            const u16* vb0 = vlds + (4 * fq + tq) * VS + 4 * tp;
            const u16* vb1 = vb0 + 16 * VS;
#pragma unroll
            for (int dt = 0; dt < NDT; ++dt) {
                const s16x4 lo = __builtin_amdgcn_ds_read_tr16_b64_v4i16((LAS s16x4*)(vb0 + dt * 16));
                const s16x4 hi = __builtin_amdgcn_ds_read_tr16_b64_v4i16((LAS s16x4*)(vb1 + dt * 16));
                const bf16x8 vf = {lo[0], lo[1], lo[2], lo[3], hi[0], hi[1], hi[2], hi[3]};
                oacc[dt] = mfma16(vf, pf, oacc[dt]);
            }
        }
        asm volatile("" ::: "memory");
        ib = ibn;
    }
    l = sum_x32(sum_x16(l));
    const float inv = 1.f / l;
#pragma unroll
    for (int dt = 0; dt < NDT; ++dt) {
        const f32x4 o = oacc[dt] * (inv * F8_SH);
        *reinterpret_cast<unsigned*>((unsigned char*)optr + (size_t)fr * ostride + dt * 16 + 4 * fq) = pk_fp8x4(o[0], o[1], o[2], o[3]);
    }
}


template <int DH, class SlabFn, class SubFn, class BiasFn>
__device__ __forceinline__ void attn_block(const u16* qptr, size_t qstride, int nslab, SlabFn slabfn, SubFn subfn, BiasFn biasfn, float scale,
                                            float m_init, float l_init, unsigned char* lds, u16* optr, size_t ostride) {
    constexpr int NK = DH / 32, NDT = DH / 16, VS = DH + 8, NLD = DH / 64;
    constexpr int STAGE = 2 * 64 * VS * 2;
    const int t = tid_(), lane = t & 63, fr = lane & 15, fq = lane >> 4;
    bf16x8 qf[NK];
#pragma unroll
    for (int kk = 0; kk < NK; ++kk) qf[kk] = ld_frag_g(qptr + (size_t)fr * qstride + kk * 32 + fq * 8);
    f32x4 oacc[NDT];
#pragma unroll
    for (int i = 0; i < NDT; ++i) oacc[i] = (f32x4){0.f, 0.f, 0.f, 0.f};
    float m = m_init, l = l_init;
    u32x4 kreg[NLD], vreg[NLD];
    auto load_slab = [&](int i) {
        const u16* kp; const u16* vp; size_t kvs; slabfn(i, kp, vp, kvs);
#pragma unroll
        for (int q = 0; q < NLD; ++q) { const int c = t + NT * q, r = c / (DH / 8), cc = c % (DH / 8);
            kreg[q] = *reinterpret_cast<const u32x4*>(kp + (size_t)r * kvs + cc * 8); vreg[q] = *reinterpret_cast<const u32x4*>(vp + (size_t)r * kvs + cc * 8); } };
    auto store_slab = [&](int st) {
        u16* Ks = (u16*)(lds + st * STAGE); u16* Vs = Ks + 64 * VS;
#pragma unroll
        for (int q = 0; q < NLD; ++q) { const int c = t + NT * q, r = c / (DH / 8), cc = c % (DH / 8);
            *reinterpret_cast<u32x4*>(Ks + r * VS + cc * 8) = kreg[q]; *reinterpret_cast<u32x4*>(Vs + r * VS + cc * 8) = vreg[q]; } };
    __syncthreads();
    load_slab(0); store_slab(0);
    if (nslab > 1) load_slab(1);
    __syncthreads();
    for (int i = 0; i < nslab; ++i) {
        const int cur = i & 1;
        if (i + 1 < nslab) store_slab(cur ^ 1);
        if (i + 2 < nslab) load_slab(i + 2);
        const u16* Ks = (const u16*)(lds + cur * STAGE); const u16* Vs = Ks + 64 * VS;
#pragma unroll
        for (int j = 0; j < 2; ++j) {
            int off;
            if (!subfn(i, j, off)) continue;
            f32x4 s[2];
#pragma unroll
            for (int st = 0; st < 2; ++st) {
                f32x4 a = (f32x4){0.f, 0.f, 0.f, 0.f};
#pragma unroll
                for (int kk = 0; kk < NK; ++kk) a = mfma16(ld_frag_s(Ks + (off + st * 16 + fr) * VS + kk * 32 + fq * 8), qf[kk], a);
                s[st] = a;
            }
            float x[8]; float mx = -INFINITY;
#pragma unroll
            for (int st = 0; st < 2; ++st)
#pragma unroll
                for (int q = 0; q < 4; ++q) { const float v = s[st][q] * scale + biasfn(i, off, fr, st * 16 + 4 * fq + q); x[st * 4 + q] = v; mx = fmaxf(mx, v); }
            mx = max_x32(max_x16(mx));
            const float m_new = fmaxf(m, mx);
            const float m_safe = (m_new == -INFINITY) ? 0.f : m_new;
            const float alpha = __expf(m - m_safe);
            float ps = 0.f; float pe[8];
#pragma unroll
            for (int q = 0; q < 8; ++q) { pe[q] = __expf(x[q] - m_safe); ps += pe[q]; }
            l = l * alpha + ps; m = m_new;
#pragma unroll
            for (int dt = 0; dt < NDT; ++dt) oacc[dt] *= alpha;
            const bf16x8 pf = mk_frag(pk_bf16(pe[0], pe[1]), pk_bf16(pe[2], pe[3]), pk_bf16(pe[4], pe[5]), pk_bf16(pe[6], pe[7]));
            typedef short s16x4 __attribute__((ext_vector_type(4)));
            const int tq = (lane & 15) >> 2, tp = lane & 3;
            const u16* vb0 = Vs + (off + 4 * fq + tq) * VS + 4 * tp;
            const u16* vb1 = vb0 + 16 * VS;
#pragma unroll
            for (int dt = 0; dt < NDT; ++dt) {
                const s16x4 lo = __builtin_amdgcn_ds_read_tr16_b64_v4i16((LAS s16x4*)(vb0 + dt * 16));
                const s16x4 hi = __builtin_amdgcn_ds_read_tr16_b64_v4i16((LAS s16x4*)(vb1 + dt * 16));
                const bf16x8 vf = {lo[0], lo[1], lo[2], lo[3], hi[0], hi[1], hi[2], hi[3]};
                oacc[dt] = mfma16(vf, pf, oacc[dt]);
            }
        }
        __syncthreads();
    }
    l = sum_x32(sum_x16(l));
    const float inv = 1.f / l;
#pragma unroll
    for (int dt = 0; dt < NDT; ++dt) {
        const f32x4 o = oacc[dt] * (inv * F8_SH);
        *reinterpret_cast<unsigned*>((unsigned char*)optr + (size_t)fr * ostride + dt * 16 + 4 * fq) = pk_fp8x4(o[0], o[1], o[2], o[3]);
    }
}

__device__ __forceinline__ void phase_l0_stage2(const Params& p, unsigned char* lds) {
    unsigned char* const ws = ws_();
    const int w = tid_() >> 6;
    const u16* P = (const u16*)(ws + WS_P);
    u16* YIN = (u16*)(ws + WS_YIN);
    for (int item = bid_(); item < 1088 + 2176; item += gdim_()) {
        if (item < 1024) {
            const int r2 = item & 31, h = (item >> 5) & 7, b = item >> 8;
            const int rr = w >> 2, qt = w & 3, r = 2 * r2 + rr;
            const int r0 = min(max(r - 4, 0), 56);
            const int krow0 = min(max(2 * r2 - 4, 0), 56), nwin = min(max(2 * r2 + 1 - 4, 0), 56) + 8 - krow0;
            const int cb = qt == 0 ? 0 : (qt == 1 ? 8 : (qt == 2 ? 24 : 32));
            const int qrow = b * SEQ + r * 64 + qt * 16;
            const float* rpb = p.na_rpb + h * 15 * 31;
            auto slabfn = [&](int i, const u16*& kp, const u16*& vp, size_t& kvs) {
                const int row = i < nwin ? b * SEQ + (krow0 + i) * 64 : NLAT + b * LC + (i - nwin) * 64;
                kp = P + (size_t)row * AB_IN + 5136 + h * 128; vp = P + (size_t)row * AB_IN + 6160 + h * 128; kvs = AB_IN; };
            auto subfn = [&](int i, int j, int& off) -> bool {
                if (i < nwin) { off = cb; return j == 0 && (krow0 + i) >= r0 && (krow0 + i) < r0 + 8; }
                off = 32 * j; return true; };
            auto biasfn = [&](int i, int off, int qi, int ki) -> float {
                if (i >= nwin) return 0.f;
                const int c = qt * 16 + qi, kc = off + ki, c0 = min(max(c - 8, 0), 48);
                if (kc < c0 || kc >= c0 + 16) return -INFINITY;
                return rpb[(krow0 + i - r + 7) * 31 + (kc - c + 15)]; };
            attn_block<128>(P + (size_t)qrow * AB_IN + 4112 + h * 128, AB_IN, nwin + 4, slabfn, subfn, biasfn, 0.08838834764831845f, -INFINITY, 0.f, lds,
                            (u16*)((unsigned char*)YIN + (size_t)qrow * D + 1024 + h * 128), D);
        } else if (item < 1088) {
            const int it = item - 1024, half = it & 1, h = (it >> 1) & 7, b = it >> 4;
            const int qrow = NLAT + b * LC + (half * 8 + w) * 16;
            auto slabfn = [&](int i, const u16*& kp, const u16*& vp, size_t& kvs) {
                const int row = NLAT + b * LC + i * 64;
                kp = P + (size_t)row * AB_IN + 5136 + h * 128; vp = P + (size_t)row * AB_IN + 6160 + h * 128; kvs = AB_IN; };
            auto subfn = [&](int, int j, int& off) -> bool { off = 32 * j; return true; };
            auto biasfn = [&](int, int, int, int) -> float { return 0.f; };
            attn_block<128>(P + (size_t)qrow * AB_IN + 4112 + h * 128, AB_IN, 4, slabfn, subfn, biasfn, 0.08838834764831845f, -INFINITY, 0.f, lds,
                            (u16*)((unsigned char*)YIN + (size_t)qrow * D + 1024 + h * 128), D);
        } else {
            mlstm_out_rows(p, (item - 1088) * 8, 8);
        }
    }
}

__device__ __forceinline__ void rope_prep(const Params& p) {
    if (bid_() != 0) return;
    float* T = (float*)(ws_() + WS_ROPE);
    for (int i = tid_(); i < 1024; i += NT) {
        const int pos = i >> 4, j = i & 15;
        const float inv = exp2f(-(float)j * (13.287712379549449f / 16.f));
        float sn, cs; sincosf((float)pos * inv, &sn, &cs);
        T[i] = cs; T[1024 + i] = sn;
    }
}
__device__ __forceinline__ void rope_rows(const Params& p, int row0, int nrows) {
    unsigned char* const ws = ws_();
    const int lane = tid_() & 63, w = tid_() >> 6;
    u16* P = (u16*)(ws + WS_P);
    const float* T = (const float*)(ws + WS_ROPE);
    for (int r = w; r < nrows; r += 8) {
        const int row = row0 + r, tt = row & (SEQ - 1), prow = tt >> 6, pcol = tt & 63;
#pragma unroll
        for (int it = 0; it < 2; ++it) {
            const int c = it * 64 + lane;
            if (c < 80) {
                const int head = c >> 2, half = (c >> 1) & 1, j0 = (c & 1) * 8;
                u16* q1 = P + (size_t)row * CD_IN + head * 64 + half * 32 + j0;
                const float* tc = T + (half ? pcol : prow) * 16 + j0;
                const u32x4 xa = *reinterpret_cast<const u32x4*>(q1), xb = *reinterpret_cast<const u32x4*>(q1 + 16);
                const f32x4 c0 = *reinterpret_cast<const f32x4*>(tc), c1 = *reinterpret_cast<const f32x4*>(tc + 4);
                const f32x4 s0 = *reinterpret_cast<const f32x4*>(tc + 1024), s1 = *reinterpret_cast<const f32x4*>(tc + 1028);
                const float cs[8] = {c0[0], c0[1], c0[2], c0[3], c1[0], c1[1], c1[2], c1[3]}, sn[8] = {s0[0], s0[1], s0[2], s0[3], s1[0], s1[1], s1[2], s1[3]};
                u32x4 oa, ob;
#pragma unroll
                for (int q = 0; q < 4; ++q) {
                    const float a0 = bf_lo(xa[q]), a1 = bf_hi(xa[q]), b0 = bf_lo(xb[q]), b1 = bf_hi(xb[q]);
                    oa[q] = pk_bf16(a0 * cs[2 * q] - b0 * sn[2 * q], a1 * cs[2 * q + 1] - b1 * sn[2 * q + 1]);
                    ob[q] = pk_bf16(b0 * cs[2 * q] + a0 * sn[2 * q], b1 * cs[2 * q + 1] + a1 * sn[2 * q + 1]);
                }
                *reinterpret_cast<u32x4*>(q1) = oa; *reinterpret_cast<u32x4*>(q1 + 16) = ob;
            }
        }
    }
}

__device__ __forceinline__ int lru_row(int b, int ci, int j) { return ci < 4 ? NLAT + b * LC + ci * 64 + j : b * SEQ + (ci - 4) * 64 + j; }
__device__ __forceinline__ void lru_chunk(const Params& p, int b, int blk, int ci, int mode, unsigned char* lds) {
    unsigned char* const ws = ws_();
    u16* ub = (u16*)lds;
    constexpr int SR = 132;
    float* sa = (float*)(ub + 64 * 136);
    float* sbt = sa + 64 * SR;
    float* sx = sbt + 64 * SR;
    const int t = tid_(), lane = t & 63, w = t >> 6, fr = lane & 15, fq = lane >> 4;
    const u16* P = (const u16*)(ws + WS_P);
    const u16* WT = (const u16*)(ws + WS_LRUW);
    float* SA = (float*)(ws + WS_LRUS);
    float* SH = SA + 2 * 4 * 68 * 1024;
    const int seglen = ci < 4 ? LC : SEQ, tt0 = ci < 4 ? ci * 64 : (ci - 4) * 64;
    const int rbase = ci < 4 ? NLAT + b * LC : b * SEQ;
    const int sc = t & 127, seg = t >> 7;
    const int chg_s = blk * 128 + sc;
    const int cg = blk * 128 + w * 16 + 4 * fq;
    bf16x8 wfa[2][2][4];
#pragma unroll
    for (int d2 = 0; d2 < 2; ++d2)
#pragma unroll
        for (int g2 = 0; g2 < 2; ++g2)
#pragma unroll
            for (int kk = 0; kk < 4; ++kk) wfa[d2][g2][kk] = ld_frag_g(WT + ((size_t)((d2 * 2 + g2) * 8 + blk) * 128 + w * 16 + fr) * 128 + fq * 8 + kk * 32);
    f32x4 gba[2][2], lama[2];
#pragma unroll
    for (int d2 = 0; d2 < 2; ++d2) {
        lama[d2] = *reinterpret_cast<const f32x4*>(p.lru_lambda + d2 * 1024 + cg);
#pragma unroll
        for (int g2 = 0; g2 < 2; ++g2) gba[d2][g2] = *reinterpret_cast<const f32x4*>(p.lru_gate_b + (d2 * 2 + g2) * 1024 + cg);
    }
    float carry[2] = {0.f, 0.f}; u16 grv[16];
    if (mode == 1) {
#pragma unroll
        for (int d2 = 0; d2 < 2; ++d2) carry[d2] = SH[((size_t)(d2 * 4 + b) * 68 + ci) * 1024 + chg_s];
#pragma unroll
        for (int s = 0; s < 16; ++s) grv[s] = P[(size_t)lru_row(b, ci, seg * 16 + s) * CD_IN + 2560 + chg_s];
    }
    __syncthreads();
    {
        const int c4 = (t & 31) * 4, j0 = (t >> 5) * 4, ch = blk * 128 + c4;
        float xv[7][4];
#pragma unroll
        for (int q = 0; q < 7; ++q) {
            const int tt = tt0 + j0 - 1 + q;
            if (tt >= 0 && tt < seglen) {
                const u32x2 v = *reinterpret_cast<const u32x2*>(P + (size_t)(rbase + tt) * CD_IN + 1536 + ch);
                xv[q][0] = bf_lo(v[0]); xv[q][1] = bf_hi(v[0]); xv[q][2] = bf_lo(v[1]); xv[q][3] = bf_hi(v[1]);
            } else { xv[q][0] = xv[q][1] = xv[q][2] = xv[q][3] = 0.f; }
        }
        f32x4 cw[4];
#pragma unroll
        for (int tp = 0; tp < 4; ++tp) cw[tp] = *reinterpret_cast<const f32x4*>(p.lru_conv_w + tp * 1024 + ch);
        const f32x4 cb = *reinterpret_cast<const f32x4*>(p.lru_conv_b + ch);
#pragma unroll
        for (int q = 0; q < 4; ++q) {
            float u[4];
#pragma unroll
            for (int cc = 0; cc < 4; ++cc) u[cc] = cb[cc] + xv[q][cc] * cw[0][cc] + xv[q + 1][cc] * cw[1][cc] + xv[q + 2][cc] * cw[2][cc] + xv[q + 3][cc] * cw[3][cc];
            u32x2 pk = {pk_bf16(u[0], u[1]), pk_bf16(u[2], u[3])};
            *reinterpret_cast<u32x2*>(ub + (j0 + q) * 136 + c4) = pk;
        }
    }
    __syncthreads();
    float hfw[16];
    for (int dir = 0; dir < 2; ++dir) {
        f32x4 av[4];
        {
            bf16x8 wf[4];
#pragma unroll
            for (int kk = 0; kk < 4; ++kk) wf[kk] = dir ? wfa[1][0][kk] : wfa[0][0][kk];
            const f32x4 gbv = dir ? gba[1][0] : gba[0][0];
            const f32x4 lamv = dir ? lama[1] : lama[0];
            float sp8[4];
#pragma unroll
            for (int q = 0; q < 4; ++q) { const float nl = -lamv[q]; sp8[q] = -8.f * (fmaxf(nl, 0.f) + __logf(1.f + __expf(-fabsf(nl)))); }
#pragma unroll
            for (int tt = 0; tt < 4; ++tt) {
                f32x4 z = (f32x4){0.f, 0.f, 0.f, 0.f};
#pragma unroll
                for (int kk = 0; kk < 4; ++kk) z = mfma16(wf[kk], ld_frag_s(ub + (tt * 16 + fr) * 136 + kk * 32 + fq * 8), z);
#pragma unroll
                for (int q = 0; q < 4; ++q) av[tt][q] = __expf(sigmoidf_(z[q] + gbv[q]) * sp8[q]);
            }
        }
        __syncthreads();
        {
            bf16x8 wf[4];
#pragma unroll
            for (int kk = 0; kk < 4; ++kk) wf[kk] = dir ? wfa[1][1][kk] : wfa[0][1][kk];
            const f32x4 gbv = dir ? gba[1][1] : gba[0][1];
#pragma unroll
            for (int tt = 0; tt < 4; ++tt) {
                f32x4 z = (f32x4){0.f, 0.f, 0.f, 0.f};
#pragma unroll
                for (int kk = 0; kk < 4; ++kk) z = mfma16(wf[kk], ld_frag_s(ub + (tt * 16 + fr) * 136 + kk * 32 + fq * 8), z);
                const int tj = tt * 16 + fr;
                const u32x2 uv = *reinterpret_cast<const u32x2*>(ub + tj * 136 + w * 16 + 4 * fq);
                const float u4[4] = {bf_lo(uv[0]), bf_hi(uv[0]), bf_lo(uv[1]), bf_hi(uv[1])};
                f32x4 bv;
#pragma unroll
                for (int q = 0; q < 4; ++q) { const float a = av[tt][q]; bv[q] = __builtin_amdgcn_sqrtf(fmaxf(1.f - a * a, 0.f)) * sigmoidf_(z[q] + gbv[q]) * u4[q]; }
                *reinterpret_cast<f32x4*>(sa + tj * SR + w * 16 + 4 * fq) = av[tt];
                *reinterpret_cast<f32x4*>(sbt + tj * SR + w * 16 + 4 * fq) = bv;
            }
        }
        __syncthreads();
        float A = 1.f, h = 0.f;
#pragma unroll
        for (int s = 0; s < 16; ++s) { const int j = seg * 16 + (dir ? 15 - s : s); const float a = sa[j * SR + sc]; h = a * h + sbt[j * SR + sc]; A *= a; }
        sx[(seg * 2 + 0) * 128 + sc] = A; sx[(seg * 2 + 1) * 128 + sc] = h;
        __syncthreads();
        const size_t sidx = ((size_t)(dir * 4 + b) * 68 + ci) * 1024 + chg_s;
        if (mode == 0) {
            if (seg == 0) {
                float At = 1.f, ht = 0.f;
#pragma unroll
                for (int s = 0; s < 4; ++s) { const int sg = dir ? 3 - s : s; const float a = sx[(sg * 2) * 128 + sc]; ht = a * ht + sx[(sg * 2 + 1) * 128 + sc]; At *= a; }
                SA[sidx] = At; SH[sidx] = ht;
            }
        } else {
            float hs = dir ? carry[1] : carry[0];
            const int nprev = dir ? 3 - seg : seg;
#pragma unroll
            for (int s = 0; s < 3; ++s) if (s < nprev) { const int sg = dir ? 3 - s : s; hs = sx[(sg * 2) * 128 + sc] * hs + sx[(sg * 2 + 1) * 128 + sc]; }
            u16* YIN = (u16*)(ws + WS_YIN);
            if (dir == 0) {
#pragma unroll
                for (int s = 0; s < 16; ++s) { const int j = seg * 16 + s; hs = sa[j * SR + sc] * hs + sbt[j * SR + sc]; hfw[s] = hs; }
            } else {
#pragma unroll
                for (int s = 0; s < 16; ++s) {
                    const int js = 15 - s, j = seg * 16 + js;
                    hs = sa[j * SR + sc] * hs + sbt[j * SR + sc];
                    const int row = lru_row(b, ci, j);
                    const float gr = bf2f(grv[js]);
                    const float th = 1.f - 2.f * frcp_(1.f + __expf(1.5957691216057308f * (gr + 0.044715f * gr * gr * gr)));
                    const float ge = 0.5f * gr * (1.f + th);
                    ((unsigned char*)YIN)[(size_t)row * D + 1024 + chg_s] = (unsigned char)(pk_fp8x4((hfw[js] + hs) * ge * F8_SH, 0.f, 0.f, 0.f) & 0xffu);
                }
            }
        }
    }
}

__device__ __forceinline__ void lru_prep_weights(const Params& p) {
    unsigned char* const ws = ws_();
    const int t = tid_();
    u16* WT = (u16*)(ws + WS_LRUW);
    for (int m = bid_(); m < 32; m += gdim_()) {
        const float* Wg = p.lru_gate_w + (size_t)m * 128 * 128;
        const int j4 = (t & 31) * 4, i8 = (t >> 5) * 8;
        f32x4 r8[8];
#pragma unroll
        for (int q = 0; q < 8; ++q) r8[q] = *reinterpret_cast<const f32x4*>(Wg + (size_t)(i8 + q) * 128 + j4);
#pragma unroll
        for (int jj = 0; jj < 4; ++jj) {
            u32x4 v = {pk_bf16(r8[0][jj], r8[1][jj]), pk_bf16(r8[2][jj], r8[3][jj]), pk_bf16(r8[4][jj], r8[5][jj]), pk_bf16(r8[6][jj], r8[7][jj])};
            *reinterpret_cast<u32x4*>(WT + ((size_t)m * 128 + j4 + jj) * 128 + i8) = v;
        }
    }
}
__device__ __forceinline__ void lru_carry(const Params& p, int item) {
    unsigned char* const ws = ws_();
    const int idx = item * NT + tid_();
    const int c = idx & 1023, b = (idx >> 10) & 3, dir = idx >> 12;
    float* SA = (float*)(ws + WS_LRUS);
    float* SH = SA + 2 * 4 * 68 * 1024;
    const size_t base = ((size_t)(dir * 4 + b) * 68) * 1024 + c;
    float h = 0.f;
#pragma unroll 4
    for (int s = 0; s < 68; ++s) {
        const int cj = dir == 0 ? s : (s < 4 ? 3 - s : 71 - s);
        const float a = SA[base + (size_t)cj * 1024], hl = SH[base + (size_t)cj * 1024];
        SH[base + (size_t)cj * 1024] = h;
        h = a * h + hl;
    }
}

__device__ __forceinline__ void gqa_item(const Params& p, int it, unsigned char* lds) {
    unsigned char* const ws = ws_();
    const int w = tid_() >> 6;
    const u16* P = (const u16*)(ws + WS_P);
    u16* YIN = (u16*)(ws + WS_YIN);
    const int t32 = it & 127, kvh = (it >> 7) & 3, b = it >> 9;
    const int hq = kvh * 4 + (w & 3), t0 = t32 * 32 + (w >> 2) * 16;
    const int kfirst = max((t32 * 32 - 128) & ~63, 0), klast = min(((t32 * 32 - 128) & ~63) + 256, SEQ - 64);
    const int nwin = (klast - kfirst) / 64 + 1;
    const int qrow = b * SEQ + t0;
    auto slabfn = [&](int i, const u16*& kp, const u16*& vp, size_t& kvs) {
        const int row = i < nwin ? b * SEQ + kfirst + i * 64 : NLAT + b * LC + (i - nwin) * 64;
        kp = P + (size_t)row * CD_IN + 1024 + kvh * 64; vp = P + (size_t)row * CD_IN + 1280 + kvh * 64; kvs = CD_IN; };
    auto subfn = [&](int i, int j, int& off) -> bool {
        off = 32 * j;
        if (i >= nwin) return true;
        const int k0 = kfirst + i * 64 + off;
        return k0 + 31 >= t0 - 128 && k0 <= t0 + 15 + 128; };
    auto biasfn = [&](int i, int off, int qi, int ki) -> float {
        if (i >= nwin) return 0.f;
        const int dq = (t0 + qi) - (kfirst + i * 64 + off + ki);
        return (dq > 128 || dq < -128) ? -INFINITY : 0.f; };
    const float sink = p.gqa_sink[hq];
    attn_block<64>(P + (size_t)qrow * CD_IN + hq * 64, CD_IN, nwin + 4, slabfn, subfn, biasfn, 0.125f, sink, ((tid_() & 63) >> 4) == 0 ? 1.f : 0.f, lds,
                   (u16*)((unsigned char*)YIN + (size_t)qrow * D + hq * 64), D);
}

__device__ __forceinline__ void phase_l1_stage1(const Params& p, unsigned char* lds) {
    for (int item = bid_(); item < 2176 + 2048; item += gdim_()) {
        if (item < 2176) { const int ci = item % 68, blk = (item / 68) & 7, b = item / (68 * 8); lru_chunk(p, b, blk, ci, 0, lds); }
        else rope_rows(p, (item - 2176) * 8, 8);
    }
}
__device__ __forceinline__ void phase_l1_stage2(const Params& p, unsigned char* lds) {
    for (int item = bid_(); item < 16 + 2048; item += gdim_()) {
        if (item < 16) lru_carry(p, item);
        else gqa_item(p, item - 16, lds);
    }
}
__device__ __forceinline__ void phase_l1_stage3(const Params& p, unsigned char* lds) {
    for (int item = bid_(); item < 2048; item += gdim_()) { const int cl = item & 63, blk = (item >> 6) & 7, b = item >> 9; lru_chunk(p, b, blk, cl + 4, 1, lds); }
}

__device__ __forceinline__ void phase_rowpass_mid(const Params& p, int l, unsigned char* lds) {
    unsigned char* const ws = ws_();
    float* R = (float*)lds;
    const int t = tid_(), lane = t & 63, w = t >> 6;
    const int nrows = l == 0 ? NTOK : NLAT;
    __syncthreads();
    constexpr int RS = D + 4;
    for (int i = t; i < D * NEXP; i += NT) { const int k = i >> 4, e = i & 15; R[e * RS + k] = p.moe_router[(size_t)l * D * NEXP + i]; }
    __syncthreads();
    const u16* Y = (const u16*)(ws + WS_Y);
    u16* XL1 = (u16*)(ws + WS_XL1);
    u16* H = (u16*)(ws + WS_H);
    float* AFF = (float*)(ws + WS_AFF);
    u32x2 yq[8]; f32x4 xq[8]; u32x2 xq2[8];
    const int rstride = gdim_() * 8;
    int row = bid_() * 8 + w;
#define RP_FETCH(ROW) do { const int _rw = (ROW); \
        _Pragma("unroll") for (int i = 0; i < 8; ++i) yq[i] = __builtin_nontemporal_load(reinterpret_cast<const u32x2*>(Y + (size_t)_rw * D + (i * 64 + lane) * 4)); \
        if (l == 0) { const float* _xr = xin_row(p, _rw); _Pragma("unroll") for (int i = 0; i < 8; ++i) xq[i] = __builtin_nontemporal_load(reinterpret_cast<const f32x4*>(_xr + (i * 64 + lane) * 4)); } \
        else { const u16* _xb = (const u16*)(ws + WS_XL2) + (size_t)_rw * D; _Pragma("unroll") for (int i = 0; i < 8; ++i) xq2[i] = __builtin_nontemporal_load(reinterpret_cast<const u32x2*>(_xb + (i * 64 + lane) * 4)); } } while (0)
    if (row < nrows) RP_FETCH(row);
    for (; row < nrows; row += rstride) {
        f32x4 v[8]; float ss = 0.f;
#pragma unroll
        for (int i = 0; i < 8; ++i) { const u32x2 q = yq[i]; v[i] = (f32x4){bf_lo(q[0]), bf_hi(q[0]), bf_lo(q[1]), bf_hi(q[1])}; ss += v[i][0] * v[i][0] + v[i][1] * v[i][1] + v[i][2] * v[i][2] + v[i][3] * v[i][3]; }
        ss = wave_sum(ss);
        const float rstd = rsqrtf(ss * (1.f / D) + 1e-6f);
        const float* g1 = mod_ptr(ws, l, row, 2);
        const float* nw = p.norm_mix_post + (size_t)l * D;
        float ss1 = 0.f;
#pragma unroll
        for (int i = 0; i < 8; ++i) {
            const int col = (i * 64 + lane) * 4;
            f32x4 x4;
            if (l == 0) x4 = xq[i];
            else { const u32x2 q = xq2[i]; x4 = (f32x4){bf_lo(q[0]), bf_hi(q[0]), bf_lo(q[1]), bf_hi(q[1])}; }
            const f32x4 w4 = *reinterpret_cast<const f32x4*>(nw + col), g4 = *reinterpret_cast<const f32x4*>(g1 + col);
            const f32x4 x1 = x4 + g4 * (v[i] * rstd * w4);
            { const u32x2 pk1 = {pk_bf16(x1[0], x1[1]), pk_bf16(x1[2], x1[3])}; *reinterpret_cast<u32x2*>(XL1 + (size_t)row * D + col) = pk1; }
            v[i] = x1; ss1 += x1[0] * x1[0] + x1[1] * x1[1] + x1[2] * x1[2] + x1[3] * x1[3];
        }
        __builtin_amdgcn_sched_barrier(0);
        if (row + rstride < nrows) RP_FETCH(row + rstride);
        __builtin_amdgcn_sched_barrier(0);
        ss1 = wave_sum(ss1);
        const float rstd1 = rsqrtf(ss1 * (1.f / D) + 1e-6f);
        const float* sh = mod_ptr(ws, l, row, 3); const float* sc = mod_ptr(ws, l, row, 4);
        const float* nw2 = p.norm_ffn_pre + (size_t)l * D;
#pragma unroll
        for (int i = 0; i < 8; ++i) {
            const int col = (i * 64 + lane) * 4;
            const f32x4 w4 = *reinterpret_cast<const f32x4*>(nw2 + col), s4 = *reinterpret_cast<const f32x4*>(sc + col), h4 = *reinterpret_cast<const f32x4*>(sh + col);
            const f32x4 o = v[i] * rstd1 * w4 * (s4 + 1.f) + h4;
            *reinterpret_cast<unsigned*>((unsigned char*)H + (size_t)row * D + col) = pk_fp8x4(o[0] * F8_SH, o[1] * F8_SH, o[2] * F8_SH, o[3] * F8_SH);
            v[i] = o;
        }
        float lg[16];
        rowdot16(v, R, lane, lg);
        const bool b5 = lane & 32, b4 = lane & 16, b3 = lane & 8, b2 = lane & 4;
        float t8[8], t4[4], t2[2], lgt;
#pragma unroll
        for (int j = 0; j < 8; ++j) { const float keep = b5 ? lg[8 + j] : lg[j], send = b5 ? lg[j] : lg[8 + j]; t8[j] = keep + partner_x32(send); }
#pragma unroll
        for (int j = 0; j < 4; ++j) { const float keep = b4 ? t8[4 + j] : t8[j], send = b4 ? t8[j] : t8[4 + j]; t4[j] = keep + partner_x16(send); }
#pragma unroll
        for (int j = 0; j < 2; ++j) { const float keep = b3 ? t4[2 + j] : t4[j], send = b3 ? t4[j] : t4[2 + j]; t2[j] = keep + dpp_f<0x140>(send); }
        { const float keep = b2 ? t2[1] : t2[0], send = b2 ? t2[0] : t2[1]; lgt = keep + dpp_f<0x141>(send); }
        lgt += dpp_f<0x4E>(lgt); lgt += dpp_f<0xB1>(lgt);
        const float mx = wave_max(lgt);
        const float pe = __expf(lgt - mx);
        const float den = wave_sum(pe) * 0.25f;
        if ((lane & 3) == 0) AFF[(size_t)row * 16 + ((b5 ? 8 : 0) + (b4 ? 4 : 0) + (b3 ? 2 : 0) + (b2 ? 1 : 0))] = pe / den;
    }
#undef RP_FETCH
}

__device__ __forceinline__ void phase_topk(const Params& p, int l, unsigned char* lds) {
    unsigned char* const ws = ws_();
    unsigned* keys = (unsigned*)lds;
    unsigned* hist = keys + 4096;
    unsigned* misc = hist + 256;
    const int t = tid_(), lane = t & 63, w = t >> 6;
    const float* AFF = (const float*)(ws + WS_AFF);
    int* SLOT = (int*)(ws + WS_SLOT);
    int* EROW = (int*)(ws + WS_EROW);
    float* EGATE = (float*)(ws + WS_EGATE);
    const int nitems = l == 0 ? 128 : 64;
    for (int item = bid_(); item < nitems; item += gdim_()) {
        const int kind = item >> 6, b = (item >> 4) & 3, ex = item & 15;
        const int n = kind ? LC : SEQ, cap = n / 8, rowbase = kind ? NLAT + b * LC : b * SEQ;
        __syncthreads();
        for (int i = t; i < n; i += NT) keys[i] = __float_as_uint(AFF[(size_t)(rowbase + i) * 16 + ex]);
        unsigned prefix = 0u, mask = 0u; int kth = cap;
        for (int shift = 24; shift >= 0; shift -= 8) {
            __syncthreads();
            if (t < 256) hist[t] = 0u;
            __syncthreads();
            for (int i = t; i < n; i += NT) { const unsigned k = keys[i]; if ((k & mask) == prefix) atomicAdd(&hist[(k >> shift) & 255u], 1u); }
            __syncthreads();
            if (t < 256) {
                unsigned above = 0u;
                for (int d2 = t + 1; d2 < 256; ++d2) above += hist[d2];
                const unsigned here = hist[t];
                if ((int)above < kth && (int)(above + here) >= kth) { misc[0] = (unsigned)t; misc[1] = (unsigned)(kth - (int)above); }
            }
            __syncthreads();
            prefix |= misc[0] << shift; mask |= 255u << shift; kth = (int)misc[1];
        }
        const unsigned T = prefix; const int need_eq = kth;
        int cgt = 0, ceq = 0;
        const int base = t * 8;
        if (base < n) {
#pragma unroll
            for (int q = 0; q < 8; ++q) { const unsigned k = keys[base + q]; cgt += (k > T); ceq += (k == T); }
        }
        int packed = cgt | (ceq << 16);
        int incl = packed;
#pragma unroll
        for (int o = 1; o < 64; o <<= 1) { const int nb = __shfl_up(incl, o, 64); if (lane >= o) incl += nb; }
        __syncthreads();
        if (lane == 63) misc[8 + w] = (unsigned)incl;
        __syncthreads();
        int woff = 0, total = 0;
#pragma unroll
        for (int q = 0; q < 8; ++q) { const int v = (int)misc[8 + q]; if (q < w) woff += v; total += v; }
        const int excl = woff + incl - packed;
        int pgt = excl & 0xffff, peq = excl >> 16;
        const int tot_gt = total & 0xffff;
        const int sbase = kind ? 2048 + b * 32 : b * 512;
        if (base < n) {
#pragma unroll
            for (int q = 0; q < 8; ++q) {
                const unsigned k = keys[base + q];
                const int row = rowbase + base + q;
                int pos = -1;
                if (k > T) { pos = pgt; ++pgt; }
                else if (k == T) { if (peq < need_eq) pos = tot_gt + peq; ++peq; }
                if (pos >= 0) { const int sl = sbase + pos; EROW[ex * EPAD + sl] = row; EGATE[ex * EPAD + sl] = __uint_as_float(k); SLOT[(size_t)row * 16 + ex] = sl; }
                else SLOT[(size_t)row * 16 + ex] = -1;
            }
        }
        if (kind == 1 && b == 3) for (int i = t; i < EPAD - 2176; i += NT) EROW[ex * EPAD + 2176 + i] = rowbase;
    }
}

__device__ __forceinline__ void phase_final(const Params& p, int l) {
    unsigned char* const ws = ws_();
    const int lane = tid_() & 63, w = __builtin_amdgcn_readfirstlane(tid_() >> 6);
    const int nrows = l == 0 ? NTOK : NLAT;
    const u16* YEXP = (const u16*)(ws + WS_YEXP);
    const int* SLOT = (const int*)(ws + WS_SLOT);
    const u16* XL1 = (const u16*)(ws + WS_XL1);
    u16* XL2 = (u16*)(ws + WS_XL2);
    u16* H = (u16*)(ws + WS_H);
    const int stride = gdim_() * 8;
    struct Pre { u32x2 xl[8], q0[8], q1[8]; };
    auto slots_of = [&](int row) -> int { const int s = SLOT[(size_t)min(row, nrows - 1) * 16 + (lane & 15)]; return (row < nrows && lane < 16) ? s : -1; };
    auto prefetch = [&](int row, int myslot, Pre& pr) {
        const int rc = min(row, nrows - 1);
        unsigned long long em = __ballot(myslot >= 0);
        const int e0 = em ? __builtin_ctzll(em) : 0; em &= em - 1;
        const int e1 = em ? __builtin_ctzll(em) : e0;
        const int sl0 = max(__shfl(myslot, e0, 64), 0), sl1 = max(__shfl(myslot, e1, 64), 0);
        const u16* y0 = YEXP + ((size_t)e0 * EPAD + sl0) * D; const u16* y1 = YEXP + ((size_t)e1 * EPAD + sl1) * D;
#pragma unroll
        for (int i = 0; i < 8; ++i) pr.xl[i] = __builtin_nontemporal_load(reinterpret_cast<const u32x2*>(XL1 + (size_t)rc * D + (i * 64 + lane) * 4));
#pragma unroll
        for (int i = 0; i < 8; ++i) { pr.q0[i] = __builtin_nontemporal_load(reinterpret_cast<const u32x2*>(y0 + (i * 64 + lane) * 4)); pr.q1[i] = __builtin_nontemporal_load(reinterpret_cast<const u32x2*>(y1 + (i * 64 + lane) * 4)); }
    };
    int row = bid_() * 8 + w;
    int slot_c = slots_of(row), slot_n = slots_of(row + stride);
    Pre cur; prefetch(row, slot_c, cur);
    for (; row < nrows; row += stride) {
        const int slot_nn = slots_of(row + 2 * stride);
        Pre nxt; prefetch(row + stride, slot_n, nxt);
        f32x4 v[8];
#pragma unroll
        for (int i = 0; i < 8; ++i) v[i] = (f32x4){0.f, 0.f, 0.f, 0.f};
        unsigned long long em = __ballot(slot_c >= 0);
        if (em) {
            em &= em - 1;
            const float f1 = em ? 1.f : 0.f;
            if (em) em &= em - 1;
#pragma unroll
            for (int i = 0; i < 8; ++i) {
                v[i][0] = bf_lo(cur.q0[i][0]) + f1 * bf_lo(cur.q1[i][0]); v[i][1] = bf_hi(cur.q0[i][0]) + f1 * bf_hi(cur.q1[i][0]);
                v[i][2] = bf_lo(cur.q0[i][1]) + f1 * bf_lo(cur.q1[i][1]); v[i][3] = bf_hi(cur.q0[i][1]) + f1 * bf_hi(cur.q1[i][1]);
            }
        }
        while (em) {
            const int e0 = __builtin_ctzll(em); em &= em - 1;
            const int sl0 = __shfl(slot_c, e0, 64);
            const u16* y0 = YEXP + ((size_t)e0 * EPAD + sl0) * D;
#pragma unroll
            for (int i = 0; i < 8; ++i) { const u32x2 q = *reinterpret_cast<const u32x2*>(y0 + (i * 64 + lane) * 4); v[i][0] += bf_lo(q[0]); v[i][1] += bf_hi(q[0]); v[i][2] += bf_lo(q[1]); v[i][3] += bf_hi(q[1]); }
        }
        float ss = 0.f;
#pragma unroll
        for (int i = 0; i < 8; ++i) ss += v[i][0] * v[i][0] + v[i][1] * v[i][1] + v[i][2] * v[i][2] + v[i][3] * v[i][3];
        ss = wave_sum(ss);
        const float rstd = rsqrtf(ss * (1.f / D) + 1e-6f);
        const float* g2 = mod_ptr(ws, l, row, 5);
        const float* nw = p.norm_ffn_post + (size_t)l * D;
        float ss2 = 0.f;
#pragma unroll
        for (int i = 0; i < 8; ++i) {
            const int col = (i * 64 + lane) * 4;
            const f32x4 x4 = {bf_lo(cur.xl[i][0]), bf_hi(cur.xl[i][0]), bf_lo(cur.xl[i][1]), bf_hi(cur.xl[i][1])};
            const f32x4 w4 = *reinterpret_cast<const f32x4*>(nw + col), g4 = *reinterpret_cast<const f32x4*>(g2 + col);
            const f32x4 x2 = x4 + g4 * (v[i] * rstd * w4);
            if (l == 0) { const u32x2 pk2 = {pk_bf16(x2[0], x2[1]), pk_bf16(x2[2], x2[3])}; *reinterpret_cast<u32x2*>(XL2 + (size_t)row * D + col) = pk2; }
            else *reinterpret_cast<f32x4*>(p.out + (size_t)row * D + col) = x2;
            v[i] = x2; ss2 += x2[0] * x2[0] + x2[1] * x2[1] + x2[2] * x2[2] + x2[3] * x2[3];
        }
        if (l == 0) {
            ss2 = wave_sum(ss2);
            const float rstd2 = rsqrtf(ss2 * (1.f / D) + 1e-6f);
            const float* sh = mod_ptr(ws, 1, row, 0); const float* sc = mod_ptr(ws, 1, row, 1);
            const float* nw1 = p.norm_mix_pre + D;
#pragma unroll
            for (int i = 0; i < 8; ++i) {
                const int col = (i * 64 + lane) * 4;
                const f32x4 w4 = *reinterpret_cast<const f32x4*>(nw1 + col), s4 = *reinterpret_cast<const f32x4*>(sc + col), h4 = *reinterpret_cast<const f32x4*>(sh + col);
                const f32x4 o = v[i] * rstd2 * w4 * (s4 + 1.f) + h4;
                if (WIN_F8_L1) *reinterpret_cast<unsigned*>((unsigned char*)H + (size_t)row * D + col) = pk_fp8x4(o[0] * F8_SH, o[1] * F8_SH, o[2] * F8_SH, o[3] * F8_SH);
                else { const u32x2 pk = {pk_bf16(o[0], o[1]), pk_bf16(o[2], o[3])}; *reinterpret_cast<u32x2*>(H + (size_t)row * D + col) = pk; }
            }
        }
        cur = nxt; slot_c = slot_n; slot_n = slot_nn;
    }
}

__global__ void __launch_bounds__(NT, 2) fwd_kernel(Params p) {
    unsigned char* lds = g_lds;
    unsigned char* wlds = lds + 512;
    if (threadIdx.x == 0) { *reinterpret_cast<uint4*>(lds) = make_uint4(0u, 0u, 0u, 0u); ((volatile LAS int*)(g_lds))[4] = (int)blockIdx.x; ((volatile LAS int*)(g_lds))[5] = (int)gridDim.x; *(volatile LAS unsigned long long*)((LAS unsigned char*)(g_lds) + 24) = (unsigned long long)p.ws; }
    if ((threadIdx.x & 63) == 0) ((volatile LAS int*)(g_lds))[8 + hw_slot_()] = threadIdx.x >> 6;
    __syncthreads();
    (void)xcd_barrier_post((unsigned*)(ws_() + WS_BAR), (volatile LAS unsigned*)lds);
#define GRID_BARRIER() do { XcdBarrier _b; _b.bar = (unsigned*)(ws_() + WS_BAR); _b.x = xb_xcc_id(); _b.st = (volatile LAS unsigned*)lds; xcd_barrier(_b); } while (0)
#ifndef PH_MASK
#define PH_MASK 0xFFFFFFFFu
#endif
#ifndef PROBE_REP_MASK
#define PROBE_REP_MASK 0u
#endif
#define PHASE(id, body) do { if (((PH_MASK >> ((id) % 32)) & 1u) && p.ph_lo <= (id) && (id) < p.ph_hi) { \
    for (int _r = 0; _r < ((((unsigned)PROBE_REP_MASK >> ((id) % 32)) & 1u) ? 2 : 1); ++_r) { body; if ((id) + 1 < p.ph_hi || _r == 0) { if ((id) + 1 < p.ph_hi) GRID_BARRIER(); } } } } while (0)
    PHASE(0, { phase_mod(p, wlds); phase_convert_dense(p, wlds); });
    PHASE(1, { phase_norm_mod(p, 0, wlds); lru_prep_weights(p); rope_prep(p); });
    {
        constexpr int l = 0, pb = 2;
        if (WIN_F8_L0 && WIN_L0_BF16_COLS) {
            PHASE(pb + 0, { phase_gemm_dense<false>(p, (const u16*)(ws_() + WS_H), NTOK, (const u16*)(ws_() + WS_WT_ABIN), WIN_L0_BF16_COLS, (u16*)(ws_() + WS_P), AB_IN, nullptr, wlds);
                            phase_gemm_dense_f8rev(p, (const u16*)(ws_() + WS_H8), NTOK, (const u16*)(ws_() + WS_WT_ABIN8 + (size_t)WIN_L0_BF16_COLS * D), AB_IN - WIN_L0_BF16_COLS,
                                                   (u16*)(ws_() + WS_P) + WIN_L0_BF16_COLS, AB_IN, wlds); });
        } else
        PHASE(pb + 0, phase_gemm_dense<WIN_F8_L0>(p, (const u16*)(ws_() + WS_H), NTOK, (const u16*)(ws_() + WS_WT_ABIN), AB_IN, (u16*)(ws_() + WS_P), AB_IN, nullptr, wlds));
        PHASE(pb + 1, phase_mlstm(p, wlds));
        PHASE(pb + 2, phase_l0_stage2(p, wlds));
        PHASE(pb + 4, phase_gemm_dense<true>(p, (const u16*)(ws_() + WS_YIN), NTOK, (const u16*)(ws_() + WS_WT_ABOUT), D, (u16*)(ws_() + WS_Y), D, nullptr, wlds));
        PHASE(pb + 5, phase_rowpass_mid(p, l, wlds));
        PHASE(pb + 6, { phase_topk(p, l, wlds); phase_convert_moe(p, l, wlds); });
        PHASE(pb + 7, phase_moe_a(p, l, wlds));
        PHASE(pb + 8, phase_moe_b(p, l, wlds));
        PHASE(pb + 9, phase_final(p, l));
    }
    {
        constexpr int l = 1, pb = 12;
        PHASE(pb + 0, phase_gemm_dense<WIN_F8_L1>(p, (const u16*)(ws_() + WS_H), NTOK, (const u16*)(ws_() + WS_WT_CDIN), CD_IN, (u16*)(ws_() + WS_P), CD_IN, nullptr, wlds));
        PHASE(pb + 1, phase_l1_stage1(p, wlds));
        PHASE(pb + 2, phase_l1_stage2(p, wlds));
        PHASE(pb + 3, phase_l1_stage3(p, wlds));
        PHASE(pb + 4, phase_gemm_dense<true>(p, (const u16*)(ws_() + WS_YIN), NLAT, (const u16*)(ws_() + WS_WT_CDOUT), D, (u16*)(ws_() + WS_Y), D, nullptr, wlds));
        PHASE(pb + 5, phase_rowpass_mid(p, l, wlds));
        PHASE(pb + 6, { phase_topk(p, l, wlds); phase_convert_moe(p, l, wlds); });
        PHASE(pb + 7, phase_moe_a(p, l, wlds));
        PHASE(pb + 8, phase_moe_b(p, l, wlds));
        PHASE(pb + 9, phase_final(p, l));
    }
}


#ifdef DBG_STOP
__global__ void dbg_digest(const unsigned char* ws, size_t off, int kind, size_t nelem, float* out, size_t nout) {
    for (size_t i = (size_t)blockIdx.x * blockDim.x + threadIdx.x; i < nout; i += (size_t)gridDim.x * blockDim.x) {
        float v = 0.f;
        for (size_t j = i; j < nelem; j += nout) {
            if (kind == 0) v += bf2f(((const u16*)(ws + off))[j]);
            else if (kind == 1) v += ((const float*)(ws + off))[j];
            else v += (float)((const int*)(ws + off))[j];
        }
        out[i] = v;
    }
}
#endif
extern "C" void kernel_launch(void* const* d_in, const int* in_sizes, int n_in, void* d_out, int out_size, void* d_ws, size_t ws_size, hipStream_t stream) {
    static int grid = 0;
    if (grid == 0) {
        if (n_in != 27 || ws_size < WS_END) { fprintf(stderr, "kernel_launch: unexpected n_in %d / ws %zu (need %zu)\n", n_in, ws_size, (size_t)WS_END); grid = -1; return; }
        int dev = 0, cus = 0, per_cu = 0;
        hipGetDevice(&dev);
        hipDeviceGetAttribute(&cus, hipDeviceAttributeMultiprocessorCount, dev);
        if (hipFuncSetAttribute((const void*)fwd_kernel, hipFuncAttributeMaxDynamicSharedMemorySize, LDS_BYTES) != hipSuccess) { fprintf(stderr, "kernel_launch: hipFuncSetAttribute failed\n"); grid = -1; return; }
        hipOccupancyMaxActiveBlocksPerMultiprocessor(&per_cu, (const void*)fwd_kernel, NT, LDS_BYTES);
        (void)hipGetLastError();
        if (per_cu < 1) fprintf(stderr, "kernel_launch: occupancy query reports %d blocks per CU\n", per_cu);
        grid = cus > 0 ? cus : 256;
    }
    if (grid < 0) return;
    hipMemsetAsync((char*)d_ws + WS_BAR, 0, XCD_BAR_WORDS * sizeof(unsigned), stream);
    Params p; memset(&p, 0, sizeof(p));
    const float** f = (const float**)&p;
    for (int i = 0; i < 27; ++i) f[i] = (const float*)d_in[i];
    p.out = (float*)d_out; p.ws = (unsigned char*)d_ws;
#if N_LAUNCH_MODE == 1
    p.ph_lo = 0; p.ph_hi = NPH;
    hipLaunchKernelGGL(fwd_kernel, dim3(grid), dim3(NT), LDS_BYTES, stream, p);
#else
#ifdef DBG_STOP
    for (int ph = 0; ph <= DBG_STOP; ++ph) { p.ph_lo = ph; p.ph_hi = ph + 1; hipLaunchKernelGGL(fwd_kernel, dim3(grid), dim3(NT), LDS_BYTES, stream, p); }
    hipLaunchKernelGGL(dbg_digest, dim3(2048), dim3(256), 0, stream, (const unsigned char*)d_ws, (size_t)DBG_OFF, (int)DBG_KIND, (size_t)DBG_NELEM, (float*)d_out, (size_t)out_size);
#else
    for (int ph = 0; ph < NPH; ++ph) { p.ph_lo = ph; p.ph_hi = ph + 1; hipLaunchKernelGGL(fwd_kernel, dim3(grid), dim3(NT), LDS_BYTES, stream, p); }
#endif
#endif
}
```
